# Optimizing an MI355X kernel written in HIP

```python
import math
import jax
import jax.numpy as jnp
from jax import lax
import numpy as np

D_MODEL = 1024
BATCH = 4
SEQ = 4096
DEPTH = 4

SSD_HEADS = 16
SSD_HEAD_DIM = 64
SSD_WIDTH = SSD_HEADS * SSD_HEAD_DIM
SSD_GROUPS = 2
SSD_STATE = 128
SSD_BC = SSD_GROUPS * SSD_STATE
SSD_XBC = SSD_WIDTH + 2 * SSD_BC
SSD_CONV = 4
SSD_CHUNK = 128
GDN_HEADS = 4
GDN_HEAD_DIM = 128
GDN_WIDTH = GDN_HEADS * GDN_HEAD_DIM
GDN_CONV = 4
GDN_CHUNK = 64
HG_HEADS = 4
HG_HEAD_DIM = 128
HG_WIDTH = HG_HEADS * HG_HEAD_DIM
HG_CHUNK = 16
D_MIX = SSD_WIDTH + GDN_WIDTH + HG_WIDTH
IN_COLS = SSD_WIDTH + SSD_XBC + SSD_HEADS + 4 * GDN_WIDTH + 2 * GDN_HEADS + 4 * HG_WIDTH
MOE_GROUPS = 4
EXPERTS_PER_GROUP = 4
N_EXPERTS = MOE_GROUPS * EXPERTS_PER_GROUP
MOE_TOP_K = 2
D_EXPERT = 256
DN_ALPHA = (2 * DEPTH) ** 0.25
DN_BETA = (8 * DEPTH) ** -0.25

kernel_name = 'hymba_style_ssd_gdn_hgrn2_hmoe_deepnorm'


def _in_proj_splits():
    sizes = (SSD_WIDTH, SSD_XBC, SSD_HEADS, 3 * GDN_WIDTH, GDN_WIDTH, GDN_HEADS, GDN_HEADS,
             HG_WIDTH, HG_WIDTH, HG_WIDTH, HG_WIDTH)
    pts, acc = [], 0
    for s in sizes[:-1]:
        acc += s
        pts.append(acc)
    return pts


def _layer_norm(x, g, b, eps=1e-5):
    xf = x.astype(jnp.float32)
    mu = jnp.mean(xf, axis=-1, keepdims=True)
    var = jnp.mean(jnp.square(xf - mu), axis=-1, keepdims=True)
    return ((xf - mu) * lax.rsqrt(var + eps) * g.astype(jnp.float32) + b.astype(jnp.float32)).astype(x.dtype)


def _rms_normalize(x, eps=1e-6):
    xf = x.astype(jnp.float32)
    return xf * lax.rsqrt(jnp.mean(xf * xf, axis=-1, keepdims=True) + eps)


def _l2_normalize(x, eps=1e-6):
    return x * lax.rsqrt(jnp.sum(x * x, axis=-1, keepdims=True) + eps)


def _causal_conv(x, w):
    k = w.shape[0]
    seq = x.shape[1]
    xp = jnp.pad(x, ((0, 0), (k - 1, 0), (0, 0)))
    out = xp[:, 0:seq, :] * w[0]
    for i in range(1, k):
        out = out + xp[:, i:i + seq, :] * w[i]
    return out


def ssd_mixer(z, xbc, dt_raw, conv_w, conv_b, dt_bias, a_log, d_skip, norm_w):
    f32 = jnp.float32
    bsz, seq, _ = z.shape
    nc, cl = seq // SSD_CHUNK, SSD_CHUNK
    g, hg, p, n = SSD_GROUPS, SSD_HEADS // SSD_GROUPS, SSD_HEAD_DIM, SSD_STATE
    xbc = jax.nn.silu(_causal_conv(xbc, conv_w) + conv_b).astype(f32)
    xs, bm, cm = jnp.split(xbc, [SSD_WIDTH, SSD_WIDTH + SSD_BC], axis=-1)
    xs = xs.reshape(bsz, nc, cl, g, hg, p)
    bm = bm.reshape(bsz, nc, cl, g, n)
    cm = cm.reshape(bsz, nc, cl, g, n)
    dt = jax.nn.softplus(dt_raw.astype(f32) + dt_bias.astype(f32)).reshape(bsz, nc, cl, g, hg)
    a = -jnp.exp(a_log.astype(f32)).reshape(g, hg)
    acum = jnp.cumsum(dt * a, axis=2)
    xdt = xs * dt[..., None]
    causal = jnp.tril(jnp.ones((cl, cl), dtype=bool))[:, :, None, None]
    seg = acum[:, :, :, None] - acum[:, :, None, :]
    decay = jnp.exp(jnp.where(causal, seg, -jnp.inf))
    cb = jnp.einsum('bclgn,bcsgn->bclsg', cm, bm)
    y_diag = jnp.einsum('bclsgh,bcsghp->bclghp', cb[..., None] * decay, xdt)
    to_end = jnp.exp(acum[:, :, -1:] - acum)
    chunk_states = jnp.einsum('bclgn,bclghp->bcghpn', bm, xdt * to_end[..., None])
    chunk_decay = jnp.exp(acum[:, :, -1])

    def step(state, inp):
        cs, cd = inp
        return state * cd[..., None, None] + cs, state

    init = jnp.zeros((bsz, g, hg, p, n), f32)
    _, prev = lax.scan(step, init, (jnp.moveaxis(chunk_states, 1, 0), jnp.moveaxis(chunk_decay, 1, 0)))
    prev = jnp.moveaxis(prev, 0, 1)
    y_off = jnp.einsum('bclgn,bcghpn->bclghp', cm, prev) * jnp.exp(acum)[..., None]
    y = y_diag + y_off + xs * d_skip.astype(f32).reshape(g, hg, 1)
    y = y.reshape(bsz, seq, SSD_WIDTH) * jax.nn.silu(z.astype(f32))
    y = _rms_normalize(y.reshape(bsz, seq, g, SSD_WIDTH // g)).reshape(bsz, seq, SSD_WIDTH)
    return (y * norm_w.astype(f32)).astype(z.dtype)


def gdn_mixer(qkv, gate, b_raw, a_raw, conv_w, dt_bias, a_log, norm_w):
    f32 = jnp.float32
    bsz, seq, _ = qkv.shape
    nh, dh, cl = GDN_HEADS, GDN_HEAD_DIM, GDN_CHUNK
    nc = seq // cl
    qkv = jax.nn.silu(_causal_conv(qkv, conv_w)).astype(f32)
    q, k, v = jnp.split(qkv, 3, axis=-1)

    def heads(t):
        return t.reshape(bsz, nc, cl, nh, dh).transpose(0, 3, 1, 2, 4)

    q = _l2_normalize(heads(q)) * (dh ** -0.5)
    k = _l2_normalize(heads(k))
    v = heads(v)
    beta = jax.nn.sigmoid(b_raw.astype(f32)).reshape(bsz, nc, cl, nh).transpose(0, 3, 1, 2)
    log_a = -jnp.exp(a_log.astype(f32)) * jax.nn.softplus(a_raw.astype(f32) + dt_bias.astype(f32))
    gcum = jnp.cumsum(log_a.reshape(bsz, nc, cl, nh).transpose(0, 3, 1, 2), axis=-1)
    incl = jnp.tril(jnp.ones((cl, cl), dtype=bool))
    strict = jnp.tril(jnp.ones((cl, cl), dtype=bool), -1)
    decay = jnp.exp(jnp.where(incl, gcum[..., :, None] - gcum[..., None, :], -jnp.inf))
    kb = k * beta[..., None]
    m = jnp.where(strict, jnp.einsum('bhnid,bhnjd->bhnij', kb, k) * decay, 0.0)
    a_mat = m + jnp.eye(cl, dtype=f32)
    rhs = jnp.concatenate([v * beta[..., None], kb * jnp.exp(gcum)[..., None]], axis=-1)
    sol = lax.linalg.triangular_solve(a_mat, rhs, left_side=True, lower=True, unit_diagonal=True)
    u, w = jnp.split(sol, 2, axis=-1)
    qk = jnp.einsum('bhnid,bhnjd->bhnij', q, k) * decay
    qg = q * jnp.exp(gcum)[..., None]
    kd = k * jnp.exp(gcum[..., -1:] - gcum)[..., None]
    gl = jnp.exp(gcum[..., -1])

    def step(state, inp):
        u_c, w_c, qk_c, qg_c, kd_c, gl_c = inp
        v_new = u_c - jnp.einsum('bhcd,bhde->bhce', w_c, state)
        o = jnp.einsum('bhcd,bhde->bhce', qg_c, state) + jnp.einsum('bhij,bhje->bhie', qk_c, v_new)
        state = state * gl_c[..., None, None] + jnp.einsum('bhcd,bhce->bhde', kd_c, v_new)
        return state, o

    init = jnp.zeros((bsz, nh, dh, dh), f32)
    _, o = lax.scan(step, init, tuple(jnp.moveaxis(t, 2, 0) for t in (u, w, qk, qg, kd, gl)))
    o = jnp.moveaxis(o, 0, 2).transpose(0, 2, 3, 1, 4).reshape(bsz, seq, nh, dh)
    o = _rms_normalize(o) * norm_w.astype(f32) * jax.nn.silu(gate.astype(f32).reshape(bsz, seq, nh, dh))
    return o.reshape(bsz, seq, GDN_WIDTH).astype(qkv.dtype)


def hgrn2_mixer(q_raw, f_raw, i_raw, gate, lb, norm_w):
    f32 = jnp.float32
    bsz, seq, _ = q_raw.shape
    nh, dk, cl = HG_HEADS, HG_HEAD_DIM, HG_CHUNK
    nc = seq // cl
    f_raw = f_raw.astype(f32)
    lb = lb.astype(f32)
    log_f = jnp.logaddexp(jnp.log(lb), jnp.log1p(-lb) + jax.nn.log_sigmoid(f_raw))
    key_in = (1.0 - lb) * jax.nn.sigmoid(-f_raw)

    def heads(t):
        return t.astype(f32).reshape(bsz, nc, cl, nh, dk).transpose(0, 3, 1, 2, 4)

    q = heads(jax.nn.silu(q_raw.astype(f32)))
    k = heads(key_in)
    v = heads(i_raw)
    bcum = jnp.cumsum(heads(log_f), axis=3)
    causal = jnp.tril(jnp.ones((cl, cl), dtype=bool))[:, :, None]
    seg = bcum[:, :, :, :, None, :] - bcum[:, :, :, None, :, :]
    decay = jnp.exp(jnp.where(causal, seg, -jnp.inf))
    scores = jnp.einsum('bhntsd,bhnsd->bhnts', q[:, :, :, :, None, :] * decay, k)
    o_intra = jnp.einsum('bhnts,bhnse->bhnte', scores, v)
    qg = q * jnp.exp(bcum)
    kd = k * jnp.exp(bcum[:, :, :, -1:] - bcum)
    gl = jnp.exp(bcum[:, :, :, -1])

    def step(state, inp):
        qg_c, kd_c, v_c, gl_c = inp
        o = jnp.einsum('bhtd,bhde->bhte', qg_c, state)
        state = state * gl_c[..., None] + jnp.einsum('bhsd,bhse->bhde', kd_c, v_c)
        return state, o

    init = jnp.zeros((bsz, nh, dk, dk), f32)
    _, o_inter = lax.scan(step, init, tuple(jnp.moveaxis(t, 2, 0) for t in (qg, kd, v, gl)))
    o = o_intra + jnp.moveaxis(o_inter, 0, 2)
    o = o.transpose(0, 2, 3, 1, 4).reshape(bsz, seq, nh, dk)
    o = _rms_normalize(o) * norm_w.astype(f32) * jax.nn.silu(gate.astype(f32).reshape(bsz, seq, nh, dk))
    return o.reshape(bsz, seq, HG_WIDTH).astype(q_raw.dtype)


def hier_moe(x, w_rg, b_rg, w_re, b_re, w_gu, w_dn):
    f32 = jnp.float32
    bsz, seq, d = x.shape
    t = x.reshape(-1, d)
    pg = jax.nn.softmax((t @ w_rg).astype(f32) + b_rg.astype(f32), axis=-1)
    g_p, g_idx = lax.top_k(pg, 1)
    le = ((t @ w_re).astype(f32) + b_re.astype(f32)).reshape(-1, MOE_GROUPS, EXPERTS_PER_GROUP)
    le = jnp.take_along_axis(le, g_idx[:, :, None], axis=1)[:, 0]
    pe = jax.nn.softmax(le, axis=-1)
    e_p, e_idx = lax.top_k(pe, MOE_TOP_K)
    wts = g_p * e_p / jnp.sum(e_p, axis=-1, keepdims=True)
    eid = g_idx * EXPERTS_PER_GROUP + e_idx
    combine = jnp.sum(jax.nn.one_hot(eid, N_EXPERTS, dtype=f32) * wts[..., None], axis=1)
    gu = jnp.einsum('td,edf->tef', t, w_gu)
    g_half, u_half = jnp.split(gu, 2, axis=-1)
    h = jax.nn.silu(g_half) * u_half * combine[..., None].astype(t.dtype)
    y = jnp.einsum('tef,efd->td', h, w_dn)
    return y.reshape(bsz, seq, d)


def setup_inputs(seed: int = 0) -> dict:
    key = jax.random.key(seed)
    ks = jax.random.split(key, 32)
    f32 = jnp.float32

    def nrm(k, shape, s):
        return jax.random.normal(k, shape, f32) * s

    def dt_bias_init(k, n_heads):
        u = jax.random.uniform(k, (DEPTH, n_heads), f32)
        dt = jnp.exp(u * (math.log(0.1) - math.log(0.001)) + math.log(0.001))
        dt = jnp.maximum(dt, 1e-4)
        return dt + jnp.log(-jnp.expm1(-dt))

    return {
        'x': nrm(ks[0], (BATCH, SEQ, D_MODEL), 1.0),
        'w_in': nrm(ks[1], (DEPTH, D_MODEL, IN_COLS), D_MODEL ** -0.5),
        'ssd_conv_w': nrm(ks[2], (DEPTH, SSD_CONV, SSD_XBC), SSD_CONV ** -0.5),
        'ssd_conv_b': nrm(ks[3], (DEPTH, SSD_XBC), 0.02),
        'ssd_dt_bias': dt_bias_init(ks[4], SSD_HEADS),
        'ssd_a_log': jnp.log(jax.random.uniform(ks[5], (DEPTH, SSD_HEADS), f32, 1.0, 16.0)),
        'ssd_d': 1.0 + nrm(ks[6], (DEPTH, SSD_HEADS), 0.02),
        'ssd_norm_w': 1.0 + nrm(ks[7], (DEPTH, SSD_WIDTH), 0.02),
        'gdn_conv_w': nrm(ks[8], (DEPTH, GDN_CONV, 3 * GDN_WIDTH), GDN_CONV ** -0.5),
        'gdn_dt_bias': dt_bias_init(ks[9], GDN_HEADS),
        'gdn_a_log': jnp.log(jax.random.uniform(ks[10], (DEPTH, GDN_HEADS), f32, 1.0, 16.0)),
        'gdn_norm_w': 1.0 + nrm(ks[11], (DEPTH, GDN_HEAD_DIM), 0.02),
        'hg_lb_logits': nrm(ks[12], (DEPTH, HG_WIDTH), 0.1),
        'hg_norm_w': 1.0 + nrm(ks[13], (DEPTH, HG_HEAD_DIM), 0.02),
        'w_out': nrm(ks[14], (DEPTH, D_MIX, D_MODEL), DN_BETA * D_MIX ** -0.5),
        'ln1_g': 1.0 + nrm(ks[15], (DEPTH, D_MODEL), 0.02),
        'ln1_b': nrm(ks[16], (DEPTH, D_MODEL), 0.02),
        'w_router_group': nrm(ks[17], (DEPTH, D_MODEL, MOE_GROUPS), D_MODEL ** -0.5),
        'b_router_group': nrm(ks[18], (DEPTH, MOE_GROUPS), 0.01),
        'w_router_expert': nrm(ks[19], (DEPTH, D_MODEL, N_EXPERTS), D_MODEL ** -0.5),
        'b_router_expert': nrm(ks[20], (DEPTH, N_EXPERTS), 0.01),
        'w_expert_gate_up': nrm(ks[21], (DEPTH, N_EXPERTS, D_MODEL, 2 * D_EXPERT), D_MODEL ** -0.5),
        'w_expert_down': nrm(ks[22], (DEPTH, N_EXPERTS, D_EXPERT, D_MODEL), DN_BETA * D_EXPERT ** -0.5),
        'ln2_g': 1.0 + nrm(ks[23], (DEPTH, D_MODEL), 0.02),
        'ln2_b': nrm(ks[24], (DEPTH, D_MODEL), 0.02),
    }


def reference(x, w_in, ssd_conv_w, ssd_conv_b, ssd_dt_bias, ssd_a_log, ssd_d, ssd_norm_w,
              gdn_conv_w, gdn_dt_bias, gdn_a_log, gdn_norm_w, hg_lb_logits, hg_norm_w, w_out,
              ln1_g, ln1_b, w_router_group, b_router_group, w_router_expert, b_router_expert,
              w_expert_gate_up, w_expert_down, ln2_g, ln2_b):
    splits = _in_proj_splits()
    lb_cum = jnp.cumsum(jax.nn.softmax(hg_lb_logits.astype(jnp.float32), axis=0), axis=0)
    lb_all = lb_cum - lb_cum[0:1]
    h = x
    for l in range(DEPTH):
        proj = jnp.einsum('bld,dc->blc', h, w_in[l])
        (z, xbc, dt_raw, qkv, gdn_gate, gdn_b, gdn_a,
         hg_q, hg_f, hg_i, hg_gate) = jnp.split(proj, splits, axis=-1)
        y_ssd = ssd_mixer(z, xbc, dt_raw, ssd_conv_w[l], ssd_conv_b[l], ssd_dt_bias[l],
                          ssd_a_log[l], ssd_d[l], ssd_norm_w[l])
        y_gdn = gdn_mixer(qkv, gdn_gate, gdn_b, gdn_a, gdn_conv_w[l], gdn_dt_bias[l],
                          gdn_a_log[l], gdn_norm_w[l])
        y_hg = hgrn2_mixer(hg_q, hg_f, hg_i, hg_gate, lb_all[l], hg_norm_w[l])
        mix = jnp.einsum('blc,cd->bld', jnp.concatenate([y_ssd, y_gdn, y_hg], axis=-1), w_out[l])
        h = _layer_norm(DN_ALPHA * h + mix, ln1_g[l], ln1_b[l])
        ffn = hier_moe(h, w_router_group[l], b_router_group[l], w_router_expert[l],
                       b_router_expert[l], w_expert_gate_up[l], w_expert_down[l])
        h = _layer_norm(DN_ALPHA * h + ffn, ln2_g[l], ln2_b[l])
    return h
```

```cpp
#include <hip/hip_runtime.h>
#include <cstdio>
#include <cstdint>
namespace pg8 {
#define PG8_LAS __attribute__((address_space(3)))
typedef unsigned short bf16_t;
typedef short bf16x8 __attribute__((ext_vector_type(8)));
typedef float f32x4 __attribute__((ext_vector_type(4)));
typedef unsigned u32x4 __attribute__((ext_vector_type(4)));
constexpr int BM = 256, BK = 64, HALF = 128, HTB = HALF * BK * 2  , STAGE_BYTES = 8 * HTB, NXCD = 8, WGM = 8;

__host__ __device__ __forceinline__ int lds_byte(int r, int c) { const int st = (r >> 4) * 2 + (c >> 5), rr = r & 15, cc = c & 31, ob = rr * 64 + cc * 2; return st * 1024 + (ob ^ (((ob >> 9) & 1) << 5)); }
__host__ __device__ __forceinline__ void stage_rc(int b, int& R, int& C) { const int st = b / 1024, sb = b % 1024, swz = sb ^ (((sb >> 9) & 1) << 5); R = (st >> 1) * 16 + swz / 64; C = (st & 1) * 32 + (swz % 64) / 2; }
__host__ __device__ __forceinline__ int perm32(int rho) { const int n = rho >> 4, i = rho & 15; return 8 * (i >> 2) + 4 * n + (i & 3); }

struct Unit { int pm, pn; };
struct Gemm { const bf16_t* A; const bf16_t* Bt; int M, N, K; };

struct StaticOrder {
    int nM, nN, nwg, G, c;
    __host__ __device__ void init(int M, int N, int G_, int c_) { nM = M / BM; nN = N / BM; nwg = nM * nN; G = G_; c = c_; }
    __host__ __device__ bool next(int i, Unit& u) const {
        const long L = (long)i * G + c; if (L >= nwg) return false;
        int wgid = (int)L; { const int q = nwg / NXCD, r = nwg % NXCD, xcd = wgid % NXCD, off = wgid / NXCD; wgid = (xcd < r ? xcd * (q + 1) : r * (q + 1) + (xcd - r) * q) + off; }
        const int nig = WGM * nN, gid = wgid / nig, fm = gid * WGM, gsz = (nM - fm) < WGM ? (nM - fm) : WGM;
        u.pm = fm + ((wgid % nig) % gsz); u.pn = (wgid % nig) / gsz; return true;
    }
    __device__ __forceinline__ void a_ready(const Unit&) const {}
    __device__ __forceinline__ void done(const Unit&) const {}
};
__device__ __forceinline__ unsigned cvt_pk_bf16(float lo, float hi) { unsigned r; asm volatile("v_cvt_pk_bf16_f32 %0, %1, %2" : "=v"(r) : "v"(lo), "v"(hi)); return r; }
typedef float f32x2 __attribute__((ext_vector_type(2)));
__device__ __forceinline__ f32x2 gelu_pk(f32x2 v) {
    const f32x2 av = __builtin_elementwise_abs(v), d = av * 0.2316418882f + 1.0f;
    f32x2 t; t.x = __builtin_amdgcn_rcpf(d.x); t.y = __builtin_amdgcn_rcpf(d.y);
    f32x2 q = t * 0.5307027145f + (-0.7265760135f); q = q * t + 0.7107068705f; q = q * t + (-0.142248368f); q = q * t + 0.127414796f; q = q * t;
    const f32x2 s = (v * v) * (-0.72134752044f);
    f32x2 e; e.x = __builtin_amdgcn_exp2f(s.x); e.y = __builtin_amdgcn_exp2f(s.y);
    const f32x2 m = v * (q * e), r = v - m;
    f32x2 o; o.x = v.x < 0.f ? m.x : r.x; o.y = v.y < 0.f ? m.y : r.y; return o;
}

template <int ACT  > struct EpiBf16 {
    static constexpr bool PERM = true, AFTER_DRAIN = false; static_assert(ACT == 0 || ACT == 1, "EpiBf16: ACT is 0 (none) or 1 (gelu_pk)");
    bf16_t* O; int ldc; const float* bias; int split_cols; size_t split_stride; float scale0;
    __device__ __forceinline__ void operator()(const f32x4 (&acc)[2][2][4][2], const Unit& u, int wr, int wc, int fr, int fq) const {
        const int row0 = u.pm * BM + wr * 64 + fr; int colt = u.pn * BM; bf16_t* base = O;
        float sc = 1.f; if (split_cols) { const int t = colt / split_cols; base += (size_t)t * split_stride; colt -= t * split_cols; if (t == 0) sc = scale0; }
        const int col0 = colt + wc * 32 + 8 * fq, bcol0 = u.pn * BM + wc * 32 + 8 * fq;
        f32x4 bv[2][2];
#pragma unroll
        for (int bj = 0; bj < 2; ++bj)
#pragma unroll
            for (int n = 0; n < 2; ++n) bv[bj][n] = bias ? *(const f32x4*)(bias + bcol0 + bj * HALF + 4 * n) : (f32x4){0.f, 0.f, 0.f, 0.f};
#pragma unroll
        for (int ai = 0; ai < 2; ++ai)
#pragma unroll
            for (int m = 0; m < 4; ++m) { bf16_t* rowp = base + (size_t)(row0 + ai * HALF + m * 16) * ldc + col0;
#pragma unroll
                for (int bj = 0; bj < 2; ++bj) { f32x4 v0 = acc[ai][bj][m][0] + bv[bj][0], v1 = acc[ai][bj][m][1] + bv[bj][1];
                    if (ACT == 1) { f32x2 a = gelu_pk((f32x2){v0[0], v0[1]}), b = gelu_pk((f32x2){v0[2], v0[3]}), c = gelu_pk((f32x2){v1[0], v1[1]}), d = gelu_pk((f32x2){v1[2], v1[3]});
                        v0 = (f32x4){a.x, a.y, b.x, b.y}; v1 = (f32x4){c.x, c.y, d.x, d.y}; }
                    v0 = v0 * sc; v1 = v1 * sc; u32x4 w; w.x = cvt_pk_bf16(v0[0], v0[1]); w.y = cvt_pk_bf16(v0[2], v0[3]); w.z = cvt_pk_bf16(v1[0], v1[1]); w.w = cvt_pk_bf16(v1[2], v1[3]);
                    *(u32x4*)(rowp + bj * HALF) = w; } }
    }
};
struct EpiF32 {
    static constexpr bool PERM = false, AFTER_DRAIN = false;
    float* C; int ldc;
    __device__ __forceinline__ void operator()(const f32x4 (&acc)[2][2][4][2], const Unit& u, int wr, int wc, int fr, int fq) const {
        const int row0 = u.pm * BM + wr * 64 + fr, col0 = u.pn * BM + wc * 32 + 4 * fq;
#pragma unroll
        for (int ai = 0; ai < 2; ++ai)
#pragma unroll
            for (int m = 0; m < 4; ++m) { float* rowp = C + (size_t)(row0 + ai * HALF + m * 16) * ldc + col0;
#pragma unroll
                for (int bj = 0; bj < 2; ++bj)
#pragma unroll
                    for (int n = 0; n < 2; ++n) *(f32x4*)(rowp + bj * HALF + n * 16) = acc[ai][bj][m][n]; }
    }
};
__device__ __forceinline__ float silu_f(float x) { return x / (1.0f + __expf(-x)); }
struct EpiSwiGLU {
    static constexpr bool PERM = true, AFTER_DRAIN = false;
    bf16_t* H; int ldh; const float* comb; int ldcomb;
    __device__ __forceinline__ void operator()(const f32x4 (&acc)[2][2][4][2], const Unit& u, int wr, int wc, int fr, int fq) const {
        const int row0 = u.pm * BM + wr * 64 + fr, col0 = u.pn * 128 + wc * 32 + 8 * fq, e = u.pn >> 1;
#pragma unroll
        for (int ai = 0; ai < 2; ++ai)
#pragma unroll
            for (int m = 0; m < 4; ++m) { const int row = row0 + ai * HALF + m * 16; const float cw = comb[(size_t)row * ldcomb + e];
                const f32x4 g0 = acc[ai][0][m][0], g1 = acc[ai][0][m][1], u0 = acc[ai][1][m][0], u1 = acc[ai][1][m][1];
                f32x4 h0, h1;
#pragma unroll
                for (int j = 0; j < 4; ++j) { h0[j] = silu_f(g0[j]) * u0[j] * cw; h1[j] = silu_f(g1[j]) * u1[j] * cw; }
                u32x4 w; w.x = cvt_pk_bf16(h0[0], h0[1]); w.y = cvt_pk_bf16(h0[2], h0[3]); w.z = cvt_pk_bf16(h1[0], h1[1]); w.w = cvt_pk_bf16(h1[2], h1[3]);
                *(u32x4*)(H + (size_t)row * ldh + col0) = w; }
    }
};
template <class Epi, class Sched, bool ALIGN_EPI = false, bool SP2 = false>
__device__ __forceinline__ void gemm_phase(PG8_LAS unsigned char* lds, const Gemm g, const Sched& S, const Epi& E) {
    int tid_ = threadIdx.x; asm volatile("" : "+v"(tid_));
    const int tid = tid_, wid = __builtin_amdgcn_readfirstlane(tid >> 6), lane = tid & 63, wr = wid >> 2, wc = wid & 3, fr = lane & 15, fq = lane >> 4;
    const int K = g.K, nt = K / BK;
    unsigned voffA[2], voffB[2];
#pragma unroll
    for (int i = 0; i < 2; ++i) { int R, C; stage_rc(tid * 16 + i * 8192, R, C); const int Rb = Epi::PERM ? ((R & ~31) + perm32(R & 31)) : R;
        voffA[i] = (unsigned)(R * K + C) * 2u; voffB[i] = (unsigned)(Rb * K + C) * 2u; }
    const size_t kstep = (size_t)(BK * 2);
    const size_t hstep = (size_t)HALF * K * 2;
    const size_t tstep = 2 * hstep;
    const unsigned ldsw = (unsigned)wid * 1024u;
    const int aoff = lds_byte(wr * 64 + fr, fq * 8), boff = lds_byte(wc * 32 + fr, fq * 8);
#define PG8_SA(b, h) (((b) * 2 + (h)) * HTB)
#define PG8_SB(b, h) ((4 + (b) * 2 + (h)) * HTB)
#define PG8_STAGE(bufoff, gbase, voff) do { _Pragma("unroll") for (int _i = 0; _i < 2; ++_i) \
        __builtin_amdgcn_global_load_lds((const unsigned*)((const char*)(gbase) + (voff)[_i]), (PG8_LAS unsigned*)(lds + (bufoff) + ldsw + _i * 8192), 16, 0, 0); } while (0)
#define PG8_LDA(dst, b, h) do { _Pragma("unroll") for (int m = 0; m < 4; ++m) _Pragma("unroll") for (int k = 0; k < 2; ++k) dst[m][k] = *(const PG8_LAS bf16x8*)(lds + PG8_SA(b, h) + aoff + m * 2048 + k * 1024); } while (0)
#define PG8_LDB(dst, b, h) do { _Pragma("unroll") for (int n = 0; n < 2; ++n) _Pragma("unroll") for (int k = 0; k < 2; ++k) dst[n][k] = *(const PG8_LAS bf16x8*)(lds + PG8_SB(b, h) + boff + n * 2048 + k * 1024); } while (0)
#define PG8_MMA(ai, bj, At, Bt) do { __builtin_amdgcn_s_setprio(1); _Pragma("unroll") for (int m = 0; m < 4; ++m) _Pragma("unroll") for (int n = 0; n < 2; ++n) _Pragma("unroll") for (int k = 0; k < 2; ++k) \
        acc[ai][bj][m][n] = __builtin_amdgcn_mfma_f32_16x16x32_bf16(Bt[n][k], At[m][k], acc[ai][bj][m][n], 0, 0, 0); __builtin_amdgcn_s_setprio(0); } while (0)
#define PG8_WAIT_V(n) asm volatile("s_waitcnt vmcnt(" #n ")" ::: "memory")
#define PG8_WAIT_L(n) asm volatile("s_waitcnt lgkmcnt(" #n ")" ::: "memory")
#define PG8_BAR __builtin_amdgcn_s_barrier()
#define PG8_SCHED __builtin_amdgcn_sched_barrier(0)
    Unit cur, nxt; int ui = 0;
    if (!S.next(0, cur)) return;
    f32x4 acc[2][2][4][2];
#pragma unroll
    for (int a = 0; a < 2; ++a)
#pragma unroll
        for (int b = 0; b < 2; ++b)
#pragma unroll
            for (int m = 0; m < 4; ++m)
#pragma unroll
                for (int n = 0; n < 2; ++n) acc[a][b][m][n] = (f32x4){0.f, 0.f, 0.f, 0.f};
    bf16x8 At[4][2], B0[2][2], B1[2][2];
    const char* cA = (const char*)g.A + (size_t)cur.pm * tstep; const char* cB = (const char*)g.Bt + (size_t)cur.pn * tstep;
    S.a_ready(cur);
    if constexpr (SP2) {
        PG8_STAGE(PG8_SB(0, 0), cB, voffB); PG8_STAGE(PG8_SB(0, 1), cB + hstep, voffB); PG8_STAGE(PG8_SA(0, 0), cA, voffA); PG8_STAGE(PG8_SA(0, 1), cA + hstep, voffA);
        if (wr == 1) PG8_BAR;
        PG8_WAIT_V(2); PG8_BAR;
        PG8_STAGE(PG8_SB(1, 0), cB + kstep, voffB); PG8_STAGE(PG8_SA(1, 0), cA + kstep, voffA); PG8_STAGE(PG8_SB(1, 1), cB + hstep + kstep, voffB);
        PG8_WAIT_V(6); PG8_BAR;
    } else {
        PG8_STAGE(PG8_SB(0, 0), cB, voffB); PG8_STAGE(PG8_SA(0, 0), cA, voffA); PG8_STAGE(PG8_SB(0, 1), cB + hstep, voffB); PG8_STAGE(PG8_SA(0, 1), cA + hstep, voffA);
        if (wr == 1) PG8_BAR;
        PG8_WAIT_V(4); PG8_BAR;
        PG8_STAGE(PG8_SB(1, 0), cB + kstep, voffB); PG8_STAGE(PG8_SA(1, 0), cA + kstep, voffA); PG8_STAGE(PG8_SB(1, 1), cB + hstep + kstep, voffB);
        PG8_WAIT_V(6); PG8_BAR;
    }
    for (;;) {
        const bool has_next = S.next(ui + 1, nxt);
        const char* nA = has_next ? (const char*)g.A + (size_t)nxt.pm * tstep : cA; const char* nB = has_next ? (const char*)g.Bt + (size_t)nxt.pn * tstep : cB;
        for (int t = 0; t < nt; t += 2) {
            const bool last = (t == nt - 2);
            const char* a1 = cA + (size_t)(t + 1) * kstep;
            const char* a2 = last ? nA : cA + (size_t)(t + 2) * kstep; const char* b2 = last ? nB : cB + (size_t)(t + 2) * kstep;
            const char* a3 = a2 + kstep; const char* b3 = b2 + kstep;
            if (last && has_next) S.a_ready(nxt);
            if constexpr (SP2) {
            PG8_LDB(B0, 0, 0); PG8_LDB(B1, 0, 1); PG8_SCHED; PG8_LDA(At, 0, 0); PG8_STAGE(PG8_SA(1, 1), a1 + hstep, voffA);
            PG8_WAIT_V(8); PG8_WAIT_L(0); PG8_BAR; PG8_MMA(0, 0, At, B0); PG8_MMA(0, 1, At, B1); PG8_BAR; PG8_SCHED;
            PG8_LDA(At, 0, 1); PG8_STAGE(PG8_SB(0, 0), b2, voffB); PG8_STAGE(PG8_SB(0, 1), b2 + hstep, voffB); PG8_STAGE(PG8_SA(0, 0), a2, voffA);
            PG8_WAIT_V(8); PG8_WAIT_L(0); PG8_BAR; PG8_MMA(1, 0, At, B0); PG8_MMA(1, 1, At, B1); PG8_BAR; PG8_SCHED;
            PG8_LDB(B0, 1, 0); PG8_LDB(B1, 1, 1); PG8_SCHED; PG8_LDA(At, 1, 0); PG8_STAGE(PG8_SA(0, 1), a2 + hstep, voffA);
            PG8_WAIT_V(8); PG8_WAIT_L(0); PG8_BAR; PG8_MMA(0, 0, At, B0); PG8_MMA(0, 1, At, B1); PG8_BAR; PG8_SCHED;
            PG8_LDA(At, 1, 1); PG8_STAGE(PG8_SB(1, 0), b3, voffB); PG8_STAGE(PG8_SB(1, 1), b3 + hstep, voffB); PG8_STAGE(PG8_SA(1, 0), a3, voffA);
            PG8_WAIT_V(8); PG8_WAIT_L(0); PG8_BAR; PG8_MMA(1, 0, At, B0); PG8_MMA(1, 1, At, B1); PG8_BAR; PG8_SCHED;
            } else {
            PG8_LDB(B0, 0, 0); PG8_SCHED; PG8_LDA(At, 0, 0); PG8_STAGE(PG8_SA(1, 1), a1 + hstep, voffA);
            PG8_WAIT_L(8); PG8_BAR; PG8_WAIT_L(0); PG8_MMA(0, 0, At, B0); PG8_BAR; PG8_SCHED;
            PG8_LDB(B1, 0, 1); PG8_STAGE(PG8_SB(0, 0), b2, voffB);
            PG8_BAR; PG8_WAIT_L(0); PG8_MMA(0, 1, At, B1); PG8_BAR;
            PG8_LDA(At, 0, 1); PG8_STAGE(PG8_SA(0, 0), a2, voffA);
            PG8_BAR; PG8_WAIT_L(0); PG8_MMA(1, 0, At, B0); PG8_BAR; PG8_SCHED;
            PG8_STAGE(PG8_SB(0, 1), b2 + hstep, voffB);
            PG8_WAIT_V(6); PG8_BAR; PG8_MMA(1, 1, At, B1); PG8_BAR;
            PG8_LDB(B0, 1, 0); PG8_SCHED; PG8_LDA(At, 1, 0); PG8_STAGE(PG8_SA(0, 1), a2 + hstep, voffA);
            PG8_WAIT_L(8); PG8_BAR; PG8_WAIT_L(0); PG8_MMA(0, 0, At, B0); PG8_BAR; PG8_SCHED;
            PG8_LDB(B1, 1, 1); PG8_STAGE(PG8_SB(1, 0), b3, voffB);
            PG8_BAR; PG8_WAIT_L(0); PG8_MMA(0, 1, At, B1); PG8_BAR;
            PG8_LDA(At, 1, 1); PG8_STAGE(PG8_SA(1, 0), a3, voffA);
            PG8_BAR; PG8_WAIT_L(0); PG8_MMA(1, 0, At, B0); PG8_BAR; PG8_SCHED;
            PG8_STAGE(PG8_SB(1, 1), b3 + hstep, voffB);
            PG8_WAIT_V(6); PG8_BAR; PG8_MMA(1, 1, At, B1); PG8_BAR;
            }
        }
        if constexpr (ALIGN_EPI) { if (wr == 0) PG8_BAR; }
        if constexpr (!Epi::AFTER_DRAIN) { E(acc, cur, wr, wc, fr, fq); S.done(cur); }
        if (!has_next) break;
#pragma unroll
        for (int a = 0; a < 2; ++a)
#pragma unroll
            for (int b = 0; b < 2; ++b)
#pragma unroll
                for (int m = 0; m < 4; ++m)
#pragma unroll
                    for (int n = 0; n < 2; ++n) acc[a][b][m][n] = (f32x4){0.f, 0.f, 0.f, 0.f};
        cur = nxt; cA = nA; cB = nB; ++ui;
        if constexpr (ALIGN_EPI) { if (wr == 1) PG8_BAR; }
    }
    PG8_WAIT_V(0);
    if constexpr (!ALIGN_EPI) { if (wr == 0) PG8_BAR; }
    PG8_BAR;
    if constexpr (Epi::AFTER_DRAIN) { E.fused(acc, cur, wr, wc, fr, fq, lds, wid, lane); S.done(cur); }
#undef PG8_SA
#undef PG8_SB
#undef PG8_STAGE
#undef PG8_LDA
#undef PG8_LDB
#undef PG8_MMA
#undef PG8_WAIT_V
#undef PG8_WAIT_L
#undef PG8_BAR
#undef PG8_SCHED
}
}
#define GAS __attribute__((address_space(1)))
#define LAS __attribute__((address_space(3)))
typedef unsigned short bf16;
typedef unsigned v4u __attribute__((ext_vector_type(4)));
typedef float f32x4 __attribute__((ext_vector_type(4)));
typedef short bf16x8 __attribute__((ext_vector_type(8)));
typedef GAS unsigned gu32;
typedef GAS unsigned long long gu64;
#define RLX_AGENT __ATOMIC_RELAXED, __HIP_MEMORY_SCOPE_AGENT
#define LDS_WAIT() asm volatile("s_waitcnt lgkmcnt(0)" ::: "memory")
#define VM_WAIT() asm volatile("s_waitcnt vmcnt(0)" ::: "memory")
__device__ __forceinline__ unsigned long long rt() { return __builtin_amdgcn_s_memrealtime(); }
__device__ __forceinline__ unsigned f2bf(float f) { unsigned u = __builtin_bit_cast(unsigned, f); return (u + 0x7fffu + ((u >> 16) & 1u)) >> 16; }
__device__ __forceinline__ unsigned pk2(float lo, float hi) { return f2bf(lo) | (f2bf(hi) << 16); }

#define XB_TMO      128
#define XB_XCNT(j)  (256  + 64 * (j))
#define XB_XSUB(j)  (1280 + 64 * (j))
#define XB_XGEN(j)  (2304 + 64 * (j))
#define XB_TOP      3328
#define XB_TOPGEN   3392
#define XCD_BAR_WORDS 3456
#define XB_SPIN_CAP (1u << 18)

__device__ __forceinline__ unsigned xb_ld(unsigned* p)              { return __hip_atomic_load(p, __ATOMIC_RELAXED, __HIP_MEMORY_SCOPE_AGENT); }
__device__ __forceinline__ unsigned xb_add(unsigned* p, unsigned v) { return __hip_atomic_fetch_add(p, v, __ATOMIC_RELAXED, __HIP_MEMORY_SCOPE_AGENT); }
__device__ __forceinline__ unsigned xb_xcc_id() { return (unsigned)__builtin_amdgcn_s_getreg((3 << 11) | 20) & 0xFu; }
#define XB_SPIN(cond, bar) do { unsigned _sp = 0; while (cond) { __builtin_amdgcn_s_sleep(1); \
    if ((++_sp & 255u) == 0u) { if (xb_ld(&(bar)[XB_TMO])) break; if (_sp > XB_SPIN_CAP) { atomicAdd(&(bar)[XB_TMO], 1u); break; } } } } while (0)

struct XcdBarrier {
    unsigned* bar; unsigned x;
    volatile LAS unsigned* st;
};

__device__ __forceinline__ XcdBarrier xcd_barrier_post(unsigned* bar, volatile LAS unsigned* st) {
    XcdBarrier b; b.bar = bar; b.x = xb_xcc_id(); b.st = st;
    if (threadIdx.x == 0) (void)xb_add(&bar[XB_XCNT(b.x)], 1u);
    return b;
}
__device__ __forceinline__ void xcd_barrier_complete(unsigned* bar, unsigned x, unsigned& nloc, unsigned& nx) {
    const unsigned G = gridDim.x * gridDim.y * gridDim.z;
    unsigned sum, cnt, mine, sp = 0u;
    for (;;) {
        sum = 0u; cnt = 0u; mine = 0u;
#pragma unroll
        for (unsigned j = 0; j < 16; ++j) { const unsigned c = xb_ld(&bar[XB_XCNT(j)]); sum += c; cnt += (c > 0u) ? 1u : 0u; mine = (j == x) ? c : mine; }
        if (sum == G) break;
        __builtin_amdgcn_s_sleep(1);
        if ((++sp & 255u) == 0u) { if (xb_ld(&bar[XB_TMO])) break; if (sp > XB_SPIN_CAP) { atomicAdd(&bar[XB_TMO], 1u); break; } }
    }
    nloc = mine > 0u ? mine : 1u; nx = cnt > 0u ? cnt : 1u;
}

__device__ __forceinline__ void xcd_barrier(const XcdBarrier& b) {
    asm volatile("s_waitcnt vmcnt(0)" ::: "memory");
    __syncthreads();
    if (threadIdx.x == 0) {
        unsigned* bar = b.bar;
        __builtin_amdgcn_s_waitcnt(0);
        unsigned nloc = b.st[0], nx = b.st[1];
        if (nloc == 0u) { xcd_barrier_complete(bar, b.x, nloc, nx); b.st[0] = nloc; b.st[1] = nx; }
        const unsigned old = xb_add(&bar[XB_XSUB(b.x)], 1u);
        const unsigned gen = old / nloc;
        if (old + 1u == (gen + 1u) * nloc) {
            __builtin_amdgcn_fence(__ATOMIC_RELEASE, "agent");
            asm volatile("s_waitcnt vmcnt(0)" ::: "memory");
            const unsigned og = xb_add(&bar[XB_TOP], 1u);
            const unsigned tg = og / nx;
            if (og + 1u == (tg + 1u) * nx) xb_add(&bar[XB_TOPGEN], 1u);
            else XB_SPIN(xb_ld(&bar[XB_TOPGEN]) == tg, bar);
            __builtin_amdgcn_fence(__ATOMIC_ACQUIRE, "agent");
            xb_add(&bar[XB_XGEN(b.x)], 1u);
            asm volatile("s_waitcnt vmcnt(0)" ::: "memory");
        } else {
            XB_SPIN(xb_ld(&bar[XB_XGEN(b.x)]) == gen, bar);
            __builtin_amdgcn_fence(__ATOMIC_ACQUIRE, "agent");
            asm volatile("s_waitcnt vmcnt(0)" ::: "memory");
        }
    }
    __syncthreads();
}
constexpr int NWAVES = 8, NTHR = NWAVES * 64;
constexpr int D = 1024, BATCH = 4, SEQ = 4096, M = BATCH * SEQ, DEPTH = 4;
constexpr int IN_COLS = 6680, NPROJ = 6912;
constexpr int O_Z = 0, O_XBC = 1024, O_DT = 2560, O_QKV = 2576, O_GG = 4112, O_GB = 4624, O_GA = 4628, O_HQ = 4632, O_HF = 5144, O_HI = 5656, O_HG = 6168;
constexpr int DMIX = 2048, NEXP = 16, DEXP = 256, NGU = NEXP * 2 * DEXP  , KDN = NEXP * DEXP  ;
constexpr float DN_ALPHA = 1.6817928305074290f;
constexpr float LN_EPS = 1e-5f;

constexpr size_t MiB = 1u << 20;
constexpr size_t WS_CTL = 0, CTL_ZERO_BYTES = 1 * MiB;
constexpr size_t WS_WIN = 2 * MiB;
constexpr size_t WS_WOUT = 56 * MiB;
constexpr size_t WS_WGU = 72 * MiB;
constexpr size_t WS_WDN = 136 * MiB;
constexpr size_t WS_HB = 168 * MiB;
constexpr size_t WS_YMIX = 200 * MiB;
constexpr size_t WS_COMB = 264 * MiB;
constexpr size_t WS_PROJ = 272 * MiB;
constexpr size_t WS_MIX = WS_PROJ;
constexpr size_t WS_H = WS_PROJ + 64 * MiB;
constexpr size_t WS_END = 488 * MiB;
constexpr int CW_BAR = 4096;

constexpr int RING_OFF = 0, RING_BYTES = 131072;
constexpr int LDSCTL_OFF = RING_BYTES, MISC_OFF = LDSCTL_OFF + 320;
constexpr int LDS_BYTES = 147456;

__device__ __forceinline__ float bf2f(unsigned short b) { return __builtin_bit_cast(float, ((unsigned)b) << 16); }
__device__ __forceinline__ float bflo(unsigned w) { return __builtin_bit_cast(float, w << 16); }
__device__ __forceinline__ float bfhi(unsigned w) { return __builtin_bit_cast(float, w & 0xffff0000u); }
__device__ __forceinline__ float siluf(float x) { return x / (1.0f + __expf(-x)); }
__device__ __forceinline__ float sigmoidf_(float x) { return 1.0f / (1.0f + __expf(-x)); }
__device__ __forceinline__ float softplusf_(float x) { return x > 20.f ? x : log1pf(__expf(x)); }
__device__ __forceinline__ float wave_sum(float v) {
#pragma unroll
    for (int o = 1; o < 64; o <<= 1) v += __shfl_xor(v, o);
    return v;
}

struct Args {
    const float* in[25]; float* out; unsigned char* ws; int ph_lo, ph_hi;
};
typedef const __attribute__((address_space(4))) Args* CArgs;
#define ARGS_HERE() ([]() { CArgs p_ = (CArgs)__builtin_amdgcn_kernarg_segment_ptr(); asm volatile("" : "+s"(p_)); return p_; }())
enum { I_X = 0, I_WIN, I_SCW, I_SCB, I_SDTB, I_SALOG, I_SD, I_SNW, I_GCW, I_GDTB, I_GALOG, I_GNW, I_HLB, I_HNW, I_WOUT, I_LN1G, I_LN1B, I_WRG, I_BRG, I_WRE, I_BRE, I_WGU, I_WDN, I_LN2G, I_LN2B };

__device__ __forceinline__ void transpose_item(const float* W, int ldw, int nvalid, int k0, int n0, bf16* WT, size_t ldt, int drow0, int dk0, LAS float* scr, int lane) {
#pragma unroll 8
    for (int i = 0; i < 32; ++i) { const int kk = 2 * i + (lane >> 5), nn = lane & 31, n = n0 + nn; scr[kk * 33 + nn] = (n < nvalid) ? W[(size_t)(k0 + kk) * ldw + n] : 0.f; }
    LDS_WAIT(); asm volatile("" ::: "memory");
    const int c = lane & 7;
#pragma unroll
    for (int j = 0; j < 4; ++j) { const int n = (lane >> 3) + 8 * j; const LAS float* s = scr + (8 * c) * 33 + n;
        v4u o; o.x = pk2(s[0 * 33], s[1 * 33]); o.y = pk2(s[2 * 33], s[3 * 33]); o.z = pk2(s[4 * 33], s[5 * 33]); o.w = pk2(s[6 * 33], s[7 * 33]);
        *(GAS v4u*)(WT + (size_t)(drow0 + n) * ldt + dk0 + k0 + 8 * c) = o; }
    LDS_WAIT(); asm volatile("" ::: "memory");
}
__device__ __forceinline__ void p0_prologue(CArgs a, LAS unsigned char* lds, int wg, int G, int tid) {
    asm volatile("" : "+v"(tid));
    const int lane = tid & 63, wave = tid >> 6;
    LAS float* scr = (LAS float*)(lds + wave * 16384);
    const int gw = wg * NWAVES + wave, NGW = G * NWAVES;
    constexpr int I_IN = 16 * (NPROJ / 32), I_OUT = (DMIX / 64) * (D / 32), I_GU = NEXP * 16 * 16, I_DN = NEXP * 4 * 32, I_LAYER = I_IN + I_OUT + I_GU + I_DN;
    unsigned char* ws = a->ws;
    for (int it = gw; it < DEPTH * I_LAYER; it += NGW) {
        const int l = it / I_LAYER; int r = it % I_LAYER;
        if (r < I_IN) { const int kb = r / (NPROJ / 32), nb = r % (NPROJ / 32);
            transpose_item(a->in[I_WIN] + (size_t)l * D * IN_COLS, IN_COLS, IN_COLS, 64 * kb, 32 * nb, (bf16*)(ws + WS_WIN) + (size_t)l * NPROJ * D, D, 32 * nb, 0, scr, lane); continue; }
        r -= I_IN;
        if (r < I_OUT) { const int kb = r / (D / 32), nb = r % (D / 32);
            transpose_item(a->in[I_WOUT] + (size_t)l * DMIX * D, D, D, 64 * kb, 32 * nb, (bf16*)(ws + WS_WOUT) + (size_t)l * D * DMIX, DMIX, 32 * nb, 0, scr, lane); continue; }
        r -= I_OUT;
        if (r < I_GU) { const int e = r / 256, q = r % 256, kb = q / 16, nb = q % 16, c0 = 32 * nb, bj = c0 / 256, hf = (c0 % 256) / 128, j0 = c0 % 128;
            transpose_item(a->in[I_WGU] + (size_t)(l * NEXP + e) * D * 512, 512, 512, 64 * kb, c0, (bf16*)(ws + WS_WGU) + (size_t)l * NGU * D, D, e * 512 + hf * 256 + bj * 128 + j0, 0, scr, lane); continue; }
        r -= I_GU;
        { const int e = r / 128, q = r % 128, kb = q / 32, nb = q % 32;
            transpose_item(a->in[I_WDN] + (size_t)(l * NEXP + e) * DEXP * D, D, D, 64 * kb, 32 * nb, (bf16*)(ws + WS_WDN) + (size_t)l * D * KDN, KDN, 32 * nb, e * DEXP, scr, lane); }
    }
    const f32x4* x4 = (const f32x4*)a->in[I_X]; f32x4* h4 = (f32x4*)a->out; unsigned long long* hb8 = (unsigned long long*)(ws + WS_HB);
    for (size_t i = (size_t)wg * NTHR + tid; i < (size_t)M * D / 4; i += (size_t)G * NTHR) { const f32x4 v = x4[i]; h4[i] = v;
        hb8[i] = (unsigned long long)pk2(v.x, v.y) | ((unsigned long long)pk2(v.z, v.w) << 32); }
}

__device__ __forceinline__ void ssd_rec_phase(CArgs a, int l, LAS unsigned char* lds, int wg, int G, int tid) {
    asm volatile("" : "+v"(tid));
    constexpr int TB = 64;
    LAS float* sX = (LAS float*)lds; LAS float* sB = sX + TB * 16; LAS float* sC = sB + TB * 128; LAS float* sDt = sC + TB * 128; LAS float* sDa = sDt + TB; LAS float* sY = sDa + TB;
    const bf16* PROJ = (const bf16*)(a->ws + WS_PROJ); bf16* YMIX = (bf16*)(a->ws + WS_YMIX);
    const float* cw = a->in[I_SCW] + (size_t)l * 4 * 1536; const float* cb = a->in[I_SCB] + (size_t)l * 1536;
    const int p_local = tid >> 5, nq = tid & 31;
    for (int unit = wg; unit < 256; unit += G) {
        const int b = unit >> 6, head = (unit >> 2) & 15, pq = unit & 3, g = head >> 3;
        const float A = -__expf(a->in[I_SALOG][l * 16 + head]), dtb = a->in[I_SDTB][l * 16 + head], Dsk = a->in[I_SD][l * 16 + head];
        float h0 = 0.f, h1 = 0.f, h2 = 0.f, h3 = 0.f;
        for (int t0 = 0; t0 < SEQ; t0 += TB) {
            __syncthreads();
            for (int idx = tid; idx < TB * 272; idx += NTHR) {
                const int tt = idx / 272, ci = idx % 272, t = t0 + tt;
                const int ch = ci < 16 ? head * 64 + pq * 16 + ci : (ci < 144 ? 1024 + g * 128 + (ci - 16) : 1280 + g * 128 + (ci - 144));
                float acc = cb[ch];
#pragma unroll
                for (int k = 0; k < 4; ++k) { const int ts = t - 3 + k; if (ts >= 0) acc += cw[k * 1536 + ch] * bf2f(PROJ[(size_t)(b * SEQ + ts) * NPROJ + O_XBC + ch]); }
                const float v = siluf(acc);
                if (ci < 16) sX[tt * 16 + ci] = v; else if (ci < 144) sB[tt * 128 + ci - 16] = v; else sC[tt * 128 + ci - 144] = v;
            }
            if (tid < TB) { const float raw = bf2f(PROJ[(size_t)(b * SEQ + t0 + tid) * NPROJ + O_DT + head]); const float dt = softplusf_(raw + dtb); sDt[tid] = dt; sDa[tid] = __expf(dt * A); }
            __syncthreads();
#pragma unroll 4
            for (int tt = 0; tt < TB; ++tt) {
                const float xv = sX[tt * 16 + p_local], da = sDa[tt], dx = sDt[tt] * xv;
                const f32x4 Bv = *(const LAS f32x4*)(sB + tt * 128 + nq * 4), Cv = *(const LAS f32x4*)(sC + tt * 128 + nq * 4);
                h0 = da * h0 + dx * Bv.x; h1 = da * h1 + dx * Bv.y; h2 = da * h2 + dx * Bv.z; h3 = da * h3 + dx * Bv.w;
                float part = (Cv.x * h0 + Cv.y * h1) + (Cv.z * h2 + Cv.w * h3);
                part += __shfl_xor(part, 1); part += __shfl_xor(part, 2); part += __shfl_xor(part, 4); part += __shfl_xor(part, 8); part += __shfl_xor(part, 16);
                if (nq == 0) sY[tt * 16 + p_local] = part + Dsk * xv;
            }
            __syncthreads();
            for (int idx = tid; idx < TB * 16; idx += NTHR) { const int tt = idx >> 4, i = idx & 15; YMIX[(size_t)(b * SEQ + t0 + tt) * DMIX + head * 64 + pq * 16 + i] = (bf16)f2bf(sY[idx]); }
        }
    }
}

__device__ __forceinline__ void gdn_rec_phase(CArgs a, int l, LAS unsigned char* lds, int wg, int G, int tid) {
    asm volatile("" : "+v"(tid));
    constexpr int TB = 32;
    LAS float* sQ = (LAS float*)lds; LAS float* sK = sQ + TB * 128; LAS float* sV = sK + TB * 128; LAS float* sBe = sV + TB * 8; LAS float* sAl = sBe + TB; LAS float* sO = sAl + TB;
    const bf16* PROJ = (const bf16*)(a->ws + WS_PROJ); bf16* YMIX = (bf16*)(a->ws + WS_YMIX);
    const float* cw = a->in[I_GCW] + (size_t)l * 4 * 1536;
    const int lane = tid & 63, w = tid >> 6;
    for (int unit = wg; unit < 256; unit += G) {
        const int b = unit >> 6, head = (unit >> 4) & 3, eb = unit & 15;
        const float nA = -__expf(a->in[I_GALOG][l * 4 + head]), dtb = a->in[I_GDTB][l * 4 + head];
        float S0 = 0.f, S1 = 0.f;
        for (int t0 = 0; t0 < SEQ; t0 += TB) {
            __syncthreads();
            for (int idx = tid; idx < TB * 264; idx += NTHR) {
                const int tt = idx / 264, ci = idx % 264, t = t0 + tt;
                const int ch = ci < 128 ? head * 128 + ci : (ci < 256 ? 512 + head * 128 + (ci - 128) : 1024 + head * 128 + eb * 8 + (ci - 256));
                float acc = 0.f;
#pragma unroll
                for (int k = 0; k < 4; ++k) { const int ts = t - 3 + k; if (ts >= 0) acc += cw[k * 1536 + ch] * bf2f(PROJ[(size_t)(b * SEQ + ts) * NPROJ + O_QKV + ch]); }
                const float v = siluf(acc);
                if (ci < 128) sQ[tt * 128 + ci] = v; else if (ci < 256) sK[tt * 128 + ci - 128] = v; else sV[tt * 8 + ci - 256] = v;
            }
            if (tid < TB) { const size_t ro = (size_t)(b * SEQ + t0 + tid) * NPROJ; const float braw = bf2f(PROJ[ro + O_GB + head]), araw = bf2f(PROJ[ro + O_GA + head]);
                sBe[tid] = sigmoidf_(braw); sAl[tid] = __expf(nA * softplusf_(araw + dtb)); }
            __syncthreads();
            for (int tt = w; tt < TB; tt += NWAVES) {
                const float q0 = sQ[tt * 128 + lane], q1 = sQ[tt * 128 + 64 + lane], k0 = sK[tt * 128 + lane], k1 = sK[tt * 128 + 64 + lane];
                const float sq = rsqrtf(wave_sum(q0 * q0 + q1 * q1) + 1e-6f) * 0.08838834764831845f, sk = rsqrtf(wave_sum(k0 * k0 + k1 * k1) + 1e-6f);
                sQ[tt * 128 + lane] = q0 * sq; sQ[tt * 128 + 64 + lane] = q1 * sq; sK[tt * 128 + lane] = k0 * sk; sK[tt * 128 + 64 + lane] = k1 * sk;
            }
            __syncthreads();
#pragma unroll 2
            for (int tt = 0; tt < TB; ++tt) {
                const float k0 = sK[tt * 128 + lane], k1 = sK[tt * 128 + 64 + lane], q0 = sQ[tt * 128 + lane], q1 = sQ[tt * 128 + 64 + lane];
                const float al = sAl[tt], be = sBe[tt], v = sV[tt * 8 + w];
                const float dot = wave_sum(k0 * S0 + k1 * S1);
                const float vn = be * (v - al * dot);
                S0 = al * S0 + k0 * vn; S1 = al * S1 + k1 * vn;
                const float od = wave_sum(q0 * S0 + q1 * S1);
                if (lane == 0) sO[tt * 8 + w] = od;
            }
            __syncthreads();
            if (tid < TB * 8) { const int tt = tid >> 3, i = tid & 7; YMIX[(size_t)(b * SEQ + t0 + tt) * DMIX + 1024 + head * 128 + eb * 8 + i] = (bf16)f2bf(sO[tid]); }
        }
    }
}

__device__ __forceinline__ void hgrn_rec_phase(CArgs a, int l, LAS unsigned char* lds, int wg, int G, int tid) {
    asm volatile("" : "+v"(tid));
    constexpr int TB = 32;
    LAS float* sQ = (LAS float*)lds; LAS float* sF = sQ + TB * 128; LAS float* sV = sF + TB * 128; LAS float* sO = sV + TB * 8; LAS float* sLb = sO + TB * 8;
    const bf16* PROJ = (const bf16*)(a->ws + WS_PROJ); bf16* YMIX = (bf16*)(a->ws + WS_YMIX);
    const int lane = tid & 63, w = tid >> 6;
    for (int unit = wg; unit < 256; unit += G) {
        const int b = unit >> 6, head = (unit >> 4) & 3, eb = unit & 15;
        __syncthreads();
        if (tid < 128) {
            const int c = head * 128 + tid; float lg[DEPTH], mx = -1e30f;
#pragma unroll
            for (int j = 0; j < DEPTH; ++j) { lg[j] = a->in[I_HLB][j * 512 + c]; mx = fmaxf(mx, lg[j]); }
            float den = 0.f, num = 0.f;
#pragma unroll
            for (int j = 0; j < DEPTH; ++j) { const float e = __expf(lg[j] - mx); den += e; if (j >= 1 && j <= l) num += e; }
            sLb[tid] = num / den;
        }
        float S0 = 0.f, S1 = 0.f;
        for (int t0 = 0; t0 < SEQ; t0 += TB) {
            __syncthreads();
            for (int idx = tid; idx < TB * 264; idx += NTHR) {
                const int tt = idx / 264, ci = idx % 264; const size_t ro = (size_t)(b * SEQ + t0 + tt) * NPROJ;
                if (ci < 128) sQ[tt * 128 + ci] = siluf(bf2f(PROJ[ro + O_HQ + head * 128 + ci]));
                else if (ci < 256) { const int d = ci - 128; const float lb = sLb[d]; sF[tt * 128 + d] = lb + (1.f - lb) * sigmoidf_(bf2f(PROJ[ro + O_HF + head * 128 + d])); }
                else sV[tt * 8 + ci - 256] = bf2f(PROJ[ro + O_HI + head * 128 + eb * 8 + (ci - 256)]);
            }
            __syncthreads();
#pragma unroll 2
            for (int tt = 0; tt < TB; ++tt) {
                const float f0 = sF[tt * 128 + lane], f1 = sF[tt * 128 + 64 + lane], q0 = sQ[tt * 128 + lane], q1 = sQ[tt * 128 + 64 + lane], v = sV[tt * 8 + w];
                S0 = f0 * S0 + (1.f - f0) * v; S1 = f1 * S1 + (1.f - f1) * v;
                const float od = wave_sum(q0 * S0 + q1 * S1);
                if (lane == 0) sO[tt * 8 + w] = od;
            }
            __syncthreads();
            if (tid < TB * 8) { const int tt = tid >> 3, i = tid & 7; YMIX[(size_t)(b * SEQ + t0 + tt) * DMIX + 1536 + head * 128 + eb * 8 + i] = (bf16)f2bf(sO[tid]); }
        }
    }
}

__device__ __forceinline__ void mix_post_phase(CArgs a, int l, int wg, int G, int tid) {
    asm volatile("" : "+v"(tid));
    const bf16* PROJ = (const bf16*)(a->ws + WS_PROJ); bf16* YMIX = (bf16*)(a->ws + WS_YMIX);
    const int lane = tid & 63, gw = wg * NWAVES + (tid >> 6), NGW = G * NWAVES;
    const float* snw = a->in[I_SNW] + l * 1024; const float* gnw = a->in[I_GNW] + l * 128; const float* hnw = a->in[I_HNW] + l * 128;
    for (int row = gw; row < M; row += NGW) {
        const bf16* pr = PROJ + (size_t)row * NPROJ; bf16* yr = YMIX + (size_t)row * DMIX;
#pragma unroll
        for (int j = 0; j < 2; ++j) {
            const int ch = j * 512 + lane * 8; const v4u yv = *(const GAS v4u*)(yr + ch), zv = *(const GAS v4u*)(pr + O_Z + ch);
            float v[8]; float ss = 0.f;
#pragma unroll
            for (int i = 0; i < 4; ++i) { v[2 * i] = bflo(yv[i]) * siluf(bflo(zv[i])); v[2 * i + 1] = bfhi(yv[i]) * siluf(bfhi(zv[i])); ss += v[2 * i] * v[2 * i] + v[2 * i + 1] * v[2 * i + 1]; }
            const float rstd = rsqrtf(wave_sum(ss) * (1.f / 512.f) + 1e-6f);
            v4u o;
#pragma unroll
            for (int i = 0; i < 4; ++i) o[i] = pk2(v[2 * i] * rstd * snw[ch + 2 * i], v[2 * i + 1] * rstd * snw[ch + 2 * i + 1]);
            *(GAS v4u*)(yr + ch) = o;
        }
#pragma unroll
        for (int part = 0; part < 2; ++part) {
            const int ch = lane * 8, yo = 1024 + part * 512 + ch, go = (part == 0 ? O_GG : O_HG) + ch; const float* nw = part == 0 ? gnw : hnw;
            const v4u yv = *(const GAS v4u*)(yr + yo), gv = *(const GAS v4u*)(pr + go);
            float v[8]; float ss = 0.f;
#pragma unroll
            for (int i = 0; i < 4; ++i) { v[2 * i] = bflo(yv[i]); v[2 * i + 1] = bfhi(yv[i]); ss += v[2 * i] * v[2 * i] + v[2 * i + 1] * v[2 * i + 1]; }
            ss += __shfl_xor(ss, 1); ss += __shfl_xor(ss, 2); ss += __shfl_xor(ss, 4); ss += __shfl_xor(ss, 8);
            const float rstd = rsqrtf(ss * (1.f / 128.f) + 1e-6f);
            v4u o;
#pragma unroll
            for (int i = 0; i < 4; ++i) { const int c = (ch & 127) + 2 * i; o[i] = pk2(v[2 * i] * rstd * nw[c] * siluf(bflo(gv[i])), v[2 * i + 1] * rstd * nw[c + 1] * siluf(bfhi(gv[i]))); }
            *(GAS v4u*)(yr + yo) = o;
        }
    }
}

template <bool ROUTER>
__device__ __forceinline__ void ln_phase(CArgs a, int l, const float* gam, const float* bet, LAS unsigned char* lds, int wg, int G, int tid) {
    asm volatile("" : "+v"(tid));
    const int lane = tid & 63, gw = wg * NWAVES + (tid >> 6), NGW = G * NWAVES;
    const float* ADD = (const float*)(a->ws + WS_MIX); float* H = a->out; bf16* HB = (bf16*)(a->ws + WS_HB); float* COMB = (float*)(a->ws + WS_COMB);
    LAS float* sW = (LAS float*)lds;
    LAS float* sL = sW + 20 * D + (tid >> 6) * 32;
    if (ROUTER) {
        __syncthreads();
        const float* wrg = a->in[I_WRG] + (size_t)l * D * 4; const float* wre = a->in[I_WRE] + (size_t)l * D * 16;
        for (int i = tid; i < D * 20; i += NTHR) { const int c = i >> 10, k = i & 1023; sW[i] = c < 4 ? wrg[k * 4 + c] : wre[k * 16 + c - 4]; }
        __syncthreads();
    }
    f32x4 gv[4], bv[4];
#pragma unroll
    for (int j = 0; j < 4; ++j) { gv[j] = *(const f32x4*)(gam + 4 * lane + 256 * j); bv[j] = *(const f32x4*)(bet + 4 * lane + 256 * j); }
    for (int row = gw; row < M; row += NGW) {
        f32x4 v[4]; float s = 0.f;
#pragma unroll
        for (int j = 0; j < 4; ++j) { const f32x4 hv = *(const GAS f32x4*)(H + (size_t)row * D + 4 * lane + 256 * j), av = *(const GAS f32x4*)(ADD + (size_t)row * D + 4 * lane + 256 * j);
            v[j] = hv * DN_ALPHA + av; s += (v[j].x + v[j].y) + (v[j].z + v[j].w); }
        const float mean = wave_sum(s) * (1.f / D); float s2 = 0.f;
#pragma unroll
        for (int j = 0; j < 4; ++j) { v[j] = v[j] - mean; s2 += (v[j].x * v[j].x + v[j].y * v[j].y) + (v[j].z * v[j].z + v[j].w * v[j].w); }
        const float rstd = rsqrtf(wave_sum(s2) * (1.f / D) + LN_EPS);
#pragma unroll
        for (int j = 0; j < 4; ++j) { v[j] = v[j] * rstd * gv[j] + bv[j];
            *(GAS f32x4*)(H + (size_t)row * D + 4 * lane + 256 * j) = v[j];
            *(GAS unsigned long long*)(HB + (size_t)row * D + 4 * lane + 256 * j) = (unsigned long long)pk2(v[j].x, v[j].y) | ((unsigned long long)pk2(v[j].z, v[j].w) << 32); }
        if (ROUTER) {
            float lg[20];
#pragma unroll 1
            for (int c = 0; c < 20; ++c) { float p = 0.f;
#pragma unroll
                for (int j = 0; j < 4; ++j) { const f32x4 wv = *(const LAS f32x4*)(sW + c * D + 4 * lane + 256 * j); p += (v[j].x * wv.x + v[j].y * wv.y) + (v[j].z * wv.z + v[j].w * wv.w); }
                p = wave_sum(p); if (lane == 0) sL[c] = p; }
#pragma unroll
            for (int c = 0; c < 20; ++c) lg[c] = sL[c];
            float pg[4], mx = -1e30f; int gi = 0;
#pragma unroll
            for (int c = 0; c < 4; ++c) { pg[c] = lg[c] + a->in[I_BRG][l * 4 + c]; if (pg[c] > mx) { mx = pg[c]; gi = c; } }
            float den = 0.f;
#pragma unroll
            for (int c = 0; c < 4; ++c) den += __expf(pg[c] - mx);
            const float g_p = 1.0f / den;
            float le[4], emx = -1e30f; int i1 = 0;
#pragma unroll
            for (int c = 0; c < 4; ++c) { float x = 0.f;
#pragma unroll
                for (int gg = 0; gg < 4; ++gg) x = (gi == gg) ? lg[4 + gg * 4 + c] + a->in[I_BRE][l * 16 + gg * 4 + c] : x;
                le[c] = x; if (x > emx) { emx = x; i1 = c; } }
            float e2mx = -1e30f; int i2 = 0;
#pragma unroll
            for (int c = 0; c < 4; ++c) if (c != i1 && le[c] > e2mx) { e2mx = le[c]; i2 = c; }
            const float x1 = 1.0f, x2 = __expf(e2mx - emx), w1 = g_p * x1 / (x1 + x2), w2 = g_p * x2 / (x1 + x2);
            if (lane < 16) { const int gl = lane >> 2, el = lane & 3; float cwv = 0.f; if (gl == gi) { if (el == i1) cwv = w1; else if (el == i2) cwv = w2; } COMB[(size_t)row * 16 + lane] = cwv; }
        }
    }
}

#ifndef PHASE_MASK
#define PHASE_MASK 0x7ff
#endif
#define PM(k) (((PHASE_MASK) >> (k)) & 1)
constexpr int NPH = 10;
constexpr int N_PHASES = 1 + DEPTH * NPH;
__global__ void __launch_bounds__(NTHR, 2) fwd(Args args) {
    extern __shared__ __attribute__((aligned(16))) unsigned char lds_raw[];
    LAS unsigned char* lds = (LAS unsigned char*)lds_raw;
    volatile LAS unsigned* MISC = (volatile LAS unsigned*)(lds + MISC_OFF);
    const int tid = threadIdx.x, G = gridDim.x, bx = blockIdx.x;
    unsigned char* ws = args.ws;
    gu32* ctl = (gu32*)(ws + WS_CTL);
    for (int u = tid; u < (LDS_BYTES - LDSCTL_OFF) / 4; u += NTHR) ((LAS unsigned*)(lds + LDSCTL_OFF))[u] = 0u;
    __syncthreads();
    const int lo = args.ph_lo, hi = args.ph_hi;
    const bool use_bar = (hi - lo) > 1;
    XcdBarrier bar; bar.bar = (unsigned*)(ctl + CW_BAR); bar.x = 0; bar.st = nullptr;
    if (use_bar) bar = xcd_barrier_post((unsigned*)(ctl + CW_BAR), MISC + 8);
#define IN(k) (lo <= (k) && (k) < hi)
#define SEAM(k) do { if (IN(k) && IN((k) + 1)) xcd_barrier(bar); } while (0)

    if (PM(10) && IN(0)) { p0_prologue(ARGS_HERE(), lds, bx, G, tid); SEAM(0); }

    for (int l = 0; l < DEPTH; ++l) {
        const int base = 1 + l * NPH;
        if (PM(0) && IN(base + 0)) {
            pg8::Gemm g{(const pg8::bf16_t*)(ws + WS_HB), (const pg8::bf16_t*)(ws + WS_WIN) + (size_t)l * NPROJ * D, M, NPROJ, D}; pg8::StaticOrder S; S.init(M, NPROJ, G, bx);
            pg8::EpiBf16<0> E{(pg8::bf16_t*)(ws + WS_PROJ), NPROJ, nullptr, 0, 0, 1.f};
            pg8::gemm_phase<pg8::EpiBf16<0>, pg8::StaticOrder, true, true>(lds + RING_OFF, g, S, E);
            SEAM(base + 0);
        }
        if (PM(1) && IN(base + 1)) { ssd_rec_phase(ARGS_HERE(), l, lds, bx, G, tid); SEAM(base + 1); }
        if (PM(2) && IN(base + 2)) { gdn_rec_phase(ARGS_HERE(), l, lds, bx, G, tid); SEAM(base + 2); }
        if (PM(3) && IN(base + 3)) { hgrn_rec_phase(ARGS_HERE(), l, lds, bx, G, tid); SEAM(base + 3); }
        if (PM(4) && IN(base + 4)) { mix_post_phase(ARGS_HERE(), l, bx, G, tid); SEAM(base + 4); }
        if (PM(5) && IN(base + 5)) {
            pg8::Gemm g{(const pg8::bf16_t*)(ws + WS_YMIX), (const pg8::bf16_t*)(ws + WS_WOUT) + (size_t)l * D * DMIX, M, D, DMIX}; pg8::StaticOrder S; S.init(M, D, G, bx);
            pg8::EpiF32 E{(float*)(ws + WS_MIX), D};
            pg8::gemm_phase<pg8::EpiF32, pg8::StaticOrder, true, true>(lds + RING_OFF, g, S, E);
            SEAM(base + 5);
        }
        if (PM(6) && IN(base + 6)) { { CArgs a_ = ARGS_HERE(); ln_phase<true>(a_, l, a_->in[I_LN1G] + l * D, a_->in[I_LN1B] + l * D, lds, bx, G, tid); }; SEAM(base + 6); }
        if (PM(7) && IN(base + 7)) {
            pg8::Gemm g{(const pg8::bf16_t*)(ws + WS_HB), (const pg8::bf16_t*)(ws + WS_WGU) + (size_t)l * NGU * D, M, NGU, D}; pg8::StaticOrder S; S.init(M, NGU, G, bx);
            pg8::EpiSwiGLU E{(pg8::bf16_t*)(ws + WS_H), KDN, (const float*)(ws + WS_COMB), 16};
            pg8::gemm_phase<pg8::EpiSwiGLU, pg8::StaticOrder, true, true>(lds + RING_OFF, g, S, E);
            SEAM(base + 7);
        }
        if (PM(8) && IN(base + 8)) {
            pg8::Gemm g{(const pg8::bf16_t*)(ws + WS_H), (const pg8::bf16_t*)(ws + WS_WDN) + (size_t)l * D * KDN, M, D, KDN}; pg8::StaticOrder S; S.init(M, D, G, bx);
            pg8::EpiF32 E{(float*)(ws + WS_MIX), D};
            pg8::gemm_phase<pg8::EpiF32, pg8::StaticOrder, true, true>(lds + RING_OFF, g, S, E);
            SEAM(base + 8);
        }
        if (PM(9) && IN(base + 9)) { { CArgs a_ = ARGS_HERE(); ln_phase<false>(a_, l, a_->in[I_LN2G] + l * D, a_->in[I_LN2B] + l * D, lds, bx, G, tid); }; SEAM(base + 9); }
    }
#undef IN
#undef SEAM
}

#ifndef MK_ONE_LAUNCH
#define MK_ONE_LAUNCH 0
#endif
extern "C" void kernel_launch(void* const* d_in, const int* in_sizes, int n_in, void* d_out, int out_size, void* d_ws, size_t ws_size, hipStream_t stream) {
    static int grid = 0;
    if (grid == 0) {
        if (n_in != 25 || out_size != M * D || ws_size < WS_END) { fprintf(stderr, "kernel_launch: unexpected shapes (n_in %d out %d ws %zu)\n", n_in, out_size, ws_size); grid = -1; return; }
        int dev = 0, cus = 0, per_cu = 0;
        if (hipGetDevice(&dev) != hipSuccess || hipDeviceGetAttribute(&cus, hipDeviceAttributeMultiprocessorCount, dev) != hipSuccess) { grid = -1; return; }
        if (hipFuncSetAttribute((const void*)fwd, hipFuncAttributeMaxDynamicSharedMemorySize, LDS_BYTES) != hipSuccess) { fprintf(stderr, "kernel_launch: hipFuncSetAttribute failed\n"); grid = -1; return; }
        if (hipOccupancyMaxActiveBlocksPerMultiprocessor(&per_cu, (const void*)fwd, NTHR, LDS_BYTES) != hipSuccess || per_cu < 1) { fprintf(stderr, "kernel_launch: occupancy query says %d\n", per_cu); (void)hipGetLastError(); grid = -1; return; }
        grid = cus;
    }
    if (grid < 0) return;
    if (hipMemsetAsync((char*)d_ws + WS_CTL, 0, CTL_ZERO_BYTES, stream) != hipSuccess) return;
    Args a{};
    for (int i = 0; i < 25; ++i) a.in[i] = (const float*)d_in[i];
    a.out = (float*)d_out; a.ws = (unsigned char*)d_ws;
#if MK_ONE_LAUNCH
    a.ph_lo = 0; a.ph_hi = N_PHASES;
    hipLaunchKernelGGL(fwd, dim3(grid), dim3(NTHR), LDS_BYTES, stream, a);
#else
    for (int p = 0; p < N_PHASES; ++p) { a.ph_lo = p; a.ph_hi = p + 1; hipLaunchKernelGGL(fwd, dim3(grid), dim3(NTHR), LDS_BYTES, stream, a); }
#endif
}
```

```cpp
#include <hip/hip_runtime.h>
#include <cstdio>
#include <cstdint>
namespace pg8 {
#define PG8_LAS __attribute__((address_space(3)))
typedef unsigned short bf16_t;
typedef short bf16x8 __attribute__((ext_vector_type(8)));
typedef float f32x4 __attribute__((ext_vector_type(4)));
typedef unsigned u32x4 __attribute__((ext_vector_type(4)));
constexpr int BM = 256, BK = 64, HALF = 128, HTB = HALF * BK * 2  , STAGE_BYTES = 8 * HTB, NXCD = 8, WGM = 8;

__host__ __device__ __forceinline__ int lds_byte(int r, int c) { const int st = (r >> 4) * 2 + (c >> 5), rr = r & 15, cc = c & 31, ob = rr * 64 + cc * 2; return st * 1024 + (ob ^ (((ob >> 9) & 1) << 5)); }
__host__ __device__ __forceinline__ void stage_rc(int b, int& R, int& C) { const int st = b / 1024, sb = b % 1024, swz = sb ^ (((sb >> 9) & 1) << 5); R = (st >> 1) * 16 + swz / 64; C = (st & 1) * 32 + (swz % 64) / 2; }
__host__ __device__ __forceinline__ int perm32(int rho) { const int n = rho >> 4, i = rho & 15; return 8 * (i >> 2) + 4 * n + (i & 3); }

struct Unit { int pm, pn; };
struct Gemm { const bf16_t* A; const bf16_t* Bt; int M, N, K; };

struct StaticOrder {
    int nM, nN, nwg, G, c;
    __host__ __device__ void init(int M, int N, int G_, int c_) { nM = M / BM; nN = N / BM; nwg = nM * nN; G = G_; c = c_; }
    __host__ __device__ bool next(int i, Unit& u) const {
        const long L = (long)i * G + c; if (L >= nwg) return false;
        int wgid = (int)L; { const int q = nwg / NXCD, r = nwg % NXCD, xcd = wgid % NXCD, off = wgid / NXCD; wgid = (xcd < r ? xcd * (q + 1) : r * (q + 1) + (xcd - r) * q) + off; }
        const int nig = WGM * nN, gid = wgid / nig, fm = gid * WGM, gsz = (nM - fm) < WGM ? (nM - fm) : WGM;
        u.pm = fm + ((wgid % nig) % gsz); u.pn = (wgid % nig) / gsz; return true;
    }
    __device__ __forceinline__ void a_ready(const Unit&) const {}
    __device__ __forceinline__ void done(const Unit&) const {}
};
__device__ __forceinline__ unsigned cvt_pk_bf16(float lo, float hi) { unsigned r; asm volatile("v_cvt_pk_bf16_f32 %0, %1, %2" : "=v"(r) : "v"(lo), "v"(hi)); return r; }
typedef float f32x2 __attribute__((ext_vector_type(2)));
__device__ __forceinline__ f32x2 gelu_pk(f32x2 v) {
    const f32x2 av = __builtin_elementwise_abs(v), d = av * 0.2316418882f + 1.0f;
    f32x2 t; t.x = __builtin_amdgcn_rcpf(d.x); t.y = __builtin_amdgcn_rcpf(d.y);
    f32x2 q = t * 0.5307027145f + (-0.7265760135f); q = q * t + 0.7107068705f; q = q * t + (-0.142248368f); q = q * t + 0.127414796f; q = q * t;
    const f32x2 s = (v * v) * (-0.72134752044f);
    f32x2 e; e.x = __builtin_amdgcn_exp2f(s.x); e.y = __builtin_amdgcn_exp2f(s.y);
    const f32x2 m = v * (q * e), r = v - m;
    f32x2 o; o.x = v.x < 0.f ? m.x : r.x; o.y = v.y < 0.f ? m.y : r.y; return o;
}

template <int ACT  > struct EpiBf16 {
    static constexpr bool PERM = true, AFTER_DRAIN = false; static_assert(ACT == 0 || ACT == 1, "EpiBf16: ACT is 0 (none) or 1 (gelu_pk)");
    bf16_t* O; int ldc; const float* bias; int split_cols; size_t split_stride; float scale0;
    __device__ __forceinline__ void operator()(const f32x4 (&acc)[2][2][4][2], const Unit& u, int wr, int wc, int fr, int fq) const {
        const int row0 = u.pm * BM + wr * 64 + fr; int colt = u.pn * BM; bf16_t* base = O;
        float sc = 1.f; if (split_cols) { const int t = colt / split_cols; base += (size_t)t * split_stride; colt -= t * split_cols; if (t == 0) sc = scale0; }
        const int col0 = colt + wc * 32 + 8 * fq, bcol0 = u.pn * BM + wc * 32 + 8 * fq;
        f32x4 bv[2][2];
#pragma unroll
        for (int bj = 0; bj < 2; ++bj)
#pragma unroll
            for (int n = 0; n < 2; ++n) bv[bj][n] = bias ? *(const f32x4*)(bias + bcol0 + bj * HALF + 4 * n) : (f32x4){0.f, 0.f, 0.f, 0.f};
#pragma unroll
        for (int ai = 0; ai < 2; ++ai)
#pragma unroll
            for (int m = 0; m < 4; ++m) { bf16_t* rowp = base + (size_t)(row0 + ai * HALF + m * 16) * ldc + col0;
#pragma unroll
                for (int bj = 0; bj < 2; ++bj) { f32x4 v0 = acc[ai][bj][m][0] + bv[bj][0], v1 = acc[ai][bj][m][1] + bv[bj][1];
                    if (ACT == 1) { f32x2 a = gelu_pk((f32x2){v0[0], v0[1]}), b = gelu_pk((f32x2){v0[2], v0[3]}), c = gelu_pk((f32x2){v1[0], v1[1]}), d = gelu_pk((f32x2){v1[2], v1[3]});
                        v0 = (f32x4){a.x, a.y, b.x, b.y}; v1 = (f32x4){c.x, c.y, d.x, d.y}; }
                    v0 = v0 * sc; v1 = v1 * sc; u32x4 w; w.x = cvt_pk_bf16(v0[0], v0[1]); w.y = cvt_pk_bf16(v0[2], v0[3]); w.z = cvt_pk_bf16(v1[0], v1[1]); w.w = cvt_pk_bf16(v1[2], v1[3]);
                    *(u32x4*)(rowp + bj * HALF) = w; } }
    }
};
struct EpiF32 {
    static constexpr bool PERM = false, AFTER_DRAIN = false;
    float* C; int ldc;
    __device__ __forceinline__ void operator()(const f32x4 (&acc)[2][2][4][2], const Unit& u, int wr, int wc, int fr, int fq) const {
        const int row0 = u.pm * BM + wr * 64 + fr, col0 = u.pn * BM + wc * 32 + 4 * fq;
#pragma unroll
        for (int ai = 0; ai < 2; ++ai)
#pragma unroll
            for (int m = 0; m < 4; ++m) { float* rowp = C + (size_t)(row0 + ai * HALF + m * 16) * ldc + col0;
#pragma unroll
                for (int bj = 0; bj < 2; ++bj)
#pragma unroll
                    for (int n = 0; n < 2; ++n) *(f32x4*)(rowp + bj * HALF + n * 16) = acc[ai][bj][m][n]; }
    }
};
__device__ __forceinline__ float silu_f(float x) { return x / (1.0f + __expf(-x)); }
struct EpiSwiGLU {
    static constexpr bool PERM = true, AFTER_DRAIN = false;
    bf16_t* H; int ldh; const float* comb; int ldcomb;
    __device__ __forceinline__ void operator()(const f32x4 (&acc)[2][2][4][2], const Unit& u, int wr, int wc, int fr, int fq) const {
        const int row0 = u.pm * BM + wr * 64 + fr, col0 = u.pn * 128 + wc * 32 + 8 * fq, e = u.pn >> 1;
#pragma unroll
        for (int ai = 0; ai < 2; ++ai)
#pragma unroll
            for (int m = 0; m < 4; ++m) { const int row = row0 + ai * HALF + m * 16; const float cw = comb[(size_t)row * ldcomb + e];
                const f32x4 g0 = acc[ai][0][m][0], g1 = acc[ai][0][m][1], u0 = acc[ai][1][m][0], u1 = acc[ai][1][m][1];
                f32x4 h0, h1;
#pragma unroll
                for (int j = 0; j < 4; ++j) { h0[j] = silu_f(g0[j]) * u0[j] * cw; h1[j] = silu_f(g1[j]) * u1[j] * cw; }
                u32x4 w; w.x = cvt_pk_bf16(h0[0], h0[1]); w.y = cvt_pk_bf16(h0[2], h0[3]); w.z = cvt_pk_bf16(h1[0], h1[1]); w.w = cvt_pk_bf16(h1[2], h1[3]);
                *(u32x4*)(H + (size_t)row * ldh + col0) = w; }
    }
};
template <class Epi, class Sched, bool ALIGN_EPI = false, bool SP2 = false>
__device__ __forceinline__ void gemm_phase(PG8_LAS unsigned char* lds, const Gemm g, const Sched& S, const Epi& E) {
    int tid_ = threadIdx.x; asm volatile("" : "+v"(tid_));
    const int tid = tid_, wid = __builtin_amdgcn_readfirstlane(tid >> 6), lane = tid & 63, wr = wid >> 2, wc = wid & 3, fr = lane & 15, fq = lane >> 4;
    const int K = g.K, nt = K / BK;
    unsigned voffA[2], voffB[2];
#pragma unroll
    for (int i = 0; i < 2; ++i) { int R, C; stage_rc(tid * 16 + i * 8192, R, C); const int Rb = Epi::PERM ? ((R & ~31) + perm32(R & 31)) : R;
        voffA[i] = (unsigned)(R * K + C) * 2u; voffB[i] = (unsigned)(Rb * K + C) * 2u; }
    const size_t kstep = (size_t)(BK * 2);
    const size_t hstep = (size_t)HALF * K * 2;
    const size_t tstep = 2 * hstep;
    const unsigned ldsw = (unsigned)wid * 1024u;
    const int aoff = lds_byte(wr * 64 + fr, fq * 8), boff = lds_byte(wc * 32 + fr, fq * 8);
#define PG8_SA(b, h) (((b) * 2 + (h)) * HTB)
#define PG8_SB(b, h) ((4 + (b) * 2 + (h)) * HTB)
#define PG8_STAGE(bufoff, gbase, voff) do { _Pragma("unroll") for (int _i = 0; _i < 2; ++_i) \
        __builtin_amdgcn_global_load_lds((const unsigned*)((const char*)(gbase) + (voff)[_i]), (PG8_LAS unsigned*)(lds + (bufoff) + ldsw + _i * 8192), 16, 0, 0); } while (0)
#define PG8_LDA(dst, b, h) do { _Pragma("unroll") for (int m = 0; m < 4; ++m) _Pragma("unroll") for (int k = 0; k < 2; ++k) dst[m][k] = *(const PG8_LAS bf16x8*)(lds + PG8_SA(b, h) + aoff + m * 2048 + k * 1024); } while (0)
#define PG8_LDB(dst, b, h) do { _Pragma("unroll") for (int n = 0; n < 2; ++n) _Pragma("unroll") for (int k = 0; k < 2; ++k) dst[n][k] = *(const PG8_LAS bf16x8*)(lds + PG8_SB(b, h) + boff + n * 2048 + k * 1024); } while (0)
#define PG8_MMA(ai, bj, At, Bt) do { __builtin_amdgcn_s_setprio(1); _Pragma("unroll") for (int m = 0; m < 4; ++m) _Pragma("unroll") for (int n = 0; n < 2; ++n) _Pragma("unroll") for (int k = 0; k < 2; ++k) \
        acc[ai][bj][m][n] = __builtin_amdgcn_mfma_f32_16x16x32_bf16(Bt[n][k], At[m][k], acc[ai][bj][m][n], 0, 0, 0); __builtin_amdgcn_s_setprio(0); } while (0)
#define PG8_WAIT_V(n) asm volatile("s_waitcnt vmcnt(" #n ")" ::: "memory")
#define PG8_WAIT_L(n) asm volatile("s_waitcnt lgkmcnt(" #n ")" ::: "memory")
#define PG8_BAR __builtin_amdgcn_s_barrier()
#define PG8_SCHED __builtin_amdgcn_sched_barrier(0)
    Unit cur, nxt; int ui = 0;
    if (!S.next(0, cur)) return;
    f32x4 acc[2][2][4][2];
#pragma unroll
    for (int a = 0; a < 2; ++a)
#pragma unroll
        for (int b = 0; b < 2; ++b)
#pragma unroll
            for (int m = 0; m < 4; ++m)
#pragma unroll
                for (int n = 0; n < 2; ++n) acc[a][b][m][n] = (f32x4){0.f, 0.f, 0.f, 0.f};
    bf16x8 At[4][2], B0[2][2], B1[2][2];
    const char* cA = (const char*)g.A + (size_t)cur.pm * tstep; const char* cB = (const char*)g.Bt + (size_t)cur.pn * tstep;
    S.a_ready(cur);
    if constexpr (SP2) {
        PG8_STAGE(PG8_SB(0, 0), cB, voffB); PG8_STAGE(PG8_SB(0, 1), cB + hstep, voffB); PG8_STAGE(PG8_SA(0, 0), cA, voffA); PG8_STAGE(PG8_SA(0, 1), cA + hstep, voffA);
        if (wr == 1) PG8_BAR;
        PG8_WAIT_V(2); PG8_BAR;
        PG8_STAGE(PG8_SB(1, 0), cB + kstep, voffB); PG8_STAGE(PG8_SA(1, 0), cA + kstep, voffA); PG8_STAGE(PG8_SB(1, 1), cB + hstep + kstep, voffB);
        PG8_WAIT_V(6); PG8_BAR;
    } else {
        PG8_STAGE(PG8_SB(0, 0), cB, voffB); PG8_STAGE(PG8_SA(0, 0), cA, voffA); PG8_STAGE(PG8_SB(0, 1), cB + hstep, voffB); PG8_STAGE(PG8_SA(0, 1), cA + hstep, voffA);
        if (wr == 1) PG8_BAR;
        PG8_WAIT_V(4); PG8_BAR;
        PG8_STAGE(PG8_SB(1, 0), cB + kstep, voffB); PG8_STAGE(PG8_SA(1, 0), cA + kstep, voffA); PG8_STAGE(PG8_SB(1, 1), cB + hstep + kstep, voffB);
        PG8_WAIT_V(6); PG8_BAR;
    }
    for (;;) {
        const bool has_next = S.next(ui + 1, nxt);
        const char* nA = has_next ? (const char*)g.A + (size_t)nxt.pm * tstep : cA; const char* nB = has_next ? (const char*)g.Bt + (size_t)nxt.pn * tstep : cB;
        for (int t = 0; t < nt; t += 2) {
            const bool last = (t == nt - 2);
            const char* a1 = cA + (size_t)(t + 1) * kstep;
            const char* a2 = last ? nA : cA + (size_t)(t + 2) * kstep; const char* b2 = last ? nB : cB + (size_t)(t + 2) * kstep;
            const char* a3 = a2 + kstep; const char* b3 = b2 + kstep;
            if (last && has_next) S.a_ready(nxt);
            if constexpr (SP2) {
            PG8_LDB(B0, 0, 0); PG8_LDB(B1, 0, 1); PG8_SCHED; PG8_LDA(At, 0, 0); PG8_STAGE(PG8_SA(1, 1), a1 + hstep, voffA);
            PG8_WAIT_V(8); PG8_WAIT_L(0); PG8_BAR; PG8_MMA(0, 0, At, B0); PG8_MMA(0, 1, At, B1); PG8_BAR; PG8_SCHED;
            PG8_LDA(At, 0, 1); PG8_STAGE(PG8_SB(0, 0), b2, voffB); PG8_STAGE(PG8_SB(0, 1), b2 + hstep, voffB); PG8_STAGE(PG8_SA(0, 0), a2, voffA);
            PG8_WAIT_V(8); PG8_WAIT_L(0); PG8_BAR; PG8_MMA(1, 0, At, B0); PG8_MMA(1, 1, At, B1); PG8_BAR; PG8_SCHED;
            PG8_LDB(B0, 1, 0); PG8_LDB(B1, 1, 1); PG8_SCHED; PG8_LDA(At, 1, 0); PG8_STAGE(PG8_SA(0, 1), a2 + hstep, voffA);
            PG8_WAIT_V(8); PG8_WAIT_L(0); PG8_BAR; PG8_MMA(0, 0, At, B0); PG8_MMA(0, 1, At, B1); PG8_BAR; PG8_SCHED;
            PG8_LDA(At, 1, 1); PG8_STAGE(PG8_SB(1, 0), b3, voffB); PG8_STAGE(PG8_SB(1, 1), b3 + hstep, voffB); PG8_STAGE(PG8_SA(1, 0), a3, voffA);
            PG8_WAIT_V(8); PG8_WAIT_L(0); PG8_BAR; PG8_MMA(1, 0, At, B0); PG8_MMA(1, 1, At, B1); PG8_BAR; PG8_SCHED;
            } else {
            PG8_LDB(B0, 0, 0); PG8_SCHED; PG8_LDA(At, 0, 0); PG8_STAGE(PG8_SA(1, 1), a1 + hstep, voffA);
            PG8_WAIT_L(8); PG8_BAR; PG8_WAIT_L(0); PG8_MMA(0, 0, At, B0); PG8_BAR; PG8_SCHED;
            PG8_LDB(B1, 0, 1); PG8_STAGE(PG8_SB(0, 0), b2, voffB);
            PG8_BAR; PG8_WAIT_L(0); PG8_MMA(0, 1, At, B1); PG8_BAR;
            PG8_LDA(At, 0, 1); PG8_STAGE(PG8_SA(0, 0), a2, voffA);
            PG8_BAR; PG8_WAIT_L(0); PG8_MMA(1, 0, At, B0); PG8_BAR; PG8_SCHED;
            PG8_STAGE(PG8_SB(0, 1), b2 + hstep, voffB);
            PG8_WAIT_V(6); PG8_BAR; PG8_MMA(1, 1, At, B1); PG8_BAR;
            PG8_LDB(B0, 1, 0); PG8_SCHED; PG8_LDA(At, 1, 0); PG8_STAGE(PG8_SA(0, 1), a2 + hstep, voffA);
            PG8_WAIT_L(8); PG8_BAR; PG8_WAIT_L(0); PG8_MMA(0, 0, At, B0); PG8_BAR; PG8_SCHED;
            PG8_LDB(B1, 1, 1); PG8_STAGE(PG8_SB(1, 0), b3, voffB);
            PG8_BAR; PG8_WAIT_L(0); PG8_MMA(0, 1, At, B1); PG8_BAR;
            PG8_LDA(At, 1, 1); PG8_STAGE(PG8_SA(1, 0), a3, voffA);
            PG8_BAR; PG8_WAIT_L(0); PG8_MMA(1, 0, At, B0); PG8_BAR; PG8_SCHED;
            PG8_STAGE(PG8_SB(1, 1), b3 + hstep, voffB);
            PG8_WAIT_V(6); PG8_BAR; PG8_MMA(1, 1, At, B1); PG8_BAR;
            }
        }
        if constexpr (ALIGN_EPI) { if (wr == 0) PG8_BAR; }
        if constexpr (!Epi::AFTER_DRAIN) { E(acc, cur, wr, wc, fr, fq); S.done(cur); }
        if (!has_next) break;
#pragma unroll
        for (int a = 0; a < 2; ++a)
#pragma unroll
            for (int b = 0; b < 2; ++b)
#pragma unroll
                for (int m = 0; m < 4; ++m)
#pragma unroll
                    for (int n = 0; n < 2; ++n) acc[a][b][m][n] = (f32x4){0.f, 0.f, 0.f, 0.f};
        cur = nxt; cA = nA; cB = nB; ++ui;
        if constexpr (ALIGN_EPI) { if (wr == 1) PG8_BAR; }
    }
    PG8_WAIT_V(0);
    if constexpr (!ALIGN_EPI) { if (wr == 0) PG8_BAR; }
    PG8_BAR;
    if constexpr (Epi::AFTER_DRAIN) { E.fused(acc, cur, wr, wc, fr, fq, lds, wid, lane); S.done(cur); }
#undef PG8_SA
#undef PG8_SB
#undef PG8_STAGE
#undef PG8_LDA
#undef PG8_LDB
#undef PG8_MMA
#undef PG8_WAIT_V
#undef PG8_WAIT_L
#undef PG8_BAR
#undef PG8_SCHED
}
}
#define GAS __attribute__((address_space(1)))
#define LAS __attribute__((address_space(3)))
typedef unsigned short bf16;
typedef unsigned v4u __attribute__((ext_vector_type(4)));
typedef float f32x4 __attribute__((ext_vector_type(4)));
typedef short bf16x8 __attribute__((ext_vector_type(8)));
typedef GAS unsigned gu32;
typedef GAS unsigned long long gu64;
#define RLX_AGENT __ATOMIC_RELAXED, __HIP_MEMORY_SCOPE_AGENT
#define LDS_WAIT() asm volatile("s_waitcnt lgkmcnt(0)" ::: "memory")
#define VM_WAIT() asm volatile("s_waitcnt vmcnt(0)" ::: "memory")
__device__ __forceinline__ unsigned long long rt() { return __builtin_amdgcn_s_memrealtime(); }
__device__ __forceinline__ unsigned f2bf(float f) { unsigned u = __builtin_bit_cast(unsigned, f); return (u + 0x7fffu + ((u >> 16) & 1u)) >> 16; }
__device__ __forceinline__ unsigned pk2(float lo, float hi) { return f2bf(lo) | (f2bf(hi) << 16); }

#define XB_TMO      128
#define XB_XCNT(j)  (256  + 64 * (j))
#define XB_XSUB(j)  (1280 + 64 * (j))
#define XB_XGEN(j)  (2304 + 64 * (j))
#define XB_TOP      3328
#define XB_TOPGEN   3392
#define XCD_BAR_WORDS 3456
#define XB_SPIN_CAP (1u << 18)

__device__ __forceinline__ unsigned xb_ld(unsigned* p)              { return __hip_atomic_load(p, __ATOMIC_RELAXED, __HIP_MEMORY_SCOPE_AGENT); }
__device__ __forceinline__ unsigned xb_add(unsigned* p, unsigned v) { return __hip_atomic_fetch_add(p, v, __ATOMIC_RELAXED, __HIP_MEMORY_SCOPE_AGENT); }
__device__ __forceinline__ unsigned xb_xcc_id() { return (unsigned)__builtin_amdgcn_s_getreg((3 << 11) | 20) & 0xFu; }
#define XB_SPIN(cond, bar) do { unsigned _sp = 0; while (cond) { __builtin_amdgcn_s_sleep(1); \
    if ((++_sp & 255u) == 0u) { if (xb_ld(&(bar)[XB_TMO])) break; if (_sp > XB_SPIN_CAP) { atomicAdd(&(bar)[XB_TMO], 1u); break; } } } } while (0)

struct XcdBarrier {
    unsigned* bar; unsigned x;
    volatile LAS unsigned* st;
};

__device__ __forceinline__ XcdBarrier xcd_barrier_post(unsigned* bar, volatile LAS unsigned* st) {
    XcdBarrier b; b.bar = bar; b.x = xb_xcc_id(); b.st = st;
    if (threadIdx.x == 0) (void)xb_add(&bar[XB_XCNT(b.x)], 1u);
    return b;
}
__device__ __forceinline__ void xcd_barrier_complete(unsigned* bar, unsigned x, unsigned& nloc, unsigned& nx) {
    const unsigned G = gridDim.x * gridDim.y * gridDim.z;
    unsigned sum, cnt, mine, sp = 0u;
    for (;;) {
        sum = 0u; cnt = 0u; mine = 0u;
#pragma unroll
        for (unsigned j = 0; j < 16; ++j) { const unsigned c = xb_ld(&bar[XB_XCNT(j)]); sum += c; cnt += (c > 0u) ? 1u : 0u; mine = (j == x) ? c : mine; }
        if (sum == G) break;
        __builtin_amdgcn_s_sleep(1);
        if ((++sp & 255u) == 0u) { if (xb_ld(&bar[XB_TMO])) break; if (sp > XB_SPIN_CAP) { atomicAdd(&bar[XB_TMO], 1u); break; } }
    }
    nloc = mine > 0u ? mine : 1u; nx = cnt > 0u ? cnt : 1u;
}

__device__ __forceinline__ void xcd_barrier(const XcdBarrier& b) {
    asm volatile("s_waitcnt vmcnt(0)" ::: "memory");
    __syncthreads();
    if (threadIdx.x == 0) {
        unsigned* bar = b.bar;
        __builtin_amdgcn_s_waitcnt(0);
        unsigned nloc = b.st[0], nx = b.st[1];
        if (nloc == 0u) { xcd_barrier_complete(bar, b.x, nloc, nx); b.st[0] = nloc; b.st[1] = nx; }
        const unsigned old = xb_add(&bar[XB_XSUB(b.x)], 1u);
        const unsigned gen = old / nloc;
        if (old + 1u == (gen + 1u) * nloc) {
            __builtin_amdgcn_fence(__ATOMIC_RELEASE, "agent");
            asm volatile("s_waitcnt vmcnt(0)" ::: "memory");
            const unsigned og = xb_add(&bar[XB_TOP], 1u);
            const unsigned tg = og / nx;
            if (og + 1u == (tg + 1u) * nx) xb_add(&bar[XB_TOPGEN], 1u);
            else XB_SPIN(xb_ld(&bar[XB_TOPGEN]) == tg, bar);
            __builtin_amdgcn_fence(__ATOMIC_ACQUIRE, "agent");
            xb_add(&bar[XB_XGEN(b.x)], 1u);
            asm volatile("s_waitcnt vmcnt(0)" ::: "memory");
        } else {
            XB_SPIN(xb_ld(&bar[XB_XGEN(b.x)]) == gen, bar);
            __builtin_amdgcn_fence(__ATOMIC_ACQUIRE, "agent");
            asm volatile("s_waitcnt vmcnt(0)" ::: "memory");
        }
    }
    __syncthreads();
}
constexpr int NWAVES = 8, NTHR = NWAVES * 64;
constexpr int D = 1024, BATCH = 4, SEQ = 4096, M = BATCH * SEQ, DEPTH = 4;
constexpr int IN_COLS = 6680, NPROJ = 6912;
constexpr int O_Z = 0, O_XBC = 1024, O_DT = 2560, O_QKV = 2576, O_GG = 4112, O_GB = 4624, O_GA = 4628, O_HQ = 4632, O_HF = 5144, O_HI = 5656, O_HG = 6168;
constexpr int DMIX = 2048, NEXP = 16, DEXP = 256, NGU = NEXP * 2 * DEXP  , KDN = NEXP * DEXP  ;
constexpr float DN_ALPHA = 1.6817928305074290f;
constexpr float LN_EPS = 1e-5f;

constexpr size_t MiB = 1u << 20;
constexpr size_t WS_CTL = 0, CTL_ZERO_BYTES = 1 * MiB;
constexpr size_t WS_WIN = 2 * MiB;
constexpr size_t WS_WOUT = 56 * MiB;
constexpr size_t WS_WGU = 72 * MiB;
constexpr size_t WS_WDN = 136 * MiB;
constexpr size_t WS_HB = 168 * MiB;
constexpr size_t WS_YMIX = 200 * MiB;
constexpr size_t WS_COMB = 264 * MiB;
constexpr size_t WS_PROJ = 272 * MiB;
constexpr size_t WS_MIX = WS_PROJ;
constexpr size_t WS_H = WS_PROJ + 64 * MiB;
constexpr size_t WS_END = 488 * MiB;
constexpr int CW_BAR = 4096;

constexpr int RING_OFF = 0, RING_BYTES = 131072;
constexpr int LDSCTL_OFF = RING_BYTES, MISC_OFF = LDSCTL_OFF + 320;
constexpr int LDS_BYTES = 147456;

__device__ __forceinline__ float bf2f(unsigned short b) { return __builtin_bit_cast(float, ((unsigned)b) << 16); }
__device__ __forceinline__ float bflo(unsigned w) { return __builtin_bit_cast(float, w << 16); }
__device__ __forceinline__ float bfhi(unsigned w) { return __builtin_bit_cast(float, w & 0xffff0000u); }
__device__ __forceinline__ float siluf(float x) { return x / (1.0f + __expf(-x)); }
__device__ __forceinline__ float sigmoidf_(float x) { return 1.0f / (1.0f + __expf(-x)); }
__device__ __forceinline__ float softplusf_(float x) { return x > 20.f ? x : log1pf(__expf(x)); }
__device__ __forceinline__ float wave_sum(float v) {
#pragma unroll
    for (int o = 1; o < 64; o <<= 1) v += __shfl_xor(v, o);
    return v;
}

struct Args {
    const float* in[25]; float* out; unsigned char* ws; int ph_lo, ph_hi;
};
typedef const __attribute__((address_space(4))) Args* CArgs;
#define ARGS_HERE() ([]() { CArgs p_ = (CArgs)__builtin_amdgcn_kernarg_segment_ptr(); asm volatile("" : "+s"(p_)); return p_; }())
enum { I_X = 0, I_WIN, I_SCW, I_SCB, I_SDTB, I_SALOG, I_SD, I_SNW, I_GCW, I_GDTB, I_GALOG, I_GNW, I_HLB, I_HNW, I_WOUT, I_LN1G, I_LN1B, I_WRG, I_BRG, I_WRE, I_BRE, I_WGU, I_WDN, I_LN2G, I_LN2B };

__device__ __forceinline__ void transpose_item(const float* W, int ldw, int nvalid, int k0, int n0, bf16* WT, size_t ldt, int drow0, int dk0, LAS float* scr, int lane) {
#pragma unroll 8
    for (int i = 0; i < 32; ++i) { const int kk = 2 * i + (lane >> 5), nn = lane & 31, n = n0 + nn; scr[kk * 33 + nn] = (n < nvalid) ? W[(size_t)(k0 + kk) * ldw + n] : 0.f; }
    LDS_WAIT(); asm volatile("" ::: "memory");
    const int c = lane & 7;
#pragma unroll
    for (int j = 0; j < 4; ++j) { const int n = (lane >> 3) + 8 * j; const LAS float* s = scr + (8 * c) * 33 + n;
        v4u o; o.x = pk2(s[0 * 33], s[1 * 33]); o.y = pk2(s[2 * 33], s[3 * 33]); o.z = pk2(s[4 * 33], s[5 * 33]); o.w = pk2(s[6 * 33], s[7 * 33]);
        *(GAS v4u*)(WT + (size_t)(drow0 + n) * ldt + dk0 + k0 + 8 * c) = o; }
    LDS_WAIT(); asm volatile("" ::: "memory");
}
__device__ __forceinline__ void p0_prologue(CArgs a, LAS unsigned char* lds, int wg, int G, int tid) {
    asm volatile("" : "+v"(tid));
    const int lane = tid & 63, wave = tid >> 6;
    LAS float* scr = (LAS float*)(lds + wave * 16384);
    const int gw = wg * NWAVES + wave, NGW = G * NWAVES;
    constexpr int I_IN = 16 * (NPROJ / 32), I_OUT = (DMIX / 64) * (D / 32), I_GU = NEXP * 16 * 16, I_DN = NEXP * 4 * 32, I_LAYER = I_IN + I_OUT + I_GU + I_DN;
    unsigned char* ws = a->ws;
    for (int it = gw; it < DEPTH * I_LAYER; it += NGW) {
        const int l = it / I_LAYER; int r = it % I_LAYER;
        if (r < I_IN) { const int kb = r / (NPROJ / 32), nb = r % (NPROJ / 32);
            transpose_item(a->in[I_WIN] + (size_t)l * D * IN_COLS, IN_COLS, IN_COLS, 64 * kb, 32 * nb, (bf16*)(ws + WS_WIN) + (size_t)l * NPROJ * D, D, 32 * nb, 0, scr, lane); continue; }
        r -= I_IN;
        if (r < I_OUT) { const int kb = r / (D / 32), nb = r % (D / 32);
            transpose_item(a->in[I_WOUT] + (size_t)l * DMIX * D, D, D, 64 * kb, 32 * nb, (bf16*)(ws + WS_WOUT) + (size_t)l * D * DMIX, DMIX, 32 * nb, 0, scr, lane); continue; }
        r -= I_OUT;
        if (r < I_GU) { const int e = r / 256, q = r % 256, kb = q / 16, nb = q % 16, c0 = 32 * nb, bj = c0 / 256, hf = (c0 % 256) / 128, j0 = c0 % 128;
            transpose_item(a->in[I_WGU] + (size_t)(l * NEXP + e) * D * 512, 512, 512, 64 * kb, c0, (bf16*)(ws + WS_WGU) + (size_t)l * NGU * D, D, e * 512 + hf * 256 + bj * 128 + j0, 0, scr, lane); continue; }
        r -= I_GU;
        { const int e = r / 128, q = r % 128, kb = q / 32, nb = q % 32;
            transpose_item(a->in[I_WDN] + (size_t)(l * NEXP + e) * DEXP * D, D, D, 64 * kb, 32 * nb, (bf16*)(ws + WS_WDN) + (size_t)l * D * KDN, KDN, 32 * nb, e * DEXP, scr, lane); }
    }
    const f32x4* x4 = (const f32x4*)a->in[I_X]; f32x4* h4 = (f32x4*)a->out; unsigned long long* hb8 = (unsigned long long*)(ws + WS_HB);
    for (size_t i = (size_t)wg * NTHR + tid; i < (size_t)M * D / 4; i += (size_t)G * NTHR) { const f32x4 v = x4[i]; h4[i] = v;
        hb8[i] = (unsigned long long)pk2(v.x, v.y) | ((unsigned long long)pk2(v.z, v.w) << 32); }
}

__device__ __forceinline__ void ssd_rec_phase(CArgs a, int l, LAS unsigned char* lds, int wg, int G, int tid) {
    asm volatile("" : "+v"(tid));
    constexpr int TB = 64;
    LAS float* sX = (LAS float*)lds; LAS float* sB = sX + TB * 16; LAS float* sC = sB + TB * 128; LAS float* sDt = sC + TB * 128; LAS float* sDa = sDt + TB; LAS float* sY = sDa + TB;
    const bf16* PROJ = (const bf16*)(a->ws + WS_PROJ); bf16* YMIX = (bf16*)(a->ws + WS_YMIX);
    const float* cw = a->in[I_SCW] + (size_t)l * 4 * 1536; const float* cb = a->in[I_SCB] + (size_t)l * 1536;
    const int p_local = tid >> 5, nq = tid & 31;
    for (int unit = wg; unit < 256; unit += G) {
        const int b = unit >> 6, head = (unit >> 2) & 15, pq = unit & 3, g = head >> 3;
        const float A = -__expf(a->in[I_SALOG][l * 16 + head]), dtb = a->in[I_SDTB][l * 16 + head], Dsk = a->in[I_SD][l * 16 + head];
        float h0 = 0.f, h1 = 0.f, h2 = 0.f, h3 = 0.f;
        for (int t0 = 0; t0 < SEQ; t0 += TB) {
            __syncthreads();
            for (int idx = tid; idx < TB * 272; idx += NTHR) {
                const int tt = idx / 272, ci = idx % 272, t = t0 + tt;
                const int ch = ci < 16 ? head * 64 + pq * 16 + ci : (ci < 144 ? 1024 + g * 128 + (ci - 16) : 1280 + g * 128 + (ci - 144));
                float acc = cb[ch];
#pragma unroll
                for (int k = 0; k < 4; ++k) { const int ts = t - 3 + k; if (ts >= 0) acc += cw[k * 1536 + ch] * bf2f(PROJ[(size_t)(b * SEQ + ts) * NPROJ + O_XBC + ch]); }
                const float v = siluf(acc);
                if (ci < 16) sX[tt * 16 + ci] = v; else if (ci < 144) sB[tt * 128 + ci - 16] = v; else sC[tt * 128 + ci - 144] = v;
            }
            if (tid < TB) { const float raw = bf2f(PROJ[(size_t)(b * SEQ + t0 + tid) * NPROJ + O_DT + head]); const float dt = softplusf_(raw + dtb); sDt[tid] = dt; sDa[tid] = __expf(dt * A); }
            __syncthreads();
#pragma unroll 4
            for (int tt = 0; tt < TB; ++tt) {
                const float xv = sX[tt * 16 + p_local], da = sDa[tt], dx = sDt[tt] * xv;
                const f32x4 Bv = *(const LAS f32x4*)(sB + tt * 128 + nq * 4), Cv = *(const LAS f32x4*)(sC + tt * 128 + nq * 4);
                h0 = da * h0 + dx * Bv.x; h1 = da * h1 + dx * Bv.y; h2 = da * h2 + dx * Bv.z; h3 = da * h3 + dx * Bv.w;
                float part = (Cv.x * h0 + Cv.y * h1) + (Cv.z * h2 + Cv.w * h3);
                part += __shfl_xor(part, 1); part += __shfl_xor(part, 2); part += __shfl_xor(part, 4); part += __shfl_xor(part, 8); part += __shfl_xor(part, 16);
                if (nq == 0) sY[tt * 16 + p_local] = part + Dsk * xv;
            }
            __syncthreads();
            for (int idx = tid; idx < TB * 16; idx += NTHR) { const int tt = idx >> 4, i = idx & 15; YMIX[(size_t)(b * SEQ + t0 + tt) * DMIX + head * 64 + pq * 16 + i] = (bf16)f2bf(sY[idx]); }
        }
    }
}

__device__ __forceinline__ void gdn_rec_phase(CArgs a, int l, LAS unsigned char* lds, int wg, int G, int tid) {
    asm volatile("" : "+v"(tid));
    constexpr int TB = 32;
    LAS float* sQ = (LAS float*)lds; LAS float* sK = sQ + TB * 128; LAS float* sV = sK + TB * 128; LAS float* sBe = sV + TB * 8; LAS float* sAl = sBe + TB; LAS float* sO = sAl + TB;
    const bf16* PROJ = (const bf16*)(a->ws + WS_PROJ); bf16* YMIX = (bf16*)(a->ws + WS_YMIX);
    const float* cw = a->in[I_GCW] + (size_t)l * 4 * 1536;
    const int lane = tid & 63, w = tid >> 6;
    for (int unit = wg; unit < 256; unit += G) {
        const int b = unit >> 6, head = (unit >> 4) & 3, eb = unit & 15;
        const float nA = -__expf(a->in[I_GALOG][l * 4 + head]), dtb = a->in[I_GDTB][l * 4 + head];
        float S0 = 0.f, S1 = 0.f;
        for (int t0 = 0; t0 < SEQ; t0 += TB) {
            __syncthreads();
            for (int idx = tid; idx < TB * 264; idx += NTHR) {
                const int tt = idx / 264, ci = idx % 264, t = t0 + tt;
                const int ch = ci < 128 ? head * 128 + ci : (ci < 256 ? 512 + head * 128 + (ci - 128) : 1024 + head * 128 + eb * 8 + (ci - 256));
                float acc = 0.f;
#pragma unroll
                for (int k = 0; k < 4; ++k) { const int ts = t - 3 + k; if (ts >= 0) acc += cw[k * 1536 + ch] * bf2f(PROJ[(size_t)(b * SEQ + ts) * NPROJ + O_QKV + ch]); }
                const float v = siluf(acc);
                if (ci < 128) sQ[tt * 128 + ci] = v; else if (ci < 256) sK[tt * 128 + ci - 128] = v; else sV[tt * 8 + ci - 256] = v;
            }
            if (tid < TB) { const size_t ro = (size_t)(b * SEQ + t0 + tid) * NPROJ; const float braw = bf2f(PROJ[ro + O_GB + head]), araw = bf2f(PROJ[ro + O_GA + head]);
                sBe[tid] = sigmoidf_(braw); sAl[tid] = __expf(nA * softplusf_(araw + dtb)); }
            __syncthreads();
            for (int tt = w; tt < TB; tt += NWAVES) {
                const float q0 = sQ[tt * 128 + lane], q1 = sQ[tt * 128 + 64 + lane], k0 = sK[tt * 128 + lane], k1 = sK[tt * 128 + 64 + lane];
                const float sq = rsqrtf(wave_sum(q0 * q0 + q1 * q1) + 1e-6f) * 0.08838834764831845f, sk = rsqrtf(wave_sum(k0 * k0 + k1 * k1) + 1e-6f);
                sQ[tt * 128 + lane] = q0 * sq; sQ[tt * 128 + 64 + lane] = q1 * sq; sK[tt * 128 + lane] = k0 * sk; sK[tt * 128 + 64 + lane] = k1 * sk;
            }
            __syncthreads();
#pragma unroll 2
            for (int tt = 0; tt < TB; ++tt) {
                const float k0 = sK[tt * 128 + lane], k1 = sK[tt * 128 + 64 + lane], q0 = sQ[tt * 128 + lane], q1 = sQ[tt * 128 + 64 + lane];
                const float al = sAl[tt], be = sBe[tt], v = sV[tt * 8 + w];
                const float dot = wave_sum(k0 * S0 + k1 * S1);
                const float vn = be * (v - al * dot);
                S0 = al * S0 + k0 * vn; S1 = al * S1 + k1 * vn;
                const float od = wave_sum(q0 * S0 + q1 * S1);
                if (lane == 0) sO[tt * 8 + w] = od;
            }
            __syncthreads();
            if (tid < TB * 8) { const int tt = tid >> 3, i = tid & 7; YMIX[(size_t)(b * SEQ + t0 + tt) * DMIX + 1024 + head * 128 + eb * 8 + i] = (bf16)f2bf(sO[tid]); }
        }
    }
}

__device__ __forceinline__ void hgrn_rec_phase(CArgs a, int l, LAS unsigned char* lds, int wg, int G, int tid) {
    asm volatile("" : "+v"(tid));
    constexpr int TB = 32;
    LAS float* sQ = (LAS float*)lds; LAS float* sF = sQ + TB * 128; LAS float* sV = sF + TB * 128; LAS float* sO = sV + TB * 8; LAS float* sLb = sO + TB * 8;
    const bf16* PROJ = (const bf16*)(a->ws + WS_PROJ); bf16* YMIX = (bf16*)(a->ws + WS_YMIX);
    const int lane = tid & 63, w = tid >> 6;
    for (int unit = wg; unit < 256; unit += G) {
        const int b = unit >> 6, head = (unit >> 4) & 3, eb = unit & 15;
        __syncthreads();
        if (tid < 128) {
            const int c = head * 128 + tid; float lg[DEPTH], mx = -1e30f;
#pragma unroll
            for (int j = 0; j < DEPTH; ++j) { lg[j] = a->in[I_HLB][j * 512 + c]; mx = fmaxf(mx, lg[j]); }
            float den = 0.f, num = 0.f;
#pragma unroll
            for (int j = 0; j < DEPTH; ++j) { const float e = __expf(lg[j] - mx); den += e; if (j >= 1 && j <= l) num += e; }
            sLb[tid] = num / den;
        }
        float S0 = 0.f, S1 = 0.f;
        for (int t0 = 0; t0 < SEQ; t0 += TB) {
            __syncthreads();
            for (int idx = tid; idx < TB * 264; idx += NTHR) {
                const int tt = idx / 264, ci = idx % 264; const size_t ro = (size_t)(b * SEQ + t0 + tt) * NPROJ;
                if (ci < 128) sQ[tt * 128 + ci] = siluf(bf2f(PROJ[ro + O_HQ + head * 128 + ci]));
                else if (ci < 256) { const int d = ci - 128; const float lb = sLb[d]; sF[tt * 128 + d] = lb + (1.f - lb) * sigmoidf_(bf2f(PROJ[ro + O_HF + head * 128 + d])); }
                else sV[tt * 8 + ci - 256] = bf2f(PROJ[ro + O_HI + head * 128 + eb * 8 + (ci - 256)]);
            }
            __syncthreads();
#pragma unroll 2
            for (int tt = 0; tt < TB; ++tt) {
                const float f0 = sF[tt * 128 + lane], f1 = sF[tt * 128 + 64 + lane], q0 = sQ[tt * 128 + lane], q1 = sQ[tt * 128 + 64 + lane], v = sV[tt * 8 + w];
                S0 = f0 * S0 + (1.f - f0) * v; S1 = f1 * S1 + (1.f - f1) * v;
                const float od = wave_sum(q0 * S0 + q1 * S1);
                if (lane == 0) sO[tt * 8 + w] = od;
            }
            __syncthreads();
            if (tid < TB * 8) { const int tt = tid >> 3, i = tid & 7; YMIX[(size_t)(b * SEQ + t0 + tt) * DMIX + 1536 + head * 128 + eb * 8 + i] = (bf16)f2bf(sO[tid]); }
        }
    }
}

__device__ __forceinline__ void mix_post_phase(CArgs a, int l, int wg, int G, int tid) {
    asm volatile("" : "+v"(tid));
    const bf16* PROJ = (const bf16*)(a->ws + WS_PROJ); bf16* YMIX = (bf16*)(a->ws + WS_YMIX);
    const int lane = tid & 63, gw = wg * NWAVES + (tid >> 6), NGW = G * NWAVES;
    const float* snw = a->in[I_SNW] + l * 1024; const float* gnw = a->in[I_GNW] + l * 128; const float* hnw = a->in[I_HNW] + l * 128;
    for (int row = gw; row < M; row += NGW) {
        const bf16* pr = PROJ + (size_t)row * NPROJ; bf16* yr = YMIX + (size_t)row * DMIX;
#pragma unroll
        for (int j = 0; j < 2; ++j) {
            const int ch = j * 512 + lane * 8; const v4u yv = *(const GAS v4u*)(yr + ch), zv = *(const GAS v4u*)(pr + O_Z + ch);
            float v[8]; float ss = 0.f;
#pragma unroll
            for (int i = 0; i < 4; ++i) { v[2 * i] = bflo(yv[i]) * siluf(bflo(zv[i])); v[2 * i + 1] = bfhi(yv[i]) * siluf(bfhi(zv[i])); ss += v[2 * i] * v[2 * i] + v[2 * i + 1] * v[2 * i + 1]; }
            const float rstd = rsqrtf(wave_sum(ss) * (1.f / 512.f) + 1e-6f);
            v4u o;
#pragma unroll
            for (int i = 0; i < 4; ++i) o[i] = pk2(v[2 * i] * rstd * snw[ch + 2 * i], v[2 * i + 1] * rstd * snw[ch + 2 * i + 1]);
            *(GAS v4u*)(yr + ch) = o;
        }
#pragma unroll
        for (int part = 0; part < 2; ++part) {
            const int ch = lane * 8, yo = 1024 + part * 512 + ch, go = (part == 0 ? O_GG : O_HG) + ch; const float* nw = part == 0 ? gnw : hnw;
            const v4u yv = *(const GAS v4u*)(yr + yo), gv = *(const GAS v4u*)(pr + go);
            float v[8]; float ss = 0.f;
#pragma unroll
            for (int i = 0; i < 4; ++i) { v[2 * i] = bflo(yv[i]); v[2 * i + 1] = bfhi(yv[i]); ss += v[2 * i] * v[2 * i] + v[2 * i + 1] * v[2 * i + 1]; }
            ss += __shfl_xor(ss, 1); ss += __shfl_xor(ss, 2); ss += __shfl_xor(ss, 4); ss += __shfl_xor(ss, 8);
            const float rstd = rsqrtf(ss * (1.f / 128.f) + 1e-6f);
            v4u o;
#pragma unroll
            for (int i = 0; i < 4; ++i) { const int c = (ch & 127) + 2 * i; o[i] = pk2(v[2 * i] * rstd * nw[c] * siluf(bflo(gv[i])), v[2 * i + 1] * rstd * nw[c + 1] * siluf(bfhi(gv[i]))); }
            *(GAS v4u*)(yr + yo) = o;
        }
    }
}

template <bool ROUTER>
__device__ __forceinline__ void ln_phase(CArgs a, int l, const float* gam, const float* bet, LAS unsigned char* lds, int wg, int G, int tid) {
    asm volatile("" : "+v"(tid));
    const int lane = tid & 63, gw = wg * NWAVES + (tid >> 6), NGW = G * NWAVES;
    const float* ADD = (const float*)(a->ws + WS_MIX); float* H = a->out; bf16* HB = (bf16*)(a->ws + WS_HB); float* COMB = (float*)(a->ws + WS_COMB);
    LAS float* sW = (LAS float*)lds;
    LAS float* sL = sW + 20 * D + (tid >> 6) * 32;
    if (ROUTER) {
        __syncthreads();
        const float* wrg = a->in[I_WRG] + (size_t)l * D * 4; const float* wre = a->in[I_WRE] + (size_t)l * D * 16;
        for (int i = tid; i < D * 20; i += NTHR) { const int c = i >> 10, k = i & 1023; sW[i] = c < 4 ? wrg[k * 4 + c] : wre[k * 16 + c - 4]; }
        __syncthreads();
    }
    f32x4 gv[4], bv[4];
#pragma unroll
    for (int j = 0; j < 4; ++j) { gv[j] = *(const f32x4*)(gam + 4 * lane + 256 * j); bv[j] = *(const f32x4*)(bet + 4 * lane + 256 * j); }
    for (int row = gw; row < M; row += NGW) {
        f32x4 v[4]; float s = 0.f;
#pragma unroll
        for (int j = 0; j < 4; ++j) { const f32x4 hv = *(const GAS f32x4*)(H + (size_t)row * D + 4 * lane + 256 * j), av = *(const GAS f32x4*)(ADD + (size_t)row * D + 4 * lane + 256 * j);
            v[j] = hv * DN_ALPHA + av; s += (v[j].x + v[j].y) + (v[j].z + v[j].w); }
        const float mean = wave_sum(s) * (1.f / D); float s2 = 0.f;
#pragma unroll
        for (int j = 0; j < 4; ++j) { v[j] = v[j] - mean; s2 += (v[j].x * v[j].x + v[j].y * v[j].y) + (v[j].z * v[j].z + v[j].w * v[j].w); }
        const float rstd = rsqrtf(wave_sum(s2) * (1.f / D) + LN_EPS);
#pragma unroll
        for (int j = 0; j < 4; ++j) { v[j] = v[j] * rstd * gv[j] + bv[j];
            *(GAS f32x4*)(H + (size_t)row * D + 4 * lane + 256 * j) = v[j];
            *(GAS unsigned long long*)(HB + (size_t)row * D + 4 * lane + 256 * j) = (unsigned long long)pk2(v[j].x, v[j].y) | ((unsigned long long)pk2(v[j].z, v[j].w) << 32); }
        if (ROUTER) {
            float lg[20];
#pragma unroll 1
            for (int c = 0; c < 20; ++c) { float p = 0.f;
#pragma unroll
                for (int j = 0; j < 4; ++j) { const f32x4 wv = *(const LAS f32x4*)(sW + c * D + 4 * lane + 256 * j); p += (v[j].x * wv.x + v[j].y * wv.y) + (v[j].z * wv.z + v[j].w * wv.w); }
                p = wave_sum(p); if (lane == 0) sL[c] = p; }
#pragma unroll
            for (int c = 0; c < 20; ++c) lg[c] = sL[c];
            float pg[4], mx = -1e30f; int gi = 0;
#pragma unroll
            for (int c = 0; c < 4; ++c) { pg[c] = lg[c] + a->in[I_BRG][l * 4 + c]; if (pg[c] > mx) { mx = pg[c]; gi = c; } }
            float den = 0.f;
#pragma unroll
            for (int c = 0; c < 4; ++c) den += __expf(pg[c] - mx);
            const float g_p = 1.0f / den;
            float le[4], emx = -1e30f; int i1 = 0;
#pragma unroll
            for (int c = 0; c < 4; ++c) { float x = 0.f;
#pragma unroll
                for (int gg = 0; gg < 4; ++gg) x = (gi == gg) ? lg[4 + gg * 4 + c] + a->in[I_BRE][l * 16 + gg * 4 + c] : x;
                le[c] = x; if (x > emx) { emx = x; i1 = c; } }
            float e2mx = -1e30f; int i2 = 0;
#pragma unroll
            for (int c = 0; c < 4; ++c) if (c != i1 && le[c] > e2mx) { e2mx = le[c]; i2 = c; }
            const float x1 = 1.0f, x2 = __expf(e2mx - emx), w1 = g_p * x1 / (x1 + x2), w2 = g_p * x2 / (x1 + x2);
            if (lane < 16) { const int gl = lane >> 2, el = lane & 3; float cwv = 0.f; if (gl == gi) { if (el == i1) cwv = w1; else if (el == i2) cwv = w2; } COMB[(size_t)row * 16 + lane] = cwv; }
        }
    }
}

#ifndef PHASE_MASK
#define PHASE_MASK 0x7ff
#endif
#define PM(k) (((PHASE_MASK) >> (k)) & 1)
constexpr int NPH = 10;
constexpr int N_PHASES = 1 + DEPTH * NPH;
__global__ void __launch_bounds__(NTHR, 2) fwd(Args args) {
    extern __shared__ __attribute__((aligned(16))) unsigned char lds_raw[];
    LAS unsigned char* lds = (LAS unsigned char*)lds_raw;
    volatile LAS unsigned* MISC = (volatile LAS unsigned*)(lds + MISC_OFF);
    const int tid = threadIdx.x, G = gridDim.x, bx = blockIdx.x;
    unsigned char* ws = args.ws;
    gu32* ctl = (gu32*)(ws + WS_CTL);
    for (int u = tid; u < (LDS_BYTES - LDSCTL_OFF) / 4; u += NTHR) ((LAS unsigned*)(lds + LDSCTL_OFF))[u] = 0u;
    __syncthreads();
    const int lo = args.ph_lo, hi = args.ph_hi;
    const bool use_bar = (hi - lo) > 1;
    XcdBarrier bar; bar.bar = (unsigned*)(ctl + CW_BAR); bar.x = 0; bar.st = nullptr;
    if (use_bar) bar = xcd_barrier_post((unsigned*)(ctl + CW_BAR), MISC + 8);
#define IN(k) (lo <= (k) && (k) < hi)
#define SEAM(k) do { if (IN(k) && IN((k) + 1)) xcd_barrier(bar); } while (0)

    if (PM(10) && IN(0)) { p0_prologue(ARGS_HERE(), lds, bx, G, tid); SEAM(0); }

    for (int l = 0; l < DEPTH; ++l) {
        const int base = 1 + l * NPH;
        if (PM(0) && IN(base + 0)) {
            pg8::Gemm g{(const pg8::bf16_t*)(ws + WS_HB), (const pg8::bf16_t*)(ws + WS_WIN) + (size_t)l * NPROJ * D, M, NPROJ, D}; pg8::StaticOrder S; S.init(M, NPROJ, G, bx);
            pg8::EpiBf16<0> E{(pg8::bf16_t*)(ws + WS_PROJ), NPROJ, nullptr, 0, 0, 1.f};
            pg8::gemm_phase<pg8::EpiBf16<0>, pg8::StaticOrder, true, true>(lds + RING_OFF, g, S, E);
            SEAM(base + 0);
        }
        if (PM(1) && IN(base + 1)) { ssd_rec_phase(ARGS_HERE(), l, lds, bx, G, tid); SEAM(base + 1); }
        if (PM(2) && IN(base + 2)) { gdn_rec_phase(ARGS_HERE(), l, lds, bx, G, tid); SEAM(base + 2); }
        if (PM(3) && IN(base + 3)) { hgrn_rec_phase(ARGS_HERE(), l, lds, bx, G, tid); SEAM(base + 3); }
        if (PM(4) && IN(base + 4)) { mix_post_phase(ARGS_HERE(), l, bx, G, tid); SEAM(base + 4); }
        if (PM(5) && IN(base + 5)) {
            pg8::Gemm g{(const pg8::bf16_t*)(ws + WS_YMIX), (const pg8::bf16_t*)(ws + WS_WOUT) + (size_t)l * D * DMIX, M, D, DMIX}; pg8::StaticOrder S; S.init(M, D, G, bx);
            pg8::EpiF32 E{(float*)(ws + WS_MIX), D};
            pg8::gemm_phase<pg8::EpiF32, pg8::StaticOrder, true, true>(lds + RING_OFF, g, S, E);
            SEAM(base + 5);
        }
        if (PM(6) && IN(base + 6)) { { CArgs a_ = ARGS_HERE(); ln_phase<true>(a_, l, a_->in[I_LN1G] + l * D, a_->in[I_LN1B] + l * D, lds, bx, G, tid); }; SEAM(base + 6); }
        if (PM(7) && IN(base + 7)) {
            pg8::Gemm g{(const pg8::bf16_t*)(ws + WS_HB), (const pg8::bf16_t*)(ws + WS_WGU) + (size_t)l * NGU * D, M, NGU, D}; pg8::StaticOrder S; S.init(M, NGU, G, bx);
            pg8::EpiSwiGLU E{(pg8::bf16_t*)(ws + WS_H), KDN, (const float*)(ws + WS_COMB), 16};
            pg8::gemm_phase<pg8::EpiSwiGLU, pg8::StaticOrder, true, true>(lds + RING_OFF, g, S, E);
            SEAM(base + 7);
        }
        if (PM(8) && IN(base + 8)) {
            pg8::Gemm g{(const pg8::bf16_t*)(ws + WS_H), (const pg8::bf16_t*)(ws + WS_WDN) + (size_t)l * D * KDN, M, D, KDN}; pg8::StaticOrder S; S.init(M, D, G, bx);
            pg8::EpiF32 E{(float*)(ws + WS_MIX), D};
            pg8::gemm_phase<pg8::EpiF32, pg8::StaticOrder, true, true>(lds + RING_OFF, g, S, E);
            SEAM(base + 8);
        }
        if (PM(9) && IN(base + 9)) { { CArgs a_ = ARGS_HERE(); ln_phase<false>(a_, l, a_->in[I_LN2G] + l * D, a_->in[I_LN2B] + l * D, lds, bx, G, tid); }; SEAM(base + 9); }
    }
#undef IN
#undef SEAM
}

#ifndef MK_ONE_LAUNCH
#define MK_ONE_LAUNCH 1
#endif
extern "C" void kernel_launch(void* const* d_in, const int* in_sizes, int n_in, void* d_out, int out_size, void* d_ws, size_t ws_size, hipStream_t stream) {
    static int grid = 0;
    if (grid == 0) {
        if (n_in != 25 || out_size != M * D || ws_size < WS_END) { fprintf(stderr, "kernel_launch: unexpected shapes (n_in %d out %d ws %zu)\n", n_in, out_size, ws_size); grid = -1; return; }
        int dev = 0, cus = 0, per_cu = 0;
        if (hipGetDevice(&dev) != hipSuccess || hipDeviceGetAttribute(&cus, hipDeviceAttributeMultiprocessorCount, dev) != hipSuccess) { grid = -1; return; }
        if (hipFuncSetAttribute((const void*)fwd, hipFuncAttributeMaxDynamicSharedMemorySize, LDS_BYTES) != hipSuccess) { fprintf(stderr, "kernel_launch: hipFuncSetAttribute failed\n"); grid = -1; return; }
        if (hipOccupancyMaxActiveBlocksPerMultiprocessor(&per_cu, (const void*)fwd, NTHR, LDS_BYTES) != hipSuccess || per_cu < 1) { fprintf(stderr, "kernel_launch: occupancy query says %d\n", per_cu); (void)hipGetLastError(); grid = -1; return; }
        grid = cus;
    }
    if (grid < 0) return;
    if (hipMemsetAsync((char*)d_ws + WS_CTL, 0, CTL_ZERO_BYTES, stream) != hipSuccess) return;
    Args a{};
    for (int i = 0; i < 25; ++i) a.in[i] = (const float*)d_in[i];
    a.out = (float*)d_out; a.ws = (unsigned char*)d_ws;
#if MK_ONE_LAUNCH
    a.ph_lo = 0; a.ph_hi = N_PHASES;
    hipLaunchKernelGGL(fwd, dim3(grid), dim3(NTHR), LDS_BYTES, stream, a);
#else
    for (int p = 0; p < N_PHASES; ++p) { a.ph_lo = p; a.ph_hi = p + 1; hipLaunchKernelGGL(fwd, dim3(grid), dim3(NTHR), LDS_BYTES, stream, a); }
#endif
}
```

```cpp
#include <hip/hip_runtime.h>
#include <cstdio>
#include <cstdint>
namespace pg8 {
#define PG8_LAS __attribute__((address_space(3)))
typedef unsigned short bf16_t;
typedef short bf16x8 __attribute__((ext_vector_type(8)));
typedef float f32x4 __attribute__((ext_vector_type(4)));
typedef unsigned u32x4 __attribute__((ext_vector_type(4)));
constexpr int BM = 256, BK = 64, HALF = 128, HTB = HALF * BK * 2  , STAGE_BYTES = 8 * HTB, NXCD = 8, WGM = 8;

__host__ __device__ __forceinline__ int lds_byte(int r, int c) { const int st = (r >> 4) * 2 + (c >> 5), rr = r & 15, cc = c & 31, ob = rr * 64 + cc * 2; return st * 1024 + (ob ^ (((ob >> 9) & 1) << 5)); }
__host__ __device__ __forceinline__ void stage_rc(int b, int& R, int& C) { const int st = b / 1024, sb = b % 1024, swz = sb ^ (((sb >> 9) & 1) << 5); R = (st >> 1) * 16 + swz / 64; C = (st & 1) * 32 + (swz % 64) / 2; }
__host__ __device__ __forceinline__ int perm32(int rho) { const int n = rho >> 4, i = rho & 15; return 8 * (i >> 2) + 4 * n + (i & 3); }

struct Unit { int pm, pn; };
struct Gemm { const bf16_t* A; const bf16_t* Bt; int M, N, K; };

struct StaticOrder {
    int nM, nN, nwg, G, c;
    __host__ __device__ void init(int M, int N, int G_, int c_) { nM = M / BM; nN = N / BM; nwg = nM * nN; G = G_; c = c_; }
    __host__ __device__ bool next(int i, Unit& u) const {
        const long L = (long)i * G + c; if (L >= nwg) return false;
        int wgid = (int)L; { const int q = nwg / NXCD, r = nwg % NXCD, xcd = wgid % NXCD, off = wgid / NXCD; wgid = (xcd < r ? xcd * (q + 1) : r * (q + 1) + (xcd - r) * q) + off; }
        const int nig = WGM * nN, gid = wgid / nig, fm = gid * WGM, gsz = (nM - fm) < WGM ? (nM - fm) : WGM;
        u.pm = fm + ((wgid % nig) % gsz); u.pn = (wgid % nig) / gsz; return true;
    }
    __device__ __forceinline__ void a_ready(const Unit&) const {}
    __device__ __forceinline__ void done(const Unit&) const {}
};
__device__ __forceinline__ unsigned cvt_pk_bf16(float lo, float hi) { unsigned r; asm volatile("v_cvt_pk_bf16_f32 %0, %1, %2" : "=v"(r) : "v"(lo), "v"(hi)); return r; }
typedef float f32x2 __attribute__((ext_vector_type(2)));
__device__ __forceinline__ f32x2 gelu_pk(f32x2 v) {
    const f32x2 av = __builtin_elementwise_abs(v), d = av * 0.2316418882f + 1.0f;
    f32x2 t; t.x = __builtin_amdgcn_rcpf(d.x); t.y = __builtin_amdgcn_rcpf(d.y);
    f32x2 q = t * 0.5307027145f + (-0.7265760135f); q = q * t + 0.7107068705f; q = q * t + (-0.142248368f); q = q * t + 0.127414796f; q = q * t;
    const f32x2 s = (v * v) * (-0.72134752044f);
    f32x2 e; e.x = __builtin_amdgcn_exp2f(s.x); e.y = __builtin_amdgcn_exp2f(s.y);
    const f32x2 m = v * (q * e), r = v - m;
    f32x2 o; o.x = v.x < 0.f ? m.x : r.x; o.y = v.y < 0.f ? m.y : r.y; return o;
}

template <int ACT  > struct EpiBf16 {
    static constexpr bool PERM = true, AFTER_DRAIN = false; static_assert(ACT == 0 || ACT == 1, "EpiBf16: ACT is 0 (none) or 1 (gelu_pk)");
    bf16_t* O; int ldc; const float* bias; int split_cols; size_t split_stride; float scale0;
    __device__ __forceinline__ void operator()(const f32x4 (&acc)[2][2][4][2], const Unit& u, int wr, int wc, int fr, int fq) const {
        const int row0 = u.pm * BM + wr * 64 + fr; int colt = u.pn * BM; bf16_t* base = O;
        float sc = 1.f; if (split_cols) { const int t = colt / split_cols; base += (size_t)t * split_stride; colt -= t * split_cols; if (t == 0) sc = scale0; }
        const int col0 = colt + wc * 32 + 8 * fq, bcol0 = u.pn * BM + wc * 32 + 8 * fq;
        f32x4 bv[2][2];
#pragma unroll
        for (int bj = 0; bj < 2; ++bj)
#pragma unroll
            for (int n = 0; n < 2; ++n) bv[bj][n] = bias ? *(const f32x4*)(bias + bcol0 + bj * HALF + 4 * n) : (f32x4){0.f, 0.f, 0.f, 0.f};
#pragma unroll
        for (int ai = 0; ai < 2; ++ai)
#pragma unroll
            for (int m = 0; m < 4; ++m) { bf16_t* rowp = base + (size_t)(row0 + ai * HALF + m * 16) * ldc + col0;
#pragma unroll
                for (int bj = 0; bj < 2; ++bj) { f32x4 v0 = acc[ai][bj][m][0] + bv[bj][0], v1 = acc[ai][bj][m][1] + bv[bj][1];
                    if (ACT == 1) { f32x2 a = gelu_pk((f32x2){v0[0], v0[1]}), b = gelu_pk((f32x2){v0[2], v0[3]}), c = gelu_pk((f32x2){v1[0], v1[1]}), d = gelu_pk((f32x2){v1[2], v1[3]});
                        v0 = (f32x4){a.x, a.y, b.x, b.y}; v1 = (f32x4){c.x, c.y, d.x, d.y}; }
                    v0 = v0 * sc; v1 = v1 * sc; u32x4 w; w.x = cvt_pk_bf16(v0[0], v0[1]); w.y = cvt_pk_bf16(v0[2], v0[3]); w.z = cvt_pk_bf16(v1[0], v1[1]); w.w = cvt_pk_bf16(v1[2], v1[3]);
                    *(u32x4*)(rowp + bj * HALF) = w; } }
    }
};
struct EpiF32 {
    static constexpr bool PERM = false, AFTER_DRAIN = false;
    float* C; int ldc;
    __device__ __forceinline__ void operator()(const f32x4 (&acc)[2][2][4][2], const Unit& u, int wr, int wc, int fr, int fq) const {
        const int row0 = u.pm * BM + wr * 64 + fr, col0 = u.pn * BM + wc * 32 + 4 * fq;
#pragma unroll
        for (int ai = 0; ai < 2; ++ai)
#pragma unroll
            for (int m = 0; m < 4; ++m) { float* rowp = C + (size_t)(row0 + ai * HALF + m * 16) * ldc + col0;
#pragma unroll
                for (int bj = 0; bj < 2; ++bj)
#pragma unroll
                    for (int n = 0; n < 2; ++n) *(f32x4*)(rowp + bj * HALF + n * 16) = acc[ai][bj][m][n]; }
    }
};
__device__ __forceinline__ float silu_f(float x) { return x / (1.0f + __expf(-x)); }
struct EpiSwiGLU {
    static constexpr bool PERM = true, AFTER_DRAIN = false;
    bf16_t* H; int ldh; const float* comb; int ldcomb;
    __device__ __forceinline__ void operator()(const f32x4 (&acc)[2][2][4][2], const Unit& u, int wr, int wc, int fr, int fq) const {
        const int row0 = u.pm * BM + wr * 64 + fr, col0 = u.pn * 128 + wc * 32 + 8 * fq, e = u.pn >> 1;
#pragma unroll
        for (int ai = 0; ai < 2; ++ai)
#pragma unroll
            for (int m = 0; m < 4; ++m) { const int row = row0 + ai * HALF + m * 16; const float cw = comb[(size_t)row * ldcomb + e];
                const f32x4 g0 = acc[ai][0][m][0], g1 = acc[ai][0][m][1], u0 = acc[ai][1][m][0], u1 = acc[ai][1][m][1];
                f32x4 h0, h1;
#pragma unroll
                for (int j = 0; j < 4; ++j) { h0[j] = silu_f(g0[j]) * u0[j] * cw; h1[j] = silu_f(g1[j]) * u1[j] * cw; }
                u32x4 w; w.x = cvt_pk_bf16(h0[0], h0[1]); w.y = cvt_pk_bf16(h0[2], h0[3]); w.z = cvt_pk_bf16(h1[0], h1[1]); w.w = cvt_pk_bf16(h1[2], h1[3]);
                *(u32x4*)(H + (size_t)row * ldh + col0) = w; }
    }
};
template <class Epi, class Sched, bool ALIGN_EPI = false, bool SP2 = false>
__device__ __forceinline__ void gemm_phase(PG8_LAS unsigned char* lds, const Gemm g, const Sched& S, const Epi& E) {
    int tid_ = threadIdx.x; asm volatile("" : "+v"(tid_));
    const int tid = tid_, wid = __builtin_amdgcn_readfirstlane(tid >> 6), lane = tid & 63, wr = wid >> 2, wc = wid & 3, fr = lane & 15, fq = lane >> 4;
    const int K = g.K, nt = K / BK;
    unsigned voffA[2], voffB[2];
#pragma unroll
    for (int i = 0; i < 2; ++i) { int R, C; stage_rc(tid * 16 + i * 8192, R, C); const int Rb = Epi::PERM ? ((R & ~31) + perm32(R & 31)) : R;
        voffA[i] = (unsigned)(R * K + C) * 2u; voffB[i] = (unsigned)(Rb * K + C) * 2u; }
    const size_t kstep = (size_t)(BK * 2);
    const size_t hstep = (size_t)HALF * K * 2;
    const size_t tstep = 2 * hstep;
    const unsigned ldsw = (unsigned)wid * 1024u;
    const int aoff = lds_byte(wr * 64 + fr, fq * 8), boff = lds_byte(wc * 32 + fr, fq * 8);
#define PG8_SA(b, h) (((b) * 2 + (h)) * HTB)
#define PG8_SB(b, h) ((4 + (b) * 2 + (h)) * HTB)
#define PG8_STAGE(bufoff, gbase, voff) do { _Pragma("unroll") for (int _i = 0; _i < 2; ++_i) \
        __builtin_amdgcn_global_load_lds((const unsigned*)((const char*)(gbase) + (voff)[_i]), (PG8_LAS unsigned*)(lds + (bufoff) + ldsw + _i * 8192), 16, 0, 0); } while (0)
#define PG8_LDA(dst, b, h) do { _Pragma("unroll") for (int m = 0; m < 4; ++m) _Pragma("unroll") for (int k = 0; k < 2; ++k) dst[m][k] = *(const PG8_LAS bf16x8*)(lds + PG8_SA(b, h) + aoff + m * 2048 + k * 1024); } while (0)
#define PG8_LDB(dst, b, h) do { _Pragma("unroll") for (int n = 0; n < 2; ++n) _Pragma("unroll") for (int k = 0; k < 2; ++k) dst[n][k] = *(const PG8_LAS bf16x8*)(lds + PG8_SB(b, h) + boff + n * 2048 + k * 1024); } while (0)
#define PG8_MMA(ai, bj, At, Bt) do { __builtin_amdgcn_s_setprio(1); _Pragma("unroll") for (int m = 0; m < 4; ++m) _Pragma("unroll") for (int n = 0; n < 2; ++n) _Pragma("unroll") for (int k = 0; k < 2; ++k) \
        acc[ai][bj][m][n] = __builtin_amdgcn_mfma_f32_16x16x32_bf16(Bt[n][k], At[m][k], acc[ai][bj][m][n], 0, 0, 0); __builtin_amdgcn_s_setprio(0); } while (0)
#define PG8_WAIT_V(n) asm volatile("s_waitcnt vmcnt(" #n ")" ::: "memory")
#define PG8_WAIT_L(n) asm volatile("s_waitcnt lgkmcnt(" #n ")" ::: "memory")
#define PG8_BAR __builtin_amdgcn_s_barrier()
#define PG8_SCHED __builtin_amdgcn_sched_barrier(0)
    Unit cur, nxt; int ui = 0;
    if (!S.next(0, cur)) return;
    f32x4 acc[2][2][4][2];
#pragma unroll
    for (int a = 0; a < 2; ++a)
#pragma unroll
        for (int b = 0; b < 2; ++b)
#pragma unroll
            for (int m = 0; m < 4; ++m)
#pragma unroll
                for (int n = 0; n < 2; ++n) acc[a][b][m][n] = (f32x4){0.f, 0.f, 0.f, 0.f};
    bf16x8 At[4][2], B0[2][2], B1[2][2];
    const char* cA = (const char*)g.A + (size_t)cur.pm * tstep; const char* cB = (const char*)g.Bt + (size_t)cur.pn * tstep;
    S.a_ready(cur);
    if constexpr (SP2) {
        PG8_STAGE(PG8_SB(0, 0), cB, voffB); PG8_STAGE(PG8_SB(0, 1), cB + hstep, voffB); PG8_STAGE(PG8_SA(0, 0), cA, voffA); PG8_STAGE(PG8_SA(0, 1), cA + hstep, voffA);
        if (wr == 1) PG8_BAR;
        PG8_WAIT_V(2); PG8_BAR;
        PG8_STAGE(PG8_SB(1, 0), cB + kstep, voffB); PG8_STAGE(PG8_SA(1, 0), cA + kstep, voffA); PG8_STAGE(PG8_SB(1, 1), cB + hstep + kstep, voffB);
        PG8_WAIT_V(6); PG8_BAR;
    } else {
        PG8_STAGE(PG8_SB(0, 0), cB, voffB); PG8_STAGE(PG8_SA(0, 0), cA, voffA); PG8_STAGE(PG8_SB(0, 1), cB + hstep, voffB); PG8_STAGE(PG8_SA(0, 1), cA + hstep, voffA);
        if (wr == 1) PG8_BAR;
        PG8_WAIT_V(4); PG8_BAR;
        PG8_STAGE(PG8_SB(1, 0), cB + kstep, voffB); PG8_STAGE(PG8_SA(1, 0), cA + kstep, voffA); PG8_STAGE(PG8_SB(1, 1), cB + hstep + kstep, voffB);
        PG8_WAIT_V(6); PG8_BAR;
    }
    for (;;) {
        const bool has_next = S.next(ui + 1, nxt);
        const char* nA = has_next ? (const char*)g.A + (size_t)nxt.pm * tstep : cA; const char* nB = has_next ? (const char*)g.Bt + (size_t)nxt.pn * tstep : cB;
        for (int t = 0; t < nt; t += 2) {
            const bool last = (t == nt - 2);
            const char* a1 = cA + (size_t)(t + 1) * kstep;
            const char* a2 = last ? nA : cA + (size_t)(t + 2) * kstep; const char* b2 = last ? nB : cB + (size_t)(t + 2) * kstep;
            const char* a3 = a2 + kstep; const char* b3 = b2 + kstep;
            if (last && has_next) S.a_ready(nxt);
            if constexpr (SP2) {
            PG8_LDB(B0, 0, 0); PG8_LDB(B1, 0, 1); PG8_SCHED; PG8_LDA(At, 0, 0); PG8_STAGE(PG8_SA(1, 1), a1 + hstep, voffA);
            PG8_WAIT_V(8); PG8_WAIT_L(0); PG8_BAR; PG8_MMA(0, 0, At, B0); PG8_MMA(0, 1, At, B1); PG8_BAR; PG8_SCHED;
            PG8_LDA(At, 0, 1); PG8_STAGE(PG8_SB(0, 0), b2, voffB); PG8_STAGE(PG8_SB(0, 1), b2 + hstep, voffB); PG8_STAGE(PG8_SA(0, 0), a2, voffA);
            PG8_WAIT_V(8); PG8_WAIT_L(0); PG8_BAR; PG8_MMA(1, 0, At, B0); PG8_MMA(1, 1, At, B1); PG8_BAR; PG8_SCHED;
            PG8_LDB(B0, 1, 0); PG8_LDB(B1, 1, 1); PG8_SCHED; PG8_LDA(At, 1, 0); PG8_STAGE(PG8_SA(0, 1), a2 + hstep, voffA);
            PG8_WAIT_V(8); PG8_WAIT_L(0); PG8_BAR; PG8_MMA(0, 0, At, B0); PG8_MMA(0, 1, At, B1); PG8_BAR; PG8_SCHED;
            PG8_LDA(At, 1, 1); PG8_STAGE(PG8_SB(1, 0), b3, voffB); PG8_STAGE(PG8_SB(1, 1), b3 + hstep, voffB); PG8_STAGE(PG8_SA(1, 0), a3, voffA);
            PG8_WAIT_V(8); PG8_WAIT_L(0); PG8_BAR; PG8_MMA(1, 0, At, B0); PG8_MMA(1, 1, At, B1); PG8_BAR; PG8_SCHED;
            } else {
            PG8_LDB(B0, 0, 0); PG8_SCHED; PG8_LDA(At, 0, 0); PG8_STAGE(PG8_SA(1, 1), a1 + hstep, voffA);
            PG8_WAIT_L(8); PG8_BAR; PG8_WAIT_L(0); PG8_MMA(0, 0, At, B0); PG8_BAR; PG8_SCHED;
            PG8_LDB(B1, 0, 1); PG8_STAGE(PG8_SB(0, 0), b2, voffB);
            PG8_BAR; PG8_WAIT_L(0); PG8_MMA(0, 1, At, B1); PG8_BAR;
            PG8_LDA(At, 0, 1); PG8_STAGE(PG8_SA(0, 0), a2, voffA);
            PG8_BAR; PG8_WAIT_L(0); PG8_MMA(1, 0, At, B0); PG8_BAR; PG8_SCHED;
            PG8_STAGE(PG8_SB(0, 1), b2 + hstep, voffB);
            PG8_WAIT_V(6); PG8_BAR; PG8_MMA(1, 1, At, B1); PG8_BAR;
            PG8_LDB(B0, 1, 0); PG8_SCHED; PG8_LDA(At, 1, 0); PG8_STAGE(PG8_SA(0, 1), a2 + hstep, voffA);
            PG8_WAIT_L(8); PG8_BAR; PG8_WAIT_L(0); PG8_MMA(0, 0, At, B0); PG8_BAR; PG8_SCHED;
            PG8_LDB(B1, 1, 1); PG8_STAGE(PG8_SB(1, 0), b3, voffB);
            PG8_BAR; PG8_WAIT_L(0); PG8_MMA(0, 1, At, B1); PG8_BAR;
            PG8_LDA(At, 1, 1); PG8_STAGE(PG8_SA(1, 0), a3, voffA);
            PG8_BAR; PG8_WAIT_L(0); PG8_MMA(1, 0, At, B0); PG8_BAR; PG8_SCHED;
            PG8_STAGE(PG8_SB(1, 1), b3 + hstep, voffB);
            PG8_WAIT_V(6); PG8_BAR; PG8_MMA(1, 1, At, B1); PG8_BAR;
            }
        }
        if constexpr (ALIGN_EPI) { if (wr == 0) PG8_BAR; }
        if constexpr (!Epi::AFTER_DRAIN) { E(acc, cur, wr, wc, fr, fq); S.done(cur); }
        if (!has_next) break;
#pragma unroll
        for (int a = 0; a < 2; ++a)
#pragma unroll
            for (int b = 0; b < 2; ++b)
#pragma unroll
                for (int m = 0; m < 4; ++m)
#pragma unroll
                    for (int n = 0; n < 2; ++n) acc[a][b][m][n] = (f32x4){0.f, 0.f, 0.f, 0.f};
        cur = nxt; cA = nA; cB = nB; ++ui;
        if constexpr (ALIGN_EPI) { if (wr == 1) PG8_BAR; }
    }
    PG8_WAIT_V(0);
    if constexpr (!ALIGN_EPI) { if (wr == 0) PG8_BAR; }
    PG8_BAR;
    if constexpr (Epi::AFTER_DRAIN) { E.fused(acc, cur, wr, wc, fr, fq, lds, wid, lane); S.done(cur); }
#undef PG8_SA
#undef PG8_SB
#undef PG8_STAGE
#undef PG8_LDA
#undef PG8_LDB
#undef PG8_MMA
#undef PG8_WAIT_V
#undef PG8_WAIT_L
#undef PG8_BAR
#undef PG8_SCHED
}
}
#define GAS __attribute__((address_space(1)))
#define LAS __attribute__((address_space(3)))
typedef unsigned short bf16;
typedef unsigned v4u __attribute__((ext_vector_type(4)));
typedef float f32x4 __attribute__((ext_vector_type(4)));
typedef short bf16x8 __attribute__((ext_vector_type(8)));
typedef GAS unsigned gu32;
typedef GAS unsigned long long gu64;
#define RLX_AGENT __ATOMIC_RELAXED, __HIP_MEMORY_SCOPE_AGENT
#define LDS_WAIT() asm volatile("s_waitcnt lgkmcnt(0)" ::: "memory")
#define VM_WAIT() asm volatile("s_waitcnt vmcnt(0)" ::: "memory")
__device__ __forceinline__ unsigned long long rt() { return __builtin_amdgcn_s_memrealtime(); }
__device__ __forceinline__ unsigned f2bf(float f) { unsigned u = __builtin_bit_cast(unsigned, f); return (u + 0x7fffu + ((u >> 16) & 1u)) >> 16; }
__device__ __forceinline__ unsigned pk2(float lo, float hi) { return f2bf(lo) | (f2bf(hi) << 16); }

#define XB_TMO      128
#define XB_XCNT(j)  (256  + 64 * (j))
#define XB_XSUB(j)  (1280 + 64 * (j))
#define XB_XGEN(j)  (2304 + 64 * (j))
#define XB_TOP      3328
#define XB_TOPGEN   3392
#define XCD_BAR_WORDS 3456
#define XB_SPIN_CAP (1u << 18)

__device__ __forceinline__ unsigned xb_ld(unsigned* p)              { return __hip_atomic_load(p, __ATOMIC_RELAXED, __HIP_MEMORY_SCOPE_AGENT); }
__device__ __forceinline__ unsigned xb_add(unsigned* p, unsigned v) { return __hip_atomic_fetch_add(p, v, __ATOMIC_RELAXED, __HIP_MEMORY_SCOPE_AGENT); }
__device__ __forceinline__ unsigned xb_xcc_id() { return (unsigned)__builtin_amdgcn_s_getreg((3 << 11) | 20) & 0xFu; }
#define XB_SPIN(cond, bar) do { unsigned _sp = 0; while (cond) { __builtin_amdgcn_s_sleep(1); \
    if ((++_sp & 255u) == 0u) { if (xb_ld(&(bar)[XB_TMO])) break; if (_sp > XB_SPIN_CAP) { atomicAdd(&(bar)[XB_TMO], 1u); break; } } } } while (0)

struct XcdBarrier {
    unsigned* bar; unsigned x;
    volatile LAS unsigned* st;
};

__device__ __forceinline__ XcdBarrier xcd_barrier_post(unsigned* bar, volatile LAS unsigned* st) {
    XcdBarrier b; b.bar = bar; b.x = xb_xcc_id(); b.st = st;
    if (threadIdx.x == 0) (void)xb_add(&bar[XB_XCNT(b.x)], 1u);
    return b;
}
__device__ __forceinline__ void xcd_barrier_complete(unsigned* bar, unsigned x, unsigned& nloc, unsigned& nx) {
    const unsigned G = gridDim.x * gridDim.y * gridDim.z;
    unsigned sum, cnt, mine, sp = 0u;
    for (;;) {
        sum = 0u; cnt = 0u; mine = 0u;
#pragma unroll
        for (unsigned j = 0; j < 16; ++j) { const unsigned c = xb_ld(&bar[XB_XCNT(j)]); sum += c; cnt += (c > 0u) ? 1u : 0u; mine = (j == x) ? c : mine; }
        if (sum == G) break;
        __builtin_amdgcn_s_sleep(1);
        if ((++sp & 255u) == 0u) { if (xb_ld(&bar[XB_TMO])) break; if (sp > XB_SPIN_CAP) { atomicAdd(&bar[XB_TMO], 1u); break; } }
    }
    nloc = mine > 0u ? mine : 1u; nx = cnt > 0u ? cnt : 1u;
}

__device__ __forceinline__ void xcd_barrier(const XcdBarrier& b) {
    asm volatile("s_waitcnt vmcnt(0)" ::: "memory");
    __syncthreads();
    if (threadIdx.x == 0) {
        unsigned* bar = b.bar;
        __builtin_amdgcn_s_waitcnt(0);
        unsigned nloc = b.st[0], nx = b.st[1];
        if (nloc == 0u) { xcd_barrier_complete(bar, b.x, nloc, nx); b.st[0] = nloc; b.st[1] = nx; }
        const unsigned old = xb_add(&bar[XB_XSUB(b.x)], 1u);
        const unsigned gen = old / nloc;
        if (old + 1u == (gen + 1u) * nloc) {
            __builtin_amdgcn_fence(__ATOMIC_RELEASE, "agent");
            asm volatile("s_waitcnt vmcnt(0)" ::: "memory");
            const unsigned og = xb_add(&bar[XB_TOP], 1u);
            const unsigned tg = og / nx;
            if (og + 1u == (tg + 1u) * nx) xb_add(&bar[XB_TOPGEN], 1u);
            else XB_SPIN(xb_ld(&bar[XB_TOPGEN]) == tg, bar);
            __builtin_amdgcn_fence(__ATOMIC_ACQUIRE, "agent");
            xb_add(&bar[XB_XGEN(b.x)], 1u);
            asm volatile("s_waitcnt vmcnt(0)" ::: "memory");
        } else {
            XB_SPIN(xb_ld(&bar[XB_XGEN(b.x)]) == gen, bar);
            __builtin_amdgcn_fence(__ATOMIC_ACQUIRE, "agent");
            asm volatile("s_waitcnt vmcnt(0)" ::: "memory");
        }
    }
    __syncthreads();
}
constexpr int NWAVES = 8, NTHR = NWAVES * 64;
constexpr int D = 1024, BATCH = 4, SEQ = 4096, M = BATCH * SEQ, DEPTH = 4;
constexpr int IN_COLS = 6680, NPROJ = 6912;
constexpr int O_Z = 0, O_XBC = 1024, O_DT = 2560, O_QKV = 2576, O_GG = 4112, O_GB = 4624, O_GA = 4628, O_HQ = 4632, O_HF = 5144, O_HI = 5656, O_HG = 6168;
constexpr int DMIX = 2048, NEXP = 16, DEXP = 256, NGU = NEXP * 2 * DEXP  , KDN = NEXP * DEXP  ;
constexpr float DN_ALPHA = 1.6817928305074290f;
constexpr float LN_EPS = 1e-5f;

constexpr size_t MiB = 1u << 20;
constexpr size_t WS_CTL = 0, CTL_ZERO_BYTES = 1 * MiB;
constexpr size_t WS_COMB = 1 * MiB;
constexpr size_t WS_WIN = 8 * MiB;
constexpr size_t WS_WOUT = 22 * MiB;
constexpr size_t WS_WGU = 26 * MiB;
constexpr size_t WS_WDN = 42 * MiB;
constexpr size_t WS_YMIX = 52 * MiB;
constexpr size_t WS_HB = WS_YMIX;
constexpr size_t WS_PROJ = 116 * MiB;
constexpr size_t WS_MIX = WS_PROJ;
constexpr size_t WS_H = WS_PROJ + 64 * MiB;
constexpr size_t WS_SCR = 332 * MiB;
constexpr size_t WS_HG_QG = WS_SCR;
constexpr size_t WS_HG_KDT = WS_SCR + 16 * MiB;
constexpr size_t WS_HG_A = WS_SCR + 32 * MiB;
constexpr size_t WS_HG_GL = WS_SCR + 40 * MiB;
constexpr size_t WS_END = 512 * MiB;
constexpr int CW_BAR = 4096;

constexpr int RING_OFF = 0, RING_BYTES = 131072;
constexpr int LDSCTL_OFF = RING_BYTES, MISC_OFF = LDSCTL_OFF + 320;
constexpr int LDS_BYTES = 147456;

__device__ __forceinline__ float bf2f(unsigned short b) { return __builtin_bit_cast(float, ((unsigned)b) << 16); }
__device__ __forceinline__ float bflo(unsigned w) { return __builtin_bit_cast(float, w << 16); }
__device__ __forceinline__ float bfhi(unsigned w) { return __builtin_bit_cast(float, w & 0xffff0000u); }
__device__ __forceinline__ float siluf(float x) { return x / (1.0f + __expf(-x)); }
__device__ __forceinline__ float sigmoidf_(float x) { return 1.0f / (1.0f + __expf(-x)); }
__device__ __forceinline__ float softplusf_(float x) { return x > 20.f ? x : log1pf(__expf(x)); }
__device__ __forceinline__ float wave_sum(float v) {
#pragma unroll
    for (int o = 1; o < 64; o <<= 1) v += __shfl_xor(v, o);
    return v;
}

struct Args {
    const float* in[25]; float* out; unsigned char* ws; int ph_lo, ph_hi;
};
typedef const __attribute__((address_space(4))) Args* CArgs;
#define ARGS_HERE() ([]() { CArgs p_ = (CArgs)__builtin_amdgcn_kernarg_segment_ptr(); asm volatile("" : "+s"(p_)); return p_; }())
enum { I_X = 0, I_WIN, I_SCW, I_SCB, I_SDTB, I_SALOG, I_SD, I_SNW, I_GCW, I_GDTB, I_GALOG, I_GNW, I_HLB, I_HNW, I_WOUT, I_LN1G, I_LN1B, I_WRG, I_BRG, I_WRE, I_BRE, I_WGU, I_WDN, I_LN2G, I_LN2B };

__device__ __forceinline__ void transpose_item(const float* W, int ldw, int nvalid, int k0, int n0, bf16* WT, size_t ldt, int drow0, int dk0, LAS float* scr, int lane) {
#pragma unroll 8
    for (int i = 0; i < 32; ++i) { const int kk = 2 * i + (lane >> 5), nn = lane & 31, n = n0 + nn; scr[kk * 33 + nn] = (n < nvalid) ? W[(size_t)(k0 + kk) * ldw + n] : 0.f; }
    LDS_WAIT(); asm volatile("" ::: "memory");
    const int c = lane & 7;
#pragma unroll
    for (int j = 0; j < 4; ++j) { const int n = (lane >> 3) + 8 * j; const LAS float* s = scr + (8 * c) * 33 + n;
        v4u o; o.x = pk2(s[0 * 33], s[1 * 33]); o.y = pk2(s[2 * 33], s[3 * 33]); o.z = pk2(s[4 * 33], s[5 * 33]); o.w = pk2(s[6 * 33], s[7 * 33]);
        *(GAS v4u*)(WT + (size_t)(drow0 + n) * ldt + dk0 + k0 + 8 * c) = o; }
    LDS_WAIT(); asm volatile("" ::: "memory");
}
__device__ __forceinline__ void weights_phase(CArgs a, int l, LAS unsigned char* lds, int wg, int G, int tid) {
    asm volatile("" : "+v"(tid));
    const int lane = tid & 63, wave = tid >> 6;
    LAS float* scr = (LAS float*)(lds + wave * 16384);
    const int gw = wg * NWAVES + wave, NGW = G * NWAVES;
    constexpr int I_IN = 16 * (NPROJ / 32), I_OUT = (DMIX / 64) * (D / 32), I_GU = NEXP * 16 * 16, I_DN = NEXP * 4 * 32, I_LAYER = I_IN + I_OUT + I_GU + I_DN;
    unsigned char* ws = a->ws;
    for (int it = gw; it < I_LAYER; it += NGW) {
        int r = it;
        if (r < I_IN) { const int kb = r / (NPROJ / 32), nb = r % (NPROJ / 32);
            transpose_item(a->in[I_WIN] + (size_t)l * D * IN_COLS, IN_COLS, IN_COLS, 64 * kb, 32 * nb, (bf16*)(ws + WS_WIN), D, 32 * nb, 0, scr, lane); continue; }
        r -= I_IN;
        if (r < I_OUT) { const int kb = r / (D / 32), nb = r % (D / 32);
            transpose_item(a->in[I_WOUT] + (size_t)l * DMIX * D, D, D, 64 * kb, 32 * nb, (bf16*)(ws + WS_WOUT), DMIX, 32 * nb, 0, scr, lane); continue; }
        r -= I_OUT;
        if (r < I_GU) { const int e = r / 256, q = r % 256, kb = q / 16, nb = q % 16, c0 = 32 * nb, bj = c0 / 256, hf = (c0 % 256) / 128, j0 = c0 % 128;
            transpose_item(a->in[I_WGU] + (size_t)(l * NEXP + e) * D * 512, 512, 512, 64 * kb, c0, (bf16*)(ws + WS_WGU), D, e * 512 + hf * 256 + bj * 128 + j0, 0, scr, lane); continue; }
        r -= I_GU;
        { const int e = r / 128, q = r % 128, kb = q / 32, nb = q % 32;
            transpose_item(a->in[I_WDN] + (size_t)(l * NEXP + e) * DEXP * D, D, D, 64 * kb, 32 * nb, (bf16*)(ws + WS_WDN), KDN, 32 * nb, e * DEXP, scr, lane); }
    }
}
__device__ __forceinline__ void p0_prologue(CArgs a, LAS unsigned char* lds, int wg, int G, int tid) {
    asm volatile("" : "+v"(tid));
    const f32x4* x4 = (const f32x4*)a->in[I_X]; f32x4* h4 = (f32x4*)a->out; unsigned long long* hb8 = (unsigned long long*)(a->ws + WS_HB);
    for (size_t i = (size_t)wg * NTHR + tid; i < (size_t)M * D / 4; i += (size_t)G * NTHR) { const f32x4 v = x4[i]; h4[i] = v;
        hb8[i] = (unsigned long long)pk2(v.x, v.y) | ((unsigned long long)pk2(v.z, v.w) << 32); }
}

__device__ __forceinline__ f32x4 mfma16(bf16x8 x, bf16x8 y, f32x4 c) { return __builtin_amdgcn_mfma_f32_16x16x32_bf16(x, y, c, 0, 0, 0); }
__device__ __forceinline__ bf16x8 lds_frag(const LAS bf16* base, int row0, int stride, int k0, int lane) { return *(const LAS bf16x8*)(base + (row0 + (lane & 15)) * stride + k0 + 8 * (lane >> 4)); }
__device__ __forceinline__ bf16x8 pack8(const float* v) { v4u w; w.x = pk2(v[0], v[1]); w.y = pk2(v[2], v[3]); w.z = pk2(v[4], v[5]); w.w = pk2(v[6], v[7]); return __builtin_bit_cast(bf16x8, w); }
__device__ __forceinline__ unsigned long long pack4(f32x4 v) { return (unsigned long long)pk2(v[0], v[1]) | ((unsigned long long)pk2(v[2], v[3]) << 32); }

__device__ __forceinline__ void hgrn_prep_phase(CArgs a, int l, LAS unsigned char* lds, int wg, int G, int tid) {
    asm volatile("" : "+v"(tid));
    constexpr int LS = 132;
    LAS float* sQ = (LAS float*)lds; LAS float* sK = sQ + 64 * LS; LAS float* sB = sK + 64 * LS; LAS float* sT = sB + 64 * LS; LAS float* sLb = sT + 512;
    const bf16* PROJ = (const bf16*)(a->ws + WS_PROJ);
    const int lane = tid & 63, w = tid >> 6, r = lane & 15, q4 = lane >> 4;
    for (int unit = wg; unit < 1024; unit += G) {
        const int b = unit >> 8, head = (unit >> 6) & 3, c = unit & 63;
        const size_t row0 = (size_t)b * SEQ + c * 64;
        __syncthreads();
        if (tid < 128) {
            const int ch = head * 128 + tid; float lg[DEPTH], mx = -1e30f;
#pragma unroll
            for (int j = 0; j < DEPTH; ++j) { lg[j] = a->in[I_HLB][j * 512 + ch]; mx = fmaxf(mx, lg[j]); }
            float den = 0.f, num = 0.f;
#pragma unroll
            for (int j = 0; j < DEPTH; ++j) { const float e = __expf(lg[j] - mx); den += e; if (j >= 1 && j <= l) num += e; }
            sLb[tid] = num / den;
        }
        __syncthreads();
        for (int p = tid; p < 1024; p += NTHR) {
            const int t = p >> 4, d8 = (p & 15) * 8;
            const v4u qv = *(const GAS v4u*)(PROJ + (row0 + t) * NPROJ + O_HQ + head * 128 + d8), fv = *(const GAS v4u*)(PROJ + (row0 + t) * NPROJ + O_HF + head * 128 + d8);
#pragma unroll
            for (int i = 0; i < 4; ++i) {
                const int d = d8 + 2 * i; const float lb0 = sLb[d], lb1 = sLb[d + 1];
                sQ[t * LS + d] = siluf(bflo(qv[i])); sQ[t * LS + d + 1] = siluf(bfhi(qv[i]));
                const float f0 = lb0 + (1.f - lb0) * sigmoidf_(bflo(fv[i])), f1 = lb1 + (1.f - lb1) * sigmoidf_(bfhi(fv[i]));
                sK[t * LS + d] = 1.f - f0; sK[t * LS + d + 1] = 1.f - f1; sB[t * LS + d] = __logf(f0); sB[t * LS + d + 1] = __logf(f1);
            }
        }
        __syncthreads();
        {
            const int d = tid & 127, seg = tid >> 7; float run = 0.f, vals[16];
#pragma unroll
            for (int i = 0; i < 16; ++i) { run += sB[(seg * 16 + i) * LS + d]; vals[i] = run; }
            sT[seg * 128 + d] = run;
            __syncthreads();
            float off = 0.f;
#pragma unroll
            for (int s2 = 0; s2 < 3; ++s2) if (s2 < seg) off += sT[s2 * 128 + d];
#pragma unroll
            for (int i = 0; i < 16; ++i) sB[(seg * 16 + i) * LS + d] = vals[i] + off;
        }
        __syncthreads();
        bf16* qg = (bf16*)(a->ws + WS_HG_QG) + (size_t)unit * 64 * 128; bf16* kdt = (bf16*)(a->ws + WS_HG_KDT) + (size_t)unit * 128 * 64;
        bf16* am = (bf16*)(a->ws + WS_HG_A) + (size_t)unit * 64 * 64; float* gl = (float*)(a->ws + WS_HG_GL) + (size_t)unit * 128;
        for (int p = tid; p < 1024; p += NTHR) { const int t = p >> 4, d8 = (p & 15) * 8; float v[8];
#pragma unroll
            for (int jj = 0; jj < 8; ++jj) v[jj] = sQ[t * LS + d8 + jj] * __expf(sB[t * LS + d8 + jj]);
            *(GAS bf16x8*)(qg + t * 128 + d8) = pack8(v); }
        for (int p = tid; p < 1024; p += NTHR) { const int d = p >> 3, s8 = (p & 7) * 8; const float bl = sB[63 * LS + d]; float v[8];
#pragma unroll
            for (int jj = 0; jj < 8; ++jj) v[jj] = sK[(s8 + jj) * LS + d] * __expf(bl - sB[(s8 + jj) * LS + d]);
            *(GAS bf16x8*)(kdt + d * 64 + s8) = pack8(v); }
        if (tid < 128) gl[tid] = __expf(sB[63 * LS + tid]);
        for (int p = w; p < 16; p += NWAVES) {
            const int i = p >> 2, j = p & 3; f32x4 acc = {0.f, 0.f, 0.f, 0.f};
            if (j <= i) {
#pragma unroll
                for (int ks = 0; ks < 4; ++ks) { const int d0 = 32 * ks + 8 * q4, t = 16 * i + r, s_ = 16 * j + r; float qf[8], kf[8];
#pragma unroll
                    for (int jj = 0; jj < 8; ++jj) { const float ref = i ? sB[(16 * i - 1) * LS + d0 + jj] : 0.f;
                        qf[jj] = sQ[t * LS + d0 + jj] * __expf(sB[t * LS + d0 + jj] - ref); kf[jj] = sK[s_ * LS + d0 + jj] * __expf(ref - sB[s_ * LS + d0 + jj]); }
                    acc = mfma16(pack8(kf), pack8(qf), acc); }
                const int t = 16 * i + r;
#pragma unroll
                for (int ii = 0; ii < 4; ++ii) if (16 * j + 4 * q4 + ii > t) acc[ii] = 0.f;
            }
            *(GAS unsigned long long*)(am + (16 * i + r) * 64 + 16 * j + 4 * q4) = pack4(acc);
        }
    }
}
__device__ __forceinline__ void hgrn_scan_phase(CArgs a, int l, LAS unsigned char* lds, int wg, int G, int tid) {
    asm volatile("" : "+v"(tid));
    constexpr int QS = 136, KS = 72;
    constexpr int B_QG = 0, B_KDT = 17408, B_A = B_KDT + 18432, B_VT = B_A + 9216, B_GL = B_VT + 4608, BUF = B_GL + 512;
    LAS unsigned char* sST0 = lds + 2 * BUF;
    const bf16* PROJ = (const bf16*)(a->ws + WS_PROJ); bf16* YMIX = (bf16*)(a->ws + WS_YMIX);
    const int lane = tid & 63, w = tid >> 6, r = lane & 15, q4 = lane >> 4;
    for (int unit = wg; unit < 64; unit += G) {
        const int b = unit >> 4, head = (unit >> 2) & 3, eb = unit & 3;
        const size_t cu0 = (size_t)(b * 4 + head) * 64;
        const bf16* QG = (const bf16*)(a->ws + WS_HG_QG) + cu0 * 64 * 128; const bf16* KDT = (const bf16*)(a->ws + WS_HG_KDT) + cu0 * 128 * 64;
        const bf16* AM = (const bf16*)(a->ws + WS_HG_A) + cu0 * 64 * 64; const float* GL = (const float*)(a->ws + WS_HG_GL) + cu0 * 128;
        const bf16* VP = PROJ + (size_t)b * SEQ * NPROJ + O_HI + head * 128 + eb * 32;
        v4u rq[2], rk[2], ra, rv; f32x4 rg;
#define HG_LOAD(n) do { _Pragma("unroll") for (int i = 0; i < 2; ++i) { const int p = tid + NTHR * i; rq[i] = *(const GAS v4u*)(QG + (size_t)(n) * 8192 + (p >> 4) * 128 + (p & 15) * 8); \
            rk[i] = *(const GAS v4u*)(KDT + (size_t)(n) * 8192 + (p >> 3) * 64 + (p & 7) * 8); } \
            ra = *(const GAS v4u*)(AM + (size_t)(n) * 4096 + (tid >> 3) * 64 + (tid & 7) * 8); \
            if (tid < 256) rv = *(const GAS v4u*)(VP + (size_t)((n) * 64 + (tid >> 2)) * NPROJ + (tid & 3) * 8); \
            if (tid < 32) rg = *(const GAS f32x4*)(GL + (size_t)(n) * 128 + tid * 4); } while (0)
#define HG_STORE(bufp) do { LAS unsigned char* bp_ = (bufp); _Pragma("unroll") for (int i = 0; i < 2; ++i) { const int p = tid + NTHR * i; \
            *(LAS v4u*)(bp_ + B_QG + ((p >> 4) * QS + (p & 15) * 8) * 2) = rq[i]; *(LAS v4u*)(bp_ + B_KDT + ((p >> 3) * KS + (p & 7) * 8) * 2) = rk[i]; } \
            *(LAS v4u*)(bp_ + B_A + ((tid >> 3) * KS + (tid & 7) * 8) * 2) = ra; \
            if (tid < 256) { LAS bf16* vt = (LAS bf16*)(bp_ + B_VT); const int t_ = tid >> 2, e8 = (tid & 3) * 8; _Pragma("unroll") for (int i = 0; i < 4; ++i) { \
                vt[(e8 + 2 * i) * KS + t_] = (bf16)(rv[i] & 0xffffu); vt[(e8 + 2 * i + 1) * KS + t_] = (bf16)(rv[i] >> 16); } } \
            if (tid < 32) *(LAS f32x4*)(bp_ + B_GL + tid * 16) = rg; } while (0)
        __syncthreads();
        HG_LOAD(0);
        for (int i = tid; i < 8704 / 4; i += NTHR) ((LAS unsigned*)sST0)[i] = 0u;
        HG_STORE(lds);
        f32x4 accS[2] = {{0.f, 0.f, 0.f, 0.f}, {0.f, 0.f, 0.f, 0.f}};
        __syncthreads();
        for (int n = 0; n < 64; ++n) {
            const int cur = n & 1; LAS unsigned char* bp = lds + cur * BUF; LAS bf16* sST = (LAS bf16*)(sST0 + cur * 8704); LAS bf16* sSTn = (LAS bf16*)(sST0 + (cur ^ 1) * 8704);
            if (n + 1 < 64) HG_LOAD(n + 1);
            {
                const int tt = w >> 1, et = w & 1; f32x4 acc = {0.f, 0.f, 0.f, 0.f};
#pragma unroll
                for (int ks = 0; ks < 4; ++ks) acc = mfma16(lds_frag(sST, 16 * et, QS, 32 * ks, lane), lds_frag((LAS bf16*)(bp + B_QG), 16 * tt, QS, 32 * ks, lane), acc);
#pragma unroll
                for (int ks = 0; ks < 2; ++ks) acc = mfma16(lds_frag((LAS bf16*)(bp + B_VT), 16 * et, KS, 32 * ks, lane), lds_frag((LAS bf16*)(bp + B_A), 16 * tt, KS, 32 * ks, lane), acc);
                *(GAS unsigned long long*)(YMIX + ((size_t)b * SEQ + n * 64 + 16 * tt + r) * DMIX + 1536 + head * 128 + eb * 32 + 16 * et + 4 * q4) = pack4(acc);
            }
            {
                const f32x4 glv = *(const LAS f32x4*)(bp + B_GL + (16 * w + 4 * q4) * 4);
#pragma unroll
                for (int et = 0; et < 2; ++et) { accS[et] = accS[et] * glv;
#pragma unroll
                    for (int ks = 0; ks < 2; ++ks) accS[et] = mfma16(lds_frag((LAS bf16*)(bp + B_KDT), 16 * w, KS, 32 * ks, lane), lds_frag((LAS bf16*)(bp + B_VT), 16 * et, KS, 32 * ks, lane), accS[et]);
                    *(LAS unsigned long long*)(sSTn + (16 * et + r) * QS + 16 * w + 4 * q4) = pack4(accS[et]); }
            }
            if (n + 1 < 64) HG_STORE(lds + (cur ^ 1) * BUF);
            __syncthreads();
        }
#undef HG_LOAD
#undef HG_STORE
    }
}

__device__ __forceinline__ void ssd_rec_phase(CArgs a, int l, LAS unsigned char* lds, int wg, int G, int tid) {
    asm volatile("" : "+v"(tid));
    constexpr int TB = 64;
    LAS float* sX = (LAS float*)lds; LAS float* sB = sX + TB * 16; LAS float* sC = sB + TB * 128; LAS float* sDt = sC + TB * 128; LAS float* sDa = sDt + TB; LAS float* sY = sDa + TB;
    const bf16* PROJ = (const bf16*)(a->ws + WS_PROJ); bf16* YMIX = (bf16*)(a->ws + WS_YMIX);
    const float* cw = a->in[I_SCW] + (size_t)l * 4 * 1536; const float* cb = a->in[I_SCB] + (size_t)l * 1536;
    const int p_local = tid >> 5, nq = tid & 31;
    for (int unit = wg; unit < 256; unit += G) {
        const int b = unit >> 6, head = (unit >> 2) & 15, pq = unit & 3, g = head >> 3;
        const float A = -__expf(a->in[I_SALOG][l * 16 + head]), dtb = a->in[I_SDTB][l * 16 + head], Dsk = a->in[I_SD][l * 16 + head];
        float h0 = 0.f, h1 = 0.f, h2 = 0.f, h3 = 0.f;
        for (int t0 = 0; t0 < SEQ; t0 += TB) {
            __syncthreads();
            for (int idx = tid; idx < TB * 272; idx += NTHR) {
                const int tt = idx / 272, ci = idx % 272, t = t0 + tt;
                const int ch = ci < 16 ? head * 64 + pq * 16 + ci : (ci < 144 ? 1024 + g * 128 + (ci - 16) : 1280 + g * 128 + (ci - 144));
                float acc = cb[ch];
#pragma unroll
                for (int k = 0; k < 4; ++k) { const int ts = t - 3 + k; if (ts >= 0) acc += cw[k * 1536 + ch] * bf2f(PROJ[(size_t)(b * SEQ + ts) * NPROJ + O_XBC + ch]); }
                const float v = siluf(acc);
                if (ci < 16) sX[tt * 16 + ci] = v; else if (ci < 144) sB[tt * 128 + ci - 16] = v; else sC[tt * 128 + ci - 144] = v;
            }
            if (tid < TB) { const float raw = bf2f(PROJ[(size_t)(b * SEQ + t0 + tid) * NPROJ + O_DT + head]); const float dt = softplusf_(raw + dtb); sDt[tid] = dt; sDa[tid] = __expf(dt * A); }
            __syncthreads();
#pragma unroll 4
            for (int tt = 0; tt < TB; ++tt) {
                const float xv = sX[tt * 16 + p_local], da = sDa[tt], dx = sDt[tt] * xv;
                const f32x4 Bv = *(const LAS f32x4*)(sB + tt * 128 + nq * 4), Cv = *(const LAS f32x4*)(sC + tt * 128 + nq * 4);
                h0 = da * h0 + dx * Bv.x; h1 = da * h1 + dx * Bv.y; h2 = da * h2 + dx * Bv.z; h3 = da * h3 + dx * Bv.w;
                float part = (Cv.x * h0 + Cv.y * h1) + (Cv.z * h2 + Cv.w * h3);
                part += __shfl_xor(part, 1); part += __shfl_xor(part, 2); part += __shfl_xor(part, 4); part += __shfl_xor(part, 8); part += __shfl_xor(part, 16);
                if (nq == 0) sY[tt * 16 + p_local] = part + Dsk * xv;
            }
            __syncthreads();
            for (int idx = tid; idx < TB * 16; idx += NTHR) { const int tt = idx >> 4, i = idx & 15; YMIX[(size_t)(b * SEQ + t0 + tt) * DMIX + head * 64 + pq * 16 + i] = (bf16)f2bf(sY[idx]); }
        }
    }
}

__device__ __forceinline__ void gdn_rec_phase(CArgs a, int l, LAS unsigned char* lds, int wg, int G, int tid) {
    asm volatile("" : "+v"(tid));
    constexpr int TB = 32;
    LAS float* sQ = (LAS float*)lds; LAS float* sK = sQ + TB * 128; LAS float* sV = sK + TB * 128; LAS float* sBe = sV + TB * 8; LAS float* sAl = sBe + TB; LAS float* sO = sAl + TB;
    const bf16* PROJ = (const bf16*)(a->ws + WS_PROJ); bf16* YMIX = (bf16*)(a->ws + WS_YMIX);
    const float* cw = a->in[I_GCW] + (size_t)l * 4 * 1536;
    const int lane = tid & 63, w = tid >> 6;
    for (int unit = wg; unit < 256; unit += G) {
        const int b = unit >> 6, head = (unit >> 4) & 3, eb = unit & 15;
        const float nA = -__expf(a->in[I_GALOG][l * 4 + head]), dtb = a->in[I_GDTB][l * 4 + head];
        float S0 = 0.f, S1 = 0.f;
        for (int t0 = 0; t0 < SEQ; t0 += TB) {
            __syncthreads();
            for (int idx = tid; idx < TB * 264; idx += NTHR) {
                const int tt = idx / 264, ci = idx % 264, t = t0 + tt;
                const int ch = ci < 128 ? head * 128 + ci : (ci < 256 ? 512 + head * 128 + (ci - 128) : 1024 + head * 128 + eb * 8 + (ci - 256));
                float acc = 0.f;
#pragma unroll
                for (int k = 0; k < 4; ++k) { const int ts = t - 3 + k; if (ts >= 0) acc += cw[k * 1536 + ch] * bf2f(PROJ[(size_t)(b * SEQ + ts) * NPROJ + O_QKV + ch]); }
                const float v = siluf(acc);
                if (ci < 128) sQ[tt * 128 + ci] = v; else if (ci < 256) sK[tt * 128 + ci - 128] = v; else sV[tt * 8 + ci - 256] = v;
            }
            if (tid < TB) { const size_t ro = (size_t)(b * SEQ + t0 + tid) * NPROJ; const float braw = bf2f(PROJ[ro + O_GB + head]), araw = bf2f(PROJ[ro + O_GA + head]);
                sBe[tid] = sigmoidf_(braw); sAl[tid] = __expf(nA * softplusf_(araw + dtb)); }
            __syncthreads();
            for (int tt = w; tt < TB; tt += NWAVES) {
                const float q0 = sQ[tt * 128 + lane], q1 = sQ[tt * 128 + 64 + lane], k0 = sK[tt * 128 + lane], k1 = sK[tt * 128 + 64 + lane];
                const float sq = rsqrtf(wave_sum(q0 * q0 + q1 * q1) + 1e-6f) * 0.08838834764831845f, sk = rsqrtf(wave_sum(k0 * k0 + k1 * k1) + 1e-6f);
                sQ[tt * 128 + lane] = q0 * sq; sQ[tt * 128 + 64 + lane] = q1 * sq; sK[tt * 128 + lane] = k0 * sk; sK[tt * 128 + 64 + lane] = k1 * sk;
            }
            __syncthreads();
#pragma unroll 2
            for (int tt = 0; tt < TB; ++tt) {
                const float k0 = sK[tt * 128 + lane], k1 = sK[tt * 128 + 64 + lane], q0 = sQ[tt * 128 + lane], q1 = sQ[tt * 128 + 64 + lane];
                const float al = sAl[tt], be = sBe[tt], v = sV[tt * 8 + w];
                const float dot = wave_sum(k0 * S0 + k1 * S1);
                const float vn = be * (v - al * dot);
                S0 = al * S0 + k0 * vn; S1 = al * S1 + k1 * vn;
                const float od = wave_sum(q0 * S0 + q1 * S1);
                if (lane == 0) sO[tt * 8 + w] = od;
            }
            __syncthreads();
            if (tid < TB * 8) { const int tt = tid >> 3, i = tid & 7; YMIX[(size_t)(b * SEQ + t0 + tt) * DMIX + 1024 + head * 128 + eb * 8 + i] = (bf16)f2bf(sO[tid]); }
        }
    }
}

__device__ __forceinline__ void hgrn_rec_phase(CArgs a, int l, LAS unsigned char* lds, int wg, int G, int tid) {
    asm volatile("" : "+v"(tid));
    constexpr int TB = 32;
    LAS float* sQ = (LAS float*)lds; LAS float* sF = sQ + TB * 128; LAS float* sV = sF + TB * 128; LAS float* sO = sV + TB * 8; LAS float* sLb = sO + TB * 8;
    const bf16* PROJ = (const bf16*)(a->ws + WS_PROJ); bf16* YMIX = (bf16*)(a->ws + WS_YMIX);
    const int lane = tid & 63, w = tid >> 6;
    for (int unit = wg; unit < 256; unit += G) {
        const int b = unit >> 6, head = (unit >> 4) & 3, eb = unit & 15;
        __syncthreads();
        if (tid < 128) {
            const int c = head * 128 + tid; float lg[DEPTH], mx = -1e30f;
#pragma unroll
            for (int j = 0; j < DEPTH; ++j) { lg[j] = a->in[I_HLB][j * 512 + c]; mx = fmaxf(mx, lg[j]); }
            float den = 0.f, num = 0.f;
#pragma unroll
            for (int j = 0; j < DEPTH; ++j) { const float e = __expf(lg[j] - mx); den += e; if (j >= 1 && j <= l) num += e; }
            sLb[tid] = num / den;
        }
        float S0 = 0.f, S1 = 0.f;
        for (int t0 = 0; t0 < SEQ; t0 += TB) {
            __syncthreads();
            for (int idx = tid; idx < TB * 264; idx += NTHR) {
                const int tt = idx / 264, ci = idx % 264; const size_t ro = (size_t)(b * SEQ + t0 + tt) * NPROJ;
                if (ci < 128) sQ[tt * 128 + ci] = siluf(bf2f(PROJ[ro + O_HQ + head * 128 + ci]));
                else if (ci < 256) { const int d = ci - 128; const float lb = sLb[d]; sF[tt * 128 + d] = lb + (1.f - lb) * sigmoidf_(bf2f(PROJ[ro + O_HF + head * 128 + d])); }
                else sV[tt * 8 + ci - 256] = bf2f(PROJ[ro + O_HI + head * 128 + eb * 8 + (ci - 256)]);
            }
            __syncthreads();
#pragma unroll 2
            for (int tt = 0; tt < TB; ++tt) {
                const float f0 = sF[tt * 128 + lane], f1 = sF[tt * 128 + 64 + lane], q0 = sQ[tt * 128 + lane], q1 = sQ[tt * 128 + 64 + lane], v = sV[tt * 8 + w];
                S0 = f0 * S0 + (1.f - f0) * v; S1 = f1 * S1 + (1.f - f1) * v;
                const float od = wave_sum(q0 * S0 + q1 * S1);
                if (lane == 0) sO[tt * 8 + w] = od;
            }
            __syncthreads();
            if (tid < TB * 8) { const int tt = tid >> 3, i = tid & 7; YMIX[(size_t)(b * SEQ + t0 + tt) * DMIX + 1536 + head * 128 + eb * 8 + i] = (bf16)f2bf(sO[tid]); }
        }
    }
}

__device__ __forceinline__ void mix_post_phase(CArgs a, int l, int wg, int G, int tid) {
    asm volatile("" : "+v"(tid));
    const bf16* PROJ = (const bf16*)(a->ws + WS_PROJ); bf16* YMIX = (bf16*)(a->ws + WS_YMIX);
    const int lane = tid & 63, gw = wg * NWAVES + (tid >> 6), NGW = G * NWAVES;
    const float* snw = a->in[I_SNW] + l * 1024; const float* gnw = a->in[I_GNW] + l * 128; const float* hnw = a->in[I_HNW] + l * 128;
    for (int row = gw; row < M; row += NGW) {
        const bf16* pr = PROJ + (size_t)row * NPROJ; bf16* yr = YMIX + (size_t)row * DMIX;
#pragma unroll
        for (int j = 0; j < 2; ++j) {
            const int ch = j * 512 + lane * 8; const v4u yv = *(const GAS v4u*)(yr + ch), zv = *(const GAS v4u*)(pr + O_Z + ch);
            float v[8]; float ss = 0.f;
#pragma unroll
            for (int i = 0; i < 4; ++i) { v[2 * i] = bflo(yv[i]) * siluf(bflo(zv[i])); v[2 * i + 1] = bfhi(yv[i]) * siluf(bfhi(zv[i])); ss += v[2 * i] * v[2 * i] + v[2 * i + 1] * v[2 * i + 1]; }
            const float rstd = rsqrtf(wave_sum(ss) * (1.f / 512.f) + 1e-6f);
            v4u o;
#pragma unroll
            for (int i = 0; i < 4; ++i) o[i] = pk2(v[2 * i] * rstd * snw[ch + 2 * i], v[2 * i + 1] * rstd * snw[ch + 2 * i + 1]);
            *(GAS v4u*)(yr + ch) = o;
        }
#pragma unroll
        for (int part = 0; part < 2; ++part) {
            const int ch = lane * 8, yo = 1024 + part * 512 + ch, go = (part == 0 ? O_GG : O_HG) + ch; const float* nw = part == 0 ? gnw : hnw;
            const v4u yv = *(const GAS v4u*)(yr + yo), gv = *(const GAS v4u*)(pr + go);
            float v[8]; float ss = 0.f;
#pragma unroll
            for (int i = 0; i < 4; ++i) { v[2 * i] = bflo(yv[i]); v[2 * i + 1] = bfhi(yv[i]); ss += v[2 * i] * v[2 * i] + v[2 * i + 1] * v[2 * i + 1]; }
            ss += __shfl_xor(ss, 1); ss += __shfl_xor(ss, 2); ss += __shfl_xor(ss, 4); ss += __shfl_xor(ss, 8);
            const float rstd = rsqrtf(ss * (1.f / 128.f) + 1e-6f);
            v4u o;
#pragma unroll
            for (int i = 0; i < 4; ++i) { const int c = (ch & 127) + 2 * i; o[i] = pk2(v[2 * i] * rstd * nw[c] * siluf(bflo(gv[i])), v[2 * i + 1] * rstd * nw[c + 1] * siluf(bfhi(gv[i]))); }
            *(GAS v4u*)(yr + yo) = o;
        }
    }
}

template <bool ROUTER>
__device__ __forceinline__ void ln_phase(CArgs a, int l, const float* gam, const float* bet, LAS unsigned char* lds, int wg, int G, int tid) {
    asm volatile("" : "+v"(tid));
    const int lane = tid & 63, gw = wg * NWAVES + (tid >> 6), NGW = G * NWAVES;
    const float* ADD = (const float*)(a->ws + WS_MIX); float* H = a->out; bf16* HB = (bf16*)(a->ws + WS_HB); float* COMB = (float*)(a->ws + WS_COMB);
    LAS float* sW = (LAS float*)lds;
    LAS float* sL = sW + 20 * D + (tid >> 6) * 32;
    if (ROUTER) {
        __syncthreads();
        const float* wrg = a->in[I_WRG] + (size_t)l * D * 4; const float* wre = a->in[I_WRE] + (size_t)l * D * 16;
        for (int i = tid; i < D * 20; i += NTHR) { const int c = i >> 10, k = i & 1023; sW[i] = c < 4 ? wrg[k * 4 + c] : wre[k * 16 + c - 4]; }
        __syncthreads();
    }
    f32x4 gv[4], bv[4];
#pragma unroll
    for (int j = 0; j < 4; ++j) { gv[j] = *(const f32x4*)(gam + 4 * lane + 256 * j); bv[j] = *(const f32x4*)(bet + 4 * lane + 256 * j); }
    for (int row = gw; row < M; row += NGW) {
        f32x4 v[4]; float s = 0.f;
#pragma unroll
        for (int j = 0; j < 4; ++j) { const f32x4 hv = *(const GAS f32x4*)(H + (size_t)row * D + 4 * lane + 256 * j), av = *(const GAS f32x4*)(ADD + (size_t)row * D + 4 * lane + 256 * j);
            v[j] = hv * DN_ALPHA + av; s += (v[j].x + v[j].y) + (v[j].z + v[j].w); }
        const float mean = wave_sum(s) * (1.f / D); float s2 = 0.f;
#pragma unroll
        for (int j = 0; j < 4; ++j) { v[j] = v[j] - mean; s2 += (v[j].x * v[j].x + v[j].y * v[j].y) + (v[j].z * v[j].z + v[j].w * v[j].w); }
        const float rstd = rsqrtf(wave_sum(s2) * (1.f / D) + LN_EPS);
#pragma unroll
        for (int j = 0; j < 4; ++j) { v[j] = v[j] * rstd * gv[j] + bv[j];
            *(GAS f32x4*)(H + (size_t)row * D + 4 * lane + 256 * j) = v[j];
            *(GAS unsigned long long*)(HB + (size_t)row * D + 4 * lane + 256 * j) = (unsigned long long)pk2(v[j].x, v[j].y) | ((unsigned long long)pk2(v[j].z, v[j].w) << 32); }
        if (ROUTER) {
            float lg[20];
#pragma unroll 1
            for (int c = 0; c < 20; ++c) { float p = 0.f;
#pragma unroll
                for (int j = 0; j < 4; ++j) { const f32x4 wv = *(const LAS f32x4*)(sW + c * D + 4 * lane + 256 * j); p += (v[j].x * wv.x + v[j].y * wv.y) + (v[j].z * wv.z + v[j].w * wv.w); }
                p = wave_sum(p); if (lane == 0) sL[c] = p; }
#pragma unroll
            for (int c = 0; c < 20; ++c) lg[c] = sL[c];
            float pg[4], mx = -1e30f; int gi = 0;
#pragma unroll
            for (int c = 0; c < 4; ++c) { pg[c] = lg[c] + a->in[I_BRG][l * 4 + c]; if (pg[c] > mx) { mx = pg[c]; gi = c; } }
            float den = 0.f;
#pragma unroll
            for (int c = 0; c < 4; ++c) den += __expf(pg[c] - mx);
            const float g_p = 1.0f / den;
            float le[4], emx = -1e30f; int i1 = 0;
#pragma unroll
            for (int c = 0; c < 4; ++c) { float x = 0.f;
#pragma unroll
                for (int gg = 0; gg < 4; ++gg) x = (gi == gg) ? lg[4 + gg * 4 + c] + a->in[I_BRE][l * 16 + gg * 4 + c] : x;
                le[c] = x; if (x > emx) { emx = x; i1 = c; } }
            float e2mx = -1e30f; int i2 = 0;
#pragma unroll
            for (int c = 0; c < 4; ++c) if (c != i1 && le[c] > e2mx) { e2mx = le[c]; i2 = c; }
            const float x1 = 1.0f, x2 = __expf(e2mx - emx), w1 = g_p * x1 / (x1 + x2), w2 = g_p * x2 / (x1 + x2);
            if (lane < 16) { const int gl = lane >> 2, el = lane & 3; float cwv = 0.f; if (gl == gi) { if (el == i1) cwv = w1; else if (el == i2) cwv = w2; } COMB[(size_t)row * 16 + lane] = cwv; }
        }
    }
}

#ifndef PHASE_MASK
#define PHASE_MASK 0x7ff
#endif
#define PM(k) (((PHASE_MASK) >> (k)) & 1)
enum { P_W = 0, P_IN, P_PREP, P_SSD, P_GDN, P_HG, P_POST, P_OUT, P_LN1, P_GU, P_DN, P_LN2, NPH };
constexpr int N_PHASES = 1 + DEPTH * NPH;
__global__ void __launch_bounds__(NTHR, 2) fwd(Args args) {
    extern __shared__ __attribute__((aligned(16))) unsigned char lds_raw[];
    LAS unsigned char* lds = (LAS unsigned char*)lds_raw;
    volatile LAS unsigned* MISC = (volatile LAS unsigned*)(lds + MISC_OFF);
    const int tid = threadIdx.x, G = gridDim.x, bx = blockIdx.x;
    unsigned char* ws = args.ws;
    gu32* ctl = (gu32*)(ws + WS_CTL);
    for (int u = tid; u < (LDS_BYTES - LDSCTL_OFF) / 4; u += NTHR) ((LAS unsigned*)(lds + LDSCTL_OFF))[u] = 0u;
    __syncthreads();
    const int lo = args.ph_lo, hi = args.ph_hi;
    const bool use_bar = (hi - lo) > 1;
    XcdBarrier bar; bar.bar = (unsigned*)(ctl + CW_BAR); bar.x = 0; bar.st = nullptr;
    if (use_bar) bar = xcd_barrier_post((unsigned*)(ctl + CW_BAR), MISC + 8);
#define IN(k) (lo <= (k) && (k) < hi)
#define SEAM(k) do { if (IN(k) && IN((k) + 1)) xcd_barrier(bar); } while (0)

    if (IN(0)) { p0_prologue(ARGS_HERE(), lds, bx, G, tid); SEAM(0); }

    for (int l = 0; l < DEPTH; ++l) {
        const int base = 1 + l * NPH;
        if (IN(base + P_W)) { weights_phase(ARGS_HERE(), l, lds, bx, G, tid); SEAM(base + P_W); }
        if (IN(base + P_IN)) {
            pg8::Gemm g{(const pg8::bf16_t*)(ws + WS_HB), (const pg8::bf16_t*)(ws + WS_WIN), M, NPROJ, D}; pg8::StaticOrder S; S.init(M, NPROJ, G, bx);
            pg8::EpiBf16<0> E{(pg8::bf16_t*)(ws + WS_PROJ), NPROJ, nullptr, 0, 0, 1.f};
            pg8::gemm_phase<pg8::EpiBf16<0>, pg8::StaticOrder, true, true>(lds + RING_OFF, g, S, E);
            SEAM(base + P_IN);
        }
        if (IN(base + P_PREP)) { hgrn_prep_phase(ARGS_HERE(), l, lds, bx, G, tid); SEAM(base + P_PREP); }
        if (IN(base + P_SSD)) { ssd_rec_phase(ARGS_HERE(), l, lds, bx, G, tid); SEAM(base + P_SSD); }
        if (IN(base + P_GDN)) { gdn_rec_phase(ARGS_HERE(), l, lds, bx, G, tid); SEAM(base + P_GDN); }
        if (IN(base + P_HG)) { hgrn_scan_phase(ARGS_HERE(), l, lds, bx, G, tid); SEAM(base + P_HG); }
        if (IN(base + P_POST)) { mix_post_phase(ARGS_HERE(), l, bx, G, tid); SEAM(base + P_POST); }
        if (IN(base + P_OUT)) {
            pg8::Gemm g{(const pg8::bf16_t*)(ws + WS_YMIX), (const pg8::bf16_t*)(ws + WS_WOUT), M, D, DMIX}; pg8::StaticOrder S; S.init(M, D, G, bx);
            pg8::EpiF32 E{(float*)(ws + WS_MIX), D};
            pg8::gemm_phase<pg8::EpiF32, pg8::StaticOrder, true, true>(lds + RING_OFF, g, S, E);
            SEAM(base + P_OUT);
        }
        if (IN(base + P_LN1)) { CArgs a_ = ARGS_HERE(); ln_phase<true>(a_, l, a_->in[I_LN1G] + l * D, a_->in[I_LN1B] + l * D, lds, bx, G, tid); SEAM(base + P_LN1); }
        if (IN(base + P_GU)) {
            pg8::Gemm g{(const pg8::bf16_t*)(ws + WS_HB), (const pg8::bf16_t*)(ws + WS_WGU), M, NGU, D}; pg8::StaticOrder S; S.init(M, NGU, G, bx);
            pg8::EpiSwiGLU E{(pg8::bf16_t*)(ws + WS_H), KDN, (const float*)(ws + WS_COMB), 16};
            pg8::gemm_phase<pg8::EpiSwiGLU, pg8::StaticOrder, true, true>(lds + RING_OFF, g, S, E);
            SEAM(base + P_GU);
        }
        if (IN(base + P_DN)) {
            pg8::Gemm g{(const pg8::bf16_t*)(ws + WS_H), (const pg8::bf16_t*)(ws + WS_WDN), M, D, KDN}; pg8::StaticOrder S; S.init(M, D, G, bx);
            pg8::EpiF32 E{(float*)(ws + WS_MIX), D};
            pg8::gemm_phase<pg8::EpiF32, pg8::StaticOrder, true, true>(lds + RING_OFF, g, S, E);
            SEAM(base + P_DN);
        }
        if (IN(base + P_LN2)) { CArgs a_ = ARGS_HERE(); ln_phase<false>(a_, l, a_->in[I_LN2G] + l * D, a_->in[I_LN2B] + l * D, lds, bx, G, tid); SEAM(base + P_LN2); }
    }
#undef IN
#undef SEAM
}

#ifndef MK_ONE_LAUNCH
#define MK_ONE_LAUNCH 1
#endif
extern "C" void kernel_launch(void* const* d_in, const int* in_sizes, int n_in, void* d_out, int out_size, void* d_ws, size_t ws_size, hipStream_t stream) {
    static int grid = 0;
    if (grid == 0) {
        if (n_in != 25 || out_size != M * D || ws_size < WS_END) { fprintf(stderr, "kernel_launch: unexpected shapes (n_in %d out %d ws %zu)\n", n_in, out_size, ws_size); grid = -1; return; }
        int dev = 0, cus = 0, per_cu = 0;
        if (hipGetDevice(&dev) != hipSuccess || hipDeviceGetAttribute(&cus, hipDeviceAttributeMultiprocessorCount, dev) != hipSuccess) { grid = -1; return; }
        if (hipFuncSetAttribute((const void*)fwd, hipFuncAttributeMaxDynamicSharedMemorySize, LDS_BYTES) != hipSuccess) { fprintf(stderr, "kernel_launch: hipFuncSetAttribute failed\n"); grid = -1; return; }
        if (hipOccupancyMaxActiveBlocksPerMultiprocessor(&per_cu, (const void*)fwd, NTHR, LDS_BYTES) != hipSuccess || per_cu < 1) { fprintf(stderr, "kernel_launch: occupancy query says %d\n", per_cu); (void)hipGetLastError(); grid = -1; return; }
        grid = cus;
    }
    if (grid < 0) return;
    if (hipMemsetAsync((char*)d_ws + WS_CTL, 0, CTL_ZERO_BYTES, stream) != hipSuccess) return;
    Args a{};
    for (int i = 0; i < 25; ++i) a.in[i] = (const float*)d_in[i];
    a.out = (float*)d_out; a.ws = (unsigned char*)d_ws;
#if MK_ONE_LAUNCH
    a.ph_lo = 0; a.ph_hi = N_PHASES;
    hipLaunchKernelGGL(fwd, dim3(grid), dim3(NTHR), LDS_BYTES, stream, a);
#else
    for (int p = 0; p < N_PHASES; ++p) { a.ph_lo = p; a.ph_hi = p + 1; hipLaunchKernelGGL(fwd, dim3(grid), dim3(NTHR), LDS_BYTES, stream, a); }
#endif
}
```

```cpp
#include <hip/hip_runtime.h>
#include <cstdio>
#include <cstdint>
namespace pg8 {
#define PG8_LAS __attribute__((address_space(3)))
typedef unsigned short bf16_t;
typedef short bf16x8 __attribute__((ext_vector_type(8)));
typedef float f32x4 __attribute__((ext_vector_type(4)));
typedef unsigned u32x4 __attribute__((ext_vector_type(4)));
constexpr int BM = 256, BK = 64, HALF = 128, HTB = HALF * BK * 2  , STAGE_BYTES = 8 * HTB, NXCD = 8, WGM = 8;

__host__ __device__ __forceinline__ int lds_byte(int r, int c) { const int st = (r >> 4) * 2 + (c >> 5), rr = r & 15, cc = c & 31, ob = rr * 64 + cc * 2; return st * 1024 + (ob ^ (((ob >> 9) & 1) << 5)); }
__host__ __device__ __forceinline__ void stage_rc(int b, int& R, int& C) { const int st = b / 1024, sb = b % 1024, swz = sb ^ (((sb >> 9) & 1) << 5); R = (st >> 1) * 16 + swz / 64; C = (st & 1) * 32 + (swz % 64) / 2; }
__host__ __device__ __forceinline__ int perm32(int rho) { const int n = rho >> 4, i = rho & 15; return 8 * (i >> 2) + 4 * n + (i & 3); }

struct Unit { int pm, pn; };
struct Gemm { const bf16_t* A; const bf16_t* Bt; int M, N, K; };

struct StaticOrder {
    int nM, nN, nwg, G, c;
    __host__ __device__ void init(int M, int N, int G_, int c_) { nM = M / BM; nN = N / BM; nwg = nM * nN; G = G_; c = c_; }
    __host__ __device__ bool next(int i, Unit& u) const {
        const long L = (long)i * G + c; if (L >= nwg) return false;
        int wgid = (int)L; { const int q = nwg / NXCD, r = nwg % NXCD, xcd = wgid % NXCD, off = wgid / NXCD; wgid = (xcd < r ? xcd * (q + 1) : r * (q + 1) + (xcd - r) * q) + off; }
        const int nig = WGM * nN, gid = wgid / nig, fm = gid * WGM, gsz = (nM - fm) < WGM ? (nM - fm) : WGM;
        u.pm = fm + ((wgid % nig) % gsz); u.pn = (wgid % nig) / gsz; return true;
    }
    __device__ __forceinline__ void a_ready(const Unit&) const {}
    __device__ __forceinline__ void done(const Unit&) const {}
};
__device__ __forceinline__ unsigned cvt_pk_bf16(float lo, float hi) { unsigned r; asm volatile("v_cvt_pk_bf16_f32 %0, %1, %2" : "=v"(r) : "v"(lo), "v"(hi)); return r; }
typedef float f32x2 __attribute__((ext_vector_type(2)));
__device__ __forceinline__ f32x2 gelu_pk(f32x2 v) {
    const f32x2 av = __builtin_elementwise_abs(v), d = av * 0.2316418882f + 1.0f;
    f32x2 t; t.x = __builtin_amdgcn_rcpf(d.x); t.y = __builtin_amdgcn_rcpf(d.y);
    f32x2 q = t * 0.5307027145f + (-0.7265760135f); q = q * t + 0.7107068705f; q = q * t + (-0.142248368f); q = q * t + 0.127414796f; q = q * t;
    const f32x2 s = (v * v) * (-0.72134752044f);
    f32x2 e; e.x = __builtin_amdgcn_exp2f(s.x); e.y = __builtin_amdgcn_exp2f(s.y);
    const f32x2 m = v * (q * e), r = v - m;
    f32x2 o; o.x = v.x < 0.f ? m.x : r.x; o.y = v.y < 0.f ? m.y : r.y; return o;
}

template <int ACT  > struct EpiBf16 {
    static constexpr bool PERM = true, AFTER_DRAIN = false; static_assert(ACT == 0 || ACT == 1, "EpiBf16: ACT is 0 (none) or 1 (gelu_pk)");
    bf16_t* O; int ldc; const float* bias; int split_cols; size_t split_stride; float scale0;
    __device__ __forceinline__ void operator()(const f32x4 (&acc)[2][2][4][2], const Unit& u, int wr, int wc, int fr, int fq) const {
        const int row0 = u.pm * BM + wr * 64 + fr; int colt = u.pn * BM; bf16_t* base = O;
        float sc = 1.f; if (split_cols) { const int t = colt / split_cols; base += (size_t)t * split_stride; colt -= t * split_cols; if (t == 0) sc = scale0; }
        const int col0 = colt + wc * 32 + 8 * fq, bcol0 = u.pn * BM + wc * 32 + 8 * fq;
        f32x4 bv[2][2];
#pragma unroll
        for (int bj = 0; bj < 2; ++bj)
#pragma unroll
            for (int n = 0; n < 2; ++n) bv[bj][n] = bias ? *(const f32x4*)(bias + bcol0 + bj * HALF + 4 * n) : (f32x4){0.f, 0.f, 0.f, 0.f};
#pragma unroll
        for (int ai = 0; ai < 2; ++ai)
#pragma unroll
            for (int m = 0; m < 4; ++m) { bf16_t* rowp = base + (size_t)(row0 + ai * HALF + m * 16) * ldc + col0;
#pragma unroll
                for (int bj = 0; bj < 2; ++bj) { f32x4 v0 = acc[ai][bj][m][0] + bv[bj][0], v1 = acc[ai][bj][m][1] + bv[bj][1];
                    if (ACT == 1) { f32x2 a = gelu_pk((f32x2){v0[0], v0[1]}), b = gelu_pk((f32x2){v0[2], v0[3]}), c = gelu_pk((f32x2){v1[0], v1[1]}), d = gelu_pk((f32x2){v1[2], v1[3]});
                        v0 = (f32x4){a.x, a.y, b.x, b.y}; v1 = (f32x4){c.x, c.y, d.x, d.y}; }
                    v0 = v0 * sc; v1 = v1 * sc; u32x4 w; w.x = cvt_pk_bf16(v0[0], v0[1]); w.y = cvt_pk_bf16(v0[2], v0[3]); w.z = cvt_pk_bf16(v1[0], v1[1]); w.w = cvt_pk_bf16(v1[2], v1[3]);
                    *(u32x4*)(rowp + bj * HALF) = w; } }
    }
};
struct EpiF32 {
    static constexpr bool PERM = false, AFTER_DRAIN = false;
    float* C; int ldc;
    __device__ __forceinline__ void operator()(const f32x4 (&acc)[2][2][4][2], const Unit& u, int wr, int wc, int fr, int fq) const {
        const int row0 = u.pm * BM + wr * 64 + fr, col0 = u.pn * BM + wc * 32 + 4 * fq;
#pragma unroll
        for (int ai = 0; ai < 2; ++ai)
#pragma unroll
            for (int m = 0; m < 4; ++m) { float* rowp = C + (size_t)(row0 + ai * HALF + m * 16) * ldc + col0;
#pragma unroll
                for (int bj = 0; bj < 2; ++bj)
#pragma unroll
                    for (int n = 0; n < 2; ++n) *(f32x4*)(rowp + bj * HALF + n * 16) = acc[ai][bj][m][n]; }
    }
};
__device__ __forceinline__ float silu_f(float x) { return x / (1.0f + __expf(-x)); }
struct EpiSwiGLU {
    static constexpr bool PERM = true, AFTER_DRAIN = false;
    bf16_t* H; int ldh; const float* comb; int ldcomb;
    __device__ __forceinline__ void operator()(const f32x4 (&acc)[2][2][4][2], const Unit& u, int wr, int wc, int fr, int fq) const {
        const int row0 = u.pm * BM + wr * 64 + fr, col0 = u.pn * 128 + wc * 32 + 8 * fq, e = u.pn >> 1;
#pragma unroll
        for (int ai = 0; ai < 2; ++ai)
#pragma unroll
            for (int m = 0; m < 4; ++m) { const int row = row0 + ai * HALF + m * 16; const float cw = comb[(size_t)row * ldcomb + e];
                const f32x4 g0 = acc[ai][0][m][0], g1 = acc[ai][0][m][1], u0 = acc[ai][1][m][0], u1 = acc[ai][1][m][1];
                f32x4 h0, h1;
#pragma unroll
                for (int j = 0; j < 4; ++j) { h0[j] = silu_f(g0[j]) * u0[j] * cw; h1[j] = silu_f(g1[j]) * u1[j] * cw; }
                u32x4 w; w.x = cvt_pk_bf16(h0[0], h0[1]); w.y = cvt_pk_bf16(h0[2], h0[3]); w.z = cvt_pk_bf16(h1[0], h1[1]); w.w = cvt_pk_bf16(h1[2], h1[3]);
                *(u32x4*)(H + (size_t)row * ldh + col0) = w; }
    }
};
template <class Epi, class Sched, bool ALIGN_EPI = false, bool SP2 = false>
__device__ __forceinline__ void gemm_phase(PG8_LAS unsigned char* lds, const Gemm g, const Sched& S, const Epi& E) {
    int tid_ = threadIdx.x; asm volatile("" : "+v"(tid_));
    const int tid = tid_, wid = __builtin_amdgcn_readfirstlane(tid >> 6), lane = tid & 63, wr = wid >> 2, wc = wid & 3, fr = lane & 15, fq = lane >> 4;
    const int K = g.K, nt = K / BK;
    unsigned voffA[2], voffB[2];
#pragma unroll
    for (int i = 0; i < 2; ++i) { int R, C; stage_rc(tid * 16 + i * 8192, R, C); const int Rb = Epi::PERM ? ((R & ~31) + perm32(R & 31)) : R;
        voffA[i] = (unsigned)(R * K + C) * 2u; voffB[i] = (unsigned)(Rb * K + C) * 2u; }
    const size_t kstep = (size_t)(BK * 2);
    const size_t hstep = (size_t)HALF * K * 2;
    const size_t tstep = 2 * hstep;
    const unsigned ldsw = (unsigned)wid * 1024u;
    const int aoff = lds_byte(wr * 64 + fr, fq * 8), boff = lds_byte(wc * 32 + fr, fq * 8);
#define PG8_SA(b, h) (((b) * 2 + (h)) * HTB)
#define PG8_SB(b, h) ((4 + (b) * 2 + (h)) * HTB)
#define PG8_STAGE(bufoff, gbase, voff) do { _Pragma("unroll") for (int _i = 0; _i < 2; ++_i) \
        __builtin_amdgcn_global_load_lds((const unsigned*)((const char*)(gbase) + (voff)[_i]), (PG8_LAS unsigned*)(lds + (bufoff) + ldsw + _i * 8192), 16, 0, 0); } while (0)
#define PG8_LDA(dst, b, h) do { _Pragma("unroll") for (int m = 0; m < 4; ++m) _Pragma("unroll") for (int k = 0; k < 2; ++k) dst[m][k] = *(const PG8_LAS bf16x8*)(lds + PG8_SA(b, h) + aoff + m * 2048 + k * 1024); } while (0)
#define PG8_LDB(dst, b, h) do { _Pragma("unroll") for (int n = 0; n < 2; ++n) _Pragma("unroll") for (int k = 0; k < 2; ++k) dst[n][k] = *(const PG8_LAS bf16x8*)(lds + PG8_SB(b, h) + boff + n * 2048 + k * 1024); } while (0)
#define PG8_MMA(ai, bj, At, Bt) do { __builtin_amdgcn_s_setprio(1); _Pragma("unroll") for (int m = 0; m < 4; ++m) _Pragma("unroll") for (int n = 0; n < 2; ++n) _Pragma("unroll") for (int k = 0; k < 2; ++k) \
        acc[ai][bj][m][n] = __builtin_amdgcn_mfma_f32_16x16x32_bf16(Bt[n][k], At[m][k], acc[ai][bj][m][n], 0, 0, 0); __builtin_amdgcn_s_setprio(0); } while (0)
#define PG8_WAIT_V(n) asm volatile("s_waitcnt vmcnt(" #n ")" ::: "memory")
#define PG8_WAIT_L(n) asm volatile("s_waitcnt lgkmcnt(" #n ")" ::: "memory")
#define PG8_BAR __builtin_amdgcn_s_barrier()
#define PG8_SCHED __builtin_amdgcn_sched_barrier(0)
    Unit cur, nxt; int ui = 0;
    if (!S.next(0, cur)) return;
    f32x4 acc[2][2][4][2];
#pragma unroll
    for (int a = 0; a < 2; ++a)
#pragma unroll
        for (int b = 0; b < 2; ++b)
#pragma unroll
            for (int m = 0; m < 4; ++m)
#pragma unroll
                for (int n = 0; n < 2; ++n) acc[a][b][m][n] = (f32x4){0.f, 0.f, 0.f, 0.f};
    bf16x8 At[4][2], B0[2][2], B1[2][2];
    const char* cA = (const char*)g.A + (size_t)cur.pm * tstep; const char* cB = (const char*)g.Bt + (size_t)cur.pn * tstep;
    S.a_ready(cur);
    if constexpr (SP2) {
        PG8_STAGE(PG8_SB(0, 0), cB, voffB); PG8_STAGE(PG8_SB(0, 1), cB + hstep, voffB); PG8_STAGE(PG8_SA(0, 0), cA, voffA); PG8_STAGE(PG8_SA(0, 1), cA + hstep, voffA);
        if (wr == 1) PG8_BAR;
        PG8_WAIT_V(2); PG8_BAR;
        PG8_STAGE(PG8_SB(1, 0), cB + kstep, voffB); PG8_STAGE(PG8_SA(1, 0), cA + kstep, voffA); PG8_STAGE(PG8_SB(1, 1), cB + hstep + kstep, voffB);
        PG8_WAIT_V(6); PG8_BAR;
    } else {
        PG8_STAGE(PG8_SB(0, 0), cB, voffB); PG8_STAGE(PG8_SA(0, 0), cA, voffA); PG8_STAGE(PG8_SB(0, 1), cB + hstep, voffB); PG8_STAGE(PG8_SA(0, 1), cA + hstep, voffA);
        if (wr == 1) PG8_BAR;
        PG8_WAIT_V(4); PG8_BAR;
        PG8_STAGE(PG8_SB(1, 0), cB + kstep, voffB); PG8_STAGE(PG8_SA(1, 0), cA + kstep, voffA); PG8_STAGE(PG8_SB(1, 1), cB + hstep + kstep, voffB);
        PG8_WAIT_V(6); PG8_BAR;
    }
    for (;;) {
        const bool has_next = S.next(ui + 1, nxt);
        const char* nA = has_next ? (const char*)g.A + (size_t)nxt.pm * tstep : cA; const char* nB = has_next ? (const char*)g.Bt + (size_t)nxt.pn * tstep : cB;
        for (int t = 0; t < nt; t += 2) {
            const bool last = (t == nt - 2);
            const char* a1 = cA + (size_t)(t + 1) * kstep;
            const char* a2 = last ? nA : cA + (size_t)(t + 2) * kstep; const char* b2 = last ? nB : cB + (size_t)(t + 2) * kstep;
            const char* a3 = a2 + kstep; const char* b3 = b2 + kstep;
            if (last && has_next) S.a_ready(nxt);
            if constexpr (SP2) {
            PG8_LDB(B0, 0, 0); PG8_LDB(B1, 0, 1); PG8_SCHED; PG8_LDA(At, 0, 0); PG8_STAGE(PG8_SA(1, 1), a1 + hstep, voffA);
            PG8_WAIT_V(8); PG8_WAIT_L(0); PG8_BAR; PG8_MMA(0, 0, At, B0); PG8_MMA(0, 1, At, B1); PG8_BAR; PG8_SCHED;
            PG8_LDA(At, 0, 1); PG8_STAGE(PG8_SB(0, 0), b2, voffB); PG8_STAGE(PG8_SB(0, 1), b2 + hstep, voffB); PG8_STAGE(PG8_SA(0, 0), a2, voffA);
            PG8_WAIT_V(8); PG8_WAIT_L(0); PG8_BAR; PG8_MMA(1, 0, At, B0); PG8_MMA(1, 1, At, B1); PG8_BAR; PG8_SCHED;
            PG8_LDB(B0, 1, 0); PG8_LDB(B1, 1, 1); PG8_SCHED; PG8_LDA(At, 1, 0); PG8_STAGE(PG8_SA(0, 1), a2 + hstep, voffA);
            PG8_WAIT_V(8); PG8_WAIT_L(0); PG8_BAR; PG8_MMA(0, 0, At, B0); PG8_MMA(0, 1, At, B1); PG8_BAR; PG8_SCHED;
            PG8_LDA(At, 1, 1); PG8_STAGE(PG8_SB(1, 0), b3, voffB); PG8_STAGE(PG8_SB(1, 1), b3 + hstep, voffB); PG8_STAGE(PG8_SA(1, 0), a3, voffA);
            PG8_WAIT_V(8); PG8_WAIT_L(0); PG8_BAR; PG8_MMA(1, 0, At, B0); PG8_MMA(1, 1, At, B1); PG8_BAR; PG8_SCHED;
            } else {
            PG8_LDB(B0, 0, 0); PG8_SCHED; PG8_LDA(At, 0, 0); PG8_STAGE(PG8_SA(1, 1), a1 + hstep, voffA);
            PG8_WAIT_L(8); PG8_BAR; PG8_WAIT_L(0); PG8_MMA(0, 0, At, B0); PG8_BAR; PG8_SCHED;
            PG8_LDB(B1, 0, 1); PG8_STAGE(PG8_SB(0, 0), b2, voffB);
            PG8_BAR; PG8_WAIT_L(0); PG8_MMA(0, 1, At, B1); PG8_BAR;
            PG8_LDA(At, 0, 1); PG8_STAGE(PG8_SA(0, 0), a2, voffA);
            PG8_BAR; PG8_WAIT_L(0); PG8_MMA(1, 0, At, B0); PG8_BAR; PG8_SCHED;
            PG8_STAGE(PG8_SB(0, 1), b2 + hstep, voffB);
            PG8_WAIT_V(6); PG8_BAR; PG8_MMA(1, 1, At, B1); PG8_BAR;
            PG8_LDB(B0, 1, 0); PG8_SCHED; PG8_LDA(At, 1, 0); PG8_STAGE(PG8_SA(0, 1), a2 + hstep, voffA);
            PG8_WAIT_L(8); PG8_BAR; PG8_WAIT_L(0); PG8_MMA(0, 0, At, B0); PG8_BAR; PG8_SCHED;
            PG8_LDB(B1, 1, 1); PG8_STAGE(PG8_SB(1, 0), b3, voffB);
            PG8_BAR; PG8_WAIT_L(0); PG8_MMA(0, 1, At, B1); PG8_BAR;
            PG8_LDA(At, 1, 1); PG8_STAGE(PG8_SA(1, 0), a3, voffA);
            PG8_BAR; PG8_WAIT_L(0); PG8_MMA(1, 0, At, B0); PG8_BAR; PG8_SCHED;
            PG8_STAGE(PG8_SB(1, 1), b3 + hstep, voffB);
            PG8_WAIT_V(6); PG8_BAR; PG8_MMA(1, 1, At, B1); PG8_BAR;
            }
        }
        if constexpr (ALIGN_EPI) { if (wr == 0) PG8_BAR; }
        if constexpr (!Epi::AFTER_DRAIN) { E(acc, cur, wr, wc, fr, fq); S.done(cur); }
        if (!has_next) break;
#pragma unroll
        for (int a = 0; a < 2; ++a)
#pragma unroll
            for (int b = 0; b < 2; ++b)
#pragma unroll
                for (int m = 0; m < 4; ++m)
#pragma unroll
                    for (int n = 0; n < 2; ++n) acc[a][b][m][n] = (f32x4){0.f, 0.f, 0.f, 0.f};
        cur = nxt; cA = nA; cB = nB; ++ui;
        if constexpr (ALIGN_EPI) { if (wr == 1) PG8_BAR; }
    }
    PG8_WAIT_V(0);
    if constexpr (!ALIGN_EPI) { if (wr == 0) PG8_BAR; }
    PG8_BAR;
    if constexpr (Epi::AFTER_DRAIN) { E.fused(acc, cur, wr, wc, fr, fq, lds, wid, lane); S.done(cur); }
#undef PG8_SA
#undef PG8_SB
#undef PG8_STAGE
#undef PG8_LDA
#undef PG8_LDB
#undef PG8_MMA
#undef PG8_WAIT_V
#undef PG8_WAIT_L
#undef PG8_BAR
#undef PG8_SCHED
}
}
#define GAS __attribute__((address_space(1)))
#define LAS __attribute__((address_space(3)))
typedef unsigned short bf16;
typedef unsigned v4u __attribute__((ext_vector_type(4)));
typedef float f32x4 __attribute__((ext_vector_type(4)));
typedef short bf16x8 __attribute__((ext_vector_type(8)));
typedef GAS unsigned gu32;
typedef GAS unsigned long long gu64;
#define RLX_AGENT __ATOMIC_RELAXED, __HIP_MEMORY_SCOPE_AGENT
#define LDS_WAIT() asm volatile("s_waitcnt lgkmcnt(0)" ::: "memory")
#define VM_WAIT() asm volatile("s_waitcnt vmcnt(0)" ::: "memory")
__device__ __forceinline__ unsigned long long rt() { return __builtin_amdgcn_s_memrealtime(); }
__device__ __forceinline__ unsigned f2bf(float f) { unsigned u = __builtin_bit_cast(unsigned, f); return (u + 0x7fffu + ((u >> 16) & 1u)) >> 16; }
__device__ __forceinline__ unsigned pk2(float lo, float hi) { return f2bf(lo) | (f2bf(hi) << 16); }

#define XB_TMO      128
#define XB_XCNT(j)  (256  + 64 * (j))
#define XB_XSUB(j)  (1280 + 64 * (j))
#define XB_XGEN(j)  (2304 + 64 * (j))
#define XB_TOP      3328
#define XB_TOPGEN   3392
#define XCD_BAR_WORDS 3456
#define XB_SPIN_CAP (1u << 18)

__device__ __forceinline__ unsigned xb_ld(unsigned* p)              { return __hip_atomic_load(p, __ATOMIC_RELAXED, __HIP_MEMORY_SCOPE_AGENT); }
__device__ __forceinline__ unsigned xb_add(unsigned* p, unsigned v) { return __hip_atomic_fetch_add(p, v, __ATOMIC_RELAXED, __HIP_MEMORY_SCOPE_AGENT); }
__device__ __forceinline__ unsigned xb_xcc_id() { return (unsigned)__builtin_amdgcn_s_getreg((3 << 11) | 20) & 0xFu; }
#define XB_SPIN(cond, bar) do { unsigned _sp = 0; while (cond) { __builtin_amdgcn_s_sleep(1); \
    if ((++_sp & 255u) == 0u) { if (xb_ld(&(bar)[XB_TMO])) break; if (_sp > XB_SPIN_CAP) { atomicAdd(&(bar)[XB_TMO], 1u); break; } } } } while (0)

struct XcdBarrier {
    unsigned* bar; unsigned x;
    volatile LAS unsigned* st;
};

__device__ __forceinline__ XcdBarrier xcd_barrier_post(unsigned* bar, volatile LAS unsigned* st) {
    XcdBarrier b; b.bar = bar; b.x = xb_xcc_id(); b.st = st;
    if (threadIdx.x == 0) (void)xb_add(&bar[XB_XCNT(b.x)], 1u);
    return b;
}
__device__ __forceinline__ void xcd_barrier_complete(unsigned* bar, unsigned x, unsigned& nloc, unsigned& nx) {
    const unsigned G = gridDim.x * gridDim.y * gridDim.z;
    unsigned sum, cnt, mine, sp = 0u;
    for (;;) {
        sum = 0u; cnt = 0u; mine = 0u;
#pragma unroll
        for (unsigned j = 0; j < 16; ++j) { const unsigned c = xb_ld(&bar[XB_XCNT(j)]); sum += c; cnt += (c > 0u) ? 1u : 0u; mine = (j == x) ? c : mine; }
        if (sum == G) break;
        __builtin_amdgcn_s_sleep(1);
        if ((++sp & 255u) == 0u) { if (xb_ld(&bar[XB_TMO])) break; if (sp > XB_SPIN_CAP) { atomicAdd(&bar[XB_TMO], 1u); break; } }
    }
    nloc = mine > 0u ? mine : 1u; nx = cnt > 0u ? cnt : 1u;
}

__device__ __forceinline__ void xcd_barrier(const XcdBarrier& b) {
    asm volatile("s_waitcnt vmcnt(0)" ::: "memory");
    __syncthreads();
    if (threadIdx.x == 0) {
        unsigned* bar = b.bar;
        __builtin_amdgcn_s_waitcnt(0);
        unsigned nloc = b.st[0], nx = b.st[1];
        if (nloc == 0u) { xcd_barrier_complete(bar, b.x, nloc, nx); b.st[0] = nloc; b.st[1] = nx; }
        const unsigned old = xb_add(&bar[XB_XSUB(b.x)], 1u);
        const unsigned gen = old / nloc;
        if (old + 1u == (gen + 1u) * nloc) {
            __builtin_amdgcn_fence(__ATOMIC_RELEASE, "agent");
            asm volatile("s_waitcnt vmcnt(0)" ::: "memory");
            const unsigned og = xb_add(&bar[XB_TOP], 1u);
            const unsigned tg = og / nx;
            if (og + 1u == (tg + 1u) * nx) xb_add(&bar[XB_TOPGEN], 1u);
            else XB_SPIN(xb_ld(&bar[XB_TOPGEN]) == tg, bar);
            __builtin_amdgcn_fence(__ATOMIC_ACQUIRE, "agent");
            xb_add(&bar[XB_XGEN(b.x)], 1u);
            asm volatile("s_waitcnt vmcnt(0)" ::: "memory");
        } else {
            XB_SPIN(xb_ld(&bar[XB_XGEN(b.x)]) == gen, bar);
            __builtin_amdgcn_fence(__ATOMIC_ACQUIRE, "agent");
            asm volatile("s_waitcnt vmcnt(0)" ::: "memory");
        }
    }
    __syncthreads();
}
constexpr int NWAVES = 8, NTHR = NWAVES * 64;
constexpr int D = 1024, BATCH = 4, SEQ = 4096, M = BATCH * SEQ, DEPTH = 4;
constexpr int IN_COLS = 6680, NPROJ = 6912;
constexpr int O_Z = 0, O_XBC = 1024, O_DT = 2560, O_QKV = 2576, O_GG = 4112, O_GB = 4624, O_GA = 4628, O_HQ = 4632, O_HF = 5144, O_HI = 5656, O_HG = 6168;
constexpr int DMIX = 2048, NEXP = 16, DEXP = 256, NGU = NEXP * 2 * DEXP  , KDN = NEXP * DEXP  ;
constexpr float DN_ALPHA = 1.6817928305074290f;
constexpr float LN_EPS = 1e-5f;

constexpr size_t MiB = 1u << 20;
constexpr size_t WS_CTL = 0, CTL_ZERO_BYTES = 1 * MiB;
constexpr size_t WS_COMB = 1 * MiB;
constexpr size_t WS_WIN = 8 * MiB;
constexpr size_t WS_WOUT = 22 * MiB;
constexpr size_t WS_WGU = 26 * MiB;
constexpr size_t WS_WDN = 42 * MiB;
constexpr size_t WS_YMIX = 52 * MiB;
constexpr size_t WS_HB = WS_YMIX;
constexpr size_t WS_PROJ = 116 * MiB;
constexpr size_t WS_MIX = WS_PROJ;
constexpr size_t WS_H = WS_PROJ + 64 * MiB;
constexpr size_t WS_SCR = 332 * MiB;
constexpr size_t WS_HG_QG = WS_SCR;
constexpr size_t WS_HG_KDT = WS_SCR + 16 * MiB;
constexpr size_t WS_HG_A = WS_SCR + 32 * MiB;
constexpr size_t WS_HG_GL = WS_SCR + 40 * MiB;
constexpr size_t WS_SSD_C = WS_SCR + 44 * MiB;
constexpr size_t WS_SSD_BT = WS_SCR + 52 * MiB;
constexpr size_t WS_SSD_CB = WS_SCR + 60 * MiB;
constexpr size_t WS_SSD_XT = WS_SCR + 68 * MiB;
constexpr size_t WS_SSD_AC = WS_SCR + 100 * MiB;
constexpr size_t WS_SSD_DT = WS_SCR + 101 * MiB;
constexpr size_t WS_END = 512 * MiB;
constexpr int CW_BAR = 4096;

constexpr int RING_OFF = 0, RING_BYTES = 131072;
constexpr int LDSCTL_OFF = RING_BYTES, MISC_OFF = LDSCTL_OFF + 320;
constexpr int LDS_BYTES = 147456;

__device__ __forceinline__ float bf2f(unsigned short b) { return __builtin_bit_cast(float, ((unsigned)b) << 16); }
__device__ __forceinline__ float bflo(unsigned w) { return __builtin_bit_cast(float, w << 16); }
__device__ __forceinline__ float bfhi(unsigned w) { return __builtin_bit_cast(float, w & 0xffff0000u); }
__device__ __forceinline__ float siluf(float x) { return x / (1.0f + __expf(-x)); }
__device__ __forceinline__ float sigmoidf_(float x) { return 1.0f / (1.0f + __expf(-x)); }
__device__ __forceinline__ float softplusf_(float x) { return x > 20.f ? x : log1pf(__expf(x)); }
__device__ __forceinline__ float wave_sum(float v) {
#pragma unroll
    for (int o = 1; o < 64; o <<= 1) v += __shfl_xor(v, o);
    return v;
}

struct Args {
    const float* in[25]; float* out; unsigned char* ws; int ph_lo, ph_hi;
};
typedef const __attribute__((address_space(4))) Args* CArgs;
#define ARGS_HERE() ([]() { CArgs p_ = (CArgs)__builtin_amdgcn_kernarg_segment_ptr(); asm volatile("" : "+s"(p_)); return p_; }())
enum { I_X = 0, I_WIN, I_SCW, I_SCB, I_SDTB, I_SALOG, I_SD, I_SNW, I_GCW, I_GDTB, I_GALOG, I_GNW, I_HLB, I_HNW, I_WOUT, I_LN1G, I_LN1B, I_WRG, I_BRG, I_WRE, I_BRE, I_WGU, I_WDN, I_LN2G, I_LN2B };

__device__ __forceinline__ void transpose_item(const float* W, int ldw, int nvalid, int k0, int n0, bf16* WT, size_t ldt, int drow0, int dk0, LAS float* scr, int lane) {
#pragma unroll 8
    for (int i = 0; i < 32; ++i) { const int kk = 2 * i + (lane >> 5), nn = lane & 31, n = n0 + nn; scr[kk * 33 + nn] = (n < nvalid) ? W[(size_t)(k0 + kk) * ldw + n] : 0.f; }
    LDS_WAIT(); asm volatile("" ::: "memory");
    const int c = lane & 7;
#pragma unroll
    for (int j = 0; j < 4; ++j) { const int n = (lane >> 3) + 8 * j; const LAS float* s = scr + (8 * c) * 33 + n;
        v4u o; o.x = pk2(s[0 * 33], s[1 * 33]); o.y = pk2(s[2 * 33], s[3 * 33]); o.z = pk2(s[4 * 33], s[5 * 33]); o.w = pk2(s[6 * 33], s[7 * 33]);
        *(GAS v4u*)(WT + (size_t)(drow0 + n) * ldt + dk0 + k0 + 8 * c) = o; }
    LDS_WAIT(); asm volatile("" ::: "memory");
}
__device__ __forceinline__ void weights_phase(CArgs a, int l, LAS unsigned char* lds, int wg, int G, int tid) {
    asm volatile("" : "+v"(tid));
    const int lane = tid & 63, wave = tid >> 6;
    LAS float* scr = (LAS float*)(lds + wave * 16384);
    const int gw = wg * NWAVES + wave, NGW = G * NWAVES;
    constexpr int I_IN = 16 * (NPROJ / 32), I_OUT = (DMIX / 64) * (D / 32), I_GU = NEXP * 16 * 16, I_DN = NEXP * 4 * 32, I_LAYER = I_IN + I_OUT + I_GU + I_DN;
    unsigned char* ws = a->ws;
    for (int it = gw; it < I_LAYER; it += NGW) {
        int r = it;
        if (r < I_IN) { const int kb = r / (NPROJ / 32), nb = r % (NPROJ / 32);
            transpose_item(a->in[I_WIN] + (size_t)l * D * IN_COLS, IN_COLS, IN_COLS, 64 * kb, 32 * nb, (bf16*)(ws + WS_WIN), D, 32 * nb, 0, scr, lane); continue; }
        r -= I_IN;
        if (r < I_OUT) { const int kb = r / (D / 32), nb = r % (D / 32);
            transpose_item(a->in[I_WOUT] + (size_t)l * DMIX * D, D, D, 64 * kb, 32 * nb, (bf16*)(ws + WS_WOUT), DMIX, 32 * nb, 0, scr, lane); continue; }
        r -= I_OUT;
        if (r < I_GU) { const int e = r / 256, q = r % 256, kb = q / 16, nb = q % 16, c0 = 32 * nb, bj = c0 / 256, hf = (c0 % 256) / 128, j0 = c0 % 128;
            transpose_item(a->in[I_WGU] + (size_t)(l * NEXP + e) * D * 512, 512, 512, 64 * kb, c0, (bf16*)(ws + WS_WGU), D, e * 512 + hf * 256 + bj * 128 + j0, 0, scr, lane); continue; }
        r -= I_GU;
        { const int e = r / 128, q = r % 128, kb = q / 32, nb = q % 32;
            transpose_item(a->in[I_WDN] + (size_t)(l * NEXP + e) * DEXP * D, D, D, 64 * kb, 32 * nb, (bf16*)(ws + WS_WDN), KDN, 32 * nb, e * DEXP, scr, lane); }
    }
}
__device__ __forceinline__ void p0_prologue(CArgs a, LAS unsigned char* lds, int wg, int G, int tid) {
    asm volatile("" : "+v"(tid));
    const f32x4* x4 = (const f32x4*)a->in[I_X]; f32x4* h4 = (f32x4*)a->out; unsigned long long* hb8 = (unsigned long long*)(a->ws + WS_HB);
    for (size_t i = (size_t)wg * NTHR + tid; i < (size_t)M * D / 4; i += (size_t)G * NTHR) { const f32x4 v = x4[i]; h4[i] = v;
        hb8[i] = (unsigned long long)pk2(v.x, v.y) | ((unsigned long long)pk2(v.z, v.w) << 32); }
}

__device__ __forceinline__ f32x4 mfma16(bf16x8 x, bf16x8 y, f32x4 c) { return __builtin_amdgcn_mfma_f32_16x16x32_bf16(x, y, c, 0, 0, 0); }
__device__ __forceinline__ bf16x8 lds_frag(const LAS bf16* base, int row0, int stride, int k0, int lane) { return *(const LAS bf16x8*)(base + (row0 + (lane & 15)) * stride + k0 + 8 * (lane >> 4)); }
__device__ __forceinline__ bf16x8 pack8(const float* v) { v4u w; w.x = pk2(v[0], v[1]); w.y = pk2(v[2], v[3]); w.z = pk2(v[4], v[5]); w.w = pk2(v[6], v[7]); return __builtin_bit_cast(bf16x8, w); }
__device__ __forceinline__ unsigned long long pack4(f32x4 v) { return (unsigned long long)pk2(v[0], v[1]) | ((unsigned long long)pk2(v[2], v[3]) << 32); }

__device__ __forceinline__ void hgrn_prep_phase(CArgs a, int l, LAS unsigned char* lds, int wg, int G, int tid) {
    asm volatile("" : "+v"(tid));
    constexpr int LS = 132;
    LAS float* sQ = (LAS float*)lds; LAS float* sK = sQ + 64 * LS; LAS float* sB = sK + 64 * LS; LAS float* sT = sB + 64 * LS; LAS float* sLb = sT + 512;
    const bf16* PROJ = (const bf16*)(a->ws + WS_PROJ);
    const int lane = tid & 63, w = tid >> 6, r = lane & 15, q4 = lane >> 4;
    for (int unit = wg; unit < 1024; unit += G) {
        const int b = unit >> 8, head = (unit >> 6) & 3, c = unit & 63;
        const size_t row0 = (size_t)b * SEQ + c * 64;
        __syncthreads();
        if (tid < 128) {
            const int ch = head * 128 + tid; float lg[DEPTH], mx = -1e30f;
#pragma unroll
            for (int j = 0; j < DEPTH; ++j) { lg[j] = a->in[I_HLB][j * 512 + ch]; mx = fmaxf(mx, lg[j]); }
            float den = 0.f, num = 0.f;
#pragma unroll
            for (int j = 0; j < DEPTH; ++j) { const float e = __expf(lg[j] - mx); den += e; if (j >= 1 && j <= l) num += e; }
            sLb[tid] = num / den;
        }
        __syncthreads();
        for (int p = tid; p < 1024; p += NTHR) {
            const int t = p >> 4, d8 = (p & 15) * 8;
            const v4u qv = *(const GAS v4u*)(PROJ + (row0 + t) * NPROJ + O_HQ + head * 128 + d8), fv = *(const GAS v4u*)(PROJ + (row0 + t) * NPROJ + O_HF + head * 128 + d8);
#pragma unroll
            for (int i = 0; i < 4; ++i) {
                const int d = d8 + 2 * i; const float lb0 = sLb[d], lb1 = sLb[d + 1];
                sQ[t * LS + d] = siluf(bflo(qv[i])); sQ[t * LS + d + 1] = siluf(bfhi(qv[i]));
                const float f0 = lb0 + (1.f - lb0) * sigmoidf_(bflo(fv[i])), f1 = lb1 + (1.f - lb1) * sigmoidf_(bfhi(fv[i]));
                sK[t * LS + d] = 1.f - f0; sK[t * LS + d + 1] = 1.f - f1; sB[t * LS + d] = __logf(f0); sB[t * LS + d + 1] = __logf(f1);
            }
        }
        __syncthreads();
        {
            const int d = tid & 127, seg = tid >> 7; float run = 0.f, vals[16];
#pragma unroll
            for (int i = 0; i < 16; ++i) { run += sB[(seg * 16 + i) * LS + d]; vals[i] = run; }
            sT[seg * 128 + d] = run;
            __syncthreads();
            float off = 0.f;
#pragma unroll
            for (int s2 = 0; s2 < 3; ++s2) if (s2 < seg) off += sT[s2 * 128 + d];
#pragma unroll
            for (int i = 0; i < 16; ++i) sB[(seg * 16 + i) * LS + d] = vals[i] + off;
        }
        __syncthreads();
        bf16* qg = (bf16*)(a->ws + WS_HG_QG) + (size_t)unit * 64 * 128; bf16* kdt = (bf16*)(a->ws + WS_HG_KDT) + (size_t)unit * 128 * 64;
        bf16* am = (bf16*)(a->ws + WS_HG_A) + (size_t)unit * 64 * 64; float* gl = (float*)(a->ws + WS_HG_GL) + (size_t)unit * 128;
        for (int p = tid; p < 1024; p += NTHR) { const int t = p >> 4, d8 = (p & 15) * 8; float v[8];
#pragma unroll
            for (int jj = 0; jj < 8; ++jj) v[jj] = sQ[t * LS + d8 + jj] * __expf(sB[t * LS + d8 + jj]);
            *(GAS bf16x8*)(qg + t * 128 + d8) = pack8(v); }
        for (int p = tid; p < 1024; p += NTHR) { const int d = p >> 3, s8 = (p & 7) * 8; const float bl = sB[63 * LS + d]; float v[8];
#pragma unroll
            for (int jj = 0; jj < 8; ++jj) v[jj] = sK[(s8 + jj) * LS + d] * __expf(bl - sB[(s8 + jj) * LS + d]);
            *(GAS bf16x8*)(kdt + d * 64 + s8) = pack8(v); }
        if (tid < 128) gl[tid] = __expf(sB[63 * LS + tid]);
        for (int p = w; p < 16; p += NWAVES) {
            const int i = p >> 2, j = p & 3; f32x4 acc = {0.f, 0.f, 0.f, 0.f};
            if (j <= i) {
#pragma unroll
                for (int ks = 0; ks < 4; ++ks) { const int d0 = 32 * ks + 8 * q4, t = 16 * i + r, s_ = 16 * j + r; float qf[8], kf[8];
#pragma unroll
                    for (int jj = 0; jj < 8; ++jj) { const float ref = i ? sB[(16 * i - 1) * LS + d0 + jj] : 0.f;
                        qf[jj] = sQ[t * LS + d0 + jj] * __expf(sB[t * LS + d0 + jj] - ref); kf[jj] = sK[s_ * LS + d0 + jj] * __expf(ref - sB[s_ * LS + d0 + jj]); }
                    acc = mfma16(pack8(kf), pack8(qf), acc); }
                const int t = 16 * i + r;
#pragma unroll
                for (int ii = 0; ii < 4; ++ii) if (16 * j + 4 * q4 + ii > t) acc[ii] = 0.f;
            }
            *(GAS unsigned long long*)(am + (16 * i + r) * 64 + 16 * j + 4 * q4) = pack4(acc);
        }
    }
}
__device__ __forceinline__ void hgrn_scan_phase(CArgs a, int l, LAS unsigned char* lds, int wg, int G, int tid) {
    asm volatile("" : "+v"(tid));
    constexpr int QS = 136, KS = 72;
    constexpr int B_QG = 0, B_KDT = 17408, B_A = B_KDT + 18432, B_VT = B_A + 9216, B_GL = B_VT + 4608, BUF = B_GL + 512;
    LAS unsigned char* sST0 = lds + 2 * BUF;
    const bf16* PROJ = (const bf16*)(a->ws + WS_PROJ); bf16* YMIX = (bf16*)(a->ws + WS_YMIX);
    const int lane = tid & 63, w = tid >> 6, r = lane & 15, q4 = lane >> 4;
    for (int unit = wg; unit < 64; unit += G) {
        const int b = unit >> 4, head = (unit >> 2) & 3, eb = unit & 3;
        const size_t cu0 = (size_t)(b * 4 + head) * 64;
        const bf16* QG = (const bf16*)(a->ws + WS_HG_QG) + cu0 * 64 * 128; const bf16* KDT = (const bf16*)(a->ws + WS_HG_KDT) + cu0 * 128 * 64;
        const bf16* AM = (const bf16*)(a->ws + WS_HG_A) + cu0 * 64 * 64; const float* GL = (const float*)(a->ws + WS_HG_GL) + cu0 * 128;
        const bf16* VP = PROJ + (size_t)b * SEQ * NPROJ + O_HI + head * 128 + eb * 32;
        v4u rq[2], rk[2], ra, rv; f32x4 rg;
#define HG_LOAD(n) do { _Pragma("unroll") for (int i = 0; i < 2; ++i) { const int p = tid + NTHR * i; rq[i] = *(const GAS v4u*)(QG + (size_t)(n) * 8192 + (p >> 4) * 128 + (p & 15) * 8); \
            rk[i] = *(const GAS v4u*)(KDT + (size_t)(n) * 8192 + (p >> 3) * 64 + (p & 7) * 8); } \
            ra = *(const GAS v4u*)(AM + (size_t)(n) * 4096 + (tid >> 3) * 64 + (tid & 7) * 8); \
            if (tid < 256) rv = *(const GAS v4u*)(VP + (size_t)((n) * 64 + (tid >> 2)) * NPROJ + (tid & 3) * 8); \
            if (tid < 32) rg = *(const GAS f32x4*)(GL + (size_t)(n) * 128 + tid * 4); } while (0)
#define HG_STORE(bufp) do { LAS unsigned char* bp_ = (bufp); _Pragma("unroll") for (int i = 0; i < 2; ++i) { const int p = tid + NTHR * i; \
            *(LAS v4u*)(bp_ + B_QG + ((p >> 4) * QS + (p & 15) * 8) * 2) = rq[i]; *(LAS v4u*)(bp_ + B_KDT + ((p >> 3) * KS + (p & 7) * 8) * 2) = rk[i]; } \
            *(LAS v4u*)(bp_ + B_A + ((tid >> 3) * KS + (tid & 7) * 8) * 2) = ra; \
            if (tid < 256) { LAS bf16* vt = (LAS bf16*)(bp_ + B_VT); const int t_ = tid >> 2, e8 = (tid & 3) * 8; _Pragma("unroll") for (int i = 0; i < 4; ++i) { \
                vt[(e8 + 2 * i) * KS + t_] = (bf16)(rv[i] & 0xffffu); vt[(e8 + 2 * i + 1) * KS + t_] = (bf16)(rv[i] >> 16); } } \
            if (tid < 32) *(LAS f32x4*)(bp_ + B_GL + tid * 16) = rg; } while (0)
        __syncthreads();
        HG_LOAD(0);
        for (int i = tid; i < 8704 / 4; i += NTHR) ((LAS unsigned*)sST0)[i] = 0u;
        HG_STORE(lds);
        f32x4 accS[2] = {{0.f, 0.f, 0.f, 0.f}, {0.f, 0.f, 0.f, 0.f}};
        __syncthreads();
        for (int n = 0; n < 64; ++n) {
            const int cur = n & 1; LAS unsigned char* bp = lds + cur * BUF; LAS bf16* sST = (LAS bf16*)(sST0 + cur * 8704); LAS bf16* sSTn = (LAS bf16*)(sST0 + (cur ^ 1) * 8704);
            if (n + 1 < 64) HG_LOAD(n + 1);
            {
                const int tt = w >> 1, et = w & 1; f32x4 acc = {0.f, 0.f, 0.f, 0.f};
#pragma unroll
                for (int ks = 0; ks < 4; ++ks) acc = mfma16(lds_frag(sST, 16 * et, QS, 32 * ks, lane), lds_frag((LAS bf16*)(bp + B_QG), 16 * tt, QS, 32 * ks, lane), acc);
#pragma unroll
                for (int ks = 0; ks < 2; ++ks) acc = mfma16(lds_frag((LAS bf16*)(bp + B_VT), 16 * et, KS, 32 * ks, lane), lds_frag((LAS bf16*)(bp + B_A), 16 * tt, KS, 32 * ks, lane), acc);
                *(GAS unsigned long long*)(YMIX + ((size_t)b * SEQ + n * 64 + 16 * tt + r) * DMIX + 1536 + head * 128 + eb * 32 + 16 * et + 4 * q4) = pack4(acc);
            }
            {
                const f32x4 glv = *(const LAS f32x4*)(bp + B_GL + (16 * w + 4 * q4) * 4);
#pragma unroll
                for (int et = 0; et < 2; ++et) { accS[et] = accS[et] * glv;
#pragma unroll
                    for (int ks = 0; ks < 2; ++ks) accS[et] = mfma16(lds_frag((LAS bf16*)(bp + B_KDT), 16 * w, KS, 32 * ks, lane), lds_frag((LAS bf16*)(bp + B_VT), 16 * et, KS, 32 * ks, lane), accS[et]);
                    *(LAS unsigned long long*)(sSTn + (16 * et + r) * QS + 16 * w + 4 * q4) = pack4(accS[et]); }
            }
            if (n + 1 < 64) HG_STORE(lds + (cur ^ 1) * BUF);
            __syncthreads();
        }
#undef HG_LOAD
#undef HG_STORE
    }
}

__device__ __forceinline__ void ssd_rec_phase(CArgs a, int l, LAS unsigned char* lds, int wg, int G, int tid) {
    asm volatile("" : "+v"(tid));
    constexpr int TB = 64;
    LAS float* sX = (LAS float*)lds; LAS float* sB = sX + TB * 16; LAS float* sC = sB + TB * 128; LAS float* sDt = sC + TB * 128; LAS float* sDa = sDt + TB; LAS float* sY = sDa + TB;
    const bf16* PROJ = (const bf16*)(a->ws + WS_PROJ); bf16* YMIX = (bf16*)(a->ws + WS_YMIX);
    const float* cw = a->in[I_SCW] + (size_t)l * 4 * 1536; const float* cb = a->in[I_SCB] + (size_t)l * 1536;
    const int p_local = tid >> 5, nq = tid & 31;
    for (int unit = wg; unit < 256; unit += G) {
        const int b = unit >> 6, head = (unit >> 2) & 15, pq = unit & 3, g = head >> 3;
        const float A = -__expf(a->in[I_SALOG][l * 16 + head]), dtb = a->in[I_SDTB][l * 16 + head], Dsk = a->in[I_SD][l * 16 + head];
        float h0 = 0.f, h1 = 0.f, h2 = 0.f, h3 = 0.f;
        for (int t0 = 0; t0 < SEQ; t0 += TB) {
            __syncthreads();
            for (int idx = tid; idx < TB * 272; idx += NTHR) {
                const int tt = idx / 272, ci = idx % 272, t = t0 + tt;
                const int ch = ci < 16 ? head * 64 + pq * 16 + ci : (ci < 144 ? 1024 + g * 128 + (ci - 16) : 1280 + g * 128 + (ci - 144));
                float acc = cb[ch];
#pragma unroll
                for (int k = 0; k < 4; ++k) { const int ts = t - 3 + k; if (ts >= 0) acc += cw[k * 1536 + ch] * bf2f(PROJ[(size_t)(b * SEQ + ts) * NPROJ + O_XBC + ch]); }
                const float v = siluf(acc);
                if (ci < 16) sX[tt * 16 + ci] = v; else if (ci < 144) sB[tt * 128 + ci - 16] = v; else sC[tt * 128 + ci - 144] = v;
            }
            if (tid < TB) { const float raw = bf2f(PROJ[(size_t)(b * SEQ + t0 + tid) * NPROJ + O_DT + head]); const float dt = softplusf_(raw + dtb); sDt[tid] = dt; sDa[tid] = __expf(dt * A); }
            __syncthreads();
#pragma unroll 4
            for (int tt = 0; tt < TB; ++tt) {
                const float xv = sX[tt * 16 + p_local], da = sDa[tt], dx = sDt[tt] * xv;
                const f32x4 Bv = *(const LAS f32x4*)(sB + tt * 128 + nq * 4), Cv = *(const LAS f32x4*)(sC + tt * 128 + nq * 4);
                h0 = da * h0 + dx * Bv.x; h1 = da * h1 + dx * Bv.y; h2 = da * h2 + dx * Bv.z; h3 = da * h3 + dx * Bv.w;
                float part = (Cv.x * h0 + Cv.y * h1) + (Cv.z * h2 + Cv.w * h3);
                part += __shfl_xor(part, 1); part += __shfl_xor(part, 2); part += __shfl_xor(part, 4); part += __shfl_xor(part, 8); part += __shfl_xor(part, 16);
                if (nq == 0) sY[tt * 16 + p_local] = part + Dsk * xv;
            }
            __syncthreads();
            for (int idx = tid; idx < TB * 16; idx += NTHR) { const int tt = idx >> 4, i = idx & 15; YMIX[(size_t)(b * SEQ + t0 + tt) * DMIX + head * 64 + pq * 16 + i] = (bf16)f2bf(sY[idx]); }
        }
    }
}

__device__ __forceinline__ void ssd_prep_phase(CArgs a, int l, LAS unsigned char* lds, int wg, int G, int tid) {
    asm volatile("" : "+v"(tid));
    constexpr int PS = 136;
    LAS bf16* sB = (LAS bf16*)lds; LAS bf16* sC = sB + 128 * PS; LAS bf16* sXT = (LAS bf16*)lds; LAS float* sDt = (LAS float*)(lds + 2 * 128 * PS * 2);
    const bf16* PROJ = (const bf16*)(a->ws + WS_PROJ);
    const float* cw = a->in[I_SCW] + (size_t)l * 4 * 1536; const float* cb = a->in[I_SCB] + (size_t)l * 1536;
    const int lane = tid & 63, w = tid >> 6, r = lane & 15, q4 = lane >> 4;
    for (int unit = wg; unit < 256; unit += G) {
        const int b = unit >> 6, c = (unit >> 1) & 31, g = unit & 1;
        const size_t row0 = (size_t)b * SEQ + c * 128;
        bf16* Cg = (bf16*)(a->ws + WS_SSD_C) + (size_t)unit * 16384; bf16* BTg = (bf16*)(a->ws + WS_SSD_BT) + (size_t)unit * 16384; bf16* CBg = (bf16*)(a->ws + WS_SSD_CB) + (size_t)unit * 16384;
        __syncthreads();
        {
            const int c16 = tid & 31, l0 = tid >> 5; const int ch = (c16 < 16 ? 1024 + g * 128 + c16 * 8 : 1280 + g * 128 + (c16 - 16) * 8);
            float wk[4][8], bias[8];
#pragma unroll
            for (int jj = 0; jj < 8; ++jj) { bias[jj] = cb[ch + jj];
#pragma unroll
                for (int k = 0; k < 4; ++k) wk[k][jj] = cw[k * 1536 + ch + jj]; }
            LAS bf16* dst = (c16 < 16 ? sB : sC) + (c16 & 15) * 8;
#pragma unroll 2
            for (int i = 0; i < 8; ++i) { const int ll = l0 + 16 * i; float acc[8];
#pragma unroll
                for (int jj = 0; jj < 8; ++jj) acc[jj] = bias[jj];
#pragma unroll
                for (int k = 0; k < 4; ++k) { const int ts = c * 128 + ll - 3 + k;
                    if (ts >= 0) { const v4u xv = *(const GAS v4u*)(PROJ + ((size_t)b * SEQ + ts) * NPROJ + O_XBC + ch);
#pragma unroll
                        for (int j = 0; j < 4; ++j) { acc[2 * j] += wk[k][2 * j] * bflo(xv[j]); acc[2 * j + 1] += wk[k][2 * j + 1] * bfhi(xv[j]); } } }
#pragma unroll
                for (int jj = 0; jj < 8; ++jj) acc[jj] = siluf(acc[jj]);
                *(LAS bf16x8*)(dst + ll * PS) = pack8(acc); }
        }
        {
            const int head = g * 8 + w; const float A = -__expf(a->in[I_SALOG][l * 16 + head]), dtb = a->in[I_SDTB][l * 16 + head];
            const int l2 = 2 * lane;
            const float dt0 = softplusf_(bf2f(PROJ[(row0 + l2) * NPROJ + O_DT + head]) + dtb), dt1 = softplusf_(bf2f(PROJ[(row0 + l2 + 1) * NPROJ + O_DT + head]) + dtb);
            const float da1 = dt1 * A; float sc = dt0 * A + da1;
#pragma unroll
            for (int o = 1; o < 64; o <<= 1) { const float t_ = __shfl_up(sc, o); if (lane >= o) sc += t_; }
            sDt[w * 128 + l2] = dt0; sDt[w * 128 + l2 + 1] = dt1;
            const size_t uh = (size_t)((b * 16 + head) * 32 + c) * 128;
            float* AC = (float*)(a->ws + WS_SSD_AC) + uh; float* DT = (float*)(a->ws + WS_SSD_DT) + uh;
            AC[l2] = sc - da1; AC[l2 + 1] = sc; DT[l2] = dt0; DT[l2 + 1] = dt1;
        }
        __syncthreads();
#pragma unroll
        for (int st = 0; st < 8; ++st) {
            f32x4 acc = {0.f, 0.f, 0.f, 0.f};
            if (st <= w) {
#pragma unroll
                for (int ks = 0; ks < 4; ++ks) acc = mfma16(lds_frag(sB, 16 * st, PS, 32 * ks, lane), lds_frag(sC, 16 * w, PS, 32 * ks, lane), acc); }
            *(GAS unsigned long long*)(CBg + (16 * w + r) * 128 + 16 * st + 4 * q4) = pack4(acc);
        }
        for (int p = tid; p < 2048; p += NTHR) { const int ll = p >> 4, n8 = (p & 15) * 8; *(GAS v4u*)(Cg + ll * 128 + n8) = *(const LAS v4u*)(sC + ll * PS + n8); }
        for (int p = tid; p < 2048; p += NTHR) { const int n = p >> 4, l8 = (p & 15) * 8; v4u o;
#pragma unroll
            for (int j = 0; j < 4; ++j) o[j] = (unsigned)sB[(l8 + 2 * j) * PS + n] | ((unsigned)sB[(l8 + 2 * j + 1) * PS + n] << 16);
            *(GAS v4u*)(BTg + n * 128 + l8) = o; }
#pragma unroll 1
        for (int hf = 0; hf < 2; ++hf) {
            __syncthreads();
            {   const int cg = tid & 31, l0 = tid >> 5, chl = cg * 8, ch = g * 512 + hf * 256 + chl, hh = hf * 4 + (cg >> 3);
                float wk[4][8], bias[8];
#pragma unroll
                for (int jj = 0; jj < 8; ++jj) { bias[jj] = cb[ch + jj];
#pragma unroll
                    for (int k = 0; k < 4; ++k) wk[k][jj] = cw[k * 1536 + ch + jj]; }
#pragma unroll 2
                for (int i = 0; i < 8; ++i) { const int ll = l0 + 16 * i; float acc[8];
#pragma unroll
                    for (int jj = 0; jj < 8; ++jj) acc[jj] = bias[jj];
#pragma unroll
                    for (int k = 0; k < 4; ++k) { const int ts = c * 128 + ll - 3 + k;
                        if (ts >= 0) { const v4u xv = *(const GAS v4u*)(PROJ + ((size_t)b * SEQ + ts) * NPROJ + O_XBC + ch);
#pragma unroll
                            for (int j = 0; j < 4; ++j) { acc[2 * j] += wk[k][2 * j] * bflo(xv[j]); acc[2 * j + 1] += wk[k][2 * j + 1] * bfhi(xv[j]); } } }
                    const float dtv = sDt[hh * 128 + ll];
#pragma unroll
                    for (int jj = 0; jj < 8; ++jj) sXT[(chl + jj) * PS + ll] = (bf16)f2bf(siluf(acc[jj]) * dtv); }
            }
            __syncthreads();
            for (int p = tid; p < 4096; p += NTHR) { const int chl = p >> 4, l8 = (p & 15) * 8, hh = hf * 4 + (chl >> 6), pp = chl & 63;
                const size_t uh = (size_t)((b * 16 + g * 8 + hh) * 32 + c);
                *(GAS v4u*)((bf16*)(a->ws + WS_SSD_XT) + (uh * 64 + pp) * 128 + l8) = *(const LAS v4u*)(sXT + chl * PS + l8); }
        }
    }
}
__device__ __forceinline__ void ssd_scan_phase(CArgs a, int l, LAS unsigned char* lds, int wg, int G, int tid) {
    asm volatile("" : "+v"(tid));
    constexpr int PS = 136, O_S = 0, O_X = 34816, O_AC = 69632, O_TE = 70656, O_DT = 71680;
    bf16* YMIX = (bf16*)(a->ws + WS_YMIX);
    const int lane = tid & 63, w = tid >> 6, r = lane & 15, q4 = lane >> 4;
    for (int unit = wg; unit < 64; unit += G) {
        const int b = unit >> 4, head = unit & 15, g = head >> 3;
        const float Dsk = a->in[I_SD][l * 16 + head];
        const bf16* Cg = (const bf16*)(a->ws + WS_SSD_C) + (size_t)((b * 32) * 2 + g) * 16384 + (16 * w + r) * 128 + 8 * q4;
        const bf16* CBg = (const bf16*)(a->ws + WS_SSD_CB) + (size_t)((b * 32) * 2 + g) * 16384 + (16 * w + r) * 128 + 8 * q4;
        const bf16* BTg = (const bf16*)(a->ws + WS_SSD_BT) + (size_t)((b * 32) * 2 + g) * 16384 + (16 * w + r) * 128 + 8 * q4;
        const size_t uh0 = (size_t)(b * 16 + head) * 32;
        const bf16* XTg = (const bf16*)(a->ws + WS_SSD_XT) + uh0 * 8192; const float* ACg = (const float*)(a->ws + WS_SSD_AC) + uh0 * 128; const float* DTg = (const float*)(a->ws + WS_SSD_DT) + uh0 * 128;
        v4u fC[4], fCB[4], fBT[4], nC[4], nCB[4], nBT[4], rx[2]; float rac = 0.f, racl = 0.f, rdt = 0.f;
#define SSD_LOAD(cc, dC, dCB, dBT) do { _Pragma("unroll") for (int ks = 0; ks < 4; ++ks) { dC[ks] = *(const GAS v4u*)(Cg + (size_t)(cc) * 32768 + 32 * ks); dCB[ks] = *(const GAS v4u*)(CBg + (size_t)(cc) * 32768 + 32 * ks); \
            dBT[ks] = *(const GAS v4u*)(BTg + (size_t)(cc) * 32768 + 32 * ks); } \
            _Pragma("unroll") for (int i = 0; i < 2; ++i) { const int p = tid + NTHR * i; rx[i] = *(const GAS v4u*)(XTg + (size_t)(cc) * 8192 + (p >> 4) * 128 + (p & 15) * 8); } \
            if (tid < 128) { rac = ACg[(cc) * 128 + tid]; racl = ACg[(cc) * 128 + 127]; rdt = DTg[(cc) * 128 + tid]; } } while (0)
#define SSD_STORE(bi) do { _Pragma("unroll") for (int i = 0; i < 2; ++i) { const int p = tid + NTHR * i; *(LAS v4u*)(lds + O_X + (bi) * 17408 + ((p >> 4) * PS + (p & 15) * 8) * 2) = rx[i]; } \
            if (tid < 128) { ((LAS float*)(lds + O_AC))[(bi) * 128 + tid] = rac; ((LAS float*)(lds + O_TE))[(bi) * 128 + tid] = __expf(racl - rac); ((LAS float*)(lds + O_DT))[(bi) * 128 + tid] = rdt; } } while (0)
        __syncthreads();
        SSD_LOAD(0, fC, fCB, fBT);
        for (int i = tid; i < 17408 / 4; i += NTHR) ((LAS unsigned*)(lds + O_S))[i] = 0u;
        SSD_STORE(0);
        f32x4 accS[4];
#pragma unroll
        for (int pt = 0; pt < 4; ++pt) accS[pt] = (f32x4){0.f, 0.f, 0.f, 0.f};
        __syncthreads();
        for (int c = 0; c < 32; ++c) {
            const int cur = c & 1;
            const LAS bf16* sS = (const LAS bf16*)(lds + O_S + cur * 17408); LAS bf16* sSn = (LAS bf16*)(lds + O_S + (cur ^ 1) * 17408); const LAS bf16* sXT = (const LAS bf16*)(lds + O_X + cur * 17408);
            const LAS float* sAc = (const LAS float*)(lds + O_AC) + cur * 128; const LAS float* sTe = (const LAS float*)(lds + O_TE) + cur * 128; const LAS float* sDt = (const LAS float*)(lds + O_DT) + cur * 128;
            if (c + 1 < 32) SSD_LOAD(c + 1, nC, nCB, nBT);
            const int lrow = 16 * w + r; const float ac_l = sAc[lrow];
            f32x4 accO[4], accD[4];
#pragma unroll
            for (int pt = 0; pt < 4; ++pt) { accO[pt] = (f32x4){0.f, 0.f, 0.f, 0.f}; accD[pt] = (f32x4){0.f, 0.f, 0.f, 0.f}; }
#pragma unroll
            for (int ks = 0; ks < 4; ++ks) { const bf16x8 yf = __builtin_bit_cast(bf16x8, fC[ks]);
#pragma unroll
                for (int pt = 0; pt < 4; ++pt) accO[pt] = mfma16(lds_frag(sS, 16 * pt, PS, 32 * ks, lane), yf, accO[pt]); }
#pragma unroll
            for (int ks = 0; ks < 4; ++ks) if (32 * ks <= 16 * w + 15) {
                float v[8]; const f32x4 a0 = *(const LAS f32x4*)(sAc + 32 * ks + 8 * q4), a1 = *(const LAS f32x4*)(sAc + 32 * ks + 8 * q4 + 4);
#pragma unroll
                for (int j = 0; j < 4; ++j) { const int s0 = 32 * ks + 8 * q4 + 2 * j; const float as0 = (2 * j < 4) ? a0[(2 * j) & 3] : a1[(2 * j) & 3], as1 = (2 * j + 1 < 4) ? a0[(2 * j + 1) & 3] : a1[(2 * j + 1) & 3];
                    v[2 * j] = (s0 <= lrow) ? bflo(fCB[ks][j]) * __expf(ac_l - as0) : 0.f; v[2 * j + 1] = (s0 + 1 <= lrow) ? bfhi(fCB[ks][j]) * __expf(ac_l - as1) : 0.f; }
                const bf16x8 yf = pack8(v);
#pragma unroll
                for (int pt = 0; pt < 4; ++pt) accD[pt] = mfma16(lds_frag(sXT, 16 * pt, PS, 32 * ks, lane), yf, accD[pt]); }
            {   const float ea = __expf(ac_l), rdtl = Dsk / sDt[lrow];
#pragma unroll
                for (int pt = 0; pt < 4; ++pt) { f32x4 y = accO[pt] * ea + accD[pt];
#pragma unroll
                    for (int ii = 0; ii < 4; ++ii) y[ii] += rdtl * bf2f(sXT[(16 * pt + 4 * q4 + ii) * PS + lrow]);
                    *(GAS unsigned long long*)(YMIX + ((size_t)b * SEQ + c * 128 + lrow) * DMIX + head * 64 + 16 * pt + 4 * q4) = pack4(y); } }
            {   const float cd = __expf(sAc[127]);
#pragma unroll
                for (int pt = 0; pt < 4; ++pt) accS[pt] = accS[pt] * cd;
#pragma unroll
                for (int ks = 0; ks < 4; ++ks) { float v[8]; const f32x4 t0 = *(const LAS f32x4*)(sTe + 32 * ks + 8 * q4), t1 = *(const LAS f32x4*)(sTe + 32 * ks + 8 * q4 + 4);
#pragma unroll
                    for (int j = 0; j < 4; ++j) { const float ts0 = (2 * j < 4) ? t0[(2 * j) & 3] : t1[(2 * j) & 3], ts1 = (2 * j + 1 < 4) ? t0[(2 * j + 1) & 3] : t1[(2 * j + 1) & 3];
                        v[2 * j] = bflo(fBT[ks][j]) * ts0; v[2 * j + 1] = bfhi(fBT[ks][j]) * ts1; }
                    const bf16x8 xf = pack8(v);
#pragma unroll
                    for (int pt = 0; pt < 4; ++pt) accS[pt] = mfma16(xf, lds_frag(sXT, 16 * pt, PS, 32 * ks, lane), accS[pt]); }
#pragma unroll
                for (int pt = 0; pt < 4; ++pt) *(LAS unsigned long long*)(sSn + (16 * pt + r) * PS + 16 * w + 4 * q4) = pack4(accS[pt]);
            }
            if (c + 1 < 32) { SSD_STORE(cur ^ 1);
#pragma unroll
                for (int ks = 0; ks < 4; ++ks) { fC[ks] = nC[ks]; fCB[ks] = nCB[ks]; fBT[ks] = nBT[ks]; } }
            __syncthreads();
        }
#undef SSD_LOAD
#undef SSD_STORE
    }
}

__device__ __forceinline__ void gdn_rec_phase(CArgs a, int l, LAS unsigned char* lds, int wg, int G, int tid) {
    asm volatile("" : "+v"(tid));
    constexpr int TB = 32;
    LAS float* sQ = (LAS float*)lds; LAS float* sK = sQ + TB * 128; LAS float* sV = sK + TB * 128; LAS float* sBe = sV + TB * 8; LAS float* sAl = sBe + TB; LAS float* sO = sAl + TB;
    const bf16* PROJ = (const bf16*)(a->ws + WS_PROJ); bf16* YMIX = (bf16*)(a->ws + WS_YMIX);
    const float* cw = a->in[I_GCW] + (size_t)l * 4 * 1536;
    const int lane = tid & 63, w = tid >> 6;
    for (int unit = wg; unit < 256; unit += G) {
        const int b = unit >> 6, head = (unit >> 4) & 3, eb = unit & 15;
        const float nA = -__expf(a->in[I_GALOG][l * 4 + head]), dtb = a->in[I_GDTB][l * 4 + head];
        float S0 = 0.f, S1 = 0.f;
        for (int t0 = 0; t0 < SEQ; t0 += TB) {
            __syncthreads();
            for (int idx = tid; idx < TB * 264; idx += NTHR) {
                const int tt = idx / 264, ci = idx % 264, t = t0 + tt;
                const int ch = ci < 128 ? head * 128 + ci : (ci < 256 ? 512 + head * 128 + (ci - 128) : 1024 + head * 128 + eb * 8 + (ci - 256));
                float acc = 0.f;
#pragma unroll
                for (int k = 0; k < 4; ++k) { const int ts = t - 3 + k; if (ts >= 0) acc += cw[k * 1536 + ch] * bf2f(PROJ[(size_t)(b * SEQ + ts) * NPROJ + O_QKV + ch]); }
                const float v = siluf(acc);
                if (ci < 128) sQ[tt * 128 + ci] = v; else if (ci < 256) sK[tt * 128 + ci - 128] = v; else sV[tt * 8 + ci - 256] = v;
            }
            if (tid < TB) { const size_t ro = (size_t)(b * SEQ + t0 + tid) * NPROJ; const float braw = bf2f(PROJ[ro + O_GB + head]), araw = bf2f(PROJ[ro + O_GA + head]);
                sBe[tid] = sigmoidf_(braw); sAl[tid] = __expf(nA * softplusf_(araw + dtb)); }
            __syncthreads();
            for (int tt = w; tt < TB; tt += NWAVES) {
                const float q0 = sQ[tt * 128 + lane], q1 = sQ[tt * 128 + 64 + lane], k0 = sK[tt * 128 + lane], k1 = sK[tt * 128 + 64 + lane];
                const float sq = rsqrtf(wave_sum(q0 * q0 + q1 * q1) + 1e-6f) * 0.08838834764831845f, sk = rsqrtf(wave_sum(k0 * k0 + k1 * k1) + 1e-6f);
                sQ[tt * 128 + lane] = q0 * sq; sQ[tt * 128 + 64 + lane] = q1 * sq; sK[tt * 128 + lane] = k0 * sk; sK[tt * 128 + 64 + lane] = k1 * sk;
            }
            __syncthreads();
#pragma unroll 2
            for (int tt = 0; tt < TB; ++tt) {
                const float k0 = sK[tt * 128 + lane], k1 = sK[tt * 128 + 64 + lane], q0 = sQ[tt * 128 + lane], q1 = sQ[tt * 128 + 64 + lane];
                const float al = sAl[tt], be = sBe[tt], v = sV[tt * 8 + w];
                const float dot = wave_sum(k0 * S0 + k1 * S1);
                const float vn = be * (v - al * dot);
                S0 = al * S0 + k0 * vn; S1 = al * S1 + k1 * vn;
                const float od = wave_sum(q0 * S0 + q1 * S1);
                if (lane == 0) sO[tt * 8 + w] = od;
            }
            __syncthreads();
            if (tid < TB * 8) { const int tt = tid >> 3, i = tid & 7; YMIX[(size_t)(b * SEQ + t0 + tt) * DMIX + 1024 + head * 128 + eb * 8 + i] = (bf16)f2bf(sO[tid]); }
        }
    }
}

__device__ __forceinline__ void hgrn_rec_phase(CArgs a, int l, LAS unsigned char* lds, int wg, int G, int tid) {
    asm volatile("" : "+v"(tid));
    constexpr int TB = 32;
    LAS float* sQ = (LAS float*)lds; LAS float* sF = sQ + TB * 128; LAS float* sV = sF + TB * 128; LAS float* sO = sV + TB * 8; LAS float* sLb = sO + TB * 8;
    const bf16* PROJ = (const bf16*)(a->ws + WS_PROJ); bf16* YMIX = (bf16*)(a->ws + WS_YMIX);
    const int lane = tid & 63, w = tid >> 6;
    for (int unit = wg; unit < 256; unit += G) {
        const int b = unit >> 6, head = (unit >> 4) & 3, eb = unit & 15;
        __syncthreads();
        if (tid < 128) {
            const int c = head * 128 + tid; float lg[DEPTH], mx = -1e30f;
#pragma unroll
            for (int j = 0; j < DEPTH; ++j) { lg[j] = a->in[I_HLB][j * 512 + c]; mx = fmaxf(mx, lg[j]); }
            float den = 0.f, num = 0.f;
#pragma unroll
            for (int j = 0; j < DEPTH; ++j) { const float e = __expf(lg[j] - mx); den += e; if (j >= 1 && j <= l) num += e; }
            sLb[tid] = num / den;
        }
        float S0 = 0.f, S1 = 0.f;
        for (int t0 = 0; t0 < SEQ; t0 += TB) {
            __syncthreads();
            for (int idx = tid; idx < TB * 264; idx += NTHR) {
                const int tt = idx / 264, ci = idx % 264; const size_t ro = (size_t)(b * SEQ + t0 + tt) * NPROJ;
                if (ci < 128) sQ[tt * 128 + ci] = siluf(bf2f(PROJ[ro + O_HQ + head * 128 + ci]));
                else if (ci < 256) { const int d = ci - 128; const float lb = sLb[d]; sF[tt * 128 + d] = lb + (1.f - lb) * sigmoidf_(bf2f(PROJ[ro + O_HF + head * 128 + d])); }
                else sV[tt * 8 + ci - 256] = bf2f(PROJ[ro + O_HI + head * 128 + eb * 8 + (ci - 256)]);
            }
            __syncthreads();
#pragma unroll 2
            for (int tt = 0; tt < TB; ++tt) {
                const float f0 = sF[tt * 128 + lane], f1 = sF[tt * 128 + 64 + lane], q0 = sQ[tt * 128 + lane], q1 = sQ[tt * 128 + 64 + lane], v = sV[tt * 8 + w];
                S0 = f0 * S0 + (1.f - f0) * v; S1 = f1 * S1 + (1.f - f1) * v;
                const float od = wave_sum(q0 * S0 + q1 * S1);
                if (lane == 0) sO[tt * 8 + w] = od;
            }
            __syncthreads();
            if (tid < TB * 8) { const int tt = tid >> 3, i = tid & 7; YMIX[(size_t)(b * SEQ + t0 + tt) * DMIX + 1536 + head * 128 + eb * 8 + i] = (bf16)f2bf(sO[tid]); }
        }
    }
}

__device__ __forceinline__ void mix_post_phase(CArgs a, int l, int wg, int G, int tid) {
    asm volatile("" : "+v"(tid));
    const bf16* PROJ = (const bf16*)(a->ws + WS_PROJ); bf16* YMIX = (bf16*)(a->ws + WS_YMIX);
    const int lane = tid & 63, gw = wg * NWAVES + (tid >> 6), NGW = G * NWAVES;
    const float* snw = a->in[I_SNW] + l * 1024; const float* gnw = a->in[I_GNW] + l * 128; const float* hnw = a->in[I_HNW] + l * 128;
    for (int row = gw; row < M; row += NGW) {
        const bf16* pr = PROJ + (size_t)row * NPROJ; bf16* yr = YMIX + (size_t)row * DMIX;
#pragma unroll
        for (int j = 0; j < 2; ++j) {
            const int ch = j * 512 + lane * 8; const v4u yv = *(const GAS v4u*)(yr + ch), zv = *(const GAS v4u*)(pr + O_Z + ch);
            float v[8]; float ss = 0.f;
#pragma unroll
            for (int i = 0; i < 4; ++i) { v[2 * i] = bflo(yv[i]) * siluf(bflo(zv[i])); v[2 * i + 1] = bfhi(yv[i]) * siluf(bfhi(zv[i])); ss += v[2 * i] * v[2 * i] + v[2 * i + 1] * v[2 * i + 1]; }
            const float rstd = rsqrtf(wave_sum(ss) * (1.f / 512.f) + 1e-6f);
            v4u o;
#pragma unroll
            for (int i = 0; i < 4; ++i) o[i] = pk2(v[2 * i] * rstd * snw[ch + 2 * i], v[2 * i + 1] * rstd * snw[ch + 2 * i + 1]);
            *(GAS v4u*)(yr + ch) = o;
        }
#pragma unroll
        for (int part = 0; part < 2; ++part) {
            const int ch = lane * 8, yo = 1024 + part * 512 + ch, go = (part == 0 ? O_GG : O_HG) + ch; const float* nw = part == 0 ? gnw : hnw;
            const v4u yv = *(const GAS v4u*)(yr + yo), gv = *(const GAS v4u*)(pr + go);
            float v[8]; float ss = 0.f;
#pragma unroll
            for (int i = 0; i < 4; ++i) { v[2 * i] = bflo(yv[i]); v[2 * i + 1] = bfhi(yv[i]); ss += v[2 * i] * v[2 * i] + v[2 * i + 1] * v[2 * i + 1]; }
            ss += __shfl_xor(ss, 1); ss += __shfl_xor(ss, 2); ss += __shfl_xor(ss, 4); ss += __shfl_xor(ss, 8);
            const float rstd = rsqrtf(ss * (1.f / 128.f) + 1e-6f);
            v4u o;
#pragma unroll
            for (int i = 0; i < 4; ++i) { const int c = (ch & 127) + 2 * i; o[i] = pk2(v[2 * i] * rstd * nw[c] * siluf(bflo(gv[i])), v[2 * i + 1] * rstd * nw[c + 1] * siluf(bfhi(gv[i]))); }
            *(GAS v4u*)(yr + yo) = o;
        }
    }
}

template <bool ROUTER>
__device__ __forceinline__ void ln_phase(CArgs a, int l, const float* gam, const float* bet, LAS unsigned char* lds, int wg, int G, int tid) {
    asm volatile("" : "+v"(tid));
    const int lane = tid & 63, gw = wg * NWAVES + (tid >> 6), NGW = G * NWAVES;
    const float* ADD = (const float*)(a->ws + WS_MIX); float* H = a->out; bf16* HB = (bf16*)(a->ws + WS_HB); float* COMB = (float*)(a->ws + WS_COMB);
    LAS float* sW = (LAS float*)lds;
    LAS float* sL = sW + 20 * D + (tid >> 6) * 32;
    if (ROUTER) {
        __syncthreads();
        const float* wrg = a->in[I_WRG] + (size_t)l * D * 4; const float* wre = a->in[I_WRE] + (size_t)l * D * 16;
        for (int i = tid; i < D * 20; i += NTHR) { const int c = i >> 10, k = i & 1023; sW[i] = c < 4 ? wrg[k * 4 + c] : wre[k * 16 + c - 4]; }
        __syncthreads();
    }
    f32x4 gv[4], bv[4];
#pragma unroll
    for (int j = 0; j < 4; ++j) { gv[j] = *(const f32x4*)(gam + 4 * lane + 256 * j); bv[j] = *(const f32x4*)(bet + 4 * lane + 256 * j); }
    for (int row = gw; row < M; row += NGW) {
        f32x4 v[4]; float s = 0.f;
#pragma unroll
        for (int j = 0; j < 4; ++j) { const f32x4 hv = *(const GAS f32x4*)(H + (size_t)row * D + 4 * lane + 256 * j), av = *(const GAS f32x4*)(ADD + (size_t)row * D + 4 * lane + 256 * j);
            v[j] = hv * DN_ALPHA + av; s += (v[j].x + v[j].y) + (v[j].z + v[j].w); }
        const float mean = wave_sum(s) * (1.f / D); float s2 = 0.f;
#pragma unroll
        for (int j = 0; j < 4; ++j) { v[j] = v[j] - mean; s2 += (v[j].x * v[j].x + v[j].y * v[j].y) + (v[j].z * v[j].z + v[j].w * v[j].w); }
        const float rstd = rsqrtf(wave_sum(s2) * (1.f / D) + LN_EPS);
#pragma unroll
        for (int j = 0; j < 4; ++j) { v[j] = v[j] * rstd * gv[j] + bv[j];
            *(GAS f32x4*)(H + (size_t)row * D + 4 * lane + 256 * j) = v[j];
            *(GAS unsigned long long*)(HB + (size_t)row * D + 4 * lane + 256 * j) = (unsigned long long)pk2(v[j].x, v[j].y) | ((unsigned long long)pk2(v[j].z, v[j].w) << 32); }
        if (ROUTER) {
            float lg[20];
#pragma unroll 1
            for (int c = 0; c < 20; ++c) { float p = 0.f;
#pragma unroll
                for (int j = 0; j < 4; ++j) { const f32x4 wv = *(const LAS f32x4*)(sW + c * D + 4 * lane + 256 * j); p += (v[j].x * wv.x + v[j].y * wv.y) + (v[j].z * wv.z + v[j].w * wv.w); }
                p = wave_sum(p); if (lane == 0) sL[c] = p; }
#pragma unroll
            for (int c = 0; c < 20; ++c) lg[c] = sL[c];
            float pg[4], mx = -1e30f; int gi = 0;
#pragma unroll
            for (int c = 0; c < 4; ++c) { pg[c] = lg[c] + a->in[I_BRG][l * 4 + c]; if (pg[c] > mx) { mx = pg[c]; gi = c; } }
            float den = 0.f;
#pragma unroll
            for (int c = 0; c < 4; ++c) den += __expf(pg[c] - mx);
            const float g_p = 1.0f / den;
            float le[4], emx = -1e30f; int i1 = 0;
#pragma unroll
            for (int c = 0; c < 4; ++c) { float x = 0.f;
#pragma unroll
                for (int gg = 0; gg < 4; ++gg) x = (gi == gg) ? lg[4 + gg * 4 + c] + a->in[I_BRE][l * 16 + gg * 4 + c] : x;
                le[c] = x; if (x > emx) { emx = x; i1 = c; } }
            float e2mx = -1e30f; int i2 = 0;
#pragma unroll
            for (int c = 0; c < 4; ++c) if (c != i1 && le[c] > e2mx) { e2mx = le[c]; i2 = c; }
            const float x1 = 1.0f, x2 = __expf(e2mx - emx), w1 = g_p * x1 / (x1 + x2), w2 = g_p * x2 / (x1 + x2);
            if (lane < 16) { const int gl = lane >> 2, el = lane & 3; float cwv = 0.f; if (gl == gi) { if (el == i1) cwv = w1; else if (el == i2) cwv = w2; } COMB[(size_t)row * 16 + lane] = cwv; }
        }
    }
}

#ifndef PHASE_MASK
#define PHASE_MASK 0x7ff
#endif
#define PM(k) (((PHASE_MASK) >> (k)) & 1)
enum { P_W = 0, P_IN, P_PREP, P_SSD, P_GDN, P_HG, P_POST, P_OUT, P_LN1, P_GU, P_DN, P_LN2, NPH };
constexpr int N_PHASES = 1 + DEPTH * NPH;
__global__ void __launch_bounds__(NTHR, 2) fwd(Args args) {
    extern __shared__ __attribute__((aligned(16))) unsigned char lds_raw[];
    LAS unsigned char* lds = (LAS unsigned char*)lds_raw;
    volatile LAS unsigned* MISC = (volatile LAS unsigned*)(lds + MISC_OFF);
    const int tid = threadIdx.x, G = gridDim.x, bx = blockIdx.x;
    unsigned char* ws = args.ws;
    gu32* ctl = (gu32*)(ws + WS_CTL);
    for (int u = tid; u < (LDS_BYTES - LDSCTL_OFF) / 4; u += NTHR) ((LAS unsigned*)(lds + LDSCTL_OFF))[u] = 0u;
    __syncthreads();
    const int lo = args.ph_lo, hi = args.ph_hi;
    const bool use_bar = (hi - lo) > 1;
    XcdBarrier bar; bar.bar = (unsigned*)(ctl + CW_BAR); bar.x = 0; bar.st = nullptr;
    if (use_bar) bar = xcd_barrier_post((unsigned*)(ctl + CW_BAR), MISC + 8);
#define IN(k) (lo <= (k) && (k) < hi)
#define SEAM(k) do { if (IN(k) && IN((k) + 1)) xcd_barrier(bar); } while (0)

    if (IN(0)) { p0_prologue(ARGS_HERE(), lds, bx, G, tid); SEAM(0); }

    for (int l = 0; l < DEPTH; ++l) {
        const int base = 1 + l * NPH;
        if (IN(base + P_W)) { weights_phase(ARGS_HERE(), l, lds, bx, G, tid); SEAM(base + P_W); }
        if (IN(base + P_IN)) {
            pg8::Gemm g{(const pg8::bf16_t*)(ws + WS_HB), (const pg8::bf16_t*)(ws + WS_WIN), M, NPROJ, D}; pg8::StaticOrder S; S.init(M, NPROJ, G, bx);
            pg8::EpiBf16<0> E{(pg8::bf16_t*)(ws + WS_PROJ), NPROJ, nullptr, 0, 0, 1.f};
            pg8::gemm_phase<pg8::EpiBf16<0>, pg8::StaticOrder, true, true>(lds + RING_OFF, g, S, E);
            SEAM(base + P_IN);
        }
        if (IN(base + P_PREP)) { hgrn_prep_phase(ARGS_HERE(), l, lds, bx, G, tid); ssd_prep_phase(ARGS_HERE(), l, lds, bx, G, tid); SEAM(base + P_PREP); }
        if (IN(base + P_SSD)) { ssd_scan_phase(ARGS_HERE(), l, lds, bx, G, tid); SEAM(base + P_SSD); }
        if (IN(base + P_GDN)) { gdn_rec_phase(ARGS_HERE(), l, lds, bx, G, tid); SEAM(base + P_GDN); }
        if (IN(base + P_HG)) { hgrn_scan_phase(ARGS_HERE(), l, lds, bx, G, tid); SEAM(base + P_HG); }
        if (IN(base + P_POST)) { mix_post_phase(ARGS_HERE(), l, bx, G, tid); SEAM(base + P_POST); }
        if (IN(base + P_OUT)) {
            pg8::Gemm g{(const pg8::bf16_t*)(ws + WS_YMIX), (const pg8::bf16_t*)(ws + WS_WOUT), M, D, DMIX}; pg8::StaticOrder S; S.init(M, D, G, bx);
            pg8::EpiF32 E{(float*)(ws + WS_MIX), D};
            pg8::gemm_phase<pg8::EpiF32, pg8::StaticOrder, true, true>(lds + RING_OFF, g, S, E);
            SEAM(base + P_OUT);
        }
        if (IN(base + P_LN1)) { CArgs a_ = ARGS_HERE(); ln_phase<true>(a_, l, a_->in[I_LN1G] + l * D, a_->in[I_LN1B] + l * D, lds, bx, G, tid); SEAM(base + P_LN1); }
        if (IN(base + P_GU)) {
            pg8::Gemm g{(const pg8::bf16_t*)(ws + WS_HB), (const pg8::bf16_t*)(ws + WS_WGU), M, NGU, D}; pg8::StaticOrder S; S.init(M, NGU, G, bx);
            pg8::EpiSwiGLU E{(pg8::bf16_t*)(ws + WS_H), KDN, (const float*)(ws + WS_COMB), 16};
            pg8::gemm_phase<pg8::EpiSwiGLU, pg8::StaticOrder, true, true>(lds + RING_OFF, g, S, E);
            SEAM(base + P_GU);
        }
        if (IN(base + P_DN)) {
            pg8::Gemm g{(const pg8::bf16_t*)(ws + WS_H), (const pg8::bf16_t*)(ws + WS_WDN), M, D, KDN}; pg8::StaticOrder S; S.init(M, D, G, bx);
            pg8::EpiF32 E{(float*)(ws + WS_MIX), D};
            pg8::gemm_phase<pg8::EpiF32, pg8::StaticOrder, true, true>(lds + RING_OFF, g, S, E);
            SEAM(base + P_DN);
        }
        if (IN(base + P_LN2)) { CArgs a_ = ARGS_HERE(); ln_phase<false>(a_, l, a_->in[I_LN2G] + l * D, a_->in[I_LN2B] + l * D, lds, bx, G, tid); SEAM(base + P_LN2); }
    }
#undef IN
#undef SEAM
}

#ifndef MK_ONE_LAUNCH
#define MK_ONE_LAUNCH 1
#endif
extern "C" void kernel_launch(void* const* d_in, const int* in_sizes, int n_in, void* d_out, int out_size, void* d_ws, size_t ws_size, hipStream_t stream) {
    static int grid = 0;
    if (grid == 0) {
        if (n_in != 25 || out_size != M * D || ws_size < WS_END) { fprintf(stderr, "kernel_launch: unexpected shapes (n_in %d out %d ws %zu)\n", n_in, out_size, ws_size); grid = -1; return; }
        int dev = 0, cus = 0, per_cu = 0;
        if (hipGetDevice(&dev) != hipSuccess || hipDeviceGetAttribute(&cus, hipDeviceAttributeMultiprocessorCount, dev) != hipSuccess) { grid = -1; return; }
        if (hipFuncSetAttribute((const void*)fwd, hipFuncAttributeMaxDynamicSharedMemorySize, LDS_BYTES) != hipSuccess) { fprintf(stderr, "kernel_launch: hipFuncSetAttribute failed\n"); grid = -1; return; }
        if (hipOccupancyMaxActiveBlocksPerMultiprocessor(&per_cu, (const void*)fwd, NTHR, LDS_BYTES) != hipSuccess || per_cu < 1) { fprintf(stderr, "kernel_launch: occupancy query says %d\n", per_cu); (void)hipGetLastError(); grid = -1; return; }
        grid = cus;
    }
    if (grid < 0) return;
    if (hipMemsetAsync((char*)d_ws + WS_CTL, 0, CTL_ZERO_BYTES, stream) != hipSuccess) return;
    Args a{};
    for (int i = 0; i < 25; ++i) a.in[i] = (const float*)d_in[i];
    a.out = (float*)d_out; a.ws = (unsigned char*)d_ws;
#if MK_ONE_LAUNCH
    a.ph_lo = 0; a.ph_hi = N_PHASES;
    hipLaunchKernelGGL(fwd, dim3(grid), dim3(NTHR), LDS_BYTES, stream, a);
#else
    for (int p = 0; p < N_PHASES; ++p) { a.ph_lo = p; a.ph_hi = p + 1; hipLaunchKernelGGL(fwd, dim3(grid), dim3(NTHR), LDS_BYTES, stream, a); }
#endif
}
```

```cpp
#include <hip/hip_runtime.h>
#include <cstdio>
#include <cstdint>
namespace pg8 {
#define PG8_LAS __attribute__((address_space(3)))
typedef unsigned short bf16_t;
typedef short bf16x8 __attribute__((ext_vector_type(8)));
typedef float f32x4 __attribute__((ext_vector_type(4)));
typedef unsigned u32x4 __attribute__((ext_vector_type(4)));
constexpr int BM = 256, BK = 64, HALF = 128, HTB = HALF * BK * 2  , STAGE_BYTES = 8 * HTB, NXCD = 8, WGM = 8;

__host__ __device__ __forceinline__ int lds_byte(int r, int c) { const int st = (r >> 4) * 2 + (c >> 5), rr = r & 15, cc = c & 31, ob = rr * 64 + cc * 2; return st * 1024 + (ob ^ (((ob >> 9) & 1) << 5)); }
__host__ __device__ __forceinline__ void stage_rc(int b, int& R, int& C) { const int st = b / 1024, sb = b % 1024, swz = sb ^ (((sb >> 9) & 1) << 5); R = (st >> 1) * 16 + swz / 64; C = (st & 1) * 32 + (swz % 64) / 2; }
__host__ __device__ __forceinline__ int perm32(int rho) { const int n = rho >> 4, i = rho & 15; return 8 * (i >> 2) + 4 * n + (i & 3); }

struct Unit { int pm, pn; };
struct Gemm { const bf16_t* A; const bf16_t* Bt; int M, N, K; };

struct StaticOrder {
    int nM, nN, nwg, G, c;
    __host__ __device__ void init(int M, int N, int G_, int c_) { nM = M / BM; nN = N / BM; nwg = nM * nN; G = G_; c = c_; }
    __host__ __device__ bool next(int i, Unit& u) const {
        const long L = (long)i * G + c; if (L >= nwg) return false;
        int wgid = (int)L; { const int q = nwg / NXCD, r = nwg % NXCD, xcd = wgid % NXCD, off = wgid / NXCD; wgid = (xcd < r ? xcd * (q + 1) : r * (q + 1) + (xcd - r) * q) + off; }
        const int nig = WGM * nN, gid = wgid / nig, fm = gid * WGM, gsz = (nM - fm) < WGM ? (nM - fm) : WGM;
        u.pm = fm + ((wgid % nig) % gsz); u.pn = (wgid % nig) / gsz; return true;
    }
    __device__ __forceinline__ void a_ready(const Unit&) const {}
    __device__ __forceinline__ void done(const Unit&) const {}
};
__device__ __forceinline__ unsigned cvt_pk_bf16(float lo, float hi) { unsigned r; asm volatile("v_cvt_pk_bf16_f32 %0, %1, %2" : "=v"(r) : "v"(lo), "v"(hi)); return r; }
typedef float f32x2 __attribute__((ext_vector_type(2)));
__device__ __forceinline__ f32x2 gelu_pk(f32x2 v) {
    const f32x2 av = __builtin_elementwise_abs(v), d = av * 0.2316418882f + 1.0f;
    f32x2 t; t.x = __builtin_amdgcn_rcpf(d.x); t.y = __builtin_amdgcn_rcpf(d.y);
    f32x2 q = t * 0.5307027145f + (-0.7265760135f); q = q * t + 0.7107068705f; q = q * t + (-0.142248368f); q = q * t + 0.127414796f; q = q * t;
    const f32x2 s = (v * v) * (-0.72134752044f);
    f32x2 e; e.x = __builtin_amdgcn_exp2f(s.x); e.y = __builtin_amdgcn_exp2f(s.y);
    const f32x2 m = v * (q * e), r = v - m;
    f32x2 o; o.x = v.x < 0.f ? m.x : r.x; o.y = v.y < 0.f ? m.y : r.y; return o;
}

template <int ACT  > struct EpiBf16 {
    static constexpr bool PERM = true, AFTER_DRAIN = false; static_assert(ACT == 0 || ACT == 1, "EpiBf16: ACT is 0 (none) or 1 (gelu_pk)");
    bf16_t* O; int ldc; const float* bias; int split_cols; size_t split_stride; float scale0;
    __device__ __forceinline__ void operator()(const f32x4 (&acc)[2][2][4][2], const Unit& u, int wr, int wc, int fr, int fq) const {
        const int row0 = u.pm * BM + wr * 64 + fr; int colt = u.pn * BM; bf16_t* base = O;
        float sc = 1.f; if (split_cols) { const int t = colt / split_cols; base += (size_t)t * split_stride; colt -= t * split_cols; if (t == 0) sc = scale0; }
        const int col0 = colt + wc * 32 + 8 * fq, bcol0 = u.pn * BM + wc * 32 + 8 * fq;
        f32x4 bv[2][2];
#pragma unroll
        for (int bj = 0; bj < 2; ++bj)
#pragma unroll
            for (int n = 0; n < 2; ++n) bv[bj][n] = bias ? *(const f32x4*)(bias + bcol0 + bj * HALF + 4 * n) : (f32x4){0.f, 0.f, 0.f, 0.f};
#pragma unroll
        for (int ai = 0; ai < 2; ++ai)
#pragma unroll
            for (int m = 0; m < 4; ++m) { bf16_t* rowp = base + (size_t)(row0 + ai * HALF + m * 16) * ldc + col0;
#pragma unroll
                for (int bj = 0; bj < 2; ++bj) { f32x4 v0 = acc[ai][bj][m][0] + bv[bj][0], v1 = acc[ai][bj][m][1] + bv[bj][1];
                    if (ACT == 1) { f32x2 a = gelu_pk((f32x2){v0[0], v0[1]}), b = gelu_pk((f32x2){v0[2], v0[3]}), c = gelu_pk((f32x2){v1[0], v1[1]}), d = gelu_pk((f32x2){v1[2], v1[3]});
                        v0 = (f32x4){a.x, a.y, b.x, b.y}; v1 = (f32x4){c.x, c.y, d.x, d.y}; }
                    v0 = v0 * sc; v1 = v1 * sc; u32x4 w; w.x = cvt_pk_bf16(v0[0], v0[1]); w.y = cvt_pk_bf16(v0[2], v0[3]); w.z = cvt_pk_bf16(v1[0], v1[1]); w.w = cvt_pk_bf16(v1[2], v1[3]);
                    *(u32x4*)(rowp + bj * HALF) = w; } }
    }
};
struct EpiF32 {
    static constexpr bool PERM = false, AFTER_DRAIN = false;
    float* C; int ldc;
    __device__ __forceinline__ void operator()(const f32x4 (&acc)[2][2][4][2], const Unit& u, int wr, int wc, int fr, int fq) const {
        const int row0 = u.pm * BM + wr * 64 + fr, col0 = u.pn * BM + wc * 32 + 4 * fq;
#pragma unroll
        for (int ai = 0; ai < 2; ++ai)
#pragma unroll
            for (int m = 0; m < 4; ++m) { float* rowp = C + (size_t)(row0 + ai * HALF + m * 16) * ldc + col0;
#pragma unroll
                for (int bj = 0; bj < 2; ++bj)
#pragma unroll
                    for (int n = 0; n < 2; ++n) *(f32x4*)(rowp + bj * HALF + n * 16) = acc[ai][bj][m][n]; }
    }
};
__device__ __forceinline__ float silu_f(float x) { return x / (1.0f + __expf(-x)); }
struct EpiSwiGLU {
    static constexpr bool PERM = true, AFTER_DRAIN = false;
    bf16_t* H; int ldh; const float* comb; int ldcomb;
    __device__ __forceinline__ void operator()(const f32x4 (&acc)[2][2][4][2], const Unit& u, int wr, int wc, int fr, int fq) const {
        const int row0 = u.pm * BM + wr * 64 + fr, col0 = u.pn * 128 + wc * 32 + 8 * fq, e = u.pn >> 1;
#pragma unroll
        for (int ai = 0; ai < 2; ++ai)
#pragma unroll
            for (int m = 0; m < 4; ++m) { const int row = row0 + ai * HALF + m * 16; const float cw = comb[(size_t)row * ldcomb + e];
                const f32x4 g0 = acc[ai][0][m][0], g1 = acc[ai][0][m][1], u0 = acc[ai][1][m][0], u1 = acc[ai][1][m][1];
                f32x4 h0, h1;
#pragma unroll
                for (int j = 0; j < 4; ++j) { h0[j] = silu_f(g0[j]) * u0[j] * cw; h1[j] = silu_f(g1[j]) * u1[j] * cw; }
                u32x4 w; w.x = cvt_pk_bf16(h0[0], h0[1]); w.y = cvt_pk_bf16(h0[2], h0[3]); w.z = cvt_pk_bf16(h1[0], h1[1]); w.w = cvt_pk_bf16(h1[2], h1[3]);
                *(u32x4*)(H + (size_t)row * ldh + col0) = w; }
    }
};
template <class Epi, class Sched, bool ALIGN_EPI = false, bool SP2 = false>
__device__ __forceinline__ void gemm_phase(PG8_LAS unsigned char* lds, const Gemm g, const Sched& S, const Epi& E) {
    int tid_ = threadIdx.x; asm volatile("" : "+v"(tid_));
    const int tid = tid_, wid = __builtin_amdgcn_readfirstlane(tid >> 6), lane = tid & 63, wr = wid >> 2, wc = wid & 3, fr = lane & 15, fq = lane >> 4;
    const int K = g.K, nt = K / BK;
    unsigned voffA[2], voffB[2];
#pragma unroll
    for (int i = 0; i < 2; ++i) { int R, C; stage_rc(tid * 16 + i * 8192, R, C); const int Rb = Epi::PERM ? ((R & ~31) + perm32(R & 31)) : R;
        voffA[i] = (unsigned)(R * K + C) * 2u; voffB[i] = (unsigned)(Rb * K + C) * 2u; }
    const size_t kstep = (size_t)(BK * 2);
    const size_t hstep = (size_t)HALF * K * 2;
    const size_t tstep = 2 * hstep;
    const unsigned ldsw = (unsigned)wid * 1024u;
    const int aoff = lds_byte(wr * 64 + fr, fq * 8), boff = lds_byte(wc * 32 + fr, fq * 8);
#define PG8_SA(b, h) (((b) * 2 + (h)) * HTB)
#define PG8_SB(b, h) ((4 + (b) * 2 + (h)) * HTB)
#define PG8_STAGE(bufoff, gbase, voff) do { _Pragma("unroll") for (int _i = 0; _i < 2; ++_i) \
        __builtin_amdgcn_global_load_lds((const unsigned*)((const char*)(gbase) + (voff)[_i]), (PG8_LAS unsigned*)(lds + (bufoff) + ldsw + _i * 8192), 16, 0, 0); } while (0)
#define PG8_LDA(dst, b, h) do { _Pragma("unroll") for (int m = 0; m < 4; ++m) _Pragma("unroll") for (int k = 0; k < 2; ++k) dst[m][k] = *(const PG8_LAS bf16x8*)(lds + PG8_SA(b, h) + aoff + m * 2048 + k * 1024); } while (0)
#define PG8_LDB(dst, b, h) do { _Pragma("unroll") for (int n = 0; n < 2; ++n) _Pragma("unroll") for (int k = 0; k < 2; ++k) dst[n][k] = *(const PG8_LAS bf16x8*)(lds + PG8_SB(b, h) + boff + n * 2048 + k * 1024); } while (0)
#define PG8_MMA(ai, bj, At, Bt) do { __builtin_amdgcn_s_setprio(1); _Pragma("unroll") for (int m = 0; m < 4; ++m) _Pragma("unroll") for (int n = 0; n < 2; ++n) _Pragma("unroll") for (int k = 0; k < 2; ++k) \
        acc[ai][bj][m][n] = __builtin_amdgcn_mfma_f32_16x16x32_bf16(Bt[n][k], At[m][k], acc[ai][bj][m][n], 0, 0, 0); __builtin_amdgcn_s_setprio(0); } while (0)
#define PG8_WAIT_V(n) asm volatile("s_waitcnt vmcnt(" #n ")" ::: "memory")
#define PG8_WAIT_L(n) asm volatile("s_waitcnt lgkmcnt(" #n ")" ::: "memory")
#define PG8_BAR __builtin_amdgcn_s_barrier()
#define PG8_SCHED __builtin_amdgcn_sched_barrier(0)
    Unit cur, nxt; int ui = 0;
    if (!S.next(0, cur)) return;
    f32x4 acc[2][2][4][2];
#pragma unroll
    for (int a = 0; a < 2; ++a)
#pragma unroll
        for (int b = 0; b < 2; ++b)
#pragma unroll
            for (int m = 0; m < 4; ++m)
#pragma unroll
                for (int n = 0; n < 2; ++n) acc[a][b][m][n] = (f32x4){0.f, 0.f, 0.f, 0.f};
    bf16x8 At[4][2], B0[2][2], B1[2][2];
    const char* cA = (const char*)g.A + (size_t)cur.pm * tstep; const char* cB = (const char*)g.Bt + (size_t)cur.pn * tstep;
    S.a_ready(cur);
    if constexpr (SP2) {
        PG8_STAGE(PG8_SB(0, 0), cB, voffB); PG8_STAGE(PG8_SB(0, 1), cB + hstep, voffB); PG8_STAGE(PG8_SA(0, 0), cA, voffA); PG8_STAGE(PG8_SA(0, 1), cA + hstep, voffA);
        if (wr == 1) PG8_BAR;
        PG8_WAIT_V(2); PG8_BAR;
        PG8_STAGE(PG8_SB(1, 0), cB + kstep, voffB); PG8_STAGE(PG8_SA(1, 0), cA + kstep, voffA); PG8_STAGE(PG8_SB(1, 1), cB + hstep + kstep, voffB);
        PG8_WAIT_V(6); PG8_BAR;
    } else {
        PG8_STAGE(PG8_SB(0, 0), cB, voffB); PG8_STAGE(PG8_SA(0, 0), cA, voffA); PG8_STAGE(PG8_SB(0, 1), cB + hstep, voffB); PG8_STAGE(PG8_SA(0, 1), cA + hstep, voffA);
        if (wr == 1) PG8_BAR;
        PG8_WAIT_V(4); PG8_BAR;
        PG8_STAGE(PG8_SB(1, 0), cB + kstep, voffB); PG8_STAGE(PG8_SA(1, 0), cA + kstep, voffA); PG8_STAGE(PG8_SB(1, 1), cB + hstep + kstep, voffB);
        PG8_WAIT_V(6); PG8_BAR;
    }
    for (;;) {
        const bool has_next = S.next(ui + 1, nxt);
        const char* nA = has_next ? (const char*)g.A + (size_t)nxt.pm * tstep : cA; const char* nB = has_next ? (const char*)g.Bt + (size_t)nxt.pn * tstep : cB;
        for (int t = 0; t < nt; t += 2) {
            const bool last = (t == nt - 2);
            const char* a1 = cA + (size_t)(t + 1) * kstep;
            const char* a2 = last ? nA : cA + (size_t)(t + 2) * kstep; const char* b2 = last ? nB : cB + (size_t)(t + 2) * kstep;
            const char* a3 = a2 + kstep; const char* b3 = b2 + kstep;
            if (last && has_next) S.a_ready(nxt);
            if constexpr (SP2) {
            PG8_LDB(B0, 0, 0); PG8_LDB(B1, 0, 1); PG8_SCHED; PG8_LDA(At, 0, 0); PG8_STAGE(PG8_SA(1, 1), a1 + hstep, voffA);
            PG8_WAIT_V(8); PG8_WAIT_L(0); PG8_BAR; PG8_MMA(0, 0, At, B0); PG8_MMA(0, 1, At, B1); PG8_BAR; PG8_SCHED;
            PG8_LDA(At, 0, 1); PG8_STAGE(PG8_SB(0, 0), b2, voffB); PG8_STAGE(PG8_SB(0, 1), b2 + hstep, voffB); PG8_STAGE(PG8_SA(0, 0), a2, voffA);
            PG8_WAIT_V(8); PG8_WAIT_L(0); PG8_BAR; PG8_MMA(1, 0, At, B0); PG8_MMA(1, 1, At, B1); PG8_BAR; PG8_SCHED;
            PG8_LDB(B0, 1, 0); PG8_LDB(B1, 1, 1); PG8_SCHED; PG8_LDA(At, 1, 0); PG8_STAGE(PG8_SA(0, 1), a2 + hstep, voffA);
            PG8_WAIT_V(8); PG8_WAIT_L(0); PG8_BAR; PG8_MMA(0, 0, At, B0); PG8_MMA(0, 1, At, B1); PG8_BAR; PG8_SCHED;
            PG8_LDA(At, 1, 1); PG8_STAGE(PG8_SB(1, 0), b3, voffB); PG8_STAGE(PG8_SB(1, 1), b3 + hstep, voffB); PG8_STAGE(PG8_SA(1, 0), a3, voffA);
            PG8_WAIT_V(8); PG8_WAIT_L(0); PG8_BAR; PG8_MMA(1, 0, At, B0); PG8_MMA(1, 1, At, B1); PG8_BAR; PG8_SCHED;
            } else {
            PG8_LDB(B0, 0, 0); PG8_SCHED; PG8_LDA(At, 0, 0); PG8_STAGE(PG8_SA(1, 1), a1 + hstep, voffA);
            PG8_WAIT_L(8); PG8_BAR; PG8_WAIT_L(0); PG8_MMA(0, 0, At, B0); PG8_BAR; PG8_SCHED;
            PG8_LDB(B1, 0, 1); PG8_STAGE(PG8_SB(0, 0), b2, voffB);
            PG8_BAR; PG8_WAIT_L(0); PG8_MMA(0, 1, At, B1); PG8_BAR;
            PG8_LDA(At, 0, 1); PG8_STAGE(PG8_SA(0, 0), a2, voffA);
            PG8_BAR; PG8_WAIT_L(0); PG8_MMA(1, 0, At, B0); PG8_BAR; PG8_SCHED;
            PG8_STAGE(PG8_SB(0, 1), b2 + hstep, voffB);
            PG8_WAIT_V(6); PG8_BAR; PG8_MMA(1, 1, At, B1); PG8_BAR;
            PG8_LDB(B0, 1, 0); PG8_SCHED; PG8_LDA(At, 1, 0); PG8_STAGE(PG8_SA(0, 1), a2 + hstep, voffA);
            PG8_WAIT_L(8); PG8_BAR; PG8_WAIT_L(0); PG8_MMA(0, 0, At, B0); PG8_BAR; PG8_SCHED;
            PG8_LDB(B1, 1, 1); PG8_STAGE(PG8_SB(1, 0), b3, voffB);
            PG8_BAR; PG8_WAIT_L(0); PG8_MMA(0, 1, At, B1); PG8_BAR;
            PG8_LDA(At, 1, 1); PG8_STAGE(PG8_SA(1, 0), a3, voffA);
            PG8_BAR; PG8_WAIT_L(0); PG8_MMA(1, 0, At, B0); PG8_BAR; PG8_SCHED;
            PG8_STAGE(PG8_SB(1, 1), b3 + hstep, voffB);
            PG8_WAIT_V(6); PG8_BAR; PG8_MMA(1, 1, At, B1); PG8_BAR;
            }
        }
        if constexpr (ALIGN_EPI) { if (wr == 0) PG8_BAR; }
        if constexpr (!Epi::AFTER_DRAIN) { E(acc, cur, wr, wc, fr, fq); S.done(cur); }
        if (!has_next) break;
#pragma unroll
        for (int a = 0; a < 2; ++a)
#pragma unroll
            for (int b = 0; b < 2; ++b)
#pragma unroll
                for (int m = 0; m < 4; ++m)
#pragma unroll
                    for (int n = 0; n < 2; ++n) acc[a][b][m][n] = (f32x4){0.f, 0.f, 0.f, 0.f};
        cur = nxt; cA = nA; cB = nB; ++ui;
        if constexpr (ALIGN_EPI) { if (wr == 1) PG8_BAR; }
    }
    PG8_WAIT_V(0);
    if constexpr (!ALIGN_EPI) { if (wr == 0) PG8_BAR; }
    PG8_BAR;
    if constexpr (Epi::AFTER_DRAIN) { E.fused(acc, cur, wr, wc, fr, fq, lds, wid, lane); S.done(cur); }
#undef PG8_SA
#undef PG8_SB
#undef PG8_STAGE
#undef PG8_LDA
#undef PG8_LDB
#undef PG8_MMA
#undef PG8_WAIT_V
#undef PG8_WAIT_L
#undef PG8_BAR
#undef PG8_SCHED
}
}
#define GAS __attribute__((address_space(1)))
#define LAS __attribute__((address_space(3)))
typedef unsigned short bf16;
typedef unsigned v4u __attribute__((ext_vector_type(4)));
typedef float f32x4 __attribute__((ext_vector_type(4)));
typedef short bf16x8 __attribute__((ext_vector_type(8)));
typedef GAS unsigned gu32;
typedef GAS unsigned long long gu64;
#define RLX_AGENT __ATOMIC_RELAXED, __HIP_MEMORY_SCOPE_AGENT
#define LDS_WAIT() asm volatile("s_waitcnt lgkmcnt(0)" ::: "memory")
#define VM_WAIT() asm volatile("s_waitcnt vmcnt(0)" ::: "memory")
__device__ __forceinline__ unsigned long long rt() { return __builtin_amdgcn_s_memrealtime(); }
__device__ __forceinline__ unsigned f2bf(float f) { unsigned u = __builtin_bit_cast(unsigned, f); return (u + 0x7fffu + ((u >> 16) & 1u)) >> 16; }
__device__ __forceinline__ unsigned pk2(float lo, float hi) { return f2bf(lo) | (f2bf(hi) << 16); }

#define XB_TMO      128
#define XB_XCNT(j)  (256  + 64 * (j))
#define XB_XSUB(j)  (1280 + 64 * (j))
#define XB_XGEN(j)  (2304 + 64 * (j))
#define XB_TOP      3328
#define XB_TOPGEN   3392
#define XCD_BAR_WORDS 3456
#define XB_SPIN_CAP (1u << 18)

__device__ __forceinline__ unsigned xb_ld(unsigned* p)              { return __hip_atomic_load(p, __ATOMIC_RELAXED, __HIP_MEMORY_SCOPE_AGENT); }
__device__ __forceinline__ unsigned xb_add(unsigned* p, unsigned v) { return __hip_atomic_fetch_add(p, v, __ATOMIC_RELAXED, __HIP_MEMORY_SCOPE_AGENT); }
__device__ __forceinline__ unsigned xb_xcc_id() { return (unsigned)__builtin_amdgcn_s_getreg((3 << 11) | 20) & 0xFu; }
#define XB_SPIN(cond, bar) do { unsigned _sp = 0; while (cond) { __builtin_amdgcn_s_sleep(1); \
    if ((++_sp & 255u) == 0u) { if (xb_ld(&(bar)[XB_TMO])) break; if (_sp > XB_SPIN_CAP) { atomicAdd(&(bar)[XB_TMO], 1u); break; } } } } while (0)

struct XcdBarrier {
    unsigned* bar; unsigned x;
    volatile LAS unsigned* st;
};

__device__ __forceinline__ XcdBarrier xcd_barrier_post(unsigned* bar, volatile LAS unsigned* st) {
    XcdBarrier b; b.bar = bar; b.x = xb_xcc_id(); b.st = st;
    if (threadIdx.x == 0) (void)xb_add(&bar[XB_XCNT(b.x)], 1u);
    return b;
}
__device__ __forceinline__ void xcd_barrier_complete(unsigned* bar, unsigned x, unsigned& nloc, unsigned& nx) {
    const unsigned G = gridDim.x * gridDim.y * gridDim.z;
    unsigned sum, cnt, mine, sp = 0u;
    for (;;) {
        sum = 0u; cnt = 0u; mine = 0u;
#pragma unroll
        for (unsigned j = 0; j < 16; ++j) { const unsigned c = xb_ld(&bar[XB_XCNT(j)]); sum += c; cnt += (c > 0u) ? 1u : 0u; mine = (j == x) ? c : mine; }
        if (sum == G) break;
        __builtin_amdgcn_s_sleep(1);
        if ((++sp & 255u) == 0u) { if (xb_ld(&bar[XB_TMO])) break; if (sp > XB_SPIN_CAP) { atomicAdd(&bar[XB_TMO], 1u); break; } }
    }
    nloc = mine > 0u ? mine : 1u; nx = cnt > 0u ? cnt : 1u;
}

__device__ __forceinline__ void xcd_barrier(const XcdBarrier& b) {
    asm volatile("s_waitcnt vmcnt(0)" ::: "memory");
    __syncthreads();
    if (threadIdx.x == 0) {
        unsigned* bar = b.bar;
        __builtin_amdgcn_s_waitcnt(0);
        unsigned nloc = b.st[0], nx = b.st[1];
        if (nloc == 0u) { xcd_barrier_complete(bar, b.x, nloc, nx); b.st[0] = nloc; b.st[1] = nx; }
        const unsigned old = xb_add(&bar[XB_XSUB(b.x)], 1u);
        const unsigned gen = old / nloc;
        if (old + 1u == (gen + 1u) * nloc) {
            __builtin_amdgcn_fence(__ATOMIC_RELEASE, "agent");
            asm volatile("s_waitcnt vmcnt(0)" ::: "memory");
            const unsigned og = xb_add(&bar[XB_TOP], 1u);
            const unsigned tg = og / nx;
            if (og + 1u == (tg + 1u) * nx) xb_add(&bar[XB_TOPGEN], 1u);
            else XB_SPIN(xb_ld(&bar[XB_TOPGEN]) == tg, bar);
            __builtin_amdgcn_fence(__ATOMIC_ACQUIRE, "agent");
            xb_add(&bar[XB_XGEN(b.x)], 1u);
            asm volatile("s_waitcnt vmcnt(0)" ::: "memory");
        } else {
            XB_SPIN(xb_ld(&bar[XB_XGEN(b.x)]) == gen, bar);
            __builtin_amdgcn_fence(__ATOMIC_ACQUIRE, "agent");
            asm volatile("s_waitcnt vmcnt(0)" ::: "memory");
        }
    }
    __syncthreads();
}
constexpr int NWAVES = 8, NTHR = NWAVES * 64;
constexpr int D = 1024, BATCH = 4, SEQ = 4096, M = BATCH * SEQ, DEPTH = 4;
constexpr int IN_COLS = 6680, NPROJ = 6912;
constexpr int O_Z = 0, O_XBC = 1024, O_DT = 2560, O_QKV = 2576, O_GG = 4112, O_GB = 4624, O_GA = 4628, O_HQ = 4632, O_HF = 5144, O_HI = 5656, O_HG = 6168;
constexpr int DMIX = 2048, NEXP = 16, DEXP = 256, NGU = NEXP * 2 * DEXP  , KDN = NEXP * DEXP  ;
constexpr float DN_ALPHA = 1.6817928305074290f;
constexpr float LN_EPS = 1e-5f;

constexpr size_t MiB = 1u << 20;
constexpr size_t WS_CTL = 0, CTL_ZERO_BYTES = 1 * MiB;
constexpr size_t WS_COMB = 1 * MiB;
constexpr size_t WS_WIN = 8 * MiB;
constexpr size_t WS_WOUT = 22 * MiB;
constexpr size_t WS_WGU = 26 * MiB;
constexpr size_t WS_WDN = 42 * MiB;
constexpr size_t WS_YMIX = 52 * MiB;
constexpr size_t WS_HB = WS_YMIX;
constexpr size_t WS_PROJ = 116 * MiB;
constexpr size_t WS_MIX = WS_PROJ;
constexpr size_t WS_H = WS_PROJ + 64 * MiB;
constexpr size_t WS_SCR = 332 * MiB;
constexpr size_t WS_HG_QG = WS_SCR;
constexpr size_t WS_HG_KDT = WS_SCR + 16 * MiB;
constexpr size_t WS_HG_A = WS_SCR + 32 * MiB;
constexpr size_t WS_HG_GL = WS_SCR + 40 * MiB;
constexpr size_t WS_SSD_C = WS_SCR + 41 * MiB;
constexpr size_t WS_SSD_BT = WS_SCR + 49 * MiB;
constexpr size_t WS_SSD_CB = WS_SCR + 57 * MiB;
constexpr size_t WS_SSD_XT = WS_SCR + 65 * MiB;
constexpr size_t WS_SSD_AC = WS_SCR + 97 * MiB;
constexpr size_t WS_SSD_DT = WS_SCR + 98 * MiB;
constexpr size_t WS_GD_K = WS_SCR + 99 * MiB;
constexpr size_t WS_GD_KT = WS_SCR + 115 * MiB;
constexpr size_t WS_GD_QG = WS_SCR + 131 * MiB;
constexpr size_t WS_GD_VT = WS_SCR + 147 * MiB;
constexpr size_t WS_GD_T = WS_SCR + 163 * MiB;
constexpr size_t WS_GD_QK = WS_SCR + 171 * MiB;
constexpr size_t WS_GD_VEC = WS_SCR + 179 * MiB;
constexpr size_t WS_END = 512 * MiB;
constexpr int CW_BAR = 4096;

constexpr int RING_OFF = 0, RING_BYTES = 131072;
constexpr int LDSCTL_OFF = RING_BYTES, MISC_OFF = LDSCTL_OFF + 320;
constexpr int LDS_BYTES = 147456;

__device__ __forceinline__ float bf2f(unsigned short b) { return __builtin_bit_cast(float, ((unsigned)b) << 16); }
__device__ __forceinline__ float bflo(unsigned w) { return __builtin_bit_cast(float, w << 16); }
__device__ __forceinline__ float bfhi(unsigned w) { return __builtin_bit_cast(float, w & 0xffff0000u); }
__device__ __forceinline__ float siluf(float x) { return x / (1.0f + __expf(-x)); }
__device__ __forceinline__ float sigmoidf_(float x) { return 1.0f / (1.0f + __expf(-x)); }
__device__ __forceinline__ float softplusf_(float x) { return x > 20.f ? x : log1pf(__expf(x)); }
__device__ __forceinline__ float wave_sum(float v) {
#pragma unroll
    for (int o = 1; o < 64; o <<= 1) v += __shfl_xor(v, o);
    return v;
}

struct Args {
    const float* in[25]; float* out; unsigned char* ws; int ph_lo, ph_hi;
};
typedef const __attribute__((address_space(4))) Args* CArgs;
#define ARGS_HERE() ([]() { CArgs p_ = (CArgs)__builtin_amdgcn_kernarg_segment_ptr(); asm volatile("" : "+s"(p_)); return p_; }())
enum { I_X = 0, I_WIN, I_SCW, I_SCB, I_SDTB, I_SALOG, I_SD, I_SNW, I_GCW, I_GDTB, I_GALOG, I_GNW, I_HLB, I_HNW, I_WOUT, I_LN1G, I_LN1B, I_WRG, I_BRG, I_WRE, I_BRE, I_WGU, I_WDN, I_LN2G, I_LN2B };

__device__ __forceinline__ void transpose_item(const float* W, int ldw, int nvalid, int k0, int n0, bf16* WT, size_t ldt, int drow0, int dk0, LAS float* scr, int lane) {
#pragma unroll 8
    for (int i = 0; i < 32; ++i) { const int kk = 2 * i + (lane >> 5), nn = lane & 31, n = n0 + nn; scr[kk * 33 + nn] = (n < nvalid) ? W[(size_t)(k0 + kk) * ldw + n] : 0.f; }
    LDS_WAIT(); asm volatile("" ::: "memory");
    const int c = lane & 7;
#pragma unroll
    for (int j = 0; j < 4; ++j) { const int n = (lane >> 3) + 8 * j; const LAS float* s = scr + (8 * c) * 33 + n;
        v4u o; o.x = pk2(s[0 * 33], s[1 * 33]); o.y = pk2(s[2 * 33], s[3 * 33]); o.z = pk2(s[4 * 33], s[5 * 33]); o.w = pk2(s[6 * 33], s[7 * 33]);
        *(GAS v4u*)(WT + (size_t)(drow0 + n) * ldt + dk0 + k0 + 8 * c) = o; }
    LDS_WAIT(); asm volatile("" ::: "memory");
}
__device__ __forceinline__ void weights_phase(CArgs a, int l, LAS unsigned char* lds, int wg, int G, int tid) {
    asm volatile("" : "+v"(tid));
    const int lane = tid & 63, wave = tid >> 6;
    LAS float* scr = (LAS float*)(lds + wave * 16384);
    const int gw = wg * NWAVES + wave, NGW = G * NWAVES;
    constexpr int I_IN = 16 * (NPROJ / 32), I_OUT = (DMIX / 64) * (D / 32), I_GU = NEXP * 16 * 16, I_DN = NEXP * 4 * 32, I_LAYER = I_IN + I_OUT + I_GU + I_DN;
    unsigned char* ws = a->ws;
    for (int it = gw; it < I_LAYER; it += NGW) {
        int r = it;
        if (r < I_IN) { const int kb = r / (NPROJ / 32), nb = r % (NPROJ / 32);
            transpose_item(a->in[I_WIN] + (size_t)l * D * IN_COLS, IN_COLS, IN_COLS, 64 * kb, 32 * nb, (bf16*)(ws + WS_WIN), D, 32 * nb, 0, scr, lane); continue; }
        r -= I_IN;
        if (r < I_OUT) { const int kb = r / (D / 32), nb = r % (D / 32);
            transpose_item(a->in[I_WOUT] + (size_t)l * DMIX * D, D, D, 64 * kb, 32 * nb, (bf16*)(ws + WS_WOUT), DMIX, 32 * nb, 0, scr, lane); continue; }
        r -= I_OUT;
        if (r < I_GU) { const int e = r / 256, q = r % 256, kb = q / 16, nb = q % 16, c0 = 32 * nb, bj = c0 / 256, hf = (c0 % 256) / 128, j0 = c0 % 128;
            transpose_item(a->in[I_WGU] + (size_t)(l * NEXP + e) * D * 512, 512, 512, 64 * kb, c0, (bf16*)(ws + WS_WGU), D, e * 512 + hf * 256 + bj * 128 + j0, 0, scr, lane); continue; }
        r -= I_GU;
        { const int e = r / 128, q = r % 128, kb = q / 32, nb = q % 32;
            transpose_item(a->in[I_WDN] + (size_t)(l * NEXP + e) * DEXP * D, D, D, 64 * kb, 32 * nb, (bf16*)(ws + WS_WDN), KDN, 32 * nb, e * DEXP, scr, lane); }
    }
}
__device__ __forceinline__ void p0_prologue(CArgs a, LAS unsigned char* lds, int wg, int G, int tid) {
    asm volatile("" : "+v"(tid));
    const f32x4* x4 = (const f32x4*)a->in[I_X]; f32x4* h4 = (f32x4*)a->out; unsigned long long* hb8 = (unsigned long long*)(a->ws + WS_HB);
    for (size_t i = (size_t)wg * NTHR + tid; i < (size_t)M * D / 4; i += (size_t)G * NTHR) { const f32x4 v = x4[i]; h4[i] = v;
        hb8[i] = (unsigned long long)pk2(v.x, v.y) | ((unsigned long long)pk2(v.z, v.w) << 32); }
}

__device__ __forceinline__ f32x4 mfma16(bf16x8 x, bf16x8 y, f32x4 c) { return __builtin_amdgcn_mfma_f32_16x16x32_bf16(x, y, c, 0, 0, 0); }
__device__ __forceinline__ bf16x8 lds_frag(const LAS bf16* base, int row0, int stride, int k0, int lane) { return *(const LAS bf16x8*)(base + (row0 + (lane & 15)) * stride + k0 + 8 * (lane >> 4)); }
__device__ __forceinline__ bf16x8 pack8(const float* v) { v4u w; w.x = pk2(v[0], v[1]); w.y = pk2(v[2], v[3]); w.z = pk2(v[4], v[5]); w.w = pk2(v[6], v[7]); return __builtin_bit_cast(bf16x8, w); }
__device__ __forceinline__ unsigned long long pack4(f32x4 v) { return (unsigned long long)pk2(v[0], v[1]) | ((unsigned long long)pk2(v[2], v[3]) << 32); }

__device__ __forceinline__ void hgrn_prep_phase(CArgs a, int l, LAS unsigned char* lds, int wg, int G, int tid) {
    asm volatile("" : "+v"(tid));
    constexpr int LS = 132;
    LAS float* sQ = (LAS float*)lds; LAS float* sK = sQ + 64 * LS; LAS float* sB = sK + 64 * LS; LAS float* sT = sB + 64 * LS; LAS float* sLb = sT + 512;
    const bf16* PROJ = (const bf16*)(a->ws + WS_PROJ);
    const int lane = tid & 63, w = tid >> 6, r = lane & 15, q4 = lane >> 4;
    for (int unit = wg; unit < 1024; unit += G) {
        const int b = unit >> 8, head = (unit >> 6) & 3, c = unit & 63;
        const size_t row0 = (size_t)b * SEQ + c * 64;
        __syncthreads();
        if (tid < 128) {
            const int ch = head * 128 + tid; float lg[DEPTH], mx = -1e30f;
#pragma unroll
            for (int j = 0; j < DEPTH; ++j) { lg[j] = a->in[I_HLB][j * 512 + ch]; mx = fmaxf(mx, lg[j]); }
            float den = 0.f, num = 0.f;
#pragma unroll
            for (int j = 0; j < DEPTH; ++j) { const float e = __expf(lg[j] - mx); den += e; if (j >= 1 && j <= l) num += e; }
            sLb[tid] = num / den;
        }
        __syncthreads();
        for (int p = tid; p < 1024; p += NTHR) {
            const int t = p >> 4, d8 = (p & 15) * 8;
            const v4u qv = *(const GAS v4u*)(PROJ + (row0 + t) * NPROJ + O_HQ + head * 128 + d8), fv = *(const GAS v4u*)(PROJ + (row0 + t) * NPROJ + O_HF + head * 128 + d8);
#pragma unroll
            for (int i = 0; i < 4; ++i) {
                const int d = d8 + 2 * i; const float lb0 = sLb[d], lb1 = sLb[d + 1];
                sQ[t * LS + d] = siluf(bflo(qv[i])); sQ[t * LS + d + 1] = siluf(bfhi(qv[i]));
                const float f0 = lb0 + (1.f - lb0) * sigmoidf_(bflo(fv[i])), f1 = lb1 + (1.f - lb1) * sigmoidf_(bfhi(fv[i]));
                sK[t * LS + d] = 1.f - f0; sK[t * LS + d + 1] = 1.f - f1; sB[t * LS + d] = __logf(f0); sB[t * LS + d + 1] = __logf(f1);
            }
        }
        __syncthreads();
        {
            const int d = tid & 127, seg = tid >> 7; float run = 0.f, vals[16];
#pragma unroll
            for (int i = 0; i < 16; ++i) { run += sB[(seg * 16 + i) * LS + d]; vals[i] = run; }
            sT[seg * 128 + d] = run;
            __syncthreads();
            float off = 0.f;
#pragma unroll
            for (int s2 = 0; s2 < 3; ++s2) if (s2 < seg) off += sT[s2 * 128 + d];
#pragma unroll
            for (int i = 0; i < 16; ++i) sB[(seg * 16 + i) * LS + d] = vals[i] + off;
        }
        __syncthreads();
        bf16* qg = (bf16*)(a->ws + WS_HG_QG) + (size_t)unit * 64 * 128; bf16* kdt = (bf16*)(a->ws + WS_HG_KDT) + (size_t)unit * 128 * 64;
        bf16* am = (bf16*)(a->ws + WS_HG_A) + (size_t)unit * 64 * 64; float* gl = (float*)(a->ws + WS_HG_GL) + (size_t)unit * 128;
        for (int p = tid; p < 1024; p += NTHR) { const int t = p >> 4, d8 = (p & 15) * 8; float v[8];
#pragma unroll
            for (int jj = 0; jj < 8; ++jj) v[jj] = sQ[t * LS + d8 + jj] * __expf(sB[t * LS + d8 + jj]);
            *(GAS bf16x8*)(qg + t * 128 + d8) = pack8(v); }
        for (int p = tid; p < 1024; p += NTHR) { const int d = p >> 3, s8 = (p & 7) * 8; const float bl = sB[63 * LS + d]; float v[8];
#pragma unroll
            for (int jj = 0; jj < 8; ++jj) v[jj] = sK[(s8 + jj) * LS + d] * __expf(bl - sB[(s8 + jj) * LS + d]);
            *(GAS bf16x8*)(kdt + d * 64 + s8) = pack8(v); }
        if (tid < 128) gl[tid] = __expf(sB[63 * LS + tid]);
        for (int p = w; p < 16; p += NWAVES) {
            const int i = p >> 2, j = p & 3; f32x4 acc = {0.f, 0.f, 0.f, 0.f};
            if (j <= i) {
#pragma unroll
                for (int ks = 0; ks < 4; ++ks) { const int d0 = 32 * ks + 8 * q4, t = 16 * i + r, s_ = 16 * j + r; float qf[8], kf[8];
#pragma unroll
                    for (int jj = 0; jj < 8; ++jj) { const float ref = i ? sB[(16 * i - 1) * LS + d0 + jj] : 0.f;
                        qf[jj] = sQ[t * LS + d0 + jj] * __expf(sB[t * LS + d0 + jj] - ref); kf[jj] = sK[s_ * LS + d0 + jj] * __expf(ref - sB[s_ * LS + d0 + jj]); }
                    acc = mfma16(pack8(kf), pack8(qf), acc); }
                const int t = 16 * i + r;
#pragma unroll
                for (int ii = 0; ii < 4; ++ii) if (16 * j + 4 * q4 + ii > t) acc[ii] = 0.f;
            }
            *(GAS unsigned long long*)(am + (16 * i + r) * 64 + 16 * j + 4 * q4) = pack4(acc);
        }
    }
}
__device__ __forceinline__ void hgrn_scan_phase(CArgs a, int l, LAS unsigned char* lds, int wg, int G, int tid) {
    asm volatile("" : "+v"(tid));
    constexpr int QS = 136, KS = 72;
    constexpr int B_QG = 0, B_KDT = 17408, B_A = B_KDT + 18432, B_VT = B_A + 9216, B_GL = B_VT + 4608, BUF = B_GL + 512;
    LAS unsigned char* sST0 = lds + 2 * BUF;
    const bf16* PROJ = (const bf16*)(a->ws + WS_PROJ); bf16* YMIX = (bf16*)(a->ws + WS_YMIX);
    const int lane = tid & 63, w = tid >> 6, r = lane & 15, q4 = lane >> 4;
    for (int unit = wg; unit < 64; unit += G) {
        const int b = unit >> 4, head = (unit >> 2) & 3, eb = unit & 3;
        const size_t cu0 = (size_t)(b * 4 + head) * 64;
        const bf16* QG = (const bf16*)(a->ws + WS_HG_QG) + cu0 * 64 * 128; const bf16* KDT = (const bf16*)(a->ws + WS_HG_KDT) + cu0 * 128 * 64;
        const bf16* AM = (const bf16*)(a->ws + WS_HG_A) + cu0 * 64 * 64; const float* GL = (const float*)(a->ws + WS_HG_GL) + cu0 * 128;
        const bf16* VP = PROJ + (size_t)b * SEQ * NPROJ + O_HI + head * 128 + eb * 32;
        v4u rq[2], rk[2], ra, rv; f32x4 rg;
#define HG_LOAD(n) do { _Pragma("unroll") for (int i = 0; i < 2; ++i) { const int p = tid + NTHR * i; rq[i] = *(const GAS v4u*)(QG + (size_t)(n) * 8192 + (p >> 4) * 128 + (p & 15) * 8); \
            rk[i] = *(const GAS v4u*)(KDT + (size_t)(n) * 8192 + (p >> 3) * 64 + (p & 7) * 8); } \
            ra = *(const GAS v4u*)(AM + (size_t)(n) * 4096 + (tid >> 3) * 64 + (tid & 7) * 8); \
            if (tid < 256) rv = *(const GAS v4u*)(VP + (size_t)((n) * 64 + (tid >> 2)) * NPROJ + (tid & 3) * 8); \
            if (tid < 32) rg = *(const GAS f32x4*)(GL + (size_t)(n) * 128 + tid * 4); } while (0)
#define HG_STORE(bufp) do { LAS unsigned char* bp_ = (bufp); _Pragma("unroll") for (int i = 0; i < 2; ++i) { const int p = tid + NTHR * i; \
            *(LAS v4u*)(bp_ + B_QG + ((p >> 4) * QS + (p & 15) * 8) * 2) = rq[i]; *(LAS v4u*)(bp_ + B_KDT + ((p >> 3) * KS + (p & 7) * 8) * 2) = rk[i]; } \
            *(LAS v4u*)(bp_ + B_A + ((tid >> 3) * KS + (tid & 7) * 8) * 2) = ra; \
            if (tid < 256) { LAS bf16* vt = (LAS bf16*)(bp_ + B_VT); const int t_ = tid >> 2, e8 = (tid & 3) * 8; _Pragma("unroll") for (int i = 0; i < 4; ++i) { \
                vt[(e8 + 2 * i) * KS + t_] = (bf16)(rv[i] & 0xffffu); vt[(e8 + 2 * i + 1) * KS + t_] = (bf16)(rv[i] >> 16); } } \
            if (tid < 32) *(LAS f32x4*)(bp_ + B_GL + tid * 16) = rg; } while (0)
        __syncthreads();
        HG_LOAD(0);
        for (int i = tid; i < 8704 / 4; i += NTHR) ((LAS unsigned*)sST0)[i] = 0u;
        HG_STORE(lds);
        f32x4 accS[2] = {{0.f, 0.f, 0.f, 0.f}, {0.f, 0.f, 0.f, 0.f}};
        __syncthreads();
        for (int n = 0; n < 64; ++n) {
            const int cur = n & 1; LAS unsigned char* bp = lds + cur * BUF; LAS bf16* sST = (LAS bf16*)(sST0 + cur * 8704); LAS bf16* sSTn = (LAS bf16*)(sST0 + (cur ^ 1) * 8704);
            if (n + 1 < 64) HG_LOAD(n + 1);
            {
                const int tt = w >> 1, et = w & 1; f32x4 acc = {0.f, 0.f, 0.f, 0.f};
#pragma unroll
                for (int ks = 0; ks < 4; ++ks) acc = mfma16(lds_frag(sST, 16 * et, QS, 32 * ks, lane), lds_frag((LAS bf16*)(bp + B_QG), 16 * tt, QS, 32 * ks, lane), acc);
#pragma unroll
                for (int ks = 0; ks < 2; ++ks) acc = mfma16(lds_frag((LAS bf16*)(bp + B_VT), 16 * et, KS, 32 * ks, lane), lds_frag((LAS bf16*)(bp + B_A), 16 * tt, KS, 32 * ks, lane), acc);
                *(GAS unsigned long long*)(YMIX + ((size_t)b * SEQ + n * 64 + 16 * tt + r) * DMIX + 1536 + head * 128 + eb * 32 + 16 * et + 4 * q4) = pack4(acc);
            }
            {
                const f32x4 glv = *(const LAS f32x4*)(bp + B_GL + (16 * w + 4 * q4) * 4);
#pragma unroll
                for (int et = 0; et < 2; ++et) { accS[et] = accS[et] * glv;
#pragma unroll
                    for (int ks = 0; ks < 2; ++ks) accS[et] = mfma16(lds_frag((LAS bf16*)(bp + B_KDT), 16 * w, KS, 32 * ks, lane), lds_frag((LAS bf16*)(bp + B_VT), 16 * et, KS, 32 * ks, lane), accS[et]);
                    *(LAS unsigned long long*)(sSTn + (16 * et + r) * QS + 16 * w + 4 * q4) = pack4(accS[et]); }
            }
            if (n + 1 < 64) HG_STORE(lds + (cur ^ 1) * BUF);
            __syncthreads();
        }
#undef HG_LOAD
#undef HG_STORE
    }
}

__device__ __forceinline__ void ssd_rec_phase(CArgs a, int l, LAS unsigned char* lds, int wg, int G, int tid) {
    asm volatile("" : "+v"(tid));
    constexpr int TB = 64;
    LAS float* sX = (LAS float*)lds; LAS float* sB = sX + TB * 16; LAS float* sC = sB + TB * 128; LAS float* sDt = sC + TB * 128; LAS float* sDa = sDt + TB; LAS float* sY = sDa + TB;
    const bf16* PROJ = (const bf16*)(a->ws + WS_PROJ); bf16* YMIX = (bf16*)(a->ws + WS_YMIX);
    const float* cw = a->in[I_SCW] + (size_t)l * 4 * 1536; const float* cb = a->in[I_SCB] + (size_t)l * 1536;
    const int p_local = tid >> 5, nq = tid & 31;
    for (int unit = wg; unit < 256; unit += G) {
        const int b = unit >> 6, head = (unit >> 2) & 15, pq = unit & 3, g = head >> 3;
        const float A = -__expf(a->in[I_SALOG][l * 16 + head]), dtb = a->in[I_SDTB][l * 16 + head], Dsk = a->in[I_SD][l * 16 + head];
        float h0 = 0.f, h1 = 0.f, h2 = 0.f, h3 = 0.f;
        for (int t0 = 0; t0 < SEQ; t0 += TB) {
            __syncthreads();
            for (int idx = tid; idx < TB * 272; idx += NTHR) {
                const int tt = idx / 272, ci = idx % 272, t = t0 + tt;
                const int ch = ci < 16 ? head * 64 + pq * 16 + ci : (ci < 144 ? 1024 + g * 128 + (ci - 16) : 1280 + g * 128 + (ci - 144));
                float acc = cb[ch];
#pragma unroll
                for (int k = 0; k < 4; ++k) { const int ts = t - 3 + k; if (ts >= 0) acc += cw[k * 1536 + ch] * bf2f(PROJ[(size_t)(b * SEQ + ts) * NPROJ + O_XBC + ch]); }
                const float v = siluf(acc);
                if (ci < 16) sX[tt * 16 + ci] = v; else if (ci < 144) sB[tt * 128 + ci - 16] = v; else sC[tt * 128 + ci - 144] = v;
            }
            if (tid < TB) { const float raw = bf2f(PROJ[(size_t)(b * SEQ + t0 + tid) * NPROJ + O_DT + head]); const float dt = softplusf_(raw + dtb); sDt[tid] = dt; sDa[tid] = __expf(dt * A); }
            __syncthreads();
#pragma unroll 4
            for (int tt = 0; tt < TB; ++tt) {
                const float xv = sX[tt * 16 + p_local], da = sDa[tt], dx = sDt[tt] * xv;
                const f32x4 Bv = *(const LAS f32x4*)(sB + tt * 128 + nq * 4), Cv = *(const LAS f32x4*)(sC + tt * 128 + nq * 4);
                h0 = da * h0 + dx * Bv.x; h1 = da * h1 + dx * Bv.y; h2 = da * h2 + dx * Bv.z; h3 = da * h3 + dx * Bv.w;
                float part = (Cv.x * h0 + Cv.y * h1) + (Cv.z * h2 + Cv.w * h3);
                part += __shfl_xor(part, 1); part += __shfl_xor(part, 2); part += __shfl_xor(part, 4); part += __shfl_xor(part, 8); part += __shfl_xor(part, 16);
                if (nq == 0) sY[tt * 16 + p_local] = part + Dsk * xv;
            }
            __syncthreads();
            for (int idx = tid; idx < TB * 16; idx += NTHR) { const int tt = idx >> 4, i = idx & 15; YMIX[(size_t)(b * SEQ + t0 + tt) * DMIX + head * 64 + pq * 16 + i] = (bf16)f2bf(sY[idx]); }
        }
    }
}

__device__ __forceinline__ void ssd_prep_phase(CArgs a, int l, LAS unsigned char* lds, int wg, int G, int tid) {
    asm volatile("" : "+v"(tid));
    constexpr int PS = 136;
    LAS bf16* sB = (LAS bf16*)lds; LAS bf16* sC = sB + 128 * PS; LAS bf16* sXT = (LAS bf16*)lds; LAS float* sDt = (LAS float*)(lds + 2 * 128 * PS * 2);
    const bf16* PROJ = (const bf16*)(a->ws + WS_PROJ);
    const float* cw = a->in[I_SCW] + (size_t)l * 4 * 1536; const float* cb = a->in[I_SCB] + (size_t)l * 1536;
    const int lane = tid & 63, w = tid >> 6, r = lane & 15, q4 = lane >> 4;
    for (int unit = wg; unit < 256; unit += G) {
        const int b = unit >> 6, c = (unit >> 1) & 31, g = unit & 1;
        const size_t row0 = (size_t)b * SEQ + c * 128;
        bf16* Cg = (bf16*)(a->ws + WS_SSD_C) + (size_t)unit * 16384; bf16* BTg = (bf16*)(a->ws + WS_SSD_BT) + (size_t)unit * 16384; bf16* CBg = (bf16*)(a->ws + WS_SSD_CB) + (size_t)unit * 16384;
        __syncthreads();
        {
            const int c16 = tid & 31, l0 = tid >> 5; const int ch = (c16 < 16 ? 1024 + g * 128 + c16 * 8 : 1280 + g * 128 + (c16 - 16) * 8);
            float wk[4][8], bias[8];
#pragma unroll
            for (int jj = 0; jj < 8; ++jj) { bias[jj] = cb[ch + jj];
#pragma unroll
                for (int k = 0; k < 4; ++k) wk[k][jj] = cw[k * 1536 + ch + jj]; }
            LAS bf16* dst = (c16 < 16 ? sB : sC) + (c16 & 15) * 8;
#pragma unroll 2
            for (int i = 0; i < 8; ++i) { const int ll = l0 + 16 * i; float acc[8];
#pragma unroll
                for (int jj = 0; jj < 8; ++jj) acc[jj] = bias[jj];
#pragma unroll
                for (int k = 0; k < 4; ++k) { const int ts = c * 128 + ll - 3 + k;
                    if (ts >= 0) { const v4u xv = *(const GAS v4u*)(PROJ + ((size_t)b * SEQ + ts) * NPROJ + O_XBC + ch);
#pragma unroll
                        for (int j = 0; j < 4; ++j) { acc[2 * j] += wk[k][2 * j] * bflo(xv[j]); acc[2 * j + 1] += wk[k][2 * j + 1] * bfhi(xv[j]); } } }
#pragma unroll
                for (int jj = 0; jj < 8; ++jj) acc[jj] = siluf(acc[jj]);
                *(LAS bf16x8*)(dst + ll * PS) = pack8(acc); }
        }
        {
            const int head = g * 8 + w; const float A = -__expf(a->in[I_SALOG][l * 16 + head]), dtb = a->in[I_SDTB][l * 16 + head];
            const int l2 = 2 * lane;
            const float dt0 = softplusf_(bf2f(PROJ[(row0 + l2) * NPROJ + O_DT + head]) + dtb), dt1 = softplusf_(bf2f(PROJ[(row0 + l2 + 1) * NPROJ + O_DT + head]) + dtb);
            const float da1 = dt1 * A; float sc = dt0 * A + da1;
#pragma unroll
            for (int o = 1; o < 64; o <<= 1) { const float t_ = __shfl_up(sc, o); if (lane >= o) sc += t_; }
            sDt[w * 128 + l2] = dt0; sDt[w * 128 + l2 + 1] = dt1;
            const size_t uh = (size_t)((b * 16 + head) * 32 + c) * 128;
            float* AC = (float*)(a->ws + WS_SSD_AC) + uh; float* DT = (float*)(a->ws + WS_SSD_DT) + uh;
            AC[l2] = sc - da1; AC[l2 + 1] = sc; DT[l2] = dt0; DT[l2 + 1] = dt1;
        }
        __syncthreads();
#pragma unroll
        for (int st = 0; st < 8; ++st) {
            f32x4 acc = {0.f, 0.f, 0.f, 0.f};
            if (st <= w) {
#pragma unroll
                for (int ks = 0; ks < 4; ++ks) acc = mfma16(lds_frag(sB, 16 * st, PS, 32 * ks, lane), lds_frag(sC, 16 * w, PS, 32 * ks, lane), acc); }
            *(GAS unsigned long long*)(CBg + (16 * w + r) * 128 + 16 * st + 4 * q4) = pack4(acc);
        }
        for (int p = tid; p < 2048; p += NTHR) { const int ll = p >> 4, n8 = (p & 15) * 8; *(GAS v4u*)(Cg + ll * 128 + n8) = *(const LAS v4u*)(sC + ll * PS + n8); }
        for (int p = tid; p < 2048; p += NTHR) { const int n = p >> 4, l8 = (p & 15) * 8; v4u o;
#pragma unroll
            for (int j = 0; j < 4; ++j) o[j] = (unsigned)sB[(l8 + 2 * j) * PS + n] | ((unsigned)sB[(l8 + 2 * j + 1) * PS + n] << 16);
            *(GAS v4u*)(BTg + n * 128 + l8) = o; }
#pragma unroll 1
        for (int hf = 0; hf < 2; ++hf) {
            __syncthreads();
            {   const int cg = tid & 31, l0 = tid >> 5, chl = cg * 8, ch = g * 512 + hf * 256 + chl, hh = hf * 4 + (cg >> 3);
                float wk[4][8], bias[8];
#pragma unroll
                for (int jj = 0; jj < 8; ++jj) { bias[jj] = cb[ch + jj];
#pragma unroll
                    for (int k = 0; k < 4; ++k) wk[k][jj] = cw[k * 1536 + ch + jj]; }
#pragma unroll 2
                for (int i = 0; i < 8; ++i) { const int ll = l0 + 16 * i; float acc[8];
#pragma unroll
                    for (int jj = 0; jj < 8; ++jj) acc[jj] = bias[jj];
#pragma unroll
                    for (int k = 0; k < 4; ++k) { const int ts = c * 128 + ll - 3 + k;
                        if (ts >= 0) { const v4u xv = *(const GAS v4u*)(PROJ + ((size_t)b * SEQ + ts) * NPROJ + O_XBC + ch);
#pragma unroll
                            for (int j = 0; j < 4; ++j) { acc[2 * j] += wk[k][2 * j] * bflo(xv[j]); acc[2 * j + 1] += wk[k][2 * j + 1] * bfhi(xv[j]); } } }
                    const float dtv = sDt[hh * 128 + ll];
#pragma unroll
                    for (int jj = 0; jj < 8; ++jj) sXT[(chl + jj) * PS + ll] = (bf16)f2bf(siluf(acc[jj]) * dtv); }
            }
            __syncthreads();
            for (int p = tid; p < 4096; p += NTHR) { const int chl = p >> 4, l8 = (p & 15) * 8, hh = hf * 4 + (chl >> 6), pp = chl & 63;
                const size_t uh = (size_t)((b * 16 + g * 8 + hh) * 32 + c);
                *(GAS v4u*)((bf16*)(a->ws + WS_SSD_XT) + (uh * 64 + pp) * 128 + l8) = *(const LAS v4u*)(sXT + chl * PS + l8); }
        }
    }
}
__device__ __forceinline__ void ssd_scan_phase(CArgs a, int l, LAS unsigned char* lds, int wg, int G, int tid) {
    asm volatile("" : "+v"(tid));
    constexpr int PS = 136, O_S = 0, O_X = 34816, O_AC = 69632, O_TE = 70656, O_DT = 71680;
    bf16* YMIX = (bf16*)(a->ws + WS_YMIX);
    const int lane = tid & 63, w = tid >> 6, r = lane & 15, q4 = lane >> 4;
    for (int unit = wg; unit < 64; unit += G) {
        const int b = unit >> 4, head = unit & 15, g = head >> 3;
        const float Dsk = a->in[I_SD][l * 16 + head];
        const bf16* Cg = (const bf16*)(a->ws + WS_SSD_C) + (size_t)((b * 32) * 2 + g) * 16384 + (16 * w + r) * 128 + 8 * q4;
        const bf16* CBg = (const bf16*)(a->ws + WS_SSD_CB) + (size_t)((b * 32) * 2 + g) * 16384 + (16 * w + r) * 128 + 8 * q4;
        const bf16* BTg = (const bf16*)(a->ws + WS_SSD_BT) + (size_t)((b * 32) * 2 + g) * 16384 + (16 * w + r) * 128 + 8 * q4;
        const size_t uh0 = (size_t)(b * 16 + head) * 32;
        const bf16* XTg = (const bf16*)(a->ws + WS_SSD_XT) + uh0 * 8192; const float* ACg = (const float*)(a->ws + WS_SSD_AC) + uh0 * 128; const float* DTg = (const float*)(a->ws + WS_SSD_DT) + uh0 * 128;
        v4u fC[4], fCB[4], fBT[4], nC[4], nCB[4], nBT[4], rx[2]; float rac = 0.f, racl = 0.f, rdt = 0.f;
#define SSD_LOAD(cc, dC, dCB, dBT) do { _Pragma("unroll") for (int ks = 0; ks < 4; ++ks) { dC[ks] = *(const GAS v4u*)(Cg + (size_t)(cc) * 32768 + 32 * ks); dCB[ks] = *(const GAS v4u*)(CBg + (size_t)(cc) * 32768 + 32 * ks); \
            dBT[ks] = *(const GAS v4u*)(BTg + (size_t)(cc) * 32768 + 32 * ks); } \
            _Pragma("unroll") for (int i = 0; i < 2; ++i) { const int p = tid + NTHR * i; rx[i] = *(const GAS v4u*)(XTg + (size_t)(cc) * 8192 + (p >> 4) * 128 + (p & 15) * 8); } \
            if (tid < 128) { rac = ACg[(cc) * 128 + tid]; racl = ACg[(cc) * 128 + 127]; rdt = DTg[(cc) * 128 + tid]; } } while (0)
#define SSD_STORE(bi) do { _Pragma("unroll") for (int i = 0; i < 2; ++i) { const int p = tid + NTHR * i; *(LAS v4u*)(lds + O_X + (bi) * 17408 + ((p >> 4) * PS + (p & 15) * 8) * 2) = rx[i]; } \
            if (tid < 128) { ((LAS float*)(lds + O_AC))[(bi) * 128 + tid] = rac; ((LAS float*)(lds + O_TE))[(bi) * 128 + tid] = __expf(racl - rac); ((LAS float*)(lds + O_DT))[(bi) * 128 + tid] = rdt; } } while (0)
        __syncthreads();
        SSD_LOAD(0, fC, fCB, fBT);
        for (int i = tid; i < 17408 / 4; i += NTHR) ((LAS unsigned*)(lds + O_S))[i] = 0u;
        SSD_STORE(0);
        f32x4 accS[4];
#pragma unroll
        for (int pt = 0; pt < 4; ++pt) accS[pt] = (f32x4){0.f, 0.f, 0.f, 0.f};
        __syncthreads();
        for (int c = 0; c < 32; ++c) {
            const int cur = c & 1;
            const LAS bf16* sS = (const LAS bf16*)(lds + O_S + cur * 17408); LAS bf16* sSn = (LAS bf16*)(lds + O_S + (cur ^ 1) * 17408); const LAS bf16* sXT = (const LAS bf16*)(lds + O_X + cur * 17408);
            const LAS float* sAc = (const LAS float*)(lds + O_AC) + cur * 128; const LAS float* sTe = (const LAS float*)(lds + O_TE) + cur * 128; const LAS float* sDt = (const LAS float*)(lds + O_DT) + cur * 128;
            if (c + 1 < 32) SSD_LOAD(c + 1, nC, nCB, nBT);
            const int lrow = 16 * w + r; const float ac_l = sAc[lrow];
            f32x4 accO[4], accD[4];
#pragma unroll
            for (int pt = 0; pt < 4; ++pt) { accO[pt] = (f32x4){0.f, 0.f, 0.f, 0.f}; accD[pt] = (f32x4){0.f, 0.f, 0.f, 0.f}; }
#pragma unroll
            for (int ks = 0; ks < 4; ++ks) { const bf16x8 yf = __builtin_bit_cast(bf16x8, fC[ks]);
#pragma unroll
                for (int pt = 0; pt < 4; ++pt) accO[pt] = mfma16(lds_frag(sS, 16 * pt, PS, 32 * ks, lane), yf, accO[pt]); }
#pragma unroll
            for (int ks = 0; ks < 4; ++ks) if (32 * ks <= 16 * w + 15) {
                float v[8]; const f32x4 a0 = *(const LAS f32x4*)(sAc + 32 * ks + 8 * q4), a1 = *(const LAS f32x4*)(sAc + 32 * ks + 8 * q4 + 4);
#pragma unroll
                for (int j = 0; j < 4; ++j) { const int s0 = 32 * ks + 8 * q4 + 2 * j; const float as0 = (2 * j < 4) ? a0[(2 * j) & 3] : a1[(2 * j) & 3], as1 = (2 * j + 1 < 4) ? a0[(2 * j + 1) & 3] : a1[(2 * j + 1) & 3];
                    v[2 * j] = (s0 <= lrow) ? bflo(fCB[ks][j]) * __expf(ac_l - as0) : 0.f; v[2 * j + 1] = (s0 + 1 <= lrow) ? bfhi(fCB[ks][j]) * __expf(ac_l - as1) : 0.f; }
                const bf16x8 yf = pack8(v);
#pragma unroll
                for (int pt = 0; pt < 4; ++pt) accD[pt] = mfma16(lds_frag(sXT, 16 * pt, PS, 32 * ks, lane), yf, accD[pt]); }
            {   const float ea = __expf(ac_l), rdtl = Dsk / sDt[lrow];
#pragma unroll
                for (int pt = 0; pt < 4; ++pt) { f32x4 y = accO[pt] * ea + accD[pt];
#pragma unroll
                    for (int ii = 0; ii < 4; ++ii) y[ii] += rdtl * bf2f(sXT[(16 * pt + 4 * q4 + ii) * PS + lrow]);
                    *(GAS unsigned long long*)(YMIX + ((size_t)b * SEQ + c * 128 + lrow) * DMIX + head * 64 + 16 * pt + 4 * q4) = pack4(y); } }
            {   const float cd = __expf(sAc[127]);
#pragma unroll
                for (int pt = 0; pt < 4; ++pt) accS[pt] = accS[pt] * cd;
#pragma unroll
                for (int ks = 0; ks < 4; ++ks) { float v[8]; const f32x4 t0 = *(const LAS f32x4*)(sTe + 32 * ks + 8 * q4), t1 = *(const LAS f32x4*)(sTe + 32 * ks + 8 * q4 + 4);
#pragma unroll
                    for (int j = 0; j < 4; ++j) { const float ts0 = (2 * j < 4) ? t0[(2 * j) & 3] : t1[(2 * j) & 3], ts1 = (2 * j + 1 < 4) ? t0[(2 * j + 1) & 3] : t1[(2 * j + 1) & 3];
                        v[2 * j] = bflo(fBT[ks][j]) * ts0; v[2 * j + 1] = bfhi(fBT[ks][j]) * ts1; }
                    const bf16x8 xf = pack8(v);
#pragma unroll
                    for (int pt = 0; pt < 4; ++pt) accS[pt] = mfma16(xf, lds_frag(sXT, 16 * pt, PS, 32 * ks, lane), accS[pt]); }
#pragma unroll
                for (int pt = 0; pt < 4; ++pt) *(LAS unsigned long long*)(sSn + (16 * pt + r) * PS + 16 * w + 4 * q4) = pack4(accS[pt]);
            }
            if (c + 1 < 32) { SSD_STORE(cur ^ 1);
#pragma unroll
                for (int ks = 0; ks < 4; ++ks) { fC[ks] = nC[ks]; fCB[ks] = nCB[ks]; fBT[ks] = nBT[ks]; } }
            __syncthreads();
        }
#undef SSD_LOAD
#undef SSD_STORE
    }
}

__device__ __forceinline__ void gdn_prep_phase(CArgs a, int l, LAS unsigned char* lds, int wg, int G, int tid) {
    asm volatile("" : "+v"(tid));
    constexpr int PS = 136, TS = 72, MS = 68, TT = 65;
    LAS bf16* sKb = (LAS bf16*)lds; LAS bf16* sQb = sKb + 64 * PS; LAS bf16* sQG = sQb + 64 * PS; LAS bf16* sVT = sQG + 64 * PS;
    LAS float* sM = (LAS float*)(lds + 3 * 17408 + 18432); LAS float* sT = sM + 64 * MS; LAS float* sVec = sT + 64 * TT;
    const bf16* PROJ = (const bf16*)(a->ws + WS_PROJ);
    const float* cw = a->in[I_GCW] + (size_t)l * 4 * 1536;
    const int lane = tid & 63, w = tid >> 6, r = lane & 15, q4 = lane >> 4;
    for (int unit = wg; unit < 1024; unit += G) {
        const int b = unit >> 8, head = (unit >> 6) & 3, n = unit & 63;
        const size_t row0 = (size_t)b * SEQ + n * 64;
        bf16* GK = (bf16*)(a->ws + WS_GD_K) + (size_t)unit * 8192; bf16* GKT = (bf16*)(a->ws + WS_GD_KT) + (size_t)unit * 8192; bf16* GQG = (bf16*)(a->ws + WS_GD_QG) + (size_t)unit * 8192;
        bf16* GVT = (bf16*)(a->ws + WS_GD_VT) + (size_t)unit * 8192; bf16* GT = (bf16*)(a->ws + WS_GD_T) + (size_t)unit * 4096; bf16* GQK = (bf16*)(a->ws + WS_GD_QK) + (size_t)unit * 4096;
        float* GVEC = (float*)(a->ws + WS_GD_VEC) + (size_t)unit * 256;
        __syncthreads();
        for (int i = tid; i < 64 * MS; i += NTHR) sM[i] = 0.f;
        if (w == 0) {
            const float nA = -__expf(a->in[I_GALOG][l * 4 + head]), dtb = a->in[I_GDTB][l * 4 + head];
            const size_t ro = (row0 + lane) * NPROJ;
            const float be = sigmoidf_(bf2f(PROJ[ro + O_GB + head])); float gsum = nA * softplusf_(bf2f(PROJ[ro + O_GA + head]) + dtb);
#pragma unroll
            for (int o = 1; o < 64; o <<= 1) { const float t_ = __shfl_up(gsum, o); if (lane >= o) gsum += t_; }
            const float glast = __shfl(gsum, 63), eg = __expf(gsum), cc = __expf(glast - gsum);
            sVec[lane] = gsum; sVec[64 + lane] = be; sVec[128 + lane] = eg;
            GVEC[lane] = be; GVEC[64 + lane] = eg; GVEC[128 + lane] = cc; GVEC[192 + lane] = __expf(glast);
        }
        __syncthreads();
        {
            float wq[4][2], wk_[4][2], wv[4][2];
#pragma unroll
            for (int k = 0; k < 4; ++k)
#pragma unroll
                for (int j = 0; j < 2; ++j) { wq[k][j] = cw[k * 1536 + head * 128 + 2 * lane + j]; wk_[k][j] = cw[k * 1536 + 512 + head * 128 + 2 * lane + j]; wv[k][j] = cw[k * 1536 + 1024 + head * 128 + 2 * lane + j]; }
#pragma unroll 2
            for (int i = 0; i < 8; ++i) { const int t = w + 8 * i; float q0 = 0.f, q1 = 0.f, k0 = 0.f, k1 = 0.f, v0 = 0.f, v1 = 0.f;
#pragma unroll
                for (int k = 0; k < 4; ++k) { const int ts = n * 64 + t - 3 + k;
                    if (ts >= 0) { const bf16* pr = PROJ + ((size_t)b * SEQ + ts) * NPROJ + O_QKV + head * 128 + 2 * lane;
                        const unsigned xq = *(const GAS unsigned*)pr, xk = *(const GAS unsigned*)(pr + 512), xv = *(const GAS unsigned*)(pr + 1024);
                        q0 += wq[k][0] * bflo(xq); q1 += wq[k][1] * bfhi(xq); k0 += wk_[k][0] * bflo(xk); k1 += wk_[k][1] * bfhi(xk); v0 += wv[k][0] * bflo(xv); v1 += wv[k][1] * bfhi(xv); } }
                q0 = siluf(q0); q1 = siluf(q1); k0 = siluf(k0); k1 = siluf(k1); v0 = siluf(v0); v1 = siluf(v1);
                const float sq = rsqrtf(wave_sum(q0 * q0 + q1 * q1) + 1e-6f) * 0.08838834764831845f, sk = rsqrtf(wave_sum(k0 * k0 + k1 * k1) + 1e-6f), eg = sVec[128 + t];
                *(LAS unsigned*)(sKb + t * PS + 2 * lane) = pk2(k0 * sk, k1 * sk); *(LAS unsigned*)(sQb + t * PS + 2 * lane) = pk2(q0 * sq, q1 * sq);
                *(LAS unsigned*)(sQG + t * PS + 2 * lane) = pk2(q0 * sq * eg, q1 * sq * eg);
                sVT[(2 * lane) * TS + t] = (bf16)f2bf(v0); sVT[(2 * lane + 1) * TS + t] = (bf16)f2bf(v1); }
        }
        __syncthreads();
        for (int p = w; p < 26; p += NWAVES) {
            int it, jt; bool isq;
            if (p < 10) { isq = false; it = p < 1 ? 0 : (p < 3 ? 1 : (p < 6 ? 2 : 3)); jt = p - (it * (it + 1)) / 2; } else { isq = true; it = (p - 10) >> 2; jt = (p - 10) & 3; }
            f32x4 acc = {0.f, 0.f, 0.f, 0.f};
            if (jt <= it) {
#pragma unroll
                for (int ks = 0; ks < 4; ++ks) acc = mfma16(lds_frag(sKb, 16 * jt, PS, 32 * ks, lane), lds_frag(isq ? sQb : sKb, 16 * it, PS, 32 * ks, lane), acc);
                const int i = 16 * it + r; const float gi = sVec[i], bi = sVec[64 + i];
#pragma unroll
                for (int ii = 0; ii < 4; ++ii) { const int j = 16 * jt + 4 * q4 + ii; const float dec = __expf(gi - sVec[j]);
                    acc[ii] = isq ? (j <= i ? acc[ii] * dec : 0.f) : (j < i ? acc[ii] * dec * bi : 0.f); }
            }
            if (isq) *(GAS unsigned long long*)(GQK + (16 * it + r) * 64 + 16 * jt + 4 * q4) = pack4(acc);
            else *(LAS f32x4*)(sM + (16 * it + r) * MS + 16 * jt + 4 * q4) = acc;
        }
        __syncthreads();
        if (w == 0) {
            int zo = 0; asm volatile("" : "+v"(zo)); const LAS float* sMv = sM + zo;
            float U[64];
#pragma unroll
            for (int i = 0; i < 64; ++i) { float a0 = -sMv[i * MS + lane], a1 = 0.f, a2 = 0.f, a3 = 0.f;
#pragma unroll
                for (int j4 = 0; j4 < (i + 3) / 4; ++j4) { const f32x4 m = *(const LAS f32x4*)(sMv + i * MS + 4 * j4);
                    if (4 * j4 + 0 < i) a0 -= m[0] * U[4 * j4 + 0]; if (4 * j4 + 1 < i) a1 -= m[1] * U[4 * j4 + 1]; if (4 * j4 + 2 < i) a2 -= m[2] * U[4 * j4 + 2]; if (4 * j4 + 3 < i) a3 -= m[3] * U[4 * j4 + 3]; }
                U[i] = (a0 + a1) + (a2 + a3); sT[i * TT + lane] = U[i]; }
        } else {
            const int t7 = tid - 64;
            for (int p = t7; p < 1024; p += NTHR - 64) { const int t = p >> 4, d8 = (p & 15) * 8; *(GAS v4u*)(GK + t * 128 + d8) = *(const LAS v4u*)(sKb + t * PS + d8); *(GAS v4u*)(GQG + t * 128 + d8) = *(const LAS v4u*)(sQG + t * PS + d8); }
            for (int p = t7; p < 1024; p += NTHR - 64) { const int d = p >> 3, s8 = (p & 7) * 8; v4u o;
#pragma unroll
                for (int j = 0; j < 4; ++j) o[j] = (unsigned)sKb[(s8 + 2 * j) * PS + d] | ((unsigned)sKb[(s8 + 2 * j + 1) * PS + d] << 16);
                *(GAS v4u*)(GKT + d * 64 + s8) = o; *(GAS v4u*)(GVT + d * 64 + s8) = *(const LAS v4u*)(sVT + d * TS + s8); }
        }
        __syncthreads();
        { const int t = tid >> 3, s8 = (tid & 7) * 8; float v[8];
#pragma unroll
            for (int jj = 0; jj < 8; ++jj) v[jj] = sT[t * TT + s8 + jj] + ((s8 + jj == t) ? 1.f : 0.f);
            *(GAS bf16x8*)(GT + t * 64 + s8) = pack8(v); }
    }
}
__device__ __forceinline__ void gdn_scan_phase(CArgs a, int l, LAS unsigned char* lds, int wg, int G, int tid) {
    asm volatile("" : "+v"(tid));
    constexpr int PS = 136, TS = 72, O_ST = 0, O_RT = 34816, O_VN = O_RT + 9216, O_VC = O_VN + 9216;
    bf16* YMIX = (bf16*)(a->ws + WS_YMIX);
    const int lane = tid & 63, w = tid >> 6, r = lane & 15, q4 = lane >> 4, st = w >> 1, eh = w & 1;
    LAS bf16* sRT = (LAS bf16*)(lds + O_RT); LAS bf16* sVN = (LAS bf16*)(lds + O_VN); LAS bf16* sVC = (LAS bf16*)(lds + O_VC);
    for (int unit = wg; unit < 32; unit += G) {
        const int b = unit >> 3, head = (unit >> 1) & 3, eb = unit & 1;
        const size_t u0 = (size_t)(b * 4 + head) * 64;
        const bf16* pK = (const bf16*)(a->ws + WS_GD_K) + u0 * 8192 + (16 * st + r) * 128 + 8 * q4; const bf16* pQG = (const bf16*)(a->ws + WS_GD_QG) + u0 * 8192 + (16 * st + r) * 128 + 8 * q4;
        const bf16* pT = (const bf16*)(a->ws + WS_GD_T) + u0 * 4096 + (16 * st + r) * 64 + 8 * q4; const bf16* pQK = (const bf16*)(a->ws + WS_GD_QK) + u0 * 4096 + (16 * st + r) * 64 + 8 * q4;
        const bf16* pKT = (const bf16*)(a->ws + WS_GD_KT) + u0 * 8192 + (16 * w + r) * 64 + 8 * q4;
        const bf16* pVT = (const bf16*)(a->ws + WS_GD_VT) + u0 * 8192 + (size_t)(eb * 64 + 32 * eh + r) * 64 + 16 * st + 4 * q4;
        const float* pVec = (const float*)(a->ws + WS_GD_VEC) + u0 * 256 + 16 * st + 4 * q4;
        v4u xK[4], xT[2], yQG[4], yQK[2], xKT[2], nK[4], nT[2], nQG[4], nQK[2], nKT[2]; unsigned long long vT[2], nvT[2]; f32x4 be4, eg4, c4, nbe4, neg4, nc4; float gl, ngl;
#define GD_LOAD(nn, K_, T_, QG_, QK_, KT_, V_, B_, E_, C_, G_) do { _Pragma("unroll") for (int ks = 0; ks < 4; ++ks) { K_[ks] = *(const GAS v4u*)(pK + (size_t)(nn) * 8192 + 32 * ks); QG_[ks] = *(const GAS v4u*)(pQG + (size_t)(nn) * 8192 + 32 * ks); } \
            _Pragma("unroll") for (int ks = 0; ks < 2; ++ks) { T_[ks] = *(const GAS v4u*)(pT + (size_t)(nn) * 4096 + 32 * ks); QK_[ks] = *(const GAS v4u*)(pQK + (size_t)(nn) * 4096 + 32 * ks); KT_[ks] = *(const GAS v4u*)(pKT + (size_t)(nn) * 8192 + 32 * ks); } \
            _Pragma("unroll") for (int j = 0; j < 2; ++j) V_[j] = *(const GAS unsigned long long*)(pVT + (size_t)(nn) * 8192 + j * 16 * 64); \
            B_ = *(const GAS f32x4*)(pVec + (size_t)(nn) * 256); E_ = *(const GAS f32x4*)(pVec + (size_t)(nn) * 256 + 64); C_ = *(const GAS f32x4*)(pVec + (size_t)(nn) * 256 + 128); G_ = pVec[(size_t)(nn) * 256 + 192 - (16 * st + 4 * q4)]; } while (0)
        __syncthreads();
        GD_LOAD(0, xK, xT, yQG, yQK, xKT, vT, be4, eg4, c4, gl);
        for (int i = tid; i < 17408 / 4; i += NTHR) ((LAS unsigned*)(lds + O_ST))[i] = 0u;
        f32x4 accS[4];
#pragma unroll
        for (int et = 0; et < 4; ++et) accS[et] = (f32x4){0.f, 0.f, 0.f, 0.f};
        __syncthreads();
        for (int n = 0; n < 64; ++n) {
            const int cur = n & 1; const LAS bf16* sST = (const LAS bf16*)(lds + O_ST + cur * 17408); LAS bf16* sSTn = (LAS bf16*)(lds + O_ST + (cur ^ 1) * 17408);
            if (n + 1 < 64) GD_LOAD(n + 1, nK, nT, nQG, nQK, nKT, nvT, nbe4, neg4, nc4, ngl);
#pragma unroll
            for (int j = 0; j < 2; ++j) {
                const int e0 = 16 * (2 * eh + j); f32x4 acc = {0.f, 0.f, 0.f, 0.f};
#pragma unroll
                for (int ks = 0; ks < 4; ++ks) acc = mfma16(__builtin_bit_cast(bf16x8, xK[ks]), lds_frag(sST, e0, PS, 32 * ks, lane), acc);
                const unsigned vlo = (unsigned)vT[j], vhi = (unsigned)(vT[j] >> 32); f32x4 rr;
                rr[0] = be4[0] * (bflo(vlo) - eg4[0] * acc[0]); rr[1] = be4[1] * (bfhi(vlo) - eg4[1] * acc[1]); rr[2] = be4[2] * (bflo(vhi) - eg4[2] * acc[2]); rr[3] = be4[3] * (bfhi(vhi) - eg4[3] * acc[3]);
                *(LAS unsigned long long*)(sRT + (e0 + r) * TS + 16 * st + 4 * q4) = pack4(rr); }
            __syncthreads();
#pragma unroll
            for (int j = 0; j < 2; ++j) {
                const int e0 = 16 * (2 * eh + j); f32x4 acc = {0.f, 0.f, 0.f, 0.f};
#pragma unroll
                for (int ks = 0; ks < 2; ++ks) acc = mfma16(__builtin_bit_cast(bf16x8, xT[ks]), lds_frag(sRT, e0, TS, 32 * ks, lane), acc);
                *(LAS unsigned long long*)(sVN + (e0 + r) * TS + 16 * st + 4 * q4) = pack4(acc); *(LAS unsigned long long*)(sVC + (e0 + r) * TS + 16 * st + 4 * q4) = pack4(acc * c4); }
            __syncthreads();
#pragma unroll
            for (int j = 0; j < 2; ++j) {
                const int e0 = 16 * (2 * eh + j); f32x4 acc = {0.f, 0.f, 0.f, 0.f};
#pragma unroll
                for (int ks = 0; ks < 4; ++ks) acc = mfma16(lds_frag(sST, e0, PS, 32 * ks, lane), __builtin_bit_cast(bf16x8, yQG[ks]), acc);
#pragma unroll
                for (int ks = 0; ks < 2; ++ks) acc = mfma16(lds_frag(sVN, e0, TS, 32 * ks, lane), __builtin_bit_cast(bf16x8, yQK[ks]), acc);
                *(GAS unsigned long long*)(YMIX + ((size_t)b * SEQ + n * 64 + 16 * st + r) * DMIX + 1024 + head * 128 + eb * 64 + e0 + 4 * q4) = pack4(acc); }
#pragma unroll
            for (int et = 0; et < 4; ++et) {
                accS[et] = accS[et] * gl;
#pragma unroll
                for (int ks = 0; ks < 2; ++ks) accS[et] = mfma16(__builtin_bit_cast(bf16x8, xKT[ks]), lds_frag(sVC, 16 * et, TS, 32 * ks, lane), accS[et]);
                *(LAS unsigned long long*)(sSTn + (16 * et + r) * PS + 16 * w + 4 * q4) = pack4(accS[et]); }
            if (n + 1 < 64) {
#pragma unroll
                for (int ks = 0; ks < 4; ++ks) { xK[ks] = nK[ks]; yQG[ks] = nQG[ks]; }
#pragma unroll
                for (int ks = 0; ks < 2; ++ks) { xT[ks] = nT[ks]; yQK[ks] = nQK[ks]; xKT[ks] = nKT[ks]; vT[ks] = nvT[ks]; }
                be4 = nbe4; eg4 = neg4; c4 = nc4; gl = ngl; }
            __syncthreads();
        }
#undef GD_LOAD
    }
}

__device__ __forceinline__ void gdn_rec_phase(CArgs a, int l, LAS unsigned char* lds, int wg, int G, int tid) {
    asm volatile("" : "+v"(tid));
    constexpr int TB = 32;
    LAS float* sQ = (LAS float*)lds; LAS float* sK = sQ + TB * 128; LAS float* sV = sK + TB * 128; LAS float* sBe = sV + TB * 8; LAS float* sAl = sBe + TB; LAS float* sO = sAl + TB;
    const bf16* PROJ = (const bf16*)(a->ws + WS_PROJ); bf16* YMIX = (bf16*)(a->ws + WS_YMIX);
    const float* cw = a->in[I_GCW] + (size_t)l * 4 * 1536;
    const int lane = tid & 63, w = tid >> 6;
    for (int unit = wg; unit < 256; unit += G) {
        const int b = unit >> 6, head = (unit >> 4) & 3, eb = unit & 15;
        const float nA = -__expf(a->in[I_GALOG][l * 4 + head]), dtb = a->in[I_GDTB][l * 4 + head];
        float S0 = 0.f, S1 = 0.f;
        for (int t0 = 0; t0 < SEQ; t0 += TB) {
            __syncthreads();
            for (int idx = tid; idx < TB * 264; idx += NTHR) {
                const int tt = idx / 264, ci = idx % 264, t = t0 + tt;
                const int ch = ci < 128 ? head * 128 + ci : (ci < 256 ? 512 + head * 128 + (ci - 128) : 1024 + head * 128 + eb * 8 + (ci - 256));
                float acc = 0.f;
#pragma unroll
                for (int k = 0; k < 4; ++k) { const int ts = t - 3 + k; if (ts >= 0) acc += cw[k * 1536 + ch] * bf2f(PROJ[(size_t)(b * SEQ + ts) * NPROJ + O_QKV + ch]); }
                const float v = siluf(acc);
                if (ci < 128) sQ[tt * 128 + ci] = v; else if (ci < 256) sK[tt * 128 + ci - 128] = v; else sV[tt * 8 + ci - 256] = v;
            }
            if (tid < TB) { const size_t ro = (size_t)(b * SEQ + t0 + tid) * NPROJ; const float braw = bf2f(PROJ[ro + O_GB + head]), araw = bf2f(PROJ[ro + O_GA + head]);
                sBe[tid] = sigmoidf_(braw); sAl[tid] = __expf(nA * softplusf_(araw + dtb)); }
            __syncthreads();
            for (int tt = w; tt < TB; tt += NWAVES) {
                const float q0 = sQ[tt * 128 + lane], q1 = sQ[tt * 128 + 64 + lane], k0 = sK[tt * 128 + lane], k1 = sK[tt * 128 + 64 + lane];
                const float sq = rsqrtf(wave_sum(q0 * q0 + q1 * q1) + 1e-6f) * 0.08838834764831845f, sk = rsqrtf(wave_sum(k0 * k0 + k1 * k1) + 1e-6f);
                sQ[tt * 128 + lane] = q0 * sq; sQ[tt * 128 + 64 + lane] = q1 * sq; sK[tt * 128 + lane] = k0 * sk; sK[tt * 128 + 64 + lane] = k1 * sk;
            }
            __syncthreads();
#pragma unroll 2
            for (int tt = 0; tt < TB; ++tt) {
                const float k0 = sK[tt * 128 + lane], k1 = sK[tt * 128 + 64 + lane], q0 = sQ[tt * 128 + lane], q1 = sQ[tt * 128 + 64 + lane];
                const float al = sAl[tt], be = sBe[tt], v = sV[tt * 8 + w];
                const float dot = wave_sum(k0 * S0 + k1 * S1);
                const float vn = be * (v - al * dot);
                S0 = al * S0 + k0 * vn; S1 = al * S1 + k1 * vn;
                const float od = wave_sum(q0 * S0 + q1 * S1);
                if (lane == 0) sO[tt * 8 + w] = od;
            }
            __syncthreads();
            if (tid < TB * 8) { const int tt = tid >> 3, i = tid & 7; YMIX[(size_t)(b * SEQ + t0 + tt) * DMIX + 1024 + head * 128 + eb * 8 + i] = (bf16)f2bf(sO[tid]); }
        }
    }
}

__device__ __forceinline__ void hgrn_rec_phase(CArgs a, int l, LAS unsigned char* lds, int wg, int G, int tid) {
    asm volatile("" : "+v"(tid));
    constexpr int TB = 32;
    LAS float* sQ = (LAS float*)lds; LAS float* sF = sQ + TB * 128; LAS float* sV = sF + TB * 128; LAS float* sO = sV + TB * 8; LAS float* sLb = sO + TB * 8;
    const bf16* PROJ = (const bf16*)(a->ws + WS_PROJ); bf16* YMIX = (bf16*)(a->ws + WS_YMIX);
    const int lane = tid & 63, w = tid >> 6;
    for (int unit = wg; unit < 256; unit += G) {
        const int b = unit >> 6, head = (unit >> 4) & 3, eb = unit & 15;
        __syncthreads();
        if (tid < 128) {
            const int c = head * 128 + tid; float lg[DEPTH], mx = -1e30f;
#pragma unroll
            for (int j = 0; j < DEPTH; ++j) { lg[j] = a->in[I_HLB][j * 512 + c]; mx = fmaxf(mx, lg[j]); }
            float den = 0.f, num = 0.f;
#pragma unroll
            for (int j = 0; j < DEPTH; ++j) { const float e = __expf(lg[j] - mx); den += e; if (j >= 1 && j <= l) num += e; }
            sLb[tid] = num / den;
        }
        float S0 = 0.f, S1 = 0.f;
        for (int t0 = 0; t0 < SEQ; t0 += TB) {
            __syncthreads();
            for (int idx = tid; idx < TB * 264; idx += NTHR) {
                const int tt = idx / 264, ci = idx % 264; const size_t ro = (size_t)(b * SEQ + t0 + tt) * NPROJ;
                if (ci < 128) sQ[tt * 128 + ci] = siluf(bf2f(PROJ[ro + O_HQ + head * 128 + ci]));
                else if (ci < 256) { const int d = ci - 128; const float lb = sLb[d]; sF[tt * 128 + d] = lb + (1.f - lb) * sigmoidf_(bf2f(PROJ[ro + O_HF + head * 128 + d])); }
                else sV[tt * 8 + ci - 256] = bf2f(PROJ[ro + O_HI + head * 128 + eb * 8 + (ci - 256)]);
            }
            __syncthreads();
#pragma unroll 2
            for (int tt = 0; tt < TB; ++tt) {
                const float f0 = sF[tt * 128 + lane], f1 = sF[tt * 128 + 64 + lane], q0 = sQ[tt * 128 + lane], q1 = sQ[tt * 128 + 64 + lane], v = sV[tt * 8 + w];
                S0 = f0 * S0 + (1.f - f0) * v; S1 = f1 * S1 + (1.f - f1) * v;
                const float od = wave_sum(q0 * S0 + q1 * S1);
                if (lane == 0) sO[tt * 8 + w] = od;
            }
            __syncthreads();
            if (tid < TB * 8) { const int tt = tid >> 3, i = tid & 7; YMIX[(size_t)(b * SEQ + t0 + tt) * DMIX + 1536 + head * 128 + eb * 8 + i] = (bf16)f2bf(sO[tid]); }
        }
    }
}

__device__ __forceinline__ void mix_post_phase(CArgs a, int l, int wg, int G, int tid) {
    asm volatile("" : "+v"(tid));
    const bf16* PROJ = (const bf16*)(a->ws + WS_PROJ); bf16* YMIX = (bf16*)(a->ws + WS_YMIX);
    const int lane = tid & 63, gw = wg * NWAVES + (tid >> 6), NGW = G * NWAVES;
    const float* snw = a->in[I_SNW] + l * 1024; const float* gnw = a->in[I_GNW] + l * 128; const float* hnw = a->in[I_HNW] + l * 128;
    for (int row = gw; row < M; row += NGW) {
        const bf16* pr = PROJ + (size_t)row * NPROJ; bf16* yr = YMIX + (size_t)row * DMIX;
#pragma unroll
        for (int j = 0; j < 2; ++j) {
            const int ch = j * 512 + lane * 8; const v4u yv = *(const GAS v4u*)(yr + ch), zv = *(const GAS v4u*)(pr + O_Z + ch);
            float v[8]; float ss = 0.f;
#pragma unroll
            for (int i = 0; i < 4; ++i) { v[2 * i] = bflo(yv[i]) * siluf(bflo(zv[i])); v[2 * i + 1] = bfhi(yv[i]) * siluf(bfhi(zv[i])); ss += v[2 * i] * v[2 * i] + v[2 * i + 1] * v[2 * i + 1]; }
            const float rstd = rsqrtf(wave_sum(ss) * (1.f / 512.f) + 1e-6f);
            v4u o;
#pragma unroll
            for (int i = 0; i < 4; ++i) o[i] = pk2(v[2 * i] * rstd * snw[ch + 2 * i], v[2 * i + 1] * rstd * snw[ch + 2 * i + 1]);
            *(GAS v4u*)(yr + ch) = o;
        }
#pragma unroll
        for (int part = 0; part < 2; ++part) {
            const int ch = lane * 8, yo = 1024 + part * 512 + ch, go = (part == 0 ? O_GG : O_HG) + ch; const float* nw = part == 0 ? gnw : hnw;
            const v4u yv = *(const GAS v4u*)(yr + yo), gv = *(const GAS v4u*)(pr + go);
            float v[8]; float ss = 0.f;
#pragma unroll
            for (int i = 0; i < 4; ++i) { v[2 * i] = bflo(yv[i]); v[2 * i + 1] = bfhi(yv[i]); ss += v[2 * i] * v[2 * i] + v[2 * i + 1] * v[2 * i + 1]; }
            ss += __shfl_xor(ss, 1); ss += __shfl_xor(ss, 2); ss += __shfl_xor(ss, 4); ss += __shfl_xor(ss, 8);
            const float rstd = rsqrtf(ss * (1.f / 128.f) + 1e-6f);
            v4u o;
#pragma unroll
            for (int i = 0; i < 4; ++i) { const int c = (ch & 127) + 2 * i; o[i] = pk2(v[2 * i] * rstd * nw[c] * siluf(bflo(gv[i])), v[2 * i + 1] * rstd * nw[c + 1] * siluf(bfhi(gv[i]))); }
            *(GAS v4u*)(yr + yo) = o;
        }
    }
}

template <bool ROUTER>
__device__ __forceinline__ void ln_phase(CArgs a, int l, const float* gam, const float* bet, LAS unsigned char* lds, int wg, int G, int tid) {
    asm volatile("" : "+v"(tid));
    const int lane = tid & 63, gw = wg * NWAVES + (tid >> 6), NGW = G * NWAVES;
    const float* ADD = (const float*)(a->ws + WS_MIX); float* H = a->out; bf16* HB = (bf16*)(a->ws + WS_HB); float* COMB = (float*)(a->ws + WS_COMB);
    LAS float* sW = (LAS float*)lds;
    LAS float* sL = sW + 20 * D + (tid >> 6) * 32;
    if (ROUTER) {
        __syncthreads();
        const float* wrg = a->in[I_WRG] + (size_t)l * D * 4; const float* wre = a->in[I_WRE] + (size_t)l * D * 16;
        for (int i = tid; i < D * 20; i += NTHR) { const int c = i >> 10, k = i & 1023; sW[i] = c < 4 ? wrg[k * 4 + c] : wre[k * 16 + c - 4]; }
        __syncthreads();
    }
    f32x4 gv[4], bv[4];
#pragma unroll
    for (int j = 0; j < 4; ++j) { gv[j] = *(const f32x4*)(gam + 4 * lane + 256 * j); bv[j] = *(const f32x4*)(bet + 4 * lane + 256 * j); }
    for (int row = gw; row < M; row += NGW) {
        f32x4 v[4]; float s = 0.f;
#pragma unroll
        for (int j = 0; j < 4; ++j) { const f32x4 hv = *(const GAS f32x4*)(H + (size_t)row * D + 4 * lane + 256 * j), av = *(const GAS f32x4*)(ADD + (size_t)row * D + 4 * lane + 256 * j);
            v[j] = hv * DN_ALPHA + av; s += (v[j].x + v[j].y) + (v[j].z + v[j].w); }
        const float mean = wave_sum(s) * (1.f / D); float s2 = 0.f;
#pragma unroll
        for (int j = 0; j < 4; ++j) { v[j] = v[j] - mean; s2 += (v[j].x * v[j].x + v[j].y * v[j].y) + (v[j].z * v[j].z + v[j].w * v[j].w); }
        const float rstd = rsqrtf(wave_sum(s2) * (1.f / D) + LN_EPS);
#pragma unroll
        for (int j = 0; j < 4; ++j) { v[j] = v[j] * rstd * gv[j] + bv[j];
            *(GAS f32x4*)(H + (size_t)row * D + 4 * lane + 256 * j) = v[j];
            *(GAS unsigned long long*)(HB + (size_t)row * D + 4 * lane + 256 * j) = (unsigned long long)pk2(v[j].x, v[j].y) | ((unsigned long long)pk2(v[j].z, v[j].w) << 32); }
        if (ROUTER) {
            float lg[20];
#pragma unroll 1
            for (int c = 0; c < 20; ++c) { float p = 0.f;
#pragma unroll
                for (int j = 0; j < 4; ++j) { const f32x4 wv = *(const LAS f32x4*)(sW + c * D + 4 * lane + 256 * j); p += (v[j].x * wv.x + v[j].y * wv.y) + (v[j].z * wv.z + v[j].w * wv.w); }
                p = wave_sum(p); if (lane == 0) sL[c] = p; }
#pragma unroll
            for (int c = 0; c < 20; ++c) lg[c] = sL[c];
            float pg[4], mx = -1e30f; int gi = 0;
#pragma unroll
            for (int c = 0; c < 4; ++c) { pg[c] = lg[c] + a->in[I_BRG][l * 4 + c]; if (pg[c] > mx) { mx = pg[c]; gi = c; } }
            float den = 0.f;
#pragma unroll
            for (int c = 0; c < 4; ++c) den += __expf(pg[c] - mx);
            const float g_p = 1.0f / den;
            float le[4], emx = -1e30f; int i1 = 0;
#pragma unroll
            for (int c = 0; c < 4; ++c) { float x = 0.f;
#pragma unroll
                for (int gg = 0; gg < 4; ++gg) x = (gi == gg) ? lg[4 + gg * 4 + c] + a->in[I_BRE][l * 16 + gg * 4 + c] : x;
                le[c] = x; if (x > emx) { emx = x; i1 = c; } }
            float e2mx = -1e30f; int i2 = 0;
#pragma unroll
            for (int c = 0; c < 4; ++c) if (c != i1 && le[c] > e2mx) { e2mx = le[c]; i2 = c; }
            const float x1 = 1.0f, x2 = __expf(e2mx - emx), w1 = g_p * x1 / (x1 + x2), w2 = g_p * x2 / (x1 + x2);
            if (lane < 16) { const int gl = lane >> 2, el = lane & 3; float cwv = 0.f; if (gl == gi) { if (el == i1) cwv = w1; else if (el == i2) cwv = w2; } COMB[(size_t)row * 16 + lane] = cwv; }
        }
    }
}

#ifndef PHASE_MASK
#define PHASE_MASK 0xffff
#endif
#define PM(k) (((PHASE_MASK) >> (k)) & 1)
enum { P_W = 0, P_IN, P_PREP, P_SSD, P_GDN, P_HG, P_POST, P_OUT, P_LN1, P_GU, P_DN, P_LN2, NPH };
constexpr int N_PHASES = 1 + DEPTH * NPH;
__global__ void __launch_bounds__(NTHR, 2) fwd(Args args) {
    extern __shared__ __attribute__((aligned(16))) unsigned char lds_raw[];
    LAS unsigned char* lds = (LAS unsigned char*)lds_raw;
    volatile LAS unsigned* MISC = (volatile LAS unsigned*)(lds + MISC_OFF);
    const int tid = threadIdx.x, G = gridDim.x, bx = blockIdx.x;
    unsigned char* ws = args.ws;
    gu32* ctl = (gu32*)(ws + WS_CTL);
    for (int u = tid; u < (LDS_BYTES - LDSCTL_OFF) / 4; u += NTHR) ((LAS unsigned*)(lds + LDSCTL_OFF))[u] = 0u;
    __syncthreads();
    const int lo = args.ph_lo, hi = args.ph_hi;
    const bool use_bar = (hi - lo) > 1;
    XcdBarrier bar; bar.bar = (unsigned*)(ctl + CW_BAR); bar.x = 0; bar.st = nullptr;
    if (use_bar) bar = xcd_barrier_post((unsigned*)(ctl + CW_BAR), MISC + 8);
#define IN(k) (lo <= (k) && (k) < hi)
#define SEAM(k) do { if (IN(k) && IN((k) + 1)) xcd_barrier(bar); } while (0)

    if (IN(0)) { p0_prologue(ARGS_HERE(), lds, bx, G, tid); SEAM(0); }

    for (int l = 0; l < DEPTH; ++l) {
        const int base = 1 + l * NPH;
        if (PM(P_W) && IN(base + P_W)) { weights_phase(ARGS_HERE(), l, lds, bx, G, tid); SEAM(base + P_W); }
        if (PM(P_IN) && IN(base + P_IN)) {
            pg8::Gemm g{(const pg8::bf16_t*)(ws + WS_HB), (const pg8::bf16_t*)(ws + WS_WIN), M, NPROJ, D}; pg8::StaticOrder S; S.init(M, NPROJ, G, bx);
            pg8::EpiBf16<0> E{(pg8::bf16_t*)(ws + WS_PROJ), NPROJ, nullptr, 0, 0, 1.f};
            pg8::gemm_phase<pg8::EpiBf16<0>, pg8::StaticOrder, true, true>(lds + RING_OFF, g, S, E);
            SEAM(base + P_IN);
        }
        if (PM(P_PREP) && IN(base + P_PREP)) {
#ifndef PREP_MASK
#define PREP_MASK 7
#endif
            if (PREP_MASK & 1) hgrn_prep_phase(ARGS_HERE(), l, lds, bx, G, tid);
            if (PREP_MASK & 2) ssd_prep_phase(ARGS_HERE(), l, lds, bx, G, tid);
            if (PREP_MASK & 4) gdn_prep_phase(ARGS_HERE(), l, lds, bx, G, tid);
            SEAM(base + P_PREP); }
        if (PM(P_SSD) && IN(base + P_SSD)) { ssd_scan_phase(ARGS_HERE(), l, lds, bx, G, tid); SEAM(base + P_SSD); }
        if (PM(P_GDN) && IN(base + P_GDN)) { gdn_scan_phase(ARGS_HERE(), l, lds, bx, G, tid); SEAM(base + P_GDN); }
        if (PM(P_HG) && IN(base + P_HG)) { hgrn_scan_phase(ARGS_HERE(), l, lds, bx, G, tid); SEAM(base + P_HG); }
        if (PM(P_POST) && IN(base + P_POST)) { mix_post_phase(ARGS_HERE(), l, bx, G, tid); SEAM(base + P_POST); }
        if (PM(P_OUT) && IN(base + P_OUT)) {
            pg8::Gemm g{(const pg8::bf16_t*)(ws + WS_YMIX), (const pg8::bf16_t*)(ws + WS_WOUT), M, D, DMIX}; pg8::StaticOrder S; S.init(M, D, G, bx);
            pg8::EpiF32 E{(float*)(ws + WS_MIX), D};
            pg8::gemm_phase<pg8::EpiF32, pg8::StaticOrder, true, true>(lds + RING_OFF, g, S, E);
            SEAM(base + P_OUT);
        }
        if (PM(P_LN1) && IN(base + P_LN1)) { CArgs a_ = ARGS_HERE(); ln_phase<true>(a_, l, a_->in[I_LN1G] + l * D, a_->in[I_LN1B] + l * D, lds, bx, G, tid); SEAM(base + P_LN1); }
        if (PM(P_GU) && IN(base + P_GU)) {
            pg8::Gemm g{(const pg8::bf16_t*)(ws + WS_HB), (const pg8::bf16_t*)(ws + WS_WGU), M, NGU, D}; pg8::StaticOrder S; S.init(M, NGU, G, bx);
            pg8::EpiSwiGLU E{(pg8::bf16_t*)(ws + WS_H), KDN, (const float*)(ws + WS_COMB), 16};
            pg8::gemm_phase<pg8::EpiSwiGLU, pg8::StaticOrder, true, true>(lds + RING_OFF, g, S, E);
            SEAM(base + P_GU);
        }
        if (PM(P_DN) && IN(base + P_DN)) {
            pg8::Gemm g{(const pg8::bf16_t*)(ws + WS_H), (const pg8::bf16_t*)(ws + WS_WDN), M, D, KDN}; pg8::StaticOrder S; S.init(M, D, G, bx);
            pg8::EpiF32 E{(float*)(ws + WS_MIX), D};
            pg8::gemm_phase<pg8::EpiF32, pg8::StaticOrder, true, true>(lds + RING_OFF, g, S, E);
            SEAM(base + P_DN);
        }
        if (PM(P_LN2) && IN(base + P_LN2)) { CArgs a_ = ARGS_HERE(); ln_phase<false>(a_, l, a_->in[I_LN2G] + l * D, a_->in[I_LN2B] + l * D, lds, bx, G, tid); SEAM(base + P_LN2); }
    }
#undef IN
#undef SEAM
}

#ifndef MK_ONE_LAUNCH
#define MK_ONE_LAUNCH 1
#endif
extern "C" void kernel_launch(void* const* d_in, const int* in_sizes, int n_in, void* d_out, int out_size, void* d_ws, size_t ws_size, hipStream_t stream) {
    static int grid = 0;
    if (grid == 0) {
        if (n_in != 25 || out_size != M * D || ws_size < WS_END) { fprintf(stderr, "kernel_launch: unexpected shapes (n_in %d out %d ws %zu)\n", n_in, out_size, ws_size); grid = -1; return; }
        int dev = 0, cus = 0, per_cu = 0;
        if (hipGetDevice(&dev) != hipSuccess || hipDeviceGetAttribute(&cus, hipDeviceAttributeMultiprocessorCount, dev) != hipSuccess) { grid = -1; return; }
        if (hipFuncSetAttribute((const void*)fwd, hipFuncAttributeMaxDynamicSharedMemorySize, LDS_BYTES) != hipSuccess) { fprintf(stderr, "kernel_launch: hipFuncSetAttribute failed\n"); grid = -1; return; }
        if (hipOccupancyMaxActiveBlocksPerMultiprocessor(&per_cu, (const void*)fwd, NTHR, LDS_BYTES) != hipSuccess || per_cu < 1) { fprintf(stderr, "kernel_launch: occupancy query says %d\n", per_cu); (void)hipGetLastError(); grid = -1; return; }
        grid = cus;
    }
    if (grid < 0) return;
    if (hipMemsetAsync((char*)d_ws + WS_CTL, 0, CTL_ZERO_BYTES, stream) != hipSuccess) return;
    Args a{};
    for (int i = 0; i < 25; ++i) a.in[i] = (const float*)d_in[i];
    a.out = (float*)d_out; a.ws = (unsigned char*)d_ws;
#if MK_ONE_LAUNCH
    a.ph_lo = 0; a.ph_hi = N_PHASES;
    hipLaunchKernelGGL(fwd, dim3(grid), dim3(NTHR), LDS_BYTES, stream, a);
#else
    for (int p = 0; p < N_PHASES; ++p) { a.ph_lo = p; a.ph_hi = p + 1; hipLaunchKernelGGL(fwd, dim3(grid), dim3(NTHR), LDS_BYTES, stream, a); }
#endif
}
```

```cpp
#include <hip/hip_runtime.h>
#include <cstdio>
#include <cstdint>
namespace pg8 {
#define PG8_LAS __attribute__((address_space(3)))
typedef unsigned short bf16_t;
typedef short bf16x8 __attribute__((ext_vector_type(8)));
typedef float f32x4 __attribute__((ext_vector_type(4)));
typedef unsigned u32x4 __attribute__((ext_vector_type(4)));
constexpr int BM = 256, BK = 64, HALF = 128, HTB = HALF * BK * 2  , STAGE_BYTES = 8 * HTB, NXCD = 8, WGM = 8;

__host__ __device__ __forceinline__ int lds_byte(int r, int c) { const int st = (r >> 4) * 2 + (c >> 5), rr = r & 15, cc = c & 31, ob = rr * 64 + cc * 2; return st * 1024 + (ob ^ (((ob >> 9) & 1) << 5)); }
__host__ __device__ __forceinline__ void stage_rc(int b, int& R, int& C) { const int st = b / 1024, sb = b % 1024, swz = sb ^ (((sb >> 9) & 1) << 5); R = (st >> 1) * 16 + swz / 64; C = (st & 1) * 32 + (swz % 64) / 2; }
__host__ __device__ __forceinline__ int perm32(int rho) { const int n = rho >> 4, i = rho & 15; return 8 * (i >> 2) + 4 * n + (i & 3); }

struct Unit { int pm, pn; };
struct Gemm { const bf16_t* A; const bf16_t* Bt; int M, N, K; };

struct StaticOrder {
    int nM, nN, nwg, G, c;
    __host__ __device__ void init(int M, int N, int G_, int c_) { nM = M / BM; nN = N / BM; nwg = nM * nN; G = G_; c = c_; }
    __host__ __device__ bool next(int i, Unit& u) const {
        const long L = (long)i * G + c; if (L >= nwg) return false;
        int wgid = (int)L; { const int q = nwg / NXCD, r = nwg % NXCD, xcd = wgid % NXCD, off = wgid / NXCD; wgid = (xcd < r ? xcd * (q + 1) : r * (q + 1) + (xcd - r) * q) + off; }
        const int nig = WGM * nN, gid = wgid / nig, fm = gid * WGM, gsz = (nM - fm) < WGM ? (nM - fm) : WGM;
        u.pm = fm + ((wgid % nig) % gsz); u.pn = (wgid % nig) / gsz; return true;
    }
    __device__ __forceinline__ void a_ready(const Unit&) const {}
    __device__ __forceinline__ void done(const Unit&) const {}
};
__device__ __forceinline__ unsigned cvt_pk_bf16(float lo, float hi) { unsigned r; asm volatile("v_cvt_pk_bf16_f32 %0, %1, %2" : "=v"(r) : "v"(lo), "v"(hi)); return r; }
typedef float f32x2 __attribute__((ext_vector_type(2)));
__device__ __forceinline__ f32x2 gelu_pk(f32x2 v) {
    const f32x2 av = __builtin_elementwise_abs(v), d = av * 0.2316418882f + 1.0f;
    f32x2 t; t.x = __builtin_amdgcn_rcpf(d.x); t.y = __builtin_amdgcn_rcpf(d.y);
    f32x2 q = t * 0.5307027145f + (-0.7265760135f); q = q * t + 0.7107068705f; q = q * t + (-0.142248368f); q = q * t + 0.127414796f; q = q * t;
    const f32x2 s = (v * v) * (-0.72134752044f);
    f32x2 e; e.x = __builtin_amdgcn_exp2f(s.x); e.y = __builtin_amdgcn_exp2f(s.y);
    const f32x2 m = v * (q * e), r = v - m;
    f32x2 o; o.x = v.x < 0.f ? m.x : r.x; o.y = v.y < 0.f ? m.y : r.y; return o;
}

template <int ACT  > struct EpiBf16 {
    static constexpr bool PERM = true, AFTER_DRAIN = false; static_assert(ACT == 0 || ACT == 1, "EpiBf16: ACT is 0 (none) or 1 (gelu_pk)");
    bf16_t* O; int ldc; const float* bias; int split_cols; size_t split_stride; float scale0;
    __device__ __forceinline__ void operator()(const f32x4 (&acc)[2][2][4][2], const Unit& u, int wr, int wc, int fr, int fq) const {
        const int row0 = u.pm * BM + wr * 64 + fr; int colt = u.pn * BM; bf16_t* base = O;
        float sc = 1.f; if (split_cols) { const int t = colt / split_cols; base += (size_t)t * split_stride; colt -= t * split_cols; if (t == 0) sc = scale0; }
        const int col0 = colt + wc * 32 + 8 * fq, bcol0 = u.pn * BM + wc * 32 + 8 * fq;
        f32x4 bv[2][2];
#pragma unroll
        for (int bj = 0; bj < 2; ++bj)
#pragma unroll
            for (int n = 0; n < 2; ++n) bv[bj][n] = bias ? *(const f32x4*)(bias + bcol0 + bj * HALF + 4 * n) : (f32x4){0.f, 0.f, 0.f, 0.f};
#pragma unroll
        for (int ai = 0; ai < 2; ++ai)
#pragma unroll
            for (int m = 0; m < 4; ++m) { bf16_t* rowp = base + (size_t)(row0 + ai * HALF + m * 16) * ldc + col0;
#pragma unroll
                for (int bj = 0; bj < 2; ++bj) { f32x4 v0 = acc[ai][bj][m][0] + bv[bj][0], v1 = acc[ai][bj][m][1] + bv[bj][1];
                    if (ACT == 1) { f32x2 a = gelu_pk((f32x2){v0[0], v0[1]}), b = gelu_pk((f32x2){v0[2], v0[3]}), c = gelu_pk((f32x2){v1[0], v1[1]}), d = gelu_pk((f32x2){v1[2], v1[3]});
                        v0 = (f32x4){a.x, a.y, b.x, b.y}; v1 = (f32x4){c.x, c.y, d.x, d.y}; }
                    v0 = v0 * sc; v1 = v1 * sc; u32x4 w; w.x = cvt_pk_bf16(v0[0], v0[1]); w.y = cvt_pk_bf16(v0[2], v0[3]); w.z = cvt_pk_bf16(v1[0], v1[1]); w.w = cvt_pk_bf16(v1[2], v1[3]);
                    *(u32x4*)(rowp + bj * HALF) = w; } }
    }
};
struct EpiF32 {
    static constexpr bool PERM = false, AFTER_DRAIN = false;
    float* C; int ldc;
    __device__ __forceinline__ void operator()(const f32x4 (&acc)[2][2][4][2], const Unit& u, int wr, int wc, int fr, int fq) const {
        const int row0 = u.pm * BM + wr * 64 + fr, col0 = u.pn * BM + wc * 32 + 4 * fq;
#pragma unroll
        for (int ai = 0; ai < 2; ++ai)
#pragma unroll
            for (int m = 0; m < 4; ++m) { float* rowp = C + (size_t)(row0 + ai * HALF + m * 16) * ldc + col0;
#pragma unroll
                for (int bj = 0; bj < 2; ++bj)
#pragma unroll
                    for (int n = 0; n < 2; ++n) *(f32x4*)(rowp + bj * HALF + n * 16) = acc[ai][bj][m][n]; }
    }
};
__device__ __forceinline__ float silu_f(float x) { return x / (1.0f + __expf(-x)); }
struct EpiSwiGLU {
    static constexpr bool PERM = true, AFTER_DRAIN = false;
    bf16_t* H; int ldh; const float* comb; int ldcomb;
    __device__ __forceinline__ void operator()(const f32x4 (&acc)[2][2][4][2], const Unit& u, int wr, int wc, int fr, int fq) const {
        const int row0 = u.pm * BM + wr * 64 + fr, col0 = u.pn * 128 + wc * 32 + 8 * fq, e = u.pn >> 1;
#pragma unroll
        for (int ai = 0; ai < 2; ++ai)
#pragma unroll
            for (int m = 0; m < 4; ++m) { const int row = row0 + ai * HALF + m * 16; const float cw = comb[(size_t)row * ldcomb + e];
                const f32x4 g0 = acc[ai][0][m][0], g1 = acc[ai][0][m][1], u0 = acc[ai][1][m][0], u1 = acc[ai][1][m][1];
                f32x4 h0, h1;
#pragma unroll
                for (int j = 0; j < 4; ++j) { h0[j] = silu_f(g0[j]) * u0[j] * cw; h1[j] = silu_f(g1[j]) * u1[j] * cw; }
                u32x4 w; w.x = cvt_pk_bf16(h0[0], h0[1]); w.y = cvt_pk_bf16(h0[2], h0[3]); w.z = cvt_pk_bf16(h1[0], h1[1]); w.w = cvt_pk_bf16(h1[2], h1[3]);
                *(u32x4*)(H + (size_t)row * ldh + col0) = w; }
    }
};
template <class Epi, class Sched, bool ALIGN_EPI = false, bool SP2 = false>
__device__ __forceinline__ void gemm_phase(PG8_LAS unsigned char* lds, const Gemm g, const Sched& S, const Epi& E) {
    int tid_ = threadIdx.x; asm volatile("" : "+v"(tid_));
    const int tid = tid_, wid = __builtin_amdgcn_readfirstlane(tid >> 6), lane = tid & 63, wr = wid >> 2, wc = wid & 3, fr = lane & 15, fq = lane >> 4;
    const int K = g.K, nt = K / BK;
    unsigned voffA[2], voffB[2];
#pragma unroll
    for (int i = 0; i < 2; ++i) { int R, C; stage_rc(tid * 16 + i * 8192, R, C); const int Rb = Epi::PERM ? ((R & ~31) + perm32(R & 31)) : R;
        voffA[i] = (unsigned)(R * K + C) * 2u; voffB[i] = (unsigned)(Rb * K + C) * 2u; }
    const size_t kstep = (size_t)(BK * 2);
    const size_t hstep = (size_t)HALF * K * 2;
    const size_t tstep = 2 * hstep;
    const unsigned ldsw = (unsigned)wid * 1024u;
    const int aoff = lds_byte(wr * 64 + fr, fq * 8), boff = lds_byte(wc * 32 + fr, fq * 8);
#define PG8_SA(b, h) (((b) * 2 + (h)) * HTB)
#define PG8_SB(b, h) ((4 + (b) * 2 + (h)) * HTB)
#define PG8_STAGE(bufoff, gbase, voff) do { _Pragma("unroll") for (int _i = 0; _i < 2; ++_i) \
        __builtin_amdgcn_global_load_lds((const unsigned*)((const char*)(gbase) + (voff)[_i]), (PG8_LAS unsigned*)(lds + (bufoff) + ldsw + _i * 8192), 16, 0, 0); } while (0)
#define PG8_LDA(dst, b, h) do { _Pragma("unroll") for (int m = 0; m < 4; ++m) _Pragma("unroll") for (int k = 0; k < 2; ++k) dst[m][k] = *(const PG8_LAS bf16x8*)(lds + PG8_SA(b, h) + aoff + m * 2048 + k * 1024); } while (0)
#define PG8_LDB(dst, b, h) do { _Pragma("unroll") for (int n = 0; n < 2; ++n) _Pragma("unroll") for (int k = 0; k < 2; ++k) dst[n][k] = *(const PG8_LAS bf16x8*)(lds + PG8_SB(b, h) + boff + n * 2048 + k * 1024); } while (0)
#define PG8_MMA(ai, bj, At, Bt) do { __builtin_amdgcn_s_setprio(1); _Pragma("unroll") for (int m = 0; m < 4; ++m) _Pragma("unroll") for (int n = 0; n < 2; ++n) _Pragma("unroll") for (int k = 0; k < 2; ++k) \
        acc[ai][bj][m][n] = __builtin_amdgcn_mfma_f32_16x16x32_bf16(Bt[n][k], At[m][k], acc[ai][bj][m][n], 0, 0, 0); __builtin_amdgcn_s_setprio(0); } while (0)
#define PG8_WAIT_V(n) asm volatile("s_waitcnt vmcnt(" #n ")" ::: "memory")
#define PG8_WAIT_L(n) asm volatile("s_waitcnt lgkmcnt(" #n ")" ::: "memory")
#define PG8_BAR __builtin_amdgcn_s_barrier()
#define PG8_SCHED __builtin_amdgcn_sched_barrier(0)
    Unit cur, nxt; int ui = 0;
    if (!S.next(0, cur)) return;
    f32x4 acc[2][2][4][2];
#pragma unroll
    for (int a = 0; a < 2; ++a)
#pragma unroll
        for (int b = 0; b < 2; ++b)
#pragma unroll
            for (int m = 0; m < 4; ++m)
#pragma unroll
                for (int n = 0; n < 2; ++n) acc[a][b][m][n] = (f32x4){0.f, 0.f, 0.f, 0.f};
    bf16x8 At[4][2], B0[2][2], B1[2][2];
    const char* cA = (const char*)g.A + (size_t)cur.pm * tstep; const char* cB = (const char*)g.Bt + (size_t)cur.pn * tstep;
    S.a_ready(cur);
    if constexpr (SP2) {
        PG8_STAGE(PG8_SB(0, 0), cB, voffB); PG8_STAGE(PG8_SB(0, 1), cB + hstep, voffB); PG8_STAGE(PG8_SA(0, 0), cA, voffA); PG8_STAGE(PG8_SA(0, 1), cA + hstep, voffA);
        if (wr == 1) PG8_BAR;
        PG8_WAIT_V(2); PG8_BAR;
        PG8_STAGE(PG8_SB(1, 0), cB + kstep, voffB); PG8_STAGE(PG8_SA(1, 0), cA + kstep, voffA); PG8_STAGE(PG8_SB(1, 1), cB + hstep + kstep, voffB);
        PG8_WAIT_V(6); PG8_BAR;
    } else {
        PG8_STAGE(PG8_SB(0, 0), cB, voffB); PG8_STAGE(PG8_SA(0, 0), cA, voffA); PG8_STAGE(PG8_SB(0, 1), cB + hstep, voffB); PG8_STAGE(PG8_SA(0, 1), cA + hstep, voffA);
        if (wr == 1) PG8_BAR;
        PG8_WAIT_V(4); PG8_BAR;
        PG8_STAGE(PG8_SB(1, 0), cB + kstep, voffB); PG8_STAGE(PG8_SA(1, 0), cA + kstep, voffA); PG8_STAGE(PG8_SB(1, 1), cB + hstep + kstep, voffB);
        PG8_WAIT_V(6); PG8_BAR;
    }
    for (;;) {
        const bool has_next = S.next(ui + 1, nxt);
        const char* nA = has_next ? (const char*)g.A + (size_t)nxt.pm * tstep : cA; const char* nB = has_next ? (const char*)g.Bt + (size_t)nxt.pn * tstep : cB;
        for (int t = 0; t < nt; t += 2) {
            const bool last = (t == nt - 2);
            const char* a1 = cA + (size_t)(t + 1) * kstep;
            const char* a2 = last ? nA : cA + (size_t)(t + 2) * kstep; const char* b2 = last ? nB : cB + (size_t)(t + 2) * kstep;
            const char* a3 = a2 + kstep; const char* b3 = b2 + kstep;
            if (last && has_next) S.a_ready(nxt);
            if constexpr (SP2) {
            PG8_LDB(B0, 0, 0); PG8_LDB(B1, 0, 1); PG8_SCHED; PG8_LDA(At, 0, 0); PG8_STAGE(PG8_SA(1, 1), a1 + hstep, voffA);
            PG8_WAIT_V(8); PG8_WAIT_L(0); PG8_BAR; PG8_MMA(0, 0, At, B0); PG8_MMA(0, 1, At, B1); PG8_BAR; PG8_SCHED;
            PG8_LDA(At, 0, 1); PG8_STAGE(PG8_SB(0, 0), b2, voffB); PG8_STAGE(PG8_SB(0, 1), b2 + hstep, voffB); PG8_STAGE(PG8_SA(0, 0), a2, voffA);
            PG8_WAIT_V(8); PG8_WAIT_L(0); PG8_BAR; PG8_MMA(1, 0, At, B0); PG8_MMA(1, 1, At, B1); PG8_BAR; PG8_SCHED;
            PG8_LDB(B0, 1, 0); PG8_LDB(B1, 1, 1); PG8_SCHED; PG8_LDA(At, 1, 0); PG8_STAGE(PG8_SA(0, 1), a2 + hstep, voffA);
            PG8_WAIT_V(8); PG8_WAIT_L(0); PG8_BAR; PG8_MMA(0, 0, At, B0); PG8_MMA(0, 1, At, B1); PG8_BAR; PG8_SCHED;
            PG8_LDA(At, 1, 1); PG8_STAGE(PG8_SB(1, 0), b3, voffB); PG8_STAGE(PG8_SB(1, 1), b3 + hstep, voffB); PG8_STAGE(PG8_SA(1, 0), a3, voffA);
            PG8_WAIT_V(8); PG8_WAIT_L(0); PG8_BAR; PG8_MMA(1, 0, At, B0); PG8_MMA(1, 1, At, B1); PG8_BAR; PG8_SCHED;
            } else {
            PG8_LDB(B0, 0, 0); PG8_SCHED; PG8_LDA(At, 0, 0); PG8_STAGE(PG8_SA(1, 1), a1 + hstep, voffA);
            PG8_WAIT_L(8); PG8_BAR; PG8_WAIT_L(0); PG8_MMA(0, 0, At, B0); PG8_BAR; PG8_SCHED;
            PG8_LDB(B1, 0, 1); PG8_STAGE(PG8_SB(0, 0), b2, voffB);
            PG8_BAR; PG8_WAIT_L(0); PG8_MMA(0, 1, At, B1); PG8_BAR;
            PG8_LDA(At, 0, 1); PG8_STAGE(PG8_SA(0, 0), a2, voffA);
            PG8_BAR; PG8_WAIT_L(0); PG8_MMA(1, 0, At, B0); PG8_BAR; PG8_SCHED;
            PG8_STAGE(PG8_SB(0, 1), b2 + hstep, voffB);
            PG8_WAIT_V(6); PG8_BAR; PG8_MMA(1, 1, At, B1); PG8_BAR;
            PG8_LDB(B0, 1, 0); PG8_SCHED; PG8_LDA(At, 1, 0); PG8_STAGE(PG8_SA(0, 1), a2 + hstep, voffA);
            PG8_WAIT_L(8); PG8_BAR; PG8_WAIT_L(0); PG8_MMA(0, 0, At, B0); PG8_BAR; PG8_SCHED;
            PG8_LDB(B1, 1, 1); PG8_STAGE(PG8_SB(1, 0), b3, voffB);
            PG8_BAR; PG8_WAIT_L(0); PG8_MMA(0, 1, At, B1); PG8_BAR;
            PG8_LDA(At, 1, 1); PG8_STAGE(PG8_SA(1, 0), a3, voffA);
            PG8_BAR; PG8_WAIT_L(0); PG8_MMA(1, 0, At, B0); PG8_BAR; PG8_SCHED;
            PG8_STAGE(PG8_SB(1, 1), b3 + hstep, voffB);
            PG8_WAIT_V(6); PG8_BAR; PG8_MMA(1, 1, At, B1); PG8_BAR;
            }
        }
        if constexpr (ALIGN_EPI) { if (wr == 0) PG8_BAR; }
        if constexpr (!Epi::AFTER_DRAIN) { E(acc, cur, wr, wc, fr, fq); S.done(cur); }
        if (!has_next) break;
#pragma unroll
        for (int a = 0; a < 2; ++a)
#pragma unroll
            for (int b = 0; b < 2; ++b)
#pragma unroll
                for (int m = 0; m < 4; ++m)
#pragma unroll
                    for (int n = 0; n < 2; ++n) acc[a][b][m][n] = (f32x4){0.f, 0.f, 0.f, 0.f};
        cur = nxt; cA = nA; cB = nB; ++ui;
        if constexpr (ALIGN_EPI) { if (wr == 1) PG8_BAR; }
    }
    PG8_WAIT_V(0);
    if constexpr (!ALIGN_EPI) { if (wr == 0) PG8_BAR; }
    PG8_BAR;
    if constexpr (Epi::AFTER_DRAIN) { E.fused(acc, cur, wr, wc, fr, fq, lds, wid, lane); S.done(cur); }
#undef PG8_SA
#undef PG8_SB
#undef PG8_STAGE
#undef PG8_LDA
#undef PG8_LDB
#undef PG8_MMA
#undef PG8_WAIT_V
#undef PG8_WAIT_L
#undef PG8_BAR
#undef PG8_SCHED
}
}
#define GAS __attribute__((address_space(1)))
#define LAS __attribute__((address_space(3)))
typedef unsigned short bf16;
typedef unsigned v4u __attribute__((ext_vector_type(4)));
typedef float f32x4 __attribute__((ext_vector_type(4)));
typedef short bf16x8 __attribute__((ext_vector_type(8)));
typedef GAS unsigned gu32;
typedef GAS unsigned long long gu64;
#define RLX_AGENT __ATOMIC_RELAXED, __HIP_MEMORY_SCOPE_AGENT
#define LDS_WAIT() asm volatile("s_waitcnt lgkmcnt(0)" ::: "memory")
#define VM_WAIT() asm volatile("s_waitcnt vmcnt(0)" ::: "memory")
__device__ __forceinline__ unsigned long long rt() { return __builtin_amdgcn_s_memrealtime(); }
__device__ __forceinline__ unsigned f2bf(float f) { unsigned u = __builtin_bit_cast(unsigned, f); return (u + 0x7fffu + ((u >> 16) & 1u)) >> 16; }
__device__ __forceinline__ unsigned pk2(float lo, float hi) { return f2bf(lo) | (f2bf(hi) << 16); }

#define XB_TMO      128
#define XB_XCNT(j)  (256  + 64 * (j))
#define XB_XSUB(j)  (1280 + 64 * (j))
#define XB_XGEN(j)  (2304 + 64 * (j))
#define XB_TOP      3328
#define XB_TOPGEN   3392
#define XCD_BAR_WORDS 3456
#define XB_SPIN_CAP (1u << 18)

__device__ __forceinline__ unsigned xb_ld(unsigned* p)              { return __hip_atomic_load(p, __ATOMIC_RELAXED, __HIP_MEMORY_SCOPE_AGENT); }
__device__ __forceinline__ unsigned xb_add(unsigned* p, unsigned v) { return __hip_atomic_fetch_add(p, v, __ATOMIC_RELAXED, __HIP_MEMORY_SCOPE_AGENT); }
__device__ __forceinline__ unsigned xb_xcc_id() { return (unsigned)__builtin_amdgcn_s_getreg((3 << 11) | 20) & 0xFu; }
#define XB_SPIN(cond, bar) do { unsigned _sp = 0; while (cond) { __builtin_amdgcn_s_sleep(1); \
    if ((++_sp & 255u) == 0u) { if (xb_ld(&(bar)[XB_TMO])) break; if (_sp > XB_SPIN_CAP) { atomicAdd(&(bar)[XB_TMO], 1u); break; } } } } while (0)

struct XcdBarrier {
    unsigned* bar; unsigned x;
    volatile LAS unsigned* st;
};

__device__ __forceinline__ XcdBarrier xcd_barrier_post(unsigned* bar, volatile LAS unsigned* st) {
    XcdBarrier b; b.bar = bar; b.x = xb_xcc_id(); b.st = st;
    if (threadIdx.x == 0) (void)xb_add(&bar[XB_XCNT(b.x)], 1u);
    return b;
}
__device__ __forceinline__ void xcd_barrier_complete(unsigned* bar, unsigned x, unsigned& nloc, unsigned& nx) {
    const unsigned G = gridDim.x * gridDim.y * gridDim.z;
    unsigned sum, cnt, mine, sp = 0u;
    for (;;) {
        sum = 0u; cnt = 0u; mine = 0u;
#pragma unroll
        for (unsigned j = 0; j < 16; ++j) { const unsigned c = xb_ld(&bar[XB_XCNT(j)]); sum += c; cnt += (c > 0u) ? 1u : 0u; mine = (j == x) ? c : mine; }
        if (sum == G) break;
        __builtin_amdgcn_s_sleep(1);
        if ((++sp & 255u) == 0u) { if (xb_ld(&bar[XB_TMO])) break; if (sp > XB_SPIN_CAP) { atomicAdd(&bar[XB_TMO], 1u); break; } }
    }
    nloc = mine > 0u ? mine : 1u; nx = cnt > 0u ? cnt : 1u;
}

__device__ __forceinline__ void xcd_barrier(const XcdBarrier& b) {
    asm volatile("s_waitcnt vmcnt(0)" ::: "memory");
    __syncthreads();
    if (threadIdx.x == 0) {
        unsigned* bar = b.bar;
        __builtin_amdgcn_s_waitcnt(0);
        unsigned nloc = b.st[0], nx = b.st[1];
        if (nloc == 0u) { xcd_barrier_complete(bar, b.x, nloc, nx); b.st[0] = nloc; b.st[1] = nx; }
        const unsigned old = xb_add(&bar[XB_XSUB(b.x)], 1u);
        const unsigned gen = old / nloc;
        if (old + 1u == (gen + 1u) * nloc) {
            __builtin_amdgcn_fence(__ATOMIC_RELEASE, "agent");
            asm volatile("s_waitcnt vmcnt(0)" ::: "memory");
            const unsigned og = xb_add(&bar[XB_TOP], 1u);
            const unsigned tg = og / nx;
            if (og + 1u == (tg + 1u) * nx) xb_add(&bar[XB_TOPGEN], 1u);
            else XB_SPIN(xb_ld(&bar[XB_TOPGEN]) == tg, bar);
            __builtin_amdgcn_fence(__ATOMIC_ACQUIRE, "agent");
            xb_add(&bar[XB_XGEN(b.x)], 1u);
            asm volatile("s_waitcnt vmcnt(0)" ::: "memory");
        } else {
            XB_SPIN(xb_ld(&bar[XB_XGEN(b.x)]) == gen, bar);
            __builtin_amdgcn_fence(__ATOMIC_ACQUIRE, "agent");
            asm volatile("s_waitcnt vmcnt(0)" ::: "memory");
        }
    }
    __syncthreads();
}
constexpr int NWAVES = 8, NTHR = NWAVES * 64;
constexpr int D = 1024, BATCH = 4, SEQ = 4096, M = BATCH * SEQ, DEPTH = 4;
constexpr int IN_COLS = 6680, NPROJ = 6912;
constexpr int O_Z = 0, O_XBC = 1024, O_DT = 2560, O_QKV = 2576, O_GG = 4112, O_GB = 4624, O_GA = 4628, O_HQ = 4632, O_HF = 5144, O_HI = 5656, O_HG = 6168;
constexpr int DMIX = 2048, NEXP = 16, DEXP = 256, NGU = NEXP * 2 * DEXP  , KDN = NEXP * DEXP  ;
constexpr float DN_ALPHA = 1.6817928305074290f;
constexpr float LN_EPS = 1e-5f;

constexpr size_t MiB = 1u << 20;
constexpr size_t WS_CTL = 0, CTL_ZERO_BYTES = 1 * MiB;
constexpr size_t WS_COMB = 1 * MiB;
constexpr size_t WS_WIN = 8 * MiB;
constexpr size_t WS_WOUT = 22 * MiB;
constexpr size_t WS_WGU = 26 * MiB;
constexpr size_t WS_WDN = 42 * MiB;
constexpr size_t WS_YMIX = 52 * MiB;
constexpr size_t WS_HB = WS_YMIX;
constexpr size_t WS_PROJ = 116 * MiB;
constexpr size_t WS_MIX = WS_PROJ;
constexpr size_t WS_H = WS_PROJ + 64 * MiB;
constexpr size_t WS_SCR = 332 * MiB;
constexpr size_t WS_HG_QG = WS_SCR;
constexpr size_t WS_HG_KDT = WS_SCR + 16 * MiB;
constexpr size_t WS_HG_A = WS_SCR + 32 * MiB;
constexpr size_t WS_HG_GL = WS_SCR + 40 * MiB;
constexpr size_t WS_SSD_C = WS_SCR + 41 * MiB;
constexpr size_t WS_SSD_BT = WS_SCR + 49 * MiB;
constexpr size_t WS_SSD_CB = WS_SCR + 57 * MiB;
constexpr size_t WS_SSD_XT = WS_SCR + 65 * MiB;
constexpr size_t WS_SSD_AC = WS_SCR + 97 * MiB;
constexpr size_t WS_SSD_DT = WS_SCR + 98 * MiB;
constexpr size_t WS_GD_K = WS_SCR + 99 * MiB;
constexpr size_t WS_GD_KT = WS_SCR + 115 * MiB;
constexpr size_t WS_GD_QG = WS_SCR + 131 * MiB;
constexpr size_t WS_GD_VT = WS_SCR + 147 * MiB;
constexpr size_t WS_GD_T = WS_SCR + 163 * MiB;
constexpr size_t WS_GD_QK = WS_SCR + 171 * MiB;
constexpr size_t WS_GD_VEC = WS_SCR + 179 * MiB;
constexpr size_t WS_END = 512 * MiB;
constexpr int CW_BAR = 4096;

constexpr int RING_OFF = 0, RING_BYTES = 131072;
constexpr int LDSCTL_OFF = RING_BYTES, MISC_OFF = LDSCTL_OFF + 320;
constexpr int LDS_BYTES = 147456;

__device__ __forceinline__ float bf2f(unsigned short b) { return __builtin_bit_cast(float, ((unsigned)b) << 16); }
__device__ __forceinline__ float bflo(unsigned w) { return __builtin_bit_cast(float, w << 16); }
__device__ __forceinline__ float bfhi(unsigned w) { return __builtin_bit_cast(float, w & 0xffff0000u); }
__device__ __forceinline__ float siluf(float x) { return x / (1.0f + __expf(-x)); }
__device__ __forceinline__ float sigmoidf_(float x) { return 1.0f / (1.0f + __expf(-x)); }
__device__ __forceinline__ float softplusf_(float x) { return x > 20.f ? x : log1pf(__expf(x)); }
__device__ __forceinline__ float wave_sum(float v) {
#pragma unroll
    for (int o = 1; o < 64; o <<= 1) v += __shfl_xor(v, o);
    return v;
}

struct Args {
    const float* in[25]; float* out; unsigned char* ws; int ph_lo, ph_hi;
};
typedef const __attribute__((address_space(4))) Args* CArgs;
#define ARGS_HERE() ([]() { CArgs p_ = (CArgs)__builtin_amdgcn_kernarg_segment_ptr(); asm volatile("" : "+s"(p_)); return p_; }())
enum { I_X = 0, I_WIN, I_SCW, I_SCB, I_SDTB, I_SALOG, I_SD, I_SNW, I_GCW, I_GDTB, I_GALOG, I_GNW, I_HLB, I_HNW, I_WOUT, I_LN1G, I_LN1B, I_WRG, I_BRG, I_WRE, I_BRE, I_WGU, I_WDN, I_LN2G, I_LN2B };

__device__ __forceinline__ void transpose_item(const float* W, int ldw, int nvalid, int k0, int n0, bf16* WT, size_t ldt, int drow0, int dk0, LAS float* scr, int lane) {
#pragma unroll 8
    for (int i = 0; i < 32; ++i) { const int kk = 2 * i + (lane >> 5), nn = lane & 31, n = n0 + nn; scr[kk * 33 + nn] = (n < nvalid) ? W[(size_t)(k0 + kk) * ldw + n] : 0.f; }
    LDS_WAIT(); asm volatile("" ::: "memory");
    const int c = lane & 7;
#pragma unroll
    for (int j = 0; j < 4; ++j) { const int n = (lane >> 3) + 8 * j; const LAS float* s = scr + (8 * c) * 33 + n;
        v4u o; o.x = pk2(s[0 * 33], s[1 * 33]); o.y = pk2(s[2 * 33], s[3 * 33]); o.z = pk2(s[4 * 33], s[5 * 33]); o.w = pk2(s[6 * 33], s[7 * 33]);
        *(GAS v4u*)(WT + (size_t)(drow0 + n) * ldt + dk0 + k0 + 8 * c) = o; }
    LDS_WAIT(); asm volatile("" ::: "memory");
}
__device__ __forceinline__ void weights_phase(CArgs a, int l, const int which, LAS unsigned char* lds, int gw, int NGW, int tid) {
    asm volatile("" : "+v"(tid));
    const int lane = tid & 63, wave = tid >> 6;
    LAS float* scr = (LAS float*)(lds + wave * 16384);
    constexpr int I_IN = 16 * (NPROJ / 32), I_OUT = (DMIX / 64) * (D / 32), I_GU = NEXP * 16 * 16, I_DN = NEXP * 4 * 32;
    const int n_in = (which & 1) ? I_IN : 0, n_out = (which & 2) ? I_OUT : 0, n_gu = (which & 4) ? I_GU : 0, n_dn = (which & 8) ? I_DN : 0;
    unsigned char* ws = a->ws;
    for (int it = gw; it < n_in + n_out + n_gu + n_dn; it += NGW) {
        int r = it;
        if (r < n_in) { const int kb = r / (NPROJ / 32), nb = r % (NPROJ / 32);
            transpose_item(a->in[I_WIN] + (size_t)l * D * IN_COLS, IN_COLS, IN_COLS, 64 * kb, 32 * nb, (bf16*)(ws + WS_WIN), D, 32 * nb, 0, scr, lane); continue; }
        r -= n_in;
        if (r < n_out) { const int kb = r / (D / 32), nb = r % (D / 32);
            transpose_item(a->in[I_WOUT] + (size_t)l * DMIX * D, D, D, 64 * kb, 32 * nb, (bf16*)(ws + WS_WOUT), DMIX, 32 * nb, 0, scr, lane); continue; }
        r -= n_out;
        if (r < n_gu) { const int e = r / 256, q = r % 256, kb = q / 16, nb = q % 16, c0 = 32 * nb, bj = c0 / 256, hf = (c0 % 256) / 128, j0 = c0 % 128;
            transpose_item(a->in[I_WGU] + (size_t)(l * NEXP + e) * D * 512, 512, 512, 64 * kb, c0, (bf16*)(ws + WS_WGU), D, e * 512 + hf * 256 + bj * 128 + j0, 0, scr, lane); continue; }
        r -= n_gu;
        { const int e = r / 128, q = r % 128, kb = q / 32, nb = q % 32;
            transpose_item(a->in[I_WDN] + (size_t)(l * NEXP + e) * DEXP * D, D, D, 64 * kb, 32 * nb, (bf16*)(ws + WS_WDN), KDN, 32 * nb, e * DEXP, scr, lane); }
    }
}
__device__ __forceinline__ void p0_prologue(CArgs a, LAS unsigned char* lds, int wg, int G, int tid) {
    asm volatile("" : "+v"(tid));
    const f32x4* x4 = (const f32x4*)a->in[I_X]; f32x4* h4 = (f32x4*)a->out; unsigned long long* hb8 = (unsigned long long*)(a->ws + WS_HB);
    for (size_t i = (size_t)wg * NTHR + tid; i < (size_t)M * D / 4; i += (size_t)G * NTHR) { const f32x4 v = x4[i]; h4[i] = v;
        hb8[i] = (unsigned long long)pk2(v.x, v.y) | ((unsigned long long)pk2(v.z, v.w) << 32); }
}

__device__ __forceinline__ f32x4 mfma16(bf16x8 x, bf16x8 y, f32x4 c) { return __builtin_amdgcn_mfma_f32_16x16x32_bf16(x, y, c, 0, 0, 0); }
__device__ __forceinline__ bf16x8 lds_frag(const LAS bf16* base, int row0, int stride, int k0, int lane) { return *(const LAS bf16x8*)(base + (row0 + (lane & 15)) * stride + k0 + 8 * (lane >> 4)); }
__device__ __forceinline__ bf16x8 pack8(const float* v) { v4u w; w.x = pk2(v[0], v[1]); w.y = pk2(v[2], v[3]); w.z = pk2(v[4], v[5]); w.w = pk2(v[6], v[7]); return __builtin_bit_cast(bf16x8, w); }
__device__ __forceinline__ unsigned long long pack4(f32x4 v) { return (unsigned long long)pk2(v[0], v[1]) | ((unsigned long long)pk2(v[2], v[3]) << 32); }

__device__ __forceinline__ void hgrn_prep_phase(CArgs a, int l, LAS unsigned char* lds, int wg, int G, int tid) {
    asm volatile("" : "+v"(tid));
    constexpr int LS = 132;
    LAS float* sQ = (LAS float*)lds; LAS float* sK = sQ + 64 * LS; LAS float* sB = sK + 64 * LS; LAS float* sT = sB + 64 * LS; LAS float* sLb = sT + 512;
    const bf16* PROJ = (const bf16*)(a->ws + WS_PROJ);
    const int lane = tid & 63, w = tid >> 6, r = lane & 15, q4 = lane >> 4;
    for (int unit = wg; unit < 1024; unit += G) {
        const int b = unit >> 8, head = (unit >> 6) & 3, c = unit & 63;
        const size_t row0 = (size_t)b * SEQ + c * 64;
        __syncthreads();
        if (tid < 128) {
            const int ch = head * 128 + tid; float lg[DEPTH], mx = -1e30f;
#pragma unroll
            for (int j = 0; j < DEPTH; ++j) { lg[j] = a->in[I_HLB][j * 512 + ch]; mx = fmaxf(mx, lg[j]); }
            float den = 0.f, num = 0.f;
#pragma unroll
            for (int j = 0; j < DEPTH; ++j) { const float e = __expf(lg[j] - mx); den += e; if (j >= 1 && j <= l) num += e; }
            sLb[tid] = num / den;
        }
        __syncthreads();
        for (int p = tid; p < 1024; p += NTHR) {
            const int t = p >> 4, d8 = (p & 15) * 8;
            const v4u qv = *(const GAS v4u*)(PROJ + (row0 + t) * NPROJ + O_HQ + head * 128 + d8), fv = *(const GAS v4u*)(PROJ + (row0 + t) * NPROJ + O_HF + head * 128 + d8);
#pragma unroll
            for (int i = 0; i < 4; ++i) {
                const int d = d8 + 2 * i; const float lb0 = sLb[d], lb1 = sLb[d + 1];
                sQ[t * LS + d] = siluf(bflo(qv[i])); sQ[t * LS + d + 1] = siluf(bfhi(qv[i]));
                const float f0 = lb0 + (1.f - lb0) * sigmoidf_(bflo(fv[i])), f1 = lb1 + (1.f - lb1) * sigmoidf_(bfhi(fv[i]));
                sK[t * LS + d] = 1.f - f0; sK[t * LS + d + 1] = 1.f - f1; sB[t * LS + d] = __logf(f0); sB[t * LS + d + 1] = __logf(f1);
            }
        }
        __syncthreads();
        {
            const int d = tid & 127, seg = tid >> 7; float run = 0.f, vals[16];
#pragma unroll
            for (int i = 0; i < 16; ++i) { run += sB[(seg * 16 + i) * LS + d]; vals[i] = run; }
            sT[seg * 128 + d] = run;
            __syncthreads();
            float off = 0.f;
#pragma unroll
            for (int s2 = 0; s2 < 3; ++s2) if (s2 < seg) off += sT[s2 * 128 + d];
#pragma unroll
            for (int i = 0; i < 16; ++i) sB[(seg * 16 + i) * LS + d] = vals[i] + off;
        }
        __syncthreads();
        bf16* qg = (bf16*)(a->ws + WS_HG_QG) + (size_t)unit * 64 * 128; bf16* kdt = (bf16*)(a->ws + WS_HG_KDT) + (size_t)unit * 128 * 64;
        bf16* am = (bf16*)(a->ws + WS_HG_A) + (size_t)unit * 64 * 64; float* gl = (float*)(a->ws + WS_HG_GL) + (size_t)unit * 128;
        for (int p = tid; p < 1024; p += NTHR) { const int t = p >> 4, d8 = (p & 15) * 8; float v[8];
#pragma unroll
            for (int jj = 0; jj < 8; ++jj) v[jj] = sQ[t * LS + d8 + jj] * __expf(sB[t * LS + d8 + jj]);
            *(GAS bf16x8*)(qg + t * 128 + d8) = pack8(v); }
        for (int p = tid; p < 1024; p += NTHR) { const int d = p >> 3, s8 = (p & 7) * 8; const float bl = sB[63 * LS + d]; float v[8];
#pragma unroll
            for (int jj = 0; jj < 8; ++jj) v[jj] = sK[(s8 + jj) * LS + d] * __expf(bl - sB[(s8 + jj) * LS + d]);
            *(GAS bf16x8*)(kdt + d * 64 + s8) = pack8(v); }
        if (tid < 128) gl[tid] = __expf(sB[63 * LS + tid]);
        for (int p = w; p < 16; p += NWAVES) {
            const int i = p >> 2, j = p & 3; f32x4 acc = {0.f, 0.f, 0.f, 0.f};
            if (j <= i) {
#pragma unroll
                for (int ks = 0; ks < 4; ++ks) { const int d0 = 32 * ks + 8 * q4, t = 16 * i + r, s_ = 16 * j + r; float qf[8], kf[8];
#pragma unroll
                    for (int jj = 0; jj < 8; ++jj) { const float ref = i ? sB[(16 * i - 1) * LS + d0 + jj] : 0.f;
                        qf[jj] = sQ[t * LS + d0 + jj] * __expf(sB[t * LS + d0 + jj] - ref); kf[jj] = sK[s_ * LS + d0 + jj] * __expf(ref - sB[s_ * LS + d0 + jj]); }
                    acc = mfma16(pack8(kf), pack8(qf), acc); }
                const int t = 16 * i + r;
#pragma unroll
                for (int ii = 0; ii < 4; ++ii) if (16 * j + 4 * q4 + ii > t) acc[ii] = 0.f;
            }
            *(GAS unsigned long long*)(am + (16 * i + r) * 64 + 16 * j + 4 * q4) = pack4(acc);
        }
    }
}
__device__ __forceinline__ void hgrn_scan_phase(CArgs a, int l, LAS unsigned char* lds, const int b, const int head, const int eb, int tid) {
    asm volatile("" : "+v"(tid));
    constexpr int QS = 136, KS = 72;
    constexpr int B_QG = 0, B_KDT = 17408, B_A = B_KDT + 18432, B_VT = B_A + 9216, B_GL = B_VT + 4608, BUF = B_GL + 512;
    LAS unsigned char* sST0 = lds + 2 * BUF;
    const bf16* PROJ = (const bf16*)(a->ws + WS_PROJ); bf16* YMIX = (bf16*)(a->ws + WS_YMIX);
    const int lane = tid & 63, w = tid >> 6, r = lane & 15, q4 = lane >> 4;
    {
        const size_t cu0 = (size_t)(b * 4 + head) * 64;
        const bf16* QG = (const bf16*)(a->ws + WS_HG_QG) + cu0 * 64 * 128; const bf16* KDT = (const bf16*)(a->ws + WS_HG_KDT) + cu0 * 128 * 64;
        const bf16* AM = (const bf16*)(a->ws + WS_HG_A) + cu0 * 64 * 64; const float* GL = (const float*)(a->ws + WS_HG_GL) + cu0 * 128;
        const bf16* VP = PROJ + (size_t)b * SEQ * NPROJ + O_HI + head * 128 + eb * 32;
        v4u rq[2], rk[2], ra, rv; f32x4 rg;
#define HG_LOAD(n) do { _Pragma("unroll") for (int i = 0; i < 2; ++i) { const int p = tid + NTHR * i; rq[i] = *(const GAS v4u*)(QG + (size_t)(n) * 8192 + (p >> 4) * 128 + (p & 15) * 8); \
            rk[i] = *(const GAS v4u*)(KDT + (size_t)(n) * 8192 + (p >> 3) * 64 + (p & 7) * 8); } \
            ra = *(const GAS v4u*)(AM + (size_t)(n) * 4096 + (tid >> 3) * 64 + (tid & 7) * 8); \
            if (tid < 256) rv = *(const GAS v4u*)(VP + (size_t)((n) * 64 + (tid >> 2)) * NPROJ + (tid & 3) * 8); \
            if (tid < 32) rg = *(const GAS f32x4*)(GL + (size_t)(n) * 128 + tid * 4); } while (0)
#define HG_STORE(bufp) do { LAS unsigned char* bp_ = (bufp); _Pragma("unroll") for (int i = 0; i < 2; ++i) { const int p = tid + NTHR * i; \
            *(LAS v4u*)(bp_ + B_QG + ((p >> 4) * QS + (p & 15) * 8) * 2) = rq[i]; *(LAS v4u*)(bp_ + B_KDT + ((p >> 3) * KS + (p & 7) * 8) * 2) = rk[i]; } \
            *(LAS v4u*)(bp_ + B_A + ((tid >> 3) * KS + (tid & 7) * 8) * 2) = ra; \
            if (tid < 256) { LAS bf16* vt = (LAS bf16*)(bp_ + B_VT); const int t_ = tid >> 2, e8 = (tid & 3) * 8; _Pragma("unroll") for (int i = 0; i < 4; ++i) { \
                vt[(e8 + 2 * i) * KS + t_] = (bf16)(rv[i] & 0xffffu); vt[(e8 + 2 * i + 1) * KS + t_] = (bf16)(rv[i] >> 16); } } \
            if (tid < 32) *(LAS f32x4*)(bp_ + B_GL + tid * 16) = rg; } while (0)
        __syncthreads();
        HG_LOAD(0);
        for (int i = tid; i < 8704 / 4; i += NTHR) ((LAS unsigned*)sST0)[i] = 0u;
        HG_STORE(lds);
        f32x4 accS[2] = {{0.f, 0.f, 0.f, 0.f}, {0.f, 0.f, 0.f, 0.f}};
        __syncthreads();
        for (int n = 0; n < 64; ++n) {
            const int cur = n & 1; LAS unsigned char* bp = lds + cur * BUF; LAS bf16* sST = (LAS bf16*)(sST0 + cur * 8704); LAS bf16* sSTn = (LAS bf16*)(sST0 + (cur ^ 1) * 8704);
            if (n + 1 < 64) HG_LOAD(n + 1);
            {
                const int tt = w >> 1, et = w & 1; f32x4 acc = {0.f, 0.f, 0.f, 0.f};
#pragma unroll
                for (int ks = 0; ks < 4; ++ks) acc = mfma16(lds_frag(sST, 16 * et, QS, 32 * ks, lane), lds_frag((LAS bf16*)(bp + B_QG), 16 * tt, QS, 32 * ks, lane), acc);
#pragma unroll
                for (int ks = 0; ks < 2; ++ks) acc = mfma16(lds_frag((LAS bf16*)(bp + B_VT), 16 * et, KS, 32 * ks, lane), lds_frag((LAS bf16*)(bp + B_A), 16 * tt, KS, 32 * ks, lane), acc);
                *(GAS unsigned long long*)(YMIX + ((size_t)b * SEQ + n * 64 + 16 * tt + r) * DMIX + 1536 + head * 128 + eb * 32 + 16 * et + 4 * q4) = pack4(acc);
            }
            {
                const f32x4 glv = *(const LAS f32x4*)(bp + B_GL + (16 * w + 4 * q4) * 4);
#pragma unroll
                for (int et = 0; et < 2; ++et) { accS[et] = accS[et] * glv;
#pragma unroll
                    for (int ks = 0; ks < 2; ++ks) accS[et] = mfma16(lds_frag((LAS bf16*)(bp + B_KDT), 16 * w, KS, 32 * ks, lane), lds_frag((LAS bf16*)(bp + B_VT), 16 * et, KS, 32 * ks, lane), accS[et]);
                    *(LAS unsigned long long*)(sSTn + (16 * et + r) * QS + 16 * w + 4 * q4) = pack4(accS[et]); }
            }
            if (n + 1 < 64) HG_STORE(lds + (cur ^ 1) * BUF);
            __syncthreads();
        }
#undef HG_LOAD
#undef HG_STORE
    }
}

__device__ __forceinline__ void ssd_rec_phase(CArgs a, int l, LAS unsigned char* lds, int wg, int G, int tid) {
    asm volatile("" : "+v"(tid));
    constexpr int TB = 64;
    LAS float* sX = (LAS float*)lds; LAS float* sB = sX + TB * 16; LAS float* sC = sB + TB * 128; LAS float* sDt = sC + TB * 128; LAS float* sDa = sDt + TB; LAS float* sY = sDa + TB;
    const bf16* PROJ = (const bf16*)(a->ws + WS_PROJ); bf16* YMIX = (bf16*)(a->ws + WS_YMIX);
    const float* cw = a->in[I_SCW] + (size_t)l * 4 * 1536; const float* cb = a->in[I_SCB] + (size_t)l * 1536;
    const int p_local = tid >> 5, nq = tid & 31;
    for (int unit = wg; unit < 256; unit += G) {
        const int b = unit >> 6, head = (unit >> 2) & 15, pq = unit & 3, g = head >> 3;
        const float A = -__expf(a->in[I_SALOG][l * 16 + head]), dtb = a->in[I_SDTB][l * 16 + head], Dsk = a->in[I_SD][l * 16 + head];
        float h0 = 0.f, h1 = 0.f, h2 = 0.f, h3 = 0.f;
        for (int t0 = 0; t0 < SEQ; t0 += TB) {
            __syncthreads();
            for (int idx = tid; idx < TB * 272; idx += NTHR) {
                const int tt = idx / 272, ci = idx % 272, t = t0 + tt;
                const int ch = ci < 16 ? head * 64 + pq * 16 + ci : (ci < 144 ? 1024 + g * 128 + (ci - 16) : 1280 + g * 128 + (ci - 144));
                float acc = cb[ch];
#pragma unroll
                for (int k = 0; k < 4; ++k) { const int ts = t - 3 + k; if (ts >= 0) acc += cw[k * 1536 + ch] * bf2f(PROJ[(size_t)(b * SEQ + ts) * NPROJ + O_XBC + ch]); }
                const float v = siluf(acc);
                if (ci < 16) sX[tt * 16 + ci] = v; else if (ci < 144) sB[tt * 128 + ci - 16] = v; else sC[tt * 128 + ci - 144] = v;
            }
            if (tid < TB) { const float raw = bf2f(PROJ[(size_t)(b * SEQ + t0 + tid) * NPROJ + O_DT + head]); const float dt = softplusf_(raw + dtb); sDt[tid] = dt; sDa[tid] = __expf(dt * A); }
            __syncthreads();
#pragma unroll 4
            for (int tt = 0; tt < TB; ++tt) {
                const float xv = sX[tt * 16 + p_local], da = sDa[tt], dx = sDt[tt] * xv;
                const f32x4 Bv = *(const LAS f32x4*)(sB + tt * 128 + nq * 4), Cv = *(const LAS f32x4*)(sC + tt * 128 + nq * 4);
                h0 = da * h0 + dx * Bv.x; h1 = da * h1 + dx * Bv.y; h2 = da * h2 + dx * Bv.z; h3 = da * h3 + dx * Bv.w;
                float part = (Cv.x * h0 + Cv.y * h1) + (Cv.z * h2 + Cv.w * h3);
                part += __shfl_xor(part, 1); part += __shfl_xor(part, 2); part += __shfl_xor(part, 4); part += __shfl_xor(part, 8); part += __shfl_xor(part, 16);
                if (nq == 0) sY[tt * 16 + p_local] = part + Dsk * xv;
            }
            __syncthreads();
            for (int idx = tid; idx < TB * 16; idx += NTHR) { const int tt = idx >> 4, i = idx & 15; YMIX[(size_t)(b * SEQ + t0 + tt) * DMIX + head * 64 + pq * 16 + i] = (bf16)f2bf(sY[idx]); }
        }
    }
}

__device__ __forceinline__ void ssd_prep_phase(CArgs a, int l, LAS unsigned char* lds, int wg, int G, int tid) {
    asm volatile("" : "+v"(tid));
    constexpr int PS = 136;
    LAS bf16* sB = (LAS bf16*)lds; LAS bf16* sC = sB + 128 * PS; LAS bf16* sXT = (LAS bf16*)lds; LAS float* sDt = (LAS float*)(lds + 2 * 128 * PS * 2);
    const bf16* PROJ = (const bf16*)(a->ws + WS_PROJ);
    const float* cw = a->in[I_SCW] + (size_t)l * 4 * 1536; const float* cb = a->in[I_SCB] + (size_t)l * 1536;
    const int lane = tid & 63, w = tid >> 6, r = lane & 15, q4 = lane >> 4;
    for (int unit = wg; unit < 256; unit += G) {
        const int b = unit >> 6, c = (unit >> 1) & 31, g = unit & 1;
        const size_t row0 = (size_t)b * SEQ + c * 128;
        bf16* Cg = (bf16*)(a->ws + WS_SSD_C) + (size_t)unit * 16384; bf16* BTg = (bf16*)(a->ws + WS_SSD_BT) + (size_t)unit * 16384; bf16* CBg = (bf16*)(a->ws + WS_SSD_CB) + (size_t)unit * 16384;
        __syncthreads();
        {
            const int c16 = tid & 31, l0 = tid >> 5; const int ch = (c16 < 16 ? 1024 + g * 128 + c16 * 8 : 1280 + g * 128 + (c16 - 16) * 8);
            float wk[4][8], bias[8];
#pragma unroll
            for (int jj = 0; jj < 8; ++jj) { bias[jj] = cb[ch + jj];
#pragma unroll
                for (int k = 0; k < 4; ++k) wk[k][jj] = cw[k * 1536 + ch + jj]; }
            LAS bf16* dst = (c16 < 16 ? sB : sC) + (c16 & 15) * 8;
#pragma unroll 2
            for (int i = 0; i < 8; ++i) { const int ll = l0 + 16 * i; float acc[8];
#pragma unroll
                for (int jj = 0; jj < 8; ++jj) acc[jj] = bias[jj];
#pragma unroll
                for (int k = 0; k < 4; ++k) { const int ts = c * 128 + ll - 3 + k;
                    if (ts >= 0) { const v4u xv = *(const GAS v4u*)(PROJ + ((size_t)b * SEQ + ts) * NPROJ + O_XBC + ch);
#pragma unroll
                        for (int j = 0; j < 4; ++j) { acc[2 * j] += wk[k][2 * j] * bflo(xv[j]); acc[2 * j + 1] += wk[k][2 * j + 1] * bfhi(xv[j]); } } }
#pragma unroll
                for (int jj = 0; jj < 8; ++jj) acc[jj] = siluf(acc[jj]);
                *(LAS bf16x8*)(dst + ll * PS) = pack8(acc); }
        }
        {
            const int head = g * 8 + w; const float A = -__expf(a->in[I_SALOG][l * 16 + head]), dtb = a->in[I_SDTB][l * 16 + head];
            const int l2 = 2 * lane;
            const float dt0 = softplusf_(bf2f(PROJ[(row0 + l2) * NPROJ + O_DT + head]) + dtb), dt1 = softplusf_(bf2f(PROJ[(row0 + l2 + 1) * NPROJ + O_DT + head]) + dtb);
            const float da1 = dt1 * A; float sc = dt0 * A + da1;
#pragma unroll
            for (int o = 1; o < 64; o <<= 1) { const float t_ = __shfl_up(sc, o); if (lane >= o) sc += t_; }
            sDt[w * 128 + l2] = dt0; sDt[w * 128 + l2 + 1] = dt1;
            const size_t uh = (size_t)((b * 16 + head) * 32 + c) * 128;
            float* AC = (float*)(a->ws + WS_SSD_AC) + uh; float* DT = (float*)(a->ws + WS_SSD_DT) + uh;
            AC[l2] = sc - da1; AC[l2 + 1] = sc; DT[l2] = dt0; DT[l2 + 1] = dt1;
        }
        __syncthreads();
#pragma unroll
        for (int st = 0; st < 8; ++st) {
            f32x4 acc = {0.f, 0.f, 0.f, 0.f};
            if (st <= w) {
#pragma unroll
                for (int ks = 0; ks < 4; ++ks) acc = mfma16(lds_frag(sB, 16 * st, PS, 32 * ks, lane), lds_frag(sC, 16 * w, PS, 32 * ks, lane), acc); }
            *(GAS unsigned long long*)(CBg + (16 * w + r) * 128 + 16 * st + 4 * q4) = pack4(acc);
        }
        for (int p = tid; p < 2048; p += NTHR) { const int ll = p >> 4, n8 = (p & 15) * 8; *(GAS v4u*)(Cg + ll * 128 + n8) = *(const LAS v4u*)(sC + ll * PS + n8); }
        for (int p = tid; p < 2048; p += NTHR) { const int n = p >> 4, l8 = (p & 15) * 8; v4u o;
#pragma unroll
            for (int j = 0; j < 4; ++j) o[j] = (unsigned)sB[(l8 + 2 * j) * PS + n] | ((unsigned)sB[(l8 + 2 * j + 1) * PS + n] << 16);
            *(GAS v4u*)(BTg + n * 128 + l8) = o; }
#pragma unroll 1
        for (int hf = 0; hf < 2; ++hf) {
            __syncthreads();
            {   const int cg = tid & 31, l0 = tid >> 5, chl = cg * 8, ch = g * 512 + hf * 256 + chl, hh = hf * 4 + (cg >> 3);
                float wk[4][8], bias[8];
#pragma unroll
                for (int jj = 0; jj < 8; ++jj) { bias[jj] = cb[ch + jj];
#pragma unroll
                    for (int k = 0; k < 4; ++k) wk[k][jj] = cw[k * 1536 + ch + jj]; }
#pragma unroll 2
                for (int i = 0; i < 8; ++i) { const int ll = l0 + 16 * i; float acc[8];
#pragma unroll
                    for (int jj = 0; jj < 8; ++jj) acc[jj] = bias[jj];
#pragma unroll
                    for (int k = 0; k < 4; ++k) { const int ts = c * 128 + ll - 3 + k;
                        if (ts >= 0) { const v4u xv = *(const GAS v4u*)(PROJ + ((size_t)b * SEQ + ts) * NPROJ + O_XBC + ch);
#pragma unroll
                            for (int j = 0; j < 4; ++j) { acc[2 * j] += wk[k][2 * j] * bflo(xv[j]); acc[2 * j + 1] += wk[k][2 * j + 1] * bfhi(xv[j]); } } }
                    const float dtv = sDt[hh * 128 + ll];
#pragma unroll
                    for (int jj = 0; jj < 8; ++jj) sXT[(chl + jj) * PS + ll] = (bf16)f2bf(siluf(acc[jj]) * dtv); }
            }
            __syncthreads();
            for (int p = tid; p < 4096; p += NTHR) { const int chl = p >> 4, l8 = (p & 15) * 8, hh = hf * 4 + (chl >> 6), pp = chl & 63;
                const size_t uh = (size_t)((b * 16 + g * 8 + hh) * 32 + c);
                *(GAS v4u*)((bf16*)(a->ws + WS_SSD_XT) + (uh * 64 + pp) * 128 + l8) = *(const LAS v4u*)(sXT + chl * PS + l8); }
        }
    }
}
__device__ __forceinline__ void ssd_scan_phase(CArgs a, int l, LAS unsigned char* lds, const int b, const int head, int tid) {
    asm volatile("" : "+v"(tid));
    constexpr int PS = 136, O_S = 0, O_X = 34816, O_AC = 69632, O_TE = 70656, O_DT = 71680;
    bf16* YMIX = (bf16*)(a->ws + WS_YMIX);
    const int lane = tid & 63, w = tid >> 6, r = lane & 15, q4 = lane >> 4;
    {
        const int g = head >> 3;
        const float Dsk = a->in[I_SD][l * 16 + head];
        const bf16* Cg = (const bf16*)(a->ws + WS_SSD_C) + (size_t)((b * 32) * 2 + g) * 16384 + (16 * w + r) * 128 + 8 * q4;
        const bf16* CBg = (const bf16*)(a->ws + WS_SSD_CB) + (size_t)((b * 32) * 2 + g) * 16384 + (16 * w + r) * 128 + 8 * q4;
        const bf16* BTg = (const bf16*)(a->ws + WS_SSD_BT) + (size_t)((b * 32) * 2 + g) * 16384 + (16 * w + r) * 128 + 8 * q4;
        const size_t uh0 = (size_t)(b * 16 + head) * 32;
        const bf16* XTg = (const bf16*)(a->ws + WS_SSD_XT) + uh0 * 8192; const float* ACg = (const float*)(a->ws + WS_SSD_AC) + uh0 * 128; const float* DTg = (const float*)(a->ws + WS_SSD_DT) + uh0 * 128;
        v4u fC[4], fCB[4], fBT[4], nC[4], nCB[4], nBT[4], rx[2]; float rac = 0.f, racl = 0.f, rdt = 0.f;
#define SSD_LOAD(cc, dC, dCB, dBT) do { _Pragma("unroll") for (int ks = 0; ks < 4; ++ks) { dC[ks] = *(const GAS v4u*)(Cg + (size_t)(cc) * 32768 + 32 * ks); dCB[ks] = *(const GAS v4u*)(CBg + (size_t)(cc) * 32768 + 32 * ks); \
            dBT[ks] = *(const GAS v4u*)(BTg + (size_t)(cc) * 32768 + 32 * ks); } \
            _Pragma("unroll") for (int i = 0; i < 2; ++i) { const int p = tid + NTHR * i; rx[i] = *(const GAS v4u*)(XTg + (size_t)(cc) * 8192 + (p >> 4) * 128 + (p & 15) * 8); } \
            if (tid < 128) { rac = ACg[(cc) * 128 + tid]; racl = ACg[(cc) * 128 + 127]; rdt = DTg[(cc) * 128 + tid]; } } while (0)
#define SSD_STORE(bi) do { _Pragma("unroll") for (int i = 0; i < 2; ++i) { const int p = tid + NTHR * i; *(LAS v4u*)(lds + O_X + (bi) * 17408 + ((p >> 4) * PS + (p & 15) * 8) * 2) = rx[i]; } \
            if (tid < 128) { ((LAS float*)(lds + O_AC))[(bi) * 128 + tid] = rac; ((LAS float*)(lds + O_TE))[(bi) * 128 + tid] = __expf(racl - rac); ((LAS float*)(lds + O_DT))[(bi) * 128 + tid] = rdt; } } while (0)
        __syncthreads();
        SSD_LOAD(0, fC, fCB, fBT);
        for (int i = tid; i < 17408 / 4; i += NTHR) ((LAS unsigned*)(lds + O_S))[i] = 0u;
        SSD_STORE(0);
        f32x4 accS[4];
#pragma unroll
        for (int pt = 0; pt < 4; ++pt) accS[pt] = (f32x4){0.f, 0.f, 0.f, 0.f};
        __syncthreads();
        for (int c = 0; c < 32; ++c) {
            const int cur = c & 1;
            const LAS bf16* sS = (const LAS bf16*)(lds + O_S + cur * 17408); LAS bf16* sSn = (LAS bf16*)(lds + O_S + (cur ^ 1) * 17408); const LAS bf16* sXT = (const LAS bf16*)(lds + O_X + cur * 17408);
            const LAS float* sAc = (const LAS float*)(lds + O_AC) + cur * 128; const LAS float* sTe = (const LAS float*)(lds + O_TE) + cur * 128; const LAS float* sDt = (const LAS float*)(lds + O_DT) + cur * 128;
            if (c + 1 < 32) SSD_LOAD(c + 1, nC, nCB, nBT);
            const int lrow = 16 * w + r; const float ac_l = sAc[lrow];
            f32x4 accO[4], accD[4];
#pragma unroll
            for (int pt = 0; pt < 4; ++pt) { accO[pt] = (f32x4){0.f, 0.f, 0.f, 0.f}; accD[pt] = (f32x4){0.f, 0.f, 0.f, 0.f}; }
#pragma unroll
            for (int ks = 0; ks < 4; ++ks) { const bf16x8 yf = __builtin_bit_cast(bf16x8, fC[ks]);
#pragma unroll
                for (int pt = 0; pt < 4; ++pt) accO[pt] = mfma16(lds_frag(sS, 16 * pt, PS, 32 * ks, lane), yf, accO[pt]); }
#pragma unroll
            for (int ks = 0; ks < 4; ++ks) if (32 * ks <= 16 * w + 15) {
                float v[8]; const f32x4 a0 = *(const LAS f32x4*)(sAc + 32 * ks + 8 * q4), a1 = *(const LAS f32x4*)(sAc + 32 * ks + 8 * q4 + 4);
#pragma unroll
                for (int j = 0; j < 4; ++j) { const int s0 = 32 * ks + 8 * q4 + 2 * j; const float as0 = (2 * j < 4) ? a0[(2 * j) & 3] : a1[(2 * j) & 3], as1 = (2 * j + 1 < 4) ? a0[(2 * j + 1) & 3] : a1[(2 * j + 1) & 3];
                    v[2 * j] = (s0 <= lrow) ? bflo(fCB[ks][j]) * __expf(ac_l - as0) : 0.f; v[2 * j + 1] = (s0 + 1 <= lrow) ? bfhi(fCB[ks][j]) * __expf(ac_l - as1) : 0.f; }
                const bf16x8 yf = pack8(v);
#pragma unroll
                for (int pt = 0; pt < 4; ++pt) accD[pt] = mfma16(lds_frag(sXT, 16 * pt, PS, 32 * ks, lane), yf, accD[pt]); }
            {   const float ea = __expf(ac_l), rdtl = Dsk / sDt[lrow];
#pragma unroll
                for (int pt = 0; pt < 4; ++pt) { f32x4 y = accO[pt] * ea + accD[pt];
#pragma unroll
                    for (int ii = 0; ii < 4; ++ii) y[ii] += rdtl * bf2f(sXT[(16 * pt + 4 * q4 + ii) * PS + lrow]);
                    *(GAS unsigned long long*)(YMIX + ((size_t)b * SEQ + c * 128 + lrow) * DMIX + head * 64 + 16 * pt + 4 * q4) = pack4(y); } }
            {   const float cd = __expf(sAc[127]);
#pragma unroll
                for (int pt = 0; pt < 4; ++pt) accS[pt] = accS[pt] * cd;
#pragma unroll
                for (int ks = 0; ks < 4; ++ks) { float v[8]; const f32x4 t0 = *(const LAS f32x4*)(sTe + 32 * ks + 8 * q4), t1 = *(const LAS f32x4*)(sTe + 32 * ks + 8 * q4 + 4);
#pragma unroll
                    for (int j = 0; j < 4; ++j) { const float ts0 = (2 * j < 4) ? t0[(2 * j) & 3] : t1[(2 * j) & 3], ts1 = (2 * j + 1 < 4) ? t0[(2 * j + 1) & 3] : t1[(2 * j + 1) & 3];
                        v[2 * j] = bflo(fBT[ks][j]) * ts0; v[2 * j + 1] = bfhi(fBT[ks][j]) * ts1; }
                    const bf16x8 xf = pack8(v);
#pragma unroll
                    for (int pt = 0; pt < 4; ++pt) accS[pt] = mfma16(xf, lds_frag(sXT, 16 * pt, PS, 32 * ks, lane), accS[pt]); }
#pragma unroll
                for (int pt = 0; pt < 4; ++pt) *(LAS unsigned long long*)(sSn + (16 * pt + r) * PS + 16 * w + 4 * q4) = pack4(accS[pt]);
            }
            if (c + 1 < 32) { SSD_STORE(cur ^ 1);
#pragma unroll
                for (int ks = 0; ks < 4; ++ks) { fC[ks] = nC[ks]; fCB[ks] = nCB[ks]; fBT[ks] = nBT[ks]; } }
            __syncthreads();
        }
#undef SSD_LOAD
#undef SSD_STORE
    }
}

__device__ __forceinline__ void gdn_prep_phase(CArgs a, int l, LAS unsigned char* lds, int wg, int G, int tid) {
    asm volatile("" : "+v"(tid));
    constexpr int PS = 136, TS = 72, MS = 68, TT = 65;
    LAS bf16* sKb = (LAS bf16*)lds; LAS bf16* sQb = sKb + 64 * PS; LAS bf16* sQG = sQb + 64 * PS; LAS bf16* sVT = sQG + 64 * PS;
    LAS float* sM = (LAS float*)(lds + 3 * 17408 + 18432); LAS float* sT = sM + 64 * MS; LAS float* sVec = sT + 64 * TT;
    const bf16* PROJ = (const bf16*)(a->ws + WS_PROJ);
    const float* cw = a->in[I_GCW] + (size_t)l * 4 * 1536;
    const int lane = tid & 63, w = tid >> 6, r = lane & 15, q4 = lane >> 4;
    for (int unit = wg; unit < 1024; unit += G) {
        const int b = unit >> 8, head = (unit >> 6) & 3, n = unit & 63;
        const size_t row0 = (size_t)b * SEQ + n * 64;
        bf16* GK = (bf16*)(a->ws + WS_GD_K) + (size_t)unit * 8192; bf16* GKT = (bf16*)(a->ws + WS_GD_KT) + (size_t)unit * 8192; bf16* GQG = (bf16*)(a->ws + WS_GD_QG) + (size_t)unit * 8192;
        bf16* GVT = (bf16*)(a->ws + WS_GD_VT) + (size_t)unit * 8192; bf16* GT = (bf16*)(a->ws + WS_GD_T) + (size_t)unit * 4096; bf16* GQK = (bf16*)(a->ws + WS_GD_QK) + (size_t)unit * 4096;
        float* GVEC = (float*)(a->ws + WS_GD_VEC) + (size_t)unit * 256;
        __syncthreads();
        for (int i = tid; i < 64 * MS; i += NTHR) sM[i] = 0.f;
        if (w == 0) {
            const float nA = -__expf(a->in[I_GALOG][l * 4 + head]), dtb = a->in[I_GDTB][l * 4 + head];
            const size_t ro = (row0 + lane) * NPROJ;
            const float be = sigmoidf_(bf2f(PROJ[ro + O_GB + head])); float gsum = nA * softplusf_(bf2f(PROJ[ro + O_GA + head]) + dtb);
#pragma unroll
            for (int o = 1; o < 64; o <<= 1) { const float t_ = __shfl_up(gsum, o); if (lane >= o) gsum += t_; }
            const float glast = __shfl(gsum, 63), eg = __expf(gsum), cc = __expf(glast - gsum);
            sVec[lane] = gsum; sVec[64 + lane] = be; sVec[128 + lane] = eg;
            GVEC[lane] = be; GVEC[64 + lane] = eg; GVEC[128 + lane] = cc; GVEC[192 + lane] = __expf(glast);
        }
        __syncthreads();
        {
            float wq[4][2], wk_[4][2], wv[4][2];
#pragma unroll
            for (int k = 0; k < 4; ++k)
#pragma unroll
                for (int j = 0; j < 2; ++j) { wq[k][j] = cw[k * 1536 + head * 128 + 2 * lane + j]; wk_[k][j] = cw[k * 1536 + 512 + head * 128 + 2 * lane + j]; wv[k][j] = cw[k * 1536 + 1024 + head * 128 + 2 * lane + j]; }
#pragma unroll 2
            for (int i = 0; i < 8; ++i) { const int t = w + 8 * i; float q0 = 0.f, q1 = 0.f, k0 = 0.f, k1 = 0.f, v0 = 0.f, v1 = 0.f;
#pragma unroll
                for (int k = 0; k < 4; ++k) { const int ts = n * 64 + t - 3 + k;
                    if (ts >= 0) { const bf16* pr = PROJ + ((size_t)b * SEQ + ts) * NPROJ + O_QKV + head * 128 + 2 * lane;
                        const unsigned xq = *(const GAS unsigned*)pr, xk = *(const GAS unsigned*)(pr + 512), xv = *(const GAS unsigned*)(pr + 1024);
                        q0 += wq[k][0] * bflo(xq); q1 += wq[k][1] * bfhi(xq); k0 += wk_[k][0] * bflo(xk); k1 += wk_[k][1] * bfhi(xk); v0 += wv[k][0] * bflo(xv); v1 += wv[k][1] * bfhi(xv); } }
                q0 = siluf(q0); q1 = siluf(q1); k0 = siluf(k0); k1 = siluf(k1); v0 = siluf(v0); v1 = siluf(v1);
                const float sq = rsqrtf(wave_sum(q0 * q0 + q1 * q1) + 1e-6f) * 0.08838834764831845f, sk = rsqrtf(wave_sum(k0 * k0 + k1 * k1) + 1e-6f), eg = sVec[128 + t];
                *(LAS unsigned*)(sKb + t * PS + 2 * lane) = pk2(k0 * sk, k1 * sk); *(LAS unsigned*)(sQb + t * PS + 2 * lane) = pk2(q0 * sq, q1 * sq);
                *(LAS unsigned*)(sQG + t * PS + 2 * lane) = pk2(q0 * sq * eg, q1 * sq * eg);
                sVT[(2 * lane) * TS + t] = (bf16)f2bf(v0); sVT[(2 * lane + 1) * TS + t] = (bf16)f2bf(v1); }
        }
        __syncthreads();
        for (int p = w; p < 26; p += NWAVES) {
            int it, jt; bool isq;
            if (p < 10) { isq = false; it = p < 1 ? 0 : (p < 3 ? 1 : (p < 6 ? 2 : 3)); jt = p - (it * (it + 1)) / 2; } else { isq = true; it = (p - 10) >> 2; jt = (p - 10) & 3; }
            f32x4 acc = {0.f, 0.f, 0.f, 0.f};
            if (jt <= it) {
#pragma unroll
                for (int ks = 0; ks < 4; ++ks) acc = mfma16(lds_frag(sKb, 16 * jt, PS, 32 * ks, lane), lds_frag(isq ? sQb : sKb, 16 * it, PS, 32 * ks, lane), acc);
                const int i = 16 * it + r; const float gi = sVec[i], bi = sVec[64 + i];
#pragma unroll
                for (int ii = 0; ii < 4; ++ii) { const int j = 16 * jt + 4 * q4 + ii; const float dec = __expf(gi - sVec[j]);
                    acc[ii] = isq ? (j <= i ? acc[ii] * dec : 0.f) : (j < i ? acc[ii] * dec * bi : 0.f); }
            }
            if (isq) *(GAS unsigned long long*)(GQK + (16 * it + r) * 64 + 16 * jt + 4 * q4) = pack4(acc);
            else *(LAS f32x4*)(sM + (16 * it + r) * MS + 16 * jt + 4 * q4) = acc;
        }
        __syncthreads();
        if (w == 0) {
            int zo = 0; asm volatile("" : "+v"(zo)); const LAS float* sMv = sM + zo;
            float U[64];
#pragma unroll
            for (int i = 0; i < 64; ++i) { float a0 = -sMv[i * MS + lane], a1 = 0.f, a2 = 0.f, a3 = 0.f;
#pragma unroll
                for (int j4 = 0; j4 < (i + 3) / 4; ++j4) { const f32x4 m = *(const LAS f32x4*)(sMv + i * MS + 4 * j4);
                    if (4 * j4 + 0 < i) a0 -= m[0] * U[4 * j4 + 0]; if (4 * j4 + 1 < i) a1 -= m[1] * U[4 * j4 + 1]; if (4 * j4 + 2 < i) a2 -= m[2] * U[4 * j4 + 2]; if (4 * j4 + 3 < i) a3 -= m[3] * U[4 * j4 + 3]; }
                U[i] = (a0 + a1) + (a2 + a3); sT[i * TT + lane] = U[i]; }
        } else {
            const int t7 = tid - 64;
            for (int p = t7; p < 1024; p += NTHR - 64) { const int t = p >> 4, d8 = (p & 15) * 8; *(GAS v4u*)(GK + t * 128 + d8) = *(const LAS v4u*)(sKb + t * PS + d8); *(GAS v4u*)(GQG + t * 128 + d8) = *(const LAS v4u*)(sQG + t * PS + d8); }
            for (int p = t7; p < 1024; p += NTHR - 64) { const int d = p >> 3, s8 = (p & 7) * 8; v4u o;
#pragma unroll
                for (int j = 0; j < 4; ++j) o[j] = (unsigned)sKb[(s8 + 2 * j) * PS + d] | ((unsigned)sKb[(s8 + 2 * j + 1) * PS + d] << 16);
                *(GAS v4u*)(GKT + d * 64 + s8) = o; *(GAS v4u*)(GVT + d * 64 + s8) = *(const LAS v4u*)(sVT + d * TS + s8); }
        }
        __syncthreads();
        { const int t = tid >> 3, s8 = (tid & 7) * 8; float v[8];
#pragma unroll
            for (int jj = 0; jj < 8; ++jj) v[jj] = sT[t * TT + s8 + jj] + ((s8 + jj == t) ? 1.f : 0.f);
            *(GAS bf16x8*)(GT + t * 64 + s8) = pack8(v); }
    }
}
__device__ __forceinline__ void gdn_scan_phase(CArgs a, int l, LAS unsigned char* lds, const int b, const int head, const int eb, int tid) {
    asm volatile("" : "+v"(tid));
    constexpr int PS = 136, TS = 72, O_ST = 0, O_RT = 34816, O_VN = O_RT + 9216, O_VC = O_VN + 9216;
    bf16* YMIX = (bf16*)(a->ws + WS_YMIX);
    const int lane = tid & 63, w = tid >> 6, r = lane & 15, q4 = lane >> 4, st = w >> 1, eh = w & 1;
    LAS bf16* sRT = (LAS bf16*)(lds + O_RT); LAS bf16* sVN = (LAS bf16*)(lds + O_VN); LAS bf16* sVC = (LAS bf16*)(lds + O_VC);
    {
        const size_t u0 = (size_t)(b * 4 + head) * 64;
        const bf16* pK = (const bf16*)(a->ws + WS_GD_K) + u0 * 8192 + (16 * st + r) * 128 + 8 * q4; const bf16* pQG = (const bf16*)(a->ws + WS_GD_QG) + u0 * 8192 + (16 * st + r) * 128 + 8 * q4;
        const bf16* pT = (const bf16*)(a->ws + WS_GD_T) + u0 * 4096 + (16 * st + r) * 64 + 8 * q4; const bf16* pQK = (const bf16*)(a->ws + WS_GD_QK) + u0 * 4096 + (16 * st + r) * 64 + 8 * q4;
        const bf16* pKT = (const bf16*)(a->ws + WS_GD_KT) + u0 * 8192 + (16 * w + r) * 64 + 8 * q4;
        const bf16* pVT = (const bf16*)(a->ws + WS_GD_VT) + u0 * 8192 + (size_t)(eb * 64 + 32 * eh + r) * 64 + 16 * st + 4 * q4;
        const float* pVec = (const float*)(a->ws + WS_GD_VEC) + u0 * 256 + 16 * st + 4 * q4;
        v4u xK[4], xT[2], yQG[4], yQK[2], xKT[2], nK[4], nT[2], nQG[4], nQK[2], nKT[2]; unsigned long long vT[2], nvT[2]; f32x4 be4, eg4, c4, nbe4, neg4, nc4; float gl, ngl;
#define GD_LOAD(nn, K_, T_, QG_, QK_, KT_, V_, B_, E_, C_, G_) do { _Pragma("unroll") for (int ks = 0; ks < 4; ++ks) { K_[ks] = *(const GAS v4u*)(pK + (size_t)(nn) * 8192 + 32 * ks); QG_[ks] = *(const GAS v4u*)(pQG + (size_t)(nn) * 8192 + 32 * ks); } \
            _Pragma("unroll") for (int ks = 0; ks < 2; ++ks) { T_[ks] = *(const GAS v4u*)(pT + (size_t)(nn) * 4096 + 32 * ks); QK_[ks] = *(const GAS v4u*)(pQK + (size_t)(nn) * 4096 + 32 * ks); KT_[ks] = *(const GAS v4u*)(pKT + (size_t)(nn) * 8192 + 32 * ks); } \
            _Pragma("unroll") for (int j = 0; j < 2; ++j) V_[j] = *(const GAS unsigned long long*)(pVT + (size_t)(nn) * 8192 + j * 16 * 64); \
            B_ = *(const GAS f32x4*)(pVec + (size_t)(nn) * 256); E_ = *(const GAS f32x4*)(pVec + (size_t)(nn) * 256 + 64); C_ = *(const GAS f32x4*)(pVec + (size_t)(nn) * 256 + 128); G_ = pVec[(size_t)(nn) * 256 + 192 - (16 * st + 4 * q4)]; } while (0)
        __syncthreads();
        GD_LOAD(0, xK, xT, yQG, yQK, xKT, vT, be4, eg4, c4, gl);
        for (int i = tid; i < 17408 / 4; i += NTHR) ((LAS unsigned*)(lds + O_ST))[i] = 0u;
        f32x4 accS[4];
#pragma unroll
        for (int et = 0; et < 4; ++et) accS[et] = (f32x4){0.f, 0.f, 0.f, 0.f};
        __syncthreads();
        for (int n = 0; n < 64; ++n) {
            const int cur = n & 1; const LAS bf16* sST = (const LAS bf16*)(lds + O_ST + cur * 17408); LAS bf16* sSTn = (LAS bf16*)(lds + O_ST + (cur ^ 1) * 17408);
            if (n + 1 < 64) GD_LOAD(n + 1, nK, nT, nQG, nQK, nKT, nvT, nbe4, neg4, nc4, ngl);
#pragma unroll
            for (int j = 0; j < 2; ++j) {
                const int e0 = 16 * (2 * eh + j); f32x4 acc = {0.f, 0.f, 0.f, 0.f};
#pragma unroll
                for (int ks = 0; ks < 4; ++ks) acc = mfma16(__builtin_bit_cast(bf16x8, xK[ks]), lds_frag(sST, e0, PS, 32 * ks, lane), acc);
                const unsigned vlo = (unsigned)vT[j], vhi = (unsigned)(vT[j] >> 32); f32x4 rr;
                rr[0] = be4[0] * (bflo(vlo) - eg4[0] * acc[0]); rr[1] = be4[1] * (bfhi(vlo) - eg4[1] * acc[1]); rr[2] = be4[2] * (bflo(vhi) - eg4[2] * acc[2]); rr[3] = be4[3] * (bfhi(vhi) - eg4[3] * acc[3]);
                *(LAS unsigned long long*)(sRT + (e0 + r) * TS + 16 * st + 4 * q4) = pack4(rr); }
            __syncthreads();
#pragma unroll
            for (int j = 0; j < 2; ++j) {
                const int e0 = 16 * (2 * eh + j); f32x4 acc = {0.f, 0.f, 0.f, 0.f};
#pragma unroll
                for (int ks = 0; ks < 2; ++ks) acc = mfma16(__builtin_bit_cast(bf16x8, xT[ks]), lds_frag(sRT, e0, TS, 32 * ks, lane), acc);
                *(LAS unsigned long long*)(sVN + (e0 + r) * TS + 16 * st + 4 * q4) = pack4(acc); *(LAS unsigned long long*)(sVC + (e0 + r) * TS + 16 * st + 4 * q4) = pack4(acc * c4); }
            __syncthreads();
#pragma unroll
            for (int j = 0; j < 2; ++j) {
                const int e0 = 16 * (2 * eh + j); f32x4 acc = {0.f, 0.f, 0.f, 0.f};
#pragma unroll
                for (int ks = 0; ks < 4; ++ks) acc = mfma16(lds_frag(sST, e0, PS, 32 * ks, lane), __builtin_bit_cast(bf16x8, yQG[ks]), acc);
#pragma unroll
                for (int ks = 0; ks < 2; ++ks) acc = mfma16(lds_frag(sVN, e0, TS, 32 * ks, lane), __builtin_bit_cast(bf16x8, yQK[ks]), acc);
                *(GAS unsigned long long*)(YMIX + ((size_t)b * SEQ + n * 64 + 16 * st + r) * DMIX + 1024 + head * 128 + eb * 64 + e0 + 4 * q4) = pack4(acc); }
#pragma unroll
            for (int et = 0; et < 4; ++et) {
                accS[et] = accS[et] * gl;
#pragma unroll
                for (int ks = 0; ks < 2; ++ks) accS[et] = mfma16(__builtin_bit_cast(bf16x8, xKT[ks]), lds_frag(sVC, 16 * et, TS, 32 * ks, lane), accS[et]);
                *(LAS unsigned long long*)(sSTn + (16 * et + r) * PS + 16 * w + 4 * q4) = pack4(accS[et]); }
            if (n + 1 < 64) {
#pragma unroll
                for (int ks = 0; ks < 4; ++ks) { xK[ks] = nK[ks]; yQG[ks] = nQG[ks]; }
#pragma unroll
                for (int ks = 0; ks < 2; ++ks) { xT[ks] = nT[ks]; yQK[ks] = nQK[ks]; xKT[ks] = nKT[ks]; vT[ks] = nvT[ks]; }
                be4 = nbe4; eg4 = neg4; c4 = nc4; gl = ngl; }
            __syncthreads();
        }
#undef GD_LOAD
    }
}

__device__ __forceinline__ void gdn_rec_phase(CArgs a, int l, LAS unsigned char* lds, int wg, int G, int tid) {
    asm volatile("" : "+v"(tid));
    constexpr int TB = 32;
    LAS float* sQ = (LAS float*)lds; LAS float* sK = sQ + TB * 128; LAS float* sV = sK + TB * 128; LAS float* sBe = sV + TB * 8; LAS float* sAl = sBe + TB; LAS float* sO = sAl + TB;
    const bf16* PROJ = (const bf16*)(a->ws + WS_PROJ); bf16* YMIX = (bf16*)(a->ws + WS_YMIX);
    const float* cw = a->in[I_GCW] + (size_t)l * 4 * 1536;
    const int lane = tid & 63, w = tid >> 6;
    for (int unit = wg; unit < 256; unit += G) {
        const int b = unit >> 6, head = (unit >> 4) & 3, eb = unit & 15;
        const float nA = -__expf(a->in[I_GALOG][l * 4 + head]), dtb = a->in[I_GDTB][l * 4 + head];
        float S0 = 0.f, S1 = 0.f;
        for (int t0 = 0; t0 < SEQ; t0 += TB) {
            __syncthreads();
            for (int idx = tid; idx < TB * 264; idx += NTHR) {
                const int tt = idx / 264, ci = idx % 264, t = t0 + tt;
                const int ch = ci < 128 ? head * 128 + ci : (ci < 256 ? 512 + head * 128 + (ci - 128) : 1024 + head * 128 + eb * 8 + (ci - 256));
                float acc = 0.f;
#pragma unroll
                for (int k = 0; k < 4; ++k) { const int ts = t - 3 + k; if (ts >= 0) acc += cw[k * 1536 + ch] * bf2f(PROJ[(size_t)(b * SEQ + ts) * NPROJ + O_QKV + ch]); }
                const float v = siluf(acc);
                if (ci < 128) sQ[tt * 128 + ci] = v; else if (ci < 256) sK[tt * 128 + ci - 128] = v; else sV[tt * 8 + ci - 256] = v;
            }
            if (tid < TB) { const size_t ro = (size_t)(b * SEQ + t0 + tid) * NPROJ; const float braw = bf2f(PROJ[ro + O_GB + head]), araw = bf2f(PROJ[ro + O_GA + head]);
                sBe[tid] = sigmoidf_(braw); sAl[tid] = __expf(nA * softplusf_(araw + dtb)); }
            __syncthreads();
            for (int tt = w; tt < TB; tt += NWAVES) {
                const float q0 = sQ[tt * 128 + lane], q1 = sQ[tt * 128 + 64 + lane], k0 = sK[tt * 128 + lane], k1 = sK[tt * 128 + 64 + lane];
                const float sq = rsqrtf(wave_sum(q0 * q0 + q1 * q1) + 1e-6f) * 0.08838834764831845f, sk = rsqrtf(wave_sum(k0 * k0 + k1 * k1) + 1e-6f);
                sQ[tt * 128 + lane] = q0 * sq; sQ[tt * 128 + 64 + lane] = q1 * sq; sK[tt * 128 + lane] = k0 * sk; sK[tt * 128 + 64 + lane] = k1 * sk;
            }
            __syncthreads();
#pragma unroll 2
            for (int tt = 0; tt < TB; ++tt) {
                const float k0 = sK[tt * 128 + lane], k1 = sK[tt * 128 + 64 + lane], q0 = sQ[tt * 128 + lane], q1 = sQ[tt * 128 + 64 + lane];
                const float al = sAl[tt], be = sBe[tt], v = sV[tt * 8 + w];
                const float dot = wave_sum(k0 * S0 + k1 * S1);
                const float vn = be * (v - al * dot);
                S0 = al * S0 + k0 * vn; S1 = al * S1 + k1 * vn;
                const float od = wave_sum(q0 * S0 + q1 * S1);
                if (lane == 0) sO[tt * 8 + w] = od;
            }
            __syncthreads();
            if (tid < TB * 8) { const int tt = tid >> 3, i = tid & 7; YMIX[(size_t)(b * SEQ + t0 + tt) * DMIX + 1024 + head * 128 + eb * 8 + i] = (bf16)f2bf(sO[tid]); }
        }
    }
}

__device__ __forceinline__ void hgrn_rec_phase(CArgs a, int l, LAS unsigned char* lds, int wg, int G, int tid) {
    asm volatile("" : "+v"(tid));
    constexpr int TB = 32;
    LAS float* sQ = (LAS float*)lds; LAS float* sF = sQ + TB * 128; LAS float* sV = sF + TB * 128; LAS float* sO = sV + TB * 8; LAS float* sLb = sO + TB * 8;
    const bf16* PROJ = (const bf16*)(a->ws + WS_PROJ); bf16* YMIX = (bf16*)(a->ws + WS_YMIX);
    const int lane = tid & 63, w = tid >> 6;
    for (int unit = wg; unit < 256; unit += G) {
        const int b = unit >> 6, head = (unit >> 4) & 3, eb = unit & 15;
        __syncthreads();
        if (tid < 128) {
            const int c = head * 128 + tid; float lg[DEPTH], mx = -1e30f;
#pragma unroll
            for (int j = 0; j < DEPTH; ++j) { lg[j] = a->in[I_HLB][j * 512 + c]; mx = fmaxf(mx, lg[j]); }
            float den = 0.f, num = 0.f;
#pragma unroll
            for (int j = 0; j < DEPTH; ++j) { const float e = __expf(lg[j] - mx); den += e; if (j >= 1 && j <= l) num += e; }
            sLb[tid] = num / den;
        }
        float S0 = 0.f, S1 = 0.f;
        for (int t0 = 0; t0 < SEQ; t0 += TB) {
            __syncthreads();
            for (int idx = tid; idx < TB * 264; idx += NTHR) {
                const int tt = idx / 264, ci = idx % 264; const size_t ro = (size_t)(b * SEQ + t0 + tt) * NPROJ;
                if (ci < 128) sQ[tt * 128 + ci] = siluf(bf2f(PROJ[ro + O_HQ + head * 128 + ci]));
                else if (ci < 256) { const int d = ci - 128; const float lb = sLb[d]; sF[tt * 128 + d] = lb + (1.f - lb) * sigmoidf_(bf2f(PROJ[ro + O_HF + head * 128 + d])); }
                else sV[tt * 8 + ci - 256] = bf2f(PROJ[ro + O_HI + head * 128 + eb * 8 + (ci - 256)]);
            }
            __syncthreads();
#pragma unroll 2
            for (int tt = 0; tt < TB; ++tt) {
                const float f0 = sF[tt * 128 + lane], f1 = sF[tt * 128 + 64 + lane], q0 = sQ[tt * 128 + lane], q1 = sQ[tt * 128 + 64 + lane], v = sV[tt * 8 + w];
                S0 = f0 * S0 + (1.f - f0) * v; S1 = f1 * S1 + (1.f - f1) * v;
                const float od = wave_sum(q0 * S0 + q1 * S1);
                if (lane == 0) sO[tt * 8 + w] = od;
            }
            __syncthreads();
            if (tid < TB * 8) { const int tt = tid >> 3, i = tid & 7; YMIX[(size_t)(b * SEQ + t0 + tt) * DMIX + 1536 + head * 128 + eb * 8 + i] = (bf16)f2bf(sO[tid]); }
        }
    }
}

__device__ __forceinline__ void mix_post_phase(CArgs a, int l, int wg, int G, int tid) {
    asm volatile("" : "+v"(tid));
    const bf16* PROJ = (const bf16*)(a->ws + WS_PROJ); bf16* YMIX = (bf16*)(a->ws + WS_YMIX);
    const int lane = tid & 63, gw = wg * NWAVES + (tid >> 6), NGW = G * NWAVES;
    const float* snw = a->in[I_SNW] + l * 1024; const float* gnw = a->in[I_GNW] + l * 128; const float* hnw = a->in[I_HNW] + l * 128;
    for (int row = gw; row < M; row += NGW) {
        const bf16* pr = PROJ + (size_t)row * NPROJ; bf16* yr = YMIX + (size_t)row * DMIX;
#pragma unroll
        for (int j = 0; j < 2; ++j) {
            const int ch = j * 512 + lane * 8; const v4u yv = *(const GAS v4u*)(yr + ch), zv = *(const GAS v4u*)(pr + O_Z + ch);
            float v[8]; float ss = 0.f;
#pragma unroll
            for (int i = 0; i < 4; ++i) { v[2 * i] = bflo(yv[i]) * siluf(bflo(zv[i])); v[2 * i + 1] = bfhi(yv[i]) * siluf(bfhi(zv[i])); ss += v[2 * i] * v[2 * i] + v[2 * i + 1] * v[2 * i + 1]; }
            const float rstd = rsqrtf(wave_sum(ss) * (1.f / 512.f) + 1e-6f);
            v4u o;
#pragma unroll
            for (int i = 0; i < 4; ++i) o[i] = pk2(v[2 * i] * rstd * snw[ch + 2 * i], v[2 * i + 1] * rstd * snw[ch + 2 * i + 1]);
            *(GAS v4u*)(yr + ch) = o;
        }
#pragma unroll
        for (int part = 0; part < 2; ++part) {
            const int ch = lane * 8, yo = 1024 + part * 512 + ch, go = (part == 0 ? O_GG : O_HG) + ch; const float* nw = part == 0 ? gnw : hnw;
            const v4u yv = *(const GAS v4u*)(yr + yo), gv = *(const GAS v4u*)(pr + go);
            float v[8]; float ss = 0.f;
#pragma unroll
            for (int i = 0; i < 4; ++i) { v[2 * i] = bflo(yv[i]); v[2 * i + 1] = bfhi(yv[i]); ss += v[2 * i] * v[2 * i] + v[2 * i + 1] * v[2 * i + 1]; }
            ss += __shfl_xor(ss, 1); ss += __shfl_xor(ss, 2); ss += __shfl_xor(ss, 4); ss += __shfl_xor(ss, 8);
            const float rstd = rsqrtf(ss * (1.f / 128.f) + 1e-6f);
            v4u o;
#pragma unroll
            for (int i = 0; i < 4; ++i) { const int c = (ch & 127) + 2 * i; o[i] = pk2(v[2 * i] * rstd * nw[c] * siluf(bflo(gv[i])), v[2 * i + 1] * rstd * nw[c + 1] * siluf(bfhi(gv[i]))); }
            *(GAS v4u*)(yr + yo) = o;
        }
    }
}

template <bool ROUTER>
__device__ __forceinline__ void ln_phase(CArgs a, int l, const float* gam, const float* bet, LAS unsigned char* lds, int wg, int G, int tid) {
    asm volatile("" : "+v"(tid));
    const int lane = tid & 63, gw = wg * NWAVES + (tid >> 6), NGW = G * NWAVES;
    const float* ADD = (const float*)(a->ws + WS_MIX); float* H = a->out; bf16* HB = (bf16*)(a->ws + WS_HB); float* COMB = (float*)(a->ws + WS_COMB);
    LAS float* sW = (LAS float*)lds;
    LAS float* sL = sW + 20 * D + (tid >> 6) * 32;
    if (ROUTER) {
        __syncthreads();
        const float* wrg = a->in[I_WRG] + (size_t)l * D * 4; const float* wre = a->in[I_WRE] + (size_t)l * D * 16;
        for (int i = tid; i < D * 20; i += NTHR) { const int c = i >> 10, k = i & 1023; sW[i] = c < 4 ? wrg[k * 4 + c] : wre[k * 16 + c - 4]; }
        __syncthreads();
    }
    f32x4 gv[4], bv[4];
#pragma unroll
    for (int j = 0; j < 4; ++j) { gv[j] = *(const f32x4*)(gam + 4 * lane + 256 * j); bv[j] = *(const f32x4*)(bet + 4 * lane + 256 * j); }
    for (int row = gw; row < M; row += NGW) {
        f32x4 v[4]; float s = 0.f;
#pragma unroll
        for (int j = 0; j < 4; ++j) { const f32x4 hv = *(const GAS f32x4*)(H + (size_t)row * D + 4 * lane + 256 * j), av = *(const GAS f32x4*)(ADD + (size_t)row * D + 4 * lane + 256 * j);
            v[j] = hv * DN_ALPHA + av; s += (v[j].x + v[j].y) + (v[j].z + v[j].w); }
        const float mean = wave_sum(s) * (1.f / D); float s2 = 0.f;
#pragma unroll
        for (int j = 0; j < 4; ++j) { v[j] = v[j] - mean; s2 += (v[j].x * v[j].x + v[j].y * v[j].y) + (v[j].z * v[j].z + v[j].w * v[j].w); }
        const float rstd = rsqrtf(wave_sum(s2) * (1.f / D) + LN_EPS);
#pragma unroll
        for (int j = 0; j < 4; ++j) { v[j] = v[j] * rstd * gv[j] + bv[j];
            *(GAS f32x4*)(H + (size_t)row * D + 4 * lane + 256 * j) = v[j];
            *(GAS unsigned long long*)(HB + (size_t)row * D + 4 * lane + 256 * j) = (unsigned long long)pk2(v[j].x, v[j].y) | ((unsigned long long)pk2(v[j].z, v[j].w) << 32); }
        if (ROUTER) {
            float lg[20];
#pragma unroll 1
            for (int c = 0; c < 20; ++c) { float p = 0.f;
#pragma unroll
                for (int j = 0; j < 4; ++j) { const f32x4 wv = *(const LAS f32x4*)(sW + c * D + 4 * lane + 256 * j); p += (v[j].x * wv.x + v[j].y * wv.y) + (v[j].z * wv.z + v[j].w * wv.w); }
                p = wave_sum(p); if (lane == 0) sL[c] = p; }
#pragma unroll
            for (int c = 0; c < 20; ++c) lg[c] = sL[c];
            float pg[4], mx = -1e30f; int gi = 0;
#pragma unroll
            for (int c = 0; c < 4; ++c) { pg[c] = lg[c] + a->in[I_BRG][l * 4 + c]; if (pg[c] > mx) { mx = pg[c]; gi = c; } }
            float den = 0.f;
#pragma unroll
            for (int c = 0; c < 4; ++c) den += __expf(pg[c] - mx);
            const float g_p = 1.0f / den;
            float le[4], emx = -1e30f; int i1 = 0;
#pragma unroll
            for (int c = 0; c < 4; ++c) { float x = 0.f;
#pragma unroll
                for (int gg = 0; gg < 4; ++gg) x = (gi == gg) ? lg[4 + gg * 4 + c] + a->in[I_BRE][l * 16 + gg * 4 + c] : x;
                le[c] = x; if (x > emx) { emx = x; i1 = c; } }
            float e2mx = -1e30f; int i2 = 0;
#pragma unroll
            for (int c = 0; c < 4; ++c) if (c != i1 && le[c] > e2mx) { e2mx = le[c]; i2 = c; }
            const float x1 = 1.0f, x2 = __expf(e2mx - emx), w1 = g_p * x1 / (x1 + x2), w2 = g_p * x2 / (x1 + x2);
            if (lane < 16) { const int gl = lane >> 2, el = lane & 3; float cwv = 0.f; if (gl == gi) { if (el == i1) cwv = w1; else if (el == i2) cwv = w2; } COMB[(size_t)row * 16 + lane] = cwv; }
        }
    }
}

enum { P_IN = 0, P_PREP, P_SCAN, P_POST, P_OUT, P_LN1, P_GU, P_DN, P_LN2, NPH };
constexpr int N_PHASES = 1 + DEPTH * NPH;
__global__ void __launch_bounds__(NTHR, 2) fwd(Args args) {
    extern __shared__ __attribute__((aligned(16))) unsigned char lds_raw[];
    LAS unsigned char* lds = (LAS unsigned char*)lds_raw;
    volatile LAS unsigned* MISC = (volatile LAS unsigned*)(lds + MISC_OFF);
    const int tid = threadIdx.x, G = gridDim.x, bx = blockIdx.x;
    unsigned char* ws = args.ws;
    gu32* ctl = (gu32*)(ws + WS_CTL);
    for (int u = tid; u < (LDS_BYTES - LDSCTL_OFF) / 4; u += NTHR) ((LAS unsigned*)(lds + LDSCTL_OFF))[u] = 0u;
    __syncthreads();
    const int lo = args.ph_lo, hi = args.ph_hi;
    const bool use_bar = (hi - lo) > 1;
    XcdBarrier bar; bar.bar = (unsigned*)(ctl + CW_BAR); bar.x = 0; bar.st = nullptr;
    if (use_bar) bar = xcd_barrier_post((unsigned*)(ctl + CW_BAR), MISC + 8);
#define IN(k) (lo <= (k) && (k) < hi)
#define SEAM(k) do { if (IN(k) && IN((k) + 1)) xcd_barrier(bar); } while (0)

    if (IN(0)) { p0_prologue(ARGS_HERE(), lds, bx, G, tid); weights_phase(ARGS_HERE(), 0, 1, lds, bx * NWAVES + (tid >> 6), G * NWAVES, tid); SEAM(0); }

    for (int l = 0; l < DEPTH; ++l) {
        const int base = 1 + l * NPH;
        if (IN(base + P_IN)) {
            pg8::Gemm g{(const pg8::bf16_t*)(ws + WS_HB), (const pg8::bf16_t*)(ws + WS_WIN), M, NPROJ, D}; pg8::StaticOrder S; S.init(M, NPROJ, G, bx);
            pg8::EpiBf16<0> E{(pg8::bf16_t*)(ws + WS_PROJ), NPROJ, nullptr, 0, 0, 1.f};
            pg8::gemm_phase<pg8::EpiBf16<0>, pg8::StaticOrder, true, true>(lds + RING_OFF, g, S, E);
            SEAM(base + P_IN);
        }
        if (IN(base + P_PREP)) {
            hgrn_prep_phase(ARGS_HERE(), l, lds, bx, G, tid);
            ssd_prep_phase(ARGS_HERE(), l, lds, bx, G, tid);
            gdn_prep_phase(ARGS_HERE(), l, lds, bx, G, tid);
            SEAM(base + P_PREP); }
        if (IN(base + P_SCAN)) {
            if (G >= 192) {
                if (bx < 64) { const int pr = bx & 7, hh = bx >> 3; ssd_scan_phase(ARGS_HERE(), l, lds, pr >> 1, (pr & 1) * 8 + hh, tid); }
                else if (bx < 96) { const int x = (bx - 64) & 7, y = (bx - 64) >> 3, pr = x * 2 + (y >> 1); gdn_scan_phase(ARGS_HERE(), l, lds, pr >> 2, pr & 3, y & 1, tid); }
                else if (bx < 160) { const int x = (bx - 96) & 7, y = (bx - 96) >> 3, pr = x * 2 + (y >> 2); hgrn_scan_phase(ARGS_HERE(), l, lds, pr >> 2, pr & 3, y & 3, tid); }
                else { weights_phase(ARGS_HERE(), l, 14, lds, (bx - 160) * NWAVES + (tid >> 6), (G - 160) * NWAVES, tid);
                       if (l + 1 < DEPTH) weights_phase(ARGS_HERE(), l + 1, 1, lds, (bx - 160) * NWAVES + (tid >> 6), (G - 160) * NWAVES, tid); }
            }
            SEAM(base + P_SCAN); }
        if (IN(base + P_POST)) { mix_post_phase(ARGS_HERE(), l, bx, G, tid); SEAM(base + P_POST); }
        if (IN(base + P_OUT)) {
            pg8::Gemm g{(const pg8::bf16_t*)(ws + WS_YMIX), (const pg8::bf16_t*)(ws + WS_WOUT), M, D, DMIX}; pg8::StaticOrder S; S.init(M, D, G, bx);
            pg8::EpiF32 E{(float*)(ws + WS_MIX), D};
            pg8::gemm_phase<pg8::EpiF32, pg8::StaticOrder, true, true>(lds + RING_OFF, g, S, E);
            SEAM(base + P_OUT);
        }
        if (IN(base + P_LN1)) { CArgs a_ = ARGS_HERE(); ln_phase<true>(a_, l, a_->in[I_LN1G] + l * D, a_->in[I_LN1B] + l * D, lds, bx, G, tid); SEAM(base + P_LN1); }
        if (IN(base + P_GU)) {
            pg8::Gemm g{(const pg8::bf16_t*)(ws + WS_HB), (const pg8::bf16_t*)(ws + WS_WGU), M, NGU, D}; pg8::StaticOrder S; S.init(M, NGU, G, bx);
            pg8::EpiSwiGLU E{(pg8::bf16_t*)(ws + WS_H), KDN, (const float*)(ws + WS_COMB), 16};
            pg8::gemm_phase<pg8::EpiSwiGLU, pg8::StaticOrder, true, true>(lds + RING_OFF, g, S, E);
            SEAM(base + P_GU);
        }
        if (IN(base + P_DN)) {
            pg8::Gemm g{(const pg8::bf16_t*)(ws + WS_H), (const pg8::bf16_t*)(ws + WS_WDN), M, D, KDN}; pg8::StaticOrder S; S.init(M, D, G, bx);
            pg8::EpiF32 E{(float*)(ws + WS_MIX), D};
            pg8::gemm_phase<pg8::EpiF32, pg8::StaticOrder, true, true>(lds + RING_OFF, g, S, E);
            SEAM(base + P_DN);
        }
        if (IN(base + P_LN2)) { CArgs a_ = ARGS_HERE(); ln_phase<false>(a_, l, a_->in[I_LN2G] + l * D, a_->in[I_LN2B] + l * D, lds, bx, G, tid); SEAM(base + P_LN2); }
    }
#undef IN
#undef SEAM
}

#ifndef MK_ONE_LAUNCH
#define MK_ONE_LAUNCH 1
#endif
extern "C" void kernel_launch(void* const* d_in, const int* in_sizes, int n_in, void* d_out, int out_size, void* d_ws, size_t ws_size, hipStream_t stream) {
    static int grid = 0;
    if (grid == 0) {
        if (n_in != 25 || out_size != M * D || ws_size < WS_END) { fprintf(stderr, "kernel_launch: unexpected shapes (n_in %d out %d ws %zu)\n", n_in, out_size, ws_size); grid = -1; return; }
        int dev = 0, cus = 0, per_cu = 0;
        if (hipGetDevice(&dev) != hipSuccess || hipDeviceGetAttribute(&cus, hipDeviceAttributeMultiprocessorCount, dev) != hipSuccess) { grid = -1; return; }
        if (hipFuncSetAttribute((const void*)fwd, hipFuncAttributeMaxDynamicSharedMemorySize, LDS_BYTES) != hipSuccess) { fprintf(stderr, "kernel_launch: hipFuncSetAttribute failed\n"); grid = -1; return; }
        if (hipOccupancyMaxActiveBlocksPerMultiprocessor(&per_cu, (const void*)fwd, NTHR, LDS_BYTES) != hipSuccess || per_cu < 1) { fprintf(stderr, "kernel_launch: occupancy query says %d\n", per_cu); (void)hipGetLastError(); grid = -1; return; }
        grid = cus;
    }
    if (grid < 0) return;
    if (hipMemsetAsync((char*)d_ws + WS_CTL, 0, CTL_ZERO_BYTES, stream) != hipSuccess) return;
    Args a{};
    for (int i = 0; i < 25; ++i) a.in[i] = (const float*)d_in[i];
    a.out = (float*)d_out; a.ws = (unsigned char*)d_ws;
#if MK_ONE_LAUNCH
    a.ph_lo = 0; a.ph_hi = N_PHASES;
    hipLaunchKernelGGL(fwd, dim3(grid), dim3(NTHR), LDS_BYTES, stream, a);
#else
    for (int p = 0; p < N_PHASES; ++p) { a.ph_lo = p; a.ph_hi = p + 1; hipLaunchKernelGGL(fwd, dim3(grid), dim3(NTHR), LDS_BYTES, stream, a); }
#endif
}
```

```cpp
#include <hip/hip_runtime.h>
#include <cstdio>
#include <cstdint>
namespace pg8 {
#define PG8_LAS __attribute__((address_space(3)))
typedef unsigned short bf16_t;
typedef short bf16x8 __attribute__((ext_vector_type(8)));
typedef float f32x4 __attribute__((ext_vector_type(4)));
typedef unsigned u32x4 __attribute__((ext_vector_type(4)));
constexpr int BM = 256, BK = 64, HALF = 128, HTB = HALF * BK * 2  , STAGE_BYTES = 8 * HTB, NXCD = 8, WGM = 8;

__host__ __device__ __forceinline__ int lds_byte(int r, int c) { const int st = (r >> 4) * 2 + (c >> 5), rr = r & 15, cc = c & 31, ob = rr * 64 + cc * 2; return st * 1024 + (ob ^ (((ob >> 9) & 1) << 5)); }
__host__ __device__ __forceinline__ void stage_rc(int b, int& R, int& C) { const int st = b / 1024, sb = b % 1024, swz = sb ^ (((sb >> 9) & 1) << 5); R = (st >> 1) * 16 + swz / 64; C = (st & 1) * 32 + (swz % 64) / 2; }
__host__ __device__ __forceinline__ int perm32(int rho) { const int n = rho >> 4, i = rho & 15; return 8 * (i >> 2) + 4 * n + (i & 3); }

struct Unit { int pm, pn; };
struct Gemm { const bf16_t* A; const bf16_t* Bt; int M, N, K; };

struct StaticOrder {
    int nM, nN, nwg, G, c;
    __host__ __device__ void init(int M, int N, int G_, int c_) { nM = M / BM; nN = N / BM; nwg = nM * nN; G = G_; c = c_; }
    __host__ __device__ bool next(int i, Unit& u) const {
        const long L = (long)i * G + c; if (L >= nwg) return false;
        int wgid = (int)L; { const int q = nwg / NXCD, r = nwg % NXCD, xcd = wgid % NXCD, off = wgid / NXCD; wgid = (xcd < r ? xcd * (q + 1) : r * (q + 1) + (xcd - r) * q) + off; }
        const int nig = WGM * nN, gid = wgid / nig, fm = gid * WGM, gsz = (nM - fm) < WGM ? (nM - fm) : WGM;
        u.pm = fm + ((wgid % nig) % gsz); u.pn = (wgid % nig) / gsz; return true;
    }
    __device__ __forceinline__ void a_ready(const Unit&) const {}
    __device__ __forceinline__ void done(const Unit&) const {}
};
__device__ __forceinline__ unsigned cvt_pk_bf16(float lo, float hi) { unsigned r; asm volatile("v_cvt_pk_bf16_f32 %0, %1, %2" : "=v"(r) : "v"(lo), "v"(hi)); return r; }
typedef float f32x2 __attribute__((ext_vector_type(2)));
__device__ __forceinline__ f32x2 gelu_pk(f32x2 v) {
    const f32x2 av = __builtin_elementwise_abs(v), d = av * 0.2316418882f + 1.0f;
    f32x2 t; t.x = __builtin_amdgcn_rcpf(d.x); t.y = __builtin_amdgcn_rcpf(d.y);
    f32x2 q = t * 0.5307027145f + (-0.7265760135f); q = q * t + 0.7107068705f; q = q * t + (-0.142248368f); q = q * t + 0.127414796f; q = q * t;
    const f32x2 s = (v * v) * (-0.72134752044f);
    f32x2 e; e.x = __builtin_amdgcn_exp2f(s.x); e.y = __builtin_amdgcn_exp2f(s.y);
    const f32x2 m = v * (q * e), r = v - m;
    f32x2 o; o.x = v.x < 0.f ? m.x : r.x; o.y = v.y < 0.f ? m.y : r.y; return o;
}

template <int ACT  > struct EpiBf16 {
    static constexpr bool PERM = true, AFTER_DRAIN = false; static_assert(ACT == 0 || ACT == 1, "EpiBf16: ACT is 0 (none) or 1 (gelu_pk)");
    bf16_t* O; int ldc; const float* bias; int split_cols; size_t split_stride; float scale0;
    __device__ __forceinline__ void operator()(const f32x4 (&acc)[2][2][4][2], const Unit& u, int wr, int wc, int fr, int fq) const {
        const int row0 = u.pm * BM + wr * 64 + fr; int colt = u.pn * BM; bf16_t* base = O;
        float sc = 1.f; if (split_cols) { const int t = colt / split_cols; base += (size_t)t * split_stride; colt -= t * split_cols; if (t == 0) sc = scale0; }
        const int col0 = colt + wc * 32 + 8 * fq, bcol0 = u.pn * BM + wc * 32 + 8 * fq;
        f32x4 bv[2][2];
#pragma unroll
        for (int bj = 0; bj < 2; ++bj)
#pragma unroll
            for (int n = 0; n < 2; ++n) bv[bj][n] = bias ? *(const f32x4*)(bias + bcol0 + bj * HALF + 4 * n) : (f32x4){0.f, 0.f, 0.f, 0.f};
#pragma unroll
        for (int ai = 0; ai < 2; ++ai)
#pragma unroll
            for (int m = 0; m < 4; ++m) { bf16_t* rowp = base + (size_t)(row0 + ai * HALF + m * 16) * ldc + col0;
#pragma unroll
                for (int bj = 0; bj < 2; ++bj) { f32x4 v0 = acc[ai][bj][m][0] + bv[bj][0], v1 = acc[ai][bj][m][1] + bv[bj][1];
                    if (ACT == 1) { f32x2 a = gelu_pk((f32x2){v0[0], v0[1]}), b = gelu_pk((f32x2){v0[2], v0[3]}), c = gelu_pk((f32x2){v1[0], v1[1]}), d = gelu_pk((f32x2){v1[2], v1[3]});
                        v0 = (f32x4){a.x, a.y, b.x, b.y}; v1 = (f32x4){c.x, c.y, d.x, d.y}; }
                    v0 = v0 * sc; v1 = v1 * sc; u32x4 w; w.x = cvt_pk_bf16(v0[0], v0[1]); w.y = cvt_pk_bf16(v0[2], v0[3]); w.z = cvt_pk_bf16(v1[0], v1[1]); w.w = cvt_pk_bf16(v1[2], v1[3]);
                    *(u32x4*)(rowp + bj * HALF) = w; } }
    }
};
struct EpiF32 {
    static constexpr bool PERM = false, AFTER_DRAIN = false;
    float* C; int ldc;
    __device__ __forceinline__ void operator()(const f32x4 (&acc)[2][2][4][2], const Unit& u, int wr, int wc, int fr, int fq) const {
        const int row0 = u.pm * BM + wr * 64 + fr, col0 = u.pn * BM + wc * 32 + 4 * fq;
#pragma unroll
        for (int ai = 0; ai < 2; ++ai)
#pragma unroll
            for (int m = 0; m < 4; ++m) { float* rowp = C + (size_t)(row0 + ai * HALF + m * 16) * ldc + col0;
#pragma unroll
                for (int bj = 0; bj < 2; ++bj)
#pragma unroll
                    for (int n = 0; n < 2; ++n) *(f32x4*)(rowp + bj * HALF + n * 16) = acc[ai][bj][m][n]; }
    }
};
__device__ __forceinline__ float silu_f(float x) { return x / (1.0f + __expf(-x)); }
struct EpiSwiGLU {
    static constexpr bool PERM = true, AFTER_DRAIN = false;
    bf16_t* H; int ldh; const float* comb; int ldcomb;
    __device__ __forceinline__ void operator()(const f32x4 (&acc)[2][2][4][2], const Unit& u, int wr, int wc, int fr, int fq) const {
        const int row0 = u.pm * BM + wr * 64 + fr, col0 = u.pn * 128 + wc * 32 + 8 * fq, e = u.pn >> 1;
#pragma unroll
        for (int ai = 0; ai < 2; ++ai)
#pragma unroll
            for (int m = 0; m < 4; ++m) { const int row = row0 + ai * HALF + m * 16; const float cw = comb[(size_t)row * ldcomb + e];
                const f32x4 g0 = acc[ai][0][m][0], g1 = acc[ai][0][m][1], u0 = acc[ai][1][m][0], u1 = acc[ai][1][m][1];
                f32x4 h0, h1;
#pragma unroll
                for (int j = 0; j < 4; ++j) { h0[j] = silu_f(g0[j]) * u0[j] * cw; h1[j] = silu_f(g1[j]) * u1[j] * cw; }
                u32x4 w; w.x = cvt_pk_bf16(h0[0], h0[1]); w.y = cvt_pk_bf16(h0[2], h0[3]); w.z = cvt_pk_bf16(h1[0], h1[1]); w.w = cvt_pk_bf16(h1[2], h1[3]);
                *(u32x4*)(H + (size_t)row * ldh + col0) = w; }
    }
};

template <int NSUB> struct MoeOrder {
    const PG8_LAS int* off; int G, c;
    __device__ __forceinline__ bool next(int i, Unit& u) const {
        const int L = i * G + c, x = L & 7, j = L >> 3, t = x + 8 * (j / NSUB), pnl = j % NSUB;
        if (t * 256 >= off[16]) return false;
        int e = 0;
#pragma unroll
        for (int k = 1; k < 16; ++k) e += (off[k] <= t * 256) ? 1 : 0;
        u.pm = t; u.pn = e * NSUB + pnl; return true;
    }
    __device__ __forceinline__ void a_ready(const Unit&) const {}
    __device__ __forceinline__ void done(const Unit&) const {}
};
struct EpiSwiGLUs {
    static constexpr bool PERM = true, AFTER_DRAIN = false;
    bf16_t* H; const float* wrow;
    __device__ __forceinline__ void operator()(const f32x4 (&acc)[2][2][4][2], const Unit& u, int wr, int wc, int fr, int fq) const {
        const int row0 = u.pm * BM + wr * 64 + fr, col0 = (u.pn & 1) * 128 + wc * 32 + 8 * fq;
#pragma unroll
        for (int ai = 0; ai < 2; ++ai)
#pragma unroll
            for (int m = 0; m < 4; ++m) { const int row = row0 + ai * HALF + m * 16; const float cw = wrow[row];
                const f32x4 g0 = acc[ai][0][m][0], g1 = acc[ai][0][m][1], u0 = acc[ai][1][m][0], u1 = acc[ai][1][m][1];
                f32x4 h0, h1;
#pragma unroll
                for (int j = 0; j < 4; ++j) { h0[j] = silu_f(g0[j]) * u0[j] * cw; h1[j] = silu_f(g1[j]) * u1[j] * cw; }
                u32x4 w; w.x = cvt_pk_bf16(h0[0], h0[1]); w.y = cvt_pk_bf16(h0[2], h0[3]); w.z = cvt_pk_bf16(h1[0], h1[1]); w.w = cvt_pk_bf16(h1[2], h1[3]);
                *(u32x4*)(H + (size_t)row * 256 + col0) = w; }
    }
};
struct EpiBf16s {
    static constexpr bool PERM = true, AFTER_DRAIN = false;
    bf16_t* O;
    __device__ __forceinline__ void operator()(const f32x4 (&acc)[2][2][4][2], const Unit& u, int wr, int wc, int fr, int fq) const {
        const int row0 = u.pm * BM + wr * 64 + fr, col0 = (u.pn & 3) * BM + wc * 32 + 8 * fq;
#pragma unroll
        for (int ai = 0; ai < 2; ++ai)
#pragma unroll
            for (int m = 0; m < 4; ++m) { bf16_t* rowp = O + (size_t)(row0 + ai * HALF + m * 16) * 1024 + col0;
#pragma unroll
                for (int bj = 0; bj < 2; ++bj) { const f32x4 v0 = acc[ai][bj][m][0], v1 = acc[ai][bj][m][1];
                    u32x4 w; w.x = cvt_pk_bf16(v0[0], v0[1]); w.y = cvt_pk_bf16(v0[2], v0[3]); w.z = cvt_pk_bf16(v1[0], v1[1]); w.w = cvt_pk_bf16(v1[2], v1[3]);
                    *(u32x4*)(rowp + bj * HALF) = w; } }
    }
};
template <class Epi, class Sched, bool ALIGN_EPI = false, bool SP2 = false>
__device__ __forceinline__ void gemm_phase(PG8_LAS unsigned char* lds, const Gemm g, const Sched& S, const Epi& E) {
    int tid_ = threadIdx.x; asm volatile("" : "+v"(tid_));
    const int tid = tid_, wid = __builtin_amdgcn_readfirstlane(tid >> 6), lane = tid & 63, wr = wid >> 2, wc = wid & 3, fr = lane & 15, fq = lane >> 4;
    const int K = g.K, nt = K / BK;
    unsigned voffA[2], voffB[2];
#pragma unroll
    for (int i = 0; i < 2; ++i) { int R, C; stage_rc(tid * 16 + i * 8192, R, C); const int Rb = Epi::PERM ? ((R & ~31) + perm32(R & 31)) : R;
        voffA[i] = (unsigned)(R * K + C) * 2u; voffB[i] = (unsigned)(Rb * K + C) * 2u; }
    const size_t kstep = (size_t)(BK * 2);
    const size_t hstep = (size_t)HALF * K * 2;
    const size_t tstep = 2 * hstep;
    const unsigned ldsw = (unsigned)wid * 1024u;
    const int aoff = lds_byte(wr * 64 + fr, fq * 8), boff = lds_byte(wc * 32 + fr, fq * 8);
#define PG8_SA(b, h) (((b) * 2 + (h)) * HTB)
#define PG8_SB(b, h) ((4 + (b) * 2 + (h)) * HTB)
#define PG8_STAGE(bufoff, gbase, voff) do { _Pragma("unroll") for (int _i = 0; _i < 2; ++_i) \
        __builtin_amdgcn_global_load_lds((const unsigned*)((const char*)(gbase) + (voff)[_i]), (PG8_LAS unsigned*)(lds + (bufoff) + ldsw + _i * 8192), 16, 0, 0); } while (0)
#define PG8_LDA(dst, b, h) do { _Pragma("unroll") for (int m = 0; m < 4; ++m) _Pragma("unroll") for (int k = 0; k < 2; ++k) dst[m][k] = *(const PG8_LAS bf16x8*)(lds + PG8_SA(b, h) + aoff + m * 2048 + k * 1024); } while (0)
#define PG8_LDB(dst, b, h) do { _Pragma("unroll") for (int n = 0; n < 2; ++n) _Pragma("unroll") for (int k = 0; k < 2; ++k) dst[n][k] = *(const PG8_LAS bf16x8*)(lds + PG8_SB(b, h) + boff + n * 2048 + k * 1024); } while (0)
#define PG8_MMA(ai, bj, At, Bt) do { __builtin_amdgcn_s_setprio(1); _Pragma("unroll") for (int m = 0; m < 4; ++m) _Pragma("unroll") for (int n = 0; n < 2; ++n) _Pragma("unroll") for (int k = 0; k < 2; ++k) \
        acc[ai][bj][m][n] = __builtin_amdgcn_mfma_f32_16x16x32_bf16(Bt[n][k], At[m][k], acc[ai][bj][m][n], 0, 0, 0); __builtin_amdgcn_s_setprio(0); } while (0)
#define PG8_WAIT_V(n) asm volatile("s_waitcnt vmcnt(" #n ")" ::: "memory")
#define PG8_WAIT_L(n) asm volatile("s_waitcnt lgkmcnt(" #n ")" ::: "memory")
#define PG8_BAR __builtin_amdgcn_s_barrier()
#define PG8_SCHED __builtin_amdgcn_sched_barrier(0)
    Unit cur, nxt; int ui = 0;
    if (!S.next(0, cur)) return;
    f32x4 acc[2][2][4][2];
#pragma unroll
    for (int a = 0; a < 2; ++a)
#pragma unroll
        for (int b = 0; b < 2; ++b)
#pragma unroll
            for (int m = 0; m < 4; ++m)
#pragma unroll
                for (int n = 0; n < 2; ++n) acc[a][b][m][n] = (f32x4){0.f, 0.f, 0.f, 0.f};
    bf16x8 At[4][2], B0[2][2], B1[2][2];
    const char* cA = (const char*)g.A + (size_t)cur.pm * tstep; const char* cB = (const char*)g.Bt + (size_t)cur.pn * tstep;
    S.a_ready(cur);
    if constexpr (SP2) {
        PG8_STAGE(PG8_SB(0, 0), cB, voffB); PG8_STAGE(PG8_SB(0, 1), cB + hstep, voffB); PG8_STAGE(PG8_SA(0, 0), cA, voffA); PG8_STAGE(PG8_SA(0, 1), cA + hstep, voffA);
        if (wr == 1) PG8_BAR;
        PG8_WAIT_V(2); PG8_BAR;
        PG8_STAGE(PG8_SB(1, 0), cB + kstep, voffB); PG8_STAGE(PG8_SA(1, 0), cA + kstep, voffA); PG8_STAGE(PG8_SB(1, 1), cB + hstep + kstep, voffB);
        PG8_WAIT_V(6); PG8_BAR;
    } else {
        PG8_STAGE(PG8_SB(0, 0), cB, voffB); PG8_STAGE(PG8_SA(0, 0), cA, voffA); PG8_STAGE(PG8_SB(0, 1), cB + hstep, voffB); PG8_STAGE(PG8_SA(0, 1), cA + hstep, voffA);
        if (wr == 1) PG8_BAR;
        PG8_WAIT_V(4); PG8_BAR;
        PG8_STAGE(PG8_SB(1, 0), cB + kstep, voffB); PG8_STAGE(PG8_SA(1, 0), cA + kstep, voffA); PG8_STAGE(PG8_SB(1, 1), cB + hstep + kstep, voffB);
        PG8_WAIT_V(6); PG8_BAR;
    }
    for (;;) {
        const bool has_next = S.next(ui + 1, nxt);
        const char* nA = has_next ? (const char*)g.A + (size_t)nxt.pm * tstep : cA; const char* nB = has_next ? (const char*)g.Bt + (size_t)nxt.pn * tstep : cB;
#pragma unroll 1
        for (int t = 0; t < nt; t += 2) {
            const bool last = (t == nt - 2);
            const char* a1 = cA + (size_t)(t + 1) * kstep;
            const char* a2 = last ? nA : cA + (size_t)(t + 2) * kstep; const char* b2 = last ? nB : cB + (size_t)(t + 2) * kstep;
            const char* a3 = a2 + kstep; const char* b3 = b2 + kstep;
            if (last && has_next) S.a_ready(nxt);
            if constexpr (SP2) {
            PG8_LDB(B0, 0, 0); PG8_LDB(B1, 0, 1); PG8_SCHED; PG8_LDA(At, 0, 0); PG8_STAGE(PG8_SA(1, 1), a1 + hstep, voffA);
            PG8_WAIT_V(8); PG8_WAIT_L(0); PG8_BAR; PG8_MMA(0, 0, At, B0); PG8_MMA(0, 1, At, B1); PG8_BAR; PG8_SCHED;
            PG8_LDA(At, 0, 1); PG8_STAGE(PG8_SB(0, 0), b2, voffB); PG8_STAGE(PG8_SB(0, 1), b2 + hstep, voffB); PG8_STAGE(PG8_SA(0, 0), a2, voffA);
            PG8_WAIT_V(8); PG8_WAIT_L(0); PG8_BAR; PG8_MMA(1, 0, At, B0); PG8_MMA(1, 1, At, B1); PG8_BAR; PG8_SCHED;
            PG8_LDB(B0, 1, 0); PG8_LDB(B1, 1, 1); PG8_SCHED; PG8_LDA(At, 1, 0); PG8_STAGE(PG8_SA(0, 1), a2 + hstep, voffA);
            PG8_WAIT_V(8); PG8_WAIT_L(0); PG8_BAR; PG8_MMA(0, 0, At, B0); PG8_MMA(0, 1, At, B1); PG8_BAR; PG8_SCHED;
            PG8_LDA(At, 1, 1); PG8_STAGE(PG8_SB(1, 0), b3, voffB); PG8_STAGE(PG8_SB(1, 1), b3 + hstep, voffB); PG8_STAGE(PG8_SA(1, 0), a3, voffA);
            PG8_WAIT_V(8); PG8_WAIT_L(0); PG8_BAR; PG8_MMA(1, 0, At, B0); PG8_MMA(1, 1, At, B1); PG8_BAR; PG8_SCHED;
            } else {
            PG8_LDB(B0, 0, 0); PG8_SCHED; PG8_LDA(At, 0, 0); PG8_STAGE(PG8_SA(1, 1), a1 + hstep, voffA);
            PG8_WAIT_L(8); PG8_BAR; PG8_WAIT_L(0); PG8_MMA(0, 0, At, B0); PG8_BAR; PG8_SCHED;
            PG8_LDB(B1, 0, 1); PG8_STAGE(PG8_SB(0, 0), b2, voffB);
            PG8_BAR; PG8_WAIT_L(0); PG8_MMA(0, 1, At, B1); PG8_BAR;
            PG8_LDA(At, 0, 1); PG8_STAGE(PG8_SA(0, 0), a2, voffA);
            PG8_BAR; PG8_WAIT_L(0); PG8_MMA(1, 0, At, B0); PG8_BAR; PG8_SCHED;
            PG8_STAGE(PG8_SB(0, 1), b2 + hstep, voffB);
            PG8_WAIT_V(6); PG8_BAR; PG8_MMA(1, 1, At, B1); PG8_BAR;
            PG8_LDB(B0, 1, 0); PG8_SCHED; PG8_LDA(At, 1, 0); PG8_STAGE(PG8_SA(0, 1), a2 + hstep, voffA);
            PG8_WAIT_L(8); PG8_BAR; PG8_WAIT_L(0); PG8_MMA(0, 0, At, B0); PG8_BAR; PG8_SCHED;
            PG8_LDB(B1, 1, 1); PG8_STAGE(PG8_SB(1, 0), b3, voffB);
            PG8_BAR; PG8_WAIT_L(0); PG8_MMA(0, 1, At, B1); PG8_BAR;
            PG8_LDA(At, 1, 1); PG8_STAGE(PG8_SA(1, 0), a3, voffA);
            PG8_BAR; PG8_WAIT_L(0); PG8_MMA(1, 0, At, B0); PG8_BAR; PG8_SCHED;
            PG8_STAGE(PG8_SB(1, 1), b3 + hstep, voffB);
            PG8_WAIT_V(6); PG8_BAR; PG8_MMA(1, 1, At, B1); PG8_BAR;
            }
        }
        if constexpr (ALIGN_EPI) { if (wr == 0) PG8_BAR; }
        if constexpr (!Epi::AFTER_DRAIN) { E(acc, cur, wr, wc, fr, fq); S.done(cur); }
        if (!has_next) break;
#pragma unroll
        for (int a = 0; a < 2; ++a)
#pragma unroll
            for (int b = 0; b < 2; ++b)
#pragma unroll
                for (int m = 0; m < 4; ++m)
#pragma unroll
                    for (int n = 0; n < 2; ++n) acc[a][b][m][n] = (f32x4){0.f, 0.f, 0.f, 0.f};
        cur = nxt; cA = nA; cB = nB; ++ui;
        if constexpr (ALIGN_EPI) { if (wr == 1) PG8_BAR; }
    }
    PG8_WAIT_V(0);
    if constexpr (!ALIGN_EPI) { if (wr == 0) PG8_BAR; }
    PG8_BAR;
    if constexpr (Epi::AFTER_DRAIN) { E.fused(acc, cur, wr, wc, fr, fq, lds, wid, lane); S.done(cur); }
#undef PG8_SA
#undef PG8_SB
#undef PG8_STAGE
#undef PG8_LDA
#undef PG8_LDB
#undef PG8_MMA
#undef PG8_WAIT_V
#undef PG8_WAIT_L
#undef PG8_BAR
#undef PG8_SCHED
}
}
#define GAS __attribute__((address_space(1)))
#define LAS __attribute__((address_space(3)))
typedef unsigned short bf16;
typedef unsigned v4u __attribute__((ext_vector_type(4)));
typedef float f32x4 __attribute__((ext_vector_type(4)));
typedef short bf16x8 __attribute__((ext_vector_type(8)));
typedef GAS unsigned gu32;
typedef GAS unsigned long long gu64;
#define RLX_AGENT __ATOMIC_RELAXED, __HIP_MEMORY_SCOPE_AGENT
#define LDS_WAIT() asm volatile("s_waitcnt lgkmcnt(0)" ::: "memory")
#define VM_WAIT() asm volatile("s_waitcnt vmcnt(0)" ::: "memory")
__device__ __forceinline__ unsigned long long rt() { return __builtin_amdgcn_s_memrealtime(); }
__device__ __forceinline__ unsigned f2bf(float f) { unsigned u = __builtin_bit_cast(unsigned, f); return (u + 0x7fffu + ((u >> 16) & 1u)) >> 16; }
__device__ __forceinline__ unsigned pk2(float lo, float hi) { return f2bf(lo) | (f2bf(hi) << 16); }

#define XB_TMO      128
#define XB_XCNT(j)  (256  + 64 * (j))
#define XB_XSUB(j)  (1280 + 64 * (j))
#define XB_XGEN(j)  (2304 + 64 * (j))
#define XB_TOP      3328
#define XB_TOPGEN   3392
#define XCD_BAR_WORDS 3456
#define XB_SPIN_CAP (1u << 18)

__device__ __forceinline__ unsigned xb_ld(unsigned* p)              { return __hip_atomic_load(p, __ATOMIC_RELAXED, __HIP_MEMORY_SCOPE_AGENT); }
__device__ __forceinline__ unsigned xb_add(unsigned* p, unsigned v) { return __hip_atomic_fetch_add(p, v, __ATOMIC_RELAXED, __HIP_MEMORY_SCOPE_AGENT); }
__device__ __forceinline__ unsigned xb_xcc_id() { return (unsigned)__builtin_amdgcn_s_getreg((3 << 11) | 20) & 0xFu; }
#define XB_SPIN(cond, bar) do { unsigned _sp = 0; while (cond) { __builtin_amdgcn_s_sleep(1); \
    if ((++_sp & 255u) == 0u) { if (xb_ld(&(bar)[XB_TMO])) break; if (_sp > XB_SPIN_CAP) { atomicAdd(&(bar)[XB_TMO], 1u); break; } } } } while (0)

struct XcdBarrier {
    unsigned* bar; unsigned x;
    volatile LAS unsigned* st;
};

__device__ __forceinline__ XcdBarrier xcd_barrier_post(unsigned* bar, volatile LAS unsigned* st) {
    XcdBarrier b; b.bar = bar; b.x = xb_xcc_id(); b.st = st;
    if (threadIdx.x == 0) (void)xb_add(&bar[XB_XCNT(b.x)], 1u);
    return b;
}
__device__ __forceinline__ void xcd_barrier_complete(unsigned* bar, unsigned x, unsigned& nloc, unsigned& nx) {
    const unsigned G = gridDim.x * gridDim.y * gridDim.z;
    unsigned sum, cnt, mine, sp = 0u;
    for (;;) {
        sum = 0u; cnt = 0u; mine = 0u;
#pragma unroll
        for (unsigned j = 0; j < 16; ++j) { const unsigned c = xb_ld(&bar[XB_XCNT(j)]); sum += c; cnt += (c > 0u) ? 1u : 0u; mine = (j == x) ? c : mine; }
        if (sum == G) break;
        __builtin_amdgcn_s_sleep(1);
        if ((++sp & 255u) == 0u) { if (xb_ld(&bar[XB_TMO])) break; if (sp > XB_SPIN_CAP) { atomicAdd(&bar[XB_TMO], 1u); break; } }
    }
    nloc = mine > 0u ? mine : 1u; nx = cnt > 0u ? cnt : 1u;
}

__device__ __forceinline__ void xcd_barrier(const XcdBarrier& b) {
    asm volatile("s_waitcnt vmcnt(0)" ::: "memory");
    __syncthreads();
    if (threadIdx.x == 0) {
        unsigned* bar = b.bar;
        __builtin_amdgcn_s_waitcnt(0);
        unsigned nloc = b.st[0], nx = b.st[1];
        if (nloc == 0u) { xcd_barrier_complete(bar, b.x, nloc, nx); b.st[0] = nloc; b.st[1] = nx; }
        const unsigned old = xb_add(&bar[XB_XSUB(b.x)], 1u);
        const unsigned gen = old / nloc;
        if (old + 1u == (gen + 1u) * nloc) {
            __builtin_amdgcn_fence(__ATOMIC_RELEASE, "agent");
            asm volatile("s_waitcnt vmcnt(0)" ::: "memory");
            const unsigned og = xb_add(&bar[XB_TOP], 1u);
            const unsigned tg = og / nx;
            if (og + 1u == (tg + 1u) * nx) xb_add(&bar[XB_TOPGEN], 1u);
            else XB_SPIN(xb_ld(&bar[XB_TOPGEN]) == tg, bar);
            __builtin_amdgcn_fence(__ATOMIC_ACQUIRE, "agent");
            xb_add(&bar[XB_XGEN(b.x)], 1u);
            asm volatile("s_waitcnt vmcnt(0)" ::: "memory");
        } else {
            XB_SPIN(xb_ld(&bar[XB_XGEN(b.x)]) == gen, bar);
            __builtin_amdgcn_fence(__ATOMIC_ACQUIRE, "agent");
            asm volatile("s_waitcnt vmcnt(0)" ::: "memory");
        }
    }
    __syncthreads();
}
constexpr int NWAVES = 8, NTHR = NWAVES * 64;
constexpr int D = 1024, BATCH = 4, SEQ = 4096, M = BATCH * SEQ, DEPTH = 4;
constexpr int IN_COLS = 6680, NPROJ = 6912;
constexpr int O_Z = 0, O_XBC = 1024, O_DT = 2560, O_QKV = 2576, O_GG = 4112, O_GB = 4624, O_GA = 4628, O_HQ = 4632, O_HF = 5144, O_HI = 5656, O_HG = 6168;
constexpr int DMIX = 2048, NEXP = 16, DEXP = 256, NGU = NEXP * 2 * DEXP  , KDN = NEXP * DEXP  ;
constexpr float DN_ALPHA = 1.6817928305074290f;
constexpr float LN_EPS = 1e-5f;

constexpr size_t MiB = 1u << 20;
constexpr size_t WS_CTL = 0, CTL_ZERO_BYTES = 1 * MiB;
constexpr size_t WS_LTOK = 2 * MiB;
constexpr size_t WS_LW = 3 * MiB;
constexpr size_t WS_SLOT = 4 * MiB;
constexpr size_t WS_WSORT = 5 * MiB;
constexpr size_t WS_WIN = 8 * MiB;
constexpr size_t WS_WOUT = 22 * MiB;
constexpr size_t WS_WGU = 26 * MiB;
constexpr size_t WS_WDN = 42 * MiB;
constexpr size_t WS_YMIX = 52 * MiB;
constexpr size_t WS_HB = WS_YMIX;
constexpr size_t WS_PROJ = 116 * MiB;
constexpr size_t WS_MIX = WS_PROJ;
constexpr int MAXROWS = 2 * M + 16 * 256;
constexpr size_t WS_XS = WS_PROJ + 64 * MiB;
constexpr size_t WS_HS = WS_PROJ + 136 * MiB;
constexpr size_t WS_YS = WS_PROJ + 154 * MiB;
constexpr int CW_CNT = 8192;
constexpr int LDS_OFF_TAB = 131072 + 1024;
constexpr size_t WS_SCR = 332 * MiB;
constexpr size_t WS_HG_QG = WS_SCR;
constexpr size_t WS_HG_KDT = WS_SCR + 16 * MiB;
constexpr size_t WS_HG_A = WS_SCR + 32 * MiB;
constexpr size_t WS_HG_GL = WS_SCR + 40 * MiB;
constexpr size_t WS_SSD_C = WS_SCR + 41 * MiB;
constexpr size_t WS_SSD_BT = WS_SCR + 49 * MiB;
constexpr size_t WS_SSD_CB = WS_SCR + 57 * MiB;
constexpr size_t WS_SSD_XT = WS_SCR + 65 * MiB;
constexpr size_t WS_SSD_AC = WS_SCR + 97 * MiB;
constexpr size_t WS_SSD_DT = WS_SCR + 98 * MiB;
constexpr size_t WS_GD_K = WS_SCR + 99 * MiB;
constexpr size_t WS_GD_KT = WS_SCR + 115 * MiB;
constexpr size_t WS_GD_QG = WS_SCR + 131 * MiB;
constexpr size_t WS_GD_VT = WS_SCR + 147 * MiB;
constexpr size_t WS_GD_T = WS_SCR + 163 * MiB;
constexpr size_t WS_GD_QK = WS_SCR + 171 * MiB;
constexpr size_t WS_GD_VEC = WS_SCR + 179 * MiB;
constexpr size_t WS_END = 512 * MiB;
constexpr int CW_BAR = 4096;

constexpr int RING_OFF = 0, RING_BYTES = 131072;
constexpr int LDSCTL_OFF = RING_BYTES, MISC_OFF = LDSCTL_OFF + 320;
constexpr int LDS_BYTES = 147456;

__device__ __forceinline__ float bf2f(unsigned short b) { return __builtin_bit_cast(float, ((unsigned)b) << 16); }
__device__ __forceinline__ float bflo(unsigned w) { return __builtin_bit_cast(float, w << 16); }
__device__ __forceinline__ float bfhi(unsigned w) { return __builtin_bit_cast(float, w & 0xffff0000u); }
__device__ __forceinline__ float siluf(float x) { return x / (1.0f + __expf(-x)); }
__device__ __forceinline__ float sigmoidf_(float x) { return 1.0f / (1.0f + __expf(-x)); }
__device__ __forceinline__ float softplusf_(float x) { return x > 20.f ? x : log1pf(__expf(x)); }
__device__ __forceinline__ float wave_sum(float v) {
#pragma unroll
    for (int o = 1; o < 64; o <<= 1) v += __shfl_xor(v, o);
    return v;
}

struct Args {
    const float* in[25]; float* out; unsigned char* ws; int ph_lo, ph_hi;
};
typedef const __attribute__((address_space(4))) Args* CArgs;
#define ARGS_HERE() ([]() { CArgs p_ = (CArgs)__builtin_amdgcn_kernarg_segment_ptr(); asm volatile("" : "+s"(p_)); return p_; }())
enum { I_X = 0, I_WIN, I_SCW, I_SCB, I_SDTB, I_SALOG, I_SD, I_SNW, I_GCW, I_GDTB, I_GALOG, I_GNW, I_HLB, I_HNW, I_WOUT, I_LN1G, I_LN1B, I_WRG, I_BRG, I_WRE, I_BRE, I_WGU, I_WDN, I_LN2G, I_LN2B };

__device__ __forceinline__ void transpose_item(const float* W, int ldw, int nvalid, int k0, int n0, bf16* WT, size_t ldt, int drow0, int dk0, LAS float* scr, int lane) {
#pragma unroll 8
    for (int i = 0; i < 32; ++i) { const int kk = 2 * i + (lane >> 5), nn = lane & 31, n = n0 + nn; scr[kk * 33 + nn] = (n < nvalid) ? W[(size_t)(k0 + kk) * ldw + n] : 0.f; }
    LDS_WAIT(); asm volatile("" ::: "memory");
    const int c = lane & 7;
#pragma unroll
    for (int j = 0; j < 4; ++j) { const int n = (lane >> 3) + 8 * j; const LAS float* s = scr + (8 * c) * 33 + n;
        v4u o; o.x = pk2(s[0 * 33], s[1 * 33]); o.y = pk2(s[2 * 33], s[3 * 33]); o.z = pk2(s[4 * 33], s[5 * 33]); o.w = pk2(s[6 * 33], s[7 * 33]);
        *(GAS v4u*)(WT + (size_t)(drow0 + n) * ldt + dk0 + k0 + 8 * c) = o; }
    LDS_WAIT(); asm volatile("" ::: "memory");
}
__device__ __forceinline__ void weights_phase(CArgs a, int l, const int which, LAS unsigned char* lds, int gw, int NGW, int tid) {
    asm volatile("" : "+v"(tid));
    const int lane = tid & 63, wave = tid >> 6;
    LAS float* scr = (LAS float*)(lds + wave * 16384);
    constexpr int I_IN = 16 * (NPROJ / 32), I_OUT = (DMIX / 64) * (D / 32), I_GU = NEXP * 16 * 16, I_DN = NEXP * 4 * 32;
    const int n_in = (which & 1) ? I_IN : 0, n_out = (which & 2) ? I_OUT : 0, n_gu = (which & 4) ? I_GU : 0, n_dn = (which & 8) ? I_DN : 0;
    unsigned char* ws = a->ws;
    for (int it = gw; it < n_in + n_out + n_gu + n_dn; it += NGW) {
        int r = it;
        if (r < n_in) { const int kb = r / (NPROJ / 32), nb = r % (NPROJ / 32);
            transpose_item(a->in[I_WIN] + (size_t)l * D * IN_COLS, IN_COLS, IN_COLS, 64 * kb, 32 * nb, (bf16*)(ws + WS_WIN), D, 32 * nb, 0, scr, lane); continue; }
        r -= n_in;
        if (r < n_out) { const int kb = r / (D / 32), nb = r % (D / 32);
            transpose_item(a->in[I_WOUT] + (size_t)l * DMIX * D, D, D, 64 * kb, 32 * nb, (bf16*)(ws + WS_WOUT), DMIX, 32 * nb, 0, scr, lane); continue; }
        r -= n_out;
        if (r < n_gu) { const int e = r / 256, q = r % 256, kb = q / 16, nb = q % 16, c0 = 32 * nb, bj = c0 / 256, hf = (c0 % 256) / 128, j0 = c0 % 128;
            transpose_item(a->in[I_WGU] + (size_t)(l * NEXP + e) * D * 512, 512, 512, 64 * kb, c0, (bf16*)(ws + WS_WGU), D, e * 512 + hf * 256 + bj * 128 + j0, 0, scr, lane); continue; }
        r -= n_gu;
        { const int e = r / 128, q = r % 128, kb = q / 32, nb = q % 32;
            transpose_item(a->in[I_WDN] + (size_t)(l * NEXP + e) * DEXP * D, D, D, 64 * kb, 32 * nb, (bf16*)(ws + WS_WDN), DEXP, e * D + 32 * nb, 0, scr, lane); }
    }
}
__device__ __forceinline__ void p0_prologue(CArgs a, LAS unsigned char* lds, int wg, int G, int tid) {
    asm volatile("" : "+v"(tid));
    const f32x4* x4 = (const f32x4*)a->in[I_X]; f32x4* h4 = (f32x4*)a->out; unsigned long long* hb8 = (unsigned long long*)(a->ws + WS_HB);
    for (size_t i = (size_t)wg * NTHR + tid; i < (size_t)M * D / 4; i += (size_t)G * NTHR) { const f32x4 v = x4[i]; h4[i] = v;
        hb8[i] = (unsigned long long)pk2(v.x, v.y) | ((unsigned long long)pk2(v.z, v.w) << 32); }
}

#define WG_BAR() do { asm volatile("s_waitcnt lgkmcnt(0)" ::: "memory"); __builtin_amdgcn_s_barrier(); asm volatile("" ::: "memory"); } while (0)
__device__ __forceinline__ f32x4 mfma16(bf16x8 x, bf16x8 y, f32x4 c) { return __builtin_amdgcn_mfma_f32_16x16x32_bf16(x, y, c, 0, 0, 0); }
__device__ __forceinline__ bf16x8 lds_frag(const LAS bf16* base, int row0, int stride, int k0, int lane) { return *(const LAS bf16x8*)(base + (row0 + (lane & 15)) * stride + k0 + 8 * (lane >> 4)); }
__device__ __forceinline__ bf16x8 pack8(const float* v) { v4u w; w.x = pk2(v[0], v[1]); w.y = pk2(v[2], v[3]); w.z = pk2(v[4], v[5]); w.w = pk2(v[6], v[7]); return __builtin_bit_cast(bf16x8, w); }
__device__ __forceinline__ unsigned long long pack4(f32x4 v) { return (unsigned long long)pk2(v[0], v[1]) | ((unsigned long long)pk2(v[2], v[3]) << 32); }

__device__ __forceinline__ void hgrn_prep_phase(CArgs a, int l, LAS unsigned char* lds, int wg, int G, int tid) {
    asm volatile("" : "+v"(tid));
    constexpr int LS = 132;
    LAS float* sQ = (LAS float*)lds; LAS float* sK = sQ + 64 * LS; LAS float* sB = sK + 64 * LS; LAS float* sT = sB + 64 * LS; LAS float* sLb = sT + 512;
    const bf16* PROJ = (const bf16*)(a->ws + WS_PROJ);
    const int lane = tid & 63, w = tid >> 6, r = lane & 15, q4 = lane >> 4;
    for (int unit = wg; unit < 1024; unit += G) {
        const int b = unit >> 8, head = (unit >> 6) & 3, c = unit & 63;
        const size_t row0 = (size_t)b * SEQ + c * 64;
        __syncthreads();
        if (tid < 128) {
            const int ch = head * 128 + tid; float lg[DEPTH], mx = -1e30f;
#pragma unroll
            for (int j = 0; j < DEPTH; ++j) { lg[j] = a->in[I_HLB][j * 512 + ch]; mx = fmaxf(mx, lg[j]); }
            float den = 0.f, num = 0.f;
#pragma unroll
            for (int j = 0; j < DEPTH; ++j) { const float e = __expf(lg[j] - mx); den += e; if (j >= 1 && j <= l) num += e; }
            sLb[tid] = num / den;
        }
        __syncthreads();
        for (int p = tid; p < 1024; p += NTHR) {
            const int t = p >> 4, d8 = (p & 15) * 8;
            const v4u qv = *(const GAS v4u*)(PROJ + (row0 + t) * NPROJ + O_HQ + head * 128 + d8), fv = *(const GAS v4u*)(PROJ + (row0 + t) * NPROJ + O_HF + head * 128 + d8);
#pragma unroll
            for (int i = 0; i < 4; ++i) {
                const int d = d8 + 2 * i; const float lb0 = sLb[d], lb1 = sLb[d + 1];
                sQ[t * LS + d] = siluf(bflo(qv[i])); sQ[t * LS + d + 1] = siluf(bfhi(qv[i]));
                const float f0 = lb0 + (1.f - lb0) * sigmoidf_(bflo(fv[i])), f1 = lb1 + (1.f - lb1) * sigmoidf_(bfhi(fv[i]));
                sK[t * LS + d] = 1.f - f0; sK[t * LS + d + 1] = 1.f - f1; sB[t * LS + d] = __logf(f0); sB[t * LS + d + 1] = __logf(f1);
            }
        }
        __syncthreads();
        {
            const int d = tid & 127, seg = tid >> 7; float run = 0.f, vals[16];
#pragma unroll
            for (int i = 0; i < 16; ++i) { run += sB[(seg * 16 + i) * LS + d]; vals[i] = run; }
            sT[seg * 128 + d] = run;
            __syncthreads();
            float off = 0.f;
#pragma unroll
            for (int s2 = 0; s2 < 3; ++s2) if (s2 < seg) off += sT[s2 * 128 + d];
#pragma unroll
            for (int i = 0; i < 16; ++i) sB[(seg * 16 + i) * LS + d] = vals[i] + off;
        }
        __syncthreads();
        bf16* qg = (bf16*)(a->ws + WS_HG_QG) + (size_t)unit * 64 * 128; bf16* kdt = (bf16*)(a->ws + WS_HG_KDT) + (size_t)unit * 128 * 64;
        bf16* am = (bf16*)(a->ws + WS_HG_A) + (size_t)unit * 64 * 64; float* gl = (float*)(a->ws + WS_HG_GL) + (size_t)unit * 128;
        for (int p = tid; p < 1024; p += NTHR) { const int t = p >> 4, d8 = (p & 15) * 8; float v[8];
#pragma unroll
            for (int jj = 0; jj < 8; ++jj) v[jj] = sQ[t * LS + d8 + jj] * __expf(sB[t * LS + d8 + jj]);
            *(GAS bf16x8*)(qg + t * 128 + d8) = pack8(v); }
        for (int p = tid; p < 1024; p += NTHR) { const int d = p >> 3, s8 = (p & 7) * 8; const float bl = sB[63 * LS + d]; float v[8];
#pragma unroll
            for (int jj = 0; jj < 8; ++jj) v[jj] = sK[(s8 + jj) * LS + d] * __expf(bl - sB[(s8 + jj) * LS + d]);
            *(GAS bf16x8*)(kdt + d * 64 + s8) = pack8(v); }
        if (tid < 128) gl[tid] = __expf(sB[63 * LS + tid]);
        for (int p = w; p < 16; p += NWAVES) {
            const int i = p >> 2, j = p & 3; f32x4 acc = {0.f, 0.f, 0.f, 0.f};
            if (j <= i) {
#pragma unroll
                for (int ks = 0; ks < 4; ++ks) { const int d0 = 32 * ks + 8 * q4, t = 16 * i + r, s_ = 16 * j + r; float qf[8], kf[8];
#pragma unroll
                    for (int jj = 0; jj < 8; ++jj) { const float ref = i ? sB[(16 * i - 1) * LS + d0 + jj] : 0.f;
                        qf[jj] = sQ[t * LS + d0 + jj] * __expf(sB[t * LS + d0 + jj] - ref); kf[jj] = sK[s_ * LS + d0 + jj] * __expf(ref - sB[s_ * LS + d0 + jj]); }
                    acc = mfma16(pack8(kf), pack8(qf), acc); }
                const int t = 16 * i + r;
#pragma unroll
                for (int ii = 0; ii < 4; ++ii) if (16 * j + 4 * q4 + ii > t) acc[ii] = 0.f;
            }
            *(GAS unsigned long long*)(am + (16 * i + r) * 64 + 16 * j + 4 * q4) = pack4(acc);
        }
    }
}
__device__ __forceinline__ void hgrn_scan_phase(CArgs a, int l, LAS unsigned char* lds, const int b, const int head, const int eb, int tid) {
    asm volatile("" : "+v"(tid));
    constexpr int QS = 136, KS = 72;
    constexpr int B_QG = 0, B_KDT = 17408, B_A = B_KDT + 18432, B_VT = B_A + 9216, B_GL = B_VT + 4608, BUF = B_GL + 512;
    LAS unsigned char* sST0 = lds + 2 * BUF;
    const bf16* PROJ = (const bf16*)(a->ws + WS_PROJ); bf16* YMIX = (bf16*)(a->ws + WS_YMIX);
    const int lane = tid & 63, w = tid >> 6, r = lane & 15, q4 = lane >> 4;
    {
        const size_t cu0 = (size_t)(b * 4 + head) * 64;
        const bf16* QG = (const bf16*)(a->ws + WS_HG_QG) + cu0 * 64 * 128; const bf16* KDT = (const bf16*)(a->ws + WS_HG_KDT) + cu0 * 128 * 64;
        const bf16* AM = (const bf16*)(a->ws + WS_HG_A) + cu0 * 64 * 64; const float* GL = (const float*)(a->ws + WS_HG_GL) + cu0 * 128;
        const bf16* VP = PROJ + (size_t)b * SEQ * NPROJ + O_HI + head * 128 + eb * 32;
        v4u rq[2], rk[2], ra, rv; f32x4 rg;
#define HG_LOAD(n) do { _Pragma("unroll") for (int i = 0; i < 2; ++i) { const int p = tid + NTHR * i; rq[i] = *(const GAS v4u*)(QG + (size_t)(n) * 8192 + (p >> 4) * 128 + (p & 15) * 8); \
            rk[i] = *(const GAS v4u*)(KDT + (size_t)(n) * 8192 + (p >> 3) * 64 + (p & 7) * 8); } \
            ra = *(const GAS v4u*)(AM + (size_t)(n) * 4096 + (tid >> 3) * 64 + (tid & 7) * 8); \
            if (tid < 256) rv = *(const GAS v4u*)(VP + (size_t)((n) * 64 + (tid >> 2)) * NPROJ + (tid & 3) * 8); \
            if (tid < 32) rg = *(const GAS f32x4*)(GL + (size_t)(n) * 128 + tid * 4); } while (0)
#define HG_STORE(bufp) do { LAS unsigned char* bp_ = (bufp); _Pragma("unroll") for (int i = 0; i < 2; ++i) { const int p = tid + NTHR * i; \
            *(LAS v4u*)(bp_ + B_QG + ((p >> 4) * QS + (p & 15) * 8) * 2) = rq[i]; *(LAS v4u*)(bp_ + B_KDT + ((p >> 3) * KS + (p & 7) * 8) * 2) = rk[i]; } \
            *(LAS v4u*)(bp_ + B_A + ((tid >> 3) * KS + (tid & 7) * 8) * 2) = ra; \
            if (tid < 256) { LAS bf16* vt = (LAS bf16*)(bp_ + B_VT); const int t_ = tid >> 2, e8 = (tid & 3) * 8; _Pragma("unroll") for (int i = 0; i < 4; ++i) { \
                vt[(e8 + 2 * i) * KS + t_] = (bf16)(rv[i] & 0xffffu); vt[(e8 + 2 * i + 1) * KS + t_] = (bf16)(rv[i] >> 16); } } \
            if (tid < 32) *(LAS f32x4*)(bp_ + B_GL + tid * 16) = rg; } while (0)
        __syncthreads();
        HG_LOAD(0);
        for (int i = tid; i < 8704 / 4; i += NTHR) ((LAS unsigned*)sST0)[i] = 0u;
        HG_STORE(lds);
        f32x4 accS[2] = {{0.f, 0.f, 0.f, 0.f}, {0.f, 0.f, 0.f, 0.f}};
        __syncthreads();
        for (int n = 0; n < 64; ++n) {
            const int cur = n & 1; LAS unsigned char* bp = lds + cur * BUF; LAS bf16* sST = (LAS bf16*)(sST0 + cur * 8704); LAS bf16* sSTn = (LAS bf16*)(sST0 + (cur ^ 1) * 8704);
            if (n + 1 < 64) HG_LOAD(n + 1);
            {
                const int tt = w >> 1, et = w & 1; f32x4 acc = {0.f, 0.f, 0.f, 0.f};
#pragma unroll
                for (int ks = 0; ks < 4; ++ks) acc = mfma16(lds_frag(sST, 16 * et, QS, 32 * ks, lane), lds_frag((LAS bf16*)(bp + B_QG), 16 * tt, QS, 32 * ks, lane), acc);
#pragma unroll
                for (int ks = 0; ks < 2; ++ks) acc = mfma16(lds_frag((LAS bf16*)(bp + B_VT), 16 * et, KS, 32 * ks, lane), lds_frag((LAS bf16*)(bp + B_A), 16 * tt, KS, 32 * ks, lane), acc);
                *(GAS unsigned long long*)(YMIX + ((size_t)b * SEQ + n * 64 + 16 * tt + r) * DMIX + 1536 + head * 128 + eb * 32 + 16 * et + 4 * q4) = pack4(acc);
            }
            {
                const f32x4 glv = *(const LAS f32x4*)(bp + B_GL + (16 * w + 4 * q4) * 4);
#pragma unroll
                for (int et = 0; et < 2; ++et) { accS[et] = accS[et] * glv;
#pragma unroll
                    for (int ks = 0; ks < 2; ++ks) accS[et] = mfma16(lds_frag((LAS bf16*)(bp + B_KDT), 16 * w, KS, 32 * ks, lane), lds_frag((LAS bf16*)(bp + B_VT), 16 * et, KS, 32 * ks, lane), accS[et]);
                    *(LAS unsigned long long*)(sSTn + (16 * et + r) * QS + 16 * w + 4 * q4) = pack4(accS[et]); }
            }
            if (n + 1 < 64) HG_STORE(lds + (cur ^ 1) * BUF);
            WG_BAR();
        }
#undef HG_LOAD
#undef HG_STORE
    }
}

__device__ __forceinline__ void ssd_rec_phase(CArgs a, int l, LAS unsigned char* lds, int wg, int G, int tid) {
    asm volatile("" : "+v"(tid));
    constexpr int TB = 64;
    LAS float* sX = (LAS float*)lds; LAS float* sB = sX + TB * 16; LAS float* sC = sB + TB * 128; LAS float* sDt = sC + TB * 128; LAS float* sDa = sDt + TB; LAS float* sY = sDa + TB;
    const bf16* PROJ = (const bf16*)(a->ws + WS_PROJ); bf16* YMIX = (bf16*)(a->ws + WS_YMIX);
    const float* cw = a->in[I_SCW] + (size_t)l * 4 * 1536; const float* cb = a->in[I_SCB] + (size_t)l * 1536;
    const int p_local = tid >> 5, nq = tid & 31;
    for (int unit = wg; unit < 256; unit += G) {
        const int b = unit >> 6, head = (unit >> 2) & 15, pq = unit & 3, g = head >> 3;
        const float A = -__expf(a->in[I_SALOG][l * 16 + head]), dtb = a->in[I_SDTB][l * 16 + head], Dsk = a->in[I_SD][l * 16 + head];
        float h0 = 0.f, h1 = 0.f, h2 = 0.f, h3 = 0.f;
        for (int t0 = 0; t0 < SEQ; t0 += TB) {
            __syncthreads();
            for (int idx = tid; idx < TB * 272; idx += NTHR) {
                const int tt = idx / 272, ci = idx % 272, t = t0 + tt;
                const int ch = ci < 16 ? head * 64 + pq * 16 + ci : (ci < 144 ? 1024 + g * 128 + (ci - 16) : 1280 + g * 128 + (ci - 144));
                float acc = cb[ch];
#pragma unroll
                for (int k = 0; k < 4; ++k) { const int ts = t - 3 + k; if (ts >= 0) acc += cw[k * 1536 + ch] * bf2f(PROJ[(size_t)(b * SEQ + ts) * NPROJ + O_XBC + ch]); }
                const float v = siluf(acc);
                if (ci < 16) sX[tt * 16 + ci] = v; else if (ci < 144) sB[tt * 128 + ci - 16] = v; else sC[tt * 128 + ci - 144] = v;
            }
            if (tid < TB) { const float raw = bf2f(PROJ[(size_t)(b * SEQ + t0 + tid) * NPROJ + O_DT + head]); const float dt = softplusf_(raw + dtb); sDt[tid] = dt; sDa[tid] = __expf(dt * A); }
            __syncthreads();
#pragma unroll 4
            for (int tt = 0; tt < TB; ++tt) {
                const float xv = sX[tt * 16 + p_local], da = sDa[tt], dx = sDt[tt] * xv;
                const f32x4 Bv = *(const LAS f32x4*)(sB + tt * 128 + nq * 4), Cv = *(const LAS f32x4*)(sC + tt * 128 + nq * 4);
                h0 = da * h0 + dx * Bv.x; h1 = da * h1 + dx * Bv.y; h2 = da * h2 + dx * Bv.z; h3 = da * h3 + dx * Bv.w;
                float part = (Cv.x * h0 + Cv.y * h1) + (Cv.z * h2 + Cv.w * h3);
                part += __shfl_xor(part, 1); part += __shfl_xor(part, 2); part += __shfl_xor(part, 4); part += __shfl_xor(part, 8); part += __shfl_xor(part, 16);
                if (nq == 0) sY[tt * 16 + p_local] = part + Dsk * xv;
            }
            __syncthreads();
            for (int idx = tid; idx < TB * 16; idx += NTHR) { const int tt = idx >> 4, i = idx & 15; YMIX[(size_t)(b * SEQ + t0 + tt) * DMIX + head * 64 + pq * 16 + i] = (bf16)f2bf(sY[idx]); }
        }
    }
}

__device__ __forceinline__ void ssd_prep_phase(CArgs a, int l, LAS unsigned char* lds, int wg, int G, int tid) {
    asm volatile("" : "+v"(tid));
    constexpr int PS = 136;
    LAS bf16* sB = (LAS bf16*)lds; LAS bf16* sC = sB + 128 * PS; LAS bf16* sXT = (LAS bf16*)lds; LAS float* sDt = (LAS float*)(lds + 2 * 128 * PS * 2);
    const bf16* PROJ = (const bf16*)(a->ws + WS_PROJ);
    const float* cw = a->in[I_SCW] + (size_t)l * 4 * 1536; const float* cb = a->in[I_SCB] + (size_t)l * 1536;
    const int lane = tid & 63, w = tid >> 6, r = lane & 15, q4 = lane >> 4;
    for (int unit = wg; unit < 256; unit += G) {
        const int b = unit >> 6, c = (unit >> 1) & 31, g = unit & 1;
        const size_t row0 = (size_t)b * SEQ + c * 128;
        bf16* Cg = (bf16*)(a->ws + WS_SSD_C) + (size_t)unit * 16384; bf16* BTg = (bf16*)(a->ws + WS_SSD_BT) + (size_t)unit * 16384; bf16* CBg = (bf16*)(a->ws + WS_SSD_CB) + (size_t)unit * 16384;
        __syncthreads();
        {
            const int c16 = tid & 31, l0 = tid >> 5; const int ch = (c16 < 16 ? 1024 + g * 128 + c16 * 8 : 1280 + g * 128 + (c16 - 16) * 8);
            float wk[4][8], bias[8];
#pragma unroll
            for (int jj = 0; jj < 8; ++jj) { bias[jj] = cb[ch + jj];
#pragma unroll
                for (int k = 0; k < 4; ++k) wk[k][jj] = cw[k * 1536 + ch + jj]; }
            LAS bf16* dst = (c16 < 16 ? sB : sC) + (c16 & 15) * 8;
#pragma unroll 2
            for (int i = 0; i < 8; ++i) { const int ll = l0 + 16 * i; float acc[8];
#pragma unroll
                for (int jj = 0; jj < 8; ++jj) acc[jj] = bias[jj];
#pragma unroll
                for (int k = 0; k < 4; ++k) { const int ts = c * 128 + ll - 3 + k;
                    if (ts >= 0) { const v4u xv = *(const GAS v4u*)(PROJ + ((size_t)b * SEQ + ts) * NPROJ + O_XBC + ch);
#pragma unroll
                        for (int j = 0; j < 4; ++j) { acc[2 * j] += wk[k][2 * j] * bflo(xv[j]); acc[2 * j + 1] += wk[k][2 * j + 1] * bfhi(xv[j]); } } }
#pragma unroll
                for (int jj = 0; jj < 8; ++jj) acc[jj] = siluf(acc[jj]);
                *(LAS bf16x8*)(dst + ll * PS) = pack8(acc); }
        }
        {
            const int head = g * 8 + w; const float A = -__expf(a->in[I_SALOG][l * 16 + head]), dtb = a->in[I_SDTB][l * 16 + head];
            const int l2 = 2 * lane;
            const float dt0 = softplusf_(bf2f(PROJ[(row0 + l2) * NPROJ + O_DT + head]) + dtb), dt1 = softplusf_(bf2f(PROJ[(row0 + l2 + 1) * NPROJ + O_DT + head]) + dtb);
            const float da1 = dt1 * A; float sc = dt0 * A + da1;
#pragma unroll
            for (int o = 1; o < 64; o <<= 1) { const float t_ = __shfl_up(sc, o); if (lane >= o) sc += t_; }
            sDt[w * 128 + l2] = dt0; sDt[w * 128 + l2 + 1] = dt1;
            const size_t uh = (size_t)((b * 16 + head) * 32 + c) * 128;
            float* AC = (float*)(a->ws + WS_SSD_AC) + uh; float* DT = (float*)(a->ws + WS_SSD_DT) + uh;
            AC[l2] = sc - da1; AC[l2 + 1] = sc; DT[l2] = dt0; DT[l2 + 1] = dt1;
        }
        __syncthreads();
#pragma unroll
        for (int st = 0; st < 8; ++st) {
            f32x4 acc = {0.f, 0.f, 0.f, 0.f};
            if (st <= w) {
#pragma unroll
                for (int ks = 0; ks < 4; ++ks) acc = mfma16(lds_frag(sB, 16 * st, PS, 32 * ks, lane), lds_frag(sC, 16 * w, PS, 32 * ks, lane), acc); }
            *(GAS unsigned long long*)(CBg + (16 * w + r) * 128 + 16 * st + 4 * q4) = pack4(acc);
        }
        for (int p = tid; p < 2048; p += NTHR) { const int ll = p >> 4, n8 = (p & 15) * 8; *(GAS v4u*)(Cg + ll * 128 + n8) = *(const LAS v4u*)(sC + ll * PS + n8); }
        for (int p = tid; p < 2048; p += NTHR) { const int n = p >> 4, l8 = (p & 15) * 8; v4u o;
#pragma unroll
            for (int j = 0; j < 4; ++j) o[j] = (unsigned)sB[(l8 + 2 * j) * PS + n] | ((unsigned)sB[(l8 + 2 * j + 1) * PS + n] << 16);
            *(GAS v4u*)(BTg + n * 128 + l8) = o; }
#pragma unroll 1
        for (int hf = 0; hf < 2; ++hf) {
            __syncthreads();
            {   const int cg = tid & 31, l0 = tid >> 5, chl = cg * 8, ch = g * 512 + hf * 256 + chl, hh = hf * 4 + (cg >> 3);
                float wk[4][8], bias[8];
#pragma unroll
                for (int jj = 0; jj < 8; ++jj) { bias[jj] = cb[ch + jj];
#pragma unroll
                    for (int k = 0; k < 4; ++k) wk[k][jj] = cw[k * 1536 + ch + jj]; }
#pragma unroll 2
                for (int i = 0; i < 8; ++i) { const int ll = l0 + 16 * i; float acc[8];
#pragma unroll
                    for (int jj = 0; jj < 8; ++jj) acc[jj] = bias[jj];
#pragma unroll
                    for (int k = 0; k < 4; ++k) { const int ts = c * 128 + ll - 3 + k;
                        if (ts >= 0) { const v4u xv = *(const GAS v4u*)(PROJ + ((size_t)b * SEQ + ts) * NPROJ + O_XBC + ch);
#pragma unroll
                            for (int j = 0; j < 4; ++j) { acc[2 * j] += wk[k][2 * j] * bflo(xv[j]); acc[2 * j + 1] += wk[k][2 * j + 1] * bfhi(xv[j]); } } }
                    const float dtv = sDt[hh * 128 + ll];
#pragma unroll
                    for (int jj = 0; jj < 8; ++jj) sXT[(chl + jj) * PS + ll] = (bf16)f2bf(siluf(acc[jj]) * dtv); }
            }
            __syncthreads();
            for (int p = tid; p < 4096; p += NTHR) { const int chl = p >> 4, l8 = (p & 15) * 8, hh = hf * 4 + (chl >> 6), pp = chl & 63;
                const size_t uh = (size_t)((b * 16 + g * 8 + hh) * 32 + c);
                *(GAS v4u*)((bf16*)(a->ws + WS_SSD_XT) + (uh * 64 + pp) * 128 + l8) = *(const LAS v4u*)(sXT + chl * PS + l8); }
        }
    }
}
__device__ __forceinline__ void ssd_scan_phase(CArgs a, int l, LAS unsigned char* lds, const int b, const int head, int tid) {
    asm volatile("" : "+v"(tid));
    constexpr int PS = 136, O_S = 0, O_X = 34816, O_AC = 69632, O_TE = 70656, O_DT = 71680;
    bf16* YMIX = (bf16*)(a->ws + WS_YMIX);
    const int lane = tid & 63, w = tid >> 6, r = lane & 15, q4 = lane >> 4;
    {
        const int g = head >> 3;
        const float Dsk = a->in[I_SD][l * 16 + head];
        const bf16* Cg = (const bf16*)(a->ws + WS_SSD_C) + (size_t)((b * 32) * 2 + g) * 16384 + (16 * w + r) * 128 + 8 * q4;
        const bf16* CBg = (const bf16*)(a->ws + WS_SSD_CB) + (size_t)((b * 32) * 2 + g) * 16384 + (16 * w + r) * 128 + 8 * q4;
        const bf16* BTg = (const bf16*)(a->ws + WS_SSD_BT) + (size_t)((b * 32) * 2 + g) * 16384 + (16 * w + r) * 128 + 8 * q4;
        const size_t uh0 = (size_t)(b * 16 + head) * 32;
        const bf16* XTg = (const bf16*)(a->ws + WS_SSD_XT) + uh0 * 8192; const float* ACg = (const float*)(a->ws + WS_SSD_AC) + uh0 * 128; const float* DTg = (const float*)(a->ws + WS_SSD_DT) + uh0 * 128;
        v4u fC[4], fCB[4], fBT[4], rx[2]; float rac = 0.f, racl = 0.f, rdt = 0.f;
#define SSD_LDF(cc, dst, src) do { _Pragma("unroll") for (int ks = 0; ks < 4; ++ks) dst[ks] = *(const GAS v4u*)(src + (size_t)(cc) * 32768 + 32 * ks); } while (0)
#define SSD_LOADX(cc) do { _Pragma("unroll") for (int i = 0; i < 2; ++i) { const int p = tid + NTHR * i; rx[i] = *(const GAS v4u*)(XTg + (size_t)(cc) * 8192 + (p >> 4) * 128 + (p & 15) * 8); } \
            if (tid < 128) { rac = ACg[(cc) * 128 + tid]; racl = ACg[(cc) * 128 + 127]; rdt = DTg[(cc) * 128 + tid]; } } while (0)
#define SSD_STORE(bi) do { _Pragma("unroll") for (int i = 0; i < 2; ++i) { const int p = tid + NTHR * i; *(LAS v4u*)(lds + O_X + (bi) * 17408 + ((p >> 4) * PS + (p & 15) * 8) * 2) = rx[i]; } \
            if (tid < 128) { ((LAS float*)(lds + O_AC))[(bi) * 128 + tid] = rac; ((LAS float*)(lds + O_TE))[(bi) * 128 + tid] = __expf(racl - rac); ((LAS float*)(lds + O_DT))[(bi) * 128 + tid] = rdt; } } while (0)
        __syncthreads();
        SSD_LDF(0, fC, Cg); SSD_LDF(0, fCB, CBg); SSD_LDF(0, fBT, BTg); SSD_LOADX(0);
        for (int i = tid; i < 17408 / 4; i += NTHR) ((LAS unsigned*)(lds + O_S))[i] = 0u;
        SSD_STORE(0);
        f32x4 accS[4];
#pragma unroll
        for (int pt = 0; pt < 4; ++pt) accS[pt] = (f32x4){0.f, 0.f, 0.f, 0.f};
        __syncthreads();
        for (int c = 0; c < 32; ++c) {
            const int cur = c & 1;
            const LAS bf16* sS = (const LAS bf16*)(lds + O_S + cur * 17408); LAS bf16* sSn = (LAS bf16*)(lds + O_S + (cur ^ 1) * 17408); const LAS bf16* sXT = (const LAS bf16*)(lds + O_X + cur * 17408);
            const LAS float* sAc = (const LAS float*)(lds + O_AC) + cur * 128; const LAS float* sTe = (const LAS float*)(lds + O_TE) + cur * 128; const LAS float* sDt = (const LAS float*)(lds + O_DT) + cur * 128;
            const int cn = c + 1 < 32 ? c + 1 : c;
            SSD_LOADX(cn);
            const int lrow = 16 * w + r; const float ac_l = sAc[lrow];
            f32x4 accO[4], accD[4];
#pragma unroll
            for (int pt = 0; pt < 4; ++pt) { accO[pt] = (f32x4){0.f, 0.f, 0.f, 0.f}; accD[pt] = (f32x4){0.f, 0.f, 0.f, 0.f}; }
#pragma unroll
            for (int ks = 0; ks < 4; ++ks) { const bf16x8 yf = __builtin_bit_cast(bf16x8, fC[ks]);
#pragma unroll
                for (int pt = 0; pt < 4; ++pt) accO[pt] = mfma16(lds_frag(sS, 16 * pt, PS, 32 * ks, lane), yf, accO[pt]); }
            SSD_LDF(cn, fC, Cg);
#pragma unroll
            for (int ks = 0; ks < 4; ++ks) if (32 * ks <= 16 * w + 15) {
                float v[8]; const f32x4 a0 = *(const LAS f32x4*)(sAc + 32 * ks + 8 * q4), a1 = *(const LAS f32x4*)(sAc + 32 * ks + 8 * q4 + 4);
#pragma unroll
                for (int j = 0; j < 4; ++j) { const int s0 = 32 * ks + 8 * q4 + 2 * j; const float as0 = (2 * j < 4) ? a0[(2 * j) & 3] : a1[(2 * j) & 3], as1 = (2 * j + 1 < 4) ? a0[(2 * j + 1) & 3] : a1[(2 * j + 1) & 3];
                    v[2 * j] = (s0 <= lrow) ? bflo(fCB[ks][j]) * __expf(ac_l - as0) : 0.f; v[2 * j + 1] = (s0 + 1 <= lrow) ? bfhi(fCB[ks][j]) * __expf(ac_l - as1) : 0.f; }
                const bf16x8 yf = pack8(v);
#pragma unroll
                for (int pt = 0; pt < 4; ++pt) accD[pt] = mfma16(lds_frag(sXT, 16 * pt, PS, 32 * ks, lane), yf, accD[pt]); }
            SSD_LDF(cn, fCB, CBg);
            {   const float ea = __expf(ac_l), rdtl = Dsk / sDt[lrow];
#pragma unroll
                for (int pt = 0; pt < 4; ++pt) { f32x4 y = accO[pt] * ea + accD[pt];
#pragma unroll
                    for (int ii = 0; ii < 4; ++ii) y[ii] += rdtl * bf2f(sXT[(16 * pt + 4 * q4 + ii) * PS + lrow]);
                    *(GAS unsigned long long*)(YMIX + ((size_t)b * SEQ + c * 128 + lrow) * DMIX + head * 64 + 16 * pt + 4 * q4) = pack4(y); } }
            {   const float cd = __expf(sAc[127]);
#pragma unroll
                for (int pt = 0; pt < 4; ++pt) accS[pt] = accS[pt] * cd;
#pragma unroll
                for (int ks = 0; ks < 4; ++ks) { float v[8]; const f32x4 t0 = *(const LAS f32x4*)(sTe + 32 * ks + 8 * q4), t1 = *(const LAS f32x4*)(sTe + 32 * ks + 8 * q4 + 4);
#pragma unroll
                    for (int j = 0; j < 4; ++j) { const float ts0 = (2 * j < 4) ? t0[(2 * j) & 3] : t1[(2 * j) & 3], ts1 = (2 * j + 1 < 4) ? t0[(2 * j + 1) & 3] : t1[(2 * j + 1) & 3];
                        v[2 * j] = bflo(fBT[ks][j]) * ts0; v[2 * j + 1] = bfhi(fBT[ks][j]) * ts1; }
                    const bf16x8 xf = pack8(v);
#pragma unroll
                    for (int pt = 0; pt < 4; ++pt) accS[pt] = mfma16(xf, lds_frag(sXT, 16 * pt, PS, 32 * ks, lane), accS[pt]); }
#pragma unroll
                for (int pt = 0; pt < 4; ++pt) *(LAS unsigned long long*)(sSn + (16 * pt + r) * PS + 16 * w + 4 * q4) = pack4(accS[pt]);
            }
            SSD_LDF(cn, fBT, BTg);
            if (c + 1 < 32) SSD_STORE(cur ^ 1);
            WG_BAR();
        }
#undef SSD_LDF
#undef SSD_LOADX
#undef SSD_STORE
    }
}

__device__ __forceinline__ void gdn_prep_phase(CArgs a, int l, LAS unsigned char* lds, int wg, int G, int tid) {
    asm volatile("" : "+v"(tid));
    constexpr int PS = 136, TS = 72, MS = 68, TT = 65;
    LAS bf16* sKb = (LAS bf16*)lds; LAS bf16* sQb = sKb + 64 * PS; LAS bf16* sQG = sQb + 64 * PS; LAS bf16* sVT = sQG + 64 * PS;
    LAS float* sM = (LAS float*)(lds + 3 * 17408 + 18432); LAS float* sT = sM + 64 * MS; LAS float* sVec = sT + 64 * TT;
    const bf16* PROJ = (const bf16*)(a->ws + WS_PROJ);
    const float* cw = a->in[I_GCW] + (size_t)l * 4 * 1536;
    const int lane = tid & 63, w = tid >> 6, r = lane & 15, q4 = lane >> 4;
    for (int unit = wg; unit < 1024; unit += G) {
        const int b = unit >> 8, head = (unit >> 6) & 3, n = unit & 63;
        const size_t row0 = (size_t)b * SEQ + n * 64;
        bf16* GK = (bf16*)(a->ws + WS_GD_K) + (size_t)unit * 8192; bf16* GKT = (bf16*)(a->ws + WS_GD_KT) + (size_t)unit * 8192; bf16* GQG = (bf16*)(a->ws + WS_GD_QG) + (size_t)unit * 8192;
        bf16* GVT = (bf16*)(a->ws + WS_GD_VT) + (size_t)unit * 8192; bf16* GT = (bf16*)(a->ws + WS_GD_T) + (size_t)unit * 4096; bf16* GQK = (bf16*)(a->ws + WS_GD_QK) + (size_t)unit * 4096;
        float* GVEC = (float*)(a->ws + WS_GD_VEC) + (size_t)unit * 256;
        __syncthreads();
        for (int i = tid; i < 64 * MS; i += NTHR) sM[i] = 0.f;
        if (w == 0) {
            const float nA = -__expf(a->in[I_GALOG][l * 4 + head]), dtb = a->in[I_GDTB][l * 4 + head];
            const size_t ro = (row0 + lane) * NPROJ;
            const float be = sigmoidf_(bf2f(PROJ[ro + O_GB + head])); float gsum = nA * softplusf_(bf2f(PROJ[ro + O_GA + head]) + dtb);
#pragma unroll
            for (int o = 1; o < 64; o <<= 1) { const float t_ = __shfl_up(gsum, o); if (lane >= o) gsum += t_; }
            const float glast = __shfl(gsum, 63), eg = __expf(gsum), cc = __expf(glast - gsum);
            sVec[lane] = gsum; sVec[64 + lane] = be; sVec[128 + lane] = eg;
            GVEC[lane] = be; GVEC[64 + lane] = eg; GVEC[128 + lane] = cc; GVEC[192 + lane] = __expf(glast);
        }
        __syncthreads();
        {
            float wq[4][2], wk_[4][2], wv[4][2];
#pragma unroll
            for (int k = 0; k < 4; ++k)
#pragma unroll
                for (int j = 0; j < 2; ++j) { wq[k][j] = cw[k * 1536 + head * 128 + 2 * lane + j]; wk_[k][j] = cw[k * 1536 + 512 + head * 128 + 2 * lane + j]; wv[k][j] = cw[k * 1536 + 1024 + head * 128 + 2 * lane + j]; }
#pragma unroll 2
            for (int i = 0; i < 8; ++i) { const int t = w + 8 * i; float q0 = 0.f, q1 = 0.f, k0 = 0.f, k1 = 0.f, v0 = 0.f, v1 = 0.f;
#pragma unroll
                for (int k = 0; k < 4; ++k) { const int ts = n * 64 + t - 3 + k;
                    if (ts >= 0) { const bf16* pr = PROJ + ((size_t)b * SEQ + ts) * NPROJ + O_QKV + head * 128 + 2 * lane;
                        const unsigned xq = *(const GAS unsigned*)pr, xk = *(const GAS unsigned*)(pr + 512), xv = *(const GAS unsigned*)(pr + 1024);
                        q0 += wq[k][0] * bflo(xq); q1 += wq[k][1] * bfhi(xq); k0 += wk_[k][0] * bflo(xk); k1 += wk_[k][1] * bfhi(xk); v0 += wv[k][0] * bflo(xv); v1 += wv[k][1] * bfhi(xv); } }
                q0 = siluf(q0); q1 = siluf(q1); k0 = siluf(k0); k1 = siluf(k1); v0 = siluf(v0); v1 = siluf(v1);
                const float sq = rsqrtf(wave_sum(q0 * q0 + q1 * q1) + 1e-6f) * 0.08838834764831845f, sk = rsqrtf(wave_sum(k0 * k0 + k1 * k1) + 1e-6f), eg = sVec[128 + t];
                *(LAS unsigned*)(sKb + t * PS + 2 * lane) = pk2(k0 * sk, k1 * sk); *(LAS unsigned*)(sQb + t * PS + 2 * lane) = pk2(q0 * sq, q1 * sq);
                *(LAS unsigned*)(sQG + t * PS + 2 * lane) = pk2(q0 * sq * eg, q1 * sq * eg);
                sVT[(2 * lane) * TS + t] = (bf16)f2bf(v0); sVT[(2 * lane + 1) * TS + t] = (bf16)f2bf(v1); }
        }
        __syncthreads();
        for (int p = w; p < 26; p += NWAVES) {
            int it, jt; bool isq;
            if (p < 10) { isq = false; it = p < 1 ? 0 : (p < 3 ? 1 : (p < 6 ? 2 : 3)); jt = p - (it * (it + 1)) / 2; } else { isq = true; it = (p - 10) >> 2; jt = (p - 10) & 3; }
            f32x4 acc = {0.f, 0.f, 0.f, 0.f};
            if (jt <= it) {
#pragma unroll
                for (int ks = 0; ks < 4; ++ks) acc = mfma16(lds_frag(sKb, 16 * jt, PS, 32 * ks, lane), lds_frag(isq ? sQb : sKb, 16 * it, PS, 32 * ks, lane), acc);
                const int i = 16 * it + r; const float gi = sVec[i], bi = sVec[64 + i];
#pragma unroll
                for (int ii = 0; ii < 4; ++ii) { const int j = 16 * jt + 4 * q4 + ii; const float dec = __expf(gi - sVec[j]);
                    acc[ii] = isq ? (j <= i ? acc[ii] * dec : 0.f) : (j < i ? acc[ii] * dec * bi : 0.f); }
            }
            if (isq) *(GAS unsigned long long*)(GQK + (16 * it + r) * 64 + 16 * jt + 4 * q4) = pack4(acc);
            else *(LAS f32x4*)(sM + (16 * it + r) * MS + 16 * jt + 4 * q4) = acc;
        }
        __syncthreads();
        if (w == 0) {
            int zo = 0; asm volatile("" : "+v"(zo)); const LAS float* sMv = sM + zo;
            float U[64];
#pragma unroll
            for (int i = 0; i < 64; ++i) { float a0 = -sMv[i * MS + lane], a1 = 0.f, a2 = 0.f, a3 = 0.f;
#pragma unroll
                for (int j4 = 0; j4 < (i + 3) / 4; ++j4) { const f32x4 m = *(const LAS f32x4*)(sMv + i * MS + 4 * j4);
                    if (4 * j4 + 0 < i) a0 -= m[0] * U[4 * j4 + 0]; if (4 * j4 + 1 < i) a1 -= m[1] * U[4 * j4 + 1]; if (4 * j4 + 2 < i) a2 -= m[2] * U[4 * j4 + 2]; if (4 * j4 + 3 < i) a3 -= m[3] * U[4 * j4 + 3]; }
                U[i] = (a0 + a1) + (a2 + a3); sT[i * TT + lane] = U[i]; }
        } else {
            const int t7 = tid - 64;
            for (int p = t7; p < 1024; p += NTHR - 64) { const int t = p >> 4, d8 = (p & 15) * 8; *(GAS v4u*)(GK + t * 128 + d8) = *(const LAS v4u*)(sKb + t * PS + d8); *(GAS v4u*)(GQG + t * 128 + d8) = *(const LAS v4u*)(sQG + t * PS + d8); }
            for (int p = t7; p < 1024; p += NTHR - 64) { const int d = p >> 3, s8 = (p & 7) * 8; v4u o;
#pragma unroll
                for (int j = 0; j < 4; ++j) o[j] = (unsigned)sKb[(s8 + 2 * j) * PS + d] | ((unsigned)sKb[(s8 + 2 * j + 1) * PS + d] << 16);
                *(GAS v4u*)(GKT + d * 64 + s8) = o; *(GAS v4u*)(GVT + d * 64 + s8) = *(const LAS v4u*)(sVT + d * TS + s8); }
        }
        __syncthreads();
        { const int t = tid >> 3, s8 = (tid & 7) * 8; float v[8];
#pragma unroll
            for (int jj = 0; jj < 8; ++jj) v[jj] = sT[t * TT + s8 + jj] + ((s8 + jj == t) ? 1.f : 0.f);
            *(GAS bf16x8*)(GT + t * 64 + s8) = pack8(v); }
    }
}
__device__ __forceinline__ void gdn_scan_phase(CArgs a, int l, LAS unsigned char* lds, const int b, const int head, const int eb, int tid) {
    asm volatile("" : "+v"(tid));
    constexpr int PS = 136, TS = 72, O_ST = 0, O_RT = 34816, O_VN = O_RT + 9216, O_VC = O_VN + 9216;
    bf16* YMIX = (bf16*)(a->ws + WS_YMIX);
    const int lane = tid & 63, w = tid >> 6, r = lane & 15, q4 = lane >> 4, st = w >> 1, eh = w & 1;
    LAS bf16* sRT = (LAS bf16*)(lds + O_RT); LAS bf16* sVN = (LAS bf16*)(lds + O_VN); LAS bf16* sVC = (LAS bf16*)(lds + O_VC);
    {
        const size_t u0 = (size_t)(b * 4 + head) * 64;
        const bf16* pK = (const bf16*)(a->ws + WS_GD_K) + u0 * 8192 + (16 * st + r) * 128 + 8 * q4; const bf16* pQG = (const bf16*)(a->ws + WS_GD_QG) + u0 * 8192 + (16 * st + r) * 128 + 8 * q4;
        const bf16* pT = (const bf16*)(a->ws + WS_GD_T) + u0 * 4096 + (16 * st + r) * 64 + 8 * q4; const bf16* pQK = (const bf16*)(a->ws + WS_GD_QK) + u0 * 4096 + (16 * st + r) * 64 + 8 * q4;
        const bf16* pKT = (const bf16*)(a->ws + WS_GD_KT) + u0 * 8192 + (16 * w + r) * 64 + 8 * q4;
        const bf16* pVT = (const bf16*)(a->ws + WS_GD_VT) + u0 * 8192 + (size_t)(eb * 64 + 32 * eh + r) * 64 + 16 * st + 4 * q4;
        const float* pVec = (const float*)(a->ws + WS_GD_VEC) + u0 * 256 + 16 * st + 4 * q4;
        v4u xK[4], xT[2], yQG[4], yQK[2], xKT[2]; unsigned long long vT[2]; f32x4 be4, eg4, c4; float gl;
#define GD_LD_A(nn) do { _Pragma("unroll") for (int ks = 0; ks < 4; ++ks) xK[ks] = *(const GAS v4u*)(pK + (size_t)(nn) * 8192 + 32 * ks); \
            _Pragma("unroll") for (int j = 0; j < 2; ++j) vT[j] = *(const GAS unsigned long long*)(pVT + (size_t)(nn) * 8192 + j * 16 * 64); \
            be4 = *(const GAS f32x4*)(pVec + (size_t)(nn) * 256); eg4 = *(const GAS f32x4*)(pVec + (size_t)(nn) * 256 + 64); } while (0)
#define GD_LD_B(nn) do { _Pragma("unroll") for (int ks = 0; ks < 2; ++ks) xT[ks] = *(const GAS v4u*)(pT + (size_t)(nn) * 4096 + 32 * ks); c4 = *(const GAS f32x4*)(pVec + (size_t)(nn) * 256 + 128); } while (0)
#define GD_LD_C(nn) do { _Pragma("unroll") for (int ks = 0; ks < 4; ++ks) yQG[ks] = *(const GAS v4u*)(pQG + (size_t)(nn) * 8192 + 32 * ks); \
            _Pragma("unroll") for (int ks = 0; ks < 2; ++ks) yQK[ks] = *(const GAS v4u*)(pQK + (size_t)(nn) * 4096 + 32 * ks); } while (0)
#define GD_LD_D(nn) do { _Pragma("unroll") for (int ks = 0; ks < 2; ++ks) xKT[ks] = *(const GAS v4u*)(pKT + (size_t)(nn) * 8192 + 32 * ks); gl = pVec[(size_t)(nn) * 256 + 192 - (16 * st + 4 * q4)]; } while (0)
        __syncthreads();
        GD_LD_A(0); GD_LD_B(0); GD_LD_C(0); GD_LD_D(0);
        for (int i = tid; i < 17408 / 4; i += NTHR) ((LAS unsigned*)(lds + O_ST))[i] = 0u;
        f32x4 accS[4];
#pragma unroll
        for (int et = 0; et < 4; ++et) accS[et] = (f32x4){0.f, 0.f, 0.f, 0.f};
        __syncthreads();
        for (int n = 0; n < 64; ++n) {
            const int cur = n & 1; const LAS bf16* sST = (const LAS bf16*)(lds + O_ST + cur * 17408); LAS bf16* sSTn = (LAS bf16*)(lds + O_ST + (cur ^ 1) * 17408);
            const int nn = n + 1 < 64 ? n + 1 : n;
#pragma unroll
            for (int j = 0; j < 2; ++j) {
                const int e0 = 16 * (2 * eh + j); f32x4 acc = {0.f, 0.f, 0.f, 0.f};
#pragma unroll
                for (int ks = 0; ks < 4; ++ks) acc = mfma16(__builtin_bit_cast(bf16x8, xK[ks]), lds_frag(sST, e0, PS, 32 * ks, lane), acc);
                const unsigned vlo = (unsigned)vT[j], vhi = (unsigned)(vT[j] >> 32); f32x4 rr;
                rr[0] = be4[0] * (bflo(vlo) - eg4[0] * acc[0]); rr[1] = be4[1] * (bfhi(vlo) - eg4[1] * acc[1]); rr[2] = be4[2] * (bflo(vhi) - eg4[2] * acc[2]); rr[3] = be4[3] * (bfhi(vhi) - eg4[3] * acc[3]);
                *(LAS unsigned long long*)(sRT + (e0 + r) * TS + 16 * st + 4 * q4) = pack4(rr); }
            GD_LD_A(nn);
            WG_BAR();
#pragma unroll
            for (int j = 0; j < 2; ++j) {
                const int e0 = 16 * (2 * eh + j); f32x4 acc = {0.f, 0.f, 0.f, 0.f};
#pragma unroll
                for (int ks = 0; ks < 2; ++ks) acc = mfma16(__builtin_bit_cast(bf16x8, xT[ks]), lds_frag(sRT, e0, TS, 32 * ks, lane), acc);
                *(LAS unsigned long long*)(sVN + (e0 + r) * TS + 16 * st + 4 * q4) = pack4(acc); *(LAS unsigned long long*)(sVC + (e0 + r) * TS + 16 * st + 4 * q4) = pack4(acc * c4); }
            GD_LD_B(nn);
            WG_BAR();
#pragma unroll
            for (int j = 0; j < 2; ++j) {
                const int e0 = 16 * (2 * eh + j); f32x4 acc = {0.f, 0.f, 0.f, 0.f};
#pragma unroll
                for (int ks = 0; ks < 4; ++ks) acc = mfma16(lds_frag(sST, e0, PS, 32 * ks, lane), __builtin_bit_cast(bf16x8, yQG[ks]), acc);
#pragma unroll
                for (int ks = 0; ks < 2; ++ks) acc = mfma16(lds_frag(sVN, e0, TS, 32 * ks, lane), __builtin_bit_cast(bf16x8, yQK[ks]), acc);
                *(GAS unsigned long long*)(YMIX + ((size_t)b * SEQ + n * 64 + 16 * st + r) * DMIX + 1024 + head * 128 + eb * 64 + e0 + 4 * q4) = pack4(acc); }
            GD_LD_C(nn);
#pragma unroll
            for (int et = 0; et < 4; ++et) {
                accS[et] = accS[et] * gl;
#pragma unroll
                for (int ks = 0; ks < 2; ++ks) accS[et] = mfma16(__builtin_bit_cast(bf16x8, xKT[ks]), lds_frag(sVC, 16 * et, TS, 32 * ks, lane), accS[et]);
                *(LAS unsigned long long*)(sSTn + (16 * et + r) * PS + 16 * w + 4 * q4) = pack4(accS[et]); }
            GD_LD_D(nn);
            WG_BAR();
        }
#undef GD_LD_A
#undef GD_LD_B
#undef GD_LD_C
#undef GD_LD_D
    }
}

__device__ __forceinline__ void gdn_rec_phase(CArgs a, int l, LAS unsigned char* lds, int wg, int G, int tid) {
    asm volatile("" : "+v"(tid));
    constexpr int TB = 32;
    LAS float* sQ = (LAS float*)lds; LAS float* sK = sQ + TB * 128; LAS float* sV = sK + TB * 128; LAS float* sBe = sV + TB * 8; LAS float* sAl = sBe + TB; LAS float* sO = sAl + TB;
    const bf16* PROJ = (const bf16*)(a->ws + WS_PROJ); bf16* YMIX = (bf16*)(a->ws + WS_YMIX);
    const float* cw = a->in[I_GCW] + (size_t)l * 4 * 1536;
    const int lane = tid & 63, w = tid >> 6;
    for (int unit = wg; unit < 256; unit += G) {
        const int b = unit >> 6, head = (unit >> 4) & 3, eb = unit & 15;
        const float nA = -__expf(a->in[I_GALOG][l * 4 + head]), dtb = a->in[I_GDTB][l * 4 + head];
        float S0 = 0.f, S1 = 0.f;
        for (int t0 = 0; t0 < SEQ; t0 += TB) {
            __syncthreads();
            for (int idx = tid; idx < TB * 264; idx += NTHR) {
                const int tt = idx / 264, ci = idx % 264, t = t0 + tt;
                const int ch = ci < 128 ? head * 128 + ci : (ci < 256 ? 512 + head * 128 + (ci - 128) : 1024 + head * 128 + eb * 8 + (ci - 256));
                float acc = 0.f;
#pragma unroll
                for (int k = 0; k < 4; ++k) { const int ts = t - 3 + k; if (ts >= 0) acc += cw[k * 1536 + ch] * bf2f(PROJ[(size_t)(b * SEQ + ts) * NPROJ + O_QKV + ch]); }
                const float v = siluf(acc);
                if (ci < 128) sQ[tt * 128 + ci] = v; else if (ci < 256) sK[tt * 128 + ci - 128] = v; else sV[tt * 8 + ci - 256] = v;
            }
            if (tid < TB) { const size_t ro = (size_t)(b * SEQ + t0 + tid) * NPROJ; const float braw = bf2f(PROJ[ro + O_GB + head]), araw = bf2f(PROJ[ro + O_GA + head]);
                sBe[tid] = sigmoidf_(braw); sAl[tid] = __expf(nA * softplusf_(araw + dtb)); }
            __syncthreads();
            for (int tt = w; tt < TB; tt += NWAVES) {
                const float q0 = sQ[tt * 128 + lane], q1 = sQ[tt * 128 + 64 + lane], k0 = sK[tt * 128 + lane], k1 = sK[tt * 128 + 64 + lane];
                const float sq = rsqrtf(wave_sum(q0 * q0 + q1 * q1) + 1e-6f) * 0.08838834764831845f, sk = rsqrtf(wave_sum(k0 * k0 + k1 * k1) + 1e-6f);
                sQ[tt * 128 + lane] = q0 * sq; sQ[tt * 128 + 64 + lane] = q1 * sq; sK[tt * 128 + lane] = k0 * sk; sK[tt * 128 + 64 + lane] = k1 * sk;
            }
            __syncthreads();
#pragma unroll 2
            for (int tt = 0; tt < TB; ++tt) {
                const float k0 = sK[tt * 128 + lane], k1 = sK[tt * 128 + 64 + lane], q0 = sQ[tt * 128 + lane], q1 = sQ[tt * 128 + 64 + lane];
                const float al = sAl[tt], be = sBe[tt], v = sV[tt * 8 + w];
                const float dot = wave_sum(k0 * S0 + k1 * S1);
                const float vn = be * (v - al * dot);
                S0 = al * S0 + k0 * vn; S1 = al * S1 + k1 * vn;
                const float od = wave_sum(q0 * S0 + q1 * S1);
                if (lane == 0) sO[tt * 8 + w] = od;
            }
            __syncthreads();
            if (tid < TB * 8) { const int tt = tid >> 3, i = tid & 7; YMIX[(size_t)(b * SEQ + t0 + tt) * DMIX + 1024 + head * 128 + eb * 8 + i] = (bf16)f2bf(sO[tid]); }
        }
    }
}

__device__ __forceinline__ void hgrn_rec_phase(CArgs a, int l, LAS unsigned char* lds, int wg, int G, int tid) {
    asm volatile("" : "+v"(tid));
    constexpr int TB = 32;
    LAS float* sQ = (LAS float*)lds; LAS float* sF = sQ + TB * 128; LAS float* sV = sF + TB * 128; LAS float* sO = sV + TB * 8; LAS float* sLb = sO + TB * 8;
    const bf16* PROJ = (const bf16*)(a->ws + WS_PROJ); bf16* YMIX = (bf16*)(a->ws + WS_YMIX);
    const int lane = tid & 63, w = tid >> 6;
    for (int unit = wg; unit < 256; unit += G) {
        const int b = unit >> 6, head = (unit >> 4) & 3, eb = unit & 15;
        __syncthreads();
        if (tid < 128) {
            const int c = head * 128 + tid; float lg[DEPTH], mx = -1e30f;
#pragma unroll
            for (int j = 0; j < DEPTH; ++j) { lg[j] = a->in[I_HLB][j * 512 + c]; mx = fmaxf(mx, lg[j]); }
            float den = 0.f, num = 0.f;
#pragma unroll
            for (int j = 0; j < DEPTH; ++j) { const float e = __expf(lg[j] - mx); den += e; if (j >= 1 && j <= l) num += e; }
            sLb[tid] = num / den;
        }
        float S0 = 0.f, S1 = 0.f;
        for (int t0 = 0; t0 < SEQ; t0 += TB) {
            __syncthreads();
            for (int idx = tid; idx < TB * 264; idx += NTHR) {
                const int tt = idx / 264, ci = idx % 264; const size_t ro = (size_t)(b * SEQ + t0 + tt) * NPROJ;
                if (ci < 128) sQ[tt * 128 + ci] = siluf(bf2f(PROJ[ro + O_HQ + head * 128 + ci]));
                else if (ci < 256) { const int d = ci - 128; const float lb = sLb[d]; sF[tt * 128 + d] = lb + (1.f - lb) * sigmoidf_(bf2f(PROJ[ro + O_HF + head * 128 + d])); }
                else sV[tt * 8 + ci - 256] = bf2f(PROJ[ro + O_HI + head * 128 + eb * 8 + (ci - 256)]);
            }
            __syncthreads();
#pragma unroll 2
            for (int tt = 0; tt < TB; ++tt) {
                const float f0 = sF[tt * 128 + lane], f1 = sF[tt * 128 + 64 + lane], q0 = sQ[tt * 128 + lane], q1 = sQ[tt * 128 + 64 + lane], v = sV[tt * 8 + w];
                S0 = f0 * S0 + (1.f - f0) * v; S1 = f1 * S1 + (1.f - f1) * v;
                const float od = wave_sum(q0 * S0 + q1 * S1);
                if (lane == 0) sO[tt * 8 + w] = od;
            }
            __syncthreads();
            if (tid < TB * 8) { const int tt = tid >> 3, i = tid & 7; YMIX[(size_t)(b * SEQ + t0 + tt) * DMIX + 1536 + head * 128 + eb * 8 + i] = (bf16)f2bf(sO[tid]); }
        }
    }
}

__device__ __forceinline__ void mix_post_phase(CArgs a, int l, int wg, int G, int tid) {
    asm volatile("" : "+v"(tid));
    const bf16* PROJ = (const bf16*)(a->ws + WS_PROJ); bf16* YMIX = (bf16*)(a->ws + WS_YMIX);
    const int lane = tid & 63, gw = wg * NWAVES + (tid >> 6), NGW = G * NWAVES;
    const float* snw = a->in[I_SNW] + l * 1024; const float* gnw = a->in[I_GNW] + l * 128; const float* hnw = a->in[I_HNW] + l * 128;
    for (int row = gw; row < M; row += NGW) {
        const bf16* pr = PROJ + (size_t)row * NPROJ; bf16* yr = YMIX + (size_t)row * DMIX;
#pragma unroll
        for (int j = 0; j < 2; ++j) {
            const int ch = j * 512 + lane * 8; const v4u yv = *(const GAS v4u*)(yr + ch), zv = *(const GAS v4u*)(pr + O_Z + ch);
            float v[8]; float ss = 0.f;
#pragma unroll
            for (int i = 0; i < 4; ++i) { v[2 * i] = bflo(yv[i]) * siluf(bflo(zv[i])); v[2 * i + 1] = bfhi(yv[i]) * siluf(bfhi(zv[i])); ss += v[2 * i] * v[2 * i] + v[2 * i + 1] * v[2 * i + 1]; }
            const float rstd = rsqrtf(wave_sum(ss) * (1.f / 512.f) + 1e-6f);
            v4u o;
#pragma unroll
            for (int i = 0; i < 4; ++i) o[i] = pk2(v[2 * i] * rstd * snw[ch + 2 * i], v[2 * i + 1] * rstd * snw[ch + 2 * i + 1]);
            *(GAS v4u*)(yr + ch) = o;
        }
#pragma unroll
        for (int part = 0; part < 2; ++part) {
            const int ch = lane * 8, yo = 1024 + part * 512 + ch, go = (part == 0 ? O_GG : O_HG) + ch; const float* nw = part == 0 ? gnw : hnw;
            const v4u yv = *(const GAS v4u*)(yr + yo), gv = *(const GAS v4u*)(pr + go);
            float v[8]; float ss = 0.f;
#pragma unroll
            for (int i = 0; i < 4; ++i) { v[2 * i] = bflo(yv[i]); v[2 * i + 1] = bfhi(yv[i]); ss += v[2 * i] * v[2 * i] + v[2 * i + 1] * v[2 * i + 1]; }
            ss += __shfl_xor(ss, 1); ss += __shfl_xor(ss, 2); ss += __shfl_xor(ss, 4); ss += __shfl_xor(ss, 8);
            const float rstd = rsqrtf(ss * (1.f / 128.f) + 1e-6f);
            v4u o;
#pragma unroll
            for (int i = 0; i < 4; ++i) { const int c = (ch & 127) + 2 * i; o[i] = pk2(v[2 * i] * rstd * nw[c] * siluf(bflo(gv[i])), v[2 * i + 1] * rstd * nw[c + 1] * siluf(bfhi(gv[i]))); }
            *(GAS v4u*)(yr + yo) = o;
        }
    }
}

__device__ __forceinline__ void moe_tables(const gu32* cnt, LAS unsigned char* lds, int tid) {
    LAS int* tab = (LAS int*)(lds + LDS_OFF_TAB);
    __syncthreads();
    if (tid == 0) { int p = 0, q = 0;
        for (int e = 0; e < 16; ++e) { const int c = (int)__hip_atomic_load(cnt + e, RLX_AGENT); tab[e] = p; tab[17 + e] = q; p += (c + 255) & ~255; q += c; }
        tab[16] = p; tab[33] = q; }
    __syncthreads();
}
template <bool ROUTER>
__device__ __forceinline__ void ln_phase(CArgs a, int l, const float* gam, const float* bet, LAS unsigned char* lds, int wg, int G, int tid) {
    asm volatile("" : "+v"(tid));
    const int lane = tid & 63, wave = tid >> 6, gw = wg * NWAVES + wave, NGW = G * NWAVES;
    const float* ADD = (const float*)(a->ws + WS_MIX); float* H = a->out; bf16* HB = (bf16*)(a->ws + WS_HB);
    gu32* cnt = (gu32*)(a->ws + WS_CTL) + CW_CNT + l * 16;
    LAS float* sW = (LAS float*)lds;
    LAS float* sL = sW + 20 * D + wave * 32;
    LAS int* sCnt = (LAS int*)(sW + 20 * D + 256);
    LAS unsigned* sEnt = (LAS unsigned*)(sCnt + 32);
    constexpr int MAXENT = 2 * NWAVES * 8;
    if (ROUTER) {
        __syncthreads();
        const float* wrg = a->in[I_WRG] + (size_t)l * D * 4; const float* wre = a->in[I_WRE] + (size_t)l * D * 16;
        for (int i = tid; i < D * 20; i += NTHR) { const int c = i >> 10, k = i & 1023; sW[i] = c < 4 ? wrg[k * 4 + c] : wre[k * 16 + c - 4]; }
        if (tid < 32) sCnt[tid] = 0;
        __syncthreads();
    } else moe_tables(cnt, lds, tid);
    const LAS int* tab = (const LAS int*)(lds + LDS_OFF_TAB);
    f32x4 gv[4], bv[4];
#pragma unroll
    for (int j = 0; j < 4; ++j) { gv[j] = *(const f32x4*)(gam + 4 * lane + 256 * j); bv[j] = *(const f32x4*)(bet + 4 * lane + 256 * j); }
    int kk = 0;
    for (int row = gw; row < M; row += NGW, ++kk) {
        f32x4 v[4]; float s = 0.f;
        if (ROUTER) {
#pragma unroll
            for (int j = 0; j < 4; ++j) { const f32x4 hv = *(const GAS f32x4*)(H + (size_t)row * D + 4 * lane + 256 * j), av = *(const GAS f32x4*)(ADD + (size_t)row * D + 4 * lane + 256 * j);
                v[j] = hv * DN_ALPHA + av; s += (v[j].x + v[j].y) + (v[j].z + v[j].w); }
        } else {
            const unsigned s0 = ((const GAS unsigned*)(a->ws + WS_SLOT))[2 * row], s1 = ((const GAS unsigned*)(a->ws + WS_SLOT))[2 * row + 1];
            const bf16* y0 = (const bf16*)(a->ws + WS_YS) + (size_t)(tab[s0 >> 16] + (int)(s0 & 0xffffu)) * D; const bf16* y1 = (const bf16*)(a->ws + WS_YS) + (size_t)(tab[s1 >> 16] + (int)(s1 & 0xffffu)) * D;
#pragma unroll
            for (int j = 0; j < 4; ++j) { const f32x4 hv = *(const GAS f32x4*)(H + (size_t)row * D + 4 * lane + 256 * j);
                const unsigned long long p0 = *(const GAS unsigned long long*)(y0 + 4 * lane + 256 * j), p1 = *(const GAS unsigned long long*)(y1 + 4 * lane + 256 * j);
                f32x4 av; av.x = bflo((unsigned)p0) + bflo((unsigned)p1); av.y = bfhi((unsigned)p0) + bfhi((unsigned)p1); av.z = bflo((unsigned)(p0 >> 32)) + bflo((unsigned)(p1 >> 32)); av.w = bfhi((unsigned)(p0 >> 32)) + bfhi((unsigned)(p1 >> 32));
                v[j] = hv * DN_ALPHA + av; s += (v[j].x + v[j].y) + (v[j].z + v[j].w); }
        }
        const float mean = wave_sum(s) * (1.f / D); float s2 = 0.f;
#pragma unroll
        for (int j = 0; j < 4; ++j) { v[j] = v[j] - mean; s2 += (v[j].x * v[j].x + v[j].y * v[j].y) + (v[j].z * v[j].z + v[j].w * v[j].w); }
        const float rstd = rsqrtf(wave_sum(s2) * (1.f / D) + LN_EPS);
#pragma unroll
        for (int j = 0; j < 4; ++j) { v[j] = v[j] * rstd * gv[j] + bv[j];
            *(GAS f32x4*)(H + (size_t)row * D + 4 * lane + 256 * j) = v[j];
            *(GAS unsigned long long*)(HB + (size_t)row * D + 4 * lane + 256 * j) = (unsigned long long)pk2(v[j].x, v[j].y) | ((unsigned long long)pk2(v[j].z, v[j].w) << 32); }
        if (ROUTER) {
            float lg[20];
#pragma unroll 1
            for (int c = 0; c < 20; ++c) { float p = 0.f;
#pragma unroll
                for (int j = 0; j < 4; ++j) { const f32x4 wv = *(const LAS f32x4*)(sW + c * D + 4 * lane + 256 * j); p += (v[j].x * wv.x + v[j].y * wv.y) + (v[j].z * wv.z + v[j].w * wv.w); }
                p = wave_sum(p); if (lane == 0) sL[c] = p; }
#pragma unroll
            for (int c = 0; c < 20; ++c) lg[c] = sL[c];
            float pg[4], mx = -1e30f; int gi = 0;
#pragma unroll
            for (int c = 0; c < 4; ++c) { pg[c] = lg[c] + a->in[I_BRG][l * 4 + c]; if (pg[c] > mx) { mx = pg[c]; gi = c; } }
            float den = 0.f;
#pragma unroll
            for (int c = 0; c < 4; ++c) den += __expf(pg[c] - mx);
            const float g_p = 1.0f / den;
            float le[4], emx = -1e30f; int i1 = 0;
#pragma unroll
            for (int c = 0; c < 4; ++c) { float x = 0.f;
#pragma unroll
                for (int gg = 0; gg < 4; ++gg) x = (gi == gg) ? lg[4 + gg * 4 + c] + a->in[I_BRE][l * 16 + gg * 4 + c] : x;
                le[c] = x; if (x > emx) { emx = x; i1 = c; } }
            float e2mx = -1e30f; int i2 = 0;
#pragma unroll
            for (int c = 0; c < 4; ++c) if (c != i1 && le[c] > e2mx) { e2mx = le[c]; i2 = c; }
            const float x2 = __expf(e2mx - emx), w1 = g_p / (1.0f + x2), w2 = g_p * x2 / (1.0f + x2);
            if (lane < 2) {
                const int e = gi * 4 + (lane == 0 ? i1 : i2); const float wv = lane == 0 ? w1 : w2;
                if (kk < 8) { const int lp = __hip_atomic_fetch_add(sCnt + e, 1, __ATOMIC_RELAXED, __HIP_MEMORY_SCOPE_WORKGROUP); LAS unsigned* en = sEnt + ((wave * 8 + kk) * 2 + lane) * 4;
                    en[0] = (unsigned)row; en[1] = (unsigned)e; en[2] = (unsigned)lp; en[3] = __builtin_bit_cast(unsigned, wv); }
                else { const int pos = (int)__hip_atomic_fetch_add(cnt + e, 1u, RLX_AGENT);
                    ((GAS int*)(a->ws + WS_LTOK))[e * M + pos] = row; ((GAS float*)(a->ws + WS_LW))[e * M + pos] = wv; ((GAS unsigned*)(a->ws + WS_SLOT))[2 * row + lane] = ((unsigned)e << 16) | (unsigned)pos; }
            }
        }
    }
    if (ROUTER) {
        __syncthreads();
        if (tid < 16) sCnt[16 + tid] = (int)__hip_atomic_fetch_add(cnt + tid, (unsigned)sCnt[tid], RLX_AGENT);
        __syncthreads();
        const int nk = kk < 8 ? kk : 8;
        if (tid < MAXENT) { const int wv_ = tid >> 4, k_ = (tid >> 1) & 7;
            const int rows_w = (M - (wg * NWAVES + wv_) + NGW - 1) / NGW; const int nkw = rows_w < 8 ? rows_w : 8;
            if (k_ < nkw) { const LAS unsigned* en = sEnt + tid * 4; const int e = (int)en[1], pos = sCnt[16 + e] + (int)en[2];
                ((GAS int*)(a->ws + WS_LTOK))[e * M + pos] = (int)en[0]; ((GAS unsigned*)(a->ws + WS_LW))[e * M + pos] = en[3]; ((GAS unsigned*)(a->ws + WS_SLOT))[2 * en[0] + (tid & 1)] = ((unsigned)e << 16) | (unsigned)pos; } }
        (void)nk;
    }
}
__device__ __forceinline__ void moe_gather_phase(CArgs a, int l, LAS unsigned char* lds, int wg, int G, int tid) {
    asm volatile("" : "+v"(tid));
    const int lane = tid & 63, gw = wg * NWAVES + (tid >> 6), NGW = G * NWAVES;
    moe_tables((gu32*)(a->ws + WS_CTL) + CW_CNT + l * 16, lds, tid);
    const LAS int* tab = (const LAS int*)(lds + LDS_OFF_TAB);
    const bf16* HB = (const bf16*)(a->ws + WS_HB); bf16* XS = (bf16*)(a->ws + WS_XS);
    for (int idx = gw; idx < 2 * M; idx += NGW) {
        int e = 0;
#pragma unroll
        for (int k = 1; k < 16; ++k) e += (tab[17 + k] <= idx) ? 1 : 0;
        const int pos = idx - tab[17 + e], dst = tab[e] + pos;
        const int row = ((const GAS int*)(a->ws + WS_LTOK))[e * M + pos];
        const v4u x0 = *(const GAS v4u*)(HB + (size_t)row * D + 8 * lane), x1 = *(const GAS v4u*)(HB + (size_t)row * D + 512 + 8 * lane);
        *(GAS v4u*)(XS + (size_t)dst * D + 8 * lane) = x0; *(GAS v4u*)(XS + (size_t)dst * D + 512 + 8 * lane) = x1;
        if (lane == 0) ((GAS float*)(a->ws + WS_WSORT))[dst] = ((const GAS float*)(a->ws + WS_LW))[e * M + pos];
    }
}

enum { P_IN = 0, P_PREP, P_SCAN, P_POST, P_OUT, P_LN1, P_GATHER, P_GU, P_DN, P_LN2, NPH };
constexpr int N_PHASES = 1 + DEPTH * NPH;
__global__ void __launch_bounds__(NTHR, 2) fwd(Args args) {
    extern __shared__ __attribute__((aligned(16))) unsigned char lds_raw[];
    LAS unsigned char* lds = (LAS unsigned char*)lds_raw;
    volatile LAS unsigned* MISC = (volatile LAS unsigned*)(lds + MISC_OFF);
    const int tid = threadIdx.x, G = gridDim.x, bx = blockIdx.x;
    unsigned char* ws = args.ws;
    gu32* ctl = (gu32*)(ws + WS_CTL);
    for (int u = tid; u < (LDS_BYTES - LDSCTL_OFF) / 4; u += NTHR) ((LAS unsigned*)(lds + LDSCTL_OFF))[u] = 0u;
    __syncthreads();
    const int lo = args.ph_lo, hi = args.ph_hi;
    const bool use_bar = (hi - lo) > 1;
    XcdBarrier bar; bar.bar = (unsigned*)(ctl + CW_BAR); bar.x = 0; bar.st = nullptr;
    if (use_bar) bar = xcd_barrier_post((unsigned*)(ctl + CW_BAR), MISC + 8);
#define IN(k) (lo <= (k) && (k) < hi)
#define SEAM(k) do { if (IN(k) && IN((k) + 1)) xcd_barrier(bar); } while (0)

    if (IN(0)) { p0_prologue(ARGS_HERE(), lds, bx, G, tid); weights_phase(ARGS_HERE(), 0, 1, lds, bx * NWAVES + (tid >> 6), G * NWAVES, tid); SEAM(0); }

    for (int l = 0; l < DEPTH; ++l) {
        const int base = 1 + l * NPH;
        if (IN(base + P_IN)) {
            pg8::Gemm g{(const pg8::bf16_t*)(ws + WS_HB), (const pg8::bf16_t*)(ws + WS_WIN), M, NPROJ, D}; pg8::StaticOrder S; S.init(M, NPROJ, G, bx);
            pg8::EpiBf16<0> E{(pg8::bf16_t*)(ws + WS_PROJ), NPROJ, nullptr, 0, 0, 1.f};
            pg8::gemm_phase<pg8::EpiBf16<0>, pg8::StaticOrder, true, true>(lds + RING_OFF, g, S, E);
            SEAM(base + P_IN);
        }
        if (IN(base + P_PREP)) {
            hgrn_prep_phase(ARGS_HERE(), l, lds, bx, G, tid);
            ssd_prep_phase(ARGS_HERE(), l, lds, bx, G, tid);
            gdn_prep_phase(ARGS_HERE(), l, lds, bx, G, tid);
            SEAM(base + P_PREP); }
        if (IN(base + P_SCAN)) {
            if (G >= 192) {
                if (bx < 64) { const int pr = bx & 7, hh = bx >> 3; ssd_scan_phase(ARGS_HERE(), l, lds, pr >> 1, (pr & 1) * 8 + hh, tid); }
                else if (bx < 96) { const int x = (bx - 64) & 7, y = (bx - 64) >> 3, pr = x * 2 + (y >> 1); gdn_scan_phase(ARGS_HERE(), l, lds, pr >> 2, pr & 3, y & 1, tid); }
                else if (bx < 160) { const int x = (bx - 96) & 7, y = (bx - 96) >> 3, pr = x * 2 + (y >> 2); hgrn_scan_phase(ARGS_HERE(), l, lds, pr >> 2, pr & 3, y & 3, tid); }
                else { weights_phase(ARGS_HERE(), l, 14, lds, (bx - 160) * NWAVES + (tid >> 6), (G - 160) * NWAVES, tid);
                       if (l + 1 < DEPTH) weights_phase(ARGS_HERE(), l + 1, 1, lds, (bx - 160) * NWAVES + (tid >> 6), (G - 160) * NWAVES, tid); }
            }
            SEAM(base + P_SCAN); }
        if (IN(base + P_POST)) { mix_post_phase(ARGS_HERE(), l, bx, G, tid); SEAM(base + P_POST); }
        if (IN(base + P_OUT)) {
            pg8::Gemm g{(const pg8::bf16_t*)(ws + WS_YMIX), (const pg8::bf16_t*)(ws + WS_WOUT), M, D, DMIX}; pg8::StaticOrder S; S.init(M, D, G, bx);
            pg8::EpiF32 E{(float*)(ws + WS_MIX), D};
            pg8::gemm_phase<pg8::EpiF32, pg8::StaticOrder, true, true>(lds + RING_OFF, g, S, E);
            SEAM(base + P_OUT);
        }
        if (IN(base + P_LN1)) { CArgs a_ = ARGS_HERE(); ln_phase<true>(a_, l, a_->in[I_LN1G] + l * D, a_->in[I_LN1B] + l * D, lds, bx, G, tid); SEAM(base + P_LN1); }
        if (IN(base + P_GATHER)) { moe_gather_phase(ARGS_HERE(), l, lds, bx, G, tid); SEAM(base + P_GATHER); }
        if (IN(base + P_GU)) {
            moe_tables(ctl + CW_CNT + l * 16, lds, tid);
            pg8::Gemm g{(const pg8::bf16_t*)(ws + WS_XS), (const pg8::bf16_t*)(ws + WS_WGU), MAXROWS, NGU, D}; pg8::MoeOrder<2> S{(const LAS int*)(lds + LDS_OFF_TAB), G, bx};
            pg8::EpiSwiGLUs E{(pg8::bf16_t*)(ws + WS_HS), (const float*)(ws + WS_WSORT)};
            pg8::gemm_phase<pg8::EpiSwiGLUs, pg8::MoeOrder<2>, true, true>(lds + RING_OFF, g, S, E);
            SEAM(base + P_GU);
        }
        if (IN(base + P_DN)) {
            moe_tables(ctl + CW_CNT + l * 16, lds, tid);
            pg8::Gemm g{(const pg8::bf16_t*)(ws + WS_HS), (const pg8::bf16_t*)(ws + WS_WDN), MAXROWS, NEXP * D, DEXP}; pg8::MoeOrder<4> S{(const LAS int*)(lds + LDS_OFF_TAB), G, bx};
            pg8::EpiBf16s E{(pg8::bf16_t*)(ws + WS_YS)};
            pg8::gemm_phase<pg8::EpiBf16s, pg8::MoeOrder<4>, true, true>(lds + RING_OFF, g, S, E);
            SEAM(base + P_DN);
        }
        if (IN(base + P_LN2)) { CArgs a_ = ARGS_HERE(); ln_phase<false>(a_, l, a_->in[I_LN2G] + l * D, a_->in[I_LN2B] + l * D, lds, bx, G, tid); SEAM(base + P_LN2); }
    }
#undef IN
#undef SEAM
}

#ifndef MK_ONE_LAUNCH
#define MK_ONE_LAUNCH 1
#endif
extern "C" void kernel_launch(void* const* d_in, const int* in_sizes, int n_in, void* d_out, int out_size, void* d_ws, size_t ws_size, hipStream_t stream) {
    static int grid = 0;
    if (grid == 0) {
        if (n_in != 25 || out_size != M * D || ws_size < WS_END) { fprintf(stderr, "kernel_launch: unexpected shapes (n_in %d out %d ws %zu)\n", n_in, out_size, ws_size); grid = -1; return; }
        int dev = 0, cus = 0, per_cu = 0;
        if (hipGetDevice(&dev) != hipSuccess || hipDeviceGetAttribute(&cus, hipDeviceAttributeMultiprocessorCount, dev) != hipSuccess) { grid = -1; return; }
        if (hipFuncSetAttribute((const void*)fwd, hipFuncAttributeMaxDynamicSharedMemorySize, LDS_BYTES) != hipSuccess) { fprintf(stderr, "kernel_launch: hipFuncSetAttribute failed\n"); grid = -1; return; }
        if (hipOccupancyMaxActiveBlocksPerMultiprocessor(&per_cu, (const void*)fwd, NTHR, LDS_BYTES) != hipSuccess || per_cu < 1) { fprintf(stderr, "kernel_launch: occupancy query says %d\n", per_cu); (void)hipGetLastError(); grid = -1; return; }
        grid = cus;
    }
    if (grid < 0) return;
    if (hipMemsetAsync((char*)d_ws + WS_CTL, 0, CTL_ZERO_BYTES, stream) != hipSuccess) return;
    Args a{};
    for (int i = 0; i < 25; ++i) a.in[i] = (const float*)d_in[i];
    a.out = (float*)d_out; a.ws = (unsigned char*)d_ws;
#if MK_ONE_LAUNCH
    a.ph_lo = 0; a.ph_hi = N_PHASES;
    hipLaunchKernelGGL(fwd, dim3(grid), dim3(NTHR), LDS_BYTES, stream, a);
#else
    for (int p = 0; p < N_PHASES; ++p) { a.ph_lo = p; a.ph_hi = p + 1; hipLaunchKernelGGL(fwd, dim3(grid), dim3(NTHR), LDS_BYTES, stream, a); }
#endif
}
```

```cpp
#include <hip/hip_runtime.h>
#include <cstdio>
#include <cstdint>
namespace pg8 {
#define PG8_LAS __attribute__((address_space(3)))
typedef unsigned short bf16_t;
typedef short bf16x8 __attribute__((ext_vector_type(8)));
typedef float f32x4 __attribute__((ext_vector_type(4)));
typedef unsigned u32x4 __attribute__((ext_vector_type(4)));
constexpr int BM = 256, BK = 64, HALF = 128, HTB = HALF * BK * 2  , STAGE_BYTES = 8 * HTB, NXCD = 8, WGM = 8;

__host__ __device__ __forceinline__ int lds_byte(int r, int c) { const int st = (r >> 4) * 2 + (c >> 5), rr = r & 15, cc = c & 31, ob = rr * 64 + cc * 2; return st * 1024 + (ob ^ (((ob >> 9) & 1) << 5)); }
__host__ __device__ __forceinline__ void stage_rc(int b, int& R, int& C) { const int st = b / 1024, sb = b % 1024, swz = sb ^ (((sb >> 9) & 1) << 5); R = (st >> 1) * 16 + swz / 64; C = (st & 1) * 32 + (swz % 64) / 2; }
__host__ __device__ __forceinline__ int perm32(int rho) { const int n = rho >> 4, i = rho & 15; return 8 * (i >> 2) + 4 * n + (i & 3); }

struct Unit { int pm, pn; };
struct Gemm { const bf16_t* A; const bf16_t* Bt; int M, N, K; };

struct StaticOrder {
    int nM, nN, nwg, G, c;
    __host__ __device__ void init(int M, int N, int G_, int c_) { nM = M / BM; nN = N / BM; nwg = nM * nN; G = G_; c = c_; }
    __host__ __device__ bool next(int i, Unit& u) const {
        const long L = (long)i * G + c; if (L >= nwg) return false;
        int wgid = (int)L; { const int q = nwg / NXCD, r = nwg % NXCD, xcd = wgid % NXCD, off = wgid / NXCD; wgid = (xcd < r ? xcd * (q + 1) : r * (q + 1) + (xcd - r) * q) + off; }
        const int nig = WGM * nN, gid = wgid / nig, fm = gid * WGM, gsz = (nM - fm) < WGM ? (nM - fm) : WGM;
        u.pm = fm + ((wgid % nig) % gsz); u.pn = (wgid % nig) / gsz; return true;
    }
    __device__ __forceinline__ void a_ready(const Unit&) const {}
    __device__ __forceinline__ void done(const Unit&) const {}
};
__device__ __forceinline__ unsigned cvt_pk_bf16(float lo, float hi) { unsigned r; asm volatile("v_cvt_pk_bf16_f32 %0, %1, %2" : "=v"(r) : "v"(lo), "v"(hi)); return r; }
typedef float f32x2 __attribute__((ext_vector_type(2)));
__device__ __forceinline__ f32x2 gelu_pk(f32x2 v) {
    const f32x2 av = __builtin_elementwise_abs(v), d = av * 0.2316418882f + 1.0f;
    f32x2 t; t.x = __builtin_amdgcn_rcpf(d.x); t.y = __builtin_amdgcn_rcpf(d.y);
    f32x2 q = t * 0.5307027145f + (-0.7265760135f); q = q * t + 0.7107068705f; q = q * t + (-0.142248368f); q = q * t + 0.127414796f; q = q * t;
    const f32x2 s = (v * v) * (-0.72134752044f);
    f32x2 e; e.x = __builtin_amdgcn_exp2f(s.x); e.y = __builtin_amdgcn_exp2f(s.y);
    const f32x2 m = v * (q * e), r = v - m;
    f32x2 o; o.x = v.x < 0.f ? m.x : r.x; o.y = v.y < 0.f ? m.y : r.y; return o;
}

template <int ACT  > struct EpiBf16 {
    static constexpr bool PERM = true, AFTER_DRAIN = false; static_assert(ACT == 0 || ACT == 1, "EpiBf16: ACT is 0 (none) or 1 (gelu_pk)");
    bf16_t* O; int ldc; const float* bias; int split_cols; size_t split_stride; float scale0;
    __device__ __forceinline__ void operator()(const f32x4 (&acc)[2][2][4][2], const Unit& u, int wr, int wc, int fr, int fq) const {
        const int row0 = u.pm * BM + wr * 64 + fr; int colt = u.pn * BM; bf16_t* base = O;
        float sc = 1.f; if (split_cols) { const int t = colt / split_cols; base += (size_t)t * split_stride; colt -= t * split_cols; if (t == 0) sc = scale0; }
        const int col0 = colt + wc * 32 + 8 * fq, bcol0 = u.pn * BM + wc * 32 + 8 * fq;
        f32x4 bv[2][2];
#pragma unroll
        for (int bj = 0; bj < 2; ++bj)
#pragma unroll
            for (int n = 0; n < 2; ++n) bv[bj][n] = bias ? *(const f32x4*)(bias + bcol0 + bj * HALF + 4 * n) : (f32x4){0.f, 0.f, 0.f, 0.f};
#pragma unroll
        for (int ai = 0; ai < 2; ++ai)
#pragma unroll
            for (int m = 0; m < 4; ++m) { bf16_t* rowp = base + (size_t)(row0 + ai * HALF + m * 16) * ldc + col0;
#pragma unroll
                for (int bj = 0; bj < 2; ++bj) { f32x4 v0 = acc[ai][bj][m][0] + bv[bj][0], v1 = acc[ai][bj][m][1] + bv[bj][1];
                    if (ACT == 1) { f32x2 a = gelu_pk((f32x2){v0[0], v0[1]}), b = gelu_pk((f32x2){v0[2], v0[3]}), c = gelu_pk((f32x2){v1[0], v1[1]}), d = gelu_pk((f32x2){v1[2], v1[3]});
                        v0 = (f32x4){a.x, a.y, b.x, b.y}; v1 = (f32x4){c.x, c.y, d.x, d.y}; }
                    v0 = v0 * sc; v1 = v1 * sc; u32x4 w; w.x = cvt_pk_bf16(v0[0], v0[1]); w.y = cvt_pk_bf16(v0[2], v0[3]); w.z = cvt_pk_bf16(v1[0], v1[1]); w.w = cvt_pk_bf16(v1[2], v1[3]);
                    *(u32x4*)(rowp + bj * HALF) = w; } }
    }
};
struct EpiF32 {
    static constexpr bool PERM = false, AFTER_DRAIN = false;
    float* C; int ldc;
    __device__ __forceinline__ void operator()(const f32x4 (&acc)[2][2][4][2], const Unit& u, int wr, int wc, int fr, int fq) const {
        const int row0 = u.pm * BM + wr * 64 + fr, col0 = u.pn * BM + wc * 32 + 4 * fq;
#pragma unroll
        for (int ai = 0; ai < 2; ++ai)
#pragma unroll
            for (int m = 0; m < 4; ++m) { float* rowp = C + (size_t)(row0 + ai * HALF + m * 16) * ldc + col0;
#pragma unroll
                for (int bj = 0; bj < 2; ++bj)
#pragma unroll
                    for (int n = 0; n < 2; ++n) *(f32x4*)(rowp + bj * HALF + n * 16) = acc[ai][bj][m][n]; }
    }
};
__device__ __forceinline__ float silu_f(float x) { return x / (1.0f + __expf(-x)); }
struct EpiSwiGLU {
    static constexpr bool PERM = true, AFTER_DRAIN = false;
    bf16_t* H; int ldh; const float* comb; int ldcomb;
    __device__ __forceinline__ void operator()(const f32x4 (&acc)[2][2][4][2], const Unit& u, int wr, int wc, int fr, int fq) const {
        const int row0 = u.pm * BM + wr * 64 + fr, col0 = u.pn * 128 + wc * 32 + 8 * fq, e = u.pn >> 1;
#pragma unroll
        for (int ai = 0; ai < 2; ++ai)
#pragma unroll
            for (int m = 0; m < 4; ++m) { const int row = row0 + ai * HALF + m * 16; const float cw = comb[(size_t)row * ldcomb + e];
                const f32x4 g0 = acc[ai][0][m][0], g1 = acc[ai][0][m][1], u0 = acc[ai][1][m][0], u1 = acc[ai][1][m][1];
                f32x4 h0, h1;
#pragma unroll
                for (int j = 0; j < 4; ++j) { h0[j] = silu_f(g0[j]) * u0[j] * cw; h1[j] = silu_f(g1[j]) * u1[j] * cw; }
                u32x4 w; w.x = cvt_pk_bf16(h0[0], h0[1]); w.y = cvt_pk_bf16(h0[2], h0[3]); w.z = cvt_pk_bf16(h1[0], h1[1]); w.w = cvt_pk_bf16(h1[2], h1[3]);
                *(u32x4*)(H + (size_t)row * ldh + col0) = w; }
    }
};

template <int NSUB> struct MoeOrder {
    const PG8_LAS int* off; int G, c;
    __device__ __forceinline__ bool next(int i, Unit& u) const {
        const int L = i * G + c, x = L & 7, j = L >> 3, t = x + 8 * (j / NSUB), pnl = j % NSUB;
        if (t * 256 >= off[16]) return false;
        int e = 0;
#pragma unroll
        for (int k = 1; k < 16; ++k) e += (off[k] <= t * 256) ? 1 : 0;
        u.pm = t; u.pn = e * NSUB + pnl; return true;
    }
    __device__ __forceinline__ void a_ready(const Unit&) const {}
    __device__ __forceinline__ void done(const Unit&) const {}
};
struct EpiSwiGLUs {
    static constexpr bool PERM = true, AFTER_DRAIN = false;
    bf16_t* H; const float* wrow;
    __device__ __forceinline__ void operator()(const f32x4 (&acc)[2][2][4][2], const Unit& u, int wr, int wc, int fr, int fq) const {
        const int row0 = u.pm * BM + wr * 64 + fr, col0 = (u.pn & 1) * 128 + wc * 32 + 8 * fq;
#pragma unroll
        for (int ai = 0; ai < 2; ++ai)
#pragma unroll
            for (int m = 0; m < 4; ++m) { const int row = row0 + ai * HALF + m * 16; const float cw = wrow[row];
                const f32x4 g0 = acc[ai][0][m][0], g1 = acc[ai][0][m][1], u0 = acc[ai][1][m][0], u1 = acc[ai][1][m][1];
                f32x4 h0, h1;
#pragma unroll
                for (int j = 0; j < 4; ++j) { h0[j] = silu_f(g0[j]) * u0[j] * cw; h1[j] = silu_f(g1[j]) * u1[j] * cw; }
                u32x4 w; w.x = cvt_pk_bf16(h0[0], h0[1]); w.y = cvt_pk_bf16(h0[2], h0[3]); w.z = cvt_pk_bf16(h1[0], h1[1]); w.w = cvt_pk_bf16(h1[2], h1[3]);
                *(u32x4*)(H + (size_t)row * 256 + col0) = w; }
    }
};
struct EpiBf16s {
    static constexpr bool PERM = true, AFTER_DRAIN = false;
    bf16_t* O;
    __device__ __forceinline__ void operator()(const f32x4 (&acc)[2][2][4][2], const Unit& u, int wr, int wc, int fr, int fq) const {
        const int row0 = u.pm * BM + wr * 64 + fr, col0 = (u.pn & 3) * BM + wc * 32 + 8 * fq;
#pragma unroll
        for (int ai = 0; ai < 2; ++ai)
#pragma unroll
            for (int m = 0; m < 4; ++m) { bf16_t* rowp = O + (size_t)(row0 + ai * HALF + m * 16) * 1024 + col0;
#pragma unroll
                for (int bj = 0; bj < 2; ++bj) { const f32x4 v0 = acc[ai][bj][m][0], v1 = acc[ai][bj][m][1];
                    u32x4 w; w.x = cvt_pk_bf16(v0[0], v0[1]); w.y = cvt_pk_bf16(v0[2], v0[3]); w.z = cvt_pk_bf16(v1[0], v1[1]); w.w = cvt_pk_bf16(v1[2], v1[3]);
                    *(u32x4*)(rowp + bj * HALF) = w; } }
    }
};
template <class Epi, class Sched, bool ALIGN_EPI = false, bool SP2 = false>
__device__ __forceinline__ void gemm_phase(PG8_LAS unsigned char* lds, const Gemm g, const Sched& S, const Epi& E) {
    int tid_ = threadIdx.x; asm volatile("" : "+v"(tid_));
    const int tid = tid_, wid = __builtin_amdgcn_readfirstlane(tid >> 6), lane = tid & 63, wr = wid >> 2, wc = wid & 3, fr = lane & 15, fq = lane >> 4;
    const int K = g.K, nt = K / BK;
    unsigned voffA[2], voffB[2];
#pragma unroll
    for (int i = 0; i < 2; ++i) { int R, C; stage_rc(tid * 16 + i * 8192, R, C); const int Rb = Epi::PERM ? ((R & ~31) + perm32(R & 31)) : R;
        voffA[i] = (unsigned)(R * K + C) * 2u; voffB[i] = (unsigned)(Rb * K + C) * 2u; }
    const size_t kstep = (size_t)(BK * 2);
    const size_t hstep = (size_t)HALF * K * 2;
    const size_t tstep = 2 * hstep;
    const unsigned ldsw = (unsigned)wid * 1024u;
    const int aoff = lds_byte(wr * 64 + fr, fq * 8), boff = lds_byte(wc * 32 + fr, fq * 8);
#define PG8_SA(b, h) (((b) * 2 + (h)) * HTB)
#define PG8_SB(b, h) ((4 + (b) * 2 + (h)) * HTB)
#define PG8_STAGE(bufoff, gbase, voff) do { _Pragma("unroll") for (int _i = 0; _i < 2; ++_i) \
        __builtin_amdgcn_global_load_lds((const unsigned*)((const char*)(gbase) + (voff)[_i]), (PG8_LAS unsigned*)(lds + (bufoff) + ldsw + _i * 8192), 16, 0, 0); } while (0)
#define PG8_LDA(dst, b, h) do { _Pragma("unroll") for (int m = 0; m < 4; ++m) _Pragma("unroll") for (int k = 0; k < 2; ++k) dst[m][k] = *(const PG8_LAS bf16x8*)(lds + PG8_SA(b, h) + aoff + m * 2048 + k * 1024); } while (0)
#define PG8_LDB(dst, b, h) do { _Pragma("unroll") for (int n = 0; n < 2; ++n) _Pragma("unroll") for (int k = 0; k < 2; ++k) dst[n][k] = *(const PG8_LAS bf16x8*)(lds + PG8_SB(b, h) + boff + n * 2048 + k * 1024); } while (0)
#define PG8_MMA(ai, bj, At, Bt) do { __builtin_amdgcn_s_setprio(1); _Pragma("unroll") for (int m = 0; m < 4; ++m) _Pragma("unroll") for (int n = 0; n < 2; ++n) _Pragma("unroll") for (int k = 0; k < 2; ++k) \
        acc[ai][bj][m][n] = __builtin_amdgcn_mfma_f32_16x16x32_bf16(Bt[n][k], At[m][k], acc[ai][bj][m][n], 0, 0, 0); __builtin_amdgcn_s_setprio(0); } while (0)
#define PG8_WAIT_V(n) asm volatile("s_waitcnt vmcnt(" #n ")" ::: "memory")
#define PG8_WAIT_L(n) asm volatile("s_waitcnt lgkmcnt(" #n ")" ::: "memory")
#define PG8_BAR __builtin_amdgcn_s_barrier()
#define PG8_SCHED __builtin_amdgcn_sched_barrier(0)
    Unit cur, nxt; int ui = 0;
    if (!S.next(0, cur)) return;
    f32x4 acc[2][2][4][2];
#pragma unroll
    for (int a = 0; a < 2; ++a)
#pragma unroll
        for (int b = 0; b < 2; ++b)
#pragma unroll
            for (int m = 0; m < 4; ++m)
#pragma unroll
                for (int n = 0; n < 2; ++n) acc[a][b][m][n] = (f32x4){0.f, 0.f, 0.f, 0.f};
    bf16x8 At[4][2], B0[2][2], B1[2][2];
    const char* cA = (const char*)g.A + (size_t)cur.pm * tstep; const char* cB = (const char*)g.Bt + (size_t)cur.pn * tstep;
    S.a_ready(cur);
    if constexpr (SP2) {
        PG8_STAGE(PG8_SB(0, 0), cB, voffB); PG8_STAGE(PG8_SB(0, 1), cB + hstep, voffB); PG8_STAGE(PG8_SA(0, 0), cA, voffA); PG8_STAGE(PG8_SA(0, 1), cA + hstep, voffA);
        if (wr == 1) PG8_BAR;
        PG8_WAIT_V(2); PG8_BAR;
        PG8_STAGE(PG8_SB(1, 0), cB + kstep, voffB); PG8_STAGE(PG8_SA(1, 0), cA + kstep, voffA); PG8_STAGE(PG8_SB(1, 1), cB + hstep + kstep, voffB);
        PG8_WAIT_V(6); PG8_BAR;
    } else {
        PG8_STAGE(PG8_SB(0, 0), cB, voffB); PG8_STAGE(PG8_SA(0, 0), cA, voffA); PG8_STAGE(PG8_SB(0, 1), cB + hstep, voffB); PG8_STAGE(PG8_SA(0, 1), cA + hstep, voffA);
        if (wr == 1) PG8_BAR;
        PG8_WAIT_V(4); PG8_BAR;
        PG8_STAGE(PG8_SB(1, 0), cB + kstep, voffB); PG8_STAGE(PG8_SA(1, 0), cA + kstep, voffA); PG8_STAGE(PG8_SB(1, 1), cB + hstep + kstep, voffB);
        PG8_WAIT_V(6); PG8_BAR;
    }
    for (;;) {
        const bool has_next = S.next(ui + 1, nxt);
        const char* nA = has_next ? (const char*)g.A + (size_t)nxt.pm * tstep : cA; const char* nB = has_next ? (const char*)g.Bt + (size_t)nxt.pn * tstep : cB;
#pragma unroll 1
        for (int t = 0; t < nt; t += 2) {
            const bool last = (t == nt - 2);
            const char* a1 = cA + (size_t)(t + 1) * kstep;
            const char* a2 = last ? nA : cA + (size_t)(t + 2) * kstep; const char* b2 = last ? nB : cB + (size_t)(t + 2) * kstep;
            const char* a3 = a2 + kstep; const char* b3 = b2 + kstep;
            if (last && has_next) S.a_ready(nxt);
            if constexpr (SP2) {
            PG8_LDB(B0, 0, 0); PG8_LDB(B1, 0, 1); PG8_SCHED; PG8_LDA(At, 0, 0); PG8_STAGE(PG8_SA(1, 1), a1 + hstep, voffA);
            PG8_WAIT_V(8); PG8_WAIT_L(0); PG8_BAR; PG8_MMA(0, 0, At, B0); PG8_MMA(0, 1, At, B1); PG8_BAR; PG8_SCHED;
            PG8_LDA(At, 0, 1); PG8_STAGE(PG8_SB(0, 0), b2, voffB); PG8_STAGE(PG8_SB(0, 1), b2 + hstep, voffB); PG8_STAGE(PG8_SA(0, 0), a2, voffA);
            PG8_WAIT_V(8); PG8_WAIT_L(0); PG8_BAR; PG8_MMA(1, 0, At, B0); PG8_MMA(1, 1, At, B1); PG8_BAR; PG8_SCHED;
            PG8_LDB(B0, 1, 0); PG8_LDB(B1, 1, 1); PG8_SCHED; PG8_LDA(At, 1, 0); PG8_STAGE(PG8_SA(0, 1), a2 + hstep, voffA);
            PG8_WAIT_V(8); PG8_WAIT_L(0); PG8_BAR; PG8_MMA(0, 0, At, B0); PG8_MMA(0, 1, At, B1); PG8_BAR; PG8_SCHED;
            PG8_LDA(At, 1, 1); PG8_STAGE(PG8_SB(1, 0), b3, voffB); PG8_STAGE(PG8_SB(1, 1), b3 + hstep, voffB); PG8_STAGE(PG8_SA(1, 0), a3, voffA);
            PG8_WAIT_V(8); PG8_WAIT_L(0); PG8_BAR; PG8_MMA(1, 0, At, B0); PG8_MMA(1, 1, At, B1); PG8_BAR; PG8_SCHED;
            } else {
            PG8_LDB(B0, 0, 0); PG8_SCHED; PG8_LDA(At, 0, 0); PG8_STAGE(PG8_SA(1, 1), a1 + hstep, voffA);
            PG8_WAIT_L(8); PG8_BAR; PG8_WAIT_L(0); PG8_MMA(0, 0, At, B0); PG8_BAR; PG8_SCHED;
            PG8_LDB(B1, 0, 1); PG8_STAGE(PG8_SB(0, 0), b2, voffB);
            PG8_BAR; PG8_WAIT_L(0); PG8_MMA(0, 1, At, B1); PG8_BAR;
            PG8_LDA(At, 0, 1); PG8_STAGE(PG8_SA(0, 0), a2, voffA);
            PG8_BAR; PG8_WAIT_L(0); PG8_MMA(1, 0, At, B0); PG8_BAR; PG8_SCHED;
            PG8_STAGE(PG8_SB(0, 1), b2 + hstep, voffB);
            PG8_WAIT_V(6); PG8_BAR; PG8_MMA(1, 1, At, B1); PG8_BAR;
            PG8_LDB(B0, 1, 0); PG8_SCHED; PG8_LDA(At, 1, 0); PG8_STAGE(PG8_SA(0, 1), a2 + hstep, voffA);
            PG8_WAIT_L(8); PG8_BAR; PG8_WAIT_L(0); PG8_MMA(0, 0, At, B0); PG8_BAR; PG8_SCHED;
            PG8_LDB(B1, 1, 1); PG8_STAGE(PG8_SB(1, 0), b3, voffB);
            PG8_BAR; PG8_WAIT_L(0); PG8_MMA(0, 1, At, B1); PG8_BAR;
            PG8_LDA(At, 1, 1); PG8_STAGE(PG8_SA(1, 0), a3, voffA);
            PG8_BAR; PG8_WAIT_L(0); PG8_MMA(1, 0, At, B0); PG8_BAR; PG8_SCHED;
            PG8_STAGE(PG8_SB(1, 1), b3 + hstep, voffB);
            PG8_WAIT_V(6); PG8_BAR; PG8_MMA(1, 1, At, B1); PG8_BAR;
            }
        }
        if constexpr (ALIGN_EPI) { if (wr == 0) PG8_BAR; }
        if constexpr (!Epi::AFTER_DRAIN) { E(acc, cur, wr, wc, fr, fq); S.done(cur); }
        if (!has_next) break;
#pragma unroll
        for (int a = 0; a < 2; ++a)
#pragma unroll
            for (int b = 0; b < 2; ++b)
#pragma unroll
                for (int m = 0; m < 4; ++m)
#pragma unroll
                    for (int n = 0; n < 2; ++n) acc[a][b][m][n] = (f32x4){0.f, 0.f, 0.f, 0.f};
        cur = nxt; cA = nA; cB = nB; ++ui;
        if constexpr (ALIGN_EPI) { if (wr == 1) PG8_BAR; }
    }
    PG8_WAIT_V(0);
    if constexpr (!ALIGN_EPI) { if (wr == 0) PG8_BAR; }
    PG8_BAR;
    if constexpr (Epi::AFTER_DRAIN) { E.fused(acc, cur, wr, wc, fr, fq, lds, wid, lane); S.done(cur); }
#undef PG8_SA
#undef PG8_SB
#undef PG8_STAGE
#undef PG8_LDA
#undef PG8_LDB
#undef PG8_MMA
#undef PG8_WAIT_V
#undef PG8_WAIT_L
#undef PG8_BAR
#undef PG8_SCHED
}
}
#define GAS __attribute__((address_space(1)))
#define LAS __attribute__((address_space(3)))
typedef unsigned short bf16;
typedef unsigned v4u __attribute__((ext_vector_type(4)));
typedef float f32x4 __attribute__((ext_vector_type(4)));
typedef short bf16x8 __attribute__((ext_vector_type(8)));
typedef GAS unsigned gu32;
typedef GAS unsigned long long gu64;
#define RLX_AGENT __ATOMIC_RELAXED, __HIP_MEMORY_SCOPE_AGENT
#define LDS_WAIT() asm volatile("s_waitcnt lgkmcnt(0)" ::: "memory")
#define VM_WAIT() asm volatile("s_waitcnt vmcnt(0)" ::: "memory")
__device__ __forceinline__ unsigned long long rt() { return __builtin_amdgcn_s_memrealtime(); }
__device__ __forceinline__ unsigned f2bf(float f) { unsigned u = __builtin_bit_cast(unsigned, f); return (u + 0x7fffu + ((u >> 16) & 1u)) >> 16; }
__device__ __forceinline__ unsigned pk2(float lo, float hi) { return f2bf(lo) | (f2bf(hi) << 16); }

#define XB_TMO      128
#define XB_XCNT(j)  (256  + 64 * (j))
#define XB_XSUB(j)  (1280 + 64 * (j))
#define XB_XGEN(j)  (2304 + 64 * (j))
#define XB_TOP      3328
#define XB_TOPGEN   3392
#define XCD_BAR_WORDS 3456
#define XB_SPIN_CAP (1u << 18)

__device__ __forceinline__ unsigned xb_ld(unsigned* p)              { return __hip_atomic_load(p, __ATOMIC_RELAXED, __HIP_MEMORY_SCOPE_AGENT); }
__device__ __forceinline__ unsigned xb_add(unsigned* p, unsigned v) { return __hip_atomic_fetch_add(p, v, __ATOMIC_RELAXED, __HIP_MEMORY_SCOPE_AGENT); }
__device__ __forceinline__ unsigned xb_xcc_id() { return (unsigned)__builtin_amdgcn_s_getreg((3 << 11) | 20) & 0xFu; }
#define XB_SPIN(cond, bar) do { unsigned _sp = 0; while (cond) { __builtin_amdgcn_s_sleep(1); \
    if ((++_sp & 255u) == 0u) { if (xb_ld(&(bar)[XB_TMO])) break; if (_sp > XB_SPIN_CAP) { atomicAdd(&(bar)[XB_TMO], 1u); break; } } } } while (0)

struct XcdBarrier {
    unsigned* bar; unsigned x;
    volatile LAS unsigned* st;
};

__device__ __forceinline__ XcdBarrier xcd_barrier_post(unsigned* bar, volatile LAS unsigned* st) {
    XcdBarrier b; b.bar = bar; b.x = xb_xcc_id(); b.st = st;
    if (threadIdx.x == 0) (void)xb_add(&bar[XB_XCNT(b.x)], 1u);
    return b;
}
__device__ __forceinline__ void xcd_barrier_complete(unsigned* bar, unsigned x, unsigned& nloc, unsigned& nx) {
    const unsigned G = gridDim.x * gridDim.y * gridDim.z;
    unsigned sum, cnt, mine, sp = 0u;
    for (;;) {
        sum = 0u; cnt = 0u; mine = 0u;
#pragma unroll
        for (unsigned j = 0; j < 16; ++j) { const unsigned c = xb_ld(&bar[XB_XCNT(j)]); sum += c; cnt += (c > 0u) ? 1u : 0u; mine = (j == x) ? c : mine; }
        if (sum == G) break;
        __builtin_amdgcn_s_sleep(1);
        if ((++sp & 255u) == 0u) { if (xb_ld(&bar[XB_TMO])) break; if (sp > XB_SPIN_CAP) { atomicAdd(&bar[XB_TMO], 1u); break; } }
    }
    nloc = mine > 0u ? mine : 1u; nx = cnt > 0u ? cnt : 1u;
}

__device__ __forceinline__ void xcd_barrier(const XcdBarrier& b) {
    asm volatile("s_waitcnt vmcnt(0)" ::: "memory");
    __syncthreads();
    if (threadIdx.x == 0) {
        unsigned* bar = b.bar;
        __builtin_amdgcn_s_waitcnt(0);
        unsigned nloc = b.st[0], nx = b.st[1];
        if (nloc == 0u) { xcd_barrier_complete(bar, b.x, nloc, nx); b.st[0] = nloc; b.st[1] = nx; }
        const unsigned old = xb_add(&bar[XB_XSUB(b.x)], 1u);
        const unsigned gen = old / nloc;
        if (old + 1u == (gen + 1u) * nloc) {
            __builtin_amdgcn_fence(__ATOMIC_RELEASE, "agent");
            asm volatile("s_waitcnt vmcnt(0)" ::: "memory");
            const unsigned og = xb_add(&bar[XB_TOP], 1u);
            const unsigned tg = og / nx;
            if (og + 1u == (tg + 1u) * nx) xb_add(&bar[XB_TOPGEN], 1u);
            else XB_SPIN(xb_ld(&bar[XB_TOPGEN]) == tg, bar);
            __builtin_amdgcn_fence(__ATOMIC_ACQUIRE, "agent");
            xb_add(&bar[XB_XGEN(b.x)], 1u);
            asm volatile("s_waitcnt vmcnt(0)" ::: "memory");
        } else {
            XB_SPIN(xb_ld(&bar[XB_XGEN(b.x)]) == gen, bar);
            __builtin_amdgcn_fence(__ATOMIC_ACQUIRE, "agent");
            asm volatile("s_waitcnt vmcnt(0)" ::: "memory");
        }
    }
    __syncthreads();
}
constexpr int NWAVES = 8, NTHR = NWAVES * 64;
constexpr int D = 1024, BATCH = 4, SEQ = 4096, M = BATCH * SEQ, DEPTH = 4;
constexpr int IN_COLS = 6680, NPROJ = 6912;
constexpr int O_Z = 0, O_XBC = 1024, O_DT = 2560, O_QKV = 2576, O_GG = 4112, O_GB = 4624, O_GA = 4628, O_HQ = 4632, O_HF = 5144, O_HI = 5656, O_HG = 6168;
constexpr int DMIX = 2048, NEXP = 16, DEXP = 256, NGU = NEXP * 2 * DEXP  , KDN = NEXP * DEXP  ;
constexpr float DN_ALPHA = 1.6817928305074290f;
constexpr float LN_EPS = 1e-5f;

constexpr size_t MiB = 1u << 20;
constexpr size_t WS_CTL = 0, CTL_ZERO_BYTES = 1 * MiB;
constexpr size_t WS_LTOK = 2 * MiB;
constexpr size_t WS_LW = 3 * MiB;
constexpr size_t WS_SLOT = 4 * MiB;
constexpr size_t WS_WSORT = 5 * MiB;
constexpr size_t WS_WIN = 8 * MiB;
constexpr size_t WS_WOUT = 22 * MiB;
constexpr size_t WS_WGU = 26 * MiB;
constexpr size_t WS_WDN = 42 * MiB;
constexpr size_t WS_YMIX = 52 * MiB;
constexpr size_t WS_HB = WS_YMIX;
constexpr size_t WS_PROJ = 116 * MiB;
constexpr size_t WS_MIX = WS_PROJ;
constexpr int MAXROWS = 2 * M + 16 * 256;
constexpr size_t WS_XS = WS_PROJ + 64 * MiB;
constexpr size_t WS_HS = WS_PROJ + 136 * MiB;
constexpr size_t WS_YS = WS_PROJ + 154 * MiB;
constexpr int CW_CNT = 8192;
constexpr int LDS_OFF_TAB = 131072 + 1024;
constexpr size_t WS_SCR = 332 * MiB;
constexpr size_t WS_HG_QG = WS_SCR;
constexpr size_t WS_HG_KDT = WS_SCR + 16 * MiB;
constexpr size_t WS_HG_A = WS_SCR + 32 * MiB;
constexpr size_t WS_HG_GL = WS_SCR + 40 * MiB;
constexpr size_t WS_SSD_C = WS_SCR + 41 * MiB;
constexpr size_t WS_SSD_BT = WS_SCR + 49 * MiB;
constexpr size_t WS_SSD_CB = WS_SCR + 57 * MiB;
constexpr size_t WS_SSD_XT = WS_SCR + 65 * MiB;
constexpr size_t WS_SSD_AC = WS_SCR + 97 * MiB;
constexpr size_t WS_SSD_DT = WS_SCR + 98 * MiB;
constexpr size_t WS_GD_K = WS_SCR + 99 * MiB;
constexpr size_t WS_GD_KT = WS_SCR + 115 * MiB;
constexpr size_t WS_GD_QG = WS_SCR + 131 * MiB;
constexpr size_t WS_GD_VT = WS_SCR + 147 * MiB;
constexpr size_t WS_GD_T = WS_SCR + 163 * MiB;
constexpr size_t WS_GD_QK = WS_SCR + 171 * MiB;
constexpr size_t WS_GD_VEC = WS_SCR + 179 * MiB;
constexpr size_t WS_END = 512 * MiB;
constexpr int CW_BAR = 4096;

constexpr int RING_OFF = 0, RING_BYTES = 131072;
constexpr int LDSCTL_OFF = RING_BYTES, MISC_OFF = LDSCTL_OFF + 320;
constexpr int LDS_BYTES = 147456;

__device__ __forceinline__ float bf2f(unsigned short b) { return __builtin_bit_cast(float, ((unsigned)b) << 16); }
__device__ __forceinline__ float bflo(unsigned w) { return __builtin_bit_cast(float, w << 16); }
__device__ __forceinline__ float bfhi(unsigned w) { return __builtin_bit_cast(float, w & 0xffff0000u); }
__device__ __forceinline__ float siluf(float x) { return x / (1.0f + __expf(-x)); }
__device__ __forceinline__ float sigmoidf_(float x) { return 1.0f / (1.0f + __expf(-x)); }
__device__ __forceinline__ float softplusf_(float x) { return x > 20.f ? x : log1pf(__expf(x)); }
__device__ __forceinline__ float wave_sum(float v) {
#pragma unroll
    for (int o = 1; o < 64; o <<= 1) v += __shfl_xor(v, o);
    return v;
}

struct Args {
    const float* in[25]; float* out; unsigned char* ws; int ph_lo, ph_hi;
};
typedef const __attribute__((address_space(4))) Args* CArgs;
#define ARGS_HERE() ([]() { CArgs p_ = (CArgs)__builtin_amdgcn_kernarg_segment_ptr(); asm volatile("" : "+s"(p_)); return p_; }())
enum { I_X = 0, I_WIN, I_SCW, I_SCB, I_SDTB, I_SALOG, I_SD, I_SNW, I_GCW, I_GDTB, I_GALOG, I_GNW, I_HLB, I_HNW, I_WOUT, I_LN1G, I_LN1B, I_WRG, I_BRG, I_WRE, I_BRE, I_WGU, I_WDN, I_LN2G, I_LN2B };

__device__ __forceinline__ void transpose_item(const float* W, int ldw, int nvalid, int k0, int n0, bf16* WT, size_t ldt, int drow0, int dk0, LAS float* scr, int lane) {
#pragma unroll 8
    for (int i = 0; i < 32; ++i) { const int kk = 2 * i + (lane >> 5), nn = lane & 31, n = n0 + nn; scr[kk * 33 + nn] = (n < nvalid) ? W[(size_t)(k0 + kk) * ldw + n] : 0.f; }
    LDS_WAIT(); asm volatile("" ::: "memory");
    const int c = lane & 7;
#pragma unroll
    for (int j = 0; j < 4; ++j) { const int n = (lane >> 3) + 8 * j; const LAS float* s = scr + (8 * c) * 33 + n;
        v4u o; o.x = pk2(s[0 * 33], s[1 * 33]); o.y = pk2(s[2 * 33], s[3 * 33]); o.z = pk2(s[4 * 33], s[5 * 33]); o.w = pk2(s[6 * 33], s[7 * 33]);
        *(GAS v4u*)(WT + (size_t)(drow0 + n) * ldt + dk0 + k0 + 8 * c) = o; }
    LDS_WAIT(); asm volatile("" ::: "memory");
}
__device__ __forceinline__ void weights_phase(CArgs a, int l, const int which, LAS unsigned char* lds, int wwg, int nwg, int tid) {
    asm volatile("" : "+v"(tid));
    const int lane = tid & 63, wave = tid >> 6, gw = wwg * NWAVES + wave, NGW = nwg * NWAVES;
    LAS float* scr = (LAS float*)(lds + wave * 16384);
    constexpr int I_IN = 16 * (NPROJ / 32), I_OUT = (DMIX / 64) * (D / 32), I_GU = NEXP * 16 * 16, I_DN = NEXP * 4 * 32;
    const int n_in = (which & 1) ? I_IN : 0, n_out = (which & 2) ? I_OUT : 0, n_gu = (which & 4) ? I_GU : 0, n_dn = (which & 8) ? I_DN : 0;
    unsigned char* ws = a->ws;
    for (int it = gw; it < n_in + n_out + n_gu + n_dn; it += NGW) {
        int r = it;
        if (r < n_in) { const int kb = r / (NPROJ / 32), nb = r % (NPROJ / 32);
            transpose_item(a->in[I_WIN] + (size_t)l * D * IN_COLS, IN_COLS, IN_COLS, 64 * kb, 32 * nb, (bf16*)(ws + WS_WIN), D, 32 * nb, 0, scr, lane); continue; }
        r -= n_in;
        if (r < n_out) { const int kb = r / (D / 32), nb = r % (D / 32);
            transpose_item(a->in[I_WOUT] + (size_t)l * DMIX * D, D, D, 64 * kb, 32 * nb, (bf16*)(ws + WS_WOUT), DMIX, 32 * nb, 0, scr, lane); continue; }
        r -= n_out;
        if (r < n_gu) { const int e = r / 256, q = r % 256, kb = q / 16, nb = q % 16, c0 = 32 * nb, bj = c0 / 256, hf = (c0 % 256) / 128, j0 = c0 % 128;
            transpose_item(a->in[I_WGU] + (size_t)(l * NEXP + e) * D * 512, 512, 512, 64 * kb, c0, (bf16*)(ws + WS_WGU), D, e * 512 + hf * 256 + bj * 128 + j0, 0, scr, lane); continue; }
        r -= n_gu;
        { const int e = r / 128, q = r % 128, kb = q / 32, nb = q % 32;
            transpose_item(a->in[I_WDN] + (size_t)(l * NEXP + e) * DEXP * D, D, D, 64 * kb, 32 * nb, (bf16*)(ws + WS_WDN), DEXP, e * D + 32 * nb, 0, scr, lane); }
    }
}
__device__ __forceinline__ void p0_prologue(CArgs a, LAS unsigned char* lds, int wg, int G, int tid) {
    asm volatile("" : "+v"(tid));
    const f32x4* x4 = (const f32x4*)a->in[I_X]; f32x4* h4 = (f32x4*)a->out; unsigned long long* hb8 = (unsigned long long*)(a->ws + WS_HB);
    for (size_t i = (size_t)wg * NTHR + tid; i < (size_t)M * D / 4; i += (size_t)G * NTHR) { const f32x4 v = x4[i]; h4[i] = v;
        hb8[i] = (unsigned long long)pk2(v.x, v.y) | ((unsigned long long)pk2(v.z, v.w) << 32); }
}

#define WG_BAR() do { asm volatile("s_waitcnt lgkmcnt(0)" ::: "memory"); __builtin_amdgcn_s_barrier(); asm volatile("" ::: "memory"); } while (0)
__device__ __forceinline__ f32x4 mfma16(bf16x8 x, bf16x8 y, f32x4 c) { return __builtin_amdgcn_mfma_f32_16x16x32_bf16(x, y, c, 0, 0, 0); }
__device__ __forceinline__ bf16x8 lds_frag(const LAS bf16* base, int row0, int stride, int k0, int lane) { return *(const LAS bf16x8*)(base + (row0 + (lane & 15)) * stride + k0 + 8 * (lane >> 4)); }
__device__ __forceinline__ bf16x8 pack8(const float* v) { v4u w; w.x = pk2(v[0], v[1]); w.y = pk2(v[2], v[3]); w.z = pk2(v[4], v[5]); w.w = pk2(v[6], v[7]); return __builtin_bit_cast(bf16x8, w); }
__device__ __forceinline__ unsigned long long pack4(f32x4 v) { return (unsigned long long)pk2(v[0], v[1]) | ((unsigned long long)pk2(v[2], v[3]) << 32); }

__device__ __forceinline__ void hgrn_prep_phase(CArgs a, int l, LAS unsigned char* lds, int wg, int G, int tid) {
    asm volatile("" : "+v"(tid));
    constexpr int LS = 132;
    LAS float* sQ = (LAS float*)lds; LAS float* sK = sQ + 64 * LS; LAS float* sB = sK + 64 * LS; LAS float* sT = sB + 64 * LS; LAS float* sLb = sT + 512;
    const bf16* PROJ = (const bf16*)(a->ws + WS_PROJ);
    const int lane = tid & 63, w = tid >> 6, r = lane & 15, q4 = lane >> 4;
    for (int unit = wg; unit < 1024; unit += G) {
        const int b = unit >> 8, head = (unit >> 6) & 3, c = unit & 63;
        const size_t row0 = (size_t)b * SEQ + c * 64;
        __syncthreads();
        if (tid < 128) {
            const int ch = head * 128 + tid; float lg[DEPTH], mx = -1e30f;
#pragma unroll
            for (int j = 0; j < DEPTH; ++j) { lg[j] = a->in[I_HLB][j * 512 + ch]; mx = fmaxf(mx, lg[j]); }
            float den = 0.f, num = 0.f;
#pragma unroll
            for (int j = 0; j < DEPTH; ++j) { const float e = __expf(lg[j] - mx); den += e; if (j >= 1 && j <= l) num += e; }
            sLb[tid] = num / den;
        }
        __syncthreads();
        for (int p = tid; p < 1024; p += NTHR) {
            const int t = p >> 4, d8 = (p & 15) * 8;
            const v4u qv = *(const GAS v4u*)(PROJ + (row0 + t) * NPROJ + O_HQ + head * 128 + d8), fv = *(const GAS v4u*)(PROJ + (row0 + t) * NPROJ + O_HF + head * 128 + d8);
#pragma unroll
            for (int i = 0; i < 4; ++i) {
                const int d = d8 + 2 * i; const float lb0 = sLb[d], lb1 = sLb[d + 1];
                sQ[t * LS + d] = siluf(bflo(qv[i])); sQ[t * LS + d + 1] = siluf(bfhi(qv[i]));
                const float f0 = lb0 + (1.f - lb0) * sigmoidf_(bflo(fv[i])), f1 = lb1 + (1.f - lb1) * sigmoidf_(bfhi(fv[i]));
                sK[t * LS + d] = 1.f - f0; sK[t * LS + d + 1] = 1.f - f1; sB[t * LS + d] = __logf(f0); sB[t * LS + d + 1] = __logf(f1);
            }
        }
        __syncthreads();
        {
            const int d = tid & 127, seg = tid >> 7; float run = 0.f, vals[16];
#pragma unroll
            for (int i = 0; i < 16; ++i) { run += sB[(seg * 16 + i) * LS + d]; vals[i] = run; }
            sT[seg * 128 + d] = run;
            __syncthreads();
            float off = 0.f;
#pragma unroll
            for (int s2 = 0; s2 < 3; ++s2) if (s2 < seg) off += sT[s2 * 128 + d];
#pragma unroll
            for (int i = 0; i < 16; ++i) sB[(seg * 16 + i) * LS + d] = vals[i] + off;
        }
        __syncthreads();
        bf16* qg = (bf16*)(a->ws + WS_HG_QG) + (size_t)unit * 64 * 128; bf16* kdt = (bf16*)(a->ws + WS_HG_KDT) + (size_t)unit * 128 * 64;
        bf16* am = (bf16*)(a->ws + WS_HG_A) + (size_t)unit * 64 * 64; float* gl = (float*)(a->ws + WS_HG_GL) + (size_t)unit * 128;
        for (int p = tid; p < 1024; p += NTHR) { const int t = p >> 4, d8 = (p & 15) * 8; float v[8];
#pragma unroll
            for (int jj = 0; jj < 8; ++jj) v[jj] = sQ[t * LS + d8 + jj] * __expf(sB[t * LS + d8 + jj]);
            *(GAS bf16x8*)(qg + t * 128 + d8) = pack8(v); }
        for (int p = tid; p < 1024; p += NTHR) { const int d = p >> 3, s8 = (p & 7) * 8; const float bl = sB[63 * LS + d]; float v[8];
#pragma unroll
            for (int jj = 0; jj < 8; ++jj) v[jj] = sK[(s8 + jj) * LS + d] * __expf(bl - sB[(s8 + jj) * LS + d]);
            *(GAS bf16x8*)(kdt + d * 64 + s8) = pack8(v); }
        if (tid < 128) gl[tid] = __expf(sB[63 * LS + tid]);
        for (int p = w; p < 16; p += NWAVES) {
            const int i = p >> 2, j = p & 3; f32x4 acc = {0.f, 0.f, 0.f, 0.f};
            if (j <= i) {
#pragma unroll
                for (int ks = 0; ks < 4; ++ks) { const int d0 = 32 * ks + 8 * q4, t = 16 * i + r, s_ = 16 * j + r; float qf[8], kf[8];
#pragma unroll
                    for (int jj = 0; jj < 8; ++jj) { const float ref = i ? sB[(16 * i - 1) * LS + d0 + jj] : 0.f;
                        qf[jj] = sQ[t * LS + d0 + jj] * __expf(sB[t * LS + d0 + jj] - ref); kf[jj] = sK[s_ * LS + d0 + jj] * __expf(ref - sB[s_ * LS + d0 + jj]); }
                    acc = mfma16(pack8(kf), pack8(qf), acc); }
                const int t = 16 * i + r;
#pragma unroll
                for (int ii = 0; ii < 4; ++ii) if (16 * j + 4 * q4 + ii > t) acc[ii] = 0.f;
            }
            *(GAS unsigned long long*)(am + (16 * i + r) * 64 + 16 * j + 4 * q4) = pack4(acc);
        }
    }
}
__device__ __forceinline__ void hgrn_scan_phase(CArgs a, int l, LAS unsigned char* lds, const int b, const int head, const int eb, int tid) {
    asm volatile("" : "+v"(tid));
    constexpr int QS = 136, KS = 72;
    constexpr int B_QG = 0, B_KDT = 17408, B_A = B_KDT + 18432, B_VT = B_A + 9216, B_GL = B_VT + 4608, BUF = B_GL + 512;
    LAS unsigned char* sST0 = lds + 2 * BUF;
    const bf16* PROJ = (const bf16*)(a->ws + WS_PROJ); bf16* YMIX = (bf16*)(a->ws + WS_YMIX);
    const int lane = tid & 63, w = tid >> 6, r = lane & 15, q4 = lane >> 4;
    {
        const size_t cu0 = (size_t)(b * 4 + head) * 64;
        const bf16* QG = (const bf16*)(a->ws + WS_HG_QG) + cu0 * 64 * 128; const bf16* KDT = (const bf16*)(a->ws + WS_HG_KDT) + cu0 * 128 * 64;
        const bf16* AM = (const bf16*)(a->ws + WS_HG_A) + cu0 * 64 * 64; const float* GL = (const float*)(a->ws + WS_HG_GL) + cu0 * 128;
        const bf16* VP = PROJ + (size_t)b * SEQ * NPROJ + O_HI + head * 128 + eb * 32;
        v4u rq[2], rk[2], ra, rv; f32x4 rg;
#define HG_LOAD(n) do { _Pragma("unroll") for (int i = 0; i < 2; ++i) { const int p = tid + NTHR * i; rq[i] = *(const GAS v4u*)(QG + (size_t)(n) * 8192 + (p >> 4) * 128 + (p & 15) * 8); \
            rk[i] = *(const GAS v4u*)(KDT + (size_t)(n) * 8192 + (p >> 3) * 64 + (p & 7) * 8); } \
            ra = *(const GAS v4u*)(AM + (size_t)(n) * 4096 + (tid >> 3) * 64 + (tid & 7) * 8); \
            if (tid < 256) rv = *(const GAS v4u*)(VP + (size_t)((n) * 64 + (tid >> 2)) * NPROJ + (tid & 3) * 8); \
            if (tid < 32) rg = *(const GAS f32x4*)(GL + (size_t)(n) * 128 + tid * 4); } while (0)
#define HG_STORE(bufp) do { LAS unsigned char* bp_ = (bufp); _Pragma("unroll") for (int i = 0; i < 2; ++i) { const int p = tid + NTHR * i; \
            *(LAS v4u*)(bp_ + B_QG + ((p >> 4) * QS + (p & 15) * 8) * 2) = rq[i]; *(LAS v4u*)(bp_ + B_KDT + ((p >> 3) * KS + (p & 7) * 8) * 2) = rk[i]; } \
            *(LAS v4u*)(bp_ + B_A + ((tid >> 3) * KS + (tid & 7) * 8) * 2) = ra; \
            if (tid < 256) { LAS bf16* vt = (LAS bf16*)(bp_ + B_VT); const int t_ = tid >> 2, e8 = (tid & 3) * 8; _Pragma("unroll") for (int i = 0; i < 4; ++i) { \
                vt[(e8 + 2 * i) * KS + t_] = (bf16)(rv[i] & 0xffffu); vt[(e8 + 2 * i + 1) * KS + t_] = (bf16)(rv[i] >> 16); } } \
            if (tid < 32) *(LAS f32x4*)(bp_ + B_GL + tid * 16) = rg; } while (0)
        __syncthreads();
        HG_LOAD(0);
        for (int i = tid; i < 8704 / 4; i += NTHR) ((LAS unsigned*)sST0)[i] = 0u;
        HG_STORE(lds);
        f32x4 accS[2] = {{0.f, 0.f, 0.f, 0.f}, {0.f, 0.f, 0.f, 0.f}};
        __syncthreads();
        for (int n = 0; n < 64; ++n) {
            const int cur = n & 1; LAS unsigned char* bp = lds + cur * BUF; LAS bf16* sST = (LAS bf16*)(sST0 + cur * 8704); LAS bf16* sSTn = (LAS bf16*)(sST0 + (cur ^ 1) * 8704);
            if (n + 1 < 64) HG_LOAD(n + 1);
            {
                const int tt = w >> 1, et = w & 1; f32x4 acc = {0.f, 0.f, 0.f, 0.f};
#pragma unroll
                for (int ks = 0; ks < 4; ++ks) acc = mfma16(lds_frag(sST, 16 * et, QS, 32 * ks, lane), lds_frag((LAS bf16*)(bp + B_QG), 16 * tt, QS, 32 * ks, lane), acc);
#pragma unroll
                for (int ks = 0; ks < 2; ++ks) acc = mfma16(lds_frag((LAS bf16*)(bp + B_VT), 16 * et, KS, 32 * ks, lane), lds_frag((LAS bf16*)(bp + B_A), 16 * tt, KS, 32 * ks, lane), acc);
                *(GAS unsigned long long*)(YMIX + ((size_t)b * SEQ + n * 64 + 16 * tt + r) * DMIX + 1536 + head * 128 + eb * 32 + 16 * et + 4 * q4) = pack4(acc);
            }
            {
                const f32x4 glv = *(const LAS f32x4*)(bp + B_GL + (16 * w + 4 * q4) * 4);
#pragma unroll
                for (int et = 0; et < 2; ++et) { accS[et] = accS[et] * glv;
#pragma unroll
                    for (int ks = 0; ks < 2; ++ks) accS[et] = mfma16(lds_frag((LAS bf16*)(bp + B_KDT), 16 * w, KS, 32 * ks, lane), lds_frag((LAS bf16*)(bp + B_VT), 16 * et, KS, 32 * ks, lane), accS[et]);
                    *(LAS unsigned long long*)(sSTn + (16 * et + r) * QS + 16 * w + 4 * q4) = pack4(accS[et]); }
            }
            if (n + 1 < 64) HG_STORE(lds + (cur ^ 1) * BUF);
            WG_BAR();
        }
#undef HG_LOAD
#undef HG_STORE
    }
}

__device__ __forceinline__ void ssd_rec_phase(CArgs a, int l, LAS unsigned char* lds, int wg, int G, int tid) {
    asm volatile("" : "+v"(tid));
    constexpr int TB = 64;
    LAS float* sX = (LAS float*)lds; LAS float* sB = sX + TB * 16; LAS float* sC = sB + TB * 128; LAS float* sDt = sC + TB * 128; LAS float* sDa = sDt + TB; LAS float* sY = sDa + TB;
    const bf16* PROJ = (const bf16*)(a->ws + WS_PROJ); bf16* YMIX = (bf16*)(a->ws + WS_YMIX);
    const float* cw = a->in[I_SCW] + (size_t)l * 4 * 1536; const float* cb = a->in[I_SCB] + (size_t)l * 1536;
    const int p_local = tid >> 5, nq = tid & 31;
    for (int unit = wg; unit < 256; unit += G) {
        const int b = unit >> 6, head = (unit >> 2) & 15, pq = unit & 3, g = head >> 3;
        const float A = -__expf(a->in[I_SALOG][l * 16 + head]), dtb = a->in[I_SDTB][l * 16 + head], Dsk = a->in[I_SD][l * 16 + head];
        float h0 = 0.f, h1 = 0.f, h2 = 0.f, h3 = 0.f;
        for (int t0 = 0; t0 < SEQ; t0 += TB) {
            __syncthreads();
            for (int idx = tid; idx < TB * 272; idx += NTHR) {
                const int tt = idx / 272, ci = idx % 272, t = t0 + tt;
                const int ch = ci < 16 ? head * 64 + pq * 16 + ci : (ci < 144 ? 1024 + g * 128 + (ci - 16) : 1280 + g * 128 + (ci - 144));
                float acc = cb[ch];
#pragma unroll
                for (int k = 0; k < 4; ++k) { const int ts = t - 3 + k; if (ts >= 0) acc += cw[k * 1536 + ch] * bf2f(PROJ[(size_t)(b * SEQ + ts) * NPROJ + O_XBC + ch]); }
                const float v = siluf(acc);
                if (ci < 16) sX[tt * 16 + ci] = v; else if (ci < 144) sB[tt * 128 + ci - 16] = v; else sC[tt * 128 + ci - 144] = v;
            }
            if (tid < TB) { const float raw = bf2f(PROJ[(size_t)(b * SEQ + t0 + tid) * NPROJ + O_DT + head]); const float dt = softplusf_(raw + dtb); sDt[tid] = dt; sDa[tid] = __expf(dt * A); }
            __syncthreads();
#pragma unroll 4
            for (int tt = 0; tt < TB; ++tt) {
                const float xv = sX[tt * 16 + p_local], da = sDa[tt], dx = sDt[tt] * xv;
                const f32x4 Bv = *(const LAS f32x4*)(sB + tt * 128 + nq * 4), Cv = *(const LAS f32x4*)(sC + tt * 128 + nq * 4);
                h0 = da * h0 + dx * Bv.x; h1 = da * h1 + dx * Bv.y; h2 = da * h2 + dx * Bv.z; h3 = da * h3 + dx * Bv.w;
                float part = (Cv.x * h0 + Cv.y * h1) + (Cv.z * h2 + Cv.w * h3);
                part += __shfl_xor(part, 1); part += __shfl_xor(part, 2); part += __shfl_xor(part, 4); part += __shfl_xor(part, 8); part += __shfl_xor(part, 16);
                if (nq == 0) sY[tt * 16 + p_local] = part + Dsk * xv;
            }
            __syncthreads();
            for (int idx = tid; idx < TB * 16; idx += NTHR) { const int tt = idx >> 4, i = idx & 15; YMIX[(size_t)(b * SEQ + t0 + tt) * DMIX + head * 64 + pq * 16 + i] = (bf16)f2bf(sY[idx]); }
        }
    }
}

__device__ __forceinline__ void ssd_prep_phase(CArgs a, int l, LAS unsigned char* lds, int wg, int G, int tid) {
    asm volatile("" : "+v"(tid));
    constexpr int PS = 136;
    LAS bf16* sB = (LAS bf16*)lds; LAS bf16* sC = sB + 128 * PS; LAS bf16* sXT = (LAS bf16*)lds; LAS float* sDt = (LAS float*)(lds + 2 * 128 * PS * 2);
    const bf16* PROJ = (const bf16*)(a->ws + WS_PROJ);
    const float* cw = a->in[I_SCW] + (size_t)l * 4 * 1536; const float* cb = a->in[I_SCB] + (size_t)l * 1536;
    const int lane = tid & 63, w = tid >> 6, r = lane & 15, q4 = lane >> 4;
    for (int unit = wg; unit < 256; unit += G) {
        const int b = unit >> 6, c = (unit >> 1) & 31, g = unit & 1;
        const size_t row0 = (size_t)b * SEQ + c * 128;
        bf16* Cg = (bf16*)(a->ws + WS_SSD_C) + (size_t)unit * 16384; bf16* BTg = (bf16*)(a->ws + WS_SSD_BT) + (size_t)unit * 16384; bf16* CBg = (bf16*)(a->ws + WS_SSD_CB) + (size_t)unit * 16384;
        __syncthreads();
        {
            const int c16 = tid & 31, l0 = tid >> 5; const int ch = (c16 < 16 ? 1024 + g * 128 + c16 * 8 : 1280 + g * 128 + (c16 - 16) * 8);
            float wk[4][8], bias[8];
#pragma unroll
            for (int jj = 0; jj < 8; ++jj) { bias[jj] = cb[ch + jj];
#pragma unroll
                for (int k = 0; k < 4; ++k) wk[k][jj] = cw[k * 1536 + ch + jj]; }
            LAS bf16* dst = (c16 < 16 ? sB : sC) + (c16 & 15) * 8;
#pragma unroll 2
            for (int i = 0; i < 8; ++i) { const int ll = l0 + 16 * i; float acc[8];
#pragma unroll
                for (int jj = 0; jj < 8; ++jj) acc[jj] = bias[jj];
#pragma unroll
                for (int k = 0; k < 4; ++k) { const int ts = c * 128 + ll - 3 + k;
                    if (ts >= 0) { const v4u xv = *(const GAS v4u*)(PROJ + ((size_t)b * SEQ + ts) * NPROJ + O_XBC + ch);
#pragma unroll
                        for (int j = 0; j < 4; ++j) { acc[2 * j] += wk[k][2 * j] * bflo(xv[j]); acc[2 * j + 1] += wk[k][2 * j + 1] * bfhi(xv[j]); } } }
#pragma unroll
                for (int jj = 0; jj < 8; ++jj) acc[jj] = siluf(acc[jj]);
                *(LAS bf16x8*)(dst + ll * PS) = pack8(acc); }
        }
        {
            const int head = g * 8 + w; const float A = -__expf(a->in[I_SALOG][l * 16 + head]), dtb = a->in[I_SDTB][l * 16 + head];
            const int l2 = 2 * lane;
            const float dt0 = softplusf_(bf2f(PROJ[(row0 + l2) * NPROJ + O_DT + head]) + dtb), dt1 = softplusf_(bf2f(PROJ[(row0 + l2 + 1) * NPROJ + O_DT + head]) + dtb);
            const float da1 = dt1 * A; float sc = dt0 * A + da1;
#pragma unroll
            for (int o = 1; o < 64; o <<= 1) { const float t_ = __shfl_up(sc, o); if (lane >= o) sc += t_; }
            sDt[w * 128 + l2] = dt0; sDt[w * 128 + l2 + 1] = dt1;
            const size_t uh = (size_t)((b * 16 + head) * 32 + c) * 128;
            float* AC = (float*)(a->ws + WS_SSD_AC) + uh; float* DT = (float*)(a->ws + WS_SSD_DT) + uh;
            AC[l2] = sc - da1; AC[l2 + 1] = sc; DT[l2] = dt0; DT[l2 + 1] = dt1;
        }
        __syncthreads();
#pragma unroll
        for (int st = 0; st < 8; ++st) {
            f32x4 acc = {0.f, 0.f, 0.f, 0.f};
            if (st <= w) {
#pragma unroll
                for (int ks = 0; ks < 4; ++ks) acc = mfma16(lds_frag(sB, 16 * st, PS, 32 * ks, lane), lds_frag(sC, 16 * w, PS, 32 * ks, lane), acc); }
            *(GAS unsigned long long*)(CBg + (16 * w + r) * 128 + 16 * st + 4 * q4) = pack4(acc);
        }
        for (int p = tid; p < 2048; p += NTHR) { const int ll = p >> 4, n8 = (p & 15) * 8; *(GAS v4u*)(Cg + ll * 128 + n8) = *(const LAS v4u*)(sC + ll * PS + n8); }
        for (int p = tid; p < 2048; p += NTHR) { const int n = p >> 4, l8 = (p & 15) * 8; v4u o;
#pragma unroll
            for (int j = 0; j < 4; ++j) o[j] = (unsigned)sB[(l8 + 2 * j) * PS + n] | ((unsigned)sB[(l8 + 2 * j + 1) * PS + n] << 16);
            *(GAS v4u*)(BTg + n * 128 + l8) = o; }
#pragma unroll 1
        for (int hf = 0; hf < 2; ++hf) {
            __syncthreads();
            {   const int cg = tid & 31, l0 = tid >> 5, chl = cg * 8, ch = g * 512 + hf * 256 + chl, hh = hf * 4 + (cg >> 3);
                float wk[4][8], bias[8];
#pragma unroll
                for (int jj = 0; jj < 8; ++jj) { bias[jj] = cb[ch + jj];
#pragma unroll
                    for (int k = 0; k < 4; ++k) wk[k][jj] = cw[k * 1536 + ch + jj]; }
#pragma unroll 2
                for (int i = 0; i < 8; ++i) { const int ll = l0 + 16 * i; float acc[8];
#pragma unroll
                    for (int jj = 0; jj < 8; ++jj) acc[jj] = bias[jj];
#pragma unroll
                    for (int k = 0; k < 4; ++k) { const int ts = c * 128 + ll - 3 + k;
                        if (ts >= 0) { const v4u xv = *(const GAS v4u*)(PROJ + ((size_t)b * SEQ + ts) * NPROJ + O_XBC + ch);
#pragma unroll
                            for (int j = 0; j < 4; ++j) { acc[2 * j] += wk[k][2 * j] * bflo(xv[j]); acc[2 * j + 1] += wk[k][2 * j + 1] * bfhi(xv[j]); } } }
                    const float dtv = sDt[hh * 128 + ll];
#pragma unroll
                    for (int jj = 0; jj < 8; ++jj) sXT[(chl + jj) * PS + ll] = (bf16)f2bf(siluf(acc[jj]) * dtv); }
            }
            __syncthreads();
            for (int p = tid; p < 4096; p += NTHR) { const int chl = p >> 4, l8 = (p & 15) * 8, hh = hf * 4 + (chl >> 6), pp = chl & 63;
                const size_t uh = (size_t)((b * 16 + g * 8 + hh) * 32 + c);
                *(GAS v4u*)((bf16*)(a->ws + WS_SSD_XT) + (uh * 64 + pp) * 128 + l8) = *(const LAS v4u*)(sXT + chl * PS + l8); }
        }
    }
}
__device__ __forceinline__ void ssd_scan_phase(CArgs a, int l, LAS unsigned char* lds, const int b, const int head, int tid) {
    asm volatile("" : "+v"(tid));
    constexpr int PS = 136, O_S = 0, O_X = 34816, O_AC = 69632, O_TE = 70656, O_DT = 71680;
    bf16* YMIX = (bf16*)(a->ws + WS_YMIX);
    const int lane = tid & 63, w = tid >> 6, r = lane & 15, q4 = lane >> 4;
    {
        const int g = head >> 3;
        const float Dsk = a->in[I_SD][l * 16 + head];
        const bf16* Cg = (const bf16*)(a->ws + WS_SSD_C) + (size_t)((b * 32) * 2 + g) * 16384 + (16 * w + r) * 128 + 8 * q4;
        const bf16* CBg = (const bf16*)(a->ws + WS_SSD_CB) + (size_t)((b * 32) * 2 + g) * 16384 + (16 * w + r) * 128 + 8 * q4;
        const bf16* BTg = (const bf16*)(a->ws + WS_SSD_BT) + (size_t)((b * 32) * 2 + g) * 16384 + (16 * w + r) * 128 + 8 * q4;
        const size_t uh0 = (size_t)(b * 16 + head) * 32;
        const bf16* XTg = (const bf16*)(a->ws + WS_SSD_XT) + uh0 * 8192; const float* ACg = (const float*)(a->ws + WS_SSD_AC) + uh0 * 128; const float* DTg = (const float*)(a->ws + WS_SSD_DT) + uh0 * 128;
        v4u fC[4], fCB[4], fBT[4], rx[2]; float rac = 0.f, racl = 0.f, rdt = 0.f;
#define SSD_LDF(cc, dst, src) do { _Pragma("unroll") for (int ks = 0; ks < 4; ++ks) dst[ks] = *(const GAS v4u*)(src + (size_t)(cc) * 32768 + 32 * ks); } while (0)
#define SSD_LOADX(cc) do { _Pragma("unroll") for (int i = 0; i < 2; ++i) { const int p = tid + NTHR * i; rx[i] = *(const GAS v4u*)(XTg + (size_t)(cc) * 8192 + (p >> 4) * 128 + (p & 15) * 8); } \
            if (tid < 128) { rac = ACg[(cc) * 128 + tid]; racl = ACg[(cc) * 128 + 127]; rdt = DTg[(cc) * 128 + tid]; } } while (0)
#define SSD_STORE(bi) do { _Pragma("unroll") for (int i = 0; i < 2; ++i) { const int p = tid + NTHR * i; *(LAS v4u*)(lds + O_X + (bi) * 17408 + ((p >> 4) * PS + (p & 15) * 8) * 2) = rx[i]; } \
            if (tid < 128) { ((LAS float*)(lds + O_AC))[(bi) * 128 + tid] = rac; ((LAS float*)(lds + O_TE))[(bi) * 128 + tid] = __expf(racl - rac); ((LAS float*)(lds + O_DT))[(bi) * 128 + tid] = rdt; } } while (0)
        __syncthreads();
        SSD_LDF(0, fC, Cg); SSD_LDF(0, fCB, CBg); SSD_LDF(0, fBT, BTg); SSD_LOADX(0);
        for (int i = tid; i < 17408 / 4; i += NTHR) ((LAS unsigned*)(lds + O_S))[i] = 0u;
        SSD_STORE(0);
        f32x4 accS[4];
#pragma unroll
        for (int pt = 0; pt < 4; ++pt) accS[pt] = (f32x4){0.f, 0.f, 0.f, 0.f};
        __syncthreads();
        for (int c = 0; c < 32; ++c) {
            const int cur = c & 1;
            const LAS bf16* sS = (const LAS bf16*)(lds + O_S + cur * 17408); LAS bf16* sSn = (LAS bf16*)(lds + O_S + (cur ^ 1) * 17408); const LAS bf16* sXT = (const LAS bf16*)(lds + O_X + cur * 17408);
            const LAS float* sAc = (const LAS float*)(lds + O_AC) + cur * 128; const LAS float* sTe = (const LAS float*)(lds + O_TE) + cur * 128; const LAS float* sDt = (const LAS float*)(lds + O_DT) + cur * 128;
            const int cn = c + 1 < 32 ? c + 1 : c;
            SSD_LOADX(cn);
            const int lrow = 16 * w + r; const float ac_l = sAc[lrow];
            f32x4 accO[4], accD[4];
#pragma unroll
            for (int pt = 0; pt < 4; ++pt) { accO[pt] = (f32x4){0.f, 0.f, 0.f, 0.f}; accD[pt] = (f32x4){0.f, 0.f, 0.f, 0.f}; }
#pragma unroll
            for (int ks = 0; ks < 4; ++ks) { const bf16x8 yf = __builtin_bit_cast(bf16x8, fC[ks]);
#pragma unroll
                for (int pt = 0; pt < 4; ++pt) accO[pt] = mfma16(lds_frag(sS, 16 * pt, PS, 32 * ks, lane), yf, accO[pt]); }
            SSD_LDF(cn, fC, Cg);
#pragma unroll
            for (int ks = 0; ks < 4; ++ks) if (32 * ks <= 16 * w + 15) {
                float v[8]; const f32x4 a0 = *(const LAS f32x4*)(sAc + 32 * ks + 8 * q4), a1 = *(const LAS f32x4*)(sAc + 32 * ks + 8 * q4 + 4);
#pragma unroll
                for (int j = 0; j < 4; ++j) { const int s0 = 32 * ks + 8 * q4 + 2 * j; const float as0 = (2 * j < 4) ? a0[(2 * j) & 3] : a1[(2 * j) & 3], as1 = (2 * j + 1 < 4) ? a0[(2 * j + 1) & 3] : a1[(2 * j + 1) & 3];
                    v[2 * j] = (s0 <= lrow) ? bflo(fCB[ks][j]) * __expf(ac_l - as0) : 0.f; v[2 * j + 1] = (s0 + 1 <= lrow) ? bfhi(fCB[ks][j]) * __expf(ac_l - as1) : 0.f; }
                const bf16x8 yf = pack8(v);
#pragma unroll
                for (int pt = 0; pt < 4; ++pt) accD[pt] = mfma16(lds_frag(sXT, 16 * pt, PS, 32 * ks, lane), yf, accD[pt]); }
            SSD_LDF(cn, fCB, CBg);
            {   const float ea = __expf(ac_l), rdtl = Dsk / sDt[lrow];
#pragma unroll
                for (int pt = 0; pt < 4; ++pt) { f32x4 y = accO[pt] * ea + accD[pt];
#pragma unroll
                    for (int ii = 0; ii < 4; ++ii) y[ii] += rdtl * bf2f(sXT[(16 * pt + 4 * q4 + ii) * PS + lrow]);
                    *(GAS unsigned long long*)(YMIX + ((size_t)b * SEQ + c * 128 + lrow) * DMIX + head * 64 + 16 * pt + 4 * q4) = pack4(y); } }
            {   const float cd = __expf(sAc[127]);
#pragma unroll
                for (int pt = 0; pt < 4; ++pt) accS[pt] = accS[pt] * cd;
#pragma unroll
                for (int ks = 0; ks < 4; ++ks) { float v[8]; const f32x4 t0 = *(const LAS f32x4*)(sTe + 32 * ks + 8 * q4), t1 = *(const LAS f32x4*)(sTe + 32 * ks + 8 * q4 + 4);
#pragma unroll
                    for (int j = 0; j < 4; ++j) { const float ts0 = (2 * j < 4) ? t0[(2 * j) & 3] : t1[(2 * j) & 3], ts1 = (2 * j + 1 < 4) ? t0[(2 * j + 1) & 3] : t1[(2 * j + 1) & 3];
                        v[2 * j] = bflo(fBT[ks][j]) * ts0; v[2 * j + 1] = bfhi(fBT[ks][j]) * ts1; }
                    const bf16x8 xf = pack8(v);
#pragma unroll
                    for (int pt = 0; pt < 4; ++pt) accS[pt] = mfma16(xf, lds_frag(sXT, 16 * pt, PS, 32 * ks, lane), accS[pt]); }
#pragma unroll
                for (int pt = 0; pt < 4; ++pt) *(LAS unsigned long long*)(sSn + (16 * pt + r) * PS + 16 * w + 4 * q4) = pack4(accS[pt]);
            }
            SSD_LDF(cn, fBT, BTg);
            if (c + 1 < 32) SSD_STORE(cur ^ 1);
            WG_BAR();
        }
#undef SSD_LDF
#undef SSD_LOADX
#undef SSD_STORE
    }
}

__device__ __forceinline__ void gdn_prep_phase(CArgs a, int l, LAS unsigned char* lds, int wg, int G, int tid) {
    asm volatile("" : "+v"(tid));
    constexpr int PS = 136, TS = 72, MS = 68, TT = 65;
    LAS bf16* sKb = (LAS bf16*)lds; LAS bf16* sQb = sKb + 64 * PS; LAS bf16* sQG = sQb + 64 * PS; LAS bf16* sVT = sQG + 64 * PS;
    LAS float* sM = (LAS float*)(lds + 3 * 17408 + 18432); LAS float* sT = sM + 64 * MS; LAS float* sVec = sT + 64 * TT; LAS bf16* sQK = (LAS bf16*)(sVec + 256);
    const bf16* PROJ = (const bf16*)(a->ws + WS_PROJ);
    const float* cw = a->in[I_GCW] + (size_t)l * 4 * 1536;
    const int lane = tid & 63, w = tid >> 6, r = lane & 15, q4 = lane >> 4;
    for (int unit = wg; unit < 1024; unit += G) {
        const int b = unit >> 8, head = (unit >> 6) & 3, n = unit & 63;
        const size_t row0 = (size_t)b * SEQ + n * 64;
#define GK ((bf16*)(a->ws + WS_GD_K) + (size_t)unit * 8192)
#define GKT ((bf16*)(a->ws + WS_GD_KT) + (size_t)unit * 8192)
#define GQG ((bf16*)(a->ws + WS_GD_QG) + (size_t)unit * 8192)
#define GVT ((bf16*)(a->ws + WS_GD_VT) + (size_t)unit * 8192)
#define GT ((bf16*)(a->ws + WS_GD_T) + (size_t)unit * 4096)
#define GQK ((bf16*)(a->ws + WS_GD_QK) + (size_t)unit * 4096)
#define GVEC ((float*)(a->ws + WS_GD_VEC) + (size_t)unit * 256)
        __syncthreads();
        for (int i = tid; i < 64 * MS; i += NTHR) sM[i] = 0.f;
        if (w == 0) {
            const float nA = -__expf(a->in[I_GALOG][l * 4 + head]), dtb = a->in[I_GDTB][l * 4 + head];
            const size_t ro = (row0 + lane) * NPROJ;
            const float be = sigmoidf_(bf2f(PROJ[ro + O_GB + head])); float gsum = nA * softplusf_(bf2f(PROJ[ro + O_GA + head]) + dtb);
#pragma unroll
            for (int o = 1; o < 64; o <<= 1) { const float t_ = __shfl_up(gsum, o); if (lane >= o) gsum += t_; }
            const float glast = __shfl(gsum, 63), eg = __expf(gsum), cc = __expf(glast - gsum);
            sVec[lane] = gsum; sVec[64 + lane] = be; sVec[128 + lane] = eg;
            GVEC[lane] = be; GVEC[64 + lane] = eg; GVEC[128 + lane] = cc; GVEC[192 + lane] = __expf(glast);
        }
        __syncthreads();
        {
            float wq[4][2], wk_[4][2], wv[4][2];
#pragma unroll
            for (int k = 0; k < 4; ++k)
#pragma unroll
                for (int j = 0; j < 2; ++j) { wq[k][j] = cw[k * 1536 + head * 128 + 2 * lane + j]; wk_[k][j] = cw[k * 1536 + 512 + head * 128 + 2 * lane + j]; wv[k][j] = cw[k * 1536 + 1024 + head * 128 + 2 * lane + j]; }
#pragma unroll 2
            for (int i = 0; i < 8; ++i) { const int t = w + 8 * i; float q0 = 0.f, q1 = 0.f, k0 = 0.f, k1 = 0.f, v0 = 0.f, v1 = 0.f;
#pragma unroll
                for (int k = 0; k < 4; ++k) { const int ts = n * 64 + t - 3 + k;
                    if (ts >= 0) { const bf16* pr = PROJ + ((size_t)b * SEQ + ts) * NPROJ + O_QKV + head * 128 + 2 * lane;
                        const unsigned xq = *(const GAS unsigned*)pr, xk = *(const GAS unsigned*)(pr + 512), xv = *(const GAS unsigned*)(pr + 1024);
                        q0 += wq[k][0] * bflo(xq); q1 += wq[k][1] * bfhi(xq); k0 += wk_[k][0] * bflo(xk); k1 += wk_[k][1] * bfhi(xk); v0 += wv[k][0] * bflo(xv); v1 += wv[k][1] * bfhi(xv); } }
                q0 = siluf(q0); q1 = siluf(q1); k0 = siluf(k0); k1 = siluf(k1); v0 = siluf(v0); v1 = siluf(v1);
                const float sq = rsqrtf(wave_sum(q0 * q0 + q1 * q1) + 1e-6f) * 0.08838834764831845f, sk = rsqrtf(wave_sum(k0 * k0 + k1 * k1) + 1e-6f), eg = sVec[128 + t];
                *(LAS unsigned*)(sKb + t * PS + 2 * lane) = pk2(k0 * sk, k1 * sk); *(LAS unsigned*)(sQb + t * PS + 2 * lane) = pk2(q0 * sq, q1 * sq);
                *(LAS unsigned*)(sQG + t * PS + 2 * lane) = pk2(q0 * sq * eg, q1 * sq * eg);
                sVT[(2 * lane) * TS + t] = (bf16)f2bf(v0); sVT[(2 * lane + 1) * TS + t] = (bf16)f2bf(v1); }
        }
        __syncthreads();
        for (int p = w; p < 26; p += NWAVES) {
            int it, jt; bool isq;
            if (p < 10) { isq = false; it = p < 1 ? 0 : (p < 3 ? 1 : (p < 6 ? 2 : 3)); jt = p - (it * (it + 1)) / 2; } else { isq = true; it = (p - 10) >> 2; jt = (p - 10) & 3; }
            f32x4 acc = {0.f, 0.f, 0.f, 0.f};
            if (jt <= it) {
#pragma unroll
                for (int ks = 0; ks < 4; ++ks) acc = mfma16(lds_frag(sKb, 16 * jt, PS, 32 * ks, lane), lds_frag(isq ? sQb : sKb, 16 * it, PS, 32 * ks, lane), acc);
                const int i = 16 * it + r; const float gi = sVec[i], bi = sVec[64 + i];
#pragma unroll
                for (int ii = 0; ii < 4; ++ii) { const int j = 16 * jt + 4 * q4 + ii; const float dec = __expf(gi - sVec[j]);
                    acc[ii] = isq ? (j <= i ? acc[ii] * dec : 0.f) : (j < i ? acc[ii] * dec * bi : 0.f); }
            }
            if (isq) *(LAS unsigned long long*)(sQK + (16 * it + r) * TS + 16 * jt + 4 * q4) = pack4(acc);
            else *(LAS f32x4*)(sM + (16 * it + r) * MS + 16 * jt + 4 * q4) = acc;
        }
        __syncthreads();
        if (w == 0) {
            int zo = 0; asm volatile("" : "+v"(zo)); const LAS float* sMv = sM + zo;
            float U[64];
#pragma unroll
            for (int i = 0; i < 64; ++i) {
                f32x4 mr[16]; float a0 = -sMv[i * MS + lane], a1 = 0.f, a2 = 0.f, a3 = 0.f;
#pragma unroll
                for (int j4 = 0; j4 < (i + 3) / 4; ++j4) mr[j4] = *(const LAS f32x4*)(sMv + i * MS + 4 * j4);
                __builtin_amdgcn_sched_barrier(0);
#pragma unroll
                for (int j4 = 0; j4 < (i + 3) / 4; ++j4) { const f32x4 m = mr[j4];
                    if (4 * j4 + 0 < i) a0 -= m[0] * U[4 * j4 + 0]; if (4 * j4 + 1 < i) a1 -= m[1] * U[4 * j4 + 1]; if (4 * j4 + 2 < i) a2 -= m[2] * U[4 * j4 + 2]; if (4 * j4 + 3 < i) a3 -= m[3] * U[4 * j4 + 3]; }
                U[i] = (a0 + a1) + (a2 + a3); sT[i * TT + lane] = U[i]; }
        } else {
            for (int f = w - 1; f < 16; f += NWAVES - 1) { const int tile = f >> 2, ks = f & 3;
                *(GAS v4u*)(GK + f * 512 + lane * 8) = *(const LAS v4u*)(sKb + (16 * tile + r) * PS + 32 * ks + 8 * q4);
                *(GAS v4u*)(GQG + f * 512 + lane * 8) = *(const LAS v4u*)(sQG + (16 * tile + r) * PS + 32 * ks + 8 * q4); }
            for (int f = w - 1; f < 8; f += NWAVES - 1) { const int tile = f >> 1, ks = f & 1;
                *(GAS v4u*)(GQK + f * 512 + lane * 8) = *(const LAS v4u*)(sQK + (16 * tile + r) * TS + 32 * ks + 8 * q4); }
            for (int f = w - 1; f < 16; f += NWAVES - 1) { const int dt = f >> 1, ks = f & 1, d = 16 * dt + r, s0 = 32 * ks + 8 * q4; v4u o;
#pragma unroll
                for (int j = 0; j < 4; ++j) o[j] = (unsigned)sKb[(s0 + 2 * j) * PS + d] | ((unsigned)sKb[(s0 + 2 * j + 1) * PS + d] << 16);
                *(GAS v4u*)(GKT + f * 512 + lane * 8) = o; }
            for (int f = w - 1; f < 32; f += NWAVES - 1) { const int et = f >> 2, st_ = f & 3;
                *(GAS unsigned long long*)(GVT + f * 256 + lane * 4) = *(const LAS unsigned long long*)(sVT + (16 * et + r) * TS + 16 * st_ + 4 * q4); }
        }
        __syncthreads();
        { const int tile = w >> 1, ks = w & 1, t = 16 * tile + r, s0 = 32 * ks + 8 * q4; float v[8];
#pragma unroll
            for (int jj = 0; jj < 8; ++jj) v[jj] = sT[t * TT + s0 + jj] + ((s0 + jj == t) ? 1.f : 0.f);
            *(GAS bf16x8*)(GT + w * 512 + lane * 8) = pack8(v); }
    }
#undef GK
#undef GKT
#undef GQG
#undef GVT
#undef GT
#undef GQK
#undef GVEC
}
__device__ __forceinline__ void gdn_scan_phase(CArgs a, int l, LAS unsigned char* lds, const int b, const int head, const int eb, int tid) {
    asm volatile("" : "+v"(tid));
    constexpr int PS = 136, TS = 72, O_ST = 0, O_RT = 34816, O_VN = O_RT + 9216, O_VC = O_VN + 9216;
    bf16* YMIX = (bf16*)(a->ws + WS_YMIX);
    const int lane = tid & 63, w = tid >> 6, r = lane & 15, q4 = lane >> 4, st = w >> 1, eh = w & 1;
    LAS bf16* sRT = (LAS bf16*)(lds + O_RT); LAS bf16* sVN = (LAS bf16*)(lds + O_VN); LAS bf16* sVC = (LAS bf16*)(lds + O_VC);
    {
        const size_t u0 = (size_t)(b * 4 + head) * 64;
        const bf16* pK = (const bf16*)(a->ws + WS_GD_K) + u0 * 8192 + (st * 4) * 512 + lane * 8; const bf16* pQG = (const bf16*)(a->ws + WS_GD_QG) + u0 * 8192 + (st * 4) * 512 + lane * 8;
        const bf16* pT = (const bf16*)(a->ws + WS_GD_T) + u0 * 4096 + (st * 2) * 512 + lane * 8; const bf16* pQK = (const bf16*)(a->ws + WS_GD_QK) + u0 * 4096 + (st * 2) * 512 + lane * 8;
        const bf16* pKT = (const bf16*)(a->ws + WS_GD_KT) + u0 * 8192 + (w * 2) * 512 + lane * 8;
        const bf16* pVT = (const bf16*)(a->ws + WS_GD_VT) + u0 * 8192 + (size_t)(((eb * 4 + 2 * eh) * 4 + st) * 256) + lane * 4;
        const float* pVec = (const float*)(a->ws + WS_GD_VEC) + u0 * 256 + 16 * st + 4 * q4;
        v4u xK[4], xT[2], yQG[4], yQK[2], xKT[2], nQG[4], nQK[2]; unsigned long long vT[2]; f32x4 be4, eg4, c4; float gl;
#define GD_LD_A(nn) do { _Pragma("unroll") for (int ks = 0; ks < 4; ++ks) xK[ks] = *(const GAS v4u*)(pK + (size_t)(nn) * 8192 + 512 * ks); \
            _Pragma("unroll") for (int j = 0; j < 2; ++j) vT[j] = *(const GAS unsigned long long*)(pVT + (size_t)(nn) * 8192 + j * 1024); \
            be4 = *(const GAS f32x4*)(pVec + (size_t)(nn) * 256); eg4 = *(const GAS f32x4*)(pVec + (size_t)(nn) * 256 + 64); } while (0)
#define GD_LD_B(nn) do { _Pragma("unroll") for (int ks = 0; ks < 2; ++ks) xT[ks] = *(const GAS v4u*)(pT + (size_t)(nn) * 4096 + 512 * ks); c4 = *(const GAS f32x4*)(pVec + (size_t)(nn) * 256 + 128); } while (0)
#define GD_LD_C(nn, QG_, QK_) do { _Pragma("unroll") for (int ks = 0; ks < 4; ++ks) QG_[ks] = *(const GAS v4u*)(pQG + (size_t)(nn) * 8192 + 512 * ks); \
            _Pragma("unroll") for (int ks = 0; ks < 2; ++ks) QK_[ks] = *(const GAS v4u*)(pQK + (size_t)(nn) * 4096 + 512 * ks); } while (0)
#define GD_LD_D(nn) do { _Pragma("unroll") for (int ks = 0; ks < 2; ++ks) xKT[ks] = *(const GAS v4u*)(pKT + (size_t)(nn) * 8192 + 512 * ks); gl = pVec[(size_t)(nn) * 256 + 192 - (16 * st + 4 * q4)]; } while (0)
        __syncthreads();
        GD_LD_A(0); GD_LD_B(0); GD_LD_C(0, yQG, yQK); GD_LD_D(0);
        for (int i = tid; i < 17408 / 4; i += NTHR) ((LAS unsigned*)(lds + O_ST))[i] = 0u;
        f32x4 accS[4];
#pragma unroll
        for (int et = 0; et < 4; ++et) accS[et] = (f32x4){0.f, 0.f, 0.f, 0.f};
        __syncthreads();
        for (int n = 0; n < 64; ++n) {
            const int cur = n & 1; const LAS bf16* sST = (const LAS bf16*)(lds + O_ST + cur * 17408); LAS bf16* sSTn = (LAS bf16*)(lds + O_ST + (cur ^ 1) * 17408);
            const int nn = n + 1 < 64 ? n + 1 : n;
            {
                bf16x8 fs[2][4];
#pragma unroll
                for (int j = 0; j < 2; ++j)
#pragma unroll
                    for (int ks = 0; ks < 4; ++ks) fs[j][ks] = lds_frag(sST, 16 * (2 * eh + j), PS, 32 * ks, lane);
                __builtin_amdgcn_sched_barrier(0);
#pragma unroll
                for (int j = 0; j < 2; ++j) { const int e0 = 16 * (2 * eh + j); f32x4 acc = {0.f, 0.f, 0.f, 0.f};
#pragma unroll
                    for (int ks = 0; ks < 4; ++ks) acc = mfma16(__builtin_bit_cast(bf16x8, xK[ks]), fs[j][ks], acc);
                    const unsigned vlo = (unsigned)vT[j], vhi = (unsigned)(vT[j] >> 32); f32x4 rr;
                    rr[0] = be4[0] * (bflo(vlo) - eg4[0] * acc[0]); rr[1] = be4[1] * (bfhi(vlo) - eg4[1] * acc[1]); rr[2] = be4[2] * (bflo(vhi) - eg4[2] * acc[2]); rr[3] = be4[3] * (bfhi(vhi) - eg4[3] * acc[3]);
                    *(LAS unsigned long long*)(sRT + (e0 + r) * TS + 16 * st + 4 * q4) = pack4(rr); }
            }
            GD_LD_A(nn); GD_LD_C(nn, nQG, nQK);
            WG_BAR();
            {
                bf16x8 fr[2][2];
#pragma unroll
                for (int j = 0; j < 2; ++j)
#pragma unroll
                    for (int ks = 0; ks < 2; ++ks) fr[j][ks] = lds_frag(sRT, 16 * (2 * eh + j), TS, 32 * ks, lane);
                __builtin_amdgcn_sched_barrier(0);
#pragma unroll
                for (int j = 0; j < 2; ++j) { const int e0 = 16 * (2 * eh + j); f32x4 acc = {0.f, 0.f, 0.f, 0.f};
#pragma unroll
                    for (int ks = 0; ks < 2; ++ks) acc = mfma16(__builtin_bit_cast(bf16x8, xT[ks]), fr[j][ks], acc);
                    *(LAS unsigned long long*)(sVN + (e0 + r) * TS + 16 * st + 4 * q4) = pack4(acc); *(LAS unsigned long long*)(sVC + (e0 + r) * TS + 16 * st + 4 * q4) = pack4(acc * c4); }
            }
            GD_LD_B(nn);
            WG_BAR();
            {
                bf16x8 fv[4][2];
#pragma unroll
                for (int et = 0; et < 4; ++et)
#pragma unroll
                    for (int ks = 0; ks < 2; ++ks) fv[et][ks] = lds_frag(sVC, 16 * et, TS, 32 * ks, lane);
                __builtin_amdgcn_sched_barrier(0);
#pragma unroll
                for (int et = 0; et < 4; ++et) { accS[et] = accS[et] * gl;
#pragma unroll
                    for (int ks = 0; ks < 2; ++ks) accS[et] = mfma16(__builtin_bit_cast(bf16x8, xKT[ks]), fv[et][ks], accS[et]);
                    *(LAS unsigned long long*)(sSTn + (16 * et + r) * PS + 16 * w + 4 * q4) = pack4(accS[et]); }
            }
            GD_LD_D(nn);
            {
                bf16x8 fs[2][4], fn[2][2];
#pragma unroll
                for (int j = 0; j < 2; ++j) {
#pragma unroll
                    for (int ks = 0; ks < 4; ++ks) fs[j][ks] = lds_frag(sST, 16 * (2 * eh + j), PS, 32 * ks, lane);
#pragma unroll
                    for (int ks = 0; ks < 2; ++ks) fn[j][ks] = lds_frag(sVN, 16 * (2 * eh + j), TS, 32 * ks, lane); }
                __builtin_amdgcn_sched_barrier(0);
#pragma unroll
                for (int j = 0; j < 2; ++j) { const int e0 = 16 * (2 * eh + j); f32x4 acc = {0.f, 0.f, 0.f, 0.f};
#pragma unroll
                    for (int ks = 0; ks < 4; ++ks) acc = mfma16(fs[j][ks], __builtin_bit_cast(bf16x8, yQG[ks]), acc);
#pragma unroll
                    for (int ks = 0; ks < 2; ++ks) acc = mfma16(fn[j][ks], __builtin_bit_cast(bf16x8, yQK[ks]), acc);
                    *(GAS unsigned long long*)(YMIX + ((size_t)b * SEQ + n * 64 + 16 * st + r) * DMIX + 1024 + head * 128 + eb * 64 + e0 + 4 * q4) = pack4(acc); }
            }
#pragma unroll
            for (int ks = 0; ks < 4; ++ks) yQG[ks] = nQG[ks];
#pragma unroll
            for (int ks = 0; ks < 2; ++ks) yQK[ks] = nQK[ks];
            WG_BAR();
        }
#undef GD_LD_A
#undef GD_LD_B
#undef GD_LD_C
#undef GD_LD_D
    }
}

__device__ __forceinline__ void gdn_rec_phase(CArgs a, int l, LAS unsigned char* lds, int wg, int G, int tid) {
    asm volatile("" : "+v"(tid));
    constexpr int TB = 32;
    LAS float* sQ = (LAS float*)lds; LAS float* sK = sQ + TB * 128; LAS float* sV = sK + TB * 128; LAS float* sBe = sV + TB * 8; LAS float* sAl = sBe + TB; LAS float* sO = sAl + TB;
    const bf16* PROJ = (const bf16*)(a->ws + WS_PROJ); bf16* YMIX = (bf16*)(a->ws + WS_YMIX);
    const float* cw = a->in[I_GCW] + (size_t)l * 4 * 1536;
    const int lane = tid & 63, w = tid >> 6;
    for (int unit = wg; unit < 256; unit += G) {
        const int b = unit >> 6, head = (unit >> 4) & 3, eb = unit & 15;
        const float nA = -__expf(a->in[I_GALOG][l * 4 + head]), dtb = a->in[I_GDTB][l * 4 + head];
        float S0 = 0.f, S1 = 0.f;
        for (int t0 = 0; t0 < SEQ; t0 += TB) {
            __syncthreads();
            for (int idx = tid; idx < TB * 264; idx += NTHR) {
                const int tt = idx / 264, ci = idx % 264, t = t0 + tt;
                const int ch = ci < 128 ? head * 128 + ci : (ci < 256 ? 512 + head * 128 + (ci - 128) : 1024 + head * 128 + eb * 8 + (ci - 256));
                float acc = 0.f;
#pragma unroll
                for (int k = 0; k < 4; ++k) { const int ts = t - 3 + k; if (ts >= 0) acc += cw[k * 1536 + ch] * bf2f(PROJ[(size_t)(b * SEQ + ts) * NPROJ + O_QKV + ch]); }
                const float v = siluf(acc);
                if (ci < 128) sQ[tt * 128 + ci] = v; else if (ci < 256) sK[tt * 128 + ci - 128] = v; else sV[tt * 8 + ci - 256] = v;
            }
            if (tid < TB) { const size_t ro = (size_t)(b * SEQ + t0 + tid) * NPROJ; const float braw = bf2f(PROJ[ro + O_GB + head]), araw = bf2f(PROJ[ro + O_GA + head]);
                sBe[tid] = sigmoidf_(braw); sAl[tid] = __expf(nA * softplusf_(araw + dtb)); }
            __syncthreads();
            for (int tt = w; tt < TB; tt += NWAVES) {
                const float q0 = sQ[tt * 128 + lane], q1 = sQ[tt * 128 + 64 + lane], k0 = sK[tt * 128 + lane], k1 = sK[tt * 128 + 64 + lane];
                const float sq = rsqrtf(wave_sum(q0 * q0 + q1 * q1) + 1e-6f) * 0.08838834764831845f, sk = rsqrtf(wave_sum(k0 * k0 + k1 * k1) + 1e-6f);
                sQ[tt * 128 + lane] = q0 * sq; sQ[tt * 128 + 64 + lane] = q1 * sq; sK[tt * 128 + lane] = k0 * sk; sK[tt * 128 + 64 + lane] = k1 * sk;
            }
            __syncthreads();
#pragma unroll 2
            for (int tt = 0; tt < TB; ++tt) {
                const float k0 = sK[tt * 128 + lane], k1 = sK[tt * 128 + 64 + lane], q0 = sQ[tt * 128 + lane], q1 = sQ[tt * 128 + 64 + lane];
                const float al = sAl[tt], be = sBe[tt], v = sV[tt * 8 + w];
                const float dot = wave_sum(k0 * S0 + k1 * S1);
                const float vn = be * (v - al * dot);
                S0 = al * S0 + k0 * vn; S1 = al * S1 + k1 * vn;
                const float od = wave_sum(q0 * S0 + q1 * S1);
                if (lane == 0) sO[tt * 8 + w] = od;
            }
            __syncthreads();
            if (tid < TB * 8) { const int tt = tid >> 3, i = tid & 7; YMIX[(size_t)(b * SEQ + t0 + tt) * DMIX + 1024 + head * 128 + eb * 8 + i] = (bf16)f2bf(sO[tid]); }
        }
    }
}

__device__ __forceinline__ void hgrn_rec_phase(CArgs a, int l, LAS unsigned char* lds, int wg, int G, int tid) {
    asm volatile("" : "+v"(tid));
    constexpr int TB = 32;
    LAS float* sQ = (LAS float*)lds; LAS float* sF = sQ + TB * 128; LAS float* sV = sF + TB * 128; LAS float* sO = sV + TB * 8; LAS float* sLb = sO + TB * 8;
    const bf16* PROJ = (const bf16*)(a->ws + WS_PROJ); bf16* YMIX = (bf16*)(a->ws + WS_YMIX);
    const int lane = tid & 63, w = tid >> 6;
    for (int unit = wg; unit < 256; unit += G) {
        const int b = unit >> 6, head = (unit >> 4) & 3, eb = unit & 15;
        __syncthreads();
        if (tid < 128) {
            const int c = head * 128 + tid; float lg[DEPTH], mx = -1e30f;
#pragma unroll
            for (int j = 0; j < DEPTH; ++j) { lg[j] = a->in[I_HLB][j * 512 + c]; mx = fmaxf(mx, lg[j]); }
            float den = 0.f, num = 0.f;
#pragma unroll
            for (int j = 0; j < DEPTH; ++j) { const float e = __expf(lg[j] - mx); den += e; if (j >= 1 && j <= l) num += e; }
            sLb[tid] = num / den;
        }
        float S0 = 0.f, S1 = 0.f;
        for (int t0 = 0; t0 < SEQ; t0 += TB) {
            __syncthreads();
            for (int idx = tid; idx < TB * 264; idx += NTHR) {
                const int tt = idx / 264, ci = idx % 264; const size_t ro = (size_t)(b * SEQ + t0 + tt) * NPROJ;
                if (ci < 128) sQ[tt * 128 + ci] = siluf(bf2f(PROJ[ro + O_HQ + head * 128 + ci]));
                else if (ci < 256) { const int d = ci - 128; const float lb = sLb[d]; sF[tt * 128 + d] = lb + (1.f - lb) * sigmoidf_(bf2f(PROJ[ro + O_HF + head * 128 + d])); }
                else sV[tt * 8 + ci - 256] = bf2f(PROJ[ro + O_HI + head * 128 + eb * 8 + (ci - 256)]);
            }
            __syncthreads();
#pragma unroll 2
            for (int tt = 0; tt < TB; ++tt) {
                const float f0 = sF[tt * 128 + lane], f1 = sF[tt * 128 + 64 + lane], q0 = sQ[tt * 128 + lane], q1 = sQ[tt * 128 + 64 + lane], v = sV[tt * 8 + w];
                S0 = f0 * S0 + (1.f - f0) * v; S1 = f1 * S1 + (1.f - f1) * v;
                const float od = wave_sum(q0 * S0 + q1 * S1);
                if (lane == 0) sO[tt * 8 + w] = od;
            }
            __syncthreads();
            if (tid < TB * 8) { const int tt = tid >> 3, i = tid & 7; YMIX[(size_t)(b * SEQ + t0 + tt) * DMIX + 1536 + head * 128 + eb * 8 + i] = (bf16)f2bf(sO[tid]); }
        }
    }
}

__device__ __forceinline__ void mix_post_phase(CArgs a, int l, int wg, int G, int tid) {
    asm volatile("" : "+v"(tid));
    const bf16* PROJ = (const bf16*)(a->ws + WS_PROJ); bf16* YMIX = (bf16*)(a->ws + WS_YMIX);
    const int lane = tid & 63, gw = wg * NWAVES + (tid >> 6), NGW = G * NWAVES;
    const float* snw = a->in[I_SNW] + l * 1024; const float* gnw = a->in[I_GNW] + l * 128; const float* hnw = a->in[I_HNW] + l * 128;
    for (int row = gw; row < M; row += NGW) {
        const bf16* pr = PROJ + (size_t)row * NPROJ; bf16* yr = YMIX + (size_t)row * DMIX;
#pragma unroll
        for (int j = 0; j < 2; ++j) {
            const int ch = j * 512 + lane * 8; const v4u yv = *(const GAS v4u*)(yr + ch), zv = *(const GAS v4u*)(pr + O_Z + ch);
            float v[8]; float ss = 0.f;
#pragma unroll
            for (int i = 0; i < 4; ++i) { v[2 * i] = bflo(yv[i]) * siluf(bflo(zv[i])); v[2 * i + 1] = bfhi(yv[i]) * siluf(bfhi(zv[i])); ss += v[2 * i] * v[2 * i] + v[2 * i + 1] * v[2 * i + 1]; }
            const float rstd = rsqrtf(wave_sum(ss) * (1.f / 512.f) + 1e-6f);
            v4u o;
#pragma unroll
            for (int i = 0; i < 4; ++i) o[i] = pk2(v[2 * i] * rstd * snw[ch + 2 * i], v[2 * i + 1] * rstd * snw[ch + 2 * i + 1]);
            *(GAS v4u*)(yr + ch) = o;
        }
#pragma unroll
        for (int part = 0; part < 2; ++part) {
            const int ch = lane * 8, yo = 1024 + part * 512 + ch, go = (part == 0 ? O_GG : O_HG) + ch; const float* nw = part == 0 ? gnw : hnw;
            const v4u yv = *(const GAS v4u*)(yr + yo), gv = *(const GAS v4u*)(pr + go);
            float v[8]; float ss = 0.f;
#pragma unroll
            for (int i = 0; i < 4; ++i) { v[2 * i] = bflo(yv[i]); v[2 * i + 1] = bfhi(yv[i]); ss += v[2 * i] * v[2 * i] + v[2 * i + 1] * v[2 * i + 1]; }
            ss += __shfl_xor(ss, 1); ss += __shfl_xor(ss, 2); ss += __shfl_xor(ss, 4); ss += __shfl_xor(ss, 8);
            const float rstd = rsqrtf(ss * (1.f / 128.f) + 1e-6f);
            v4u o;
#pragma unroll
            for (int i = 0; i < 4; ++i) { const int c = (ch & 127) + 2 * i; o[i] = pk2(v[2 * i] * rstd * nw[c] * siluf(bflo(gv[i])), v[2 * i + 1] * rstd * nw[c + 1] * siluf(bfhi(gv[i]))); }
            *(GAS v4u*)(yr + yo) = o;
        }
    }
}

__device__ __forceinline__ void moe_tables(const gu32* cnt, LAS unsigned char* lds, int tid) {
    LAS int* tab = (LAS int*)(lds + LDS_OFF_TAB);
    __syncthreads();
    if (tid == 0) { int p = 0, q = 0;
        for (int e = 0; e < 16; ++e) { const int c = (int)__hip_atomic_load(cnt + e, RLX_AGENT); tab[e] = p; tab[17 + e] = q; p += (c + 255) & ~255; q += c; }
        tab[16] = p; tab[33] = q; }
    __syncthreads();
}
template <bool ROUTER>
__device__ __forceinline__ void ln_phase(CArgs a, int l, const float* gam, const float* bet, LAS unsigned char* lds, int wg, int G, int tid) {
    asm volatile("" : "+v"(tid));
    const int lane = tid & 63, wave = tid >> 6, gw = wg * NWAVES + wave, NGW = G * NWAVES;
    const float* ADD = (const float*)(a->ws + WS_MIX); float* H = a->out; bf16* HB = (bf16*)(a->ws + WS_HB);
    gu32* cnt = (gu32*)(a->ws + WS_CTL) + CW_CNT + l * 16;
    LAS float* sW = (LAS float*)lds;
    LAS float* sL = sW + 20 * D + wave * 32;
    LAS int* sCnt = (LAS int*)(sW + 20 * D + 256);
    LAS unsigned* sEnt = (LAS unsigned*)(sCnt + 32);
    constexpr int MAXENT = 2 * NWAVES * 8;
    if (ROUTER) {
        __syncthreads();
        const float* wrg = a->in[I_WRG] + (size_t)l * D * 4; const float* wre = a->in[I_WRE] + (size_t)l * D * 16;
        for (int i = tid; i < D * 20; i += NTHR) { const int c = i >> 10, k = i & 1023; sW[i] = c < 4 ? wrg[k * 4 + c] : wre[k * 16 + c - 4]; }
        if (tid < 32) sCnt[tid] = 0;
        __syncthreads();
    } else moe_tables(cnt, lds, tid);
    const LAS int* tab = (const LAS int*)(lds + LDS_OFF_TAB);
    f32x4 gv[4], bv[4];
#pragma unroll
    for (int j = 0; j < 4; ++j) { gv[j] = *(const f32x4*)(gam + 4 * lane + 256 * j); bv[j] = *(const f32x4*)(bet + 4 * lane + 256 * j); }
    int kk = 0;
    for (int row = gw; row < M; row += NGW, ++kk) {
        f32x4 v[4]; float s = 0.f;
        if (ROUTER) {
#pragma unroll
            for (int j = 0; j < 4; ++j) { const f32x4 hv = *(const GAS f32x4*)(H + (size_t)row * D + 4 * lane + 256 * j), av = *(const GAS f32x4*)(ADD + (size_t)row * D + 4 * lane + 256 * j);
                v[j] = hv * DN_ALPHA + av; s += (v[j].x + v[j].y) + (v[j].z + v[j].w); }
        } else {
            const unsigned s0 = ((const GAS unsigned*)(a->ws + WS_SLOT))[2 * row], s1 = ((const GAS unsigned*)(a->ws + WS_SLOT))[2 * row + 1];
            const bf16* y0 = (const bf16*)(a->ws + WS_YS) + (size_t)(tab[s0 >> 16] + (int)(s0 & 0xffffu)) * D; const bf16* y1 = (const bf16*)(a->ws + WS_YS) + (size_t)(tab[s1 >> 16] + (int)(s1 & 0xffffu)) * D;
#pragma unroll
            for (int j = 0; j < 4; ++j) { const f32x4 hv = *(const GAS f32x4*)(H + (size_t)row * D + 4 * lane + 256 * j);
                const unsigned long long p0 = *(const GAS unsigned long long*)(y0 + 4 * lane + 256 * j), p1 = *(const GAS unsigned long long*)(y1 + 4 * lane + 256 * j);
                f32x4 av; av.x = bflo((unsigned)p0) + bflo((unsigned)p1); av.y = bfhi((unsigned)p0) + bfhi((unsigned)p1); av.z = bflo((unsigned)(p0 >> 32)) + bflo((unsigned)(p1 >> 32)); av.w = bfhi((unsigned)(p0 >> 32)) + bfhi((unsigned)(p1 >> 32));
                v[j] = hv * DN_ALPHA + av; s += (v[j].x + v[j].y) + (v[j].z + v[j].w); }
        }
        const float mean = wave_sum(s) * (1.f / D); float s2 = 0.f;
#pragma unroll
        for (int j = 0; j < 4; ++j) { v[j] = v[j] - mean; s2 += (v[j].x * v[j].x + v[j].y * v[j].y) + (v[j].z * v[j].z + v[j].w * v[j].w); }
        const float rstd = rsqrtf(wave_sum(s2) * (1.f / D) + LN_EPS);
#pragma unroll
        for (int j = 0; j < 4; ++j) { v[j] = v[j] * rstd * gv[j] + bv[j];
            *(GAS f32x4*)(H + (size_t)row * D + 4 * lane + 256 * j) = v[j];
            *(GAS unsigned long long*)(HB + (size_t)row * D + 4 * lane + 256 * j) = (unsigned long long)pk2(v[j].x, v[j].y) | ((unsigned long long)pk2(v[j].z, v[j].w) << 32); }
        if (ROUTER) {
            float lg[20];
#pragma unroll 1
            for (int c = 0; c < 20; ++c) { float p = 0.f;
#pragma unroll
                for (int j = 0; j < 4; ++j) { const f32x4 wv = *(const LAS f32x4*)(sW + c * D + 4 * lane + 256 * j); p += (v[j].x * wv.x + v[j].y * wv.y) + (v[j].z * wv.z + v[j].w * wv.w); }
                p = wave_sum(p); if (lane == 0) sL[c] = p; }
#pragma unroll
            for (int c = 0; c < 20; ++c) lg[c] = sL[c];
            float pg[4], mx = -1e30f; int gi = 0;
#pragma unroll
            for (int c = 0; c < 4; ++c) { pg[c] = lg[c] + a->in[I_BRG][l * 4 + c]; if (pg[c] > mx) { mx = pg[c]; gi = c; } }
            float den = 0.f;
#pragma unroll
            for (int c = 0; c < 4; ++c) den += __expf(pg[c] - mx);
            const float g_p = 1.0f / den;
            float le[4], emx = -1e30f; int i1 = 0;
#pragma unroll
            for (int c = 0; c < 4; ++c) { float x = 0.f;
#pragma unroll
                for (int gg = 0; gg < 4; ++gg) x = (gi == gg) ? lg[4 + gg * 4 + c] + a->in[I_BRE][l * 16 + gg * 4 + c] : x;
                le[c] = x; if (x > emx) { emx = x; i1 = c; } }
            float e2mx = -1e30f; int i2 = 0;
#pragma unroll
            for (int c = 0; c < 4; ++c) if (c != i1 && le[c] > e2mx) { e2mx = le[c]; i2 = c; }
            const float x2 = __expf(e2mx - emx), w1 = g_p / (1.0f + x2), w2 = g_p * x2 / (1.0f + x2);
            if (lane < 2) {
                const int e = gi * 4 + (lane == 0 ? i1 : i2); const float wv = lane == 0 ? w1 : w2;
                if (kk < 8) { const int lp = __hip_atomic_fetch_add(sCnt + e, 1, __ATOMIC_RELAXED, __HIP_MEMORY_SCOPE_WORKGROUP); LAS unsigned* en = sEnt + ((wave * 8 + kk) * 2 + lane) * 4;
                    en[0] = (unsigned)row; en[1] = (unsigned)e; en[2] = (unsigned)lp; en[3] = __builtin_bit_cast(unsigned, wv); }
                else { const int pos = (int)__hip_atomic_fetch_add(cnt + e, 1u, RLX_AGENT);
                    ((GAS int*)(a->ws + WS_LTOK))[e * M + pos] = row; ((GAS float*)(a->ws + WS_LW))[e * M + pos] = wv; ((GAS unsigned*)(a->ws + WS_SLOT))[2 * row + lane] = ((unsigned)e << 16) | (unsigned)pos; }
            }
        }
    }
    if (ROUTER) {
        __syncthreads();
        if (tid < 16) sCnt[16 + tid] = (int)__hip_atomic_fetch_add(cnt + tid, (unsigned)sCnt[tid], RLX_AGENT);
        __syncthreads();
        const int nk = kk < 8 ? kk : 8;
        if (tid < MAXENT) { const int wv_ = tid >> 4, k_ = (tid >> 1) & 7;
            const int rows_w = (M - (wg * NWAVES + wv_) + NGW - 1) / NGW; const int nkw = rows_w < 8 ? rows_w : 8;
            if (k_ < nkw) { const LAS unsigned* en = sEnt + tid * 4; const int e = (int)en[1], pos = sCnt[16 + e] + (int)en[2];
                ((GAS int*)(a->ws + WS_LTOK))[e * M + pos] = (int)en[0]; ((GAS unsigned*)(a->ws + WS_LW))[e * M + pos] = en[3]; ((GAS unsigned*)(a->ws + WS_SLOT))[2 * en[0] + (tid & 1)] = ((unsigned)e << 16) | (unsigned)pos; } }
        (void)nk;
    }
}
__device__ __forceinline__ void moe_gather_phase(CArgs a, int l, LAS unsigned char* lds, int wg, int G, int tid) {
    asm volatile("" : "+v"(tid));
    const int lane = tid & 63, gw = wg * NWAVES + (tid >> 6), NGW = G * NWAVES;
    moe_tables((gu32*)(a->ws + WS_CTL) + CW_CNT + l * 16, lds, tid);
    const LAS int* tab = (const LAS int*)(lds + LDS_OFF_TAB);
    const bf16* HB = (const bf16*)(a->ws + WS_HB); bf16* XS = (bf16*)(a->ws + WS_XS);
    for (int idx = gw; idx < 2 * M; idx += NGW) {
        int e = 0;
#pragma unroll
        for (int k = 1; k < 16; ++k) e += (tab[17 + k] <= idx) ? 1 : 0;
        const int pos = idx - tab[17 + e], dst = tab[e] + pos;
        const int row = ((const GAS int*)(a->ws + WS_LTOK))[e * M + pos];
        const v4u x0 = *(const GAS v4u*)(HB + (size_t)row * D + 8 * lane), x1 = *(const GAS v4u*)(HB + (size_t)row * D + 512 + 8 * lane);
        *(GAS v4u*)(XS + (size_t)dst * D + 8 * lane) = x0; *(GAS v4u*)(XS + (size_t)dst * D + 512 + 8 * lane) = x1;
        if (lane == 0) ((GAS float*)(a->ws + WS_WSORT))[dst] = ((const GAS float*)(a->ws + WS_LW))[e * M + pos];
    }
}

enum { P_IN = 0, P_PREP, P_SCAN, P_POST, P_OUT, P_LN1, P_GATHER, P_GU, P_DN, P_LN2, NPH };
constexpr int N_PHASES = 1 + DEPTH * NPH;
__global__ void __launch_bounds__(NTHR, 2) fwd(Args args) {
    extern __shared__ __attribute__((aligned(16))) unsigned char lds_raw[];
    LAS unsigned char* lds = (LAS unsigned char*)lds_raw;
    volatile LAS unsigned* MISC = (volatile LAS unsigned*)(lds + MISC_OFF);
    const int tid = threadIdx.x, G = gridDim.x, bx = blockIdx.x;
    unsigned char* ws0 = args.ws;
    gu32* ctl = (gu32*)(ws0 + WS_CTL);
    for (int u = tid; u < (LDS_BYTES - LDSCTL_OFF) / 4; u += NTHR) ((LAS unsigned*)(lds + LDSCTL_OFF))[u] = 0u;
    __syncthreads();
    const int lo = args.ph_lo, hi = args.ph_hi;
    const bool use_bar = (hi - lo) > 1;
    XcdBarrier bar; bar.bar = (unsigned*)(ctl + CW_BAR); bar.x = 0; bar.st = nullptr;
    if (use_bar) bar = xcd_barrier_post((unsigned*)(ctl + CW_BAR), MISC + 8);
#define IN(k) (lo <= (k) && (k) < hi)
#define SEAM(k) do { if (IN(k) && IN((k) + 1)) xcd_barrier(bar); } while (0)

    if (IN(0)) { p0_prologue(ARGS_HERE(), lds, bx, G, tid); weights_phase(ARGS_HERE(), 0, 1, lds, bx, G, tid); SEAM(0); }

    for (int l = 0; l < DEPTH; ++l) {
        const int base = 1 + l * NPH;
        unsigned char* ws = ws0; asm volatile("" : "+s"(ws));
        if (IN(base + P_IN)) {
            pg8::Gemm g{(const pg8::bf16_t*)(ws + WS_HB), (const pg8::bf16_t*)(ws + WS_WIN), M, NPROJ, D}; pg8::StaticOrder S; S.init(M, NPROJ, G, bx);
            pg8::EpiBf16<0> E{(pg8::bf16_t*)(ws + WS_PROJ), NPROJ, nullptr, 0, 0, 1.f};
            pg8::gemm_phase<pg8::EpiBf16<0>, pg8::StaticOrder, true, true>(lds + RING_OFF, g, S, E);
            SEAM(base + P_IN);
        }
        if (IN(base + P_PREP)) {
            hgrn_prep_phase(ARGS_HERE(), l, lds, bx, G, tid);
            ssd_prep_phase(ARGS_HERE(), l, lds, bx, G, tid);
            gdn_prep_phase(ARGS_HERE(), l, lds, bx, G, tid);
            SEAM(base + P_PREP); }
        if (IN(base + P_SCAN)) {
            if (G >= 192) {
                if (bx < 64) { const int pr = bx & 7, hh = bx >> 3; ssd_scan_phase(ARGS_HERE(), l, lds, pr >> 1, (pr & 1) * 8 + hh, tid); }
                else if (bx < 96) { const int x = (bx - 64) & 7, y = (bx - 64) >> 3, pr = x * 2 + (y >> 1); gdn_scan_phase(ARGS_HERE(), l, lds, pr >> 2, pr & 3, y & 1, tid); }
                else if (bx < 160) { const int x = (bx - 96) & 7, y = (bx - 96) >> 3, pr = x * 2 + (y >> 2); hgrn_scan_phase(ARGS_HERE(), l, lds, pr >> 2, pr & 3, y & 3, tid); }
                else { weights_phase(ARGS_HERE(), l, 14, lds, bx - 160, G - 160, tid);
                       if (l + 1 < DEPTH) weights_phase(ARGS_HERE(), l + 1, 1, lds, bx - 160, G - 160, tid); }
            }
            SEAM(base + P_SCAN); }
        if (IN(base + P_POST)) { mix_post_phase(ARGS_HERE(), l, bx, G, tid); SEAM(base + P_POST); }
        if (IN(base + P_OUT)) {
            pg8::Gemm g{(const pg8::bf16_t*)(ws + WS_YMIX), (const pg8::bf16_t*)(ws + WS_WOUT), M, D, DMIX}; pg8::StaticOrder S; S.init(M, D, G, bx);
            pg8::EpiF32 E{(float*)(ws + WS_MIX), D};
            pg8::gemm_phase<pg8::EpiF32, pg8::StaticOrder, true, true>(lds + RING_OFF, g, S, E);
            SEAM(base + P_OUT);
        }
        if (IN(base + P_LN1)) { CArgs a_ = ARGS_HERE(); ln_phase<true>(a_, l, a_->in[I_LN1G] + l * D, a_->in[I_LN1B] + l * D, lds, bx, G, tid); SEAM(base + P_LN1); }
        if (IN(base + P_GATHER)) { moe_gather_phase(ARGS_HERE(), l, lds, bx, G, tid); SEAM(base + P_GATHER); }
        if (IN(base + P_GU)) {
            moe_tables(ctl + CW_CNT + l * 16, lds, tid);
            pg8::Gemm g{(const pg8::bf16_t*)(ws + WS_XS), (const pg8::bf16_t*)(ws + WS_WGU), MAXROWS, NGU, D}; pg8::MoeOrder<2> S{(const LAS int*)(lds + LDS_OFF_TAB), G, bx};
            pg8::EpiSwiGLUs E{(pg8::bf16_t*)(ws + WS_HS), (const float*)(ws + WS_WSORT)};
            pg8::gemm_phase<pg8::EpiSwiGLUs, pg8::MoeOrder<2>, true, true>(lds + RING_OFF, g, S, E);
            SEAM(base + P_GU);
        }
        if (IN(base + P_DN)) {
            moe_tables(ctl + CW_CNT + l * 16, lds, tid);
            pg8::Gemm g{(const pg8::bf16_t*)(ws + WS_HS), (const pg8::bf16_t*)(ws + WS_WDN), MAXROWS, NEXP * D, DEXP}; pg8::MoeOrder<4> S{(const LAS int*)(lds + LDS_OFF_TAB), G, bx};
            pg8::EpiBf16s E{(pg8::bf16_t*)(ws + WS_YS)};
            pg8::gemm_phase<pg8::EpiBf16s, pg8::MoeOrder<4>, true, true>(lds + RING_OFF, g, S, E);
            SEAM(base + P_DN);
        }
        if (IN(base + P_LN2)) { CArgs a_ = ARGS_HERE(); ln_phase<false>(a_, l, a_->in[I_LN2G] + l * D, a_->in[I_LN2B] + l * D, lds, bx, G, tid); SEAM(base + P_LN2); }
    }
#undef IN
#undef SEAM
}

#ifndef MK_ONE_LAUNCH
#define MK_ONE_LAUNCH 1
#endif
extern "C" void kernel_launch(void* const* d_in, const int* in_sizes, int n_in, void* d_out, int out_size, void* d_ws, size_t ws_size, hipStream_t stream) {
    static int grid = 0;
    if (grid == 0) {
        if (n_in != 25 || out_size != M * D || ws_size < WS_END) { fprintf(stderr, "kernel_launch: unexpected shapes (n_in %d out %d ws %zu)\n", n_in, out_size, ws_size); grid = -1; return; }
        int dev = 0, cus = 0, per_cu = 0;
        if (hipGetDevice(&dev) != hipSuccess || hipDeviceGetAttribute(&cus, hipDeviceAttributeMultiprocessorCount, dev) != hipSuccess) { grid = -1; return; }
        if (hipFuncSetAttribute((const void*)fwd, hipFuncAttributeMaxDynamicSharedMemorySize, LDS_BYTES) != hipSuccess) { fprintf(stderr, "kernel_launch: hipFuncSetAttribute failed\n"); grid = -1; return; }
        if (hipOccupancyMaxActiveBlocksPerMultiprocessor(&per_cu, (const void*)fwd, NTHR, LDS_BYTES) != hipSuccess || per_cu < 1) { fprintf(stderr, "kernel_launch: occupancy query says %d\n", per_cu); (void)hipGetLastError(); grid = -1; return; }
        grid = cus;
    }
    if (grid < 0) return;
    if (hipMemsetAsync((char*)d_ws + WS_CTL, 0, CTL_ZERO_BYTES, stream) != hipSuccess) return;
    Args a{};
    for (int i = 0; i < 25; ++i) a.in[i] = (const float*)d_in[i];
    a.out = (float*)d_out; a.ws = (unsigned char*)d_ws;
#if MK_ONE_LAUNCH
    a.ph_lo = 0; a.ph_hi = N_PHASES;
    hipLaunchKernelGGL(fwd, dim3(grid), dim3(NTHR), LDS_BYTES, stream, a);
#else
    for (int p = 0; p < N_PHASES; ++p) { a.ph_lo = p; a.ph_hi = p + 1; hipLaunchKernelGGL(fwd, dim3(grid), dim3(NTHR), LDS_BYTES, stream, a); }
#endif
}
```

```cpp
#include <hip/hip_runtime.h>
#include <cstdio>
#include <cstdint>
namespace pg8 {
#define PG8_LAS __attribute__((address_space(3)))
typedef unsigned short bf16_t;
typedef short bf16x8 __attribute__((ext_vector_type(8)));
typedef float f32x4 __attribute__((ext_vector_type(4)));
typedef unsigned u32x4 __attribute__((ext_vector_type(4)));
constexpr int BM = 256, BK = 64, HALF = 128, HTB = HALF * BK * 2  , STAGE_BYTES = 8 * HTB, NXCD = 8, WGM = 8;

__host__ __device__ __forceinline__ int lds_byte(int r, int c) { const int st = (r >> 4) * 2 + (c >> 5), rr = r & 15, cc = c & 31, ob = rr * 64 + cc * 2; return st * 1024 + (ob ^ (((ob >> 9) & 1) << 5)); }
__host__ __device__ __forceinline__ void stage_rc(int b, int& R, int& C) { const int st = b / 1024, sb = b % 1024, swz = sb ^ (((sb >> 9) & 1) << 5); R = (st >> 1) * 16 + swz / 64; C = (st & 1) * 32 + (swz % 64) / 2; }
__host__ __device__ __forceinline__ int perm32(int rho) { const int n = rho >> 4, i = rho & 15; return 8 * (i >> 2) + 4 * n + (i & 3); }

struct Unit { int pm, pn; };
struct Gemm { const bf16_t* A; const bf16_t* Bt; int M, N, K; };

struct StaticOrder {
    int nM, nN, nwg, G, c;
    __host__ __device__ void init(int M, int N, int G_, int c_) { nM = M / BM; nN = N / BM; nwg = nM * nN; G = G_; c = c_; }
    __host__ __device__ bool next(int i, Unit& u) const {
        const long L = (long)i * G + c; if (L >= nwg) return false;
        int wgid = (int)L; { const int q = nwg / NXCD, r = nwg % NXCD, xcd = wgid % NXCD, off = wgid / NXCD; wgid = (xcd < r ? xcd * (q + 1) : r * (q + 1) + (xcd - r) * q) + off; }
        const int nig = WGM * nN, gid = wgid / nig, fm = gid * WGM, gsz = (nM - fm) < WGM ? (nM - fm) : WGM;
        u.pm = fm + ((wgid % nig) % gsz); u.pn = (wgid % nig) / gsz; return true;
    }
    __device__ __forceinline__ void a_ready(const Unit&) const {}
    __device__ __forceinline__ void done(const Unit&) const {}
};
__device__ __forceinline__ unsigned cvt_pk_bf16(float lo, float hi) { unsigned r; asm volatile("v_cvt_pk_bf16_f32 %0, %1, %2" : "=v"(r) : "v"(lo), "v"(hi)); return r; }
typedef float f32x2 __attribute__((ext_vector_type(2)));
__device__ __forceinline__ f32x2 gelu_pk(f32x2 v) {
    const f32x2 av = __builtin_elementwise_abs(v), d = av * 0.2316418882f + 1.0f;
    f32x2 t; t.x = __builtin_amdgcn_rcpf(d.x); t.y = __builtin_amdgcn_rcpf(d.y);
    f32x2 q = t * 0.5307027145f + (-0.7265760135f); q = q * t + 0.7107068705f; q = q * t + (-0.142248368f); q = q * t + 0.127414796f; q = q * t;
    const f32x2 s = (v * v) * (-0.72134752044f);
    f32x2 e; e.x = __builtin_amdgcn_exp2f(s.x); e.y = __builtin_amdgcn_exp2f(s.y);
    const f32x2 m = v * (q * e), r = v - m;
    f32x2 o; o.x = v.x < 0.f ? m.x : r.x; o.y = v.y < 0.f ? m.y : r.y; return o;
}

template <int ACT  > struct EpiBf16 {
    static constexpr bool PERM = true, AFTER_DRAIN = false; static_assert(ACT == 0 || ACT == 1, "EpiBf16: ACT is 0 (none) or 1 (gelu_pk)");
    bf16_t* O; int ldc; const float* bias; int split_cols; size_t split_stride; float scale0;
    __device__ __forceinline__ void operator()(const f32x4 (&acc)[2][2][4][2], const Unit& u, int wr, int wc, int fr, int fq) const {
        const int row0 = u.pm * BM + wr * 64 + fr; int colt = u.pn * BM; bf16_t* base = O;
        float sc = 1.f; if (split_cols) { const int t = colt / split_cols; base += (size_t)t * split_stride; colt -= t * split_cols; if (t == 0) sc = scale0; }
        const int col0 = colt + wc * 32 + 8 * fq, bcol0 = u.pn * BM + wc * 32 + 8 * fq;
        f32x4 bv[2][2];
#pragma unroll
        for (int bj = 0; bj < 2; ++bj)
#pragma unroll
            for (int n = 0; n < 2; ++n) bv[bj][n] = bias ? *(const f32x4*)(bias + bcol0 + bj * HALF + 4 * n) : (f32x4){0.f, 0.f, 0.f, 0.f};
#pragma unroll
        for (int ai = 0; ai < 2; ++ai)
#pragma unroll
            for (int m = 0; m < 4; ++m) { bf16_t* rowp = base + (size_t)(row0 + ai * HALF + m * 16) * ldc + col0;
#pragma unroll
                for (int bj = 0; bj < 2; ++bj) { f32x4 v0 = acc[ai][bj][m][0] + bv[bj][0], v1 = acc[ai][bj][m][1] + bv[bj][1];
                    if (ACT == 1) { f32x2 a = gelu_pk((f32x2){v0[0], v0[1]}), b = gelu_pk((f32x2){v0[2], v0[3]}), c = gelu_pk((f32x2){v1[0], v1[1]}), d = gelu_pk((f32x2){v1[2], v1[3]});
                        v0 = (f32x4){a.x, a.y, b.x, b.y}; v1 = (f32x4){c.x, c.y, d.x, d.y}; }
                    v0 = v0 * sc; v1 = v1 * sc; u32x4 w; w.x = cvt_pk_bf16(v0[0], v0[1]); w.y = cvt_pk_bf16(v0[2], v0[3]); w.z = cvt_pk_bf16(v1[0], v1[1]); w.w = cvt_pk_bf16(v1[2], v1[3]);
                    *(u32x4*)(rowp + bj * HALF) = w; } }
    }
};
struct EpiF32 {
    static constexpr bool PERM = false, AFTER_DRAIN = false;
    float* C; int ldc;
    __device__ __forceinline__ void operator()(const f32x4 (&acc)[2][2][4][2], const Unit& u, int wr, int wc, int fr, int fq) const {
        const int row0 = u.pm * BM + wr * 64 + fr, col0 = u.pn * BM + wc * 32 + 4 * fq;
#pragma unroll
        for (int ai = 0; ai < 2; ++ai)
#pragma unroll
            for (int m = 0; m < 4; ++m) { float* rowp = C + (size_t)(row0 + ai * HALF + m * 16) * ldc + col0;
#pragma unroll
                for (int bj = 0; bj < 2; ++bj)
#pragma unroll
                    for (int n = 0; n < 2; ++n) *(f32x4*)(rowp + bj * HALF + n * 16) = acc[ai][bj][m][n]; }
    }
};
__device__ __forceinline__ float silu_f(float x) { return x / (1.0f + __expf(-x)); }
struct EpiSwiGLU {
    static constexpr bool PERM = true, AFTER_DRAIN = false;
    bf16_t* H; int ldh; const float* comb; int ldcomb;
    __device__ __forceinline__ void operator()(const f32x4 (&acc)[2][2][4][2], const Unit& u, int wr, int wc, int fr, int fq) const {
        const int row0 = u.pm * BM + wr * 64 + fr, col0 = u.pn * 128 + wc * 32 + 8 * fq, e = u.pn >> 1;
#pragma unroll
        for (int ai = 0; ai < 2; ++ai)
#pragma unroll
            for (int m = 0; m < 4; ++m) { const int row = row0 + ai * HALF + m * 16; const float cw = comb[(size_t)row * ldcomb + e];
                const f32x4 g0 = acc[ai][0][m][0], g1 = acc[ai][0][m][1], u0 = acc[ai][1][m][0], u1 = acc[ai][1][m][1];
                f32x4 h0, h1;
#pragma unroll
                for (int j = 0; j < 4; ++j) { h0[j] = silu_f(g0[j]) * u0[j] * cw; h1[j] = silu_f(g1[j]) * u1[j] * cw; }
                u32x4 w; w.x = cvt_pk_bf16(h0[0], h0[1]); w.y = cvt_pk_bf16(h0[2], h0[3]); w.z = cvt_pk_bf16(h1[0], h1[1]); w.w = cvt_pk_bf16(h1[2], h1[3]);
                *(u32x4*)(H + (size_t)row * ldh + col0) = w; }
    }
};

template <int NSUB> struct MoeOrder {
    const PG8_LAS int* off; int G, c;
    __device__ __forceinline__ bool next(int i, Unit& u) const {
        const int L = i * G + c, x = L & 7, j = L >> 3, t = x + 8 * (j / NSUB), pnl = j % NSUB;
        if (t * 256 >= off[16]) return false;
        int e = 0;
#pragma unroll
        for (int k = 1; k < 16; ++k) e += (off[k] <= t * 256) ? 1 : 0;
        u.pm = t; u.pn = e * NSUB + pnl; return true;
    }
    __device__ __forceinline__ void a_ready(const Unit&) const {}
    __device__ __forceinline__ void done(const Unit&) const {}
};
struct EpiSwiGLUs {
    static constexpr bool PERM = true, AFTER_DRAIN = false;
    bf16_t* H; const float* wrow;
    __device__ __forceinline__ void operator()(const f32x4 (&acc)[2][2][4][2], const Unit& u, int wr, int wc, int fr, int fq) const {
        const int row0 = u.pm * BM + wr * 64 + fr, col0 = (u.pn & 1) * 128 + wc * 32 + 8 * fq;
#pragma unroll
        for (int ai = 0; ai < 2; ++ai)
#pragma unroll
            for (int m = 0; m < 4; ++m) { const int row = row0 + ai * HALF + m * 16; const float cw = wrow[row];
                const f32x4 g0 = acc[ai][0][m][0], g1 = acc[ai][0][m][1], u0 = acc[ai][1][m][0], u1 = acc[ai][1][m][1];
                f32x4 h0, h1;
#pragma unroll
                for (int j = 0; j < 4; ++j) { h0[j] = silu_f(g0[j]) * u0[j] * cw; h1[j] = silu_f(g1[j]) * u1[j] * cw; }
                u32x4 w; w.x = cvt_pk_bf16(h0[0], h0[1]); w.y = cvt_pk_bf16(h0[2], h0[3]); w.z = cvt_pk_bf16(h1[0], h1[1]); w.w = cvt_pk_bf16(h1[2], h1[3]);
                *(u32x4*)(H + (size_t)row * 256 + col0) = w; }
    }
};
struct EpiBf16s {
    static constexpr bool PERM = true, AFTER_DRAIN = false;
    bf16_t* O;
    __device__ __forceinline__ void operator()(const f32x4 (&acc)[2][2][4][2], const Unit& u, int wr, int wc, int fr, int fq) const {
        const int row0 = u.pm * BM + wr * 64 + fr, col0 = (u.pn & 3) * BM + wc * 32 + 8 * fq;
#pragma unroll
        for (int ai = 0; ai < 2; ++ai)
#pragma unroll
            for (int m = 0; m < 4; ++m) { bf16_t* rowp = O + (size_t)(row0 + ai * HALF + m * 16) * 1024 + col0;
#pragma unroll
                for (int bj = 0; bj < 2; ++bj) { const f32x4 v0 = acc[ai][bj][m][0], v1 = acc[ai][bj][m][1];
                    u32x4 w; w.x = cvt_pk_bf16(v0[0], v0[1]); w.y = cvt_pk_bf16(v0[2], v0[3]); w.z = cvt_pk_bf16(v1[0], v1[1]); w.w = cvt_pk_bf16(v1[2], v1[3]);
                    *(u32x4*)(rowp + bj * HALF) = w; } }
    }
};
template <class Epi, class Sched, bool ALIGN_EPI = false, bool SP2 = false>
__device__ __forceinline__ void gemm_phase(PG8_LAS unsigned char* lds, const Gemm g, const Sched& S, const Epi& E) {
    int tid_ = threadIdx.x; asm volatile("" : "+v"(tid_));
    const int tid = tid_, wid = __builtin_amdgcn_readfirstlane(tid >> 6), lane = tid & 63, wr = wid >> 2, wc = wid & 3, fr = lane & 15, fq = lane >> 4;
    const int K = g.K, nt = K / BK;
    unsigned voffA[2], voffB[2];
#pragma unroll
    for (int i = 0; i < 2; ++i) { int R, C; stage_rc(tid * 16 + i * 8192, R, C); const int Rb = Epi::PERM ? ((R & ~31) + perm32(R & 31)) : R;
        voffA[i] = (unsigned)(R * K + C) * 2u; voffB[i] = (unsigned)(Rb * K + C) * 2u; }
    const size_t kstep = (size_t)(BK * 2);
    const size_t hstep = (size_t)HALF * K * 2;
    const size_t tstep = 2 * hstep;
    const unsigned ldsw = (unsigned)wid * 1024u;
    const int aoff = lds_byte(wr * 64 + fr, fq * 8), boff = lds_byte(wc * 32 + fr, fq * 8);
#define PG8_SA(b, h) (((b) * 2 + (h)) * HTB)
#define PG8_SB(b, h) ((4 + (b) * 2 + (h)) * HTB)
#define PG8_STAGE(bufoff, gbase, voff) do { _Pragma("unroll") for (int _i = 0; _i < 2; ++_i) \
        __builtin_amdgcn_global_load_lds((const unsigned*)((const char*)(gbase) + (voff)[_i]), (PG8_LAS unsigned*)(lds + (bufoff) + ldsw + _i * 8192), 16, 0, 0); } while (0)
#define PG8_LDA(dst, b, h) do { _Pragma("unroll") for (int m = 0; m < 4; ++m) _Pragma("unroll") for (int k = 0; k < 2; ++k) dst[m][k] = *(const PG8_LAS bf16x8*)(lds + PG8_SA(b, h) + aoff + m * 2048 + k * 1024); } while (0)
#define PG8_LDB(dst, b, h) do { _Pragma("unroll") for (int n = 0; n < 2; ++n) _Pragma("unroll") for (int k = 0; k < 2; ++k) dst[n][k] = *(const PG8_LAS bf16x8*)(lds + PG8_SB(b, h) + boff + n * 2048 + k * 1024); } while (0)
#define PG8_MMA(ai, bj, At, Bt) do { __builtin_amdgcn_s_setprio(1); _Pragma("unroll") for (int m = 0; m < 4; ++m) _Pragma("unroll") for (int n = 0; n < 2; ++n) _Pragma("unroll") for (int k = 0; k < 2; ++k) \
        acc[ai][bj][m][n] = __builtin_amdgcn_mfma_f32_16x16x32_bf16(Bt[n][k], At[m][k], acc[ai][bj][m][n], 0, 0, 0); __builtin_amdgcn_s_setprio(0); } while (0)
#define PG8_WAIT_V(n) asm volatile("s_waitcnt vmcnt(" #n ")" ::: "memory")
#define PG8_WAIT_L(n) asm volatile("s_waitcnt lgkmcnt(" #n ")" ::: "memory")
#define PG8_BAR __builtin_amdgcn_s_barrier()
#define PG8_SCHED __builtin_amdgcn_sched_barrier(0)
    Unit cur, nxt; int ui = 0;
    if (!S.next(0, cur)) return;
    f32x4 acc[2][2][4][2];
#pragma unroll
    for (int a = 0; a < 2; ++a)
#pragma unroll
        for (int b = 0; b < 2; ++b)
#pragma unroll
            for (int m = 0; m < 4; ++m)
#pragma unroll
                for (int n = 0; n < 2; ++n) acc[a][b][m][n] = (f32x4){0.f, 0.f, 0.f, 0.f};
    bf16x8 At[4][2], B0[2][2], B1[2][2];
    const char* cA = (const char*)g.A + (size_t)cur.pm * tstep; const char* cB = (const char*)g.Bt + (size_t)cur.pn * tstep;
    S.a_ready(cur);
    if constexpr (SP2) {
        PG8_STAGE(PG8_SB(0, 0), cB, voffB); PG8_STAGE(PG8_SB(0, 1), cB + hstep, voffB); PG8_STAGE(PG8_SA(0, 0), cA, voffA); PG8_STAGE(PG8_SA(0, 1), cA + hstep, voffA);
        if (wr == 1) PG8_BAR;
        PG8_WAIT_V(2); PG8_BAR;
        PG8_STAGE(PG8_SB(1, 0), cB + kstep, voffB); PG8_STAGE(PG8_SA(1, 0), cA + kstep, voffA); PG8_STAGE(PG8_SB(1, 1), cB + hstep + kstep, voffB);
        PG8_WAIT_V(6); PG8_BAR;
    } else {
        PG8_STAGE(PG8_SB(0, 0), cB, voffB); PG8_STAGE(PG8_SA(0, 0), cA, voffA); PG8_STAGE(PG8_SB(0, 1), cB + hstep, voffB); PG8_STAGE(PG8_SA(0, 1), cA + hstep, voffA);
        if (wr == 1) PG8_BAR;
        PG8_WAIT_V(4); PG8_BAR;
        PG8_STAGE(PG8_SB(1, 0), cB + kstep, voffB); PG8_STAGE(PG8_SA(1, 0), cA + kstep, voffA); PG8_STAGE(PG8_SB(1, 1), cB + hstep + kstep, voffB);
        PG8_WAIT_V(6); PG8_BAR;
    }
    for (;;) {
        const bool has_next = S.next(ui + 1, nxt);
        const char* nA = has_next ? (const char*)g.A + (size_t)nxt.pm * tstep : cA; const char* nB = has_next ? (const char*)g.Bt + (size_t)nxt.pn * tstep : cB;
#pragma unroll 1
        for (int t = 0; t < nt; t += 2) {
            const bool last = (t == nt - 2);
            const char* a1 = cA + (size_t)(t + 1) * kstep;
            const char* a2 = last ? nA : cA + (size_t)(t + 2) * kstep; const char* b2 = last ? nB : cB + (size_t)(t + 2) * kstep;
            const char* a3 = a2 + kstep; const char* b3 = b2 + kstep;
            if (last && has_next) S.a_ready(nxt);
            if constexpr (SP2) {
            PG8_LDB(B0, 0, 0); PG8_LDB(B1, 0, 1); PG8_SCHED; PG8_LDA(At, 0, 0); PG8_STAGE(PG8_SA(1, 1), a1 + hstep, voffA);
            PG8_WAIT_V(8); PG8_WAIT_L(0); PG8_BAR; PG8_MMA(0, 0, At, B0); PG8_MMA(0, 1, At, B1); PG8_BAR; PG8_SCHED;
            PG8_LDA(At, 0, 1); PG8_STAGE(PG8_SB(0, 0), b2, voffB); PG8_STAGE(PG8_SB(0, 1), b2 + hstep, voffB); PG8_STAGE(PG8_SA(0, 0), a2, voffA);
            PG8_WAIT_V(8); PG8_WAIT_L(0); PG8_BAR; PG8_MMA(1, 0, At, B0); PG8_MMA(1, 1, At, B1); PG8_BAR; PG8_SCHED;
            PG8_LDB(B0, 1, 0); PG8_LDB(B1, 1, 1); PG8_SCHED; PG8_LDA(At, 1, 0); PG8_STAGE(PG8_SA(0, 1), a2 + hstep, voffA);
            PG8_WAIT_V(8); PG8_WAIT_L(0); PG8_BAR; PG8_MMA(0, 0, At, B0); PG8_MMA(0, 1, At, B1); PG8_BAR; PG8_SCHED;
            PG8_LDA(At, 1, 1); PG8_STAGE(PG8_SB(1, 0), b3, voffB); PG8_STAGE(PG8_SB(1, 1), b3 + hstep, voffB); PG8_STAGE(PG8_SA(1, 0), a3, voffA);
            PG8_WAIT_V(8); PG8_WAIT_L(0); PG8_BAR; PG8_MMA(1, 0, At, B0); PG8_MMA(1, 1, At, B1); PG8_BAR; PG8_SCHED;
            } else {
            PG8_LDB(B0, 0, 0); PG8_SCHED; PG8_LDA(At, 0, 0); PG8_STAGE(PG8_SA(1, 1), a1 + hstep, voffA);
            PG8_WAIT_L(8); PG8_BAR; PG8_WAIT_L(0); PG8_MMA(0, 0, At, B0); PG8_BAR; PG8_SCHED;
            PG8_LDB(B1, 0, 1); PG8_STAGE(PG8_SB(0, 0), b2, voffB);
            PG8_BAR; PG8_WAIT_L(0); PG8_MMA(0, 1, At, B1); PG8_BAR;
            PG8_LDA(At, 0, 1); PG8_STAGE(PG8_SA(0, 0), a2, voffA);
            PG8_BAR; PG8_WAIT_L(0); PG8_MMA(1, 0, At, B0); PG8_BAR; PG8_SCHED;
            PG8_STAGE(PG8_SB(0, 1), b2 + hstep, voffB);
            PG8_WAIT_V(6); PG8_BAR; PG8_MMA(1, 1, At, B1); PG8_BAR;
            PG8_LDB(B0, 1, 0); PG8_SCHED; PG8_LDA(At, 1, 0); PG8_STAGE(PG8_SA(0, 1), a2 + hstep, voffA);
            PG8_WAIT_L(8); PG8_BAR; PG8_WAIT_L(0); PG8_MMA(0, 0, At, B0); PG8_BAR; PG8_SCHED;
            PG8_LDB(B1, 1, 1); PG8_STAGE(PG8_SB(1, 0), b3, voffB);
            PG8_BAR; PG8_WAIT_L(0); PG8_MMA(0, 1, At, B1); PG8_BAR;
            PG8_LDA(At, 1, 1); PG8_STAGE(PG8_SA(1, 0), a3, voffA);
            PG8_BAR; PG8_WAIT_L(0); PG8_MMA(1, 0, At, B0); PG8_BAR; PG8_SCHED;
            PG8_STAGE(PG8_SB(1, 1), b3 + hstep, voffB);
            PG8_WAIT_V(6); PG8_BAR; PG8_MMA(1, 1, At, B1); PG8_BAR;
            }
        }
        if constexpr (ALIGN_EPI) { if (wr == 0) PG8_BAR; }
        if constexpr (!Epi::AFTER_DRAIN) { E(acc, cur, wr, wc, fr, fq); S.done(cur); }
        if (!has_next) break;
#pragma unroll
        for (int a = 0; a < 2; ++a)
#pragma unroll
            for (int b = 0; b < 2; ++b)
#pragma unroll
                for (int m = 0; m < 4; ++m)
#pragma unroll
                    for (int n = 0; n < 2; ++n) acc[a][b][m][n] = (f32x4){0.f, 0.f, 0.f, 0.f};
        cur = nxt; cA = nA; cB = nB; ++ui;
        if constexpr (ALIGN_EPI) { if (wr == 1) PG8_BAR; }
    }
    PG8_WAIT_V(0);
    if constexpr (!ALIGN_EPI) { if (wr == 0) PG8_BAR; }
    PG8_BAR;
    if constexpr (Epi::AFTER_DRAIN) { E.fused(acc, cur, wr, wc, fr, fq, lds, wid, lane); S.done(cur); }
#undef PG8_SA
#undef PG8_SB
#undef PG8_STAGE
#undef PG8_LDA
#undef PG8_LDB
#undef PG8_MMA
#undef PG8_WAIT_V
#undef PG8_WAIT_L
#undef PG8_BAR
#undef PG8_SCHED
}
}
#define GAS __attribute__((address_space(1)))
#define LAS __attribute__((address_space(3)))
typedef unsigned short bf16;
typedef unsigned v4u __attribute__((ext_vector_type(4)));
typedef float f32x4 __attribute__((ext_vector_type(4)));
typedef short bf16x8 __attribute__((ext_vector_type(8)));
typedef GAS unsigned gu32;
typedef GAS unsigned long long gu64;
#define RLX_AGENT __ATOMIC_RELAXED, __HIP_MEMORY_SCOPE_AGENT
#define LDS_WAIT() asm volatile("s_waitcnt lgkmcnt(0)" ::: "memory")
#define VM_WAIT() asm volatile("s_waitcnt vmcnt(0)" ::: "memory")
__device__ __forceinline__ unsigned long long rt() { return __builtin_amdgcn_s_memrealtime(); }
__device__ __forceinline__ unsigned f2bf(float f) { unsigned u = __builtin_bit_cast(unsigned, f); return (u + 0x7fffu + ((u >> 16) & 1u)) >> 16; }
__device__ __forceinline__ unsigned pk2(float lo, float hi) { return f2bf(lo) | (f2bf(hi) << 16); }

#define XB_TMO      128
#define XB_XCNT(j)  (256  + 64 * (j))
#define XB_XSUB(j)  (1280 + 64 * (j))
#define XB_XGEN(j)  (2304 + 64 * (j))
#define XB_TOP      3328
#define XB_TOPGEN   3392
#define XCD_BAR_WORDS 3456
#define XB_SPIN_CAP (1u << 18)

__device__ __forceinline__ unsigned xb_ld(unsigned* p)              { return __hip_atomic_load(p, __ATOMIC_RELAXED, __HIP_MEMORY_SCOPE_AGENT); }
__device__ __forceinline__ unsigned xb_add(unsigned* p, unsigned v) { return __hip_atomic_fetch_add(p, v, __ATOMIC_RELAXED, __HIP_MEMORY_SCOPE_AGENT); }
__device__ __forceinline__ unsigned xb_xcc_id() { return (unsigned)__builtin_amdgcn_s_getreg((3 << 11) | 20) & 0xFu; }
#define XB_SPIN(cond, bar) do { unsigned _sp = 0; while (cond) { __builtin_amdgcn_s_sleep(1); \
    if ((++_sp & 255u) == 0u) { if (xb_ld(&(bar)[XB_TMO])) break; if (_sp > XB_SPIN_CAP) { atomicAdd(&(bar)[XB_TMO], 1u); break; } } } } while (0)

struct XcdBarrier {
    unsigned* bar; unsigned x;
    volatile LAS unsigned* st;
};

__device__ __forceinline__ XcdBarrier xcd_barrier_post(unsigned* bar, volatile LAS unsigned* st) {
    XcdBarrier b; b.bar = bar; b.x = xb_xcc_id(); b.st = st;
    if (threadIdx.x == 0) (void)xb_add(&bar[XB_XCNT(b.x)], 1u);
    return b;
}
__device__ __forceinline__ void xcd_barrier_complete(unsigned* bar, unsigned x, unsigned& nloc, unsigned& nx) {
    const unsigned G = gridDim.x * gridDim.y * gridDim.z;
    unsigned sum, cnt, mine, sp = 0u;
    for (;;) {
        sum = 0u; cnt = 0u; mine = 0u;
#pragma unroll
        for (unsigned j = 0; j < 16; ++j) { const unsigned c = xb_ld(&bar[XB_XCNT(j)]); sum += c; cnt += (c > 0u) ? 1u : 0u; mine = (j == x) ? c : mine; }
        if (sum == G) break;
        __builtin_amdgcn_s_sleep(1);
        if ((++sp & 255u) == 0u) { if (xb_ld(&bar[XB_TMO])) break; if (sp > XB_SPIN_CAP) { atomicAdd(&bar[XB_TMO], 1u); break; } }
    }
    nloc = mine > 0u ? mine : 1u; nx = cnt > 0u ? cnt : 1u;
}

__device__ __forceinline__ void xcd_barrier(const XcdBarrier& b) {
    asm volatile("s_waitcnt vmcnt(0)" ::: "memory");
    __syncthreads();
    if (threadIdx.x == 0) {
        unsigned* bar = b.bar;
        __builtin_amdgcn_s_waitcnt(0);
        unsigned nloc = b.st[0], nx = b.st[1];
        if (nloc == 0u) { xcd_barrier_complete(bar, b.x, nloc, nx); b.st[0] = nloc; b.st[1] = nx; }
        const unsigned old = xb_add(&bar[XB_XSUB(b.x)], 1u);
        const unsigned gen = old / nloc;
        if (old + 1u == (gen + 1u) * nloc) {
            __builtin_amdgcn_fence(__ATOMIC_RELEASE, "agent");
            asm volatile("s_waitcnt vmcnt(0)" ::: "memory");
            const unsigned og = xb_add(&bar[XB_TOP], 1u);
            const unsigned tg = og / nx;
            if (og + 1u == (tg + 1u) * nx) xb_add(&bar[XB_TOPGEN], 1u);
            else XB_SPIN(xb_ld(&bar[XB_TOPGEN]) == tg, bar);
            __builtin_amdgcn_fence(__ATOMIC_ACQUIRE, "agent");
            xb_add(&bar[XB_XGEN(b.x)], 1u);
            asm volatile("s_waitcnt vmcnt(0)" ::: "memory");
        } else {
            XB_SPIN(xb_ld(&bar[XB_XGEN(b.x)]) == gen, bar);
            __builtin_amdgcn_fence(__ATOMIC_ACQUIRE, "agent");
            asm volatile("s_waitcnt vmcnt(0)" ::: "memory");
        }
    }
    __syncthreads();
}
constexpr int NWAVES = 8, NTHR = NWAVES * 64;
constexpr int D = 1024, BATCH = 4, SEQ = 4096, M = BATCH * SEQ, DEPTH = 4;
constexpr int IN_COLS = 6680, NPROJ = 6912;
constexpr int O_Z = 0, O_XBC = 1024, O_DT = 2560, O_QKV = 2576, O_GG = 4112, O_GB = 4624, O_GA = 4628, O_HQ = 4632, O_HF = 5144, O_HI = 5656, O_HG = 6168;
constexpr int DMIX = 2048, NEXP = 16, DEXP = 256, NGU = NEXP * 2 * DEXP  , KDN = NEXP * DEXP  ;
constexpr float DN_ALPHA = 1.6817928305074290f;
constexpr float LN_EPS = 1e-5f;

constexpr size_t MiB = 1u << 20;
constexpr size_t WS_CTL = 0, CTL_ZERO_BYTES = 1 * MiB;
constexpr size_t WS_LTOK = 2 * MiB;
constexpr size_t WS_LW = 3 * MiB;
constexpr size_t WS_SLOT = 4 * MiB;
constexpr size_t WS_WSORT = 5 * MiB;
constexpr size_t WS_WIN = 8 * MiB;
constexpr size_t WS_WOUT = 22 * MiB;
constexpr size_t WS_WGU = 26 * MiB;
constexpr size_t WS_WDN = 42 * MiB;
constexpr size_t WS_YMIX = 52 * MiB;
constexpr size_t WS_HB = WS_YMIX;
constexpr size_t WS_PROJ = 116 * MiB;
constexpr size_t WS_MIX = WS_PROJ;
constexpr int MAXROWS = 2 * M + 16 * 256;
constexpr size_t WS_XS = WS_PROJ + 64 * MiB;
constexpr size_t WS_HS = WS_PROJ + 136 * MiB;
constexpr size_t WS_YS = WS_PROJ + 154 * MiB;
constexpr int CW_CNT = 8192;
constexpr int LDS_OFF_TAB = 131072 + 1024;
constexpr size_t WS_SCR = 332 * MiB;
constexpr size_t WS_HG_QG = WS_SCR;
constexpr size_t WS_HG_KDT = WS_SCR + 16 * MiB;
constexpr size_t WS_HG_A = WS_SCR + 32 * MiB;
constexpr size_t WS_HG_GL = WS_SCR + 40 * MiB;
constexpr size_t WS_SSD_C = WS_SCR + 41 * MiB;
constexpr size_t WS_SSD_BT = WS_SCR + 49 * MiB;
constexpr size_t WS_SSD_CB = WS_SCR + 57 * MiB;
constexpr size_t WS_SSD_XT = WS_SCR + 65 * MiB;
constexpr size_t WS_SSD_AC = WS_SCR + 97 * MiB;
constexpr size_t WS_SSD_DT = WS_SCR + 98 * MiB;
constexpr size_t WS_GD_K = WS_SCR + 99 * MiB;
constexpr size_t WS_GD_KT = WS_SCR + 115 * MiB;
constexpr size_t WS_GD_QG = WS_SCR + 131 * MiB;
constexpr size_t WS_GD_VT = WS_SCR + 147 * MiB;
constexpr size_t WS_GD_T = WS_SCR + 163 * MiB;
constexpr size_t WS_GD_QK = WS_SCR + 171 * MiB;
constexpr size_t WS_GD_VEC = WS_SCR + 179 * MiB;
constexpr size_t WS_END = 512 * MiB;
constexpr int CW_BAR = 4096;

constexpr int RING_OFF = 0, RING_BYTES = 131072;
constexpr int LDSCTL_OFF = RING_BYTES, MISC_OFF = LDSCTL_OFF + 320;
constexpr int LDS_BYTES = 147456;

__device__ __forceinline__ float bf2f(unsigned short b) { return __builtin_bit_cast(float, ((unsigned)b) << 16); }
__device__ __forceinline__ float bflo(unsigned w) { return __builtin_bit_cast(float, w << 16); }
__device__ __forceinline__ float bfhi(unsigned w) { return __builtin_bit_cast(float, w & 0xffff0000u); }
__device__ __forceinline__ float siluf(float x) { return x / (1.0f + __expf(-x)); }
__device__ __forceinline__ float sigmoidf_(float x) { return 1.0f / (1.0f + __expf(-x)); }
__device__ __forceinline__ float softplusf_(float x) { return x > 20.f ? x : log1pf(__expf(x)); }
#define DPP_ADD(v, ctrl) ((v) + __builtin_bit_cast(float, __builtin_amdgcn_update_dpp(0, __builtin_bit_cast(int, (v)), (ctrl), 0xf, 0xf, false)))
__device__ __forceinline__ float wave_sum(float v) {
    v = DPP_ADD(v, 0xB1);
    v = DPP_ADD(v, 0x4E);
    v = DPP_ADD(v, 0x141);
    v = DPP_ADD(v, 0x140);
    const int iv = __builtin_bit_cast(int, v);
    return (__builtin_bit_cast(float, __builtin_amdgcn_readlane(iv, 0)) + __builtin_bit_cast(float, __builtin_amdgcn_readlane(iv, 16))) + (__builtin_bit_cast(float, __builtin_amdgcn_readlane(iv, 32)) + __builtin_bit_cast(float, __builtin_amdgcn_readlane(iv, 48)));
}
__device__ __forceinline__ float row16_sum(float v) {
    v = DPP_ADD(v, 0xB1); v = DPP_ADD(v, 0x4E); v = DPP_ADD(v, 0x141); v = DPP_ADD(v, 0x140); return v;
}

struct Args {
    const float* in[25]; float* out; unsigned char* ws; int ph_lo, ph_hi;
};
typedef const __attribute__((address_space(4))) Args* CArgs;
#define ARGS_HERE() ([]() { CArgs p_ = (CArgs)__builtin_amdgcn_kernarg_segment_ptr(); asm volatile("" : "+s"(p_)); return p_; }())
enum { I_X = 0, I_WIN, I_SCW, I_SCB, I_SDTB, I_SALOG, I_SD, I_SNW, I_GCW, I_GDTB, I_GALOG, I_GNW, I_HLB, I_HNW, I_WOUT, I_LN1G, I_LN1B, I_WRG, I_BRG, I_WRE, I_BRE, I_WGU, I_WDN, I_LN2G, I_LN2B };

__device__ __forceinline__ void transpose_item(const float* W, int ldw, int nvalid, int k0, int n0, bf16* WT, size_t ldt, int drow0, int dk0, LAS float* scr, int lane) {
#pragma unroll 8
    for (int i = 0; i < 32; ++i) { const int kk = 2 * i + (lane >> 5), nn = lane & 31, n = n0 + nn; scr[kk * 33 + nn] = (n < nvalid) ? W[(size_t)(k0 + kk) * ldw + n] : 0.f; }
    LDS_WAIT(); asm volatile("" ::: "memory");
    const int c = lane & 7;
#pragma unroll
    for (int j = 0; j < 4; ++j) { const int n = (lane >> 3) + 8 * j; const LAS float* s = scr + (8 * c) * 33 + n;
        v4u o; o.x = pk2(s[0 * 33], s[1 * 33]); o.y = pk2(s[2 * 33], s[3 * 33]); o.z = pk2(s[4 * 33], s[5 * 33]); o.w = pk2(s[6 * 33], s[7 * 33]);
        *(GAS v4u*)(WT + (size_t)(drow0 + n) * ldt + dk0 + k0 + 8 * c) = o; }
    LDS_WAIT(); asm volatile("" ::: "memory");
}
__device__ __forceinline__ void weights_phase(CArgs a, int l, const int which, LAS unsigned char* lds, int wwg, int nwg, int tid) {
    asm volatile("" : "+v"(tid));
    const int lane = tid & 63, wave = tid >> 6, gw = wwg * NWAVES + wave, NGW = nwg * NWAVES;
    LAS float* scr = (LAS float*)(lds + wave * 16384);
    constexpr int I_IN = 16 * (NPROJ / 32), I_OUT = (DMIX / 64) * (D / 32), I_GU = NEXP * 16 * 16, I_DN = NEXP * 4 * 32;
    const int n_in = (which & 1) ? I_IN : 0, n_out = (which & 2) ? I_OUT : 0, n_gu = (which & 4) ? I_GU : 0, n_dn = (which & 8) ? I_DN : 0;
    unsigned char* ws = a->ws;
    for (int it = gw; it < n_in + n_out + n_gu + n_dn; it += NGW) {
        int r = it;
        if (r < n_in) { const int kb = r / (NPROJ / 32), nb = r % (NPROJ / 32);
            transpose_item(a->in[I_WIN] + (size_t)l * D * IN_COLS, IN_COLS, IN_COLS, 64 * kb, 32 * nb, (bf16*)(ws + WS_WIN), D, 32 * nb, 0, scr, lane); continue; }
        r -= n_in;
        if (r < n_out) { const int kb = r / (D / 32), nb = r % (D / 32);
            transpose_item(a->in[I_WOUT] + (size_t)l * DMIX * D, D, D, 64 * kb, 32 * nb, (bf16*)(ws + WS_WOUT), DMIX, 32 * nb, 0, scr, lane); continue; }
        r -= n_out;
        if (r < n_gu) { const int e = r / 256, q = r % 256, kb = q / 16, nb = q % 16, c0 = 32 * nb, bj = c0 / 256, hf = (c0 % 256) / 128, j0 = c0 % 128;
            transpose_item(a->in[I_WGU] + (size_t)(l * NEXP + e) * D * 512, 512, 512, 64 * kb, c0, (bf16*)(ws + WS_WGU), D, e * 512 + hf * 256 + bj * 128 + j0, 0, scr, lane); continue; }
        r -= n_gu;
        { const int e = r / 128, q = r % 128, kb = q / 32, nb = q % 32;
            transpose_item(a->in[I_WDN] + (size_t)(l * NEXP + e) * DEXP * D, D, D, 64 * kb, 32 * nb, (bf16*)(ws + WS_WDN), DEXP, e * D + 32 * nb, 0, scr, lane); }
    }
}
__device__ __forceinline__ void p0_prologue(CArgs a, LAS unsigned char* lds, int wg, int G, int tid) {
    asm volatile("" : "+v"(tid));
    const f32x4* x4 = (const f32x4*)a->in[I_X]; f32x4* h4 = (f32x4*)a->out; unsigned long long* hb8 = (unsigned long long*)(a->ws + WS_HB);
    for (size_t i = (size_t)wg * NTHR + tid; i < (size_t)M * D / 4; i += (size_t)G * NTHR) { const f32x4 v = x4[i]; h4[i] = v;
        hb8[i] = (unsigned long long)pk2(v.x, v.y) | ((unsigned long long)pk2(v.z, v.w) << 32); }
}

#define WG_BAR() do { asm volatile("s_waitcnt lgkmcnt(0)" ::: "memory"); __builtin_amdgcn_s_barrier(); asm volatile("" ::: "memory"); } while (0)
__device__ __forceinline__ f32x4 mfma16(bf16x8 x, bf16x8 y, f32x4 c) { return __builtin_amdgcn_mfma_f32_16x16x32_bf16(x, y, c, 0, 0, 0); }
__device__ __forceinline__ bf16x8 lds_frag(const LAS bf16* base, int row0, int stride, int k0, int lane) { return *(const LAS bf16x8*)(base + (row0 + (lane & 15)) * stride + k0 + 8 * (lane >> 4)); }
__device__ __forceinline__ bf16x8 pack8(const float* v) { v4u w; w.x = pk2(v[0], v[1]); w.y = pk2(v[2], v[3]); w.z = pk2(v[4], v[5]); w.w = pk2(v[6], v[7]); return __builtin_bit_cast(bf16x8, w); }
__device__ __forceinline__ unsigned long long pack4(f32x4 v) { return (unsigned long long)pk2(v[0], v[1]) | ((unsigned long long)pk2(v[2], v[3]) << 32); }

__device__ __forceinline__ void hgrn_prep_phase(CArgs a, int l, LAS unsigned char* lds, int wg, int G, int tid) {
    asm volatile("" : "+v"(tid));
    constexpr int LS = 132;
    LAS float* sQ = (LAS float*)lds; LAS float* sK = sQ + 64 * LS; LAS float* sB = sK + 64 * LS; LAS float* sT = sB + 64 * LS; LAS float* sLb = sT + 512;
    const bf16* PROJ = (const bf16*)(a->ws + WS_PROJ);
    const int lane = tid & 63, w = tid >> 6, r = lane & 15, q4 = lane >> 4;
    for (int unit = wg; unit < 1024; unit += G) {
        const int b = unit >> 8, head = (unit >> 6) & 3, c = unit & 63;
        const size_t row0 = (size_t)b * SEQ + c * 64;
        __syncthreads();
        if (tid < 128) {
            const int ch = head * 128 + tid; float lg[DEPTH], mx = -1e30f;
#pragma unroll
            for (int j = 0; j < DEPTH; ++j) { lg[j] = a->in[I_HLB][j * 512 + ch]; mx = fmaxf(mx, lg[j]); }
            float den = 0.f, num = 0.f;
#pragma unroll
            for (int j = 0; j < DEPTH; ++j) { const float e = __expf(lg[j] - mx); den += e; if (j >= 1 && j <= l) num += e; }
            sLb[tid] = num / den;
        }
        __syncthreads();
        for (int p = tid; p < 1024; p += NTHR) {
            const int t = p >> 4, d8 = (p & 15) * 8;
            const v4u qv = *(const GAS v4u*)(PROJ + (row0 + t) * NPROJ + O_HQ + head * 128 + d8), fv = *(const GAS v4u*)(PROJ + (row0 + t) * NPROJ + O_HF + head * 128 + d8);
#pragma unroll
            for (int i = 0; i < 4; ++i) {
                const int d = d8 + 2 * i; const float lb0 = sLb[d], lb1 = sLb[d + 1];
                sQ[t * LS + d] = siluf(bflo(qv[i])); sQ[t * LS + d + 1] = siluf(bfhi(qv[i]));
                const float f0 = lb0 + (1.f - lb0) * sigmoidf_(bflo(fv[i])), f1 = lb1 + (1.f - lb1) * sigmoidf_(bfhi(fv[i]));
                sK[t * LS + d] = 1.f - f0; sK[t * LS + d + 1] = 1.f - f1; sB[t * LS + d] = __logf(f0); sB[t * LS + d + 1] = __logf(f1);
            }
        }
        __syncthreads();
        {
            const int d = tid & 127, seg = tid >> 7; float run = 0.f, vals[16];
#pragma unroll
            for (int i = 0; i < 16; ++i) { run += sB[(seg * 16 + i) * LS + d]; vals[i] = run; }
            sT[seg * 128 + d] = run;
            __syncthreads();
            float off = 0.f;
#pragma unroll
            for (int s2 = 0; s2 < 3; ++s2) if (s2 < seg) off += sT[s2 * 128 + d];
#pragma unroll
            for (int i = 0; i < 16; ++i) sB[(seg * 16 + i) * LS + d] = vals[i] + off;
        }
        __syncthreads();
        bf16* qg = (bf16*)(a->ws + WS_HG_QG) + (size_t)unit * 64 * 128; bf16* kdt = (bf16*)(a->ws + WS_HG_KDT) + (size_t)unit * 128 * 64;
        bf16* am = (bf16*)(a->ws + WS_HG_A) + (size_t)unit * 64 * 64; float* gl = (float*)(a->ws + WS_HG_GL) + (size_t)unit * 128;
        for (int p = tid; p < 1024; p += NTHR) { const int t = p >> 4, d8 = (p & 15) * 8; float v[8];
#pragma unroll
            for (int jj = 0; jj < 8; ++jj) v[jj] = sQ[t * LS + d8 + jj] * __expf(sB[t * LS + d8 + jj]);
            *(GAS bf16x8*)(qg + t * 128 + d8) = pack8(v); }
        for (int p = tid; p < 1024; p += NTHR) { const int d = p >> 3, s8 = (p & 7) * 8; const float bl = sB[63 * LS + d]; float v[8];
#pragma unroll
            for (int jj = 0; jj < 8; ++jj) v[jj] = sK[(s8 + jj) * LS + d] * __expf(bl - sB[(s8 + jj) * LS + d]);
            *(GAS bf16x8*)(kdt + d * 64 + s8) = pack8(v); }
        if (tid < 128) gl[tid] = __expf(sB[63 * LS + tid]);
        for (int p = w; p < 16; p += NWAVES) {
            const int i = p >> 2, j = p & 3; f32x4 acc = {0.f, 0.f, 0.f, 0.f};
            if (j <= i) {
#pragma unroll
                for (int ks = 0; ks < 4; ++ks) { const int d0 = 32 * ks + 8 * q4, t = 16 * i + r, s_ = 16 * j + r; float qf[8], kf[8];
#pragma unroll
                    for (int jj = 0; jj < 8; ++jj) { const float ref = i ? sB[(16 * i - 1) * LS + d0 + jj] : 0.f;
                        qf[jj] = sQ[t * LS + d0 + jj] * __expf(sB[t * LS + d0 + jj] - ref); kf[jj] = sK[s_ * LS + d0 + jj] * __expf(ref - sB[s_ * LS + d0 + jj]); }
                    acc = mfma16(pack8(kf), pack8(qf), acc); }
                const int t = 16 * i + r;
#pragma unroll
                for (int ii = 0; ii < 4; ++ii) if (16 * j + 4 * q4 + ii > t) acc[ii] = 0.f;
            }
            *(GAS unsigned long long*)(am + (16 * i + r) * 64 + 16 * j + 4 * q4) = pack4(acc);
        }
    }
}
__device__ __forceinline__ void hgrn_scan_phase(CArgs a, int l, LAS unsigned char* lds, const int b, const int head, const int eb, int tid) {
    asm volatile("" : "+v"(tid));
    constexpr int QS = 136, KS = 72;
    constexpr int B_QG = 0, B_KDT = 17408, B_A = B_KDT + 18432, B_VT = B_A + 9216, B_GL = B_VT + 4608, BUF = B_GL + 512;
    LAS unsigned char* sST0 = lds + 2 * BUF;
    const bf16* PROJ = (const bf16*)(a->ws + WS_PROJ); bf16* YMIX = (bf16*)(a->ws + WS_YMIX);
    const int lane = tid & 63, w = tid >> 6, r = lane & 15, q4 = lane >> 4;
    {
        const size_t cu0 = (size_t)(b * 4 + head) * 64;
        const bf16* QG = (const bf16*)(a->ws + WS_HG_QG) + cu0 * 64 * 128; const bf16* KDT = (const bf16*)(a->ws + WS_HG_KDT) + cu0 * 128 * 64;
        const bf16* AM = (const bf16*)(a->ws + WS_HG_A) + cu0 * 64 * 64; const float* GL = (const float*)(a->ws + WS_HG_GL) + cu0 * 128;
        const bf16* VP = PROJ + (size_t)b * SEQ * NPROJ + O_HI + head * 128 + eb * 32;
        v4u rq[2], rk[2], ra, rv; f32x4 rg;
#define HG_LOAD(n) do { _Pragma("unroll") for (int i = 0; i < 2; ++i) { const int p = tid + NTHR * i; rq[i] = *(const GAS v4u*)(QG + (size_t)(n) * 8192 + (p >> 4) * 128 + (p & 15) * 8); \
            rk[i] = *(const GAS v4u*)(KDT + (size_t)(n) * 8192 + (p >> 3) * 64 + (p & 7) * 8); } \
            ra = *(const GAS v4u*)(AM + (size_t)(n) * 4096 + (tid >> 3) * 64 + (tid & 7) * 8); \
            if (tid < 256) rv = *(const GAS v4u*)(VP + (size_t)((n) * 64 + (tid >> 2)) * NPROJ + (tid & 3) * 8); \
            if (tid < 32) rg = *(const GAS f32x4*)(GL + (size_t)(n) * 128 + tid * 4); } while (0)
#define HG_STORE(bufp) do { LAS unsigned char* bp_ = (bufp); _Pragma("unroll") for (int i = 0; i < 2; ++i) { const int p = tid + NTHR * i; \
            *(LAS v4u*)(bp_ + B_QG + ((p >> 4) * QS + (p & 15) * 8) * 2) = rq[i]; *(LAS v4u*)(bp_ + B_KDT + ((p >> 3) * KS + (p & 7) * 8) * 2) = rk[i]; } \
            *(LAS v4u*)(bp_ + B_A + ((tid >> 3) * KS + (tid & 7) * 8) * 2) = ra; \
            if (tid < 256) { LAS bf16* vt = (LAS bf16*)(bp_ + B_VT); const int t_ = tid >> 2, e8 = (tid & 3) * 8; _Pragma("unroll") for (int i = 0; i < 4; ++i) { \
                vt[(e8 + 2 * i) * KS + t_] = (bf16)(rv[i] & 0xffffu); vt[(e8 + 2 * i + 1) * KS + t_] = (bf16)(rv[i] >> 16); } } \
            if (tid < 32) *(LAS f32x4*)(bp_ + B_GL + tid * 16) = rg; } while (0)
        __syncthreads();
        HG_LOAD(0);
        for (int i = tid; i < 8704 / 4; i += NTHR) ((LAS unsigned*)sST0)[i] = 0u;
        HG_STORE(lds);
        f32x4 accS[2] = {{0.f, 0.f, 0.f, 0.f}, {0.f, 0.f, 0.f, 0.f}};
        __syncthreads();
        for (int n = 0; n < 64; ++n) {
            const int cur = n & 1; LAS unsigned char* bp = lds + cur * BUF; LAS bf16* sST = (LAS bf16*)(sST0 + cur * 8704); LAS bf16* sSTn = (LAS bf16*)(sST0 + (cur ^ 1) * 8704);
            if (n + 1 < 64) HG_LOAD(n + 1);
            {
                const int tt = w >> 1, et = w & 1; f32x4 acc = {0.f, 0.f, 0.f, 0.f};
#pragma unroll
                for (int ks = 0; ks < 4; ++ks) acc = mfma16(lds_frag(sST, 16 * et, QS, 32 * ks, lane), lds_frag((LAS bf16*)(bp + B_QG), 16 * tt, QS, 32 * ks, lane), acc);
#pragma unroll
                for (int ks = 0; ks < 2; ++ks) acc = mfma16(lds_frag((LAS bf16*)(bp + B_VT), 16 * et, KS, 32 * ks, lane), lds_frag((LAS bf16*)(bp + B_A), 16 * tt, KS, 32 * ks, lane), acc);
                *(GAS unsigned long long*)(YMIX + ((size_t)b * SEQ + n * 64 + 16 * tt + r) * DMIX + 1536 + head * 128 + eb * 32 + 16 * et + 4 * q4) = pack4(acc);
            }
            {
                const f32x4 glv = *(const LAS f32x4*)(bp + B_GL + (16 * w + 4 * q4) * 4);
#pragma unroll
                for (int et = 0; et < 2; ++et) { accS[et] = accS[et] * glv;
#pragma unroll
                    for (int ks = 0; ks < 2; ++ks) accS[et] = mfma16(lds_frag((LAS bf16*)(bp + B_KDT), 16 * w, KS, 32 * ks, lane), lds_frag((LAS bf16*)(bp + B_VT), 16 * et, KS, 32 * ks, lane), accS[et]);
                    *(LAS unsigned long long*)(sSTn + (16 * et + r) * QS + 16 * w + 4 * q4) = pack4(accS[et]); }
            }
            if (n + 1 < 64) HG_STORE(lds + (cur ^ 1) * BUF);
            WG_BAR();
        }
#undef HG_LOAD
#undef HG_STORE
    }
}

__device__ __forceinline__ void ssd_rec_phase(CArgs a, int l, LAS unsigned char* lds, int wg, int G, int tid) {
    asm volatile("" : "+v"(tid));
    constexpr int TB = 64;
    LAS float* sX = (LAS float*)lds; LAS float* sB = sX + TB * 16; LAS float* sC = sB + TB * 128; LAS float* sDt = sC + TB * 128; LAS float* sDa = sDt + TB; LAS float* sY = sDa + TB;
    const bf16* PROJ = (const bf16*)(a->ws + WS_PROJ); bf16* YMIX = (bf16*)(a->ws + WS_YMIX);
    const float* cw = a->in[I_SCW] + (size_t)l * 4 * 1536; const float* cb = a->in[I_SCB] + (size_t)l * 1536;
    const int p_local = tid >> 5, nq = tid & 31;
    for (int unit = wg; unit < 256; unit += G) {
        const int b = unit >> 6, head = (unit >> 2) & 15, pq = unit & 3, g = head >> 3;
        const float A = -__expf(a->in[I_SALOG][l * 16 + head]), dtb = a->in[I_SDTB][l * 16 + head], Dsk = a->in[I_SD][l * 16 + head];
        float h0 = 0.f, h1 = 0.f, h2 = 0.f, h3 = 0.f;
        for (int t0 = 0; t0 < SEQ; t0 += TB) {
            __syncthreads();
            for (int idx = tid; idx < TB * 272; idx += NTHR) {
                const int tt = idx / 272, ci = idx % 272, t = t0 + tt;
                const int ch = ci < 16 ? head * 64 + pq * 16 + ci : (ci < 144 ? 1024 + g * 128 + (ci - 16) : 1280 + g * 128 + (ci - 144));
                float acc = cb[ch];
#pragma unroll
                for (int k = 0; k < 4; ++k) { const int ts = t - 3 + k; if (ts >= 0) acc += cw[k * 1536 + ch] * bf2f(PROJ[(size_t)(b * SEQ + ts) * NPROJ + O_XBC + ch]); }
                const float v = siluf(acc);
                if (ci < 16) sX[tt * 16 + ci] = v; else if (ci < 144) sB[tt * 128 + ci - 16] = v; else sC[tt * 128 + ci - 144] = v;
            }
            if (tid < TB) { const float raw = bf2f(PROJ[(size_t)(b * SEQ + t0 + tid) * NPROJ + O_DT + head]); const float dt = softplusf_(raw + dtb); sDt[tid] = dt; sDa[tid] = __expf(dt * A); }
            __syncthreads();
#pragma unroll 4
            for (int tt = 0; tt < TB; ++tt) {
                const float xv = sX[tt * 16 + p_local], da = sDa[tt], dx = sDt[tt] * xv;
                const f32x4 Bv = *(const LAS f32x4*)(sB + tt * 128 + nq * 4), Cv = *(const LAS f32x4*)(sC + tt * 128 + nq * 4);
                h0 = da * h0 + dx * Bv.x; h1 = da * h1 + dx * Bv.y; h2 = da * h2 + dx * Bv.z; h3 = da * h3 + dx * Bv.w;
                float part = (Cv.x * h0 + Cv.y * h1) + (Cv.z * h2 + Cv.w * h3);
                part += __shfl_xor(part, 1); part += __shfl_xor(part, 2); part += __shfl_xor(part, 4); part += __shfl_xor(part, 8); part += __shfl_xor(part, 16);
                if (nq == 0) sY[tt * 16 + p_local] = part + Dsk * xv;
            }
            __syncthreads();
            for (int idx = tid; idx < TB * 16; idx += NTHR) { const int tt = idx >> 4, i = idx & 15; YMIX[(size_t)(b * SEQ + t0 + tt) * DMIX + head * 64 + pq * 16 + i] = (bf16)f2bf(sY[idx]); }
        }
    }
}

__device__ __forceinline__ void ssd_prep_phase(CArgs a, int l, LAS unsigned char* lds, int wg, int G, int tid) {
    asm volatile("" : "+v"(tid));
    constexpr int PS = 136;
    LAS bf16* sB = (LAS bf16*)lds; LAS bf16* sC = sB + 128 * PS; LAS bf16* sXT = (LAS bf16*)lds; LAS float* sDt = (LAS float*)(lds + 2 * 128 * PS * 2); LAS bf16* sCB = (LAS bf16*)(lds + 2 * 128 * PS * 2 + 4096);
    const bf16* PROJ = (const bf16*)(a->ws + WS_PROJ);
    const float* cw = a->in[I_SCW] + (size_t)l * 4 * 1536; const float* cb = a->in[I_SCB] + (size_t)l * 1536;
    const int lane = tid & 63, w = tid >> 6, r = lane & 15, q4 = lane >> 4;
    for (int unit = wg; unit < 256; unit += G) {
        const int b = unit >> 6, c = (unit >> 1) & 31, g = unit & 1;
        const size_t row0 = (size_t)b * SEQ + c * 128;
        bf16* Cg = (bf16*)(a->ws + WS_SSD_C) + (size_t)unit * 16384; bf16* BTg = (bf16*)(a->ws + WS_SSD_BT) + (size_t)unit * 16384; bf16* CBg = (bf16*)(a->ws + WS_SSD_CB) + (size_t)unit * 16384;
        __syncthreads();
        {
            const int c16 = tid & 31, l0 = tid >> 5; const int ch = (c16 < 16 ? 1024 + g * 128 + c16 * 8 : 1280 + g * 128 + (c16 - 16) * 8);
            float wk[4][8], bias[8];
#pragma unroll
            for (int jj = 0; jj < 8; ++jj) { bias[jj] = cb[ch + jj];
#pragma unroll
                for (int k = 0; k < 4; ++k) wk[k][jj] = cw[k * 1536 + ch + jj]; }
            LAS bf16* dst = (c16 < 16 ? sB : sC) + (c16 & 15) * 8;
#pragma unroll 2
            for (int i = 0; i < 8; ++i) { const int ll = l0 + 16 * i; float acc[8];
#pragma unroll
                for (int jj = 0; jj < 8; ++jj) acc[jj] = bias[jj];
#pragma unroll
                for (int k = 0; k < 4; ++k) { const int ts = c * 128 + ll - 3 + k;
                    if (ts >= 0) { const v4u xv = *(const GAS v4u*)(PROJ + ((size_t)b * SEQ + ts) * NPROJ + O_XBC + ch);
#pragma unroll
                        for (int j = 0; j < 4; ++j) { acc[2 * j] += wk[k][2 * j] * bflo(xv[j]); acc[2 * j + 1] += wk[k][2 * j + 1] * bfhi(xv[j]); } } }
#pragma unroll
                for (int jj = 0; jj < 8; ++jj) acc[jj] = siluf(acc[jj]);
                *(LAS bf16x8*)(dst + ll * PS) = pack8(acc); }
        }
        {
            const int head = g * 8 + w; const float A = -__expf(a->in[I_SALOG][l * 16 + head]), dtb = a->in[I_SDTB][l * 16 + head];
            const int l2 = 2 * lane;
            const float dt0 = softplusf_(bf2f(PROJ[(row0 + l2) * NPROJ + O_DT + head]) + dtb), dt1 = softplusf_(bf2f(PROJ[(row0 + l2 + 1) * NPROJ + O_DT + head]) + dtb);
            const float da1 = dt1 * A; float sc = dt0 * A + da1;
#pragma unroll
            for (int o = 1; o < 64; o <<= 1) { const float t_ = __shfl_up(sc, o); if (lane >= o) sc += t_; }
            sDt[w * 128 + l2] = dt0; sDt[w * 128 + l2 + 1] = dt1;
            const size_t uh = (size_t)((b * 16 + head) * 32 + c) * 128;
            float* AC = (float*)(a->ws + WS_SSD_AC) + uh; float* DT = (float*)(a->ws + WS_SSD_DT) + uh;
            AC[l2] = sc - da1; AC[l2 + 1] = sc; DT[l2] = dt0; DT[l2 + 1] = dt1;
        }
        __syncthreads();
#pragma unroll
        for (int st = 0; st < 8; ++st) {
            f32x4 acc = {0.f, 0.f, 0.f, 0.f};
            if (st <= w) {
#pragma unroll
                for (int ks = 0; ks < 4; ++ks) acc = mfma16(lds_frag(sB, 16 * st, PS, 32 * ks, lane), lds_frag(sC, 16 * w, PS, 32 * ks, lane), acc); }
            *(LAS unsigned long long*)(sCB + (16 * w + r) * PS + 16 * st + 4 * q4) = pack4(acc);
        }
        __syncthreads();
        for (int f = w; f < 32; f += NWAVES) { const int tile = f >> 2, ks = f & 3;
            *(GAS v4u*)(Cg + f * 512 + lane * 8) = *(const LAS v4u*)(sC + (16 * tile + r) * PS + 32 * ks + 8 * q4);
            *(GAS v4u*)(CBg + f * 512 + lane * 8) = *(const LAS v4u*)(sCB + (16 * tile + r) * PS + 32 * ks + 8 * q4);
            const int n = 16 * tile + r, l0 = 32 * ks + 8 * q4; v4u o;
#pragma unroll
            for (int j = 0; j < 4; ++j) o[j] = (unsigned)sB[(l0 + 2 * j) * PS + n] | ((unsigned)sB[(l0 + 2 * j + 1) * PS + n] << 16);
            *(GAS v4u*)(BTg + f * 512 + lane * 8) = o; }
#pragma unroll 1
        for (int hf = 0; hf < 2; ++hf) {
            __syncthreads();
            {   const int cg = tid & 31, l0 = tid >> 5, chl = cg * 8, ch = g * 512 + hf * 256 + chl, hh = hf * 4 + (cg >> 3);
                float wk[4][8], bias[8];
#pragma unroll
                for (int jj = 0; jj < 8; ++jj) { bias[jj] = cb[ch + jj];
#pragma unroll
                    for (int k = 0; k < 4; ++k) wk[k][jj] = cw[k * 1536 + ch + jj]; }
#pragma unroll 2
                for (int i = 0; i < 8; ++i) { const int ll = l0 + 16 * i; float acc[8];
#pragma unroll
                    for (int jj = 0; jj < 8; ++jj) acc[jj] = bias[jj];
#pragma unroll
                    for (int k = 0; k < 4; ++k) { const int ts = c * 128 + ll - 3 + k;
                        if (ts >= 0) { const v4u xv = *(const GAS v4u*)(PROJ + ((size_t)b * SEQ + ts) * NPROJ + O_XBC + ch);
#pragma unroll
                            for (int j = 0; j < 4; ++j) { acc[2 * j] += wk[k][2 * j] * bflo(xv[j]); acc[2 * j + 1] += wk[k][2 * j + 1] * bfhi(xv[j]); } } }
                    const float dtv = sDt[hh * 128 + ll];
#pragma unroll
                    for (int jj = 0; jj < 8; ++jj) sXT[(chl + jj) * PS + ll] = (bf16)f2bf(siluf(acc[jj]) * dtv); }
            }
            __syncthreads();
            for (int p = tid; p < 4096; p += NTHR) { const int chl = p >> 4, l8 = (p & 15) * 8, hh = hf * 4 + (chl >> 6), pp = chl & 63;
                const size_t uh = (size_t)((b * 16 + g * 8 + hh) * 32 + c);
                *(GAS v4u*)((bf16*)(a->ws + WS_SSD_XT) + (uh * 64 + pp) * 128 + l8) = *(const LAS v4u*)(sXT + chl * PS + l8); }
        }
    }
}
__device__ __forceinline__ void ssd_scan_phase(CArgs a, int l, LAS unsigned char* lds, const int b, const int head, int tid) {
    asm volatile("" : "+v"(tid));
    constexpr int PS = 136, O_S = 0, O_X = 34816, O_AC = 69632, O_TE = 70656, O_DT = 71680;
    bf16* YMIX = (bf16*)(a->ws + WS_YMIX);
    const int lane = tid & 63, w = tid >> 6, r = lane & 15, q4 = lane >> 4;
    {
        const int g = head >> 3;
        const float Dsk = a->in[I_SD][l * 16 + head];
        const bf16* Cg = (const bf16*)(a->ws + WS_SSD_C) + (size_t)((b * 32) * 2 + g) * 16384 + (w * 4) * 512 + lane * 8;
        const bf16* CBg = (const bf16*)(a->ws + WS_SSD_CB) + (size_t)((b * 32) * 2 + g) * 16384 + (w * 4) * 512 + lane * 8;
        const bf16* BTg = (const bf16*)(a->ws + WS_SSD_BT) + (size_t)((b * 32) * 2 + g) * 16384 + (w * 4) * 512 + lane * 8;
        const size_t uh0 = (size_t)(b * 16 + head) * 32;
        const bf16* XTg = (const bf16*)(a->ws + WS_SSD_XT) + uh0 * 8192; const float* ACg = (const float*)(a->ws + WS_SSD_AC) + uh0 * 128; const float* DTg = (const float*)(a->ws + WS_SSD_DT) + uh0 * 128;
        v4u fC[4], fCB[4], fBT[4], rx[2]; float rac = 0.f, racl = 0.f, rdt = 0.f;
#define SSD_LDF(cc, dst, src) do { _Pragma("unroll") for (int ks = 0; ks < 4; ++ks) dst[ks] = *(const GAS v4u*)(src + (size_t)(cc) * 32768 + 512 * ks); } while (0)
#define SSD_LOADX(cc) do { _Pragma("unroll") for (int i = 0; i < 2; ++i) { const int p = tid + NTHR * i; rx[i] = *(const GAS v4u*)(XTg + (size_t)(cc) * 8192 + (p >> 4) * 128 + (p & 15) * 8); } \
            if (tid < 128) { rac = ACg[(cc) * 128 + tid]; racl = ACg[(cc) * 128 + 127]; rdt = DTg[(cc) * 128 + tid]; } } while (0)
#define SSD_STORE(bi) do { _Pragma("unroll") for (int i = 0; i < 2; ++i) { const int p = tid + NTHR * i; *(LAS v4u*)(lds + O_X + (bi) * 17408 + ((p >> 4) * PS + (p & 15) * 8) * 2) = rx[i]; } \
            if (tid < 128) { ((LAS float*)(lds + O_AC))[(bi) * 128 + tid] = rac; ((LAS float*)(lds + O_TE))[(bi) * 128 + tid] = __expf(racl - rac); ((LAS float*)(lds + O_DT))[(bi) * 128 + tid] = rdt; } } while (0)
        __syncthreads();
        SSD_LDF(0, fC, Cg); SSD_LDF(0, fCB, CBg); SSD_LDF(0, fBT, BTg); SSD_LOADX(0);
        for (int i = tid; i < 17408 / 4; i += NTHR) ((LAS unsigned*)(lds + O_S))[i] = 0u;
        SSD_STORE(0);
        f32x4 accS[4];
#pragma unroll
        for (int pt = 0; pt < 4; ++pt) accS[pt] = (f32x4){0.f, 0.f, 0.f, 0.f};
        __syncthreads();
        for (int c = 0; c < 32; ++c) {
            const int cur = c & 1;
            const LAS bf16* sS = (const LAS bf16*)(lds + O_S + cur * 17408); LAS bf16* sSn = (LAS bf16*)(lds + O_S + (cur ^ 1) * 17408); const LAS bf16* sXT = (const LAS bf16*)(lds + O_X + cur * 17408);
            const LAS float* sAc = (const LAS float*)(lds + O_AC) + cur * 128; const LAS float* sTe = (const LAS float*)(lds + O_TE) + cur * 128; const LAS float* sDt = (const LAS float*)(lds + O_DT) + cur * 128;
            const int cn = c + 1 < 32 ? c + 1 : c;
            SSD_LOADX(cn);
            const int lrow = 16 * w + r; const float ac_l = sAc[lrow];
            f32x4 accO[4], accD[4];
#pragma unroll
            for (int pt = 0; pt < 4; ++pt) { accO[pt] = (f32x4){0.f, 0.f, 0.f, 0.f}; accD[pt] = (f32x4){0.f, 0.f, 0.f, 0.f}; }
#pragma unroll
            for (int ks = 0; ks < 4; ++ks) { const bf16x8 yf = __builtin_bit_cast(bf16x8, fC[ks]);
#pragma unroll
                for (int pt = 0; pt < 4; ++pt) accO[pt] = mfma16(lds_frag(sS, 16 * pt, PS, 32 * ks, lane), yf, accO[pt]); }
            SSD_LDF(cn, fC, Cg);
#pragma unroll
            for (int ks = 0; ks < 4; ++ks) if (32 * ks <= 16 * w + 15) {
                float v[8]; const f32x4 a0 = *(const LAS f32x4*)(sAc + 32 * ks + 8 * q4), a1 = *(const LAS f32x4*)(sAc + 32 * ks + 8 * q4 + 4);
#pragma unroll
                for (int j = 0; j < 4; ++j) { const int s0 = 32 * ks + 8 * q4 + 2 * j; const float as0 = (2 * j < 4) ? a0[(2 * j) & 3] : a1[(2 * j) & 3], as1 = (2 * j + 1 < 4) ? a0[(2 * j + 1) & 3] : a1[(2 * j + 1) & 3];
                    v[2 * j] = (s0 <= lrow) ? bflo(fCB[ks][j]) * __expf(ac_l - as0) : 0.f; v[2 * j + 1] = (s0 + 1 <= lrow) ? bfhi(fCB[ks][j]) * __expf(ac_l - as1) : 0.f; }
                const bf16x8 yf = pack8(v);
#pragma unroll
                for (int pt = 0; pt < 4; ++pt) accD[pt] = mfma16(lds_frag(sXT, 16 * pt, PS, 32 * ks, lane), yf, accD[pt]); }
            SSD_LDF(cn, fCB, CBg);
            {   const float ea = __expf(ac_l), rdtl = Dsk / sDt[lrow];
#pragma unroll
                for (int pt = 0; pt < 4; ++pt) { f32x4 y = accO[pt] * ea + accD[pt];
#pragma unroll
                    for (int ii = 0; ii < 4; ++ii) y[ii] += rdtl * bf2f(sXT[(16 * pt + 4 * q4 + ii) * PS + lrow]);
                    *(GAS unsigned long long*)(YMIX + ((size_t)b * SEQ + c * 128 + lrow) * DMIX + head * 64 + 16 * pt + 4 * q4) = pack4(y); } }
            {   const float cd = __expf(sAc[127]);
#pragma unroll
                for (int pt = 0; pt < 4; ++pt) accS[pt] = accS[pt] * cd;
#pragma unroll
                for (int ks = 0; ks < 4; ++ks) { float v[8]; const f32x4 t0 = *(const LAS f32x4*)(sTe + 32 * ks + 8 * q4), t1 = *(const LAS f32x4*)(sTe + 32 * ks + 8 * q4 + 4);
#pragma unroll
                    for (int j = 0; j < 4; ++j) { const float ts0 = (2 * j < 4) ? t0[(2 * j) & 3] : t1[(2 * j) & 3], ts1 = (2 * j + 1 < 4) ? t0[(2 * j + 1) & 3] : t1[(2 * j + 1) & 3];
                        v[2 * j] = bflo(fBT[ks][j]) * ts0; v[2 * j + 1] = bfhi(fBT[ks][j]) * ts1; }
                    const bf16x8 xf = pack8(v);
#pragma unroll
                    for (int pt = 0; pt < 4; ++pt) accS[pt] = mfma16(xf, lds_frag(sXT, 16 * pt, PS, 32 * ks, lane), accS[pt]); }
#pragma unroll
                for (int pt = 0; pt < 4; ++pt) *(LAS unsigned long long*)(sSn + (16 * pt + r) * PS + 16 * w + 4 * q4) = pack4(accS[pt]);
            }
            SSD_LDF(cn, fBT, BTg);
            if (c + 1 < 32) SSD_STORE(cur ^ 1);
            WG_BAR();
        }
#undef SSD_LDF
#undef SSD_LOADX
#undef SSD_STORE
    }
}

__device__ __forceinline__ void gdn_prep_phase(CArgs a, int l, LAS unsigned char* lds, int wg, int G, int tid) {
    asm volatile("" : "+v"(tid));
    constexpr int PS = 136, TS = 72, MS = 68, TT = 65;
    LAS bf16* sKb = (LAS bf16*)lds; LAS bf16* sQb = sKb + 64 * PS; LAS bf16* sQG = sQb + 64 * PS; LAS bf16* sVT = sQG + 64 * PS;
    LAS float* sM = (LAS float*)(lds + 3 * 17408 + 18432); LAS float* sT = sM + 64 * MS; LAS float* sVec = sT + 64 * TT; LAS bf16* sQK = (LAS bf16*)(sVec + 256);
    const bf16* PROJ = (const bf16*)(a->ws + WS_PROJ);
    const float* cw = a->in[I_GCW] + (size_t)l * 4 * 1536;
    const int lane = tid & 63, w = tid >> 6, r = lane & 15, q4 = lane >> 4;
    for (int unit = wg; unit < 1024; unit += G) {
        const int b = unit >> 8, head = (unit >> 6) & 3, n = unit & 63;
        const size_t row0 = (size_t)b * SEQ + n * 64;
#define GW ((bf16*)(a->ws + WS_GD_K) + (size_t)unit * 8192)
#define GKT ((bf16*)(a->ws + WS_GD_KT) + (size_t)unit * 8192)
#define GQG ((bf16*)(a->ws + WS_GD_QG) + (size_t)unit * 8192)
#define GUT ((bf16*)(a->ws + WS_GD_VT) + (size_t)unit * 8192)
#define GT ((bf16*)(a->ws + WS_GD_T) + (size_t)unit * 4096)
#define GQK ((bf16*)(a->ws + WS_GD_QK) + (size_t)unit * 4096)
#define GVEC ((float*)(a->ws + WS_GD_VEC) + (size_t)unit * 256)
        __syncthreads();
        for (int i = tid; i < 64 * MS; i += NTHR) sM[i] = 0.f;
        if (w == 0) {
            const float nA = -__expf(a->in[I_GALOG][l * 4 + head]), dtb = a->in[I_GDTB][l * 4 + head];
            const size_t ro = (row0 + lane) * NPROJ;
            const float be = sigmoidf_(bf2f(PROJ[ro + O_GB + head])); float gsum = nA * softplusf_(bf2f(PROJ[ro + O_GA + head]) + dtb);
#pragma unroll
            for (int o = 1; o < 64; o <<= 1) { const float t_ = __shfl_up(gsum, o); if (lane >= o) gsum += t_; }
            const float glast = __shfl(gsum, 63), eg = __expf(gsum), cc = __expf(glast - gsum);
            sVec[lane] = gsum; sVec[64 + lane] = be; sVec[128 + lane] = eg;
            GVEC[lane] = be; GVEC[64 + lane] = eg; GVEC[128 + lane] = cc; GVEC[192 + lane] = __expf(glast);
        }
        __syncthreads();
        {
            float wq[4][2], wk_[4][2], wv[4][2];
#pragma unroll
            for (int k = 0; k < 4; ++k)
#pragma unroll
                for (int j = 0; j < 2; ++j) { wq[k][j] = cw[k * 1536 + head * 128 + 2 * lane + j]; wk_[k][j] = cw[k * 1536 + 512 + head * 128 + 2 * lane + j]; wv[k][j] = cw[k * 1536 + 1024 + head * 128 + 2 * lane + j]; }
#pragma unroll 2
            for (int i = 0; i < 8; ++i) { const int t = w + 8 * i; float q0 = 0.f, q1 = 0.f, k0 = 0.f, k1 = 0.f, v0 = 0.f, v1 = 0.f;
#pragma unroll
                for (int k = 0; k < 4; ++k) { const int ts = n * 64 + t - 3 + k;
                    if (ts >= 0) { const bf16* pr = PROJ + ((size_t)b * SEQ + ts) * NPROJ + O_QKV + head * 128 + 2 * lane;
                        const unsigned xq = *(const GAS unsigned*)pr, xk = *(const GAS unsigned*)(pr + 512), xv = *(const GAS unsigned*)(pr + 1024);
                        q0 += wq[k][0] * bflo(xq); q1 += wq[k][1] * bfhi(xq); k0 += wk_[k][0] * bflo(xk); k1 += wk_[k][1] * bfhi(xk); v0 += wv[k][0] * bflo(xv); v1 += wv[k][1] * bfhi(xv); } }
                q0 = siluf(q0); q1 = siluf(q1); k0 = siluf(k0); k1 = siluf(k1); v0 = siluf(v0); v1 = siluf(v1);
                const float sq = rsqrtf(wave_sum(q0 * q0 + q1 * q1) + 1e-6f) * 0.08838834764831845f, sk = rsqrtf(wave_sum(k0 * k0 + k1 * k1) + 1e-6f), eg = sVec[128 + t];
                *(LAS unsigned*)(sKb + t * PS + 2 * lane) = pk2(k0 * sk, k1 * sk); *(LAS unsigned*)(sQb + t * PS + 2 * lane) = pk2(q0 * sq, q1 * sq);
                *(LAS unsigned*)(sQG + t * PS + 2 * lane) = pk2(q0 * sq * eg, q1 * sq * eg);
                sVT[(2 * lane) * TS + t] = (bf16)f2bf(v0); sVT[(2 * lane + 1) * TS + t] = (bf16)f2bf(v1); }
        }
        __syncthreads();
        for (int p = w; p < 26; p += NWAVES) {
            int it, jt; bool isq;
            if (p < 10) { isq = false; it = p < 1 ? 0 : (p < 3 ? 1 : (p < 6 ? 2 : 3)); jt = p - (it * (it + 1)) / 2; } else { isq = true; it = (p - 10) >> 2; jt = (p - 10) & 3; }
            f32x4 acc = {0.f, 0.f, 0.f, 0.f};
            if (jt <= it) {
#pragma unroll
                for (int ks = 0; ks < 4; ++ks) acc = mfma16(lds_frag(sKb, 16 * jt, PS, 32 * ks, lane), lds_frag(isq ? sQb : sKb, 16 * it, PS, 32 * ks, lane), acc);
                const int i = 16 * it + r; const float gi = sVec[i], bi = sVec[64 + i];
#pragma unroll
                for (int ii = 0; ii < 4; ++ii) { const int j = 16 * jt + 4 * q4 + ii; const float dec = __expf(gi - sVec[j]);
                    acc[ii] = isq ? (j <= i ? acc[ii] * dec : 0.f) : (j < i ? acc[ii] * dec * bi : 0.f); }
            }
            if (isq) *(LAS unsigned long long*)(sQK + (16 * it + r) * TS + 16 * jt + 4 * q4) = pack4(acc);
            else *(LAS f32x4*)(sM + (16 * it + r) * MS + 16 * jt + 4 * q4) = acc;
        }
        __syncthreads();
        if (w == 0) {
            int zo = 0; asm volatile("" : "+v"(zo)); const LAS float* sMv = sM + zo;
            float U[64];
#pragma unroll
            for (int i = 0; i < 64; ++i) {
                f32x4 mr[16]; float a0 = -sMv[i * MS + lane], a1 = 0.f, a2 = 0.f, a3 = 0.f;
#pragma unroll
                for (int j4 = 0; j4 < (i + 3) / 4; ++j4) mr[j4] = *(const LAS f32x4*)(sMv + i * MS + 4 * j4);
                __builtin_amdgcn_sched_barrier(0);
#pragma unroll
                for (int j4 = 0; j4 < (i + 3) / 4; ++j4) { const f32x4 m = mr[j4];
                    if (4 * j4 + 0 < i) a0 -= m[0] * U[4 * j4 + 0]; if (4 * j4 + 1 < i) a1 -= m[1] * U[4 * j4 + 1]; if (4 * j4 + 2 < i) a2 -= m[2] * U[4 * j4 + 2]; if (4 * j4 + 3 < i) a3 -= m[3] * U[4 * j4 + 3]; }
                U[i] = (a0 + a1) + (a2 + a3); sT[i * TT + lane] = U[i]; }
        } else {
            for (int f = w - 1; f < 16; f += NWAVES - 1) { const int tile = f >> 2, ks = f & 3;
                *(GAS v4u*)(GQG + f * 512 + lane * 8) = *(const LAS v4u*)(sQG + (16 * tile + r) * PS + 32 * ks + 8 * q4); }
            for (int f = w - 1; f < 8; f += NWAVES - 1) { const int tile = f >> 1, ks = f & 1;
                *(GAS v4u*)(GQK + f * 512 + lane * 8) = *(const LAS v4u*)(sQK + (16 * tile + r) * TS + 32 * ks + 8 * q4); }
            for (int f = w - 1; f < 16; f += NWAVES - 1) { const int dt = f >> 1, ks = f & 1, d = 16 * dt + r, s0 = 32 * ks + 8 * q4; v4u o;
#pragma unroll
                for (int j = 0; j < 4; ++j) o[j] = (unsigned)sKb[(s0 + 2 * j) * PS + d] | ((unsigned)sKb[(s0 + 2 * j + 1) * PS + d] << 16);
                *(GAS v4u*)(GKT + f * 512 + lane * 8) = o; }
        }
        __syncthreads();
        {
            LAS bf16* sTb = (LAS bf16*)sM; LAS bf16* sKgT = sQb;
            { const int t = tid >> 3, s8 = (tid & 7) * 8; float v[8];
#pragma unroll
                for (int jj = 0; jj < 8; ++jj) v[jj] = sT[t * TT + s8 + jj] + ((s8 + jj == t) ? 1.f : 0.f);
                *(LAS bf16x8*)(sTb + t * TS + s8) = pack8(v); }
            for (int p = tid; p < 1024; p += NTHR) { const int d = p >> 3, s8 = (p & 7) * 8; float v[8], u8[8]; const v4u vv = *(const LAS v4u*)(sVT + d * TS + s8);
#pragma unroll
                for (int jj = 0; jj < 8; ++jj) { const float be = sVec[64 + s8 + jj]; v[jj] = bf2f(sKb[(s8 + jj) * PS + d]) * be * sVec[128 + s8 + jj]; u8[jj] = ((jj & 1) ? bfhi(vv[jj >> 1]) : bflo(vv[jj >> 1])) * be; }
                *(LAS bf16x8*)(sKgT + d * TS + s8) = pack8(v); *(LAS bf16x8*)(sVT + d * TS + s8) = pack8(u8); }
        }
        __syncthreads();
        {
            const LAS bf16* sTb = (const LAS bf16*)sM; const LAS bf16* sKgT = sQb; LAS bf16* sW = (LAS bf16*)((LAS unsigned char*)sM + 9216);
            const int st_ = w >> 1;
            const bf16x8 t0 = lds_frag(sTb, 16 * st_, TS, 0, lane), t1 = lds_frag(sTb, 16 * st_, TS, 32, lane);
#pragma unroll
            for (int c4_ = 0; c4_ < 4; ++c4_) { const int ct = (w & 1) * 4 + c4_;
                f32x4 aw = {0.f, 0.f, 0.f, 0.f}, au = {0.f, 0.f, 0.f, 0.f};
                aw = mfma16(lds_frag(sKgT, 16 * ct, TS, 0, lane), t0, aw); aw = mfma16(lds_frag(sKgT, 16 * ct, TS, 32, lane), t1, aw);
                au = mfma16(t0, lds_frag(sVT, 16 * ct, TS, 0, lane), au); au = mfma16(t1, lds_frag(sVT, 16 * ct, TS, 32, lane), au);
                *(LAS unsigned long long*)(sW + (16 * st_ + r) * PS + 16 * ct + 4 * q4) = pack4(aw);
                *(GAS unsigned long long*)(GUT + (ct * 4 + st_) * 256 + lane * 4) = pack4(au); }
        }
        __syncthreads();
        { const LAS bf16* sW = (const LAS bf16*)((LAS unsigned char*)sM + 9216);
            for (int f = w; f < 16; f += NWAVES) { const int tile = f >> 2, ks = f & 3;
                *(GAS v4u*)(GW + f * 512 + lane * 8) = *(const LAS v4u*)(sW + (16 * tile + r) * PS + 32 * ks + 8 * q4); } }
    }
#undef GW
#undef GKT
#undef GQG
#undef GUT
#undef GT
#undef GQK
#undef GVEC
}
__device__ __forceinline__ void gdn_scan_phase(CArgs a, int l, LAS unsigned char* lds, const int b, const int head, const int eb, int tid) {
    asm volatile("" : "+v"(tid));
    constexpr int PS = 136, TS = 72, O_ST = 0, O_RT = 34816, O_VN = O_RT + 9216, O_VC = O_VN + 9216;
    bf16* YMIX = (bf16*)(a->ws + WS_YMIX);
    const int lane = tid & 63, w = tid >> 6, r = lane & 15, q4 = lane >> 4, st = w >> 1, eh = w & 1;
    LAS bf16* sRT = (LAS bf16*)(lds + O_RT); LAS bf16* sVN = (LAS bf16*)(lds + O_VN); LAS bf16* sVC = (LAS bf16*)(lds + O_VC);
    {
        const size_t u0 = (size_t)(b * 4 + head) * 64;
        const bf16* pW = (const bf16*)(a->ws + WS_GD_K) + u0 * 8192 + (st * 4) * 512 + lane * 8; const bf16* pQG = (const bf16*)(a->ws + WS_GD_QG) + u0 * 8192 + (st * 4) * 512 + lane * 8;
        const bf16* pQK = (const bf16*)(a->ws + WS_GD_QK) + u0 * 4096 + (st * 2) * 512 + lane * 8;
        const bf16* pKT = (const bf16*)(a->ws + WS_GD_KT) + u0 * 8192 + (w * 2) * 512 + lane * 8;
        const bf16* pUT = (const bf16*)(a->ws + WS_GD_VT) + u0 * 8192 + (size_t)(((eb * 4 + 2 * eh) * 4 + st) * 256) + lane * 4;
        const float* pVec = (const float*)(a->ws + WS_GD_VEC) + u0 * 256 + 16 * st + 4 * q4;
        v4u xW[4], yQG[4], yQK[2], xKT[2], nQG[4], nQK[2]; unsigned long long uT[2]; f32x4 c4; float gl;
#define GD_LD_A(nn) do { _Pragma("unroll") for (int ks = 0; ks < 4; ++ks) xW[ks] = *(const GAS v4u*)(pW + (size_t)(nn) * 8192 + 512 * ks); \
            _Pragma("unroll") for (int j = 0; j < 2; ++j) uT[j] = *(const GAS unsigned long long*)(pUT + (size_t)(nn) * 8192 + j * 1024); \
            c4 = *(const GAS f32x4*)(pVec + (size_t)(nn) * 256 + 128); } while (0)
#define GD_LD_C(nn, QG_, QK_) do { _Pragma("unroll") for (int ks = 0; ks < 4; ++ks) QG_[ks] = *(const GAS v4u*)(pQG + (size_t)(nn) * 8192 + 512 * ks); \
            _Pragma("unroll") for (int ks = 0; ks < 2; ++ks) QK_[ks] = *(const GAS v4u*)(pQK + (size_t)(nn) * 4096 + 512 * ks); } while (0)
#define GD_LD_D(nn) do { _Pragma("unroll") for (int ks = 0; ks < 2; ++ks) xKT[ks] = *(const GAS v4u*)(pKT + (size_t)(nn) * 8192 + 512 * ks); gl = pVec[(size_t)(nn) * 256 + 192 - (16 * st + 4 * q4)]; } while (0)
        __syncthreads();
        GD_LD_A(0); GD_LD_C(0, yQG, yQK); GD_LD_D(0);
        for (int i = tid; i < 17408 / 4; i += NTHR) ((LAS unsigned*)(lds + O_ST))[i] = 0u;
        f32x4 accS[4];
#pragma unroll
        for (int et = 0; et < 4; ++et) accS[et] = (f32x4){0.f, 0.f, 0.f, 0.f};
        __syncthreads();
        for (int n = 0; n < 64; ++n) {
            const int cur = n & 1; const LAS bf16* sST = (const LAS bf16*)(lds + O_ST + cur * 17408); LAS bf16* sSTn = (LAS bf16*)(lds + O_ST + (cur ^ 1) * 17408);
            const int nn = n + 1 < 64 ? n + 1 : n;
            {
                bf16x8 fs[2][4];
#pragma unroll
                for (int j = 0; j < 2; ++j)
#pragma unroll
                    for (int ks = 0; ks < 4; ++ks) fs[j][ks] = lds_frag(sST, 16 * (2 * eh + j), PS, 32 * ks, lane);
                __builtin_amdgcn_sched_barrier(0);
#pragma unroll
                for (int j = 0; j < 2; ++j) { const int e0 = 16 * (2 * eh + j); f32x4 acc = {0.f, 0.f, 0.f, 0.f};
#pragma unroll
                    for (int ks = 0; ks < 4; ++ks) acc = mfma16(__builtin_bit_cast(bf16x8, xW[ks]), fs[j][ks], acc);
                    const unsigned ulo = (unsigned)uT[j], uhi = (unsigned)(uT[j] >> 32); f32x4 vn;
                    vn[0] = bflo(ulo) - acc[0]; vn[1] = bfhi(ulo) - acc[1]; vn[2] = bflo(uhi) - acc[2]; vn[3] = bfhi(uhi) - acc[3];
                    *(LAS unsigned long long*)(sVN + (e0 + r) * TS + 16 * st + 4 * q4) = pack4(vn); *(LAS unsigned long long*)(sVC + (e0 + r) * TS + 16 * st + 4 * q4) = pack4(vn * c4); }
            }
            GD_LD_A(nn); GD_LD_C(nn, nQG, nQK);
            WG_BAR();
            {
                bf16x8 fv[4][2];
#pragma unroll
                for (int et = 0; et < 4; ++et)
#pragma unroll
                    for (int ks = 0; ks < 2; ++ks) fv[et][ks] = lds_frag(sVC, 16 * et, TS, 32 * ks, lane);
                __builtin_amdgcn_sched_barrier(0);
#pragma unroll
                for (int et = 0; et < 4; ++et) { accS[et] = accS[et] * gl;
#pragma unroll
                    for (int ks = 0; ks < 2; ++ks) accS[et] = mfma16(__builtin_bit_cast(bf16x8, xKT[ks]), fv[et][ks], accS[et]);
                    *(LAS unsigned long long*)(sSTn + (16 * et + r) * PS + 16 * w + 4 * q4) = pack4(accS[et]); }
            }
            GD_LD_D(nn);
            {
                bf16x8 fs[2][4], fn[2][2];
#pragma unroll
                for (int j = 0; j < 2; ++j) {
#pragma unroll
                    for (int ks = 0; ks < 4; ++ks) fs[j][ks] = lds_frag(sST, 16 * (2 * eh + j), PS, 32 * ks, lane);
#pragma unroll
                    for (int ks = 0; ks < 2; ++ks) fn[j][ks] = lds_frag(sVN, 16 * (2 * eh + j), TS, 32 * ks, lane); }
                __builtin_amdgcn_sched_barrier(0);
#pragma unroll
                for (int j = 0; j < 2; ++j) { const int e0 = 16 * (2 * eh + j); f32x4 acc = {0.f, 0.f, 0.f, 0.f};
#pragma unroll
                    for (int ks = 0; ks < 4; ++ks) acc = mfma16(fs[j][ks], __builtin_bit_cast(bf16x8, yQG[ks]), acc);
#pragma unroll
                    for (int ks = 0; ks < 2; ++ks) acc = mfma16(fn[j][ks], __builtin_bit_cast(bf16x8, yQK[ks]), acc);
                    *(GAS unsigned long long*)(YMIX + ((size_t)b * SEQ + n * 64 + 16 * st + r) * DMIX + 1024 + head * 128 + eb * 64 + e0 + 4 * q4) = pack4(acc); }
            }
#pragma unroll
            for (int ks = 0; ks < 4; ++ks) yQG[ks] = nQG[ks];
#pragma unroll
            for (int ks = 0; ks < 2; ++ks) yQK[ks] = nQK[ks];
            WG_BAR();
        }
#undef GD_LD_A
#undef GD_LD_C
#undef GD_LD_D
    }
}

__device__ __forceinline__ void gdn_rec_phase(CArgs a, int l, LAS unsigned char* lds, int wg, int G, int tid) {
    asm volatile("" : "+v"(tid));
    constexpr int TB = 32;
    LAS float* sQ = (LAS float*)lds; LAS float* sK = sQ + TB * 128; LAS float* sV = sK + TB * 128; LAS float* sBe = sV + TB * 8; LAS float* sAl = sBe + TB; LAS float* sO = sAl + TB;
    const bf16* PROJ = (const bf16*)(a->ws + WS_PROJ); bf16* YMIX = (bf16*)(a->ws + WS_YMIX);
    const float* cw = a->in[I_GCW] + (size_t)l * 4 * 1536;
    const int lane = tid & 63, w = tid >> 6;
    for (int unit = wg; unit < 256; unit += G) {
        const int b = unit >> 6, head = (unit >> 4) & 3, eb = unit & 15;
        const float nA = -__expf(a->in[I_GALOG][l * 4 + head]), dtb = a->in[I_GDTB][l * 4 + head];
        float S0 = 0.f, S1 = 0.f;
        for (int t0 = 0; t0 < SEQ; t0 += TB) {
            __syncthreads();
            for (int idx = tid; idx < TB * 264; idx += NTHR) {
                const int tt = idx / 264, ci = idx % 264, t = t0 + tt;
                const int ch = ci < 128 ? head * 128 + ci : (ci < 256 ? 512 + head * 128 + (ci - 128) : 1024 + head * 128 + eb * 8 + (ci - 256));
                float acc = 0.f;
#pragma unroll
                for (int k = 0; k < 4; ++k) { const int ts = t - 3 + k; if (ts >= 0) acc += cw[k * 1536 + ch] * bf2f(PROJ[(size_t)(b * SEQ + ts) * NPROJ + O_QKV + ch]); }
                const float v = siluf(acc);
                if (ci < 128) sQ[tt * 128 + ci] = v; else if (ci < 256) sK[tt * 128 + ci - 128] = v; else sV[tt * 8 + ci - 256] = v;
            }
            if (tid < TB) { const size_t ro = (size_t)(b * SEQ + t0 + tid) * NPROJ; const float braw = bf2f(PROJ[ro + O_GB + head]), araw = bf2f(PROJ[ro + O_GA + head]);
                sBe[tid] = sigmoidf_(braw); sAl[tid] = __expf(nA * softplusf_(araw + dtb)); }
            __syncthreads();
            for (int tt = w; tt < TB; tt += NWAVES) {
                const float q0 = sQ[tt * 128 + lane], q1 = sQ[tt * 128 + 64 + lane], k0 = sK[tt * 128 + lane], k1 = sK[tt * 128 + 64 + lane];
                const float sq = rsqrtf(wave_sum(q0 * q0 + q1 * q1) + 1e-6f) * 0.08838834764831845f, sk = rsqrtf(wave_sum(k0 * k0 + k1 * k1) + 1e-6f);
                sQ[tt * 128 + lane] = q0 * sq; sQ[tt * 128 + 64 + lane] = q1 * sq; sK[tt * 128 + lane] = k0 * sk; sK[tt * 128 + 64 + lane] = k1 * sk;
            }
            __syncthreads();
#pragma unroll 2
            for (int tt = 0; tt < TB; ++tt) {
                const float k0 = sK[tt * 128 + lane], k1 = sK[tt * 128 + 64 + lane], q0 = sQ[tt * 128 + lane], q1 = sQ[tt * 128 + 64 + lane];
                const float al = sAl[tt], be = sBe[tt], v = sV[tt * 8 + w];
                const float dot = wave_sum(k0 * S0 + k1 * S1);
                const float vn = be * (v - al * dot);
                S0 = al * S0 + k0 * vn; S1 = al * S1 + k1 * vn;
                const float od = wave_sum(q0 * S0 + q1 * S1);
                if (lane == 0) sO[tt * 8 + w] = od;
            }
            __syncthreads();
            if (tid < TB * 8) { const int tt = tid >> 3, i = tid & 7; YMIX[(size_t)(b * SEQ + t0 + tt) * DMIX + 1024 + head * 128 + eb * 8 + i] = (bf16)f2bf(sO[tid]); }
        }
    }
}

__device__ __forceinline__ void hgrn_rec_phase(CArgs a, int l, LAS unsigned char* lds, int wg, int G, int tid) {
    asm volatile("" : "+v"(tid));
    constexpr int TB = 32;
    LAS float* sQ = (LAS float*)lds; LAS float* sF = sQ + TB * 128; LAS float* sV = sF + TB * 128; LAS float* sO = sV + TB * 8; LAS float* sLb = sO + TB * 8;
    const bf16* PROJ = (const bf16*)(a->ws + WS_PROJ); bf16* YMIX = (bf16*)(a->ws + WS_YMIX);
    const int lane = tid & 63, w = tid >> 6;
    for (int unit = wg; unit < 256; unit += G) {
        const int b = unit >> 6, head = (unit >> 4) & 3, eb = unit & 15;
        __syncthreads();
        if (tid < 128) {
            const int c = head * 128 + tid; float lg[DEPTH], mx = -1e30f;
#pragma unroll
            for (int j = 0; j < DEPTH; ++j) { lg[j] = a->in[I_HLB][j * 512 + c]; mx = fmaxf(mx, lg[j]); }
            float den = 0.f, num = 0.f;
#pragma unroll
            for (int j = 0; j < DEPTH; ++j) { const float e = __expf(lg[j] - mx); den += e; if (j >= 1 && j <= l) num += e; }
            sLb[tid] = num / den;
        }
        float S0 = 0.f, S1 = 0.f;
        for (int t0 = 0; t0 < SEQ; t0 += TB) {
            __syncthreads();
            for (int idx = tid; idx < TB * 264; idx += NTHR) {
                const int tt = idx / 264, ci = idx % 264; const size_t ro = (size_t)(b * SEQ + t0 + tt) * NPROJ;
                if (ci < 128) sQ[tt * 128 + ci] = siluf(bf2f(PROJ[ro + O_HQ + head * 128 + ci]));
                else if (ci < 256) { const int d = ci - 128; const float lb = sLb[d]; sF[tt * 128 + d] = lb + (1.f - lb) * sigmoidf_(bf2f(PROJ[ro + O_HF + head * 128 + d])); }
                else sV[tt * 8 + ci - 256] = bf2f(PROJ[ro + O_HI + head * 128 + eb * 8 + (ci - 256)]);
            }
            __syncthreads();
#pragma unroll 2
            for (int tt = 0; tt < TB; ++tt) {
                const float f0 = sF[tt * 128 + lane], f1 = sF[tt * 128 + 64 + lane], q0 = sQ[tt * 128 + lane], q1 = sQ[tt * 128 + 64 + lane], v = sV[tt * 8 + w];
                S0 = f0 * S0 + (1.f - f0) * v; S1 = f1 * S1 + (1.f - f1) * v;
                const float od = wave_sum(q0 * S0 + q1 * S1);
                if (lane == 0) sO[tt * 8 + w] = od;
            }
            __syncthreads();
            if (tid < TB * 8) { const int tt = tid >> 3, i = tid & 7; YMIX[(size_t)(b * SEQ + t0 + tt) * DMIX + 1536 + head * 128 + eb * 8 + i] = (bf16)f2bf(sO[tid]); }
        }
    }
}

__device__ __forceinline__ void mix_post_phase(CArgs a, int l, int wg, int G, int tid) {
    asm volatile("" : "+v"(tid));
    const bf16* PROJ = (const bf16*)(a->ws + WS_PROJ); bf16* YMIX = (bf16*)(a->ws + WS_YMIX);
    const int lane = tid & 63, gw = wg * NWAVES + (tid >> 6), NGW = G * NWAVES;
    const float* snw = a->in[I_SNW] + l * 1024; const float* gnw = a->in[I_GNW] + l * 128; const float* hnw = a->in[I_HNW] + l * 128;
    for (int row = gw; row < M; row += NGW) {
        const bf16* pr = PROJ + (size_t)row * NPROJ; bf16* yr = YMIX + (size_t)row * DMIX;
#pragma unroll
        for (int j = 0; j < 2; ++j) {
            const int ch = j * 512 + lane * 8; const v4u yv = *(const GAS v4u*)(yr + ch), zv = *(const GAS v4u*)(pr + O_Z + ch);
            float v[8]; float ss = 0.f;
#pragma unroll
            for (int i = 0; i < 4; ++i) { v[2 * i] = bflo(yv[i]) * siluf(bflo(zv[i])); v[2 * i + 1] = bfhi(yv[i]) * siluf(bfhi(zv[i])); ss += v[2 * i] * v[2 * i] + v[2 * i + 1] * v[2 * i + 1]; }
            const float rstd = rsqrtf(wave_sum(ss) * (1.f / 512.f) + 1e-6f);
            v4u o;
#pragma unroll
            for (int i = 0; i < 4; ++i) o[i] = pk2(v[2 * i] * rstd * snw[ch + 2 * i], v[2 * i + 1] * rstd * snw[ch + 2 * i + 1]);
            *(GAS v4u*)(yr + ch) = o;
        }
#pragma unroll
        for (int part = 0; part < 2; ++part) {
            const int ch = lane * 8, yo = 1024 + part * 512 + ch, go = (part == 0 ? O_GG : O_HG) + ch; const float* nw = part == 0 ? gnw : hnw;
            const v4u yv = *(const GAS v4u*)(yr + yo), gv = *(const GAS v4u*)(pr + go);
            float v[8]; float ss = 0.f;
#pragma unroll
            for (int i = 0; i < 4; ++i) { v[2 * i] = bflo(yv[i]); v[2 * i + 1] = bfhi(yv[i]); ss += v[2 * i] * v[2 * i] + v[2 * i + 1] * v[2 * i + 1]; }
            ss = row16_sum(ss);
            const float rstd = rsqrtf(ss * (1.f / 128.f) + 1e-6f);
            v4u o;
#pragma unroll
            for (int i = 0; i < 4; ++i) { const int c = (ch & 127) + 2 * i; o[i] = pk2(v[2 * i] * rstd * nw[c] * siluf(bflo(gv[i])), v[2 * i + 1] * rstd * nw[c + 1] * siluf(bfhi(gv[i]))); }
            *(GAS v4u*)(yr + yo) = o;
        }
    }
}

__device__ __forceinline__ void moe_tables(const gu32* cnt, LAS unsigned char* lds, int tid) {
    LAS int* tab = (LAS int*)(lds + LDS_OFF_TAB);
    __syncthreads();
    if (tid == 0) { int p = 0, q = 0;
        for (int e = 0; e < 16; ++e) { const int c = (int)__hip_atomic_load(cnt + e, RLX_AGENT); tab[e] = p; tab[17 + e] = q; p += (c + 255) & ~255; q += c; }
        tab[16] = p; tab[33] = q; }
    __syncthreads();
}
template <bool ROUTER>
__device__ __forceinline__ void ln_phase(CArgs a, int l, const float* gam, const float* bet, LAS unsigned char* lds, int wg, int G, int tid) {
    asm volatile("" : "+v"(tid));
    const int lane = tid & 63, wave = tid >> 6, gw = wg * NWAVES + wave, NGW = G * NWAVES;
    const float* ADD = (const float*)(a->ws + WS_MIX); float* H = a->out; bf16* HB = (bf16*)(a->ws + WS_HB);
    gu32* cnt = (gu32*)(a->ws + WS_CTL) + CW_CNT + l * 16;
    LAS float* sW = (LAS float*)lds;
    LAS float* sL = sW + 20 * D + wave * 32;
    LAS int* sCnt = (LAS int*)(sW + 20 * D + 256);
    LAS unsigned* sEnt = (LAS unsigned*)(sCnt + 32);
    constexpr int MAXENT = 2 * NWAVES * 8;
    if (ROUTER) {
        __syncthreads();
        const float* wrg = a->in[I_WRG] + (size_t)l * D * 4; const float* wre = a->in[I_WRE] + (size_t)l * D * 16;
        for (int i = tid; i < D * 20; i += NTHR) { const int c = i >> 10, k = i & 1023; sW[i] = c < 4 ? wrg[k * 4 + c] : wre[k * 16 + c - 4]; }
        if (tid < 32) sCnt[tid] = 0;
        __syncthreads();
    } else moe_tables(cnt, lds, tid);
    const LAS int* tab = (const LAS int*)(lds + LDS_OFF_TAB);
    f32x4 gv[4], bv[4];
#pragma unroll
    for (int j = 0; j < 4; ++j) { gv[j] = *(const f32x4*)(gam + 4 * lane + 256 * j); bv[j] = *(const f32x4*)(bet + 4 * lane + 256 * j); }
    int kk = 0;
    for (int row = gw; row < M; row += NGW, ++kk) {
        f32x4 v[4]; float s = 0.f;
        if (ROUTER) {
#pragma unroll
            for (int j = 0; j < 4; ++j) { const f32x4 hv = *(const GAS f32x4*)(H + (size_t)row * D + 4 * lane + 256 * j), av = *(const GAS f32x4*)(ADD + (size_t)row * D + 4 * lane + 256 * j);
                v[j] = hv * DN_ALPHA + av; s += (v[j].x + v[j].y) + (v[j].z + v[j].w); }
        } else {
            const unsigned s0 = ((const GAS unsigned*)(a->ws + WS_SLOT))[2 * row], s1 = ((const GAS unsigned*)(a->ws + WS_SLOT))[2 * row + 1];
            const bf16* y0 = (const bf16*)(a->ws + WS_YS) + (size_t)(tab[s0 >> 16] + (int)(s0 & 0xffffu)) * D; const bf16* y1 = (const bf16*)(a->ws + WS_YS) + (size_t)(tab[s1 >> 16] + (int)(s1 & 0xffffu)) * D;
#pragma unroll
            for (int j = 0; j < 4; ++j) { const f32x4 hv = *(const GAS f32x4*)(H + (size_t)row * D + 4 * lane + 256 * j);
                const unsigned long long p0 = *(const GAS unsigned long long*)(y0 + 4 * lane + 256 * j), p1 = *(const GAS unsigned long long*)(y1 + 4 * lane + 256 * j);
                f32x4 av; av.x = bflo((unsigned)p0) + bflo((unsigned)p1); av.y = bfhi((unsigned)p0) + bfhi((unsigned)p1); av.z = bflo((unsigned)(p0 >> 32)) + bflo((unsigned)(p1 >> 32)); av.w = bfhi((unsigned)(p0 >> 32)) + bfhi((unsigned)(p1 >> 32));
                v[j] = hv * DN_ALPHA + av; s += (v[j].x + v[j].y) + (v[j].z + v[j].w); }
        }
        const float mean = wave_sum(s) * (1.f / D); float s2 = 0.f;
#pragma unroll
        for (int j = 0; j < 4; ++j) { v[j] = v[j] - mean; s2 += (v[j].x * v[j].x + v[j].y * v[j].y) + (v[j].z * v[j].z + v[j].w * v[j].w); }
        const float rstd = rsqrtf(wave_sum(s2) * (1.f / D) + LN_EPS);
#pragma unroll
        for (int j = 0; j < 4; ++j) { v[j] = v[j] * rstd * gv[j] + bv[j];
            *(GAS f32x4*)(H + (size_t)row * D + 4 * lane + 256 * j) = v[j];
            *(GAS unsigned long long*)(HB + (size_t)row * D + 4 * lane + 256 * j) = (unsigned long long)pk2(v[j].x, v[j].y) | ((unsigned long long)pk2(v[j].z, v[j].w) << 32); }
        if (ROUTER) {
            float lg[20];
#pragma unroll 1
            for (int c = 0; c < 20; ++c) { float p = 0.f;
#pragma unroll
                for (int j = 0; j < 4; ++j) { const f32x4 wv = *(const LAS f32x4*)(sW + c * D + 4 * lane + 256 * j); p += (v[j].x * wv.x + v[j].y * wv.y) + (v[j].z * wv.z + v[j].w * wv.w); }
                p = wave_sum(p); if (lane == 0) sL[c] = p; }
#pragma unroll
            for (int c = 0; c < 20; ++c) lg[c] = sL[c];
            float pg[4], mx = -1e30f; int gi = 0;
#pragma unroll
            for (int c = 0; c < 4; ++c) { pg[c] = lg[c] + a->in[I_BRG][l * 4 + c]; if (pg[c] > mx) { mx = pg[c]; gi = c; } }
            float den = 0.f;
#pragma unroll
            for (int c = 0; c < 4; ++c) den += __expf(pg[c] - mx);
            const float g_p = 1.0f / den;
            float le[4], emx = -1e30f; int i1 = 0;
#pragma unroll
            for (int c = 0; c < 4; ++c) { float x = 0.f;
#pragma unroll
                for (int gg = 0; gg < 4; ++gg) x = (gi == gg) ? lg[4 + gg * 4 + c] + a->in[I_BRE][l * 16 + gg * 4 + c] : x;
                le[c] = x; if (x > emx) { emx = x; i1 = c; } }
            float e2mx = -1e30f; int i2 = 0;
#pragma unroll
            for (int c = 0; c < 4; ++c) if (c != i1 && le[c] > e2mx) { e2mx = le[c]; i2 = c; }
            const float x2 = __expf(e2mx - emx), w1 = g_p / (1.0f + x2), w2 = g_p * x2 / (1.0f + x2);
            if (lane < 2) {
                const int e = gi * 4 + (lane == 0 ? i1 : i2); const float wv = lane == 0 ? w1 : w2;
                if (kk < 8) { const int lp = __hip_atomic_fetch_add(sCnt + e, 1, __ATOMIC_RELAXED, __HIP_MEMORY_SCOPE_WORKGROUP); LAS unsigned* en = sEnt + ((wave * 8 + kk) * 2 + lane) * 4;
                    en[0] = (unsigned)row; en[1] = (unsigned)e; en[2] = (unsigned)lp; en[3] = __builtin_bit_cast(unsigned, wv); }
                else { const int pos = (int)__hip_atomic_fetch_add(cnt + e, 1u, RLX_AGENT);
                    ((GAS int*)(a->ws + WS_LTOK))[e * M + pos] = row; ((GAS float*)(a->ws + WS_LW))[e * M + pos] = wv; ((GAS unsigned*)(a->ws + WS_SLOT))[2 * row + lane] = ((unsigned)e << 16) | (unsigned)pos; }
            }
        }
    }
    if (ROUTER) {
        __syncthreads();
        if (tid < 16) sCnt[16 + tid] = (int)__hip_atomic_fetch_add(cnt + tid, (unsigned)sCnt[tid], RLX_AGENT);
        __syncthreads();
        const int nk = kk < 8 ? kk : 8;
        if (tid < MAXENT) { const int wv_ = tid >> 4, k_ = (tid >> 1) & 7;
            const int rows_w = (M - (wg * NWAVES + wv_) + NGW - 1) / NGW; const int nkw = rows_w < 8 ? rows_w : 8;
            if (k_ < nkw) { const LAS unsigned* en = sEnt + tid * 4; const int e = (int)en[1], pos = sCnt[16 + e] + (int)en[2];
                ((GAS int*)(a->ws + WS_LTOK))[e * M + pos] = (int)en[0]; ((GAS unsigned*)(a->ws + WS_LW))[e * M + pos] = en[3]; ((GAS unsigned*)(a->ws + WS_SLOT))[2 * en[0] + (tid & 1)] = ((unsigned)e << 16) | (unsigned)pos; } }
        (void)nk;
    }
}
__device__ __forceinline__ void moe_gather_phase(CArgs a, int l, LAS unsigned char* lds, int wg, int G, int tid) {
    asm volatile("" : "+v"(tid));
    const int lane = tid & 63, gw = wg * NWAVES + (tid >> 6), NGW = G * NWAVES;
    moe_tables((gu32*)(a->ws + WS_CTL) + CW_CNT + l * 16, lds, tid);
    const LAS int* tab = (const LAS int*)(lds + LDS_OFF_TAB);
    const bf16* HB = (const bf16*)(a->ws + WS_HB); bf16* XS = (bf16*)(a->ws + WS_XS);
    for (int idx = gw; idx < 2 * M; idx += NGW) {
        int e = 0;
#pragma unroll
        for (int k = 1; k < 16; ++k) e += (tab[17 + k] <= idx) ? 1 : 0;
        const int pos = idx - tab[17 + e], dst = tab[e] + pos;
        const int row = ((const GAS int*)(a->ws + WS_LTOK))[e * M + pos];
        const v4u x0 = *(const GAS v4u*)(HB + (size_t)row * D + 8 * lane), x1 = *(const GAS v4u*)(HB + (size_t)row * D + 512 + 8 * lane);
        *(GAS v4u*)(XS + (size_t)dst * D + 8 * lane) = x0; *(GAS v4u*)(XS + (size_t)dst * D + 512 + 8 * lane) = x1;
        if (lane == 0) ((GAS float*)(a->ws + WS_WSORT))[dst] = ((const GAS float*)(a->ws + WS_LW))[e * M + pos];
    }
}

enum { P_IN = 0, P_PREP, P_SCAN, P_POST, P_OUT, P_LN1, P_GATHER, P_GU, P_DN, P_LN2, NPH };
constexpr int N_PHASES = 1 + DEPTH * NPH;
__global__ void __launch_bounds__(NTHR, 2) fwd(Args args) {
    extern __shared__ __attribute__((aligned(16))) unsigned char lds_raw[];
    LAS unsigned char* lds = (LAS unsigned char*)lds_raw;
    volatile LAS unsigned* MISC = (volatile LAS unsigned*)(lds + MISC_OFF);
    const int tid = threadIdx.x, G = gridDim.x, bx = blockIdx.x;
    unsigned char* ws0 = args.ws;
    gu32* ctl = (gu32*)(ws0 + WS_CTL);
    for (int u = tid; u < (LDS_BYTES - LDSCTL_OFF) / 4; u += NTHR) ((LAS unsigned*)(lds + LDSCTL_OFF))[u] = 0u;
    __syncthreads();
    const int lo = args.ph_lo, hi = args.ph_hi;
    const bool use_bar = (hi - lo) > 1;
    XcdBarrier bar; bar.bar = (unsigned*)(ctl + CW_BAR); bar.x = 0; bar.st = nullptr;
    if (use_bar) bar = xcd_barrier_post((unsigned*)(ctl + CW_BAR), MISC + 8);
#define IN(k) (lo <= (k) && (k) < hi)
#define SEAM(k) do { if (IN(k) && IN((k) + 1)) xcd_barrier(bar); } while (0)

    if (IN(0)) { p0_prologue(ARGS_HERE(), lds, bx, G, tid); weights_phase(ARGS_HERE(), 0, 1, lds, bx, G, tid); SEAM(0); }

    for (int l = 0; l < DEPTH; ++l) {
        const int base = 1 + l * NPH;
        unsigned char* ws = ws0; asm volatile("" : "+s"(ws));
        if (IN(base + P_IN)) {
            pg8::Gemm g{(const pg8::bf16_t*)(ws + WS_HB), (const pg8::bf16_t*)(ws + WS_WIN), M, NPROJ, D}; pg8::StaticOrder S; S.init(M, NPROJ, G, bx);
            pg8::EpiBf16<0> E{(pg8::bf16_t*)(ws + WS_PROJ), NPROJ, nullptr, 0, 0, 1.f};
            pg8::gemm_phase<pg8::EpiBf16<0>, pg8::StaticOrder, true, true>(lds + RING_OFF, g, S, E);
            SEAM(base + P_IN);
        }
        if (IN(base + P_PREP)) {
            hgrn_prep_phase(ARGS_HERE(), l, lds, bx, G, tid);
            ssd_prep_phase(ARGS_HERE(), l, lds, bx, G, tid);
            gdn_prep_phase(ARGS_HERE(), l, lds, bx, G, tid);
            SEAM(base + P_PREP); }
        if (IN(base + P_SCAN)) {
            if (G >= 192) {
                if (bx < 64) { const int pr = bx & 7, hh = bx >> 3; ssd_scan_phase(ARGS_HERE(), l, lds, pr >> 1, (pr & 1) * 8 + hh, tid); }
                else if (bx < 96) { const int x = (bx - 64) & 7, y = (bx - 64) >> 3, pr = x * 2 + (y >> 1); gdn_scan_phase(ARGS_HERE(), l, lds, pr >> 2, pr & 3, y & 1, tid); }
                else if (bx < 160) { const int x = (bx - 96) & 7, y = (bx - 96) >> 3, pr = x * 2 + (y >> 2); hgrn_scan_phase(ARGS_HERE(), l, lds, pr >> 2, pr & 3, y & 3, tid); }
                else { weights_phase(ARGS_HERE(), l, 14, lds, bx - 160, G - 160, tid);
                       if (l + 1 < DEPTH) weights_phase(ARGS_HERE(), l + 1, 1, lds, bx - 160, G - 160, tid); }
            }
            SEAM(base + P_SCAN); }
        if (IN(base + P_POST)) { mix_post_phase(ARGS_HERE(), l, bx, G, tid); SEAM(base + P_POST); }
        if (IN(base + P_OUT)) {
            pg8::Gemm g{(const pg8::bf16_t*)(ws + WS_YMIX), (const pg8::bf16_t*)(ws + WS_WOUT), M, D, DMIX}; pg8::StaticOrder S; S.init(M, D, G, bx);
            pg8::EpiF32 E{(float*)(ws + WS_MIX), D};
            pg8::gemm_phase<pg8::EpiF32, pg8::StaticOrder, true, true>(lds + RING_OFF, g, S, E);
            SEAM(base + P_OUT);
        }
        if (IN(base + P_LN1)) { CArgs a_ = ARGS_HERE(); ln_phase<true>(a_, l, a_->in[I_LN1G] + l * D, a_->in[I_LN1B] + l * D, lds, bx, G, tid); SEAM(base + P_LN1); }
        if (IN(base + P_GATHER)) { moe_gather_phase(ARGS_HERE(), l, lds, bx, G, tid); SEAM(base + P_GATHER); }
        if (IN(base + P_GU)) {
            moe_tables(ctl + CW_CNT + l * 16, lds, tid);
            pg8::Gemm g{(const pg8::bf16_t*)(ws + WS_XS), (const pg8::bf16_t*)(ws + WS_WGU), MAXROWS, NGU, D}; pg8::MoeOrder<2> S{(const LAS int*)(lds + LDS_OFF_TAB), G, bx};
            pg8::EpiSwiGLUs E{(pg8::bf16_t*)(ws + WS_HS), (const float*)(ws + WS_WSORT)};
            pg8::gemm_phase<pg8::EpiSwiGLUs, pg8::MoeOrder<2>, true, true>(lds + RING_OFF, g, S, E);
            SEAM(base + P_GU);
        }
        if (IN(base + P_DN)) {
            moe_tables(ctl + CW_CNT + l * 16, lds, tid);
            pg8::Gemm g{(const pg8::bf16_t*)(ws + WS_HS), (const pg8::bf16_t*)(ws + WS_WDN), MAXROWS, NEXP * D, DEXP}; pg8::MoeOrder<4> S{(const LAS int*)(lds + LDS_OFF_TAB), G, bx};
            pg8::EpiBf16s E{(pg8::bf16_t*)(ws + WS_YS)};
            pg8::gemm_phase<pg8::EpiBf16s, pg8::MoeOrder<4>, true, true>(lds + RING_OFF, g, S, E);
            SEAM(base + P_DN);
        }
        if (IN(base + P_LN2)) { CArgs a_ = ARGS_HERE(); ln_phase<false>(a_, l, a_->in[I_LN2G] + l * D, a_->in[I_LN2B] + l * D, lds, bx, G, tid); SEAM(base + P_LN2); }
    }
#undef IN
#undef SEAM
}

#ifndef MK_ONE_LAUNCH
#define MK_ONE_LAUNCH 1
#endif
extern "C" void kernel_launch(void* const* d_in, const int* in_sizes, int n_in, void* d_out, int out_size, void* d_ws, size_t ws_size, hipStream_t stream) {
    static int grid = 0;
    if (grid == 0) {
        if (n_in != 25 || out_size != M * D || ws_size < WS_END) { fprintf(stderr, "kernel_launch: unexpected shapes (n_in %d out %d ws %zu)\n", n_in, out_size, ws_size); grid = -1; return; }
        int dev = 0, cus = 0, per_cu = 0;
        if (hipGetDevice(&dev) != hipSuccess || hipDeviceGetAttribute(&cus, hipDeviceAttributeMultiprocessorCount, dev) != hipSuccess) { grid = -1; return; }
        if (hipFuncSetAttribute((const void*)fwd, hipFuncAttributeMaxDynamicSharedMemorySize, LDS_BYTES) != hipSuccess) { fprintf(stderr, "kernel_launch: hipFuncSetAttribute failed\n"); grid = -1; return; }
        if (hipOccupancyMaxActiveBlocksPerMultiprocessor(&per_cu, (const void*)fwd, NTHR, LDS_BYTES) != hipSuccess || per_cu < 1) { fprintf(stderr, "kernel_launch: occupancy query says %d\n", per_cu); (void)hipGetLastError(); grid = -1; return; }
        grid = cus;
    }
    if (grid < 0) return;
    if (hipMemsetAsync((char*)d_ws + WS_CTL, 0, CTL_ZERO_BYTES, stream) != hipSuccess) return;
    Args a{};
    for (int i = 0; i < 25; ++i) a.in[i] = (const float*)d_in[i];
    a.out = (float*)d_out; a.ws = (unsigned char*)d_ws;
#if MK_ONE_LAUNCH
    a.ph_lo = 0; a.ph_hi = N_PHASES;
    hipLaunchKernelGGL(fwd, dim3(grid), dim3(NTHR), LDS_BYTES, stream, a);
#else
    for (int p = 0; p < N_PHASES; ++p) { a.ph_lo = p; a.ph_hi = p + 1; hipLaunchKernelGGL(fwd, dim3(grid), dim3(NTHR), LDS_BYTES, stream, a); }
#endif
}
```

```cpp
#include <hip/hip_runtime.h>
#include <cstdio>
#include <cstdint>
namespace pg8 {
#define PG8_LAS __attribute__((address_space(3)))
typedef unsigned short bf16_t;
typedef short bf16x8 __attribute__((ext_vector_type(8)));
typedef float f32x4 __attribute__((ext_vector_type(4)));
typedef unsigned u32x4 __attribute__((ext_vector_type(4)));
constexpr int BM = 256, BK = 64, HALF = 128, HTB = HALF * BK * 2  , STAGE_BYTES = 8 * HTB, NXCD = 8, WGM = 8;

__host__ __device__ __forceinline__ int lds_byte(int r, int c) { const int st = (r >> 4) * 2 + (c >> 5), rr = r & 15, cc = c & 31, ob = rr * 64 + cc * 2; return st * 1024 + (ob ^ (((ob >> 9) & 1) << 5)); }
__host__ __device__ __forceinline__ void stage_rc(int b, int& R, int& C) { const int st = b / 1024, sb = b % 1024, swz = sb ^ (((sb >> 9) & 1) << 5); R = (st >> 1) * 16 + swz / 64; C = (st & 1) * 32 + (swz % 64) / 2; }
__host__ __device__ __forceinline__ int perm32(int rho) { const int n = rho >> 4, i = rho & 15; return 8 * (i >> 2) + 4 * n + (i & 3); }

struct Unit { int pm, pn; };
struct Gemm { const bf16_t* A; const bf16_t* Bt; int M, N, K; };

struct StaticOrder {
    int nM, nN, nwg, G, c;
    __host__ __device__ void init(int M, int N, int G_, int c_) { nM = M / BM; nN = N / BM; nwg = nM * nN; G = G_; c = c_; }
    __host__ __device__ bool next(int i, Unit& u) const {
        const long L = (long)i * G + c; if (L >= nwg) return false;
        int wgid = (int)L; { const int q = nwg / NXCD, r = nwg % NXCD, xcd = wgid % NXCD, off = wgid / NXCD; wgid = (xcd < r ? xcd * (q + 1) : r * (q + 1) + (xcd - r) * q) + off; }
        const int nig = WGM * nN, gid = wgid / nig, fm = gid * WGM, gsz = (nM - fm) < WGM ? (nM - fm) : WGM;
        u.pm = fm + ((wgid % nig) % gsz); u.pn = (wgid % nig) / gsz; return true;
    }
    __device__ __forceinline__ void a_ready(const Unit&) const {}
    __device__ __forceinline__ void done(const Unit&) const {}
};
__device__ __forceinline__ unsigned cvt_pk_bf16(float lo, float hi) { unsigned r; asm volatile("v_cvt_pk_bf16_f32 %0, %1, %2" : "=v"(r) : "v"(lo), "v"(hi)); return r; }
typedef float f32x2 __attribute__((ext_vector_type(2)));
__device__ __forceinline__ f32x2 gelu_pk(f32x2 v) {
    const f32x2 av = __builtin_elementwise_abs(v), d = av * 0.2316418882f + 1.0f;
    f32x2 t; t.x = __builtin_amdgcn_rcpf(d.x); t.y = __builtin_amdgcn_rcpf(d.y);
    f32x2 q = t * 0.5307027145f + (-0.7265760135f); q = q * t + 0.7107068705f; q = q * t + (-0.142248368f); q = q * t + 0.127414796f; q = q * t;
    const f32x2 s = (v * v) * (-0.72134752044f);
    f32x2 e; e.x = __builtin_amdgcn_exp2f(s.x); e.y = __builtin_amdgcn_exp2f(s.y);
    const f32x2 m = v * (q * e), r = v - m;
    f32x2 o; o.x = v.x < 0.f ? m.x : r.x; o.y = v.y < 0.f ? m.y : r.y; return o;
}

template <int ACT  > struct EpiBf16 {
    static constexpr bool PERM = true, AFTER_DRAIN = false; static_assert(ACT == 0 || ACT == 1, "EpiBf16: ACT is 0 (none) or 1 (gelu_pk)");
    bf16_t* O; int ldc; const float* bias; int split_cols; size_t split_stride; float scale0;
    __device__ __forceinline__ void operator()(const f32x4 (&acc)[2][2][4][2], const Unit& u, int wr, int wc, int fr, int fq) const {
        const int row0 = u.pm * BM + wr * 64 + fr; int colt = u.pn * BM; bf16_t* base = O;
        float sc = 1.f; if (split_cols) { const int t = colt / split_cols; base += (size_t)t * split_stride; colt -= t * split_cols; if (t == 0) sc = scale0; }
        const int col0 = colt + wc * 32 + 8 * fq, bcol0 = u.pn * BM + wc * 32 + 8 * fq;
        f32x4 bv[2][2];
#pragma unroll
        for (int bj = 0; bj < 2; ++bj)
#pragma unroll
            for (int n = 0; n < 2; ++n) bv[bj][n] = bias ? *(const f32x4*)(bias + bcol0 + bj * HALF + 4 * n) : (f32x4){0.f, 0.f, 0.f, 0.f};
#pragma unroll
        for (int ai = 0; ai < 2; ++ai)
#pragma unroll
            for (int m = 0; m < 4; ++m) { bf16_t* rowp = base + (size_t)(row0 + ai * HALF + m * 16) * ldc + col0;
#pragma unroll
                for (int bj = 0; bj < 2; ++bj) { f32x4 v0 = acc[ai][bj][m][0] + bv[bj][0], v1 = acc[ai][bj][m][1] + bv[bj][1];
                    if (ACT == 1) { f32x2 a = gelu_pk((f32x2){v0[0], v0[1]}), b = gelu_pk((f32x2){v0[2], v0[3]}), c = gelu_pk((f32x2){v1[0], v1[1]}), d = gelu_pk((f32x2){v1[2], v1[3]});
                        v0 = (f32x4){a.x, a.y, b.x, b.y}; v1 = (f32x4){c.x, c.y, d.x, d.y}; }
                    v0 = v0 * sc; v1 = v1 * sc; u32x4 w; w.x = cvt_pk_bf16(v0[0], v0[1]); w.y = cvt_pk_bf16(v0[2], v0[3]); w.z = cvt_pk_bf16(v1[0], v1[1]); w.w = cvt_pk_bf16(v1[2], v1[3]);
                    *(u32x4*)(rowp + bj * HALF) = w; } }
    }
};
struct EpiF32 {
    static constexpr bool PERM = false, AFTER_DRAIN = false;
    float* C; int ldc;
    __device__ __forceinline__ void operator()(const f32x4 (&acc)[2][2][4][2], const Unit& u, int wr, int wc, int fr, int fq) const {
        const int row0 = u.pm * BM + wr * 64 + fr, col0 = u.pn * BM + wc * 32 + 4 * fq;
#pragma unroll
        for (int ai = 0; ai < 2; ++ai)
#pragma unroll
            for (int m = 0; m < 4; ++m) { float* rowp = C + (size_t)(row0 + ai * HALF + m * 16) * ldc + col0;
#pragma unroll
                for (int bj = 0; bj < 2; ++bj)
#pragma unroll
                    for (int n = 0; n < 2; ++n) *(f32x4*)(rowp + bj * HALF + n * 16) = acc[ai][bj][m][n]; }
    }
};
__device__ __forceinline__ float silu_f(float x) { return x / (1.0f + __expf(-x)); }
struct EpiSwiGLU {
    static constexpr bool PERM = true, AFTER_DRAIN = false;
    bf16_t* H; int ldh; const float* comb; int ldcomb;
    __device__ __forceinline__ void operator()(const f32x4 (&acc)[2][2][4][2], const Unit& u, int wr, int wc, int fr, int fq) const {
        const int row0 = u.pm * BM + wr * 64 + fr, col0 = u.pn * 128 + wc * 32 + 8 * fq, e = u.pn >> 1;
#pragma unroll
        for (int ai = 0; ai < 2; ++ai)
#pragma unroll
            for (int m = 0; m < 4; ++m) { const int row = row0 + ai * HALF + m * 16; const float cw = comb[(size_t)row * ldcomb + e];
                const f32x4 g0 = acc[ai][0][m][0], g1 = acc[ai][0][m][1], u0 = acc[ai][1][m][0], u1 = acc[ai][1][m][1];
                f32x4 h0, h1;
#pragma unroll
                for (int j = 0; j < 4; ++j) { h0[j] = silu_f(g0[j]) * u0[j] * cw; h1[j] = silu_f(g1[j]) * u1[j] * cw; }
                u32x4 w; w.x = cvt_pk_bf16(h0[0], h0[1]); w.y = cvt_pk_bf16(h0[2], h0[3]); w.z = cvt_pk_bf16(h1[0], h1[1]); w.w = cvt_pk_bf16(h1[2], h1[3]);
                *(u32x4*)(H + (size_t)row * ldh + col0) = w; }
    }
};

template <int NSUB> struct MoeOrder {
    const PG8_LAS int* off; int G, c;
    __device__ __forceinline__ bool next(int i, Unit& u) const {
        const int L = i * G + c, x = L & 7, j = L >> 3, t = x + 8 * (j / NSUB), pnl = j % NSUB;
        if (t * 256 >= off[16]) return false;
        int e = 0;
#pragma unroll
        for (int k = 1; k < 16; ++k) e += (off[k] <= t * 256) ? 1 : 0;
        u.pm = t; u.pn = e * NSUB + pnl; return true;
    }
    __device__ __forceinline__ void a_ready(const Unit&) const {}
    __device__ __forceinline__ void done(const Unit&) const {}
};
struct EpiSwiGLUs {
    static constexpr bool PERM = true, AFTER_DRAIN = false;
    bf16_t* H; const float* wrow;
    __device__ __forceinline__ void operator()(const f32x4 (&acc)[2][2][4][2], const Unit& u, int wr, int wc, int fr, int fq) const {
        const int row0 = u.pm * BM + wr * 64 + fr, col0 = (u.pn & 1) * 128 + wc * 32 + 8 * fq;
#pragma unroll
        for (int ai = 0; ai < 2; ++ai)
#pragma unroll
            for (int m = 0; m < 4; ++m) { const int row = row0 + ai * HALF + m * 16; const float cw = wrow[row];
                const f32x4 g0 = acc[ai][0][m][0], g1 = acc[ai][0][m][1], u0 = acc[ai][1][m][0], u1 = acc[ai][1][m][1];
                f32x4 h0, h1;
#pragma unroll
                for (int j = 0; j < 4; ++j) { h0[j] = silu_f(g0[j]) * u0[j] * cw; h1[j] = silu_f(g1[j]) * u1[j] * cw; }
                u32x4 w; w.x = cvt_pk_bf16(h0[0], h0[1]); w.y = cvt_pk_bf16(h0[2], h0[3]); w.z = cvt_pk_bf16(h1[0], h1[1]); w.w = cvt_pk_bf16(h1[2], h1[3]);
                *(u32x4*)(H + (size_t)row * 256 + col0) = w; }
    }
};
struct EpiBf16s {
    static constexpr bool PERM = true, AFTER_DRAIN = false;
    bf16_t* O;
    __device__ __forceinline__ void operator()(const f32x4 (&acc)[2][2][4][2], const Unit& u, int wr, int wc, int fr, int fq) const {
        const int row0 = u.pm * BM + wr * 64 + fr, col0 = (u.pn & 3) * BM + wc * 32 + 8 * fq;
#pragma unroll
        for (int ai = 0; ai < 2; ++ai)
#pragma unroll
            for (int m = 0; m < 4; ++m) { bf16_t* rowp = O + (size_t)(row0 + ai * HALF + m * 16) * 1024 + col0;
#pragma unroll
                for (int bj = 0; bj < 2; ++bj) { const f32x4 v0 = acc[ai][bj][m][0], v1 = acc[ai][bj][m][1];
                    u32x4 w; w.x = cvt_pk_bf16(v0[0], v0[1]); w.y = cvt_pk_bf16(v0[2], v0[3]); w.z = cvt_pk_bf16(v1[0], v1[1]); w.w = cvt_pk_bf16(v1[2], v1[3]);
                    *(u32x4*)(rowp + bj * HALF) = w; } }
    }
};
template <class Epi, class Sched, bool ALIGN_EPI = false, bool SP2 = false>
__device__ __forceinline__ void gemm_phase(PG8_LAS unsigned char* lds, const Gemm g, const Sched& S, const Epi& E) {
    int tid_ = threadIdx.x; asm volatile("" : "+v"(tid_));
    const int tid = tid_, wid = __builtin_amdgcn_readfirstlane(tid >> 6), lane = tid & 63, wr = wid >> 2, wc = wid & 3, fr = lane & 15, fq = lane >> 4;
    const int K = g.K, nt = K / BK;
    unsigned voffA[2], voffB[2];
#pragma unroll
    for (int i = 0; i < 2; ++i) { int R, C; stage_rc(tid * 16 + i * 8192, R, C); const int Rb = Epi::PERM ? ((R & ~31) + perm32(R & 31)) : R;
        voffA[i] = (unsigned)(R * K + C) * 2u; voffB[i] = (unsigned)(Rb * K + C) * 2u; }
    const size_t kstep = (size_t)(BK * 2);
    const size_t hstep = (size_t)HALF * K * 2;
    const size_t tstep = 2 * hstep;
    const unsigned ldsw = (unsigned)wid * 1024u;
    const int aoff = lds_byte(wr * 64 + fr, fq * 8), boff = lds_byte(wc * 32 + fr, fq * 8);
#define PG8_SA(b, h) (((b) * 2 + (h)) * HTB)
#define PG8_SB(b, h) ((4 + (b) * 2 + (h)) * HTB)
#define PG8_STAGE(bufoff, gbase, voff) do { _Pragma("unroll") for (int _i = 0; _i < 2; ++_i) \
        __builtin_amdgcn_global_load_lds((const unsigned*)((const char*)(gbase) + (voff)[_i]), (PG8_LAS unsigned*)(lds + (bufoff) + ldsw + _i * 8192), 16, 0, 0); } while (0)
#define PG8_LDA(dst, b, h) do { _Pragma("unroll") for (int m = 0; m < 4; ++m) _Pragma("unroll") for (int k = 0; k < 2; ++k) dst[m][k] = *(const PG8_LAS bf16x8*)(lds + PG8_SA(b, h) + aoff + m * 2048 + k * 1024); } while (0)
#define PG8_LDB(dst, b, h) do { _Pragma("unroll") for (int n = 0; n < 2; ++n) _Pragma("unroll") for (int k = 0; k < 2; ++k) dst[n][k] = *(const PG8_LAS bf16x8*)(lds + PG8_SB(b, h) + boff + n * 2048 + k * 1024); } while (0)
#define PG8_MMA(ai, bj, At, Bt) do { __builtin_amdgcn_s_setprio(1); _Pragma("unroll") for (int m = 0; m < 4; ++m) _Pragma("unroll") for (int n = 0; n < 2; ++n) _Pragma("unroll") for (int k = 0; k < 2; ++k) \
        acc[ai][bj][m][n] = __builtin_amdgcn_mfma_f32_16x16x32_bf16(Bt[n][k], At[m][k], acc[ai][bj][m][n], 0, 0, 0); __builtin_amdgcn_s_setprio(0); } while (0)
#define PG8_WAIT_V(n) asm volatile("s_waitcnt vmcnt(" #n ")" ::: "memory")
#define PG8_WAIT_L(n) asm volatile("s_waitcnt lgkmcnt(" #n ")" ::: "memory")
#define PG8_BAR __builtin_amdgcn_s_barrier()
#define PG8_SCHED __builtin_amdgcn_sched_barrier(0)
    Unit cur, nxt; int ui = 0;
    if (!S.next(0, cur)) return;
    f32x4 acc[2][2][4][2];
#pragma unroll
    for (int a = 0; a < 2; ++a)
#pragma unroll
        for (int b = 0; b < 2; ++b)
#pragma unroll
            for (int m = 0; m < 4; ++m)
#pragma unroll
                for (int n = 0; n < 2; ++n) acc[a][b][m][n] = (f32x4){0.f, 0.f, 0.f, 0.f};
    bf16x8 At[4][2], B0[2][2], B1[2][2];
    const char* cA = (const char*)g.A + (size_t)cur.pm * tstep; const char* cB = (const char*)g.Bt + (size_t)cur.pn * tstep;
    S.a_ready(cur);
    if constexpr (SP2) {
        PG8_STAGE(PG8_SB(0, 0), cB, voffB); PG8_STAGE(PG8_SB(0, 1), cB + hstep, voffB); PG8_STAGE(PG8_SA(0, 0), cA, voffA); PG8_STAGE(PG8_SA(0, 1), cA + hstep, voffA);
        if (wr == 1) PG8_BAR;
        PG8_WAIT_V(2); PG8_BAR;
        PG8_STAGE(PG8_SB(1, 0), cB + kstep, voffB); PG8_STAGE(PG8_SA(1, 0), cA + kstep, voffA); PG8_STAGE(PG8_SB(1, 1), cB + hstep + kstep, voffB);
        PG8_WAIT_V(6); PG8_BAR;
    } else {
        PG8_STAGE(PG8_SB(0, 0), cB, voffB); PG8_STAGE(PG8_SA(0, 0), cA, voffA); PG8_STAGE(PG8_SB(0, 1), cB + hstep, voffB); PG8_STAGE(PG8_SA(0, 1), cA + hstep, voffA);
        if (wr == 1) PG8_BAR;
        PG8_WAIT_V(4); PG8_BAR;
        PG8_STAGE(PG8_SB(1, 0), cB + kstep, voffB); PG8_STAGE(PG8_SA(1, 0), cA + kstep, voffA); PG8_STAGE(PG8_SB(1, 1), cB + hstep + kstep, voffB);
        PG8_WAIT_V(6); PG8_BAR;
    }
    for (;;) {
        const bool has_next = S.next(ui + 1, nxt);
        const char* nA = has_next ? (const char*)g.A + (size_t)nxt.pm * tstep : cA; const char* nB = has_next ? (const char*)g.Bt + (size_t)nxt.pn * tstep : cB;
#pragma unroll 1
        for (int t = 0; t < nt; t += 2) {
            const bool last = (t == nt - 2);
            const char* a1 = cA + (size_t)(t + 1) * kstep;
            const char* a2 = last ? nA : cA + (size_t)(t + 2) * kstep; const char* b2 = last ? nB : cB + (size_t)(t + 2) * kstep;
            const char* a3 = a2 + kstep; const char* b3 = b2 + kstep;
            if (last && has_next) S.a_ready(nxt);
            if constexpr (SP2) {
            PG8_LDB(B0, 0, 0); PG8_LDB(B1, 0, 1); PG8_SCHED; PG8_LDA(At, 0, 0); PG8_STAGE(PG8_SA(1, 1), a1 + hstep, voffA);
            PG8_WAIT_V(8); PG8_WAIT_L(0); PG8_BAR; PG8_MMA(0, 0, At, B0); PG8_MMA(0, 1, At, B1); PG8_BAR; PG8_SCHED;
            PG8_LDA(At, 0, 1); PG8_STAGE(PG8_SB(0, 0), b2, voffB); PG8_STAGE(PG8_SB(0, 1), b2 + hstep, voffB); PG8_STAGE(PG8_SA(0, 0), a2, voffA);
            PG8_WAIT_V(8); PG8_WAIT_L(0); PG8_BAR; PG8_MMA(1, 0, At, B0); PG8_MMA(1, 1, At, B1); PG8_BAR; PG8_SCHED;
            PG8_LDB(B0, 1, 0); PG8_LDB(B1, 1, 1); PG8_SCHED; PG8_LDA(At, 1, 0); PG8_STAGE(PG8_SA(0, 1), a2 + hstep, voffA);
            PG8_WAIT_V(8); PG8_WAIT_L(0); PG8_BAR; PG8_MMA(0, 0, At, B0); PG8_MMA(0, 1, At, B1); PG8_BAR; PG8_SCHED;
            PG8_LDA(At, 1, 1); PG8_STAGE(PG8_SB(1, 0), b3, voffB); PG8_STAGE(PG8_SB(1, 1), b3 + hstep, voffB); PG8_STAGE(PG8_SA(1, 0), a3, voffA);
            PG8_WAIT_V(8); PG8_WAIT_L(0); PG8_BAR; PG8_MMA(1, 0, At, B0); PG8_MMA(1, 1, At, B1); PG8_BAR; PG8_SCHED;
            } else {
            PG8_LDB(B0, 0, 0); PG8_SCHED; PG8_LDA(At, 0, 0); PG8_STAGE(PG8_SA(1, 1), a1 + hstep, voffA);
            PG8_WAIT_L(8); PG8_BAR; PG8_WAIT_L(0); PG8_MMA(0, 0, At, B0); PG8_BAR; PG8_SCHED;
            PG8_LDB(B1, 0, 1); PG8_STAGE(PG8_SB(0, 0), b2, voffB);
            PG8_BAR; PG8_WAIT_L(0); PG8_MMA(0, 1, At, B1); PG8_BAR;
            PG8_LDA(At, 0, 1); PG8_STAGE(PG8_SA(0, 0), a2, voffA);
            PG8_BAR; PG8_WAIT_L(0); PG8_MMA(1, 0, At, B0); PG8_BAR; PG8_SCHED;
            PG8_STAGE(PG8_SB(0, 1), b2 + hstep, voffB);
            PG8_WAIT_V(6); PG8_BAR; PG8_MMA(1, 1, At, B1); PG8_BAR;
            PG8_LDB(B0, 1, 0); PG8_SCHED; PG8_LDA(At, 1, 0); PG8_STAGE(PG8_SA(0, 1), a2 + hstep, voffA);
            PG8_WAIT_L(8); PG8_BAR; PG8_WAIT_L(0); PG8_MMA(0, 0, At, B0); PG8_BAR; PG8_SCHED;
            PG8_LDB(B1, 1, 1); PG8_STAGE(PG8_SB(1, 0), b3, voffB);
            PG8_BAR; PG8_WAIT_L(0); PG8_MMA(0, 1, At, B1); PG8_BAR;
            PG8_LDA(At, 1, 1); PG8_STAGE(PG8_SA(1, 0), a3, voffA);
            PG8_BAR; PG8_WAIT_L(0); PG8_MMA(1, 0, At, B0); PG8_BAR; PG8_SCHED;
            PG8_STAGE(PG8_SB(1, 1), b3 + hstep, voffB);
            PG8_WAIT_V(6); PG8_BAR; PG8_MMA(1, 1, At, B1); PG8_BAR;
            }
        }
        if constexpr (ALIGN_EPI) { if (wr == 0) PG8_BAR; }
        if constexpr (!Epi::AFTER_DRAIN) { E(acc, cur, wr, wc, fr, fq); S.done(cur); }
        if (!has_next) break;
#pragma unroll
        for (int a = 0; a < 2; ++a)
#pragma unroll
            for (int b = 0; b < 2; ++b)
#pragma unroll
                for (int m = 0; m < 4; ++m)
#pragma unroll
                    for (int n = 0; n < 2; ++n) acc[a][b][m][n] = (f32x4){0.f, 0.f, 0.f, 0.f};
        cur = nxt; cA = nA; cB = nB; ++ui;
        if constexpr (ALIGN_EPI) { if (wr == 1) PG8_BAR; }
    }
    PG8_WAIT_V(0);
    if constexpr (!ALIGN_EPI) { if (wr == 0) PG8_BAR; }
    PG8_BAR;
    if constexpr (Epi::AFTER_DRAIN) { E.fused(acc, cur, wr, wc, fr, fq, lds, wid, lane); S.done(cur); }
#undef PG8_SA
#undef PG8_SB
#undef PG8_STAGE
#undef PG8_LDA
#undef PG8_LDB
#undef PG8_MMA
#undef PG8_WAIT_V
#undef PG8_WAIT_L
#undef PG8_BAR
#undef PG8_SCHED
}
}
#define GAS __attribute__((address_space(1)))
#define LAS __attribute__((address_space(3)))
typedef unsigned short bf16;
typedef unsigned v4u __attribute__((ext_vector_type(4)));
typedef float f32x4 __attribute__((ext_vector_type(4)));
typedef short bf16x8 __attribute__((ext_vector_type(8)));
typedef GAS unsigned gu32;
typedef GAS unsigned long long gu64;
#define RLX_AGENT __ATOMIC_RELAXED, __HIP_MEMORY_SCOPE_AGENT
#define LDS_WAIT() asm volatile("s_waitcnt lgkmcnt(0)" ::: "memory")
#define VM_WAIT() asm volatile("s_waitcnt vmcnt(0)" ::: "memory")
__device__ __forceinline__ unsigned long long rt() { return __builtin_amdgcn_s_memrealtime(); }
__device__ __forceinline__ unsigned f2bf(float f) { unsigned u = __builtin_bit_cast(unsigned, f); return (u + 0x7fffu + ((u >> 16) & 1u)) >> 16; }
__device__ __forceinline__ unsigned pk2(float lo, float hi) { return f2bf(lo) | (f2bf(hi) << 16); }

#define XB_TMO      128
#define XB_XCNT(j)  (256  + 64 * (j))
#define XB_XSUB(j)  (1280 + 64 * (j))
#define XB_XGEN(j)  (2304 + 64 * (j))
#define XB_TOP      3328
#define XB_TOPGEN   3392
#define XCD_BAR_WORDS 3456
#define XB_SPIN_CAP (1u << 18)

__device__ __forceinline__ unsigned xb_ld(unsigned* p)              { return __hip_atomic_load(p, __ATOMIC_RELAXED, __HIP_MEMORY_SCOPE_AGENT); }
__device__ __forceinline__ unsigned xb_add(unsigned* p, unsigned v) { return __hip_atomic_fetch_add(p, v, __ATOMIC_RELAXED, __HIP_MEMORY_SCOPE_AGENT); }
__device__ __forceinline__ unsigned xb_xcc_id() { return (unsigned)__builtin_amdgcn_s_getreg((3 << 11) | 20) & 0xFu; }
#define XB_SPIN(cond, bar) do { unsigned _sp = 0; while (cond) { __builtin_amdgcn_s_sleep(1); \
    if ((++_sp & 255u) == 0u) { if (xb_ld(&(bar)[XB_TMO])) break; if (_sp > XB_SPIN_CAP) { atomicAdd(&(bar)[XB_TMO], 1u); break; } } } } while (0)

struct XcdBarrier {
    unsigned* bar; unsigned x;
    volatile LAS unsigned* st;
};

__device__ __forceinline__ XcdBarrier xcd_barrier_post(unsigned* bar, volatile LAS unsigned* st) {
    XcdBarrier b; b.bar = bar; b.x = xb_xcc_id(); b.st = st;
    if (threadIdx.x == 0) (void)xb_add(&bar[XB_XCNT(b.x)], 1u);
    return b;
}
__device__ __forceinline__ void xcd_barrier_complete(unsigned* bar, unsigned x, unsigned& nloc, unsigned& nx) {
    const unsigned G = gridDim.x * gridDim.y * gridDim.z;
    unsigned sum, cnt, mine, sp = 0u;
    for (;;) {
        sum = 0u; cnt = 0u; mine = 0u;
#pragma unroll
        for (unsigned j = 0; j < 16; ++j) { const unsigned c = xb_ld(&bar[XB_XCNT(j)]); sum += c; cnt += (c > 0u) ? 1u : 0u; mine = (j == x) ? c : mine; }
        if (sum == G) break;
        __builtin_amdgcn_s_sleep(1);
        if ((++sp & 255u) == 0u) { if (xb_ld(&bar[XB_TMO])) break; if (sp > XB_SPIN_CAP) { atomicAdd(&bar[XB_TMO], 1u); break; } }
    }
    nloc = mine > 0u ? mine : 1u; nx = cnt > 0u ? cnt : 1u;
}

__device__ __forceinline__ void xcd_barrier(const XcdBarrier& b) {
    asm volatile("s_waitcnt vmcnt(0)" ::: "memory");
    __syncthreads();
    if (threadIdx.x == 0) {
        unsigned* bar = b.bar;
        __builtin_amdgcn_s_waitcnt(0);
        unsigned nloc = b.st[0], nx = b.st[1];
        if (nloc == 0u) { xcd_barrier_complete(bar, b.x, nloc, nx); b.st[0] = nloc; b.st[1] = nx; }
        const unsigned old = xb_add(&bar[XB_XSUB(b.x)], 1u);
        const unsigned gen = old / nloc;
        if (old + 1u == (gen + 1u) * nloc) {
            __builtin_amdgcn_fence(__ATOMIC_RELEASE, "agent");
            asm volatile("s_waitcnt vmcnt(0)" ::: "memory");
            const unsigned og = xb_add(&bar[XB_TOP], 1u);
            const unsigned tg = og / nx;
            if (og + 1u == (tg + 1u) * nx) xb_add(&bar[XB_TOPGEN], 1u);
            else XB_SPIN(xb_ld(&bar[XB_TOPGEN]) == tg, bar);
            __builtin_amdgcn_fence(__ATOMIC_ACQUIRE, "agent");
            xb_add(&bar[XB_XGEN(b.x)], 1u);
            asm volatile("s_waitcnt vmcnt(0)" ::: "memory");
        } else {
            XB_SPIN(xb_ld(&bar[XB_XGEN(b.x)]) == gen, bar);
            __builtin_amdgcn_fence(__ATOMIC_ACQUIRE, "agent");
            asm volatile("s_waitcnt vmcnt(0)" ::: "memory");
        }
    }
    __syncthreads();
}
constexpr int NWAVES = 8, NTHR = NWAVES * 64;
constexpr int D = 1024, BATCH = 4, SEQ = 4096, M = BATCH * SEQ, DEPTH = 4;
constexpr int IN_COLS = 6680, NPROJ = 6912;
constexpr int O_Z = 0, O_XBC = 1024, O_DT = 2560, O_QKV = 2576, O_GG = 4112, O_GB = 4624, O_GA = 4628, O_HQ = 4632, O_HF = 5144, O_HI = 5656, O_HG = 6168;
constexpr int DMIX = 2048, NEXP = 16, DEXP = 256, NGU = NEXP * 2 * DEXP  , KDN = NEXP * DEXP  ;
constexpr float DN_ALPHA = 1.6817928305074290f;
constexpr float LN_EPS = 1e-5f;

constexpr size_t MiB = 1u << 20;
constexpr size_t WS_CTL = 0, CTL_ZERO_BYTES = 1 * MiB;
constexpr size_t WS_LTOK = 2 * MiB;
constexpr size_t WS_LW = 3 * MiB;
constexpr size_t WS_SLOT = 4 * MiB;
constexpr size_t WS_WSORT = 5 * MiB;
constexpr size_t WS_WIN = 8 * MiB;
constexpr size_t WS_WOUT = 22 * MiB;
constexpr size_t WS_WGU = 26 * MiB;
constexpr size_t WS_WDN = 42 * MiB;
constexpr size_t WS_YMIX = 52 * MiB;
constexpr size_t WS_HB = WS_YMIX;
constexpr size_t WS_PROJ = 116 * MiB;
constexpr size_t WS_MIX = WS_PROJ;
constexpr int MAXROWS = 2 * M + 16 * 256;
constexpr size_t WS_XS = WS_PROJ + 64 * MiB;
constexpr size_t WS_HS = WS_PROJ + 136 * MiB;
constexpr size_t WS_YS = WS_PROJ + 154 * MiB;
constexpr int CW_CNT = 8192;
constexpr int LDS_OFF_TAB = 131072 + 1024;
constexpr size_t WS_SCR = 332 * MiB;
constexpr size_t WS_HG_QG = WS_SCR;
constexpr size_t WS_HG_KDT = WS_SCR + 16 * MiB;
constexpr size_t WS_HG_A = WS_SCR + 32 * MiB;
constexpr size_t WS_HG_GL = WS_SCR + 40 * MiB;
constexpr size_t WS_SSD_C = WS_SCR + 41 * MiB;
constexpr size_t WS_SSD_BT = WS_SCR + 49 * MiB;
constexpr size_t WS_SSD_CB = WS_SCR + 57 * MiB;
constexpr size_t WS_SSD_XT = WS_SCR + 65 * MiB;
constexpr size_t WS_SSD_AC = WS_SCR + 97 * MiB;
constexpr size_t WS_SSD_DT = WS_SCR + 98 * MiB;
constexpr size_t WS_GD_K = WS_SCR + 99 * MiB;
constexpr size_t WS_GD_KT = WS_SCR + 115 * MiB;
constexpr size_t WS_GD_QG = WS_SCR + 131 * MiB;
constexpr size_t WS_GD_VT = WS_SCR + 147 * MiB;
constexpr size_t WS_GD_T = WS_SCR + 163 * MiB;
constexpr size_t WS_GD_QK = WS_SCR + 171 * MiB;
constexpr size_t WS_GD_VEC = WS_SCR + 179 * MiB;
constexpr size_t WS_END = 512 * MiB;
constexpr int CW_BAR = 4096;

constexpr int RING_OFF = 0, RING_BYTES = 131072;
constexpr int LDSCTL_OFF = RING_BYTES, MISC_OFF = LDSCTL_OFF + 320;
constexpr int LDS_BYTES = 147456;

__device__ __forceinline__ float bf2f(unsigned short b) { return __builtin_bit_cast(float, ((unsigned)b) << 16); }
__device__ __forceinline__ float bflo(unsigned w) { return __builtin_bit_cast(float, w << 16); }
__device__ __forceinline__ float bfhi(unsigned w) { return __builtin_bit_cast(float, w & 0xffff0000u); }
__device__ __forceinline__ float siluf(float x) { return x / (1.0f + __expf(-x)); }
__device__ __forceinline__ float sigmoidf_(float x) { return 1.0f / (1.0f + __expf(-x)); }
__device__ __forceinline__ float softplusf_(float x) { return x > 20.f ? x : log1pf(__expf(x)); }
#define DPP_ADD(v, ctrl) ((v) + __builtin_bit_cast(float, __builtin_amdgcn_update_dpp(0, __builtin_bit_cast(int, (v)), (ctrl), 0xf, 0xf, false)))
__device__ __forceinline__ float wave_sum(float v) {
    v = DPP_ADD(v, 0xB1);
    v = DPP_ADD(v, 0x4E);
    v = DPP_ADD(v, 0x141);
    v = DPP_ADD(v, 0x140);
    const int iv = __builtin_bit_cast(int, v);
    return (__builtin_bit_cast(float, __builtin_amdgcn_readlane(iv, 0)) + __builtin_bit_cast(float, __builtin_amdgcn_readlane(iv, 16))) + (__builtin_bit_cast(float, __builtin_amdgcn_readlane(iv, 32)) + __builtin_bit_cast(float, __builtin_amdgcn_readlane(iv, 48)));
}
__device__ __forceinline__ float row16_sum(float v) {
    v = DPP_ADD(v, 0xB1); v = DPP_ADD(v, 0x4E); v = DPP_ADD(v, 0x141); v = DPP_ADD(v, 0x140); return v;
}

struct Args {
    const float* in[25]; float* out; unsigned char* ws; int ph_lo, ph_hi;
};
typedef const __attribute__((address_space(4))) Args* CArgs;
#define ARGS_HERE() ([]() { CArgs p_ = (CArgs)__builtin_amdgcn_kernarg_segment_ptr(); asm volatile("" : "+s"(p_)); return p_; }())
enum { I_X = 0, I_WIN, I_SCW, I_SCB, I_SDTB, I_SALOG, I_SD, I_SNW, I_GCW, I_GDTB, I_GALOG, I_GNW, I_HLB, I_HNW, I_WOUT, I_LN1G, I_LN1B, I_WRG, I_BRG, I_WRE, I_BRE, I_WGU, I_WDN, I_LN2G, I_LN2B };

__device__ __forceinline__ void transpose_item(const float* W, int ldw, int nvalid, int k0, int n0, bf16* WT, size_t ldt, int drow0, int dk0, LAS float* scr, int lane) {
#pragma unroll 8
    for (int i = 0; i < 32; ++i) { const int kk = 2 * i + (lane >> 5), nn = lane & 31, n = n0 + nn; scr[kk * 33 + nn] = (n < nvalid) ? W[(size_t)(k0 + kk) * ldw + n] : 0.f; }
    LDS_WAIT(); asm volatile("" ::: "memory");
    const int c = lane & 7;
#pragma unroll
    for (int j = 0; j < 4; ++j) { const int n = (lane >> 3) + 8 * j; const LAS float* s = scr + (8 * c) * 33 + n;
        v4u o; o.x = pk2(s[0 * 33], s[1 * 33]); o.y = pk2(s[2 * 33], s[3 * 33]); o.z = pk2(s[4 * 33], s[5 * 33]); o.w = pk2(s[6 * 33], s[7 * 33]);
        *(GAS v4u*)(WT + (size_t)(drow0 + n) * ldt + dk0 + k0 + 8 * c) = o; }
    LDS_WAIT(); asm volatile("" ::: "memory");
}
__device__ __forceinline__ void weights_phase(CArgs a, int l, const int which, LAS unsigned char* lds, int wwg, int nwg, int tid) {
    asm volatile("" : "+v"(tid));
    const int lane = tid & 63, wave = tid >> 6, gw = wwg * NWAVES + wave, NGW = nwg * NWAVES;
    LAS float* scr = (LAS float*)(lds + wave * 16384);
    constexpr int I_IN = 16 * (NPROJ / 32), I_OUT = (DMIX / 64) * (D / 32), I_GU = NEXP * 16 * 16, I_DN = NEXP * 4 * 32;
    const int n_in = (which & 1) ? I_IN : 0, n_out = (which & 2) ? I_OUT : 0, n_gu = (which & 4) ? I_GU : 0, n_dn = (which & 8) ? I_DN : 0;
    unsigned char* ws = a->ws;
    for (int it = gw; it < n_in + n_out + n_gu + n_dn; it += NGW) {
        int r = it;
        if (r < n_in) { const int kb = r / (NPROJ / 32), nb = r % (NPROJ / 32);
            transpose_item(a->in[I_WIN] + (size_t)l * D * IN_COLS, IN_COLS, IN_COLS, 64 * kb, 32 * nb, (bf16*)(ws + WS_WIN), D, 32 * nb, 0, scr, lane); continue; }
        r -= n_in;
        if (r < n_out) { const int kb = r / (D / 32), nb = r % (D / 32);
            transpose_item(a->in[I_WOUT] + (size_t)l * DMIX * D, D, D, 64 * kb, 32 * nb, (bf16*)(ws + WS_WOUT), DMIX, 32 * nb, 0, scr, lane); continue; }
        r -= n_out;
        if (r < n_gu) { const int e = r / 256, q = r % 256, kb = q / 16, nb = q % 16, c0 = 32 * nb, bj = c0 / 256, hf = (c0 % 256) / 128, j0 = c0 % 128;
            transpose_item(a->in[I_WGU] + (size_t)(l * NEXP + e) * D * 512, 512, 512, 64 * kb, c0, (bf16*)(ws + WS_WGU), D, e * 512 + hf * 256 + bj * 128 + j0, 0, scr, lane); continue; }
        r -= n_gu;
        { const int e = r / 128, q = r % 128, kb = q / 32, nb = q % 32;
            transpose_item(a->in[I_WDN] + (size_t)(l * NEXP + e) * DEXP * D, D, D, 64 * kb, 32 * nb, (bf16*)(ws + WS_WDN), DEXP, e * D + 32 * nb, 0, scr, lane); }
    }
}
__device__ __forceinline__ void p0_prologue(CArgs a, LAS unsigned char* lds, int wg, int G, int tid) {
    asm volatile("" : "+v"(tid));
    const f32x4* x4 = (const f32x4*)a->in[I_X]; f32x4* h4 = (f32x4*)a->out; unsigned long long* hb8 = (unsigned long long*)(a->ws + WS_HB);
    for (size_t i = (size_t)wg * NTHR + tid; i < (size_t)M * D / 4; i += (size_t)G * NTHR) { const f32x4 v = x4[i]; h4[i] = v;
        hb8[i] = (unsigned long long)pk2(v.x, v.y) | ((unsigned long long)pk2(v.z, v.w) << 32); }
}

#define WG_BAR() do { asm volatile("s_waitcnt lgkmcnt(0)" ::: "memory"); __builtin_amdgcn_s_barrier(); asm volatile("" ::: "memory"); } while (0)
__device__ __forceinline__ f32x4 mfma16(bf16x8 x, bf16x8 y, f32x4 c) { return __builtin_amdgcn_mfma_f32_16x16x32_bf16(x, y, c, 0, 0, 0); }
__device__ __forceinline__ bf16x8 lds_frag(const LAS bf16* base, int row0, int stride, int k0, int lane) { return *(const LAS bf16x8*)(base + (row0 + (lane & 15)) * stride + k0 + 8 * (lane >> 4)); }
__device__ __forceinline__ bf16x8 pack8(const float* v) { v4u w; w.x = pk2(v[0], v[1]); w.y = pk2(v[2], v[3]); w.z = pk2(v[4], v[5]); w.w = pk2(v[6], v[7]); return __builtin_bit_cast(bf16x8, w); }
__device__ __forceinline__ unsigned long long pack4(f32x4 v) { return (unsigned long long)pk2(v[0], v[1]) | ((unsigned long long)pk2(v[2], v[3]) << 32); }

__device__ __forceinline__ void hgrn_prep_phase(CArgs a, int l, LAS unsigned char* lds, int wg, int G, int tid) {
    asm volatile("" : "+v"(tid));
    constexpr int LS = 132;
    LAS float* sQ = (LAS float*)lds; LAS float* sK = sQ + 64 * LS; LAS float* sB = sK + 64 * LS; LAS float* sT = sB + 64 * LS; LAS float* sLb = sT + 512;
    const bf16* PROJ = (const bf16*)(a->ws + WS_PROJ);
    const int lane = tid & 63, w = tid >> 6, r = lane & 15, q4 = lane >> 4;
    for (int unit = wg; unit < 1024; unit += G) {
        const int b = unit >> 8, head = (unit >> 6) & 3, c = unit & 63;
        const size_t row0 = (size_t)b * SEQ + c * 64;
        __syncthreads();
        if (tid < 128) {
            const int ch = head * 128 + tid; float lg[DEPTH], mx = -1e30f;
#pragma unroll
            for (int j = 0; j < DEPTH; ++j) { lg[j] = a->in[I_HLB][j * 512 + ch]; mx = fmaxf(mx, lg[j]); }
            float den = 0.f, num = 0.f;
#pragma unroll
            for (int j = 0; j < DEPTH; ++j) { const float e = __expf(lg[j] - mx); den += e; if (j >= 1 && j <= l) num += e; }
            sLb[tid] = num / den;
        }
        __syncthreads();
        for (int p = tid; p < 1024; p += NTHR) {
            const int t = p >> 4, d8 = (p & 15) * 8;
            const v4u qv = *(const GAS v4u*)(PROJ + (row0 + t) * NPROJ + O_HQ + head * 128 + d8), fv = *(const GAS v4u*)(PROJ + (row0 + t) * NPROJ + O_HF + head * 128 + d8);
#pragma unroll
            for (int i = 0; i < 4; ++i) {
                const int d = d8 + 2 * i; const float lb0 = sLb[d], lb1 = sLb[d + 1];
                sQ[t * LS + d] = siluf(bflo(qv[i])); sQ[t * LS + d + 1] = siluf(bfhi(qv[i]));
                const float f0 = lb0 + (1.f - lb0) * sigmoidf_(bflo(fv[i])), f1 = lb1 + (1.f - lb1) * sigmoidf_(bfhi(fv[i]));
                sK[t * LS + d] = 1.f - f0; sK[t * LS + d + 1] = 1.f - f1; sB[t * LS + d] = __logf(f0); sB[t * LS + d + 1] = __logf(f1);
            }
        }
        __syncthreads();
        {
            const int d = tid & 127, seg = tid >> 7; float run = 0.f, vals[16];
#pragma unroll
            for (int i = 0; i < 16; ++i) { run += sB[(seg * 16 + i) * LS + d]; vals[i] = run; }
            sT[seg * 128 + d] = run;
            __syncthreads();
            float off = 0.f;
#pragma unroll
            for (int s2 = 0; s2 < 3; ++s2) if (s2 < seg) off += sT[s2 * 128 + d];
#pragma unroll
            for (int i = 0; i < 16; ++i) sB[(seg * 16 + i) * LS + d] = vals[i] + off;
        }
        __syncthreads();
        bf16* qg = (bf16*)(a->ws + WS_HG_QG) + (size_t)unit * 64 * 128; bf16* kdt = (bf16*)(a->ws + WS_HG_KDT) + (size_t)unit * 128 * 64;
        bf16* am = (bf16*)(a->ws + WS_HG_A) + (size_t)unit * 64 * 64; float* gl = (float*)(a->ws + WS_HG_GL) + (size_t)unit * 128;
        for (int p = tid; p < 1024; p += NTHR) { const int t = p >> 4, d8 = (p & 15) * 8; float v[8];
#pragma unroll
            for (int jj = 0; jj < 8; ++jj) v[jj] = sQ[t * LS + d8 + jj] * __expf(sB[t * LS + d8 + jj]);
            *(GAS bf16x8*)(qg + t * 128 + d8) = pack8(v); }
        for (int p = tid; p < 1024; p += NTHR) { const int d = p >> 3, s8 = (p & 7) * 8; const float bl = sB[63 * LS + d]; float v[8];
#pragma unroll
            for (int jj = 0; jj < 8; ++jj) v[jj] = sK[(s8 + jj) * LS + d] * __expf(bl - sB[(s8 + jj) * LS + d]);
            *(GAS bf16x8*)(kdt + d * 64 + s8) = pack8(v); }
        if (tid < 128) gl[tid] = __expf(sB[63 * LS + tid]);
        for (int p = w; p < 16; p += NWAVES) {
            const int i = p >> 2, j = p & 3; f32x4 acc = {0.f, 0.f, 0.f, 0.f};
            if (j <= i) {
#pragma unroll
                for (int ks = 0; ks < 4; ++ks) { const int d0 = 32 * ks + 8 * q4, t = 16 * i + r, s_ = 16 * j + r; float qf[8], kf[8];
#pragma unroll
                    for (int jj = 0; jj < 8; ++jj) { const float ref = i ? sB[(16 * i - 1) * LS + d0 + jj] : 0.f;
                        qf[jj] = sQ[t * LS + d0 + jj] * __expf(sB[t * LS + d0 + jj] - ref); kf[jj] = sK[s_ * LS + d0 + jj] * __expf(ref - sB[s_ * LS + d0 + jj]); }
                    acc = mfma16(pack8(kf), pack8(qf), acc); }
                const int t = 16 * i + r;
#pragma unroll
                for (int ii = 0; ii < 4; ++ii) if (16 * j + 4 * q4 + ii > t) acc[ii] = 0.f;
            }
            *(GAS unsigned long long*)(am + (16 * i + r) * 64 + 16 * j + 4 * q4) = pack4(acc);
        }
    }
}
__device__ __forceinline__ void hgrn_scan_phase(CArgs a, int l, LAS unsigned char* lds, const int b, const int head, const int eb, int tid) {
    asm volatile("" : "+v"(tid));
    constexpr int QS = 136, KS = 72;
    constexpr int B_QG = 0, B_KDT = 17408, B_A = B_KDT + 18432, B_VT = B_A + 9216, B_GL = B_VT + 4608, BUF = B_GL + 512;
    LAS unsigned char* sST0 = lds + 2 * BUF;
    const bf16* PROJ = (const bf16*)(a->ws + WS_PROJ); bf16* YMIX = (bf16*)(a->ws + WS_YMIX);
    const int lane = tid & 63, w = tid >> 6, r = lane & 15, q4 = lane >> 4;
    {
        const size_t cu0 = (size_t)(b * 4 + head) * 64;
        const bf16* QG = (const bf16*)(a->ws + WS_HG_QG) + cu0 * 64 * 128; const bf16* KDT = (const bf16*)(a->ws + WS_HG_KDT) + cu0 * 128 * 64;
        const bf16* AM = (const bf16*)(a->ws + WS_HG_A) + cu0 * 64 * 64; const float* GL = (const float*)(a->ws + WS_HG_GL) + cu0 * 128;
        const bf16* VP = PROJ + (size_t)b * SEQ * NPROJ + O_HI + head * 128 + eb * 32;
        v4u rq[2], rk[2], ra, rv; f32x4 rg;
#define HG_LOAD(n) do { _Pragma("unroll") for (int i = 0; i < 2; ++i) { const int p = tid + NTHR * i; rq[i] = *(const GAS v4u*)(QG + (size_t)(n) * 8192 + (p >> 4) * 128 + (p & 15) * 8); \
            rk[i] = *(const GAS v4u*)(KDT + (size_t)(n) * 8192 + (p >> 3) * 64 + (p & 7) * 8); } \
            ra = *(const GAS v4u*)(AM + (size_t)(n) * 4096 + (tid >> 3) * 64 + (tid & 7) * 8); \
            if (tid < 256) rv = *(const GAS v4u*)(VP + (size_t)((n) * 64 + (tid >> 2)) * NPROJ + (tid & 3) * 8); \
            if (tid < 32) rg = *(const GAS f32x4*)(GL + (size_t)(n) * 128 + tid * 4); } while (0)
#define HG_STORE(bufp) do { LAS unsigned char* bp_ = (bufp); _Pragma("unroll") for (int i = 0; i < 2; ++i) { const int p = tid + NTHR * i; \
            *(LAS v4u*)(bp_ + B_QG + ((p >> 4) * QS + (p & 15) * 8) * 2) = rq[i]; *(LAS v4u*)(bp_ + B_KDT + ((p >> 3) * KS + (p & 7) * 8) * 2) = rk[i]; } \
            *(LAS v4u*)(bp_ + B_A + ((tid >> 3) * KS + (tid & 7) * 8) * 2) = ra; \
            if (tid < 256) { LAS bf16* vt = (LAS bf16*)(bp_ + B_VT); const int t_ = tid >> 2, e8 = (tid & 3) * 8; _Pragma("unroll") for (int i = 0; i < 4; ++i) { \
                vt[(e8 + 2 * i) * KS + t_] = (bf16)(rv[i] & 0xffffu); vt[(e8 + 2 * i + 1) * KS + t_] = (bf16)(rv[i] >> 16); } } \
            if (tid < 32) *(LAS f32x4*)(bp_ + B_GL + tid * 16) = rg; } while (0)
        __syncthreads();
        HG_LOAD(0);
        for (int i = tid; i < 8704 / 4; i += NTHR) ((LAS unsigned*)sST0)[i] = 0u;
        HG_STORE(lds);
        f32x4 accS[2] = {{0.f, 0.f, 0.f, 0.f}, {0.f, 0.f, 0.f, 0.f}};
        __syncthreads();
        for (int n = 0; n < 64; ++n) {
            const int cur = n & 1; LAS unsigned char* bp = lds + cur * BUF; LAS bf16* sST = (LAS bf16*)(sST0 + cur * 8704); LAS bf16* sSTn = (LAS bf16*)(sST0 + (cur ^ 1) * 8704);
            if (n + 1 < 64) HG_LOAD(n + 1);
            {
                const int tt = w >> 1, et = w & 1; f32x4 acc = {0.f, 0.f, 0.f, 0.f};
#pragma unroll
                for (int ks = 0; ks < 4; ++ks) acc = mfma16(lds_frag(sST, 16 * et, QS, 32 * ks, lane), lds_frag((LAS bf16*)(bp + B_QG), 16 * tt, QS, 32 * ks, lane), acc);
#pragma unroll
                for (int ks = 0; ks < 2; ++ks) acc = mfma16(lds_frag((LAS bf16*)(bp + B_VT), 16 * et, KS, 32 * ks, lane), lds_frag((LAS bf16*)(bp + B_A), 16 * tt, KS, 32 * ks, lane), acc);
                *(GAS unsigned long long*)(YMIX + ((size_t)b * SEQ + n * 64 + 16 * tt + r) * DMIX + 1536 + head * 128 + eb * 32 + 16 * et + 4 * q4) = pack4(acc);
            }
            {
                const f32x4 glv = *(const LAS f32x4*)(bp + B_GL + (16 * w + 4 * q4) * 4);
#pragma unroll
                for (int et = 0; et < 2; ++et) { accS[et] = accS[et] * glv;
#pragma unroll
                    for (int ks = 0; ks < 2; ++ks) accS[et] = mfma16(lds_frag((LAS bf16*)(bp + B_KDT), 16 * w, KS, 32 * ks, lane), lds_frag((LAS bf16*)(bp + B_VT), 16 * et, KS, 32 * ks, lane), accS[et]);
                    *(LAS unsigned long long*)(sSTn + (16 * et + r) * QS + 16 * w + 4 * q4) = pack4(accS[et]); }
            }
            if (n + 1 < 64) HG_STORE(lds + (cur ^ 1) * BUF);
            WG_BAR();
        }
#undef HG_LOAD
#undef HG_STORE
    }
}

__device__ __forceinline__ void ssd_rec_phase(CArgs a, int l, LAS unsigned char* lds, int wg, int G, int tid) {
    asm volatile("" : "+v"(tid));
    constexpr int TB = 64;
    LAS float* sX = (LAS float*)lds; LAS float* sB = sX + TB * 16; LAS float* sC = sB + TB * 128; LAS float* sDt = sC + TB * 128; LAS float* sDa = sDt + TB; LAS float* sY = sDa + TB;
    const bf16* PROJ = (const bf16*)(a->ws + WS_PROJ); bf16* YMIX = (bf16*)(a->ws + WS_YMIX);
    const float* cw = a->in[I_SCW] + (size_t)l * 4 * 1536; const float* cb = a->in[I_SCB] + (size_t)l * 1536;
    const int p_local = tid >> 5, nq = tid & 31;
    for (int unit = wg; unit < 256; unit += G) {
        const int b = unit >> 6, head = (unit >> 2) & 15, pq = unit & 3, g = head >> 3;
        const float A = -__expf(a->in[I_SALOG][l * 16 + head]), dtb = a->in[I_SDTB][l * 16 + head], Dsk = a->in[I_SD][l * 16 + head];
        float h0 = 0.f, h1 = 0.f, h2 = 0.f, h3 = 0.f;
        for (int t0 = 0; t0 < SEQ; t0 += TB) {
            __syncthreads();
            for (int idx = tid; idx < TB * 272; idx += NTHR) {
                const int tt = idx / 272, ci = idx % 272, t = t0 + tt;
                const int ch = ci < 16 ? head * 64 + pq * 16 + ci : (ci < 144 ? 1024 + g * 128 + (ci - 16) : 1280 + g * 128 + (ci - 144));
                float acc = cb[ch];
#pragma unroll
                for (int k = 0; k < 4; ++k) { const int ts = t - 3 + k; if (ts >= 0) acc += cw[k * 1536 + ch] * bf2f(PROJ[(size_t)(b * SEQ + ts) * NPROJ + O_XBC + ch]); }
                const float v = siluf(acc);
                if (ci < 16) sX[tt * 16 + ci] = v; else if (ci < 144) sB[tt * 128 + ci - 16] = v; else sC[tt * 128 + ci - 144] = v;
            }
            if (tid < TB) { const float raw = bf2f(PROJ[(size_t)(b * SEQ + t0 + tid) * NPROJ + O_DT + head]); const float dt = softplusf_(raw + dtb); sDt[tid] = dt; sDa[tid] = __expf(dt * A); }
            __syncthreads();
#pragma unroll 4
            for (int tt = 0; tt < TB; ++tt) {
                const float xv = sX[tt * 16 + p_local], da = sDa[tt], dx = sDt[tt] * xv;
                const f32x4 Bv = *(const LAS f32x4*)(sB + tt * 128 + nq * 4), Cv = *(const LAS f32x4*)(sC + tt * 128 + nq * 4);
                h0 = da * h0 + dx * Bv.x; h1 = da * h1 + dx * Bv.y; h2 = da * h2 + dx * Bv.z; h3 = da * h3 + dx * Bv.w;
                float part = (Cv.x * h0 + Cv.y * h1) + (Cv.z * h2 + Cv.w * h3);
                part += __shfl_xor(part, 1); part += __shfl_xor(part, 2); part += __shfl_xor(part, 4); part += __shfl_xor(part, 8); part += __shfl_xor(part, 16);
                if (nq == 0) sY[tt * 16 + p_local] = part + Dsk * xv;
            }
            __syncthreads();
            for (int idx = tid; idx < TB * 16; idx += NTHR) { const int tt = idx >> 4, i = idx & 15; YMIX[(size_t)(b * SEQ + t0 + tt) * DMIX + head * 64 + pq * 16 + i] = (bf16)f2bf(sY[idx]); }
        }
    }
}

__device__ __forceinline__ void ssd_prep_phase(CArgs a, int l, LAS unsigned char* lds, int wg, int G, int tid) {
    asm volatile("" : "+v"(tid));
    constexpr int PS = 136;
    LAS bf16* sB = (LAS bf16*)lds; LAS bf16* sC = sB + 128 * PS; LAS bf16* sXT = (LAS bf16*)lds; LAS float* sDt = (LAS float*)(lds + 2 * 128 * PS * 2); LAS bf16* sCB = (LAS bf16*)(lds + 2 * 128 * PS * 2 + 4096);
    const bf16* PROJ = (const bf16*)(a->ws + WS_PROJ);
    const float* cw = a->in[I_SCW] + (size_t)l * 4 * 1536; const float* cb = a->in[I_SCB] + (size_t)l * 1536;
    const int lane = tid & 63, w = tid >> 6, r = lane & 15, q4 = lane >> 4;
    for (int unit = wg; unit < 256; unit += G) {
        const int b = unit >> 6, c = (unit >> 1) & 31, g = unit & 1;
        const size_t row0 = (size_t)b * SEQ + c * 128;
        bf16* Cg = (bf16*)(a->ws + WS_SSD_C) + (size_t)unit * 16384; bf16* BTg = (bf16*)(a->ws + WS_SSD_BT) + (size_t)unit * 16384; bf16* CBg = (bf16*)(a->ws + WS_SSD_CB) + (size_t)unit * 16384;
        __syncthreads();
        {
            const int c16 = tid & 31, l0 = tid >> 5; const int ch = (c16 < 16 ? 1024 + g * 128 + c16 * 8 : 1280 + g * 128 + (c16 - 16) * 8);
            float wk[4][8], bias[8];
#pragma unroll
            for (int jj = 0; jj < 8; ++jj) { bias[jj] = cb[ch + jj];
#pragma unroll
                for (int k = 0; k < 4; ++k) wk[k][jj] = cw[k * 1536 + ch + jj]; }
            LAS bf16* dst = (c16 < 16 ? sB : sC) + (c16 & 15) * 8;
#pragma unroll 2
            for (int i = 0; i < 8; ++i) { const int ll = l0 + 16 * i; float acc[8];
#pragma unroll
                for (int jj = 0; jj < 8; ++jj) acc[jj] = bias[jj];
#pragma unroll
                for (int k = 0; k < 4; ++k) { const int ts = c * 128 + ll - 3 + k;
                    if (ts >= 0) { const v4u xv = *(const GAS v4u*)(PROJ + ((size_t)b * SEQ + ts) * NPROJ + O_XBC + ch);
#pragma unroll
                        for (int j = 0; j < 4; ++j) { acc[2 * j] += wk[k][2 * j] * bflo(xv[j]); acc[2 * j + 1] += wk[k][2 * j + 1] * bfhi(xv[j]); } } }
#pragma unroll
                for (int jj = 0; jj < 8; ++jj) acc[jj] = siluf(acc[jj]);
                *(LAS bf16x8*)(dst + ll * PS) = pack8(acc); }
        }
        {
            const int head = g * 8 + w; const float A = -__expf(a->in[I_SALOG][l * 16 + head]), dtb = a->in[I_SDTB][l * 16 + head];
            const int l2 = 2 * lane;
            const float dt0 = softplusf_(bf2f(PROJ[(row0 + l2) * NPROJ + O_DT + head]) + dtb), dt1 = softplusf_(bf2f(PROJ[(row0 + l2 + 1) * NPROJ + O_DT + head]) + dtb);
            const float da1 = dt1 * A; float sc = dt0 * A + da1;
#pragma unroll
            for (int o = 1; o < 64; o <<= 1) { const float t_ = __shfl_up(sc, o); if (lane >= o) sc += t_; }
            sDt[w * 128 + l2] = dt0; sDt[w * 128 + l2 + 1] = dt1;
            const size_t uh = (size_t)((b * 16 + head) * 32 + c) * 128;
            float* AC = (float*)(a->ws + WS_SSD_AC) + uh; float* DT = (float*)(a->ws + WS_SSD_DT) + uh;
            AC[l2] = sc - da1; AC[l2 + 1] = sc; DT[l2] = dt0; DT[l2 + 1] = dt1;
        }
        __syncthreads();
#pragma unroll
        for (int st = 0; st < 8; ++st) {
            f32x4 acc = {0.f, 0.f, 0.f, 0.f};
            if (st <= w) {
#pragma unroll
                for (int ks = 0; ks < 4; ++ks) acc = mfma16(lds_frag(sB, 16 * st, PS, 32 * ks, lane), lds_frag(sC, 16 * w, PS, 32 * ks, lane), acc); }
            *(LAS unsigned long long*)(sCB + (16 * w + r) * PS + 16 * st + 4 * q4) = pack4(acc);
        }
        __syncthreads();
        for (int f = w; f < 32; f += NWAVES) { const int tile = f >> 2, ks = f & 3;
            *(GAS v4u*)(Cg + f * 512 + lane * 8) = *(const LAS v4u*)(sC + (16 * tile + r) * PS + 32 * ks + 8 * q4);
            *(GAS v4u*)(CBg + f * 512 + lane * 8) = *(const LAS v4u*)(sCB + (16 * tile + r) * PS + 32 * ks + 8 * q4);
            const int n = 16 * tile + r, l0 = 32 * ks + 8 * q4; v4u o;
#pragma unroll
            for (int j = 0; j < 4; ++j) o[j] = (unsigned)sB[(l0 + 2 * j) * PS + n] | ((unsigned)sB[(l0 + 2 * j + 1) * PS + n] << 16);
            *(GAS v4u*)(BTg + f * 512 + lane * 8) = o; }
#pragma unroll 1
        for (int hf = 0; hf < 2; ++hf) {
            __syncthreads();
            {   const int cg = tid & 31, l0 = tid >> 5, chl = cg * 8, ch = g * 512 + hf * 256 + chl, hh = hf * 4 + (cg >> 3);
                float wk[4][8], bias[8];
#pragma unroll
                for (int jj = 0; jj < 8; ++jj) { bias[jj] = cb[ch + jj];
#pragma unroll
                    for (int k = 0; k < 4; ++k) wk[k][jj] = cw[k * 1536 + ch + jj]; }
#pragma unroll 2
                for (int i = 0; i < 8; ++i) { const int ll = l0 + 16 * i; float acc[8];
#pragma unroll
                    for (int jj = 0; jj < 8; ++jj) acc[jj] = bias[jj];
#pragma unroll
                    for (int k = 0; k < 4; ++k) { const int ts = c * 128 + ll - 3 + k;
                        if (ts >= 0) { const v4u xv = *(const GAS v4u*)(PROJ + ((size_t)b * SEQ + ts) * NPROJ + O_XBC + ch);
#pragma unroll
                            for (int j = 0; j < 4; ++j) { acc[2 * j] += wk[k][2 * j] * bflo(xv[j]); acc[2 * j + 1] += wk[k][2 * j + 1] * bfhi(xv[j]); } } }
                    const float dtv = sDt[hh * 128 + ll];
#pragma unroll
                    for (int jj = 0; jj < 8; ++jj) sXT[(chl + jj) * PS + ll] = (bf16)f2bf(siluf(acc[jj]) * dtv); }
            }
            __syncthreads();
            for (int p = tid; p < 4096; p += NTHR) { const int chl = p >> 4, l8 = (p & 15) * 8, hh = hf * 4 + (chl >> 6), pp = chl & 63;
                const size_t uh = (size_t)((b * 16 + g * 8 + hh) * 32 + c);
                *(GAS v4u*)((bf16*)(a->ws + WS_SSD_XT) + (uh * 64 + pp) * 128 + l8) = *(const LAS v4u*)(sXT + chl * PS + l8); }
        }
    }
}
__device__ __forceinline__ void ssd_scan_phase(CArgs a, int l, LAS unsigned char* lds, const int b, const int head, int tid) {
    asm volatile("" : "+v"(tid));
    constexpr int PS = 136, O_S = 0, O_X = 34816, O_AC = 69632, O_TE = 70656, O_DT = 71680;
    bf16* YMIX = (bf16*)(a->ws + WS_YMIX);
    const int lane = tid & 63, w = tid >> 6, r = lane & 15, q4 = lane >> 4;
    {
        const int g = head >> 3;
        const float Dsk = a->in[I_SD][l * 16 + head];
        const bf16* Cg = (const bf16*)(a->ws + WS_SSD_C) + (size_t)((b * 32) * 2 + g) * 16384 + (w * 4) * 512 + lane * 8;
        const bf16* CBg = (const bf16*)(a->ws + WS_SSD_CB) + (size_t)((b * 32) * 2 + g) * 16384 + (w * 4) * 512 + lane * 8;
        const bf16* BTg = (const bf16*)(a->ws + WS_SSD_BT) + (size_t)((b * 32) * 2 + g) * 16384 + (w * 4) * 512 + lane * 8;
        const size_t uh0 = (size_t)(b * 16 + head) * 32;
        const bf16* XTg = (const bf16*)(a->ws + WS_SSD_XT) + uh0 * 8192; const float* ACg = (const float*)(a->ws + WS_SSD_AC) + uh0 * 128; const float* DTg = (const float*)(a->ws + WS_SSD_DT) + uh0 * 128;
        v4u fC[4], fCB[4], fBT[4], rx[2]; float rac = 0.f, racl = 0.f, rdt = 0.f;
#define SSD_LDF(cc, dst, src) do { _Pragma("unroll") for (int ks = 0; ks < 4; ++ks) dst[ks] = *(const GAS v4u*)(src + (size_t)(cc) * 32768 + 512 * ks); } while (0)
#define SSD_LOADX(cc) do { _Pragma("unroll") for (int i = 0; i < 2; ++i) { const int p = tid + NTHR * i; rx[i] = *(const GAS v4u*)(XTg + (size_t)(cc) * 8192 + (p >> 4) * 128 + (p & 15) * 8); } \
            if (tid < 128) { rac = ACg[(cc) * 128 + tid]; racl = ACg[(cc) * 128 + 127]; rdt = DTg[(cc) * 128 + tid]; } } while (0)
#define SSD_STORE(bi) do { _Pragma("unroll") for (int i = 0; i < 2; ++i) { const int p = tid + NTHR * i; *(LAS v4u*)(lds + O_X + (bi) * 17408 + ((p >> 4) * PS + (p & 15) * 8) * 2) = rx[i]; } \
            if (tid < 128) { ((LAS float*)(lds + O_AC))[(bi) * 128 + tid] = rac; ((LAS float*)(lds + O_TE))[(bi) * 128 + tid] = __expf(racl - rac); ((LAS float*)(lds + O_DT))[(bi) * 128 + tid] = rdt; } } while (0)
        __syncthreads();
        SSD_LDF(0, fC, Cg); SSD_LDF(0, fCB, CBg); SSD_LDF(0, fBT, BTg); SSD_LOADX(0);
        for (int i = tid; i < 17408 / 4; i += NTHR) ((LAS unsigned*)(lds + O_S))[i] = 0u;
        SSD_STORE(0);
        f32x4 accS[4];
#pragma unroll
        for (int pt = 0; pt < 4; ++pt) accS[pt] = (f32x4){0.f, 0.f, 0.f, 0.f};
        __syncthreads();
        for (int c = 0; c < 32; ++c) {
            const int cur = c & 1;
            const LAS bf16* sS = (const LAS bf16*)(lds + O_S + cur * 17408); LAS bf16* sSn = (LAS bf16*)(lds + O_S + (cur ^ 1) * 17408); const LAS bf16* sXT = (const LAS bf16*)(lds + O_X + cur * 17408);
            const LAS float* sAc = (const LAS float*)(lds + O_AC) + cur * 128; const LAS float* sTe = (const LAS float*)(lds + O_TE) + cur * 128; const LAS float* sDt = (const LAS float*)(lds + O_DT) + cur * 128;
            const int cn = c + 1 < 32 ? c + 1 : c;
            SSD_LOADX(cn);
            const int lrow = 16 * w + r; const float ac_l = sAc[lrow];
            f32x4 accO[4], accD[4];
#pragma unroll
            for (int pt = 0; pt < 4; ++pt) { accO[pt] = (f32x4){0.f, 0.f, 0.f, 0.f}; accD[pt] = (f32x4){0.f, 0.f, 0.f, 0.f}; }
#pragma unroll
            for (int ks = 0; ks < 4; ++ks) { const bf16x8 yf = __builtin_bit_cast(bf16x8, fC[ks]);
#pragma unroll
                for (int pt = 0; pt < 4; ++pt) accO[pt] = mfma16(lds_frag(sS, 16 * pt, PS, 32 * ks, lane), yf, accO[pt]); }
            SSD_LDF(cn, fC, Cg);
#pragma unroll
            for (int ks = 0; ks < 4; ++ks) if (32 * ks <= 16 * w + 15) {
                float v[8]; const f32x4 a0 = *(const LAS f32x4*)(sAc + 32 * ks + 8 * q4), a1 = *(const LAS f32x4*)(sAc + 32 * ks + 8 * q4 + 4);
#pragma unroll
                for (int j = 0; j < 4; ++j) { const int s0 = 32 * ks + 8 * q4 + 2 * j; const float as0 = (2 * j < 4) ? a0[(2 * j) & 3] : a1[(2 * j) & 3], as1 = (2 * j + 1 < 4) ? a0[(2 * j + 1) & 3] : a1[(2 * j + 1) & 3];
                    v[2 * j] = (s0 <= lrow) ? bflo(fCB[ks][j]) * __expf(ac_l - as0) : 0.f; v[2 * j + 1] = (s0 + 1 <= lrow) ? bfhi(fCB[ks][j]) * __expf(ac_l - as1) : 0.f; }
                const bf16x8 yf = pack8(v);
#pragma unroll
                for (int pt = 0; pt < 4; ++pt) accD[pt] = mfma16(lds_frag(sXT, 16 * pt, PS, 32 * ks, lane), yf, accD[pt]); }
            SSD_LDF(cn, fCB, CBg);
            {   const float ea = __expf(ac_l), rdtl = Dsk / sDt[lrow];
#pragma unroll
                for (int pt = 0; pt < 4; ++pt) { f32x4 y = accO[pt] * ea + accD[pt];
#pragma unroll
                    for (int ii = 0; ii < 4; ++ii) y[ii] += rdtl * bf2f(sXT[(16 * pt + 4 * q4 + ii) * PS + lrow]);
                    *(GAS unsigned long long*)(YMIX + ((size_t)b * SEQ + c * 128 + lrow) * DMIX + head * 64 + 16 * pt + 4 * q4) = pack4(y); } }
            {   const float cd = __expf(sAc[127]);
#pragma unroll
                for (int pt = 0; pt < 4; ++pt) accS[pt] = accS[pt] * cd;
#pragma unroll
                for (int ks = 0; ks < 4; ++ks) { float v[8]; const f32x4 t0 = *(const LAS f32x4*)(sTe + 32 * ks + 8 * q4), t1 = *(const LAS f32x4*)(sTe + 32 * ks + 8 * q4 + 4);
#pragma unroll
                    for (int j = 0; j < 4; ++j) { const float ts0 = (2 * j < 4) ? t0[(2 * j) & 3] : t1[(2 * j) & 3], ts1 = (2 * j + 1 < 4) ? t0[(2 * j + 1) & 3] : t1[(2 * j + 1) & 3];
                        v[2 * j] = bflo(fBT[ks][j]) * ts0; v[2 * j + 1] = bfhi(fBT[ks][j]) * ts1; }
                    const bf16x8 xf = pack8(v);
#pragma unroll
                    for (int pt = 0; pt < 4; ++pt) accS[pt] = mfma16(xf, lds_frag(sXT, 16 * pt, PS, 32 * ks, lane), accS[pt]); }
#pragma unroll
                for (int pt = 0; pt < 4; ++pt) *(LAS unsigned long long*)(sSn + (16 * pt + r) * PS + 16 * w + 4 * q4) = pack4(accS[pt]);
            }
            SSD_LDF(cn, fBT, BTg);
            if (c + 1 < 32) SSD_STORE(cur ^ 1);
            WG_BAR();
        }
#undef SSD_LDF
#undef SSD_LOADX
#undef SSD_STORE
    }
}

__device__ __forceinline__ void gdn_prep_phase(CArgs a, int l, LAS unsigned char* lds, int wg, int G, int tid) {
    asm volatile("" : "+v"(tid));
    constexpr int PS = 136, TS = 72, MS = 68, TT = 65;
    LAS bf16* sKb = (LAS bf16*)lds; LAS bf16* sQb = sKb + 64 * PS; LAS bf16* sQG = sQb + 64 * PS; LAS bf16* sVT = sQG + 64 * PS;
    LAS float* sM = (LAS float*)(lds + 3 * 17408 + 18432); LAS float* sT = sM + 64 * MS; LAS float* sVec = sT + 64 * TT; LAS bf16* sQK = (LAS bf16*)(sVec + 256);
    const bf16* PROJ = (const bf16*)(a->ws + WS_PROJ);
    const float* cw = a->in[I_GCW] + (size_t)l * 4 * 1536;
    const int lane = tid & 63, w = tid >> 6, r = lane & 15, q4 = lane >> 4;
    for (int unit = wg; unit < 1024; unit += G) {
        const int b = unit >> 8, head = (unit >> 6) & 3, n = unit & 63;
        const size_t row0 = (size_t)b * SEQ + n * 64;
#define GW ((bf16*)(a->ws + WS_GD_K) + (size_t)unit * 8192)
#define GKT ((bf16*)(a->ws + WS_GD_KT) + (size_t)unit * 8192)
#define GQG ((bf16*)(a->ws + WS_GD_QG) + (size_t)unit * 8192)
#define GUT ((bf16*)(a->ws + WS_GD_VT) + (size_t)unit * 8192)
#define GT ((bf16*)(a->ws + WS_GD_T) + (size_t)unit * 4096)
#define GQK ((bf16*)(a->ws + WS_GD_QK) + (size_t)unit * 4096)
#define GVEC ((float*)(a->ws + WS_GD_VEC) + (size_t)unit * 256)
        __syncthreads();
        for (int i = tid; i < 64 * MS; i += NTHR) sM[i] = 0.f;
        if (w == 0) {
            const float nA = -__expf(a->in[I_GALOG][l * 4 + head]), dtb = a->in[I_GDTB][l * 4 + head];
            const size_t ro = (row0 + lane) * NPROJ;
            const float be = sigmoidf_(bf2f(PROJ[ro + O_GB + head])); float gsum = nA * softplusf_(bf2f(PROJ[ro + O_GA + head]) + dtb);
#pragma unroll
            for (int o = 1; o < 64; o <<= 1) { const float t_ = __shfl_up(gsum, o); if (lane >= o) gsum += t_; }
            const float glast = __shfl(gsum, 63), eg = __expf(gsum), cc = __expf(glast - gsum);
            sVec[lane] = gsum; sVec[64 + lane] = be; sVec[128 + lane] = eg;
            GVEC[lane] = be; GVEC[64 + lane] = eg; GVEC[128 + lane] = cc; GVEC[192 + lane] = __expf(glast);
        }
        __syncthreads();
        {
            float wq[4][2], wk_[4][2], wv[4][2];
#pragma unroll
            for (int k = 0; k < 4; ++k)
#pragma unroll
                for (int j = 0; j < 2; ++j) { wq[k][j] = cw[k * 1536 + head * 128 + 2 * lane + j]; wk_[k][j] = cw[k * 1536 + 512 + head * 128 + 2 * lane + j]; wv[k][j] = cw[k * 1536 + 1024 + head * 128 + 2 * lane + j]; }
#pragma unroll 4
            for (int i = 0; i < 8; ++i) { const int t = w + 8 * i; float q0 = 0.f, q1 = 0.f, k0 = 0.f, k1 = 0.f, v0 = 0.f, v1 = 0.f;
#pragma unroll
                for (int k = 0; k < 4; ++k) { const int ts = n * 64 + t - 3 + k;
                    if (ts >= 0) { const bf16* pr = PROJ + ((size_t)b * SEQ + ts) * NPROJ + O_QKV + head * 128 + 2 * lane;
                        const unsigned xq = *(const GAS unsigned*)pr, xk = *(const GAS unsigned*)(pr + 512), xv = *(const GAS unsigned*)(pr + 1024);
                        q0 += wq[k][0] * bflo(xq); q1 += wq[k][1] * bfhi(xq); k0 += wk_[k][0] * bflo(xk); k1 += wk_[k][1] * bfhi(xk); v0 += wv[k][0] * bflo(xv); v1 += wv[k][1] * bfhi(xv); } }
                q0 = siluf(q0); q1 = siluf(q1); k0 = siluf(k0); k1 = siluf(k1); v0 = siluf(v0); v1 = siluf(v1);
                const float sq = rsqrtf(wave_sum(q0 * q0 + q1 * q1) + 1e-6f) * 0.08838834764831845f, sk = rsqrtf(wave_sum(k0 * k0 + k1 * k1) + 1e-6f), eg = sVec[128 + t];
                *(LAS unsigned*)(sKb + t * PS + 2 * lane) = pk2(k0 * sk, k1 * sk); *(LAS unsigned*)(sQb + t * PS + 2 * lane) = pk2(q0 * sq, q1 * sq);
                *(LAS unsigned*)(sQG + t * PS + 2 * lane) = pk2(q0 * sq * eg, q1 * sq * eg);
                sVT[(2 * lane) * TS + t] = (bf16)f2bf(v0); sVT[(2 * lane + 1) * TS + t] = (bf16)f2bf(v1); }
        }
        __syncthreads();
        for (int p = w; p < 26; p += NWAVES) {
            int it, jt; bool isq;
            if (p < 10) { isq = false; it = p < 1 ? 0 : (p < 3 ? 1 : (p < 6 ? 2 : 3)); jt = p - (it * (it + 1)) / 2; } else { isq = true; it = (p - 10) >> 2; jt = (p - 10) & 3; }
            f32x4 acc = {0.f, 0.f, 0.f, 0.f};
            if (jt <= it) {
#pragma unroll
                for (int ks = 0; ks < 4; ++ks) acc = mfma16(lds_frag(sKb, 16 * jt, PS, 32 * ks, lane), lds_frag(isq ? sQb : sKb, 16 * it, PS, 32 * ks, lane), acc);
                const int i = 16 * it + r; const float gi = sVec[i], bi = sVec[64 + i];
#pragma unroll
                for (int ii = 0; ii < 4; ++ii) { const int j = 16 * jt + 4 * q4 + ii; const float dec = __expf(gi - sVec[j]);
                    acc[ii] = isq ? (j <= i ? acc[ii] * dec : 0.f) : (j < i ? acc[ii] * dec * bi : 0.f); }
            }
            if (isq) *(LAS unsigned long long*)(sQK + (16 * it + r) * TS + 16 * jt + 4 * q4) = pack4(acc);
            else *(LAS f32x4*)(sM + (16 * it + r) * MS + 16 * jt + 4 * q4) = acc;
        }
        __syncthreads();
        if (w == 0) {
            int zo = 0; asm volatile("" : "+v"(zo)); const LAS float* sMv = sM + zo;
            float U[64];
#pragma unroll
            for (int i = 0; i < 64; ++i) {
                f32x4 mr[16]; float a0 = -sMv[i * MS + lane], a1 = 0.f, a2 = 0.f, a3 = 0.f;
#pragma unroll
                for (int j4 = 0; j4 < (i + 3) / 4; ++j4) mr[j4] = *(const LAS f32x4*)(sMv + i * MS + 4 * j4);
                __builtin_amdgcn_sched_barrier(0);
#pragma unroll
                for (int j4 = 0; j4 < (i + 3) / 4; ++j4) { const f32x4 m = mr[j4];
                    if (4 * j4 + 0 < i) a0 -= m[0] * U[4 * j4 + 0]; if (4 * j4 + 1 < i) a1 -= m[1] * U[4 * j4 + 1]; if (4 * j4 + 2 < i) a2 -= m[2] * U[4 * j4 + 2]; if (4 * j4 + 3 < i) a3 -= m[3] * U[4 * j4 + 3]; }
                U[i] = (a0 + a1) + (a2 + a3); sT[i * TT + lane] = U[i]; }
        } else {
            for (int f = w - 1; f < 16; f += NWAVES - 1) { const int tile = f >> 2, ks = f & 3;
                *(GAS v4u*)(GQG + f * 512 + lane * 8) = *(const LAS v4u*)(sQG + (16 * tile + r) * PS + 32 * ks + 8 * q4); }
            for (int f = w - 1; f < 8; f += NWAVES - 1) { const int tile = f >> 1, ks = f & 1;
                *(GAS v4u*)(GQK + f * 512 + lane * 8) = *(const LAS v4u*)(sQK + (16 * tile + r) * TS + 32 * ks + 8 * q4); }
            for (int f = w - 1; f < 16; f += NWAVES - 1) { const int dt = f >> 1, ks = f & 1, d = 16 * dt + r, s0 = 32 * ks + 8 * q4; v4u o;
#pragma unroll
                for (int j = 0; j < 4; ++j) o[j] = (unsigned)sKb[(s0 + 2 * j) * PS + d] | ((unsigned)sKb[(s0 + 2 * j + 1) * PS + d] << 16);
                *(GAS v4u*)(GKT + f * 512 + lane * 8) = o; }
        }
        __syncthreads();
        {
            LAS bf16* sTb = (LAS bf16*)sM; LAS bf16* sKgT = sQb;
            { const int t = tid >> 3, s8 = (tid & 7) * 8; float v[8];
#pragma unroll
                for (int jj = 0; jj < 8; ++jj) v[jj] = sT[t * TT + s8 + jj] + ((s8 + jj == t) ? 1.f : 0.f);
                *(LAS bf16x8*)(sTb + t * TS + s8) = pack8(v); }
            for (int p = tid; p < 1024; p += NTHR) { const int d = p >> 3, s8 = (p & 7) * 8; float v[8], u8[8]; const v4u vv = *(const LAS v4u*)(sVT + d * TS + s8);
#pragma unroll
                for (int jj = 0; jj < 8; ++jj) { const float be = sVec[64 + s8 + jj]; v[jj] = bf2f(sKb[(s8 + jj) * PS + d]) * be * sVec[128 + s8 + jj]; u8[jj] = ((jj & 1) ? bfhi(vv[jj >> 1]) : bflo(vv[jj >> 1])) * be; }
                *(LAS bf16x8*)(sKgT + d * TS + s8) = pack8(v); *(LAS bf16x8*)(sVT + d * TS + s8) = pack8(u8); }
        }
        __syncthreads();
        {
            const LAS bf16* sTb = (const LAS bf16*)sM; const LAS bf16* sKgT = sQb; LAS bf16* sW = (LAS bf16*)((LAS unsigned char*)sM + 9216);
            const int st_ = w >> 1;
            const bf16x8 t0 = lds_frag(sTb, 16 * st_, TS, 0, lane), t1 = lds_frag(sTb, 16 * st_, TS, 32, lane);
#pragma unroll
            for (int c4_ = 0; c4_ < 4; ++c4_) { const int ct = (w & 1) * 4 + c4_;
                f32x4 aw = {0.f, 0.f, 0.f, 0.f}, au = {0.f, 0.f, 0.f, 0.f};
                aw = mfma16(lds_frag(sKgT, 16 * ct, TS, 0, lane), t0, aw); aw = mfma16(lds_frag(sKgT, 16 * ct, TS, 32, lane), t1, aw);
                au = mfma16(t0, lds_frag(sVT, 16 * ct, TS, 0, lane), au); au = mfma16(t1, lds_frag(sVT, 16 * ct, TS, 32, lane), au);
                *(LAS unsigned long long*)(sW + (16 * st_ + r) * PS + 16 * ct + 4 * q4) = pack4(aw);
                *(GAS unsigned long long*)(GUT + (ct * 4 + st_) * 256 + lane * 4) = pack4(au); }
        }
        __syncthreads();
        { const LAS bf16* sW = (const LAS bf16*)((LAS unsigned char*)sM + 9216);
            for (int f = w; f < 16; f += NWAVES) { const int tile = f >> 2, ks = f & 3;
                *(GAS v4u*)(GW + f * 512 + lane * 8) = *(const LAS v4u*)(sW + (16 * tile + r) * PS + 32 * ks + 8 * q4); } }
    }
#undef GW
#undef GKT
#undef GQG
#undef GUT
#undef GT
#undef GQK
#undef GVEC
}
__device__ __forceinline__ void gdn_scan_phase(CArgs a, int l, LAS unsigned char* lds, const int b, const int head, const int eb, int tid) {
    asm volatile("" : "+v"(tid));
    constexpr int PS = 136, TS = 72, O_ST = 0, O_RT = 34816, O_VN = O_RT + 9216, O_VC = O_VN + 9216;
    bf16* YMIX = (bf16*)(a->ws + WS_YMIX);
    const int lane = tid & 63, w = tid >> 6, r = lane & 15, q4 = lane >> 4, st = w >> 1, eh = w & 1;
    LAS bf16* sRT = (LAS bf16*)(lds + O_RT); LAS bf16* sVN = (LAS bf16*)(lds + O_VN); LAS bf16* sVC = (LAS bf16*)(lds + O_VC);
    {
        const size_t u0 = (size_t)(b * 4 + head) * 64;
        const bf16* pW = (const bf16*)(a->ws + WS_GD_K) + u0 * 8192 + (st * 4) * 512 + lane * 8; const bf16* pQG = (const bf16*)(a->ws + WS_GD_QG) + u0 * 8192 + (st * 4) * 512 + lane * 8;
        const bf16* pQK = (const bf16*)(a->ws + WS_GD_QK) + u0 * 4096 + (st * 2) * 512 + lane * 8;
        const bf16* pKT = (const bf16*)(a->ws + WS_GD_KT) + u0 * 8192 + (w * 2) * 512 + lane * 8;
        const bf16* pUT = (const bf16*)(a->ws + WS_GD_VT) + u0 * 8192 + (size_t)(((eb * 4 + 2 * eh) * 4 + st) * 256) + lane * 4;
        const float* pVec = (const float*)(a->ws + WS_GD_VEC) + u0 * 256 + 16 * st + 4 * q4;
        v4u xW[4], yQG[4], yQK[2], xKT[2], nQG[4], nQK[2]; unsigned long long uT[2]; f32x4 c4; float gl;
#define GD_LD_A(nn) do { _Pragma("unroll") for (int ks = 0; ks < 4; ++ks) xW[ks] = *(const GAS v4u*)(pW + (size_t)(nn) * 8192 + 512 * ks); \
            _Pragma("unroll") for (int j = 0; j < 2; ++j) uT[j] = *(const GAS unsigned long long*)(pUT + (size_t)(nn) * 8192 + j * 1024); \
            c4 = *(const GAS f32x4*)(pVec + (size_t)(nn) * 256 + 128); } while (0)
#define GD_LD_C(nn, QG_, QK_) do { _Pragma("unroll") for (int ks = 0; ks < 4; ++ks) QG_[ks] = *(const GAS v4u*)(pQG + (size_t)(nn) * 8192 + 512 * ks); \
            _Pragma("unroll") for (int ks = 0; ks < 2; ++ks) QK_[ks] = *(const GAS v4u*)(pQK + (size_t)(nn) * 4096 + 512 * ks); } while (0)
#define GD_LD_D(nn) do { _Pragma("unroll") for (int ks = 0; ks < 2; ++ks) xKT[ks] = *(const GAS v4u*)(pKT + (size_t)(nn) * 8192 + 512 * ks); gl = pVec[(size_t)(nn) * 256 + 192 - (16 * st + 4 * q4)]; } while (0)
        __syncthreads();
        GD_LD_A(0); GD_LD_C(0, yQG, yQK); GD_LD_D(0);
        for (int i = tid; i < 17408 / 4; i += NTHR) ((LAS unsigned*)(lds + O_ST))[i] = 0u;
        f32x4 accS[4];
#pragma unroll
        for (int et = 0; et < 4; ++et) accS[et] = (f32x4){0.f, 0.f, 0.f, 0.f};
        __syncthreads();
        for (int n = 0; n < 64; ++n) {
            const int cur = n & 1; const LAS bf16* sST = (const LAS bf16*)(lds + O_ST + cur * 17408); LAS bf16* sSTn = (LAS bf16*)(lds + O_ST + (cur ^ 1) * 17408);
            const int nn = n + 1 < 64 ? n + 1 : n;
            {
                bf16x8 fs[2][4];
#pragma unroll
                for (int j = 0; j < 2; ++j)
#pragma unroll
                    for (int ks = 0; ks < 4; ++ks) fs[j][ks] = lds_frag(sST, 16 * (2 * eh + j), PS, 32 * ks, lane);
                __builtin_amdgcn_sched_barrier(0);
#pragma unroll
                for (int j = 0; j < 2; ++j) { const int e0 = 16 * (2 * eh + j); f32x4 acc = {0.f, 0.f, 0.f, 0.f};
#pragma unroll
                    for (int ks = 0; ks < 4; ++ks) acc = mfma16(__builtin_bit_cast(bf16x8, xW[ks]), fs[j][ks], acc);
                    const unsigned ulo = (unsigned)uT[j], uhi = (unsigned)(uT[j] >> 32); f32x4 vn;
                    vn[0] = bflo(ulo) - acc[0]; vn[1] = bfhi(ulo) - acc[1]; vn[2] = bflo(uhi) - acc[2]; vn[3] = bfhi(uhi) - acc[3];
                    *(LAS unsigned long long*)(sVN + (e0 + r) * TS + 16 * st + 4 * q4) = pack4(vn); *(LAS unsigned long long*)(sVC + (e0 + r) * TS + 16 * st + 4 * q4) = pack4(vn * c4); }
            }
            GD_LD_A(nn); GD_LD_C(nn, nQG, nQK);
            WG_BAR();
            {
                bf16x8 fv[4][2];
#pragma unroll
                for (int et = 0; et < 4; ++et)
#pragma unroll
                    for (int ks = 0; ks < 2; ++ks) fv[et][ks] = lds_frag(sVC, 16 * et, TS, 32 * ks, lane);
                __builtin_amdgcn_sched_barrier(0);
#pragma unroll
                for (int et = 0; et < 4; ++et) { accS[et] = accS[et] * gl;
#pragma unroll
                    for (int ks = 0; ks < 2; ++ks) accS[et] = mfma16(__builtin_bit_cast(bf16x8, xKT[ks]), fv[et][ks], accS[et]);
                    *(LAS unsigned long long*)(sSTn + (16 * et + r) * PS + 16 * w + 4 * q4) = pack4(accS[et]); }
            }
            GD_LD_D(nn);
            {
                bf16x8 fs[2][4], fn[2][2];
#pragma unroll
                for (int j = 0; j < 2; ++j) {
#pragma unroll
                    for (int ks = 0; ks < 4; ++ks) fs[j][ks] = lds_frag(sST, 16 * (2 * eh + j), PS, 32 * ks, lane);
#pragma unroll
                    for (int ks = 0; ks < 2; ++ks) fn[j][ks] = lds_frag(sVN, 16 * (2 * eh + j), TS, 32 * ks, lane); }
                __builtin_amdgcn_sched_barrier(0);
#pragma unroll
                for (int j = 0; j < 2; ++j) { const int e0 = 16 * (2 * eh + j); f32x4 acc = {0.f, 0.f, 0.f, 0.f};
#pragma unroll
                    for (int ks = 0; ks < 4; ++ks) acc = mfma16(fs[j][ks], __builtin_bit_cast(bf16x8, yQG[ks]), acc);
#pragma unroll
                    for (int ks = 0; ks < 2; ++ks) acc = mfma16(fn[j][ks], __builtin_bit_cast(bf16x8, yQK[ks]), acc);
                    *(GAS unsigned long long*)(YMIX + ((size_t)b * SEQ + n * 64 + 16 * st + r) * DMIX + 1024 + head * 128 + eb * 64 + e0 + 4 * q4) = pack4(acc); }
            }
#pragma unroll
            for (int ks = 0; ks < 4; ++ks) yQG[ks] = nQG[ks];
#pragma unroll
            for (int ks = 0; ks < 2; ++ks) yQK[ks] = nQK[ks];
            WG_BAR();
        }
#undef GD_LD_A
#undef GD_LD_C
#undef GD_LD_D
    }
}

__device__ __forceinline__ void gdn_rec_phase(CArgs a, int l, LAS unsigned char* lds, int wg, int G, int tid) {
    asm volatile("" : "+v"(tid));
    constexpr int TB = 32;
    LAS float* sQ = (LAS float*)lds; LAS float* sK = sQ + TB * 128; LAS float* sV = sK + TB * 128; LAS float* sBe = sV + TB * 8; LAS float* sAl = sBe + TB; LAS float* sO = sAl + TB;
    const bf16* PROJ = (const bf16*)(a->ws + WS_PROJ); bf16* YMIX = (bf16*)(a->ws + WS_YMIX);
    const float* cw = a->in[I_GCW] + (size_t)l * 4 * 1536;
    const int lane = tid & 63, w = tid >> 6;
    for (int unit = wg; unit < 256; unit += G) {
        const int b = unit >> 6, head = (unit >> 4) & 3, eb = unit & 15;
        const float nA = -__expf(a->in[I_GALOG][l * 4 + head]), dtb = a->in[I_GDTB][l * 4 + head];
        float S0 = 0.f, S1 = 0.f;
        for (int t0 = 0; t0 < SEQ; t0 += TB) {
            __syncthreads();
            for (int idx = tid; idx < TB * 264; idx += NTHR) {
                const int tt = idx / 264, ci = idx % 264, t = t0 + tt;
                const int ch = ci < 128 ? head * 128 + ci : (ci < 256 ? 512 + head * 128 + (ci - 128) : 1024 + head * 128 + eb * 8 + (ci - 256));
                float acc = 0.f;
#pragma unroll
                for (int k = 0; k < 4; ++k) { const int ts = t - 3 + k; if (ts >= 0) acc += cw[k * 1536 + ch] * bf2f(PROJ[(size_t)(b * SEQ + ts) * NPROJ + O_QKV + ch]); }
                const float v = siluf(acc);
                if (ci < 128) sQ[tt * 128 + ci] = v; else if (ci < 256) sK[tt * 128 + ci - 128] = v; else sV[tt * 8 + ci - 256] = v;
            }
            if (tid < TB) { const size_t ro = (size_t)(b * SEQ + t0 + tid) * NPROJ; const float braw = bf2f(PROJ[ro + O_GB + head]), araw = bf2f(PROJ[ro + O_GA + head]);
                sBe[tid] = sigmoidf_(braw); sAl[tid] = __expf(nA * softplusf_(araw + dtb)); }
            __syncthreads();
            for (int tt = w; tt < TB; tt += NWAVES) {
                const float q0 = sQ[tt * 128 + lane], q1 = sQ[tt * 128 + 64 + lane], k0 = sK[tt * 128 + lane], k1 = sK[tt * 128 + 64 + lane];
                const float sq = rsqrtf(wave_sum(q0 * q0 + q1 * q1) + 1e-6f) * 0.08838834764831845f, sk = rsqrtf(wave_sum(k0 * k0 + k1 * k1) + 1e-6f);
                sQ[tt * 128 + lane] = q0 * sq; sQ[tt * 128 + 64 + lane] = q1 * sq; sK[tt * 128 + lane] = k0 * sk; sK[tt * 128 + 64 + lane] = k1 * sk;
            }
            __syncthreads();
#pragma unroll 2
            for (int tt = 0; tt < TB; ++tt) {
                const float k0 = sK[tt * 128 + lane], k1 = sK[tt * 128 + 64 + lane], q0 = sQ[tt * 128 + lane], q1 = sQ[tt * 128 + 64 + lane];
                const float al = sAl[tt], be = sBe[tt], v = sV[tt * 8 + w];
                const float dot = wave_sum(k0 * S0 + k1 * S1);
                const float vn = be * (v - al * dot);
                S0 = al * S0 + k0 * vn; S1 = al * S1 + k1 * vn;
                const float od = wave_sum(q0 * S0 + q1 * S1);
                if (lane == 0) sO[tt * 8 + w] = od;
            }
            __syncthreads();
            if (tid < TB * 8) { const int tt = tid >> 3, i = tid & 7; YMIX[(size_t)(b * SEQ + t0 + tt) * DMIX + 1024 + head * 128 + eb * 8 + i] = (bf16)f2bf(sO[tid]); }
        }
    }
}

__device__ __forceinline__ void hgrn_rec_phase(CArgs a, int l, LAS unsigned char* lds, int wg, int G, int tid) {
    asm volatile("" : "+v"(tid));
    constexpr int TB = 32;
    LAS float* sQ = (LAS float*)lds; LAS float* sF = sQ + TB * 128; LAS float* sV = sF + TB * 128; LAS float* sO = sV + TB * 8; LAS float* sLb = sO + TB * 8;
    const bf16* PROJ = (const bf16*)(a->ws + WS_PROJ); bf16* YMIX = (bf16*)(a->ws + WS_YMIX);
    const int lane = tid & 63, w = tid >> 6;
    for (int unit = wg; unit < 256; unit += G) {
        const int b = unit >> 6, head = (unit >> 4) & 3, eb = unit & 15;
        __syncthreads();
        if (tid < 128) {
            const int c = head * 128 + tid; float lg[DEPTH], mx = -1e30f;
#pragma unroll
            for (int j = 0; j < DEPTH; ++j) { lg[j] = a->in[I_HLB][j * 512 + c]; mx = fmaxf(mx, lg[j]); }
            float den = 0.f, num = 0.f;
#pragma unroll
            for (int j = 0; j < DEPTH; ++j) { const float e = __expf(lg[j] - mx); den += e; if (j >= 1 && j <= l) num += e; }
            sLb[tid] = num / den;
        }
        float S0 = 0.f, S1 = 0.f;
        for (int t0 = 0; t0 < SEQ; t0 += TB) {
            __syncthreads();
            for (int idx = tid; idx < TB * 264; idx += NTHR) {
                const int tt = idx / 264, ci = idx % 264; const size_t ro = (size_t)(b * SEQ + t0 + tt) * NPROJ;
                if (ci < 128) sQ[tt * 128 + ci] = siluf(bf2f(PROJ[ro + O_HQ + head * 128 + ci]));
                else if (ci < 256) { const int d = ci - 128; const float lb = sLb[d]; sF[tt * 128 + d] = lb + (1.f - lb) * sigmoidf_(bf2f(PROJ[ro + O_HF + head * 128 + d])); }
                else sV[tt * 8 + ci - 256] = bf2f(PROJ[ro + O_HI + head * 128 + eb * 8 + (ci - 256)]);
            }
            __syncthreads();
#pragma unroll 2
            for (int tt = 0; tt < TB; ++tt) {
                const float f0 = sF[tt * 128 + lane], f1 = sF[tt * 128 + 64 + lane], q0 = sQ[tt * 128 + lane], q1 = sQ[tt * 128 + 64 + lane], v = sV[tt * 8 + w];
                S0 = f0 * S0 + (1.f - f0) * v; S1 = f1 * S1 + (1.f - f1) * v;
                const float od = wave_sum(q0 * S0 + q1 * S1);
                if (lane == 0) sO[tt * 8 + w] = od;
            }
            __syncthreads();
            if (tid < TB * 8) { const int tt = tid >> 3, i = tid & 7; YMIX[(size_t)(b * SEQ + t0 + tt) * DMIX + 1536 + head * 128 + eb * 8 + i] = (bf16)f2bf(sO[tid]); }
        }
    }
}

__device__ __forceinline__ void mix_post_phase(CArgs a, int l, int wg, int G, int tid) {
    asm volatile("" : "+v"(tid));
    const bf16* PROJ = (const bf16*)(a->ws + WS_PROJ); bf16* YMIX = (bf16*)(a->ws + WS_YMIX);
    const int lane = tid & 63, gw = wg * NWAVES + (tid >> 6), NGW = G * NWAVES;
    const float* snw = a->in[I_SNW] + l * 1024; const float* gnw = a->in[I_GNW] + l * 128; const float* hnw = a->in[I_HNW] + l * 128;
    for (int row = gw; row < M; row += NGW) {
        const bf16* pr = PROJ + (size_t)row * NPROJ; bf16* yr = YMIX + (size_t)row * DMIX;
#pragma unroll
        for (int j = 0; j < 2; ++j) {
            const int ch = j * 512 + lane * 8; const v4u yv = *(const GAS v4u*)(yr + ch), zv = *(const GAS v4u*)(pr + O_Z + ch);
            float v[8]; float ss = 0.f;
#pragma unroll
            for (int i = 0; i < 4; ++i) { v[2 * i] = bflo(yv[i]) * siluf(bflo(zv[i])); v[2 * i + 1] = bfhi(yv[i]) * siluf(bfhi(zv[i])); ss += v[2 * i] * v[2 * i] + v[2 * i + 1] * v[2 * i + 1]; }
            const float rstd = rsqrtf(wave_sum(ss) * (1.f / 512.f) + 1e-6f);
            v4u o;
#pragma unroll
            for (int i = 0; i < 4; ++i) o[i] = pk2(v[2 * i] * rstd * snw[ch + 2 * i], v[2 * i + 1] * rstd * snw[ch + 2 * i + 1]);
            *(GAS v4u*)(yr + ch) = o;
        }
#pragma unroll
        for (int part = 0; part < 2; ++part) {
            const int ch = lane * 8, yo = 1024 + part * 512 + ch, go = (part == 0 ? O_GG : O_HG) + ch; const float* nw = part == 0 ? gnw : hnw;
            const v4u yv = *(const GAS v4u*)(yr + yo), gv = *(const GAS v4u*)(pr + go);
            float v[8]; float ss = 0.f;
#pragma unroll
            for (int i = 0; i < 4; ++i) { v[2 * i] = bflo(yv[i]); v[2 * i + 1] = bfhi(yv[i]); ss += v[2 * i] * v[2 * i] + v[2 * i + 1] * v[2 * i + 1]; }
            ss = row16_sum(ss);
            const float rstd = rsqrtf(ss * (1.f / 128.f) + 1e-6f);
            v4u o;
#pragma unroll
            for (int i = 0; i < 4; ++i) { const int c = (ch & 127) + 2 * i; o[i] = pk2(v[2 * i] * rstd * nw[c] * siluf(bflo(gv[i])), v[2 * i + 1] * rstd * nw[c + 1] * siluf(bfhi(gv[i]))); }
            *(GAS v4u*)(yr + yo) = o;
        }
    }
}

__device__ __forceinline__ void moe_tables(const gu32* cnt, LAS unsigned char* lds, int tid) {
    LAS int* tab = (LAS int*)(lds + LDS_OFF_TAB);
    __syncthreads();
    if (tid == 0) { int p = 0, q = 0;
        for (int e = 0; e < 16; ++e) { const int c = (int)__hip_atomic_load(cnt + e, RLX_AGENT); tab[e] = p; tab[17 + e] = q; p += (c + 255) & ~255; q += c; }
        tab[16] = p; tab[33] = q; }
    __syncthreads();
}
template <bool ROUTER>
__device__ __forceinline__ void ln_phase(CArgs a, int l, const float* gam, const float* bet, LAS unsigned char* lds, int wg, int G, int tid) {
    asm volatile("" : "+v"(tid));
    const int lane = tid & 63, wave = tid >> 6, gw = wg * NWAVES + wave, NGW = G * NWAVES;
    const float* ADD = (const float*)(a->ws + WS_MIX); float* H = a->out; bf16* HB = (bf16*)(a->ws + WS_HB);
    gu32* cnt = (gu32*)(a->ws + WS_CTL) + CW_CNT + l * 16;
    LAS float* sW = (LAS float*)lds;
    LAS float* sL = sW + 20 * D + wave * 32;
    LAS int* sCnt = (LAS int*)(sW + 20 * D + 256);
    LAS unsigned* sEnt = (LAS unsigned*)(sCnt + 32);
    constexpr int MAXENT = 2 * NWAVES * 8;
    if (ROUTER) {
        __syncthreads();
        const float* wrg = a->in[I_WRG] + (size_t)l * D * 4; const float* wre = a->in[I_WRE] + (size_t)l * D * 16;
        for (int i = tid; i < D * 20; i += NTHR) { const int c = i >> 10, k = i & 1023; sW[i] = c < 4 ? wrg[k * 4 + c] : wre[k * 16 + c - 4]; }
        if (tid < 32) sCnt[tid] = 0;
        __syncthreads();
    } else moe_tables(cnt, lds, tid);
    const LAS int* tab = (const LAS int*)(lds + LDS_OFF_TAB);
    f32x4 gv[4], bv[4];
#pragma unroll
    for (int j = 0; j < 4; ++j) { gv[j] = *(const f32x4*)(gam + 4 * lane + 256 * j); bv[j] = *(const f32x4*)(bet + 4 * lane + 256 * j); }
    int kk = 0;
    for (int row = gw; row < M; row += NGW, ++kk) {
        f32x4 v[4]; float s = 0.f;
        if (ROUTER) {
#pragma unroll
            for (int j = 0; j < 4; ++j) { const f32x4 hv = *(const GAS f32x4*)(H + (size_t)row * D + 4 * lane + 256 * j), av = *(const GAS f32x4*)(ADD + (size_t)row * D + 4 * lane + 256 * j);
                v[j] = hv * DN_ALPHA + av; s += (v[j].x + v[j].y) + (v[j].z + v[j].w); }
        } else {
            const unsigned s0 = ((const GAS unsigned*)(a->ws + WS_SLOT))[2 * row], s1 = ((const GAS unsigned*)(a->ws + WS_SLOT))[2 * row + 1];
            const bf16* y0 = (const bf16*)(a->ws + WS_YS) + (size_t)(tab[s0 >> 16] + (int)(s0 & 0xffffu)) * D; const bf16* y1 = (const bf16*)(a->ws + WS_YS) + (size_t)(tab[s1 >> 16] + (int)(s1 & 0xffffu)) * D;
#pragma unroll
            for (int j = 0; j < 4; ++j) { const f32x4 hv = *(const GAS f32x4*)(H + (size_t)row * D + 4 * lane + 256 * j);
                const unsigned long long p0 = *(const GAS unsigned long long*)(y0 + 4 * lane + 256 * j), p1 = *(const GAS unsigned long long*)(y1 + 4 * lane + 256 * j);
                f32x4 av; av.x = bflo((unsigned)p0) + bflo((unsigned)p1); av.y = bfhi((unsigned)p0) + bfhi((unsigned)p1); av.z = bflo((unsigned)(p0 >> 32)) + bflo((unsigned)(p1 >> 32)); av.w = bfhi((unsigned)(p0 >> 32)) + bfhi((unsigned)(p1 >> 32));
                v[j] = hv * DN_ALPHA + av; s += (v[j].x + v[j].y) + (v[j].z + v[j].w); }
        }
        const float mean = wave_sum(s) * (1.f / D); float s2 = 0.f;
#pragma unroll
        for (int j = 0; j < 4; ++j) { v[j] = v[j] - mean; s2 += (v[j].x * v[j].x + v[j].y * v[j].y) + (v[j].z * v[j].z + v[j].w * v[j].w); }
        const float rstd = rsqrtf(wave_sum(s2) * (1.f / D) + LN_EPS);
#pragma unroll
        for (int j = 0; j < 4; ++j) { v[j] = v[j] * rstd * gv[j] + bv[j];
            *(GAS f32x4*)(H + (size_t)row * D + 4 * lane + 256 * j) = v[j];
            *(GAS unsigned long long*)(HB + (size_t)row * D + 4 * lane + 256 * j) = (unsigned long long)pk2(v[j].x, v[j].y) | ((unsigned long long)pk2(v[j].z, v[j].w) << 32); }
        if (ROUTER) {
            float lg[20];
#pragma unroll 1
            for (int c = 0; c < 20; ++c) { float p = 0.f;
#pragma unroll
                for (int j = 0; j < 4; ++j) { const f32x4 wv = *(const LAS f32x4*)(sW + c * D + 4 * lane + 256 * j); p += (v[j].x * wv.x + v[j].y * wv.y) + (v[j].z * wv.z + v[j].w * wv.w); }
                p = wave_sum(p); if (lane == 0) sL[c] = p; }
#pragma unroll
            for (int c = 0; c < 20; ++c) lg[c] = sL[c];
            float pg[4], mx = -1e30f; int gi = 0;
#pragma unroll
            for (int c = 0; c < 4; ++c) { pg[c] = lg[c] + a->in[I_BRG][l * 4 + c]; if (pg[c] > mx) { mx = pg[c]; gi = c; } }
            float den = 0.f;
#pragma unroll
            for (int c = 0; c < 4; ++c) den += __expf(pg[c] - mx);
            const float g_p = 1.0f / den;
            float le[4], emx = -1e30f; int i1 = 0;
#pragma unroll
            for (int c = 0; c < 4; ++c) { float x = 0.f;
#pragma unroll
                for (int gg = 0; gg < 4; ++gg) x = (gi == gg) ? lg[4 + gg * 4 + c] + a->in[I_BRE][l * 16 + gg * 4 + c] : x;
                le[c] = x; if (x > emx) { emx = x; i1 = c; } }
            float e2mx = -1e30f; int i2 = 0;
#pragma unroll
            for (int c = 0; c < 4; ++c) if (c != i1 && le[c] > e2mx) { e2mx = le[c]; i2 = c; }
            const float x2 = __expf(e2mx - emx), w1 = g_p / (1.0f + x2), w2 = g_p * x2 / (1.0f + x2);
            if (lane < 2) {
                const int e = gi * 4 + (lane == 0 ? i1 : i2); const float wv = lane == 0 ? w1 : w2;
                if (kk < 8) { const int lp = __hip_atomic_fetch_add(sCnt + e, 1, __ATOMIC_RELAXED, __HIP_MEMORY_SCOPE_WORKGROUP); LAS unsigned* en = sEnt + ((wave * 8 + kk) * 2 + lane) * 4;
                    en[0] = (unsigned)row; en[1] = (unsigned)e; en[2] = (unsigned)lp; en[3] = __builtin_bit_cast(unsigned, wv); }
                else { const int pos = (int)__hip_atomic_fetch_add(cnt + e, 1u, RLX_AGENT);
                    ((GAS int*)(a->ws + WS_LTOK))[e * M + pos] = row; ((GAS float*)(a->ws + WS_LW))[e * M + pos] = wv; ((GAS unsigned*)(a->ws + WS_SLOT))[2 * row + lane] = ((unsigned)e << 16) | (unsigned)pos; }
            }
        }
    }
    if (ROUTER) {
        __syncthreads();
        if (tid < 16) sCnt[16 + tid] = (int)__hip_atomic_fetch_add(cnt + tid, (unsigned)sCnt[tid], RLX_AGENT);
        __syncthreads();
        const int nk = kk < 8 ? kk : 8;
        if (tid < MAXENT) { const int wv_ = tid >> 4, k_ = (tid >> 1) & 7;
            const int rows_w = (M - (wg * NWAVES + wv_) + NGW - 1) / NGW; const int nkw = rows_w < 8 ? rows_w : 8;
            if (k_ < nkw) { const LAS unsigned* en = sEnt + tid * 4; const int e = (int)en[1], pos = sCnt[16 + e] + (int)en[2];
                ((GAS int*)(a->ws + WS_LTOK))[e * M + pos] = (int)en[0]; ((GAS unsigned*)(a->ws + WS_LW))[e * M + pos] = en[3]; ((GAS unsigned*)(a->ws + WS_SLOT))[2 * en[0] + (tid & 1)] = ((unsigned)e << 16) | (unsigned)pos; } }
        (void)nk;
    }
}
__device__ __forceinline__ void moe_gather_phase(CArgs a, int l, LAS unsigned char* lds, int wg, int G, int tid) {
    asm volatile("" : "+v"(tid));
    const int lane = tid & 63, gw = wg * NWAVES + (tid >> 6), NGW = G * NWAVES;
    moe_tables((gu32*)(a->ws + WS_CTL) + CW_CNT + l * 16, lds, tid);
    const LAS int* tab = (const LAS int*)(lds + LDS_OFF_TAB);
    const bf16* HB = (const bf16*)(a->ws + WS_HB); bf16* XS = (bf16*)(a->ws + WS_XS);
    for (int idx = gw; idx < 2 * M; idx += NGW) {
        int e = 0;
#pragma unroll
        for (int k = 1; k < 16; ++k) e += (tab[17 + k] <= idx) ? 1 : 0;
        const int pos = idx - tab[17 + e], dst = tab[e] + pos;
        const int row = ((const GAS int*)(a->ws + WS_LTOK))[e * M + pos];
        const v4u x0 = *(const GAS v4u*)(HB + (size_t)row * D + 8 * lane), x1 = *(const GAS v4u*)(HB + (size_t)row * D + 512 + 8 * lane);
        *(GAS v4u*)(XS + (size_t)dst * D + 8 * lane) = x0; *(GAS v4u*)(XS + (size_t)dst * D + 512 + 8 * lane) = x1;
        if (lane == 0) ((GAS float*)(a->ws + WS_WSORT))[dst] = ((const GAS float*)(a->ws + WS_LW))[e * M + pos];
    }
}

enum { P_IN = 0, P_PREP, P_SCAN, P_POST, P_OUT, P_LN1, P_GATHER, P_GU, P_DN, P_LN2, NPH };
constexpr int N_PHASES = 1 + DEPTH * NPH;
__global__ void __launch_bounds__(NTHR, 2) fwd(Args args) {
    extern __shared__ __attribute__((aligned(16))) unsigned char lds_raw[];
    LAS unsigned char* lds = (LAS unsigned char*)lds_raw;
    volatile LAS unsigned* MISC = (volatile LAS unsigned*)(lds + MISC_OFF);
    const int tid = threadIdx.x, G = gridDim.x, bx = blockIdx.x;
    unsigned char* ws0 = args.ws;
    gu32* ctl = (gu32*)(ws0 + WS_CTL);
    for (int u = tid; u < (LDS_BYTES - LDSCTL_OFF) / 4; u += NTHR) ((LAS unsigned*)(lds + LDSCTL_OFF))[u] = 0u;
    __syncthreads();
    const int lo = args.ph_lo, hi = args.ph_hi;
    const bool use_bar = (hi - lo) > 1;
    XcdBarrier bar; bar.bar = (unsigned*)(ctl + CW_BAR); bar.x = 0; bar.st = nullptr;
    if (use_bar) bar = xcd_barrier_post((unsigned*)(ctl + CW_BAR), MISC + 8);
#define IN(k) (lo <= (k) && (k) < hi)
#define SEAM(k) do { if (IN(k) && IN((k) + 1)) xcd_barrier(bar); } while (0)

    if (IN(0)) { p0_prologue(ARGS_HERE(), lds, bx, G, tid); weights_phase(ARGS_HERE(), 0, 1, lds, bx, G, tid); SEAM(0); }

    for (int l = 0; l < DEPTH; ++l) {
        const int base = 1 + l * NPH;
        unsigned char* ws = ws0; asm volatile("" : "+s"(ws));
        if (IN(base + P_IN)) {
            pg8::Gemm g{(const pg8::bf16_t*)(ws + WS_HB), (const pg8::bf16_t*)(ws + WS_WIN), M, NPROJ, D}; pg8::StaticOrder S; S.init(M, NPROJ, G, bx);
            pg8::EpiBf16<0> E{(pg8::bf16_t*)(ws + WS_PROJ), NPROJ, nullptr, 0, 0, 1.f};
            pg8::gemm_phase<pg8::EpiBf16<0>, pg8::StaticOrder, true, true>(lds + RING_OFF, g, S, E);
            SEAM(base + P_IN);
        }
        if (IN(base + P_PREP)) {
            hgrn_prep_phase(ARGS_HERE(), l, lds, bx, G, tid);
            ssd_prep_phase(ARGS_HERE(), l, lds, bx, G, tid);
            gdn_prep_phase(ARGS_HERE(), l, lds, bx, G, tid);
            SEAM(base + P_PREP); }
        if (IN(base + P_SCAN)) {
            if (G >= 192) {
                if (bx < 64) { const int pr = bx & 7, hh = bx >> 3; ssd_scan_phase(ARGS_HERE(), l, lds, pr >> 1, (pr & 1) * 8 + hh, tid); }
                else if (bx < 96) { const int x = (bx - 64) & 7, y = (bx - 64) >> 3, pr = x * 2 + (y >> 1); gdn_scan_phase(ARGS_HERE(), l, lds, pr >> 2, pr & 3, y & 1, tid); }
                else if (bx < 160) { const int x = (bx - 96) & 7, y = (bx - 96) >> 3, pr = x * 2 + (y >> 2); hgrn_scan_phase(ARGS_HERE(), l, lds, pr >> 2, pr & 3, y & 3, tid); }
                else { weights_phase(ARGS_HERE(), l, 14, lds, bx - 160, G - 160, tid);
                       if (l + 1 < DEPTH) weights_phase(ARGS_HERE(), l + 1, 1, lds, bx - 160, G - 160, tid); }
            }
            SEAM(base + P_SCAN); }
        if (IN(base + P_POST)) { mix_post_phase(ARGS_HERE(), l, bx, G, tid); SEAM(base + P_POST); }
        if (IN(base + P_OUT)) {
            pg8::Gemm g{(const pg8::bf16_t*)(ws + WS_YMIX), (const pg8::bf16_t*)(ws + WS_WOUT), M, D, DMIX}; pg8::StaticOrder S; S.init(M, D, G, bx);
            pg8::EpiF32 E{(float*)(ws + WS_MIX), D};
            pg8::gemm_phase<pg8::EpiF32, pg8::StaticOrder, true, true>(lds + RING_OFF, g, S, E);
            SEAM(base + P_OUT);
        }
        if (IN(base + P_LN1)) { CArgs a_ = ARGS_HERE(); ln_phase<true>(a_, l, a_->in[I_LN1G] + l * D, a_->in[I_LN1B] + l * D, lds, bx, G, tid); SEAM(base + P_LN1); }
        if (IN(base + P_GATHER)) { moe_gather_phase(ARGS_HERE(), l, lds, bx, G, tid); SEAM(base + P_GATHER); }
        if (IN(base + P_GU)) {
            moe_tables(ctl + CW_CNT + l * 16, lds, tid);
            pg8::Gemm g{(const pg8::bf16_t*)(ws + WS_XS), (const pg8::bf16_t*)(ws + WS_WGU), MAXROWS, NGU, D}; pg8::MoeOrder<2> S{(const LAS int*)(lds + LDS_OFF_TAB), G, bx};
            pg8::EpiSwiGLUs E{(pg8::bf16_t*)(ws + WS_HS), (const float*)(ws + WS_WSORT)};
            pg8::gemm_phase<pg8::EpiSwiGLUs, pg8::MoeOrder<2>, true, true>(lds + RING_OFF, g, S, E);
            SEAM(base + P_GU);
        }
        if (IN(base + P_DN)) {
            moe_tables(ctl + CW_CNT + l * 16, lds, tid);
            pg8::Gemm g{(const pg8::bf16_t*)(ws + WS_HS), (const pg8::bf16_t*)(ws + WS_WDN), MAXROWS, NEXP * D, DEXP}; pg8::MoeOrder<4> S{(const LAS int*)(lds + LDS_OFF_TAB), G, bx};
            pg8::EpiBf16s E{(pg8::bf16_t*)(ws + WS_YS)};
            pg8::gemm_phase<pg8::EpiBf16s, pg8::MoeOrder<4>, true, true>(lds + RING_OFF, g, S, E);
            SEAM(base + P_DN);
        }
        if (IN(base + P_LN2)) { CArgs a_ = ARGS_HERE(); ln_phase<false>(a_, l, a_->in[I_LN2G] + l * D, a_->in[I_LN2B] + l * D, lds, bx, G, tid); SEAM(base + P_LN2); }
    }
#undef IN
#undef SEAM
}

#ifndef MK_ONE_LAUNCH
#define MK_ONE_LAUNCH 1
#endif
extern "C" void kernel_launch(void* const* d_in, const int* in_sizes, int n_in, void* d_out, int out_size, void* d_ws, size_t ws_size, hipStream_t stream) {
    static int grid = 0;
    if (grid == 0) {
        if (n_in != 25 || out_size != M * D || ws_size < WS_END) { fprintf(stderr, "kernel_launch: unexpected shapes (n_in %d out %d ws %zu)\n", n_in, out_size, ws_size); grid = -1; return; }
        int dev = 0, cus = 0, per_cu = 0;
        if (hipGetDevice(&dev) != hipSuccess || hipDeviceGetAttribute(&cus, hipDeviceAttributeMultiprocessorCount, dev) != hipSuccess) { grid = -1; return; }
        if (hipFuncSetAttribute((const void*)fwd, hipFuncAttributeMaxDynamicSharedMemorySize, LDS_BYTES) != hipSuccess) { fprintf(stderr, "kernel_launch: hipFuncSetAttribute failed\n"); grid = -1; return; }
        if (hipOccupancyMaxActiveBlocksPerMultiprocessor(&per_cu, (const void*)fwd, NTHR, LDS_BYTES) != hipSuccess || per_cu < 1) { fprintf(stderr, "kernel_launch: occupancy query says %d\n", per_cu); (void)hipGetLastError(); grid = -1; return; }
        grid = cus;
    }
    if (grid < 0) return;
    if (hipMemsetAsync((char*)d_ws + WS_CTL, 0, CTL_ZERO_BYTES, stream) != hipSuccess) return;
    Args a{};
    for (int i = 0; i < 25; ++i) a.in[i] = (const float*)d_in[i];
    a.out = (float*)d_out; a.ws = (unsigned char*)d_ws;
#if MK_ONE_LAUNCH
    a.ph_lo = 0; a.ph_hi = N_PHASES;
    hipLaunchKernelGGL(fwd, dim3(grid), dim3(NTHR), LDS_BYTES, stream, a);
#else
    for (int p = 0; p < N_PHASES; ++p) { a.ph_lo = p; a.ph_hi = p + 1; hipLaunchKernelGGL(fwd, dim3(grid), dim3(NTHR), LDS_BYTES, stream, a); }
#endif
}
```

```cpp
#include <hip/hip_runtime.h>
#include <cstdio>
#include <cstdint>
namespace pg8 {
#define PG8_LAS __attribute__((address_space(3)))
typedef unsigned short bf16_t;
typedef short bf16x8 __attribute__((ext_vector_type(8)));
typedef float f32x4 __attribute__((ext_vector_type(4)));
typedef unsigned u32x4 __attribute__((ext_vector_type(4)));
constexpr int BM = 256, BK = 64, HALF = 128, HTB = HALF * BK * 2  , STAGE_BYTES = 8 * HTB, NXCD = 8, WGM = 8;

__host__ __device__ __forceinline__ int lds_byte(int r, int c) { const int st = (r >> 4) * 2 + (c >> 5), rr = r & 15, cc = c & 31, ob = rr * 64 + cc * 2; return st * 1024 + (ob ^ (((ob >> 9) & 1) << 5)); }
__host__ __device__ __forceinline__ void stage_rc(int b, int& R, int& C) { const int st = b / 1024, sb = b % 1024, swz = sb ^ (((sb >> 9) & 1) << 5); R = (st >> 1) * 16 + swz / 64; C = (st & 1) * 32 + (swz % 64) / 2; }
__host__ __device__ __forceinline__ int perm32(int rho) { const int n = rho >> 4, i = rho & 15; return 8 * (i >> 2) + 4 * n + (i & 3); }

struct Unit { int pm, pn; };
struct Gemm { const bf16_t* A; const bf16_t* Bt; int M, N, K; };

struct StaticOrder {
    static constexpr bool GATHER = false;
    int nM, nN, nwg, G, c;
    __host__ __device__ void init(int M, int N, int G_, int c_) { nM = M / BM; nN = N / BM; nwg = nM * nN; G = G_; c = c_; }
    __host__ __device__ bool next(int i, Unit& u) const {
        const long L = (long)i * G + c; if (L >= nwg) return false;
        int wgid = (int)L; { const int q = nwg / NXCD, r = nwg % NXCD, xcd = wgid % NXCD, off = wgid / NXCD; wgid = (xcd < r ? xcd * (q + 1) : r * (q + 1) + (xcd - r) * q) + off; }
        const int nig = WGM * nN, gid = wgid / nig, fm = gid * WGM, gsz = (nM - fm) < WGM ? (nM - fm) : WGM;
        u.pm = fm + ((wgid % nig) % gsz); u.pn = (wgid % nig) / gsz; return true;
    }
    __device__ __forceinline__ void a_ready(const Unit&) const {}
    __device__ __forceinline__ void done(const Unit&) const {}
    __device__ __forceinline__ int row_token(int, const Unit&) const { return 0; }
};
__device__ __forceinline__ unsigned cvt_pk_bf16(float lo, float hi) { unsigned r; asm volatile("v_cvt_pk_bf16_f32 %0, %1, %2" : "=v"(r) : "v"(lo), "v"(hi)); return r; }
typedef float f32x2 __attribute__((ext_vector_type(2)));
__device__ __forceinline__ f32x2 gelu_pk(f32x2 v) {
    const f32x2 av = __builtin_elementwise_abs(v), d = av * 0.2316418882f + 1.0f;
    f32x2 t; t.x = __builtin_amdgcn_rcpf(d.x); t.y = __builtin_amdgcn_rcpf(d.y);
    f32x2 q = t * 0.5307027145f + (-0.7265760135f); q = q * t + 0.7107068705f; q = q * t + (-0.142248368f); q = q * t + 0.127414796f; q = q * t;
    const f32x2 s = (v * v) * (-0.72134752044f);
    f32x2 e; e.x = __builtin_amdgcn_exp2f(s.x); e.y = __builtin_amdgcn_exp2f(s.y);
    const f32x2 m = v * (q * e), r = v - m;
    f32x2 o; o.x = v.x < 0.f ? m.x : r.x; o.y = v.y < 0.f ? m.y : r.y; return o;
}

template <int ACT  > struct EpiBf16 {
    static constexpr bool PERM = true, AFTER_DRAIN = false; static_assert(ACT == 0 || ACT == 1, "EpiBf16: ACT is 0 (none) or 1 (gelu_pk)");
    bf16_t* O; int ldc; const float* bias; int split_cols; size_t split_stride; float scale0;
    __device__ __forceinline__ void operator()(const f32x4 (&acc)[2][2][4][2], const Unit& u, int wr, int wc, int fr, int fq) const {
        const int row0 = u.pm * BM + wr * 64 + fr; int colt = u.pn * BM; bf16_t* base = O;
        float sc = 1.f; if (split_cols) { const int t = colt / split_cols; base += (size_t)t * split_stride; colt -= t * split_cols; if (t == 0) sc = scale0; }
        const int col0 = colt + wc * 32 + 8 * fq, bcol0 = u.pn * BM + wc * 32 + 8 * fq;
        f32x4 bv[2][2];
#pragma unroll
        for (int bj = 0; bj < 2; ++bj)
#pragma unroll
            for (int n = 0; n < 2; ++n) bv[bj][n] = bias ? *(const f32x4*)(bias + bcol0 + bj * HALF + 4 * n) : (f32x4){0.f, 0.f, 0.f, 0.f};
#pragma unroll
        for (int ai = 0; ai < 2; ++ai)
#pragma unroll
            for (int m = 0; m < 4; ++m) { bf16_t* rowp = base + (size_t)(row0 + ai * HALF + m * 16) * ldc + col0;
#pragma unroll
                for (int bj = 0; bj < 2; ++bj) { f32x4 v0 = acc[ai][bj][m][0] + bv[bj][0], v1 = acc[ai][bj][m][1] + bv[bj][1];
                    if (ACT == 1) { f32x2 a = gelu_pk((f32x2){v0[0], v0[1]}), b = gelu_pk((f32x2){v0[2], v0[3]}), c = gelu_pk((f32x2){v1[0], v1[1]}), d = gelu_pk((f32x2){v1[2], v1[3]});
                        v0 = (f32x4){a.x, a.y, b.x, b.y}; v1 = (f32x4){c.x, c.y, d.x, d.y}; }
                    v0 = v0 * sc; v1 = v1 * sc; u32x4 w; w.x = cvt_pk_bf16(v0[0], v0[1]); w.y = cvt_pk_bf16(v0[2], v0[3]); w.z = cvt_pk_bf16(v1[0], v1[1]); w.w = cvt_pk_bf16(v1[2], v1[3]);
                    *(u32x4*)(rowp + bj * HALF) = w; } }
    }
};
struct EpiF32 {
    static constexpr bool PERM = false, AFTER_DRAIN = false;
    float* C; int ldc;
    __device__ __forceinline__ void operator()(const f32x4 (&acc)[2][2][4][2], const Unit& u, int wr, int wc, int fr, int fq) const {
        const int row0 = u.pm * BM + wr * 64 + fr, col0 = u.pn * BM + wc * 32 + 4 * fq;
#pragma unroll
        for (int ai = 0; ai < 2; ++ai)
#pragma unroll
            for (int m = 0; m < 4; ++m) { float* rowp = C + (size_t)(row0 + ai * HALF + m * 16) * ldc + col0;
#pragma unroll
                for (int bj = 0; bj < 2; ++bj)
#pragma unroll
                    for (int n = 0; n < 2; ++n) *(f32x4*)(rowp + bj * HALF + n * 16) = acc[ai][bj][m][n]; }
    }
};
__device__ __forceinline__ float silu_f(float x) { return x / (1.0f + __expf(-x)); }
struct EpiSwiGLU {
    static constexpr bool PERM = true, AFTER_DRAIN = false;
    bf16_t* H; int ldh; const float* comb; int ldcomb;
    __device__ __forceinline__ void operator()(const f32x4 (&acc)[2][2][4][2], const Unit& u, int wr, int wc, int fr, int fq) const {
        const int row0 = u.pm * BM + wr * 64 + fr, col0 = u.pn * 128 + wc * 32 + 8 * fq, e = u.pn >> 1;
#pragma unroll
        for (int ai = 0; ai < 2; ++ai)
#pragma unroll
            for (int m = 0; m < 4; ++m) { const int row = row0 + ai * HALF + m * 16; const float cw = comb[(size_t)row * ldcomb + e];
                const f32x4 g0 = acc[ai][0][m][0], g1 = acc[ai][0][m][1], u0 = acc[ai][1][m][0], u1 = acc[ai][1][m][1];
                f32x4 h0, h1;
#pragma unroll
                for (int j = 0; j < 4; ++j) { h0[j] = silu_f(g0[j]) * u0[j] * cw; h1[j] = silu_f(g1[j]) * u1[j] * cw; }
                u32x4 w; w.x = cvt_pk_bf16(h0[0], h0[1]); w.y = cvt_pk_bf16(h0[2], h0[3]); w.z = cvt_pk_bf16(h1[0], h1[1]); w.w = cvt_pk_bf16(h1[2], h1[3]);
                *(u32x4*)(H + (size_t)row * ldh + col0) = w; }
    }
};

template <int NSUB, bool GATHER_ = false> struct MoeOrder {
    static constexpr bool GATHER = GATHER_;
    const PG8_LAS int* off; int G, c; const int* ltok; int lstride;
    __device__ __forceinline__ int row_token(int srow, const Unit& u) const { const int e = u.pn / NSUB, pos = srow - off[e]; return pos < off[18 + e] - off[17 + e] ? ltok[e * lstride + pos] : 0; }
    __device__ __forceinline__ bool next(int i, Unit& u) const {
        const int L = i * G + c, x = L & 7, j = L >> 3, t = x + 8 * (j / NSUB), pnl = j % NSUB;
        if (t * 256 >= off[16]) return false;
        int e = 0;
#pragma unroll
        for (int k = 1; k < 16; ++k) e += (off[k] <= t * 256) ? 1 : 0;
        u.pm = t; u.pn = e * NSUB + pnl; return true;
    }
    __device__ __forceinline__ void a_ready(const Unit&) const {}
    __device__ __forceinline__ void done(const Unit&) const {}
};
struct EpiSwiGLUs {
    static constexpr bool PERM = true, AFTER_DRAIN = false;
    bf16_t* H; const float* lw; int lstride; const PG8_LAS int* off;
    __device__ __forceinline__ void operator()(const f32x4 (&acc)[2][2][4][2], const Unit& u, int wr, int wc, int fr, int fq) const {
        const int row0 = u.pm * BM + wr * 64 + fr, col0 = (u.pn & 1) * 128 + wc * 32 + 8 * fq;
#pragma unroll
        for (int ai = 0; ai < 2; ++ai)
#pragma unroll
            for (int m = 0; m < 4; ++m) { const int row = row0 + ai * HALF + m * 16; const int e_ = u.pn >> 1, pos_ = row - off[e_]; const float cw = pos_ < off[18 + e_] - off[17 + e_] ? lw[e_ * lstride + pos_] : 0.f;
                const f32x4 g0 = acc[ai][0][m][0], g1 = acc[ai][0][m][1], u0 = acc[ai][1][m][0], u1 = acc[ai][1][m][1];
                f32x4 h0, h1;
#pragma unroll
                for (int j = 0; j < 4; ++j) { h0[j] = silu_f(g0[j]) * u0[j] * cw; h1[j] = silu_f(g1[j]) * u1[j] * cw; }
                u32x4 w; w.x = cvt_pk_bf16(h0[0], h0[1]); w.y = cvt_pk_bf16(h0[2], h0[3]); w.z = cvt_pk_bf16(h1[0], h1[1]); w.w = cvt_pk_bf16(h1[2], h1[3]);
                *(u32x4*)(H + (size_t)row * 256 + col0) = w; }
    }
};
struct EpiBf16s {
    static constexpr bool PERM = true, AFTER_DRAIN = false;
    bf16_t* O;
    __device__ __forceinline__ void operator()(const f32x4 (&acc)[2][2][4][2], const Unit& u, int wr, int wc, int fr, int fq) const {
        const int row0 = u.pm * BM + wr * 64 + fr, col0 = (u.pn & 3) * BM + wc * 32 + 8 * fq;
#pragma unroll
        for (int ai = 0; ai < 2; ++ai)
#pragma unroll
            for (int m = 0; m < 4; ++m) { bf16_t* rowp = O + (size_t)(row0 + ai * HALF + m * 16) * 1024 + col0;
#pragma unroll
                for (int bj = 0; bj < 2; ++bj) { const f32x4 v0 = acc[ai][bj][m][0], v1 = acc[ai][bj][m][1];
                    u32x4 w; w.x = cvt_pk_bf16(v0[0], v0[1]); w.y = cvt_pk_bf16(v0[2], v0[3]); w.z = cvt_pk_bf16(v1[0], v1[1]); w.w = cvt_pk_bf16(v1[2], v1[3]);
                    *(u32x4*)(rowp + bj * HALF) = w; } }
    }
};
template <class Epi, class Sched, bool ALIGN_EPI = false, bool SP2 = false>
__device__ __forceinline__ void gemm_phase(PG8_LAS unsigned char* lds, const Gemm g, const Sched& S, const Epi& E) {
    int tid_ = threadIdx.x; asm volatile("" : "+v"(tid_));
    const int tid = tid_, wid = __builtin_amdgcn_readfirstlane(tid >> 6), lane = tid & 63, wr = wid >> 2, wc = wid & 3, fr = lane & 15, fq = lane >> 4;
    const int K = g.K, nt = K / BK;
    unsigned voffA[2], voffB[2];
#pragma unroll
    for (int i = 0; i < 2; ++i) { int R, C; stage_rc(tid * 16 + i * 8192, R, C); const int Rb = Epi::PERM ? ((R & ~31) + perm32(R & 31)) : R;
        voffA[i] = (unsigned)(R * K + C) * 2u; voffB[i] = (unsigned)(Rb * K + C) * 2u; }
    constexpr bool GATHER = Sched::GATHER; static_assert(!GATHER || SP2, "the gather path is written for the two-super-phase loop");
    int gR[2], gC[2];
#pragma unroll
    for (int i = 0; i < 2; ++i) stage_rc(tid * 16 + i * 8192, gR[i], gC[i]);
    unsigned vA0[2] = {0u, 0u}, vA1[2] = {0u, 0u}, nvA0[2] = {0u, 0u}, nvA1[2] = {0u, 0u};
#define PG8_GLOOK(U, D0, D1) do { _Pragma("unroll") for (int _i = 0; _i < 2; ++_i) { \
        D0[_i] = (unsigned)S.row_token((U).pm * BM + gR[_i], (U)) * (unsigned)(K * 2) + (unsigned)gC[_i] * 2u; D1[_i] = (unsigned)S.row_token((U).pm * BM + HALF + gR[_i], (U)) * (unsigned)(K * 2) + (unsigned)gC[_i] * 2u; } } while (0)
    const size_t kstep = (size_t)(BK * 2);
    const size_t hstep = (size_t)HALF * K * 2;
    const size_t tstep = 2 * hstep;
    const unsigned ldsw = (unsigned)wid * 1024u;
    const int aoff = lds_byte(wr * 64 + fr, fq * 8), boff = lds_byte(wc * 32 + fr, fq * 8);
#define PG8_SA(b, h) (((b) * 2 + (h)) * HTB)
#define PG8_SB(b, h) ((4 + (b) * 2 + (h)) * HTB)
#define PG8_STAGE(bufoff, gbase, voff) do { _Pragma("unroll") for (int _i = 0; _i < 2; ++_i) \
        __builtin_amdgcn_global_load_lds((const unsigned*)((const char*)(gbase) + (voff)[_i]), (PG8_LAS unsigned*)(lds + (bufoff) + ldsw + _i * 8192), 16, 0, 0); } while (0)
#define PG8_LDA(dst, b, h) do { _Pragma("unroll") for (int m = 0; m < 4; ++m) _Pragma("unroll") for (int k = 0; k < 2; ++k) dst[m][k] = *(const PG8_LAS bf16x8*)(lds + PG8_SA(b, h) + aoff + m * 2048 + k * 1024); } while (0)
#define PG8_LDB(dst, b, h) do { _Pragma("unroll") for (int n = 0; n < 2; ++n) _Pragma("unroll") for (int k = 0; k < 2; ++k) dst[n][k] = *(const PG8_LAS bf16x8*)(lds + PG8_SB(b, h) + boff + n * 2048 + k * 1024); } while (0)
#define PG8_MMA(ai, bj, At, Bt) do { __builtin_amdgcn_s_setprio(1); _Pragma("unroll") for (int m = 0; m < 4; ++m) _Pragma("unroll") for (int n = 0; n < 2; ++n) _Pragma("unroll") for (int k = 0; k < 2; ++k) \
        acc[ai][bj][m][n] = __builtin_amdgcn_mfma_f32_16x16x32_bf16(Bt[n][k], At[m][k], acc[ai][bj][m][n], 0, 0, 0); __builtin_amdgcn_s_setprio(0); } while (0)
#define PG8_WAIT_V(n) asm volatile("s_waitcnt vmcnt(" #n ")" ::: "memory")
#define PG8_WAIT_L(n) asm volatile("s_waitcnt lgkmcnt(" #n ")" ::: "memory")
#define PG8_BAR __builtin_amdgcn_s_barrier()
#define PG8_SCHED __builtin_amdgcn_sched_barrier(0)
    Unit cur, nxt; int ui = 0;
    if (!S.next(0, cur)) return;
    f32x4 acc[2][2][4][2];
#pragma unroll
    for (int a = 0; a < 2; ++a)
#pragma unroll
        for (int b = 0; b < 2; ++b)
#pragma unroll
            for (int m = 0; m < 4; ++m)
#pragma unroll
                for (int n = 0; n < 2; ++n) acc[a][b][m][n] = (f32x4){0.f, 0.f, 0.f, 0.f};
    bf16x8 At[4][2], B0[2][2], B1[2][2];
    const char* cA = (const char*)g.A + (GATHER ? (size_t)0 : (size_t)cur.pm * tstep); const char* cB = (const char*)g.Bt + (size_t)cur.pn * tstep;
    if constexpr (GATHER) PG8_GLOOK(cur, vA0, vA1);
    S.a_ready(cur);
    if constexpr (SP2) {
        PG8_STAGE(PG8_SB(0, 0), cB, voffB); PG8_STAGE(PG8_SB(0, 1), cB + hstep, voffB);
        if constexpr (GATHER) { PG8_STAGE(PG8_SA(0, 0), cA, vA0); PG8_STAGE(PG8_SA(0, 1), cA, vA1); } else { PG8_STAGE(PG8_SA(0, 0), cA, voffA); PG8_STAGE(PG8_SA(0, 1), cA + hstep, voffA); }
        if (wr == 1) PG8_BAR;
        PG8_WAIT_V(2); PG8_BAR;
        PG8_STAGE(PG8_SB(1, 0), cB + kstep, voffB); if constexpr (GATHER) PG8_STAGE(PG8_SA(1, 0), cA + kstep, vA0); else PG8_STAGE(PG8_SA(1, 0), cA + kstep, voffA); PG8_STAGE(PG8_SB(1, 1), cB + hstep + kstep, voffB);
        PG8_WAIT_V(6); PG8_BAR;
    } else {
        PG8_STAGE(PG8_SB(0, 0), cB, voffB); PG8_STAGE(PG8_SA(0, 0), cA, voffA); PG8_STAGE(PG8_SB(0, 1), cB + hstep, voffB); PG8_STAGE(PG8_SA(0, 1), cA + hstep, voffA);
        if (wr == 1) PG8_BAR;
        PG8_WAIT_V(4); PG8_BAR;
        PG8_STAGE(PG8_SB(1, 0), cB + kstep, voffB); PG8_STAGE(PG8_SA(1, 0), cA + kstep, voffA); PG8_STAGE(PG8_SB(1, 1), cB + hstep + kstep, voffB);
        PG8_WAIT_V(6); PG8_BAR;
    }
    for (;;) {
        const bool has_next = S.next(ui + 1, nxt);
        const char* nA = (has_next && !GATHER) ? (const char*)g.A + (size_t)nxt.pm * tstep : cA; const char* nB = has_next ? (const char*)g.Bt + (size_t)nxt.pn * tstep : cB;
        if constexpr (GATHER) { if (has_next) PG8_GLOOK(nxt, nvA0, nvA1); else { nvA0[0] = vA0[0]; nvA0[1] = vA0[1]; nvA1[0] = vA1[0]; nvA1[1] = vA1[1]; } }
#pragma unroll 1
        for (int t = 0; t < nt; t += 2) {
            const bool last = (t == nt - 2);
            const char* a1 = cA + (size_t)(t + 1) * kstep;
            const char* a2 = last ? nA : cA + (size_t)(t + 2) * kstep; const char* b2 = last ? nB : cB + (size_t)(t + 2) * kstep;
            const char* a3 = a2 + kstep; const char* b3 = b2 + kstep;
            if (last && has_next) S.a_ready(nxt);
            if constexpr (SP2) {
            PG8_LDB(B0, 0, 0); PG8_LDB(B1, 0, 1); PG8_SCHED; PG8_LDA(At, 0, 0); if constexpr (GATHER) PG8_STAGE(PG8_SA(1, 1), a1, vA1); else PG8_STAGE(PG8_SA(1, 1), a1 + hstep, voffA);
            PG8_WAIT_V(8); PG8_WAIT_L(0); PG8_BAR; PG8_MMA(0, 0, At, B0); PG8_MMA(0, 1, At, B1); PG8_BAR; PG8_SCHED;
            PG8_LDA(At, 0, 1); PG8_STAGE(PG8_SB(0, 0), b2, voffB); PG8_STAGE(PG8_SB(0, 1), b2 + hstep, voffB); if constexpr (GATHER) { unsigned v_[2] = {last ? nvA0[0] : vA0[0], last ? nvA0[1] : vA0[1]}; PG8_STAGE(PG8_SA(0, 0), a2, v_); } else PG8_STAGE(PG8_SA(0, 0), a2, voffA);
            PG8_WAIT_V(8); PG8_WAIT_L(0); PG8_BAR; PG8_MMA(1, 0, At, B0); PG8_MMA(1, 1, At, B1); PG8_BAR; PG8_SCHED;
            PG8_LDB(B0, 1, 0); PG8_LDB(B1, 1, 1); PG8_SCHED; PG8_LDA(At, 1, 0); if constexpr (GATHER) { unsigned v_[2] = {last ? nvA1[0] : vA1[0], last ? nvA1[1] : vA1[1]}; PG8_STAGE(PG8_SA(0, 1), a2, v_); } else PG8_STAGE(PG8_SA(0, 1), a2 + hstep, voffA);
            PG8_WAIT_V(8); PG8_WAIT_L(0); PG8_BAR; PG8_MMA(0, 0, At, B0); PG8_MMA(0, 1, At, B1); PG8_BAR; PG8_SCHED;
            PG8_LDA(At, 1, 1); PG8_STAGE(PG8_SB(1, 0), b3, voffB); PG8_STAGE(PG8_SB(1, 1), b3 + hstep, voffB); if constexpr (GATHER) { unsigned v_[2] = {last ? nvA0[0] : vA0[0], last ? nvA0[1] : vA0[1]}; PG8_STAGE(PG8_SA(1, 0), a3, v_); } else PG8_STAGE(PG8_SA(1, 0), a3, voffA);
            PG8_WAIT_V(8); PG8_WAIT_L(0); PG8_BAR; PG8_MMA(1, 0, At, B0); PG8_MMA(1, 1, At, B1); PG8_BAR; PG8_SCHED;
            } else {
            PG8_LDB(B0, 0, 0); PG8_SCHED; PG8_LDA(At, 0, 0); PG8_STAGE(PG8_SA(1, 1), a1 + hstep, voffA);
            PG8_WAIT_L(8); PG8_BAR; PG8_WAIT_L(0); PG8_MMA(0, 0, At, B0); PG8_BAR; PG8_SCHED;
            PG8_LDB(B1, 0, 1); PG8_STAGE(PG8_SB(0, 0), b2, voffB);
            PG8_BAR; PG8_WAIT_L(0); PG8_MMA(0, 1, At, B1); PG8_BAR;
            PG8_LDA(At, 0, 1); PG8_STAGE(PG8_SA(0, 0), a2, voffA);
            PG8_BAR; PG8_WAIT_L(0); PG8_MMA(1, 0, At, B0); PG8_BAR; PG8_SCHED;
            PG8_STAGE(PG8_SB(0, 1), b2 + hstep, voffB);
            PG8_WAIT_V(6); PG8_BAR; PG8_MMA(1, 1, At, B1); PG8_BAR;
            PG8_LDB(B0, 1, 0); PG8_SCHED; PG8_LDA(At, 1, 0); PG8_STAGE(PG8_SA(0, 1), a2 + hstep, voffA);
            PG8_WAIT_L(8); PG8_BAR; PG8_WAIT_L(0); PG8_MMA(0, 0, At, B0); PG8_BAR; PG8_SCHED;
            PG8_LDB(B1, 1, 1); PG8_STAGE(PG8_SB(1, 0), b3, voffB);
            PG8_BAR; PG8_WAIT_L(0); PG8_MMA(0, 1, At, B1); PG8_BAR;
            PG8_LDA(At, 1, 1); PG8_STAGE(PG8_SA(1, 0), a3, voffA);
            PG8_BAR; PG8_WAIT_L(0); PG8_MMA(1, 0, At, B0); PG8_BAR; PG8_SCHED;
            PG8_STAGE(PG8_SB(1, 1), b3 + hstep, voffB);
            PG8_WAIT_V(6); PG8_BAR; PG8_MMA(1, 1, At, B1); PG8_BAR;
            }
        }
        if constexpr (ALIGN_EPI) { if (wr == 0) PG8_BAR; }
        if constexpr (!Epi::AFTER_DRAIN) { E(acc, cur, wr, wc, fr, fq); S.done(cur); }
        if (!has_next) break;
#pragma unroll
        for (int a = 0; a < 2; ++a)
#pragma unroll
            for (int b = 0; b < 2; ++b)
#pragma unroll
                for (int m = 0; m < 4; ++m)
#pragma unroll
                    for (int n = 0; n < 2; ++n) acc[a][b][m][n] = (f32x4){0.f, 0.f, 0.f, 0.f};
        cur = nxt; cA = nA; cB = nB; ++ui;
        if constexpr (GATHER) { vA0[0] = nvA0[0]; vA0[1] = nvA0[1]; vA1[0] = nvA1[0]; vA1[1] = nvA1[1]; }
        if constexpr (ALIGN_EPI) { if (wr == 1) PG8_BAR; }
    }
    PG8_WAIT_V(0);
    if constexpr (!ALIGN_EPI) { if (wr == 0) PG8_BAR; }
    PG8_BAR;
    if constexpr (Epi::AFTER_DRAIN) { E.fused(acc, cur, wr, wc, fr, fq, lds, wid, lane); S.done(cur); }
#undef PG8_GLOOK
#undef PG8_SA
#undef PG8_SB
#undef PG8_STAGE
#undef PG8_LDA
#undef PG8_LDB
#undef PG8_MMA
#undef PG8_WAIT_V
#undef PG8_WAIT_L
#undef PG8_BAR
#undef PG8_SCHED
}
}
#define GAS __attribute__((address_space(1)))
#define LAS __attribute__((address_space(3)))
typedef unsigned short bf16;
typedef unsigned v4u __attribute__((ext_vector_type(4)));
typedef float f32x4 __attribute__((ext_vector_type(4)));
typedef short bf16x8 __attribute__((ext_vector_type(8)));
typedef GAS unsigned gu32;
typedef GAS unsigned long long gu64;
#define RLX_AGENT __ATOMIC_RELAXED, __HIP_MEMORY_SCOPE_AGENT
#define LDS_WAIT() asm volatile("s_waitcnt lgkmcnt(0)" ::: "memory")
#define VM_WAIT() asm volatile("s_waitcnt vmcnt(0)" ::: "memory")
__device__ __forceinline__ unsigned long long rt() { return __builtin_amdgcn_s_memrealtime(); }
__device__ __forceinline__ unsigned f2bf(float f) { unsigned u = __builtin_bit_cast(unsigned, f); return (u + 0x7fffu + ((u >> 16) & 1u)) >> 16; }
__device__ __forceinline__ unsigned pk2(float lo, float hi) { return f2bf(lo) | (f2bf(hi) << 16); }

#define XB_TMO      128
#define XB_XCNT(j)  (256  + 64 * (j))
#define XB_XSUB(j)  (1280 + 64 * (j))
#define XB_XGEN(j)  (2304 + 64 * (j))
#define XB_TOP      3328
#define XB_TOPGEN   3392
#define XCD_BAR_WORDS 3456
#define XB_SPIN_CAP (1u << 18)

__device__ __forceinline__ unsigned xb_ld(unsigned* p)              { return __hip_atomic_load(p, __ATOMIC_RELAXED, __HIP_MEMORY_SCOPE_AGENT); }
__device__ __forceinline__ unsigned xb_add(unsigned* p, unsigned v) { return __hip_atomic_fetch_add(p, v, __ATOMIC_RELAXED, __HIP_MEMORY_SCOPE_AGENT); }
__device__ __forceinline__ unsigned xb_xcc_id() { return (unsigned)__builtin_amdgcn_s_getreg((3 << 11) | 20) & 0xFu; }
#define XB_SPIN(cond, bar) do { unsigned _sp = 0; while (cond) { __builtin_amdgcn_s_sleep(1); \
    if ((++_sp & 255u) == 0u) { if (xb_ld(&(bar)[XB_TMO])) break; if (_sp > XB_SPIN_CAP) { atomicAdd(&(bar)[XB_TMO], 1u); break; } } } } while (0)

struct XcdBarrier {
    unsigned* bar; unsigned x;
    volatile LAS unsigned* st;
};

__device__ __forceinline__ XcdBarrier xcd_barrier_post(unsigned* bar, volatile LAS unsigned* st) {
    XcdBarrier b; b.bar = bar; b.x = xb_xcc_id(); b.st = st;
    if (threadIdx.x == 0) (void)xb_add(&bar[XB_XCNT(b.x)], 1u);
    return b;
}
__device__ __forceinline__ void xcd_barrier_complete(unsigned* bar, unsigned x, unsigned& nloc, unsigned& nx) {
    const unsigned G = gridDim.x * gridDim.y * gridDim.z;
    unsigned sum, cnt, mine, sp = 0u;
    for (;;) {
        sum = 0u; cnt = 0u; mine = 0u;
#pragma unroll
        for (unsigned j = 0; j < 16; ++j) { const unsigned c = xb_ld(&bar[XB_XCNT(j)]); sum += c; cnt += (c > 0u) ? 1u : 0u; mine = (j == x) ? c : mine; }
        if (sum == G) break;
        __builtin_amdgcn_s_sleep(1);
        if ((++sp & 255u) == 0u) { if (xb_ld(&bar[XB_TMO])) break; if (sp > XB_SPIN_CAP) { atomicAdd(&bar[XB_TMO], 1u); break; } }
    }
    nloc = mine > 0u ? mine : 1u; nx = cnt > 0u ? cnt : 1u;
}

__device__ __forceinline__ void xcd_barrier(const XcdBarrier& b) {
    asm volatile("s_waitcnt vmcnt(0)" ::: "memory");
    __syncthreads();
    if (threadIdx.x == 0) {
        unsigned* bar = b.bar;
        __builtin_amdgcn_s_waitcnt(0);
        unsigned nloc = b.st[0], nx = b.st[1];
        if (nloc == 0u) { xcd_barrier_complete(bar, b.x, nloc, nx); b.st[0] = nloc; b.st[1] = nx; }
        const unsigned old = xb_add(&bar[XB_XSUB(b.x)], 1u);
        const unsigned gen = old / nloc;
        if (old + 1u == (gen + 1u) * nloc) {
            __builtin_amdgcn_fence(__ATOMIC_RELEASE, "agent");
            asm volatile("s_waitcnt vmcnt(0)" ::: "memory");
            const unsigned og = xb_add(&bar[XB_TOP], 1u);
            const unsigned tg = og / nx;
            if (og + 1u == (tg + 1u) * nx) xb_add(&bar[XB_TOPGEN], 1u);
            else XB_SPIN(xb_ld(&bar[XB_TOPGEN]) == tg, bar);
            __builtin_amdgcn_fence(__ATOMIC_ACQUIRE, "agent");
            xb_add(&bar[XB_XGEN(b.x)], 1u);
            asm volatile("s_waitcnt vmcnt(0)" ::: "memory");
        } else {
            XB_SPIN(xb_ld(&bar[XB_XGEN(b.x)]) == gen, bar);
            __builtin_amdgcn_fence(__ATOMIC_ACQUIRE, "agent");
            asm volatile("s_waitcnt vmcnt(0)" ::: "memory");
        }
    }
    __syncthreads();
}
constexpr int NWAVES = 8, NTHR = NWAVES * 64;
constexpr int D = 1024, BATCH = 4, SEQ = 4096, M = BATCH * SEQ, DEPTH = 4;
constexpr int IN_COLS = 6680, NPROJ = 6912;
constexpr int O_Z = 0, O_XBC = 1024, O_DT = 2560, O_QKV = 2576, O_GG = 4112, O_GB = 4624, O_GA = 4628, O_HQ = 4632, O_HF = 5144, O_HI = 5656, O_HG = 6168;
constexpr int DMIX = 2048, NEXP = 16, DEXP = 256, NGU = NEXP * 2 * DEXP  , KDN = NEXP * DEXP  ;
constexpr float DN_ALPHA = 1.6817928305074290f;
constexpr float LN_EPS = 1e-5f;

constexpr size_t MiB = 1u << 20;
constexpr size_t WS_CTL = 0, CTL_ZERO_BYTES = 1 * MiB;
constexpr size_t WS_LTOK = 2 * MiB;
constexpr size_t WS_LW = 3 * MiB;
constexpr size_t WS_SLOT = 4 * MiB;
constexpr size_t WS_WSORT = 5 * MiB;
constexpr size_t WS_WIN = 8 * MiB;
constexpr size_t WS_WOUT = 22 * MiB;
constexpr size_t WS_WGU = 26 * MiB;
constexpr size_t WS_WDN = 42 * MiB;
constexpr size_t WS_YMIX = 52 * MiB;
constexpr size_t WS_HB = WS_YMIX;
constexpr size_t WS_PROJ = 116 * MiB;
constexpr size_t WS_MIX = WS_PROJ;
constexpr int MAXROWS = 2 * M + 16 * 256;
constexpr size_t WS_XS = WS_PROJ + 64 * MiB;
constexpr size_t WS_HS = WS_PROJ + 136 * MiB;
constexpr size_t WS_YS = WS_PROJ + 154 * MiB;
constexpr int CW_CNT = 8192;
constexpr int LDS_OFF_TAB = 131072 + 1024;
constexpr size_t WS_SCR = 332 * MiB;
constexpr size_t WS_HG_QG = WS_SCR;
constexpr size_t WS_HG_KDT = WS_SCR + 16 * MiB;
constexpr size_t WS_HG_A = WS_SCR + 32 * MiB;
constexpr size_t WS_HG_GL = WS_SCR + 40 * MiB;
constexpr size_t WS_SSD_C = WS_SCR + 41 * MiB;
constexpr size_t WS_SSD_BT = WS_SCR + 49 * MiB;
constexpr size_t WS_SSD_CB = WS_SCR + 57 * MiB;
constexpr size_t WS_SSD_XT = WS_SCR + 65 * MiB;
constexpr size_t WS_SSD_AC = WS_SCR + 97 * MiB;
constexpr size_t WS_SSD_DT = WS_SCR + 98 * MiB;
constexpr size_t WS_GD_K = WS_SCR + 99 * MiB;
constexpr size_t WS_GD_KT = WS_SCR + 115 * MiB;
constexpr size_t WS_GD_QG = WS_SCR + 131 * MiB;
constexpr size_t WS_GD_VT = WS_SCR + 147 * MiB;
constexpr size_t WS_GD_T = WS_SCR + 163 * MiB;
constexpr size_t WS_GD_QK = WS_SCR + 171 * MiB;
constexpr size_t WS_GD_VEC = WS_SCR + 179 * MiB;
constexpr size_t WS_END = 512 * MiB;
constexpr int CW_BAR = 4096;

constexpr int RING_OFF = 0, RING_BYTES = 131072;
constexpr int LDSCTL_OFF = RING_BYTES, MISC_OFF = LDSCTL_OFF + 320;
constexpr int LDS_BYTES = 147456;

__device__ __forceinline__ float bf2f(unsigned short b) { return __builtin_bit_cast(float, ((unsigned)b) << 16); }
__device__ __forceinline__ float bflo(unsigned w) { return __builtin_bit_cast(float, w << 16); }
__device__ __forceinline__ float bfhi(unsigned w) { return __builtin_bit_cast(float, w & 0xffff0000u); }
__device__ __forceinline__ float siluf(float x) { return x / (1.0f + __expf(-x)); }
__device__ __forceinline__ float sigmoidf_(float x) { return 1.0f / (1.0f + __expf(-x)); }
__device__ __forceinline__ float softplusf_(float x) { return x > 20.f ? x : log1pf(__expf(x)); }
#define DPP_ADD(v, ctrl) ((v) + __builtin_bit_cast(float, __builtin_amdgcn_update_dpp(0, __builtin_bit_cast(int, (v)), (ctrl), 0xf, 0xf, false)))
__device__ __forceinline__ float wave_sum(float v) {
    v = DPP_ADD(v, 0xB1);
    v = DPP_ADD(v, 0x4E);
    v = DPP_ADD(v, 0x141);
    v = DPP_ADD(v, 0x140);
    const int iv = __builtin_bit_cast(int, v);
    return (__builtin_bit_cast(float, __builtin_amdgcn_readlane(iv, 0)) + __builtin_bit_cast(float, __builtin_amdgcn_readlane(iv, 16))) + (__builtin_bit_cast(float, __builtin_amdgcn_readlane(iv, 32)) + __builtin_bit_cast(float, __builtin_amdgcn_readlane(iv, 48)));
}
__device__ __forceinline__ float row16_sum(float v) {
    v = DPP_ADD(v, 0xB1); v = DPP_ADD(v, 0x4E); v = DPP_ADD(v, 0x141); v = DPP_ADD(v, 0x140); return v;
}

struct Args {
    const float* in[25]; float* out; unsigned char* ws; int ph_lo, ph_hi;
};
typedef const __attribute__((address_space(4))) Args* CArgs;
#define ARGS_HERE() ([]() { CArgs p_ = (CArgs)__builtin_amdgcn_kernarg_segment_ptr(); asm volatile("" : "+s"(p_)); return p_; }())
enum { I_X = 0, I_WIN, I_SCW, I_SCB, I_SDTB, I_SALOG, I_SD, I_SNW, I_GCW, I_GDTB, I_GALOG, I_GNW, I_HLB, I_HNW, I_WOUT, I_LN1G, I_LN1B, I_WRG, I_BRG, I_WRE, I_BRE, I_WGU, I_WDN, I_LN2G, I_LN2B };

__device__ __forceinline__ void transpose_item(const float* W, int ldw, int nvalid, int k0, int n0, bf16* WT, size_t ldt, int drow0, int dk0, LAS float* scr, int lane) {
#pragma unroll 8
    for (int i = 0; i < 32; ++i) { const int kk = 2 * i + (lane >> 5), nn = lane & 31, n = n0 + nn; scr[kk * 33 + nn] = (n < nvalid) ? W[(size_t)(k0 + kk) * ldw + n] : 0.f; }
    LDS_WAIT(); asm volatile("" ::: "memory");
    const int c = lane & 7;
#pragma unroll
    for (int j = 0; j < 4; ++j) { const int n = (lane >> 3) + 8 * j; const LAS float* s = scr + (8 * c) * 33 + n;
        v4u o; o.x = pk2(s[0 * 33], s[1 * 33]); o.y = pk2(s[2 * 33], s[3 * 33]); o.z = pk2(s[4 * 33], s[5 * 33]); o.w = pk2(s[6 * 33], s[7 * 33]);
        *(GAS v4u*)(WT + (size_t)(drow0 + n) * ldt + dk0 + k0 + 8 * c) = o; }
    LDS_WAIT(); asm volatile("" ::: "memory");
}
__device__ __forceinline__ void weights_phase(CArgs a, int l, const int which, LAS unsigned char* lds, int wwg, int nwg, int tid) {
    asm volatile("" : "+v"(tid));
    const int lane = tid & 63, wave = tid >> 6, gw = wwg * NWAVES + wave, NGW = nwg * NWAVES;
    LAS float* scr = (LAS float*)(lds + wave * 16384);
    constexpr int I_IN = 16 * (NPROJ / 32), I_OUT = (DMIX / 64) * (D / 32), I_GU = NEXP * 16 * 16, I_DN = NEXP * 4 * 32;
    const int n_in = (which & 1) ? I_IN : 0, n_out = (which & 2) ? I_OUT : 0, n_gu = (which & 4) ? I_GU : 0, n_dn = (which & 8) ? I_DN : 0;
    unsigned char* ws = a->ws;
    for (int it = gw; it < n_in + n_out + n_gu + n_dn; it += NGW) {
        int r = it;
        if (r < n_in) { const int kb = r / (NPROJ / 32), nb = r % (NPROJ / 32);
            transpose_item(a->in[I_WIN] + (size_t)l * D * IN_COLS, IN_COLS, IN_COLS, 64 * kb, 32 * nb, (bf16*)(ws + WS_WIN), D, 32 * nb, 0, scr, lane); continue; }
        r -= n_in;
        if (r < n_out) { const int kb = r / (D / 32), nb = r % (D / 32);
            transpose_item(a->in[I_WOUT] + (size_t)l * DMIX * D, D, D, 64 * kb, 32 * nb, (bf16*)(ws + WS_WOUT), DMIX, 32 * nb, 0, scr, lane); continue; }
        r -= n_out;
        if (r < n_gu) { const int e = r / 256, q = r % 256, kb = q / 16, nb = q % 16, c0 = 32 * nb, bj = c0 / 256, hf = (c0 % 256) / 128, j0 = c0 % 128;
            transpose_item(a->in[I_WGU] + (size_t)(l * NEXP + e) * D * 512, 512, 512, 64 * kb, c0, (bf16*)(ws + WS_WGU), D, e * 512 + hf * 256 + bj * 128 + j0, 0, scr, lane); continue; }
        r -= n_gu;
        { const int e = r / 128, q = r % 128, kb = q / 32, nb = q % 32;
            transpose_item(a->in[I_WDN] + (size_t)(l * NEXP + e) * DEXP * D, D, D, 64 * kb, 32 * nb, (bf16*)(ws + WS_WDN), DEXP, e * D + 32 * nb, 0, scr, lane); }
    }
}
__device__ __forceinline__ void p0_prologue(CArgs a, LAS unsigned char* lds, int wg, int G, int tid) {
    asm volatile("" : "+v"(tid));
    const f32x4* x4 = (const f32x4*)a->in[I_X]; f32x4* h4 = (f32x4*)a->out; unsigned long long* hb8 = (unsigned long long*)(a->ws + WS_HB);
    for (size_t i = (size_t)wg * NTHR + tid; i < (size_t)M * D / 4; i += (size_t)G * NTHR) { const f32x4 v = x4[i]; h4[i] = v;
        hb8[i] = (unsigned long long)pk2(v.x, v.y) | ((unsigned long long)pk2(v.z, v.w) << 32); }
}

#define WG_BAR() do { asm volatile("s_waitcnt lgkmcnt(0)" ::: "memory"); __builtin_amdgcn_s_barrier(); asm volatile("" ::: "memory"); } while (0)
__device__ __forceinline__ f32x4 mfma16(bf16x8 x, bf16x8 y, f32x4 c) { return __builtin_amdgcn_mfma_f32_16x16x32_bf16(x, y, c, 0, 0, 0); }
__device__ __forceinline__ bf16x8 lds_frag(const LAS bf16* base, int row0, int stride, int k0, int lane) { return *(const LAS bf16x8*)(base + (row0 + (lane & 15)) * stride + k0 + 8 * (lane >> 4)); }
__device__ __forceinline__ bf16x8 pack8(const float* v) { v4u w; w.x = pk2(v[0], v[1]); w.y = pk2(v[2], v[3]); w.z = pk2(v[4], v[5]); w.w = pk2(v[6], v[7]); return __builtin_bit_cast(bf16x8, w); }
__device__ __forceinline__ unsigned long long pack4(f32x4 v) { return (unsigned long long)pk2(v[0], v[1]) | ((unsigned long long)pk2(v[2], v[3]) << 32); }

__device__ __forceinline__ void hgrn_prep_phase(CArgs a, int l, LAS unsigned char* lds, int wg, int G, int tid) {
    asm volatile("" : "+v"(tid));
    constexpr int LS = 132;
    LAS float* sQ = (LAS float*)lds; LAS float* sK = sQ + 64 * LS; LAS float* sB = sK + 64 * LS; LAS float* sT = sB + 64 * LS; LAS float* sLb = sT + 512;
    const bf16* PROJ = (const bf16*)(a->ws + WS_PROJ);
    const int lane = tid & 63, w = tid >> 6, r = lane & 15, q4 = lane >> 4;
    for (int unit = wg; unit < 1024; unit += G) {
        const int b = unit >> 8, head = (unit >> 6) & 3, c = unit & 63;
        const size_t row0 = (size_t)b * SEQ + c * 64;
        __syncthreads();
        if (tid < 128) {
            const int ch = head * 128 + tid; float lg[DEPTH], mx = -1e30f;
#pragma unroll
            for (int j = 0; j < DEPTH; ++j) { lg[j] = a->in[I_HLB][j * 512 + ch]; mx = fmaxf(mx, lg[j]); }
            float den = 0.f, num = 0.f;
#pragma unroll
            for (int j = 0; j < DEPTH; ++j) { const float e = __expf(lg[j] - mx); den += e; if (j >= 1 && j <= l) num += e; }
            sLb[tid] = num / den;
        }
        __syncthreads();
        for (int p = tid; p < 1024; p += NTHR) {
            const int t = p >> 4, d8 = (p & 15) * 8;
            const v4u qv = *(const GAS v4u*)(PROJ + (row0 + t) * NPROJ + O_HQ + head * 128 + d8), fv = *(const GAS v4u*)(PROJ + (row0 + t) * NPROJ + O_HF + head * 128 + d8);
#pragma unroll
            for (int i = 0; i < 4; ++i) {
                const int d = d8 + 2 * i; const float lb0 = sLb[d], lb1 = sLb[d + 1];
                sQ[t * LS + d] = siluf(bflo(qv[i])); sQ[t * LS + d + 1] = siluf(bfhi(qv[i]));
                const float f0 = lb0 + (1.f - lb0) * sigmoidf_(bflo(fv[i])), f1 = lb1 + (1.f - lb1) * sigmoidf_(bfhi(fv[i]));
                sK[t * LS + d] = 1.f - f0; sK[t * LS + d + 1] = 1.f - f1; sB[t * LS + d] = __logf(f0); sB[t * LS + d + 1] = __logf(f1);
            }
        }
        __syncthreads();
        {
            const int d = tid & 127, seg = tid >> 7; float run = 0.f, vals[16];
#pragma unroll
            for (int i = 0; i < 16; ++i) { run += sB[(seg * 16 + i) * LS + d]; vals[i] = run; }
            sT[seg * 128 + d] = run;
            __syncthreads();
            float off = 0.f;
#pragma unroll
            for (int s2 = 0; s2 < 3; ++s2) if (s2 < seg) off += sT[s2 * 128 + d];
#pragma unroll
            for (int i = 0; i < 16; ++i) sB[(seg * 16 + i) * LS + d] = vals[i] + off;
        }
        __syncthreads();
        bf16* qg = (bf16*)(a->ws + WS_HG_QG) + (size_t)unit * 64 * 128; bf16* kdt = (bf16*)(a->ws + WS_HG_KDT) + (size_t)unit * 128 * 64;
        bf16* am = (bf16*)(a->ws + WS_HG_A) + (size_t)unit * 64 * 64; float* gl = (float*)(a->ws + WS_HG_GL) + (size_t)unit * 128;
        for (int p = tid; p < 1024; p += NTHR) { const int t = p >> 4, d8 = (p & 15) * 8; float v[8];
#pragma unroll
            for (int jj = 0; jj < 8; ++jj) v[jj] = sQ[t * LS + d8 + jj] * __expf(sB[t * LS + d8 + jj]);
            *(GAS bf16x8*)(qg + t * 128 + d8) = pack8(v); }
        for (int p = tid; p < 1024; p += NTHR) { const int d = p >> 3, s8 = (p & 7) * 8; const float bl = sB[63 * LS + d]; float v[8];
#pragma unroll
            for (int jj = 0; jj < 8; ++jj) v[jj] = sK[(s8 + jj) * LS + d] * __expf(bl - sB[(s8 + jj) * LS + d]);
            *(GAS bf16x8*)(kdt + d * 64 + s8) = pack8(v); }
        if (tid < 128) gl[tid] = __expf(sB[63 * LS + tid]);
        for (int p = w; p < 16; p += NWAVES) {
            const int i = p >> 2, j = p & 3; f32x4 acc = {0.f, 0.f, 0.f, 0.f};
            if (j <= i) {
#pragma unroll
                for (int ks = 0; ks < 4; ++ks) { const int d0 = 32 * ks + 8 * q4, t = 16 * i + r, s_ = 16 * j + r; float qf[8], kf[8];
#pragma unroll
                    for (int jj = 0; jj < 8; ++jj) { const float ref = i ? sB[(16 * i - 1) * LS + d0 + jj] : 0.f;
                        qf[jj] = sQ[t * LS + d0 + jj] * __expf(sB[t * LS + d0 + jj] - ref); kf[jj] = sK[s_ * LS + d0 + jj] * __expf(ref - sB[s_ * LS + d0 + jj]); }
                    acc = mfma16(pack8(kf), pack8(qf), acc); }
                const int t = 16 * i + r;
#pragma unroll
                for (int ii = 0; ii < 4; ++ii) if (16 * j + 4 * q4 + ii > t) acc[ii] = 0.f;
            }
            *(GAS unsigned long long*)(am + (16 * i + r) * 64 + 16 * j + 4 * q4) = pack4(acc);
        }
    }
}
__device__ __forceinline__ void hgrn_scan_phase(CArgs a, int l, LAS unsigned char* lds, const int b, const int head, const int eb, int tid) {
    asm volatile("" : "+v"(tid));
    constexpr int QS = 136, KS = 72;
    constexpr int B_QG = 0, B_KDT = 17408, B_A = B_KDT + 18432, B_VT = B_A + 9216, B_GL = B_VT + 4608, BUF = B_GL + 512;
    LAS unsigned char* sST0 = lds + 2 * BUF;
    const bf16* PROJ = (const bf16*)(a->ws + WS_PROJ); bf16* YMIX = (bf16*)(a->ws + WS_YMIX);
    const int lane = tid & 63, w = tid >> 6, r = lane & 15, q4 = lane >> 4;
    {
        const size_t cu0 = (size_t)(b * 4 + head) * 64;
        const bf16* QG = (const bf16*)(a->ws + WS_HG_QG) + cu0 * 64 * 128; const bf16* KDT = (const bf16*)(a->ws + WS_HG_KDT) + cu0 * 128 * 64;
        const bf16* AM = (const bf16*)(a->ws + WS_HG_A) + cu0 * 64 * 64; const float* GL = (const float*)(a->ws + WS_HG_GL) + cu0 * 128;
        const bf16* VP = PROJ + (size_t)b * SEQ * NPROJ + O_HI + head * 128 + eb * 32;
        v4u rq[2], rk[2], ra, rv; f32x4 rg;
#define HG_LOAD(n) do { _Pragma("unroll") for (int i = 0; i < 2; ++i) { const int p = tid + NTHR * i; rq[i] = *(const GAS v4u*)(QG + (size_t)(n) * 8192 + (p >> 4) * 128 + (p & 15) * 8); \
            rk[i] = *(const GAS v4u*)(KDT + (size_t)(n) * 8192 + (p >> 3) * 64 + (p & 7) * 8); } \
            ra = *(const GAS v4u*)(AM + (size_t)(n) * 4096 + (tid >> 3) * 64 + (tid & 7) * 8); \
            if (tid < 256) rv = *(const GAS v4u*)(VP + (size_t)((n) * 64 + (tid >> 2)) * NPROJ + (tid & 3) * 8); \
            if (tid < 32) rg = *(const GAS f32x4*)(GL + (size_t)(n) * 128 + tid * 4); } while (0)
#define HG_STORE(bufp) do { LAS unsigned char* bp_ = (bufp); _Pragma("unroll") for (int i = 0; i < 2; ++i) { const int p = tid + NTHR * i; \
            *(LAS v4u*)(bp_ + B_QG + ((p >> 4) * QS + (p & 15) * 8) * 2) = rq[i]; *(LAS v4u*)(bp_ + B_KDT + ((p >> 3) * KS + (p & 7) * 8) * 2) = rk[i]; } \
            *(LAS v4u*)(bp_ + B_A + ((tid >> 3) * KS + (tid & 7) * 8) * 2) = ra; \
            if (tid < 256) { LAS bf16* vt = (LAS bf16*)(bp_ + B_VT); const int t_ = tid >> 2, e8 = (tid & 3) * 8; _Pragma("unroll") for (int i = 0; i < 4; ++i) { \
                vt[(e8 + 2 * i) * KS + t_] = (bf16)(rv[i] & 0xffffu); vt[(e8 + 2 * i + 1) * KS + t_] = (bf16)(rv[i] >> 16); } } \
            if (tid < 32) *(LAS f32x4*)(bp_ + B_GL + tid * 16) = rg; } while (0)
        __syncthreads();
        HG_LOAD(0);
        for (int i = tid; i < 8704 / 4; i += NTHR) ((LAS unsigned*)sST0)[i] = 0u;
        HG_STORE(lds);
        f32x4 accS[2] = {{0.f, 0.f, 0.f, 0.f}, {0.f, 0.f, 0.f, 0.f}};
        __syncthreads();
        for (int n = 0; n < 64; ++n) {
            const int cur = n & 1; LAS unsigned char* bp = lds + cur * BUF; LAS bf16* sST = (LAS bf16*)(sST0 + cur * 8704); LAS bf16* sSTn = (LAS bf16*)(sST0 + (cur ^ 1) * 8704);
            if (n + 1 < 64) HG_LOAD(n + 1);
            {
                const int tt = w >> 1, et = w & 1; f32x4 acc = {0.f, 0.f, 0.f, 0.f};
#pragma unroll
                for (int ks = 0; ks < 4; ++ks) acc = mfma16(lds_frag(sST, 16 * et, QS, 32 * ks, lane), lds_frag((LAS bf16*)(bp + B_QG), 16 * tt, QS, 32 * ks, lane), acc);
#pragma unroll
                for (int ks = 0; ks < 2; ++ks) acc = mfma16(lds_frag((LAS bf16*)(bp + B_VT), 16 * et, KS, 32 * ks, lane), lds_frag((LAS bf16*)(bp + B_A), 16 * tt, KS, 32 * ks, lane), acc);
                *(GAS unsigned long long*)(YMIX + ((size_t)b * SEQ + n * 64 + 16 * tt + r) * DMIX + 1536 + head * 128 + eb * 32 + 16 * et + 4 * q4) = pack4(acc);
            }
            {
                const f32x4 glv = *(const LAS f32x4*)(bp + B_GL + (16 * w + 4 * q4) * 4);
#pragma unroll
                for (int et = 0; et < 2; ++et) { accS[et] = accS[et] * glv;
#pragma unroll
                    for (int ks = 0; ks < 2; ++ks) accS[et] = mfma16(lds_frag((LAS bf16*)(bp + B_KDT), 16 * w, KS, 32 * ks, lane), lds_frag((LAS bf16*)(bp + B_VT), 16 * et, KS, 32 * ks, lane), accS[et]);
                    *(LAS unsigned long long*)(sSTn + (16 * et + r) * QS + 16 * w + 4 * q4) = pack4(accS[et]); }
            }
            if (n + 1 < 64) HG_STORE(lds + (cur ^ 1) * BUF);
            WG_BAR();
        }
#undef HG_LOAD
#undef HG_STORE
    }
}

__device__ __forceinline__ void ssd_rec_phase(CArgs a, int l, LAS unsigned char* lds, int wg, int G, int tid) {
    asm volatile("" : "+v"(tid));
    constexpr int TB = 64;
    LAS float* sX = (LAS float*)lds; LAS float* sB = sX + TB * 16; LAS float* sC = sB + TB * 128; LAS float* sDt = sC + TB * 128; LAS float* sDa = sDt + TB; LAS float* sY = sDa + TB;
    const bf16* PROJ = (const bf16*)(a->ws + WS_PROJ); bf16* YMIX = (bf16*)(a->ws + WS_YMIX);
    const float* cw = a->in[I_SCW] + (size_t)l * 4 * 1536; const float* cb = a->in[I_SCB] + (size_t)l * 1536;
    const int p_local = tid >> 5, nq = tid & 31;
    for (int unit = wg; unit < 256; unit += G) {
        const int b = unit >> 6, head = (unit >> 2) & 15, pq = unit & 3, g = head >> 3;
        const float A = -__expf(a->in[I_SALOG][l * 16 + head]), dtb = a->in[I_SDTB][l * 16 + head], Dsk = a->in[I_SD][l * 16 + head];
        float h0 = 0.f, h1 = 0.f, h2 = 0.f, h3 = 0.f;
        for (int t0 = 0; t0 < SEQ; t0 += TB) {
            __syncthreads();
            for (int idx = tid; idx < TB * 272; idx += NTHR) {
                const int tt = idx / 272, ci = idx % 272, t = t0 + tt;
                const int ch = ci < 16 ? head * 64 + pq * 16 + ci : (ci < 144 ? 1024 + g * 128 + (ci - 16) : 1280 + g * 128 + (ci - 144));
                float acc = cb[ch];
#pragma unroll
                for (int k = 0; k < 4; ++k) { const int ts = t - 3 + k; if (ts >= 0) acc += cw[k * 1536 + ch] * bf2f(PROJ[(size_t)(b * SEQ + ts) * NPROJ + O_XBC + ch]); }
                const float v = siluf(acc);
                if (ci < 16) sX[tt * 16 + ci] = v; else if (ci < 144) sB[tt * 128 + ci - 16] = v; else sC[tt * 128 + ci - 144] = v;
            }
            if (tid < TB) { const float raw = bf2f(PROJ[(size_t)(b * SEQ + t0 + tid) * NPROJ + O_DT + head]); const float dt = softplusf_(raw + dtb); sDt[tid] = dt; sDa[tid] = __expf(dt * A); }
            __syncthreads();
#pragma unroll 4
            for (int tt = 0; tt < TB; ++tt) {
                const float xv = sX[tt * 16 + p_local], da = sDa[tt], dx = sDt[tt] * xv;
                const f32x4 Bv = *(const LAS f32x4*)(sB + tt * 128 + nq * 4), Cv = *(const LAS f32x4*)(sC + tt * 128 + nq * 4);
                h0 = da * h0 + dx * Bv.x; h1 = da * h1 + dx * Bv.y; h2 = da * h2 + dx * Bv.z; h3 = da * h3 + dx * Bv.w;
                float part = (Cv.x * h0 + Cv.y * h1) + (Cv.z * h2 + Cv.w * h3);
                part += __shfl_xor(part, 1); part += __shfl_xor(part, 2); part += __shfl_xor(part, 4); part += __shfl_xor(part, 8); part += __shfl_xor(part, 16);
                if (nq == 0) sY[tt * 16 + p_local] = part + Dsk * xv;
            }
            __syncthreads();
            for (int idx = tid; idx < TB * 16; idx += NTHR) { const int tt = idx >> 4, i = idx & 15; YMIX[(size_t)(b * SEQ + t0 + tt) * DMIX + head * 64 + pq * 16 + i] = (bf16)f2bf(sY[idx]); }
        }
    }
}

__device__ __forceinline__ void ssd_prep_phase(CArgs a, int l, LAS unsigned char* lds, int wg, int G, int tid) {
    asm volatile("" : "+v"(tid));
    constexpr int PS = 136;
    LAS bf16* sB = (LAS bf16*)lds; LAS bf16* sC = sB + 128 * PS; LAS bf16* sXT = (LAS bf16*)lds; LAS float* sDt = (LAS float*)(lds + 2 * 128 * PS * 2); LAS bf16* sCB = (LAS bf16*)(lds + 2 * 128 * PS * 2 + 4096);
    const bf16* PROJ = (const bf16*)(a->ws + WS_PROJ);
    const float* cw = a->in[I_SCW] + (size_t)l * 4 * 1536; const float* cb = a->in[I_SCB] + (size_t)l * 1536;
    const int lane = tid & 63, w = tid >> 6, r = lane & 15, q4 = lane >> 4;
    for (int unit = wg; unit < 256; unit += G) {
        const int b = unit >> 6, c = (unit >> 1) & 31, g = unit & 1;
        const size_t row0 = (size_t)b * SEQ + c * 128;
        bf16* Cg = (bf16*)(a->ws + WS_SSD_C) + (size_t)unit * 16384; bf16* BTg = (bf16*)(a->ws + WS_SSD_BT) + (size_t)unit * 16384; bf16* CBg = (bf16*)(a->ws + WS_SSD_CB) + (size_t)unit * 16384;
        __syncthreads();
        {
            const int c16 = tid & 31, l0 = tid >> 5; const int ch = (c16 < 16 ? 1024 + g * 128 + c16 * 8 : 1280 + g * 128 + (c16 - 16) * 8);
            float wk[4][8], bias[8];
#pragma unroll
            for (int jj = 0; jj < 8; ++jj) { bias[jj] = cb[ch + jj];
#pragma unroll
                for (int k = 0; k < 4; ++k) wk[k][jj] = cw[k * 1536 + ch + jj]; }
            LAS bf16* dst = (c16 < 16 ? sB : sC) + (c16 & 15) * 8;
#pragma unroll 2
            for (int i = 0; i < 8; ++i) { const int ll = l0 + 16 * i; float acc[8];
#pragma unroll
                for (int jj = 0; jj < 8; ++jj) acc[jj] = bias[jj];
#pragma unroll
                for (int k = 0; k < 4; ++k) { const int ts = c * 128 + ll - 3 + k;
                    if (ts >= 0) { const v4u xv = *(const GAS v4u*)(PROJ + ((size_t)b * SEQ + ts) * NPROJ + O_XBC + ch);
#pragma unroll
                        for (int j = 0; j < 4; ++j) { acc[2 * j] += wk[k][2 * j] * bflo(xv[j]); acc[2 * j + 1] += wk[k][2 * j + 1] * bfhi(xv[j]); } } }
#pragma unroll
                for (int jj = 0; jj < 8; ++jj) acc[jj] = siluf(acc[jj]);
                *(LAS bf16x8*)(dst + ll * PS) = pack8(acc); }
        }
        {
            const int head = g * 8 + w; const float A = -__expf(a->in[I_SALOG][l * 16 + head]), dtb = a->in[I_SDTB][l * 16 + head];
            const int l2 = 2 * lane;
            const float dt0 = softplusf_(bf2f(PROJ[(row0 + l2) * NPROJ + O_DT + head]) + dtb), dt1 = softplusf_(bf2f(PROJ[(row0 + l2 + 1) * NPROJ + O_DT + head]) + dtb);
            const float da1 = dt1 * A; float sc = dt0 * A + da1;
#pragma unroll
            for (int o = 1; o < 64; o <<= 1) { const float t_ = __shfl_up(sc, o); if (lane >= o) sc += t_; }
            sDt[w * 128 + l2] = dt0; sDt[w * 128 + l2 + 1] = dt1;
            const size_t uh = (size_t)((b * 16 + head) * 32 + c) * 128;
            float* AC = (float*)(a->ws + WS_SSD_AC) + uh; float* DT = (float*)(a->ws + WS_SSD_DT) + uh;
            AC[l2] = sc - da1; AC[l2 + 1] = sc; DT[l2] = dt0; DT[l2 + 1] = dt1;
        }
        __syncthreads();
#pragma unroll
        for (int st = 0; st < 8; ++st) {
            f32x4 acc = {0.f, 0.f, 0.f, 0.f};
            if (st <= w) {
#pragma unroll
                for (int ks = 0; ks < 4; ++ks) acc = mfma16(lds_frag(sB, 16 * st, PS, 32 * ks, lane), lds_frag(sC, 16 * w, PS, 32 * ks, lane), acc); }
            *(LAS unsigned long long*)(sCB + (16 * w + r) * PS + 16 * st + 4 * q4) = pack4(acc);
        }
        __syncthreads();
        for (int f = w; f < 32; f += NWAVES) { const int tile = f >> 2, ks = f & 3;
            *(GAS v4u*)(Cg + f * 512 + lane * 8) = *(const LAS v4u*)(sC + (16 * tile + r) * PS + 32 * ks + 8 * q4);
            *(GAS v4u*)(CBg + f * 512 + lane * 8) = *(const LAS v4u*)(sCB + (16 * tile + r) * PS + 32 * ks + 8 * q4);
            const int n = 16 * tile + r, l0 = 32 * ks + 8 * q4; v4u o;
#pragma unroll
            for (int j = 0; j < 4; ++j) o[j] = (unsigned)sB[(l0 + 2 * j) * PS + n] | ((unsigned)sB[(l0 + 2 * j + 1) * PS + n] << 16);
            *(GAS v4u*)(BTg + f * 512 + lane * 8) = o; }
#pragma unroll 1
        for (int hf = 0; hf < 2; ++hf) {
            __syncthreads();
            {   const int cg = tid & 31, l0 = tid >> 5, chl = cg * 8, ch = g * 512 + hf * 256 + chl, hh = hf * 4 + (cg >> 3);
                float wk[4][8], bias[8];
#pragma unroll
                for (int jj = 0; jj < 8; ++jj) { bias[jj] = cb[ch + jj];
#pragma unroll
                    for (int k = 0; k < 4; ++k) wk[k][jj] = cw[k * 1536 + ch + jj]; }
#pragma unroll 2
                for (int i = 0; i < 8; ++i) { const int ll = l0 + 16 * i; float acc[8];
#pragma unroll
                    for (int jj = 0; jj < 8; ++jj) acc[jj] = bias[jj];
#pragma unroll
                    for (int k = 0; k < 4; ++k) { const int ts = c * 128 + ll - 3 + k;
                        if (ts >= 0) { const v4u xv = *(const GAS v4u*)(PROJ + ((size_t)b * SEQ + ts) * NPROJ + O_XBC + ch);
#pragma unroll
                            for (int j = 0; j < 4; ++j) { acc[2 * j] += wk[k][2 * j] * bflo(xv[j]); acc[2 * j + 1] += wk[k][2 * j + 1] * bfhi(xv[j]); } } }
                    const float dtv = sDt[hh * 128 + ll];
#pragma unroll
                    for (int jj = 0; jj < 8; ++jj) sXT[(chl + jj) * PS + ll] = (bf16)f2bf(siluf(acc[jj]) * dtv); }
            }
            __syncthreads();
            for (int p = tid; p < 4096; p += NTHR) { const int chl = p >> 4, l8 = (p & 15) * 8, hh = hf * 4 + (chl >> 6), pp = chl & 63;
                const size_t uh = (size_t)((b * 16 + g * 8 + hh) * 32 + c);
                *(GAS v4u*)((bf16*)(a->ws + WS_SSD_XT) + (uh * 64 + pp) * 128 + l8) = *(const LAS v4u*)(sXT + chl * PS + l8); }
        }
    }
}
__device__ __forceinline__ void ssd_scan_phase(CArgs a, int l, LAS unsigned char* lds, const int b, const int head, int tid) {
    asm volatile("" : "+v"(tid));
    constexpr int PS = 136, O_S = 0, O_X = 34816, O_AC = 69632, O_TE = 70656, O_DT = 71680;
    bf16* YMIX = (bf16*)(a->ws + WS_YMIX);
    const int lane = tid & 63, w = tid >> 6, r = lane & 15, q4 = lane >> 4;
    {
        const int g = head >> 3;
        const float Dsk = a->in[I_SD][l * 16 + head];
        const bf16* Cg = (const bf16*)(a->ws + WS_SSD_C) + (size_t)((b * 32) * 2 + g) * 16384 + (w * 4) * 512 + lane * 8;
        const bf16* CBg = (const bf16*)(a->ws + WS_SSD_CB) + (size_t)((b * 32) * 2 + g) * 16384 + (w * 4) * 512 + lane * 8;
        const bf16* BTg = (const bf16*)(a->ws + WS_SSD_BT) + (size_t)((b * 32) * 2 + g) * 16384 + (w * 4) * 512 + lane * 8;
        const size_t uh0 = (size_t)(b * 16 + head) * 32;
        const bf16* XTg = (const bf16*)(a->ws + WS_SSD_XT) + uh0 * 8192; const float* ACg = (const float*)(a->ws + WS_SSD_AC) + uh0 * 128; const float* DTg = (const float*)(a->ws + WS_SSD_DT) + uh0 * 128;
        v4u fC[4], fCB[4], fBT[4], rx[2]; float rac = 0.f, racl = 0.f, rdt = 0.f;
#define SSD_LDF(cc, dst, src) do { _Pragma("unroll") for (int ks = 0; ks < 4; ++ks) dst[ks] = *(const GAS v4u*)(src + (size_t)(cc) * 32768 + 512 * ks); } while (0)
#define SSD_LOADX(cc) do { _Pragma("unroll") for (int i = 0; i < 2; ++i) { const int p = tid + NTHR * i; rx[i] = *(const GAS v4u*)(XTg + (size_t)(cc) * 8192 + (p >> 4) * 128 + (p & 15) * 8); } \
            if (tid < 128) { rac = ACg[(cc) * 128 + tid]; racl = ACg[(cc) * 128 + 127]; rdt = DTg[(cc) * 128 + tid]; } } while (0)
#define SSD_STORE(bi) do { _Pragma("unroll") for (int i = 0; i < 2; ++i) { const int p = tid + NTHR * i; *(LAS v4u*)(lds + O_X + (bi) * 17408 + ((p >> 4) * PS + (p & 15) * 8) * 2) = rx[i]; } \
            if (tid < 128) { ((LAS float*)(lds + O_AC))[(bi) * 128 + tid] = rac; ((LAS float*)(lds + O_TE))[(bi) * 128 + tid] = __expf(racl - rac); ((LAS float*)(lds + O_DT))[(bi) * 128 + tid] = rdt; } } while (0)
        __syncthreads();
        SSD_LDF(0, fC, Cg); SSD_LDF(0, fCB, CBg); SSD_LDF(0, fBT, BTg); SSD_LOADX(0);
        for (int i = tid; i < 17408 / 4; i += NTHR) ((LAS unsigned*)(lds + O_S))[i] = 0u;
        SSD_STORE(0);
        f32x4 accS[4];
#pragma unroll
        for (int pt = 0; pt < 4; ++pt) accS[pt] = (f32x4){0.f, 0.f, 0.f, 0.f};
        __syncthreads();
        for (int c = 0; c < 32; ++c) {
            const int cur = c & 1;
            const LAS bf16* sS = (const LAS bf16*)(lds + O_S + cur * 17408); LAS bf16* sSn = (LAS bf16*)(lds + O_S + (cur ^ 1) * 17408); const LAS bf16* sXT = (const LAS bf16*)(lds + O_X + cur * 17408);
            const LAS float* sAc = (const LAS float*)(lds + O_AC) + cur * 128; const LAS float* sTe = (const LAS float*)(lds + O_TE) + cur * 128; const LAS float* sDt = (const LAS float*)(lds + O_DT) + cur * 128;
            const int cn = c + 1 < 32 ? c + 1 : c;
            SSD_LOADX(cn);
            const int lrow = 16 * w + r; const float ac_l = sAc[lrow];
            f32x4 accO[4], accD[4];
#pragma unroll
            for (int pt = 0; pt < 4; ++pt) { accO[pt] = (f32x4){0.f, 0.f, 0.f, 0.f}; accD[pt] = (f32x4){0.f, 0.f, 0.f, 0.f}; }
#pragma unroll
            for (int ks = 0; ks < 4; ++ks) { const bf16x8 yf = __builtin_bit_cast(bf16x8, fC[ks]);
#pragma unroll
                for (int pt = 0; pt < 4; ++pt) accO[pt] = mfma16(lds_frag(sS, 16 * pt, PS, 32 * ks, lane), yf, accO[pt]); }
            SSD_LDF(cn, fC, Cg);
#pragma unroll
            for (int ks = 0; ks < 4; ++ks) if (32 * ks <= 16 * w + 15) {
                float v[8]; const f32x4 a0 = *(const LAS f32x4*)(sAc + 32 * ks + 8 * q4), a1 = *(const LAS f32x4*)(sAc + 32 * ks + 8 * q4 + 4);
#pragma unroll
                for (int j = 0; j < 4; ++j) { const int s0 = 32 * ks + 8 * q4 + 2 * j; const float as0 = (2 * j < 4) ? a0[(2 * j) & 3] : a1[(2 * j) & 3], as1 = (2 * j + 1 < 4) ? a0[(2 * j + 1) & 3] : a1[(2 * j + 1) & 3];
                    v[2 * j] = (s0 <= lrow) ? bflo(fCB[ks][j]) * __expf(ac_l - as0) : 0.f; v[2 * j + 1] = (s0 + 1 <= lrow) ? bfhi(fCB[ks][j]) * __expf(ac_l - as1) : 0.f; }
                const bf16x8 yf = pack8(v);
#pragma unroll
                for (int pt = 0; pt < 4; ++pt) accD[pt] = mfma16(lds_frag(sXT, 16 * pt, PS, 32 * ks, lane), yf, accD[pt]); }
            SSD_LDF(cn, fCB, CBg);
            {   const float ea = __expf(ac_l), rdtl = Dsk / sDt[lrow];
#pragma unroll
                for (int pt = 0; pt < 4; ++pt) { f32x4 y = accO[pt] * ea + accD[pt];
#pragma unroll
                    for (int ii = 0; ii < 4; ++ii) y[ii] += rdtl * bf2f(sXT[(16 * pt + 4 * q4 + ii) * PS + lrow]);
                    *(GAS unsigned long long*)(YMIX + ((size_t)b * SEQ + c * 128 + lrow) * DMIX + head * 64 + 16 * pt + 4 * q4) = pack4(y); } }
            {   const float cd = __expf(sAc[127]);
#pragma unroll
                for (int pt = 0; pt < 4; ++pt) accS[pt] = accS[pt] * cd;
#pragma unroll
                for (int ks = 0; ks < 4; ++ks) { float v[8]; const f32x4 t0 = *(const LAS f32x4*)(sTe + 32 * ks + 8 * q4), t1 = *(const LAS f32x4*)(sTe + 32 * ks + 8 * q4 + 4);
#pragma unroll
                    for (int j = 0; j < 4; ++j) { const float ts0 = (2 * j < 4) ? t0[(2 * j) & 3] : t1[(2 * j) & 3], ts1 = (2 * j + 1 < 4) ? t0[(2 * j + 1) & 3] : t1[(2 * j + 1) & 3];
                        v[2 * j] = bflo(fBT[ks][j]) * ts0; v[2 * j + 1] = bfhi(fBT[ks][j]) * ts1; }
                    const bf16x8 xf = pack8(v);
#pragma unroll
                    for (int pt = 0; pt < 4; ++pt) accS[pt] = mfma16(xf, lds_frag(sXT, 16 * pt, PS, 32 * ks, lane), accS[pt]); }
#pragma unroll
                for (int pt = 0; pt < 4; ++pt) *(LAS unsigned long long*)(sSn + (16 * pt + r) * PS + 16 * w + 4 * q4) = pack4(accS[pt]);
            }
            SSD_LDF(cn, fBT, BTg);
            if (c + 1 < 32) SSD_STORE(cur ^ 1);
            WG_BAR();
        }
#undef SSD_LDF
#undef SSD_LOADX
#undef SSD_STORE
    }
}

__device__ __forceinline__ void gdn_prep_phase(CArgs a, int l, LAS unsigned char* lds, int wg, int G, int tid) {
    asm volatile("" : "+v"(tid));
    constexpr int PS = 136, TS = 72, MS = 68, TT = 65;
    LAS bf16* sKb = (LAS bf16*)lds; LAS bf16* sQb = sKb + 64 * PS; LAS bf16* sQG = sQb + 64 * PS; LAS bf16* sVT = sQG + 64 * PS;
    LAS float* sM = (LAS float*)(lds + 3 * 17408 + 18432); LAS float* sT = sM + 64 * MS; LAS float* sVec = sT + 64 * TT; LAS bf16* sQK = (LAS bf16*)(sVec + 256);
    const bf16* PROJ = (const bf16*)(a->ws + WS_PROJ);
    const float* cw = a->in[I_GCW] + (size_t)l * 4 * 1536;
    const int lane = tid & 63, w = tid >> 6, r = lane & 15, q4 = lane >> 4;
    for (int unit = wg; unit < 1024; unit += G) {
        const int b = unit >> 8, head = (unit >> 6) & 3, n = unit & 63;
        const size_t row0 = (size_t)b * SEQ + n * 64;
#define GW ((bf16*)(a->ws + WS_GD_K) + (size_t)unit * 8192)
#define GKT ((bf16*)(a->ws + WS_GD_KT) + (size_t)unit * 8192)
#define GQG ((bf16*)(a->ws + WS_GD_QG) + (size_t)unit * 8192)
#define GUT ((bf16*)(a->ws + WS_GD_VT) + (size_t)unit * 8192)
#define GT ((bf16*)(a->ws + WS_GD_T) + (size_t)unit * 4096)
#define GQK ((bf16*)(a->ws + WS_GD_QK) + (size_t)unit * 4096)
#define GVEC ((float*)(a->ws + WS_GD_VEC) + (size_t)unit * 256)
        __syncthreads();
        for (int i = tid; i < 64 * MS; i += NTHR) sM[i] = 0.f;
        if (w == 0) {
            const float nA = -__expf(a->in[I_GALOG][l * 4 + head]), dtb = a->in[I_GDTB][l * 4 + head];
            const size_t ro = (row0 + lane) * NPROJ;
            const float be = sigmoidf_(bf2f(PROJ[ro + O_GB + head])); float gsum = nA * softplusf_(bf2f(PROJ[ro + O_GA + head]) + dtb);
#pragma unroll
            for (int o = 1; o < 64; o <<= 1) { const float t_ = __shfl_up(gsum, o); if (lane >= o) gsum += t_; }
            const float glast = __shfl(gsum, 63), eg = __expf(gsum), cc = __expf(glast - gsum);
            sVec[lane] = gsum; sVec[64 + lane] = be; sVec[128 + lane] = eg;
            GVEC[lane] = be; GVEC[64 + lane] = eg; GVEC[128 + lane] = cc; GVEC[192 + lane] = __expf(glast);
        }
        __syncthreads();
        {
            float wq[4][2], wk_[4][2], wv[4][2];
#pragma unroll
            for (int k = 0; k < 4; ++k)
#pragma unroll
                for (int j = 0; j < 2; ++j) { wq[k][j] = cw[k * 1536 + head * 128 + 2 * lane + j]; wk_[k][j] = cw[k * 1536 + 512 + head * 128 + 2 * lane + j]; wv[k][j] = cw[k * 1536 + 1024 + head * 128 + 2 * lane + j]; }
#pragma unroll 4
            for (int i = 0; i < 8; ++i) { const int t = w + 8 * i; float q0 = 0.f, q1 = 0.f, k0 = 0.f, k1 = 0.f, v0 = 0.f, v1 = 0.f;
#pragma unroll
                for (int k = 0; k < 4; ++k) { const int ts = n * 64 + t - 3 + k;
                    if (ts >= 0) { const bf16* pr = PROJ + ((size_t)b * SEQ + ts) * NPROJ + O_QKV + head * 128 + 2 * lane;
                        const unsigned xq = *(const GAS unsigned*)pr, xk = *(const GAS unsigned*)(pr + 512), xv = *(const GAS unsigned*)(pr + 1024);
                        q0 += wq[k][0] * bflo(xq); q1 += wq[k][1] * bfhi(xq); k0 += wk_[k][0] * bflo(xk); k1 += wk_[k][1] * bfhi(xk); v0 += wv[k][0] * bflo(xv); v1 += wv[k][1] * bfhi(xv); } }
                q0 = siluf(q0); q1 = siluf(q1); k0 = siluf(k0); k1 = siluf(k1); v0 = siluf(v0); v1 = siluf(v1);
                const float sq = rsqrtf(wave_sum(q0 * q0 + q1 * q1) + 1e-6f) * 0.08838834764831845f, sk = rsqrtf(wave_sum(k0 * k0 + k1 * k1) + 1e-6f), eg = sVec[128 + t];
                *(LAS unsigned*)(sKb + t * PS + 2 * lane) = pk2(k0 * sk, k1 * sk); *(LAS unsigned*)(sQb + t * PS + 2 * lane) = pk2(q0 * sq, q1 * sq);
                *(LAS unsigned*)(sQG + t * PS + 2 * lane) = pk2(q0 * sq * eg, q1 * sq * eg);
                sVT[(2 * lane) * TS + t] = (bf16)f2bf(v0); sVT[(2 * lane + 1) * TS + t] = (bf16)f2bf(v1); }
        }
        __syncthreads();
        for (int p = w; p < 26; p += NWAVES) {
            int it, jt; bool isq;
            if (p < 10) { isq = false; it = p < 1 ? 0 : (p < 3 ? 1 : (p < 6 ? 2 : 3)); jt = p - (it * (it + 1)) / 2; } else { isq = true; it = (p - 10) >> 2; jt = (p - 10) & 3; }
            f32x4 acc = {0.f, 0.f, 0.f, 0.f};
            if (jt <= it) {
#pragma unroll
                for (int ks = 0; ks < 4; ++ks) acc = mfma16(lds_frag(sKb, 16 * jt, PS, 32 * ks, lane), lds_frag(isq ? sQb : sKb, 16 * it, PS, 32 * ks, lane), acc);
                const int i = 16 * it + r; const float gi = sVec[i], bi = sVec[64 + i];
#pragma unroll
                for (int ii = 0; ii < 4; ++ii) { const int j = 16 * jt + 4 * q4 + ii; const float dec = __expf(gi - sVec[j]);
                    acc[ii] = isq ? (j <= i ? acc[ii] * dec : 0.f) : (j < i ? acc[ii] * dec * bi : 0.f); }
            }
            if (isq) *(LAS unsigned long long*)(sQK + (16 * it + r) * TS + 16 * jt + 4 * q4) = pack4(acc);
            else *(LAS f32x4*)(sM + (16 * it + r) * MS + 16 * jt + 4 * q4) = acc;
        }
        __syncthreads();
        if (w == 0) {
            int zo = 0; asm volatile("" : "+v"(zo)); const LAS float* sMv = sM + zo;
            float U[64];
#pragma unroll
            for (int i = 0; i < 64; ++i) {
                f32x4 mr[16]; float a0 = -sMv[i * MS + lane], a1 = 0.f, a2 = 0.f, a3 = 0.f;
#pragma unroll
                for (int j4 = 0; j4 < (i + 3) / 4; ++j4) mr[j4] = *(const LAS f32x4*)(sMv + i * MS + 4 * j4);
                __builtin_amdgcn_sched_barrier(0);
#pragma unroll
                for (int j4 = 0; j4 < (i + 3) / 4; ++j4) { const f32x4 m = mr[j4];
                    if (4 * j4 + 0 < i) a0 -= m[0] * U[4 * j4 + 0]; if (4 * j4 + 1 < i) a1 -= m[1] * U[4 * j4 + 1]; if (4 * j4 + 2 < i) a2 -= m[2] * U[4 * j4 + 2]; if (4 * j4 + 3 < i) a3 -= m[3] * U[4 * j4 + 3]; }
                U[i] = (a0 + a1) + (a2 + a3); sT[i * TT + lane] = U[i]; }
        } else {
            for (int f = w - 1; f < 16; f += NWAVES - 1) { const int tile = f >> 2, ks = f & 3;
                *(GAS v4u*)(GQG + f * 512 + lane * 8) = *(const LAS v4u*)(sQG + (16 * tile + r) * PS + 32 * ks + 8 * q4); }
            for (int f = w - 1; f < 8; f += NWAVES - 1) { const int tile = f >> 1, ks = f & 1;
                *(GAS v4u*)(GQK + f * 512 + lane * 8) = *(const LAS v4u*)(sQK + (16 * tile + r) * TS + 32 * ks + 8 * q4); }
            for (int f = w - 1; f < 16; f += NWAVES - 1) { const int dt = f >> 1, ks = f & 1, d = 16 * dt + r, s0 = 32 * ks + 8 * q4; v4u o;
#pragma unroll
                for (int j = 0; j < 4; ++j) o[j] = (unsigned)sKb[(s0 + 2 * j) * PS + d] | ((unsigned)sKb[(s0 + 2 * j + 1) * PS + d] << 16);
                *(GAS v4u*)(GKT + f * 512 + lane * 8) = o; }
        }
        __syncthreads();
        {
            LAS bf16* sTb = (LAS bf16*)sM; LAS bf16* sKgT = sQb;
            { const int t = tid >> 3, s8 = (tid & 7) * 8; float v[8];
#pragma unroll
                for (int jj = 0; jj < 8; ++jj) v[jj] = sT[t * TT + s8 + jj] + ((s8 + jj == t) ? 1.f : 0.f);
                *(LAS bf16x8*)(sTb + t * TS + s8) = pack8(v); }
            for (int p = tid; p < 1024; p += NTHR) { const int d = p >> 3, s8 = (p & 7) * 8; float v[8], u8[8]; const v4u vv = *(const LAS v4u*)(sVT + d * TS + s8);
#pragma unroll
                for (int jj = 0; jj < 8; ++jj) { const float be = sVec[64 + s8 + jj]; v[jj] = bf2f(sKb[(s8 + jj) * PS + d]) * be * sVec[128 + s8 + jj]; u8[jj] = ((jj & 1) ? bfhi(vv[jj >> 1]) : bflo(vv[jj >> 1])) * be; }
                *(LAS bf16x8*)(sKgT + d * TS + s8) = pack8(v); *(LAS bf16x8*)(sVT + d * TS + s8) = pack8(u8); }
        }
        __syncthreads();
        {
            const LAS bf16* sTb = (const LAS bf16*)sM; const LAS bf16* sKgT = sQb; LAS bf16* sW = (LAS bf16*)((LAS unsigned char*)sM + 9216);
            const int st_ = w >> 1;
            const bf16x8 t0 = lds_frag(sTb, 16 * st_, TS, 0, lane), t1 = lds_frag(sTb, 16 * st_, TS, 32, lane);
#pragma unroll
            for (int c4_ = 0; c4_ < 4; ++c4_) { const int ct = (w & 1) * 4 + c4_;
                f32x4 aw = {0.f, 0.f, 0.f, 0.f}, au = {0.f, 0.f, 0.f, 0.f};
                aw = mfma16(lds_frag(sKgT, 16 * ct, TS, 0, lane), t0, aw); aw = mfma16(lds_frag(sKgT, 16 * ct, TS, 32, lane), t1, aw);
                au = mfma16(t0, lds_frag(sVT, 16 * ct, TS, 0, lane), au); au = mfma16(t1, lds_frag(sVT, 16 * ct, TS, 32, lane), au);
                *(LAS unsigned long long*)(sW + (16 * st_ + r) * PS + 16 * ct + 4 * q4) = pack4(aw);
                *(GAS unsigned long long*)(GUT + (ct * 4 + st_) * 256 + lane * 4) = pack4(au); }
        }
        __syncthreads();
        { const LAS bf16* sW = (const LAS bf16*)((LAS unsigned char*)sM + 9216);
            for (int f = w; f < 16; f += NWAVES) { const int tile = f >> 2, ks = f & 3;
                *(GAS v4u*)(GW + f * 512 + lane * 8) = *(const LAS v4u*)(sW + (16 * tile + r) * PS + 32 * ks + 8 * q4); } }
    }
#undef GW
#undef GKT
#undef GQG
#undef GUT
#undef GT
#undef GQK
#undef GVEC
}
__device__ __forceinline__ void gdn_scan_phase(CArgs a, int l, LAS unsigned char* lds, const int b, const int head, const int eb, int tid) {
    asm volatile("" : "+v"(tid));
    constexpr int PS = 136, TS = 72, O_ST = 0, O_RT = 34816, O_VN = O_RT + 9216, O_VC = O_VN + 9216;
    bf16* YMIX = (bf16*)(a->ws + WS_YMIX);
    const int lane = tid & 63, w = tid >> 6, r = lane & 15, q4 = lane >> 4, st = w >> 1, eh = w & 1;
    LAS bf16* sRT = (LAS bf16*)(lds + O_RT); LAS bf16* sVN = (LAS bf16*)(lds + O_VN); LAS bf16* sVC = (LAS bf16*)(lds + O_VC);
    {
        const size_t u0 = (size_t)(b * 4 + head) * 64;
        const bf16* pW = (const bf16*)(a->ws + WS_GD_K) + u0 * 8192 + (st * 4) * 512 + lane * 8; const bf16* pQG = (const bf16*)(a->ws + WS_GD_QG) + u0 * 8192 + (st * 4) * 512 + lane * 8;
        const bf16* pQK = (const bf16*)(a->ws + WS_GD_QK) + u0 * 4096 + (st * 2) * 512 + lane * 8;
        const bf16* pKT = (const bf16*)(a->ws + WS_GD_KT) + u0 * 8192 + (w * 2) * 512 + lane * 8;
        const bf16* pUT = (const bf16*)(a->ws + WS_GD_VT) + u0 * 8192 + (size_t)(((eb * 4 + 2 * eh) * 4 + st) * 256) + lane * 4;
        const float* pVec = (const float*)(a->ws + WS_GD_VEC) + u0 * 256 + 16 * st + 4 * q4;
        v4u xW[4], yQG[4], yQK[2], xKT[2], nQG[4], nQK[2]; unsigned long long uT[2]; f32x4 c4; float gl;
#define GD_LD_A(nn) do { _Pragma("unroll") for (int ks = 0; ks < 4; ++ks) xW[ks] = *(const GAS v4u*)(pW + (size_t)(nn) * 8192 + 512 * ks); \
            _Pragma("unroll") for (int j = 0; j < 2; ++j) uT[j] = *(const GAS unsigned long long*)(pUT + (size_t)(nn) * 8192 + j * 1024); \
            c4 = *(const GAS f32x4*)(pVec + (size_t)(nn) * 256 + 128); } while (0)
#define GD_LD_C(nn, QG_, QK_) do { _Pragma("unroll") for (int ks = 0; ks < 4; ++ks) QG_[ks] = *(const GAS v4u*)(pQG + (size_t)(nn) * 8192 + 512 * ks); \
            _Pragma("unroll") for (int ks = 0; ks < 2; ++ks) QK_[ks] = *(const GAS v4u*)(pQK + (size_t)(nn) * 4096 + 512 * ks); } while (0)
#define GD_LD_D(nn) do { _Pragma("unroll") for (int ks = 0; ks < 2; ++ks) xKT[ks] = *(const GAS v4u*)(pKT + (size_t)(nn) * 8192 + 512 * ks); gl = pVec[(size_t)(nn) * 256 + 192 - (16 * st + 4 * q4)]; } while (0)
        __syncthreads();
        GD_LD_A(0); GD_LD_C(0, yQG, yQK); GD_LD_D(0);
        for (int i = tid; i < 17408 / 4; i += NTHR) ((LAS unsigned*)(lds + O_ST))[i] = 0u;
        f32x4 accS[4];
#pragma unroll
        for (int et = 0; et < 4; ++et) accS[et] = (f32x4){0.f, 0.f, 0.f, 0.f};
        __syncthreads();
        for (int n = 0; n < 64; ++n) {
            const int cur = n & 1; const LAS bf16* sST = (const LAS bf16*)(lds + O_ST + cur * 17408); LAS bf16* sSTn = (LAS bf16*)(lds + O_ST + (cur ^ 1) * 17408);
            const int nn = n + 1 < 64 ? n + 1 : n;
            {
                bf16x8 fs[2][4];
#pragma unroll
                for (int j = 0; j < 2; ++j)
#pragma unroll
                    for (int ks = 0; ks < 4; ++ks) fs[j][ks] = lds_frag(sST, 16 * (2 * eh + j), PS, 32 * ks, lane);
                __builtin_amdgcn_sched_barrier(0);
#pragma unroll
                for (int j = 0; j < 2; ++j) { const int e0 = 16 * (2 * eh + j); f32x4 acc = {0.f, 0.f, 0.f, 0.f};
#pragma unroll
                    for (int ks = 0; ks < 4; ++ks) acc = mfma16(__builtin_bit_cast(bf16x8, xW[ks]), fs[j][ks], acc);
                    const unsigned ulo = (unsigned)uT[j], uhi = (unsigned)(uT[j] >> 32); f32x4 vn;
                    vn[0] = bflo(ulo) - acc[0]; vn[1] = bfhi(ulo) - acc[1]; vn[2] = bflo(uhi) - acc[2]; vn[3] = bfhi(uhi) - acc[3];
                    *(LAS unsigned long long*)(sVN + (e0 + r) * TS + 16 * st + 4 * q4) = pack4(vn); *(LAS unsigned long long*)(sVC + (e0 + r) * TS + 16 * st + 4 * q4) = pack4(vn * c4); }
            }
            GD_LD_A(nn); GD_LD_C(nn, nQG, nQK);
            WG_BAR();
            {
                bf16x8 fv[4][2];
#pragma unroll
                for (int et = 0; et < 4; ++et)
#pragma unroll
                    for (int ks = 0; ks < 2; ++ks) fv[et][ks] = lds_frag(sVC, 16 * et, TS, 32 * ks, lane);
                __builtin_amdgcn_sched_barrier(0);
#pragma unroll
                for (int et = 0; et < 4; ++et) { accS[et] = accS[et] * gl;
#pragma unroll
                    for (int ks = 0; ks < 2; ++ks) accS[et] = mfma16(__builtin_bit_cast(bf16x8, xKT[ks]), fv[et][ks], accS[et]);
                    *(LAS unsigned long long*)(sSTn + (16 * et + r) * PS + 16 * w + 4 * q4) = pack4(accS[et]); }
            }
            GD_LD_D(nn);
            {
                bf16x8 fs[2][4], fn[2][2];
#pragma unroll
                for (int j = 0; j < 2; ++j) {
#pragma unroll
                    for (int ks = 0; ks < 4; ++ks) fs[j][ks] = lds_frag(sST, 16 * (2 * eh + j), PS, 32 * ks, lane);
#pragma unroll
                    for (int ks = 0; ks < 2; ++ks) fn[j][ks] = lds_frag(sVN, 16 * (2 * eh + j), TS, 32 * ks, lane); }
                __builtin_amdgcn_sched_barrier(0);
#pragma unroll
                for (int j = 0; j < 2; ++j) { const int e0 = 16 * (2 * eh + j); f32x4 acc = {0.f, 0.f, 0.f, 0.f};
#pragma unroll
                    for (int ks = 0; ks < 4; ++ks) acc = mfma16(fs[j][ks], __builtin_bit_cast(bf16x8, yQG[ks]), acc);
#pragma unroll
                    for (int ks = 0; ks < 2; ++ks) acc = mfma16(fn[j][ks], __builtin_bit_cast(bf16x8, yQK[ks]), acc);
                    *(GAS unsigned long long*)(YMIX + ((size_t)b * SEQ + n * 64 + 16 * st + r) * DMIX + 1024 + head * 128 + eb * 64 + e0 + 4 * q4) = pack4(acc); }
            }
#pragma unroll
            for (int ks = 0; ks < 4; ++ks) yQG[ks] = nQG[ks];
#pragma unroll
            for (int ks = 0; ks < 2; ++ks) yQK[ks] = nQK[ks];
            WG_BAR();
        }
#undef GD_LD_A
#undef GD_LD_C
#undef GD_LD_D
    }
}

__device__ __forceinline__ void gdn_rec_phase(CArgs a, int l, LAS unsigned char* lds, int wg, int G, int tid) {
    asm volatile("" : "+v"(tid));
    constexpr int TB = 32;
    LAS float* sQ = (LAS float*)lds; LAS float* sK = sQ + TB * 128; LAS float* sV = sK + TB * 128; LAS float* sBe = sV + TB * 8; LAS float* sAl = sBe + TB; LAS float* sO = sAl + TB;
    const bf16* PROJ = (const bf16*)(a->ws + WS_PROJ); bf16* YMIX = (bf16*)(a->ws + WS_YMIX);
    const float* cw = a->in[I_GCW] + (size_t)l * 4 * 1536;
    const int lane = tid & 63, w = tid >> 6;
    for (int unit = wg; unit < 256; unit += G) {
        const int b = unit >> 6, head = (unit >> 4) & 3, eb = unit & 15;
        const float nA = -__expf(a->in[I_GALOG][l * 4 + head]), dtb = a->in[I_GDTB][l * 4 + head];
        float S0 = 0.f, S1 = 0.f;
        for (int t0 = 0; t0 < SEQ; t0 += TB) {
            __syncthreads();
            for (int idx = tid; idx < TB * 264; idx += NTHR) {
                const int tt = idx / 264, ci = idx % 264, t = t0 + tt;
                const int ch = ci < 128 ? head * 128 + ci : (ci < 256 ? 512 + head * 128 + (ci - 128) : 1024 + head * 128 + eb * 8 + (ci - 256));
                float acc = 0.f;
#pragma unroll
                for (int k = 0; k < 4; ++k) { const int ts = t - 3 + k; if (ts >= 0) acc += cw[k * 1536 + ch] * bf2f(PROJ[(size_t)(b * SEQ + ts) * NPROJ + O_QKV + ch]); }
                const float v = siluf(acc);
                if (ci < 128) sQ[tt * 128 + ci] = v; else if (ci < 256) sK[tt * 128 + ci - 128] = v; else sV[tt * 8 + ci - 256] = v;
            }
            if (tid < TB) { const size_t ro = (size_t)(b * SEQ + t0 + tid) * NPROJ; const float braw = bf2f(PROJ[ro + O_GB + head]), araw = bf2f(PROJ[ro + O_GA + head]);
                sBe[tid] = sigmoidf_(braw); sAl[tid] = __expf(nA * softplusf_(araw + dtb)); }
            __syncthreads();
            for (int tt = w; tt < TB; tt += NWAVES) {
                const float q0 = sQ[tt * 128 + lane], q1 = sQ[tt * 128 + 64 + lane], k0 = sK[tt * 128 + lane], k1 = sK[tt * 128 + 64 + lane];
                const float sq = rsqrtf(wave_sum(q0 * q0 + q1 * q1) + 1e-6f) * 0.08838834764831845f, sk = rsqrtf(wave_sum(k0 * k0 + k1 * k1) + 1e-6f);
                sQ[tt * 128 + lane] = q0 * sq; sQ[tt * 128 + 64 + lane] = q1 * sq; sK[tt * 128 + lane] = k0 * sk; sK[tt * 128 + 64 + lane] = k1 * sk;
            }
            __syncthreads();
#pragma unroll 2
            for (int tt = 0; tt < TB; ++tt) {
                const float k0 = sK[tt * 128 + lane], k1 = sK[tt * 128 + 64 + lane], q0 = sQ[tt * 128 + lane], q1 = sQ[tt * 128 + 64 + lane];
                const float al = sAl[tt], be = sBe[tt], v = sV[tt * 8 + w];
                const float dot = wave_sum(k0 * S0 + k1 * S1);
                const float vn = be * (v - al * dot);
                S0 = al * S0 + k0 * vn; S1 = al * S1 + k1 * vn;
                const float od = wave_sum(q0 * S0 + q1 * S1);
                if (lane == 0) sO[tt * 8 + w] = od;
            }
            __syncthreads();
            if (tid < TB * 8) { const int tt = tid >> 3, i = tid & 7; YMIX[(size_t)(b * SEQ + t0 + tt) * DMIX + 1024 + head * 128 + eb * 8 + i] = (bf16)f2bf(sO[tid]); }
        }
    }
}

__device__ __forceinline__ void hgrn_rec_phase(CArgs a, int l, LAS unsigned char* lds, int wg, int G, int tid) {
    asm volatile("" : "+v"(tid));
    constexpr int TB = 32;
    LAS float* sQ = (LAS float*)lds; LAS float* sF = sQ + TB * 128; LAS float* sV = sF + TB * 128; LAS float* sO = sV + TB * 8; LAS float* sLb = sO + TB * 8;
    const bf16* PROJ = (const bf16*)(a->ws + WS_PROJ); bf16* YMIX = (bf16*)(a->ws + WS_YMIX);
    const int lane = tid & 63, w = tid >> 6;
    for (int unit = wg; unit < 256; unit += G) {
        const int b = unit >> 6, head = (unit >> 4) & 3, eb = unit & 15;
        __syncthreads();
        if (tid < 128) {
            const int c = head * 128 + tid; float lg[DEPTH], mx = -1e30f;
#pragma unroll
            for (int j = 0; j < DEPTH; ++j) { lg[j] = a->in[I_HLB][j * 512 + c]; mx = fmaxf(mx, lg[j]); }
            float den = 0.f, num = 0.f;
#pragma unroll
            for (int j = 0; j < DEPTH; ++j) { const float e = __expf(lg[j] - mx); den += e; if (j >= 1 && j <= l) num += e; }
            sLb[tid] = num / den;
        }
        float S0 = 0.f, S1 = 0.f;
        for (int t0 = 0; t0 < SEQ; t0 += TB) {
            __syncthreads();
            for (int idx = tid; idx < TB * 264; idx += NTHR) {
                const int tt = idx / 264, ci = idx % 264; const size_t ro = (size_t)(b * SEQ + t0 + tt) * NPROJ;
                if (ci < 128) sQ[tt * 128 + ci] = siluf(bf2f(PROJ[ro + O_HQ + head * 128 + ci]));
                else if (ci < 256) { const int d = ci - 128; const float lb = sLb[d]; sF[tt * 128 + d] = lb + (1.f - lb) * sigmoidf_(bf2f(PROJ[ro + O_HF + head * 128 + d])); }
                else sV[tt * 8 + ci - 256] = bf2f(PROJ[ro + O_HI + head * 128 + eb * 8 + (ci - 256)]);
            }
            __syncthreads();
#pragma unroll 2
            for (int tt = 0; tt < TB; ++tt) {
                const float f0 = sF[tt * 128 + lane], f1 = sF[tt * 128 + 64 + lane], q0 = sQ[tt * 128 + lane], q1 = sQ[tt * 128 + 64 + lane], v = sV[tt * 8 + w];
                S0 = f0 * S0 + (1.f - f0) * v; S1 = f1 * S1 + (1.f - f1) * v;
                const float od = wave_sum(q0 * S0 + q1 * S1);
                if (lane == 0) sO[tt * 8 + w] = od;
            }
            __syncthreads();
            if (tid < TB * 8) { const int tt = tid >> 3, i = tid & 7; YMIX[(size_t)(b * SEQ + t0 + tt) * DMIX + 1536 + head * 128 + eb * 8 + i] = (bf16)f2bf(sO[tid]); }
        }
    }
}

__device__ __forceinline__ void mix_post_phase(CArgs a, int l, int wg, int G, int tid) {
    asm volatile("" : "+v"(tid));
    const bf16* PROJ = (const bf16*)(a->ws + WS_PROJ); bf16* YMIX = (bf16*)(a->ws + WS_YMIX);
    const int lane = tid & 63, gw = wg * NWAVES + (tid >> 6), NGW = G * NWAVES;
    const float* snw = a->in[I_SNW] + l * 1024; const float* gnw = a->in[I_GNW] + l * 128; const float* hnw = a->in[I_HNW] + l * 128;
    for (int row = gw; row < M; row += NGW) {
        const bf16* pr = PROJ + (size_t)row * NPROJ; bf16* yr = YMIX + (size_t)row * DMIX;
#pragma unroll
        for (int j = 0; j < 2; ++j) {
            const int ch = j * 512 + lane * 8; const v4u yv = *(const GAS v4u*)(yr + ch), zv = *(const GAS v4u*)(pr + O_Z + ch);
            float v[8]; float ss = 0.f;
#pragma unroll
            for (int i = 0; i < 4; ++i) { v[2 * i] = bflo(yv[i]) * siluf(bflo(zv[i])); v[2 * i + 1] = bfhi(yv[i]) * siluf(bfhi(zv[i])); ss += v[2 * i] * v[2 * i] + v[2 * i + 1] * v[2 * i + 1]; }
            const float rstd = rsqrtf(wave_sum(ss) * (1.f / 512.f) + 1e-6f);
            v4u o;
#pragma unroll
            for (int i = 0; i < 4; ++i) o[i] = pk2(v[2 * i] * rstd * snw[ch + 2 * i], v[2 * i + 1] * rstd * snw[ch + 2 * i + 1]);
            *(GAS v4u*)(yr + ch) = o;
        }
#pragma unroll
        for (int part = 0; part < 2; ++part) {
            const int ch = lane * 8, yo = 1024 + part * 512 + ch, go = (part == 0 ? O_GG : O_HG) + ch; const float* nw = part == 0 ? gnw : hnw;
            const v4u yv = *(const GAS v4u*)(yr + yo), gv = *(const GAS v4u*)(pr + go);
            float v[8]; float ss = 0.f;
#pragma unroll
            for (int i = 0; i < 4; ++i) { v[2 * i] = bflo(yv[i]); v[2 * i + 1] = bfhi(yv[i]); ss += v[2 * i] * v[2 * i] + v[2 * i + 1] * v[2 * i + 1]; }
            ss = row16_sum(ss);
            const float rstd = rsqrtf(ss * (1.f / 128.f) + 1e-6f);
            v4u o;
#pragma unroll
            for (int i = 0; i < 4; ++i) { const int c = (ch & 127) + 2 * i; o[i] = pk2(v[2 * i] * rstd * nw[c] * siluf(bflo(gv[i])), v[2 * i + 1] * rstd * nw[c + 1] * siluf(bfhi(gv[i]))); }
            *(GAS v4u*)(yr + yo) = o;
        }
    }
}

__device__ __forceinline__ void moe_tables(const gu32* cnt, LAS unsigned char* lds, int tid) {
    LAS int* tab = (LAS int*)(lds + LDS_OFF_TAB);
    __syncthreads();
    if (tid == 0) { int p = 0, q = 0;
        for (int e = 0; e < 16; ++e) { const int c = (int)__hip_atomic_load(cnt + e, RLX_AGENT); tab[e] = p; tab[17 + e] = q; p += (c + 255) & ~255; q += c; }
        tab[16] = p; tab[33] = q; }
    __syncthreads();
}
template <bool ROUTER>
__device__ __forceinline__ void ln_phase(CArgs a, int l, const float* gam, const float* bet, LAS unsigned char* lds, int wg, int G, int tid) {
    asm volatile("" : "+v"(tid));
    const int lane = tid & 63, wave = tid >> 6, gw = wg * NWAVES + wave, NGW = G * NWAVES;
    const float* ADD = (const float*)(a->ws + WS_MIX); float* H = a->out; bf16* HB = (bf16*)(a->ws + WS_HB);
    gu32* cnt = (gu32*)(a->ws + WS_CTL) + CW_CNT + l * 16;
    LAS float* sW = (LAS float*)lds;
    LAS float* sL = sW + 20 * D + wave * 32;
    LAS int* sCnt = (LAS int*)(sW + 20 * D + 256);
    LAS unsigned* sEnt = (LAS unsigned*)(sCnt + 32);
    constexpr int MAXENT = 2 * NWAVES * 8;
    if (ROUTER) {
        __syncthreads();
        const float* wrg = a->in[I_WRG] + (size_t)l * D * 4; const float* wre = a->in[I_WRE] + (size_t)l * D * 16;
        for (int i = tid; i < D * 20; i += NTHR) { const int c = i >> 10, k = i & 1023; sW[i] = c < 4 ? wrg[k * 4 + c] : wre[k * 16 + c - 4]; }
        if (tid < 32) sCnt[tid] = 0;
        __syncthreads();
    } else moe_tables(cnt, lds, tid);
    const LAS int* tab = (const LAS int*)(lds + LDS_OFF_TAB);
    f32x4 gv[4], bv[4];
#pragma unroll
    for (int j = 0; j < 4; ++j) { gv[j] = *(const f32x4*)(gam + 4 * lane + 256 * j); bv[j] = *(const f32x4*)(bet + 4 * lane + 256 * j); }
    int kk = 0;
    for (int row = gw; row < M; row += NGW, ++kk) {
        f32x4 v[4]; float s = 0.f;
        if (ROUTER) {
#pragma unroll
            for (int j = 0; j < 4; ++j) { const f32x4 hv = *(const GAS f32x4*)(H + (size_t)row * D + 4 * lane + 256 * j), av = *(const GAS f32x4*)(ADD + (size_t)row * D + 4 * lane + 256 * j);
                v[j] = hv * DN_ALPHA + av; s += (v[j].x + v[j].y) + (v[j].z + v[j].w); }
        } else {
            const unsigned s0 = ((const GAS unsigned*)(a->ws + WS_SLOT))[2 * row], s1 = ((const GAS unsigned*)(a->ws + WS_SLOT))[2 * row + 1];
            const bf16* y0 = (const bf16*)(a->ws + WS_YS) + (size_t)(tab[s0 >> 16] + (int)(s0 & 0xffffu)) * D; const bf16* y1 = (const bf16*)(a->ws + WS_YS) + (size_t)(tab[s1 >> 16] + (int)(s1 & 0xffffu)) * D;
#pragma unroll
            for (int j = 0; j < 4; ++j) { const f32x4 hv = *(const GAS f32x4*)(H + (size_t)row * D + 4 * lane + 256 * j);
                const unsigned long long p0 = *(const GAS unsigned long long*)(y0 + 4 * lane + 256 * j), p1 = *(const GAS unsigned long long*)(y1 + 4 * lane + 256 * j);
                f32x4 av; av.x = bflo((unsigned)p0) + bflo((unsigned)p1); av.y = bfhi((unsigned)p0) + bfhi((unsigned)p1); av.z = bflo((unsigned)(p0 >> 32)) + bflo((unsigned)(p1 >> 32)); av.w = bfhi((unsigned)(p0 >> 32)) + bfhi((unsigned)(p1 >> 32));
                v[j] = hv * DN_ALPHA + av; s += (v[j].x + v[j].y) + (v[j].z + v[j].w); }
        }
        const float mean = wave_sum(s) * (1.f / D); float s2 = 0.f;
#pragma unroll
        for (int j = 0; j < 4; ++j) { v[j] = v[j] - mean; s2 += (v[j].x * v[j].x + v[j].y * v[j].y) + (v[j].z * v[j].z + v[j].w * v[j].w); }
        const float rstd = rsqrtf(wave_sum(s2) * (1.f / D) + LN_EPS);
#pragma unroll
        for (int j = 0; j < 4; ++j) { v[j] = v[j] * rstd * gv[j] + bv[j];
            *(GAS f32x4*)(H + (size_t)row * D + 4 * lane + 256 * j) = v[j];
            *(GAS unsigned long long*)(HB + (size_t)row * D + 4 * lane + 256 * j) = (unsigned long long)pk2(v[j].x, v[j].y) | ((unsigned long long)pk2(v[j].z, v[j].w) << 32); }
        if (ROUTER) {
            float lg[20];
#pragma unroll 1
            for (int c = 0; c < 20; ++c) { float p = 0.f;
#pragma unroll
                for (int j = 0; j < 4; ++j) { const f32x4 wv = *(const LAS f32x4*)(sW + c * D + 4 * lane + 256 * j); p += (v[j].x * wv.x + v[j].y * wv.y) + (v[j].z * wv.z + v[j].w * wv.w); }
                p = wave_sum(p); if (lane == 0) sL[c] = p; }
#pragma unroll
            for (int c = 0; c < 20; ++c) lg[c] = sL[c];
            float pg[4], mx = -1e30f; int gi = 0;
#pragma unroll
            for (int c = 0; c < 4; ++c) { pg[c] = lg[c] + a->in[I_BRG][l * 4 + c]; if (pg[c] > mx) { mx = pg[c]; gi = c; } }
            float den = 0.f;
#pragma unroll
            for (int c = 0; c < 4; ++c) den += __expf(pg[c] - mx);
            const float g_p = 1.0f / den;
            float le[4], emx = -1e30f; int i1 = 0;
#pragma unroll
            for (int c = 0; c < 4; ++c) { float x = 0.f;
#pragma unroll
                for (int gg = 0; gg < 4; ++gg) x = (gi == gg) ? lg[4 + gg * 4 + c] + a->in[I_BRE][l * 16 + gg * 4 + c] : x;
                le[c] = x; if (x > emx) { emx = x; i1 = c; } }
            float e2mx = -1e30f; int i2 = 0;
#pragma unroll
            for (int c = 0; c < 4; ++c) if (c != i1 && le[c] > e2mx) { e2mx = le[c]; i2 = c; }
            const float x2 = __expf(e2mx - emx), w1 = g_p / (1.0f + x2), w2 = g_p * x2 / (1.0f + x2);
            if (lane < 2) {
                const int e = gi * 4 + (lane == 0 ? i1 : i2); const float wv = lane == 0 ? w1 : w2;
                if (kk < 8) { const int lp = __hip_atomic_fetch_add(sCnt + e, 1, __ATOMIC_RELAXED, __HIP_MEMORY_SCOPE_WORKGROUP); LAS unsigned* en = sEnt + ((wave * 8 + kk) * 2 + lane) * 4;
                    en[0] = (unsigned)row; en[1] = (unsigned)e; en[2] = (unsigned)lp; en[3] = __builtin_bit_cast(unsigned, wv); }
                else { const int pos = (int)__hip_atomic_fetch_add(cnt + e, 1u, RLX_AGENT);
                    ((GAS int*)(a->ws + WS_LTOK))[e * M + pos] = row; ((GAS float*)(a->ws + WS_LW))[e * M + pos] = wv; ((GAS unsigned*)(a->ws + WS_SLOT))[2 * row + lane] = ((unsigned)e << 16) | (unsigned)pos; }
            }
        }
    }
    if (ROUTER) {
        __syncthreads();
        if (tid < 16) sCnt[16 + tid] = (int)__hip_atomic_fetch_add(cnt + tid, (unsigned)sCnt[tid], RLX_AGENT);
        __syncthreads();
        const int nk = kk < 8 ? kk : 8;
        if (tid < MAXENT) { const int wv_ = tid >> 4, k_ = (tid >> 1) & 7;
            int nkw = 0;
#pragma unroll
            for (int k2 = 0; k2 < 8; ++k2) nkw += (wg * NWAVES + wv_ + k2 * NGW < M) ? 1 : 0;
            if (k_ < nkw) { const LAS unsigned* en = sEnt + tid * 4; const int e = (int)en[1], pos = sCnt[16 + e] + (int)en[2];
                ((GAS int*)(a->ws + WS_LTOK))[e * M + pos] = (int)en[0]; ((GAS unsigned*)(a->ws + WS_LW))[e * M + pos] = en[3]; ((GAS unsigned*)(a->ws + WS_SLOT))[2 * en[0] + (tid & 1)] = ((unsigned)e << 16) | (unsigned)pos; } }
        (void)nk;
    }
}
__device__ __forceinline__ void moe_gather_phase(CArgs a, int l, LAS unsigned char* lds, int wg, int G, int tid) {
    asm volatile("" : "+v"(tid));
    const int lane = tid & 63, gw = wg * NWAVES + (tid >> 6), NGW = G * NWAVES;
    moe_tables((gu32*)(a->ws + WS_CTL) + CW_CNT + l * 16, lds, tid);
    const LAS int* tab = (const LAS int*)(lds + LDS_OFF_TAB);
    const bf16* HB = (const bf16*)(a->ws + WS_HB); bf16* XS = (bf16*)(a->ws + WS_XS);
    for (int idx = gw; idx < 2 * M; idx += NGW) {
        int e = 0;
#pragma unroll
        for (int k = 1; k < 16; ++k) e += (tab[17 + k] <= idx) ? 1 : 0;
        const int pos = idx - tab[17 + e], dst = tab[e] + pos;
        const int row = ((const GAS int*)(a->ws + WS_LTOK))[e * M + pos];
        const v4u x0 = *(const GAS v4u*)(HB + (size_t)row * D + 8 * lane), x1 = *(const GAS v4u*)(HB + (size_t)row * D + 512 + 8 * lane);
        *(GAS v4u*)(XS + (size_t)dst * D + 8 * lane) = x0; *(GAS v4u*)(XS + (size_t)dst * D + 512 + 8 * lane) = x1;
        if (lane == 0) ((GAS float*)(a->ws + WS_WSORT))[dst] = ((const GAS float*)(a->ws + WS_LW))[e * M + pos];
    }
}

enum { P_IN = 0, P_PREP, P_SCAN, P_POST, P_OUT, P_LN1, P_GU, P_DN, P_LN2, NPH };
constexpr int N_PHASES = 1 + DEPTH * NPH;
__global__ void __launch_bounds__(NTHR, 2) fwd(Args args) {
    extern __shared__ __attribute__((aligned(16))) unsigned char lds_raw[];
    LAS unsigned char* lds = (LAS unsigned char*)lds_raw;
    volatile LAS unsigned* MISC = (volatile LAS unsigned*)(lds + MISC_OFF);
    const int tid = threadIdx.x, G = gridDim.x, bx = blockIdx.x;
    unsigned char* ws0 = args.ws;
    gu32* ctl = (gu32*)(ws0 + WS_CTL);
    for (int u = tid; u < (LDS_BYTES - LDSCTL_OFF) / 4; u += NTHR) ((LAS unsigned*)(lds + LDSCTL_OFF))[u] = 0u;
    __syncthreads();
    const int lo = args.ph_lo, hi = args.ph_hi;
    const bool use_bar = (hi - lo) > 1;
    XcdBarrier bar; bar.bar = (unsigned*)(ctl + CW_BAR); bar.x = 0; bar.st = nullptr;
    if (use_bar) bar = xcd_barrier_post((unsigned*)(ctl + CW_BAR), MISC + 8);
#define IN(k) (lo <= (k) && (k) < hi)
#define SEAM(k) do { if (IN(k) && IN((k) + 1)) xcd_barrier(bar); } while (0)

    if (IN(0)) { p0_prologue(ARGS_HERE(), lds, bx, G, tid); weights_phase(ARGS_HERE(), 0, 1, lds, bx, G, tid); SEAM(0); }

    for (int l = 0; l < DEPTH; ++l) {
        const int base = 1 + l * NPH;
        unsigned char* ws = ws0; asm volatile("" : "+s"(ws));
        if (IN(base + P_IN)) {
            pg8::Gemm g{(const pg8::bf16_t*)(ws + WS_HB), (const pg8::bf16_t*)(ws + WS_WIN), M, NPROJ, D}; pg8::StaticOrder S; S.init(M, NPROJ, G, bx);
            pg8::EpiBf16<0> E{(pg8::bf16_t*)(ws + WS_PROJ), NPROJ, nullptr, 0, 0, 1.f};
            pg8::gemm_phase<pg8::EpiBf16<0>, pg8::StaticOrder, true, true>(lds + RING_OFF, g, S, E);
            SEAM(base + P_IN);
        }
        if (IN(base + P_PREP)) {
            hgrn_prep_phase(ARGS_HERE(), l, lds, bx, G, tid);
            ssd_prep_phase(ARGS_HERE(), l, lds, bx, G, tid);
            gdn_prep_phase(ARGS_HERE(), l, lds, bx, G, tid);
            SEAM(base + P_PREP); }
        if (IN(base + P_SCAN)) {
            if (G >= 192) {
                if (bx < 64) { const int pr = bx & 7, hh = bx >> 3; ssd_scan_phase(ARGS_HERE(), l, lds, pr >> 1, (pr & 1) * 8 + hh, tid); }
                else if (bx < 96) { const int x = (bx - 64) & 7, y = (bx - 64) >> 3, pr = x * 2 + (y >> 1); gdn_scan_phase(ARGS_HERE(), l, lds, pr >> 2, pr & 3, y & 1, tid); }
                else if (bx < 160) { const int x = (bx - 96) & 7, y = (bx - 96) >> 3, pr = x * 2 + (y >> 2); hgrn_scan_phase(ARGS_HERE(), l, lds, pr >> 2, pr & 3, y & 3, tid); }
                else { weights_phase(ARGS_HERE(), l, 14, lds, bx - 160, G - 160, tid);
                       if (l + 1 < DEPTH) weights_phase(ARGS_HERE(), l + 1, 1, lds, bx - 160, G - 160, tid); }
            }
            SEAM(base + P_SCAN); }
        if (IN(base + P_POST)) { mix_post_phase(ARGS_HERE(), l, bx, G, tid); SEAM(base + P_POST); }
        if (IN(base + P_OUT)) {
            pg8::Gemm g{(const pg8::bf16_t*)(ws + WS_YMIX), (const pg8::bf16_t*)(ws + WS_WOUT), M, D, DMIX}; pg8::StaticOrder S; S.init(M, D, G, bx);
            pg8::EpiF32 E{(float*)(ws + WS_MIX), D};
            pg8::gemm_phase<pg8::EpiF32, pg8::StaticOrder, true, true>(lds + RING_OFF, g, S, E);
            SEAM(base + P_OUT);
        }
        if (IN(base + P_LN1)) { CArgs a_ = ARGS_HERE(); ln_phase<true>(a_, l, a_->in[I_LN1G] + l * D, a_->in[I_LN1B] + l * D, lds, bx, G, tid); SEAM(base + P_LN1); }
        if (IN(base + P_GU)) {
            moe_tables(ctl + CW_CNT + l * 16, lds, tid);
            pg8::Gemm g{(const pg8::bf16_t*)(ws + WS_HB), (const pg8::bf16_t*)(ws + WS_WGU), MAXROWS, NGU, D}; pg8::MoeOrder<2, true> S{(const LAS int*)(lds + LDS_OFF_TAB), G, bx, (const int*)(ws + WS_LTOK), M};
            pg8::EpiSwiGLUs E{(pg8::bf16_t*)(ws + WS_HS), (const float*)(ws + WS_LW), M, (const LAS int*)(lds + LDS_OFF_TAB)};
            pg8::gemm_phase<pg8::EpiSwiGLUs, pg8::MoeOrder<2, true>, true, true>(lds + RING_OFF, g, S, E);
            SEAM(base + P_GU);
        }
        if (IN(base + P_DN)) {
            moe_tables(ctl + CW_CNT + l * 16, lds, tid);
            pg8::Gemm g{(const pg8::bf16_t*)(ws + WS_HS), (const pg8::bf16_t*)(ws + WS_WDN), MAXROWS, NEXP * D, DEXP}; pg8::MoeOrder<4> S{(const LAS int*)(lds + LDS_OFF_TAB), G, bx, nullptr, 0};
            pg8::EpiBf16s E{(pg8::bf16_t*)(ws + WS_YS)};
            pg8::gemm_phase<pg8::EpiBf16s, pg8::MoeOrder<4>, true, true>(lds + RING_OFF, g, S, E);
            SEAM(base + P_DN);
        }
        if (IN(base + P_LN2)) { CArgs a_ = ARGS_HERE(); ln_phase<false>(a_, l, a_->in[I_LN2G] + l * D, a_->in[I_LN2B] + l * D, lds, bx, G, tid); SEAM(base + P_LN2); }
    }
#undef IN
#undef SEAM
}

#ifndef MK_ONE_LAUNCH
#define MK_ONE_LAUNCH 1
#endif
extern "C" void kernel_launch(void* const* d_in, const int* in_sizes, int n_in, void* d_out, int out_size, void* d_ws, size_t ws_size, hipStream_t stream) {
    static int grid = 0;
    if (grid == 0) {
        if (n_in != 25 || out_size != M * D || ws_size < WS_END) { fprintf(stderr, "kernel_launch: unexpected shapes (n_in %d out %d ws %zu)\n", n_in, out_size, ws_size); grid = -1; return; }
        int dev = 0, cus = 0, per_cu = 0;
        if (hipGetDevice(&dev) != hipSuccess || hipDeviceGetAttribute(&cus, hipDeviceAttributeMultiprocessorCount, dev) != hipSuccess) { grid = -1; return; }
        if (hipFuncSetAttribute((const void*)fwd, hipFuncAttributeMaxDynamicSharedMemorySize, LDS_BYTES) != hipSuccess) { fprintf(stderr, "kernel_launch: hipFuncSetAttribute failed\n"); grid = -1; return; }
        if (hipOccupancyMaxActiveBlocksPerMultiprocessor(&per_cu, (const void*)fwd, NTHR, LDS_BYTES) != hipSuccess || per_cu < 1) { fprintf(stderr, "kernel_launch: occupancy query says %d\n", per_cu); (void)hipGetLastError(); grid = -1; return; }
        grid = cus;
    }
    if (grid < 0) return;
    if (hipMemsetAsync((char*)d_ws + WS_CTL, 0, CTL_ZERO_BYTES, stream) != hipSuccess) return;
    Args a{};
    for (int i = 0; i < 25; ++i) a.in[i] = (const float*)d_in[i];
    a.out = (float*)d_out; a.ws = (unsigned char*)d_ws;
#if MK_ONE_LAUNCH
    a.ph_lo = 0; a.ph_hi = N_PHASES;
    hipLaunchKernelGGL(fwd, dim3(grid), dim3(NTHR), LDS_BYTES, stream, a);
#else
    for (int p = 0; p < N_PHASES; ++p) { a.ph_lo = p; a.ph_hi = p + 1; hipLaunchKernelGGL(fwd, dim3(grid), dim3(NTHR), LDS_BYTES, stream, a); }
#endif
}
```

```cpp
#include <hip/hip_runtime.h>
#include <cstdio>
#include <cstdint>
namespace pg8 {
#define PG8_LAS __attribute__((address_space(3)))
typedef unsigned short bf16_t;
typedef short bf16x8 __attribute__((ext_vector_type(8)));
typedef float f32x4 __attribute__((ext_vector_type(4)));
typedef unsigned u32x4 __attribute__((ext_vector_type(4)));
constexpr int BM = 256, BK = 64, HALF = 128, HTB = HALF * BK * 2  , STAGE_BYTES = 8 * HTB, NXCD = 8, WGM = 8;

__host__ __device__ __forceinline__ int lds_byte(int r, int c) { const int st = (r >> 4) * 2 + (c >> 5), rr = r & 15, cc = c & 31, ob = rr * 64 + cc * 2; return st * 1024 + (ob ^ (((ob >> 9) & 1) << 5)); }
__host__ __device__ __forceinline__ void stage_rc(int b, int& R, int& C) { const int st = b / 1024, sb = b % 1024, swz = sb ^ (((sb >> 9) & 1) << 5); R = (st >> 1) * 16 + swz / 64; C = (st & 1) * 32 + (swz % 64) / 2; }
__host__ __device__ __forceinline__ int perm32(int rho) { const int n = rho >> 4, i = rho & 15; return 8 * (i >> 2) + 4 * n + (i & 3); }

struct Unit { int pm, pn; };
struct Gemm { const bf16_t* A; const bf16_t* Bt; int M, N, K; };

struct StaticOrder {
    static constexpr bool GATHER = false;
    int nM, nN, nwg, G, c;
    __host__ __device__ void init(int M, int N, int G_, int c_) { nM = M / BM; nN = N / BM; nwg = nM * nN; G = G_; c = c_; }
    __host__ __device__ bool next(int i, Unit& u) const {
        const long L = (long)i * G + c; if (L >= nwg) return false;
        int wgid = (int)L; { const int q = nwg / NXCD, r = nwg % NXCD, xcd = wgid % NXCD, off = wgid / NXCD; wgid = (xcd < r ? xcd * (q + 1) : r * (q + 1) + (xcd - r) * q) + off; }
        const int nig = WGM * nN, gid = wgid / nig, fm = gid * WGM, gsz = (nM - fm) < WGM ? (nM - fm) : WGM;
        u.pm = fm + ((wgid % nig) % gsz); u.pn = (wgid % nig) / gsz; return true;
    }
    __device__ __forceinline__ void a_ready(const Unit&) const {}
    __device__ __forceinline__ void done(const Unit&) const {}
    __device__ __forceinline__ int row_token(int, const Unit&) const { return 0; }
};
__device__ __forceinline__ unsigned cvt_pk_bf16(float lo, float hi) { unsigned r; asm volatile("v_cvt_pk_bf16_f32 %0, %1, %2" : "=v"(r) : "v"(lo), "v"(hi)); return r; }
typedef float f32x2 __attribute__((ext_vector_type(2)));
__device__ __forceinline__ f32x2 gelu_pk(f32x2 v) {
    const f32x2 av = __builtin_elementwise_abs(v), d = av * 0.2316418882f + 1.0f;
    f32x2 t; t.x = __builtin_amdgcn_rcpf(d.x); t.y = __builtin_amdgcn_rcpf(d.y);
    f32x2 q = t * 0.5307027145f + (-0.7265760135f); q = q * t + 0.7107068705f; q = q * t + (-0.142248368f); q = q * t + 0.127414796f; q = q * t;
    const f32x2 s = (v * v) * (-0.72134752044f);
    f32x2 e; e.x = __builtin_amdgcn_exp2f(s.x); e.y = __builtin_amdgcn_exp2f(s.y);
    const f32x2 m = v * (q * e), r = v - m;
    f32x2 o; o.x = v.x < 0.f ? m.x : r.x; o.y = v.y < 0.f ? m.y : r.y; return o;
}

template <int ACT  > struct EpiBf16 {
    static constexpr bool PERM = true, AFTER_DRAIN = false; static_assert(ACT == 0 || ACT == 1, "EpiBf16: ACT is 0 (none) or 1 (gelu_pk)");
    bf16_t* O; int ldc; const float* bias; int split_cols; size_t split_stride; float scale0;
    __device__ __forceinline__ void operator()(const f32x4 (&acc)[2][2][4][2], const Unit& u, int wr, int wc, int fr, int fq) const {
        const int row0 = u.pm * BM + wr * 64 + fr; int colt = u.pn * BM; bf16_t* base = O;
        float sc = 1.f; if (split_cols) { const int t = colt / split_cols; base += (size_t)t * split_stride; colt -= t * split_cols; if (t == 0) sc = scale0; }
        const int col0 = colt + wc * 32 + 8 * fq, bcol0 = u.pn * BM + wc * 32 + 8 * fq;
        f32x4 bv[2][2];
#pragma unroll
        for (int bj = 0; bj < 2; ++bj)
#pragma unroll
            for (int n = 0; n < 2; ++n) bv[bj][n] = bias ? *(const f32x4*)(bias + bcol0 + bj * HALF + 4 * n) : (f32x4){0.f, 0.f, 0.f, 0.f};
#pragma unroll
        for (int ai = 0; ai < 2; ++ai)
#pragma unroll
            for (int m = 0; m < 4; ++m) { bf16_t* rowp = base + (size_t)(row0 + ai * HALF + m * 16) * ldc + col0;
#pragma unroll
                for (int bj = 0; bj < 2; ++bj) { f32x4 v0 = acc[ai][bj][m][0] + bv[bj][0], v1 = acc[ai][bj][m][1] + bv[bj][1];
                    if (ACT == 1) { f32x2 a = gelu_pk((f32x2){v0[0], v0[1]}), b = gelu_pk((f32x2){v0[2], v0[3]}), c = gelu_pk((f32x2){v1[0], v1[1]}), d = gelu_pk((f32x2){v1[2], v1[3]});
                        v0 = (f32x4){a.x, a.y, b.x, b.y}; v1 = (f32x4){c.x, c.y, d.x, d.y}; }
                    v0 = v0 * sc; v1 = v1 * sc; u32x4 w; w.x = cvt_pk_bf16(v0[0], v0[1]); w.y = cvt_pk_bf16(v0[2], v0[3]); w.z = cvt_pk_bf16(v1[0], v1[1]); w.w = cvt_pk_bf16(v1[2], v1[3]);
                    *(u32x4*)(rowp + bj * HALF) = w; } }
    }
};
struct EpiF32 {
    static constexpr bool PERM = false, AFTER_DRAIN = false;
    float* C; int ldc;
    __device__ __forceinline__ void operator()(const f32x4 (&acc)[2][2][4][2], const Unit& u, int wr, int wc, int fr, int fq) const {
        const int row0 = u.pm * BM + wr * 64 + fr, col0 = u.pn * BM + wc * 32 + 4 * fq;
#pragma unroll
        for (int ai = 0; ai < 2; ++ai)
#pragma unroll
            for (int m = 0; m < 4; ++m) { float* rowp = C + (size_t)(row0 + ai * HALF + m * 16) * ldc + col0;
#pragma unroll
                for (int bj = 0; bj < 2; ++bj)
#pragma unroll
                    for (int n = 0; n < 2; ++n) *(f32x4*)(rowp + bj * HALF + n * 16) = acc[ai][bj][m][n]; }
    }
};
__device__ __forceinline__ float silu_f(float x) { return x / (1.0f + __expf(-x)); }
struct EpiSwiGLU {
    static constexpr bool PERM = true, AFTER_DRAIN = false;
    bf16_t* H; int ldh; const float* comb; int ldcomb;
    __device__ __forceinline__ void operator()(const f32x4 (&acc)[2][2][4][2], const Unit& u, int wr, int wc, int fr, int fq) const {
        const int row0 = u.pm * BM + wr * 64 + fr, col0 = u.pn * 128 + wc * 32 + 8 * fq, e = u.pn >> 1;
#pragma unroll
        for (int ai = 0; ai < 2; ++ai)
#pragma unroll
            for (int m = 0; m < 4; ++m) { const int row = row0 + ai * HALF + m * 16; const float cw = comb[(size_t)row * ldcomb + e];
                const f32x4 g0 = acc[ai][0][m][0], g1 = acc[ai][0][m][1], u0 = acc[ai][1][m][0], u1 = acc[ai][1][m][1];
                f32x4 h0, h1;
#pragma unroll
                for (int j = 0; j < 4; ++j) { h0[j] = silu_f(g0[j]) * u0[j] * cw; h1[j] = silu_f(g1[j]) * u1[j] * cw; }
                u32x4 w; w.x = cvt_pk_bf16(h0[0], h0[1]); w.y = cvt_pk_bf16(h0[2], h0[3]); w.z = cvt_pk_bf16(h1[0], h1[1]); w.w = cvt_pk_bf16(h1[2], h1[3]);
                *(u32x4*)(H + (size_t)row * ldh + col0) = w; }
    }
};

template <int NSUB, bool GATHER_ = false> struct MoeOrder {
    static constexpr bool GATHER = GATHER_;
    const PG8_LAS int* off; int G, c; const int* ltok; int lstride;
    __device__ __forceinline__ int row_token(int srow, const Unit& u) const { const int e = u.pn / NSUB, pos = srow - off[e]; return pos < off[18 + e] - off[17 + e] ? ltok[e * lstride + pos] : 0; }
    __device__ __forceinline__ bool next(int i, Unit& u) const {
        const int L = i * G + c, x = L & 7, j = L >> 3, t = x + 8 * (j / NSUB), pnl = j % NSUB;
        if (t * 256 >= off[16]) return false;
        int e = 0;
#pragma unroll
        for (int k = 1; k < 16; ++k) e += (off[k] <= t * 256) ? 1 : 0;
        u.pm = t; u.pn = e * NSUB + pnl; return true;
    }
    __device__ __forceinline__ void a_ready(const Unit&) const {}
    __device__ __forceinline__ void done(const Unit&) const {}
};
struct EpiSwiGLUs {
    static constexpr bool PERM = true, AFTER_DRAIN = false;
    bf16_t* H; const float* lw; int lstride; const PG8_LAS int* off;
    __device__ __forceinline__ void operator()(const f32x4 (&acc)[2][2][4][2], const Unit& u, int wr, int wc, int fr, int fq) const {
        const int row0 = u.pm * BM + wr * 64 + fr, col0 = (u.pn & 1) * 128 + wc * 32 + 8 * fq;
#pragma unroll
        for (int ai = 0; ai < 2; ++ai)
#pragma unroll
            for (int m = 0; m < 4; ++m) { const int row = row0 + ai * HALF + m * 16; const int e_ = u.pn >> 1, pos_ = row - off[e_]; const float cw = pos_ < off[18 + e_] - off[17 + e_] ? lw[e_ * lstride + pos_] : 0.f;
                const f32x4 g0 = acc[ai][0][m][0], g1 = acc[ai][0][m][1], u0 = acc[ai][1][m][0], u1 = acc[ai][1][m][1];
                f32x4 h0, h1;
#pragma unroll
                for (int j = 0; j < 4; ++j) { h0[j] = silu_f(g0[j]) * u0[j] * cw; h1[j] = silu_f(g1[j]) * u1[j] * cw; }
                u32x4 w; w.x = cvt_pk_bf16(h0[0], h0[1]); w.y = cvt_pk_bf16(h0[2], h0[3]); w.z = cvt_pk_bf16(h1[0], h1[1]); w.w = cvt_pk_bf16(h1[2], h1[3]);
                *(u32x4*)(H + (size_t)row * 256 + col0) = w; }
    }
};
struct EpiBf16s {
    static constexpr bool PERM = true, AFTER_DRAIN = false;
    bf16_t* O;
    __device__ __forceinline__ void operator()(const f32x4 (&acc)[2][2][4][2], const Unit& u, int wr, int wc, int fr, int fq) const {
        const int row0 = u.pm * BM + wr * 64 + fr, col0 = (u.pn & 3) * BM + wc * 32 + 8 * fq;
#pragma unroll
        for (int ai = 0; ai < 2; ++ai)
#pragma unroll
            for (int m = 0; m < 4; ++m) { bf16_t* rowp = O + (size_t)(row0 + ai * HALF + m * 16) * 1024 + col0;
#pragma unroll
                for (int bj = 0; bj < 2; ++bj) { const f32x4 v0 = acc[ai][bj][m][0], v1 = acc[ai][bj][m][1];
                    u32x4 w; w.x = cvt_pk_bf16(v0[0], v0[1]); w.y = cvt_pk_bf16(v0[2], v0[3]); w.z = cvt_pk_bf16(v1[0], v1[1]); w.w = cvt_pk_bf16(v1[2], v1[3]);
                    *(u32x4*)(rowp + bj * HALF) = w; } }
    }
};
template <class Epi, class Sched, bool ALIGN_EPI = false, bool SP2 = false>
__device__ __forceinline__ void gemm_phase(PG8_LAS unsigned char* lds, const Gemm g, const Sched& S, const Epi& E) {
    int tid_ = threadIdx.x; asm volatile("" : "+v"(tid_));
    const int tid = tid_, wid = __builtin_amdgcn_readfirstlane(tid >> 6), lane = tid & 63, wr = wid >> 2, wc = wid & 3, fr = lane & 15, fq = lane >> 4;
    const int K = g.K, nt = K / BK;
    unsigned voffA[2], voffB[2];
#pragma unroll
    for (int i = 0; i < 2; ++i) { int R, C; stage_rc(tid * 16 + i * 8192, R, C); const int Rb = Epi::PERM ? ((R & ~31) + perm32(R & 31)) : R;
        voffA[i] = (unsigned)(R * K + C) * 2u; voffB[i] = (unsigned)(Rb * K + C) * 2u; }
    constexpr bool GATHER = Sched::GATHER; static_assert(!GATHER || SP2, "the gather path is written for the two-super-phase loop");
    int gR[2], gC[2];
#pragma unroll
    for (int i = 0; i < 2; ++i) stage_rc(tid * 16 + i * 8192, gR[i], gC[i]);
    unsigned vA0[2] = {0u, 0u}, vA1[2] = {0u, 0u}, nvA0[2] = {0u, 0u}, nvA1[2] = {0u, 0u};
#define PG8_GLOOK(U, D0, D1) do { _Pragma("unroll") for (int _i = 0; _i < 2; ++_i) { \
        D0[_i] = (unsigned)S.row_token((U).pm * BM + gR[_i], (U)) * (unsigned)(K * 2) + (unsigned)gC[_i] * 2u; D1[_i] = (unsigned)S.row_token((U).pm * BM + HALF + gR[_i], (U)) * (unsigned)(K * 2) + (unsigned)gC[_i] * 2u; } } while (0)
    const size_t kstep = (size_t)(BK * 2);
    const size_t hstep = (size_t)HALF * K * 2;
    const size_t tstep = 2 * hstep;
    const unsigned ldsw = (unsigned)wid * 1024u;
    const int aoff = lds_byte(wr * 64 + fr, fq * 8), boff = lds_byte(wc * 32 + fr, fq * 8);
#define PG8_SA(b, h) (((b) * 2 + (h)) * HTB)
#define PG8_SB(b, h) ((4 + (b) * 2 + (h)) * HTB)
#define PG8_STAGE(bufoff, gbase, voff) do { _Pragma("unroll") for (int _i = 0; _i < 2; ++_i) \
        __builtin_amdgcn_global_load_lds((const unsigned*)((const char*)(gbase) + (voff)[_i]), (PG8_LAS unsigned*)(lds + (bufoff) + ldsw + _i * 8192), 16, 0, 0); } while (0)
#define PG8_LDA(dst, b, h) do { _Pragma("unroll") for (int m = 0; m < 4; ++m) _Pragma("unroll") for (int k = 0; k < 2; ++k) dst[m][k] = *(const PG8_LAS bf16x8*)(lds + PG8_SA(b, h) + aoff + m * 2048 + k * 1024); } while (0)
#define PG8_LDB(dst, b, h) do { _Pragma("unroll") for (int n = 0; n < 2; ++n) _Pragma("unroll") for (int k = 0; k < 2; ++k) dst[n][k] = *(const PG8_LAS bf16x8*)(lds + PG8_SB(b, h) + boff + n * 2048 + k * 1024); } while (0)
#define PG8_MMA(ai, bj, At, Bt) do { __builtin_amdgcn_s_setprio(1); _Pragma("unroll") for (int m = 0; m < 4; ++m) _Pragma("unroll") for (int n = 0; n < 2; ++n) _Pragma("unroll") for (int k = 0; k < 2; ++k) \
        acc[ai][bj][m][n] = __builtin_amdgcn_mfma_f32_16x16x32_bf16(Bt[n][k], At[m][k], acc[ai][bj][m][n], 0, 0, 0); __builtin_amdgcn_s_setprio(0); } while (0)
#define PG8_WAIT_V(n) asm volatile("s_waitcnt vmcnt(" #n ")" ::: "memory")
#define PG8_WAIT_L(n) asm volatile("s_waitcnt lgkmcnt(" #n ")" ::: "memory")
#define PG8_BAR __builtin_amdgcn_s_barrier()
#define PG8_SCHED __builtin_amdgcn_sched_barrier(0)
    Unit cur, nxt; int ui = 0;
    if (!S.next(0, cur)) return;
    f32x4 acc[2][2][4][2];
#pragma unroll
    for (int a = 0; a < 2; ++a)
#pragma unroll
        for (int b = 0; b < 2; ++b)
#pragma unroll
            for (int m = 0; m < 4; ++m)
#pragma unroll
                for (int n = 0; n < 2; ++n) acc[a][b][m][n] = (f32x4){0.f, 0.f, 0.f, 0.f};
    bf16x8 At[4][2], B0[2][2], B1[2][2];
    const char* cA = (const char*)g.A + (GATHER ? (size_t)0 : (size_t)cur.pm * tstep); const char* cB = (const char*)g.Bt + (size_t)cur.pn * tstep;
    if constexpr (GATHER) PG8_GLOOK(cur, vA0, vA1);
    S.a_ready(cur);
    if constexpr (SP2) {
        PG8_STAGE(PG8_SB(0, 0), cB, voffB); PG8_STAGE(PG8_SB(0, 1), cB + hstep, voffB);
        if constexpr (GATHER) { PG8_STAGE(PG8_SA(0, 0), cA, vA0); PG8_STAGE(PG8_SA(0, 1), cA, vA1); } else { PG8_STAGE(PG8_SA(0, 0), cA, voffA); PG8_STAGE(PG8_SA(0, 1), cA + hstep, voffA); }
        if (wr == 1) PG8_BAR;
        PG8_WAIT_V(2); PG8_BAR;
        PG8_STAGE(PG8_SB(1, 0), cB + kstep, voffB); if constexpr (GATHER) PG8_STAGE(PG8_SA(1, 0), cA + kstep, vA0); else PG8_STAGE(PG8_SA(1, 0), cA + kstep, voffA); PG8_STAGE(PG8_SB(1, 1), cB + hstep + kstep, voffB);
        PG8_WAIT_V(6); PG8_BAR;
    } else {
        PG8_STAGE(PG8_SB(0, 0), cB, voffB); PG8_STAGE(PG8_SA(0, 0), cA, voffA); PG8_STAGE(PG8_SB(0, 1), cB + hstep, voffB); PG8_STAGE(PG8_SA(0, 1), cA + hstep, voffA);
        if (wr == 1) PG8_BAR;
        PG8_WAIT_V(4); PG8_BAR;
        PG8_STAGE(PG8_SB(1, 0), cB + kstep, voffB); PG8_STAGE(PG8_SA(1, 0), cA + kstep, voffA); PG8_STAGE(PG8_SB(1, 1), cB + hstep + kstep, voffB);
        PG8_WAIT_V(6); PG8_BAR;
    }
    for (;;) {
        const bool has_next = S.next(ui + 1, nxt);
        const char* nA = (has_next && !GATHER) ? (const char*)g.A + (size_t)nxt.pm * tstep : cA; const char* nB = has_next ? (const char*)g.Bt + (size_t)nxt.pn * tstep : cB;
        if constexpr (GATHER) { if (has_next) PG8_GLOOK(nxt, nvA0, nvA1); else { nvA0[0] = vA0[0]; nvA0[1] = vA0[1]; nvA1[0] = vA1[0]; nvA1[1] = vA1[1]; } }
#pragma unroll 1
        for (int t = 0; t < nt; t += 2) {
            const bool last = (t == nt - 2);
            const char* a1 = cA + (size_t)(t + 1) * kstep;
            const char* a2 = last ? nA : cA + (size_t)(t + 2) * kstep; const char* b2 = last ? nB : cB + (size_t)(t + 2) * kstep;
            const char* a3 = a2 + kstep; const char* b3 = b2 + kstep;
            if (last && has_next) S.a_ready(nxt);
            if constexpr (SP2) {
            PG8_LDB(B0, 0, 0); PG8_LDB(B1, 0, 1); PG8_SCHED; PG8_LDA(At, 0, 0); if constexpr (GATHER) PG8_STAGE(PG8_SA(1, 1), a1, vA1); else PG8_STAGE(PG8_SA(1, 1), a1 + hstep, voffA);
            PG8_WAIT_V(8); PG8_WAIT_L(0); PG8_BAR; PG8_MMA(0, 0, At, B0); PG8_MMA(0, 1, At, B1); PG8_BAR; PG8_SCHED;
            PG8_LDA(At, 0, 1); PG8_STAGE(PG8_SB(0, 0), b2, voffB); PG8_STAGE(PG8_SB(0, 1), b2 + hstep, voffB); if constexpr (GATHER) { unsigned v_[2] = {last ? nvA0[0] : vA0[0], last ? nvA0[1] : vA0[1]}; PG8_STAGE(PG8_SA(0, 0), a2, v_); } else PG8_STAGE(PG8_SA(0, 0), a2, voffA);
            PG8_WAIT_V(8); PG8_WAIT_L(0); PG8_BAR; PG8_MMA(1, 0, At, B0); PG8_MMA(1, 1, At, B1); PG8_BAR; PG8_SCHED;
            PG8_LDB(B0, 1, 0); PG8_LDB(B1, 1, 1); PG8_SCHED; PG8_LDA(At, 1, 0); if constexpr (GATHER) { unsigned v_[2] = {last ? nvA1[0] : vA1[0], last ? nvA1[1] : vA1[1]}; PG8_STAGE(PG8_SA(0, 1), a2, v_); } else PG8_STAGE(PG8_SA(0, 1), a2 + hstep, voffA);
            PG8_WAIT_V(8); PG8_WAIT_L(0); PG8_BAR; PG8_MMA(0, 0, At, B0); PG8_MMA(0, 1, At, B1); PG8_BAR; PG8_SCHED;
            PG8_LDA(At, 1, 1); PG8_STAGE(PG8_SB(1, 0), b3, voffB); PG8_STAGE(PG8_SB(1, 1), b3 + hstep, voffB); if constexpr (GATHER) { unsigned v_[2] = {last ? nvA0[0] : vA0[0], last ? nvA0[1] : vA0[1]}; PG8_STAGE(PG8_SA(1, 0), a3, v_); } else PG8_STAGE(PG8_SA(1, 0), a3, voffA);
            PG8_WAIT_V(8); PG8_WAIT_L(0); PG8_BAR; PG8_MMA(1, 0, At, B0); PG8_MMA(1, 1, At, B1); PG8_BAR; PG8_SCHED;
            } else {
            PG8_LDB(B0, 0, 0); PG8_SCHED; PG8_LDA(At, 0, 0); PG8_STAGE(PG8_SA(1, 1), a1 + hstep, voffA);
            PG8_WAIT_L(8); PG8_BAR; PG8_WAIT_L(0); PG8_MMA(0, 0, At, B0); PG8_BAR; PG8_SCHED;
            PG8_LDB(B1, 0, 1); PG8_STAGE(PG8_SB(0, 0), b2, voffB);
            PG8_BAR; PG8_WAIT_L(0); PG8_MMA(0, 1, At, B1); PG8_BAR;
            PG8_LDA(At, 0, 1); PG8_STAGE(PG8_SA(0, 0), a2, voffA);
            PG8_BAR; PG8_WAIT_L(0); PG8_MMA(1, 0, At, B0); PG8_BAR; PG8_SCHED;
            PG8_STAGE(PG8_SB(0, 1), b2 + hstep, voffB);
            PG8_WAIT_V(6); PG8_BAR; PG8_MMA(1, 1, At, B1); PG8_BAR;
            PG8_LDB(B0, 1, 0); PG8_SCHED; PG8_LDA(At, 1, 0); PG8_STAGE(PG8_SA(0, 1), a2 + hstep, voffA);
            PG8_WAIT_L(8); PG8_BAR; PG8_WAIT_L(0); PG8_MMA(0, 0, At, B0); PG8_BAR; PG8_SCHED;
            PG8_LDB(B1, 1, 1); PG8_STAGE(PG8_SB(1, 0), b3, voffB);
            PG8_BAR; PG8_WAIT_L(0); PG8_MMA(0, 1, At, B1); PG8_BAR;
            PG8_LDA(At, 1, 1); PG8_STAGE(PG8_SA(1, 0), a3, voffA);
            PG8_BAR; PG8_WAIT_L(0); PG8_MMA(1, 0, At, B0); PG8_BAR; PG8_SCHED;
            PG8_STAGE(PG8_SB(1, 1), b3 + hstep, voffB);
            PG8_WAIT_V(6); PG8_BAR; PG8_MMA(1, 1, At, B1); PG8_BAR;
            }
        }
        if constexpr (ALIGN_EPI) { if (wr == 0) PG8_BAR; }
        if constexpr (!Epi::AFTER_DRAIN) { E(acc, cur, wr, wc, fr, fq); S.done(cur); }
        if (!has_next) break;
#pragma unroll
        for (int a = 0; a < 2; ++a)
#pragma unroll
            for (int b = 0; b < 2; ++b)
#pragma unroll
                for (int m = 0; m < 4; ++m)
#pragma unroll
                    for (int n = 0; n < 2; ++n) acc[a][b][m][n] = (f32x4){0.f, 0.f, 0.f, 0.f};
        cur = nxt; cA = nA; cB = nB; ++ui;
        if constexpr (GATHER) { vA0[0] = nvA0[0]; vA0[1] = nvA0[1]; vA1[0] = nvA1[0]; vA1[1] = nvA1[1]; }
        if constexpr (ALIGN_EPI) { if (wr == 1) PG8_BAR; }
    }
    PG8_WAIT_V(0);
    if constexpr (!ALIGN_EPI) { if (wr == 0) PG8_BAR; }
    PG8_BAR;
    if constexpr (Epi::AFTER_DRAIN) { E.fused(acc, cur, wr, wc, fr, fq, lds, wid, lane); S.done(cur); }
#undef PG8_GLOOK
#undef PG8_SA
#undef PG8_SB
#undef PG8_STAGE
#undef PG8_LDA
#undef PG8_LDB
#undef PG8_MMA
#undef PG8_WAIT_V
#undef PG8_WAIT_L
#undef PG8_BAR
#undef PG8_SCHED
}
}
#define GAS __attribute__((address_space(1)))
#define LAS __attribute__((address_space(3)))
typedef unsigned short bf16;
typedef unsigned v4u __attribute__((ext_vector_type(4)));
typedef float f32x4 __attribute__((ext_vector_type(4)));
typedef short bf16x8 __attribute__((ext_vector_type(8)));
typedef GAS unsigned gu32;
typedef GAS unsigned long long gu64;
#define RLX_AGENT __ATOMIC_RELAXED, __HIP_MEMORY_SCOPE_AGENT
#define LDS_WAIT() asm volatile("s_waitcnt lgkmcnt(0)" ::: "memory")
#define VM_WAIT() asm volatile("s_waitcnt vmcnt(0)" ::: "memory")
__device__ __forceinline__ unsigned long long rt() { return __builtin_amdgcn_s_memrealtime(); }
__device__ __forceinline__ unsigned f2bf(float f) { unsigned u = __builtin_bit_cast(unsigned, f); return (u + 0x7fffu + ((u >> 16) & 1u)) >> 16; }
__device__ __forceinline__ unsigned pk2(float lo, float hi) { return f2bf(lo) | (f2bf(hi) << 16); }

#define XB_TMO      128
#define XB_XCNT(j)  (256  + 64 * (j))
#define XB_XSUB(j)  (1280 + 64 * (j))
#define XB_XGEN(j)  (2304 + 64 * (j))
#define XB_TOP      3328
#define XB_TOPGEN   3392
#define XCD_BAR_WORDS 3456
#define XB_SPIN_CAP (1u << 18)

__device__ __forceinline__ unsigned xb_ld(unsigned* p)              { return __hip_atomic_load(p, __ATOMIC_RELAXED, __HIP_MEMORY_SCOPE_AGENT); }
__device__ __forceinline__ unsigned xb_add(unsigned* p, unsigned v) { return __hip_atomic_fetch_add(p, v, __ATOMIC_RELAXED, __HIP_MEMORY_SCOPE_AGENT); }
__device__ __forceinline__ unsigned xb_xcc_id() { return (unsigned)__builtin_amdgcn_s_getreg((3 << 11) | 20) & 0xFu; }
#define XB_SPIN(cond, bar) do { unsigned _sp = 0; while (cond) { __builtin_amdgcn_s_sleep(1); \
    if ((++_sp & 255u) == 0u) { if (xb_ld(&(bar)[XB_TMO])) break; if (_sp > XB_SPIN_CAP) { atomicAdd(&(bar)[XB_TMO], 1u); break; } } } } while (0)

struct XcdBarrier {
    unsigned* bar; unsigned x;
    volatile LAS unsigned* st;
};

__device__ __forceinline__ XcdBarrier xcd_barrier_post(unsigned* bar, volatile LAS unsigned* st) {
    XcdBarrier b; b.bar = bar; b.x = xb_xcc_id(); b.st = st;
    if (threadIdx.x == 0) (void)xb_add(&bar[XB_XCNT(b.x)], 1u);
    return b;
}
__device__ __forceinline__ void xcd_barrier_complete(unsigned* bar, unsigned x, unsigned& nloc, unsigned& nx) {
    const unsigned G = gridDim.x * gridDim.y * gridDim.z;
    unsigned sum, cnt, mine, sp = 0u;
    for (;;) {
        sum = 0u; cnt = 0u; mine = 0u;
#pragma unroll
        for (unsigned j = 0; j < 16; ++j) { const unsigned c = xb_ld(&bar[XB_XCNT(j)]); sum += c; cnt += (c > 0u) ? 1u : 0u; mine = (j == x) ? c : mine; }
        if (sum == G) break;
        __builtin_amdgcn_s_sleep(1);
        if ((++sp & 255u) == 0u) { if (xb_ld(&bar[XB_TMO])) break; if (sp > XB_SPIN_CAP) { atomicAdd(&bar[XB_TMO], 1u); break; } }
    }
    nloc = mine > 0u ? mine : 1u; nx = cnt > 0u ? cnt : 1u;
}

__device__ __forceinline__ void xcd_barrier(const XcdBarrier& b) {
    asm volatile("s_waitcnt vmcnt(0)" ::: "memory");
    __syncthreads();
    if (threadIdx.x == 0) {
        unsigned* bar = b.bar;
        __builtin_amdgcn_s_waitcnt(0);
        unsigned nloc = b.st[0], nx = b.st[1];
        if (nloc == 0u) { xcd_barrier_complete(bar, b.x, nloc, nx); b.st[0] = nloc; b.st[1] = nx; }
        const unsigned old = xb_add(&bar[XB_XSUB(b.x)], 1u);
        const unsigned gen = old / nloc;
        if (old + 1u == (gen + 1u) * nloc) {
            __builtin_amdgcn_fence(__ATOMIC_RELEASE, "agent");
            asm volatile("s_waitcnt vmcnt(0)" ::: "memory");
            const unsigned og = xb_add(&bar[XB_TOP], 1u);
            const unsigned tg = og / nx;
            if (og + 1u == (tg + 1u) * nx) xb_add(&bar[XB_TOPGEN], 1u);
            else XB_SPIN(xb_ld(&bar[XB_TOPGEN]) == tg, bar);
            __builtin_amdgcn_fence(__ATOMIC_ACQUIRE, "agent");
            xb_add(&bar[XB_XGEN(b.x)], 1u);
            asm volatile("s_waitcnt vmcnt(0)" ::: "memory");
        } else {
            XB_SPIN(xb_ld(&bar[XB_XGEN(b.x)]) == gen, bar);
            __builtin_amdgcn_fence(__ATOMIC_ACQUIRE, "agent");
            asm volatile("s_waitcnt vmcnt(0)" ::: "memory");
        }
    }
    __syncthreads();
}
constexpr int NWAVES = 8, NTHR = NWAVES * 64;
constexpr int D = 1024, BATCH = 4, SEQ = 4096, M = BATCH * SEQ, DEPTH = 4;
constexpr int IN_COLS = 6680, NPROJ = 6912;
constexpr int O_Z = 0, O_XBC = 1024, O_DT = 2560, O_QKV = 2576, O_GG = 4112, O_GB = 4624, O_GA = 4628, O_HQ = 4632, O_HF = 5144, O_HI = 5656, O_HG = 6168;
constexpr int DMIX = 2048, NEXP = 16, DEXP = 256, NGU = NEXP * 2 * DEXP  , KDN = NEXP * DEXP  ;
constexpr float DN_ALPHA = 1.6817928305074290f;
constexpr float LN_EPS = 1e-5f;

constexpr size_t MiB = 1u << 20;
constexpr size_t WS_CTL = 0, CTL_ZERO_BYTES = 1 * MiB;
constexpr size_t WS_LTOK = 2 * MiB;
constexpr size_t WS_LW = 3 * MiB;
constexpr size_t WS_SLOT = 4 * MiB;
constexpr size_t WS_WSORT = 5 * MiB;
constexpr size_t WS_WIN = 8 * MiB;
constexpr size_t WS_WOUT = 22 * MiB;
constexpr size_t WS_WGU = 26 * MiB;
constexpr size_t WS_WDN = 42 * MiB;
constexpr size_t WS_YMIX = 52 * MiB;
constexpr size_t WS_HB = WS_YMIX;
constexpr size_t WS_PROJ = 116 * MiB;
constexpr size_t WS_MIX = WS_PROJ;
constexpr int MAXROWS = 2 * M + 16 * 256;
constexpr size_t WS_XS = WS_PROJ + 64 * MiB;
constexpr size_t WS_HS = WS_PROJ + 136 * MiB;
constexpr size_t WS_YS = WS_PROJ + 154 * MiB;
constexpr int CW_CNT = 8192;
constexpr int LDS_OFF_TAB = 131072 + 1024;
constexpr size_t WS_SCR = 332 * MiB;
constexpr size_t WS_HG_QG = WS_SCR;
constexpr size_t WS_HG_KDT = WS_SCR + 16 * MiB;
constexpr size_t WS_HG_A = WS_SCR + 32 * MiB;
constexpr size_t WS_HG_GL = WS_SCR + 40 * MiB;
constexpr size_t WS_SSD_C = WS_SCR + 41 * MiB;
constexpr size_t WS_SSD_BT = WS_SCR + 49 * MiB;
constexpr size_t WS_SSD_CB = WS_SCR + 57 * MiB;
constexpr size_t WS_SSD_XT = WS_SCR + 65 * MiB;
constexpr size_t WS_SSD_AC = WS_SCR + 97 * MiB;
constexpr size_t WS_SSD_DT = WS_SCR + 98 * MiB;
constexpr size_t WS_GD_K = WS_SCR + 99 * MiB;
constexpr size_t WS_GD_KT = WS_SCR + 115 * MiB;
constexpr size_t WS_GD_QG = WS_SCR + 131 * MiB;
constexpr size_t WS_GD_VT = WS_SCR + 147 * MiB;
constexpr size_t WS_GD_T = WS_SCR + 163 * MiB;
constexpr size_t WS_GD_QK = WS_SCR + 171 * MiB;
constexpr size_t WS_GD_VEC = WS_SCR + 179 * MiB;
constexpr size_t WS_END = 512 * MiB;
constexpr int CW_BAR = 4096;

constexpr int RING_OFF = 0, RING_BYTES = 131072;
constexpr int LDSCTL_OFF = RING_BYTES, MISC_OFF = LDSCTL_OFF + 320;
constexpr int LDS_BYTES = 147456;

__device__ __forceinline__ float bf2f(unsigned short b) { return __builtin_bit_cast(float, ((unsigned)b) << 16); }
__device__ __forceinline__ float bflo(unsigned w) { return __builtin_bit_cast(float, w << 16); }
__device__ __forceinline__ float bfhi(unsigned w) { return __builtin_bit_cast(float, w & 0xffff0000u); }
__device__ __forceinline__ float siluf(float x) { return x / (1.0f + __expf(-x)); }
__device__ __forceinline__ float sigmoidf_(float x) { return 1.0f / (1.0f + __expf(-x)); }
__device__ __forceinline__ float softplusf_(float x) { return x > 20.f ? x : log1pf(__expf(x)); }
#define DPP_ADD(v, ctrl) ((v) + __builtin_bit_cast(float, __builtin_amdgcn_update_dpp(0, __builtin_bit_cast(int, (v)), (ctrl), 0xf, 0xf, false)))
__device__ __forceinline__ float wave_sum(float v) {
    v = DPP_ADD(v, 0xB1);
    v = DPP_ADD(v, 0x4E);
    v = DPP_ADD(v, 0x141);
    v = DPP_ADD(v, 0x140);
    const int iv = __builtin_bit_cast(int, v);
    return (__builtin_bit_cast(float, __builtin_amdgcn_readlane(iv, 0)) + __builtin_bit_cast(float, __builtin_amdgcn_readlane(iv, 16))) + (__builtin_bit_cast(float, __builtin_amdgcn_readlane(iv, 32)) + __builtin_bit_cast(float, __builtin_amdgcn_readlane(iv, 48)));
}
__device__ __forceinline__ float row16_sum(float v) {
    v = DPP_ADD(v, 0xB1); v = DPP_ADD(v, 0x4E); v = DPP_ADD(v, 0x141); v = DPP_ADD(v, 0x140); return v;
}

struct Args {
    const float* in[25]; float* out; unsigned char* ws; int ph_lo, ph_hi;
};
typedef const __attribute__((address_space(4))) Args* CArgs;
#define ARGS_HERE() ([]() { CArgs p_ = (CArgs)__builtin_amdgcn_kernarg_segment_ptr(); asm volatile("" : "+s"(p_)); return p_; }())
enum { I_X = 0, I_WIN, I_SCW, I_SCB, I_SDTB, I_SALOG, I_SD, I_SNW, I_GCW, I_GDTB, I_GALOG, I_GNW, I_HLB, I_HNW, I_WOUT, I_LN1G, I_LN1B, I_WRG, I_BRG, I_WRE, I_BRE, I_WGU, I_WDN, I_LN2G, I_LN2B };

__device__ __forceinline__ void transpose_item(const float* W, int ldw, int nvalid, int k0, int n0, bf16* WT, size_t ldt, int drow0, int dk0, LAS float* scr, int lane) {
#pragma unroll 8
    for (int i = 0; i < 32; ++i) { const int kk = 2 * i + (lane >> 5), nn = lane & 31, n = n0 + nn; scr[kk * 33 + nn] = (n < nvalid) ? W[(size_t)(k0 + kk) * ldw + n] : 0.f; }
    LDS_WAIT(); asm volatile("" ::: "memory");
    const int c = lane & 7;
#pragma unroll
    for (int j = 0; j < 4; ++j) { const int n = (lane >> 3) + 8 * j; const LAS float* s = scr + (8 * c) * 33 + n;
        v4u o; o.x = pk2(s[0 * 33], s[1 * 33]); o.y = pk2(s[2 * 33], s[3 * 33]); o.z = pk2(s[4 * 33], s[5 * 33]); o.w = pk2(s[6 * 33], s[7 * 33]);
        *(GAS v4u*)(WT + (size_t)(drow0 + n) * ldt + dk0 + k0 + 8 * c) = o; }
    LDS_WAIT(); asm volatile("" ::: "memory");
}
__device__ __forceinline__ void weights_phase(CArgs a, int l, const int which, LAS unsigned char* lds, int wwg, int nwg, int tid) {
    asm volatile("" : "+v"(tid));
    const int lane = tid & 63, wave = tid >> 6, gw = wwg * NWAVES + wave, NGW = nwg * NWAVES;
    LAS float* scr = (LAS float*)(lds + wave * 16384);
    constexpr int I_IN = 16 * (NPROJ / 32), I_OUT = (DMIX / 64) * (D / 32), I_GU = NEXP * 16 * 16, I_DN = NEXP * 4 * 32;
    const int n_in = (which & 1) ? I_IN : 0, n_out = (which & 2) ? I_OUT : 0, n_gu = (which & 4) ? I_GU : 0, n_dn = (which & 8) ? I_DN : 0;
    unsigned char* ws = a->ws;
    for (int it = gw; it < n_in + n_out + n_gu + n_dn; it += NGW) {
        int r = it;
        if (r < n_in) { const int kb = r / (NPROJ / 32), nb = r % (NPROJ / 32);
            transpose_item(a->in[I_WIN] + (size_t)l * D * IN_COLS, IN_COLS, IN_COLS, 64 * kb, 32 * nb, (bf16*)(ws + WS_WIN), D, 32 * nb, 0, scr, lane); continue; }
        r -= n_in;
        if (r < n_out) { const int kb = r / (D / 32), nb = r % (D / 32);
            transpose_item(a->in[I_WOUT] + (size_t)l * DMIX * D, D, D, 64 * kb, 32 * nb, (bf16*)(ws + WS_WOUT), DMIX, 32 * nb, 0, scr, lane); continue; }
        r -= n_out;
        if (r < n_gu) { const int e = r / 256, q = r % 256, kb = q / 16, nb = q % 16, c0 = 32 * nb, bj = c0 / 256, hf = (c0 % 256) / 128, j0 = c0 % 128;
            transpose_item(a->in[I_WGU] + (size_t)(l * NEXP + e) * D * 512, 512, 512, 64 * kb, c0, (bf16*)(ws + WS_WGU), D, e * 512 + hf * 256 + bj * 128 + j0, 0, scr, lane); continue; }
        r -= n_gu;
        { const int e = r / 128, q = r % 128, kb = q / 32, nb = q % 32;
            transpose_item(a->in[I_WDN] + (size_t)(l * NEXP + e) * DEXP * D, D, D, 64 * kb, 32 * nb, (bf16*)(ws + WS_WDN), DEXP, e * D + 32 * nb, 0, scr, lane); }
    }
}
__device__ __forceinline__ void p0_prologue(CArgs a, LAS unsigned char* lds, int wg, int G, int tid) {
    asm volatile("" : "+v"(tid));
    const f32x4* x4 = (const f32x4*)a->in[I_X]; f32x4* h4 = (f32x4*)a->out; unsigned long long* hb8 = (unsigned long long*)(a->ws + WS_HB);
    for (size_t i = (size_t)wg * NTHR + tid; i < (size_t)M * D / 4; i += (size_t)G * NTHR) { const f32x4 v = x4[i]; h4[i] = v;
        hb8[i] = (unsigned long long)pk2(v.x, v.y) | ((unsigned long long)pk2(v.z, v.w) << 32); }
}

#define WG_BAR() do { asm volatile("s_waitcnt lgkmcnt(0)" ::: "memory"); __builtin_amdgcn_s_barrier(); asm volatile("" ::: "memory"); } while (0)
__device__ __forceinline__ f32x4 mfma16(bf16x8 x, bf16x8 y, f32x4 c) { return __builtin_amdgcn_mfma_f32_16x16x32_bf16(x, y, c, 0, 0, 0); }
__device__ __forceinline__ bf16x8 lds_frag(const LAS bf16* base, int row0, int stride, int k0, int lane) { return *(const LAS bf16x8*)(base + (row0 + (lane & 15)) * stride + k0 + 8 * (lane >> 4)); }
__device__ __forceinline__ bf16x8 pack8(const float* v) { v4u w; w.x = pk2(v[0], v[1]); w.y = pk2(v[2], v[3]); w.z = pk2(v[4], v[5]); w.w = pk2(v[6], v[7]); return __builtin_bit_cast(bf16x8, w); }
__device__ __forceinline__ unsigned long long pack4(f32x4 v) { return (unsigned long long)pk2(v[0], v[1]) | ((unsigned long long)pk2(v[2], v[3]) << 32); }

__device__ __forceinline__ void hgrn_prep_phase(CArgs a, int l, LAS unsigned char* lds, int wg, int G, int tid) {
    asm volatile("" : "+v"(tid));
    constexpr int LS = 132;
    LAS float* sQ = (LAS float*)lds; LAS float* sK = sQ + 64 * LS; LAS float* sB = sK + 64 * LS; LAS float* sT = sB + 64 * LS; LAS float* sLb = sT + 512;
    const bf16* PROJ = (const bf16*)(a->ws + WS_PROJ);
    const int lane = tid & 63, w = tid >> 6, r = lane & 15, q4 = lane >> 4;
    for (int unit = wg; unit < 1024; unit += G) {
        const int b = unit >> 8, head = (unit >> 6) & 3, c = unit & 63;
        const size_t row0 = (size_t)b * SEQ + c * 64;
        __syncthreads();
        if (tid < 128) {
            const int ch = head * 128 + tid; float lg[DEPTH], mx = -1e30f;
#pragma unroll
            for (int j = 0; j < DEPTH; ++j) { lg[j] = a->in[I_HLB][j * 512 + ch]; mx = fmaxf(mx, lg[j]); }
            float den = 0.f, num = 0.f;
#pragma unroll
            for (int j = 0; j < DEPTH; ++j) { const float e = __expf(lg[j] - mx); den += e; if (j >= 1 && j <= l) num += e; }
            sLb[tid] = num / den;
        }
        __syncthreads();
        for (int p = tid; p < 1024; p += NTHR) {
            const int t = p >> 4, d8 = (p & 15) * 8;
            const v4u qv = *(const GAS v4u*)(PROJ + (row0 + t) * NPROJ + O_HQ + head * 128 + d8), fv = *(const GAS v4u*)(PROJ + (row0 + t) * NPROJ + O_HF + head * 128 + d8);
#pragma unroll
            for (int i = 0; i < 4; ++i) {
                const int d = d8 + 2 * i; const float lb0 = sLb[d], lb1 = sLb[d + 1];
                sQ[t * LS + d] = siluf(bflo(qv[i])); sQ[t * LS + d + 1] = siluf(bfhi(qv[i]));
                const float f0 = lb0 + (1.f - lb0) * sigmoidf_(bflo(fv[i])), f1 = lb1 + (1.f - lb1) * sigmoidf_(bfhi(fv[i]));
                sK[t * LS + d] = 1.f - f0; sK[t * LS + d + 1] = 1.f - f1; sB[t * LS + d] = __logf(f0); sB[t * LS + d + 1] = __logf(f1);
            }
        }
        __syncthreads();
        {
            const int d = tid & 127, seg = tid >> 7; float run = 0.f, vals[16];
#pragma unroll
            for (int i = 0; i < 16; ++i) { run += sB[(seg * 16 + i) * LS + d]; vals[i] = run; }
            sT[seg * 128 + d] = run;
            __syncthreads();
            float off = 0.f;
#pragma unroll
            for (int s2 = 0; s2 < 3; ++s2) if (s2 < seg) off += sT[s2 * 128 + d];
#pragma unroll
            for (int i = 0; i < 16; ++i) sB[(seg * 16 + i) * LS + d] = vals[i] + off;
        }
        __syncthreads();
        bf16* qg = (bf16*)(a->ws + WS_HG_QG) + (size_t)unit * 64 * 128; bf16* kdt = (bf16*)(a->ws + WS_HG_KDT) + (size_t)unit * 128 * 64;
        bf16* am = (bf16*)(a->ws + WS_HG_A) + (size_t)unit * 64 * 64; float* gl = (float*)(a->ws + WS_HG_GL) + (size_t)unit * 128;
        for (int p = tid; p < 1024; p += NTHR) { const int t = p >> 4, d8 = (p & 15) * 8; float v[8];
#pragma unroll
            for (int jj = 0; jj < 8; ++jj) v[jj] = sQ[t * LS + d8 + jj] * __expf(sB[t * LS + d8 + jj]);
            *(GAS bf16x8*)(qg + t * 128 + d8) = pack8(v); }
        for (int p = tid; p < 1024; p += NTHR) { const int d = p >> 3, s8 = (p & 7) * 8; const float bl = sB[63 * LS + d]; float v[8];
#pragma unroll
            for (int jj = 0; jj < 8; ++jj) v[jj] = sK[(s8 + jj) * LS + d] * __expf(bl - sB[(s8 + jj) * LS + d]);
            *(GAS bf16x8*)(kdt + d * 64 + s8) = pack8(v); }
        if (tid < 128) gl[tid] = __expf(sB[63 * LS + tid]);
        for (int p = w; p < 16; p += NWAVES) {
            const int i = p >> 2, j = p & 3; f32x4 acc = {0.f, 0.f, 0.f, 0.f};
            if (j <= i) {
#pragma unroll
                for (int ks = 0; ks < 4; ++ks) { const int d0 = 32 * ks + 8 * q4, t = 16 * i + r, s_ = 16 * j + r; float qf[8], kf[8];
#pragma unroll
                    for (int jj = 0; jj < 8; ++jj) { const float ref = i ? sB[(16 * i - 1) * LS + d0 + jj] : 0.f;
                        qf[jj] = sQ[t * LS + d0 + jj] * __expf(sB[t * LS + d0 + jj] - ref); kf[jj] = sK[s_ * LS + d0 + jj] * __expf(ref - sB[s_ * LS + d0 + jj]); }
                    acc = mfma16(pack8(kf), pack8(qf), acc); }
                const int t = 16 * i + r;
#pragma unroll
                for (int ii = 0; ii < 4; ++ii) if (16 * j + 4 * q4 + ii > t) acc[ii] = 0.f;
            }
            *(GAS unsigned long long*)(am + (16 * i + r) * 64 + 16 * j + 4 * q4) = pack4(acc);
        }
    }
}
__device__ __forceinline__ void hgrn_scan_phase(CArgs a, int l, LAS unsigned char* lds, const int b, const int head, const int eb, int tid) {
    asm volatile("" : "+v"(tid));
    constexpr int QS = 136, KS = 72;
    constexpr int B_QG = 0, B_KDT = 17408, B_A = B_KDT + 18432, B_VT = B_A + 9216, B_GL = B_VT + 4608, BUF = B_GL + 512;
    LAS unsigned char* sST0 = lds + 2 * BUF;
    const bf16* PROJ = (const bf16*)(a->ws + WS_PROJ); bf16* YMIX = (bf16*)(a->ws + WS_YMIX);
    const int lane = tid & 63, w = tid >> 6, r = lane & 15, q4 = lane >> 4;
    {
        const size_t cu0 = (size_t)(b * 4 + head) * 64;
        const bf16* QG = (const bf16*)(a->ws + WS_HG_QG) + cu0 * 64 * 128; const bf16* KDT = (const bf16*)(a->ws + WS_HG_KDT) + cu0 * 128 * 64;
        const bf16* AM = (const bf16*)(a->ws + WS_HG_A) + cu0 * 64 * 64; const float* GL = (const float*)(a->ws + WS_HG_GL) + cu0 * 128;
        const bf16* VP = PROJ + (size_t)b * SEQ * NPROJ + O_HI + head * 128 + eb * 32;
        v4u rq[2], rk[2], ra, rv; f32x4 rg;
#define HG_LOAD(n) do { _Pragma("unroll") for (int i = 0; i < 2; ++i) { const int p = tid + NTHR * i; rq[i] = *(const GAS v4u*)(QG + (size_t)(n) * 8192 + (p >> 4) * 128 + (p & 15) * 8); \
            rk[i] = *(const GAS v4u*)(KDT + (size_t)(n) * 8192 + (p >> 3) * 64 + (p & 7) * 8); } \
            ra = *(const GAS v4u*)(AM + (size_t)(n) * 4096 + (tid >> 3) * 64 + (tid & 7) * 8); \
            if (tid < 256) rv = *(const GAS v4u*)(VP + (size_t)((n) * 64 + (tid >> 2)) * NPROJ + (tid & 3) * 8); \
            if (tid < 32) rg = *(const GAS f32x4*)(GL + (size_t)(n) * 128 + tid * 4); } while (0)
#define HG_STORE(bufp) do { LAS unsigned char* bp_ = (bufp); _Pragma("unroll") for (int i = 0; i < 2; ++i) { const int p = tid + NTHR * i; \
            *(LAS v4u*)(bp_ + B_QG + ((p >> 4) * QS + (p & 15) * 8) * 2) = rq[i]; *(LAS v4u*)(bp_ + B_KDT + ((p >> 3) * KS + (p & 7) * 8) * 2) = rk[i]; } \
            *(LAS v4u*)(bp_ + B_A + ((tid >> 3) * KS + (tid & 7) * 8) * 2) = ra; \
            if (tid < 256) { LAS bf16* vt = (LAS bf16*)(bp_ + B_VT); const int t_ = tid >> 2, e8 = (tid & 3) * 8; _Pragma("unroll") for (int i = 0; i < 4; ++i) { \
                vt[(e8 + 2 * i) * KS + t_] = (bf16)(rv[i] & 0xffffu); vt[(e8 + 2 * i + 1) * KS + t_] = (bf16)(rv[i] >> 16); } } \
            if (tid < 32) *(LAS f32x4*)(bp_ + B_GL + tid * 16) = rg; } while (0)
        __syncthreads();
        HG_LOAD(0);
        for (int i = tid; i < 8704 / 4; i += NTHR) ((LAS unsigned*)sST0)[i] = 0u;
        HG_STORE(lds);
        f32x4 accS[2] = {{0.f, 0.f, 0.f, 0.f}, {0.f, 0.f, 0.f, 0.f}};
        __syncthreads();
        for (int n = 0; n < 64; ++n) {
            const int cur = n & 1; LAS unsigned char* bp = lds + cur * BUF; LAS bf16* sST = (LAS bf16*)(sST0 + cur * 8704); LAS bf16* sSTn = (LAS bf16*)(sST0 + (cur ^ 1) * 8704);
            if (n + 1 < 64) HG_LOAD(n + 1);
            {
                const int tt = w >> 1, et = w & 1; f32x4 acc = {0.f, 0.f, 0.f, 0.f};
#pragma unroll
                for (int ks = 0; ks < 4; ++ks) acc = mfma16(lds_frag(sST, 16 * et, QS, 32 * ks, lane), lds_frag((LAS bf16*)(bp + B_QG), 16 * tt, QS, 32 * ks, lane), acc);
#pragma unroll
                for (int ks = 0; ks < 2; ++ks) acc = mfma16(lds_frag((LAS bf16*)(bp + B_VT), 16 * et, KS, 32 * ks, lane), lds_frag((LAS bf16*)(bp + B_A), 16 * tt, KS, 32 * ks, lane), acc);
                *(GAS unsigned long long*)(YMIX + ((size_t)b * SEQ + n * 64 + 16 * tt + r) * DMIX + 1536 + head * 128 + eb * 32 + 16 * et + 4 * q4) = pack4(acc);
            }
            {
                const f32x4 glv = *(const LAS f32x4*)(bp + B_GL + (16 * w + 4 * q4) * 4);
#pragma unroll
                for (int et = 0; et < 2; ++et) { accS[et] = accS[et] * glv;
#pragma unroll
                    for (int ks = 0; ks < 2; ++ks) accS[et] = mfma16(lds_frag((LAS bf16*)(bp + B_KDT), 16 * w, KS, 32 * ks, lane), lds_frag((LAS bf16*)(bp + B_VT), 16 * et, KS, 32 * ks, lane), accS[et]);
                    *(LAS unsigned long long*)(sSTn + (16 * et + r) * QS + 16 * w + 4 * q4) = pack4(accS[et]); }
            }
            if (n + 1 < 64) HG_STORE(lds + (cur ^ 1) * BUF);
            WG_BAR();
        }
#undef HG_LOAD
#undef HG_STORE
    }
}

__device__ __forceinline__ void ssd_rec_phase(CArgs a, int l, LAS unsigned char* lds, int wg, int G, int tid) {
    asm volatile("" : "+v"(tid));
    constexpr int TB = 64;
    LAS float* sX = (LAS float*)lds; LAS float* sB = sX + TB * 16; LAS float* sC = sB + TB * 128; LAS float* sDt = sC + TB * 128; LAS float* sDa = sDt + TB; LAS float* sY = sDa + TB;
    const bf16* PROJ = (const bf16*)(a->ws + WS_PROJ); bf16* YMIX = (bf16*)(a->ws + WS_YMIX);
    const float* cw = a->in[I_SCW] + (size_t)l * 4 * 1536; const float* cb = a->in[I_SCB] + (size_t)l * 1536;
    const int p_local = tid >> 5, nq = tid & 31;
    for (int unit = wg; unit < 256; unit += G) {
        const int b = unit >> 6, head = (unit >> 2) & 15, pq = unit & 3, g = head >> 3;
        const float A = -__expf(a->in[I_SALOG][l * 16 + head]), dtb = a->in[I_SDTB][l * 16 + head], Dsk = a->in[I_SD][l * 16 + head];
        float h0 = 0.f, h1 = 0.f, h2 = 0.f, h3 = 0.f;
        for (int t0 = 0; t0 < SEQ; t0 += TB) {
            __syncthreads();
            for (int idx = tid; idx < TB * 272; idx += NTHR) {
                const int tt = idx / 272, ci = idx % 272, t = t0 + tt;
                const int ch = ci < 16 ? head * 64 + pq * 16 + ci : (ci < 144 ? 1024 + g * 128 + (ci - 16) : 1280 + g * 128 + (ci - 144));
                float acc = cb[ch];
#pragma unroll
                for (int k = 0; k < 4; ++k) { const int ts = t - 3 + k; if (ts >= 0) acc += cw[k * 1536 + ch] * bf2f(PROJ[(size_t)(b * SEQ + ts) * NPROJ + O_XBC + ch]); }
                const float v = siluf(acc);
                if (ci < 16) sX[tt * 16 + ci] = v; else if (ci < 144) sB[tt * 128 + ci - 16] = v; else sC[tt * 128 + ci - 144] = v;
            }
            if (tid < TB) { const float raw = bf2f(PROJ[(size_t)(b * SEQ + t0 + tid) * NPROJ + O_DT + head]); const float dt = softplusf_(raw + dtb); sDt[tid] = dt; sDa[tid] = __expf(dt * A); }
            __syncthreads();
#pragma unroll 4
            for (int tt = 0; tt < TB; ++tt) {
                const float xv = sX[tt * 16 + p_local], da = sDa[tt], dx = sDt[tt] * xv;
                const f32x4 Bv = *(const LAS f32x4*)(sB + tt * 128 + nq * 4), Cv = *(const LAS f32x4*)(sC + tt * 128 + nq * 4);
                h0 = da * h0 + dx * Bv.x; h1 = da * h1 + dx * Bv.y; h2 = da * h2 + dx * Bv.z; h3 = da * h3 + dx * Bv.w;
                float part = (Cv.x * h0 + Cv.y * h1) + (Cv.z * h2 + Cv.w * h3);
                part += __shfl_xor(part, 1); part += __shfl_xor(part, 2); part += __shfl_xor(part, 4); part += __shfl_xor(part, 8); part += __shfl_xor(part, 16);
                if (nq == 0) sY[tt * 16 + p_local] = part + Dsk * xv;
            }
            __syncthreads();
            for (int idx = tid; idx < TB * 16; idx += NTHR) { const int tt = idx >> 4, i = idx & 15; YMIX[(size_t)(b * SEQ + t0 + tt) * DMIX + head * 64 + pq * 16 + i] = (bf16)f2bf(sY[idx]); }
        }
    }
}

__device__ __forceinline__ void ssd_prep_phase(CArgs a, int l, LAS unsigned char* lds, int wg, int G, int tid) {
    asm volatile("" : "+v"(tid));
    constexpr int PS = 136;
    LAS bf16* sB = (LAS bf16*)lds; LAS bf16* sC = sB + 128 * PS; LAS bf16* sXT = (LAS bf16*)lds; LAS float* sDt = (LAS float*)(lds + 2 * 128 * PS * 2); LAS bf16* sCB = (LAS bf16*)(lds + 2 * 128 * PS * 2 + 4096);
    const bf16* PROJ = (const bf16*)(a->ws + WS_PROJ);
    const float* cw = a->in[I_SCW] + (size_t)l * 4 * 1536; const float* cb = a->in[I_SCB] + (size_t)l * 1536;
    const int lane = tid & 63, w = tid >> 6, r = lane & 15, q4 = lane >> 4;
    for (int unit = wg; unit < 256; unit += G) {
        const int b = unit >> 6, c = (unit >> 1) & 31, g = unit & 1;
        const size_t row0 = (size_t)b * SEQ + c * 128;
        bf16* Cg = (bf16*)(a->ws + WS_SSD_C) + (size_t)unit * 16384; bf16* BTg = (bf16*)(a->ws + WS_SSD_BT) + (size_t)unit * 16384; bf16* CBg = (bf16*)(a->ws + WS_SSD_CB) + (size_t)unit * 16384;
        __syncthreads();
        {
            const int c16 = tid & 31, l0 = tid >> 5; const int ch = (c16 < 16 ? 1024 + g * 128 + c16 * 8 : 1280 + g * 128 + (c16 - 16) * 8);
            float wk[4][8], bias[8];
#pragma unroll
            for (int jj = 0; jj < 8; ++jj) { bias[jj] = cb[ch + jj];
#pragma unroll
                for (int k = 0; k < 4; ++k) wk[k][jj] = cw[k * 1536 + ch + jj]; }
            LAS bf16* dst = (c16 < 16 ? sB : sC) + (c16 & 15) * 8;
#pragma unroll 2
            for (int i = 0; i < 8; ++i) { const int ll = l0 + 16 * i; float acc[8];
#pragma unroll
                for (int jj = 0; jj < 8; ++jj) acc[jj] = bias[jj];
#pragma unroll
                for (int k = 0; k < 4; ++k) { const int ts = c * 128 + ll - 3 + k;
                    if (ts >= 0) { const v4u xv = *(const GAS v4u*)(PROJ + ((size_t)b * SEQ + ts) * NPROJ + O_XBC + ch);
#pragma unroll
                        for (int j = 0; j < 4; ++j) { acc[2 * j] += wk[k][2 * j] * bflo(xv[j]); acc[2 * j + 1] += wk[k][2 * j + 1] * bfhi(xv[j]); } } }
#pragma unroll
                for (int jj = 0; jj < 8; ++jj) acc[jj] = siluf(acc[jj]);
                *(LAS bf16x8*)(dst + ll * PS) = pack8(acc); }
        }
        {
            const int head = g * 8 + w; const float A = -__expf(a->in[I_SALOG][l * 16 + head]), dtb = a->in[I_SDTB][l * 16 + head];
            const int l2 = 2 * lane;
            const float dt0 = softplusf_(bf2f(PROJ[(row0 + l2) * NPROJ + O_DT + head]) + dtb), dt1 = softplusf_(bf2f(PROJ[(row0 + l2 + 1) * NPROJ + O_DT + head]) + dtb);
            const float da1 = dt1 * A; float sc = dt0 * A + da1;
#pragma unroll
            for (int o = 1; o < 64; o <<= 1) { const float t_ = __shfl_up(sc, o); if (lane >= o) sc += t_; }
            sDt[w * 128 + l2] = dt0; sDt[w * 128 + l2 + 1] = dt1;
            const size_t uh = (size_t)((b * 16 + head) * 32 + c) * 128;
            float* AC = (float*)(a->ws + WS_SSD_AC) + uh; float* DT = (float*)(a->ws + WS_SSD_DT) + uh;
            AC[l2] = sc - da1; AC[l2 + 1] = sc; DT[l2] = dt0; DT[l2 + 1] = dt1;
        }
        __syncthreads();
#pragma unroll
        for (int st = 0; st < 8; ++st) {
            f32x4 acc = {0.f, 0.f, 0.f, 0.f};
            if (st <= w) {
#pragma unroll
                for (int ks = 0; ks < 4; ++ks) acc = mfma16(lds_frag(sB, 16 * st, PS, 32 * ks, lane), lds_frag(sC, 16 * w, PS, 32 * ks, lane), acc); }
            *(LAS unsigned long long*)(sCB + (16 * w + r) * PS + 16 * st + 4 * q4) = pack4(acc);
        }
        __syncthreads();
        for (int f = w; f < 32; f += NWAVES) { const int tile = f >> 2, ks = f & 3;
            *(GAS v4u*)(Cg + f * 512 + lane * 8) = *(const LAS v4u*)(sC + (16 * tile + r) * PS + 32 * ks + 8 * q4);
            *(GAS v4u*)(CBg + f * 512 + lane * 8) = *(const LAS v4u*)(sCB + (16 * tile + r) * PS + 32 * ks + 8 * q4);
            const int n = 16 * tile + r, l0 = 32 * ks + 8 * q4; v4u o;
#pragma unroll
            for (int j = 0; j < 4; ++j) o[j] = (unsigned)sB[(l0 + 2 * j) * PS + n] | ((unsigned)sB[(l0 + 2 * j + 1) * PS + n] << 16);
            *(GAS v4u*)(BTg + f * 512 + lane * 8) = o; }
#pragma unroll 1
        for (int hf = 0; hf < 2; ++hf) {
            __syncthreads();
            {   const int cg = tid & 31, l0 = tid >> 5, chl = cg * 8, ch = g * 512 + hf * 256 + chl, hh = hf * 4 + (cg >> 3);
                float wk[4][8], bias[8];
#pragma unroll
                for (int jj = 0; jj < 8; ++jj) { bias[jj] = cb[ch + jj];
#pragma unroll
                    for (int k = 0; k < 4; ++k) wk[k][jj] = cw[k * 1536 + ch + jj]; }
#pragma unroll 2
                for (int i = 0; i < 8; ++i) { const int ll = l0 + 16 * i; float acc[8];
#pragma unroll
                    for (int jj = 0; jj < 8; ++jj) acc[jj] = bias[jj];
#pragma unroll
                    for (int k = 0; k < 4; ++k) { const int ts = c * 128 + ll - 3 + k;
                        if (ts >= 0) { const v4u xv = *(const GAS v4u*)(PROJ + ((size_t)b * SEQ + ts) * NPROJ + O_XBC + ch);
#pragma unroll
                            for (int j = 0; j < 4; ++j) { acc[2 * j] += wk[k][2 * j] * bflo(xv[j]); acc[2 * j + 1] += wk[k][2 * j + 1] * bfhi(xv[j]); } } }
                    const float dtv = sDt[hh * 128 + ll];
#pragma unroll
                    for (int jj = 0; jj < 8; ++jj) sXT[(chl + jj) * PS + ll] = (bf16)f2bf(siluf(acc[jj]) * dtv); }
            }
            __syncthreads();
            for (int p = tid; p < 4096; p += NTHR) { const int chl = p >> 4, l8 = (p & 15) * 8, hh = hf * 4 + (chl >> 6), pp = chl & 63;
                const size_t uh = (size_t)((b * 16 + g * 8 + hh) * 32 + c);
                *(GAS v4u*)((bf16*)(a->ws + WS_SSD_XT) + (uh * 64 + pp) * 128 + l8) = *(const LAS v4u*)(sXT + chl * PS + l8); }
        }
    }
}
__device__ __forceinline__ void ssd_scan_phase(CArgs a, int l, LAS unsigned char* lds, const int b, const int head, int tid) {
    asm volatile("" : "+v"(tid));
    constexpr int PS = 136, O_S = 0, O_X = 34816, O_AC = 69632, O_TE = 70656, O_DT = 71680;
    bf16* YMIX = (bf16*)(a->ws + WS_YMIX);
    const int lane = tid & 63, w = tid >> 6, r = lane & 15, q4 = lane >> 4;
    {
        const int g = head >> 3;
        const float Dsk = a->in[I_SD][l * 16 + head];
        const bf16* Cg = (const bf16*)(a->ws + WS_SSD_C) + (size_t)((b * 32) * 2 + g) * 16384 + (w * 4) * 512 + lane * 8;
        const bf16* CBg = (const bf16*)(a->ws + WS_SSD_CB) + (size_t)((b * 32) * 2 + g) * 16384 + (w * 4) * 512 + lane * 8;
        const bf16* BTg = (const bf16*)(a->ws + WS_SSD_BT) + (size_t)((b * 32) * 2 + g) * 16384 + (w * 4) * 512 + lane * 8;
        const size_t uh0 = (size_t)(b * 16 + head) * 32;
        const bf16* XTg = (const bf16*)(a->ws + WS_SSD_XT) + uh0 * 8192; const float* ACg = (const float*)(a->ws + WS_SSD_AC) + uh0 * 128; const float* DTg = (const float*)(a->ws + WS_SSD_DT) + uh0 * 128;
        v4u fC[4], fCB[4], fBT[4], rx[2]; float rac = 0.f, racl = 0.f, rdt = 0.f;
#define SSD_LDF(cc, dst, src) do { _Pragma("unroll") for (int ks = 0; ks < 4; ++ks) dst[ks] = *(const GAS v4u*)(src + (size_t)(cc) * 32768 + 512 * ks); } while (0)
#define SSD_LOADX(cc) do { _Pragma("unroll") for (int i = 0; i < 2; ++i) { const int p = tid + NTHR * i; rx[i] = *(const GAS v4u*)(XTg + (size_t)(cc) * 8192 + (p >> 4) * 128 + (p & 15) * 8); } \
            if (tid < 128) { rac = ACg[(cc) * 128 + tid]; racl = ACg[(cc) * 128 + 127]; rdt = DTg[(cc) * 128 + tid]; } } while (0)
#define SSD_STORE(bi) do { _Pragma("unroll") for (int i = 0; i < 2; ++i) { const int p = tid + NTHR * i; *(LAS v4u*)(lds + O_X + (bi) * 17408 + ((p >> 4) * PS + (p & 15) * 8) * 2) = rx[i]; } \
            if (tid < 128) { ((LAS float*)(lds + O_AC))[(bi) * 128 + tid] = rac; ((LAS float*)(lds + O_TE))[(bi) * 128 + tid] = __expf(racl - rac); ((LAS float*)(lds + O_DT))[(bi) * 128 + tid] = rdt; } } while (0)
        __syncthreads();
        SSD_LDF(0, fC, Cg); SSD_LDF(0, fCB, CBg); SSD_LDF(0, fBT, BTg); SSD_LOADX(0);
        for (int i = tid; i < 17408 / 4; i += NTHR) ((LAS unsigned*)(lds + O_S))[i] = 0u;
        SSD_STORE(0);
        f32x4 accS[4];
#pragma unroll
        for (int pt = 0; pt < 4; ++pt) accS[pt] = (f32x4){0.f, 0.f, 0.f, 0.f};
        __syncthreads();
        for (int c = 0; c < 32; ++c) {
            const int cur = c & 1;
            const LAS bf16* sS = (const LAS bf16*)(lds + O_S + cur * 17408); LAS bf16* sSn = (LAS bf16*)(lds + O_S + (cur ^ 1) * 17408); const LAS bf16* sXT = (const LAS bf16*)(lds + O_X + cur * 17408);
            const LAS float* sAc = (const LAS float*)(lds + O_AC) + cur * 128; const LAS float* sTe = (const LAS float*)(lds + O_TE) + cur * 128; const LAS float* sDt = (const LAS float*)(lds + O_DT) + cur * 128;
            const int cn = c + 1 < 32 ? c + 1 : c;
            SSD_LOADX(cn);
            const int lrow = 16 * w + r; const float ac_l = sAc[lrow];
            f32x4 accO[4], accD[4];
#pragma unroll
            for (int pt = 0; pt < 4; ++pt) { accO[pt] = (f32x4){0.f, 0.f, 0.f, 0.f}; accD[pt] = (f32x4){0.f, 0.f, 0.f, 0.f}; }
#pragma unroll
            for (int ks = 0; ks < 4; ++ks) { const bf16x8 yf = __builtin_bit_cast(bf16x8, fC[ks]);
#pragma unroll
                for (int pt = 0; pt < 4; ++pt) accO[pt] = mfma16(lds_frag(sS, 16 * pt, PS, 32 * ks, lane), yf, accO[pt]); }
            SSD_LDF(cn, fC, Cg);
#pragma unroll
            for (int ks = 0; ks < 4; ++ks) if (32 * ks <= 16 * w + 15) {
                float v[8]; const f32x4 a0 = *(const LAS f32x4*)(sAc + 32 * ks + 8 * q4), a1 = *(const LAS f32x4*)(sAc + 32 * ks + 8 * q4 + 4);
#pragma unroll
                for (int j = 0; j < 4; ++j) { const int s0 = 32 * ks + 8 * q4 + 2 * j; const float as0 = (2 * j < 4) ? a0[(2 * j) & 3] : a1[(2 * j) & 3], as1 = (2 * j + 1 < 4) ? a0[(2 * j + 1) & 3] : a1[(2 * j + 1) & 3];
                    v[2 * j] = (s0 <= lrow) ? bflo(fCB[ks][j]) * __expf(ac_l - as0) : 0.f; v[2 * j + 1] = (s0 + 1 <= lrow) ? bfhi(fCB[ks][j]) * __expf(ac_l - as1) : 0.f; }
                const bf16x8 yf = pack8(v);
#pragma unroll
                for (int pt = 0; pt < 4; ++pt) accD[pt] = mfma16(lds_frag(sXT, 16 * pt, PS, 32 * ks, lane), yf, accD[pt]); }
            SSD_LDF(cn, fCB, CBg);
            {   const float ea = __expf(ac_l), rdtl = Dsk / sDt[lrow];
#pragma unroll
                for (int pt = 0; pt < 4; ++pt) { f32x4 y = accO[pt] * ea + accD[pt];
#pragma unroll
                    for (int ii = 0; ii < 4; ++ii) y[ii] += rdtl * bf2f(sXT[(16 * pt + 4 * q4 + ii) * PS + lrow]);
                    *(GAS unsigned long long*)(YMIX + ((size_t)b * SEQ + c * 128 + lrow) * DMIX + head * 64 + 16 * pt + 4 * q4) = pack4(y); } }
            {   const float cd = __expf(sAc[127]);
#pragma unroll
                for (int pt = 0; pt < 4; ++pt) accS[pt] = accS[pt] * cd;
#pragma unroll
                for (int ks = 0; ks < 4; ++ks) { float v[8]; const f32x4 t0 = *(const LAS f32x4*)(sTe + 32 * ks + 8 * q4), t1 = *(const LAS f32x4*)(sTe + 32 * ks + 8 * q4 + 4);
#pragma unroll
                    for (int j = 0; j < 4; ++j) { const float ts0 = (2 * j < 4) ? t0[(2 * j) & 3] : t1[(2 * j) & 3], ts1 = (2 * j + 1 < 4) ? t0[(2 * j + 1) & 3] : t1[(2 * j + 1) & 3];
                        v[2 * j] = bflo(fBT[ks][j]) * ts0; v[2 * j + 1] = bfhi(fBT[ks][j]) * ts1; }
                    const bf16x8 xf = pack8(v);
#pragma unroll
                    for (int pt = 0; pt < 4; ++pt) accS[pt] = mfma16(xf, lds_frag(sXT, 16 * pt, PS, 32 * ks, lane), accS[pt]); }
#pragma unroll
                for (int pt = 0; pt < 4; ++pt) *(LAS unsigned long long*)(sSn + (16 * pt + r) * PS + 16 * w + 4 * q4) = pack4(accS[pt]);
            }
            SSD_LDF(cn, fBT, BTg);
            if (c + 1 < 32) SSD_STORE(cur ^ 1);
            WG_BAR();
        }
#undef SSD_LDF
#undef SSD_LOADX
#undef SSD_STORE
    }
}

__device__ __forceinline__ void gdn_prep_phase(CArgs a, int l, LAS unsigned char* lds, int wg, int G, int tid) {
    asm volatile("" : "+v"(tid));
    constexpr int PS = 136, TS = 72, MS = 68, TT = 65;
    LAS bf16* sKb = (LAS bf16*)lds; LAS bf16* sQb = sKb + 64 * PS; LAS bf16* sQG = sQb + 64 * PS; LAS bf16* sVT = sQG + 64 * PS;
    LAS float* sM = (LAS float*)(lds + 3 * 17408 + 18432); LAS float* sT = sM + 64 * MS; LAS float* sVec = sT + 64 * TT; LAS bf16* sQK = (LAS bf16*)(sVec + 256);
    const bf16* PROJ = (const bf16*)(a->ws + WS_PROJ);
    const float* cw = a->in[I_GCW] + (size_t)l * 4 * 1536;
    const int lane = tid & 63, w = tid >> 6, r = lane & 15, q4 = lane >> 4;
    for (int unit = wg; unit < 1024; unit += G) {
        const int b = unit >> 8, head = (unit >> 6) & 3, n = unit & 63;
        const size_t row0 = (size_t)b * SEQ + n * 64;
#define GW ((bf16*)(a->ws + WS_GD_K) + (size_t)unit * 8192)
#define GKT ((bf16*)(a->ws + WS_GD_KT) + (size_t)unit * 8192)
#define GQG ((bf16*)(a->ws + WS_GD_QG) + (size_t)unit * 8192)
#define GUT ((bf16*)(a->ws + WS_GD_VT) + (size_t)unit * 8192)
#define GT ((bf16*)(a->ws + WS_GD_T) + (size_t)unit * 4096)
#define GQK ((bf16*)(a->ws + WS_GD_QK) + (size_t)unit * 4096)
#define GVEC ((float*)(a->ws + WS_GD_VEC) + (size_t)unit * 256)
        __syncthreads();
        for (int i = tid; i < 64 * MS; i += NTHR) sM[i] = 0.f;
        if (w == 0) {
            const float nA = -__expf(a->in[I_GALOG][l * 4 + head]), dtb = a->in[I_GDTB][l * 4 + head];
            const size_t ro = (row0 + lane) * NPROJ;
            const float be = sigmoidf_(bf2f(PROJ[ro + O_GB + head])); float gsum = nA * softplusf_(bf2f(PROJ[ro + O_GA + head]) + dtb);
#pragma unroll
            for (int o = 1; o < 64; o <<= 1) { const float t_ = __shfl_up(gsum, o); if (lane >= o) gsum += t_; }
            const float glast = __shfl(gsum, 63), eg = __expf(gsum), cc = __expf(glast - gsum);
            sVec[lane] = gsum; sVec[64 + lane] = be; sVec[128 + lane] = eg;
            GVEC[lane] = be; GVEC[64 + lane] = eg; GVEC[128 + lane] = cc; GVEC[192 + lane] = __expf(glast);
        }
        __syncthreads();
        {
            float wq[4][2], wk_[4][2], wv[4][2];
#pragma unroll
            for (int k = 0; k < 4; ++k)
#pragma unroll
                for (int j = 0; j < 2; ++j) { wq[k][j] = cw[k * 1536 + head * 128 + 2 * lane + j]; wk_[k][j] = cw[k * 1536 + 512 + head * 128 + 2 * lane + j]; wv[k][j] = cw[k * 1536 + 1024 + head * 128 + 2 * lane + j]; }
#pragma unroll 4
            for (int i = 0; i < 8; ++i) { const int t = w + 8 * i; float q0 = 0.f, q1 = 0.f, k0 = 0.f, k1 = 0.f, v0 = 0.f, v1 = 0.f;
#pragma unroll
                for (int k = 0; k < 4; ++k) { const int ts = n * 64 + t - 3 + k;
                    if (ts >= 0) { const bf16* pr = PROJ + ((size_t)b * SEQ + ts) * NPROJ + O_QKV + head * 128 + 2 * lane;
                        const unsigned xq = *(const GAS unsigned*)pr, xk = *(const GAS unsigned*)(pr + 512), xv = *(const GAS unsigned*)(pr + 1024);
                        q0 += wq[k][0] * bflo(xq); q1 += wq[k][1] * bfhi(xq); k0 += wk_[k][0] * bflo(xk); k1 += wk_[k][1] * bfhi(xk); v0 += wv[k][0] * bflo(xv); v1 += wv[k][1] * bfhi(xv); } }
                q0 = siluf(q0); q1 = siluf(q1); k0 = siluf(k0); k1 = siluf(k1); v0 = siluf(v0); v1 = siluf(v1);
                const float sq = rsqrtf(wave_sum(q0 * q0 + q1 * q1) + 1e-6f) * 0.08838834764831845f, sk = rsqrtf(wave_sum(k0 * k0 + k1 * k1) + 1e-6f), eg = sVec[128 + t];
                *(LAS unsigned*)(sKb + t * PS + 2 * lane) = pk2(k0 * sk, k1 * sk); *(LAS unsigned*)(sQb + t * PS + 2 * lane) = pk2(q0 * sq, q1 * sq);
                *(LAS unsigned*)(sQG + t * PS + 2 * lane) = pk2(q0 * sq * eg, q1 * sq * eg);
                sVT[(2 * lane) * TS + t] = (bf16)f2bf(v0); sVT[(2 * lane + 1) * TS + t] = (bf16)f2bf(v1); }
        }
        __syncthreads();
        for (int p = w; p < 26; p += NWAVES) {
            int it, jt; bool isq;
            if (p < 10) { isq = false; it = p < 1 ? 0 : (p < 3 ? 1 : (p < 6 ? 2 : 3)); jt = p - (it * (it + 1)) / 2; } else { isq = true; it = (p - 10) >> 2; jt = (p - 10) & 3; }
            f32x4 acc = {0.f, 0.f, 0.f, 0.f};
            if (jt <= it) {
#pragma unroll
                for (int ks = 0; ks < 4; ++ks) acc = mfma16(lds_frag(sKb, 16 * jt, PS, 32 * ks, lane), lds_frag(isq ? sQb : sKb, 16 * it, PS, 32 * ks, lane), acc);
                const int i = 16 * it + r; const float gi = sVec[i], bi = sVec[64 + i];
#pragma unroll
                for (int ii = 0; ii < 4; ++ii) { const int j = 16 * jt + 4 * q4 + ii; const float dec = __expf(gi - sVec[j]);
                    acc[ii] = isq ? (j <= i ? acc[ii] * dec : 0.f) : (j < i ? acc[ii] * dec * bi : 0.f); }
            }
            if (isq) *(LAS unsigned long long*)(sQK + (16 * it + r) * TS + 16 * jt + 4 * q4) = pack4(acc);
            else *(LAS f32x4*)(sM + (16 * it + r) * MS + 16 * jt + 4 * q4) = acc;
        }
        __syncthreads();
        {
            LAS float* sX = (LAS float*)(sQK + 64 * TS);
            if (w < 4) {
                int zo = 0; asm volatile("" : "+v"(zo)); const LAS float* sMv = sM + zo + (16 * w) * MS + 16 * w;
                if (lane < 16) { float ud[16];
#pragma unroll
                    for (int rr = 0; rr < 16; ++rr) { float acc = -sMv[rr * MS + lane];
#pragma unroll
                        for (int j = 0; j < rr; ++j) acc -= sMv[rr * MS + j] * ud[j];
                        ud[rr] = acc; sT[(16 * w + rr) * TT + 16 * w + lane] = acc + ((rr == lane) ? 1.f : 0.f); } }
                for (int jb = w + 1; jb < 4; ++jb)
                    for (int idx = lane; idx < 256; idx += 64) sT[(16 * w + (idx >> 4)) * TT + 16 * jb + (idx & 15)] = 0.f;
            } else {
                for (int f = w - 4; f < 16; f += 4) { const int tile = f >> 2, ks = f & 3;
                    *(GAS v4u*)(GQG + f * 512 + lane * 8) = *(const LAS v4u*)(sQG + (16 * tile + r) * PS + 32 * ks + 8 * q4); }
                for (int f = w - 4; f < 8; f += 4) { const int tile = f >> 1, ks = f & 1;
                    *(GAS v4u*)(GQK + f * 512 + lane * 8) = *(const LAS v4u*)(sQK + (16 * tile + r) * TS + 32 * ks + 8 * q4); }
                for (int f = w - 4; f < 16; f += 4) { const int dt = f >> 1, ks = f & 1, d = 16 * dt + r, s0 = 32 * ks + 8 * q4; v4u o;
#pragma unroll
                    for (int j = 0; j < 4; ++j) o[j] = (unsigned)sKb[(s0 + 2 * j) * PS + d] | ((unsigned)sKb[(s0 + 2 * j + 1) * PS + d] << 16);
                    *(GAS v4u*)(GKT + f * 512 + lane * 8) = o; }
            }
            WG_BAR();
#pragma unroll
            for (int ib = 1; ib < 4; ++ib) {
                if (w < ib) { const int jb = w; f32x4 acc = {0.f, 0.f, 0.f, 0.f};
                    for (int kb = jb; kb < ib; ++kb)
#pragma unroll
                        for (int kc = 0; kc < 4; ++kc) acc = __builtin_amdgcn_mfma_f32_16x16x4f32(sM[(16 * ib + r) * MS + 16 * kb + 4 * kc + q4], sT[(16 * kb + 4 * kc + q4) * TT + 16 * jb + r], acc, 0, 0, 0);
                    LAS float* sx = sX + w * 272;
#pragma unroll
                    for (int rr = 0; rr < 4; ++rr) sx[(4 * q4 + rr) * 17 + r] = acc[rr];
                    asm volatile("s_waitcnt lgkmcnt(0)" ::: "memory");
                    f32x4 acc2 = {0.f, 0.f, 0.f, 0.f};
#pragma unroll
                    for (int kc = 0; kc < 4; ++kc) acc2 = __builtin_amdgcn_mfma_f32_16x16x4f32(sT[(16 * ib + r) * TT + 16 * ib + 4 * kc + q4], sx[(4 * kc + q4) * 17 + r], acc2, 0, 0, 0);
#pragma unroll
                    for (int rr = 0; rr < 4; ++rr) sT[(16 * ib + 4 * q4 + rr) * TT + 16 * jb + r] = -acc2[rr];
                }
                WG_BAR();
            }
        }
        {
            LAS bf16* sTb = (LAS bf16*)sM; LAS bf16* sKgT = sQb;
            { const int t = tid >> 3, s8 = (tid & 7) * 8; float v[8];
#pragma unroll
                for (int jj = 0; jj < 8; ++jj) v[jj] = sT[t * TT + s8 + jj];
                *(LAS bf16x8*)(sTb + t * TS + s8) = pack8(v); }
            for (int p = tid; p < 1024; p += NTHR) { const int d = p >> 3, s8 = (p & 7) * 8; float v[8], u8[8]; const v4u vv = *(const LAS v4u*)(sVT + d * TS + s8);
#pragma unroll
                for (int jj = 0; jj < 8; ++jj) { const float be = sVec[64 + s8 + jj]; v[jj] = bf2f(sKb[(s8 + jj) * PS + d]) * be * sVec[128 + s8 + jj]; u8[jj] = ((jj & 1) ? bfhi(vv[jj >> 1]) : bflo(vv[jj >> 1])) * be; }
                *(LAS bf16x8*)(sKgT + d * TS + s8) = pack8(v); *(LAS bf16x8*)(sVT + d * TS + s8) = pack8(u8); }
        }
        __syncthreads();
        {
            const LAS bf16* sTb = (const LAS bf16*)sM; const LAS bf16* sKgT = sQb; LAS bf16* sW = (LAS bf16*)((LAS unsigned char*)sM + 9216);
            const int st_ = w >> 1;
            const bf16x8 t0 = lds_frag(sTb, 16 * st_, TS, 0, lane), t1 = lds_frag(sTb, 16 * st_, TS, 32, lane);
#pragma unroll
            for (int c4_ = 0; c4_ < 4; ++c4_) { const int ct = (w & 1) * 4 + c4_;
                f32x4 aw = {0.f, 0.f, 0.f, 0.f}, au = {0.f, 0.f, 0.f, 0.f};
                aw = mfma16(lds_frag(sKgT, 16 * ct, TS, 0, lane), t0, aw); aw = mfma16(lds_frag(sKgT, 16 * ct, TS, 32, lane), t1, aw);
                au = mfma16(t0, lds_frag(sVT, 16 * ct, TS, 0, lane), au); au = mfma16(t1, lds_frag(sVT, 16 * ct, TS, 32, lane), au);
                *(LAS unsigned long long*)(sW + (16 * st_ + r) * PS + 16 * ct + 4 * q4) = pack4(aw);
                *(GAS unsigned long long*)(GUT + (ct * 4 + st_) * 256 + lane * 4) = pack4(au); }
        }
        __syncthreads();
        { const LAS bf16* sW = (const LAS bf16*)((LAS unsigned char*)sM + 9216);
            for (int f = w; f < 16; f += NWAVES) { const int tile = f >> 2, ks = f & 3;
                *(GAS v4u*)(GW + f * 512 + lane * 8) = *(const LAS v4u*)(sW + (16 * tile + r) * PS + 32 * ks + 8 * q4); } }
    }
#undef GW
#undef GKT
#undef GQG
#undef GUT
#undef GT
#undef GQK
#undef GVEC
}
__device__ __forceinline__ void gdn_scan_phase(CArgs a, int l, LAS unsigned char* lds, const int b, const int head, const int eb, int tid) {
    asm volatile("" : "+v"(tid));
    constexpr int PS = 136, TS = 72, O_ST = 0, O_RT = 34816, O_VN = O_RT + 9216, O_VC = O_VN + 9216;
    bf16* YMIX = (bf16*)(a->ws + WS_YMIX);
    const int lane = tid & 63, w = tid >> 6, r = lane & 15, q4 = lane >> 4, st = w >> 1, eh = w & 1;
    LAS bf16* sRT = (LAS bf16*)(lds + O_RT); LAS bf16* sVN = (LAS bf16*)(lds + O_VN); LAS bf16* sVC = (LAS bf16*)(lds + O_VC);
    {
        const size_t u0 = (size_t)(b * 4 + head) * 64;
        const bf16* pW = (const bf16*)(a->ws + WS_GD_K) + u0 * 8192 + (st * 4) * 512 + lane * 8; const bf16* pQG = (const bf16*)(a->ws + WS_GD_QG) + u0 * 8192 + (st * 4) * 512 + lane * 8;
        const bf16* pQK = (const bf16*)(a->ws + WS_GD_QK) + u0 * 4096 + (st * 2) * 512 + lane * 8;
        const bf16* pKT = (const bf16*)(a->ws + WS_GD_KT) + u0 * 8192 + (w * 2) * 512 + lane * 8;
        const bf16* pUT = (const bf16*)(a->ws + WS_GD_VT) + u0 * 8192 + (size_t)(((eb * 4 + 2 * eh) * 4 + st) * 256) + lane * 4;
        const float* pVec = (const float*)(a->ws + WS_GD_VEC) + u0 * 256 + 16 * st + 4 * q4;
        v4u xW[4], yQG[4], yQK[2], xKT[2], nQG[4], nQK[2]; unsigned long long uT[2]; f32x4 c4; float gl;
#define GD_LD_A(nn) do { _Pragma("unroll") for (int ks = 0; ks < 4; ++ks) xW[ks] = *(const GAS v4u*)(pW + (size_t)(nn) * 8192 + 512 * ks); \
            _Pragma("unroll") for (int j = 0; j < 2; ++j) uT[j] = *(const GAS unsigned long long*)(pUT + (size_t)(nn) * 8192 + j * 1024); \
            c4 = *(const GAS f32x4*)(pVec + (size_t)(nn) * 256 + 128); } while (0)
#define GD_LD_C(nn, QG_, QK_) do { _Pragma("unroll") for (int ks = 0; ks < 4; ++ks) QG_[ks] = *(const GAS v4u*)(pQG + (size_t)(nn) * 8192 + 512 * ks); \
            _Pragma("unroll") for (int ks = 0; ks < 2; ++ks) QK_[ks] = *(const GAS v4u*)(pQK + (size_t)(nn) * 4096 + 512 * ks); } while (0)
#define GD_LD_D(nn) do { _Pragma("unroll") for (int ks = 0; ks < 2; ++ks) xKT[ks] = *(const GAS v4u*)(pKT + (size_t)(nn) * 8192 + 512 * ks); gl = pVec[(size_t)(nn) * 256 + 192 - (16 * st + 4 * q4)]; } while (0)
        __syncthreads();
        GD_LD_A(0); GD_LD_C(0, yQG, yQK); GD_LD_D(0);
        for (int i = tid; i < 17408 / 4; i += NTHR) ((LAS unsigned*)(lds + O_ST))[i] = 0u;
        f32x4 accS[4];
#pragma unroll
        for (int et = 0; et < 4; ++et) accS[et] = (f32x4){0.f, 0.f, 0.f, 0.f};
        __syncthreads();
        for (int n = 0; n < 64; ++n) {
            const int cur = n & 1; const LAS bf16* sST = (const LAS bf16*)(lds + O_ST + cur * 17408); LAS bf16* sSTn = (LAS bf16*)(lds + O_ST + (cur ^ 1) * 17408);
            const int nn = n + 1 < 64 ? n + 1 : n;
            {
                bf16x8 fs[2][4];
#pragma unroll
                for (int j = 0; j < 2; ++j)
#pragma unroll
                    for (int ks = 0; ks < 4; ++ks) fs[j][ks] = lds_frag(sST, 16 * (2 * eh + j), PS, 32 * ks, lane);
                __builtin_amdgcn_sched_barrier(0);
#pragma unroll
                for (int j = 0; j < 2; ++j) { const int e0 = 16 * (2 * eh + j); f32x4 acc = {0.f, 0.f, 0.f, 0.f};
#pragma unroll
                    for (int ks = 0; ks < 4; ++ks) acc = mfma16(__builtin_bit_cast(bf16x8, xW[ks]), fs[j][ks], acc);
                    const unsigned ulo = (unsigned)uT[j], uhi = (unsigned)(uT[j] >> 32); f32x4 vn;
                    vn[0] = bflo(ulo) - acc[0]; vn[1] = bfhi(ulo) - acc[1]; vn[2] = bflo(uhi) - acc[2]; vn[3] = bfhi(uhi) - acc[3];
                    *(LAS unsigned long long*)(sVN + (e0 + r) * TS + 16 * st + 4 * q4) = pack4(vn); *(LAS unsigned long long*)(sVC + (e0 + r) * TS + 16 * st + 4 * q4) = pack4(vn * c4); }
            }
            GD_LD_A(nn); GD_LD_C(nn, nQG, nQK);
            WG_BAR();
            {
                bf16x8 fv[4][2];
#pragma unroll
                for (int et = 0; et < 4; ++et)
#pragma unroll
                    for (int ks = 0; ks < 2; ++ks) fv[et][ks] = lds_frag(sVC, 16 * et, TS, 32 * ks, lane);
                __builtin_amdgcn_sched_barrier(0);
#pragma unroll
                for (int et = 0; et < 4; ++et) { accS[et] = accS[et] * gl;
#pragma unroll
                    for (int ks = 0; ks < 2; ++ks) accS[et] = mfma16(__builtin_bit_cast(bf16x8, xKT[ks]), fv[et][ks], accS[et]);
                    *(LAS unsigned long long*)(sSTn + (16 * et + r) * PS + 16 * w + 4 * q4) = pack4(accS[et]); }
            }
            GD_LD_D(nn);
            {
                bf16x8 fs[2][4], fn[2][2];
#pragma unroll
                for (int j = 0; j < 2; ++j) {
#pragma unroll
                    for (int ks = 0; ks < 4; ++ks) fs[j][ks] = lds_frag(sST, 16 * (2 * eh + j), PS, 32 * ks, lane);
#pragma unroll
                    for (int ks = 0; ks < 2; ++ks) fn[j][ks] = lds_frag(sVN, 16 * (2 * eh + j), TS, 32 * ks, lane); }
                __builtin_amdgcn_sched_barrier(0);
#pragma unroll
                for (int j = 0; j < 2; ++j) { const int e0 = 16 * (2 * eh + j); f32x4 acc = {0.f, 0.f, 0.f, 0.f};
#pragma unroll
                    for (int ks = 0; ks < 4; ++ks) acc = mfma16(fs[j][ks], __builtin_bit_cast(bf16x8, yQG[ks]), acc);
#pragma unroll
                    for (int ks = 0; ks < 2; ++ks) acc = mfma16(fn[j][ks], __builtin_bit_cast(bf16x8, yQK[ks]), acc);
                    *(GAS unsigned long long*)(YMIX + ((size_t)b * SEQ + n * 64 + 16 * st + r) * DMIX + 1024 + head * 128 + eb * 64 + e0 + 4 * q4) = pack4(acc); }
            }
#pragma unroll
            for (int ks = 0; ks < 4; ++ks) yQG[ks] = nQG[ks];
#pragma unroll
            for (int ks = 0; ks < 2; ++ks) yQK[ks] = nQK[ks];
            WG_BAR();
        }
#undef GD_LD_A
#undef GD_LD_C
#undef GD_LD_D
    }
}

__device__ __forceinline__ void gdn_rec_phase(CArgs a, int l, LAS unsigned char* lds, int wg, int G, int tid) {
    asm volatile("" : "+v"(tid));
    constexpr int TB = 32;
    LAS float* sQ = (LAS float*)lds; LAS float* sK = sQ + TB * 128; LAS float* sV = sK + TB * 128; LAS float* sBe = sV + TB * 8; LAS float* sAl = sBe + TB; LAS float* sO = sAl + TB;
    const bf16* PROJ = (const bf16*)(a->ws + WS_PROJ); bf16* YMIX = (bf16*)(a->ws + WS_YMIX);
    const float* cw = a->in[I_GCW] + (size_t)l * 4 * 1536;
    const int lane = tid & 63, w = tid >> 6;
    for (int unit = wg; unit < 256; unit += G) {
        const int b = unit >> 6, head = (unit >> 4) & 3, eb = unit & 15;
        const float nA = -__expf(a->in[I_GALOG][l * 4 + head]), dtb = a->in[I_GDTB][l * 4 + head];
        float S0 = 0.f, S1 = 0.f;
        for (int t0 = 0; t0 < SEQ; t0 += TB) {
            __syncthreads();
            for (int idx = tid; idx < TB * 264; idx += NTHR) {
                const int tt = idx / 264, ci = idx % 264, t = t0 + tt;
                const int ch = ci < 128 ? head * 128 + ci : (ci < 256 ? 512 + head * 128 + (ci - 128) : 1024 + head * 128 + eb * 8 + (ci - 256));
                float acc = 0.f;
#pragma unroll
                for (int k = 0; k < 4; ++k) { const int ts = t - 3 + k; if (ts >= 0) acc += cw[k * 1536 + ch] * bf2f(PROJ[(size_t)(b * SEQ + ts) * NPROJ + O_QKV + ch]); }
                const float v = siluf(acc);
                if (ci < 128) sQ[tt * 128 + ci] = v; else if (ci < 256) sK[tt * 128 + ci - 128] = v; else sV[tt * 8 + ci - 256] = v;
            }
            if (tid < TB) { const size_t ro = (size_t)(b * SEQ + t0 + tid) * NPROJ; const float braw = bf2f(PROJ[ro + O_GB + head]), araw = bf2f(PROJ[ro + O_GA + head]);
                sBe[tid] = sigmoidf_(braw); sAl[tid] = __expf(nA * softplusf_(araw + dtb)); }
            __syncthreads();
            for (int tt = w; tt < TB; tt += NWAVES) {
                const float q0 = sQ[tt * 128 + lane], q1 = sQ[tt * 128 + 64 + lane], k0 = sK[tt * 128 + lane], k1 = sK[tt * 128 + 64 + lane];
                const float sq = rsqrtf(wave_sum(q0 * q0 + q1 * q1) + 1e-6f) * 0.08838834764831845f, sk = rsqrtf(wave_sum(k0 * k0 + k1 * k1) + 1e-6f);
                sQ[tt * 128 + lane] = q0 * sq; sQ[tt * 128 + 64 + lane] = q1 * sq; sK[tt * 128 + lane] = k0 * sk; sK[tt * 128 + 64 + lane] = k1 * sk;
            }
            __syncthreads();
#pragma unroll 2
            for (int tt = 0; tt < TB; ++tt) {
                const float k0 = sK[tt * 128 + lane], k1 = sK[tt * 128 + 64 + lane], q0 = sQ[tt * 128 + lane], q1 = sQ[tt * 128 + 64 + lane];
                const float al = sAl[tt], be = sBe[tt], v = sV[tt * 8 + w];
                const float dot = wave_sum(k0 * S0 + k1 * S1);
                const float vn = be * (v - al * dot);
                S0 = al * S0 + k0 * vn; S1 = al * S1 + k1 * vn;
                const float od = wave_sum(q0 * S0 + q1 * S1);
                if (lane == 0) sO[tt * 8 + w] = od;
            }
            __syncthreads();
            if (tid < TB * 8) { const int tt = tid >> 3, i = tid & 7; YMIX[(size_t)(b * SEQ + t0 + tt) * DMIX + 1024 + head * 128 + eb * 8 + i] = (bf16)f2bf(sO[tid]); }
        }
    }
}

__device__ __forceinline__ void hgrn_rec_phase(CArgs a, int l, LAS unsigned char* lds, int wg, int G, int tid) {
    asm volatile("" : "+v"(tid));
    constexpr int TB = 32;
    LAS float* sQ = (LAS float*)lds; LAS float* sF = sQ + TB * 128; LAS float* sV = sF + TB * 128; LAS float* sO = sV + TB * 8; LAS float* sLb = sO + TB * 8;
    const bf16* PROJ = (const bf16*)(a->ws + WS_PROJ); bf16* YMIX = (bf16*)(a->ws + WS_YMIX);
    const int lane = tid & 63, w = tid >> 6;
    for (int unit = wg; unit < 256; unit += G) {
        const int b = unit >> 6, head = (unit >> 4) & 3, eb = unit & 15;
        __syncthreads();
        if (tid < 128) {
            const int c = head * 128 + tid; float lg[DEPTH], mx = -1e30f;
#pragma unroll
            for (int j = 0; j < DEPTH; ++j) { lg[j] = a->in[I_HLB][j * 512 + c]; mx = fmaxf(mx, lg[j]); }
            float den = 0.f, num = 0.f;
#pragma unroll
            for (int j = 0; j < DEPTH; ++j) { const float e = __expf(lg[j] - mx); den += e; if (j >= 1 && j <= l) num += e; }
            sLb[tid] = num / den;
        }
        float S0 = 0.f, S1 = 0.f;
        for (int t0 = 0; t0 < SEQ; t0 += TB) {
            __syncthreads();
            for (int idx = tid; idx < TB * 264; idx += NTHR) {
                const int tt = idx / 264, ci = idx % 264; const size_t ro = (size_t)(b * SEQ + t0 + tt) * NPROJ;
                if (ci < 128) sQ[tt * 128 + ci] = siluf(bf2f(PROJ[ro + O_HQ + head * 128 + ci]));
                else if (ci < 256) { const int d = ci - 128; const float lb = sLb[d]; sF[tt * 128 + d] = lb + (1.f - lb) * sigmoidf_(bf2f(PROJ[ro + O_HF + head * 128 + d])); }
                else sV[tt * 8 + ci - 256] = bf2f(PROJ[ro + O_HI + head * 128 + eb * 8 + (ci - 256)]);
            }
            __syncthreads();
#pragma unroll 2
            for (int tt = 0; tt < TB; ++tt) {
                const float f0 = sF[tt * 128 + lane], f1 = sF[tt * 128 + 64 + lane], q0 = sQ[tt * 128 + lane], q1 = sQ[tt * 128 + 64 + lane], v = sV[tt * 8 + w];
                S0 = f0 * S0 + (1.f - f0) * v; S1 = f1 * S1 + (1.f - f1) * v;
                const float od = wave_sum(q0 * S0 + q1 * S1);
                if (lane == 0) sO[tt * 8 + w] = od;
            }
            __syncthreads();
            if (tid < TB * 8) { const int tt = tid >> 3, i = tid & 7; YMIX[(size_t)(b * SEQ + t0 + tt) * DMIX + 1536 + head * 128 + eb * 8 + i] = (bf16)f2bf(sO[tid]); }
        }
    }
}

__device__ __forceinline__ void mix_post_phase(CArgs a, int l, int wg, int G, int tid) {
    asm volatile("" : "+v"(tid));
    const bf16* PROJ = (const bf16*)(a->ws + WS_PROJ); bf16* YMIX = (bf16*)(a->ws + WS_YMIX);
    const int lane = tid & 63, gw = wg * NWAVES + (tid >> 6), NGW = G * NWAVES;
    const float* snw = a->in[I_SNW] + l * 1024; const float* gnw = a->in[I_GNW] + l * 128; const float* hnw = a->in[I_HNW] + l * 128;
    for (int row = gw; row < M; row += NGW) {
        const bf16* pr = PROJ + (size_t)row * NPROJ; bf16* yr = YMIX + (size_t)row * DMIX;
#pragma unroll
        for (int j = 0; j < 2; ++j) {
            const int ch = j * 512 + lane * 8; const v4u yv = *(const GAS v4u*)(yr + ch), zv = *(const GAS v4u*)(pr + O_Z + ch);
            float v[8]; float ss = 0.f;
#pragma unroll
            for (int i = 0; i < 4; ++i) { v[2 * i] = bflo(yv[i]) * siluf(bflo(zv[i])); v[2 * i + 1] = bfhi(yv[i]) * siluf(bfhi(zv[i])); ss += v[2 * i] * v[2 * i] + v[2 * i + 1] * v[2 * i + 1]; }
            const float rstd = rsqrtf(wave_sum(ss) * (1.f / 512.f) + 1e-6f);
            v4u o;
#pragma unroll
            for (int i = 0; i < 4; ++i) o[i] = pk2(v[2 * i] * rstd * snw[ch + 2 * i], v[2 * i + 1] * rstd * snw[ch + 2 * i + 1]);
            *(GAS v4u*)(yr + ch) = o;
        }
#pragma unroll
        for (int part = 0; part < 2; ++part) {
            const int ch = lane * 8, yo = 1024 + part * 512 + ch, go = (part == 0 ? O_GG : O_HG) + ch; const float* nw = part == 0 ? gnw : hnw;
            const v4u yv = *(const GAS v4u*)(yr + yo), gv = *(const GAS v4u*)(pr + go);
            float v[8]; float ss = 0.f;
#pragma unroll
            for (int i = 0; i < 4; ++i) { v[2 * i] = bflo(yv[i]); v[2 * i + 1] = bfhi(yv[i]); ss += v[2 * i] * v[2 * i] + v[2 * i + 1] * v[2 * i + 1]; }
            ss = row16_sum(ss);
            const float rstd = rsqrtf(ss * (1.f / 128.f) + 1e-6f);
            v4u o;
#pragma unroll
            for (int i = 0; i < 4; ++i) { const int c = (ch & 127) + 2 * i; o[i] = pk2(v[2 * i] * rstd * nw[c] * siluf(bflo(gv[i])), v[2 * i + 1] * rstd * nw[c + 1] * siluf(bfhi(gv[i]))); }
            *(GAS v4u*)(yr + yo) = o;
        }
    }
}

__device__ __forceinline__ void moe_tables(const gu32* cnt, LAS unsigned char* lds, int tid) {
    LAS int* tab = (LAS int*)(lds + LDS_OFF_TAB);
    __syncthreads();
    if (tid == 0) { int p = 0, q = 0;
        for (int e = 0; e < 16; ++e) { const int c = (int)__hip_atomic_load(cnt + e, RLX_AGENT); tab[e] = p; tab[17 + e] = q; p += (c + 255) & ~255; q += c; }
        tab[16] = p; tab[33] = q; }
    __syncthreads();
}
template <bool ROUTER>
__device__ __forceinline__ void ln_phase(CArgs a, int l, const float* gam, const float* bet, LAS unsigned char* lds, int wg, int G, int tid) {
    asm volatile("" : "+v"(tid));
    const int lane = tid & 63, wave = tid >> 6, gw = wg * NWAVES + wave, NGW = G * NWAVES;
    const float* ADD = (const float*)(a->ws + WS_MIX); float* H = a->out; bf16* HB = (bf16*)(a->ws + WS_HB);
    gu32* cnt = (gu32*)(a->ws + WS_CTL) + CW_CNT + l * 16;
    LAS float* sW = (LAS float*)lds;
    LAS float* sL = sW + 20 * D + wave * 32;
    LAS int* sCnt = (LAS int*)(sW + 20 * D + 256);
    LAS unsigned* sEnt = (LAS unsigned*)(sCnt + 32);
    constexpr int MAXENT = 2 * NWAVES * 8;
    if (ROUTER) {
        __syncthreads();
        const float* wrg = a->in[I_WRG] + (size_t)l * D * 4; const float* wre = a->in[I_WRE] + (size_t)l * D * 16;
        for (int i = tid; i < D * 20; i += NTHR) { const int c = i >> 10, k = i & 1023; sW[i] = c < 4 ? wrg[k * 4 + c] : wre[k * 16 + c - 4]; }
        if (tid < 32) sCnt[tid] = 0;
        __syncthreads();
    } else moe_tables(cnt, lds, tid);
    const LAS int* tab = (const LAS int*)(lds + LDS_OFF_TAB);
    f32x4 gv[4], bv[4];
#pragma unroll
    for (int j = 0; j < 4; ++j) { gv[j] = *(const f32x4*)(gam + 4 * lane + 256 * j); bv[j] = *(const f32x4*)(bet + 4 * lane + 256 * j); }
    int kk = 0;
    f32x4 ph[4], pa[4];
    if (ROUTER && gw < M) {
#pragma unroll
        for (int j = 0; j < 4; ++j) { ph[j] = *(const GAS f32x4*)(H + (size_t)gw * D + 4 * lane + 256 * j); pa[j] = *(const GAS f32x4*)(ADD + (size_t)gw * D + 4 * lane + 256 * j); } }
    for (int row = gw; row < M; row += NGW, ++kk) {
        f32x4 v[4]; float s = 0.f;
        if (ROUTER) {
#pragma unroll
            for (int j = 0; j < 4; ++j) { v[j] = ph[j] * DN_ALPHA + pa[j]; s += (v[j].x + v[j].y) + (v[j].z + v[j].w); }
            const int nrow = row + NGW < M ? row + NGW : row;
#pragma unroll
            for (int j = 0; j < 4; ++j) { ph[j] = *(const GAS f32x4*)(H + (size_t)nrow * D + 4 * lane + 256 * j); pa[j] = *(const GAS f32x4*)(ADD + (size_t)nrow * D + 4 * lane + 256 * j); }
        } else {
            const unsigned s0 = ((const GAS unsigned*)(a->ws + WS_SLOT))[2 * row], s1 = ((const GAS unsigned*)(a->ws + WS_SLOT))[2 * row + 1];
            const bf16* y0 = (const bf16*)(a->ws + WS_YS) + (size_t)(tab[s0 >> 16] + (int)(s0 & 0xffffu)) * D; const bf16* y1 = (const bf16*)(a->ws + WS_YS) + (size_t)(tab[s1 >> 16] + (int)(s1 & 0xffffu)) * D;
#pragma unroll
            for (int j = 0; j < 4; ++j) { const f32x4 hv = *(const GAS f32x4*)(H + (size_t)row * D + 4 * lane + 256 * j);
                const unsigned long long p0 = *(const GAS unsigned long long*)(y0 + 4 * lane + 256 * j), p1 = *(const GAS unsigned long long*)(y1 + 4 * lane + 256 * j);
                f32x4 av; av.x = bflo((unsigned)p0) + bflo((unsigned)p1); av.y = bfhi((unsigned)p0) + bfhi((unsigned)p1); av.z = bflo((unsigned)(p0 >> 32)) + bflo((unsigned)(p1 >> 32)); av.w = bfhi((unsigned)(p0 >> 32)) + bfhi((unsigned)(p1 >> 32));
                v[j] = hv * DN_ALPHA + av; s += (v[j].x + v[j].y) + (v[j].z + v[j].w); }
        }
        const float mean = wave_sum(s) * (1.f / D); float s2 = 0.f;
#pragma unroll
        for (int j = 0; j < 4; ++j) { v[j] = v[j] - mean; s2 += (v[j].x * v[j].x + v[j].y * v[j].y) + (v[j].z * v[j].z + v[j].w * v[j].w); }
        const float rstd = rsqrtf(wave_sum(s2) * (1.f / D) + LN_EPS);
#pragma unroll
        for (int j = 0; j < 4; ++j) { v[j] = v[j] * rstd * gv[j] + bv[j];
            *(GAS f32x4*)(H + (size_t)row * D + 4 * lane + 256 * j) = v[j];
            *(GAS unsigned long long*)(HB + (size_t)row * D + 4 * lane + 256 * j) = (unsigned long long)pk2(v[j].x, v[j].y) | ((unsigned long long)pk2(v[j].z, v[j].w) << 32); }
        if (ROUTER) {
            float lg[20];
#pragma unroll 1
            for (int c = 0; c < 20; ++c) { float p = 0.f;
#pragma unroll
                for (int j = 0; j < 4; ++j) { const f32x4 wv = *(const LAS f32x4*)(sW + c * D + 4 * lane + 256 * j); p += (v[j].x * wv.x + v[j].y * wv.y) + (v[j].z * wv.z + v[j].w * wv.w); }
                p = wave_sum(p); if (lane == 0) sL[c] = p; }
#pragma unroll
            for (int c = 0; c < 20; ++c) lg[c] = sL[c];
            float pg[4], mx = -1e30f; int gi = 0;
#pragma unroll
            for (int c = 0; c < 4; ++c) { pg[c] = lg[c] + a->in[I_BRG][l * 4 + c]; if (pg[c] > mx) { mx = pg[c]; gi = c; } }
            float den = 0.f;
#pragma unroll
            for (int c = 0; c < 4; ++c) den += __expf(pg[c] - mx);
            const float g_p = 1.0f / den;
            float le[4], emx = -1e30f; int i1 = 0;
#pragma unroll
            for (int c = 0; c < 4; ++c) { float x = 0.f;
#pragma unroll
                for (int gg = 0; gg < 4; ++gg) x = (gi == gg) ? lg[4 + gg * 4 + c] + a->in[I_BRE][l * 16 + gg * 4 + c] : x;
                le[c] = x; if (x > emx) { emx = x; i1 = c; } }
            float e2mx = -1e30f; int i2 = 0;
#pragma unroll
            for (int c = 0; c < 4; ++c) if (c != i1 && le[c] > e2mx) { e2mx = le[c]; i2 = c; }
            const float x2 = __expf(e2mx - emx), w1 = g_p / (1.0f + x2), w2 = g_p * x2 / (1.0f + x2);
            if (lane < 2) {
                const int e = gi * 4 + (lane == 0 ? i1 : i2); const float wv = lane == 0 ? w1 : w2;
                if (kk < 8) { const int lp = __hip_atomic_fetch_add(sCnt + e, 1, __ATOMIC_RELAXED, __HIP_MEMORY_SCOPE_WORKGROUP); LAS unsigned* en = sEnt + ((wave * 8 + kk) * 2 + lane) * 4;
                    en[0] = (unsigned)row; en[1] = (unsigned)e; en[2] = (unsigned)lp; en[3] = __builtin_bit_cast(unsigned, wv); }
                else { const int pos = (int)__hip_atomic_fetch_add(cnt + e, 1u, RLX_AGENT);
                    ((GAS int*)(a->ws + WS_LTOK))[e * M + pos] = row; ((GAS float*)(a->ws + WS_LW))[e * M + pos] = wv; ((GAS unsigned*)(a->ws + WS_SLOT))[2 * row + lane] = ((unsigned)e << 16) | (unsigned)pos; }
            }
        }
    }
    if (ROUTER) {
        __syncthreads();
        if (tid < 16) sCnt[16 + tid] = (int)__hip_atomic_fetch_add(cnt + tid, (unsigned)sCnt[tid], RLX_AGENT);
        __syncthreads();
        const int nk = kk < 8 ? kk : 8;
        if (tid < MAXENT) { const int wv_ = tid >> 4, k_ = (tid >> 1) & 7;
            int nkw = 0;
#pragma unroll
            for (int k2 = 0; k2 < 8; ++k2) nkw += (wg * NWAVES + wv_ + k2 * NGW < M) ? 1 : 0;
            if (k_ < nkw) { const LAS unsigned* en = sEnt + tid * 4; const int e = (int)en[1], pos = sCnt[16 + e] + (int)en[2];
                ((GAS int*)(a->ws + WS_LTOK))[e * M + pos] = (int)en[0]; ((GAS unsigned*)(a->ws + WS_LW))[e * M + pos] = en[3]; ((GAS unsigned*)(a->ws + WS_SLOT))[2 * en[0] + (tid & 1)] = ((unsigned)e << 16) | (unsigned)pos; } }
        (void)nk;
    }
}
__device__ __forceinline__ void moe_gather_phase(CArgs a, int l, LAS unsigned char* lds, int wg, int G, int tid) {
    asm volatile("" : "+v"(tid));
    const int lane = tid & 63, gw = wg * NWAVES + (tid >> 6), NGW = G * NWAVES;
    moe_tables((gu32*)(a->ws + WS_CTL) + CW_CNT + l * 16, lds, tid);
    const LAS int* tab = (const LAS int*)(lds + LDS_OFF_TAB);
    const bf16* HB = (const bf16*)(a->ws + WS_HB); bf16* XS = (bf16*)(a->ws + WS_XS);
    for (int idx = gw; idx < 2 * M; idx += NGW) {
        int e = 0;
#pragma unroll
        for (int k = 1; k < 16; ++k) e += (tab[17 + k] <= idx) ? 1 : 0;
        const int pos = idx - tab[17 + e], dst = tab[e] + pos;
        const int row = ((const GAS int*)(a->ws + WS_LTOK))[e * M + pos];
        const v4u x0 = *(const GAS v4u*)(HB + (size_t)row * D + 8 * lane), x1 = *(const GAS v4u*)(HB + (size_t)row * D + 512 + 8 * lane);
        *(GAS v4u*)(XS + (size_t)dst * D + 8 * lane) = x0; *(GAS v4u*)(XS + (size_t)dst * D + 512 + 8 * lane) = x1;
        if (lane == 0) ((GAS float*)(a->ws + WS_WSORT))[dst] = ((const GAS float*)(a->ws + WS_LW))[e * M + pos];
    }
}

enum { P_IN = 0, P_PREP, P_SCAN, P_POST, P_OUT, P_LN1, P_GU, P_DN, P_LN2, NPH };
constexpr int N_PHASES = 1 + DEPTH * NPH;
__global__ void __launch_bounds__(NTHR, 2) fwd(Args args) {
    extern __shared__ __attribute__((aligned(16))) unsigned char lds_raw[];
    LAS unsigned char* lds = (LAS unsigned char*)lds_raw;
    volatile LAS unsigned* MISC = (volatile LAS unsigned*)(lds + MISC_OFF);
    const int tid = threadIdx.x, G = gridDim.x, bx = blockIdx.x;
    unsigned char* ws0 = args.ws;
    gu32* ctl = (gu32*)(ws0 + WS_CTL);
    for (int u = tid; u < (LDS_BYTES - LDSCTL_OFF) / 4; u += NTHR) ((LAS unsigned*)(lds + LDSCTL_OFF))[u] = 0u;
    __syncthreads();
    const int lo = args.ph_lo, hi = args.ph_hi;
    const bool use_bar = (hi - lo) > 1;
    XcdBarrier bar; bar.bar = (unsigned*)(ctl + CW_BAR); bar.x = 0; bar.st = nullptr;
    if (use_bar) bar = xcd_barrier_post((unsigned*)(ctl + CW_BAR), MISC + 8);
#define IN(k) (lo <= (k) && (k) < hi)
#define SEAM(k) do { if (IN(k) && IN((k) + 1)) xcd_barrier(bar); } while (0)

    if (IN(0)) { p0_prologue(ARGS_HERE(), lds, bx, G, tid); weights_phase(ARGS_HERE(), 0, 1, lds, bx, G, tid); SEAM(0); }

    for (int l = 0; l < DEPTH; ++l) {
        const int base = 1 + l * NPH;
        unsigned char* ws = ws0; asm volatile("" : "+s"(ws));
        if (IN(base + P_IN)) {
            pg8::Gemm g{(const pg8::bf16_t*)(ws + WS_HB), (const pg8::bf16_t*)(ws + WS_WIN), M, NPROJ, D}; pg8::StaticOrder S; S.init(M, NPROJ, G, bx);
            pg8::EpiBf16<0> E{(pg8::bf16_t*)(ws + WS_PROJ), NPROJ, nullptr, 0, 0, 1.f};
            pg8::gemm_phase<pg8::EpiBf16<0>, pg8::StaticOrder, true, true>(lds + RING_OFF, g, S, E);
            SEAM(base + P_IN);
        }
        if (IN(base + P_PREP)) {
            hgrn_prep_phase(ARGS_HERE(), l, lds, bx, G, tid);
            ssd_prep_phase(ARGS_HERE(), l, lds, bx, G, tid);
            gdn_prep_phase(ARGS_HERE(), l, lds, bx, G, tid);
            SEAM(base + P_PREP); }
        if (IN(base + P_SCAN)) {
            if (G >= 192) {
                if (bx < 64) { const int pr = bx & 7, hh = bx >> 3; ssd_scan_phase(ARGS_HERE(), l, lds, pr >> 1, (pr & 1) * 8 + hh, tid); }
                else if (bx < 96) { const int x = (bx - 64) & 7, y = (bx - 64) >> 3, pr = x * 2 + (y >> 1); gdn_scan_phase(ARGS_HERE(), l, lds, pr >> 2, pr & 3, y & 1, tid); }
                else if (bx < 160) { const int x = (bx - 96) & 7, y = (bx - 96) >> 3, pr = x * 2 + (y >> 2); hgrn_scan_phase(ARGS_HERE(), l, lds, pr >> 2, pr & 3, y & 3, tid); }
                else { weights_phase(ARGS_HERE(), l, 14, lds, bx - 160, G - 160, tid);
                       if (l + 1 < DEPTH) weights_phase(ARGS_HERE(), l + 1, 1, lds, bx - 160, G - 160, tid); }
            }
            SEAM(base + P_SCAN); }
        if (IN(base + P_POST)) { mix_post_phase(ARGS_HERE(), l, bx, G, tid); SEAM(base + P_POST); }
        if (IN(base + P_OUT)) {
            pg8::Gemm g{(const pg8::bf16_t*)(ws + WS_YMIX), (const pg8::bf16_t*)(ws + WS_WOUT), M, D, DMIX}; pg8::StaticOrder S; S.init(M, D, G, bx);
            pg8::EpiF32 E{(float*)(ws + WS_MIX), D};
            pg8::gemm_phase<pg8::EpiF32, pg8::StaticOrder, true, true>(lds + RING_OFF, g, S, E);
            SEAM(base + P_OUT);
        }
        if (IN(base + P_LN1)) { CArgs a_ = ARGS_HERE(); ln_phase<true>(a_, l, a_->in[I_LN1G] + l * D, a_->in[I_LN1B] + l * D, lds, bx, G, tid); SEAM(base + P_LN1); }
        if (IN(base + P_GU)) {
            moe_tables(ctl + CW_CNT + l * 16, lds, tid);
            pg8::Gemm g{(const pg8::bf16_t*)(ws + WS_HB), (const pg8::bf16_t*)(ws + WS_WGU), MAXROWS, NGU, D}; pg8::MoeOrder<2, true> S{(const LAS int*)(lds + LDS_OFF_TAB), G, bx, (const int*)(ws + WS_LTOK), M};
            pg8::EpiSwiGLUs E{(pg8::bf16_t*)(ws + WS_HS), (const float*)(ws + WS_LW), M, (const LAS int*)(lds + LDS_OFF_TAB)};
            pg8::gemm_phase<pg8::EpiSwiGLUs, pg8::MoeOrder<2, true>, true, true>(lds + RING_OFF, g, S, E);
            SEAM(base + P_GU);
        }
        if (IN(base + P_DN)) {
            moe_tables(ctl + CW_CNT + l * 16, lds, tid);
            pg8::Gemm g{(const pg8::bf16_t*)(ws + WS_HS), (const pg8::bf16_t*)(ws + WS_WDN), MAXROWS, NEXP * D, DEXP}; pg8::MoeOrder<4> S{(const LAS int*)(lds + LDS_OFF_TAB), G, bx, nullptr, 0};
            pg8::EpiBf16s E{(pg8::bf16_t*)(ws + WS_YS)};
            pg8::gemm_phase<pg8::EpiBf16s, pg8::MoeOrder<4>, true, true>(lds + RING_OFF, g, S, E);
            SEAM(base + P_DN);
        }
        if (IN(base + P_LN2)) { CArgs a_ = ARGS_HERE(); ln_phase<false>(a_, l, a_->in[I_LN2G] + l * D, a_->in[I_LN2B] + l * D, lds, bx, G, tid); SEAM(base + P_LN2); }
    }
#undef IN
#undef SEAM
}

#ifndef MK_ONE_LAUNCH
#define MK_ONE_LAUNCH 1
#endif
extern "C" void kernel_launch(void* const* d_in, const int* in_sizes, int n_in, void* d_out, int out_size, void* d_ws, size_t ws_size, hipStream_t stream) {
    static int grid = 0;
    if (grid == 0) {
        if (n_in != 25 || out_size != M * D || ws_size < WS_END) { fprintf(stderr, "kernel_launch: unexpected shapes (n_in %d out %d ws %zu)\n", n_in, out_size, ws_size); grid = -1; return; }
        int dev = 0, cus = 0, per_cu = 0;
        if (hipGetDevice(&dev) != hipSuccess || hipDeviceGetAttribute(&cus, hipDeviceAttributeMultiprocessorCount, dev) != hipSuccess) { grid = -1; return; }
        if (hipFuncSetAttribute((const void*)fwd, hipFuncAttributeMaxDynamicSharedMemorySize, LDS_BYTES) != hipSuccess) { fprintf(stderr, "kernel_launch: hipFuncSetAttribute failed\n"); grid = -1; return; }
        if (hipOccupancyMaxActiveBlocksPerMultiprocessor(&per_cu, (const void*)fwd, NTHR, LDS_BYTES) != hipSuccess || per_cu < 1) { fprintf(stderr, "kernel_launch: occupancy query says %d\n", per_cu); (void)hipGetLastError(); grid = -1; return; }
        grid = cus;
    }
    if (grid < 0) return;
    if (hipMemsetAsync((char*)d_ws + WS_CTL, 0, CTL_ZERO_BYTES, stream) != hipSuccess) return;
    Args a{};
    for (int i = 0; i < 25; ++i) a.in[i] = (const float*)d_in[i];
    a.out = (float*)d_out; a.ws = (unsigned char*)d_ws;
#if MK_ONE_LAUNCH
    a.ph_lo = 0; a.ph_hi = N_PHASES;
    hipLaunchKernelGGL(fwd, dim3(grid), dim3(NTHR), LDS_BYTES, stream, a);
#else
    for (int p = 0; p < N_PHASES; ++p) { a.ph_lo = p; a.ph_hi = p + 1; hipLaunchKernelGGL(fwd, dim3(grid), dim3(NTHR), LDS_BYTES, stream, a); }
#endif
}
```

```cpp
#include <hip/hip_runtime.h>
#include <cstdio>
#include <cstdint>
namespace pg8 {
#define PG8_LAS __attribute__((address_space(3)))
typedef unsigned short bf16_t;
typedef short bf16x8 __attribute__((ext_vector_type(8)));
typedef float f32x4 __attribute__((ext_vector_type(4)));
typedef unsigned u32x4 __attribute__((ext_vector_type(4)));
constexpr int BM = 256, BK = 64, HALF = 128, HTB = HALF * BK * 2  , STAGE_BYTES = 8 * HTB, NXCD = 8, WGM = 8;

__host__ __device__ __forceinline__ int lds_byte(int r, int c) { const int st = (r >> 4) * 2 + (c >> 5), rr = r & 15, cc = c & 31, ob = rr * 64 + cc * 2; return st * 1024 + (ob ^ (((ob >> 9) & 1) << 5)); }
__host__ __device__ __forceinline__ void stage_rc(int b, int& R, int& C) { const int st = b / 1024, sb = b % 1024, swz = sb ^ (((sb >> 9) & 1) << 5); R = (st >> 1) * 16 + swz / 64; C = (st & 1) * 32 + (swz % 64) / 2; }
__host__ __device__ __forceinline__ int perm32(int rho) { const int n = rho >> 4, i = rho & 15; return 8 * (i >> 2) + 4 * n + (i & 3); }

struct Unit { int pm, pn; };
struct Gemm { const bf16_t* A; const bf16_t* Bt; int M, N, K; };

struct StaticOrder {
    static constexpr bool GATHER = false;
    int nM, nN, nwg, G, c;
    __host__ __device__ void init(int M, int N, int G_, int c_) { nM = M / BM; nN = N / BM; nwg = nM * nN; G = G_; c = c_; }
    __host__ __device__ bool next(int i, Unit& u) const {
        const long L = (long)i * G + c; if (L >= nwg) return false;
        int wgid = (int)L; { const int q = nwg / NXCD, r = nwg % NXCD, xcd = wgid % NXCD, off = wgid / NXCD; wgid = (xcd < r ? xcd * (q + 1) : r * (q + 1) + (xcd - r) * q) + off; }
        const int nig = WGM * nN, gid = wgid / nig, fm = gid * WGM, gsz = (nM - fm) < WGM ? (nM - fm) : WGM;
        u.pm = fm + ((wgid % nig) % gsz); u.pn = (wgid % nig) / gsz; return true;
    }
    __device__ __forceinline__ void a_ready(const Unit&) const {}
    __device__ __forceinline__ void done(const Unit&) const {}
    __device__ __forceinline__ int row_token(int, const Unit&) const { return 0; }
};
__device__ __forceinline__ unsigned cvt_pk_bf16(float lo, float hi) { unsigned r; asm volatile("v_cvt_pk_bf16_f32 %0, %1, %2" : "=v"(r) : "v"(lo), "v"(hi)); return r; }
typedef float f32x2 __attribute__((ext_vector_type(2)));
__device__ __forceinline__ f32x2 gelu_pk(f32x2 v) {
    const f32x2 av = __builtin_elementwise_abs(v), d = av * 0.2316418882f + 1.0f;
    f32x2 t; t.x = __builtin_amdgcn_rcpf(d.x); t.y = __builtin_amdgcn_rcpf(d.y);
    f32x2 q = t * 0.5307027145f + (-0.7265760135f); q = q * t + 0.7107068705f; q = q * t + (-0.142248368f); q = q * t + 0.127414796f; q = q * t;
    const f32x2 s = (v * v) * (-0.72134752044f);
    f32x2 e; e.x = __builtin_amdgcn_exp2f(s.x); e.y = __builtin_amdgcn_exp2f(s.y);
    const f32x2 m = v * (q * e), r = v - m;
    f32x2 o; o.x = v.x < 0.f ? m.x : r.x; o.y = v.y < 0.f ? m.y : r.y; return o;
}

template <int ACT  > struct EpiBf16 {
    static constexpr bool PERM = true, AFTER_DRAIN = false; static_assert(ACT == 0 || ACT == 1, "EpiBf16: ACT is 0 (none) or 1 (gelu_pk)");
    bf16_t* O; int ldc; const float* bias; int split_cols; size_t split_stride; float scale0;
    __device__ __forceinline__ void operator()(const f32x4 (&acc)[2][2][4][2], const Unit& u, int wr, int wc, int fr, int fq) const {
        const int row0 = u.pm * BM + wr * 64 + fr; int colt = u.pn * BM; bf16_t* base = O;
        float sc = 1.f; if (split_cols) { const int t = colt / split_cols; base += (size_t)t * split_stride; colt -= t * split_cols; if (t == 0) sc = scale0; }
        const int col0 = colt + wc * 32 + 8 * fq, bcol0 = u.pn * BM + wc * 32 + 8 * fq;
        f32x4 bv[2][2];
#pragma unroll
        for (int bj = 0; bj < 2; ++bj)
#pragma unroll
            for (int n = 0; n < 2; ++n) bv[bj][n] = bias ? *(const f32x4*)(bias + bcol0 + bj * HALF + 4 * n) : (f32x4){0.f, 0.f, 0.f, 0.f};
#pragma unroll
        for (int ai = 0; ai < 2; ++ai)
#pragma unroll
            for (int m = 0; m < 4; ++m) { bf16_t* rowp = base + (size_t)(row0 + ai * HALF + m * 16) * ldc + col0;
#pragma unroll
                for (int bj = 0; bj < 2; ++bj) { f32x4 v0 = acc[ai][bj][m][0] + bv[bj][0], v1 = acc[ai][bj][m][1] + bv[bj][1];
                    if (ACT == 1) { f32x2 a = gelu_pk((f32x2){v0[0], v0[1]}), b = gelu_pk((f32x2){v0[2], v0[3]}), c = gelu_pk((f32x2){v1[0], v1[1]}), d = gelu_pk((f32x2){v1[2], v1[3]});
                        v0 = (f32x4){a.x, a.y, b.x, b.y}; v1 = (f32x4){c.x, c.y, d.x, d.y}; }
                    v0 = v0 * sc; v1 = v1 * sc; u32x4 w; w.x = cvt_pk_bf16(v0[0], v0[1]); w.y = cvt_pk_bf16(v0[2], v0[3]); w.z = cvt_pk_bf16(v1[0], v1[1]); w.w = cvt_pk_bf16(v1[2], v1[3]);
                    *(u32x4*)(rowp + bj * HALF) = w; } }
    }
};
struct EpiF32 {
    static constexpr bool PERM = false, AFTER_DRAIN = false;
    float* C; int ldc;
    __device__ __forceinline__ void operator()(const f32x4 (&acc)[2][2][4][2], const Unit& u, int wr, int wc, int fr, int fq) const {
        const int row0 = u.pm * BM + wr * 64 + fr, col0 = u.pn * BM + wc * 32 + 4 * fq;
#pragma unroll
        for (int ai = 0; ai < 2; ++ai)
#pragma unroll
            for (int m = 0; m < 4; ++m) { float* rowp = C + (size_t)(row0 + ai * HALF + m * 16) * ldc + col0;
#pragma unroll
                for (int bj = 0; bj < 2; ++bj)
#pragma unroll
                    for (int n = 0; n < 2; ++n) *(f32x4*)(rowp + bj * HALF + n * 16) = acc[ai][bj][m][n]; }
    }
};
__device__ __forceinline__ float silu_f(float x) { return x * __builtin_amdgcn_rcpf(1.0f + __expf(-x)); }
struct EpiSwiGLU {
    static constexpr bool PERM = true, AFTER_DRAIN = false;
    bf16_t* H; int ldh; const float* comb; int ldcomb;
    __device__ __forceinline__ void operator()(const f32x4 (&acc)[2][2][4][2], const Unit& u, int wr, int wc, int fr, int fq) const {
        const int row0 = u.pm * BM + wr * 64 + fr, col0 = u.pn * 128 + wc * 32 + 8 * fq, e = u.pn >> 1;
#pragma unroll
        for (int ai = 0; ai < 2; ++ai)
#pragma unroll
            for (int m = 0; m < 4; ++m) { const int row = row0 + ai * HALF + m * 16; const float cw = comb[(size_t)row * ldcomb + e];
                const f32x4 g0 = acc[ai][0][m][0], g1 = acc[ai][0][m][1], u0 = acc[ai][1][m][0], u1 = acc[ai][1][m][1];
                f32x4 h0, h1;
#pragma unroll
                for (int j = 0; j < 4; ++j) { h0[j] = silu_f(g0[j]) * u0[j] * cw; h1[j] = silu_f(g1[j]) * u1[j] * cw; }
                u32x4 w; w.x = cvt_pk_bf16(h0[0], h0[1]); w.y = cvt_pk_bf16(h0[2], h0[3]); w.z = cvt_pk_bf16(h1[0], h1[1]); w.w = cvt_pk_bf16(h1[2], h1[3]);
                *(u32x4*)(H + (size_t)row * ldh + col0) = w; }
    }
};

template <int NSUB, bool GATHER_ = false> struct MoeOrder {
    static constexpr bool GATHER = GATHER_;
    const PG8_LAS int* off; int G, c; const int* ltok; int lstride;
    __device__ __forceinline__ int row_token(int srow, const Unit& u) const { const int e = u.pn / NSUB, pos = srow - off[e]; return pos < off[18 + e] - off[17 + e] ? ltok[e * lstride + pos] : 0; }
    __device__ __forceinline__ bool next(int i, Unit& u) const {
        const int L = i * G + c, x = L & 7, j = L >> 3, t = x + 8 * (j / NSUB), pnl = j % NSUB;
        if (t * 256 >= off[16]) return false;
        int e = 0;
#pragma unroll
        for (int k = 1; k < 16; ++k) e += (off[k] <= t * 256) ? 1 : 0;
        u.pm = t; u.pn = e * NSUB + pnl; return true;
    }
    __device__ __forceinline__ void a_ready(const Unit&) const {}
    __device__ __forceinline__ void done(const Unit&) const {}
};
struct EpiSwiGLUs {
    static constexpr bool PERM = true, AFTER_DRAIN = false;
    bf16_t* H; const float* lw; int lstride; const PG8_LAS int* off;
    __device__ __forceinline__ void operator()(const f32x4 (&acc)[2][2][4][2], const Unit& u, int wr, int wc, int fr, int fq) const {
        const int row0 = u.pm * BM + wr * 64 + fr, col0 = (u.pn & 1) * 128 + wc * 32 + 8 * fq;
#pragma unroll
        for (int ai = 0; ai < 2; ++ai)
#pragma unroll
            for (int m = 0; m < 4; ++m) { const int row = row0 + ai * HALF + m * 16; const int e_ = u.pn >> 1, pos_ = row - off[e_]; const float cw = pos_ < off[18 + e_] - off[17 + e_] ? lw[e_ * lstride + pos_] : 0.f;
                const f32x4 g0 = acc[ai][0][m][0], g1 = acc[ai][0][m][1], u0 = acc[ai][1][m][0], u1 = acc[ai][1][m][1];
                f32x4 h0, h1;
#pragma unroll
                for (int j = 0; j < 4; ++j) { h0[j] = silu_f(g0[j]) * u0[j] * cw; h1[j] = silu_f(g1[j]) * u1[j] * cw; }
                u32x4 w; w.x = cvt_pk_bf16(h0[0], h0[1]); w.y = cvt_pk_bf16(h0[2], h0[3]); w.z = cvt_pk_bf16(h1[0], h1[1]); w.w = cvt_pk_bf16(h1[2], h1[3]);
                *(u32x4*)(H + (size_t)row * 256 + col0) = w; }
    }
};
struct EpiBf16s {
    static constexpr bool PERM = true, AFTER_DRAIN = false;
    bf16_t* O;
    __device__ __forceinline__ void operator()(const f32x4 (&acc)[2][2][4][2], const Unit& u, int wr, int wc, int fr, int fq) const {
        const int row0 = u.pm * BM + wr * 64 + fr, col0 = (u.pn & 3) * BM + wc * 32 + 8 * fq;
#pragma unroll
        for (int ai = 0; ai < 2; ++ai)
#pragma unroll
            for (int m = 0; m < 4; ++m) { bf16_t* rowp = O + (size_t)(row0 + ai * HALF + m * 16) * 1024 + col0;
#pragma unroll
                for (int bj = 0; bj < 2; ++bj) { const f32x4 v0 = acc[ai][bj][m][0], v1 = acc[ai][bj][m][1];
                    u32x4 w; w.x = cvt_pk_bf16(v0[0], v0[1]); w.y = cvt_pk_bf16(v0[2], v0[3]); w.z = cvt_pk_bf16(v1[0], v1[1]); w.w = cvt_pk_bf16(v1[2], v1[3]);
                    *(u32x4*)(rowp + bj * HALF) = w; } }
    }
};
template <class Epi, class Sched, bool ALIGN_EPI = false, bool SP2 = false>
__device__ __forceinline__ void gemm_phase(PG8_LAS unsigned char* lds, const Gemm g, const Sched& S, const Epi& E) {
    int tid_ = threadIdx.x; asm volatile("" : "+v"(tid_));
    const int tid = tid_, wid = __builtin_amdgcn_readfirstlane(tid >> 6), lane = tid & 63, wr = wid >> 2, wc = wid & 3, fr = lane & 15, fq = lane >> 4;
    const int K = g.K, nt = K / BK;
    unsigned voffA[2], voffB[2];
#pragma unroll
    for (int i = 0; i < 2; ++i) { int R, C; stage_rc(tid * 16 + i * 8192, R, C); const int Rb = Epi::PERM ? ((R & ~31) + perm32(R & 31)) : R;
        voffA[i] = (unsigned)(R * K + C) * 2u; voffB[i] = (unsigned)(Rb * K + C) * 2u; }
    constexpr bool GATHER = Sched::GATHER; static_assert(!GATHER || SP2, "the gather path is written for the two-super-phase loop");
    int gR[2], gC[2];
#pragma unroll
    for (int i = 0; i < 2; ++i) stage_rc(tid * 16 + i * 8192, gR[i], gC[i]);
    unsigned vA0[2] = {0u, 0u}, vA1[2] = {0u, 0u}, nvA0[2] = {0u, 0u}, nvA1[2] = {0u, 0u};
#define PG8_GLOOK(U, D0, D1) do { _Pragma("unroll") for (int _i = 0; _i < 2; ++_i) { \
        D0[_i] = (unsigned)S.row_token((U).pm * BM + gR[_i], (U)) * (unsigned)(K * 2) + (unsigned)gC[_i] * 2u; D1[_i] = (unsigned)S.row_token((U).pm * BM + HALF + gR[_i], (U)) * (unsigned)(K * 2) + (unsigned)gC[_i] * 2u; } } while (0)
    const size_t kstep = (size_t)(BK * 2);
    const size_t hstep = (size_t)HALF * K * 2;
    const size_t tstep = 2 * hstep;
    const unsigned ldsw = (unsigned)wid * 1024u;
    const int aoff = lds_byte(wr * 64 + fr, fq * 8), boff = lds_byte(wc * 32 + fr, fq * 8);
#define PG8_SA(b, h) (((b) * 2 + (h)) * HTB)
#define PG8_SB(b, h) ((4 + (b) * 2 + (h)) * HTB)
#define PG8_STAGE(bufoff, gbase, voff) do { _Pragma("unroll") for (int _i = 0; _i < 2; ++_i) \
        __builtin_amdgcn_global_load_lds((const unsigned*)((const char*)(gbase) + (voff)[_i]), (PG8_LAS unsigned*)(lds + (bufoff) + ldsw + _i * 8192), 16, 0, 0); } while (0)
#define PG8_LDA(dst, b, h) do { _Pragma("unroll") for (int m = 0; m < 4; ++m) _Pragma("unroll") for (int k = 0; k < 2; ++k) dst[m][k] = *(const PG8_LAS bf16x8*)(lds + PG8_SA(b, h) + aoff + m * 2048 + k * 1024); } while (0)
#define PG8_LDB(dst, b, h) do { _Pragma("unroll") for (int n = 0; n < 2; ++n) _Pragma("unroll") for (int k = 0; k < 2; ++k) dst[n][k] = *(const PG8_LAS bf16x8*)(lds + PG8_SB(b, h) + boff + n * 2048 + k * 1024); } while (0)
#define PG8_MMA(ai, bj, At, Bt) do { __builtin_amdgcn_s_setprio(1); _Pragma("unroll") for (int m = 0; m < 4; ++m) _Pragma("unroll") for (int n = 0; n < 2; ++n) _Pragma("unroll") for (int k = 0; k < 2; ++k) \
        acc[ai][bj][m][n] = __builtin_amdgcn_mfma_f32_16x16x32_bf16(Bt[n][k], At[m][k], acc[ai][bj][m][n], 0, 0, 0); __builtin_amdgcn_s_setprio(0); } while (0)
#define PG8_WAIT_V(n) asm volatile("s_waitcnt vmcnt(" #n ")" ::: "memory")
#define PG8_WAIT_L(n) asm volatile("s_waitcnt lgkmcnt(" #n ")" ::: "memory")
#define PG8_BAR __builtin_amdgcn_s_barrier()
#define PG8_SCHED __builtin_amdgcn_sched_barrier(0)
    Unit cur, nxt; int ui = 0;
    if (!S.next(0, cur)) return;
    f32x4 acc[2][2][4][2];
#pragma unroll
    for (int a = 0; a < 2; ++a)
#pragma unroll
        for (int b = 0; b < 2; ++b)
#pragma unroll
            for (int m = 0; m < 4; ++m)
#pragma unroll
                for (int n = 0; n < 2; ++n) acc[a][b][m][n] = (f32x4){0.f, 0.f, 0.f, 0.f};
    bf16x8 At[4][2], B0[2][2], B1[2][2];
    const char* cA = (const char*)g.A + (GATHER ? (size_t)0 : (size_t)cur.pm * tstep); const char* cB = (const char*)g.Bt + (size_t)cur.pn * tstep;
    if constexpr (GATHER) PG8_GLOOK(cur, vA0, vA1);
    S.a_ready(cur);
    if constexpr (SP2) {
        PG8_STAGE(PG8_SB(0, 0), cB, voffB); PG8_STAGE(PG8_SB(0, 1), cB + hstep, voffB);
        if constexpr (GATHER) { PG8_STAGE(PG8_SA(0, 0), cA, vA0); PG8_STAGE(PG8_SA(0, 1), cA, vA1); } else { PG8_STAGE(PG8_SA(0, 0), cA, voffA); PG8_STAGE(PG8_SA(0, 1), cA + hstep, voffA); }
        if (wr == 1) PG8_BAR;
        PG8_WAIT_V(2); PG8_BAR;
        PG8_STAGE(PG8_SB(1, 0), cB + kstep, voffB); if constexpr (GATHER) PG8_STAGE(PG8_SA(1, 0), cA + kstep, vA0); else PG8_STAGE(PG8_SA(1, 0), cA + kstep, voffA); PG8_STAGE(PG8_SB(1, 1), cB + hstep + kstep, voffB);
        PG8_WAIT_V(6); PG8_BAR;
    } else {
        PG8_STAGE(PG8_SB(0, 0), cB, voffB); PG8_STAGE(PG8_SA(0, 0), cA, voffA); PG8_STAGE(PG8_SB(0, 1), cB + hstep, voffB); PG8_STAGE(PG8_SA(0, 1), cA + hstep, voffA);
        if (wr == 1) PG8_BAR;
        PG8_WAIT_V(4); PG8_BAR;
        PG8_STAGE(PG8_SB(1, 0), cB + kstep, voffB); PG8_STAGE(PG8_SA(1, 0), cA + kstep, voffA); PG8_STAGE(PG8_SB(1, 1), cB + hstep + kstep, voffB);
        PG8_WAIT_V(6); PG8_BAR;
    }
    for (;;) {
        const bool has_next = S.next(ui + 1, nxt);
        const char* nA = (has_next && !GATHER) ? (const char*)g.A + (size_t)nxt.pm * tstep : cA; const char* nB = has_next ? (const char*)g.Bt + (size_t)nxt.pn * tstep : cB;
        if constexpr (GATHER) { if (has_next) PG8_GLOOK(nxt, nvA0, nvA1); else { nvA0[0] = vA0[0]; nvA0[1] = vA0[1]; nvA1[0] = vA1[0]; nvA1[1] = vA1[1]; } }
#pragma unroll 1
        for (int t = 0; t < nt; t += 2) {
            const bool last = (t == nt - 2);
            const char* a1 = cA + (size_t)(t + 1) * kstep;
            const char* a2 = last ? nA : cA + (size_t)(t + 2) * kstep; const char* b2 = last ? nB : cB + (size_t)(t + 2) * kstep;
            const char* a3 = a2 + kstep; const char* b3 = b2 + kstep;
            if (last && has_next) S.a_ready(nxt);
            if constexpr (SP2) {
            PG8_LDB(B0, 0, 0); PG8_LDB(B1, 0, 1); PG8_SCHED; PG8_LDA(At, 0, 0); if constexpr (GATHER) PG8_STAGE(PG8_SA(1, 1), a1, vA1); else PG8_STAGE(PG8_SA(1, 1), a1 + hstep, voffA);
            PG8_WAIT_V(8); PG8_WAIT_L(0); PG8_BAR; PG8_MMA(0, 0, At, B0); PG8_MMA(0, 1, At, B1); PG8_BAR; PG8_SCHED;
            PG8_LDA(At, 0, 1); PG8_STAGE(PG8_SB(0, 0), b2, voffB); PG8_STAGE(PG8_SB(0, 1), b2 + hstep, voffB); if constexpr (GATHER) { unsigned v_[2] = {last ? nvA0[0] : vA0[0], last ? nvA0[1] : vA0[1]}; PG8_STAGE(PG8_SA(0, 0), a2, v_); } else PG8_STAGE(PG8_SA(0, 0), a2, voffA);
            PG8_WAIT_V(8); PG8_WAIT_L(0); PG8_BAR; PG8_MMA(1, 0, At, B0); PG8_MMA(1, 1, At, B1); PG8_BAR; PG8_SCHED;
            PG8_LDB(B0, 1, 0); PG8_LDB(B1, 1, 1); PG8_SCHED; PG8_LDA(At, 1, 0); if constexpr (GATHER) { unsigned v_[2] = {last ? nvA1[0] : vA1[0], last ? nvA1[1] : vA1[1]}; PG8_STAGE(PG8_SA(0, 1), a2, v_); } else PG8_STAGE(PG8_SA(0, 1), a2 + hstep, voffA);
            PG8_WAIT_V(8); PG8_WAIT_L(0); PG8_BAR; PG8_MMA(0, 0, At, B0); PG8_MMA(0, 1, At, B1); PG8_BAR; PG8_SCHED;
            PG8_LDA(At, 1, 1); PG8_STAGE(PG8_SB(1, 0), b3, voffB); PG8_STAGE(PG8_SB(1, 1), b3 + hstep, voffB); if constexpr (GATHER) { unsigned v_[2] = {last ? nvA0[0] : vA0[0], last ? nvA0[1] : vA0[1]}; PG8_STAGE(PG8_SA(1, 0), a3, v_); } else PG8_STAGE(PG8_SA(1, 0), a3, voffA);
            PG8_WAIT_V(8); PG8_WAIT_L(0); PG8_BAR; PG8_MMA(1, 0, At, B0); PG8_MMA(1, 1, At, B1); PG8_BAR; PG8_SCHED;
            } else {
            PG8_LDB(B0, 0, 0); PG8_SCHED; PG8_LDA(At, 0, 0); PG8_STAGE(PG8_SA(1, 1), a1 + hstep, voffA);
            PG8_WAIT_L(8); PG8_BAR; PG8_WAIT_L(0); PG8_MMA(0, 0, At, B0); PG8_BAR; PG8_SCHED;
            PG8_LDB(B1, 0, 1); PG8_STAGE(PG8_SB(0, 0), b2, voffB);
            PG8_BAR; PG8_WAIT_L(0); PG8_MMA(0, 1, At, B1); PG8_BAR;
            PG8_LDA(At, 0, 1); PG8_STAGE(PG8_SA(0, 0), a2, voffA);
            PG8_BAR; PG8_WAIT_L(0); PG8_MMA(1, 0, At, B0); PG8_BAR; PG8_SCHED;
            PG8_STAGE(PG8_SB(0, 1), b2 + hstep, voffB);
            PG8_WAIT_V(6); PG8_BAR; PG8_MMA(1, 1, At, B1); PG8_BAR;
            PG8_LDB(B0, 1, 0); PG8_SCHED; PG8_LDA(At, 1, 0); PG8_STAGE(PG8_SA(0, 1), a2 + hstep, voffA);
            PG8_WAIT_L(8); PG8_BAR; PG8_WAIT_L(0); PG8_MMA(0, 0, At, B0); PG8_BAR; PG8_SCHED;
            PG8_LDB(B1, 1, 1); PG8_STAGE(PG8_SB(1, 0), b3, voffB);
            PG8_BAR; PG8_WAIT_L(0); PG8_MMA(0, 1, At, B1); PG8_BAR;
            PG8_LDA(At, 1, 1); PG8_STAGE(PG8_SA(1, 0), a3, voffA);
            PG8_BAR; PG8_WAIT_L(0); PG8_MMA(1, 0, At, B0); PG8_BAR; PG8_SCHED;
            PG8_STAGE(PG8_SB(1, 1), b3 + hstep, voffB);
            PG8_WAIT_V(6); PG8_BAR; PG8_MMA(1, 1, At, B1); PG8_BAR;
            }
        }
        if constexpr (ALIGN_EPI) { if (wr == 0) PG8_BAR; }
        if constexpr (!Epi::AFTER_DRAIN) { E(acc, cur, wr, wc, fr, fq); S.done(cur); }
        if (!has_next) break;
#pragma unroll
        for (int a = 0; a < 2; ++a)
#pragma unroll
            for (int b = 0; b < 2; ++b)
#pragma unroll
                for (int m = 0; m < 4; ++m)
#pragma unroll
                    for (int n = 0; n < 2; ++n) acc[a][b][m][n] = (f32x4){0.f, 0.f, 0.f, 0.f};
        cur = nxt; cA = nA; cB = nB; ++ui;
        if constexpr (GATHER) { vA0[0] = nvA0[0]; vA0[1] = nvA0[1]; vA1[0] = nvA1[0]; vA1[1] = nvA1[1]; }
        if constexpr (ALIGN_EPI) { if (wr == 1) PG8_BAR; }
    }
    PG8_WAIT_V(0);
    if constexpr (!ALIGN_EPI) { if (wr == 0) PG8_BAR; }
    PG8_BAR;
    if constexpr (Epi::AFTER_DRAIN) { E.fused(acc, cur, wr, wc, fr, fq, lds, wid, lane); S.done(cur); }
#undef PG8_GLOOK
#undef PG8_SA
#undef PG8_SB
#undef PG8_STAGE
#undef PG8_LDA
#undef PG8_LDB
#undef PG8_MMA
#undef PG8_WAIT_V
#undef PG8_WAIT_L
#undef PG8_BAR
#undef PG8_SCHED
}
}
#define GAS __attribute__((address_space(1)))
#define LAS __attribute__((address_space(3)))
typedef unsigned short bf16;
typedef unsigned v4u __attribute__((ext_vector_type(4)));
typedef float f32x4 __attribute__((ext_vector_type(4)));
typedef short bf16x8 __attribute__((ext_vector_type(8)));
typedef GAS unsigned gu32;
typedef GAS unsigned long long gu64;
#define RLX_AGENT __ATOMIC_RELAXED, __HIP_MEMORY_SCOPE_AGENT
#define LDS_WAIT() asm volatile("s_waitcnt lgkmcnt(0)" ::: "memory")
#define VM_WAIT() asm volatile("s_waitcnt vmcnt(0)" ::: "memory")
__device__ __forceinline__ unsigned long long rt() { return __builtin_amdgcn_s_memrealtime(); }
typedef __bf16 bf16x2_hw __attribute__((ext_vector_type(2)));
__device__ __forceinline__ unsigned pk2(float lo, float hi) { bf16x2_hw v; v.x = (__bf16)lo; v.y = (__bf16)hi; return __builtin_bit_cast(unsigned, v); }
__device__ __forceinline__ unsigned f2bf(float f) { return pk2(f, 0.f) & 0xffffu; }

#define XB_TMO      128
#define XB_XCNT(j)  (256  + 64 * (j))
#define XB_XSUB(j)  (1280 + 64 * (j))
#define XB_XGEN(j)  (2304 + 64 * (j))
#define XB_TOP      3328
#define XB_TOPGEN   3392
#define XCD_BAR_WORDS 3456
#define XB_SPIN_CAP (1u << 18)

__device__ __forceinline__ unsigned xb_ld(unsigned* p)              { return __hip_atomic_load(p, __ATOMIC_RELAXED, __HIP_MEMORY_SCOPE_AGENT); }
__device__ __forceinline__ unsigned xb_add(unsigned* p, unsigned v) { return __hip_atomic_fetch_add(p, v, __ATOMIC_RELAXED, __HIP_MEMORY_SCOPE_AGENT); }
__device__ __forceinline__ unsigned xb_xcc_id() { return (unsigned)__builtin_amdgcn_s_getreg((3 << 11) | 20) & 0xFu; }
#define XB_SPIN(cond, bar) do { unsigned _sp = 0; while (cond) { __builtin_amdgcn_s_sleep(1); \
    if ((++_sp & 255u) == 0u) { if (xb_ld(&(bar)[XB_TMO])) break; if (_sp > XB_SPIN_CAP) { atomicAdd(&(bar)[XB_TMO], 1u); break; } } } } while (0)

struct XcdBarrier {
    unsigned* bar; unsigned x;
    volatile LAS unsigned* st;
};

__device__ __forceinline__ XcdBarrier xcd_barrier_post(unsigned* bar, volatile LAS unsigned* st) {
    XcdBarrier b; b.bar = bar; b.x = xb_xcc_id(); b.st = st;
    if (threadIdx.x == 0) (void)xb_add(&bar[XB_XCNT(b.x)], 1u);
    return b;
}
__device__ __forceinline__ void xcd_barrier_complete(unsigned* bar, unsigned x, unsigned& nloc, unsigned& nx) {
    const unsigned G = gridDim.x * gridDim.y * gridDim.z;
    unsigned sum, cnt, mine, sp = 0u;
    for (;;) {
        sum = 0u; cnt = 0u; mine = 0u;
#pragma unroll
        for (unsigned j = 0; j < 16; ++j) { const unsigned c = xb_ld(&bar[XB_XCNT(j)]); sum += c; cnt += (c > 0u) ? 1u : 0u; mine = (j == x) ? c : mine; }
        if (sum == G) break;
        __builtin_amdgcn_s_sleep(1);
        if ((++sp & 255u) == 0u) { if (xb_ld(&bar[XB_TMO])) break; if (sp > XB_SPIN_CAP) { atomicAdd(&bar[XB_TMO], 1u); break; } }
    }
    nloc = mine > 0u ? mine : 1u; nx = cnt > 0u ? cnt : 1u;
}

__device__ __forceinline__ void xcd_barrier(const XcdBarrier& b) {
    asm volatile("s_waitcnt vmcnt(0)" ::: "memory");
    __syncthreads();
    if (threadIdx.x == 0) {
        unsigned* bar = b.bar;
        __builtin_amdgcn_s_waitcnt(0);
        unsigned nloc = b.st[0], nx = b.st[1];
        if (nloc == 0u) { xcd_barrier_complete(bar, b.x, nloc, nx); b.st[0] = nloc; b.st[1] = nx; }
        const unsigned old = xb_add(&bar[XB_XSUB(b.x)], 1u);
        const unsigned gen = old / nloc;
        if (old + 1u == (gen + 1u) * nloc) {
            __builtin_amdgcn_fence(__ATOMIC_RELEASE, "agent");
            asm volatile("s_waitcnt vmcnt(0)" ::: "memory");
            const unsigned og = xb_add(&bar[XB_TOP], 1u);
            const unsigned tg = og / nx;
            if (og + 1u == (tg + 1u) * nx) xb_add(&bar[XB_TOPGEN], 1u);
            else XB_SPIN(xb_ld(&bar[XB_TOPGEN]) == tg, bar);
            __builtin_amdgcn_fence(__ATOMIC_ACQUIRE, "agent");
            xb_add(&bar[XB_XGEN(b.x)], 1u);
            asm volatile("s_waitcnt vmcnt(0)" ::: "memory");
        } else {
            XB_SPIN(xb_ld(&bar[XB_XGEN(b.x)]) == gen, bar);
            __builtin_amdgcn_fence(__ATOMIC_ACQUIRE, "agent");
            asm volatile("s_waitcnt vmcnt(0)" ::: "memory");
        }
    }
    __syncthreads();
}
constexpr int NWAVES = 8, NTHR = NWAVES * 64;
constexpr int D = 1024, BATCH = 4, SEQ = 4096, M = BATCH * SEQ, DEPTH = 4;
constexpr int IN_COLS = 6680, NPROJ = 6912;
constexpr int O_Z = 0, O_XBC = 1024, O_DT = 2560, O_QKV = 2576, O_GG = 4112, O_GB = 4624, O_GA = 4628, O_HQ = 4632, O_HF = 5144, O_HI = 5656, O_HG = 6168;
constexpr int DMIX = 2048, NEXP = 16, DEXP = 256, NGU = NEXP * 2 * DEXP  , KDN = NEXP * DEXP  ;
constexpr float DN_ALPHA = 1.6817928305074290f;
constexpr float LN_EPS = 1e-5f;

constexpr size_t MiB = 1u << 20;
constexpr size_t WS_CTL = 0, CTL_ZERO_BYTES = 1 * MiB;
constexpr size_t WS_LTOK = 2 * MiB;
constexpr size_t WS_LW = 3 * MiB;
constexpr size_t WS_SLOT = 4 * MiB;
constexpr size_t WS_WSORT = 5 * MiB;
constexpr size_t WS_WIN = 8 * MiB;
constexpr size_t WS_WOUT = 22 * MiB;
constexpr size_t WS_WGU = 26 * MiB;
constexpr size_t WS_WDN = 42 * MiB;
constexpr size_t WS_YMIX = 52 * MiB;
constexpr size_t WS_HB = WS_YMIX;
constexpr size_t WS_PROJ = 116 * MiB;
constexpr size_t WS_MIX = WS_PROJ;
constexpr int MAXROWS = 2 * M + 16 * 256;
constexpr size_t WS_XS = WS_PROJ + 64 * MiB;
constexpr size_t WS_HS = WS_PROJ + 136 * MiB;
constexpr size_t WS_YS = WS_PROJ + 154 * MiB;
constexpr int CW_CNT = 8192;
constexpr int LDS_OFF_TAB = 131072 + 1024;
constexpr size_t WS_SCR = 332 * MiB;
constexpr size_t WS_HG_QG = WS_SCR;
constexpr size_t WS_HG_KDT = WS_SCR + 16 * MiB;
constexpr size_t WS_HG_A = WS_SCR + 32 * MiB;
constexpr size_t WS_HG_GL = WS_SCR + 40 * MiB;
constexpr size_t WS_SSD_C = WS_SCR + 41 * MiB;
constexpr size_t WS_SSD_BT = WS_SCR + 49 * MiB;
constexpr size_t WS_SSD_CB = WS_SCR + 57 * MiB;
constexpr size_t WS_SSD_XT = WS_SCR + 65 * MiB;
constexpr size_t WS_SSD_AC = WS_SCR + 97 * MiB;
constexpr size_t WS_SSD_DT = WS_SCR + 98 * MiB;
constexpr size_t WS_GD_K = WS_SCR + 99 * MiB;
constexpr size_t WS_GD_KT = WS_SCR + 115 * MiB;
constexpr size_t WS_GD_QG = WS_SCR + 131 * MiB;
constexpr size_t WS_GD_VT = WS_SCR + 147 * MiB;
constexpr size_t WS_GD_T = WS_SCR + 163 * MiB;
constexpr size_t WS_GD_QK = WS_SCR + 171 * MiB;
constexpr size_t WS_GD_VEC = WS_SCR + 179 * MiB;
constexpr size_t WS_END = 512 * MiB;
constexpr int CW_BAR = 4096;

constexpr int RING_OFF = 0, RING_BYTES = 131072;
constexpr int LDSCTL_OFF = RING_BYTES, MISC_OFF = LDSCTL_OFF + 320;
constexpr int LDS_BYTES = 147456;

__device__ __forceinline__ float bf2f(unsigned short b) { return __builtin_bit_cast(float, ((unsigned)b) << 16); }
__device__ __forceinline__ float bflo(unsigned w) { return __builtin_bit_cast(float, w << 16); }
__device__ __forceinline__ float bfhi(unsigned w) { return __builtin_bit_cast(float, w & 0xffff0000u); }
__device__ __forceinline__ float siluf(float x) { return x * __builtin_amdgcn_rcpf(1.0f + __expf(-x)); }
__device__ __forceinline__ float sigmoidf_(float x) { return __builtin_amdgcn_rcpf(1.0f + __expf(-x)); }
__device__ __forceinline__ float softplusf_(float x) { return x > 20.f ? x : log1pf(__expf(x)); }
#define DPP_ADD(v, ctrl) ((v) + __builtin_bit_cast(float, __builtin_amdgcn_update_dpp(0, __builtin_bit_cast(int, (v)), (ctrl), 0xf, 0xf, false)))
__device__ __forceinline__ float wave_sum(float v) {
    v = DPP_ADD(v, 0xB1);
    v = DPP_ADD(v, 0x4E);
    v = DPP_ADD(v, 0x141);
    v = DPP_ADD(v, 0x140);
    const int iv = __builtin_bit_cast(int, v);
    return (__builtin_bit_cast(float, __builtin_amdgcn_readlane(iv, 0)) + __builtin_bit_cast(float, __builtin_amdgcn_readlane(iv, 16))) + (__builtin_bit_cast(float, __builtin_amdgcn_readlane(iv, 32)) + __builtin_bit_cast(float, __builtin_amdgcn_readlane(iv, 48)));
}
__device__ __forceinline__ float row16_sum(float v) {
    v = DPP_ADD(v, 0xB1); v = DPP_ADD(v, 0x4E); v = DPP_ADD(v, 0x141); v = DPP_ADD(v, 0x140); return v;
}

struct Args {
    const float* in[25]; float* out; unsigned char* ws; int ph_lo, ph_hi;
};
typedef const __attribute__((address_space(4))) Args* CArgs;
#define ARGS_HERE() ([]() { CArgs p_ = (CArgs)__builtin_amdgcn_kernarg_segment_ptr(); asm volatile("" : "+s"(p_)); return p_; }())
enum { I_X = 0, I_WIN, I_SCW, I_SCB, I_SDTB, I_SALOG, I_SD, I_SNW, I_GCW, I_GDTB, I_GALOG, I_GNW, I_HLB, I_HNW, I_WOUT, I_LN1G, I_LN1B, I_WRG, I_BRG, I_WRE, I_BRE, I_WGU, I_WDN, I_LN2G, I_LN2B };

__device__ __forceinline__ void transpose_item(const float* W, int ldw, int nvalid, int k0, int n0, bf16* WT, size_t ldt, int drow0, int dk0, LAS float* scr, int lane) {
#pragma unroll 8
    for (int i = 0; i < 32; ++i) { const int kk = 2 * i + (lane >> 5), nn = lane & 31, n = n0 + nn; scr[kk * 33 + nn] = (n < nvalid) ? W[(size_t)(k0 + kk) * ldw + n] : 0.f; }
    LDS_WAIT(); asm volatile("" ::: "memory");
    const int c = lane & 7;
#pragma unroll
    for (int j = 0; j < 4; ++j) { const int n = (lane >> 3) + 8 * j; const LAS float* s = scr + (8 * c) * 33 + n;
        v4u o; o.x = pk2(s[0 * 33], s[1 * 33]); o.y = pk2(s[2 * 33], s[3 * 33]); o.z = pk2(s[4 * 33], s[5 * 33]); o.w = pk2(s[6 * 33], s[7 * 33]);
        *(GAS v4u*)(WT + (size_t)(drow0 + n) * ldt + dk0 + k0 + 8 * c) = o; }
    LDS_WAIT(); asm volatile("" ::: "memory");
}
__device__ __forceinline__ void weights_phase(CArgs a, int l, const int which, LAS unsigned char* lds, int wwg, int nwg, int tid) {
    asm volatile("" : "+v"(tid));
    const int lane = tid & 63, wave = tid >> 6, gw = wwg * NWAVES + wave, NGW = nwg * NWAVES;
    LAS float* scr = (LAS float*)(lds + wave * 16384);
    constexpr int I_IN = 16 * (NPROJ / 32), I_OUT = (DMIX / 64) * (D / 32), I_GU = NEXP * 16 * 16, I_DN = NEXP * 4 * 32;
    const int n_in = (which & 1) ? I_IN : 0, n_out = (which & 2) ? I_OUT : 0, n_gu = (which & 4) ? I_GU : 0, n_dn = (which & 8) ? I_DN : 0;
    unsigned char* ws = a->ws;
    for (int it = gw; it < n_in + n_out + n_gu + n_dn; it += NGW) {
        int r = it;
        if (r < n_in) { const int kb = r / (NPROJ / 32), nb = r % (NPROJ / 32);
            transpose_item(a->in[I_WIN] + (size_t)l * D * IN_COLS, IN_COLS, IN_COLS, 64 * kb, 32 * nb, (bf16*)(ws + WS_WIN), D, 32 * nb, 0, scr, lane); continue; }
        r -= n_in;
        if (r < n_out) { const int kb = r / (D / 32), nb = r % (D / 32);
            transpose_item(a->in[I_WOUT] + (size_t)l * DMIX * D, D, D, 64 * kb, 32 * nb, (bf16*)(ws + WS_WOUT), DMIX, 32 * nb, 0, scr, lane); continue; }
        r -= n_out;
        if (r < n_gu) { const int e = r / 256, q = r % 256, kb = q / 16, nb = q % 16, c0 = 32 * nb, bj = c0 / 256, hf = (c0 % 256) / 128, j0 = c0 % 128;
            transpose_item(a->in[I_WGU] + (size_t)(l * NEXP + e) * D * 512, 512, 512, 64 * kb, c0, (bf16*)(ws + WS_WGU), D, e * 512 + hf * 256 + bj * 128 + j0, 0, scr, lane); continue; }
        r -= n_gu;
        { const int e = r / 128, q = r % 128, kb = q / 32, nb = q % 32;
            transpose_item(a->in[I_WDN] + (size_t)(l * NEXP + e) * DEXP * D, D, D, 64 * kb, 32 * nb, (bf16*)(ws + WS_WDN), DEXP, e * D + 32 * nb, 0, scr, lane); }
    }
}
__device__ __forceinline__ void p0_prologue(CArgs a, LAS unsigned char* lds, int wg, int G, int tid) {
    asm volatile("" : "+v"(tid));
    const f32x4* x4 = (const f32x4*)a->in[I_X]; f32x4* h4 = (f32x4*)a->out; unsigned long long* hb8 = (unsigned long long*)(a->ws + WS_HB);
    for (size_t i = (size_t)wg * NTHR + tid; i < (size_t)M * D / 4; i += (size_t)G * NTHR) { const f32x4 v = x4[i]; h4[i] = v;
        hb8[i] = (unsigned long long)pk2(v.x, v.y) | ((unsigned long long)pk2(v.z, v.w) << 32); }
}

#define WG_BAR() do { asm volatile("s_waitcnt lgkmcnt(0)" ::: "memory"); __builtin_amdgcn_s_barrier(); asm volatile("" ::: "memory"); } while (0)
__device__ __forceinline__ f32x4 mfma16(bf16x8 x, bf16x8 y, f32x4 c) { return __builtin_amdgcn_mfma_f32_16x16x32_bf16(x, y, c, 0, 0, 0); }
__device__ __forceinline__ bf16x8 lds_frag(const LAS bf16* base, int row0, int stride, int k0, int lane) { return *(const LAS bf16x8*)(base + (row0 + (lane & 15)) * stride + k0 + 8 * (lane >> 4)); }
__device__ __forceinline__ bf16x8 pack8(const float* v) { v4u w; w.x = pk2(v[0], v[1]); w.y = pk2(v[2], v[3]); w.z = pk2(v[4], v[5]); w.w = pk2(v[6], v[7]); return __builtin_bit_cast(bf16x8, w); }
__device__ __forceinline__ unsigned long long pack4(f32x4 v) { return (unsigned long long)pk2(v[0], v[1]) | ((unsigned long long)pk2(v[2], v[3]) << 32); }

__device__ __forceinline__ void hgrn_prep_phase(CArgs a, int l, LAS unsigned char* lds, int wg, int G, int tid) {
    asm volatile("" : "+v"(tid));
    constexpr int LS = 132;
    LAS float* sQ = (LAS float*)lds; LAS float* sK = sQ + 64 * LS; LAS float* sB = sK + 64 * LS; LAS float* sT = sB + 64 * LS; LAS float* sLb = sT + 512;
    const bf16* PROJ = (const bf16*)(a->ws + WS_PROJ);
    const int lane = tid & 63, w = tid >> 6, r = lane & 15, q4 = lane >> 4;
    for (int unit = wg; unit < 1024; unit += G) {
        const int b = unit >> 8, head = (unit >> 6) & 3, c = unit & 63;
        const size_t row0 = (size_t)b * SEQ + c * 64;
        __syncthreads();
        if (tid < 128) {
            const int ch = head * 128 + tid; float lg[DEPTH], mx = -1e30f;
#pragma unroll
            for (int j = 0; j < DEPTH; ++j) { lg[j] = a->in[I_HLB][j * 512 + ch]; mx = fmaxf(mx, lg[j]); }
            float den = 0.f, num = 0.f;
#pragma unroll
            for (int j = 0; j < DEPTH; ++j) { const float e = __expf(lg[j] - mx); den += e; if (j >= 1 && j <= l) num += e; }
            sLb[tid] = num / den;
        }
        __syncthreads();
        for (int p = tid; p < 1024; p += NTHR) {
            const int t = p >> 4, d8 = (p & 15) * 8;
            const v4u qv = *(const GAS v4u*)(PROJ + (row0 + t) * NPROJ + O_HQ + head * 128 + d8), fv = *(const GAS v4u*)(PROJ + (row0 + t) * NPROJ + O_HF + head * 128 + d8);
#pragma unroll
            for (int i = 0; i < 4; ++i) {
                const int d = d8 + 2 * i; const float lb0 = sLb[d], lb1 = sLb[d + 1];
                sQ[t * LS + d] = siluf(bflo(qv[i])); sQ[t * LS + d + 1] = siluf(bfhi(qv[i]));
                const float f0 = lb0 + (1.f - lb0) * sigmoidf_(bflo(fv[i])), f1 = lb1 + (1.f - lb1) * sigmoidf_(bfhi(fv[i]));
                sK[t * LS + d] = 1.f - f0; sK[t * LS + d + 1] = 1.f - f1; sB[t * LS + d] = __logf(f0); sB[t * LS + d + 1] = __logf(f1);
            }
        }
        __syncthreads();
        {
            const int d = tid & 127, seg = tid >> 7; float run = 0.f, vals[16];
#pragma unroll
            for (int i = 0; i < 16; ++i) { run += sB[(seg * 16 + i) * LS + d]; vals[i] = run; }
            sT[seg * 128 + d] = run;
            __syncthreads();
            float off = 0.f;
#pragma unroll
            for (int s2 = 0; s2 < 3; ++s2) if (s2 < seg) off += sT[s2 * 128 + d];
#pragma unroll
            for (int i = 0; i < 16; ++i) sB[(seg * 16 + i) * LS + d] = vals[i] + off;
        }
        __syncthreads();
        bf16* qg = (bf16*)(a->ws + WS_HG_QG) + (size_t)unit * 64 * 128; bf16* kdt = (bf16*)(a->ws + WS_HG_KDT) + (size_t)unit * 128 * 64;
        bf16* am = (bf16*)(a->ws + WS_HG_A) + (size_t)unit * 64 * 64; float* gl = (float*)(a->ws + WS_HG_GL) + (size_t)unit * 128;
        for (int p = tid; p < 1024; p += NTHR) { const int t = p >> 4, d8 = (p & 15) * 8; float v[8];
#pragma unroll
            for (int jj = 0; jj < 8; ++jj) v[jj] = sQ[t * LS + d8 + jj] * __expf(sB[t * LS + d8 + jj]);
            *(GAS bf16x8*)(qg + t * 128 + d8) = pack8(v); }
        for (int p = tid; p < 1024; p += NTHR) { const int d = p >> 3, s8 = (p & 7) * 8; const float bl = sB[63 * LS + d]; float v[8];
#pragma unroll
            for (int jj = 0; jj < 8; ++jj) v[jj] = sK[(s8 + jj) * LS + d] * __expf(bl - sB[(s8 + jj) * LS + d]);
            *(GAS bf16x8*)(kdt + d * 64 + s8) = pack8(v); }
        if (tid < 128) gl[tid] = __expf(sB[63 * LS + tid]);
        for (int p = w; p < 16; p += NWAVES) {
            const int i = p >> 2, j = p & 3; f32x4 acc = {0.f, 0.f, 0.f, 0.f};
            if (j <= i) {
#pragma unroll
                for (int ks = 0; ks < 4; ++ks) { const int d0 = 32 * ks + 8 * q4, t = 16 * i + r, s_ = 16 * j + r; float qf[8], kf[8];
#pragma unroll
                    for (int jj = 0; jj < 8; ++jj) { const float ref = i ? sB[(16 * i - 1) * LS + d0 + jj] : 0.f;
                        qf[jj] = sQ[t * LS + d0 + jj] * __expf(sB[t * LS + d0 + jj] - ref); kf[jj] = sK[s_ * LS + d0 + jj] * __expf(ref - sB[s_ * LS + d0 + jj]); }
                    acc = mfma16(pack8(kf), pack8(qf), acc); }
                const int t = 16 * i + r;
#pragma unroll
                for (int ii = 0; ii < 4; ++ii) if (16 * j + 4 * q4 + ii > t) acc[ii] = 0.f;
            }
            *(GAS unsigned long long*)(am + (16 * i + r) * 64 + 16 * j + 4 * q4) = pack4(acc);
        }
    }
}
__device__ __forceinline__ void hgrn_scan_phase(CArgs a, int l, LAS unsigned char* lds, const int b, const int head, const int eb, int tid) {
    asm volatile("" : "+v"(tid));
    constexpr int QS = 136, KS = 72;
    constexpr int B_QG = 0, B_KDT = 17408, B_A = B_KDT + 18432, B_VT = B_A + 9216, B_GL = B_VT + 4608, BUF = B_GL + 512;
    LAS unsigned char* sST0 = lds + 2 * BUF;
    const bf16* PROJ = (const bf16*)(a->ws + WS_PROJ); bf16* YMIX = (bf16*)(a->ws + WS_YMIX);
    const int lane = tid & 63, w = tid >> 6, r = lane & 15, q4 = lane >> 4;
    {
        const size_t cu0 = (size_t)(b * 4 + head) * 64;
        const bf16* QG = (const bf16*)(a->ws + WS_HG_QG) + cu0 * 64 * 128; const bf16* KDT = (const bf16*)(a->ws + WS_HG_KDT) + cu0 * 128 * 64;
        const bf16* AM = (const bf16*)(a->ws + WS_HG_A) + cu0 * 64 * 64; const float* GL = (const float*)(a->ws + WS_HG_GL) + cu0 * 128;
        const bf16* VP = PROJ + (size_t)b * SEQ * NPROJ + O_HI + head * 128 + eb * 32;
        v4u rq[2], rk[2], ra, rv; f32x4 rg;
#define HG_LOAD(n) do { _Pragma("unroll") for (int i = 0; i < 2; ++i) { const int p = tid + NTHR * i; rq[i] = *(const GAS v4u*)(QG + (size_t)(n) * 8192 + (p >> 4) * 128 + (p & 15) * 8); \
            rk[i] = *(const GAS v4u*)(KDT + (size_t)(n) * 8192 + (p >> 3) * 64 + (p & 7) * 8); } \
            ra = *(const GAS v4u*)(AM + (size_t)(n) * 4096 + (tid >> 3) * 64 + (tid & 7) * 8); \
            if (tid < 256) rv = *(const GAS v4u*)(VP + (size_t)((n) * 64 + (tid >> 2)) * NPROJ + (tid & 3) * 8); \
            if (tid < 32) rg = *(const GAS f32x4*)(GL + (size_t)(n) * 128 + tid * 4); } while (0)
#define HG_STORE(bufp) do { LAS unsigned char* bp_ = (bufp); _Pragma("unroll") for (int i = 0; i < 2; ++i) { const int p = tid + NTHR * i; \
            *(LAS v4u*)(bp_ + B_QG + ((p >> 4) * QS + (p & 15) * 8) * 2) = rq[i]; *(LAS v4u*)(bp_ + B_KDT + ((p >> 3) * KS + (p & 7) * 8) * 2) = rk[i]; } \
            *(LAS v4u*)(bp_ + B_A + ((tid >> 3) * KS + (tid & 7) * 8) * 2) = ra; \
            if (tid < 256) { LAS bf16* vt = (LAS bf16*)(bp_ + B_VT); const int t_ = tid >> 2, e8 = (tid & 3) * 8; _Pragma("unroll") for (int i = 0; i < 4; ++i) { \
                vt[(e8 + 2 * i) * KS + t_] = (bf16)(rv[i] & 0xffffu); vt[(e8 + 2 * i + 1) * KS + t_] = (bf16)(rv[i] >> 16); } } \
            if (tid < 32) *(LAS f32x4*)(bp_ + B_GL + tid * 16) = rg; } while (0)
        __syncthreads();
        HG_LOAD(0);
        for (int i = tid; i < 8704 / 4; i += NTHR) ((LAS unsigned*)sST0)[i] = 0u;
        HG_STORE(lds);
        f32x4 accS[2] = {{0.f, 0.f, 0.f, 0.f}, {0.f, 0.f, 0.f, 0.f}};
        __syncthreads();
        for (int n = 0; n < 64; ++n) {
            const int cur = n & 1; LAS unsigned char* bp = lds + cur * BUF; LAS bf16* sST = (LAS bf16*)(sST0 + cur * 8704); LAS bf16* sSTn = (LAS bf16*)(sST0 + (cur ^ 1) * 8704);
            if (n + 1 < 64) HG_LOAD(n + 1);
            {
                const int tt = w >> 1, et = w & 1; f32x4 acc = {0.f, 0.f, 0.f, 0.f};
#pragma unroll
                for (int ks = 0; ks < 4; ++ks) acc = mfma16(lds_frag(sST, 16 * et, QS, 32 * ks, lane), lds_frag((LAS bf16*)(bp + B_QG), 16 * tt, QS, 32 * ks, lane), acc);
#pragma unroll
                for (int ks = 0; ks < 2; ++ks) acc = mfma16(lds_frag((LAS bf16*)(bp + B_VT), 16 * et, KS, 32 * ks, lane), lds_frag((LAS bf16*)(bp + B_A), 16 * tt, KS, 32 * ks, lane), acc);
                *(GAS unsigned long long*)(YMIX + ((size_t)b * SEQ + n * 64 + 16 * tt + r) * DMIX + 1536 + head * 128 + eb * 32 + 16 * et + 4 * q4) = pack4(acc);
            }
            {
                const f32x4 glv = *(const LAS f32x4*)(bp + B_GL + (16 * w + 4 * q4) * 4);
#pragma unroll
                for (int et = 0; et < 2; ++et) { accS[et] = accS[et] * glv;
#pragma unroll
                    for (int ks = 0; ks < 2; ++ks) accS[et] = mfma16(lds_frag((LAS bf16*)(bp + B_KDT), 16 * w, KS, 32 * ks, lane), lds_frag((LAS bf16*)(bp + B_VT), 16 * et, KS, 32 * ks, lane), accS[et]);
                    *(LAS unsigned long long*)(sSTn + (16 * et + r) * QS + 16 * w + 4 * q4) = pack4(accS[et]); }
            }
            if (n + 1 < 64) HG_STORE(lds + (cur ^ 1) * BUF);
            WG_BAR();
        }
#undef HG_LOAD
#undef HG_STORE
    }
}

__device__ __forceinline__ void ssd_rec_phase(CArgs a, int l, LAS unsigned char* lds, int wg, int G, int tid) {
    asm volatile("" : "+v"(tid));
    constexpr int TB = 64;
    LAS float* sX = (LAS float*)lds; LAS float* sB = sX + TB * 16; LAS float* sC = sB + TB * 128; LAS float* sDt = sC + TB * 128; LAS float* sDa = sDt + TB; LAS float* sY = sDa + TB;
    const bf16* PROJ = (const bf16*)(a->ws + WS_PROJ); bf16* YMIX = (bf16*)(a->ws + WS_YMIX);
    const float* cw = a->in[I_SCW] + (size_t)l * 4 * 1536; const float* cb = a->in[I_SCB] + (size_t)l * 1536;
    const int p_local = tid >> 5, nq = tid & 31;
    for (int unit = wg; unit < 256; unit += G) {
        const int b = unit >> 6, head = (unit >> 2) & 15, pq = unit & 3, g = head >> 3;
        const float A = -__expf(a->in[I_SALOG][l * 16 + head]), dtb = a->in[I_SDTB][l * 16 + head], Dsk = a->in[I_SD][l * 16 + head];
        float h0 = 0.f, h1 = 0.f, h2 = 0.f, h3 = 0.f;
        for (int t0 = 0; t0 < SEQ; t0 += TB) {
            __syncthreads();
            for (int idx = tid; idx < TB * 272; idx += NTHR) {
                const int tt = idx / 272, ci = idx % 272, t = t0 + tt;
                const int ch = ci < 16 ? head * 64 + pq * 16 + ci : (ci < 144 ? 1024 + g * 128 + (ci - 16) : 1280 + g * 128 + (ci - 144));
                float acc = cb[ch];
#pragma unroll
                for (int k = 0; k < 4; ++k) { const int ts = t - 3 + k; if (ts >= 0) acc += cw[k * 1536 + ch] * bf2f(PROJ[(size_t)(b * SEQ + ts) * NPROJ + O_XBC + ch]); }
                const float v = siluf(acc);
                if (ci < 16) sX[tt * 16 + ci] = v; else if (ci < 144) sB[tt * 128 + ci - 16] = v; else sC[tt * 128 + ci - 144] = v;
            }
            if (tid < TB) { const float raw = bf2f(PROJ[(size_t)(b * SEQ + t0 + tid) * NPROJ + O_DT + head]); const float dt = softplusf_(raw + dtb); sDt[tid] = dt; sDa[tid] = __expf(dt * A); }
            __syncthreads();
#pragma unroll 4
            for (int tt = 0; tt < TB; ++tt) {
                const float xv = sX[tt * 16 + p_local], da = sDa[tt], dx = sDt[tt] * xv;
                const f32x4 Bv = *(const LAS f32x4*)(sB + tt * 128 + nq * 4), Cv = *(const LAS f32x4*)(sC + tt * 128 + nq * 4);
                h0 = da * h0 + dx * Bv.x; h1 = da * h1 + dx * Bv.y; h2 = da * h2 + dx * Bv.z; h3 = da * h3 + dx * Bv.w;
                float part = (Cv.x * h0 + Cv.y * h1) + (Cv.z * h2 + Cv.w * h3);
                part += __shfl_xor(part, 1); part += __shfl_xor(part, 2); part += __shfl_xor(part, 4); part += __shfl_xor(part, 8); part += __shfl_xor(part, 16);
                if (nq == 0) sY[tt * 16 + p_local] = part + Dsk * xv;
            }
            __syncthreads();
            for (int idx = tid; idx < TB * 16; idx += NTHR) { const int tt = idx >> 4, i = idx & 15; YMIX[(size_t)(b * SEQ + t0 + tt) * DMIX + head * 64 + pq * 16 + i] = (bf16)f2bf(sY[idx]); }
        }
    }
}

__device__ __forceinline__ void ssd_prep_phase(CArgs a, int l, LAS unsigned char* lds, int wg, int G, int tid) {
    asm volatile("" : "+v"(tid));
    constexpr int PS = 136;
    LAS bf16* sB = (LAS bf16*)lds; LAS bf16* sC = sB + 128 * PS; LAS bf16* sXT = (LAS bf16*)lds; LAS float* sDt = (LAS float*)(lds + 2 * 128 * PS * 2); LAS bf16* sCB = (LAS bf16*)(lds + 2 * 128 * PS * 2 + 4096);
    const bf16* PROJ = (const bf16*)(a->ws + WS_PROJ);
    const float* cw = a->in[I_SCW] + (size_t)l * 4 * 1536; const float* cb = a->in[I_SCB] + (size_t)l * 1536;
    const int lane = tid & 63, w = tid >> 6, r = lane & 15, q4 = lane >> 4;
    for (int unit = wg; unit < 256; unit += G) {
        const int b = unit >> 6, c = (unit >> 1) & 31, g = unit & 1;
        const size_t row0 = (size_t)b * SEQ + c * 128;
        bf16* Cg = (bf16*)(a->ws + WS_SSD_C) + (size_t)unit * 16384; bf16* BTg = (bf16*)(a->ws + WS_SSD_BT) + (size_t)unit * 16384; bf16* CBg = (bf16*)(a->ws + WS_SSD_CB) + (size_t)unit * 16384;
        __syncthreads();
        {
            const int c16 = tid & 31, l0 = tid >> 5; const int ch = (c16 < 16 ? 1024 + g * 128 + c16 * 8 : 1280 + g * 128 + (c16 - 16) * 8);
            float wk[4][8], bias[8];
#pragma unroll
            for (int jj = 0; jj < 8; ++jj) { bias[jj] = cb[ch + jj];
#pragma unroll
                for (int k = 0; k < 4; ++k) wk[k][jj] = cw[k * 1536 + ch + jj]; }
            LAS bf16* dst = (c16 < 16 ? sB : sC) + (c16 & 15) * 8;
#pragma unroll 2
            for (int i = 0; i < 8; ++i) { const int ll = l0 + 16 * i; float acc[8];
#pragma unroll
                for (int jj = 0; jj < 8; ++jj) acc[jj] = bias[jj];
#pragma unroll
                for (int k = 0; k < 4; ++k) { const int ts = c * 128 + ll - 3 + k;
                    if (ts >= 0) { const v4u xv = *(const GAS v4u*)(PROJ + ((size_t)b * SEQ + ts) * NPROJ + O_XBC + ch);
#pragma unroll
                        for (int j = 0; j < 4; ++j) { acc[2 * j] += wk[k][2 * j] * bflo(xv[j]); acc[2 * j + 1] += wk[k][2 * j + 1] * bfhi(xv[j]); } } }
#pragma unroll
                for (int jj = 0; jj < 8; ++jj) acc[jj] = siluf(acc[jj]);
                *(LAS bf16x8*)(dst + ll * PS) = pack8(acc); }
        }
        {
            const int head = g * 8 + w; const float A = -__expf(a->in[I_SALOG][l * 16 + head]), dtb = a->in[I_SDTB][l * 16 + head];
            const int l2 = 2 * lane;
            const float dt0 = softplusf_(bf2f(PROJ[(row0 + l2) * NPROJ + O_DT + head]) + dtb), dt1 = softplusf_(bf2f(PROJ[(row0 + l2 + 1) * NPROJ + O_DT + head]) + dtb);
            const float da1 = dt1 * A; float sc = dt0 * A + da1;
#pragma unroll
            for (int o = 1; o < 64; o <<= 1) { const float t_ = __shfl_up(sc, o); if (lane >= o) sc += t_; }
            sDt[w * 128 + l2] = dt0; sDt[w * 128 + l2 + 1] = dt1;
            const size_t uh = (size_t)((b * 16 + head) * 32 + c) * 128;
            float* AC = (float*)(a->ws + WS_SSD_AC) + uh; float* DT = (float*)(a->ws + WS_SSD_DT) + uh;
            AC[l2] = sc - da1; AC[l2 + 1] = sc; DT[l2] = dt0; DT[l2 + 1] = dt1;
        }
        __syncthreads();
#pragma unroll
        for (int st = 0; st < 8; ++st) {
            f32x4 acc = {0.f, 0.f, 0.f, 0.f};
            if (st <= w) {
#pragma unroll
                for (int ks = 0; ks < 4; ++ks) acc = mfma16(lds_frag(sB, 16 * st, PS, 32 * ks, lane), lds_frag(sC, 16 * w, PS, 32 * ks, lane), acc); }
            *(LAS unsigned long long*)(sCB + (16 * w + r) * PS + 16 * st + 4 * q4) = pack4(acc);
        }
        __syncthreads();
        for (int f = w; f < 32; f += NWAVES) { const int tile = f >> 2, ks = f & 3;
            *(GAS v4u*)(Cg + f * 512 + lane * 8) = *(const LAS v4u*)(sC + (16 * tile + r) * PS + 32 * ks + 8 * q4);
            *(GAS v4u*)(CBg + f * 512 + lane * 8) = *(const LAS v4u*)(sCB + (16 * tile + r) * PS + 32 * ks + 8 * q4);
            const int n = 16 * tile + r, l0 = 32 * ks + 8 * q4; v4u o;
#pragma unroll
            for (int j = 0; j < 4; ++j) o[j] = (unsigned)sB[(l0 + 2 * j) * PS + n] | ((unsigned)sB[(l0 + 2 * j + 1) * PS + n] << 16);
            *(GAS v4u*)(BTg + f * 512 + lane * 8) = o; }
#pragma unroll 1
        for (int hf = 0; hf < 2; ++hf) {
            __syncthreads();
            {   const int cg = tid & 31, l0 = tid >> 5, chl = cg * 8, ch = g * 512 + hf * 256 + chl, hh = hf * 4 + (cg >> 3);
                float wk[4][8], bias[8];
#pragma unroll
                for (int jj = 0; jj < 8; ++jj) { bias[jj] = cb[ch + jj];
#pragma unroll
                    for (int k = 0; k < 4; ++k) wk[k][jj] = cw[k * 1536 + ch + jj]; }
#pragma unroll 2
                for (int i = 0; i < 8; ++i) { const int ll = l0 + 16 * i; float acc[8];
#pragma unroll
                    for (int jj = 0; jj < 8; ++jj) acc[jj] = bias[jj];
#pragma unroll
                    for (int k = 0; k < 4; ++k) { const int ts = c * 128 + ll - 3 + k;
                        if (ts >= 0) { const v4u xv = *(const GAS v4u*)(PROJ + ((size_t)b * SEQ + ts) * NPROJ + O_XBC + ch);
#pragma unroll
                            for (int j = 0; j < 4; ++j) { acc[2 * j] += wk[k][2 * j] * bflo(xv[j]); acc[2 * j + 1] += wk[k][2 * j + 1] * bfhi(xv[j]); } } }
                    const float dtv = sDt[hh * 128 + ll];
#pragma unroll
                    for (int jj = 0; jj < 8; ++jj) sXT[(chl + jj) * PS + ll] = (bf16)f2bf(siluf(acc[jj]) * dtv); }
            }
            __syncthreads();
            for (int p = tid; p < 4096; p += NTHR) { const int chl = p >> 4, l8 = (p & 15) * 8, hh = hf * 4 + (chl >> 6), pp = chl & 63;
                const size_t uh = (size_t)((b * 16 + g * 8 + hh) * 32 + c);
                *(GAS v4u*)((bf16*)(a->ws + WS_SSD_XT) + (uh * 64 + pp) * 128 + l8) = *(const LAS v4u*)(sXT + chl * PS + l8); }
        }
    }
}
__device__ __forceinline__ void ssd_scan_phase(CArgs a, int l, LAS unsigned char* lds, const int b, const int head, int tid) {
    asm volatile("" : "+v"(tid));
    constexpr int PS = 136, O_S = 0, O_X = 34816, O_AC = 69632, O_TE = 70656, O_DT = 71680;
    bf16* YMIX = (bf16*)(a->ws + WS_YMIX);
    const int lane = tid & 63, w = tid >> 6, r = lane & 15, q4 = lane >> 4;
    {
        const int g = head >> 3;
        const float Dsk = a->in[I_SD][l * 16 + head];
        const bf16* Cg = (const bf16*)(a->ws + WS_SSD_C) + (size_t)((b * 32) * 2 + g) * 16384 + (w * 4) * 512 + lane * 8;
        const bf16* CBg = (const bf16*)(a->ws + WS_SSD_CB) + (size_t)((b * 32) * 2 + g) * 16384 + (w * 4) * 512 + lane * 8;
        const bf16* BTg = (const bf16*)(a->ws + WS_SSD_BT) + (size_t)((b * 32) * 2 + g) * 16384 + (w * 4) * 512 + lane * 8;
        const size_t uh0 = (size_t)(b * 16 + head) * 32;
        const bf16* XTg = (const bf16*)(a->ws + WS_SSD_XT) + uh0 * 8192; const float* ACg = (const float*)(a->ws + WS_SSD_AC) + uh0 * 128; const float* DTg = (const float*)(a->ws + WS_SSD_DT) + uh0 * 128;
        v4u fC[4], fCB[4], fBT[4], rx[2]; float rac = 0.f, racl = 0.f, rdt = 0.f;
#define SSD_LDF(cc, dst, src) do { _Pragma("unroll") for (int ks = 0; ks < 4; ++ks) dst[ks] = *(const GAS v4u*)(src + (size_t)(cc) * 32768 + 512 * ks); } while (0)
#define SSD_LOADX(cc) do { _Pragma("unroll") for (int i = 0; i < 2; ++i) { const int p = tid + NTHR * i; rx[i] = *(const GAS v4u*)(XTg + (size_t)(cc) * 8192 + (p >> 4) * 128 + (p & 15) * 8); } \
            if (tid < 128) { rac = ACg[(cc) * 128 + tid]; racl = ACg[(cc) * 128 + 127]; rdt = DTg[(cc) * 128 + tid]; } } while (0)
#define SSD_STORE(bi) do { _Pragma("unroll") for (int i = 0; i < 2; ++i) { const int p = tid + NTHR * i; *(LAS v4u*)(lds + O_X + (bi) * 17408 + ((p >> 4) * PS + (p & 15) * 8) * 2) = rx[i]; } \
            if (tid < 128) { ((LAS float*)(lds + O_AC))[(bi) * 128 + tid] = rac; ((LAS float*)(lds + O_TE))[(bi) * 128 + tid] = __expf(racl - rac); ((LAS float*)(lds + O_DT))[(bi) * 128 + tid] = rdt; } } while (0)
        __syncthreads();
        SSD_LDF(0, fC, Cg); SSD_LDF(0, fCB, CBg); SSD_LDF(0, fBT, BTg); SSD_LOADX(0);
        for (int i = tid; i < 17408 / 4; i += NTHR) ((LAS unsigned*)(lds + O_S))[i] = 0u;
        SSD_STORE(0);
        f32x4 accS[4];
#pragma unroll
        for (int pt = 0; pt < 4; ++pt) accS[pt] = (f32x4){0.f, 0.f, 0.f, 0.f};
        __syncthreads();
        for (int c = 0; c < 32; ++c) {
            const int cur = c & 1;
            const LAS bf16* sS = (const LAS bf16*)(lds + O_S + cur * 17408); LAS bf16* sSn = (LAS bf16*)(lds + O_S + (cur ^ 1) * 17408); const LAS bf16* sXT = (const LAS bf16*)(lds + O_X + cur * 17408);
            const LAS float* sAc = (const LAS float*)(lds + O_AC) + cur * 128; const LAS float* sTe = (const LAS float*)(lds + O_TE) + cur * 128; const LAS float* sDt = (const LAS float*)(lds + O_DT) + cur * 128;
            const int cn = c + 1 < 32 ? c + 1 : c;
            SSD_LOADX(cn);
            const int lrow = 16 * w + r; const float ac_l = sAc[lrow];
            f32x4 accO[4], accD[4];
#pragma unroll
            for (int pt = 0; pt < 4; ++pt) { accO[pt] = (f32x4){0.f, 0.f, 0.f, 0.f}; accD[pt] = (f32x4){0.f, 0.f, 0.f, 0.f}; }
#pragma unroll
            for (int ks = 0; ks < 4; ++ks) { const bf16x8 yf = __builtin_bit_cast(bf16x8, fC[ks]);
#pragma unroll
                for (int pt = 0; pt < 4; ++pt) accO[pt] = mfma16(lds_frag(sS, 16 * pt, PS, 32 * ks, lane), yf, accO[pt]); }
            SSD_LDF(cn, fC, Cg);
#pragma unroll
            for (int ks = 0; ks < 4; ++ks) if (32 * ks <= 16 * w + 15) {
                float v[8]; const f32x4 a0 = *(const LAS f32x4*)(sAc + 32 * ks + 8 * q4), a1 = *(const LAS f32x4*)(sAc + 32 * ks + 8 * q4 + 4);
#pragma unroll
                for (int j = 0; j < 4; ++j) { const int s0 = 32 * ks + 8 * q4 + 2 * j; const float as0 = (2 * j < 4) ? a0[(2 * j) & 3] : a1[(2 * j) & 3], as1 = (2 * j + 1 < 4) ? a0[(2 * j + 1) & 3] : a1[(2 * j + 1) & 3];
                    v[2 * j] = (s0 <= lrow) ? bflo(fCB[ks][j]) * __expf(ac_l - as0) : 0.f; v[2 * j + 1] = (s0 + 1 <= lrow) ? bfhi(fCB[ks][j]) * __expf(ac_l - as1) : 0.f; }
                const bf16x8 yf = pack8(v);
#pragma unroll
                for (int pt = 0; pt < 4; ++pt) accD[pt] = mfma16(lds_frag(sXT, 16 * pt, PS, 32 * ks, lane), yf, accD[pt]); }
            SSD_LDF(cn, fCB, CBg);
            {   const float ea = __expf(ac_l), rdtl = Dsk / sDt[lrow];
#pragma unroll
                for (int pt = 0; pt < 4; ++pt) { f32x4 y = accO[pt] * ea + accD[pt];
#pragma unroll
                    for (int ii = 0; ii < 4; ++ii) y[ii] += rdtl * bf2f(sXT[(16 * pt + 4 * q4 + ii) * PS + lrow]);
                    *(GAS unsigned long long*)(YMIX + ((size_t)b * SEQ + c * 128 + lrow) * DMIX + head * 64 + 16 * pt + 4 * q4) = pack4(y); } }
            {   const float cd = __expf(sAc[127]);
#pragma unroll
                for (int pt = 0; pt < 4; ++pt) accS[pt] = accS[pt] * cd;
#pragma unroll
                for (int ks = 0; ks < 4; ++ks) { float v[8]; const f32x4 t0 = *(const LAS f32x4*)(sTe + 32 * ks + 8 * q4), t1 = *(const LAS f32x4*)(sTe + 32 * ks + 8 * q4 + 4);
#pragma unroll
                    for (int j = 0; j < 4; ++j) { const float ts0 = (2 * j < 4) ? t0[(2 * j) & 3] : t1[(2 * j) & 3], ts1 = (2 * j + 1 < 4) ? t0[(2 * j + 1) & 3] : t1[(2 * j + 1) & 3];
                        v[2 * j] = bflo(fBT[ks][j]) * ts0; v[2 * j + 1] = bfhi(fBT[ks][j]) * ts1; }
                    const bf16x8 xf = pack8(v);
#pragma unroll
                    for (int pt = 0; pt < 4; ++pt) accS[pt] = mfma16(xf, lds_frag(sXT, 16 * pt, PS, 32 * ks, lane), accS[pt]); }
#pragma unroll
                for (int pt = 0; pt < 4; ++pt) *(LAS unsigned long long*)(sSn + (16 * pt + r) * PS + 16 * w + 4 * q4) = pack4(accS[pt]);
            }
            SSD_LDF(cn, fBT, BTg);
            if (c + 1 < 32) SSD_STORE(cur ^ 1);
            WG_BAR();
        }
#undef SSD_LDF
#undef SSD_LOADX
#undef SSD_STORE
    }
}

__device__ __forceinline__ void gdn_prep_phase(CArgs a, int l, LAS unsigned char* lds, int wg, int G, int tid) {
    asm volatile("" : "+v"(tid));
    constexpr int PS = 136, TS = 72, MS = 68, TT = 65;
    LAS bf16* sKb = (LAS bf16*)lds; LAS bf16* sQb = sKb + 64 * PS; LAS bf16* sQG = sQb + 64 * PS; LAS bf16* sVT = sQG + 64 * PS;
    LAS float* sM = (LAS float*)(lds + 3 * 17408 + 18432); LAS float* sT = sM + 64 * MS; LAS float* sVec = sT + 64 * TT; LAS bf16* sQK = (LAS bf16*)(sVec + 256);
    const bf16* PROJ = (const bf16*)(a->ws + WS_PROJ);
    const float* cw = a->in[I_GCW] + (size_t)l * 4 * 1536;
    const int lane = tid & 63, w = tid >> 6, r = lane & 15, q4 = lane >> 4;
    for (int unit = wg; unit < 1024; unit += G) {
        const int b = unit >> 8, head = (unit >> 6) & 3, n = unit & 63;
        const size_t row0 = (size_t)b * SEQ + n * 64;
#define GW ((bf16*)(a->ws + WS_GD_K) + (size_t)unit * 8192)
#define GKT ((bf16*)(a->ws + WS_GD_KT) + (size_t)unit * 8192)
#define GQG ((bf16*)(a->ws + WS_GD_QG) + (size_t)unit * 8192)
#define GUT ((bf16*)(a->ws + WS_GD_VT) + (size_t)unit * 8192)
#define GT ((bf16*)(a->ws + WS_GD_T) + (size_t)unit * 4096)
#define GQK ((bf16*)(a->ws + WS_GD_QK) + (size_t)unit * 4096)
#define GVEC ((float*)(a->ws + WS_GD_VEC) + (size_t)unit * 256)
        __syncthreads();
        for (int i = tid; i < 64 * MS; i += NTHR) sM[i] = 0.f;
        if (w == 0) {
            const float nA = -__expf(a->in[I_GALOG][l * 4 + head]), dtb = a->in[I_GDTB][l * 4 + head];
            const size_t ro = (row0 + lane) * NPROJ;
            const float be = sigmoidf_(bf2f(PROJ[ro + O_GB + head])); float gsum = nA * softplusf_(bf2f(PROJ[ro + O_GA + head]) + dtb);
#pragma unroll
            for (int o = 1; o < 64; o <<= 1) { const float t_ = __shfl_up(gsum, o); if (lane >= o) gsum += t_; }
            const float glast = __shfl(gsum, 63), eg = __expf(gsum), cc = __expf(glast - gsum);
            sVec[lane] = gsum; sVec[64 + lane] = be; sVec[128 + lane] = eg;
            GVEC[lane] = be; GVEC[64 + lane] = eg; GVEC[128 + lane] = cc; GVEC[192 + lane] = __expf(glast);
        }
        __syncthreads();
        {
            float wq[4][2], wk_[4][2], wv[4][2];
#pragma unroll
            for (int k = 0; k < 4; ++k)
#pragma unroll
                for (int j = 0; j < 2; ++j) { wq[k][j] = cw[k * 1536 + head * 128 + 2 * lane + j]; wk_[k][j] = cw[k * 1536 + 512 + head * 128 + 2 * lane + j]; wv[k][j] = cw[k * 1536 + 1024 + head * 128 + 2 * lane + j]; }
#pragma unroll 4
            for (int i = 0; i < 8; ++i) { const int t = w + 8 * i; float q0 = 0.f, q1 = 0.f, k0 = 0.f, k1 = 0.f, v0 = 0.f, v1 = 0.f;
#pragma unroll
                for (int k = 0; k < 4; ++k) { const int ts = n * 64 + t - 3 + k;
                    if (ts >= 0) { const bf16* pr = PROJ + ((size_t)b * SEQ + ts) * NPROJ + O_QKV + head * 128 + 2 * lane;
                        const unsigned xq = *(const GAS unsigned*)pr, xk = *(const GAS unsigned*)(pr + 512), xv = *(const GAS unsigned*)(pr + 1024);
                        q0 += wq[k][0] * bflo(xq); q1 += wq[k][1] * bfhi(xq); k0 += wk_[k][0] * bflo(xk); k1 += wk_[k][1] * bfhi(xk); v0 += wv[k][0] * bflo(xv); v1 += wv[k][1] * bfhi(xv); } }
                q0 = siluf(q0); q1 = siluf(q1); k0 = siluf(k0); k1 = siluf(k1); v0 = siluf(v0); v1 = siluf(v1);
                const float sq = rsqrtf(wave_sum(q0 * q0 + q1 * q1) + 1e-6f) * 0.08838834764831845f, sk = rsqrtf(wave_sum(k0 * k0 + k1 * k1) + 1e-6f), eg = sVec[128 + t];
                *(LAS unsigned*)(sKb + t * PS + 2 * lane) = pk2(k0 * sk, k1 * sk); *(LAS unsigned*)(sQb + t * PS + 2 * lane) = pk2(q0 * sq, q1 * sq);
                *(LAS unsigned*)(sQG + t * PS + 2 * lane) = pk2(q0 * sq * eg, q1 * sq * eg);
                sVT[(2 * lane) * TS + t] = (bf16)f2bf(v0); sVT[(2 * lane + 1) * TS + t] = (bf16)f2bf(v1); }
        }
        __syncthreads();
        for (int p = w; p < 26; p += NWAVES) {
            int it, jt; bool isq;
            if (p < 10) { isq = false; it = p < 1 ? 0 : (p < 3 ? 1 : (p < 6 ? 2 : 3)); jt = p - (it * (it + 1)) / 2; } else { isq = true; it = (p - 10) >> 2; jt = (p - 10) & 3; }
            f32x4 acc = {0.f, 0.f, 0.f, 0.f};
            if (jt <= it) {
#pragma unroll
                for (int ks = 0; ks < 4; ++ks) acc = mfma16(lds_frag(sKb, 16 * jt, PS, 32 * ks, lane), lds_frag(isq ? sQb : sKb, 16 * it, PS, 32 * ks, lane), acc);
                const int i = 16 * it + r; const float gi = sVec[i], bi = sVec[64 + i];
#pragma unroll
                for (int ii = 0; ii < 4; ++ii) { const int j = 16 * jt + 4 * q4 + ii; const float dec = __expf(gi - sVec[j]);
                    acc[ii] = isq ? (j <= i ? acc[ii] * dec : 0.f) : (j < i ? acc[ii] * dec * bi : 0.f); }
            }
            if (isq) *(LAS unsigned long long*)(sQK + (16 * it + r) * TS + 16 * jt + 4 * q4) = pack4(acc);
            else *(LAS f32x4*)(sM + (16 * it + r) * MS + 16 * jt + 4 * q4) = acc;
        }
        __syncthreads();
        {
            LAS float* sX = (LAS float*)(sQK + 64 * TS);
            if (w < 4) {
                int zo = 0; asm volatile("" : "+v"(zo)); const LAS float* sMv = sM + zo + (16 * w) * MS + 16 * w;
                if (lane < 16) { float ud[16];
#pragma unroll
                    for (int rr = 0; rr < 16; ++rr) { float acc = -sMv[rr * MS + lane];
#pragma unroll
                        for (int j = 0; j < rr; ++j) acc -= sMv[rr * MS + j] * ud[j];
                        ud[rr] = acc; sT[(16 * w + rr) * TT + 16 * w + lane] = acc + ((rr == lane) ? 1.f : 0.f); } }
                for (int jb = w + 1; jb < 4; ++jb)
                    for (int idx = lane; idx < 256; idx += 64) sT[(16 * w + (idx >> 4)) * TT + 16 * jb + (idx & 15)] = 0.f;
            } else {
                for (int f = w - 4; f < 16; f += 4) { const int tile = f >> 2, ks = f & 3;
                    *(GAS v4u*)(GQG + f * 512 + lane * 8) = *(const LAS v4u*)(sQG + (16 * tile + r) * PS + 32 * ks + 8 * q4); }
                for (int f = w - 4; f < 8; f += 4) { const int tile = f >> 1, ks = f & 1;
                    *(GAS v4u*)(GQK + f * 512 + lane * 8) = *(const LAS v4u*)(sQK + (16 * tile + r) * TS + 32 * ks + 8 * q4); }
                for (int f = w - 4; f < 16; f += 4) { const int dt = f >> 1, ks = f & 1, d = 16 * dt + r, s0 = 32 * ks + 8 * q4; v4u o;
#pragma unroll
                    for (int j = 0; j < 4; ++j) o[j] = (unsigned)sKb[(s0 + 2 * j) * PS + d] | ((unsigned)sKb[(s0 + 2 * j + 1) * PS + d] << 16);
                    *(GAS v4u*)(GKT + f * 512 + lane * 8) = o; }
            }
            WG_BAR();
#pragma unroll
            for (int ib = 1; ib < 4; ++ib) {
                if (w < ib) { const int jb = w; f32x4 acc = {0.f, 0.f, 0.f, 0.f};
                    for (int kb = jb; kb < ib; ++kb)
#pragma unroll
                        for (int kc = 0; kc < 4; ++kc) acc = __builtin_amdgcn_mfma_f32_16x16x4f32(sM[(16 * ib + r) * MS + 16 * kb + 4 * kc + q4], sT[(16 * kb + 4 * kc + q4) * TT + 16 * jb + r], acc, 0, 0, 0);
                    LAS float* sx = sX + w * 272;
#pragma unroll
                    for (int rr = 0; rr < 4; ++rr) sx[(4 * q4 + rr) * 17 + r] = acc[rr];
                    asm volatile("s_waitcnt lgkmcnt(0)" ::: "memory");
                    f32x4 acc2 = {0.f, 0.f, 0.f, 0.f};
#pragma unroll
                    for (int kc = 0; kc < 4; ++kc) acc2 = __builtin_amdgcn_mfma_f32_16x16x4f32(sT[(16 * ib + r) * TT + 16 * ib + 4 * kc + q4], sx[(4 * kc + q4) * 17 + r], acc2, 0, 0, 0);
#pragma unroll
                    for (int rr = 0; rr < 4; ++rr) sT[(16 * ib + 4 * q4 + rr) * TT + 16 * jb + r] = -acc2[rr];
                }
                WG_BAR();
            }
        }
        {
            LAS bf16* sTb = (LAS bf16*)sM; LAS bf16* sKgT = sQb;
            { const int t = tid >> 3, s8 = (tid & 7) * 8; float v[8];
#pragma unroll
                for (int jj = 0; jj < 8; ++jj) v[jj] = sT[t * TT + s8 + jj];
                *(LAS bf16x8*)(sTb + t * TS + s8) = pack8(v); }
            for (int p = tid; p < 1024; p += NTHR) { const int d = p >> 3, s8 = (p & 7) * 8; float v[8], u8[8]; const v4u vv = *(const LAS v4u*)(sVT + d * TS + s8);
#pragma unroll
                for (int jj = 0; jj < 8; ++jj) { const float be = sVec[64 + s8 + jj]; v[jj] = bf2f(sKb[(s8 + jj) * PS + d]) * be * sVec[128 + s8 + jj]; u8[jj] = ((jj & 1) ? bfhi(vv[jj >> 1]) : bflo(vv[jj >> 1])) * be; }
                *(LAS bf16x8*)(sKgT + d * TS + s8) = pack8(v); *(LAS bf16x8*)(sVT + d * TS + s8) = pack8(u8); }
        }
        __syncthreads();
        {
            const LAS bf16* sTb = (const LAS bf16*)sM; const LAS bf16* sKgT = sQb; LAS bf16* sW = (LAS bf16*)((LAS unsigned char*)sM + 9216);
            const int st_ = w >> 1;
            const bf16x8 t0 = lds_frag(sTb, 16 * st_, TS, 0, lane), t1 = lds_frag(sTb, 16 * st_, TS, 32, lane);
#pragma unroll
            for (int c4_ = 0; c4_ < 4; ++c4_) { const int ct = (w & 1) * 4 + c4_;
                f32x4 aw = {0.f, 0.f, 0.f, 0.f}, au = {0.f, 0.f, 0.f, 0.f};
                aw = mfma16(lds_frag(sKgT, 16 * ct, TS, 0, lane), t0, aw); aw = mfma16(lds_frag(sKgT, 16 * ct, TS, 32, lane), t1, aw);
                au = mfma16(t0, lds_frag(sVT, 16 * ct, TS, 0, lane), au); au = mfma16(t1, lds_frag(sVT, 16 * ct, TS, 32, lane), au);
                *(LAS unsigned long long*)(sW + (16 * st_ + r) * PS + 16 * ct + 4 * q4) = pack4(aw);
                *(GAS unsigned long long*)(GUT + (ct * 4 + st_) * 256 + lane * 4) = pack4(au); }
        }
        __syncthreads();
        { const LAS bf16* sW = (const LAS bf16*)((LAS unsigned char*)sM + 9216);
            for (int f = w; f < 16; f += NWAVES) { const int tile = f >> 2, ks = f & 3;
                *(GAS v4u*)(GW + f * 512 + lane * 8) = *(const LAS v4u*)(sW + (16 * tile + r) * PS + 32 * ks + 8 * q4); } }
    }
#undef GW
#undef GKT
#undef GQG
#undef GUT
#undef GT
#undef GQK
#undef GVEC
}
__device__ __forceinline__ void gdn_scan_phase(CArgs a, int l, LAS unsigned char* lds, const int b, const int head, const int eb, int tid) {
    asm volatile("" : "+v"(tid));
    constexpr int PS = 136, TS = 72, O_ST = 0, O_RT = 34816, O_VN = O_RT + 9216, O_VC = O_VN + 9216;
    bf16* YMIX = (bf16*)(a->ws + WS_YMIX);
    const int lane = tid & 63, w = tid >> 6, r = lane & 15, q4 = lane >> 4, st = w >> 1, eh = w & 1;
    LAS bf16* sRT = (LAS bf16*)(lds + O_RT); LAS bf16* sVN = (LAS bf16*)(lds + O_VN); LAS bf16* sVC = (LAS bf16*)(lds + O_VC);
    {
        const size_t u0 = (size_t)(b * 4 + head) * 64;
        const bf16* pW = (const bf16*)(a->ws + WS_GD_K) + u0 * 8192 + (st * 4) * 512 + lane * 8; const bf16* pQG = (const bf16*)(a->ws + WS_GD_QG) + u0 * 8192 + (st * 4) * 512 + lane * 8;
        const bf16* pQK = (const bf16*)(a->ws + WS_GD_QK) + u0 * 4096 + (st * 2) * 512 + lane * 8;
        const bf16* pKT = (const bf16*)(a->ws + WS_GD_KT) + u0 * 8192 + (w * 2) * 512 + lane * 8;
        const bf16* pUT = (const bf16*)(a->ws + WS_GD_VT) + u0 * 8192 + (size_t)(((eb * 4 + 2 * eh) * 4 + st) * 256) + lane * 4;
        const float* pVec = (const float*)(a->ws + WS_GD_VEC) + u0 * 256 + 16 * st + 4 * q4;
        v4u xW[4], yQG[4], yQK[2], xKT[2], nQG[4], nQK[2]; unsigned long long uT[2]; f32x4 c4; float gl;
#define GD_LD_A(nn) do { _Pragma("unroll") for (int ks = 0; ks < 4; ++ks) xW[ks] = *(const GAS v4u*)(pW + (size_t)(nn) * 8192 + 512 * ks); \
            _Pragma("unroll") for (int j = 0; j < 2; ++j) uT[j] = *(const GAS unsigned long long*)(pUT + (size_t)(nn) * 8192 + j * 1024); \
            c4 = *(const GAS f32x4*)(pVec + (size_t)(nn) * 256 + 128); } while (0)
#define GD_LD_C(nn, QG_, QK_) do { _Pragma("unroll") for (int ks = 0; ks < 4; ++ks) QG_[ks] = *(const GAS v4u*)(pQG + (size_t)(nn) * 8192 + 512 * ks); \
            _Pragma("unroll") for (int ks = 0; ks < 2; ++ks) QK_[ks] = *(const GAS v4u*)(pQK + (size_t)(nn) * 4096 + 512 * ks); } while (0)
#define GD_LD_D(nn) do { _Pragma("unroll") for (int ks = 0; ks < 2; ++ks) xKT[ks] = *(const GAS v4u*)(pKT + (size_t)(nn) * 8192 + 512 * ks); gl = pVec[(size_t)(nn) * 256 + 192 - (16 * st + 4 * q4)]; } while (0)
        __syncthreads();
        GD_LD_A(0); GD_LD_C(0, yQG, yQK); GD_LD_D(0);
        for (int i = tid; i < 17408 / 4; i += NTHR) ((LAS unsigned*)(lds + O_ST))[i] = 0u;
        f32x4 accS[4];
#pragma unroll
        for (int et = 0; et < 4; ++et) accS[et] = (f32x4){0.f, 0.f, 0.f, 0.f};
        __syncthreads();
        for (int n = 0; n < 64; ++n) {
            const int cur = n & 1; const LAS bf16* sST = (const LAS bf16*)(lds + O_ST + cur * 17408); LAS bf16* sSTn = (LAS bf16*)(lds + O_ST + (cur ^ 1) * 17408);
            const int nn = n + 1 < 64 ? n + 1 : n;
            {
                bf16x8 fs[2][4];
#pragma unroll
                for (int j = 0; j < 2; ++j)
#pragma unroll
                    for (int ks = 0; ks < 4; ++ks) fs[j][ks] = lds_frag(sST, 16 * (2 * eh + j), PS, 32 * ks, lane);
                __builtin_amdgcn_sched_barrier(0);
#pragma unroll
                for (int j = 0; j < 2; ++j) { const int e0 = 16 * (2 * eh + j); f32x4 acc = {0.f, 0.f, 0.f, 0.f};
#pragma unroll
                    for (int ks = 0; ks < 4; ++ks) acc = mfma16(__builtin_bit_cast(bf16x8, xW[ks]), fs[j][ks], acc);
                    const unsigned ulo = (unsigned)uT[j], uhi = (unsigned)(uT[j] >> 32); f32x4 vn;
                    vn[0] = bflo(ulo) - acc[0]; vn[1] = bfhi(ulo) - acc[1]; vn[2] = bflo(uhi) - acc[2]; vn[3] = bfhi(uhi) - acc[3];
                    *(LAS unsigned long long*)(sVN + (e0 + r) * TS + 16 * st + 4 * q4) = pack4(vn); *(LAS unsigned long long*)(sVC + (e0 + r) * TS + 16 * st + 4 * q4) = pack4(vn * c4); }
            }
            GD_LD_A(nn); GD_LD_C(nn, nQG, nQK);
            WG_BAR();
            {
                bf16x8 fv[4][2];
#pragma unroll
                for (int et = 0; et < 4; ++et)
#pragma unroll
                    for (int ks = 0; ks < 2; ++ks) fv[et][ks] = lds_frag(sVC, 16 * et, TS, 32 * ks, lane);
                __builtin_amdgcn_sched_barrier(0);
#pragma unroll
                for (int et = 0; et < 4; ++et) { accS[et] = accS[et] * gl;
#pragma unroll
                    for (int ks = 0; ks < 2; ++ks) accS[et] = mfma16(__builtin_bit_cast(bf16x8, xKT[ks]), fv[et][ks], accS[et]);
                    *(LAS unsigned long long*)(sSTn + (16 * et + r) * PS + 16 * w + 4 * q4) = pack4(accS[et]); }
            }
            GD_LD_D(nn);
            {
                bf16x8 fs[2][4], fn[2][2];
#pragma unroll
                for (int j = 0; j < 2; ++j) {
#pragma unroll
                    for (int ks = 0; ks < 4; ++ks) fs[j][ks] = lds_frag(sST, 16 * (2 * eh + j), PS, 32 * ks, lane);
#pragma unroll
                    for (int ks = 0; ks < 2; ++ks) fn[j][ks] = lds_frag(sVN, 16 * (2 * eh + j), TS, 32 * ks, lane); }
                __builtin_amdgcn_sched_barrier(0);
#pragma unroll
                for (int j = 0; j < 2; ++j) { const int e0 = 16 * (2 * eh + j); f32x4 acc = {0.f, 0.f, 0.f, 0.f};
#pragma unroll
                    for (int ks = 0; ks < 4; ++ks) acc = mfma16(fs[j][ks], __builtin_bit_cast(bf16x8, yQG[ks]), acc);
#pragma unroll
                    for (int ks = 0; ks < 2; ++ks) acc = mfma16(fn[j][ks], __builtin_bit_cast(bf16x8, yQK[ks]), acc);
                    *(GAS unsigned long long*)(YMIX + ((size_t)b * SEQ + n * 64 + 16 * st + r) * DMIX + 1024 + head * 128 + eb * 64 + e0 + 4 * q4) = pack4(acc); }
            }
#pragma unroll
            for (int ks = 0; ks < 4; ++ks) yQG[ks] = nQG[ks];
#pragma unroll
            for (int ks = 0; ks < 2; ++ks) yQK[ks] = nQK[ks];
            WG_BAR();
        }
#undef GD_LD_A
#undef GD_LD_C
#undef GD_LD_D
    }
}

__device__ __forceinline__ void gdn_rec_phase(CArgs a, int l, LAS unsigned char* lds, int wg, int G, int tid) {
    asm volatile("" : "+v"(tid));
    constexpr int TB = 32;
    LAS float* sQ = (LAS float*)lds; LAS float* sK = sQ + TB * 128; LAS float* sV = sK + TB * 128; LAS float* sBe = sV + TB * 8; LAS float* sAl = sBe + TB; LAS float* sO = sAl + TB;
    const bf16* PROJ = (const bf16*)(a->ws + WS_PROJ); bf16* YMIX = (bf16*)(a->ws + WS_YMIX);
    const float* cw = a->in[I_GCW] + (size_t)l * 4 * 1536;
    const int lane = tid & 63, w = tid >> 6;
    for (int unit = wg; unit < 256; unit += G) {
        const int b = unit >> 6, head = (unit >> 4) & 3, eb = unit & 15;
        const float nA = -__expf(a->in[I_GALOG][l * 4 + head]), dtb = a->in[I_GDTB][l * 4 + head];
        float S0 = 0.f, S1 = 0.f;
        for (int t0 = 0; t0 < SEQ; t0 += TB) {
            __syncthreads();
            for (int idx = tid; idx < TB * 264; idx += NTHR) {
                const int tt = idx / 264, ci = idx % 264, t = t0 + tt;
                const int ch = ci < 128 ? head * 128 + ci : (ci < 256 ? 512 + head * 128 + (ci - 128) : 1024 + head * 128 + eb * 8 + (ci - 256));
                float acc = 0.f;
#pragma unroll
                for (int k = 0; k < 4; ++k) { const int ts = t - 3 + k; if (ts >= 0) acc += cw[k * 1536 + ch] * bf2f(PROJ[(size_t)(b * SEQ + ts) * NPROJ + O_QKV + ch]); }
                const float v = siluf(acc);
                if (ci < 128) sQ[tt * 128 + ci] = v; else if (ci < 256) sK[tt * 128 + ci - 128] = v; else sV[tt * 8 + ci - 256] = v;
            }
            if (tid < TB) { const size_t ro = (size_t)(b * SEQ + t0 + tid) * NPROJ; const float braw = bf2f(PROJ[ro + O_GB + head]), araw = bf2f(PROJ[ro + O_GA + head]);
                sBe[tid] = sigmoidf_(braw); sAl[tid] = __expf(nA * softplusf_(araw + dtb)); }
            __syncthreads();
            for (int tt = w; tt < TB; tt += NWAVES) {
                const float q0 = sQ[tt * 128 + lane], q1 = sQ[tt * 128 + 64 + lane], k0 = sK[tt * 128 + lane], k1 = sK[tt * 128 + 64 + lane];
                const float sq = rsqrtf(wave_sum(q0 * q0 + q1 * q1) + 1e-6f) * 0.08838834764831845f, sk = rsqrtf(wave_sum(k0 * k0 + k1 * k1) + 1e-6f);
                sQ[tt * 128 + lane] = q0 * sq; sQ[tt * 128 + 64 + lane] = q1 * sq; sK[tt * 128 + lane] = k0 * sk; sK[tt * 128 + 64 + lane] = k1 * sk;
            }
            __syncthreads();
#pragma unroll 2
            for (int tt = 0; tt < TB; ++tt) {
                const float k0 = sK[tt * 128 + lane], k1 = sK[tt * 128 + 64 + lane], q0 = sQ[tt * 128 + lane], q1 = sQ[tt * 128 + 64 + lane];
                const float al = sAl[tt], be = sBe[tt], v = sV[tt * 8 + w];
                const float dot = wave_sum(k0 * S0 + k1 * S1);
                const float vn = be * (v - al * dot);
                S0 = al * S0 + k0 * vn; S1 = al * S1 + k1 * vn;
                const float od = wave_sum(q0 * S0 + q1 * S1);
                if (lane == 0) sO[tt * 8 + w] = od;
            }
            __syncthreads();
            if (tid < TB * 8) { const int tt = tid >> 3, i = tid & 7; YMIX[(size_t)(b * SEQ + t0 + tt) * DMIX + 1024 + head * 128 + eb * 8 + i] = (bf16)f2bf(sO[tid]); }
        }
    }
}

__device__ __forceinline__ void hgrn_rec_phase(CArgs a, int l, LAS unsigned char* lds, int wg, int G, int tid) {
    asm volatile("" : "+v"(tid));
    constexpr int TB = 32;
    LAS float* sQ = (LAS float*)lds; LAS float* sF = sQ + TB * 128; LAS float* sV = sF + TB * 128; LAS float* sO = sV + TB * 8; LAS float* sLb = sO + TB * 8;
    const bf16* PROJ = (const bf16*)(a->ws + WS_PROJ); bf16* YMIX = (bf16*)(a->ws + WS_YMIX);
    const int lane = tid & 63, w = tid >> 6;
    for (int unit = wg; unit < 256; unit += G) {
        const int b = unit >> 6, head = (unit >> 4) & 3, eb = unit & 15;
        __syncthreads();
        if (tid < 128) {
            const int c = head * 128 + tid; float lg[DEPTH], mx = -1e30f;
#pragma unroll
            for (int j = 0; j < DEPTH; ++j) { lg[j] = a->in[I_HLB][j * 512 + c]; mx = fmaxf(mx, lg[j]); }
            float den = 0.f, num = 0.f;
#pragma unroll
            for (int j = 0; j < DEPTH; ++j) { const float e = __expf(lg[j] - mx); den += e; if (j >= 1 && j <= l) num += e; }
            sLb[tid] = num / den;
        }
        float S0 = 0.f, S1 = 0.f;
        for (int t0 = 0; t0 < SEQ; t0 += TB) {
            __syncthreads();
            for (int idx = tid; idx < TB * 264; idx += NTHR) {
                const int tt = idx / 264, ci = idx % 264; const size_t ro = (size_t)(b * SEQ + t0 + tt) * NPROJ;
                if (ci < 128) sQ[tt * 128 + ci] = siluf(bf2f(PROJ[ro + O_HQ + head * 128 + ci]));
                else if (ci < 256) { const int d = ci - 128; const float lb = sLb[d]; sF[tt * 128 + d] = lb + (1.f - lb) * sigmoidf_(bf2f(PROJ[ro + O_HF + head * 128 + d])); }
                else sV[tt * 8 + ci - 256] = bf2f(PROJ[ro + O_HI + head * 128 + eb * 8 + (ci - 256)]);
            }
            __syncthreads();
#pragma unroll 2
            for (int tt = 0; tt < TB; ++tt) {
                const float f0 = sF[tt * 128 + lane], f1 = sF[tt * 128 + 64 + lane], q0 = sQ[tt * 128 + lane], q1 = sQ[tt * 128 + 64 + lane], v = sV[tt * 8 + w];
                S0 = f0 * S0 + (1.f - f0) * v; S1 = f1 * S1 + (1.f - f1) * v;
                const float od = wave_sum(q0 * S0 + q1 * S1);
                if (lane == 0) sO[tt * 8 + w] = od;
            }
            __syncthreads();
            if (tid < TB * 8) { const int tt = tid >> 3, i = tid & 7; YMIX[(size_t)(b * SEQ + t0 + tt) * DMIX + 1536 + head * 128 + eb * 8 + i] = (bf16)f2bf(sO[tid]); }
        }
    }
}

__device__ __forceinline__ void mix_post_phase(CArgs a, int l, int wg, int G, int tid) {
    asm volatile("" : "+v"(tid));
    const bf16* PROJ = (const bf16*)(a->ws + WS_PROJ); bf16* YMIX = (bf16*)(a->ws + WS_YMIX);
    const int lane = tid & 63, gw = wg * NWAVES + (tid >> 6), NGW = G * NWAVES;
    const float* snw = a->in[I_SNW] + l * 1024; const float* gnw = a->in[I_GNW] + l * 128; const float* hnw = a->in[I_HNW] + l * 128;
    for (int row = gw; row < M; row += NGW) {
        const bf16* pr = PROJ + (size_t)row * NPROJ; bf16* yr = YMIX + (size_t)row * DMIX;
#pragma unroll
        for (int j = 0; j < 2; ++j) {
            const int ch = j * 512 + lane * 8; const v4u yv = *(const GAS v4u*)(yr + ch), zv = *(const GAS v4u*)(pr + O_Z + ch);
            float v[8]; float ss = 0.f;
#pragma unroll
            for (int i = 0; i < 4; ++i) { v[2 * i] = bflo(yv[i]) * siluf(bflo(zv[i])); v[2 * i + 1] = bfhi(yv[i]) * siluf(bfhi(zv[i])); ss += v[2 * i] * v[2 * i] + v[2 * i + 1] * v[2 * i + 1]; }
            const float rstd = rsqrtf(wave_sum(ss) * (1.f / 512.f) + 1e-6f);
            v4u o;
#pragma unroll
            for (int i = 0; i < 4; ++i) o[i] = pk2(v[2 * i] * rstd * snw[ch + 2 * i], v[2 * i + 1] * rstd * snw[ch + 2 * i + 1]);
            *(GAS v4u*)(yr + ch) = o;
        }
#pragma unroll
        for (int part = 0; part < 2; ++part) {
            const int ch = lane * 8, yo = 1024 + part * 512 + ch, go = (part == 0 ? O_GG : O_HG) + ch; const float* nw = part == 0 ? gnw : hnw;
            const v4u yv = *(const GAS v4u*)(yr + yo), gv = *(const GAS v4u*)(pr + go);
            float v[8]; float ss = 0.f;
#pragma unroll
            for (int i = 0; i < 4; ++i) { v[2 * i] = bflo(yv[i]); v[2 * i + 1] = bfhi(yv[i]); ss += v[2 * i] * v[2 * i] + v[2 * i + 1] * v[2 * i + 1]; }
            ss = row16_sum(ss);
            const float rstd = rsqrtf(ss * (1.f / 128.f) + 1e-6f);
            v4u o;
#pragma unroll
            for (int i = 0; i < 4; ++i) { const int c = (ch & 127) + 2 * i; o[i] = pk2(v[2 * i] * rstd * nw[c] * siluf(bflo(gv[i])), v[2 * i + 1] * rstd * nw[c + 1] * siluf(bfhi(gv[i]))); }
            *(GAS v4u*)(yr + yo) = o;
        }
    }
}

__device__ __forceinline__ void moe_tables(const gu32* cnt, LAS unsigned char* lds, int tid) {
    LAS int* tab = (LAS int*)(lds + LDS_OFF_TAB);
    __syncthreads();
    if (tid == 0) { int p = 0, q = 0;
        for (int e = 0; e < 16; ++e) { const int c = (int)__hip_atomic_load(cnt + e, RLX_AGENT); tab[e] = p; tab[17 + e] = q; p += (c + 255) & ~255; q += c; }
        tab[16] = p; tab[33] = q; }
    __syncthreads();
}
template <bool ROUTER>
__device__ __forceinline__ void ln_phase(CArgs a, int l, const float* gam, const float* bet, LAS unsigned char* lds, int wg, int G, int tid) {
    asm volatile("" : "+v"(tid));
    const int lane = tid & 63, wave = tid >> 6, gw = wg * NWAVES + wave, NGW = G * NWAVES;
    const float* ADD = (const float*)(a->ws + WS_MIX); float* H = a->out; bf16* HB = (bf16*)(a->ws + WS_HB);
    gu32* cnt = (gu32*)(a->ws + WS_CTL) + CW_CNT + l * 16;
    LAS float* sW = (LAS float*)lds;
    LAS float* sL = sW + 20 * D + wave * 32;
    LAS int* sCnt = (LAS int*)(sW + 20 * D + 256);
    LAS unsigned* sEnt = (LAS unsigned*)(sCnt + 32);
    constexpr int MAXENT = 2 * NWAVES * 8;
    if (ROUTER) {
        __syncthreads();
        const float* wrg = a->in[I_WRG] + (size_t)l * D * 4; const float* wre = a->in[I_WRE] + (size_t)l * D * 16;
        for (int i = tid; i < D * 20; i += NTHR) { const int c = i >> 10, k = i & 1023; sW[i] = c < 4 ? wrg[k * 4 + c] : wre[k * 16 + c - 4]; }
        if (tid < 32) sCnt[tid] = 0;
        __syncthreads();
    } else moe_tables(cnt, lds, tid);
    const LAS int* tab = (const LAS int*)(lds + LDS_OFF_TAB);
    f32x4 gv[4], bv[4];
#pragma unroll
    for (int j = 0; j < 4; ++j) { gv[j] = *(const f32x4*)(gam + 4 * lane + 256 * j); bv[j] = *(const f32x4*)(bet + 4 * lane + 256 * j); }
    int kk = 0;
    f32x4 ph[4], pa[4];
    if (ROUTER && gw < M) {
#pragma unroll
        for (int j = 0; j < 4; ++j) { ph[j] = *(const GAS f32x4*)(H + (size_t)gw * D + 4 * lane + 256 * j); pa[j] = *(const GAS f32x4*)(ADD + (size_t)gw * D + 4 * lane + 256 * j); } }
    for (int row = gw; row < M; row += NGW, ++kk) {
        f32x4 v[4]; float s = 0.f;
        if (ROUTER) {
#pragma unroll
            for (int j = 0; j < 4; ++j) { v[j] = ph[j] * DN_ALPHA + pa[j]; s += (v[j].x + v[j].y) + (v[j].z + v[j].w); }
            const int nrow = row + NGW < M ? row + NGW : row;
#pragma unroll
            for (int j = 0; j < 4; ++j) { ph[j] = *(const GAS f32x4*)(H + (size_t)nrow * D + 4 * lane + 256 * j); pa[j] = *(const GAS f32x4*)(ADD + (size_t)nrow * D + 4 * lane + 256 * j); }
        } else {
            const unsigned s0 = ((const GAS unsigned*)(a->ws + WS_SLOT))[2 * row], s1 = ((const GAS unsigned*)(a->ws + WS_SLOT))[2 * row + 1];
            const bf16* y0 = (const bf16*)(a->ws + WS_YS) + (size_t)(tab[s0 >> 16] + (int)(s0 & 0xffffu)) * D; const bf16* y1 = (const bf16*)(a->ws + WS_YS) + (size_t)(tab[s1 >> 16] + (int)(s1 & 0xffffu)) * D;
#pragma unroll
            for (int j = 0; j < 4; ++j) { const f32x4 hv = *(const GAS f32x4*)(H + (size_t)row * D + 4 * lane + 256 * j);
                const unsigned long long p0 = *(const GAS unsigned long long*)(y0 + 4 * lane + 256 * j), p1 = *(const GAS unsigned long long*)(y1 + 4 * lane + 256 * j);
                f32x4 av; av.x = bflo((unsigned)p0) + bflo((unsigned)p1); av.y = bfhi((unsigned)p0) + bfhi((unsigned)p1); av.z = bflo((unsigned)(p0 >> 32)) + bflo((unsigned)(p1 >> 32)); av.w = bfhi((unsigned)(p0 >> 32)) + bfhi((unsigned)(p1 >> 32));
                v[j] = hv * DN_ALPHA + av; s += (v[j].x + v[j].y) + (v[j].z + v[j].w); }
        }
        const float mean = wave_sum(s) * (1.f / D); float s2 = 0.f;
#pragma unroll
        for (int j = 0; j < 4; ++j) { v[j] = v[j] - mean; s2 += (v[j].x * v[j].x + v[j].y * v[j].y) + (v[j].z * v[j].z + v[j].w * v[j].w); }
        const float rstd = rsqrtf(wave_sum(s2) * (1.f / D) + LN_EPS);
#pragma unroll
        for (int j = 0; j < 4; ++j) { v[j] = v[j] * rstd * gv[j] + bv[j];
            *(GAS f32x4*)(H + (size_t)row * D + 4 * lane + 256 * j) = v[j];
            *(GAS unsigned long long*)(HB + (size_t)row * D + 4 * lane + 256 * j) = (unsigned long long)pk2(v[j].x, v[j].y) | ((unsigned long long)pk2(v[j].z, v[j].w) << 32); }
        if (ROUTER) {
            float lg[20];
#pragma unroll 1
            for (int c = 0; c < 20; ++c) { float p = 0.f;
#pragma unroll
                for (int j = 0; j < 4; ++j) { const f32x4 wv = *(const LAS f32x4*)(sW + c * D + 4 * lane + 256 * j); p += (v[j].x * wv.x + v[j].y * wv.y) + (v[j].z * wv.z + v[j].w * wv.w); }
                p = wave_sum(p); if (lane == 0) sL[c] = p; }
#pragma unroll
            for (int c = 0; c < 20; ++c) lg[c] = sL[c];
            float pg[4], mx = -1e30f; int gi = 0;
#pragma unroll
            for (int c = 0; c < 4; ++c) { pg[c] = lg[c] + a->in[I_BRG][l * 4 + c]; if (pg[c] > mx) { mx = pg[c]; gi = c; } }
            float den = 0.f;
#pragma unroll
            for (int c = 0; c < 4; ++c) den += __expf(pg[c] - mx);
            const float g_p = 1.0f / den;
            float le[4], emx = -1e30f; int i1 = 0;
#pragma unroll
            for (int c = 0; c < 4; ++c) { float x = 0.f;
#pragma unroll
                for (int gg = 0; gg < 4; ++gg) x = (gi == gg) ? lg[4 + gg * 4 + c] + a->in[I_BRE][l * 16 + gg * 4 + c] : x;
                le[c] = x; if (x > emx) { emx = x; i1 = c; } }
            float e2mx = -1e30f; int i2 = 0;
#pragma unroll
            for (int c = 0; c < 4; ++c) if (c != i1 && le[c] > e2mx) { e2mx = le[c]; i2 = c; }
            const float x2 = __expf(e2mx - emx), w1 = g_p / (1.0f + x2), w2 = g_p * x2 / (1.0f + x2);
            if (lane < 2) {
                const int e = gi * 4 + (lane == 0 ? i1 : i2); const float wv = lane == 0 ? w1 : w2;
                if (kk < 8) { const int lp = __hip_atomic_fetch_add(sCnt + e, 1, __ATOMIC_RELAXED, __HIP_MEMORY_SCOPE_WORKGROUP); LAS unsigned* en = sEnt + ((wave * 8 + kk) * 2 + lane) * 4;
                    en[0] = (unsigned)row; en[1] = (unsigned)e; en[2] = (unsigned)lp; en[3] = __builtin_bit_cast(unsigned, wv); }
                else { const int pos = (int)__hip_atomic_fetch_add(cnt + e, 1u, RLX_AGENT);
                    ((GAS int*)(a->ws + WS_LTOK))[e * M + pos] = row; ((GAS float*)(a->ws + WS_LW))[e * M + pos] = wv; ((GAS unsigned*)(a->ws + WS_SLOT))[2 * row + lane] = ((unsigned)e << 16) | (unsigned)pos; }
            }
        }
    }
    if (ROUTER) {
        __syncthreads();
        if (tid < 16) sCnt[16 + tid] = (int)__hip_atomic_fetch_add(cnt + tid, (unsigned)sCnt[tid], RLX_AGENT);
        __syncthreads();
        const int nk = kk < 8 ? kk : 8;
        if (tid < MAXENT) { const int wv_ = tid >> 4, k_ = (tid >> 1) & 7;
            int nkw = 0;
#pragma unroll
            for (int k2 = 0; k2 < 8; ++k2) nkw += (wg * NWAVES + wv_ + k2 * NGW < M) ? 1 : 0;
            if (k_ < nkw) { const LAS unsigned* en = sEnt + tid * 4; const int e = (int)en[1], pos = sCnt[16 + e] + (int)en[2];
                ((GAS int*)(a->ws + WS_LTOK))[e * M + pos] = (int)en[0]; ((GAS unsigned*)(a->ws + WS_LW))[e * M + pos] = en[3]; ((GAS unsigned*)(a->ws + WS_SLOT))[2 * en[0] + (tid & 1)] = ((unsigned)e << 16) | (unsigned)pos; } }
        (void)nk;
    }
}
__device__ __forceinline__ void moe_gather_phase(CArgs a, int l, LAS unsigned char* lds, int wg, int G, int tid) {
    asm volatile("" : "+v"(tid));
    const int lane = tid & 63, gw = wg * NWAVES + (tid >> 6), NGW = G * NWAVES;
    moe_tables((gu32*)(a->ws + WS_CTL) + CW_CNT + l * 16, lds, tid);
    const LAS int* tab = (const LAS int*)(lds + LDS_OFF_TAB);
    const bf16* HB = (const bf16*)(a->ws + WS_HB); bf16* XS = (bf16*)(a->ws + WS_XS);
    for (int idx = gw; idx < 2 * M; idx += NGW) {
        int e = 0;
#pragma unroll
        for (int k = 1; k < 16; ++k) e += (tab[17 + k] <= idx) ? 1 : 0;
        const int pos = idx - tab[17 + e], dst = tab[e] + pos;
        const int row = ((const GAS int*)(a->ws + WS_LTOK))[e * M + pos];
        const v4u x0 = *(const GAS v4u*)(HB + (size_t)row * D + 8 * lane), x1 = *(const GAS v4u*)(HB + (size_t)row * D + 512 + 8 * lane);
        *(GAS v4u*)(XS + (size_t)dst * D + 8 * lane) = x0; *(GAS v4u*)(XS + (size_t)dst * D + 512 + 8 * lane) = x1;
        if (lane == 0) ((GAS float*)(a->ws + WS_WSORT))[dst] = ((const GAS float*)(a->ws + WS_LW))[e * M + pos];
    }
}

enum { P_IN = 0, P_PREP, P_SCAN, P_POST, P_OUT, P_LN1, P_GU, P_DN, P_LN2, NPH };
constexpr int N_PHASES = 1 + DEPTH * NPH;
__global__ void __launch_bounds__(NTHR, 2) fwd(Args args) {
    extern __shared__ __attribute__((aligned(16))) unsigned char lds_raw[];
    LAS unsigned char* lds = (LAS unsigned char*)lds_raw;
    volatile LAS unsigned* MISC = (volatile LAS unsigned*)(lds + MISC_OFF);
    const int tid = threadIdx.x, G = gridDim.x, bx = blockIdx.x;
    unsigned char* ws0 = args.ws;
    gu32* ctl = (gu32*)(ws0 + WS_CTL);
    for (int u = tid; u < (LDS_BYTES - LDSCTL_OFF) / 4; u += NTHR) ((LAS unsigned*)(lds + LDSCTL_OFF))[u] = 0u;
    __syncthreads();
    const int lo = args.ph_lo, hi = args.ph_hi;
    const bool use_bar = (hi - lo) > 1;
    XcdBarrier bar; bar.bar = (unsigned*)(ctl + CW_BAR); bar.x = 0; bar.st = nullptr;
    if (use_bar) bar = xcd_barrier_post((unsigned*)(ctl + CW_BAR), MISC + 8);
#define IN(k) (lo <= (k) && (k) < hi)
#define SEAM(k) do { if (IN(k) && IN((k) + 1)) xcd_barrier(bar); } while (0)

    if (IN(0)) { p0_prologue(ARGS_HERE(), lds, bx, G, tid); weights_phase(ARGS_HERE(), 0, 1, lds, bx, G, tid); SEAM(0); }

    for (int l = 0; l < DEPTH; ++l) {
        const int base = 1 + l * NPH;
        unsigned char* ws = ws0; asm volatile("" : "+s"(ws));
        if (IN(base + P_IN)) {
            pg8::Gemm g{(const pg8::bf16_t*)(ws + WS_HB), (const pg8::bf16_t*)(ws + WS_WIN), M, NPROJ, D}; pg8::StaticOrder S; S.init(M, NPROJ, G, bx);
            pg8::EpiBf16<0> E{(pg8::bf16_t*)(ws + WS_PROJ), NPROJ, nullptr, 0, 0, 1.f};
            pg8::gemm_phase<pg8::EpiBf16<0>, pg8::StaticOrder, true, true>(lds + RING_OFF, g, S, E);
            SEAM(base + P_IN);
        }
        if (IN(base + P_PREP)) {
            hgrn_prep_phase(ARGS_HERE(), l, lds, bx, G, tid);
            ssd_prep_phase(ARGS_HERE(), l, lds, bx, G, tid);
            gdn_prep_phase(ARGS_HERE(), l, lds, bx, G, tid);
            SEAM(base + P_PREP); }
        if (IN(base + P_SCAN)) {
            if (G >= 192) {
                if (bx < 64) { const int pr = bx & 7, hh = bx >> 3; ssd_scan_phase(ARGS_HERE(), l, lds, pr >> 1, (pr & 1) * 8 + hh, tid); }
                else if (bx < 96) { const int x = (bx - 64) & 7, y = (bx - 64) >> 3, pr = x * 2 + (y >> 1); gdn_scan_phase(ARGS_HERE(), l, lds, pr >> 2, pr & 3, y & 1, tid); }
                else if (bx < 160) { const int x = (bx - 96) & 7, y = (bx - 96) >> 3, pr = x * 2 + (y >> 2); hgrn_scan_phase(ARGS_HERE(), l, lds, pr >> 2, pr & 3, y & 3, tid); }
                else { weights_phase(ARGS_HERE(), l, 14, lds, bx - 160, G - 160, tid);
                       if (l + 1 < DEPTH) weights_phase(ARGS_HERE(), l + 1, 1, lds, bx - 160, G - 160, tid); }
            }
            SEAM(base + P_SCAN); }
        if (IN(base + P_POST)) { mix_post_phase(ARGS_HERE(), l, bx, G, tid); SEAM(base + P_POST); }
        if (IN(base + P_OUT)) {
            pg8::Gemm g{(const pg8::bf16_t*)(ws + WS_YMIX), (const pg8::bf16_t*)(ws + WS_WOUT), M, D, DMIX}; pg8::StaticOrder S; S.init(M, D, G, bx);
            pg8::EpiF32 E{(float*)(ws + WS_MIX), D};
            pg8::gemm_phase<pg8::EpiF32, pg8::StaticOrder, true, true>(lds + RING_OFF, g, S, E);
            SEAM(base + P_OUT);
        }
        if (IN(base + P_LN1)) { CArgs a_ = ARGS_HERE(); ln_phase<true>(a_, l, a_->in[I_LN1G] + l * D, a_->in[I_LN1B] + l * D, lds, bx, G, tid); SEAM(base + P_LN1); }
        if (IN(base + P_GU)) {
            moe_tables(ctl + CW_CNT + l * 16, lds, tid);
            pg8::Gemm g{(const pg8::bf16_t*)(ws + WS_HB), (const pg8::bf16_t*)(ws + WS_WGU), MAXROWS, NGU, D}; pg8::MoeOrder<2, true> S{(const LAS int*)(lds + LDS_OFF_TAB), G, bx, (const int*)(ws + WS_LTOK), M};
            pg8::EpiSwiGLUs E{(pg8::bf16_t*)(ws + WS_HS), (const float*)(ws + WS_LW), M, (const LAS int*)(lds + LDS_OFF_TAB)};
            pg8::gemm_phase<pg8::EpiSwiGLUs, pg8::MoeOrder<2, true>, true, true>(lds + RING_OFF, g, S, E);
            SEAM(base + P_GU);
        }
        if (IN(base + P_DN)) {
            moe_tables(ctl + CW_CNT + l * 16, lds, tid);
            pg8::Gemm g{(const pg8::bf16_t*)(ws + WS_HS), (const pg8::bf16_t*)(ws + WS_WDN), MAXROWS, NEXP * D, DEXP}; pg8::MoeOrder<4> S{(const LAS int*)(lds + LDS_OFF_TAB), G, bx, nullptr, 0};
            pg8::EpiBf16s E{(pg8::bf16_t*)(ws + WS_YS)};
            pg8::gemm_phase<pg8::EpiBf16s, pg8::MoeOrder<4>, true, true>(lds + RING_OFF, g, S, E);
            SEAM(base + P_DN);
        }
        if (IN(base + P_LN2)) { CArgs a_ = ARGS_HERE(); ln_phase<false>(a_, l, a_->in[I_LN2G] + l * D, a_->in[I_LN2B] + l * D, lds, bx, G, tid); SEAM(base + P_LN2); }
    }
#undef IN
#undef SEAM
}

#ifndef MK_ONE_LAUNCH
#define MK_ONE_LAUNCH 1
#endif
extern "C" void kernel_launch(void* const* d_in, const int* in_sizes, int n_in, void* d_out, int out_size, void* d_ws, size_t ws_size, hipStream_t stream) {
    static int grid = 0;
    if (grid == 0) {
        if (n_in != 25 || out_size != M * D || ws_size < WS_END) { fprintf(stderr, "kernel_launch: unexpected shapes (n_in %d out %d ws %zu)\n", n_in, out_size, ws_size); grid = -1; return; }
        int dev = 0, cus = 0, per_cu = 0;
        if (hipGetDevice(&dev) != hipSuccess || hipDeviceGetAttribute(&cus, hipDeviceAttributeMultiprocessorCount, dev) != hipSuccess) { grid = -1; return; }
        if (hipFuncSetAttribute((const void*)fwd, hipFuncAttributeMaxDynamicSharedMemorySize, LDS_BYTES) != hipSuccess) { fprintf(stderr, "kernel_launch: hipFuncSetAttribute failed\n"); grid = -1; return; }
        if (hipOccupancyMaxActiveBlocksPerMultiprocessor(&per_cu, (const void*)fwd, NTHR, LDS_BYTES) != hipSuccess || per_cu < 1) { fprintf(stderr, "kernel_launch: occupancy query says %d\n", per_cu); (void)hipGetLastError(); grid = -1; return; }
        grid = cus;
    }
    if (grid < 0) return;
    if (hipMemsetAsync((char*)d_ws + WS_CTL, 0, CTL_ZERO_BYTES, stream) != hipSuccess) return;
    Args a{};
    for (int i = 0; i < 25; ++i) a.in[i] = (const float*)d_in[i];
    a.out = (float*)d_out; a.ws = (unsigned char*)d_ws;
#if MK_ONE_LAUNCH
    a.ph_lo = 0; a.ph_hi = N_PHASES;
    hipLaunchKernelGGL(fwd, dim3(grid), dim3(NTHR), LDS_BYTES, stream, a);
#else
    for (int p = 0; p < N_PHASES; ++p) { a.ph_lo = p; a.ph_hi = p + 1; hipLaunchKernelGGL(fwd, dim3(grid), dim3(NTHR), LDS_BYTES, stream, a); }
#endif
}
```

```cpp
#include <hip/hip_runtime.h>
#include <cstdio>
#include <cstdint>
namespace pg8 {
#define PG8_LAS __attribute__((address_space(3)))
typedef unsigned short bf16_t;
typedef short bf16x8 __attribute__((ext_vector_type(8)));
typedef float f32x4 __attribute__((ext_vector_type(4)));
typedef unsigned u32x4 __attribute__((ext_vector_type(4)));
constexpr int BM = 256, BK = 64, HALF = 128, HTB = HALF * BK * 2  , STAGE_BYTES = 8 * HTB, NXCD = 8, WGM = 8;

__host__ __device__ __forceinline__ int lds_byte(int r, int c) { const int st = (r >> 4) * 2 + (c >> 5), rr = r & 15, cc = c & 31, ob = rr * 64 + cc * 2; return st * 1024 + (ob ^ (((ob >> 9) & 1) << 5)); }
__host__ __device__ __forceinline__ void stage_rc(int b, int& R, int& C) { const int st = b / 1024, sb = b % 1024, swz = sb ^ (((sb >> 9) & 1) << 5); R = (st >> 1) * 16 + swz / 64; C = (st & 1) * 32 + (swz % 64) / 2; }
__host__ __device__ __forceinline__ int perm32(int rho) { const int n = rho >> 4, i = rho & 15; return 8 * (i >> 2) + 4 * n + (i & 3); }

struct Unit { int pm, pn; };
struct Gemm { const bf16_t* A; const bf16_t* Bt; int M, N, K; };

struct StaticOrder {
    static constexpr bool GATHER = false;
    int nM, nN, nwg, G, c;
    __host__ __device__ void init(int M, int N, int G_, int c_) { nM = M / BM; nN = N / BM; nwg = nM * nN; G = G_; c = c_; }
    __host__ __device__ bool next(int i, Unit& u) const {
        const long L = (long)i * G + c; if (L >= nwg) return false;
        int wgid = (int)L; { const int q = nwg / NXCD, r = nwg % NXCD, xcd = wgid % NXCD, off = wgid / NXCD; wgid = (xcd < r ? xcd * (q + 1) : r * (q + 1) + (xcd - r) * q) + off; }
        const int nig = WGM * nN, gid = wgid / nig, fm = gid * WGM, gsz = (nM - fm) < WGM ? (nM - fm) : WGM;
        u.pm = fm + ((wgid % nig) % gsz); u.pn = (wgid % nig) / gsz; return true;
    }
    __device__ __forceinline__ void a_ready(const Unit&) const {}
    __device__ __forceinline__ void done(const Unit&) const {}
    __device__ __forceinline__ int row_token(int, const Unit&) const { return 0; }
};
__device__ __forceinline__ unsigned cvt_pk_bf16(float lo, float hi) { unsigned r; asm volatile("v_cvt_pk_bf16_f32 %0, %1, %2" : "=v"(r) : "v"(lo), "v"(hi)); return r; }
typedef float f32x2 __attribute__((ext_vector_type(2)));
__device__ __forceinline__ f32x2 gelu_pk(f32x2 v) {
    const f32x2 av = __builtin_elementwise_abs(v), d = av * 0.2316418882f + 1.0f;
    f32x2 t; t.x = __builtin_amdgcn_rcpf(d.x); t.y = __builtin_amdgcn_rcpf(d.y);
    f32x2 q = t * 0.5307027145f + (-0.7265760135f); q = q * t + 0.7107068705f; q = q * t + (-0.142248368f); q = q * t + 0.127414796f; q = q * t;
    const f32x2 s = (v * v) * (-0.72134752044f);
    f32x2 e; e.x = __builtin_amdgcn_exp2f(s.x); e.y = __builtin_amdgcn_exp2f(s.y);
    const f32x2 m = v * (q * e), r = v - m;
    f32x2 o; o.x = v.x < 0.f ? m.x : r.x; o.y = v.y < 0.f ? m.y : r.y; return o;
}

template <int ACT  > struct EpiBf16 {
    static constexpr bool PERM = true, AFTER_DRAIN = false; static_assert(ACT == 0 || ACT == 1, "EpiBf16: ACT is 0 (none) or 1 (gelu_pk)");
    bf16_t* O; int ldc; const float* bias; int split_cols; size_t split_stride; float scale0;
    __device__ __forceinline__ void operator()(const f32x4 (&acc)[2][2][4][2], const Unit& u, int wr, int wc, int fr, int fq) const {
        const int row0 = u.pm * BM + wr * 64 + fr; int colt = u.pn * BM; bf16_t* base = O;
        float sc = 1.f; if (split_cols) { const int t = colt / split_cols; base += (size_t)t * split_stride; colt -= t * split_cols; if (t == 0) sc = scale0; }
        const int col0 = colt + wc * 32 + 8 * fq, bcol0 = u.pn * BM + wc * 32 + 8 * fq;
        f32x4 bv[2][2];
#pragma unroll
        for (int bj = 0; bj < 2; ++bj)
#pragma unroll
            for (int n = 0; n < 2; ++n) bv[bj][n] = bias ? *(const f32x4*)(bias + bcol0 + bj * HALF + 4 * n) : (f32x4){0.f, 0.f, 0.f, 0.f};
#pragma unroll
        for (int ai = 0; ai < 2; ++ai)
#pragma unroll
            for (int m = 0; m < 4; ++m) { bf16_t* rowp = base + (size_t)(row0 + ai * HALF + m * 16) * ldc + col0;
#pragma unroll
                for (int bj = 0; bj < 2; ++bj) { f32x4 v0 = acc[ai][bj][m][0] + bv[bj][0], v1 = acc[ai][bj][m][1] + bv[bj][1];
                    if (ACT == 1) { f32x2 a = gelu_pk((f32x2){v0[0], v0[1]}), b = gelu_pk((f32x2){v0[2], v0[3]}), c = gelu_pk((f32x2){v1[0], v1[1]}), d = gelu_pk((f32x2){v1[2], v1[3]});
                        v0 = (f32x4){a.x, a.y, b.x, b.y}; v1 = (f32x4){c.x, c.y, d.x, d.y}; }
                    v0 = v0 * sc; v1 = v1 * sc; u32x4 w; w.x = cvt_pk_bf16(v0[0], v0[1]); w.y = cvt_pk_bf16(v0[2], v0[3]); w.z = cvt_pk_bf16(v1[0], v1[1]); w.w = cvt_pk_bf16(v1[2], v1[3]);
                    *(u32x4*)(rowp + bj * HALF) = w; } }
    }
};
struct EpiF32 {
    static constexpr bool PERM = false, AFTER_DRAIN = false;
    float* C; int ldc;
    __device__ __forceinline__ void operator()(const f32x4 (&acc)[2][2][4][2], const Unit& u, int wr, int wc, int fr, int fq) const {
        const int row0 = u.pm * BM + wr * 64 + fr, col0 = u.pn * BM + wc * 32 + 4 * fq;
#pragma unroll
        for (int ai = 0; ai < 2; ++ai)
#pragma unroll
            for (int m = 0; m < 4; ++m) { float* rowp = C + (size_t)(row0 + ai * HALF + m * 16) * ldc + col0;
#pragma unroll
                for (int bj = 0; bj < 2; ++bj)
#pragma unroll
                    for (int n = 0; n < 2; ++n) *(f32x4*)(rowp + bj * HALF + n * 16) = acc[ai][bj][m][n]; }
    }
};
__device__ __forceinline__ float silu_f(float x) { return x * __builtin_amdgcn_rcpf(1.0f + __expf(-x)); }
struct EpiSwiGLU {
    static constexpr bool PERM = true, AFTER_DRAIN = false;
    bf16_t* H; int ldh; const float* comb; int ldcomb;
    __device__ __forceinline__ void operator()(const f32x4 (&acc)[2][2][4][2], const Unit& u, int wr, int wc, int fr, int fq) const {
        const int row0 = u.pm * BM + wr * 64 + fr, col0 = u.pn * 128 + wc * 32 + 8 * fq, e = u.pn >> 1;
#pragma unroll
        for (int ai = 0; ai < 2; ++ai)
#pragma unroll
            for (int m = 0; m < 4; ++m) { const int row = row0 + ai * HALF + m * 16; const float cw = comb[(size_t)row * ldcomb + e];
                const f32x4 g0 = acc[ai][0][m][0], g1 = acc[ai][0][m][1], u0 = acc[ai][1][m][0], u1 = acc[ai][1][m][1];
                f32x4 h0, h1;
#pragma unroll
                for (int j = 0; j < 4; ++j) { h0[j] = silu_f(g0[j]) * u0[j] * cw; h1[j] = silu_f(g1[j]) * u1[j] * cw; }
                u32x4 w; w.x = cvt_pk_bf16(h0[0], h0[1]); w.y = cvt_pk_bf16(h0[2], h0[3]); w.z = cvt_pk_bf16(h1[0], h1[1]); w.w = cvt_pk_bf16(h1[2], h1[3]);
                *(u32x4*)(H + (size_t)row * ldh + col0) = w; }
    }
};

template <int NSUB, bool GATHER_ = false> struct MoeOrder {
    static constexpr bool GATHER = GATHER_;
    const PG8_LAS int* off; int G, c; const int* ltok; int lstride;
    __device__ __forceinline__ int row_token(int srow, const Unit& u) const { const int e = u.pn / NSUB, pos = srow - off[e]; return pos < off[18 + e] - off[17 + e] ? ltok[e * lstride + pos] : 0; }
    __device__ __forceinline__ bool next(int i, Unit& u) const {
        const int L = i * G + c, x = L & 7, j = L >> 3, t = x + 8 * (j / NSUB), pnl = j % NSUB;
        if (t * 256 >= off[16]) return false;
        int e = 0;
#pragma unroll
        for (int k = 1; k < 16; ++k) e += (off[k] <= t * 256) ? 1 : 0;
        u.pm = t; u.pn = e * NSUB + pnl; return true;
    }
    __device__ __forceinline__ void a_ready(const Unit&) const {}
    __device__ __forceinline__ void done(const Unit&) const {}
};
struct EpiSwiGLUs {
    static constexpr bool PERM = true, AFTER_DRAIN = false;
    bf16_t* H; const float* lw; int lstride; const PG8_LAS int* off;
    __device__ __forceinline__ void operator()(const f32x4 (&acc)[2][2][4][2], const Unit& u, int wr, int wc, int fr, int fq) const {
        const int row0 = u.pm * BM + wr * 64 + fr, col0 = (u.pn & 1) * 128 + wc * 32 + 8 * fq;
#pragma unroll
        for (int ai = 0; ai < 2; ++ai)
#pragma unroll
            for (int m = 0; m < 4; ++m) { const int row = row0 + ai * HALF + m * 16; const int e_ = u.pn >> 1, pos_ = row - off[e_]; const float cw = pos_ < off[18 + e_] - off[17 + e_] ? lw[e_ * lstride + pos_] : 0.f;
                const f32x4 g0 = acc[ai][0][m][0], g1 = acc[ai][0][m][1], u0 = acc[ai][1][m][0], u1 = acc[ai][1][m][1];
                f32x4 h0, h1;
#pragma unroll
                for (int j = 0; j < 4; ++j) { h0[j] = silu_f(g0[j]) * u0[j] * cw; h1[j] = silu_f(g1[j]) * u1[j] * cw; }
                u32x4 w; w.x = cvt_pk_bf16(h0[0], h0[1]); w.y = cvt_pk_bf16(h0[2], h0[3]); w.z = cvt_pk_bf16(h1[0], h1[1]); w.w = cvt_pk_bf16(h1[2], h1[3]);
                *(u32x4*)(H + (size_t)row * 256 + col0) = w; }
    }
};
struct EpiBf16s {
    static constexpr bool PERM = true, AFTER_DRAIN = false;
    bf16_t* O;
    __device__ __forceinline__ void operator()(const f32x4 (&acc)[2][2][4][2], const Unit& u, int wr, int wc, int fr, int fq) const {
        const int row0 = u.pm * BM + wr * 64 + fr, col0 = (u.pn & 3) * BM + wc * 32 + 8 * fq;
#pragma unroll
        for (int ai = 0; ai < 2; ++ai)
#pragma unroll
            for (int m = 0; m < 4; ++m) { bf16_t* rowp = O + (size_t)(row0 + ai * HALF + m * 16) * 1024 + col0;
#pragma unroll
                for (int bj = 0; bj < 2; ++bj) { const f32x4 v0 = acc[ai][bj][m][0], v1 = acc[ai][bj][m][1];
                    u32x4 w; w.x = cvt_pk_bf16(v0[0], v0[1]); w.y = cvt_pk_bf16(v0[2], v0[3]); w.z = cvt_pk_bf16(v1[0], v1[1]); w.w = cvt_pk_bf16(v1[2], v1[3]);
                    *(u32x4*)(rowp + bj * HALF) = w; } }
    }
};
template <class Epi, class Sched, bool ALIGN_EPI = false, bool SP2 = false>
__device__ __forceinline__ void gemm_phase(PG8_LAS unsigned char* lds, const Gemm g, const Sched& S, const Epi& E) {
    int tid_ = threadIdx.x; asm volatile("" : "+v"(tid_));
    const int tid = tid_, wid = __builtin_amdgcn_readfirstlane(tid >> 6), lane = tid & 63, wr = wid >> 2, wc = wid & 3, fr = lane & 15, fq = lane >> 4;
    const int K = g.K, nt = K / BK;
    unsigned voffA[2], voffB[2];
#pragma unroll
    for (int i = 0; i < 2; ++i) { int R, C; stage_rc(tid * 16 + i * 8192, R, C); const int Rb = Epi::PERM ? ((R & ~31) + perm32(R & 31)) : R;
        voffA[i] = (unsigned)(R * K + C) * 2u; voffB[i] = (unsigned)(Rb * K + C) * 2u; }
    constexpr bool GATHER = Sched::GATHER; static_assert(!GATHER || SP2, "the gather path is written for the two-super-phase loop");
    int gR[2], gC[2];
#pragma unroll
    for (int i = 0; i < 2; ++i) stage_rc(tid * 16 + i * 8192, gR[i], gC[i]);
    unsigned vA0[2] = {0u, 0u}, vA1[2] = {0u, 0u}, nvA0[2] = {0u, 0u}, nvA1[2] = {0u, 0u};
#define PG8_GLOOK(U, D0, D1) do { _Pragma("unroll") for (int _i = 0; _i < 2; ++_i) { \
        D0[_i] = (unsigned)S.row_token((U).pm * BM + gR[_i], (U)) * (unsigned)(K * 2) + (unsigned)gC[_i] * 2u; D1[_i] = (unsigned)S.row_token((U).pm * BM + HALF + gR[_i], (U)) * (unsigned)(K * 2) + (unsigned)gC[_i] * 2u; } } while (0)
    const size_t kstep = (size_t)(BK * 2);
    const size_t hstep = (size_t)HALF * K * 2;
    const size_t tstep = 2 * hstep;
    const unsigned ldsw = (unsigned)wid * 1024u;
    const int aoff = lds_byte(wr * 64 + fr, fq * 8), boff = lds_byte(wc * 32 + fr, fq * 8);
#define PG8_SA(b, h) (((b) * 2 + (h)) * HTB)
#define PG8_SB(b, h) ((4 + (b) * 2 + (h)) * HTB)
#define PG8_STAGE(bufoff, gbase, voff) do { _Pragma("unroll") for (int _i = 0; _i < 2; ++_i) \
        __builtin_amdgcn_global_load_lds((const unsigned*)((const char*)(gbase) + (voff)[_i]), (PG8_LAS unsigned*)(lds + (bufoff) + ldsw + _i * 8192), 16, 0, 0); } while (0)
#define PG8_LDA(dst, b, h) do { _Pragma("unroll") for (int m = 0; m < 4; ++m) _Pragma("unroll") for (int k = 0; k < 2; ++k) dst[m][k] = *(const PG8_LAS bf16x8*)(lds + PG8_SA(b, h) + aoff + m * 2048 + k * 1024); } while (0)
#define PG8_LDB(dst, b, h) do { _Pragma("unroll") for (int n = 0; n < 2; ++n) _Pragma("unroll") for (int k = 0; k < 2; ++k) dst[n][k] = *(const PG8_LAS bf16x8*)(lds + PG8_SB(b, h) + boff + n * 2048 + k * 1024); } while (0)
#define PG8_MMA(ai, bj, At, Bt) do { __builtin_amdgcn_s_setprio(1); _Pragma("unroll") for (int m = 0; m < 4; ++m) _Pragma("unroll") for (int n = 0; n < 2; ++n) _Pragma("unroll") for (int k = 0; k < 2; ++k) \
        acc[ai][bj][m][n] = __builtin_amdgcn_mfma_f32_16x16x32_bf16(Bt[n][k], At[m][k], acc[ai][bj][m][n], 0, 0, 0); __builtin_amdgcn_s_setprio(0); } while (0)
#define PG8_WAIT_V(n) asm volatile("s_waitcnt vmcnt(" #n ")" ::: "memory")
#define PG8_WAIT_L(n) asm volatile("s_waitcnt lgkmcnt(" #n ")" ::: "memory")
#define PG8_BAR __builtin_amdgcn_s_barrier()
#define PG8_SCHED __builtin_amdgcn_sched_barrier(0)
    Unit cur, nxt; int ui = 0;
    if (!S.next(0, cur)) return;
    f32x4 acc[2][2][4][2];
#pragma unroll
    for (int a = 0; a < 2; ++a)
#pragma unroll
        for (int b = 0; b < 2; ++b)
#pragma unroll
            for (int m = 0; m < 4; ++m)
#pragma unroll
                for (int n = 0; n < 2; ++n) acc[a][b][m][n] = (f32x4){0.f, 0.f, 0.f, 0.f};
    bf16x8 At[4][2], B0[2][2], B1[2][2];
    const char* cA = (const char*)g.A + (GATHER ? (size_t)0 : (size_t)cur.pm * tstep); const char* cB = (const char*)g.Bt + (size_t)cur.pn * tstep;
    if constexpr (GATHER) PG8_GLOOK(cur, vA0, vA1);
    S.a_ready(cur);
    if constexpr (SP2) {
        PG8_STAGE(PG8_SB(0, 0), cB, voffB); PG8_STAGE(PG8_SB(0, 1), cB + hstep, voffB);
        if constexpr (GATHER) { PG8_STAGE(PG8_SA(0, 0), cA, vA0); PG8_STAGE(PG8_SA(0, 1), cA, vA1); } else { PG8_STAGE(PG8_SA(0, 0), cA, voffA); PG8_STAGE(PG8_SA(0, 1), cA + hstep, voffA); }
        if (wr == 1) PG8_BAR;
        PG8_WAIT_V(2); PG8_BAR;
        PG8_STAGE(PG8_SB(1, 0), cB + kstep, voffB); if constexpr (GATHER) PG8_STAGE(PG8_SA(1, 0), cA + kstep, vA0); else PG8_STAGE(PG8_SA(1, 0), cA + kstep, voffA); PG8_STAGE(PG8_SB(1, 1), cB + hstep + kstep, voffB);
        PG8_WAIT_V(6); PG8_BAR;
    } else {
        PG8_STAGE(PG8_SB(0, 0), cB, voffB); PG8_STAGE(PG8_SA(0, 0), cA, voffA); PG8_STAGE(PG8_SB(0, 1), cB + hstep, voffB); PG8_STAGE(PG8_SA(0, 1), cA + hstep, voffA);
        if (wr == 1) PG8_BAR;
        PG8_WAIT_V(4); PG8_BAR;
        PG8_STAGE(PG8_SB(1, 0), cB + kstep, voffB); PG8_STAGE(PG8_SA(1, 0), cA + kstep, voffA); PG8_STAGE(PG8_SB(1, 1), cB + hstep + kstep, voffB);
        PG8_WAIT_V(6); PG8_BAR;
    }
    for (;;) {
        const bool has_next = S.next(ui + 1, nxt);
        const char* nA = (has_next && !GATHER) ? (const char*)g.A + (size_t)nxt.pm * tstep : cA; const char* nB = has_next ? (const char*)g.Bt + (size_t)nxt.pn * tstep : cB;
        if constexpr (GATHER) { if (has_next) PG8_GLOOK(nxt, nvA0, nvA1); else { nvA0[0] = vA0[0]; nvA0[1] = vA0[1]; nvA1[0] = vA1[0]; nvA1[1] = vA1[1]; } }
#pragma unroll 1
        for (int t = 0; t < nt; t += 2) {
            const bool last = (t == nt - 2);
            const char* a1 = cA + (size_t)(t + 1) * kstep;
            const char* a2 = last ? nA : cA + (size_t)(t + 2) * kstep; const char* b2 = last ? nB : cB + (size_t)(t + 2) * kstep;
            const char* a3 = a2 + kstep; const char* b3 = b2 + kstep;
            if (last && has_next) S.a_ready(nxt);
            if constexpr (SP2) {
            PG8_LDB(B0, 0, 0); PG8_LDB(B1, 0, 1); PG8_SCHED; PG8_LDA(At, 0, 0); if constexpr (GATHER) PG8_STAGE(PG8_SA(1, 1), a1, vA1); else PG8_STAGE(PG8_SA(1, 1), a1 + hstep, voffA);
            PG8_WAIT_V(8); PG8_WAIT_L(0); PG8_BAR; PG8_MMA(0, 0, At, B0); PG8_MMA(0, 1, At, B1); PG8_BAR; PG8_SCHED;
            PG8_LDA(At, 0, 1); PG8_STAGE(PG8_SB(0, 0), b2, voffB); PG8_STAGE(PG8_SB(0, 1), b2 + hstep, voffB); if constexpr (GATHER) { unsigned v_[2] = {last ? nvA0[0] : vA0[0], last ? nvA0[1] : vA0[1]}; PG8_STAGE(PG8_SA(0, 0), a2, v_); } else PG8_STAGE(PG8_SA(0, 0), a2, voffA);
            PG8_WAIT_V(8); PG8_WAIT_L(0); PG8_BAR; PG8_MMA(1, 0, At, B0); PG8_MMA(1, 1, At, B1); PG8_BAR; PG8_SCHED;
            PG8_LDB(B0, 1, 0); PG8_LDB(B1, 1, 1); PG8_SCHED; PG8_LDA(At, 1, 0); if constexpr (GATHER) { unsigned v_[2] = {last ? nvA1[0] : vA1[0], last ? nvA1[1] : vA1[1]}; PG8_STAGE(PG8_SA(0, 1), a2, v_); } else PG8_STAGE(PG8_SA(0, 1), a2 + hstep, voffA);
            PG8_WAIT_V(8); PG8_WAIT_L(0); PG8_BAR; PG8_MMA(0, 0, At, B0); PG8_MMA(0, 1, At, B1); PG8_BAR; PG8_SCHED;
            PG8_LDA(At, 1, 1); PG8_STAGE(PG8_SB(1, 0), b3, voffB); PG8_STAGE(PG8_SB(1, 1), b3 + hstep, voffB); if constexpr (GATHER) { unsigned v_[2] = {last ? nvA0[0] : vA0[0], last ? nvA0[1] : vA0[1]}; PG8_STAGE(PG8_SA(1, 0), a3, v_); } else PG8_STAGE(PG8_SA(1, 0), a3, voffA);
            PG8_WAIT_V(8); PG8_WAIT_L(0); PG8_BAR; PG8_MMA(1, 0, At, B0); PG8_MMA(1, 1, At, B1); PG8_BAR; PG8_SCHED;
            } else {
            PG8_LDB(B0, 0, 0); PG8_SCHED; PG8_LDA(At, 0, 0); PG8_STAGE(PG8_SA(1, 1), a1 + hstep, voffA);
            PG8_WAIT_L(8); PG8_BAR; PG8_WAIT_L(0); PG8_MMA(0, 0, At, B0); PG8_BAR; PG8_SCHED;
            PG8_LDB(B1, 0, 1); PG8_STAGE(PG8_SB(0, 0), b2, voffB);
            PG8_BAR; PG8_WAIT_L(0); PG8_MMA(0, 1, At, B1); PG8_BAR;
            PG8_LDA(At, 0, 1); PG8_STAGE(PG8_SA(0, 0), a2, voffA);
            PG8_BAR; PG8_WAIT_L(0); PG8_MMA(1, 0, At, B0); PG8_BAR; PG8_SCHED;
            PG8_STAGE(PG8_SB(0, 1), b2 + hstep, voffB);
            PG8_WAIT_V(6); PG8_BAR; PG8_MMA(1, 1, At, B1); PG8_BAR;
            PG8_LDB(B0, 1, 0); PG8_SCHED; PG8_LDA(At, 1, 0); PG8_STAGE(PG8_SA(0, 1), a2 + hstep, voffA);
            PG8_WAIT_L(8); PG8_BAR; PG8_WAIT_L(0); PG8_MMA(0, 0, At, B0); PG8_BAR; PG8_SCHED;
            PG8_LDB(B1, 1, 1); PG8_STAGE(PG8_SB(1, 0), b3, voffB);
            PG8_BAR; PG8_WAIT_L(0); PG8_MMA(0, 1, At, B1); PG8_BAR;
            PG8_LDA(At, 1, 1); PG8_STAGE(PG8_SA(1, 0), a3, voffA);
            PG8_BAR; PG8_WAIT_L(0); PG8_MMA(1, 0, At, B0); PG8_BAR; PG8_SCHED;
            PG8_STAGE(PG8_SB(1, 1), b3 + hstep, voffB);
            PG8_WAIT_V(6); PG8_BAR; PG8_MMA(1, 1, At, B1); PG8_BAR;
            }
        }
        if constexpr (ALIGN_EPI) { if (wr == 0) PG8_BAR; }
        if constexpr (!Epi::AFTER_DRAIN) { E(acc, cur, wr, wc, fr, fq); S.done(cur); }
        if (!has_next) break;
#pragma unroll
        for (int a = 0; a < 2; ++a)
#pragma unroll
            for (int b = 0; b < 2; ++b)
#pragma unroll
                for (int m = 0; m < 4; ++m)
#pragma unroll
                    for (int n = 0; n < 2; ++n) acc[a][b][m][n] = (f32x4){0.f, 0.f, 0.f, 0.f};
        cur = nxt; cA = nA; cB = nB; ++ui;
        if constexpr (GATHER) { vA0[0] = nvA0[0]; vA0[1] = nvA0[1]; vA1[0] = nvA1[0]; vA1[1] = nvA1[1]; }
        if constexpr (ALIGN_EPI) { if (wr == 1) PG8_BAR; }
    }
    PG8_WAIT_V(0);
    if constexpr (!ALIGN_EPI) { if (wr == 0) PG8_BAR; }
    PG8_BAR;
    if constexpr (Epi::AFTER_DRAIN) { E.fused(acc, cur, wr, wc, fr, fq, lds, wid, lane); S.done(cur); }
#undef PG8_GLOOK
#undef PG8_SA
#undef PG8_SB
#undef PG8_STAGE
#undef PG8_LDA
#undef PG8_LDB
#undef PG8_MMA
#undef PG8_WAIT_V
#undef PG8_WAIT_L
#undef PG8_BAR
#undef PG8_SCHED
}
}
#define GAS __attribute__((address_space(1)))
#define LAS __attribute__((address_space(3)))
typedef unsigned short bf16;
typedef unsigned v4u __attribute__((ext_vector_type(4)));
typedef float f32x4 __attribute__((ext_vector_type(4)));
typedef short bf16x8 __attribute__((ext_vector_type(8)));
typedef GAS unsigned gu32;
typedef GAS unsigned long long gu64;
#define RLX_AGENT __ATOMIC_RELAXED, __HIP_MEMORY_SCOPE_AGENT
#define LDS_WAIT() asm volatile("s_waitcnt lgkmcnt(0)" ::: "memory")
#define VM_WAIT() asm volatile("s_waitcnt vmcnt(0)" ::: "memory")
__device__ __forceinline__ unsigned long long rt() { return __builtin_amdgcn_s_memrealtime(); }
typedef __bf16 bf16x2_hw __attribute__((ext_vector_type(2)));
__device__ __forceinline__ unsigned pk2(float lo, float hi) { bf16x2_hw v; v.x = (__bf16)lo; v.y = (__bf16)hi; return __builtin_bit_cast(unsigned, v); }
__device__ __forceinline__ unsigned f2bf(float f) { return pk2(f, 0.f) & 0xffffu; }

#define XB_TMO      128
#define XB_XCNT(j)  (256  + 64 * (j))
#define XB_XSUB(j)  (1280 + 64 * (j))
#define XB_XGEN(j)  (2304 + 64 * (j))
#define XB_TOP      3328
#define XB_TOPGEN   3392
#define XCD_BAR_WORDS 3456
#define XB_SPIN_CAP (1u << 18)

__device__ __forceinline__ unsigned xb_ld(unsigned* p)              { return __hip_atomic_load(p, __ATOMIC_RELAXED, __HIP_MEMORY_SCOPE_AGENT); }
__device__ __forceinline__ unsigned xb_add(unsigned* p, unsigned v) { return __hip_atomic_fetch_add(p, v, __ATOMIC_RELAXED, __HIP_MEMORY_SCOPE_AGENT); }
__device__ __forceinline__ unsigned xb_xcc_id() { return (unsigned)__builtin_amdgcn_s_getreg((3 << 11) | 20) & 0xFu; }
#define XB_SPIN(cond, bar) do { unsigned _sp = 0; while (cond) { __builtin_amdgcn_s_sleep(1); \
    if ((++_sp & 255u) == 0u) { if (xb_ld(&(bar)[XB_TMO])) break; if (_sp > XB_SPIN_CAP) { atomicAdd(&(bar)[XB_TMO], 1u); break; } } } } while (0)

struct XcdBarrier {
    unsigned* bar; unsigned x;
    volatile LAS unsigned* st;
};

__device__ __forceinline__ XcdBarrier xcd_barrier_post(unsigned* bar, volatile LAS unsigned* st) {
    XcdBarrier b; b.bar = bar; b.x = xb_xcc_id(); b.st = st;
    if (threadIdx.x == 0) (void)xb_add(&bar[XB_XCNT(b.x)], 1u);
    return b;
}
__device__ __forceinline__ void xcd_barrier_complete(unsigned* bar, unsigned x, unsigned& nloc, unsigned& nx) {
    const unsigned G = gridDim.x * gridDim.y * gridDim.z;
    unsigned sum, cnt, mine, sp = 0u;
    for (;;) {
        sum = 0u; cnt = 0u; mine = 0u;
#pragma unroll
        for (unsigned j = 0; j < 16; ++j) { const unsigned c = xb_ld(&bar[XB_XCNT(j)]); sum += c; cnt += (c > 0u) ? 1u : 0u; mine = (j == x) ? c : mine; }
        if (sum == G) break;
        __builtin_amdgcn_s_sleep(1);
        if ((++sp & 255u) == 0u) { if (xb_ld(&bar[XB_TMO])) break; if (sp > XB_SPIN_CAP) { atomicAdd(&bar[XB_TMO], 1u); break; } }
    }
    nloc = mine > 0u ? mine : 1u; nx = cnt > 0u ? cnt : 1u;
}

__device__ __forceinline__ void xcd_barrier(const XcdBarrier& b) {
    asm volatile("s_waitcnt vmcnt(0)" ::: "memory");
    __syncthreads();
    if (threadIdx.x == 0) {
        unsigned* bar = b.bar;
        __builtin_amdgcn_s_waitcnt(0);
        unsigned nloc = b.st[0], nx = b.st[1];
        if (nloc == 0u) { xcd_barrier_complete(bar, b.x, nloc, nx); b.st[0] = nloc; b.st[1] = nx; }
        const unsigned old = xb_add(&bar[XB_XSUB(b.x)], 1u);
        const unsigned gen = old / nloc;
        if (old + 1u == (gen + 1u) * nloc) {
            __builtin_amdgcn_fence(__ATOMIC_RELEASE, "agent");
            asm volatile("s_waitcnt vmcnt(0)" ::: "memory");
            const unsigned og = xb_add(&bar[XB_TOP], 1u);
            const unsigned tg = og / nx;
            if (og + 1u == (tg + 1u) * nx) xb_add(&bar[XB_TOPGEN], 1u);
            else XB_SPIN(xb_ld(&bar[XB_TOPGEN]) == tg, bar);
            __builtin_amdgcn_fence(__ATOMIC_ACQUIRE, "agent");
            xb_add(&bar[XB_XGEN(b.x)], 1u);
            asm volatile("s_waitcnt vmcnt(0)" ::: "memory");
        } else {
            XB_SPIN(xb_ld(&bar[XB_XGEN(b.x)]) == gen, bar);
            __builtin_amdgcn_fence(__ATOMIC_ACQUIRE, "agent");
            asm volatile("s_waitcnt vmcnt(0)" ::: "memory");
        }
    }
    __syncthreads();
}
constexpr int NWAVES = 8, NTHR = NWAVES * 64;
constexpr int D = 1024, BATCH = 4, SEQ = 4096, M = BATCH * SEQ, DEPTH = 4;
constexpr int IN_COLS = 6680, NPROJ = 6912;
constexpr int O_Z = 0, O_XBC = 1024, O_DT = 2560, O_QKV = 2576, O_GG = 4112, O_GB = 4624, O_GA = 4628, O_HQ = 4632, O_HF = 5144, O_HI = 5656, O_HG = 6168;
constexpr int DMIX = 2048, NEXP = 16, DEXP = 256, NGU = NEXP * 2 * DEXP  , KDN = NEXP * DEXP  ;
constexpr float DN_ALPHA = 1.6817928305074290f;
constexpr float LN_EPS = 1e-5f;

constexpr size_t MiB = 1u << 20;
constexpr size_t WS_CTL = 0, CTL_ZERO_BYTES = 1 * MiB;
constexpr size_t WS_LTOK = 2 * MiB;
constexpr size_t WS_LW = 3 * MiB;
constexpr size_t WS_SLOT = 4 * MiB;
constexpr size_t WS_WSORT = 5 * MiB;
constexpr size_t WS_WIN = 8 * MiB;
constexpr size_t WS_WOUT = 22 * MiB;
constexpr size_t WS_WGU = 26 * MiB;
constexpr size_t WS_WDN = 42 * MiB;
constexpr size_t WS_YMIX = 52 * MiB;
constexpr size_t WS_HB = WS_YMIX;
constexpr size_t WS_PROJ = 116 * MiB;
constexpr size_t WS_MIX = WS_PROJ;
constexpr int MAXROWS = 2 * M + 16 * 256;
constexpr size_t WS_XS = WS_PROJ + 64 * MiB;
constexpr size_t WS_HS = WS_PROJ + 136 * MiB;
constexpr size_t WS_YS = WS_PROJ + 154 * MiB;
constexpr int CW_CNT = 8192;
constexpr int LDS_OFF_TAB = 131072 + 1024;
constexpr size_t WS_SCR = 332 * MiB;
constexpr size_t WS_HG_QG = WS_SCR;
constexpr size_t WS_HG_KDT = WS_SCR + 16 * MiB;
constexpr size_t WS_HG_A = WS_SCR + 32 * MiB;
constexpr size_t WS_HG_GL = WS_SCR + 40 * MiB;
constexpr size_t WS_SSD_C = WS_SCR + 41 * MiB;
constexpr size_t WS_SSD_BT = WS_SCR + 49 * MiB;
constexpr size_t WS_SSD_CB = WS_SCR + 57 * MiB;
constexpr size_t WS_SSD_XT = WS_SCR + 65 * MiB;
constexpr size_t WS_SSD_AC = WS_SCR + 97 * MiB;
constexpr size_t WS_SSD_DT = WS_SCR + 98 * MiB;
constexpr size_t WS_GD_K = WS_SCR + 99 * MiB;
constexpr size_t WS_GD_KT = WS_SCR + 115 * MiB;
constexpr size_t WS_GD_QG = WS_SCR + 131 * MiB;
constexpr size_t WS_GD_VT = WS_SCR + 147 * MiB;
constexpr size_t WS_GD_T = WS_SCR + 163 * MiB;
constexpr size_t WS_GD_QK = WS_SCR + 171 * MiB;
constexpr size_t WS_GD_VEC = WS_SCR + 179 * MiB;
constexpr size_t WS_END = 512 * MiB;
constexpr int CW_BAR = 4096;

constexpr int RING_OFF = 0, RING_BYTES = 131072;
constexpr int LDSCTL_OFF = RING_BYTES, MISC_OFF = LDSCTL_OFF + 320;
constexpr int LDS_BYTES = 147456;

__device__ __forceinline__ float bf2f(unsigned short b) { return __builtin_bit_cast(float, ((unsigned)b) << 16); }
__device__ __forceinline__ float bflo(unsigned w) { return __builtin_bit_cast(float, w << 16); }
__device__ __forceinline__ float bfhi(unsigned w) { return __builtin_bit_cast(float, w & 0xffff0000u); }
__device__ __forceinline__ float siluf(float x) { return x * __builtin_amdgcn_rcpf(1.0f + __expf(-x)); }
__device__ __forceinline__ float sigmoidf_(float x) { return __builtin_amdgcn_rcpf(1.0f + __expf(-x)); }
__device__ __forceinline__ float softplusf_(float x) { return x > 20.f ? x : log1pf(__expf(x)); }
#define DPP_ADD(v, ctrl) ((v) + __builtin_bit_cast(float, __builtin_amdgcn_update_dpp(0, __builtin_bit_cast(int, (v)), (ctrl), 0xf, 0xf, false)))
__device__ __forceinline__ float wave_sum(float v) {
    v = DPP_ADD(v, 0xB1);
    v = DPP_ADD(v, 0x4E);
    v = DPP_ADD(v, 0x141);
    v = DPP_ADD(v, 0x140);
    const int iv = __builtin_bit_cast(int, v);
    return (__builtin_bit_cast(float, __builtin_amdgcn_readlane(iv, 0)) + __builtin_bit_cast(float, __builtin_amdgcn_readlane(iv, 16))) + (__builtin_bit_cast(float, __builtin_amdgcn_readlane(iv, 32)) + __builtin_bit_cast(float, __builtin_amdgcn_readlane(iv, 48)));
}
__device__ __forceinline__ float row16_sum(float v) {
    v = DPP_ADD(v, 0xB1); v = DPP_ADD(v, 0x4E); v = DPP_ADD(v, 0x141); v = DPP_ADD(v, 0x140); return v;
}

struct Args {
    const float* in[25]; float* out; unsigned char* ws; int ph_lo, ph_hi;
};
typedef const __attribute__((address_space(4))) Args* CArgs;
#define ARGS_HERE() ([]() { CArgs p_ = (CArgs)__builtin_amdgcn_kernarg_segment_ptr(); asm volatile("" : "+s"(p_)); return p_; }())
enum { I_X = 0, I_WIN, I_SCW, I_SCB, I_SDTB, I_SALOG, I_SD, I_SNW, I_GCW, I_GDTB, I_GALOG, I_GNW, I_HLB, I_HNW, I_WOUT, I_LN1G, I_LN1B, I_WRG, I_BRG, I_WRE, I_BRE, I_WGU, I_WDN, I_LN2G, I_LN2B };

__device__ __forceinline__ void transpose_item(const float* W, int ldw, int nvalid, int k0, int n0, bf16* WT, size_t ldt, int drow0, int dk0, LAS float* scr, int lane) {
#pragma unroll 8
    for (int i = 0; i < 32; ++i) { const int kk = 2 * i + (lane >> 5), nn = lane & 31, n = n0 + nn; scr[kk * 33 + nn] = (n < nvalid) ? W[(size_t)(k0 + kk) * ldw + n] : 0.f; }
    LDS_WAIT(); asm volatile("" ::: "memory");
    const int c = lane & 7;
#pragma unroll
    for (int j = 0; j < 4; ++j) { const int n = (lane >> 3) + 8 * j; const LAS float* s = scr + (8 * c) * 33 + n;
        v4u o; o.x = pk2(s[0 * 33], s[1 * 33]); o.y = pk2(s[2 * 33], s[3 * 33]); o.z = pk2(s[4 * 33], s[5 * 33]); o.w = pk2(s[6 * 33], s[7 * 33]);
        *(GAS v4u*)(WT + (size_t)(drow0 + n) * ldt + dk0 + k0 + 8 * c) = o; }
    LDS_WAIT(); asm volatile("" ::: "memory");
}
__device__ __forceinline__ void weights_phase(CArgs a, int l, const int which, LAS unsigned char* lds, int wwg, int nwg, int tid) {
    asm volatile("" : "+v"(tid));
    const int lane = tid & 63, wave = tid >> 6, gw = wwg * NWAVES + wave, NGW = nwg * NWAVES;
    LAS float* scr = (LAS float*)(lds + wave * 16384);
    constexpr int I_IN = 16 * (NPROJ / 32), I_OUT = (DMIX / 64) * (D / 32), I_GU = NEXP * 16 * 16, I_DN = NEXP * 4 * 32;
    const int n_in = (which & 1) ? I_IN : 0, n_out = (which & 2) ? I_OUT : 0, n_gu = (which & 4) ? I_GU : 0, n_dn = (which & 8) ? I_DN : 0;
    unsigned char* ws = a->ws;
    for (int it = gw; it < n_in + n_out + n_gu + n_dn; it += NGW) {
        int r = it;
        if (r < n_in) { const int kb = r / (NPROJ / 32), nb = r % (NPROJ / 32);
            transpose_item(a->in[I_WIN] + (size_t)l * D * IN_COLS, IN_COLS, IN_COLS, 64 * kb, 32 * nb, (bf16*)(ws + WS_WIN), D, 32 * nb, 0, scr, lane); continue; }
        r -= n_in;
        if (r < n_out) { const int kb = r / (D / 32), nb = r % (D / 32);
            transpose_item(a->in[I_WOUT] + (size_t)l * DMIX * D, D, D, 64 * kb, 32 * nb, (bf16*)(ws + WS_WOUT), DMIX, 32 * nb, 0, scr, lane); continue; }
        r -= n_out;
        if (r < n_gu) { const int e = r / 256, q = r % 256, kb = q / 16, nb = q % 16, c0 = 32 * nb, bj = c0 / 256, hf = (c0 % 256) / 128, j0 = c0 % 128;
            transpose_item(a->in[I_WGU] + (size_t)(l * NEXP + e) * D * 512, 512, 512, 64 * kb, c0, (bf16*)(ws + WS_WGU), D, e * 512 + hf * 256 + bj * 128 + j0, 0, scr, lane); continue; }
        r -= n_gu;
        { const int e = r / 128, q = r % 128, kb = q / 32, nb = q % 32;
            transpose_item(a->in[I_WDN] + (size_t)(l * NEXP + e) * DEXP * D, D, D, 64 * kb, 32 * nb, (bf16*)(ws + WS_WDN), DEXP, e * D + 32 * nb, 0, scr, lane); }
    }
}
__device__ __forceinline__ void p0_prologue(CArgs a, LAS unsigned char* lds, int wg, int G, int tid) {
    asm volatile("" : "+v"(tid));
    const f32x4* x4 = (const f32x4*)a->in[I_X]; f32x4* h4 = (f32x4*)a->out; unsigned long long* hb8 = (unsigned long long*)(a->ws + WS_HB);
    for (size_t i = (size_t)wg * NTHR + tid; i < (size_t)M * D / 4; i += (size_t)G * NTHR) { const f32x4 v = x4[i]; (void)h4;
        hb8[i] = (unsigned long long)pk2(v.x, v.y) | ((unsigned long long)pk2(v.z, v.w) << 32); }
}

#define WG_BAR() do { asm volatile("s_waitcnt lgkmcnt(0)" ::: "memory"); __builtin_amdgcn_s_barrier(); asm volatile("" ::: "memory"); } while (0)
__device__ __forceinline__ f32x4 mfma16(bf16x8 x, bf16x8 y, f32x4 c) { return __builtin_amdgcn_mfma_f32_16x16x32_bf16(x, y, c, 0, 0, 0); }
__device__ __forceinline__ bf16x8 lds_frag(const LAS bf16* base, int row0, int stride, int k0, int lane) { return *(const LAS bf16x8*)(base + (row0 + (lane & 15)) * stride + k0 + 8 * (lane >> 4)); }
__device__ __forceinline__ bf16x8 pack8(const float* v) { v4u w; w.x = pk2(v[0], v[1]); w.y = pk2(v[2], v[3]); w.z = pk2(v[4], v[5]); w.w = pk2(v[6], v[7]); return __builtin_bit_cast(bf16x8, w); }
__device__ __forceinline__ unsigned long long pack4(f32x4 v) { return (unsigned long long)pk2(v[0], v[1]) | ((unsigned long long)pk2(v[2], v[3]) << 32); }

__device__ __forceinline__ void hgrn_prep_phase(CArgs a, int l, LAS unsigned char* lds, int wg, int G, int tid) {
    asm volatile("" : "+v"(tid));
    constexpr int LS = 132;
    LAS float* sQ = (LAS float*)lds; LAS float* sK = sQ + 64 * LS; LAS float* sB = sK + 64 * LS; LAS float* sT = sB + 64 * LS; LAS float* sLb = sT + 512;
    const bf16* PROJ = (const bf16*)(a->ws + WS_PROJ);
    const int lane = tid & 63, w = tid >> 6, r = lane & 15, q4 = lane >> 4;
    for (int unit = wg; unit < 1024; unit += G) {
        const int b = unit >> 8, head = (unit >> 6) & 3, c = unit & 63;
        const size_t row0 = (size_t)b * SEQ + c * 64;
        __syncthreads();
        if (tid < 128) {
            const int ch = head * 128 + tid; float lg[DEPTH], mx = -1e30f;
#pragma unroll
            for (int j = 0; j < DEPTH; ++j) { lg[j] = a->in[I_HLB][j * 512 + ch]; mx = fmaxf(mx, lg[j]); }
            float den = 0.f, num = 0.f;
#pragma unroll
            for (int j = 0; j < DEPTH; ++j) { const float e = __expf(lg[j] - mx); den += e; if (j >= 1 && j <= l) num += e; }
            sLb[tid] = num / den;
        }
        __syncthreads();
        for (int p = tid; p < 1024; p += NTHR) {
            const int t = p >> 4, d8 = (p & 15) * 8;
            const v4u qv = *(const GAS v4u*)(PROJ + (row0 + t) * NPROJ + O_HQ + head * 128 + d8), fv = *(const GAS v4u*)(PROJ + (row0 + t) * NPROJ + O_HF + head * 128 + d8);
#pragma unroll
            for (int i = 0; i < 4; ++i) {
                const int d = d8 + 2 * i; const float lb0 = sLb[d], lb1 = sLb[d + 1];
                sQ[t * LS + d] = siluf(bflo(qv[i])); sQ[t * LS + d + 1] = siluf(bfhi(qv[i]));
                const float f0 = lb0 + (1.f - lb0) * sigmoidf_(bflo(fv[i])), f1 = lb1 + (1.f - lb1) * sigmoidf_(bfhi(fv[i]));
                sK[t * LS + d] = 1.f - f0; sK[t * LS + d + 1] = 1.f - f1; sB[t * LS + d] = __logf(f0); sB[t * LS + d + 1] = __logf(f1);
            }
        }
        __syncthreads();
        {
            const int d = tid & 127, seg = tid >> 7; float run = 0.f, vals[16];
#pragma unroll
            for (int i = 0; i < 16; ++i) { run += sB[(seg * 16 + i) * LS + d]; vals[i] = run; }
            sT[seg * 128 + d] = run;
            __syncthreads();
            float off = 0.f;
#pragma unroll
            for (int s2 = 0; s2 < 3; ++s2) if (s2 < seg) off += sT[s2 * 128 + d];
#pragma unroll
            for (int i = 0; i < 16; ++i) sB[(seg * 16 + i) * LS + d] = vals[i] + off;
        }
        __syncthreads();
        bf16* qg = (bf16*)(a->ws + WS_HG_QG) + (size_t)unit * 64 * 128; bf16* kdt = (bf16*)(a->ws + WS_HG_KDT) + (size_t)unit * 128 * 64;
        bf16* am = (bf16*)(a->ws + WS_HG_A) + (size_t)unit * 64 * 64; float* gl = (float*)(a->ws + WS_HG_GL) + (size_t)unit * 128;
        for (int p = tid; p < 1024; p += NTHR) { const int t = p >> 4, d8 = (p & 15) * 8; float v[8];
#pragma unroll
            for (int jj = 0; jj < 8; ++jj) v[jj] = sQ[t * LS + d8 + jj] * __expf(sB[t * LS + d8 + jj]);
            *(GAS bf16x8*)(qg + t * 128 + d8) = pack8(v); }
        for (int p = tid; p < 1024; p += NTHR) { const int d = p >> 3, s8 = (p & 7) * 8; const float bl = sB[63 * LS + d]; float v[8];
#pragma unroll
            for (int jj = 0; jj < 8; ++jj) v[jj] = sK[(s8 + jj) * LS + d] * __expf(bl - sB[(s8 + jj) * LS + d]);
            *(GAS bf16x8*)(kdt + d * 64 + s8) = pack8(v); }
        if (tid < 128) gl[tid] = __expf(sB[63 * LS + tid]);
        for (int p = w; p < 16; p += NWAVES) {
            const int i = p >> 2, j = p & 3; f32x4 acc = {0.f, 0.f, 0.f, 0.f};
            if (j <= i) {
#pragma unroll
                for (int ks = 0; ks < 4; ++ks) { const int d0 = 32 * ks + 8 * q4, t = 16 * i + r, s_ = 16 * j + r; float qf[8], kf[8];
#pragma unroll
                    for (int jj = 0; jj < 8; ++jj) { const float ref = i ? sB[(16 * i - 1) * LS + d0 + jj] : 0.f;
                        qf[jj] = sQ[t * LS + d0 + jj] * __expf(sB[t * LS + d0 + jj] - ref); kf[jj] = sK[s_ * LS + d0 + jj] * __expf(ref - sB[s_ * LS + d0 + jj]); }
                    acc = mfma16(pack8(kf), pack8(qf), acc); }
                const int t = 16 * i + r;
#pragma unroll
                for (int ii = 0; ii < 4; ++ii) if (16 * j + 4 * q4 + ii > t) acc[ii] = 0.f;
            }
            *(GAS unsigned long long*)(am + (16 * i + r) * 64 + 16 * j + 4 * q4) = pack4(acc);
        }
    }
}
__device__ __forceinline__ void hgrn_scan_phase(CArgs a, int l, LAS unsigned char* lds, const int b, const int head, const int eb, int tid) {
    asm volatile("" : "+v"(tid));
    constexpr int QS = 136, KS = 72;
    constexpr int B_QG = 0, B_KDT = 17408, B_A = B_KDT + 18432, B_VT = B_A + 9216, B_GL = B_VT + 4608, BUF = B_GL + 512;
    LAS unsigned char* sST0 = lds + 2 * BUF;
    const bf16* PROJ = (const bf16*)(a->ws + WS_PROJ); bf16* YMIX = (bf16*)(a->ws + WS_YMIX);
    const int lane = tid & 63, w = tid >> 6, r = lane & 15, q4 = lane >> 4;
    {
        const size_t cu0 = (size_t)(b * 4 + head) * 64;
        const bf16* QG = (const bf16*)(a->ws + WS_HG_QG) + cu0 * 64 * 128; const bf16* KDT = (const bf16*)(a->ws + WS_HG_KDT) + cu0 * 128 * 64;
        const bf16* AM = (const bf16*)(a->ws + WS_HG_A) + cu0 * 64 * 64; const float* GL = (const float*)(a->ws + WS_HG_GL) + cu0 * 128;
        const bf16* VP = PROJ + (size_t)b * SEQ * NPROJ + O_HI + head * 128 + eb * 32;
        v4u rq[2], rk[2], ra, rv; f32x4 rg;
#define HG_LOAD(n) do { _Pragma("unroll") for (int i = 0; i < 2; ++i) { const int p = tid + NTHR * i; rq[i] = *(const GAS v4u*)(QG + (size_t)(n) * 8192 + (p >> 4) * 128 + (p & 15) * 8); \
            rk[i] = *(const GAS v4u*)(KDT + (size_t)(n) * 8192 + (p >> 3) * 64 + (p & 7) * 8); } \
            ra = *(const GAS v4u*)(AM + (size_t)(n) * 4096 + (tid >> 3) * 64 + (tid & 7) * 8); \
            if (tid < 256) rv = *(const GAS v4u*)(VP + (size_t)((n) * 64 + (tid >> 2)) * NPROJ + (tid & 3) * 8); \
            if (tid < 32) rg = *(const GAS f32x4*)(GL + (size_t)(n) * 128 + tid * 4); } while (0)
#define HG_STORE(bufp) do { LAS unsigned char* bp_ = (bufp); _Pragma("unroll") for (int i = 0; i < 2; ++i) { const int p = tid + NTHR * i; \
            *(LAS v4u*)(bp_ + B_QG + ((p >> 4) * QS + (p & 15) * 8) * 2) = rq[i]; *(LAS v4u*)(bp_ + B_KDT + ((p >> 3) * KS + (p & 7) * 8) * 2) = rk[i]; } \
            *(LAS v4u*)(bp_ + B_A + ((tid >> 3) * KS + (tid & 7) * 8) * 2) = ra; \
            if (tid < 256) { LAS bf16* vt = (LAS bf16*)(bp_ + B_VT); const int t_ = tid >> 2, e8 = (tid & 3) * 8; _Pragma("unroll") for (int i = 0; i < 4; ++i) { \
                vt[(e8 + 2 * i) * KS + t_] = (bf16)(rv[i] & 0xffffu); vt[(e8 + 2 * i + 1) * KS + t_] = (bf16)(rv[i] >> 16); } } \
            if (tid < 32) *(LAS f32x4*)(bp_ + B_GL + tid * 16) = rg; } while (0)
        __syncthreads();
        HG_LOAD(0);
        for (int i = tid; i < 8704 / 4; i += NTHR) ((LAS unsigned*)sST0)[i] = 0u;
        HG_STORE(lds);
        f32x4 accS[2] = {{0.f, 0.f, 0.f, 0.f}, {0.f, 0.f, 0.f, 0.f}};
        __syncthreads();
        for (int n = 0; n < 64; ++n) {
            const int cur = n & 1; LAS unsigned char* bp = lds + cur * BUF; LAS bf16* sST = (LAS bf16*)(sST0 + cur * 8704); LAS bf16* sSTn = (LAS bf16*)(sST0 + (cur ^ 1) * 8704);
            if (n + 1 < 64) HG_LOAD(n + 1);
            {
                const int tt = w >> 1, et = w & 1; f32x4 acc = {0.f, 0.f, 0.f, 0.f};
#pragma unroll
                for (int ks = 0; ks < 4; ++ks) acc = mfma16(lds_frag(sST, 16 * et, QS, 32 * ks, lane), lds_frag((LAS bf16*)(bp + B_QG), 16 * tt, QS, 32 * ks, lane), acc);
#pragma unroll
                for (int ks = 0; ks < 2; ++ks) acc = mfma16(lds_frag((LAS bf16*)(bp + B_VT), 16 * et, KS, 32 * ks, lane), lds_frag((LAS bf16*)(bp + B_A), 16 * tt, KS, 32 * ks, lane), acc);
                *(GAS unsigned long long*)(YMIX + ((size_t)b * SEQ + n * 64 + 16 * tt + r) * DMIX + 1536 + head * 128 + eb * 32 + 16 * et + 4 * q4) = pack4(acc);
            }
            {
                const f32x4 glv = *(const LAS f32x4*)(bp + B_GL + (16 * w + 4 * q4) * 4);
#pragma unroll
                for (int et = 0; et < 2; ++et) { accS[et] = accS[et] * glv;
#pragma unroll
                    for (int ks = 0; ks < 2; ++ks) accS[et] = mfma16(lds_frag((LAS bf16*)(bp + B_KDT), 16 * w, KS, 32 * ks, lane), lds_frag((LAS bf16*)(bp + B_VT), 16 * et, KS, 32 * ks, lane), accS[et]);
                    *(LAS unsigned long long*)(sSTn + (16 * et + r) * QS + 16 * w + 4 * q4) = pack4(accS[et]); }
            }
            if (n + 1 < 64) HG_STORE(lds + (cur ^ 1) * BUF);
            WG_BAR();
        }
#undef HG_LOAD
#undef HG_STORE
    }
}

__device__ __forceinline__ void ssd_rec_phase(CArgs a, int l, LAS unsigned char* lds, int wg, int G, int tid) {
    asm volatile("" : "+v"(tid));
    constexpr int TB = 64;
    LAS float* sX = (LAS float*)lds; LAS float* sB = sX + TB * 16; LAS float* sC = sB + TB * 128; LAS float* sDt = sC + TB * 128; LAS float* sDa = sDt + TB; LAS float* sY = sDa + TB;
    const bf16* PROJ = (const bf16*)(a->ws + WS_PROJ); bf16* YMIX = (bf16*)(a->ws + WS_YMIX);
    const float* cw = a->in[I_SCW] + (size_t)l * 4 * 1536; const float* cb = a->in[I_SCB] + (size_t)l * 1536;
    const int p_local = tid >> 5, nq = tid & 31;
    for (int unit = wg; unit < 256; unit += G) {
        const int b = unit >> 6, head = (unit >> 2) & 15, pq = unit & 3, g = head >> 3;
        const float A = -__expf(a->in[I_SALOG][l * 16 + head]), dtb = a->in[I_SDTB][l * 16 + head], Dsk = a->in[I_SD][l * 16 + head];
        float h0 = 0.f, h1 = 0.f, h2 = 0.f, h3 = 0.f;
        for (int t0 = 0; t0 < SEQ; t0 += TB) {
            __syncthreads();
            for (int idx = tid; idx < TB * 272; idx += NTHR) {
                const int tt = idx / 272, ci = idx % 272, t = t0 + tt;
                const int ch = ci < 16 ? head * 64 + pq * 16 + ci : (ci < 144 ? 1024 + g * 128 + (ci - 16) : 1280 + g * 128 + (ci - 144));
                float acc = cb[ch];
#pragma unroll
                for (int k = 0; k < 4; ++k) { const int ts = t - 3 + k; if (ts >= 0) acc += cw[k * 1536 + ch] * bf2f(PROJ[(size_t)(b * SEQ + ts) * NPROJ + O_XBC + ch]); }
                const float v = siluf(acc);
                if (ci < 16) sX[tt * 16 + ci] = v; else if (ci < 144) sB[tt * 128 + ci - 16] = v; else sC[tt * 128 + ci - 144] = v;
            }
            if (tid < TB) { const float raw = bf2f(PROJ[(size_t)(b * SEQ + t0 + tid) * NPROJ + O_DT + head]); const float dt = softplusf_(raw + dtb); sDt[tid] = dt; sDa[tid] = __expf(dt * A); }
            __syncthreads();
#pragma unroll 4
            for (int tt = 0; tt < TB; ++tt) {
                const float xv = sX[tt * 16 + p_local], da = sDa[tt], dx = sDt[tt] * xv;
                const f32x4 Bv = *(const LAS f32x4*)(sB + tt * 128 + nq * 4), Cv = *(const LAS f32x4*)(sC + tt * 128 + nq * 4);
                h0 = da * h0 + dx * Bv.x; h1 = da * h1 + dx * Bv.y; h2 = da * h2 + dx * Bv.z; h3 = da * h3 + dx * Bv.w;
                float part = (Cv.x * h0 + Cv.y * h1) + (Cv.z * h2 + Cv.w * h3);
                part += __shfl_xor(part, 1); part += __shfl_xor(part, 2); part += __shfl_xor(part, 4); part += __shfl_xor(part, 8); part += __shfl_xor(part, 16);
                if (nq == 0) sY[tt * 16 + p_local] = part + Dsk * xv;
            }
            __syncthreads();
            for (int idx = tid; idx < TB * 16; idx += NTHR) { const int tt = idx >> 4, i = idx & 15; YMIX[(size_t)(b * SEQ + t0 + tt) * DMIX + head * 64 + pq * 16 + i] = (bf16)f2bf(sY[idx]); }
        }
    }
}

__device__ __forceinline__ void ssd_prep_phase(CArgs a, int l, LAS unsigned char* lds, int wg, int G, int tid) {
    asm volatile("" : "+v"(tid));
    constexpr int PS = 136;
    LAS bf16* sB = (LAS bf16*)lds; LAS bf16* sC = sB + 128 * PS; LAS bf16* sXT = (LAS bf16*)lds; LAS float* sDt = (LAS float*)(lds + 2 * 128 * PS * 2); LAS bf16* sCB = (LAS bf16*)(lds + 2 * 128 * PS * 2 + 4096);
    const bf16* PROJ = (const bf16*)(a->ws + WS_PROJ);
    const float* cw = a->in[I_SCW] + (size_t)l * 4 * 1536; const float* cb = a->in[I_SCB] + (size_t)l * 1536;
    const int lane = tid & 63, w = tid >> 6, r = lane & 15, q4 = lane >> 4;
    for (int unit = wg; unit < 256; unit += G) {
        const int b = unit >> 6, c = (unit >> 1) & 31, g = unit & 1;
        const size_t row0 = (size_t)b * SEQ + c * 128;
        bf16* Cg = (bf16*)(a->ws + WS_SSD_C) + (size_t)unit * 16384; bf16* BTg = (bf16*)(a->ws + WS_SSD_BT) + (size_t)unit * 16384; bf16* CBg = (bf16*)(a->ws + WS_SSD_CB) + (size_t)unit * 16384;
        __syncthreads();
        {
            const int c16 = tid & 31, l0 = tid >> 5; const int ch = (c16 < 16 ? 1024 + g * 128 + c16 * 8 : 1280 + g * 128 + (c16 - 16) * 8);
            float wk[4][8], bias[8];
#pragma unroll
            for (int jj = 0; jj < 8; ++jj) { bias[jj] = cb[ch + jj];
#pragma unroll
                for (int k = 0; k < 4; ++k) wk[k][jj] = cw[k * 1536 + ch + jj]; }
            LAS bf16* dst = (c16 < 16 ? sB : sC) + (c16 & 15) * 8;
#pragma unroll 2
            for (int i = 0; i < 8; ++i) { const int ll = l0 + 16 * i; float acc[8];
#pragma unroll
                for (int jj = 0; jj < 8; ++jj) acc[jj] = bias[jj];
#pragma unroll
                for (int k = 0; k < 4; ++k) { const int ts = c * 128 + ll - 3 + k;
                    if (ts >= 0) { const v4u xv = *(const GAS v4u*)(PROJ + ((size_t)b * SEQ + ts) * NPROJ + O_XBC + ch);
#pragma unroll
                        for (int j = 0; j < 4; ++j) { acc[2 * j] += wk[k][2 * j] * bflo(xv[j]); acc[2 * j + 1] += wk[k][2 * j + 1] * bfhi(xv[j]); } } }
#pragma unroll
                for (int jj = 0; jj < 8; ++jj) acc[jj] = siluf(acc[jj]);
                *(LAS bf16x8*)(dst + ll * PS) = pack8(acc); }
        }
        {
            const int head = g * 8 + w; const float A = -__expf(a->in[I_SALOG][l * 16 + head]), dtb = a->in[I_SDTB][l * 16 + head];
            const int l2 = 2 * lane;
            const float dt0 = softplusf_(bf2f(PROJ[(row0 + l2) * NPROJ + O_DT + head]) + dtb), dt1 = softplusf_(bf2f(PROJ[(row0 + l2 + 1) * NPROJ + O_DT + head]) + dtb);
            const float da1 = dt1 * A; float sc = dt0 * A + da1;
#pragma unroll
            for (int o = 1; o < 64; o <<= 1) { const float t_ = __shfl_up(sc, o); if (lane >= o) sc += t_; }
            sDt[w * 128 + l2] = dt0; sDt[w * 128 + l2 + 1] = dt1;
            const size_t uh = (size_t)((b * 16 + head) * 32 + c) * 128;
            float* AC = (float*)(a->ws + WS_SSD_AC) + uh; float* DT = (float*)(a->ws + WS_SSD_DT) + uh;
            AC[l2] = sc - da1; AC[l2 + 1] = sc; DT[l2] = dt0; DT[l2 + 1] = dt1;
        }
        __syncthreads();
#pragma unroll
        for (int st = 0; st < 8; ++st) {
            f32x4 acc = {0.f, 0.f, 0.f, 0.f};
            if (st <= w) {
#pragma unroll
                for (int ks = 0; ks < 4; ++ks) acc = mfma16(lds_frag(sB, 16 * st, PS, 32 * ks, lane), lds_frag(sC, 16 * w, PS, 32 * ks, lane), acc); }
            *(LAS unsigned long long*)(sCB + (16 * w + r) * PS + 16 * st + 4 * q4) = pack4(acc);
        }
        __syncthreads();
        for (int f = w; f < 32; f += NWAVES) { const int tile = f >> 2, ks = f & 3;
            *(GAS v4u*)(Cg + f * 512 + lane * 8) = *(const LAS v4u*)(sC + (16 * tile + r) * PS + 32 * ks + 8 * q4);
            *(GAS v4u*)(CBg + f * 512 + lane * 8) = *(const LAS v4u*)(sCB + (16 * tile + r) * PS + 32 * ks + 8 * q4);
            const int n = 16 * tile + r, l0 = 32 * ks + 8 * q4; v4u o;
#pragma unroll
            for (int j = 0; j < 4; ++j) o[j] = (unsigned)sB[(l0 + 2 * j) * PS + n] | ((unsigned)sB[(l0 + 2 * j + 1) * PS + n] << 16);
            *(GAS v4u*)(BTg + f * 512 + lane * 8) = o; }
#pragma unroll 1
        for (int hf = 0; hf < 2; ++hf) {
            __syncthreads();
            {   const int cg = tid & 31, l0 = tid >> 5, chl = cg * 8, ch = g * 512 + hf * 256 + chl, hh = hf * 4 + (cg >> 3);
                float wk[4][8], bias[8];
#pragma unroll
                for (int jj = 0; jj < 8; ++jj) { bias[jj] = cb[ch + jj];
#pragma unroll
                    for (int k = 0; k < 4; ++k) wk[k][jj] = cw[k * 1536 + ch + jj]; }
#pragma unroll 2
                for (int i = 0; i < 8; ++i) { const int ll = l0 + 16 * i; float acc[8];
#pragma unroll
                    for (int jj = 0; jj < 8; ++jj) acc[jj] = bias[jj];
#pragma unroll
                    for (int k = 0; k < 4; ++k) { const int ts = c * 128 + ll - 3 + k;
                        if (ts >= 0) { const v4u xv = *(const GAS v4u*)(PROJ + ((size_t)b * SEQ + ts) * NPROJ + O_XBC + ch);
#pragma unroll
                            for (int j = 0; j < 4; ++j) { acc[2 * j] += wk[k][2 * j] * bflo(xv[j]); acc[2 * j + 1] += wk[k][2 * j + 1] * bfhi(xv[j]); } } }
                    const float dtv = sDt[hh * 128 + ll];
#pragma unroll
                    for (int jj = 0; jj < 8; ++jj) sXT[(chl + jj) * PS + ll] = (bf16)f2bf(siluf(acc[jj]) * dtv); }
            }
            __syncthreads();
            for (int p = tid; p < 4096; p += NTHR) { const int chl = p >> 4, l8 = (p & 15) * 8, hh = hf * 4 + (chl >> 6), pp = chl & 63;
                const size_t uh = (size_t)((b * 16 + g * 8 + hh) * 32 + c);
                *(GAS v4u*)((bf16*)(a->ws + WS_SSD_XT) + (uh * 64 + pp) * 128 + l8) = *(const LAS v4u*)(sXT + chl * PS + l8); }
        }
    }
}
__device__ __forceinline__ void ssd_scan_phase(CArgs a, int l, LAS unsigned char* lds, const int b, const int head, int tid) {
    asm volatile("" : "+v"(tid));
    constexpr int PS = 136, O_S = 0, O_X = 34816, O_AC = 69632, O_TE = 70656, O_DT = 71680;
    bf16* YMIX = (bf16*)(a->ws + WS_YMIX);
    const int lane = tid & 63, w = tid >> 6, r = lane & 15, q4 = lane >> 4;
    {
        const int g = head >> 3;
        const float Dsk = a->in[I_SD][l * 16 + head];
        const bf16* Cg = (const bf16*)(a->ws + WS_SSD_C) + (size_t)((b * 32) * 2 + g) * 16384 + (w * 4) * 512 + lane * 8;
        const bf16* CBg = (const bf16*)(a->ws + WS_SSD_CB) + (size_t)((b * 32) * 2 + g) * 16384 + (w * 4) * 512 + lane * 8;
        const bf16* BTg = (const bf16*)(a->ws + WS_SSD_BT) + (size_t)((b * 32) * 2 + g) * 16384 + (w * 4) * 512 + lane * 8;
        const size_t uh0 = (size_t)(b * 16 + head) * 32;
        const bf16* XTg = (const bf16*)(a->ws + WS_SSD_XT) + uh0 * 8192; const float* ACg = (const float*)(a->ws + WS_SSD_AC) + uh0 * 128; const float* DTg = (const float*)(a->ws + WS_SSD_DT) + uh0 * 128;
        v4u fC[4], fCB[4], fBT[4], rx[2]; float rac = 0.f, racl = 0.f, rdt = 0.f;
#define SSD_LDF(cc, dst, src) do { _Pragma("unroll") for (int ks = 0; ks < 4; ++ks) dst[ks] = *(const GAS v4u*)(src + (size_t)(cc) * 32768 + 512 * ks); } while (0)
#define SSD_LOADX(cc) do { _Pragma("unroll") for (int i = 0; i < 2; ++i) { const int p = tid + NTHR * i; rx[i] = *(const GAS v4u*)(XTg + (size_t)(cc) * 8192 + (p >> 4) * 128 + (p & 15) * 8); } \
            if (tid < 128) { rac = ACg[(cc) * 128 + tid]; racl = ACg[(cc) * 128 + 127]; rdt = DTg[(cc) * 128 + tid]; } } while (0)
#define SSD_STORE(bi) do { _Pragma("unroll") for (int i = 0; i < 2; ++i) { const int p = tid + NTHR * i; *(LAS v4u*)(lds + O_X + (bi) * 17408 + ((p >> 4) * PS + (p & 15) * 8) * 2) = rx[i]; } \
            if (tid < 128) { ((LAS float*)(lds + O_AC))[(bi) * 128 + tid] = rac; ((LAS float*)(lds + O_TE))[(bi) * 128 + tid] = __expf(racl - rac); ((LAS float*)(lds + O_DT))[(bi) * 128 + tid] = rdt; } } while (0)
        __syncthreads();
        SSD_LDF(0, fC, Cg); SSD_LDF(0, fCB, CBg); SSD_LDF(0, fBT, BTg); SSD_LOADX(0);
        for (int i = tid; i < 17408 / 4; i += NTHR) ((LAS unsigned*)(lds + O_S))[i] = 0u;
        SSD_STORE(0);
        f32x4 accS[4];
#pragma unroll
        for (int pt = 0; pt < 4; ++pt) accS[pt] = (f32x4){0.f, 0.f, 0.f, 0.f};
        __syncthreads();
        for (int c = 0; c < 32; ++c) {
            const int cur = c & 1;
            const LAS bf16* sS = (const LAS bf16*)(lds + O_S + cur * 17408); LAS bf16* sSn = (LAS bf16*)(lds + O_S + (cur ^ 1) * 17408); const LAS bf16* sXT = (const LAS bf16*)(lds + O_X + cur * 17408);
            const LAS float* sAc = (const LAS float*)(lds + O_AC) + cur * 128; const LAS float* sTe = (const LAS float*)(lds + O_TE) + cur * 128; const LAS float* sDt = (const LAS float*)(lds + O_DT) + cur * 128;
            const int cn = c + 1 < 32 ? c + 1 : c;
            SSD_LOADX(cn);
            const int lrow = 16 * w + r; const float ac_l = sAc[lrow];
            f32x4 accO[4], accD[4];
#pragma unroll
            for (int pt = 0; pt < 4; ++pt) { accO[pt] = (f32x4){0.f, 0.f, 0.f, 0.f}; accD[pt] = (f32x4){0.f, 0.f, 0.f, 0.f}; }
#pragma unroll
            for (int ks = 0; ks < 4; ++ks) { const bf16x8 yf = __builtin_bit_cast(bf16x8, fC[ks]);
#pragma unroll
                for (int pt = 0; pt < 4; ++pt) accO[pt] = mfma16(lds_frag(sS, 16 * pt, PS, 32 * ks, lane), yf, accO[pt]); }
            SSD_LDF(cn, fC, Cg);
#pragma unroll
            for (int ks = 0; ks < 4; ++ks) if (32 * ks <= 16 * w + 15) {
                float v[8]; const f32x4 a0 = *(const LAS f32x4*)(sAc + 32 * ks + 8 * q4), a1 = *(const LAS f32x4*)(sAc + 32 * ks + 8 * q4 + 4);
#pragma unroll
                for (int j = 0; j < 4; ++j) { const int s0 = 32 * ks + 8 * q4 + 2 * j; const float as0 = (2 * j < 4) ? a0[(2 * j) & 3] : a1[(2 * j) & 3], as1 = (2 * j + 1 < 4) ? a0[(2 * j + 1) & 3] : a1[(2 * j + 1) & 3];
                    v[2 * j] = (s0 <= lrow) ? bflo(fCB[ks][j]) * __expf(ac_l - as0) : 0.f; v[2 * j + 1] = (s0 + 1 <= lrow) ? bfhi(fCB[ks][j]) * __expf(ac_l - as1) : 0.f; }
                const bf16x8 yf = pack8(v);
#pragma unroll
                for (int pt = 0; pt < 4; ++pt) accD[pt] = mfma16(lds_frag(sXT, 16 * pt, PS, 32 * ks, lane), yf, accD[pt]); }
            SSD_LDF(cn, fCB, CBg);
            {   const float ea = __expf(ac_l), rdtl = Dsk / sDt[lrow];
#pragma unroll
                for (int pt = 0; pt < 4; ++pt) { f32x4 y = accO[pt] * ea + accD[pt];
#pragma unroll
                    for (int ii = 0; ii < 4; ++ii) y[ii] += rdtl * bf2f(sXT[(16 * pt + 4 * q4 + ii) * PS + lrow]);
                    *(GAS unsigned long long*)(YMIX + ((size_t)b * SEQ + c * 128 + lrow) * DMIX + head * 64 + 16 * pt + 4 * q4) = pack4(y); } }
            {   const float cd = __expf(sAc[127]);
#pragma unroll
                for (int pt = 0; pt < 4; ++pt) accS[pt] = accS[pt] * cd;
#pragma unroll
                for (int ks = 0; ks < 4; ++ks) { float v[8]; const f32x4 t0 = *(const LAS f32x4*)(sTe + 32 * ks + 8 * q4), t1 = *(const LAS f32x4*)(sTe + 32 * ks + 8 * q4 + 4);
#pragma unroll
                    for (int j = 0; j < 4; ++j) { const float ts0 = (2 * j < 4) ? t0[(2 * j) & 3] : t1[(2 * j) & 3], ts1 = (2 * j + 1 < 4) ? t0[(2 * j + 1) & 3] : t1[(2 * j + 1) & 3];
                        v[2 * j] = bflo(fBT[ks][j]) * ts0; v[2 * j + 1] = bfhi(fBT[ks][j]) * ts1; }
                    const bf16x8 xf = pack8(v);
#pragma unroll
                    for (int pt = 0; pt < 4; ++pt) accS[pt] = mfma16(xf, lds_frag(sXT, 16 * pt, PS, 32 * ks, lane), accS[pt]); }
#pragma unroll
                for (int pt = 0; pt < 4; ++pt) *(LAS unsigned long long*)(sSn + (16 * pt + r) * PS + 16 * w + 4 * q4) = pack4(accS[pt]);
            }
            SSD_LDF(cn, fBT, BTg);
            if (c + 1 < 32) SSD_STORE(cur ^ 1);
            WG_BAR();
        }
#undef SSD_LDF
#undef SSD_LOADX
#undef SSD_STORE
    }
}

__device__ __forceinline__ void gdn_prep_phase(CArgs a, int l, LAS unsigned char* lds, int wg, int G, int tid) {
    asm volatile("" : "+v"(tid));
    constexpr int PS = 136, TS = 72, MS = 68, TT = 65;
    LAS bf16* sKb = (LAS bf16*)lds; LAS bf16* sQb = sKb + 64 * PS; LAS bf16* sQG = sQb + 64 * PS; LAS bf16* sVT = sQG + 64 * PS;
    LAS float* sM = (LAS float*)(lds + 3 * 17408 + 18432); LAS float* sT = sM + 64 * MS; LAS float* sVec = sT + 64 * TT; LAS bf16* sQK = (LAS bf16*)(sVec + 256);
    const bf16* PROJ = (const bf16*)(a->ws + WS_PROJ);
    const float* cw = a->in[I_GCW] + (size_t)l * 4 * 1536;
    const int lane = tid & 63, w = tid >> 6, r = lane & 15, q4 = lane >> 4;
    for (int unit = wg; unit < 1024; unit += G) {
        const int b = unit >> 8, head = (unit >> 6) & 3, n = unit & 63;
        const size_t row0 = (size_t)b * SEQ + n * 64;
#define GW ((bf16*)(a->ws + WS_GD_K) + (size_t)unit * 8192)
#define GKT ((bf16*)(a->ws + WS_GD_KT) + (size_t)unit * 8192)
#define GQG ((bf16*)(a->ws + WS_GD_QG) + (size_t)unit * 8192)
#define GUT ((bf16*)(a->ws + WS_GD_VT) + (size_t)unit * 8192)
#define GT ((bf16*)(a->ws + WS_GD_T) + (size_t)unit * 4096)
#define GQK ((bf16*)(a->ws + WS_GD_QK) + (size_t)unit * 4096)
#define GVEC ((float*)(a->ws + WS_GD_VEC) + (size_t)unit * 256)
        __syncthreads();
        for (int i = tid; i < 64 * MS; i += NTHR) sM[i] = 0.f;
        if (w == 0) {
            const float nA = -__expf(a->in[I_GALOG][l * 4 + head]), dtb = a->in[I_GDTB][l * 4 + head];
            const size_t ro = (row0 + lane) * NPROJ;
            const float be = sigmoidf_(bf2f(PROJ[ro + O_GB + head])); float gsum = nA * softplusf_(bf2f(PROJ[ro + O_GA + head]) + dtb);
#pragma unroll
            for (int o = 1; o < 64; o <<= 1) { const float t_ = __shfl_up(gsum, o); if (lane >= o) gsum += t_; }
            const float glast = __shfl(gsum, 63), eg = __expf(gsum), cc = __expf(glast - gsum);
            sVec[lane] = gsum; sVec[64 + lane] = be; sVec[128 + lane] = eg;
            GVEC[lane] = be; GVEC[64 + lane] = eg; GVEC[128 + lane] = cc; GVEC[192 + lane] = __expf(glast);
        }
        __syncthreads();
        {
            const int rg = lane >> 4, c8 = (lane & 15) * 8;
#pragma unroll 1
            for (int part = 0; part < 3; ++part) {
                float wt[4][8];
#pragma unroll
                for (int k = 0; k < 4; ++k) { const f32x4 w0 = *(const f32x4*)(cw + k * 1536 + part * 512 + head * 128 + c8), w1 = *(const f32x4*)(cw + k * 1536 + part * 512 + head * 128 + c8 + 4);
#pragma unroll
                    for (int jj = 0; jj < 4; ++jj) { wt[k][jj] = w0[jj]; wt[k][4 + jj] = w1[jj]; } }
#pragma unroll
                for (int it = 0; it < 2; ++it) { const int t = 8 * w + 4 * it + rg; float acc[8];
#pragma unroll
                    for (int jj = 0; jj < 8; ++jj) acc[jj] = 0.f;
#pragma unroll
                    for (int k = 0; k < 4; ++k) { const int ts = n * 64 + t - 3 + k;
                        if (ts >= 0) { const v4u xv = *(const GAS v4u*)(PROJ + ((size_t)b * SEQ + ts) * NPROJ + O_QKV + part * 512 + head * 128 + c8);
#pragma unroll
                            for (int j = 0; j < 4; ++j) { acc[2 * j] += wt[k][2 * j] * bflo(xv[j]); acc[2 * j + 1] += wt[k][2 * j + 1] * bfhi(xv[j]); } } }
                    float ss = 0.f;
#pragma unroll
                    for (int jj = 0; jj < 8; ++jj) { acc[jj] = siluf(acc[jj]); ss += acc[jj] * acc[jj]; }
                    if (part == 2) {
#pragma unroll
                        for (int jj = 0; jj < 8; ++jj) sVT[(c8 + jj) * TS + t] = (bf16)f2bf(acc[jj]);
                    } else {
                        const float sc = rsqrtf(row16_sum(ss) + 1e-6f) * (part == 0 ? 0.08838834764831845f : 1.0f);
#pragma unroll
                        for (int jj = 0; jj < 8; ++jj) acc[jj] *= sc;
                        if (part == 1) *(LAS bf16x8*)(sKb + t * PS + c8) = pack8(acc);
                        else { *(LAS bf16x8*)(sQb + t * PS + c8) = pack8(acc); const float eg = sVec[128 + t];
#pragma unroll
                            for (int jj = 0; jj < 8; ++jj) acc[jj] *= eg;
                            *(LAS bf16x8*)(sQG + t * PS + c8) = pack8(acc); }
                    }
                }
            }
        }
        __syncthreads();
        for (int p = w; p < 26; p += NWAVES) {
            int it, jt; bool isq;
            if (p < 10) { isq = false; it = p < 1 ? 0 : (p < 3 ? 1 : (p < 6 ? 2 : 3)); jt = p - (it * (it + 1)) / 2; } else { isq = true; it = (p - 10) >> 2; jt = (p - 10) & 3; }
            f32x4 acc = {0.f, 0.f, 0.f, 0.f};
            if (jt <= it) {
#pragma unroll
                for (int ks = 0; ks < 4; ++ks) acc = mfma16(lds_frag(sKb, 16 * jt, PS, 32 * ks, lane), lds_frag(isq ? sQb : sKb, 16 * it, PS, 32 * ks, lane), acc);
                const int i = 16 * it + r; const float gi = sVec[i], bi = sVec[64 + i];
#pragma unroll
                for (int ii = 0; ii < 4; ++ii) { const int j = 16 * jt + 4 * q4 + ii; const float dec = __expf(gi - sVec[j]);
                    acc[ii] = isq ? (j <= i ? acc[ii] * dec : 0.f) : (j < i ? acc[ii] * dec * bi : 0.f); }
            }
            if (isq) *(LAS unsigned long long*)(sQK + (16 * it + r) * TS + 16 * jt + 4 * q4) = pack4(acc);
            else *(LAS f32x4*)(sM + (16 * it + r) * MS + 16 * jt + 4 * q4) = acc;
        }
        __syncthreads();
        {
            LAS float* sX = (LAS float*)(sQK + 64 * TS);
            if (w < 4) {
                int zo = 0; asm volatile("" : "+v"(zo)); const LAS float* sMv = sM + zo + (16 * w) * MS + 16 * w;
                if (lane < 16) { float ud[16];
#pragma unroll
                    for (int rr = 0; rr < 16; ++rr) { float acc = -sMv[rr * MS + lane];
#pragma unroll
                        for (int j = 0; j < rr; ++j) acc -= sMv[rr * MS + j] * ud[j];
                        ud[rr] = acc; sT[(16 * w + rr) * TT + 16 * w + lane] = acc + ((rr == lane) ? 1.f : 0.f); } }
                for (int jb = w + 1; jb < 4; ++jb)
                    for (int idx = lane; idx < 256; idx += 64) sT[(16 * w + (idx >> 4)) * TT + 16 * jb + (idx & 15)] = 0.f;
            } else {
                for (int f = w - 4; f < 16; f += 4) { const int tile = f >> 2, ks = f & 3;
                    *(GAS v4u*)(GQG + f * 512 + lane * 8) = *(const LAS v4u*)(sQG + (16 * tile + r) * PS + 32 * ks + 8 * q4); }
                for (int f = w - 4; f < 8; f += 4) { const int tile = f >> 1, ks = f & 1;
                    *(GAS v4u*)(GQK + f * 512 + lane * 8) = *(const LAS v4u*)(sQK + (16 * tile + r) * TS + 32 * ks + 8 * q4); }
                for (int f = w - 4; f < 16; f += 4) { const int dt = f >> 1, ks = f & 1, d = 16 * dt + r, s0 = 32 * ks + 8 * q4; v4u o;
#pragma unroll
                    for (int j = 0; j < 4; ++j) o[j] = (unsigned)sKb[(s0 + 2 * j) * PS + d] | ((unsigned)sKb[(s0 + 2 * j + 1) * PS + d] << 16);
                    *(GAS v4u*)(GKT + f * 512 + lane * 8) = o; }
            }
            WG_BAR();
#pragma unroll
            for (int ib = 1; ib < 4; ++ib) {
                if (w < ib) { const int jb = w; f32x4 acc = {0.f, 0.f, 0.f, 0.f};
                    for (int kb = jb; kb < ib; ++kb)
#pragma unroll
                        for (int kc = 0; kc < 4; ++kc) acc = __builtin_amdgcn_mfma_f32_16x16x4f32(sM[(16 * ib + r) * MS + 16 * kb + 4 * kc + q4], sT[(16 * kb + 4 * kc + q4) * TT + 16 * jb + r], acc, 0, 0, 0);
                    LAS float* sx = sX + w * 272;
#pragma unroll
                    for (int rr = 0; rr < 4; ++rr) sx[(4 * q4 + rr) * 17 + r] = acc[rr];
                    asm volatile("s_waitcnt lgkmcnt(0)" ::: "memory");
                    f32x4 acc2 = {0.f, 0.f, 0.f, 0.f};
#pragma unroll
                    for (int kc = 0; kc < 4; ++kc) acc2 = __builtin_amdgcn_mfma_f32_16x16x4f32(sT[(16 * ib + r) * TT + 16 * ib + 4 * kc + q4], sx[(4 * kc + q4) * 17 + r], acc2, 0, 0, 0);
#pragma unroll
                    for (int rr = 0; rr < 4; ++rr) sT[(16 * ib + 4 * q4 + rr) * TT + 16 * jb + r] = -acc2[rr];
                }
                WG_BAR();
            }
        }
        {
            LAS bf16* sTb = (LAS bf16*)sM; LAS bf16* sKgT = sQb;
            { const int t = tid >> 3, s8 = (tid & 7) * 8; float v[8];
#pragma unroll
                for (int jj = 0; jj < 8; ++jj) v[jj] = sT[t * TT + s8 + jj];
                *(LAS bf16x8*)(sTb + t * TS + s8) = pack8(v); }
            for (int p = tid; p < 1024; p += NTHR) { const int d = p >> 3, s8 = (p & 7) * 8; float v[8], u8[8]; const v4u vv = *(const LAS v4u*)(sVT + d * TS + s8);
#pragma unroll
                for (int jj = 0; jj < 8; ++jj) { const float be = sVec[64 + s8 + jj]; v[jj] = bf2f(sKb[(s8 + jj) * PS + d]) * be * sVec[128 + s8 + jj]; u8[jj] = ((jj & 1) ? bfhi(vv[jj >> 1]) : bflo(vv[jj >> 1])) * be; }
                *(LAS bf16x8*)(sKgT + d * TS + s8) = pack8(v); *(LAS bf16x8*)(sVT + d * TS + s8) = pack8(u8); }
        }
        __syncthreads();
        {
            const LAS bf16* sTb = (const LAS bf16*)sM; const LAS bf16* sKgT = sQb; LAS bf16* sW = (LAS bf16*)((LAS unsigned char*)sM + 9216);
            const int st_ = w >> 1;
            const bf16x8 t0 = lds_frag(sTb, 16 * st_, TS, 0, lane), t1 = lds_frag(sTb, 16 * st_, TS, 32, lane);
#pragma unroll
            for (int c4_ = 0; c4_ < 4; ++c4_) { const int ct = (w & 1) * 4 + c4_;
                f32x4 aw = {0.f, 0.f, 0.f, 0.f}, au = {0.f, 0.f, 0.f, 0.f};
                aw = mfma16(lds_frag(sKgT, 16 * ct, TS, 0, lane), t0, aw); aw = mfma16(lds_frag(sKgT, 16 * ct, TS, 32, lane), t1, aw);
                au = mfma16(t0, lds_frag(sVT, 16 * ct, TS, 0, lane), au); au = mfma16(t1, lds_frag(sVT, 16 * ct, TS, 32, lane), au);
                *(LAS unsigned long long*)(sW + (16 * st_ + r) * PS + 16 * ct + 4 * q4) = pack4(aw);
                *(GAS unsigned long long*)(GUT + (ct * 4 + st_) * 256 + lane * 4) = pack4(au); }
        }
        __syncthreads();
        { const LAS bf16* sW = (const LAS bf16*)((LAS unsigned char*)sM + 9216);
            for (int f = w; f < 16; f += NWAVES) { const int tile = f >> 2, ks = f & 3;
                *(GAS v4u*)(GW + f * 512 + lane * 8) = *(const LAS v4u*)(sW + (16 * tile + r) * PS + 32 * ks + 8 * q4); } }
    }
#undef GW
#undef GKT
#undef GQG
#undef GUT
#undef GT
#undef GQK
#undef GVEC
}
__device__ __forceinline__ void gdn_scan_phase(CArgs a, int l, LAS unsigned char* lds, const int b, const int head, const int eb, int tid) {
    asm volatile("" : "+v"(tid));
    constexpr int PS = 136, TS = 72, O_ST = 0, O_RT = 34816, O_VN = O_RT + 9216, O_VC = O_VN + 9216;
    bf16* YMIX = (bf16*)(a->ws + WS_YMIX);
    const int lane = tid & 63, w = tid >> 6, r = lane & 15, q4 = lane >> 4, st = w >> 1, eh = w & 1;
    LAS bf16* sRT = (LAS bf16*)(lds + O_RT); LAS bf16* sVN = (LAS bf16*)(lds + O_VN); LAS bf16* sVC = (LAS bf16*)(lds + O_VC);
    {
        const size_t u0 = (size_t)(b * 4 + head) * 64;
        const bf16* pW = (const bf16*)(a->ws + WS_GD_K) + u0 * 8192 + (st * 4) * 512 + lane * 8; const bf16* pQG = (const bf16*)(a->ws + WS_GD_QG) + u0 * 8192 + (st * 4) * 512 + lane * 8;
        const bf16* pQK = (const bf16*)(a->ws + WS_GD_QK) + u0 * 4096 + (st * 2) * 512 + lane * 8;
        const bf16* pKT = (const bf16*)(a->ws + WS_GD_KT) + u0 * 8192 + (w * 2) * 512 + lane * 8;
        const bf16* pUT = (const bf16*)(a->ws + WS_GD_VT) + u0 * 8192 + (size_t)(((eb * 4 + 2 * eh) * 4 + st) * 256) + lane * 4;
        const float* pVec = (const float*)(a->ws + WS_GD_VEC) + u0 * 256 + 16 * st + 4 * q4;
        v4u xW[4], yQG[4], yQK[2], xKT[2], nQG[4], nQK[2]; unsigned long long uT[2]; f32x4 c4; float gl;
#define GD_LD_A(nn) do { _Pragma("unroll") for (int ks = 0; ks < 4; ++ks) xW[ks] = *(const GAS v4u*)(pW + (size_t)(nn) * 8192 + 512 * ks); \
            _Pragma("unroll") for (int j = 0; j < 2; ++j) uT[j] = *(const GAS unsigned long long*)(pUT + (size_t)(nn) * 8192 + j * 1024); \
            c4 = *(const GAS f32x4*)(pVec + (size_t)(nn) * 256 + 128); } while (0)
#define GD_LD_C(nn, QG_, QK_) do { _Pragma("unroll") for (int ks = 0; ks < 4; ++ks) QG_[ks] = *(const GAS v4u*)(pQG + (size_t)(nn) * 8192 + 512 * ks); \
            _Pragma("unroll") for (int ks = 0; ks < 2; ++ks) QK_[ks] = *(const GAS v4u*)(pQK + (size_t)(nn) * 4096 + 512 * ks); } while (0)
#define GD_LD_D(nn) do { _Pragma("unroll") for (int ks = 0; ks < 2; ++ks) xKT[ks] = *(const GAS v4u*)(pKT + (size_t)(nn) * 8192 + 512 * ks); gl = pVec[(size_t)(nn) * 256 + 192 - (16 * st + 4 * q4)]; } while (0)
        __syncthreads();
        GD_LD_A(0); GD_LD_C(0, yQG, yQK); GD_LD_D(0);
        for (int i = tid; i < 17408 / 4; i += NTHR) ((LAS unsigned*)(lds + O_ST))[i] = 0u;
        f32x4 accS[4];
#pragma unroll
        for (int et = 0; et < 4; ++et) accS[et] = (f32x4){0.f, 0.f, 0.f, 0.f};
        __syncthreads();
        for (int n = 0; n < 64; ++n) {
            const int cur = n & 1; const LAS bf16* sST = (const LAS bf16*)(lds + O_ST + cur * 17408); LAS bf16* sSTn = (LAS bf16*)(lds + O_ST + (cur ^ 1) * 17408);
            const int nn = n + 1 < 64 ? n + 1 : n;
            {
                bf16x8 fs[2][4];
#pragma unroll
                for (int j = 0; j < 2; ++j)
#pragma unroll
                    for (int ks = 0; ks < 4; ++ks) fs[j][ks] = lds_frag(sST, 16 * (2 * eh + j), PS, 32 * ks, lane);
                __builtin_amdgcn_sched_barrier(0);
#pragma unroll
                for (int j = 0; j < 2; ++j) { const int e0 = 16 * (2 * eh + j); f32x4 acc = {0.f, 0.f, 0.f, 0.f};
#pragma unroll
                    for (int ks = 0; ks < 4; ++ks) acc = mfma16(__builtin_bit_cast(bf16x8, xW[ks]), fs[j][ks], acc);
                    const unsigned ulo = (unsigned)uT[j], uhi = (unsigned)(uT[j] >> 32); f32x4 vn;
                    vn[0] = bflo(ulo) - acc[0]; vn[1] = bfhi(ulo) - acc[1]; vn[2] = bflo(uhi) - acc[2]; vn[3] = bfhi(uhi) - acc[3];
                    *(LAS unsigned long long*)(sVN + (e0 + r) * TS + 16 * st + 4 * q4) = pack4(vn); *(LAS unsigned long long*)(sVC + (e0 + r) * TS + 16 * st + 4 * q4) = pack4(vn * c4); }
            }
            GD_LD_A(nn); GD_LD_C(nn, nQG, nQK);
            WG_BAR();
            {
                bf16x8 fv[4][2];
#pragma unroll
                for (int et = 0; et < 4; ++et)
#pragma unroll
                    for (int ks = 0; ks < 2; ++ks) fv[et][ks] = lds_frag(sVC, 16 * et, TS, 32 * ks, lane);
                __builtin_amdgcn_sched_barrier(0);
#pragma unroll
                for (int et = 0; et < 4; ++et) { accS[et] = accS[et] * gl;
#pragma unroll
                    for (int ks = 0; ks < 2; ++ks) accS[et] = mfma16(__builtin_bit_cast(bf16x8, xKT[ks]), fv[et][ks], accS[et]);
                    *(LAS unsigned long long*)(sSTn + (16 * et + r) * PS + 16 * w + 4 * q4) = pack4(accS[et]); }
            }
            GD_LD_D(nn);
            {
                bf16x8 fs[2][4], fn[2][2];
#pragma unroll
                for (int j = 0; j < 2; ++j) {
#pragma unroll
                    for (int ks = 0; ks < 4; ++ks) fs[j][ks] = lds_frag(sST, 16 * (2 * eh + j), PS, 32 * ks, lane);
#pragma unroll
                    for (int ks = 0; ks < 2; ++ks) fn[j][ks] = lds_frag(sVN, 16 * (2 * eh + j), TS, 32 * ks, lane); }
                __builtin_amdgcn_sched_barrier(0);
#pragma unroll
                for (int j = 0; j < 2; ++j) { const int e0 = 16 * (2 * eh + j); f32x4 acc = {0.f, 0.f, 0.f, 0.f};
#pragma unroll
                    for (int ks = 0; ks < 4; ++ks) acc = mfma16(fs[j][ks], __builtin_bit_cast(bf16x8, yQG[ks]), acc);
#pragma unroll
                    for (int ks = 0; ks < 2; ++ks) acc = mfma16(fn[j][ks], __builtin_bit_cast(bf16x8, yQK[ks]), acc);
                    *(GAS unsigned long long*)(YMIX + ((size_t)b * SEQ + n * 64 + 16 * st + r) * DMIX + 1024 + head * 128 + eb * 64 + e0 + 4 * q4) = pack4(acc); }
            }
#pragma unroll
            for (int ks = 0; ks < 4; ++ks) yQG[ks] = nQG[ks];
#pragma unroll
            for (int ks = 0; ks < 2; ++ks) yQK[ks] = nQK[ks];
            WG_BAR();
        }
#undef GD_LD_A
#undef GD_LD_C
#undef GD_LD_D
    }
}

__device__ __forceinline__ void gdn_rec_phase(CArgs a, int l, LAS unsigned char* lds, int wg, int G, int tid) {
    asm volatile("" : "+v"(tid));
    constexpr int TB = 32;
    LAS float* sQ = (LAS float*)lds; LAS float* sK = sQ + TB * 128; LAS float* sV = sK + TB * 128; LAS float* sBe = sV + TB * 8; LAS float* sAl = sBe + TB; LAS float* sO = sAl + TB;
    const bf16* PROJ = (const bf16*)(a->ws + WS_PROJ); bf16* YMIX = (bf16*)(a->ws + WS_YMIX);
    const float* cw = a->in[I_GCW] + (size_t)l * 4 * 1536;
    const int lane = tid & 63, w = tid >> 6;
    for (int unit = wg; unit < 256; unit += G) {
        const int b = unit >> 6, head = (unit >> 4) & 3, eb = unit & 15;
        const float nA = -__expf(a->in[I_GALOG][l * 4 + head]), dtb = a->in[I_GDTB][l * 4 + head];
        float S0 = 0.f, S1 = 0.f;
        for (int t0 = 0; t0 < SEQ; t0 += TB) {
            __syncthreads();
            for (int idx = tid; idx < TB * 264; idx += NTHR) {
                const int tt = idx / 264, ci = idx % 264, t = t0 + tt;
                const int ch = ci < 128 ? head * 128 + ci : (ci < 256 ? 512 + head * 128 + (ci - 128) : 1024 + head * 128 + eb * 8 + (ci - 256));
                float acc = 0.f;
#pragma unroll
                for (int k = 0; k < 4; ++k) { const int ts = t - 3 + k; if (ts >= 0) acc += cw[k * 1536 + ch] * bf2f(PROJ[(size_t)(b * SEQ + ts) * NPROJ + O_QKV + ch]); }
                const float v = siluf(acc);
                if (ci < 128) sQ[tt * 128 + ci] = v; else if (ci < 256) sK[tt * 128 + ci - 128] = v; else sV[tt * 8 + ci - 256] = v;
            }
            if (tid < TB) { const size_t ro = (size_t)(b * SEQ + t0 + tid) * NPROJ; const float braw = bf2f(PROJ[ro + O_GB + head]), araw = bf2f(PROJ[ro + O_GA + head]);
                sBe[tid] = sigmoidf_(braw); sAl[tid] = __expf(nA * softplusf_(araw + dtb)); }
            __syncthreads();
            for (int tt = w; tt < TB; tt += NWAVES) {
                const float q0 = sQ[tt * 128 + lane], q1 = sQ[tt * 128 + 64 + lane], k0 = sK[tt * 128 + lane], k1 = sK[tt * 128 + 64 + lane];
                const float sq = rsqrtf(wave_sum(q0 * q0 + q1 * q1) + 1e-6f) * 0.08838834764831845f, sk = rsqrtf(wave_sum(k0 * k0 + k1 * k1) + 1e-6f);
                sQ[tt * 128 + lane] = q0 * sq; sQ[tt * 128 + 64 + lane] = q1 * sq; sK[tt * 128 + lane] = k0 * sk; sK[tt * 128 + 64 + lane] = k1 * sk;
            }
            __syncthreads();
#pragma unroll 2
            for (int tt = 0; tt < TB; ++tt) {
                const float k0 = sK[tt * 128 + lane], k1 = sK[tt * 128 + 64 + lane], q0 = sQ[tt * 128 + lane], q1 = sQ[tt * 128 + 64 + lane];
                const float al = sAl[tt], be = sBe[tt], v = sV[tt * 8 + w];
                const float dot = wave_sum(k0 * S0 + k1 * S1);
                const float vn = be * (v - al * dot);
                S0 = al * S0 + k0 * vn; S1 = al * S1 + k1 * vn;
                const float od = wave_sum(q0 * S0 + q1 * S1);
                if (lane == 0) sO[tt * 8 + w] = od;
            }
            __syncthreads();
            if (tid < TB * 8) { const int tt = tid >> 3, i = tid & 7; YMIX[(size_t)(b * SEQ + t0 + tt) * DMIX + 1024 + head * 128 + eb * 8 + i] = (bf16)f2bf(sO[tid]); }
        }
    }
}

__device__ __forceinline__ void hgrn_rec_phase(CArgs a, int l, LAS unsigned char* lds, int wg, int G, int tid) {
    asm volatile("" : "+v"(tid));
    constexpr int TB = 32;
    LAS float* sQ = (LAS float*)lds; LAS float* sF = sQ + TB * 128; LAS float* sV = sF + TB * 128; LAS float* sO = sV + TB * 8; LAS float* sLb = sO + TB * 8;
    const bf16* PROJ = (const bf16*)(a->ws + WS_PROJ); bf16* YMIX = (bf16*)(a->ws + WS_YMIX);
    const int lane = tid & 63, w = tid >> 6;
    for (int unit = wg; unit < 256; unit += G) {
        const int b = unit >> 6, head = (unit >> 4) & 3, eb = unit & 15;
        __syncthreads();
        if (tid < 128) {
            const int c = head * 128 + tid; float lg[DEPTH], mx = -1e30f;
#pragma unroll
            for (int j = 0; j < DEPTH; ++j) { lg[j] = a->in[I_HLB][j * 512 + c]; mx = fmaxf(mx, lg[j]); }
            float den = 0.f, num = 0.f;
#pragma unroll
            for (int j = 0; j < DEPTH; ++j) { const float e = __expf(lg[j] - mx); den += e; if (j >= 1 && j <= l) num += e; }
            sLb[tid] = num / den;
        }
        float S0 = 0.f, S1 = 0.f;
        for (int t0 = 0; t0 < SEQ; t0 += TB) {
            __syncthreads();
            for (int idx = tid; idx < TB * 264; idx += NTHR) {
                const int tt = idx / 264, ci = idx % 264; const size_t ro = (size_t)(b * SEQ + t0 + tt) * NPROJ;
                if (ci < 128) sQ[tt * 128 + ci] = siluf(bf2f(PROJ[ro + O_HQ + head * 128 + ci]));
                else if (ci < 256) { const int d = ci - 128; const float lb = sLb[d]; sF[tt * 128 + d] = lb + (1.f - lb) * sigmoidf_(bf2f(PROJ[ro + O_HF + head * 128 + d])); }
                else sV[tt * 8 + ci - 256] = bf2f(PROJ[ro + O_HI + head * 128 + eb * 8 + (ci - 256)]);
            }
            __syncthreads();
#pragma unroll 2
            for (int tt = 0; tt < TB; ++tt) {
                const float f0 = sF[tt * 128 + lane], f1 = sF[tt * 128 + 64 + lane], q0 = sQ[tt * 128 + lane], q1 = sQ[tt * 128 + 64 + lane], v = sV[tt * 8 + w];
                S0 = f0 * S0 + (1.f - f0) * v; S1 = f1 * S1 + (1.f - f1) * v;
                const float od = wave_sum(q0 * S0 + q1 * S1);
                if (lane == 0) sO[tt * 8 + w] = od;
            }
            __syncthreads();
            if (tid < TB * 8) { const int tt = tid >> 3, i = tid & 7; YMIX[(size_t)(b * SEQ + t0 + tt) * DMIX + 1536 + head * 128 + eb * 8 + i] = (bf16)f2bf(sO[tid]); }
        }
    }
}

__device__ __forceinline__ void mix_post_phase(CArgs a, int l, int wg, int G, int tid) {
    asm volatile("" : "+v"(tid));
    const bf16* PROJ = (const bf16*)(a->ws + WS_PROJ); bf16* YMIX = (bf16*)(a->ws + WS_YMIX);
    const int lane = tid & 63, gw = wg * NWAVES + (tid >> 6), NGW = G * NWAVES;
    const float* snw = a->in[I_SNW] + l * 1024; const float* gnw = a->in[I_GNW] + l * 128; const float* hnw = a->in[I_HNW] + l * 128;
    for (int row = gw; row < M; row += NGW) {
        const bf16* pr = PROJ + (size_t)row * NPROJ; bf16* yr = YMIX + (size_t)row * DMIX;
#pragma unroll
        for (int j = 0; j < 2; ++j) {
            const int ch = j * 512 + lane * 8; const v4u yv = *(const GAS v4u*)(yr + ch), zv = *(const GAS v4u*)(pr + O_Z + ch);
            float v[8]; float ss = 0.f;
#pragma unroll
            for (int i = 0; i < 4; ++i) { v[2 * i] = bflo(yv[i]) * siluf(bflo(zv[i])); v[2 * i + 1] = bfhi(yv[i]) * siluf(bfhi(zv[i])); ss += v[2 * i] * v[2 * i] + v[2 * i + 1] * v[2 * i + 1]; }
            const float rstd = rsqrtf(wave_sum(ss) * (1.f / 512.f) + 1e-6f);
            v4u o;
#pragma unroll
            for (int i = 0; i < 4; ++i) o[i] = pk2(v[2 * i] * rstd * snw[ch + 2 * i], v[2 * i + 1] * rstd * snw[ch + 2 * i + 1]);
            *(GAS v4u*)(yr + ch) = o;
        }
#pragma unroll
        for (int part = 0; part < 2; ++part) {
            const int ch = lane * 8, yo = 1024 + part * 512 + ch, go = (part == 0 ? O_GG : O_HG) + ch; const float* nw = part == 0 ? gnw : hnw;
            const v4u yv = *(const GAS v4u*)(yr + yo), gv = *(const GAS v4u*)(pr + go);
            float v[8]; float ss = 0.f;
#pragma unroll
            for (int i = 0; i < 4; ++i) { v[2 * i] = bflo(yv[i]); v[2 * i + 1] = bfhi(yv[i]); ss += v[2 * i] * v[2 * i] + v[2 * i + 1] * v[2 * i + 1]; }
            ss = row16_sum(ss);
            const float rstd = rsqrtf(ss * (1.f / 128.f) + 1e-6f);
            v4u o;
#pragma unroll
            for (int i = 0; i < 4; ++i) { const int c = (ch & 127) + 2 * i; o[i] = pk2(v[2 * i] * rstd * nw[c] * siluf(bflo(gv[i])), v[2 * i + 1] * rstd * nw[c + 1] * siluf(bfhi(gv[i]))); }
            *(GAS v4u*)(yr + yo) = o;
        }
    }
}

__device__ __forceinline__ void moe_tables(const gu32* cnt, LAS unsigned char* lds, int tid) {
    LAS int* tab = (LAS int*)(lds + LDS_OFF_TAB);
    __syncthreads();
    if (tid == 0) { int p = 0, q = 0;
        for (int e = 0; e < 16; ++e) { const int c = (int)__hip_atomic_load(cnt + e, RLX_AGENT); tab[e] = p; tab[17 + e] = q; p += (c + 255) & ~255; q += c; }
        tab[16] = p; tab[33] = q; }
    __syncthreads();
}
template <bool ROUTER>
__device__ __forceinline__ void ln_phase(CArgs a, int l, const float* gam, const float* bet, LAS unsigned char* lds, int wg, int G, int tid) {
    asm volatile("" : "+v"(tid));
    const int lane = tid & 63, wave = tid >> 6, gw = wg * NWAVES + wave, NGW = G * NWAVES;
    const float* ADD = (const float*)(a->ws + WS_MIX); float* H = a->out; bf16* HB = (bf16*)(a->ws + WS_HB);
    gu32* cnt = (gu32*)(a->ws + WS_CTL) + CW_CNT + l * 16;
    LAS float* sW = (LAS float*)lds;
    LAS float* sL = sW + 20 * D + wave * 32;
    LAS int* sCnt = (LAS int*)(sW + 20 * D + 256);
    LAS unsigned* sEnt = (LAS unsigned*)(sCnt + 32);
    constexpr int MAXENT = 2 * NWAVES * 8;
    if (ROUTER) {
        __syncthreads();
        const float* wrg = a->in[I_WRG] + (size_t)l * D * 4; const float* wre = a->in[I_WRE] + (size_t)l * D * 16;
        for (int i = tid; i < D * 20; i += NTHR) { const int c = i >> 10, k = i & 1023; sW[i] = c < 4 ? wrg[k * 4 + c] : wre[k * 16 + c - 4]; }
        if (tid < 32) sCnt[tid] = 0;
        __syncthreads();
    } else moe_tables(cnt, lds, tid);
    const LAS int* tab = (const LAS int*)(lds + LDS_OFF_TAB);
    f32x4 gv[4], bv[4];
#pragma unroll
    for (int j = 0; j < 4; ++j) { gv[j] = *(const f32x4*)(gam + 4 * lane + 256 * j); bv[j] = *(const f32x4*)(bet + 4 * lane + 256 * j); }
    int kk = 0;
    f32x4 ph[4], pa[4];
    const float* Hin = (ROUTER && l == 0) ? a->in[I_X] : H;
    if (ROUTER && gw < M) {
#pragma unroll
        for (int j = 0; j < 4; ++j) { ph[j] = *(const GAS f32x4*)(Hin + (size_t)gw * D + 4 * lane + 256 * j); pa[j] = *(const GAS f32x4*)(ADD + (size_t)gw * D + 4 * lane + 256 * j); } }
    for (int row = gw; row < M; row += NGW, ++kk) {
        f32x4 v[4]; float s = 0.f;
        if (ROUTER) {
#pragma unroll
            for (int j = 0; j < 4; ++j) { v[j] = ph[j] * DN_ALPHA + pa[j]; s += (v[j].x + v[j].y) + (v[j].z + v[j].w); }
            const int nrow = row + NGW < M ? row + NGW : row;
#pragma unroll
            for (int j = 0; j < 4; ++j) { ph[j] = *(const GAS f32x4*)(Hin + (size_t)nrow * D + 4 * lane + 256 * j); pa[j] = *(const GAS f32x4*)(ADD + (size_t)nrow * D + 4 * lane + 256 * j); }
        } else {
            const unsigned s0 = ((const GAS unsigned*)(a->ws + WS_SLOT))[2 * row], s1 = ((const GAS unsigned*)(a->ws + WS_SLOT))[2 * row + 1];
            const bf16* y0 = (const bf16*)(a->ws + WS_YS) + (size_t)(tab[s0 >> 16] + (int)(s0 & 0xffffu)) * D; const bf16* y1 = (const bf16*)(a->ws + WS_YS) + (size_t)(tab[s1 >> 16] + (int)(s1 & 0xffffu)) * D;
#pragma unroll
            for (int j = 0; j < 4; ++j) { const f32x4 hv = *(const GAS f32x4*)(H + (size_t)row * D + 4 * lane + 256 * j);
                const unsigned long long p0 = *(const GAS unsigned long long*)(y0 + 4 * lane + 256 * j), p1 = *(const GAS unsigned long long*)(y1 + 4 * lane + 256 * j);
                f32x4 av; av.x = bflo((unsigned)p0) + bflo((unsigned)p1); av.y = bfhi((unsigned)p0) + bfhi((unsigned)p1); av.z = bflo((unsigned)(p0 >> 32)) + bflo((unsigned)(p1 >> 32)); av.w = bfhi((unsigned)(p0 >> 32)) + bfhi((unsigned)(p1 >> 32));
                v[j] = hv * DN_ALPHA + av; s += (v[j].x + v[j].y) + (v[j].z + v[j].w); }
        }
        const float mean = wave_sum(s) * (1.f / D); float s2 = 0.f;
#pragma unroll
        for (int j = 0; j < 4; ++j) { v[j] = v[j] - mean; s2 += (v[j].x * v[j].x + v[j].y * v[j].y) + (v[j].z * v[j].z + v[j].w * v[j].w); }
        const float rstd = rsqrtf(wave_sum(s2) * (1.f / D) + LN_EPS);
#pragma unroll
        for (int j = 0; j < 4; ++j) { v[j] = v[j] * rstd * gv[j] + bv[j];
            *(GAS f32x4*)(H + (size_t)row * D + 4 * lane + 256 * j) = v[j];
            *(GAS unsigned long long*)(HB + (size_t)row * D + 4 * lane + 256 * j) = (unsigned long long)pk2(v[j].x, v[j].y) | ((unsigned long long)pk2(v[j].z, v[j].w) << 32); }
        if (ROUTER) {
            float lg[20];
#pragma unroll 1
            for (int c = 0; c < 20; ++c) { float p = 0.f;
#pragma unroll
                for (int j = 0; j < 4; ++j) { const f32x4 wv = *(const LAS f32x4*)(sW + c * D + 4 * lane + 256 * j); p += (v[j].x * wv.x + v[j].y * wv.y) + (v[j].z * wv.z + v[j].w * wv.w); }
                p = wave_sum(p); if (lane == 0) sL[c] = p; }
#pragma unroll
            for (int c = 0; c < 20; ++c) lg[c] = sL[c];
            float pg[4], mx = -1e30f; int gi = 0;
#pragma unroll
            for (int c = 0; c < 4; ++c) { pg[c] = lg[c] + a->in[I_BRG][l * 4 + c]; if (pg[c] > mx) { mx = pg[c]; gi = c; } }
            float den = 0.f;
#pragma unroll
            for (int c = 0; c < 4; ++c) den += __expf(pg[c] - mx);
            const float g_p = 1.0f / den;
            float le[4], emx = -1e30f; int i1 = 0;
#pragma unroll
            for (int c = 0; c < 4; ++c) { float x = 0.f;
#pragma unroll
                for (int gg = 0; gg < 4; ++gg) x = (gi == gg) ? lg[4 + gg * 4 + c] + a->in[I_BRE][l * 16 + gg * 4 + c] : x;
                le[c] = x; if (x > emx) { emx = x; i1 = c; } }
            float e2mx = -1e30f; int i2 = 0;
#pragma unroll
            for (int c = 0; c < 4; ++c) if (c != i1 && le[c] > e2mx) { e2mx = le[c]; i2 = c; }
            const float x2 = __expf(e2mx - emx), w1 = g_p / (1.0f + x2), w2 = g_p * x2 / (1.0f + x2);
            if (lane < 2) {
                const int e = gi * 4 + (lane == 0 ? i1 : i2); const float wv = lane == 0 ? w1 : w2;
                if (kk < 8) { const int lp = __hip_atomic_fetch_add(sCnt + e, 1, __ATOMIC_RELAXED, __HIP_MEMORY_SCOPE_WORKGROUP); LAS unsigned* en = sEnt + ((wave * 8 + kk) * 2 + lane) * 4;
                    en[0] = (unsigned)row; en[1] = (unsigned)e; en[2] = (unsigned)lp; en[3] = __builtin_bit_cast(unsigned, wv); }
                else { const int pos = (int)__hip_atomic_fetch_add(cnt + e, 1u, RLX_AGENT);
                    ((GAS int*)(a->ws + WS_LTOK))[e * M + pos] = row; ((GAS float*)(a->ws + WS_LW))[e * M + pos] = wv; ((GAS unsigned*)(a->ws + WS_SLOT))[2 * row + lane] = ((unsigned)e << 16) | (unsigned)pos; }
            }
        }
    }
    if (ROUTER) {
        __syncthreads();
        if (tid < 16) sCnt[16 + tid] = (int)__hip_atomic_fetch_add(cnt + tid, (unsigned)sCnt[tid], RLX_AGENT);
        __syncthreads();
        const int nk = kk < 8 ? kk : 8;
        if (tid < MAXENT) { const int wv_ = tid >> 4, k_ = (tid >> 1) & 7;
            int nkw = 0;
#pragma unroll
            for (int k2 = 0; k2 < 8; ++k2) nkw += (wg * NWAVES + wv_ + k2 * NGW < M) ? 1 : 0;
            if (k_ < nkw) { const LAS unsigned* en = sEnt + tid * 4; const int e = (int)en[1], pos = sCnt[16 + e] + (int)en[2];
                ((GAS int*)(a->ws + WS_LTOK))[e * M + pos] = (int)en[0]; ((GAS unsigned*)(a->ws + WS_LW))[e * M + pos] = en[3]; ((GAS unsigned*)(a->ws + WS_SLOT))[2 * en[0] + (tid & 1)] = ((unsigned)e << 16) | (unsigned)pos; } }
        (void)nk;
    }
}
__device__ __forceinline__ void moe_gather_phase(CArgs a, int l, LAS unsigned char* lds, int wg, int G, int tid) {
    asm volatile("" : "+v"(tid));
    const int lane = tid & 63, gw = wg * NWAVES + (tid >> 6), NGW = G * NWAVES;
    moe_tables((gu32*)(a->ws + WS_CTL) + CW_CNT + l * 16, lds, tid);
    const LAS int* tab = (const LAS int*)(lds + LDS_OFF_TAB);
    const bf16* HB = (const bf16*)(a->ws + WS_HB); bf16* XS = (bf16*)(a->ws + WS_XS);
    for (int idx = gw; idx < 2 * M; idx += NGW) {
        int e = 0;
#pragma unroll
        for (int k = 1; k < 16; ++k) e += (tab[17 + k] <= idx) ? 1 : 0;
        const int pos = idx - tab[17 + e], dst = tab[e] + pos;
        const int row = ((const GAS int*)(a->ws + WS_LTOK))[e * M + pos];
        const v4u x0 = *(const GAS v4u*)(HB + (size_t)row * D + 8 * lane), x1 = *(const GAS v4u*)(HB + (size_t)row * D + 512 + 8 * lane);
        *(GAS v4u*)(XS + (size_t)dst * D + 8 * lane) = x0; *(GAS v4u*)(XS + (size_t)dst * D + 512 + 8 * lane) = x1;
        if (lane == 0) ((GAS float*)(a->ws + WS_WSORT))[dst] = ((const GAS float*)(a->ws + WS_LW))[e * M + pos];
    }
}

enum { P_IN = 0, P_PREP, P_SCAN, P_POST, P_OUT, P_LN1, P_GU, P_DN, P_LN2, NPH };
constexpr int N_PHASES = 1 + DEPTH * NPH;
__global__ void __launch_bounds__(NTHR, 2) fwd(Args args) {
    extern __shared__ __attribute__((aligned(16))) unsigned char lds_raw[];
    LAS unsigned char* lds = (LAS unsigned char*)lds_raw;
    volatile LAS unsigned* MISC = (volatile LAS unsigned*)(lds + MISC_OFF);
    const int tid = threadIdx.x, G = gridDim.x, bx = blockIdx.x;
    unsigned char* ws0 = args.ws;
    gu32* ctl = (gu32*)(ws0 + WS_CTL);
    for (int u = tid; u < (LDS_BYTES - LDSCTL_OFF) / 4; u += NTHR) ((LAS unsigned*)(lds + LDSCTL_OFF))[u] = 0u;
    __syncthreads();
    const int lo = args.ph_lo, hi = args.ph_hi;
    const bool use_bar = (hi - lo) > 1;
    XcdBarrier bar; bar.bar = (unsigned*)(ctl + CW_BAR); bar.x = 0; bar.st = nullptr;
    if (use_bar) bar = xcd_barrier_post((unsigned*)(ctl + CW_BAR), MISC + 8);
#define IN(k) (lo <= (k) && (k) < hi)
#define SEAM(k) do { if (IN(k) && IN((k) + 1)) xcd_barrier(bar); } while (0)

    if (IN(0)) { p0_prologue(ARGS_HERE(), lds, bx, G, tid); weights_phase(ARGS_HERE(), 0, 1, lds, bx, G, tid); SEAM(0); }

    for (int l = 0; l < DEPTH; ++l) {
        const int base = 1 + l * NPH;
        unsigned char* ws = ws0; asm volatile("" : "+s"(ws));
        if (IN(base + P_IN)) {
            pg8::Gemm g{(const pg8::bf16_t*)(ws + WS_HB), (const pg8::bf16_t*)(ws + WS_WIN), M, NPROJ, D}; pg8::StaticOrder S; S.init(M, NPROJ, G, bx);
            pg8::EpiBf16<0> E{(pg8::bf16_t*)(ws + WS_PROJ), NPROJ, nullptr, 0, 0, 1.f};
            pg8::gemm_phase<pg8::EpiBf16<0>, pg8::StaticOrder, true, true>(lds + RING_OFF, g, S, E);
            SEAM(base + P_IN);
        }
        if (IN(base + P_PREP)) {
            hgrn_prep_phase(ARGS_HERE(), l, lds, bx, G, tid);
            ssd_prep_phase(ARGS_HERE(), l, lds, bx, G, tid);
            gdn_prep_phase(ARGS_HERE(), l, lds, bx, G, tid);
            SEAM(base + P_PREP); }
        if (IN(base + P_SCAN)) {
            if (G >= 192) {
                if (bx < 64) { const int pr = bx & 7, hh = bx >> 3; ssd_scan_phase(ARGS_HERE(), l, lds, pr >> 1, (pr & 1) * 8 + hh, tid); }
                else if (bx < 96) { const int x = (bx - 64) & 7, y = (bx - 64) >> 3, pr = x * 2 + (y >> 1); gdn_scan_phase(ARGS_HERE(), l, lds, pr >> 2, pr & 3, y & 1, tid); }
                else if (bx < 160) { const int x = (bx - 96) & 7, y = (bx - 96) >> 3, pr = x * 2 + (y >> 2); hgrn_scan_phase(ARGS_HERE(), l, lds, pr >> 2, pr & 3, y & 3, tid); }
                else { weights_phase(ARGS_HERE(), l, 14, lds, bx - 160, G - 160, tid);
                       if (l + 1 < DEPTH) weights_phase(ARGS_HERE(), l + 1, 1, lds, bx - 160, G - 160, tid); }
            }
            SEAM(base + P_SCAN); }
        if (IN(base + P_POST)) { mix_post_phase(ARGS_HERE(), l, bx, G, tid); SEAM(base + P_POST); }
        if (IN(base + P_OUT)) {
            pg8::Gemm g{(const pg8::bf16_t*)(ws + WS_YMIX), (const pg8::bf16_t*)(ws + WS_WOUT), M, D, DMIX}; pg8::StaticOrder S; S.init(M, D, G, bx);
            pg8::EpiF32 E{(float*)(ws + WS_MIX), D};
            pg8::gemm_phase<pg8::EpiF32, pg8::StaticOrder, true, true>(lds + RING_OFF, g, S, E);
            SEAM(base + P_OUT);
        }
        if (IN(base + P_LN1)) { CArgs a_ = ARGS_HERE(); ln_phase<true>(a_, l, a_->in[I_LN1G] + l * D, a_->in[I_LN1B] + l * D, lds, bx, G, tid); SEAM(base + P_LN1); }
        if (IN(base + P_GU)) {
            moe_tables(ctl + CW_CNT + l * 16, lds, tid);
            pg8::Gemm g{(const pg8::bf16_t*)(ws + WS_HB), (const pg8::bf16_t*)(ws + WS_WGU), MAXROWS, NGU, D}; pg8::MoeOrder<2, true> S{(const LAS int*)(lds + LDS_OFF_TAB), G, bx, (const int*)(ws + WS_LTOK), M};
            pg8::EpiSwiGLUs E{(pg8::bf16_t*)(ws + WS_HS), (const float*)(ws + WS_LW), M, (const LAS int*)(lds + LDS_OFF_TAB)};
            pg8::gemm_phase<pg8::EpiSwiGLUs, pg8::MoeOrder<2, true>, true, true>(lds + RING_OFF, g, S, E);
            SEAM(base + P_GU);
        }
        if (IN(base + P_DN)) {
            moe_tables(ctl + CW_CNT + l * 16, lds, tid);
            pg8::Gemm g{(const pg8::bf16_t*)(ws + WS_HS), (const pg8::bf16_t*)(ws + WS_WDN), MAXROWS, NEXP * D, DEXP}; pg8::MoeOrder<4> S{(const LAS int*)(lds + LDS_OFF_TAB), G, bx, nullptr, 0};
            pg8::EpiBf16s E{(pg8::bf16_t*)(ws + WS_YS)};
            pg8::gemm_phase<pg8::EpiBf16s, pg8::MoeOrder<4>, true, true>(lds + RING_OFF, g, S, E);
            SEAM(base + P_DN);
        }
        if (IN(base + P_LN2)) { CArgs a_ = ARGS_HERE(); ln_phase<false>(a_, l, a_->in[I_LN2G] + l * D, a_->in[I_LN2B] + l * D, lds, bx, G, tid); SEAM(base + P_LN2); }
    }
#undef IN
#undef SEAM
}

#ifndef MK_ONE_LAUNCH
#define MK_ONE_LAUNCH 1
#endif
extern "C" void kernel_launch(void* const* d_in, const int* in_sizes, int n_in, void* d_out, int out_size, void* d_ws, size_t ws_size, hipStream_t stream) {
    static int grid = 0;
    if (grid == 0) {
        if (n_in != 25 || out_size != M * D || ws_size < WS_END) { fprintf(stderr, "kernel_launch: unexpected shapes (n_in %d out %d ws %zu)\n", n_in, out_size, ws_size); grid = -1; return; }
        int dev = 0, cus = 0, per_cu = 0;
        if (hipGetDevice(&dev) != hipSuccess || hipDeviceGetAttribute(&cus, hipDeviceAttributeMultiprocessorCount, dev) != hipSuccess) { grid = -1; return; }
        if (hipFuncSetAttribute((const void*)fwd, hipFuncAttributeMaxDynamicSharedMemorySize, LDS_BYTES) != hipSuccess) { fprintf(stderr, "kernel_launch: hipFuncSetAttribute failed\n"); grid = -1; return; }
        if (hipOccupancyMaxActiveBlocksPerMultiprocessor(&per_cu, (const void*)fwd, NTHR, LDS_BYTES) != hipSuccess || per_cu < 1) { fprintf(stderr, "kernel_launch: occupancy query says %d\n", per_cu); (void)hipGetLastError(); grid = -1; return; }
        grid = cus;
    }
    if (grid < 0) return;
    if (hipMemsetAsync((char*)d_ws + WS_CTL, 0, CTL_ZERO_BYTES, stream) != hipSuccess) return;
    Args a{};
    for (int i = 0; i < 25; ++i) a.in[i] = (const float*)d_in[i];
    a.out = (float*)d_out; a.ws = (unsigned char*)d_ws;
#if MK_ONE_LAUNCH
    a.ph_lo = 0; a.ph_hi = N_PHASES;
    hipLaunchKernelGGL(fwd, dim3(grid), dim3(NTHR), LDS_BYTES, stream, a);
#else
    for (int p = 0; p < N_PHASES; ++p) { a.ph_lo = p; a.ph_hi = p + 1; hipLaunchKernelGGL(fwd, dim3(grid), dim3(NTHR), LDS_BYTES, stream, a); }
#endif
}
```

```cpp
#include <hip/hip_runtime.h>
#include <cstdio>
#include <cstdint>
namespace pg8 {
#define PG8_LAS __attribute__((address_space(3)))
typedef unsigned short bf16_t;
typedef short bf16x8 __attribute__((ext_vector_type(8)));
typedef float f32x4 __attribute__((ext_vector_type(4)));
typedef unsigned u32x4 __attribute__((ext_vector_type(4)));
constexpr int BM = 256, BK = 64, HALF = 128, HTB = HALF * BK * 2  , STAGE_BYTES = 8 * HTB, NXCD = 8, WGM = 8;

__host__ __device__ __forceinline__ int lds_byte(int r, int c) { const int st = (r >> 4) * 2 + (c >> 5), rr = r & 15, cc = c & 31, ob = rr * 64 + cc * 2; return st * 1024 + (ob ^ (((ob >> 9) & 1) << 5)); }
__host__ __device__ __forceinline__ void stage_rc(int b, int& R, int& C) { const int st = b / 1024, sb = b % 1024, swz = sb ^ (((sb >> 9) & 1) << 5); R = (st >> 1) * 16 + swz / 64; C = (st & 1) * 32 + (swz % 64) / 2; }
__host__ __device__ __forceinline__ int perm32(int rho) { const int n = rho >> 4, i = rho & 15; return 8 * (i >> 2) + 4 * n + (i & 3); }

struct Unit { int pm, pn; };
struct Gemm { const bf16_t* A; const bf16_t* Bt; int M, N, K; };

struct StaticOrder {
    static constexpr bool GATHER = false;
    int nM, nN, nwg, G, c;
    __host__ __device__ void init(int M, int N, int G_, int c_) { nM = M / BM; nN = N / BM; nwg = nM * nN; G = G_; c = c_; }
    __host__ __device__ bool next(int i, Unit& u) const {
        const long L = (long)i * G + c; if (L >= nwg) return false;
        int wgid = (int)L; { const int q = nwg / NXCD, r = nwg % NXCD, xcd = wgid % NXCD, off = wgid / NXCD; wgid = (xcd < r ? xcd * (q + 1) : r * (q + 1) + (xcd - r) * q) + off; }
        const int nig = WGM * nN, gid = wgid / nig, fm = gid * WGM, gsz = (nM - fm) < WGM ? (nM - fm) : WGM;
        u.pm = fm + ((wgid % nig) % gsz); u.pn = (wgid % nig) / gsz; return true;
    }
    __device__ __forceinline__ void a_ready(const Unit&) const {}
    __device__ __forceinline__ void done(const Unit&) const {}
    __device__ __forceinline__ int row_token(int, const Unit&) const { return 0; }
};
__device__ __forceinline__ unsigned cvt_pk_bf16(float lo, float hi) { unsigned r; asm volatile("v_cvt_pk_bf16_f32 %0, %1, %2" : "=v"(r) : "v"(lo), "v"(hi)); return r; }
typedef float f32x2 __attribute__((ext_vector_type(2)));
__device__ __forceinline__ f32x2 gelu_pk(f32x2 v) {
    const f32x2 av = __builtin_elementwise_abs(v), d = av * 0.2316418882f + 1.0f;
    f32x2 t; t.x = __builtin_amdgcn_rcpf(d.x); t.y = __builtin_amdgcn_rcpf(d.y);
    f32x2 q = t * 0.5307027145f + (-0.7265760135f); q = q * t + 0.7107068705f; q = q * t + (-0.142248368f); q = q * t + 0.127414796f; q = q * t;
    const f32x2 s = (v * v) * (-0.72134752044f);
    f32x2 e; e.x = __builtin_amdgcn_exp2f(s.x); e.y = __builtin_amdgcn_exp2f(s.y);
    const f32x2 m = v * (q * e), r = v - m;
    f32x2 o; o.x = v.x < 0.f ? m.x : r.x; o.y = v.y < 0.f ? m.y : r.y; return o;
}

template <int ACT  > struct EpiBf16 {
    static constexpr bool PERM = true, AFTER_DRAIN = false; static_assert(ACT == 0 || ACT == 1, "EpiBf16: ACT is 0 (none) or 1 (gelu_pk)");
    bf16_t* O; int ldc; const float* bias; int split_cols; size_t split_stride; float scale0;
    __device__ __forceinline__ void operator()(const f32x4 (&acc)[2][2][4][2], const Unit& u, int wr, int wc, int fr, int fq) const {
        const int row0 = u.pm * BM + wr * 64 + fr; int colt = u.pn * BM; bf16_t* base = O;
        float sc = 1.f; if (split_cols) { const int t = colt / split_cols; base += (size_t)t * split_stride; colt -= t * split_cols; if (t == 0) sc = scale0; }
        const int col0 = colt + wc * 32 + 8 * fq, bcol0 = u.pn * BM + wc * 32 + 8 * fq;
        f32x4 bv[2][2];
#pragma unroll
        for (int bj = 0; bj < 2; ++bj)
#pragma unroll
            for (int n = 0; n < 2; ++n) bv[bj][n] = bias ? *(const f32x4*)(bias + bcol0 + bj * HALF + 4 * n) : (f32x4){0.f, 0.f, 0.f, 0.f};
#pragma unroll
        for (int ai = 0; ai < 2; ++ai)
#pragma unroll
            for (int m = 0; m < 4; ++m) { bf16_t* rowp = base + (size_t)(row0 + ai * HALF + m * 16) * ldc + col0;
#pragma unroll
                for (int bj = 0; bj < 2; ++bj) { f32x4 v0 = acc[ai][bj][m][0] + bv[bj][0], v1 = acc[ai][bj][m][1] + bv[bj][1];
                    if (ACT == 1) { f32x2 a = gelu_pk((f32x2){v0[0], v0[1]}), b = gelu_pk((f32x2){v0[2], v0[3]}), c = gelu_pk((f32x2){v1[0], v1[1]}), d = gelu_pk((f32x2){v1[2], v1[3]});
                        v0 = (f32x4){a.x, a.y, b.x, b.y}; v1 = (f32x4){c.x, c.y, d.x, d.y}; }
                    v0 = v0 * sc; v1 = v1 * sc; u32x4 w; w.x = cvt_pk_bf16(v0[0], v0[1]); w.y = cvt_pk_bf16(v0[2], v0[3]); w.z = cvt_pk_bf16(v1[0], v1[1]); w.w = cvt_pk_bf16(v1[2], v1[3]);
                    *(u32x4*)(rowp + bj * HALF) = w; } }
    }
};
struct EpiF32 {
    static constexpr bool PERM = false, AFTER_DRAIN = false;
    float* C; int ldc;
    __device__ __forceinline__ void operator()(const f32x4 (&acc)[2][2][4][2], const Unit& u, int wr, int wc, int fr, int fq) const {
        const int row0 = u.pm * BM + wr * 64 + fr, col0 = u.pn * BM + wc * 32 + 4 * fq;
#pragma unroll
        for (int ai = 0; ai < 2; ++ai)
#pragma unroll
            for (int m = 0; m < 4; ++m) { float* rowp = C + (size_t)(row0 + ai * HALF + m * 16) * ldc + col0;
#pragma unroll
                for (int bj = 0; bj < 2; ++bj)
#pragma unroll
                    for (int n = 0; n < 2; ++n) *(f32x4*)(rowp + bj * HALF + n * 16) = acc[ai][bj][m][n]; }
    }
};
__device__ __forceinline__ float silu_f(float x) { return x * __builtin_amdgcn_rcpf(1.0f + __expf(-x)); }
struct EpiSwiGLU {
    static constexpr bool PERM = true, AFTER_DRAIN = false;
    bf16_t* H; int ldh; const float* comb; int ldcomb;
    __device__ __forceinline__ void operator()(const f32x4 (&acc)[2][2][4][2], const Unit& u, int wr, int wc, int fr, int fq) const {
        const int row0 = u.pm * BM + wr * 64 + fr, col0 = u.pn * 128 + wc * 32 + 8 * fq, e = u.pn >> 1;
#pragma unroll
        for (int ai = 0; ai < 2; ++ai)
#pragma unroll
            for (int m = 0; m < 4; ++m) { const int row = row0 + ai * HALF + m * 16; const float cw = comb[(size_t)row * ldcomb + e];
                const f32x4 g0 = acc[ai][0][m][0], g1 = acc[ai][0][m][1], u0 = acc[ai][1][m][0], u1 = acc[ai][1][m][1];
                f32x4 h0, h1;
#pragma unroll
                for (int j = 0; j < 4; ++j) { h0[j] = silu_f(g0[j]) * u0[j] * cw; h1[j] = silu_f(g1[j]) * u1[j] * cw; }
                u32x4 w; w.x = cvt_pk_bf16(h0[0], h0[1]); w.y = cvt_pk_bf16(h0[2], h0[3]); w.z = cvt_pk_bf16(h1[0], h1[1]); w.w = cvt_pk_bf16(h1[2], h1[3]);
                *(u32x4*)(H + (size_t)row * ldh + col0) = w; }
    }
};

template <int NSUB, bool GATHER_ = false> struct MoeOrder {
    static constexpr bool GATHER = GATHER_;
    const PG8_LAS int* off; int G, c; const int* ltok; int lstride;
    __device__ __forceinline__ int row_token(int srow, const Unit& u) const { const int e = u.pn / NSUB, pos = srow - off[e]; return pos < off[18 + e] - off[17 + e] ? ltok[e * lstride + pos] : 0; }
    __device__ __forceinline__ bool next(int i, Unit& u) const {
        const int L = i * G + c, x = L & 7, j = L >> 3, t = x + 8 * (j / NSUB), pnl = j % NSUB;
        if (t * 256 >= off[16]) return false;
        int e = 0;
#pragma unroll
        for (int k = 1; k < 16; ++k) e += (off[k] <= t * 256) ? 1 : 0;
        u.pm = t; u.pn = e * NSUB + pnl; return true;
    }
    __device__ __forceinline__ void a_ready(const Unit&) const {}
    __device__ __forceinline__ void done(const Unit&) const {}
};
struct EpiSwiGLUs {
    static constexpr bool PERM = true, AFTER_DRAIN = false;
    bf16_t* H; const float* lw; int lstride; const PG8_LAS int* off;
    __device__ __forceinline__ void operator()(const f32x4 (&acc)[2][2][4][2], const Unit& u, int wr, int wc, int fr, int fq) const {
        const int row0 = u.pm * BM + wr * 64 + fr, col0 = (u.pn & 1) * 128 + wc * 32 + 8 * fq;
#pragma unroll
        for (int ai = 0; ai < 2; ++ai)
#pragma unroll
            for (int m = 0; m < 4; ++m) { const int row = row0 + ai * HALF + m * 16; const int e_ = u.pn >> 1, pos_ = row - off[e_]; const float cw = pos_ < off[18 + e_] - off[17 + e_] ? lw[e_ * lstride + pos_] : 0.f;
                const f32x4 g0 = acc[ai][0][m][0], g1 = acc[ai][0][m][1], u0 = acc[ai][1][m][0], u1 = acc[ai][1][m][1];
                f32x4 h0, h1;
#pragma unroll
                for (int j = 0; j < 4; ++j) { h0[j] = silu_f(g0[j]) * u0[j] * cw; h1[j] = silu_f(g1[j]) * u1[j] * cw; }
                u32x4 w; w.x = cvt_pk_bf16(h0[0], h0[1]); w.y = cvt_pk_bf16(h0[2], h0[3]); w.z = cvt_pk_bf16(h1[0], h1[1]); w.w = cvt_pk_bf16(h1[2], h1[3]);
                *(u32x4*)(H + (size_t)row * 256 + col0) = w; }
    }
};
struct EpiBf16s {
    static constexpr bool PERM = true, AFTER_DRAIN = false;
    bf16_t* O;
    __device__ __forceinline__ void operator()(const f32x4 (&acc)[2][2][4][2], const Unit& u, int wr, int wc, int fr, int fq) const {
        const int row0 = u.pm * BM + wr * 64 + fr, col0 = (u.pn & 3) * BM + wc * 32 + 8 * fq;
#pragma unroll
        for (int ai = 0; ai < 2; ++ai)
#pragma unroll
            for (int m = 0; m < 4; ++m) { bf16_t* rowp = O + (size_t)(row0 + ai * HALF + m * 16) * 1024 + col0;
#pragma unroll
                for (int bj = 0; bj < 2; ++bj) { const f32x4 v0 = acc[ai][bj][m][0], v1 = acc[ai][bj][m][1];
                    u32x4 w; w.x = cvt_pk_bf16(v0[0], v0[1]); w.y = cvt_pk_bf16(v0[2], v0[3]); w.z = cvt_pk_bf16(v1[0], v1[1]); w.w = cvt_pk_bf16(v1[2], v1[3]);
                    *(u32x4*)(rowp + bj * HALF) = w; } }
    }
};
template <class Epi, class Sched, bool ALIGN_EPI = false, bool SP2 = false>
__device__ __forceinline__ void gemm_phase(PG8_LAS unsigned char* lds, const Gemm g, const Sched& S, const Epi& E) {
    int tid_ = threadIdx.x; asm volatile("" : "+v"(tid_));
    const int tid = tid_, wid = __builtin_amdgcn_readfirstlane(tid >> 6), lane = tid & 63, wr = wid >> 2, wc = wid & 3, fr = lane & 15, fq = lane >> 4;
    const int K = g.K, nt = K / BK;
    unsigned voffA[2], voffB[2];
#pragma unroll
    for (int i = 0; i < 2; ++i) { int R, C; stage_rc(tid * 16 + i * 8192, R, C); const int Rb = Epi::PERM ? ((R & ~31) + perm32(R & 31)) : R;
        voffA[i] = (unsigned)(R * K + C) * 2u; voffB[i] = (unsigned)(Rb * K + C) * 2u; }
    constexpr bool GATHER = Sched::GATHER; static_assert(!GATHER || SP2, "the gather path is written for the two-super-phase loop");
    int gR[2], gC[2];
#pragma unroll
    for (int i = 0; i < 2; ++i) stage_rc(tid * 16 + i * 8192, gR[i], gC[i]);
    unsigned vA0[2] = {0u, 0u}, vA1[2] = {0u, 0u}, nvA0[2] = {0u, 0u}, nvA1[2] = {0u, 0u};
#define PG8_GLOOK(U, D0, D1) do { _Pragma("unroll") for (int _i = 0; _i < 2; ++_i) { \
        D0[_i] = (unsigned)S.row_token((U).pm * BM + gR[_i], (U)) * (unsigned)(K * 2) + (unsigned)gC[_i] * 2u; D1[_i] = (unsigned)S.row_token((U).pm * BM + HALF + gR[_i], (U)) * (unsigned)(K * 2) + (unsigned)gC[_i] * 2u; } } while (0)
    const size_t kstep = (size_t)(BK * 2);
    const size_t hstep = (size_t)HALF * K * 2;
    const size_t tstep = 2 * hstep;
    const unsigned ldsw = (unsigned)wid * 1024u;
    const int aoff = lds_byte(wr * 64 + fr, fq * 8), boff = lds_byte(wc * 32 + fr, fq * 8);
#define PG8_SA(b, h) (((b) * 2 + (h)) * HTB)
#define PG8_SB(b, h) ((4 + (b) * 2 + (h)) * HTB)
#define PG8_STAGE(bufoff, gbase, voff) do { _Pragma("unroll") for (int _i = 0; _i < 2; ++_i) \
        __builtin_amdgcn_global_load_lds((const unsigned*)((const char*)(gbase) + (voff)[_i]), (PG8_LAS unsigned*)(lds + (bufoff) + ldsw + _i * 8192), 16, 0, 0); } while (0)
#define PG8_LDA(dst, b, h) do { _Pragma("unroll") for (int m = 0; m < 4; ++m) _Pragma("unroll") for (int k = 0; k < 2; ++k) dst[m][k] = *(const PG8_LAS bf16x8*)(lds + PG8_SA(b, h) + aoff + m * 2048 + k * 1024); } while (0)
#define PG8_LDB(dst, b, h) do { _Pragma("unroll") for (int n = 0; n < 2; ++n) _Pragma("unroll") for (int k = 0; k < 2; ++k) dst[n][k] = *(const PG8_LAS bf16x8*)(lds + PG8_SB(b, h) + boff + n * 2048 + k * 1024); } while (0)
#define PG8_MMA(ai, bj, At, Bt) do { __builtin_amdgcn_s_setprio(1); _Pragma("unroll") for (int m = 0; m < 4; ++m) _Pragma("unroll") for (int n = 0; n < 2; ++n) _Pragma("unroll") for (int k = 0; k < 2; ++k) \
        acc[ai][bj][m][n] = __builtin_amdgcn_mfma_f32_16x16x32_bf16(Bt[n][k], At[m][k], acc[ai][bj][m][n], 0, 0, 0); __builtin_amdgcn_s_setprio(0); } while (0)
#define PG8_WAIT_V(n) asm volatile("s_waitcnt vmcnt(" #n ")" ::: "memory")
#define PG8_WAIT_L(n) asm volatile("s_waitcnt lgkmcnt(" #n ")" ::: "memory")
#define PG8_BAR __builtin_amdgcn_s_barrier()
#define PG8_SCHED __builtin_amdgcn_sched_barrier(0)
    Unit cur, nxt; int ui = 0;
    if (!S.next(0, cur)) return;
    f32x4 acc[2][2][4][2];
#pragma unroll
    for (int a = 0; a < 2; ++a)
#pragma unroll
        for (int b = 0; b < 2; ++b)
#pragma unroll
            for (int m = 0; m < 4; ++m)
#pragma unroll
                for (int n = 0; n < 2; ++n) acc[a][b][m][n] = (f32x4){0.f, 0.f, 0.f, 0.f};
    bf16x8 At[4][2], B0[2][2], B1[2][2];
    const char* cA = (const char*)g.A + (GATHER ? (size_t)0 : (size_t)cur.pm * tstep); const char* cB = (const char*)g.Bt + (size_t)cur.pn * tstep;
    if constexpr (GATHER) PG8_GLOOK(cur, vA0, vA1);
    S.a_ready(cur);
    if constexpr (SP2) {
        PG8_STAGE(PG8_SB(0, 0), cB, voffB); PG8_STAGE(PG8_SB(0, 1), cB + hstep, voffB);
        if constexpr (GATHER) { PG8_STAGE(PG8_SA(0, 0), cA, vA0); PG8_STAGE(PG8_SA(0, 1), cA, vA1); } else { PG8_STAGE(PG8_SA(0, 0), cA, voffA); PG8_STAGE(PG8_SA(0, 1), cA + hstep, voffA); }
        if (wr == 1) PG8_BAR;
        PG8_WAIT_V(2); PG8_BAR;
        PG8_STAGE(PG8_SB(1, 0), cB + kstep, voffB); if constexpr (GATHER) PG8_STAGE(PG8_SA(1, 0), cA + kstep, vA0); else PG8_STAGE(PG8_SA(1, 0), cA + kstep, voffA); PG8_STAGE(PG8_SB(1, 1), cB + hstep + kstep, voffB);
        PG8_WAIT_V(6); PG8_BAR;
    } else {
        PG8_STAGE(PG8_SB(0, 0), cB, voffB); PG8_STAGE(PG8_SA(0, 0), cA, voffA); PG8_STAGE(PG8_SB(0, 1), cB + hstep, voffB); PG8_STAGE(PG8_SA(0, 1), cA + hstep, voffA);
        if (wr == 1) PG8_BAR;
        PG8_WAIT_V(4); PG8_BAR;
        PG8_STAGE(PG8_SB(1, 0), cB + kstep, voffB); PG8_STAGE(PG8_SA(1, 0), cA + kstep, voffA); PG8_STAGE(PG8_SB(1, 1), cB + hstep + kstep, voffB);
        PG8_WAIT_V(6); PG8_BAR;
    }
    for (;;) {
        const bool has_next = S.next(ui + 1, nxt);
        const char* nA = (has_next && !GATHER) ? (const char*)g.A + (size_t)nxt.pm * tstep : cA; const char* nB = has_next ? (const char*)g.Bt + (size_t)nxt.pn * tstep : cB;
        if constexpr (GATHER) { if (has_next) PG8_GLOOK(nxt, nvA0, nvA1); else { nvA0[0] = vA0[0]; nvA0[1] = vA0[1]; nvA1[0] = vA1[0]; nvA1[1] = vA1[1]; } }
#pragma unroll 1
        for (int t = 0; t < nt; t += 2) {
            const bool last = (t == nt - 2);
            const char* a1 = cA + (size_t)(t + 1) * kstep;
            const char* a2 = last ? nA : cA + (size_t)(t + 2) * kstep; const char* b2 = last ? nB : cB + (size_t)(t + 2) * kstep;
            const char* a3 = a2 + kstep; const char* b3 = b2 + kstep;
            if (last && has_next) S.a_ready(nxt);
            if constexpr (SP2) {
            PG8_LDB(B0, 0, 0); PG8_LDB(B1, 0, 1); PG8_SCHED; PG8_LDA(At, 0, 0); if constexpr (GATHER) PG8_STAGE(PG8_SA(1, 1), a1, vA1); else PG8_STAGE(PG8_SA(1, 1), a1 + hstep, voffA);
            PG8_WAIT_V(8); PG8_WAIT_L(0); PG8_BAR; PG8_MMA(0, 0, At, B0); PG8_MMA(0, 1, At, B1); PG8_BAR; PG8_SCHED;
            PG8_LDA(At, 0, 1); PG8_STAGE(PG8_SB(0, 0), b2, voffB); PG8_STAGE(PG8_SB(0, 1), b2 + hstep, voffB); if constexpr (GATHER) { unsigned v_[2] = {last ? nvA0[0] : vA0[0], last ? nvA0[1] : vA0[1]}; PG8_STAGE(PG8_SA(0, 0), a2, v_); } else PG8_STAGE(PG8_SA(0, 0), a2, voffA);
            PG8_WAIT_V(8); PG8_WAIT_L(0); PG8_BAR; PG8_MMA(1, 0, At, B0); PG8_MMA(1, 1, At, B1); PG8_BAR; PG8_SCHED;
            PG8_LDB(B0, 1, 0); PG8_LDB(B1, 1, 1); PG8_SCHED; PG8_LDA(At, 1, 0); if constexpr (GATHER) { unsigned v_[2] = {last ? nvA1[0] : vA1[0], last ? nvA1[1] : vA1[1]}; PG8_STAGE(PG8_SA(0, 1), a2, v_); } else PG8_STAGE(PG8_SA(0, 1), a2 + hstep, voffA);
            PG8_WAIT_V(8); PG8_WAIT_L(0); PG8_BAR; PG8_MMA(0, 0, At, B0); PG8_MMA(0, 1, At, B1); PG8_BAR; PG8_SCHED;
            PG8_LDA(At, 1, 1); PG8_STAGE(PG8_SB(1, 0), b3, voffB); PG8_STAGE(PG8_SB(1, 1), b3 + hstep, voffB); if constexpr (GATHER) { unsigned v_[2] = {last ? nvA0[0] : vA0[0], last ? nvA0[1] : vA0[1]}; PG8_STAGE(PG8_SA(1, 0), a3, v_); } else PG8_STAGE(PG8_SA(1, 0), a3, voffA);
            PG8_WAIT_V(8); PG8_WAIT_L(0); PG8_BAR; PG8_MMA(1, 0, At, B0); PG8_MMA(1, 1, At, B1); PG8_BAR; PG8_SCHED;
            } else {
            PG8_LDB(B0, 0, 0); PG8_SCHED; PG8_LDA(At, 0, 0); PG8_STAGE(PG8_SA(1, 1), a1 + hstep, voffA);
            PG8_WAIT_L(8); PG8_BAR; PG8_WAIT_L(0); PG8_MMA(0, 0, At, B0); PG8_BAR; PG8_SCHED;
            PG8_LDB(B1, 0, 1); PG8_STAGE(PG8_SB(0, 0), b2, voffB);
            PG8_BAR; PG8_WAIT_L(0); PG8_MMA(0, 1, At, B1); PG8_BAR;
            PG8_LDA(At, 0, 1); PG8_STAGE(PG8_SA(0, 0), a2, voffA);
            PG8_BAR; PG8_WAIT_L(0); PG8_MMA(1, 0, At, B0); PG8_BAR; PG8_SCHED;
            PG8_STAGE(PG8_SB(0, 1), b2 + hstep, voffB);
            PG8_WAIT_V(6); PG8_BAR; PG8_MMA(1, 1, At, B1); PG8_BAR;
            PG8_LDB(B0, 1, 0); PG8_SCHED; PG8_LDA(At, 1, 0); PG8_STAGE(PG8_SA(0, 1), a2 + hstep, voffA);
            PG8_WAIT_L(8); PG8_BAR; PG8_WAIT_L(0); PG8_MMA(0, 0, At, B0); PG8_BAR; PG8_SCHED;
            PG8_LDB(B1, 1, 1); PG8_STAGE(PG8_SB(1, 0), b3, voffB);
            PG8_BAR; PG8_WAIT_L(0); PG8_MMA(0, 1, At, B1); PG8_BAR;
            PG8_LDA(At, 1, 1); PG8_STAGE(PG8_SA(1, 0), a3, voffA);
            PG8_BAR; PG8_WAIT_L(0); PG8_MMA(1, 0, At, B0); PG8_BAR; PG8_SCHED;
            PG8_STAGE(PG8_SB(1, 1), b3 + hstep, voffB);
            PG8_WAIT_V(6); PG8_BAR; PG8_MMA(1, 1, At, B1); PG8_BAR;
            }
        }
        if constexpr (ALIGN_EPI) { if (wr == 0) PG8_BAR; }
        if constexpr (!Epi::AFTER_DRAIN) { E(acc, cur, wr, wc, fr, fq); S.done(cur); }
        if (!has_next) break;
#pragma unroll
        for (int a = 0; a < 2; ++a)
#pragma unroll
            for (int b = 0; b < 2; ++b)
#pragma unroll
                for (int m = 0; m < 4; ++m)
#pragma unroll
                    for (int n = 0; n < 2; ++n) acc[a][b][m][n] = (f32x4){0.f, 0.f, 0.f, 0.f};
        cur = nxt; cA = nA; cB = nB; ++ui;
        if constexpr (GATHER) { vA0[0] = nvA0[0]; vA0[1] = nvA0[1]; vA1[0] = nvA1[0]; vA1[1] = nvA1[1]; }
        if constexpr (ALIGN_EPI) { if (wr == 1) PG8_BAR; }
    }
    PG8_WAIT_V(0);
    if constexpr (!ALIGN_EPI) { if (wr == 0) PG8_BAR; }
    PG8_BAR;
    if constexpr (Epi::AFTER_DRAIN) { E.fused(acc, cur, wr, wc, fr, fq, lds, wid, lane); S.done(cur); }
#undef PG8_GLOOK
#undef PG8_SA
#undef PG8_SB
#undef PG8_STAGE
#undef PG8_LDA
#undef PG8_LDB
#undef PG8_MMA
#undef PG8_WAIT_V
#undef PG8_WAIT_L
#undef PG8_BAR
#undef PG8_SCHED
}
}
#define GAS __attribute__((address_space(1)))
#define LAS __attribute__((address_space(3)))
typedef unsigned short bf16;
typedef unsigned v4u __attribute__((ext_vector_type(4)));
typedef float f32x4 __attribute__((ext_vector_type(4)));
typedef short bf16x8 __attribute__((ext_vector_type(8)));
typedef GAS unsigned gu32;
typedef GAS unsigned long long gu64;
#define RLX_AGENT __ATOMIC_RELAXED, __HIP_MEMORY_SCOPE_AGENT
#define LDS_WAIT() asm volatile("s_waitcnt lgkmcnt(0)" ::: "memory")
#define VM_WAIT() asm volatile("s_waitcnt vmcnt(0)" ::: "memory")
__device__ __forceinline__ unsigned long long rt() { return __builtin_amdgcn_s_memrealtime(); }
typedef __bf16 bf16x2_hw __attribute__((ext_vector_type(2)));
__device__ __forceinline__ unsigned pk2(float lo, float hi) { bf16x2_hw v; v.x = (__bf16)lo; v.y = (__bf16)hi; return __builtin_bit_cast(unsigned, v); }
__device__ __forceinline__ unsigned f2bf(float f) { return pk2(f, 0.f) & 0xffffu; }

#define XB_TMO      128
#define XB_XCNT(j)  (256  + 64 * (j))
#define XB_XSUB(j)  (1280 + 64 * (j))
#define XB_XGEN(j)  (2304 + 64 * (j))
#define XB_TOP      3328
#define XB_TOPGEN   3392
#define XCD_BAR_WORDS 3456
#define XB_SPIN_CAP (1u << 18)

__device__ __forceinline__ unsigned xb_ld(unsigned* p)              { return __hip_atomic_load(p, __ATOMIC_RELAXED, __HIP_MEMORY_SCOPE_AGENT); }
__device__ __forceinline__ unsigned xb_add(unsigned* p, unsigned v) { return __hip_atomic_fetch_add(p, v, __ATOMIC_RELAXED, __HIP_MEMORY_SCOPE_AGENT); }
__device__ __forceinline__ unsigned xb_xcc_id() { return (unsigned)__builtin_amdgcn_s_getreg((3 << 11) | 20) & 0xFu; }
#define XB_SPIN(cond, bar) do { unsigned _sp = 0; while (cond) { __builtin_amdgcn_s_sleep(1); \
    if ((++_sp & 255u) == 0u) { if (xb_ld(&(bar)[XB_TMO])) break; if (_sp > XB_SPIN_CAP) { atomicAdd(&(bar)[XB_TMO], 1u); break; } } } } while (0)

struct XcdBarrier {
    unsigned* bar; unsigned x;
    volatile LAS unsigned* st;
};

__device__ __forceinline__ XcdBarrier xcd_barrier_post(unsigned* bar, volatile LAS unsigned* st) {
    XcdBarrier b; b.bar = bar; b.x = xb_xcc_id(); b.st = st;
    if (threadIdx.x == 0) (void)xb_add(&bar[XB_XCNT(b.x)], 1u);
    return b;
}
__device__ __forceinline__ void xcd_barrier_complete(unsigned* bar, unsigned x, unsigned& nloc, unsigned& nx) {
    const unsigned G = gridDim.x * gridDim.y * gridDim.z;
    unsigned sum, cnt, mine, sp = 0u;
    for (;;) {
        sum = 0u; cnt = 0u; mine = 0u;
#pragma unroll
        for (unsigned j = 0; j < 16; ++j) { const unsigned c = xb_ld(&bar[XB_XCNT(j)]); sum += c; cnt += (c > 0u) ? 1u : 0u; mine = (j == x) ? c : mine; }
        if (sum == G) break;
        __builtin_amdgcn_s_sleep(1);
        if ((++sp & 255u) == 0u) { if (xb_ld(&bar[XB_TMO])) break; if (sp > XB_SPIN_CAP) { atomicAdd(&bar[XB_TMO], 1u); break; } }
    }
    nloc = mine > 0u ? mine : 1u; nx = cnt > 0u ? cnt : 1u;
}

__device__ __forceinline__ void xcd_barrier(const XcdBarrier& b) {
    asm volatile("s_waitcnt vmcnt(0)" ::: "memory");
    __syncthreads();
    if (threadIdx.x == 0) {
        unsigned* bar = b.bar;
        __builtin_amdgcn_s_waitcnt(0);
        unsigned nloc = b.st[0], nx = b.st[1];
        if (nloc == 0u) { xcd_barrier_complete(bar, b.x, nloc, nx); b.st[0] = nloc; b.st[1] = nx; }
        const unsigned old = xb_add(&bar[XB_XSUB(b.x)], 1u);
        const unsigned gen = old / nloc;
        if (old + 1u == (gen + 1u) * nloc) {
            __builtin_amdgcn_fence(__ATOMIC_RELEASE, "agent");
            asm volatile("s_waitcnt vmcnt(0)" ::: "memory");
            const unsigned og = xb_add(&bar[XB_TOP], 1u);
            const unsigned tg = og / nx;
            if (og + 1u == (tg + 1u) * nx) xb_add(&bar[XB_TOPGEN], 1u);
            else XB_SPIN(xb_ld(&bar[XB_TOPGEN]) == tg, bar);
            __builtin_amdgcn_fence(__ATOMIC_ACQUIRE, "agent");
            xb_add(&bar[XB_XGEN(b.x)], 1u);
            asm volatile("s_waitcnt vmcnt(0)" ::: "memory");
        } else {
            XB_SPIN(xb_ld(&bar[XB_XGEN(b.x)]) == gen, bar);
            __builtin_amdgcn_fence(__ATOMIC_ACQUIRE, "agent");
            asm volatile("s_waitcnt vmcnt(0)" ::: "memory");
        }
    }
    __syncthreads();
}
constexpr int NWAVES = 8, NTHR = NWAVES * 64;
constexpr int D = 1024, BATCH = 4, SEQ = 4096, M = BATCH * SEQ, DEPTH = 4;
constexpr int IN_COLS = 6680, NPROJ = 6912;
constexpr int O_Z = 0, O_XBC = 1024, O_DT = 2560, O_QKV = 2576, O_GG = 4112, O_GB = 4624, O_GA = 4628, O_HQ = 4632, O_HF = 5144, O_HI = 5656, O_HG = 6168;
constexpr int DMIX = 2048, NEXP = 16, DEXP = 256, NGU = NEXP * 2 * DEXP  , KDN = NEXP * DEXP  ;
constexpr float DN_ALPHA = 1.6817928305074290f;
constexpr float LN_EPS = 1e-5f;

constexpr size_t MiB = 1u << 20;
constexpr size_t WS_CTL = 0, CTL_ZERO_BYTES = 1 * MiB;
constexpr size_t WS_LTOK = 2 * MiB;
constexpr size_t WS_LW = 3 * MiB;
constexpr size_t WS_SLOT = 4 * MiB;
constexpr size_t WS_WSORT = 5 * MiB;
constexpr size_t WS_WIN = 8 * MiB;
constexpr size_t WS_WOUT = 22 * MiB;
constexpr size_t WS_WGU = 26 * MiB;
constexpr size_t WS_WDN = 42 * MiB;
constexpr size_t WS_YMIX = 52 * MiB;
constexpr size_t WS_HB = WS_YMIX;
constexpr size_t WS_PROJ = 116 * MiB;
constexpr size_t WS_MIX = WS_PROJ;
constexpr int MAXROWS = 2 * M + 16 * 256;
constexpr size_t WS_XS = WS_PROJ + 64 * MiB;
constexpr size_t WS_HS = WS_PROJ + 136 * MiB;
constexpr size_t WS_YS = WS_PROJ + 154 * MiB;
constexpr int CW_CNT = 8192;
constexpr int LDS_OFF_TAB = 131072 + 1024;
constexpr size_t WS_SCR = 332 * MiB;
constexpr size_t WS_HG_QG = WS_SCR;
constexpr size_t WS_HG_KDT = WS_SCR + 16 * MiB;
constexpr size_t WS_HG_A = WS_SCR + 32 * MiB;
constexpr size_t WS_HG_GL = WS_SCR + 40 * MiB;
constexpr size_t WS_SSD_C = WS_SCR + 41 * MiB;
constexpr size_t WS_SSD_BT = WS_SCR + 49 * MiB;
constexpr size_t WS_SSD_CB = WS_SCR + 57 * MiB;
constexpr size_t WS_SSD_XT = WS_SCR + 65 * MiB;
constexpr size_t WS_SSD_AC = WS_SCR + 97 * MiB;
constexpr size_t WS_SSD_DT = WS_SCR + 98 * MiB;
constexpr size_t WS_GD_K = WS_SCR + 99 * MiB;
constexpr size_t WS_GD_KT = WS_SCR + 115 * MiB;
constexpr size_t WS_GD_QG = WS_SCR + 131 * MiB;
constexpr size_t WS_GD_VT = WS_SCR + 147 * MiB;
constexpr size_t WS_GD_T = WS_SCR + 163 * MiB;
constexpr size_t WS_GD_QK = WS_SCR + 171 * MiB;
constexpr size_t WS_GD_VEC = WS_SCR + 179 * MiB;
constexpr size_t WS_END = 512 * MiB;
constexpr int CW_BAR = 4096;

constexpr int RING_OFF = 0, RING_BYTES = 131072;
constexpr int LDSCTL_OFF = RING_BYTES, MISC_OFF = LDSCTL_OFF + 320;
constexpr int LDS_BYTES = 147456;

__device__ __forceinline__ float bf2f(unsigned short b) { return __builtin_bit_cast(float, ((unsigned)b) << 16); }
__device__ __forceinline__ float bflo(unsigned w) { return __builtin_bit_cast(float, w << 16); }
__device__ __forceinline__ float bfhi(unsigned w) { return __builtin_bit_cast(float, w & 0xffff0000u); }
__device__ __forceinline__ float siluf(float x) { return x * __builtin_amdgcn_rcpf(1.0f + __expf(-x)); }
__device__ __forceinline__ float sigmoidf_(float x) { return __builtin_amdgcn_rcpf(1.0f + __expf(-x)); }
__device__ __forceinline__ float softplusf_(float x) { return x > 20.f ? x : log1pf(__expf(x)); }
#define DPP_ADD(v, ctrl) ((v) + __builtin_bit_cast(float, __builtin_amdgcn_update_dpp(0, __builtin_bit_cast(int, (v)), (ctrl), 0xf, 0xf, false)))
__device__ __forceinline__ float wave_sum(float v) {
    v = DPP_ADD(v, 0xB1);
    v = DPP_ADD(v, 0x4E);
    v = DPP_ADD(v, 0x141);
    v = DPP_ADD(v, 0x140);
    const int iv = __builtin_bit_cast(int, v);
    return (__builtin_bit_cast(float, __builtin_amdgcn_readlane(iv, 0)) + __builtin_bit_cast(float, __builtin_amdgcn_readlane(iv, 16))) + (__builtin_bit_cast(float, __builtin_amdgcn_readlane(iv, 32)) + __builtin_bit_cast(float, __builtin_amdgcn_readlane(iv, 48)));
}
__device__ __forceinline__ float row16_sum(float v) {
    v = DPP_ADD(v, 0xB1); v = DPP_ADD(v, 0x4E); v = DPP_ADD(v, 0x141); v = DPP_ADD(v, 0x140); return v;
}

struct Args {
    const float* in[25]; float* out; unsigned char* ws; int ph_lo, ph_hi;
};
typedef const __attribute__((address_space(4))) Args* CArgs;
#define ARGS_HERE() ([]() { CArgs p_ = (CArgs)__builtin_amdgcn_kernarg_segment_ptr(); asm volatile("" : "+s"(p_)); return p_; }())
enum { I_X = 0, I_WIN, I_SCW, I_SCB, I_SDTB, I_SALOG, I_SD, I_SNW, I_GCW, I_GDTB, I_GALOG, I_GNW, I_HLB, I_HNW, I_WOUT, I_LN1G, I_LN1B, I_WRG, I_BRG, I_WRE, I_BRE, I_WGU, I_WDN, I_LN2G, I_LN2B };

__device__ __forceinline__ void transpose_item(const float* W, int ldw, int nvalid, int k0, int n0, bf16* WT, size_t ldt, int drow0, int dk0, LAS float* scr, int lane) {
#pragma unroll 8
    for (int i = 0; i < 32; ++i) { const int kk = 2 * i + (lane >> 5), nn = lane & 31, n = n0 + nn; scr[kk * 33 + nn] = (n < nvalid) ? W[(size_t)(k0 + kk) * ldw + n] : 0.f; }
    LDS_WAIT(); asm volatile("" ::: "memory");
    const int c = lane & 7;
#pragma unroll
    for (int j = 0; j < 4; ++j) { const int n = (lane >> 3) + 8 * j; const LAS float* s = scr + (8 * c) * 33 + n;
        v4u o; o.x = pk2(s[0 * 33], s[1 * 33]); o.y = pk2(s[2 * 33], s[3 * 33]); o.z = pk2(s[4 * 33], s[5 * 33]); o.w = pk2(s[6 * 33], s[7 * 33]);
        *(GAS v4u*)(WT + (size_t)(drow0 + n) * ldt + dk0 + k0 + 8 * c) = o; }
    LDS_WAIT(); asm volatile("" ::: "memory");
}
__device__ __forceinline__ void weights_phase(CArgs a, int l, const int which, LAS unsigned char* lds, int wwg, int nwg, int tid) {
    asm volatile("" : "+v"(tid));
    const int lane = tid & 63, wave = tid >> 6, gw = wwg * NWAVES + wave, NGW = nwg * NWAVES;
    LAS float* scr = (LAS float*)(lds + wave * 16384);
    constexpr int I_IN = 16 * (NPROJ / 32), I_OUT = (DMIX / 64) * (D / 32), I_GU = NEXP * 16 * 16, I_DN = NEXP * 4 * 32;
    const int n_in = (which & 1) ? I_IN : 0, n_out = (which & 2) ? I_OUT : 0, n_gu = (which & 4) ? I_GU : 0, n_dn = (which & 8) ? I_DN : 0;
    unsigned char* ws = a->ws;
    for (int it = gw; it < n_in + n_out + n_gu + n_dn; it += NGW) {
        int r = it;
        if (r < n_in) { const int kb = r / (NPROJ / 32), nb = r % (NPROJ / 32);
            transpose_item(a->in[I_WIN] + (size_t)l * D * IN_COLS, IN_COLS, IN_COLS, 64 * kb, 32 * nb, (bf16*)(ws + WS_WIN), D, 32 * nb, 0, scr, lane); continue; }
        r -= n_in;
        if (r < n_out) { const int kb = r / (D / 32), nb = r % (D / 32);
            transpose_item(a->in[I_WOUT] + (size_t)l * DMIX * D, D, D, 64 * kb, 32 * nb, (bf16*)(ws + WS_WOUT), DMIX, 32 * nb, 0, scr, lane); continue; }
        r -= n_out;
        if (r < n_gu) { const int e = r / 256, q = r % 256, kb = q / 16, nb = q % 16, c0 = 32 * nb, bj = c0 / 256, hf = (c0 % 256) / 128, j0 = c0 % 128;
            transpose_item(a->in[I_WGU] + (size_t)(l * NEXP + e) * D * 512, 512, 512, 64 * kb, c0, (bf16*)(ws + WS_WGU), D, e * 512 + hf * 256 + bj * 128 + j0, 0, scr, lane); continue; }
        r -= n_gu;
        { const int e = r / 128, q = r % 128, kb = q / 32, nb = q % 32;
            transpose_item(a->in[I_WDN] + (size_t)(l * NEXP + e) * DEXP * D, D, D, 64 * kb, 32 * nb, (bf16*)(ws + WS_WDN), DEXP, e * D + 32 * nb, 0, scr, lane); }
    }
}
__device__ __forceinline__ void p0_prologue(CArgs a, LAS unsigned char* lds, int wg, int G, int tid) {
    asm volatile("" : "+v"(tid));
    const f32x4* x4 = (const f32x4*)a->in[I_X]; f32x4* h4 = (f32x4*)a->out; unsigned long long* hb8 = (unsigned long long*)(a->ws + WS_HB);
    for (size_t i = (size_t)wg * NTHR + tid; i < (size_t)M * D / 4; i += (size_t)G * NTHR) { const f32x4 v = x4[i]; (void)h4;
        hb8[i] = (unsigned long long)pk2(v.x, v.y) | ((unsigned long long)pk2(v.z, v.w) << 32); }
}

#define WG_BAR() do { asm volatile("s_waitcnt lgkmcnt(0)" ::: "memory"); __builtin_amdgcn_s_barrier(); asm volatile("" ::: "memory"); } while (0)
__device__ __forceinline__ f32x4 mfma16(bf16x8 x, bf16x8 y, f32x4 c) { return __builtin_amdgcn_mfma_f32_16x16x32_bf16(x, y, c, 0, 0, 0); }
__device__ __forceinline__ bf16x8 lds_frag(const LAS bf16* base, int row0, int stride, int k0, int lane) { return *(const LAS bf16x8*)(base + (row0 + (lane & 15)) * stride + k0 + 8 * (lane >> 4)); }
__device__ __forceinline__ bf16x8 pack8(const float* v) { v4u w; w.x = pk2(v[0], v[1]); w.y = pk2(v[2], v[3]); w.z = pk2(v[4], v[5]); w.w = pk2(v[6], v[7]); return __builtin_bit_cast(bf16x8, w); }
__device__ __forceinline__ unsigned long long pack4(f32x4 v) { return (unsigned long long)pk2(v[0], v[1]) | ((unsigned long long)pk2(v[2], v[3]) << 32); }

__device__ __forceinline__ void hgrn_prep_phase(CArgs a, int l, LAS unsigned char* lds, int wg, int G, int tid) {
    asm volatile("" : "+v"(tid));
    constexpr int LS = 132;
    LAS float* sQ = (LAS float*)lds; LAS float* sK = sQ + 64 * LS; LAS float* sB = sK + 64 * LS; LAS float* sT = sB + 64 * LS; LAS float* sLb = sT + 512;
    const bf16* PROJ = (const bf16*)(a->ws + WS_PROJ);
    const int lane = tid & 63, w = tid >> 6, r = lane & 15, q4 = lane >> 4;
    for (int unit = wg; unit < 1024; unit += G) {
        const int b = unit >> 8, head = (unit >> 6) & 3, c = unit & 63;
        const size_t row0 = (size_t)b * SEQ + c * 64;
        __syncthreads();
        if (tid < 128) {
            const int ch = head * 128 + tid; float lg[DEPTH], mx = -1e30f;
#pragma unroll
            for (int j = 0; j < DEPTH; ++j) { lg[j] = a->in[I_HLB][j * 512 + ch]; mx = fmaxf(mx, lg[j]); }
            float den = 0.f, num = 0.f;
#pragma unroll
            for (int j = 0; j < DEPTH; ++j) { const float e = __expf(lg[j] - mx); den += e; if (j >= 1 && j <= l) num += e; }
            sLb[tid] = num / den;
        }
        __syncthreads();
        for (int p = tid; p < 1024; p += NTHR) {
            const int t = p >> 4, d8 = (p & 15) * 8;
            const v4u qv = *(const GAS v4u*)(PROJ + (row0 + t) * NPROJ + O_HQ + head * 128 + d8), fv = *(const GAS v4u*)(PROJ + (row0 + t) * NPROJ + O_HF + head * 128 + d8);
            const f32x4 lbA = *(const LAS f32x4*)(sLb + d8), lbB = *(const LAS f32x4*)(sLb + d8 + 4); float qo[8], ko[8], bo[8];
#pragma unroll
            for (int i = 0; i < 4; ++i) {
                const float lb0 = (2 * i < 4) ? lbA[(2 * i) & 3] : lbB[(2 * i) & 3], lb1 = (2 * i + 1 < 4) ? lbA[(2 * i + 1) & 3] : lbB[(2 * i + 1) & 3];
                qo[2 * i] = siluf(bflo(qv[i])); qo[2 * i + 1] = siluf(bfhi(qv[i]));
                const float f0 = lb0 + (1.f - lb0) * sigmoidf_(bflo(fv[i])), f1 = lb1 + (1.f - lb1) * sigmoidf_(bfhi(fv[i]));
                ko[2 * i] = 1.f - f0; ko[2 * i + 1] = 1.f - f1; bo[2 * i] = __logf(f0); bo[2 * i + 1] = __logf(f1);
            }
            *(LAS f32x4*)(sQ + t * LS + d8) = (f32x4){qo[0], qo[1], qo[2], qo[3]}; *(LAS f32x4*)(sQ + t * LS + d8 + 4) = (f32x4){qo[4], qo[5], qo[6], qo[7]};
            *(LAS f32x4*)(sK + t * LS + d8) = (f32x4){ko[0], ko[1], ko[2], ko[3]}; *(LAS f32x4*)(sK + t * LS + d8 + 4) = (f32x4){ko[4], ko[5], ko[6], ko[7]};
            *(LAS f32x4*)(sB + t * LS + d8) = (f32x4){bo[0], bo[1], bo[2], bo[3]}; *(LAS f32x4*)(sB + t * LS + d8 + 4) = (f32x4){bo[4], bo[5], bo[6], bo[7]};
        }
        __syncthreads();
        {
            const int d = tid & 127, seg = tid >> 7; float run = 0.f, vals[16];
#pragma unroll
            for (int i = 0; i < 16; ++i) { run += sB[(seg * 16 + i) * LS + d]; vals[i] = run; }
            sT[seg * 128 + d] = run;
            __syncthreads();
            float off = 0.f;
#pragma unroll
            for (int s2 = 0; s2 < 3; ++s2) if (s2 < seg) off += sT[s2 * 128 + d];
#pragma unroll
            for (int i = 0; i < 16; ++i) sB[(seg * 16 + i) * LS + d] = vals[i] + off;
        }
        __syncthreads();
        bf16* qg = (bf16*)(a->ws + WS_HG_QG) + (size_t)unit * 64 * 128; bf16* kdt = (bf16*)(a->ws + WS_HG_KDT) + (size_t)unit * 128 * 64;
        bf16* am = (bf16*)(a->ws + WS_HG_A) + (size_t)unit * 64 * 64; float* gl = (float*)(a->ws + WS_HG_GL) + (size_t)unit * 128;
        for (int p = tid; p < 1024; p += NTHR) { const int t = p >> 4, d8 = (p & 15) * 8; float v[8];
            const f32x4 q0 = *(const LAS f32x4*)(sQ + t * LS + d8), q1 = *(const LAS f32x4*)(sQ + t * LS + d8 + 4), b0 = *(const LAS f32x4*)(sB + t * LS + d8), b1 = *(const LAS f32x4*)(sB + t * LS + d8 + 4);
#pragma unroll
            for (int jj = 0; jj < 4; ++jj) { v[jj] = q0[jj] * __expf(b0[jj]); v[4 + jj] = q1[jj] * __expf(b1[jj]); }
            *(GAS bf16x8*)(qg + t * 128 + d8) = pack8(v); }
        for (int p = tid; p < 1024; p += NTHR) { const int d = p >> 3, s8 = (p & 7) * 8; const float bl = sB[63 * LS + d]; float v[8];
#pragma unroll
            for (int jj = 0; jj < 8; ++jj) v[jj] = sK[(s8 + jj) * LS + d] * __expf(bl - sB[(s8 + jj) * LS + d]);
            *(GAS bf16x8*)(kdt + d * 64 + s8) = pack8(v); }
        if (tid < 128) gl[tid] = __expf(sB[63 * LS + tid]);
        for (int p = w; p < 16; p += NWAVES) {
            const int i = p >> 2, j = p & 3; f32x4 acc = {0.f, 0.f, 0.f, 0.f};
            if (j <= i) {
#pragma unroll
                for (int ks = 0; ks < 4; ++ks) { const int d0 = 32 * ks + 8 * q4, t = 16 * i + r, s_ = 16 * j + r; float qf[8], kf[8];
                    const int rrow = i ? 16 * i - 1 : 0;
#pragma unroll
                    for (int hh = 0; hh < 2; ++hh) { const int dd = d0 + 4 * hh;
                        f32x4 rf = *(const LAS f32x4*)(sB + rrow * LS + dd); if (!i) rf = (f32x4){0.f, 0.f, 0.f, 0.f};
                        const f32x4 qq = *(const LAS f32x4*)(sQ + t * LS + dd), bt = *(const LAS f32x4*)(sB + t * LS + dd), kk_ = *(const LAS f32x4*)(sK + s_ * LS + dd), bs = *(const LAS f32x4*)(sB + s_ * LS + dd);
#pragma unroll
                        for (int jj = 0; jj < 4; ++jj) { qf[4 * hh + jj] = qq[jj] * __expf(bt[jj] - rf[jj]); kf[4 * hh + jj] = kk_[jj] * __expf(rf[jj] - bs[jj]); } }
                    acc = mfma16(pack8(kf), pack8(qf), acc); }
                const int t = 16 * i + r;
#pragma unroll
                for (int ii = 0; ii < 4; ++ii) if (16 * j + 4 * q4 + ii > t) acc[ii] = 0.f;
            }
            *(GAS unsigned long long*)(am + (16 * i + r) * 64 + 16 * j + 4 * q4) = pack4(acc);
        }
    }
}
__device__ __forceinline__ void hgrn_scan_phase(CArgs a, int l, LAS unsigned char* lds, const int b, const int head, const int eb, int tid) {
    asm volatile("" : "+v"(tid));
    constexpr int QS = 136, KS = 72;
    constexpr int B_QG = 0, B_KDT = 17408, B_A = B_KDT + 18432, B_VT = B_A + 9216, B_GL = B_VT + 4608, BUF = B_GL + 512;
    LAS unsigned char* sST0 = lds + 2 * BUF;
    const bf16* PROJ = (const bf16*)(a->ws + WS_PROJ); bf16* YMIX = (bf16*)(a->ws + WS_YMIX);
    const int lane = tid & 63, w = tid >> 6, r = lane & 15, q4 = lane >> 4;
    {
        const size_t cu0 = (size_t)(b * 4 + head) * 64;
        const bf16* QG = (const bf16*)(a->ws + WS_HG_QG) + cu0 * 64 * 128; const bf16* KDT = (const bf16*)(a->ws + WS_HG_KDT) + cu0 * 128 * 64;
        const bf16* AM = (const bf16*)(a->ws + WS_HG_A) + cu0 * 64 * 64; const float* GL = (const float*)(a->ws + WS_HG_GL) + cu0 * 128;
        const bf16* VP = PROJ + (size_t)b * SEQ * NPROJ + O_HI + head * 128 + eb * 32;
        v4u rq[2], rk[2], ra, rv; f32x4 rg;
#define HG_LOAD(n) do { _Pragma("unroll") for (int i = 0; i < 2; ++i) { const int p = tid + NTHR * i; rq[i] = *(const GAS v4u*)(QG + (size_t)(n) * 8192 + (p >> 4) * 128 + (p & 15) * 8); \
            rk[i] = *(const GAS v4u*)(KDT + (size_t)(n) * 8192 + (p >> 3) * 64 + (p & 7) * 8); } \
            ra = *(const GAS v4u*)(AM + (size_t)(n) * 4096 + (tid >> 3) * 64 + (tid & 7) * 8); \
            if (tid < 256) rv = *(const GAS v4u*)(VP + (size_t)((n) * 64 + (tid >> 2)) * NPROJ + (tid & 3) * 8); \
            if (tid < 32) rg = *(const GAS f32x4*)(GL + (size_t)(n) * 128 + tid * 4); } while (0)
#define HG_STORE(bufp) do { LAS unsigned char* bp_ = (bufp); _Pragma("unroll") for (int i = 0; i < 2; ++i) { const int p = tid + NTHR * i; \
            *(LAS v4u*)(bp_ + B_QG + ((p >> 4) * QS + (p & 15) * 8) * 2) = rq[i]; *(LAS v4u*)(bp_ + B_KDT + ((p >> 3) * KS + (p & 7) * 8) * 2) = rk[i]; } \
            *(LAS v4u*)(bp_ + B_A + ((tid >> 3) * KS + (tid & 7) * 8) * 2) = ra; \
            if (tid < 256) { LAS bf16* vt = (LAS bf16*)(bp_ + B_VT); const int t_ = tid >> 2, e8 = (tid & 3) * 8; _Pragma("unroll") for (int i = 0; i < 4; ++i) { \
                vt[(e8 + 2 * i) * KS + t_] = (bf16)(rv[i] & 0xffffu); vt[(e8 + 2 * i + 1) * KS + t_] = (bf16)(rv[i] >> 16); } } \
            if (tid < 32) *(LAS f32x4*)(bp_ + B_GL + tid * 16) = rg; } while (0)
        __syncthreads();
        HG_LOAD(0);
        for (int i = tid; i < 8704 / 4; i += NTHR) ((LAS unsigned*)sST0)[i] = 0u;
        HG_STORE(lds);
        f32x4 accS[2] = {{0.f, 0.f, 0.f, 0.f}, {0.f, 0.f, 0.f, 0.f}};
        __syncthreads();
        for (int n = 0; n < 64; ++n) {
            const int cur = n & 1; LAS unsigned char* bp = lds + cur * BUF; LAS bf16* sST = (LAS bf16*)(sST0 + cur * 8704); LAS bf16* sSTn = (LAS bf16*)(sST0 + (cur ^ 1) * 8704);
            if (n + 1 < 64) HG_LOAD(n + 1);
            {
                const int tt = w >> 1, et = w & 1; f32x4 acc = {0.f, 0.f, 0.f, 0.f};
#pragma unroll
                for (int ks = 0; ks < 4; ++ks) acc = mfma16(lds_frag(sST, 16 * et, QS, 32 * ks, lane), lds_frag((LAS bf16*)(bp + B_QG), 16 * tt, QS, 32 * ks, lane), acc);
#pragma unroll
                for (int ks = 0; ks < 2; ++ks) acc = mfma16(lds_frag((LAS bf16*)(bp + B_VT), 16 * et, KS, 32 * ks, lane), lds_frag((LAS bf16*)(bp + B_A), 16 * tt, KS, 32 * ks, lane), acc);
                *(GAS unsigned long long*)(YMIX + ((size_t)b * SEQ + n * 64 + 16 * tt + r) * DMIX + 1536 + head * 128 + eb * 32 + 16 * et + 4 * q4) = pack4(acc);
            }
            {
                const f32x4 glv = *(const LAS f32x4*)(bp + B_GL + (16 * w + 4 * q4) * 4);
#pragma unroll
                for (int et = 0; et < 2; ++et) { accS[et] = accS[et] * glv;
#pragma unroll
                    for (int ks = 0; ks < 2; ++ks) accS[et] = mfma16(lds_frag((LAS bf16*)(bp + B_KDT), 16 * w, KS, 32 * ks, lane), lds_frag((LAS bf16*)(bp + B_VT), 16 * et, KS, 32 * ks, lane), accS[et]);
                    *(LAS unsigned long long*)(sSTn + (16 * et + r) * QS + 16 * w + 4 * q4) = pack4(accS[et]); }
            }
            if (n + 1 < 64) HG_STORE(lds + (cur ^ 1) * BUF);
            WG_BAR();
        }
#undef HG_LOAD
#undef HG_STORE
    }
}

__device__ __forceinline__ void ssd_rec_phase(CArgs a, int l, LAS unsigned char* lds, int wg, int G, int tid) {
    asm volatile("" : "+v"(tid));
    constexpr int TB = 64;
    LAS float* sX = (LAS float*)lds; LAS float* sB = sX + TB * 16; LAS float* sC = sB + TB * 128; LAS float* sDt = sC + TB * 128; LAS float* sDa = sDt + TB; LAS float* sY = sDa + TB;
    const bf16* PROJ = (const bf16*)(a->ws + WS_PROJ); bf16* YMIX = (bf16*)(a->ws + WS_YMIX);
    const float* cw = a->in[I_SCW] + (size_t)l * 4 * 1536; const float* cb = a->in[I_SCB] + (size_t)l * 1536;
    const int p_local = tid >> 5, nq = tid & 31;
    for (int unit = wg; unit < 256; unit += G) {
        const int b = unit >> 6, head = (unit >> 2) & 15, pq = unit & 3, g = head >> 3;
        const float A = -__expf(a->in[I_SALOG][l * 16 + head]), dtb = a->in[I_SDTB][l * 16 + head], Dsk = a->in[I_SD][l * 16 + head];
        float h0 = 0.f, h1 = 0.f, h2 = 0.f, h3 = 0.f;
        for (int t0 = 0; t0 < SEQ; t0 += TB) {
            __syncthreads();
            for (int idx = tid; idx < TB * 272; idx += NTHR) {
                const int tt = idx / 272, ci = idx % 272, t = t0 + tt;
                const int ch = ci < 16 ? head * 64 + pq * 16 + ci : (ci < 144 ? 1024 + g * 128 + (ci - 16) : 1280 + g * 128 + (ci - 144));
                float acc = cb[ch];
#pragma unroll
                for (int k = 0; k < 4; ++k) { const int ts = t - 3 + k; if (ts >= 0) acc += cw[k * 1536 + ch] * bf2f(PROJ[(size_t)(b * SEQ + ts) * NPROJ + O_XBC + ch]); }
                const float v = siluf(acc);
                if (ci < 16) sX[tt * 16 + ci] = v; else if (ci < 144) sB[tt * 128 + ci - 16] = v; else sC[tt * 128 + ci - 144] = v;
            }
            if (tid < TB) { const float raw = bf2f(PROJ[(size_t)(b * SEQ + t0 + tid) * NPROJ + O_DT + head]); const float dt = softplusf_(raw + dtb); sDt[tid] = dt; sDa[tid] = __expf(dt * A); }
            __syncthreads();
#pragma unroll 4
            for (int tt = 0; tt < TB; ++tt) {
                const float xv = sX[tt * 16 + p_local], da = sDa[tt], dx = sDt[tt] * xv;
                const f32x4 Bv = *(const LAS f32x4*)(sB + tt * 128 + nq * 4), Cv = *(const LAS f32x4*)(sC + tt * 128 + nq * 4);
                h0 = da * h0 + dx * Bv.x; h1 = da * h1 + dx * Bv.y; h2 = da * h2 + dx * Bv.z; h3 = da * h3 + dx * Bv.w;
                float part = (Cv.x * h0 + Cv.y * h1) + (Cv.z * h2 + Cv.w * h3);
                part += __shfl_xor(part, 1); part += __shfl_xor(part, 2); part += __shfl_xor(part, 4); part += __shfl_xor(part, 8); part += __shfl_xor(part, 16);
                if (nq == 0) sY[tt * 16 + p_local] = part + Dsk * xv;
            }
            __syncthreads();
            for (int idx = tid; idx < TB * 16; idx += NTHR) { const int tt = idx >> 4, i = idx & 15; YMIX[(size_t)(b * SEQ + t0 + tt) * DMIX + head * 64 + pq * 16 + i] = (bf16)f2bf(sY[idx]); }
        }
    }
}

__device__ __forceinline__ void ssd_prep_phase(CArgs a, int l, LAS unsigned char* lds, int wg, int G, int tid) {
    asm volatile("" : "+v"(tid));
    constexpr int PS = 136;
    LAS bf16* sB = (LAS bf16*)lds; LAS bf16* sC = sB + 128 * PS; LAS bf16* sXT = (LAS bf16*)lds; LAS float* sDt = (LAS float*)(lds + 2 * 128 * PS * 2); LAS bf16* sCB = (LAS bf16*)(lds + 2 * 128 * PS * 2 + 4096);
    const bf16* PROJ = (const bf16*)(a->ws + WS_PROJ);
    const float* cw = a->in[I_SCW] + (size_t)l * 4 * 1536; const float* cb = a->in[I_SCB] + (size_t)l * 1536;
    const int lane = tid & 63, w = tid >> 6, r = lane & 15, q4 = lane >> 4;
    for (int unit = wg; unit < 256; unit += G) {
        const int b = unit >> 6, c = (unit >> 1) & 31, g = unit & 1;
        const size_t row0 = (size_t)b * SEQ + c * 128;
        bf16* Cg = (bf16*)(a->ws + WS_SSD_C) + (size_t)unit * 16384; bf16* BTg = (bf16*)(a->ws + WS_SSD_BT) + (size_t)unit * 16384; bf16* CBg = (bf16*)(a->ws + WS_SSD_CB) + (size_t)unit * 16384;
        __syncthreads();
        {
            const int c16 = tid & 31, l0 = tid >> 5; const int ch = (c16 < 16 ? 1024 + g * 128 + c16 * 8 : 1280 + g * 128 + (c16 - 16) * 8);
            float wk[4][8], bias[8];
#pragma unroll
            for (int jj = 0; jj < 8; ++jj) { bias[jj] = cb[ch + jj];
#pragma unroll
                for (int k = 0; k < 4; ++k) wk[k][jj] = cw[k * 1536 + ch + jj]; }
            LAS bf16* dst = (c16 < 16 ? sB : sC) + (c16 & 15) * 8;
#pragma unroll 2
            for (int i = 0; i < 8; ++i) { const int ll = l0 + 16 * i; float acc[8];
#pragma unroll
                for (int jj = 0; jj < 8; ++jj) acc[jj] = bias[jj];
#pragma unroll
                for (int k = 0; k < 4; ++k) { const int ts = c * 128 + ll - 3 + k;
                    if (ts >= 0) { const v4u xv = *(const GAS v4u*)(PROJ + ((size_t)b * SEQ + ts) * NPROJ + O_XBC + ch);
#pragma unroll
                        for (int j = 0; j < 4; ++j) { acc[2 * j] += wk[k][2 * j] * bflo(xv[j]); acc[2 * j + 1] += wk[k][2 * j + 1] * bfhi(xv[j]); } } }
#pragma unroll
                for (int jj = 0; jj < 8; ++jj) acc[jj] = siluf(acc[jj]);
                *(LAS bf16x8*)(dst + ll * PS) = pack8(acc); }
        }
        {
            const int head = g * 8 + w; const float A = -__expf(a->in[I_SALOG][l * 16 + head]), dtb = a->in[I_SDTB][l * 16 + head];
            const int l2 = 2 * lane;
            const float dt0 = softplusf_(bf2f(PROJ[(row0 + l2) * NPROJ + O_DT + head]) + dtb), dt1 = softplusf_(bf2f(PROJ[(row0 + l2 + 1) * NPROJ + O_DT + head]) + dtb);
            const float da1 = dt1 * A; float sc = dt0 * A + da1;
#pragma unroll
            for (int o = 1; o < 64; o <<= 1) { const float t_ = __shfl_up(sc, o); if (lane >= o) sc += t_; }
            sDt[w * 128 + l2] = dt0; sDt[w * 128 + l2 + 1] = dt1;
            const size_t uh = (size_t)((b * 16 + head) * 32 + c) * 128;
            float* AC = (float*)(a->ws + WS_SSD_AC) + uh; float* DT = (float*)(a->ws + WS_SSD_DT) + uh;
            AC[l2] = sc - da1; AC[l2 + 1] = sc; DT[l2] = dt0; DT[l2 + 1] = dt1;
        }
        __syncthreads();
#pragma unroll
        for (int st = 0; st < 8; ++st) {
            f32x4 acc = {0.f, 0.f, 0.f, 0.f};
            if (st <= w) {
#pragma unroll
                for (int ks = 0; ks < 4; ++ks) acc = mfma16(lds_frag(sB, 16 * st, PS, 32 * ks, lane), lds_frag(sC, 16 * w, PS, 32 * ks, lane), acc); }
            *(LAS unsigned long long*)(sCB + (16 * w + r) * PS + 16 * st + 4 * q4) = pack4(acc);
        }
        __syncthreads();
        for (int f = w; f < 32; f += NWAVES) { const int tile = f >> 2, ks = f & 3;
            *(GAS v4u*)(Cg + f * 512 + lane * 8) = *(const LAS v4u*)(sC + (16 * tile + r) * PS + 32 * ks + 8 * q4);
            *(GAS v4u*)(CBg + f * 512 + lane * 8) = *(const LAS v4u*)(sCB + (16 * tile + r) * PS + 32 * ks + 8 * q4);
            const int n = 16 * tile + r, l0 = 32 * ks + 8 * q4; v4u o;
#pragma unroll
            for (int j = 0; j < 4; ++j) o[j] = (unsigned)sB[(l0 + 2 * j) * PS + n] | ((unsigned)sB[(l0 + 2 * j + 1) * PS + n] << 16);
            *(GAS v4u*)(BTg + f * 512 + lane * 8) = o; }
#pragma unroll 1
        for (int hf = 0; hf < 2; ++hf) {
            __syncthreads();
            {   const int cg = tid & 31, l0 = tid >> 5, chl = cg * 8, ch = g * 512 + hf * 256 + chl, hh = hf * 4 + (cg >> 3);
                float wk[4][8], bias[8];
#pragma unroll
                for (int jj = 0; jj < 8; ++jj) { bias[jj] = cb[ch + jj];
#pragma unroll
                    for (int k = 0; k < 4; ++k) wk[k][jj] = cw[k * 1536 + ch + jj]; }
#pragma unroll 2
                for (int i = 0; i < 8; ++i) { const int ll = l0 + 16 * i; float acc[8];
#pragma unroll
                    for (int jj = 0; jj < 8; ++jj) acc[jj] = bias[jj];
#pragma unroll
                    for (int k = 0; k < 4; ++k) { const int ts = c * 128 + ll - 3 + k;
                        if (ts >= 0) { const v4u xv = *(const GAS v4u*)(PROJ + ((size_t)b * SEQ + ts) * NPROJ + O_XBC + ch);
#pragma unroll
                            for (int j = 0; j < 4; ++j) { acc[2 * j] += wk[k][2 * j] * bflo(xv[j]); acc[2 * j + 1] += wk[k][2 * j + 1] * bfhi(xv[j]); } } }
                    const float dtv = sDt[hh * 128 + ll];
#pragma unroll
                    for (int jj = 0; jj < 8; ++jj) sXT[(chl + jj) * PS + ll] = (bf16)f2bf(siluf(acc[jj]) * dtv); }
            }
            __syncthreads();
            for (int p = tid; p < 4096; p += NTHR) { const int chl = p >> 4, l8 = (p & 15) * 8, hh = hf * 4 + (chl >> 6), pp = chl & 63;
                const size_t uh = (size_t)((b * 16 + g * 8 + hh) * 32 + c);
                *(GAS v4u*)((bf16*)(a->ws + WS_SSD_XT) + (uh * 64 + pp) * 128 + l8) = *(const LAS v4u*)(sXT + chl * PS + l8); }
        }
    }
}
__device__ __forceinline__ void ssd_scan_phase(CArgs a, int l, LAS unsigned char* lds, const int b, const int head, int tid) {
    asm volatile("" : "+v"(tid));
    constexpr int PS = 136, O_S = 0, O_X = 34816, O_AC = 69632, O_TE = 70656, O_DT = 71680;
    bf16* YMIX = (bf16*)(a->ws + WS_YMIX);
    const int lane = tid & 63, w = tid >> 6, r = lane & 15, q4 = lane >> 4;
    {
        const int g = head >> 3;
        const float Dsk = a->in[I_SD][l * 16 + head];
        const bf16* Cg = (const bf16*)(a->ws + WS_SSD_C) + (size_t)((b * 32) * 2 + g) * 16384 + (w * 4) * 512 + lane * 8;
        const bf16* CBg = (const bf16*)(a->ws + WS_SSD_CB) + (size_t)((b * 32) * 2 + g) * 16384 + (w * 4) * 512 + lane * 8;
        const bf16* BTg = (const bf16*)(a->ws + WS_SSD_BT) + (size_t)((b * 32) * 2 + g) * 16384 + (w * 4) * 512 + lane * 8;
        const size_t uh0 = (size_t)(b * 16 + head) * 32;
        const bf16* XTg = (const bf16*)(a->ws + WS_SSD_XT) + uh0 * 8192; const float* ACg = (const float*)(a->ws + WS_SSD_AC) + uh0 * 128; const float* DTg = (const float*)(a->ws + WS_SSD_DT) + uh0 * 128;
        v4u fC[4], fCB[4], fBT[4], rx[2]; float rac = 0.f, racl = 0.f, rdt = 0.f;
#define SSD_LDF(cc, dst, src) do { _Pragma("unroll") for (int ks = 0; ks < 4; ++ks) dst[ks] = *(const GAS v4u*)(src + (size_t)(cc) * 32768 + 512 * ks); } while (0)
#define SSD_LOADX(cc) do { _Pragma("unroll") for (int i = 0; i < 2; ++i) { const int p = tid + NTHR * i; rx[i] = *(const GAS v4u*)(XTg + (size_t)(cc) * 8192 + (p >> 4) * 128 + (p & 15) * 8); } \
            if (tid < 128) { rac = ACg[(cc) * 128 + tid]; racl = ACg[(cc) * 128 + 127]; rdt = DTg[(cc) * 128 + tid]; } } while (0)
#define SSD_STORE(bi) do { _Pragma("unroll") for (int i = 0; i < 2; ++i) { const int p = tid + NTHR * i; *(LAS v4u*)(lds + O_X + (bi) * 17408 + ((p >> 4) * PS + (p & 15) * 8) * 2) = rx[i]; } \
            if (tid < 128) { ((LAS float*)(lds + O_AC))[(bi) * 128 + tid] = rac; ((LAS float*)(lds + O_TE))[(bi) * 128 + tid] = __expf(racl - rac); ((LAS float*)(lds + O_DT))[(bi) * 128 + tid] = rdt; } } while (0)
        __syncthreads();
        SSD_LDF(0, fC, Cg); SSD_LDF(0, fCB, CBg); SSD_LDF(0, fBT, BTg); SSD_LOADX(0);
        for (int i = tid; i < 17408 / 4; i += NTHR) ((LAS unsigned*)(lds + O_S))[i] = 0u;
        SSD_STORE(0);
        f32x4 accS[4];
#pragma unroll
        for (int pt = 0; pt < 4; ++pt) accS[pt] = (f32x4){0.f, 0.f, 0.f, 0.f};
        __syncthreads();
        for (int c = 0; c < 32; ++c) {
            const int cur = c & 1;
            const LAS bf16* sS = (const LAS bf16*)(lds + O_S + cur * 17408); LAS bf16* sSn = (LAS bf16*)(lds + O_S + (cur ^ 1) * 17408); const LAS bf16* sXT = (const LAS bf16*)(lds + O_X + cur * 17408);
            const LAS float* sAc = (const LAS float*)(lds + O_AC) + cur * 128; const LAS float* sTe = (const LAS float*)(lds + O_TE) + cur * 128; const LAS float* sDt = (const LAS float*)(lds + O_DT) + cur * 128;
            const int cn = c + 1 < 32 ? c + 1 : c;
            SSD_LOADX(cn);
            const int lrow = 16 * w + r; const float ac_l = sAc[lrow];
            f32x4 accO[4], accD[4];
#pragma unroll
            for (int pt = 0; pt < 4; ++pt) { accO[pt] = (f32x4){0.f, 0.f, 0.f, 0.f}; accD[pt] = (f32x4){0.f, 0.f, 0.f, 0.f}; }
#pragma unroll
            for (int ks = 0; ks < 4; ++ks) { const bf16x8 yf = __builtin_bit_cast(bf16x8, fC[ks]);
#pragma unroll
                for (int pt = 0; pt < 4; ++pt) accO[pt] = mfma16(lds_frag(sS, 16 * pt, PS, 32 * ks, lane), yf, accO[pt]); }
            SSD_LDF(cn, fC, Cg);
#pragma unroll
            for (int ks = 0; ks < 4; ++ks) if (32 * ks <= 16 * w + 15) {
                float v[8]; const f32x4 a0 = *(const LAS f32x4*)(sAc + 32 * ks + 8 * q4), a1 = *(const LAS f32x4*)(sAc + 32 * ks + 8 * q4 + 4);
#pragma unroll
                for (int j = 0; j < 4; ++j) { const int s0 = 32 * ks + 8 * q4 + 2 * j; const float as0 = (2 * j < 4) ? a0[(2 * j) & 3] : a1[(2 * j) & 3], as1 = (2 * j + 1 < 4) ? a0[(2 * j + 1) & 3] : a1[(2 * j + 1) & 3];
                    v[2 * j] = (s0 <= lrow) ? bflo(fCB[ks][j]) * __expf(ac_l - as0) : 0.f; v[2 * j + 1] = (s0 + 1 <= lrow) ? bfhi(fCB[ks][j]) * __expf(ac_l - as1) : 0.f; }
                const bf16x8 yf = pack8(v);
#pragma unroll
                for (int pt = 0; pt < 4; ++pt) accD[pt] = mfma16(lds_frag(sXT, 16 * pt, PS, 32 * ks, lane), yf, accD[pt]); }
            SSD_LDF(cn, fCB, CBg);
            {   const float ea = __expf(ac_l), rdtl = Dsk / sDt[lrow];
#pragma unroll
                for (int pt = 0; pt < 4; ++pt) { f32x4 y = accO[pt] * ea + accD[pt];
#pragma unroll
                    for (int ii = 0; ii < 4; ++ii) y[ii] += rdtl * bf2f(sXT[(16 * pt + 4 * q4 + ii) * PS + lrow]);
                    *(GAS unsigned long long*)(YMIX + ((size_t)b * SEQ + c * 128 + lrow) * DMIX + head * 64 + 16 * pt + 4 * q4) = pack4(y); } }
            {   const float cd = __expf(sAc[127]);
#pragma unroll
                for (int pt = 0; pt < 4; ++pt) accS[pt] = accS[pt] * cd;
#pragma unroll
                for (int ks = 0; ks < 4; ++ks) { float v[8]; const f32x4 t0 = *(const LAS f32x4*)(sTe + 32 * ks + 8 * q4), t1 = *(const LAS f32x4*)(sTe + 32 * ks + 8 * q4 + 4);
#pragma unroll
                    for (int j = 0; j < 4; ++j) { const float ts0 = (2 * j < 4) ? t0[(2 * j) & 3] : t1[(2 * j) & 3], ts1 = (2 * j + 1 < 4) ? t0[(2 * j + 1) & 3] : t1[(2 * j + 1) & 3];
                        v[2 * j] = bflo(fBT[ks][j]) * ts0; v[2 * j + 1] = bfhi(fBT[ks][j]) * ts1; }
                    const bf16x8 xf = pack8(v);
#pragma unroll
                    for (int pt = 0; pt < 4; ++pt) accS[pt] = mfma16(xf, lds_frag(sXT, 16 * pt, PS, 32 * ks, lane), accS[pt]); }
#pragma unroll
                for (int pt = 0; pt < 4; ++pt) *(LAS unsigned long long*)(sSn + (16 * pt + r) * PS + 16 * w + 4 * q4) = pack4(accS[pt]);
            }
            SSD_LDF(cn, fBT, BTg);
            if (c + 1 < 32) SSD_STORE(cur ^ 1);
            WG_BAR();
        }
#undef SSD_LDF
#undef SSD_LOADX
#undef SSD_STORE
    }
}

__device__ __forceinline__ void gdn_prep_phase(CArgs a, int l, LAS unsigned char* lds, int wg, int G, int tid) {
    asm volatile("" : "+v"(tid));
    constexpr int PS = 136, TS = 72, MS = 68, TT = 65;
    LAS bf16* sKb = (LAS bf16*)lds; LAS bf16* sQb = sKb + 64 * PS; LAS bf16* sQG = sQb + 64 * PS; LAS bf16* sVT = sQG + 64 * PS;
    LAS float* sM = (LAS float*)(lds + 3 * 17408 + 18432); LAS float* sT = sM + 64 * MS; LAS float* sVec = sT + 64 * TT; LAS bf16* sQK = (LAS bf16*)(sVec + 256);
    const bf16* PROJ = (const bf16*)(a->ws + WS_PROJ);
    const float* cw = a->in[I_GCW] + (size_t)l * 4 * 1536;
    const int lane = tid & 63, w = tid >> 6, r = lane & 15, q4 = lane >> 4;
    for (int unit = wg; unit < 1024; unit += G) {
        const int b = unit >> 8, head = (unit >> 6) & 3, n = unit & 63;
        const size_t row0 = (size_t)b * SEQ + n * 64;
#define GW ((bf16*)(a->ws + WS_GD_K) + (size_t)unit * 8192)
#define GKT ((bf16*)(a->ws + WS_GD_KT) + (size_t)unit * 8192)
#define GQG ((bf16*)(a->ws + WS_GD_QG) + (size_t)unit * 8192)
#define GUT ((bf16*)(a->ws + WS_GD_VT) + (size_t)unit * 8192)
#define GT ((bf16*)(a->ws + WS_GD_T) + (size_t)unit * 4096)
#define GQK ((bf16*)(a->ws + WS_GD_QK) + (size_t)unit * 4096)
#define GVEC ((float*)(a->ws + WS_GD_VEC) + (size_t)unit * 256)
        __syncthreads();
        for (int i = tid; i < 64 * MS; i += NTHR) sM[i] = 0.f;
        if (w == 0) {
            const float nA = -__expf(a->in[I_GALOG][l * 4 + head]), dtb = a->in[I_GDTB][l * 4 + head];
            const size_t ro = (row0 + lane) * NPROJ;
            const float be = sigmoidf_(bf2f(PROJ[ro + O_GB + head])); float gsum = nA * softplusf_(bf2f(PROJ[ro + O_GA + head]) + dtb);
#pragma unroll
            for (int o = 1; o < 64; o <<= 1) { const float t_ = __shfl_up(gsum, o); if (lane >= o) gsum += t_; }
            const float glast = __shfl(gsum, 63), eg = __expf(gsum), cc = __expf(glast - gsum);
            sVec[lane] = gsum; sVec[64 + lane] = be; sVec[128 + lane] = eg;
            GVEC[lane] = be; GVEC[64 + lane] = eg; GVEC[128 + lane] = cc; GVEC[192 + lane] = __expf(glast);
        }
        __syncthreads();
        {
            const int rg = lane >> 4, c8 = (lane & 15) * 8;
#pragma unroll 1
            for (int part = 0; part < 3; ++part) {
                float wt[4][8];
#pragma unroll
                for (int k = 0; k < 4; ++k) { const f32x4 w0 = *(const f32x4*)(cw + k * 1536 + part * 512 + head * 128 + c8), w1 = *(const f32x4*)(cw + k * 1536 + part * 512 + head * 128 + c8 + 4);
#pragma unroll
                    for (int jj = 0; jj < 4; ++jj) { wt[k][jj] = w0[jj]; wt[k][4 + jj] = w1[jj]; } }
#pragma unroll
                for (int it = 0; it < 2; ++it) { const int t = 8 * w + 4 * it + rg; float acc[8];
#pragma unroll
                    for (int jj = 0; jj < 8; ++jj) acc[jj] = 0.f;
#pragma unroll
                    for (int k = 0; k < 4; ++k) { const int ts = n * 64 + t - 3 + k;
                        if (ts >= 0) { const v4u xv = *(const GAS v4u*)(PROJ + ((size_t)b * SEQ + ts) * NPROJ + O_QKV + part * 512 + head * 128 + c8);
#pragma unroll
                            for (int j = 0; j < 4; ++j) { acc[2 * j] += wt[k][2 * j] * bflo(xv[j]); acc[2 * j + 1] += wt[k][2 * j + 1] * bfhi(xv[j]); } } }
                    float ss = 0.f;
#pragma unroll
                    for (int jj = 0; jj < 8; ++jj) { acc[jj] = siluf(acc[jj]); ss += acc[jj] * acc[jj]; }
                    if (part == 2) {
#pragma unroll
                        for (int jj = 0; jj < 8; ++jj) sVT[(c8 + jj) * TS + t] = (bf16)f2bf(acc[jj]);
                    } else {
                        const float sc = rsqrtf(row16_sum(ss) + 1e-6f) * (part == 0 ? 0.08838834764831845f : 1.0f);
#pragma unroll
                        for (int jj = 0; jj < 8; ++jj) acc[jj] *= sc;
                        if (part == 1) *(LAS bf16x8*)(sKb + t * PS + c8) = pack8(acc);
                        else { *(LAS bf16x8*)(sQb + t * PS + c8) = pack8(acc); const float eg = sVec[128 + t];
#pragma unroll
                            for (int jj = 0; jj < 8; ++jj) acc[jj] *= eg;
                            *(LAS bf16x8*)(sQG + t * PS + c8) = pack8(acc); }
                    }
                }
            }
        }
        __syncthreads();
        for (int p = w; p < 26; p += NWAVES) {
            int it, jt; bool isq;
            if (p < 10) { isq = false; it = p < 1 ? 0 : (p < 3 ? 1 : (p < 6 ? 2 : 3)); jt = p - (it * (it + 1)) / 2; } else { isq = true; it = (p - 10) >> 2; jt = (p - 10) & 3; }
            f32x4 acc = {0.f, 0.f, 0.f, 0.f};
            if (jt <= it) {
#pragma unroll
                for (int ks = 0; ks < 4; ++ks) acc = mfma16(lds_frag(sKb, 16 * jt, PS, 32 * ks, lane), lds_frag(isq ? sQb : sKb, 16 * it, PS, 32 * ks, lane), acc);
                const int i = 16 * it + r; const float gi = sVec[i], bi = sVec[64 + i];
#pragma unroll
                for (int ii = 0; ii < 4; ++ii) { const int j = 16 * jt + 4 * q4 + ii; const float dec = __expf(gi - sVec[j]);
                    acc[ii] = isq ? (j <= i ? acc[ii] * dec : 0.f) : (j < i ? acc[ii] * dec * bi : 0.f); }
            }
            if (isq) *(LAS unsigned long long*)(sQK + (16 * it + r) * TS + 16 * jt + 4 * q4) = pack4(acc);
            else *(LAS f32x4*)(sM + (16 * it + r) * MS + 16 * jt + 4 * q4) = acc;
        }
        __syncthreads();
        {
            LAS float* sX = (LAS float*)(sQK + 64 * TS);
            if (w < 4) {
                int zo = 0; asm volatile("" : "+v"(zo)); const LAS float* sMv = sM + zo + (16 * w) * MS + 16 * w;
                if (lane < 16) { float ud[16];
#pragma unroll
                    for (int rr = 0; rr < 16; ++rr) { float acc = -sMv[rr * MS + lane];
#pragma unroll
                        for (int j = 0; j < rr; ++j) acc -= sMv[rr * MS + j] * ud[j];
                        ud[rr] = acc; sT[(16 * w + rr) * TT + 16 * w + lane] = acc + ((rr == lane) ? 1.f : 0.f); } }
                for (int jb = w + 1; jb < 4; ++jb)
                    for (int idx = lane; idx < 256; idx += 64) sT[(16 * w + (idx >> 4)) * TT + 16 * jb + (idx & 15)] = 0.f;
            } else {
                for (int f = w - 4; f < 16; f += 4) { const int tile = f >> 2, ks = f & 3;
                    *(GAS v4u*)(GQG + f * 512 + lane * 8) = *(const LAS v4u*)(sQG + (16 * tile + r) * PS + 32 * ks + 8 * q4); }
                for (int f = w - 4; f < 8; f += 4) { const int tile = f >> 1, ks = f & 1;
                    *(GAS v4u*)(GQK + f * 512 + lane * 8) = *(const LAS v4u*)(sQK + (16 * tile + r) * TS + 32 * ks + 8 * q4); }
                for (int f = w - 4; f < 16; f += 4) { const int dt = f >> 1, ks = f & 1, d = 16 * dt + r, s0 = 32 * ks + 8 * q4; v4u o;
#pragma unroll
                    for (int j = 0; j < 4; ++j) o[j] = (unsigned)sKb[(s0 + 2 * j) * PS + d] | ((unsigned)sKb[(s0 + 2 * j + 1) * PS + d] << 16);
                    *(GAS v4u*)(GKT + f * 512 + lane * 8) = o; }
            }
            WG_BAR();
#pragma unroll
            for (int ib = 1; ib < 4; ++ib) {
                if (w < ib) { const int jb = w; f32x4 acc = {0.f, 0.f, 0.f, 0.f};
                    for (int kb = jb; kb < ib; ++kb)
#pragma unroll
                        for (int kc = 0; kc < 4; ++kc) acc = __builtin_amdgcn_mfma_f32_16x16x4f32(sM[(16 * ib + r) * MS + 16 * kb + 4 * kc + q4], sT[(16 * kb + 4 * kc + q4) * TT + 16 * jb + r], acc, 0, 0, 0);
                    LAS float* sx = sX + w * 272;
#pragma unroll
                    for (int rr = 0; rr < 4; ++rr) sx[(4 * q4 + rr) * 17 + r] = acc[rr];
                    asm volatile("s_waitcnt lgkmcnt(0)" ::: "memory");
                    f32x4 acc2 = {0.f, 0.f, 0.f, 0.f};
#pragma unroll
                    for (int kc = 0; kc < 4; ++kc) acc2 = __builtin_amdgcn_mfma_f32_16x16x4f32(sT[(16 * ib + r) * TT + 16 * ib + 4 * kc + q4], sx[(4 * kc + q4) * 17 + r], acc2, 0, 0, 0);
#pragma unroll
                    for (int rr = 0; rr < 4; ++rr) sT[(16 * ib + 4 * q4 + rr) * TT + 16 * jb + r] = -acc2[rr];
                }
                WG_BAR();
            }
        }
        {
            LAS bf16* sTb = (LAS bf16*)sM; LAS bf16* sKgT = sQb;
            { const int t = tid >> 3, s8 = (tid & 7) * 8; float v[8];
#pragma unroll
                for (int jj = 0; jj < 8; ++jj) v[jj] = sT[t * TT + s8 + jj];
                *(LAS bf16x8*)(sTb + t * TS + s8) = pack8(v); }
            for (int p = tid; p < 1024; p += NTHR) { const int d = p >> 3, s8 = (p & 7) * 8; float v[8], u8[8]; const v4u vv = *(const LAS v4u*)(sVT + d * TS + s8);
#pragma unroll
                for (int jj = 0; jj < 8; ++jj) { const float be = sVec[64 + s8 + jj]; v[jj] = bf2f(sKb[(s8 + jj) * PS + d]) * be * sVec[128 + s8 + jj]; u8[jj] = ((jj & 1) ? bfhi(vv[jj >> 1]) : bflo(vv[jj >> 1])) * be; }
                *(LAS bf16x8*)(sKgT + d * TS + s8) = pack8(v); *(LAS bf16x8*)(sVT + d * TS + s8) = pack8(u8); }
        }
        __syncthreads();
        {
            const LAS bf16* sTb = (const LAS bf16*)sM; const LAS bf16* sKgT = sQb; LAS bf16* sW = (LAS bf16*)((LAS unsigned char*)sM + 9216);
            const int st_ = w >> 1;
            const bf16x8 t0 = lds_frag(sTb, 16 * st_, TS, 0, lane), t1 = lds_frag(sTb, 16 * st_, TS, 32, lane);
#pragma unroll
            for (int c4_ = 0; c4_ < 4; ++c4_) { const int ct = (w & 1) * 4 + c4_;
                f32x4 aw = {0.f, 0.f, 0.f, 0.f}, au = {0.f, 0.f, 0.f, 0.f};
                aw = mfma16(lds_frag(sKgT, 16 * ct, TS, 0, lane), t0, aw); aw = mfma16(lds_frag(sKgT, 16 * ct, TS, 32, lane), t1, aw);
                au = mfma16(t0, lds_frag(sVT, 16 * ct, TS, 0, lane), au); au = mfma16(t1, lds_frag(sVT, 16 * ct, TS, 32, lane), au);
                *(LAS unsigned long long*)(sW + (16 * st_ + r) * PS + 16 * ct + 4 * q4) = pack4(aw);
                *(GAS unsigned long long*)(GUT + (ct * 4 + st_) * 256 + lane * 4) = pack4(au); }
        }
        __syncthreads();
        { const LAS bf16* sW = (const LAS bf16*)((LAS unsigned char*)sM + 9216);
            for (int f = w; f < 16; f += NWAVES) { const int tile = f >> 2, ks = f & 3;
                *(GAS v4u*)(GW + f * 512 + lane * 8) = *(const LAS v4u*)(sW + (16 * tile + r) * PS + 32 * ks + 8 * q4); } }
    }
#undef GW
#undef GKT
#undef GQG
#undef GUT
#undef GT
#undef GQK
#undef GVEC
}
__device__ __forceinline__ void gdn_scan_phase(CArgs a, int l, LAS unsigned char* lds, const int b, const int head, const int eb, int tid) {
    asm volatile("" : "+v"(tid));
    constexpr int PS = 136, TS = 72, O_ST = 0, O_RT = 34816, O_VN = O_RT + 9216, O_VC = O_VN + 9216;
    bf16* YMIX = (bf16*)(a->ws + WS_YMIX);
    const int lane = tid & 63, w = tid >> 6, r = lane & 15, q4 = lane >> 4, st = w >> 1, eh = w & 1;
    LAS bf16* sRT = (LAS bf16*)(lds + O_RT); LAS bf16* sVN = (LAS bf16*)(lds + O_VN); LAS bf16* sVC = (LAS bf16*)(lds + O_VC);
    {
        const size_t u0 = (size_t)(b * 4 + head) * 64;
        const bf16* pW = (const bf16*)(a->ws + WS_GD_K) + u0 * 8192 + (st * 4) * 512 + lane * 8; const bf16* pQG = (const bf16*)(a->ws + WS_GD_QG) + u0 * 8192 + (st * 4) * 512 + lane * 8;
        const bf16* pQK = (const bf16*)(a->ws + WS_GD_QK) + u0 * 4096 + (st * 2) * 512 + lane * 8;
        const bf16* pKT = (const bf16*)(a->ws + WS_GD_KT) + u0 * 8192 + (w * 2) * 512 + lane * 8;
        const bf16* pUT = (const bf16*)(a->ws + WS_GD_VT) + u0 * 8192 + (size_t)(((eb * 4 + 2 * eh) * 4 + st) * 256) + lane * 4;
        const float* pVec = (const float*)(a->ws + WS_GD_VEC) + u0 * 256 + 16 * st + 4 * q4;
        v4u xW[4], yQG[4], yQK[2], xKT[2], nQG[4], nQK[2]; unsigned long long uT[2]; f32x4 c4; float gl;
#define GD_LD_A(nn) do { _Pragma("unroll") for (int ks = 0; ks < 4; ++ks) xW[ks] = *(const GAS v4u*)(pW + (size_t)(nn) * 8192 + 512 * ks); \
            _Pragma("unroll") for (int j = 0; j < 2; ++j) uT[j] = *(const GAS unsigned long long*)(pUT + (size_t)(nn) * 8192 + j * 1024); \
            c4 = *(const GAS f32x4*)(pVec + (size_t)(nn) * 256 + 128); } while (0)
#define GD_LD_C(nn, QG_, QK_) do { _Pragma("unroll") for (int ks = 0; ks < 4; ++ks) QG_[ks] = *(const GAS v4u*)(pQG + (size_t)(nn) * 8192 + 512 * ks); \
            _Pragma("unroll") for (int ks = 0; ks < 2; ++ks) QK_[ks] = *(const GAS v4u*)(pQK + (size_t)(nn) * 4096 + 512 * ks); } while (0)
#define GD_LD_D(nn) do { _Pragma("unroll") for (int ks = 0; ks < 2; ++ks) xKT[ks] = *(const GAS v4u*)(pKT + (size_t)(nn) * 8192 + 512 * ks); gl = pVec[(size_t)(nn) * 256 + 192 - (16 * st + 4 * q4)]; } while (0)
        __syncthreads();
        GD_LD_A(0); GD_LD_C(0, yQG, yQK); GD_LD_D(0);
        for (int i = tid; i < 17408 / 4; i += NTHR) ((LAS unsigned*)(lds + O_ST))[i] = 0u;
        f32x4 accS[4];
#pragma unroll
        for (int et = 0; et < 4; ++et) accS[et] = (f32x4){0.f, 0.f, 0.f, 0.f};
        __syncthreads();
        for (int n = 0; n < 64; ++n) {
            const int cur = n & 1; const LAS bf16* sST = (const LAS bf16*)(lds + O_ST + cur * 17408); LAS bf16* sSTn = (LAS bf16*)(lds + O_ST + (cur ^ 1) * 17408);
            const int nn = n + 1 < 64 ? n + 1 : n;
            {
                bf16x8 fs[2][4];
#pragma unroll
                for (int j = 0; j < 2; ++j)
#pragma unroll
                    for (int ks = 0; ks < 4; ++ks) fs[j][ks] = lds_frag(sST, 16 * (2 * eh + j), PS, 32 * ks, lane);
                __builtin_amdgcn_sched_barrier(0);
#pragma unroll
                for (int j = 0; j < 2; ++j) { const int e0 = 16 * (2 * eh + j); f32x4 acc = {0.f, 0.f, 0.f, 0.f};
#pragma unroll
                    for (int ks = 0; ks < 4; ++ks) acc = mfma16(__builtin_bit_cast(bf16x8, xW[ks]), fs[j][ks], acc);
                    const unsigned ulo = (unsigned)uT[j], uhi = (unsigned)(uT[j] >> 32); f32x4 vn;
                    vn[0] = bflo(ulo) - acc[0]; vn[1] = bfhi(ulo) - acc[1]; vn[2] = bflo(uhi) - acc[2]; vn[3] = bfhi(uhi) - acc[3];
                    *(LAS unsigned long long*)(sVN + (e0 + r) * TS + 16 * st + 4 * q4) = pack4(vn); *(LAS unsigned long long*)(sVC + (e0 + r) * TS + 16 * st + 4 * q4) = pack4(vn * c4); }
            }
            GD_LD_A(nn); GD_LD_C(nn, nQG, nQK);
            WG_BAR();
            {
                bf16x8 fv[4][2];
#pragma unroll
                for (int et = 0; et < 4; ++et)
#pragma unroll
                    for (int ks = 0; ks < 2; ++ks) fv[et][ks] = lds_frag(sVC, 16 * et, TS, 32 * ks, lane);
                __builtin_amdgcn_sched_barrier(0);
#pragma unroll
                for (int et = 0; et < 4; ++et) { accS[et] = accS[et] * gl;
#pragma unroll
                    for (int ks = 0; ks < 2; ++ks) accS[et] = mfma16(__builtin_bit_cast(bf16x8, xKT[ks]), fv[et][ks], accS[et]);
                    *(LAS unsigned long long*)(sSTn + (16 * et + r) * PS + 16 * w + 4 * q4) = pack4(accS[et]); }
            }
            GD_LD_D(nn);
            {
                bf16x8 fs[2][4], fn[2][2];
#pragma unroll
                for (int j = 0; j < 2; ++j) {
#pragma unroll
                    for (int ks = 0; ks < 4; ++ks) fs[j][ks] = lds_frag(sST, 16 * (2 * eh + j), PS, 32 * ks, lane);
#pragma unroll
                    for (int ks = 0; ks < 2; ++ks) fn[j][ks] = lds_frag(sVN, 16 * (2 * eh + j), TS, 32 * ks, lane); }
                __builtin_amdgcn_sched_barrier(0);
#pragma unroll
                for (int j = 0; j < 2; ++j) { const int e0 = 16 * (2 * eh + j); f32x4 acc = {0.f, 0.f, 0.f, 0.f};
#pragma unroll
                    for (int ks = 0; ks < 4; ++ks) acc = mfma16(fs[j][ks], __builtin_bit_cast(bf16x8, yQG[ks]), acc);
#pragma unroll
                    for (int ks = 0; ks < 2; ++ks) acc = mfma16(fn[j][ks], __builtin_bit_cast(bf16x8, yQK[ks]), acc);
                    *(GAS unsigned long long*)(YMIX + ((size_t)b * SEQ + n * 64 + 16 * st + r) * DMIX + 1024 + head * 128 + eb * 64 + e0 + 4 * q4) = pack4(acc); }
            }
#pragma unroll
            for (int ks = 0; ks < 4; ++ks) yQG[ks] = nQG[ks];
#pragma unroll
            for (int ks = 0; ks < 2; ++ks) yQK[ks] = nQK[ks];
            WG_BAR();
        }
#undef GD_LD_A
#undef GD_LD_C
#undef GD_LD_D
    }
}

__device__ __forceinline__ void gdn_rec_phase(CArgs a, int l, LAS unsigned char* lds, int wg, int G, int tid) {
    asm volatile("" : "+v"(tid));
    constexpr int TB = 32;
    LAS float* sQ = (LAS float*)lds; LAS float* sK = sQ + TB * 128; LAS float* sV = sK + TB * 128; LAS float* sBe = sV + TB * 8; LAS float* sAl = sBe + TB; LAS float* sO = sAl + TB;
    const bf16* PROJ = (const bf16*)(a->ws + WS_PROJ); bf16* YMIX = (bf16*)(a->ws + WS_YMIX);
    const float* cw = a->in[I_GCW] + (size_t)l * 4 * 1536;
    const int lane = tid & 63, w = tid >> 6;
    for (int unit = wg; unit < 256; unit += G) {
        const int b = unit >> 6, head = (unit >> 4) & 3, eb = unit & 15;
        const float nA = -__expf(a->in[I_GALOG][l * 4 + head]), dtb = a->in[I_GDTB][l * 4 + head];
        float S0 = 0.f, S1 = 0.f;
        for (int t0 = 0; t0 < SEQ; t0 += TB) {
            __syncthreads();
            for (int idx = tid; idx < TB * 264; idx += NTHR) {
                const int tt = idx / 264, ci = idx % 264, t = t0 + tt;
                const int ch = ci < 128 ? head * 128 + ci : (ci < 256 ? 512 + head * 128 + (ci - 128) : 1024 + head * 128 + eb * 8 + (ci - 256));
                float acc = 0.f;
#pragma unroll
                for (int k = 0; k < 4; ++k) { const int ts = t - 3 + k; if (ts >= 0) acc += cw[k * 1536 + ch] * bf2f(PROJ[(size_t)(b * SEQ + ts) * NPROJ + O_QKV + ch]); }
                const float v = siluf(acc);
                if (ci < 128) sQ[tt * 128 + ci] = v; else if (ci < 256) sK[tt * 128 + ci - 128] = v; else sV[tt * 8 + ci - 256] = v;
            }
            if (tid < TB) { const size_t ro = (size_t)(b * SEQ + t0 + tid) * NPROJ; const float braw = bf2f(PROJ[ro + O_GB + head]), araw = bf2f(PROJ[ro + O_GA + head]);
                sBe[tid] = sigmoidf_(braw); sAl[tid] = __expf(nA * softplusf_(araw + dtb)); }
            __syncthreads();
            for (int tt = w; tt < TB; tt += NWAVES) {
                const float q0 = sQ[tt * 128 + lane], q1 = sQ[tt * 128 + 64 + lane], k0 = sK[tt * 128 + lane], k1 = sK[tt * 128 + 64 + lane];
                const float sq = rsqrtf(wave_sum(q0 * q0 + q1 * q1) + 1e-6f) * 0.08838834764831845f, sk = rsqrtf(wave_sum(k0 * k0 + k1 * k1) + 1e-6f);
                sQ[tt * 128 + lane] = q0 * sq; sQ[tt * 128 + 64 + lane] = q1 * sq; sK[tt * 128 + lane] = k0 * sk; sK[tt * 128 + 64 + lane] = k1 * sk;
            }
            __syncthreads();
#pragma unroll 2
            for (int tt = 0; tt < TB; ++tt) {
                const float k0 = sK[tt * 128 + lane], k1 = sK[tt * 128 + 64 + lane], q0 = sQ[tt * 128 + lane], q1 = sQ[tt * 128 + 64 + lane];
                const float al = sAl[tt], be = sBe[tt], v = sV[tt * 8 + w];
                const float dot = wave_sum(k0 * S0 + k1 * S1);
                const float vn = be * (v - al * dot);
                S0 = al * S0 + k0 * vn; S1 = al * S1 + k1 * vn;
                const float od = wave_sum(q0 * S0 + q1 * S1);
                if (lane == 0) sO[tt * 8 + w] = od;
            }
            __syncthreads();
            if (tid < TB * 8) { const int tt = tid >> 3, i = tid & 7; YMIX[(size_t)(b * SEQ + t0 + tt) * DMIX + 1024 + head * 128 + eb * 8 + i] = (bf16)f2bf(sO[tid]); }
        }
    }
}

__device__ __forceinline__ void hgrn_rec_phase(CArgs a, int l, LAS unsigned char* lds, int wg, int G, int tid) {
    asm volatile("" : "+v"(tid));
    constexpr int TB = 32;
    LAS float* sQ = (LAS float*)lds; LAS float* sF = sQ + TB * 128; LAS float* sV = sF + TB * 128; LAS float* sO = sV + TB * 8; LAS float* sLb = sO + TB * 8;
    const bf16* PROJ = (const bf16*)(a->ws + WS_PROJ); bf16* YMIX = (bf16*)(a->ws + WS_YMIX);
    const int lane = tid & 63, w = tid >> 6;
    for (int unit = wg; unit < 256; unit += G) {
        const int b = unit >> 6, head = (unit >> 4) & 3, eb = unit & 15;
        __syncthreads();
        if (tid < 128) {
            const int c = head * 128 + tid; float lg[DEPTH], mx = -1e30f;
#pragma unroll
            for (int j = 0; j < DEPTH; ++j) { lg[j] = a->in[I_HLB][j * 512 + c]; mx = fmaxf(mx, lg[j]); }
            float den = 0.f, num = 0.f;
#pragma unroll
            for (int j = 0; j < DEPTH; ++j) { const float e = __expf(lg[j] - mx); den += e; if (j >= 1 && j <= l) num += e; }
            sLb[tid] = num / den;
        }
        float S0 = 0.f, S1 = 0.f;
        for (int t0 = 0; t0 < SEQ; t0 += TB) {
            __syncthreads();
            for (int idx = tid; idx < TB * 264; idx += NTHR) {
                const int tt = idx / 264, ci = idx % 264; const size_t ro = (size_t)(b * SEQ + t0 + tt) * NPROJ;
                if (ci < 128) sQ[tt * 128 + ci] = siluf(bf2f(PROJ[ro + O_HQ + head * 128 + ci]));
                else if (ci < 256) { const int d = ci - 128; const float lb = sLb[d]; sF[tt * 128 + d] = lb + (1.f - lb) * sigmoidf_(bf2f(PROJ[ro + O_HF + head * 128 + d])); }
                else sV[tt * 8 + ci - 256] = bf2f(PROJ[ro + O_HI + head * 128 + eb * 8 + (ci - 256)]);
            }
            __syncthreads();
#pragma unroll 2
            for (int tt = 0; tt < TB; ++tt) {
                const float f0 = sF[tt * 128 + lane], f1 = sF[tt * 128 + 64 + lane], q0 = sQ[tt * 128 + lane], q1 = sQ[tt * 128 + 64 + lane], v = sV[tt * 8 + w];
                S0 = f0 * S0 + (1.f - f0) * v; S1 = f1 * S1 + (1.f - f1) * v;
                const float od = wave_sum(q0 * S0 + q1 * S1);
                if (lane == 0) sO[tt * 8 + w] = od;
            }
            __syncthreads();
            if (tid < TB * 8) { const int tt = tid >> 3, i = tid & 7; YMIX[(size_t)(b * SEQ + t0 + tt) * DMIX + 1536 + head * 128 + eb * 8 + i] = (bf16)f2bf(sO[tid]); }
        }
    }
}

__device__ __forceinline__ void mix_post_phase(CArgs a, int l, int wg, int G, int tid) {
    asm volatile("" : "+v"(tid));
    const bf16* PROJ = (const bf16*)(a->ws + WS_PROJ); bf16* YMIX = (bf16*)(a->ws + WS_YMIX);
    const int lane = tid & 63, gw = wg * NWAVES + (tid >> 6), NGW = G * NWAVES;
    const float* snw = a->in[I_SNW] + l * 1024; const float* gnw = a->in[I_GNW] + l * 128; const float* hnw = a->in[I_HNW] + l * 128;
    for (int row = gw; row < M; row += NGW) {
        const bf16* pr = PROJ + (size_t)row * NPROJ; bf16* yr = YMIX + (size_t)row * DMIX;
#pragma unroll
        for (int j = 0; j < 2; ++j) {
            const int ch = j * 512 + lane * 8; const v4u yv = *(const GAS v4u*)(yr + ch), zv = *(const GAS v4u*)(pr + O_Z + ch);
            float v[8]; float ss = 0.f;
#pragma unroll
            for (int i = 0; i < 4; ++i) { v[2 * i] = bflo(yv[i]) * siluf(bflo(zv[i])); v[2 * i + 1] = bfhi(yv[i]) * siluf(bfhi(zv[i])); ss += v[2 * i] * v[2 * i] + v[2 * i + 1] * v[2 * i + 1]; }
            const float rstd = rsqrtf(wave_sum(ss) * (1.f / 512.f) + 1e-6f);
            v4u o;
#pragma unroll
            for (int i = 0; i < 4; ++i) o[i] = pk2(v[2 * i] * rstd * snw[ch + 2 * i], v[2 * i + 1] * rstd * snw[ch + 2 * i + 1]);
            *(GAS v4u*)(yr + ch) = o;
        }
#pragma unroll
        for (int part = 0; part < 2; ++part) {
            const int ch = lane * 8, yo = 1024 + part * 512 + ch, go = (part == 0 ? O_GG : O_HG) + ch; const float* nw = part == 0 ? gnw : hnw;
            const v4u yv = *(const GAS v4u*)(yr + yo), gv = *(const GAS v4u*)(pr + go);
            float v[8]; float ss = 0.f;
#pragma unroll
            for (int i = 0; i < 4; ++i) { v[2 * i] = bflo(yv[i]); v[2 * i + 1] = bfhi(yv[i]); ss += v[2 * i] * v[2 * i] + v[2 * i + 1] * v[2 * i + 1]; }
            ss = row16_sum(ss);
            const float rstd = rsqrtf(ss * (1.f / 128.f) + 1e-6f);
            v4u o;
#pragma unroll
            for (int i = 0; i < 4; ++i) { const int c = (ch & 127) + 2 * i; o[i] = pk2(v[2 * i] * rstd * nw[c] * siluf(bflo(gv[i])), v[2 * i + 1] * rstd * nw[c + 1] * siluf(bfhi(gv[i]))); }
            *(GAS v4u*)(yr + yo) = o;
        }
    }
}

__device__ __forceinline__ void moe_tables(const gu32* cnt, LAS unsigned char* lds, int tid) {
    LAS int* tab = (LAS int*)(lds + LDS_OFF_TAB);
    __syncthreads();
    if (tid == 0) { int p = 0, q = 0;
        for (int e = 0; e < 16; ++e) { const int c = (int)__hip_atomic_load(cnt + e, RLX_AGENT); tab[e] = p; tab[17 + e] = q; p += (c + 255) & ~255; q += c; }
        tab[16] = p; tab[33] = q; }
    __syncthreads();
}
template <bool ROUTER>
__device__ __forceinline__ void ln_phase(CArgs a, int l, const float* gam, const float* bet, LAS unsigned char* lds, int wg, int G, int tid) {
    asm volatile("" : "+v"(tid));
    const int lane = tid & 63, wave = tid >> 6, gw = wg * NWAVES + wave, NGW = G * NWAVES;
    const float* ADD = (const float*)(a->ws + WS_MIX); float* H = a->out; bf16* HB = (bf16*)(a->ws + WS_HB);
    gu32* cnt = (gu32*)(a->ws + WS_CTL) + CW_CNT + l * 16;
    LAS float* sW = (LAS float*)lds;
    LAS float* sL = sW + 20 * D + wave * 32;
    LAS int* sCnt = (LAS int*)(sW + 20 * D + 256);
    LAS unsigned* sEnt = (LAS unsigned*)(sCnt + 32);
    constexpr int MAXENT = 2 * NWAVES * 8;
    if (ROUTER) {
        __syncthreads();
        const float* wrg = a->in[I_WRG] + (size_t)l * D * 4; const float* wre = a->in[I_WRE] + (size_t)l * D * 16;
        for (int i = tid; i < D * 20; i += NTHR) { const int c = i >> 10, k = i & 1023; sW[i] = c < 4 ? wrg[k * 4 + c] : wre[k * 16 + c - 4]; }
        if (tid < 32) sCnt[tid] = 0;
        __syncthreads();
    } else moe_tables(cnt, lds, tid);
    const LAS int* tab = (const LAS int*)(lds + LDS_OFF_TAB);
    f32x4 gv[4], bv[4];
#pragma unroll
    for (int j = 0; j < 4; ++j) { gv[j] = *(const f32x4*)(gam + 4 * lane + 256 * j); bv[j] = *(const f32x4*)(bet + 4 * lane + 256 * j); }
    int kk = 0;
    f32x4 ph[4], pa[4];
    const float* Hin = (ROUTER && l == 0) ? a->in[I_X] : H;
    if (ROUTER && gw < M) {
#pragma unroll
        for (int j = 0; j < 4; ++j) { ph[j] = *(const GAS f32x4*)(Hin + (size_t)gw * D + 4 * lane + 256 * j); pa[j] = *(const GAS f32x4*)(ADD + (size_t)gw * D + 4 * lane + 256 * j); } }
    for (int row = gw; row < M; row += NGW, ++kk) {
        f32x4 v[4]; float s = 0.f;
        if (ROUTER) {
#pragma unroll
            for (int j = 0; j < 4; ++j) { v[j] = ph[j] * DN_ALPHA + pa[j]; s += (v[j].x + v[j].y) + (v[j].z + v[j].w); }
            const int nrow = row + NGW < M ? row + NGW : row;
#pragma unroll
            for (int j = 0; j < 4; ++j) { ph[j] = *(const GAS f32x4*)(Hin + (size_t)nrow * D + 4 * lane + 256 * j); pa[j] = *(const GAS f32x4*)(ADD + (size_t)nrow * D + 4 * lane + 256 * j); }
        } else {
            const unsigned s0 = ((const GAS unsigned*)(a->ws + WS_SLOT))[2 * row], s1 = ((const GAS unsigned*)(a->ws + WS_SLOT))[2 * row + 1];
            const bf16* y0 = (const bf16*)(a->ws + WS_YS) + (size_t)(tab[s0 >> 16] + (int)(s0 & 0xffffu)) * D; const bf16* y1 = (const bf16*)(a->ws + WS_YS) + (size_t)(tab[s1 >> 16] + (int)(s1 & 0xffffu)) * D;
#pragma unroll
            for (int j = 0; j < 4; ++j) { const f32x4 hv = *(const GAS f32x4*)(H + (size_t)row * D + 4 * lane + 256 * j);
                const unsigned long long p0 = *(const GAS unsigned long long*)(y0 + 4 * lane + 256 * j), p1 = *(const GAS unsigned long long*)(y1 + 4 * lane + 256 * j);
                f32x4 av; av.x = bflo((unsigned)p0) + bflo((unsigned)p1); av.y = bfhi((unsigned)p0) + bfhi((unsigned)p1); av.z = bflo((unsigned)(p0 >> 32)) + bflo((unsigned)(p1 >> 32)); av.w = bfhi((unsigned)(p0 >> 32)) + bfhi((unsigned)(p1 >> 32));
                v[j] = hv * DN_ALPHA + av; s += (v[j].x + v[j].y) + (v[j].z + v[j].w); }
        }
        const float mean = wave_sum(s) * (1.f / D); float s2 = 0.f;
#pragma unroll
        for (int j = 0; j < 4; ++j) { v[j] = v[j] - mean; s2 += (v[j].x * v[j].x + v[j].y * v[j].y) + (v[j].z * v[j].z + v[j].w * v[j].w); }
        const float rstd = rsqrtf(wave_sum(s2) * (1.f / D) + LN_EPS);
#pragma unroll
        for (int j = 0; j < 4; ++j) { v[j] = v[j] * rstd * gv[j] + bv[j];
            *(GAS f32x4*)(H + (size_t)row * D + 4 * lane + 256 * j) = v[j];
            *(GAS unsigned long long*)(HB + (size_t)row * D + 4 * lane + 256 * j) = (unsigned long long)pk2(v[j].x, v[j].y) | ((unsigned long long)pk2(v[j].z, v[j].w) << 32); }
        if (ROUTER) {
            float lg[20];
#pragma unroll 1
            for (int c = 0; c < 20; ++c) { float p = 0.f;
#pragma unroll
                for (int j = 0; j < 4; ++j) { const f32x4 wv = *(const LAS f32x4*)(sW + c * D + 4 * lane + 256 * j); p += (v[j].x * wv.x + v[j].y * wv.y) + (v[j].z * wv.z + v[j].w * wv.w); }
                p = wave_sum(p); if (lane == 0) sL[c] = p; }
#pragma unroll
            for (int c = 0; c < 20; ++c) lg[c] = sL[c];
            float pg[4], mx = -1e30f; int gi = 0;
#pragma unroll
            for (int c = 0; c < 4; ++c) { pg[c] = lg[c] + a->in[I_BRG][l * 4 + c]; if (pg[c] > mx) { mx = pg[c]; gi = c; } }
            float den = 0.f;
#pragma unroll
            for (int c = 0; c < 4; ++c) den += __expf(pg[c] - mx);
            const float g_p = 1.0f / den;
            float le[4], emx = -1e30f; int i1 = 0;
#pragma unroll
            for (int c = 0; c < 4; ++c) { float x = 0.f;
#pragma unroll
                for (int gg = 0; gg < 4; ++gg) x = (gi == gg) ? lg[4 + gg * 4 + c] + a->in[I_BRE][l * 16 + gg * 4 + c] : x;
                le[c] = x; if (x > emx) { emx = x; i1 = c; } }
            float e2mx = -1e30f; int i2 = 0;
#pragma unroll
            for (int c = 0; c < 4; ++c) if (c != i1 && le[c] > e2mx) { e2mx = le[c]; i2 = c; }
            const float x2 = __expf(e2mx - emx), w1 = g_p / (1.0f + x2), w2 = g_p * x2 / (1.0f + x2);
            if (lane < 2) {
                const int e = gi * 4 + (lane == 0 ? i1 : i2); const float wv = lane == 0 ? w1 : w2;
                if (kk < 8) { const int lp = __hip_atomic_fetch_add(sCnt + e, 1, __ATOMIC_RELAXED, __HIP_MEMORY_SCOPE_WORKGROUP); LAS unsigned* en = sEnt + ((wave * 8 + kk) * 2 + lane) * 4;
                    en[0] = (unsigned)row; en[1] = (unsigned)e; en[2] = (unsigned)lp; en[3] = __builtin_bit_cast(unsigned, wv); }
                else { const int pos = (int)__hip_atomic_fetch_add(cnt + e, 1u, RLX_AGENT);
                    ((GAS int*)(a->ws + WS_LTOK))[e * M + pos] = row; ((GAS float*)(a->ws + WS_LW))[e * M + pos] = wv; ((GAS unsigned*)(a->ws + WS_SLOT))[2 * row + lane] = ((unsigned)e << 16) | (unsigned)pos; }
            }
        }
    }
    if (ROUTER) {
        __syncthreads();
        if (tid < 16) sCnt[16 + tid] = (int)__hip_atomic_fetch_add(cnt + tid, (unsigned)sCnt[tid], RLX_AGENT);
        __syncthreads();
        const int nk = kk < 8 ? kk : 8;
        if (tid < MAXENT) { const int wv_ = tid >> 4, k_ = (tid >> 1) & 7;
            int nkw = 0;
#pragma unroll
            for (int k2 = 0; k2 < 8; ++k2) nkw += (wg * NWAVES + wv_ + k2 * NGW < M) ? 1 : 0;
            if (k_ < nkw) { const LAS unsigned* en = sEnt + tid * 4; const int e = (int)en[1], pos = sCnt[16 + e] + (int)en[2];
                ((GAS int*)(a->ws + WS_LTOK))[e * M + pos] = (int)en[0]; ((GAS unsigned*)(a->ws + WS_LW))[e * M + pos] = en[3]; ((GAS unsigned*)(a->ws + WS_SLOT))[2 * en[0] + (tid & 1)] = ((unsigned)e << 16) | (unsigned)pos; } }
        (void)nk;
    }
}
__device__ __forceinline__ void moe_gather_phase(CArgs a, int l, LAS unsigned char* lds, int wg, int G, int tid) {
    asm volatile("" : "+v"(tid));
    const int lane = tid & 63, gw = wg * NWAVES + (tid >> 6), NGW = G * NWAVES;
    moe_tables((gu32*)(a->ws + WS_CTL) + CW_CNT + l * 16, lds, tid);
    const LAS int* tab = (const LAS int*)(lds + LDS_OFF_TAB);
    const bf16* HB = (const bf16*)(a->ws + WS_HB); bf16* XS = (bf16*)(a->ws + WS_XS);
    for (int idx = gw; idx < 2 * M; idx += NGW) {
        int e = 0;
#pragma unroll
        for (int k = 1; k < 16; ++k) e += (tab[17 + k] <= idx) ? 1 : 0;
        const int pos = idx - tab[17 + e], dst = tab[e] + pos;
        const int row = ((const GAS int*)(a->ws + WS_LTOK))[e * M + pos];
        const v4u x0 = *(const GAS v4u*)(HB + (size_t)row * D + 8 * lane), x1 = *(const GAS v4u*)(HB + (size_t)row * D + 512 + 8 * lane);
        *(GAS v4u*)(XS + (size_t)dst * D + 8 * lane) = x0; *(GAS v4u*)(XS + (size_t)dst * D + 512 + 8 * lane) = x1;
        if (lane == 0) ((GAS float*)(a->ws + WS_WSORT))[dst] = ((const GAS float*)(a->ws + WS_LW))[e * M + pos];
    }
}

enum { P_IN = 0, P_PREP, P_SCAN, P_POST, P_OUT, P_LN1, P_GU, P_DN, P_LN2, NPH };
constexpr int N_PHASES = 1 + DEPTH * NPH;
__global__ void __launch_bounds__(NTHR, 2) fwd(Args args) {
    extern __shared__ __attribute__((aligned(16))) unsigned char lds_raw[];
    LAS unsigned char* lds = (LAS unsigned char*)lds_raw;
    volatile LAS unsigned* MISC = (volatile LAS unsigned*)(lds + MISC_OFF);
    const int tid = threadIdx.x, G = gridDim.x, bx = blockIdx.x;
    unsigned char* ws0 = args.ws;
    gu32* ctl = (gu32*)(ws0 + WS_CTL);
    for (int u = tid; u < (LDS_BYTES - LDSCTL_OFF) / 4; u += NTHR) ((LAS unsigned*)(lds + LDSCTL_OFF))[u] = 0u;
    __syncthreads();
    const int lo = args.ph_lo, hi = args.ph_hi;
    const bool use_bar = (hi - lo) > 1;
    XcdBarrier bar; bar.bar = (unsigned*)(ctl + CW_BAR); bar.x = 0; bar.st = nullptr;
    if (use_bar) bar = xcd_barrier_post((unsigned*)(ctl + CW_BAR), MISC + 8);
#define IN(k) (lo <= (k) && (k) < hi)
#define SEAM(k) do { if (IN(k) && IN((k) + 1)) xcd_barrier(bar); } while (0)

    if (IN(0)) { p0_prologue(ARGS_HERE(), lds, bx, G, tid); weights_phase(ARGS_HERE(), 0, 1, lds, bx, G, tid); SEAM(0); }

    for (int l = 0; l < DEPTH; ++l) {
        const int base = 1 + l * NPH;
        unsigned char* ws = ws0; asm volatile("" : "+s"(ws));
        if (IN(base + P_IN)) {
            pg8::Gemm g{(const pg8::bf16_t*)(ws + WS_HB), (const pg8::bf16_t*)(ws + WS_WIN), M, NPROJ, D}; pg8::StaticOrder S; S.init(M, NPROJ, G, bx);
            pg8::EpiBf16<0> E{(pg8::bf16_t*)(ws + WS_PROJ), NPROJ, nullptr, 0, 0, 1.f};
            pg8::gemm_phase<pg8::EpiBf16<0>, pg8::StaticOrder, true, true>(lds + RING_OFF, g, S, E);
            SEAM(base + P_IN);
        }
        if (IN(base + P_PREP)) {
            hgrn_prep_phase(ARGS_HERE(), l, lds, bx, G, tid);
            ssd_prep_phase(ARGS_HERE(), l, lds, bx, G, tid);
            gdn_prep_phase(ARGS_HERE(), l, lds, bx, G, tid);
            SEAM(base + P_PREP); }
        if (IN(base + P_SCAN)) {
            if (G >= 192) {
                if (bx < 64) { const int pr = bx & 7, hh = bx >> 3; ssd_scan_phase(ARGS_HERE(), l, lds, pr >> 1, (pr & 1) * 8 + hh, tid); }
                else if (bx < 96) { const int x = (bx - 64) & 7, y = (bx - 64) >> 3, pr = x * 2 + (y >> 1); gdn_scan_phase(ARGS_HERE(), l, lds, pr >> 2, pr & 3, y & 1, tid); }
                else if (bx < 160) { const int x = (bx - 96) & 7, y = (bx - 96) >> 3, pr = x * 2 + (y >> 2); hgrn_scan_phase(ARGS_HERE(), l, lds, pr >> 2, pr & 3, y & 3, tid); }
                else { weights_phase(ARGS_HERE(), l, 14, lds, bx - 160, G - 160, tid);
                       if (l + 1 < DEPTH) weights_phase(ARGS_HERE(), l + 1, 1, lds, bx - 160, G - 160, tid); }
            }
            SEAM(base + P_SCAN); }
        if (IN(base + P_POST)) { mix_post_phase(ARGS_HERE(), l, bx, G, tid); SEAM(base + P_POST); }
        if (IN(base + P_OUT)) {
            pg8::Gemm g{(const pg8::bf16_t*)(ws + WS_YMIX), (const pg8::bf16_t*)(ws + WS_WOUT), M, D, DMIX}; pg8::StaticOrder S; S.init(M, D, G, bx);
            pg8::EpiF32 E{(float*)(ws + WS_MIX), D};
            pg8::gemm_phase<pg8::EpiF32, pg8::StaticOrder, true, true>(lds + RING_OFF, g, S, E);
            SEAM(base + P_OUT);
        }
        if (IN(base + P_LN1)) { CArgs a_ = ARGS_HERE(); ln_phase<true>(a_, l, a_->in[I_LN1G] + l * D, a_->in[I_LN1B] + l * D, lds, bx, G, tid); SEAM(base + P_LN1); }
        if (IN(base + P_GU)) {
            moe_tables(ctl + CW_CNT + l * 16, lds, tid);
            pg8::Gemm g{(const pg8::bf16_t*)(ws + WS_HB), (const pg8::bf16_t*)(ws + WS_WGU), MAXROWS, NGU, D}; pg8::MoeOrder<2, true> S{(const LAS int*)(lds + LDS_OFF_TAB), G, bx, (const int*)(ws + WS_LTOK), M};
            pg8::EpiSwiGLUs E{(pg8::bf16_t*)(ws + WS_HS), (const float*)(ws + WS_LW), M, (const LAS int*)(lds + LDS_OFF_TAB)};
            pg8::gemm_phase<pg8::EpiSwiGLUs, pg8::MoeOrder<2, true>, true, true>(lds + RING_OFF, g, S, E);
            SEAM(base + P_GU);
        }
        if (IN(base + P_DN)) {
            moe_tables(ctl + CW_CNT + l * 16, lds, tid);
            pg8::Gemm g{(const pg8::bf16_t*)(ws + WS_HS), (const pg8::bf16_t*)(ws + WS_WDN), MAXROWS, NEXP * D, DEXP}; pg8::MoeOrder<4> S{(const LAS int*)(lds + LDS_OFF_TAB), G, bx, nullptr, 0};
            pg8::EpiBf16s E{(pg8::bf16_t*)(ws + WS_YS)};
            pg8::gemm_phase<pg8::EpiBf16s, pg8::MoeOrder<4>, true, true>(lds + RING_OFF, g, S, E);
            SEAM(base + P_DN);
        }
        if (IN(base + P_LN2)) { CArgs a_ = ARGS_HERE(); ln_phase<false>(a_, l, a_->in[I_LN2G] + l * D, a_->in[I_LN2B] + l * D, lds, bx, G, tid); SEAM(base + P_LN2); }
    }
#undef IN
#undef SEAM
}

#ifndef MK_ONE_LAUNCH
#define MK_ONE_LAUNCH 1
#endif
extern "C" void kernel_launch(void* const* d_in, const int* in_sizes, int n_in, void* d_out, int out_size, void* d_ws, size_t ws_size, hipStream_t stream) {
    static int grid = 0;
    if (grid == 0) {
        if (n_in != 25 || out_size != M * D || ws_size < WS_END) { fprintf(stderr, "kernel_launch: unexpected shapes (n_in %d out %d ws %zu)\n", n_in, out_size, ws_size); grid = -1; return; }
        int dev = 0, cus = 0, per_cu = 0;
        if (hipGetDevice(&dev) != hipSuccess || hipDeviceGetAttribute(&cus, hipDeviceAttributeMultiprocessorCount, dev) != hipSuccess) { grid = -1; return; }
        if (hipFuncSetAttribute((const void*)fwd, hipFuncAttributeMaxDynamicSharedMemorySize, LDS_BYTES) != hipSuccess) { fprintf(stderr, "kernel_launch: hipFuncSetAttribute failed\n"); grid = -1; return; }
        if (hipOccupancyMaxActiveBlocksPerMultiprocessor(&per_cu, (const void*)fwd, NTHR, LDS_BYTES) != hipSuccess || per_cu < 1) { fprintf(stderr, "kernel_launch: occupancy query says %d\n", per_cu); (void)hipGetLastError(); grid = -1; return; }
        grid = cus;
    }
    if (grid < 0) return;
    if (hipMemsetAsync((char*)d_ws + WS_CTL, 0, CTL_ZERO_BYTES, stream) != hipSuccess) return;
    Args a{};
    for (int i = 0; i < 25; ++i) a.in[i] = (const float*)d_in[i];
    a.out = (float*)d_out; a.ws = (unsigned char*)d_ws;
#if MK_ONE_LAUNCH
    a.ph_lo = 0; a.ph_hi = N_PHASES;
    hipLaunchKernelGGL(fwd, dim3(grid), dim3(NTHR), LDS_BYTES, stream, a);
#else
    for (int p = 0; p < N_PHASES; ++p) { a.ph_lo = p; a.ph_hi = p + 1; hipLaunchKernelGGL(fwd, dim3(grid), dim3(NTHR), LDS_BYTES, stream, a); }
#endif
}
```

```cpp
#include <hip/hip_runtime.h>
#include <cstdio>
#include <cstdint>
namespace pg8 {
#define PG8_LAS __attribute__((address_space(3)))
typedef unsigned short bf16_t;
typedef short bf16x8 __attribute__((ext_vector_type(8)));
typedef float f32x4 __attribute__((ext_vector_type(4)));
typedef unsigned u32x4 __attribute__((ext_vector_type(4)));
constexpr int BM = 256, BK = 64, HALF = 128, HTB = HALF * BK * 2  , STAGE_BYTES = 8 * HTB, NXCD = 8, WGM = 8;

__host__ __device__ __forceinline__ int lds_byte(int r, int c) { const int st = (r >> 4) * 2 + (c >> 5), rr = r & 15, cc = c & 31, ob = rr * 64 + cc * 2; return st * 1024 + (ob ^ (((ob >> 9) & 1) << 5)); }
__host__ __device__ __forceinline__ void stage_rc(int b, int& R, int& C) { const int st = b / 1024, sb = b % 1024, swz = sb ^ (((sb >> 9) & 1) << 5); R = (st >> 1) * 16 + swz / 64; C = (st & 1) * 32 + (swz % 64) / 2; }
__host__ __device__ __forceinline__ int perm32(int rho) { const int n = rho >> 4, i = rho & 15; return 8 * (i >> 2) + 4 * n + (i & 3); }

struct Unit { int pm, pn; };
struct Gemm { const bf16_t* A; const bf16_t* Bt; int M, N, K; };

struct StaticOrder {
    static constexpr bool GATHER = false;
    int nM, nN, nwg, G, c;
    __host__ __device__ void init(int M, int N, int G_, int c_) { nM = M / BM; nN = N / BM; nwg = nM * nN; G = G_; c = c_; }
    __host__ __device__ bool next(int i, Unit& u) const {
        const long L = (long)i * G + c; if (L >= nwg) return false;
        int wgid = (int)L; { const int q = nwg / NXCD, r = nwg % NXCD, xcd = wgid % NXCD, off = wgid / NXCD; wgid = (xcd < r ? xcd * (q + 1) : r * (q + 1) + (xcd - r) * q) + off; }
        const int nig = WGM * nN, gid = wgid / nig, fm = gid * WGM, gsz = (nM - fm) < WGM ? (nM - fm) : WGM;
        u.pm = fm + ((wgid % nig) % gsz); u.pn = (wgid % nig) / gsz; return true;
    }
    __device__ __forceinline__ void a_ready(const Unit&) const {}
    __device__ __forceinline__ void done(const Unit&) const {}
    __device__ __forceinline__ int row_token(int, const Unit&) const { return 0; }
};
__device__ __forceinline__ unsigned cvt_pk_bf16(float lo, float hi) { unsigned r; asm volatile("v_cvt_pk_bf16_f32 %0, %1, %2" : "=v"(r) : "v"(lo), "v"(hi)); return r; }
typedef float f32x2 __attribute__((ext_vector_type(2)));
__device__ __forceinline__ f32x2 gelu_pk(f32x2 v) {
    const f32x2 av = __builtin_elementwise_abs(v), d = av * 0.2316418882f + 1.0f;
    f32x2 t; t.x = __builtin_amdgcn_rcpf(d.x); t.y = __builtin_amdgcn_rcpf(d.y);
    f32x2 q = t * 0.5307027145f + (-0.7265760135f); q = q * t + 0.7107068705f; q = q * t + (-0.142248368f); q = q * t + 0.127414796f; q = q * t;
    const f32x2 s = (v * v) * (-0.72134752044f);
    f32x2 e; e.x = __builtin_amdgcn_exp2f(s.x); e.y = __builtin_amdgcn_exp2f(s.y);
    const f32x2 m = v * (q * e), r = v - m;
    f32x2 o; o.x = v.x < 0.f ? m.x : r.x; o.y = v.y < 0.f ? m.y : r.y; return o;
}

template <int ACT  > struct EpiBf16 {
    static constexpr bool PERM = true, AFTER_DRAIN = false; static_assert(ACT == 0 || ACT == 1, "EpiBf16: ACT is 0 (none) or 1 (gelu_pk)");
    bf16_t* O; int ldc; const float* bias; int split_cols; size_t split_stride; float scale0;
    __device__ __forceinline__ void operator()(const f32x4 (&acc)[2][2][4][2], const Unit& u, int wr, int wc, int fr, int fq) const {
        const int row0 = u.pm * BM + wr * 64 + fr; int colt = u.pn * BM; bf16_t* base = O;
        float sc = 1.f; if (split_cols) { const int t = colt / split_cols; base += (size_t)t * split_stride; colt -= t * split_cols; if (t == 0) sc = scale0; }
        const int col0 = colt + wc * 32 + 8 * fq, bcol0 = u.pn * BM + wc * 32 + 8 * fq;
        f32x4 bv[2][2];
#pragma unroll
        for (int bj = 0; bj < 2; ++bj)
#pragma unroll
            for (int n = 0; n < 2; ++n) bv[bj][n] = bias ? *(const f32x4*)(bias + bcol0 + bj * HALF + 4 * n) : (f32x4){0.f, 0.f, 0.f, 0.f};
#pragma unroll
        for (int ai = 0; ai < 2; ++ai)
#pragma unroll
            for (int m = 0; m < 4; ++m) { bf16_t* rowp = base + (size_t)(row0 + ai * HALF + m * 16) * ldc + col0;
#pragma unroll
                for (int bj = 0; bj < 2; ++bj) { f32x4 v0 = acc[ai][bj][m][0] + bv[bj][0], v1 = acc[ai][bj][m][1] + bv[bj][1];
                    if (ACT == 1) { f32x2 a = gelu_pk((f32x2){v0[0], v0[1]}), b = gelu_pk((f32x2){v0[2], v0[3]}), c = gelu_pk((f32x2){v1[0], v1[1]}), d = gelu_pk((f32x2){v1[2], v1[3]});
                        v0 = (f32x4){a.x, a.y, b.x, b.y}; v1 = (f32x4){c.x, c.y, d.x, d.y}; }
                    v0 = v0 * sc; v1 = v1 * sc; u32x4 w; w.x = cvt_pk_bf16(v0[0], v0[1]); w.y = cvt_pk_bf16(v0[2], v0[3]); w.z = cvt_pk_bf16(v1[0], v1[1]); w.w = cvt_pk_bf16(v1[2], v1[3]);
                    *(u32x4*)(rowp + bj * HALF) = w; } }
    }
};
struct EpiF32 {
    static constexpr bool PERM = false, AFTER_DRAIN = false;
    float* C; int ldc;
    __device__ __forceinline__ void operator()(const f32x4 (&acc)[2][2][4][2], const Unit& u, int wr, int wc, int fr, int fq) const {
        const int row0 = u.pm * BM + wr * 64 + fr, col0 = u.pn * BM + wc * 32 + 4 * fq;
#pragma unroll
        for (int ai = 0; ai < 2; ++ai)
#pragma unroll
            for (int m = 0; m < 4; ++m) { float* rowp = C + (size_t)(row0 + ai * HALF + m * 16) * ldc + col0;
#pragma unroll
                for (int bj = 0; bj < 2; ++bj)
#pragma unroll
                    for (int n = 0; n < 2; ++n) *(f32x4*)(rowp + bj * HALF + n * 16) = acc[ai][bj][m][n]; }
    }
};
__device__ __forceinline__ float silu_f(float x) { return x * __builtin_amdgcn_rcpf(1.0f + __expf(-x)); }
struct EpiSwiGLU {
    static constexpr bool PERM = true, AFTER_DRAIN = false;
    bf16_t* H; int ldh; const float* comb; int ldcomb;
    __device__ __forceinline__ void operator()(const f32x4 (&acc)[2][2][4][2], const Unit& u, int wr, int wc, int fr, int fq) const {
        const int row0 = u.pm * BM + wr * 64 + fr, col0 = u.pn * 128 + wc * 32 + 8 * fq, e = u.pn >> 1;
#pragma unroll
        for (int ai = 0; ai < 2; ++ai)
#pragma unroll
            for (int m = 0; m < 4; ++m) { const int row = row0 + ai * HALF + m * 16; const float cw = comb[(size_t)row * ldcomb + e];
                const f32x4 g0 = acc[ai][0][m][0], g1 = acc[ai][0][m][1], u0 = acc[ai][1][m][0], u1 = acc[ai][1][m][1];
                f32x4 h0, h1;
#pragma unroll
                for (int j = 0; j < 4; ++j) { h0[j] = silu_f(g0[j]) * u0[j] * cw; h1[j] = silu_f(g1[j]) * u1[j] * cw; }
                u32x4 w; w.x = cvt_pk_bf16(h0[0], h0[1]); w.y = cvt_pk_bf16(h0[2], h0[3]); w.z = cvt_pk_bf16(h1[0], h1[1]); w.w = cvt_pk_bf16(h1[2], h1[3]);
                *(u32x4*)(H + (size_t)row * ldh + col0) = w; }
    }
};

template <int NSUB, bool GATHER_ = false> struct MoeOrder {
    static constexpr bool GATHER = GATHER_;
    const PG8_LAS int* off; int G, c; const int* ltok; int lstride;
    __device__ __forceinline__ int row_token(int srow, const Unit& u) const { const int e = u.pn / NSUB, pos = srow - off[e]; return pos < off[18 + e] - off[17 + e] ? ltok[e * lstride + pos] : 0; }
    __device__ __forceinline__ bool next(int i, Unit& u) const {
        const int L = i * G + c, x = L & 7, j = L >> 3, t = x + 8 * (j / NSUB), pnl = j % NSUB;
        if (t * 256 >= off[16]) return false;
        int e = 0;
#pragma unroll
        for (int k = 1; k < 16; ++k) e += (off[k] <= t * 256) ? 1 : 0;
        u.pm = t; u.pn = e * NSUB + pnl; return true;
    }
    __device__ __forceinline__ void a_ready(const Unit&) const {}
    __device__ __forceinline__ void done(const Unit&) const {}
};
struct EpiSwiGLUs {
    static constexpr bool PERM = true, AFTER_DRAIN = false;
    bf16_t* H; const float* lw; int lstride; const PG8_LAS int* off;
    __device__ __forceinline__ void operator()(const f32x4 (&acc)[2][2][4][2], const Unit& u, int wr, int wc, int fr, int fq) const {
        const int row0 = u.pm * BM + wr * 64 + fr, col0 = (u.pn & 1) * 128 + wc * 32 + 8 * fq;
#pragma unroll
        for (int ai = 0; ai < 2; ++ai)
#pragma unroll
            for (int m = 0; m < 4; ++m) { const int row = row0 + ai * HALF + m * 16; const int e_ = u.pn >> 1, pos_ = row - off[e_]; const float cw = pos_ < off[18 + e_] - off[17 + e_] ? lw[e_ * lstride + pos_] : 0.f;
                const f32x4 g0 = acc[ai][0][m][0], g1 = acc[ai][0][m][1], u0 = acc[ai][1][m][0], u1 = acc[ai][1][m][1];
                f32x4 h0, h1;
#pragma unroll
                for (int j = 0; j < 4; ++j) { h0[j] = silu_f(g0[j]) * u0[j] * cw; h1[j] = silu_f(g1[j]) * u1[j] * cw; }
                u32x4 w; w.x = cvt_pk_bf16(h0[0], h0[1]); w.y = cvt_pk_bf16(h0[2], h0[3]); w.z = cvt_pk_bf16(h1[0], h1[1]); w.w = cvt_pk_bf16(h1[2], h1[3]);
                *(u32x4*)(H + (size_t)row * 256 + col0) = w; }
    }
};
struct EpiBf16s {
    static constexpr bool PERM = true, AFTER_DRAIN = false;
    bf16_t* O;
    __device__ __forceinline__ void operator()(const f32x4 (&acc)[2][2][4][2], const Unit& u, int wr, int wc, int fr, int fq) const {
        const int row0 = u.pm * BM + wr * 64 + fr, col0 = (u.pn & 3) * BM + wc * 32 + 8 * fq;
#pragma unroll
        for (int ai = 0; ai < 2; ++ai)
#pragma unroll
            for (int m = 0; m < 4; ++m) { bf16_t* rowp = O + (size_t)(row0 + ai * HALF + m * 16) * 1024 + col0;
#pragma unroll
                for (int bj = 0; bj < 2; ++bj) { const f32x4 v0 = acc[ai][bj][m][0], v1 = acc[ai][bj][m][1];
                    u32x4 w; w.x = cvt_pk_bf16(v0[0], v0[1]); w.y = cvt_pk_bf16(v0[2], v0[3]); w.z = cvt_pk_bf16(v1[0], v1[1]); w.w = cvt_pk_bf16(v1[2], v1[3]);
                    *(u32x4*)(rowp + bj * HALF) = w; } }
    }
};
template <class Epi, class Sched, bool ALIGN_EPI = false, bool SP2 = false>
__device__ __forceinline__ void gemm_phase(PG8_LAS unsigned char* lds, const Gemm g, const Sched& S, const Epi& E) {
    int tid_ = threadIdx.x; asm volatile("" : "+v"(tid_));
    const int tid = tid_, wid = __builtin_amdgcn_readfirstlane(tid >> 6), lane = tid & 63, wr = wid >> 2, wc = wid & 3, fr = lane & 15, fq = lane >> 4;
    const int K = g.K, nt = K / BK;
    unsigned voffA[2], voffB[2];
#pragma unroll
    for (int i = 0; i < 2; ++i) { int R, C; stage_rc(tid * 16 + i * 8192, R, C); const int Rb = Epi::PERM ? ((R & ~31) + perm32(R & 31)) : R;
        voffA[i] = (unsigned)(R * K + C) * 2u; voffB[i] = (unsigned)(Rb * K + C) * 2u; }
    constexpr bool GATHER = Sched::GATHER; static_assert(!GATHER || SP2, "the gather path is written for the two-super-phase loop");
    int gR[2], gC[2];
#pragma unroll
    for (int i = 0; i < 2; ++i) stage_rc(tid * 16 + i * 8192, gR[i], gC[i]);
    unsigned vA0[2] = {0u, 0u}, vA1[2] = {0u, 0u}, nvA0[2] = {0u, 0u}, nvA1[2] = {0u, 0u};
#define PG8_GLOOK(U, D0, D1) do { _Pragma("unroll") for (int _i = 0; _i < 2; ++_i) { \
        D0[_i] = (unsigned)S.row_token((U).pm * BM + gR[_i], (U)) * (unsigned)(K * 2) + (unsigned)gC[_i] * 2u; D1[_i] = (unsigned)S.row_token((U).pm * BM + HALF + gR[_i], (U)) * (unsigned)(K * 2) + (unsigned)gC[_i] * 2u; } } while (0)
    const size_t kstep = (size_t)(BK * 2);
    const size_t hstep = (size_t)HALF * K * 2;
    const size_t tstep = 2 * hstep;
    const unsigned ldsw = (unsigned)wid * 1024u;
    const int aoff = lds_byte(wr * 64 + fr, fq * 8), boff = lds_byte(wc * 32 + fr, fq * 8);
#define PG8_SA(b, h) (((b) * 2 + (h)) * HTB)
#define PG8_SB(b, h) ((4 + (b) * 2 + (h)) * HTB)
#define PG8_STAGE(bufoff, gbase, voff) do { _Pragma("unroll") for (int _i = 0; _i < 2; ++_i) \
        __builtin_amdgcn_global_load_lds((const unsigned*)((const char*)(gbase) + (voff)[_i]), (PG8_LAS unsigned*)(lds + (bufoff) + ldsw + _i * 8192), 16, 0, 0); } while (0)
#define PG8_LDA(dst, b, h) do { _Pragma("unroll") for (int m = 0; m < 4; ++m) _Pragma("unroll") for (int k = 0; k < 2; ++k) dst[m][k] = *(const PG8_LAS bf16x8*)(lds + PG8_SA(b, h) + aoff + m * 2048 + k * 1024); } while (0)
#define PG8_LDB(dst, b, h) do { _Pragma("unroll") for (int n = 0; n < 2; ++n) _Pragma("unroll") for (int k = 0; k < 2; ++k) dst[n][k] = *(const PG8_LAS bf16x8*)(lds + PG8_SB(b, h) + boff + n * 2048 + k * 1024); } while (0)
#define PG8_MMA(ai, bj, At, Bt) do { __builtin_amdgcn_s_setprio(1); _Pragma("unroll") for (int m = 0; m < 4; ++m) _Pragma("unroll") for (int n = 0; n < 2; ++n) _Pragma("unroll") for (int k = 0; k < 2; ++k) \
        acc[ai][bj][m][n] = __builtin_amdgcn_mfma_f32_16x16x32_bf16(Bt[n][k], At[m][k], acc[ai][bj][m][n], 0, 0, 0); __builtin_amdgcn_s_setprio(0); } while (0)
#define PG8_WAIT_V(n) asm volatile("s_waitcnt vmcnt(" #n ")" ::: "memory")
#define PG8_WAIT_L(n) asm volatile("s_waitcnt lgkmcnt(" #n ")" ::: "memory")
#define PG8_BAR __builtin_amdgcn_s_barrier()
#define PG8_SCHED __builtin_amdgcn_sched_barrier(0)
    Unit cur, nxt; int ui = 0;
    if (!S.next(0, cur)) return;
    f32x4 acc[2][2][4][2];
#pragma unroll
    for (int a = 0; a < 2; ++a)
#pragma unroll
        for (int b = 0; b < 2; ++b)
#pragma unroll
            for (int m = 0; m < 4; ++m)
#pragma unroll
                for (int n = 0; n < 2; ++n) acc[a][b][m][n] = (f32x4){0.f, 0.f, 0.f, 0.f};
    bf16x8 At[4][2], B0[2][2], B1[2][2];
    const char* cA = (const char*)g.A + (GATHER ? (size_t)0 : (size_t)cur.pm * tstep); const char* cB = (const char*)g.Bt + (size_t)cur.pn * tstep;
    if constexpr (GATHER) PG8_GLOOK(cur, vA0, vA1);
    S.a_ready(cur);
    if constexpr (SP2) {
        PG8_STAGE(PG8_SB(0, 0), cB, voffB); PG8_STAGE(PG8_SB(0, 1), cB + hstep, voffB);
        if constexpr (GATHER) { PG8_STAGE(PG8_SA(0, 0), cA, vA0); PG8_STAGE(PG8_SA(0, 1), cA, vA1); } else { PG8_STAGE(PG8_SA(0, 0), cA, voffA); PG8_STAGE(PG8_SA(0, 1), cA + hstep, voffA); }
        if (wr == 1) PG8_BAR;
        PG8_WAIT_V(2); PG8_BAR;
        PG8_STAGE(PG8_SB(1, 0), cB + kstep, voffB); if constexpr (GATHER) PG8_STAGE(PG8_SA(1, 0), cA + kstep, vA0); else PG8_STAGE(PG8_SA(1, 0), cA + kstep, voffA); PG8_STAGE(PG8_SB(1, 1), cB + hstep + kstep, voffB);
        PG8_WAIT_V(6); PG8_BAR;
    } else {
        PG8_STAGE(PG8_SB(0, 0), cB, voffB); PG8_STAGE(PG8_SA(0, 0), cA, voffA); PG8_STAGE(PG8_SB(0, 1), cB + hstep, voffB); PG8_STAGE(PG8_SA(0, 1), cA + hstep, voffA);
        if (wr == 1) PG8_BAR;
        PG8_WAIT_V(4); PG8_BAR;
        PG8_STAGE(PG8_SB(1, 0), cB + kstep, voffB); PG8_STAGE(PG8_SA(1, 0), cA + kstep, voffA); PG8_STAGE(PG8_SB(1, 1), cB + hstep + kstep, voffB);
        PG8_WAIT_V(6); PG8_BAR;
    }
    for (;;) {
        const bool has_next = S.next(ui + 1, nxt);
        const char* nA = (has_next && !GATHER) ? (const char*)g.A + (size_t)nxt.pm * tstep : cA; const char* nB = has_next ? (const char*)g.Bt + (size_t)nxt.pn * tstep : cB;
        if constexpr (GATHER) { if (has_next) PG8_GLOOK(nxt, nvA0, nvA1); else { nvA0[0] = vA0[0]; nvA0[1] = vA0[1]; nvA1[0] = vA1[0]; nvA1[1] = vA1[1]; } }
#pragma unroll 1
        for (int t = 0; t < nt; t += 2) {
            const bool last = (t == nt - 2);
            const char* a1 = cA + (size_t)(t + 1) * kstep;
            const char* a2 = last ? nA : cA + (size_t)(t + 2) * kstep; const char* b2 = last ? nB : cB + (size_t)(t + 2) * kstep;
            const char* a3 = a2 + kstep; const char* b3 = b2 + kstep;
            if (last && has_next) S.a_ready(nxt);
            if constexpr (SP2) {
            PG8_LDB(B0, 0, 0); PG8_LDB(B1, 0, 1); PG8_SCHED; PG8_LDA(At, 0, 0); if constexpr (GATHER) PG8_STAGE(PG8_SA(1, 1), a1, vA1); else PG8_STAGE(PG8_SA(1, 1), a1 + hstep, voffA);
            PG8_WAIT_V(8); PG8_WAIT_L(0); PG8_BAR; PG8_MMA(0, 0, At, B0); PG8_MMA(0, 1, At, B1); PG8_BAR; PG8_SCHED;
            PG8_LDA(At, 0, 1); PG8_STAGE(PG8_SB(0, 0), b2, voffB); PG8_STAGE(PG8_SB(0, 1), b2 + hstep, voffB); if constexpr (GATHER) { unsigned v_[2] = {last ? nvA0[0] : vA0[0], last ? nvA0[1] : vA0[1]}; PG8_STAGE(PG8_SA(0, 0), a2, v_); } else PG8_STAGE(PG8_SA(0, 0), a2, voffA);
            PG8_WAIT_V(8); PG8_WAIT_L(0); PG8_BAR; PG8_MMA(1, 0, At, B0); PG8_MMA(1, 1, At, B1); PG8_BAR; PG8_SCHED;
            PG8_LDB(B0, 1, 0); PG8_LDB(B1, 1, 1); PG8_SCHED; PG8_LDA(At, 1, 0); if constexpr (GATHER) { unsigned v_[2] = {last ? nvA1[0] : vA1[0], last ? nvA1[1] : vA1[1]}; PG8_STAGE(PG8_SA(0, 1), a2, v_); } else PG8_STAGE(PG8_SA(0, 1), a2 + hstep, voffA);
            PG8_WAIT_V(8); PG8_WAIT_L(0); PG8_BAR; PG8_MMA(0, 0, At, B0); PG8_MMA(0, 1, At, B1); PG8_BAR; PG8_SCHED;
            PG8_LDA(At, 1, 1); PG8_STAGE(PG8_SB(1, 0), b3, voffB); PG8_STAGE(PG8_SB(1, 1), b3 + hstep, voffB); if constexpr (GATHER) { unsigned v_[2] = {last ? nvA0[0] : vA0[0], last ? nvA0[1] : vA0[1]}; PG8_STAGE(PG8_SA(1, 0), a3, v_); } else PG8_STAGE(PG8_SA(1, 0), a3, voffA);
            PG8_WAIT_V(8); PG8_WAIT_L(0); PG8_BAR; PG8_MMA(1, 0, At, B0); PG8_MMA(1, 1, At, B1); PG8_BAR; PG8_SCHED;
            } else {
            PG8_LDB(B0, 0, 0); PG8_SCHED; PG8_LDA(At, 0, 0); PG8_STAGE(PG8_SA(1, 1), a1 + hstep, voffA);
            PG8_WAIT_L(8); PG8_BAR; PG8_WAIT_L(0); PG8_MMA(0, 0, At, B0); PG8_BAR; PG8_SCHED;
            PG8_LDB(B1, 0, 1); PG8_STAGE(PG8_SB(0, 0), b2, voffB);
            PG8_BAR; PG8_WAIT_L(0); PG8_MMA(0, 1, At, B1); PG8_BAR;
            PG8_LDA(At, 0, 1); PG8_STAGE(PG8_SA(0, 0), a2, voffA);
            PG8_BAR; PG8_WAIT_L(0); PG8_MMA(1, 0, At, B0); PG8_BAR; PG8_SCHED;
            PG8_STAGE(PG8_SB(0, 1), b2 + hstep, voffB);
            PG8_WAIT_V(6); PG8_BAR; PG8_MMA(1, 1, At, B1); PG8_BAR;
            PG8_LDB(B0, 1, 0); PG8_SCHED; PG8_LDA(At, 1, 0); PG8_STAGE(PG8_SA(0, 1), a2 + hstep, voffA);
            PG8_WAIT_L(8); PG8_BAR; PG8_WAIT_L(0); PG8_MMA(0, 0, At, B0); PG8_BAR; PG8_SCHED;
            PG8_LDB(B1, 1, 1); PG8_STAGE(PG8_SB(1, 0), b3, voffB);
            PG8_BAR; PG8_WAIT_L(0); PG8_MMA(0, 1, At, B1); PG8_BAR;
            PG8_LDA(At, 1, 1); PG8_STAGE(PG8_SA(1, 0), a3, voffA);
            PG8_BAR; PG8_WAIT_L(0); PG8_MMA(1, 0, At, B0); PG8_BAR; PG8_SCHED;
            PG8_STAGE(PG8_SB(1, 1), b3 + hstep, voffB);
            PG8_WAIT_V(6); PG8_BAR; PG8_MMA(1, 1, At, B1); PG8_BAR;
            }
        }
        if constexpr (ALIGN_EPI) { if (wr == 0) PG8_BAR; }
        if constexpr (!Epi::AFTER_DRAIN) { E(acc, cur, wr, wc, fr, fq); S.done(cur); }
        if (!has_next) break;
#pragma unroll
        for (int a = 0; a < 2; ++a)
#pragma unroll
            for (int b = 0; b < 2; ++b)
#pragma unroll
                for (int m = 0; m < 4; ++m)
#pragma unroll
                    for (int n = 0; n < 2; ++n) acc[a][b][m][n] = (f32x4){0.f, 0.f, 0.f, 0.f};
        cur = nxt; cA = nA; cB = nB; ++ui;
        if constexpr (GATHER) { vA0[0] = nvA0[0]; vA0[1] = nvA0[1]; vA1[0] = nvA1[0]; vA1[1] = nvA1[1]; }
        if constexpr (ALIGN_EPI) { if (wr == 1) PG8_BAR; }
    }
    PG8_WAIT_V(0);
    if constexpr (!ALIGN_EPI) { if (wr == 0) PG8_BAR; }
    PG8_BAR;
    if constexpr (Epi::AFTER_DRAIN) { E.fused(acc, cur, wr, wc, fr, fq, lds, wid, lane); S.done(cur); }
#undef PG8_GLOOK
#undef PG8_SA
#undef PG8_SB
#undef PG8_STAGE
#undef PG8_LDA
#undef PG8_LDB
#undef PG8_MMA
#undef PG8_WAIT_V
#undef PG8_WAIT_L
#undef PG8_BAR
#undef PG8_SCHED
}
}
#define GAS __attribute__((address_space(1)))
#define LAS __attribute__((address_space(3)))
typedef unsigned short bf16;
typedef unsigned v4u __attribute__((ext_vector_type(4)));
typedef float f32x4 __attribute__((ext_vector_type(4)));
typedef short bf16x8 __attribute__((ext_vector_type(8)));
typedef GAS unsigned gu32;
typedef GAS unsigned long long gu64;
#define RLX_AGENT __ATOMIC_RELAXED, __HIP_MEMORY_SCOPE_AGENT
#define LDS_WAIT() asm volatile("s_waitcnt lgkmcnt(0)" ::: "memory")
#define VM_WAIT() asm volatile("s_waitcnt vmcnt(0)" ::: "memory")
__device__ __forceinline__ unsigned long long rt() { return __builtin_amdgcn_s_memrealtime(); }
typedef __bf16 bf16x2_hw __attribute__((ext_vector_type(2)));
__device__ __forceinline__ unsigned pk2(float lo, float hi) { bf16x2_hw v; v.x = (__bf16)lo; v.y = (__bf16)hi; return __builtin_bit_cast(unsigned, v); }
__device__ __forceinline__ unsigned f2bf(float f) { return pk2(f, 0.f) & 0xffffu; }

#define XB_TMO      128
#define XB_XCNT(j)  (256  + 64 * (j))
#define XB_XSUB(j)  (1280 + 64 * (j))
#define XB_XGEN(j)  (2304 + 64 * (j))
#define XB_TOP      3328
#define XB_TOPGEN   3392
#define XCD_BAR_WORDS 3456
#define XB_SPIN_CAP (1u << 18)

__device__ __forceinline__ unsigned xb_ld(unsigned* p)              { return __hip_atomic_load(p, __ATOMIC_RELAXED, __HIP_MEMORY_SCOPE_AGENT); }
__device__ __forceinline__ unsigned xb_add(unsigned* p, unsigned v) { return __hip_atomic_fetch_add(p, v, __ATOMIC_RELAXED, __HIP_MEMORY_SCOPE_AGENT); }
__device__ __forceinline__ unsigned xb_xcc_id() { return (unsigned)__builtin_amdgcn_s_getreg((3 << 11) | 20) & 0xFu; }
#define XB_SPIN(cond, bar) do { unsigned _sp = 0; while (cond) { __builtin_amdgcn_s_sleep(1); \
    if ((++_sp & 255u) == 0u) { if (xb_ld(&(bar)[XB_TMO])) break; if (_sp > XB_SPIN_CAP) { atomicAdd(&(bar)[XB_TMO], 1u); break; } } } } while (0)

struct XcdBarrier {
    unsigned* bar; unsigned x;
    volatile LAS unsigned* st;
};

__device__ __forceinline__ XcdBarrier xcd_barrier_post(unsigned* bar, volatile LAS unsigned* st) {
    XcdBarrier b; b.bar = bar; b.x = xb_xcc_id(); b.st = st;
    if (threadIdx.x == 0) (void)xb_add(&bar[XB_XCNT(b.x)], 1u);
    return b;
}
__device__ __forceinline__ void xcd_barrier_complete(unsigned* bar, unsigned x, unsigned& nloc, unsigned& nx) {
    const unsigned G = gridDim.x * gridDim.y * gridDim.z;
    unsigned sum, cnt, mine, sp = 0u;
    for (;;) {
        sum = 0u; cnt = 0u; mine = 0u;
#pragma unroll
        for (unsigned j = 0; j < 16; ++j) { const unsigned c = xb_ld(&bar[XB_XCNT(j)]); sum += c; cnt += (c > 0u) ? 1u : 0u; mine = (j == x) ? c : mine; }
        if (sum == G) break;
        __builtin_amdgcn_s_sleep(1);
        if ((++sp & 255u) == 0u) { if (xb_ld(&bar[XB_TMO])) break; if (sp > XB_SPIN_CAP) { atomicAdd(&bar[XB_TMO], 1u); break; } }
    }
    nloc = mine > 0u ? mine : 1u; nx = cnt > 0u ? cnt : 1u;
}

__device__ __forceinline__ void xcd_barrier(const XcdBarrier& b) {
    asm volatile("s_waitcnt vmcnt(0)" ::: "memory");
    __syncthreads();
    if (threadIdx.x == 0) {
        unsigned* bar = b.bar;
        __builtin_amdgcn_s_waitcnt(0);
        unsigned nloc = b.st[0], nx = b.st[1];
        if (nloc == 0u) { xcd_barrier_complete(bar, b.x, nloc, nx); b.st[0] = nloc; b.st[1] = nx; }
        const unsigned old = xb_add(&bar[XB_XSUB(b.x)], 1u);
        const unsigned gen = old / nloc;
        if (old + 1u == (gen + 1u) * nloc) {
            __builtin_amdgcn_fence(__ATOMIC_RELEASE, "agent");
            asm volatile("s_waitcnt vmcnt(0)" ::: "memory");
            const unsigned og = xb_add(&bar[XB_TOP], 1u);
            const unsigned tg = og / nx;
            if (og + 1u == (tg + 1u) * nx) xb_add(&bar[XB_TOPGEN], 1u);
            else XB_SPIN(xb_ld(&bar[XB_TOPGEN]) == tg, bar);
            __builtin_amdgcn_fence(__ATOMIC_ACQUIRE, "agent");
            xb_add(&bar[XB_XGEN(b.x)], 1u);
            asm volatile("s_waitcnt vmcnt(0)" ::: "memory");
        } else {
            XB_SPIN(xb_ld(&bar[XB_XGEN(b.x)]) == gen, bar);
            __builtin_amdgcn_fence(__ATOMIC_ACQUIRE, "agent");
            asm volatile("s_waitcnt vmcnt(0)" ::: "memory");
        }
    }
    __syncthreads();
}
constexpr int NWAVES = 8, NTHR = NWAVES * 64;
constexpr int D = 1024, BATCH = 4, SEQ = 4096, M = BATCH * SEQ, DEPTH = 4;
constexpr int IN_COLS = 6680, NPROJ = 6912;
constexpr int O_Z = 0, O_XBC = 1024, O_DT = 2560, O_QKV = 2576, O_GG = 4112, O_GB = 4624, O_GA = 4628, O_HQ = 4632, O_HF = 5144, O_HI = 5656, O_HG = 6168;
constexpr int DMIX = 2048, NEXP = 16, DEXP = 256, NGU = NEXP * 2 * DEXP  , KDN = NEXP * DEXP  ;
constexpr float DN_ALPHA = 1.6817928305074290f;
constexpr float LN_EPS = 1e-5f;

constexpr size_t MiB = 1u << 20;
constexpr size_t WS_CTL = 0, CTL_ZERO_BYTES = 1 * MiB;
constexpr size_t WS_LTOK = 2 * MiB;
constexpr size_t WS_LW = 3 * MiB;
constexpr size_t WS_SLOT = 4 * MiB;
constexpr size_t WS_WSORT = 5 * MiB;
constexpr size_t WS_WIN = 8 * MiB;
constexpr size_t WS_WOUT = 22 * MiB;
constexpr size_t WS_WGU = 26 * MiB;
constexpr size_t WS_WDN = 42 * MiB;
constexpr size_t WS_YMIX = 52 * MiB;
constexpr size_t WS_HB = WS_YMIX;
constexpr size_t WS_PROJ = 116 * MiB;
constexpr size_t WS_MIX = WS_PROJ;
constexpr int MAXROWS = 2 * M + 16 * 256;
constexpr size_t WS_XS = WS_PROJ + 64 * MiB;
constexpr size_t WS_HS = WS_PROJ + 136 * MiB;
constexpr size_t WS_YS = WS_PROJ + 154 * MiB;
constexpr int CW_CNT = 8192;
constexpr int LDS_OFF_TAB = 131072 + 1024;
constexpr size_t WS_SCR = 332 * MiB;
constexpr size_t WS_HG_QG = WS_SCR;
constexpr size_t WS_HG_KDT = WS_SCR + 16 * MiB;
constexpr size_t WS_HG_A = WS_SCR + 32 * MiB;
constexpr size_t WS_HG_GL = WS_SCR + 40 * MiB;
constexpr size_t WS_SSD_C = WS_SCR + 41 * MiB;
constexpr size_t WS_SSD_BT = WS_SCR + 49 * MiB;
constexpr size_t WS_SSD_CB = WS_SCR + 57 * MiB;
constexpr size_t WS_SSD_XT = WS_SCR + 65 * MiB;
constexpr size_t WS_SSD_AC = WS_SCR + 97 * MiB;
constexpr size_t WS_SSD_DT = WS_SCR + 98 * MiB;
constexpr size_t WS_GD_K = WS_SCR + 99 * MiB;
constexpr size_t WS_GD_KT = WS_SCR + 115 * MiB;
constexpr size_t WS_GD_QG = WS_SCR + 131 * MiB;
constexpr size_t WS_GD_VT = WS_SCR + 147 * MiB;
constexpr size_t WS_GD_T = WS_SCR + 163 * MiB;
constexpr size_t WS_GD_QK = WS_SCR + 171 * MiB;
constexpr size_t WS_GD_VEC = WS_SCR + 179 * MiB;
constexpr size_t WS_END = 512 * MiB;
constexpr int CW_BAR = 4096;

constexpr int RING_OFF = 0, RING_BYTES = 131072;
constexpr int LDSCTL_OFF = RING_BYTES, MISC_OFF = LDSCTL_OFF + 320;
constexpr int LDS_BYTES = 147456;

__device__ __forceinline__ float bf2f(unsigned short b) { return __builtin_bit_cast(float, ((unsigned)b) << 16); }
__device__ __forceinline__ float bflo(unsigned w) { return __builtin_bit_cast(float, w << 16); }
__device__ __forceinline__ float bfhi(unsigned w) { return __builtin_bit_cast(float, w & 0xffff0000u); }
__device__ __forceinline__ float siluf(float x) { return x * __builtin_amdgcn_rcpf(1.0f + __expf(-x)); }
__device__ __forceinline__ float sigmoidf_(float x) { return __builtin_amdgcn_rcpf(1.0f + __expf(-x)); }
__device__ __forceinline__ float softplusf_(float x) { return x > 20.f ? x : log1pf(__expf(x)); }
#define DPP_ADD(v, ctrl) ((v) + __builtin_bit_cast(float, __builtin_amdgcn_update_dpp(0, __builtin_bit_cast(int, (v)), (ctrl), 0xf, 0xf, false)))
__device__ __forceinline__ float wave_sum(float v) {
    v = DPP_ADD(v, 0xB1);
    v = DPP_ADD(v, 0x4E);
    v = DPP_ADD(v, 0x141);
    v = DPP_ADD(v, 0x140);
    const int iv = __builtin_bit_cast(int, v);
    return (__builtin_bit_cast(float, __builtin_amdgcn_readlane(iv, 0)) + __builtin_bit_cast(float, __builtin_amdgcn_readlane(iv, 16))) + (__builtin_bit_cast(float, __builtin_amdgcn_readlane(iv, 32)) + __builtin_bit_cast(float, __builtin_amdgcn_readlane(iv, 48)));
}
__device__ __forceinline__ float row16_sum(float v) {
    v = DPP_ADD(v, 0xB1); v = DPP_ADD(v, 0x4E); v = DPP_ADD(v, 0x141); v = DPP_ADD(v, 0x140); return v;
}

struct Args {
    const float* in[25]; float* out; unsigned char* ws; int ph_lo, ph_hi;
};
typedef const __attribute__((address_space(4))) Args* CArgs;
#define ARGS_HERE() ([]() { CArgs p_ = (CArgs)__builtin_amdgcn_kernarg_segment_ptr(); asm volatile("" : "+s"(p_)); return p_; }())
enum { I_X = 0, I_WIN, I_SCW, I_SCB, I_SDTB, I_SALOG, I_SD, I_SNW, I_GCW, I_GDTB, I_GALOG, I_GNW, I_HLB, I_HNW, I_WOUT, I_LN1G, I_LN1B, I_WRG, I_BRG, I_WRE, I_BRE, I_WGU, I_WDN, I_LN2G, I_LN2B };

__device__ __forceinline__ void transpose_item(const float* W, int ldw, int nvalid, int k0, int n0, bf16* WT, size_t ldt, int drow0, int dk0, LAS float* scr, int lane) {
#pragma unroll 8
    for (int i = 0; i < 32; ++i) { const int kk = 2 * i + (lane >> 5), nn = lane & 31, n = n0 + nn; scr[kk * 33 + nn] = (n < nvalid) ? W[(size_t)(k0 + kk) * ldw + n] : 0.f; }
    LDS_WAIT(); asm volatile("" ::: "memory");
    const int c = lane & 7;
#pragma unroll
    for (int j = 0; j < 4; ++j) { const int n = (lane >> 3) + 8 * j; const LAS float* s = scr + (8 * c) * 33 + n;
        v4u o; o.x = pk2(s[0 * 33], s[1 * 33]); o.y = pk2(s[2 * 33], s[3 * 33]); o.z = pk2(s[4 * 33], s[5 * 33]); o.w = pk2(s[6 * 33], s[7 * 33]);
        *(GAS v4u*)(WT + (size_t)(drow0 + n) * ldt + dk0 + k0 + 8 * c) = o; }
    LDS_WAIT(); asm volatile("" ::: "memory");
}
__device__ __forceinline__ void weights_phase(CArgs a, int l, const int which, LAS unsigned char* lds, int wwg, int nwg, int tid) {
    asm volatile("" : "+v"(tid));
    const int lane = tid & 63, wave = tid >> 6, gw = wwg * NWAVES + wave, NGW = nwg * NWAVES;
    LAS float* scr = (LAS float*)(lds + wave * 16384);
    constexpr int I_IN = 16 * (NPROJ / 32), I_OUT = (DMIX / 64) * (D / 32), I_GU = NEXP * 16 * 16, I_DN = NEXP * 4 * 32;
    const int n_in = (which & 1) ? I_IN : 0, n_out = (which & 2) ? I_OUT : 0, n_gu = (which & 4) ? I_GU : 0, n_dn = (which & 8) ? I_DN : 0;
    unsigned char* ws = a->ws;
    for (int it = gw; it < n_in + n_out + n_gu + n_dn; it += NGW) {
        int r = it;
        if (r < n_in) { const int kb = r / (NPROJ / 32), nb = r % (NPROJ / 32);
            transpose_item(a->in[I_WIN] + (size_t)l * D * IN_COLS, IN_COLS, IN_COLS, 64 * kb, 32 * nb, (bf16*)(ws + WS_WIN), D, 32 * nb, 0, scr, lane); continue; }
        r -= n_in;
        if (r < n_out) { const int kb = r / (D / 32), nb = r % (D / 32);
            transpose_item(a->in[I_WOUT] + (size_t)l * DMIX * D, D, D, 64 * kb, 32 * nb, (bf16*)(ws + WS_WOUT), DMIX, 32 * nb, 0, scr, lane); continue; }
        r -= n_out;
        if (r < n_gu) { const int e = r / 256, q = r % 256, kb = q / 16, nb = q % 16, c0 = 32 * nb, bj = c0 / 256, hf = (c0 % 256) / 128, j0 = c0 % 128;
            transpose_item(a->in[I_WGU] + (size_t)(l * NEXP + e) * D * 512, 512, 512, 64 * kb, c0, (bf16*)(ws + WS_WGU), D, e * 512 + hf * 256 + bj * 128 + j0, 0, scr, lane); continue; }
        r -= n_gu;
        { const int e = r / 128, q = r % 128, kb = q / 32, nb = q % 32;
            transpose_item(a->in[I_WDN] + (size_t)(l * NEXP + e) * DEXP * D, D, D, 64 * kb, 32 * nb, (bf16*)(ws + WS_WDN), DEXP, e * D + 32 * nb, 0, scr, lane); }
    }
}
__device__ __forceinline__ void p0_prologue(CArgs a, LAS unsigned char* lds, int wg, int G, int tid) {
    asm volatile("" : "+v"(tid));
    const f32x4* x4 = (const f32x4*)a->in[I_X]; f32x4* h4 = (f32x4*)a->out; unsigned long long* hb8 = (unsigned long long*)(a->ws + WS_HB);
    for (size_t i = (size_t)wg * NTHR + tid; i < (size_t)M * D / 4; i += (size_t)G * NTHR) { const f32x4 v = x4[i]; (void)h4;
        hb8[i] = (unsigned long long)pk2(v.x, v.y) | ((unsigned long long)pk2(v.z, v.w) << 32); }
}

#define WG_BAR() do { asm volatile("s_waitcnt lgkmcnt(0)" ::: "memory"); __builtin_amdgcn_s_barrier(); asm volatile("" ::: "memory"); } while (0)
__device__ __forceinline__ f32x4 mfma16(bf16x8 x, bf16x8 y, f32x4 c) { return __builtin_amdgcn_mfma_f32_16x16x32_bf16(x, y, c, 0, 0, 0); }
__device__ __forceinline__ bf16x8 lds_frag(const LAS bf16* base, int row0, int stride, int k0, int lane) { return *(const LAS bf16x8*)(base + (row0 + (lane & 15)) * stride + k0 + 8 * (lane >> 4)); }
__device__ __forceinline__ bf16x8 pack8(const float* v) { v4u w; w.x = pk2(v[0], v[1]); w.y = pk2(v[2], v[3]); w.z = pk2(v[4], v[5]); w.w = pk2(v[6], v[7]); return __builtin_bit_cast(bf16x8, w); }
__device__ __forceinline__ unsigned long long pack4(f32x4 v) { return (unsigned long long)pk2(v[0], v[1]) | ((unsigned long long)pk2(v[2], v[3]) << 32); }

__device__ __forceinline__ void hgrn_prep_phase(CArgs a, int l, LAS unsigned char* lds, int wg, int G, int tid) {
    asm volatile("" : "+v"(tid));
    constexpr int LS = 132;
    LAS float* sQ = (LAS float*)lds; LAS float* sK = sQ + 64 * LS; LAS float* sB = sK + 64 * LS; LAS float* sT = sB + 64 * LS; LAS float* sLb = sT + 512;
    const bf16* PROJ = (const bf16*)(a->ws + WS_PROJ);
    const int lane = tid & 63, w = tid >> 6, r = lane & 15, q4 = lane >> 4;
    for (int unit = wg; unit < 1024; unit += G) {
        const int b = unit >> 8, head = (unit >> 6) & 3, c = unit & 63;
        const size_t row0 = (size_t)b * SEQ + c * 64;
        __syncthreads();
        if (tid < 128) {
            const int ch = head * 128 + tid; float lg[DEPTH], mx = -1e30f;
#pragma unroll
            for (int j = 0; j < DEPTH; ++j) { lg[j] = a->in[I_HLB][j * 512 + ch]; mx = fmaxf(mx, lg[j]); }
            float den = 0.f, num = 0.f;
#pragma unroll
            for (int j = 0; j < DEPTH; ++j) { const float e = __expf(lg[j] - mx); den += e; if (j >= 1 && j <= l) num += e; }
            sLb[tid] = num / den;
        }
        __syncthreads();
        for (int p = tid; p < 1024; p += NTHR) {
            const int t = p >> 4, d8 = (p & 15) * 8;
            const v4u qv = *(const GAS v4u*)(PROJ + (row0 + t) * NPROJ + O_HQ + head * 128 + d8), fv = *(const GAS v4u*)(PROJ + (row0 + t) * NPROJ + O_HF + head * 128 + d8);
            const f32x4 lbA = *(const LAS f32x4*)(sLb + d8), lbB = *(const LAS f32x4*)(sLb + d8 + 4); float qo[8], ko[8], bo[8];
#pragma unroll
            for (int i = 0; i < 4; ++i) {
                const float lb0 = (2 * i < 4) ? lbA[(2 * i) & 3] : lbB[(2 * i) & 3], lb1 = (2 * i + 1 < 4) ? lbA[(2 * i + 1) & 3] : lbB[(2 * i + 1) & 3];
                qo[2 * i] = siluf(bflo(qv[i])); qo[2 * i + 1] = siluf(bfhi(qv[i]));
                const float f0 = lb0 + (1.f - lb0) * sigmoidf_(bflo(fv[i])), f1 = lb1 + (1.f - lb1) * sigmoidf_(bfhi(fv[i]));
                ko[2 * i] = 1.f - f0; ko[2 * i + 1] = 1.f - f1; bo[2 * i] = __logf(f0); bo[2 * i + 1] = __logf(f1);
            }
            *(LAS f32x4*)(sQ + t * LS + d8) = (f32x4){qo[0], qo[1], qo[2], qo[3]}; *(LAS f32x4*)(sQ + t * LS + d8 + 4) = (f32x4){qo[4], qo[5], qo[6], qo[7]};
            *(LAS f32x4*)(sK + t * LS + d8) = (f32x4){ko[0], ko[1], ko[2], ko[3]}; *(LAS f32x4*)(sK + t * LS + d8 + 4) = (f32x4){ko[4], ko[5], ko[6], ko[7]};
            *(LAS f32x4*)(sB + t * LS + d8) = (f32x4){bo[0], bo[1], bo[2], bo[3]}; *(LAS f32x4*)(sB + t * LS + d8 + 4) = (f32x4){bo[4], bo[5], bo[6], bo[7]};
        }
        __syncthreads();
        {
            const int d = tid & 127, seg = tid >> 7; float run = 0.f, vals[16];
#pragma unroll
            for (int i = 0; i < 16; ++i) { run += sB[(seg * 16 + i) * LS + d]; vals[i] = run; }
            sT[seg * 128 + d] = run;
            __syncthreads();
            float off = 0.f;
#pragma unroll
            for (int s2 = 0; s2 < 3; ++s2) if (s2 < seg) off += sT[s2 * 128 + d];
#pragma unroll
            for (int i = 0; i < 16; ++i) sB[(seg * 16 + i) * LS + d] = vals[i] + off;
        }
        __syncthreads();
        bf16* qg = (bf16*)(a->ws + WS_HG_QG) + (size_t)unit * 64 * 128; bf16* kdt = (bf16*)(a->ws + WS_HG_KDT) + (size_t)unit * 128 * 64;
        bf16* am = (bf16*)(a->ws + WS_HG_A) + (size_t)unit * 64 * 64; float* gl = (float*)(a->ws + WS_HG_GL) + (size_t)unit * 128;
        for (int p = tid; p < 1024; p += NTHR) { const int t = p >> 4, d8 = (p & 15) * 8; float v[8];
            const f32x4 q0 = *(const LAS f32x4*)(sQ + t * LS + d8), q1 = *(const LAS f32x4*)(sQ + t * LS + d8 + 4), b0 = *(const LAS f32x4*)(sB + t * LS + d8), b1 = *(const LAS f32x4*)(sB + t * LS + d8 + 4);
#pragma unroll
            for (int jj = 0; jj < 4; ++jj) { v[jj] = q0[jj] * __expf(b0[jj]); v[4 + jj] = q1[jj] * __expf(b1[jj]); }
            *(GAS bf16x8*)(qg + t * 128 + d8) = pack8(v); }
        for (int p = tid; p < 1024; p += NTHR) { const int d = p >> 3, s8 = (p & 7) * 8; const float bl = sB[63 * LS + d]; float v[8];
#pragma unroll
            for (int jj = 0; jj < 8; ++jj) v[jj] = sK[(s8 + jj) * LS + d] * __expf(bl - sB[(s8 + jj) * LS + d]);
            *(GAS bf16x8*)(kdt + d * 64 + s8) = pack8(v); }
        if (tid < 128) gl[tid] = __expf(sB[63 * LS + tid]);
        for (int p = w; p < 16; p += NWAVES) {
            const int i = p >> 2, j = p & 3; f32x4 acc = {0.f, 0.f, 0.f, 0.f};
            if (j <= i) {
#pragma unroll
                for (int ks = 0; ks < 4; ++ks) { const int d0 = 32 * ks + 8 * q4, t = 16 * i + r, s_ = 16 * j + r; float qf[8], kf[8];
                    const int rrow = i ? 16 * i - 1 : 0;
#pragma unroll
                    for (int hh = 0; hh < 2; ++hh) { const int dd = d0 + 4 * hh;
                        f32x4 rf = *(const LAS f32x4*)(sB + rrow * LS + dd); if (!i) rf = (f32x4){0.f, 0.f, 0.f, 0.f};
                        const f32x4 qq = *(const LAS f32x4*)(sQ + t * LS + dd), bt = *(const LAS f32x4*)(sB + t * LS + dd), kk_ = *(const LAS f32x4*)(sK + s_ * LS + dd), bs = *(const LAS f32x4*)(sB + s_ * LS + dd);
#pragma unroll
                        for (int jj = 0; jj < 4; ++jj) { qf[4 * hh + jj] = qq[jj] * __expf(bt[jj] - rf[jj]); kf[4 * hh + jj] = kk_[jj] * __expf(rf[jj] - bs[jj]); } }
                    acc = mfma16(pack8(kf), pack8(qf), acc); }
                const int t = 16 * i + r;
#pragma unroll
                for (int ii = 0; ii < 4; ++ii) if (16 * j + 4 * q4 + ii > t) acc[ii] = 0.f;
            }
            *(GAS unsigned long long*)(am + (16 * i + r) * 64 + 16 * j + 4 * q4) = pack4(acc);
        }
    }
}
__device__ __forceinline__ void hgrn_scan_phase(CArgs a, int l, LAS unsigned char* lds, const int b, const int head, const int eb, int tid) {
    asm volatile("" : "+v"(tid));
    constexpr int QS = 136, KS = 72;
    constexpr int B_QG = 0, B_KDT = 17408, B_A = B_KDT + 18432, B_VT = B_A + 9216, B_GL = B_VT + 4608, BUF = B_GL + 512;
    LAS unsigned char* sST0 = lds + 2 * BUF;
    const bf16* PROJ = (const bf16*)(a->ws + WS_PROJ); bf16* YMIX = (bf16*)(a->ws + WS_YMIX);
    const int lane = tid & 63, w = tid >> 6, r = lane & 15, q4 = lane >> 4;
    {
        const size_t cu0 = (size_t)(b * 4 + head) * 64;
        const bf16* QG = (const bf16*)(a->ws + WS_HG_QG) + cu0 * 64 * 128; const bf16* KDT = (const bf16*)(a->ws + WS_HG_KDT) + cu0 * 128 * 64;
        const bf16* AM = (const bf16*)(a->ws + WS_HG_A) + cu0 * 64 * 64; const float* GL = (const float*)(a->ws + WS_HG_GL) + cu0 * 128;
        const bf16* VP = PROJ + (size_t)b * SEQ * NPROJ + O_HI + head * 128 + eb * 32;
        v4u rq[2], rk[2], ra, rv; f32x4 rg;
#define HG_LOAD(n) do { _Pragma("unroll") for (int i = 0; i < 2; ++i) { const int p = tid + NTHR * i; rq[i] = *(const GAS v4u*)(QG + (size_t)(n) * 8192 + (p >> 4) * 128 + (p & 15) * 8); \
            rk[i] = *(const GAS v4u*)(KDT + (size_t)(n) * 8192 + (p >> 3) * 64 + (p & 7) * 8); } \
            ra = *(const GAS v4u*)(AM + (size_t)(n) * 4096 + (tid >> 3) * 64 + (tid & 7) * 8); \
            if (tid < 256) rv = *(const GAS v4u*)(VP + (size_t)((n) * 64 + (tid >> 2)) * NPROJ + (tid & 3) * 8); \
            if (tid < 32) rg = *(const GAS f32x4*)(GL + (size_t)(n) * 128 + tid * 4); } while (0)
#define HG_STORE(bufp) do { LAS unsigned char* bp_ = (bufp); _Pragma("unroll") for (int i = 0; i < 2; ++i) { const int p = tid + NTHR * i; \
            *(LAS v4u*)(bp_ + B_QG + ((p >> 4) * QS + (p & 15) * 8) * 2) = rq[i]; *(LAS v4u*)(bp_ + B_KDT + ((p >> 3) * KS + (p & 7) * 8) * 2) = rk[i]; } \
            *(LAS v4u*)(bp_ + B_A + ((tid >> 3) * KS + (tid & 7) * 8) * 2) = ra; \
            if (tid < 256) { LAS bf16* vt = (LAS bf16*)(bp_ + B_VT); const int t_ = tid >> 2, e8 = (tid & 3) * 8; _Pragma("unroll") for (int i = 0; i < 4; ++i) { \
                vt[(e8 + 2 * i) * KS + t_] = (bf16)(rv[i] & 0xffffu); vt[(e8 + 2 * i + 1) * KS + t_] = (bf16)(rv[i] >> 16); } } \
            if (tid < 32) *(LAS f32x4*)(bp_ + B_GL + tid * 16) = rg; } while (0)
        __syncthreads();
        HG_LOAD(0);
        for (int i = tid; i < 8704 / 4; i += NTHR) ((LAS unsigned*)sST0)[i] = 0u;
        HG_STORE(lds);
        f32x4 accS[2] = {{0.f, 0.f, 0.f, 0.f}, {0.f, 0.f, 0.f, 0.f}};
        __syncthreads();
        for (int n = 0; n < 64; ++n) {
            const int cur = n & 1; LAS unsigned char* bp = lds + cur * BUF; LAS bf16* sST = (LAS bf16*)(sST0 + cur * 8704); LAS bf16* sSTn = (LAS bf16*)(sST0 + (cur ^ 1) * 8704);
            if (n + 1 < 64) HG_LOAD(n + 1);
            {
                const int tt = w >> 1, et = w & 1; f32x4 acc = {0.f, 0.f, 0.f, 0.f};
#pragma unroll
                for (int ks = 0; ks < 4; ++ks) acc = mfma16(lds_frag(sST, 16 * et, QS, 32 * ks, lane), lds_frag((LAS bf16*)(bp + B_QG), 16 * tt, QS, 32 * ks, lane), acc);
#pragma unroll
                for (int ks = 0; ks < 2; ++ks) acc = mfma16(lds_frag((LAS bf16*)(bp + B_VT), 16 * et, KS, 32 * ks, lane), lds_frag((LAS bf16*)(bp + B_A), 16 * tt, KS, 32 * ks, lane), acc);
                *(GAS unsigned long long*)(YMIX + ((size_t)b * SEQ + n * 64 + 16 * tt + r) * DMIX + 1536 + head * 128 + eb * 32 + 16 * et + 4 * q4) = pack4(acc);
            }
            {
                const f32x4 glv = *(const LAS f32x4*)(bp + B_GL + (16 * w + 4 * q4) * 4);
#pragma unroll
                for (int et = 0; et < 2; ++et) { accS[et] = accS[et] * glv;
#pragma unroll
                    for (int ks = 0; ks < 2; ++ks) accS[et] = mfma16(lds_frag((LAS bf16*)(bp + B_KDT), 16 * w, KS, 32 * ks, lane), lds_frag((LAS bf16*)(bp + B_VT), 16 * et, KS, 32 * ks, lane), accS[et]);
                    *(LAS unsigned long long*)(sSTn + (16 * et + r) * QS + 16 * w + 4 * q4) = pack4(accS[et]); }
            }
            if (n + 1 < 64) HG_STORE(lds + (cur ^ 1) * BUF);
            WG_BAR();
        }
#undef HG_LOAD
#undef HG_STORE
    }
}

__device__ __forceinline__ void ssd_rec_phase(CArgs a, int l, LAS unsigned char* lds, int wg, int G, int tid) {
    asm volatile("" : "+v"(tid));
    constexpr int TB = 64;
    LAS float* sX = (LAS float*)lds; LAS float* sB = sX + TB * 16; LAS float* sC = sB + TB * 128; LAS float* sDt = sC + TB * 128; LAS float* sDa = sDt + TB; LAS float* sY = sDa + TB;
    const bf16* PROJ = (const bf16*)(a->ws + WS_PROJ); bf16* YMIX = (bf16*)(a->ws + WS_YMIX);
    const float* cw = a->in[I_SCW] + (size_t)l * 4 * 1536; const float* cb = a->in[I_SCB] + (size_t)l * 1536;
    const int p_local = tid >> 5, nq = tid & 31;
    for (int unit = wg; unit < 256; unit += G) {
        const int b = unit >> 6, head = (unit >> 2) & 15, pq = unit & 3, g = head >> 3;
        const float A = -__expf(a->in[I_SALOG][l * 16 + head]), dtb = a->in[I_SDTB][l * 16 + head], Dsk = a->in[I_SD][l * 16 + head];
        float h0 = 0.f, h1 = 0.f, h2 = 0.f, h3 = 0.f;
        for (int t0 = 0; t0 < SEQ; t0 += TB) {
            __syncthreads();
            for (int idx = tid; idx < TB * 272; idx += NTHR) {
                const int tt = idx / 272, ci = idx % 272, t = t0 + tt;
                const int ch = ci < 16 ? head * 64 + pq * 16 + ci : (ci < 144 ? 1024 + g * 128 + (ci - 16) : 1280 + g * 128 + (ci - 144));
                float acc = cb[ch];
#pragma unroll
                for (int k = 0; k < 4; ++k) { const int ts = t - 3 + k; if (ts >= 0) acc += cw[k * 1536 + ch] * bf2f(PROJ[(size_t)(b * SEQ + ts) * NPROJ + O_XBC + ch]); }
                const float v = siluf(acc);
                if (ci < 16) sX[tt * 16 + ci] = v; else if (ci < 144) sB[tt * 128 + ci - 16] = v; else sC[tt * 128 + ci - 144] = v;
            }
            if (tid < TB) { const float raw = bf2f(PROJ[(size_t)(b * SEQ + t0 + tid) * NPROJ + O_DT + head]); const float dt = softplusf_(raw + dtb); sDt[tid] = dt; sDa[tid] = __expf(dt * A); }
            __syncthreads();
#pragma unroll 4
            for (int tt = 0; tt < TB; ++tt) {
                const float xv = sX[tt * 16 + p_local], da = sDa[tt], dx = sDt[tt] * xv;
                const f32x4 Bv = *(const LAS f32x4*)(sB + tt * 128 + nq * 4), Cv = *(const LAS f32x4*)(sC + tt * 128 + nq * 4);
                h0 = da * h0 + dx * Bv.x; h1 = da * h1 + dx * Bv.y; h2 = da * h2 + dx * Bv.z; h3 = da * h3 + dx * Bv.w;
                float part = (Cv.x * h0 + Cv.y * h1) + (Cv.z * h2 + Cv.w * h3);
                part += __shfl_xor(part, 1); part += __shfl_xor(part, 2); part += __shfl_xor(part, 4); part += __shfl_xor(part, 8); part += __shfl_xor(part, 16);
                if (nq == 0) sY[tt * 16 + p_local] = part + Dsk * xv;
            }
            __syncthreads();
            for (int idx = tid; idx < TB * 16; idx += NTHR) { const int tt = idx >> 4, i = idx & 15; YMIX[(size_t)(b * SEQ + t0 + tt) * DMIX + head * 64 + pq * 16 + i] = (bf16)f2bf(sY[idx]); }
        }
    }
}

__device__ __forceinline__ void ssd_prep_phase(CArgs a, int l, LAS unsigned char* lds, int wg, int G, int tid) {
    asm volatile("" : "+v"(tid));
    constexpr int PS = 136;
    LAS bf16* sB = (LAS bf16*)lds; LAS bf16* sC = sB + 128 * PS; LAS bf16* sXT = (LAS bf16*)lds; LAS float* sDt = (LAS float*)(lds + 2 * 128 * PS * 2); LAS bf16* sCB = (LAS bf16*)(lds + 2 * 128 * PS * 2 + 4096);
    const bf16* PROJ = (const bf16*)(a->ws + WS_PROJ);
    const float* cw = a->in[I_SCW] + (size_t)l * 4 * 1536; const float* cb = a->in[I_SCB] + (size_t)l * 1536;
    const int lane = tid & 63, w = tid >> 6, r = lane & 15, q4 = lane >> 4;
    for (int unit = wg; unit < 256; unit += G) {
        const int b = unit >> 6, c = (unit >> 1) & 31, g = unit & 1;
        const size_t row0 = (size_t)b * SEQ + c * 128;
        bf16* Cg = (bf16*)(a->ws + WS_SSD_C) + (size_t)unit * 16384; bf16* BTg = (bf16*)(a->ws + WS_SSD_BT) + (size_t)unit * 16384; bf16* CBg = (bf16*)(a->ws + WS_SSD_CB) + (size_t)unit * 16384;
        __syncthreads();
        {
            const int c16 = tid & 31, l0 = tid >> 5; const int ch = (c16 < 16 ? 1024 + g * 128 + c16 * 8 : 1280 + g * 128 + (c16 - 16) * 8);
            float wk[4][8], bias[8];
#pragma unroll
            for (int jj = 0; jj < 8; ++jj) { bias[jj] = cb[ch + jj];
#pragma unroll
                for (int k = 0; k < 4; ++k) wk[k][jj] = cw[k * 1536 + ch + jj]; }
            LAS bf16* dst = (c16 < 16 ? sB : sC) + (c16 & 15) * 8;
#pragma unroll 2
            for (int i = 0; i < 8; ++i) { const int ll = l0 + 16 * i; float acc[8];
#pragma unroll
                for (int jj = 0; jj < 8; ++jj) acc[jj] = bias[jj];
#pragma unroll
                for (int k = 0; k < 4; ++k) { const int ts = c * 128 + ll - 3 + k;
                    if (ts >= 0) { const v4u xv = *(const GAS v4u*)(PROJ + ((size_t)b * SEQ + ts) * NPROJ + O_XBC + ch);
#pragma unroll
                        for (int j = 0; j < 4; ++j) { acc[2 * j] += wk[k][2 * j] * bflo(xv[j]); acc[2 * j + 1] += wk[k][2 * j + 1] * bfhi(xv[j]); } } }
#pragma unroll
                for (int jj = 0; jj < 8; ++jj) acc[jj] = siluf(acc[jj]);
                *(LAS bf16x8*)(dst + ll * PS) = pack8(acc); }
        }
        {
            const int head = g * 8 + w; const float A = -__expf(a->in[I_SALOG][l * 16 + head]), dtb = a->in[I_SDTB][l * 16 + head];
            const int l2 = 2 * lane;
            const float dt0 = softplusf_(bf2f(PROJ[(row0 + l2) * NPROJ + O_DT + head]) + dtb), dt1 = softplusf_(bf2f(PROJ[(row0 + l2 + 1) * NPROJ + O_DT + head]) + dtb);
            const float da1 = dt1 * A; float sc = dt0 * A + da1;
#pragma unroll
            for (int o = 1; o < 64; o <<= 1) { const float t_ = __shfl_up(sc, o); if (lane >= o) sc += t_; }
            sDt[w * 128 + l2] = dt0; sDt[w * 128 + l2 + 1] = dt1;
            const size_t uh = (size_t)((b * 16 + head) * 32 + c) * 128;
            float* AC = (float*)(a->ws + WS_SSD_AC) + uh; float* DT = (float*)(a->ws + WS_SSD_DT) + uh;
            AC[l2] = sc - da1; AC[l2 + 1] = sc; DT[l2] = dt0; DT[l2 + 1] = dt1;
        }
        __syncthreads();
#pragma unroll
        for (int st = 0; st < 8; ++st) {
            f32x4 acc = {0.f, 0.f, 0.f, 0.f};
            if (st <= w) {
#pragma unroll
                for (int ks = 0; ks < 4; ++ks) acc = mfma16(lds_frag(sB, 16 * st, PS, 32 * ks, lane), lds_frag(sC, 16 * w, PS, 32 * ks, lane), acc); }
            *(LAS unsigned long long*)(sCB + (16 * w + r) * PS + 16 * st + 4 * q4) = pack4(acc);
        }
        __syncthreads();
        for (int f = w; f < 32; f += NWAVES) { const int tile = f >> 2, ks = f & 3;
            *(GAS v4u*)(Cg + f * 512 + lane * 8) = *(const LAS v4u*)(sC + (16 * tile + r) * PS + 32 * ks + 8 * q4);
            *(GAS v4u*)(CBg + f * 512 + lane * 8) = *(const LAS v4u*)(sCB + (16 * tile + r) * PS + 32 * ks + 8 * q4);
            const int n = 16 * tile + r, l0 = 32 * ks + 8 * q4; v4u o;
#pragma unroll
            for (int j = 0; j < 4; ++j) o[j] = (unsigned)sB[(l0 + 2 * j) * PS + n] | ((unsigned)sB[(l0 + 2 * j + 1) * PS + n] << 16);
            *(GAS v4u*)(BTg + f * 512 + lane * 8) = o; }
#pragma unroll 1
        for (int hf = 0; hf < 2; ++hf) {
            __syncthreads();
            {   const int cg = tid & 31, l0 = tid >> 5, chl = cg * 8, ch = g * 512 + hf * 256 + chl, hh = hf * 4 + (cg >> 3);
                float wk[4][8], bias[8];
#pragma unroll
                for (int jj = 0; jj < 8; ++jj) { bias[jj] = cb[ch + jj];
#pragma unroll
                    for (int k = 0; k < 4; ++k) wk[k][jj] = cw[k * 1536 + ch + jj]; }
#pragma unroll 2
                for (int i = 0; i < 8; ++i) { const int ll = l0 + 16 * i; float acc[8];
#pragma unroll
                    for (int jj = 0; jj < 8; ++jj) acc[jj] = bias[jj];
#pragma unroll
                    for (int k = 0; k < 4; ++k) { const int ts = c * 128 + ll - 3 + k;
                        if (ts >= 0) { const v4u xv = *(const GAS v4u*)(PROJ + ((size_t)b * SEQ + ts) * NPROJ + O_XBC + ch);
#pragma unroll
                            for (int j = 0; j < 4; ++j) { acc[2 * j] += wk[k][2 * j] * bflo(xv[j]); acc[2 * j + 1] += wk[k][2 * j + 1] * bfhi(xv[j]); } } }
                    const float dtv = sDt[hh * 128 + ll];
#pragma unroll
                    for (int jj = 0; jj < 8; ++jj) sXT[(chl + jj) * PS + ll] = (bf16)f2bf(siluf(acc[jj]) * dtv); }
            }
            __syncthreads();
            for (int p = tid; p < 4096; p += NTHR) { const int chl = p >> 4, l8 = (p & 15) * 8, hh = hf * 4 + (chl >> 6), pp = chl & 63;
                const size_t uh = (size_t)((b * 16 + g * 8 + hh) * 32 + c);
                *(GAS v4u*)((bf16*)(a->ws + WS_SSD_XT) + (uh * 64 + pp) * 128 + l8) = *(const LAS v4u*)(sXT + chl * PS + l8); }
        }
    }
}
__device__ __forceinline__ void ssd_scan_phase(CArgs a, int l, LAS unsigned char* lds, const int b, const int head, int tid) {
    asm volatile("" : "+v"(tid));
    constexpr int PS = 136, O_S = 0, O_X = 34816, O_AC = 69632, O_TE = 70656, O_DT = 71680;
    bf16* YMIX = (bf16*)(a->ws + WS_YMIX);
    const int lane = tid & 63, w = tid >> 6, r = lane & 15, q4 = lane >> 4;
    {
        const int g = head >> 3;
        const float Dsk = a->in[I_SD][l * 16 + head];
        const bf16* Cg = (const bf16*)(a->ws + WS_SSD_C) + (size_t)((b * 32) * 2 + g) * 16384 + (w * 4) * 512 + lane * 8;
        const bf16* CBg = (const bf16*)(a->ws + WS_SSD_CB) + (size_t)((b * 32) * 2 + g) * 16384 + (w * 4) * 512 + lane * 8;
        const bf16* BTg = (const bf16*)(a->ws + WS_SSD_BT) + (size_t)((b * 32) * 2 + g) * 16384 + (w * 4) * 512 + lane * 8;
        const size_t uh0 = (size_t)(b * 16 + head) * 32;
        const bf16* XTg = (const bf16*)(a->ws + WS_SSD_XT) + uh0 * 8192; const float* ACg = (const float*)(a->ws + WS_SSD_AC) + uh0 * 128; const float* DTg = (const float*)(a->ws + WS_SSD_DT) + uh0 * 128;
        v4u fC[4], fCB[4], fBT[4], rx[2]; float rac = 0.f, racl = 0.f, rdt = 0.f;
#define SSD_LDF(cc, dst, src) do { _Pragma("unroll") for (int ks = 0; ks < 4; ++ks) dst[ks] = *(const GAS v4u*)(src + (size_t)(cc) * 32768 + 512 * ks); } while (0)
#define SSD_LOADX(cc) do { _Pragma("unroll") for (int i = 0; i < 2; ++i) { const int p = tid + NTHR * i; rx[i] = *(const GAS v4u*)(XTg + (size_t)(cc) * 8192 + (p >> 4) * 128 + (p & 15) * 8); } \
            if (tid < 128) { rac = ACg[(cc) * 128 + tid]; racl = ACg[(cc) * 128 + 127]; rdt = DTg[(cc) * 128 + tid]; } } while (0)
#define SSD_STORE(bi) do { _Pragma("unroll") for (int i = 0; i < 2; ++i) { const int p = tid + NTHR * i; *(LAS v4u*)(lds + O_X + (bi) * 17408 + ((p >> 4) * PS + (p & 15) * 8) * 2) = rx[i]; } \
            if (tid < 128) { ((LAS float*)(lds + O_AC))[(bi) * 128 + tid] = rac; ((LAS float*)(lds + O_TE))[(bi) * 128 + tid] = __expf(racl - rac); ((LAS float*)(lds + O_DT))[(bi) * 128 + tid] = rdt; } } while (0)
        __syncthreads();
        SSD_LDF(0, fC, Cg); SSD_LDF(0, fCB, CBg); SSD_LDF(0, fBT, BTg); SSD_LOADX(0);
        for (int i = tid; i < 17408 / 4; i += NTHR) ((LAS unsigned*)(lds + O_S))[i] = 0u;
        SSD_STORE(0);
        f32x4 accS[4];
#pragma unroll
        for (int pt = 0; pt < 4; ++pt) accS[pt] = (f32x4){0.f, 0.f, 0.f, 0.f};
        __syncthreads();
        for (int c = 0; c < 32; ++c) {
            const int cur = c & 1;
            const LAS bf16* sS = (const LAS bf16*)(lds + O_S + cur * 17408); LAS bf16* sSn = (LAS bf16*)(lds + O_S + (cur ^ 1) * 17408); const LAS bf16* sXT = (const LAS bf16*)(lds + O_X + cur * 17408);
            const LAS float* sAc = (const LAS float*)(lds + O_AC) + cur * 128; const LAS float* sTe = (const LAS float*)(lds + O_TE) + cur * 128; const LAS float* sDt = (const LAS float*)(lds + O_DT) + cur * 128;
            const int cn = c + 1 < 32 ? c + 1 : c;
            SSD_LOADX(cn);
            const int lrow = 16 * w + r; const float ac_l = sAc[lrow];
            f32x4 accO[4], accD[4];
#pragma unroll
            for (int pt = 0; pt < 4; ++pt) { accO[pt] = (f32x4){0.f, 0.f, 0.f, 0.f}; accD[pt] = (f32x4){0.f, 0.f, 0.f, 0.f}; }
#pragma unroll
            for (int ks = 0; ks < 4; ++ks) { const bf16x8 yf = __builtin_bit_cast(bf16x8, fC[ks]);
#pragma unroll
                for (int pt = 0; pt < 4; ++pt) accO[pt] = mfma16(lds_frag(sS, 16 * pt, PS, 32 * ks, lane), yf, accO[pt]); }
            SSD_LDF(cn, fC, Cg);
#pragma unroll
            for (int ks = 0; ks < 4; ++ks) if (32 * ks <= 16 * w + 15) {
                float v[8]; const f32x4 a0 = *(const LAS f32x4*)(sAc + 32 * ks + 8 * q4), a1 = *(const LAS f32x4*)(sAc + 32 * ks + 8 * q4 + 4);
#pragma unroll
                for (int j = 0; j < 4; ++j) { const int s0 = 32 * ks + 8 * q4 + 2 * j; const float as0 = (2 * j < 4) ? a0[(2 * j) & 3] : a1[(2 * j) & 3], as1 = (2 * j + 1 < 4) ? a0[(2 * j + 1) & 3] : a1[(2 * j + 1) & 3];
                    v[2 * j] = (s0 <= lrow) ? bflo(fCB[ks][j]) * __expf(ac_l - as0) : 0.f; v[2 * j + 1] = (s0 + 1 <= lrow) ? bfhi(fCB[ks][j]) * __expf(ac_l - as1) : 0.f; }
                const bf16x8 yf = pack8(v);
#pragma unroll
                for (int pt = 0; pt < 4; ++pt) accD[pt] = mfma16(lds_frag(sXT, 16 * pt, PS, 32 * ks, lane), yf, accD[pt]); }
            SSD_LDF(cn, fCB, CBg);
            {   const float ea = __expf(ac_l), rdtl = Dsk / sDt[lrow];
#pragma unroll
                for (int pt = 0; pt < 4; ++pt) { f32x4 y = accO[pt] * ea + accD[pt];
#pragma unroll
                    for (int ii = 0; ii < 4; ++ii) y[ii] += rdtl * bf2f(sXT[(16 * pt + 4 * q4 + ii) * PS + lrow]);
                    *(GAS unsigned long long*)(YMIX + ((size_t)b * SEQ + c * 128 + lrow) * DMIX + head * 64 + 16 * pt + 4 * q4) = pack4(y); } }
            {   const float cd = __expf(sAc[127]);
#pragma unroll
                for (int pt = 0; pt < 4; ++pt) accS[pt] = accS[pt] * cd;
#pragma unroll
                for (int ks = 0; ks < 4; ++ks) { float v[8]; const f32x4 t0 = *(const LAS f32x4*)(sTe + 32 * ks + 8 * q4), t1 = *(const LAS f32x4*)(sTe + 32 * ks + 8 * q4 + 4);
#pragma unroll
                    for (int j = 0; j < 4; ++j) { const float ts0 = (2 * j < 4) ? t0[(2 * j) & 3] : t1[(2 * j) & 3], ts1 = (2 * j + 1 < 4) ? t0[(2 * j + 1) & 3] : t1[(2 * j + 1) & 3];
                        v[2 * j] = bflo(fBT[ks][j]) * ts0; v[2 * j + 1] = bfhi(fBT[ks][j]) * ts1; }
                    const bf16x8 xf = pack8(v);
#pragma unroll
                    for (int pt = 0; pt < 4; ++pt) accS[pt] = mfma16(xf, lds_frag(sXT, 16 * pt, PS, 32 * ks, lane), accS[pt]); }
#pragma unroll
                for (int pt = 0; pt < 4; ++pt) *(LAS unsigned long long*)(sSn + (16 * pt + r) * PS + 16 * w + 4 * q4) = pack4(accS[pt]);
            }
            SSD_LDF(cn, fBT, BTg);
            if (c + 1 < 32) SSD_STORE(cur ^ 1);
            WG_BAR();
        }
#undef SSD_LDF
#undef SSD_LOADX
#undef SSD_STORE
    }
}

__device__ __forceinline__ void gdn_prep_phase(CArgs a, int l, LAS unsigned char* lds, int wg, int G, int tid) {
    asm volatile("" : "+v"(tid));
    constexpr int PS = 136, TS = 72, MS = 68, TT = 65;
    LAS bf16* sKb = (LAS bf16*)lds; LAS bf16* sQb = sKb + 64 * PS; LAS bf16* sQG = sQb + 64 * PS; LAS bf16* sVT = sQG + 64 * PS;
    LAS float* sM = (LAS float*)(lds + 3 * 17408 + 18432); LAS float* sT = sM + 64 * MS; LAS float* sVec = sT + 64 * TT; LAS bf16* sQK = (LAS bf16*)(sVec + 256);
    const bf16* PROJ = (const bf16*)(a->ws + WS_PROJ);
    const float* cw = a->in[I_GCW] + (size_t)l * 4 * 1536;
    const int lane = tid & 63, w = tid >> 6, r = lane & 15, q4 = lane >> 4;
    for (int unit = wg; unit < 1024; unit += G) {
        const int b = unit >> 8, head = (unit >> 6) & 3, n = unit & 63;
        const size_t row0 = (size_t)b * SEQ + n * 64;
#define GW ((bf16*)(a->ws + WS_GD_K) + (size_t)unit * 8192)
#define GKT ((bf16*)(a->ws + WS_GD_KT) + (size_t)unit * 8192)
#define GQG ((bf16*)(a->ws + WS_GD_QG) + (size_t)unit * 8192)
#define GUT ((bf16*)(a->ws + WS_GD_VT) + (size_t)unit * 8192)
#define GT ((bf16*)(a->ws + WS_GD_T) + (size_t)unit * 4096)
#define GQK ((bf16*)(a->ws + WS_GD_QK) + (size_t)unit * 4096)
#define GVEC ((float*)(a->ws + WS_GD_VEC) + (size_t)unit * 256)
        __syncthreads();
        for (int i = tid; i < 64 * MS; i += NTHR) sM[i] = 0.f;
        if (w == 0) {
            const float nA = -__expf(a->in[I_GALOG][l * 4 + head]), dtb = a->in[I_GDTB][l * 4 + head];
            const size_t ro = (row0 + lane) * NPROJ;
            const float be = sigmoidf_(bf2f(PROJ[ro + O_GB + head])); float gsum = nA * softplusf_(bf2f(PROJ[ro + O_GA + head]) + dtb);
#pragma unroll
            for (int o = 1; o < 64; o <<= 1) { const float t_ = __shfl_up(gsum, o); if (lane >= o) gsum += t_; }
            const float glast = __shfl(gsum, 63), eg = __expf(gsum), cc = __expf(glast - gsum);
            sVec[lane] = gsum; sVec[64 + lane] = be; sVec[128 + lane] = eg;
            GVEC[lane] = be; GVEC[64 + lane] = eg; GVEC[128 + lane] = cc; GVEC[192 + lane] = __expf(glast);
        }
        __syncthreads();
        {
            const int rg = lane >> 4, c8 = (lane & 15) * 8;
#pragma unroll 1
            for (int part = 0; part < 3; ++part) {
                float wt[4][8];
#pragma unroll
                for (int k = 0; k < 4; ++k) { const f32x4 w0 = *(const f32x4*)(cw + k * 1536 + part * 512 + head * 128 + c8), w1 = *(const f32x4*)(cw + k * 1536 + part * 512 + head * 128 + c8 + 4);
#pragma unroll
                    for (int jj = 0; jj < 4; ++jj) { wt[k][jj] = w0[jj]; wt[k][4 + jj] = w1[jj]; } }
#pragma unroll
                for (int it = 0; it < 2; ++it) { const int t = 8 * w + 4 * it + rg; float acc[8];
#pragma unroll
                    for (int jj = 0; jj < 8; ++jj) acc[jj] = 0.f;
#pragma unroll
                    for (int k = 0; k < 4; ++k) { const int ts = n * 64 + t - 3 + k;
                        if (ts >= 0) { const v4u xv = *(const GAS v4u*)(PROJ + ((size_t)b * SEQ + ts) * NPROJ + O_QKV + part * 512 + head * 128 + c8);
#pragma unroll
                            for (int j = 0; j < 4; ++j) { acc[2 * j] += wt[k][2 * j] * bflo(xv[j]); acc[2 * j + 1] += wt[k][2 * j + 1] * bfhi(xv[j]); } } }
                    float ss = 0.f;
#pragma unroll
                    for (int jj = 0; jj < 8; ++jj) { acc[jj] = siluf(acc[jj]); ss += acc[jj] * acc[jj]; }
                    if (part == 2) {
#pragma unroll
                        for (int jj = 0; jj < 8; ++jj) sVT[(c8 + jj) * TS + t] = (bf16)f2bf(acc[jj]);
                    } else {
                        const float sc = rsqrtf(row16_sum(ss) + 1e-6f) * (part == 0 ? 0.08838834764831845f : 1.0f);
#pragma unroll
                        for (int jj = 0; jj < 8; ++jj) acc[jj] *= sc;
                        if (part == 1) *(LAS bf16x8*)(sKb + t * PS + c8) = pack8(acc);
                        else { *(LAS bf16x8*)(sQb + t * PS + c8) = pack8(acc); const float eg = sVec[128 + t];
#pragma unroll
                            for (int jj = 0; jj < 8; ++jj) acc[jj] *= eg;
                            *(LAS bf16x8*)(sQG + t * PS + c8) = pack8(acc); }
                    }
                }
            }
        }
        __syncthreads();
        for (int p = w; p < 26; p += NWAVES) {
            int it, jt; bool isq;
            if (p < 10) { isq = false; it = p < 1 ? 0 : (p < 3 ? 1 : (p < 6 ? 2 : 3)); jt = p - (it * (it + 1)) / 2; } else { isq = true; it = (p - 10) >> 2; jt = (p - 10) & 3; }
            f32x4 acc = {0.f, 0.f, 0.f, 0.f};
            if (jt <= it) {
#pragma unroll
                for (int ks = 0; ks < 4; ++ks) acc = mfma16(lds_frag(sKb, 16 * jt, PS, 32 * ks, lane), lds_frag(isq ? sQb : sKb, 16 * it, PS, 32 * ks, lane), acc);
                const int i = 16 * it + r; const float gi = sVec[i], bi = sVec[64 + i];
#pragma unroll
                for (int ii = 0; ii < 4; ++ii) { const int j = 16 * jt + 4 * q4 + ii; const float dec = __expf(gi - sVec[j]);
                    acc[ii] = isq ? (j <= i ? acc[ii] * dec : 0.f) : (j < i ? acc[ii] * dec * bi : 0.f); }
            }
            if (isq) *(LAS unsigned long long*)(sQK + (16 * it + r) * TS + 16 * jt + 4 * q4) = pack4(acc);
            else *(LAS f32x4*)(sM + (16 * it + r) * MS + 16 * jt + 4 * q4) = acc;
        }
        __syncthreads();
        {
            LAS float* sX = (LAS float*)(sQK + 64 * TS);
            if (w < 4) {
                int zo = 0; asm volatile("" : "+v"(zo)); const LAS float* sMv = sM + zo + (16 * w) * MS + 16 * w;
                if (lane < 16) { float ud[16];
#pragma unroll
                    for (int rr = 0; rr < 16; ++rr) { float acc = -sMv[rr * MS + lane];
#pragma unroll
                        for (int j = 0; j < rr; ++j) acc -= sMv[rr * MS + j] * ud[j];
                        ud[rr] = acc; sT[(16 * w + rr) * TT + 16 * w + lane] = acc + ((rr == lane) ? 1.f : 0.f); } }
                for (int jb = w + 1; jb < 4; ++jb)
                    for (int idx = lane; idx < 256; idx += 64) sT[(16 * w + (idx >> 4)) * TT + 16 * jb + (idx & 15)] = 0.f;
            } else {
                for (int f = w - 4; f < 16; f += 4) { const int tile = f >> 2, ks = f & 3;
                    *(GAS v4u*)(GQG + f * 512 + lane * 8) = *(const LAS v4u*)(sQG + (16 * tile + r) * PS + 32 * ks + 8 * q4); }
                for (int f = w - 4; f < 8; f += 4) { const int tile = f >> 1, ks = f & 1;
                    *(GAS v4u*)(GQK + f * 512 + lane * 8) = *(const LAS v4u*)(sQK + (16 * tile + r) * TS + 32 * ks + 8 * q4); }
                for (int f = w - 4; f < 16; f += 4) { const int dt = f >> 1, ks = f & 1, d = 16 * dt + r, s0 = 32 * ks + 8 * q4; v4u o;
#pragma unroll
                    for (int j = 0; j < 4; ++j) o[j] = (unsigned)sKb[(s0 + 2 * j) * PS + d] | ((unsigned)sKb[(s0 + 2 * j + 1) * PS + d] << 16);
                    *(GAS v4u*)(GKT + f * 512 + lane * 8) = o; }
            }
            WG_BAR();
#pragma unroll
            for (int ib = 1; ib < 4; ++ib) {
                if (w < ib) { const int jb = w; f32x4 acc = {0.f, 0.f, 0.f, 0.f};
                    for (int kb = jb; kb < ib; ++kb)
#pragma unroll
                        for (int kc = 0; kc < 4; ++kc) acc = __builtin_amdgcn_mfma_f32_16x16x4f32(sM[(16 * ib + r) * MS + 16 * kb + 4 * kc + q4], sT[(16 * kb + 4 * kc + q4) * TT + 16 * jb + r], acc, 0, 0, 0);
                    LAS float* sx = sX + w * 272;
#pragma unroll
                    for (int rr = 0; rr < 4; ++rr) sx[(4 * q4 + rr) * 17 + r] = acc[rr];
                    asm volatile("s_waitcnt lgkmcnt(0)" ::: "memory");
                    f32x4 acc2 = {0.f, 0.f, 0.f, 0.f};
#pragma unroll
                    for (int kc = 0; kc < 4; ++kc) acc2 = __builtin_amdgcn_mfma_f32_16x16x4f32(sT[(16 * ib + r) * TT + 16 * ib + 4 * kc + q4], sx[(4 * kc + q4) * 17 + r], acc2, 0, 0, 0);
#pragma unroll
                    for (int rr = 0; rr < 4; ++rr) sT[(16 * ib + 4 * q4 + rr) * TT + 16 * jb + r] = -acc2[rr];
                }
                WG_BAR();
            }
        }
        {
            LAS bf16* sTb = (LAS bf16*)sM; LAS bf16* sKgT = sQb;
            { const int t = tid >> 3, s8 = (tid & 7) * 8; float v[8];
#pragma unroll
                for (int jj = 0; jj < 8; ++jj) v[jj] = sT[t * TT + s8 + jj];
                *(LAS bf16x8*)(sTb + t * TS + s8) = pack8(v); }
            for (int p = tid; p < 1024; p += NTHR) { const int d = p >> 3, s8 = (p & 7) * 8; float v[8], u8[8]; const v4u vv = *(const LAS v4u*)(sVT + d * TS + s8);
#pragma unroll
                for (int jj = 0; jj < 8; ++jj) { const float be = sVec[64 + s8 + jj]; v[jj] = bf2f(sKb[(s8 + jj) * PS + d]) * be * sVec[128 + s8 + jj]; u8[jj] = ((jj & 1) ? bfhi(vv[jj >> 1]) : bflo(vv[jj >> 1])) * be; }
                *(LAS bf16x8*)(sKgT + d * TS + s8) = pack8(v); *(LAS bf16x8*)(sVT + d * TS + s8) = pack8(u8); }
        }
        __syncthreads();
        {
            const LAS bf16* sTb = (const LAS bf16*)sM; const LAS bf16* sKgT = sQb; LAS bf16* sW = (LAS bf16*)((LAS unsigned char*)sM + 9216);
            const int st_ = w >> 1;
            const bf16x8 t0 = lds_frag(sTb, 16 * st_, TS, 0, lane), t1 = lds_frag(sTb, 16 * st_, TS, 32, lane);
#pragma unroll
            for (int c4_ = 0; c4_ < 4; ++c4_) { const int ct = (w & 1) * 4 + c4_;
                f32x4 aw = {0.f, 0.f, 0.f, 0.f}, au = {0.f, 0.f, 0.f, 0.f};
                aw = mfma16(lds_frag(sKgT, 16 * ct, TS, 0, lane), t0, aw); aw = mfma16(lds_frag(sKgT, 16 * ct, TS, 32, lane), t1, aw);
                au = mfma16(t0, lds_frag(sVT, 16 * ct, TS, 0, lane), au); au = mfma16(t1, lds_frag(sVT, 16 * ct, TS, 32, lane), au);
                *(LAS unsigned long long*)(sW + (16 * st_ + r) * PS + 16 * ct + 4 * q4) = pack4(aw);
                *(GAS unsigned long long*)(GUT + (ct * 4 + st_) * 256 + lane * 4) = pack4(au); }
        }
        __syncthreads();
        { const LAS bf16* sW = (const LAS bf16*)((LAS unsigned char*)sM + 9216);
            for (int f = w; f < 16; f += NWAVES) { const int tile = f >> 2, ks = f & 3;
                *(GAS v4u*)(GW + f * 512 + lane * 8) = *(const LAS v4u*)(sW + (16 * tile + r) * PS + 32 * ks + 8 * q4); } }
    }
#undef GW
#undef GKT
#undef GQG
#undef GUT
#undef GT
#undef GQK
#undef GVEC
}
__device__ __forceinline__ void gdn_scan_phase(CArgs a, int l, LAS unsigned char* lds, const int b, const int head, const int eb, int tid) {
    asm volatile("" : "+v"(tid));
    constexpr int PS = 136, TS = 72, O_ST = 0, O_RT = 34816, O_VN = O_RT + 9216, O_VC = O_VN + 9216;
    bf16* YMIX = (bf16*)(a->ws + WS_YMIX);
    const int lane = tid & 63, w = tid >> 6, r = lane & 15, q4 = lane >> 4, st = w >> 1, eh = w & 1;
    LAS bf16* sRT = (LAS bf16*)(lds + O_RT); LAS bf16* sVN = (LAS bf16*)(lds + O_VN); LAS bf16* sVC = (LAS bf16*)(lds + O_VC);
    {
        const size_t u0 = (size_t)(b * 4 + head) * 64;
        const bf16* pW = (const bf16*)(a->ws + WS_GD_K) + u0 * 8192 + (st * 4) * 512 + lane * 8; const bf16* pQG = (const bf16*)(a->ws + WS_GD_QG) + u0 * 8192 + (st * 4) * 512 + lane * 8;
        const bf16* pQK = (const bf16*)(a->ws + WS_GD_QK) + u0 * 4096 + (st * 2) * 512 + lane * 8;
        const bf16* pKT = (const bf16*)(a->ws + WS_GD_KT) + u0 * 8192 + (w * 2) * 512 + lane * 8;
        const bf16* pUT = (const bf16*)(a->ws + WS_GD_VT) + u0 * 8192 + (size_t)(((eb * 4 + 2 * eh) * 4 + st) * 256) + lane * 4;
        const float* pVec = (const float*)(a->ws + WS_GD_VEC) + u0 * 256 + 16 * st + 4 * q4;
        v4u xW[4], yQG[4], yQK[2], xKT[2], nQG[4], nQK[2]; unsigned long long uT[2]; f32x4 c4; float gl;
#define GD_LD_A(nn) do { _Pragma("unroll") for (int ks = 0; ks < 4; ++ks) xW[ks] = *(const GAS v4u*)(pW + (size_t)(nn) * 8192 + 512 * ks); \
            _Pragma("unroll") for (int j = 0; j < 2; ++j) uT[j] = *(const GAS unsigned long long*)(pUT + (size_t)(nn) * 8192 + j * 1024); \
            c4 = *(const GAS f32x4*)(pVec + (size_t)(nn) * 256 + 128); } while (0)
#define GD_LD_C(nn, QG_, QK_) do { _Pragma("unroll") for (int ks = 0; ks < 4; ++ks) QG_[ks] = *(const GAS v4u*)(pQG + (size_t)(nn) * 8192 + 512 * ks); \
            _Pragma("unroll") for (int ks = 0; ks < 2; ++ks) QK_[ks] = *(const GAS v4u*)(pQK + (size_t)(nn) * 4096 + 512 * ks); } while (0)
#define GD_LD_D(nn) do { _Pragma("unroll") for (int ks = 0; ks < 2; ++ks) xKT[ks] = *(const GAS v4u*)(pKT + (size_t)(nn) * 8192 + 512 * ks); gl = pVec[(size_t)(nn) * 256 + 192 - (16 * st + 4 * q4)]; } while (0)
        __syncthreads();
        GD_LD_A(0); GD_LD_C(0, yQG, yQK); GD_LD_D(0);
        for (int i = tid; i < 17408 / 4; i += NTHR) ((LAS unsigned*)(lds + O_ST))[i] = 0u;
        f32x4 accS[4];
#pragma unroll
        for (int et = 0; et < 4; ++et) accS[et] = (f32x4){0.f, 0.f, 0.f, 0.f};
        __syncthreads();
        for (int n = 0; n < 64; ++n) {
            const int cur = n & 1; const LAS bf16* sST = (const LAS bf16*)(lds + O_ST + cur * 17408); LAS bf16* sSTn = (LAS bf16*)(lds + O_ST + (cur ^ 1) * 17408);
            const int nn = n + 1 < 64 ? n + 1 : n;
            {
                bf16x8 fs[2][4];
#pragma unroll
                for (int j = 0; j < 2; ++j)
#pragma unroll
                    for (int ks = 0; ks < 4; ++ks) fs[j][ks] = lds_frag(sST, 16 * (2 * eh + j), PS, 32 * ks, lane);
                __builtin_amdgcn_sched_barrier(0);
#pragma unroll
                for (int j = 0; j < 2; ++j) { const int e0 = 16 * (2 * eh + j); f32x4 acc = {0.f, 0.f, 0.f, 0.f};
#pragma unroll
                    for (int ks = 0; ks < 4; ++ks) acc = mfma16(__builtin_bit_cast(bf16x8, xW[ks]), fs[j][ks], acc);
                    const unsigned ulo = (unsigned)uT[j], uhi = (unsigned)(uT[j] >> 32); f32x4 vn;
                    vn[0] = bflo(ulo) - acc[0]; vn[1] = bfhi(ulo) - acc[1]; vn[2] = bflo(uhi) - acc[2]; vn[3] = bfhi(uhi) - acc[3];
                    *(LAS unsigned long long*)(sVN + (e0 + r) * TS + 16 * st + 4 * q4) = pack4(vn); *(LAS unsigned long long*)(sVC + (e0 + r) * TS + 16 * st + 4 * q4) = pack4(vn * c4); }
            }
            GD_LD_A(nn); GD_LD_C(nn, nQG, nQK);
            WG_BAR();
            {
                bf16x8 fv[4][2];
#pragma unroll
                for (int et = 0; et < 4; ++et)
#pragma unroll
                    for (int ks = 0; ks < 2; ++ks) fv[et][ks] = lds_frag(sVC, 16 * et, TS, 32 * ks, lane);
                __builtin_amdgcn_sched_barrier(0);
#pragma unroll
                for (int et = 0; et < 4; ++et) { accS[et] = accS[et] * gl;
#pragma unroll
                    for (int ks = 0; ks < 2; ++ks) accS[et] = mfma16(__builtin_bit_cast(bf16x8, xKT[ks]), fv[et][ks], accS[et]);
                    *(LAS unsigned long long*)(sSTn + (16 * et + r) * PS + 16 * w + 4 * q4) = pack4(accS[et]); }
            }
            GD_LD_D(nn);
            {
                bf16x8 fs[2][4], fn[2][2];
#pragma unroll
                for (int j = 0; j < 2; ++j) {
#pragma unroll
                    for (int ks = 0; ks < 4; ++ks) fs[j][ks] = lds_frag(sST, 16 * (2 * eh + j), PS, 32 * ks, lane);
#pragma unroll
                    for (int ks = 0; ks < 2; ++ks) fn[j][ks] = lds_frag(sVN, 16 * (2 * eh + j), TS, 32 * ks, lane); }
                __builtin_amdgcn_sched_barrier(0);
#pragma unroll
                for (int j = 0; j < 2; ++j) { const int e0 = 16 * (2 * eh + j); f32x4 acc = {0.f, 0.f, 0.f, 0.f};
#pragma unroll
                    for (int ks = 0; ks < 4; ++ks) acc = mfma16(fs[j][ks], __builtin_bit_cast(bf16x8, yQG[ks]), acc);
#pragma unroll
                    for (int ks = 0; ks < 2; ++ks) acc = mfma16(fn[j][ks], __builtin_bit_cast(bf16x8, yQK[ks]), acc);
                    *(GAS unsigned long long*)(YMIX + ((size_t)b * SEQ + n * 64 + 16 * st + r) * DMIX + 1024 + head * 128 + eb * 64 + e0 + 4 * q4) = pack4(acc); }
            }
#pragma unroll
            for (int ks = 0; ks < 4; ++ks) yQG[ks] = nQG[ks];
#pragma unroll
            for (int ks = 0; ks < 2; ++ks) yQK[ks] = nQK[ks];
            WG_BAR();
        }
#undef GD_LD_A
#undef GD_LD_C
#undef GD_LD_D
    }
}

__device__ __forceinline__ void gdn_rec_phase(CArgs a, int l, LAS unsigned char* lds, int wg, int G, int tid) {
    asm volatile("" : "+v"(tid));
    constexpr int TB = 32;
    LAS float* sQ = (LAS float*)lds; LAS float* sK = sQ + TB * 128; LAS float* sV = sK + TB * 128; LAS float* sBe = sV + TB * 8; LAS float* sAl = sBe + TB; LAS float* sO = sAl + TB;
    const bf16* PROJ = (const bf16*)(a->ws + WS_PROJ); bf16* YMIX = (bf16*)(a->ws + WS_YMIX);
    const float* cw = a->in[I_GCW] + (size_t)l * 4 * 1536;
    const int lane = tid & 63, w = tid >> 6;
    for (int unit = wg; unit < 256; unit += G) {
        const int b = unit >> 6, head = (unit >> 4) & 3, eb = unit & 15;
        const float nA = -__expf(a->in[I_GALOG][l * 4 + head]), dtb = a->in[I_GDTB][l * 4 + head];
        float S0 = 0.f, S1 = 0.f;
        for (int t0 = 0; t0 < SEQ; t0 += TB) {
            __syncthreads();
            for (int idx = tid; idx < TB * 264; idx += NTHR) {
                const int tt = idx / 264, ci = idx % 264, t = t0 + tt;
                const int ch = ci < 128 ? head * 128 + ci : (ci < 256 ? 512 + head * 128 + (ci - 128) : 1024 + head * 128 + eb * 8 + (ci - 256));
                float acc = 0.f;
#pragma unroll
                for (int k = 0; k < 4; ++k) { const int ts = t - 3 + k; if (ts >= 0) acc += cw[k * 1536 + ch] * bf2f(PROJ[(size_t)(b * SEQ + ts) * NPROJ + O_QKV + ch]); }
                const float v = siluf(acc);
                if (ci < 128) sQ[tt * 128 + ci] = v; else if (ci < 256) sK[tt * 128 + ci - 128] = v; else sV[tt * 8 + ci - 256] = v;
            }
            if (tid < TB) { const size_t ro = (size_t)(b * SEQ + t0 + tid) * NPROJ; const float braw = bf2f(PROJ[ro + O_GB + head]), araw = bf2f(PROJ[ro + O_GA + head]);
                sBe[tid] = sigmoidf_(braw); sAl[tid] = __expf(nA * softplusf_(araw + dtb)); }
            __syncthreads();
            for (int tt = w; tt < TB; tt += NWAVES) {
                const float q0 = sQ[tt * 128 + lane], q1 = sQ[tt * 128 + 64 + lane], k0 = sK[tt * 128 + lane], k1 = sK[tt * 128 + 64 + lane];
                const float sq = rsqrtf(wave_sum(q0 * q0 + q1 * q1) + 1e-6f) * 0.08838834764831845f, sk = rsqrtf(wave_sum(k0 * k0 + k1 * k1) + 1e-6f);
                sQ[tt * 128 + lane] = q0 * sq; sQ[tt * 128 + 64 + lane] = q1 * sq; sK[tt * 128 + lane] = k0 * sk; sK[tt * 128 + 64 + lane] = k1 * sk;
            }
            __syncthreads();
#pragma unroll 2
            for (int tt = 0; tt < TB; ++tt) {
                const float k0 = sK[tt * 128 + lane], k1 = sK[tt * 128 + 64 + lane], q0 = sQ[tt * 128 + lane], q1 = sQ[tt * 128 + 64 + lane];
                const float al = sAl[tt], be = sBe[tt], v = sV[tt * 8 + w];
                const float dot = wave_sum(k0 * S0 + k1 * S1);
                const float vn = be * (v - al * dot);
                S0 = al * S0 + k0 * vn; S1 = al * S1 + k1 * vn;
                const float od = wave_sum(q0 * S0 + q1 * S1);
                if (lane == 0) sO[tt * 8 + w] = od;
            }
            __syncthreads();
            if (tid < TB * 8) { const int tt = tid >> 3, i = tid & 7; YMIX[(size_t)(b * SEQ + t0 + tt) * DMIX + 1024 + head * 128 + eb * 8 + i] = (bf16)f2bf(sO[tid]); }
        }
    }
}

__device__ __forceinline__ void hgrn_rec_phase(CArgs a, int l, LAS unsigned char* lds, int wg, int G, int tid) {
    asm volatile("" : "+v"(tid));
    constexpr int TB = 32;
    LAS float* sQ = (LAS float*)lds; LAS float* sF = sQ + TB * 128; LAS float* sV = sF + TB * 128; LAS float* sO = sV + TB * 8; LAS float* sLb = sO + TB * 8;
    const bf16* PROJ = (const bf16*)(a->ws + WS_PROJ); bf16* YMIX = (bf16*)(a->ws + WS_YMIX);
    const int lane = tid & 63, w = tid >> 6;
    for (int unit = wg; unit < 256; unit += G) {
        const int b = unit >> 6, head = (unit >> 4) & 3, eb = unit & 15;
        __syncthreads();
        if (tid < 128) {
            const int c = head * 128 + tid; float lg[DEPTH], mx = -1e30f;
#pragma unroll
            for (int j = 0; j < DEPTH; ++j) { lg[j] = a->in[I_HLB][j * 512 + c]; mx = fmaxf(mx, lg[j]); }
            float den = 0.f, num = 0.f;
#pragma unroll
            for (int j = 0; j < DEPTH; ++j) { const float e = __expf(lg[j] - mx); den += e; if (j >= 1 && j <= l) num += e; }
            sLb[tid] = num / den;
        }
        float S0 = 0.f, S1 = 0.f;
        for (int t0 = 0; t0 < SEQ; t0 += TB) {
            __syncthreads();
            for (int idx = tid; idx < TB * 264; idx += NTHR) {
                const int tt = idx / 264, ci = idx % 264; const size_t ro = (size_t)(b * SEQ + t0 + tt) * NPROJ;
                if (ci < 128) sQ[tt * 128 + ci] = siluf(bf2f(PROJ[ro + O_HQ + head * 128 + ci]));
                else if (ci < 256) { const int d = ci - 128; const float lb = sLb[d]; sF[tt * 128 + d] = lb + (1.f - lb) * sigmoidf_(bf2f(PROJ[ro + O_HF + head * 128 + d])); }
                else sV[tt * 8 + ci - 256] = bf2f(PROJ[ro + O_HI + head * 128 + eb * 8 + (ci - 256)]);
            }
            __syncthreads();
#pragma unroll 2
            for (int tt = 0; tt < TB; ++tt) {
                const float f0 = sF[tt * 128 + lane], f1 = sF[tt * 128 + 64 + lane], q0 = sQ[tt * 128 + lane], q1 = sQ[tt * 128 + 64 + lane], v = sV[tt * 8 + w];
                S0 = f0 * S0 + (1.f - f0) * v; S1 = f1 * S1 + (1.f - f1) * v;
                const float od = wave_sum(q0 * S0 + q1 * S1);
                if (lane == 0) sO[tt * 8 + w] = od;
            }
            __syncthreads();
            if (tid < TB * 8) { const int tt = tid >> 3, i = tid & 7; YMIX[(size_t)(b * SEQ + t0 + tt) * DMIX + 1536 + head * 128 + eb * 8 + i] = (bf16)f2bf(sO[tid]); }
        }
    }
}

__device__ __forceinline__ void mix_post_phase(CArgs a, int l, int wg, int G, int tid) {
    asm volatile("" : "+v"(tid));
    const bf16* PROJ = (const bf16*)(a->ws + WS_PROJ); bf16* YMIX = (bf16*)(a->ws + WS_YMIX);
    const int lane = tid & 63, gw = wg * NWAVES + (tid >> 6), NGW = G * NWAVES;
    const float* snw = a->in[I_SNW] + l * 1024; const float* gnw = a->in[I_GNW] + l * 128; const float* hnw = a->in[I_HNW] + l * 128;
    for (int row = gw; row < M; row += NGW) {
        const bf16* pr = PROJ + (size_t)row * NPROJ; bf16* yr = YMIX + (size_t)row * DMIX;
#pragma unroll
        for (int j = 0; j < 2; ++j) {
            const int ch = j * 512 + lane * 8; const v4u yv = *(const GAS v4u*)(yr + ch), zv = *(const GAS v4u*)(pr + O_Z + ch);
            float v[8]; float ss = 0.f;
#pragma unroll
            for (int i = 0; i < 4; ++i) { v[2 * i] = bflo(yv[i]) * siluf(bflo(zv[i])); v[2 * i + 1] = bfhi(yv[i]) * siluf(bfhi(zv[i])); ss += v[2 * i] * v[2 * i] + v[2 * i + 1] * v[2 * i + 1]; }
            const float rstd = rsqrtf(wave_sum(ss) * (1.f / 512.f) + 1e-6f);
            v4u o;
#pragma unroll
            for (int i = 0; i < 4; ++i) o[i] = pk2(v[2 * i] * rstd * snw[ch + 2 * i], v[2 * i + 1] * rstd * snw[ch + 2 * i + 1]);
            *(GAS v4u*)(yr + ch) = o;
        }
#pragma unroll
        for (int part = 0; part < 2; ++part) {
            const int ch = lane * 8, yo = 1024 + part * 512 + ch, go = (part == 0 ? O_GG : O_HG) + ch; const float* nw = part == 0 ? gnw : hnw;
            const v4u yv = *(const GAS v4u*)(yr + yo), gv = *(const GAS v4u*)(pr + go);
            float v[8]; float ss = 0.f;
#pragma unroll
            for (int i = 0; i < 4; ++i) { v[2 * i] = bflo(yv[i]); v[2 * i + 1] = bfhi(yv[i]); ss += v[2 * i] * v[2 * i] + v[2 * i + 1] * v[2 * i + 1]; }
            ss = row16_sum(ss);
            const float rstd = rsqrtf(ss * (1.f / 128.f) + 1e-6f);
            v4u o;
#pragma unroll
            for (int i = 0; i < 4; ++i) { const int c = (ch & 127) + 2 * i; o[i] = pk2(v[2 * i] * rstd * nw[c] * siluf(bflo(gv[i])), v[2 * i + 1] * rstd * nw[c + 1] * siluf(bfhi(gv[i]))); }
            *(GAS v4u*)(yr + yo) = o;
        }
    }
}

__device__ __forceinline__ void moe_tables(const gu32* cnt, LAS unsigned char* lds, int tid) {
    LAS int* tab = (LAS int*)(lds + LDS_OFF_TAB);
    __syncthreads();
    if (tid == 0) { int p = 0, q = 0;
        for (int e = 0; e < 16; ++e) { const int c = (int)__hip_atomic_load(cnt + e, RLX_AGENT); tab[e] = p; tab[17 + e] = q; p += (c + 255) & ~255; q += c; }
        tab[16] = p; tab[33] = q; }
    __syncthreads();
}
template <bool ROUTER>
__device__ __forceinline__ void ln_phase(CArgs a, int l, const float* gam, const float* bet, LAS unsigned char* lds, int wg, int G, int tid) {
    asm volatile("" : "+v"(tid));
    const int lane = tid & 63, wave = tid >> 6, gw = wg * NWAVES + wave, NGW = G * NWAVES;
    const bf16* ADD = (const bf16*)(a->ws + WS_MIX); float* H = a->out; bf16* HB = (bf16*)(a->ws + WS_HB);
    gu32* cnt = (gu32*)(a->ws + WS_CTL) + CW_CNT + l * 16;
    LAS float* sW = (LAS float*)lds;
    LAS float* sL = sW + 20 * D + wave * 32;
    LAS int* sCnt = (LAS int*)(sW + 20 * D + 256);
    LAS unsigned* sEnt = (LAS unsigned*)(sCnt + 32);
    constexpr int MAXENT = 2 * NWAVES * 8;
    if (ROUTER) {
        __syncthreads();
        const float* wrg = a->in[I_WRG] + (size_t)l * D * 4; const float* wre = a->in[I_WRE] + (size_t)l * D * 16;
        for (int i = tid; i < D * 20; i += NTHR) { const int c = i >> 10, k = i & 1023; sW[i] = c < 4 ? wrg[k * 4 + c] : wre[k * 16 + c - 4]; }
        if (tid < 32) sCnt[tid] = 0;
        __syncthreads();
    } else moe_tables(cnt, lds, tid);
    const LAS int* tab = (const LAS int*)(lds + LDS_OFF_TAB);
    f32x4 gv[4], bv[4];
#pragma unroll
    for (int j = 0; j < 4; ++j) { gv[j] = *(const f32x4*)(gam + 4 * lane + 256 * j); bv[j] = *(const f32x4*)(bet + 4 * lane + 256 * j); }
    int kk = 0;
    f32x4 ph[4]; unsigned long long pa[4];
    const float* Hin = (ROUTER && l == 0) ? a->in[I_X] : H;
    if (ROUTER && gw < M) {
#pragma unroll
        for (int j = 0; j < 4; ++j) { ph[j] = *(const GAS f32x4*)(Hin + (size_t)gw * D + 4 * lane + 256 * j); pa[j] = *(const GAS unsigned long long*)(ADD + (size_t)gw * D + 4 * lane + 256 * j); } }
    for (int row = gw; row < M; row += NGW, ++kk) {
        f32x4 v[4]; float s = 0.f;
        if (ROUTER) {
#pragma unroll
            for (int j = 0; j < 4; ++j) { const f32x4 av = {bflo((unsigned)pa[j]), bfhi((unsigned)pa[j]), bflo((unsigned)(pa[j] >> 32)), bfhi((unsigned)(pa[j] >> 32))}; v[j] = ph[j] * DN_ALPHA + av; s += (v[j].x + v[j].y) + (v[j].z + v[j].w); }
            const int nrow = row + NGW < M ? row + NGW : row;
#pragma unroll
            for (int j = 0; j < 4; ++j) { ph[j] = *(const GAS f32x4*)(Hin + (size_t)nrow * D + 4 * lane + 256 * j); pa[j] = *(const GAS unsigned long long*)(ADD + (size_t)nrow * D + 4 * lane + 256 * j); }
        } else {
            const unsigned s0 = ((const GAS unsigned*)(a->ws + WS_SLOT))[2 * row], s1 = ((const GAS unsigned*)(a->ws + WS_SLOT))[2 * row + 1];
            const bf16* y0 = (const bf16*)(a->ws + WS_YS) + (size_t)(tab[s0 >> 16] + (int)(s0 & 0xffffu)) * D; const bf16* y1 = (const bf16*)(a->ws + WS_YS) + (size_t)(tab[s1 >> 16] + (int)(s1 & 0xffffu)) * D;
#pragma unroll
            for (int j = 0; j < 4; ++j) { const f32x4 hv = *(const GAS f32x4*)(H + (size_t)row * D + 4 * lane + 256 * j);
                const unsigned long long p0 = *(const GAS unsigned long long*)(y0 + 4 * lane + 256 * j), p1 = *(const GAS unsigned long long*)(y1 + 4 * lane + 256 * j);
                f32x4 av; av.x = bflo((unsigned)p0) + bflo((unsigned)p1); av.y = bfhi((unsigned)p0) + bfhi((unsigned)p1); av.z = bflo((unsigned)(p0 >> 32)) + bflo((unsigned)(p1 >> 32)); av.w = bfhi((unsigned)(p0 >> 32)) + bfhi((unsigned)(p1 >> 32));
                v[j] = hv * DN_ALPHA + av; s += (v[j].x + v[j].y) + (v[j].z + v[j].w); }
        }
        const float mean = wave_sum(s) * (1.f / D); float s2 = 0.f;
#pragma unroll
        for (int j = 0; j < 4; ++j) { v[j] = v[j] - mean; s2 += (v[j].x * v[j].x + v[j].y * v[j].y) + (v[j].z * v[j].z + v[j].w * v[j].w); }
        const float rstd = rsqrtf(wave_sum(s2) * (1.f / D) + LN_EPS);
#pragma unroll
        for (int j = 0; j < 4; ++j) { v[j] = v[j] * rstd * gv[j] + bv[j];
            *(GAS f32x4*)(H + (size_t)row * D + 4 * lane + 256 * j) = v[j];
            *(GAS unsigned long long*)(HB + (size_t)row * D + 4 * lane + 256 * j) = (unsigned long long)pk2(v[j].x, v[j].y) | ((unsigned long long)pk2(v[j].z, v[j].w) << 32); }
        if (ROUTER) {
            float lg[20];
#pragma unroll 1
            for (int c = 0; c < 20; ++c) { float p = 0.f;
#pragma unroll
                for (int j = 0; j < 4; ++j) { const f32x4 wv = *(const LAS f32x4*)(sW + c * D + 4 * lane + 256 * j); p += (v[j].x * wv.x + v[j].y * wv.y) + (v[j].z * wv.z + v[j].w * wv.w); }
                p = wave_sum(p); if (lane == 0) sL[c] = p; }
#pragma unroll
            for (int c = 0; c < 20; ++c) lg[c] = sL[c];
            float pg[4], mx = -1e30f; int gi = 0;
#pragma unroll
            for (int c = 0; c < 4; ++c) { pg[c] = lg[c] + a->in[I_BRG][l * 4 + c]; if (pg[c] > mx) { mx = pg[c]; gi = c; } }
            float den = 0.f;
#pragma unroll
            for (int c = 0; c < 4; ++c) den += __expf(pg[c] - mx);
            const float g_p = 1.0f / den;
            float le[4], emx = -1e30f; int i1 = 0;
#pragma unroll
            for (int c = 0; c < 4; ++c) { float x = 0.f;
#pragma unroll
                for (int gg = 0; gg < 4; ++gg) x = (gi == gg) ? lg[4 + gg * 4 + c] + a->in[I_BRE][l * 16 + gg * 4 + c] : x;
                le[c] = x; if (x > emx) { emx = x; i1 = c; } }
            float e2mx = -1e30f; int i2 = 0;
#pragma unroll
            for (int c = 0; c < 4; ++c) if (c != i1 && le[c] > e2mx) { e2mx = le[c]; i2 = c; }
            const float x2 = __expf(e2mx - emx), w1 = g_p / (1.0f + x2), w2 = g_p * x2 / (1.0f + x2);
            if (lane < 2) {
                const int e = gi * 4 + (lane == 0 ? i1 : i2); const float wv = lane == 0 ? w1 : w2;
                if (kk < 8) { const int lp = __hip_atomic_fetch_add(sCnt + e, 1, __ATOMIC_RELAXED, __HIP_MEMORY_SCOPE_WORKGROUP); LAS unsigned* en = sEnt + ((wave * 8 + kk) * 2 + lane) * 4;
                    en[0] = (unsigned)row; en[1] = (unsigned)e; en[2] = (unsigned)lp; en[3] = __builtin_bit_cast(unsigned, wv); }
                else { const int pos = (int)__hip_atomic_fetch_add(cnt + e, 1u, RLX_AGENT);
                    ((GAS int*)(a->ws + WS_LTOK))[e * M + pos] = row; ((GAS float*)(a->ws + WS_LW))[e * M + pos] = wv; ((GAS unsigned*)(a->ws + WS_SLOT))[2 * row + lane] = ((unsigned)e << 16) | (unsigned)pos; }
            }
        }
    }
    if (ROUTER) {
        __syncthreads();
        if (tid < 16) sCnt[16 + tid] = (int)__hip_atomic_fetch_add(cnt + tid, (unsigned)sCnt[tid], RLX_AGENT);
        __syncthreads();
        const int nk = kk < 8 ? kk : 8;
        if (tid < MAXENT) { const int wv_ = tid >> 4, k_ = (tid >> 1) & 7;
            int nkw = 0;
#pragma unroll
            for (int k2 = 0; k2 < 8; ++k2) nkw += (wg * NWAVES + wv_ + k2 * NGW < M) ? 1 : 0;
            if (k_ < nkw) { const LAS unsigned* en = sEnt + tid * 4; const int e = (int)en[1], pos = sCnt[16 + e] + (int)en[2];
                ((GAS int*)(a->ws + WS_LTOK))[e * M + pos] = (int)en[0]; ((GAS unsigned*)(a->ws + WS_LW))[e * M + pos] = en[3]; ((GAS unsigned*)(a->ws + WS_SLOT))[2 * en[0] + (tid & 1)] = ((unsigned)e << 16) | (unsigned)pos; } }
        (void)nk;
    }
}
__device__ __forceinline__ void moe_gather_phase(CArgs a, int l, LAS unsigned char* lds, int wg, int G, int tid) {
    asm volatile("" : "+v"(tid));
    const int lane = tid & 63, gw = wg * NWAVES + (tid >> 6), NGW = G * NWAVES;
    moe_tables((gu32*)(a->ws + WS_CTL) + CW_CNT + l * 16, lds, tid);
    const LAS int* tab = (const LAS int*)(lds + LDS_OFF_TAB);
    const bf16* HB = (const bf16*)(a->ws + WS_HB); bf16* XS = (bf16*)(a->ws + WS_XS);
    for (int idx = gw; idx < 2 * M; idx += NGW) {
        int e = 0;
#pragma unroll
        for (int k = 1; k < 16; ++k) e += (tab[17 + k] <= idx) ? 1 : 0;
        const int pos = idx - tab[17 + e], dst = tab[e] + pos;
        const int row = ((const GAS int*)(a->ws + WS_LTOK))[e * M + pos];
        const v4u x0 = *(const GAS v4u*)(HB + (size_t)row * D + 8 * lane), x1 = *(const GAS v4u*)(HB + (size_t)row * D + 512 + 8 * lane);
        *(GAS v4u*)(XS + (size_t)dst * D + 8 * lane) = x0; *(GAS v4u*)(XS + (size_t)dst * D + 512 + 8 * lane) = x1;
        if (lane == 0) ((GAS float*)(a->ws + WS_WSORT))[dst] = ((const GAS float*)(a->ws + WS_LW))[e * M + pos];
    }
}

enum { P_IN = 0, P_PREP, P_SCAN, P_POST, P_OUT, P_LN1, P_GU, P_DN, P_LN2, NPH };
constexpr int N_PHASES = 1 + DEPTH * NPH;
__global__ void __launch_bounds__(NTHR, 2) fwd(Args args) {
    extern __shared__ __attribute__((aligned(16))) unsigned char lds_raw[];
    LAS unsigned char* lds = (LAS unsigned char*)lds_raw;
    volatile LAS unsigned* MISC = (volatile LAS unsigned*)(lds + MISC_OFF);
    const int tid = threadIdx.x, G = gridDim.x, bx = blockIdx.x;
    unsigned char* ws0 = args.ws;
    gu32* ctl = (gu32*)(ws0 + WS_CTL);
    for (int u = tid; u < (LDS_BYTES - LDSCTL_OFF) / 4; u += NTHR) ((LAS unsigned*)(lds + LDSCTL_OFF))[u] = 0u;
    __syncthreads();
    const int lo = args.ph_lo, hi = args.ph_hi;
    const bool use_bar = (hi - lo) > 1;
    XcdBarrier bar; bar.bar = (unsigned*)(ctl + CW_BAR); bar.x = 0; bar.st = nullptr;
    if (use_bar) bar = xcd_barrier_post((unsigned*)(ctl + CW_BAR), MISC + 8);
#define IN(k) (lo <= (k) && (k) < hi)
#define SEAM(k) do { if (IN(k) && IN((k) + 1)) xcd_barrier(bar); } while (0)

    if (IN(0)) { p0_prologue(ARGS_HERE(), lds, bx, G, tid); weights_phase(ARGS_HERE(), 0, 1, lds, bx, G, tid); SEAM(0); }

    for (int l = 0; l < DEPTH; ++l) {
        const int base = 1 + l * NPH;
        unsigned char* ws = ws0; asm volatile("" : "+s"(ws));
        if (IN(base + P_IN)) {
            pg8::Gemm g{(const pg8::bf16_t*)(ws + WS_HB), (const pg8::bf16_t*)(ws + WS_WIN), M, NPROJ, D}; pg8::StaticOrder S; S.init(M, NPROJ, G, bx);
            pg8::EpiBf16<0> E{(pg8::bf16_t*)(ws + WS_PROJ), NPROJ, nullptr, 0, 0, 1.f};
            pg8::gemm_phase<pg8::EpiBf16<0>, pg8::StaticOrder, true, true>(lds + RING_OFF, g, S, E);
            SEAM(base + P_IN);
        }
        if (IN(base + P_PREP)) {
            hgrn_prep_phase(ARGS_HERE(), l, lds, bx, G, tid);
            ssd_prep_phase(ARGS_HERE(), l, lds, bx, G, tid);
            gdn_prep_phase(ARGS_HERE(), l, lds, bx, G, tid);
            SEAM(base + P_PREP); }
        if (IN(base + P_SCAN)) {
            if (G >= 192) {
                if (bx < 64) { const int pr = bx & 7, hh = bx >> 3; ssd_scan_phase(ARGS_HERE(), l, lds, pr >> 1, (pr & 1) * 8 + hh, tid); }
                else if (bx < 96) { const int x = (bx - 64) & 7, y = (bx - 64) >> 3, pr = x * 2 + (y >> 1); gdn_scan_phase(ARGS_HERE(), l, lds, pr >> 2, pr & 3, y & 1, tid); }
                else if (bx < 160) { const int x = (bx - 96) & 7, y = (bx - 96) >> 3, pr = x * 2 + (y >> 2); hgrn_scan_phase(ARGS_HERE(), l, lds, pr >> 2, pr & 3, y & 3, tid); }
                else { weights_phase(ARGS_HERE(), l, 14, lds, bx - 160, G - 160, tid);
                       if (l + 1 < DEPTH) weights_phase(ARGS_HERE(), l + 1, 1, lds, bx - 160, G - 160, tid); }
            }
            SEAM(base + P_SCAN); }
        if (IN(base + P_POST)) { mix_post_phase(ARGS_HERE(), l, bx, G, tid); SEAM(base + P_POST); }
        if (IN(base + P_OUT)) {
            pg8::Gemm g{(const pg8::bf16_t*)(ws + WS_YMIX), (const pg8::bf16_t*)(ws + WS_WOUT), M, D, DMIX}; pg8::StaticOrder S; S.init(M, D, G, bx);
            pg8::EpiBf16<0> E{(pg8::bf16_t*)(ws + WS_MIX), D, nullptr, 0, 0, 1.f};
            pg8::gemm_phase<pg8::EpiBf16<0>, pg8::StaticOrder, true, true>(lds + RING_OFF, g, S, E);
            SEAM(base + P_OUT);
        }
        if (IN(base + P_LN1)) { CArgs a_ = ARGS_HERE(); ln_phase<true>(a_, l, a_->in[I_LN1G] + l * D, a_->in[I_LN1B] + l * D, lds, bx, G, tid); SEAM(base + P_LN1); }
        if (IN(base + P_GU)) {
            moe_tables(ctl + CW_CNT + l * 16, lds, tid);
            pg8::Gemm g{(const pg8::bf16_t*)(ws + WS_HB), (const pg8::bf16_t*)(ws + WS_WGU), MAXROWS, NGU, D}; pg8::MoeOrder<2, true> S{(const LAS int*)(lds + LDS_OFF_TAB), G, bx, (const int*)(ws + WS_LTOK), M};
            pg8::EpiSwiGLUs E{(pg8::bf16_t*)(ws + WS_HS), (const float*)(ws + WS_LW), M, (const LAS int*)(lds + LDS_OFF_TAB)};
            pg8::gemm_phase<pg8::EpiSwiGLUs, pg8::MoeOrder<2, true>, true, true>(lds + RING_OFF, g, S, E);
            SEAM(base + P_GU);
        }
        if (IN(base + P_DN)) {
            moe_tables(ctl + CW_CNT + l * 16, lds, tid);
            pg8::Gemm g{(const pg8::bf16_t*)(ws + WS_HS), (const pg8::bf16_t*)(ws + WS_WDN), MAXROWS, NEXP * D, DEXP}; pg8::MoeOrder<4> S{(const LAS int*)(lds + LDS_OFF_TAB), G, bx, nullptr, 0};
            pg8::EpiBf16s E{(pg8::bf16_t*)(ws + WS_YS)};
            pg8::gemm_phase<pg8::EpiBf16s, pg8::MoeOrder<4>, true, true>(lds + RING_OFF, g, S, E);
            SEAM(base + P_DN);
        }
        if (IN(base + P_LN2)) { CArgs a_ = ARGS_HERE(); ln_phase<false>(a_, l, a_->in[I_LN2G] + l * D, a_->in[I_LN2B] + l * D, lds, bx, G, tid); SEAM(base + P_LN2); }
    }
#undef IN
#undef SEAM
}

#ifndef MK_ONE_LAUNCH
#define MK_ONE_LAUNCH 1
#endif
extern "C" void kernel_launch(void* const* d_in, const int* in_sizes, int n_in, void* d_out, int out_size, void* d_ws, size_t ws_size, hipStream_t stream) {
    static int grid = 0;
    if (grid == 0) {
        if (n_in != 25 || out_size != M * D || ws_size < WS_END) { fprintf(stderr, "kernel_launch: unexpected shapes (n_in %d out %d ws %zu)\n", n_in, out_size, ws_size); grid = -1; return; }
        int dev = 0, cus = 0, per_cu = 0;
        if (hipGetDevice(&dev) != hipSuccess || hipDeviceGetAttribute(&cus, hipDeviceAttributeMultiprocessorCount, dev) != hipSuccess) { grid = -1; return; }
        if (hipFuncSetAttribute((const void*)fwd, hipFuncAttributeMaxDynamicSharedMemorySize, LDS_BYTES) != hipSuccess) { fprintf(stderr, "kernel_launch: hipFuncSetAttribute failed\n"); grid = -1; return; }
        if (hipOccupancyMaxActiveBlocksPerMultiprocessor(&per_cu, (const void*)fwd, NTHR, LDS_BYTES) != hipSuccess || per_cu < 1) { fprintf(stderr, "kernel_launch: occupancy query says %d\n", per_cu); (void)hipGetLastError(); grid = -1; return; }
        grid = cus;
    }
    if (grid < 0) return;
    if (hipMemsetAsync((char*)d_ws + WS_CTL, 0, CTL_ZERO_BYTES, stream) != hipSuccess) return;
    Args a{};
    for (int i = 0; i < 25; ++i) a.in[i] = (const float*)d_in[i];
    a.out = (float*)d_out; a.ws = (unsigned char*)d_ws;
#if MK_ONE_LAUNCH
    a.ph_lo = 0; a.ph_hi = N_PHASES;
    hipLaunchKernelGGL(fwd, dim3(grid), dim3(NTHR), LDS_BYTES, stream, a);
#else
    for (int p = 0; p < N_PHASES; ++p) { a.ph_lo = p; a.ph_hi = p + 1; hipLaunchKernelGGL(fwd, dim3(grid), dim3(NTHR), LDS_BYTES, stream, a); }
#endif
}
```

```cpp
#include <hip/hip_runtime.h>
#include <cstdio>
#include <cstdint>
namespace pg8 {
#define PG8_LAS __attribute__((address_space(3)))
typedef unsigned short bf16_t;
typedef short bf16x8 __attribute__((ext_vector_type(8)));
typedef float f32x4 __attribute__((ext_vector_type(4)));
typedef unsigned u32x4 __attribute__((ext_vector_type(4)));
constexpr int BM = 256, BK = 64, HALF = 128, HTB = HALF * BK * 2  , STAGE_BYTES = 8 * HTB, NXCD = 8, WGM = 8;

__host__ __device__ __forceinline__ int lds_byte(int r, int c) { const int st = (r >> 4) * 2 + (c >> 5), rr = r & 15, cc = c & 31, ob = rr * 64 + cc * 2; return st * 1024 + (ob ^ (((ob >> 9) & 1) << 5)); }
__host__ __device__ __forceinline__ void stage_rc(int b, int& R, int& C) { const int st = b / 1024, sb = b % 1024, swz = sb ^ (((sb >> 9) & 1) << 5); R = (st >> 1) * 16 + swz / 64; C = (st & 1) * 32 + (swz % 64) / 2; }
__host__ __device__ __forceinline__ int perm32(int rho) { const int n = rho >> 4, i = rho & 15; return 8 * (i >> 2) + 4 * n + (i & 3); }

struct Unit { int pm, pn; };
struct Gemm { const bf16_t* A; const bf16_t* Bt; int M, N, K; };

struct StaticOrder {
    static constexpr bool GATHER = false;
    int nM, nN, nwg, G, c;
    __host__ __device__ void init(int M, int N, int G_, int c_) { nM = M / BM; nN = N / BM; nwg = nM * nN; G = G_; c = c_; }
    __host__ __device__ bool next(int i, Unit& u) const {
        const long L = (long)i * G + c; if (L >= nwg) return false;
        int wgid = (int)L; { const int q = nwg / NXCD, r = nwg % NXCD, xcd = wgid % NXCD, off = wgid / NXCD; wgid = (xcd < r ? xcd * (q + 1) : r * (q + 1) + (xcd - r) * q) + off; }
        const int nig = WGM * nN, gid = wgid / nig, fm = gid * WGM, gsz = (nM - fm) < WGM ? (nM - fm) : WGM;
        u.pm = fm + ((wgid % nig) % gsz); u.pn = (wgid % nig) / gsz; return true;
    }
    __device__ __forceinline__ void a_ready(const Unit&) const {}
    __device__ __forceinline__ void done(const Unit&) const {}
    __device__ __forceinline__ int row_token(int, const Unit&) const { return 0; }
};
__device__ __forceinline__ unsigned cvt_pk_bf16(float lo, float hi) { unsigned r; asm volatile("v_cvt_pk_bf16_f32 %0, %1, %2" : "=v"(r) : "v"(lo), "v"(hi)); return r; }
typedef float f32x2 __attribute__((ext_vector_type(2)));
__device__ __forceinline__ f32x2 gelu_pk(f32x2 v) {
    const f32x2 av = __builtin_elementwise_abs(v), d = av * 0.2316418882f + 1.0f;
    f32x2 t; t.x = __builtin_amdgcn_rcpf(d.x); t.y = __builtin_amdgcn_rcpf(d.y);
    f32x2 q = t * 0.5307027145f + (-0.7265760135f); q = q * t + 0.7107068705f; q = q * t + (-0.142248368f); q = q * t + 0.127414796f; q = q * t;
    const f32x2 s = (v * v) * (-0.72134752044f);
    f32x2 e; e.x = __builtin_amdgcn_exp2f(s.x); e.y = __builtin_amdgcn_exp2f(s.y);
    const f32x2 m = v * (q * e), r = v - m;
    f32x2 o; o.x = v.x < 0.f ? m.x : r.x; o.y = v.y < 0.f ? m.y : r.y; return o;
}

template <int ACT  > struct EpiBf16 {
    static constexpr bool PERM = true, AFTER_DRAIN = false; static_assert(ACT == 0 || ACT == 1, "EpiBf16: ACT is 0 (none) or 1 (gelu_pk)");
    bf16_t* O; int ldc; const float* bias; int split_cols; size_t split_stride; float scale0;
    __device__ __forceinline__ void operator()(const f32x4 (&acc)[2][2][4][2], const Unit& u, int wr, int wc, int fr, int fq) const {
        const int row0 = u.pm * BM + wr * 64 + fr; int colt = u.pn * BM; bf16_t* base = O;
        float sc = 1.f; if (split_cols) { const int t = colt / split_cols; base += (size_t)t * split_stride; colt -= t * split_cols; if (t == 0) sc = scale0; }
        const int col0 = colt + wc * 32 + 8 * fq, bcol0 = u.pn * BM + wc * 32 + 8 * fq;
        f32x4 bv[2][2];
#pragma unroll
        for (int bj = 0; bj < 2; ++bj)
#pragma unroll
            for (int n = 0; n < 2; ++n) bv[bj][n] = bias ? *(const f32x4*)(bias + bcol0 + bj * HALF + 4 * n) : (f32x4){0.f, 0.f, 0.f, 0.f};
#pragma unroll
        for (int ai = 0; ai < 2; ++ai)
#pragma unroll
            for (int m = 0; m < 4; ++m) { bf16_t* rowp = base + (size_t)(row0 + ai * HALF + m * 16) * ldc + col0;
#pragma unroll
                for (int bj = 0; bj < 2; ++bj) { f32x4 v0 = acc[ai][bj][m][0] + bv[bj][0], v1 = acc[ai][bj][m][1] + bv[bj][1];
                    if (ACT == 1) { f32x2 a = gelu_pk((f32x2){v0[0], v0[1]}), b = gelu_pk((f32x2){v0[2], v0[3]}), c = gelu_pk((f32x2){v1[0], v1[1]}), d = gelu_pk((f32x2){v1[2], v1[3]});
                        v0 = (f32x4){a.x, a.y, b.x, b.y}; v1 = (f32x4){c.x, c.y, d.x, d.y}; }
                    v0 = v0 * sc; v1 = v1 * sc; u32x4 w; w.x = cvt_pk_bf16(v0[0], v0[1]); w.y = cvt_pk_bf16(v0[2], v0[3]); w.z = cvt_pk_bf16(v1[0], v1[1]); w.w = cvt_pk_bf16(v1[2], v1[3]);
                    *(u32x4*)(rowp + bj * HALF) = w; } }
    }
};
struct EpiF32 {
    static constexpr bool PERM = false, AFTER_DRAIN = false;
    float* C; int ldc;
    __device__ __forceinline__ void operator()(const f32x4 (&acc)[2][2][4][2], const Unit& u, int wr, int wc, int fr, int fq) const {
        const int row0 = u.pm * BM + wr * 64 + fr, col0 = u.pn * BM + wc * 32 + 4 * fq;
#pragma unroll
        for (int ai = 0; ai < 2; ++ai)
#pragma unroll
            for (int m = 0; m < 4; ++m) { float* rowp = C + (size_t)(row0 + ai * HALF + m * 16) * ldc + col0;
#pragma unroll
                for (int bj = 0; bj < 2; ++bj)
#pragma unroll
                    for (int n = 0; n < 2; ++n) *(f32x4*)(rowp + bj * HALF + n * 16) = acc[ai][bj][m][n]; }
    }
};
__device__ __forceinline__ float silu_f(float x) { return x * __builtin_amdgcn_rcpf(1.0f + __expf(-x)); }
struct EpiSwiGLU {
    static constexpr bool PERM = true, AFTER_DRAIN = false;
    bf16_t* H; int ldh; const float* comb; int ldcomb;
    __device__ __forceinline__ void operator()(const f32x4 (&acc)[2][2][4][2], const Unit& u, int wr, int wc, int fr, int fq) const {
        const int row0 = u.pm * BM + wr * 64 + fr, col0 = u.pn * 128 + wc * 32 + 8 * fq, e = u.pn >> 1;
#pragma unroll
        for (int ai = 0; ai < 2; ++ai)
#pragma unroll
            for (int m = 0; m < 4; ++m) { const int row = row0 + ai * HALF + m * 16; const float cw = comb[(size_t)row * ldcomb + e];
                const f32x4 g0 = acc[ai][0][m][0], g1 = acc[ai][0][m][1], u0 = acc[ai][1][m][0], u1 = acc[ai][1][m][1];
                f32x4 h0, h1;
#pragma unroll
                for (int j = 0; j < 4; ++j) { h0[j] = silu_f(g0[j]) * u0[j] * cw; h1[j] = silu_f(g1[j]) * u1[j] * cw; }
                u32x4 w; w.x = cvt_pk_bf16(h0[0], h0[1]); w.y = cvt_pk_bf16(h0[2], h0[3]); w.z = cvt_pk_bf16(h1[0], h1[1]); w.w = cvt_pk_bf16(h1[2], h1[3]);
                *(u32x4*)(H + (size_t)row * ldh + col0) = w; }
    }
};

template <int NSUB, bool GATHER_ = false> struct MoeOrder {
    static constexpr bool GATHER = GATHER_;
    const PG8_LAS int* off; int G, c; const int* ltok; int lstride;
    __device__ __forceinline__ int row_token(int srow, const Unit& u) const { const int e = u.pn / NSUB, pos = srow - off[e]; return pos < off[18 + e] - off[17 + e] ? ltok[e * lstride + pos] : 0; }
    __device__ __forceinline__ bool next(int i, Unit& u) const {
        const int L = i * G + c, x = L & 7, j = L >> 3, t = x + 8 * (j / NSUB), pnl = j % NSUB;
        if (t * 256 >= off[16]) return false;
        int e = 0;
#pragma unroll
        for (int k = 1; k < 16; ++k) e += (off[k] <= t * 256) ? 1 : 0;
        u.pm = t; u.pn = e * NSUB + pnl; return true;
    }
    __device__ __forceinline__ void a_ready(const Unit&) const {}
    __device__ __forceinline__ void done(const Unit&) const {}
};
struct EpiSwiGLUs {
    static constexpr bool PERM = true, AFTER_DRAIN = false;
    bf16_t* H; const float* lw; int lstride; const PG8_LAS int* off;
    __device__ __forceinline__ void operator()(const f32x4 (&acc)[2][2][4][2], const Unit& u, int wr, int wc, int fr, int fq) const {
        const int row0 = u.pm * BM + wr * 64 + fr, col0 = (u.pn & 1) * 128 + wc * 32 + 8 * fq;
#pragma unroll
        for (int ai = 0; ai < 2; ++ai)
#pragma unroll
            for (int m = 0; m < 4; ++m) { const int row = row0 + ai * HALF + m * 16; const int e_ = u.pn >> 1, pos_ = row - off[e_]; const float cw = pos_ < off[18 + e_] - off[17 + e_] ? lw[e_ * lstride + pos_] : 0.f;
                const f32x4 g0 = acc[ai][0][m][0], g1 = acc[ai][0][m][1], u0 = acc[ai][1][m][0], u1 = acc[ai][1][m][1];
                f32x4 h0, h1;
#pragma unroll
                for (int j = 0; j < 4; ++j) { h0[j] = silu_f(g0[j]) * u0[j] * cw; h1[j] = silu_f(g1[j]) * u1[j] * cw; }
                u32x4 w; w.x = cvt_pk_bf16(h0[0], h0[1]); w.y = cvt_pk_bf16(h0[2], h0[3]); w.z = cvt_pk_bf16(h1[0], h1[1]); w.w = cvt_pk_bf16(h1[2], h1[3]);
                *(u32x4*)(H + (size_t)row * 256 + col0) = w; }
    }
};
struct EpiBf16s {
    static constexpr bool PERM = true, AFTER_DRAIN = false;
    bf16_t* O;
    __device__ __forceinline__ void operator()(const f32x4 (&acc)[2][2][4][2], const Unit& u, int wr, int wc, int fr, int fq) const {
        const int row0 = u.pm * BM + wr * 64 + fr, col0 = (u.pn & 3) * BM + wc * 32 + 8 * fq;
#pragma unroll
        for (int ai = 0; ai < 2; ++ai)
#pragma unroll
            for (int m = 0; m < 4; ++m) { bf16_t* rowp = O + (size_t)(row0 + ai * HALF + m * 16) * 1024 + col0;
#pragma unroll
                for (int bj = 0; bj < 2; ++bj) { const f32x4 v0 = acc[ai][bj][m][0], v1 = acc[ai][bj][m][1];
                    u32x4 w; w.x = cvt_pk_bf16(v0[0], v0[1]); w.y = cvt_pk_bf16(v0[2], v0[3]); w.z = cvt_pk_bf16(v1[0], v1[1]); w.w = cvt_pk_bf16(v1[2], v1[3]);
                    *(u32x4*)(rowp + bj * HALF) = w; } }
    }
};
template <class Epi, class Sched, bool ALIGN_EPI = false, bool SP2 = false>
__device__ __forceinline__ void gemm_phase(PG8_LAS unsigned char* lds, const Gemm g, const Sched& S, const Epi& E) {
    int tid_ = threadIdx.x; asm volatile("" : "+v"(tid_));
    const int tid = tid_, wid = __builtin_amdgcn_readfirstlane(tid >> 6), lane = tid & 63, wr = wid >> 2, wc = wid & 3, fr = lane & 15, fq = lane >> 4;
    const int K = g.K, nt = K / BK;
    unsigned voffA[2], voffB[2];
#pragma unroll
    for (int i = 0; i < 2; ++i) { int R, C; stage_rc(tid * 16 + i * 8192, R, C); const int Rb = Epi::PERM ? ((R & ~31) + perm32(R & 31)) : R;
        voffA[i] = (unsigned)(R * K + C) * 2u; voffB[i] = (unsigned)(Rb * K + C) * 2u; }
    constexpr bool GATHER = Sched::GATHER; static_assert(!GATHER || SP2, "the gather path is written for the two-super-phase loop");
    int gR[2], gC[2];
#pragma unroll
    for (int i = 0; i < 2; ++i) stage_rc(tid * 16 + i * 8192, gR[i], gC[i]);
    unsigned vA0[2] = {0u, 0u}, vA1[2] = {0u, 0u}, nvA0[2] = {0u, 0u}, nvA1[2] = {0u, 0u};
#define PG8_GLOOK(U, D0, D1) do { _Pragma("unroll") for (int _i = 0; _i < 2; ++_i) { \
        D0[_i] = (unsigned)S.row_token((U).pm * BM + gR[_i], (U)) * (unsigned)(K * 2) + (unsigned)gC[_i] * 2u; D1[_i] = (unsigned)S.row_token((U).pm * BM + HALF + gR[_i], (U)) * (unsigned)(K * 2) + (unsigned)gC[_i] * 2u; } } while (0)
    const size_t kstep = (size_t)(BK * 2);
    const size_t hstep = (size_t)HALF * K * 2;
    const size_t tstep = 2 * hstep;
    const unsigned ldsw = (unsigned)wid * 1024u;
    const int aoff = lds_byte(wr * 64 + fr, fq * 8), boff = lds_byte(wc * 32 + fr, fq * 8);
#define PG8_SA(b, h) (((b) * 2 + (h)) * HTB)
#define PG8_SB(b, h) ((4 + (b) * 2 + (h)) * HTB)
#define PG8_STAGE(bufoff, gbase, voff) do { _Pragma("unroll") for (int _i = 0; _i < 2; ++_i) \
        __builtin_amdgcn_global_load_lds((const unsigned*)((const char*)(gbase) + (voff)[_i]), (PG8_LAS unsigned*)(lds + (bufoff) + ldsw + _i * 8192), 16, 0, 0); } while (0)
#define PG8_LDA(dst, b, h) do { _Pragma("unroll") for (int m = 0; m < 4; ++m) _Pragma("unroll") for (int k = 0; k < 2; ++k) dst[m][k] = *(const PG8_LAS bf16x8*)(lds + PG8_SA(b, h) + aoff + m * 2048 + k * 1024); } while (0)
#define PG8_LDB(dst, b, h) do { _Pragma("unroll") for (int n = 0; n < 2; ++n) _Pragma("unroll") for (int k = 0; k < 2; ++k) dst[n][k] = *(const PG8_LAS bf16x8*)(lds + PG8_SB(b, h) + boff + n * 2048 + k * 1024); } while (0)
#define PG8_MMA(ai, bj, At, Bt) do { __builtin_amdgcn_s_setprio(1); _Pragma("unroll") for (int m = 0; m < 4; ++m) _Pragma("unroll") for (int n = 0; n < 2; ++n) _Pragma("unroll") for (int k = 0; k < 2; ++k) \
        acc[ai][bj][m][n] = __builtin_amdgcn_mfma_f32_16x16x32_bf16(Bt[n][k], At[m][k], acc[ai][bj][m][n], 0, 0, 0); __builtin_amdgcn_s_setprio(0); } while (0)
#define PG8_WAIT_V(n) asm volatile("s_waitcnt vmcnt(" #n ")" ::: "memory")
#define PG8_WAIT_L(n) asm volatile("s_waitcnt lgkmcnt(" #n ")" ::: "memory")
#define PG8_BAR __builtin_amdgcn_s_barrier()
#define PG8_SCHED __builtin_amdgcn_sched_barrier(0)
    Unit cur, nxt; int ui = 0;
    if (!S.next(0, cur)) return;
    f32x4 acc[2][2][4][2];
#pragma unroll
    for (int a = 0; a < 2; ++a)
#pragma unroll
        for (int b = 0; b < 2; ++b)
#pragma unroll
            for (int m = 0; m < 4; ++m)
#pragma unroll
                for (int n = 0; n < 2; ++n) acc[a][b][m][n] = (f32x4){0.f, 0.f, 0.f, 0.f};
    bf16x8 At[4][2], B0[2][2], B1[2][2];
    const char* cA = (const char*)g.A + (GATHER ? (size_t)0 : (size_t)cur.pm * tstep); const char* cB = (const char*)g.Bt + (size_t)cur.pn * tstep;
    if constexpr (GATHER) PG8_GLOOK(cur, vA0, vA1);
    S.a_ready(cur);
    if constexpr (SP2) {
        PG8_STAGE(PG8_SB(0, 0), cB, voffB); PG8_STAGE(PG8_SB(0, 1), cB + hstep, voffB);
        if constexpr (GATHER) { PG8_STAGE(PG8_SA(0, 0), cA, vA0); PG8_STAGE(PG8_SA(0, 1), cA, vA1); } else { PG8_STAGE(PG8_SA(0, 0), cA, voffA); PG8_STAGE(PG8_SA(0, 1), cA + hstep, voffA); }
        if (wr == 1) PG8_BAR;
        PG8_WAIT_V(2); PG8_BAR;
        PG8_STAGE(PG8_SB(1, 0), cB + kstep, voffB); if constexpr (GATHER) PG8_STAGE(PG8_SA(1, 0), cA + kstep, vA0); else PG8_STAGE(PG8_SA(1, 0), cA + kstep, voffA); PG8_STAGE(PG8_SB(1, 1), cB + hstep + kstep, voffB);
        PG8_WAIT_V(6); PG8_BAR;
    } else {
        PG8_STAGE(PG8_SB(0, 0), cB, voffB); PG8_STAGE(PG8_SA(0, 0), cA, voffA); PG8_STAGE(PG8_SB(0, 1), cB + hstep, voffB); PG8_STAGE(PG8_SA(0, 1), cA + hstep, voffA);
        if (wr == 1) PG8_BAR;
        PG8_WAIT_V(4); PG8_BAR;
        PG8_STAGE(PG8_SB(1, 0), cB + kstep, voffB); PG8_STAGE(PG8_SA(1, 0), cA + kstep, voffA); PG8_STAGE(PG8_SB(1, 1), cB + hstep + kstep, voffB);
        PG8_WAIT_V(6); PG8_BAR;
    }
    for (;;) {
        const bool has_next = S.next(ui + 1, nxt);
        const char* nA = (has_next && !GATHER) ? (const char*)g.A + (size_t)nxt.pm * tstep : cA; const char* nB = has_next ? (const char*)g.Bt + (size_t)nxt.pn * tstep : cB;
        if constexpr (GATHER) { if (has_next) PG8_GLOOK(nxt, nvA0, nvA1); else { nvA0[0] = vA0[0]; nvA0[1] = vA0[1]; nvA1[0] = vA1[0]; nvA1[1] = vA1[1]; } }
#pragma unroll 1
        for (int t = 0; t < nt; t += 2) {
            const bool last = (t == nt - 2);
            const char* a1 = cA + (size_t)(t + 1) * kstep;
            const char* a2 = last ? nA : cA + (size_t)(t + 2) * kstep; const char* b2 = last ? nB : cB + (size_t)(t + 2) * kstep;
            const char* a3 = a2 + kstep; const char* b3 = b2 + kstep;
            if (last && has_next) S.a_ready(nxt);
            if constexpr (SP2) {
            PG8_LDB(B0, 0, 0); PG8_LDB(B1, 0, 1); PG8_SCHED; PG8_LDA(At, 0, 0); if constexpr (GATHER) PG8_STAGE(PG8_SA(1, 1), a1, vA1); else PG8_STAGE(PG8_SA(1, 1), a1 + hstep, voffA);
            PG8_WAIT_V(8); PG8_WAIT_L(0); PG8_BAR; PG8_MMA(0, 0, At, B0); PG8_MMA(0, 1, At, B1); PG8_BAR; PG8_SCHED;
            PG8_LDA(At, 0, 1); PG8_STAGE(PG8_SB(0, 0), b2, voffB); PG8_STAGE(PG8_SB(0, 1), b2 + hstep, voffB); if constexpr (GATHER) { unsigned v_[2] = {last ? nvA0[0] : vA0[0], last ? nvA0[1] : vA0[1]}; PG8_STAGE(PG8_SA(0, 0), a2, v_); } else PG8_STAGE(PG8_SA(0, 0), a2, voffA);
            PG8_WAIT_V(8); PG8_WAIT_L(0); PG8_BAR; PG8_MMA(1, 0, At, B0); PG8_MMA(1, 1, At, B1); PG8_BAR; PG8_SCHED;
            PG8_LDB(B0, 1, 0); PG8_LDB(B1, 1, 1); PG8_SCHED; PG8_LDA(At, 1, 0); if constexpr (GATHER) { unsigned v_[2] = {last ? nvA1[0] : vA1[0], last ? nvA1[1] : vA1[1]}; PG8_STAGE(PG8_SA(0, 1), a2, v_); } else PG8_STAGE(PG8_SA(0, 1), a2 + hstep, voffA);
            PG8_WAIT_V(8); PG8_WAIT_L(0); PG8_BAR; PG8_MMA(0, 0, At, B0); PG8_MMA(0, 1, At, B1); PG8_BAR; PG8_SCHED;
            PG8_LDA(At, 1, 1); PG8_STAGE(PG8_SB(1, 0), b3, voffB); PG8_STAGE(PG8_SB(1, 1), b3 + hstep, voffB); if constexpr (GATHER) { unsigned v_[2] = {last ? nvA0[0] : vA0[0], last ? nvA0[1] : vA0[1]}; PG8_STAGE(PG8_SA(1, 0), a3, v_); } else PG8_STAGE(PG8_SA(1, 0), a3, voffA);
            PG8_WAIT_V(8); PG8_WAIT_L(0); PG8_BAR; PG8_MMA(1, 0, At, B0); PG8_MMA(1, 1, At, B1); PG8_BAR; PG8_SCHED;
            } else {
            PG8_LDB(B0, 0, 0); PG8_SCHED; PG8_LDA(At, 0, 0); PG8_STAGE(PG8_SA(1, 1), a1 + hstep, voffA);
            PG8_WAIT_L(8); PG8_BAR; PG8_WAIT_L(0); PG8_MMA(0, 0, At, B0); PG8_BAR; PG8_SCHED;
            PG8_LDB(B1, 0, 1); PG8_STAGE(PG8_SB(0, 0), b2, voffB);
            PG8_BAR; PG8_WAIT_L(0); PG8_MMA(0, 1, At, B1); PG8_BAR;
            PG8_LDA(At, 0, 1); PG8_STAGE(PG8_SA(0, 0), a2, voffA);
            PG8_BAR; PG8_WAIT_L(0); PG8_MMA(1, 0, At, B0); PG8_BAR; PG8_SCHED;
            PG8_STAGE(PG8_SB(0, 1), b2 + hstep, voffB);
            PG8_WAIT_V(6); PG8_BAR; PG8_MMA(1, 1, At, B1); PG8_BAR;
            PG8_LDB(B0, 1, 0); PG8_SCHED; PG8_LDA(At, 1, 0); PG8_STAGE(PG8_SA(0, 1), a2 + hstep, voffA);
            PG8_WAIT_L(8); PG8_BAR; PG8_WAIT_L(0); PG8_MMA(0, 0, At, B0); PG8_BAR; PG8_SCHED;
            PG8_LDB(B1, 1, 1); PG8_STAGE(PG8_SB(1, 0), b3, voffB);
            PG8_BAR; PG8_WAIT_L(0); PG8_MMA(0, 1, At, B1); PG8_BAR;
            PG8_LDA(At, 1, 1); PG8_STAGE(PG8_SA(1, 0), a3, voffA);
            PG8_BAR; PG8_WAIT_L(0); PG8_MMA(1, 0, At, B0); PG8_BAR; PG8_SCHED;
            PG8_STAGE(PG8_SB(1, 1), b3 + hstep, voffB);
            PG8_WAIT_V(6); PG8_BAR; PG8_MMA(1, 1, At, B1); PG8_BAR;
            }
        }
        if constexpr (ALIGN_EPI) { if (wr == 0) PG8_BAR; }
        if constexpr (!Epi::AFTER_DRAIN) { E(acc, cur, wr, wc, fr, fq); S.done(cur); }
        if (!has_next) break;
#pragma unroll
        for (int a = 0; a < 2; ++a)
#pragma unroll
            for (int b = 0; b < 2; ++b)
#pragma unroll
                for (int m = 0; m < 4; ++m)
#pragma unroll
                    for (int n = 0; n < 2; ++n) acc[a][b][m][n] = (f32x4){0.f, 0.f, 0.f, 0.f};
        cur = nxt; cA = nA; cB = nB; ++ui;
        if constexpr (GATHER) { vA0[0] = nvA0[0]; vA0[1] = nvA0[1]; vA1[0] = nvA1[0]; vA1[1] = nvA1[1]; }
        if constexpr (ALIGN_EPI) { if (wr == 1) PG8_BAR; }
    }
    PG8_WAIT_V(0);
    if constexpr (!ALIGN_EPI) { if (wr == 0) PG8_BAR; }
    PG8_BAR;
    if constexpr (Epi::AFTER_DRAIN) { E.fused(acc, cur, wr, wc, fr, fq, lds, wid, lane); S.done(cur); }
#undef PG8_GLOOK
#undef PG8_SA
#undef PG8_SB
#undef PG8_STAGE
#undef PG8_LDA
#undef PG8_LDB
#undef PG8_MMA
#undef PG8_WAIT_V
#undef PG8_WAIT_L
#undef PG8_BAR
#undef PG8_SCHED
}
}
#define GAS __attribute__((address_space(1)))
#define LAS __attribute__((address_space(3)))
typedef unsigned short bf16;
typedef unsigned v4u __attribute__((ext_vector_type(4)));
typedef float f32x4 __attribute__((ext_vector_type(4)));
typedef short bf16x8 __attribute__((ext_vector_type(8)));
typedef GAS unsigned gu32;
typedef GAS unsigned long long gu64;
#define RLX_AGENT __ATOMIC_RELAXED, __HIP_MEMORY_SCOPE_AGENT
#define LDS_WAIT() asm volatile("s_waitcnt lgkmcnt(0)" ::: "memory")
#define VM_WAIT() asm volatile("s_waitcnt vmcnt(0)" ::: "memory")
__device__ __forceinline__ unsigned long long rt() { return __builtin_amdgcn_s_memrealtime(); }
typedef __bf16 bf16x2_hw __attribute__((ext_vector_type(2)));
__device__ __forceinline__ unsigned pk2(float lo, float hi) { bf16x2_hw v; v.x = (__bf16)lo; v.y = (__bf16)hi; return __builtin_bit_cast(unsigned, v); }
__device__ __forceinline__ unsigned f2bf(float f) { return pk2(f, 0.f) & 0xffffu; }

#define XB_TMO      128
#define XB_XCNT(j)  (256  + 64 * (j))
#define XB_XSUB(j)  (1280 + 64 * (j))
#define XB_XGEN(j)  (2304 + 64 * (j))
#define XB_TOP      3328
#define XB_TOPGEN   3392
#define XCD_BAR_WORDS 3456
#define XB_SPIN_CAP (1u << 18)

__device__ __forceinline__ unsigned xb_ld(unsigned* p)              { return __hip_atomic_load(p, __ATOMIC_RELAXED, __HIP_MEMORY_SCOPE_AGENT); }
__device__ __forceinline__ unsigned xb_add(unsigned* p, unsigned v) { return __hip_atomic_fetch_add(p, v, __ATOMIC_RELAXED, __HIP_MEMORY_SCOPE_AGENT); }
__device__ __forceinline__ unsigned xb_xcc_id() { return (unsigned)__builtin_amdgcn_s_getreg((3 << 11) | 20) & 0xFu; }
#define XB_SPIN(cond, bar) do { unsigned _sp = 0; while (cond) { __builtin_amdgcn_s_sleep(1); \
    if ((++_sp & 255u) == 0u) { if (xb_ld(&(bar)[XB_TMO])) break; if (_sp > XB_SPIN_CAP) { atomicAdd(&(bar)[XB_TMO], 1u); break; } } } } while (0)

struct XcdBarrier {
    unsigned* bar; unsigned x;
    volatile LAS unsigned* st;
};

__device__ __forceinline__ XcdBarrier xcd_barrier_post(unsigned* bar, volatile LAS unsigned* st) {
    XcdBarrier b; b.bar = bar; b.x = xb_xcc_id(); b.st = st;
    if (threadIdx.x == 0) (void)xb_add(&bar[XB_XCNT(b.x)], 1u);
    return b;
}
__device__ __forceinline__ void xcd_barrier_complete(unsigned* bar, unsigned x, unsigned& nloc, unsigned& nx) {
    const unsigned G = gridDim.x * gridDim.y * gridDim.z;
    unsigned sum, cnt, mine, sp = 0u;
    for (;;) {
        sum = 0u; cnt = 0u; mine = 0u;
#pragma unroll
        for (unsigned j = 0; j < 16; ++j) { const unsigned c = xb_ld(&bar[XB_XCNT(j)]); sum += c; cnt += (c > 0u) ? 1u : 0u; mine = (j == x) ? c : mine; }
        if (sum == G) break;
        __builtin_amdgcn_s_sleep(1);
        if ((++sp & 255u) == 0u) { if (xb_ld(&bar[XB_TMO])) break; if (sp > XB_SPIN_CAP) { atomicAdd(&bar[XB_TMO], 1u); break; } }
    }
    nloc = mine > 0u ? mine : 1u; nx = cnt > 0u ? cnt : 1u;
}

__device__ __forceinline__ void xcd_barrier(const XcdBarrier& b) {
    asm volatile("s_waitcnt vmcnt(0)" ::: "memory");
    __syncthreads();
    if (threadIdx.x == 0) {
        unsigned* bar = b.bar;
        __builtin_amdgcn_s_waitcnt(0);
        unsigned nloc = b.st[0], nx = b.st[1];
        if (nloc == 0u) { xcd_barrier_complete(bar, b.x, nloc, nx); b.st[0] = nloc; b.st[1] = nx; }
        const unsigned old = xb_add(&bar[XB_XSUB(b.x)], 1u);
        const unsigned gen = old / nloc;
        if (old + 1u == (gen + 1u) * nloc) {
            __builtin_amdgcn_fence(__ATOMIC_RELEASE, "agent");
            asm volatile("s_waitcnt vmcnt(0)" ::: "memory");
            const unsigned og = xb_add(&bar[XB_TOP], 1u);
            const unsigned tg = og / nx;
            if (og + 1u == (tg + 1u) * nx) xb_add(&bar[XB_TOPGEN], 1u);
            else XB_SPIN(xb_ld(&bar[XB_TOPGEN]) == tg, bar);
            __builtin_amdgcn_fence(__ATOMIC_ACQUIRE, "agent");
            xb_add(&bar[XB_XGEN(b.x)], 1u);
            asm volatile("s_waitcnt vmcnt(0)" ::: "memory");
        } else {
            XB_SPIN(xb_ld(&bar[XB_XGEN(b.x)]) == gen, bar);
            __builtin_amdgcn_fence(__ATOMIC_ACQUIRE, "agent");
            asm volatile("s_waitcnt vmcnt(0)" ::: "memory");
        }
    }
    __syncthreads();
}
constexpr int NWAVES = 8, NTHR = NWAVES * 64;
constexpr int D = 1024, BATCH = 4, SEQ = 4096, M = BATCH * SEQ, DEPTH = 4;
constexpr int IN_COLS = 6680, NPROJ = 6912;
constexpr int O_Z = 0, O_XBC = 1024, O_DT = 2560, O_QKV = 2576, O_GG = 4112, O_GB = 4624, O_GA = 4628, O_HQ = 4632, O_HF = 5144, O_HI = 5656, O_HG = 6168;
constexpr int DMIX = 2048, NEXP = 16, DEXP = 256, NGU = NEXP * 2 * DEXP  , KDN = NEXP * DEXP  ;
constexpr float DN_ALPHA = 1.6817928305074290f;
constexpr float LN_EPS = 1e-5f;

constexpr size_t MiB = 1u << 20;
constexpr size_t WS_CTL = 0, CTL_ZERO_BYTES = 1 * MiB;
constexpr size_t WS_LTOK = 2 * MiB;
constexpr size_t WS_LW = 3 * MiB;
constexpr size_t WS_SLOT = 4 * MiB;
constexpr size_t WS_WSORT = 5 * MiB;
constexpr size_t WS_WIN = 8 * MiB;
constexpr size_t WS_WOUT = 22 * MiB;
constexpr size_t WS_WGU = 26 * MiB;
constexpr size_t WS_WDN = 42 * MiB;
constexpr size_t WS_YMIX = 52 * MiB;
constexpr size_t WS_HB = WS_YMIX;
constexpr size_t WS_PROJ = 116 * MiB;
constexpr size_t WS_MIX = WS_PROJ;
constexpr int MAXROWS = 2 * M + 16 * 256;
constexpr size_t WS_XS = WS_PROJ + 64 * MiB;
constexpr size_t WS_HS = WS_PROJ + 136 * MiB;
constexpr size_t WS_YS = WS_PROJ + 154 * MiB;
constexpr int CW_CNT = 8192;
constexpr int LDS_OFF_TAB = 131072 + 1024;
constexpr size_t WS_SCR = 332 * MiB;
constexpr size_t WS_HG_QG = WS_SCR;
constexpr size_t WS_HG_KDT = WS_SCR + 16 * MiB;
constexpr size_t WS_HG_A = WS_SCR + 32 * MiB;
constexpr size_t WS_HG_GL = WS_SCR + 40 * MiB;
constexpr size_t WS_SSD_C = WS_SCR + 41 * MiB;
constexpr size_t WS_SSD_BT = WS_SCR + 49 * MiB;
constexpr size_t WS_SSD_CB = WS_SCR + 57 * MiB;
constexpr size_t WS_SSD_XT = WS_SCR + 65 * MiB;
constexpr size_t WS_SSD_AC = WS_SCR + 97 * MiB;
constexpr size_t WS_SSD_DT = WS_SCR + 98 * MiB;
constexpr size_t WS_GD_K = WS_SCR + 99 * MiB;
constexpr size_t WS_GD_KT = WS_SCR + 115 * MiB;
constexpr size_t WS_GD_QG = WS_SCR + 131 * MiB;
constexpr size_t WS_GD_VT = WS_SCR + 147 * MiB;
constexpr size_t WS_GD_T = WS_SCR + 163 * MiB;
constexpr size_t WS_GD_QK = WS_SCR + 171 * MiB;
constexpr size_t WS_GD_VEC = WS_SCR + 179 * MiB;
constexpr size_t WS_END = 512 * MiB;
constexpr int CW_BAR = 4096;

constexpr int RING_OFF = 0, RING_BYTES = 131072;
constexpr int LDSCTL_OFF = RING_BYTES, MISC_OFF = LDSCTL_OFF + 320;
constexpr int LDS_BYTES = 147456;

__device__ __forceinline__ float bf2f(unsigned short b) { return __builtin_bit_cast(float, ((unsigned)b) << 16); }
__device__ __forceinline__ float bflo(unsigned w) { return __builtin_bit_cast(float, w << 16); }
__device__ __forceinline__ float bfhi(unsigned w) { return __builtin_bit_cast(float, w & 0xffff0000u); }
__device__ __forceinline__ float siluf(float x) { return x * __builtin_amdgcn_rcpf(1.0f + __expf(-x)); }
__device__ __forceinline__ float sigmoidf_(float x) { return __builtin_amdgcn_rcpf(1.0f + __expf(-x)); }
__device__ __forceinline__ float softplusf_(float x) { return x > 20.f ? x : log1pf(__expf(x)); }
#define DPP_ADD(v, ctrl) ((v) + __builtin_bit_cast(float, __builtin_amdgcn_update_dpp(0, __builtin_bit_cast(int, (v)), (ctrl), 0xf, 0xf, false)))
__device__ __forceinline__ float wave_sum(float v) {
    v = DPP_ADD(v, 0xB1);
    v = DPP_ADD(v, 0x4E);
    v = DPP_ADD(v, 0x141);
    v = DPP_ADD(v, 0x140);
    const int iv = __builtin_bit_cast(int, v);
    return (__builtin_bit_cast(float, __builtin_amdgcn_readlane(iv, 0)) + __builtin_bit_cast(float, __builtin_amdgcn_readlane(iv, 16))) + (__builtin_bit_cast(float, __builtin_amdgcn_readlane(iv, 32)) + __builtin_bit_cast(float, __builtin_amdgcn_readlane(iv, 48)));
}
__device__ __forceinline__ float row16_sum(float v) {
    v = DPP_ADD(v, 0xB1); v = DPP_ADD(v, 0x4E); v = DPP_ADD(v, 0x141); v = DPP_ADD(v, 0x140); return v;
}

struct Args {
    const float* in[25]; float* out; unsigned char* ws; int ph_lo, ph_hi;
};
typedef const __attribute__((address_space(4))) Args* CArgs;
#define ARGS_HERE() ([]() { CArgs p_ = (CArgs)__builtin_amdgcn_kernarg_segment_ptr(); asm volatile("" : "+s"(p_)); return p_; }())
enum { I_X = 0, I_WIN, I_SCW, I_SCB, I_SDTB, I_SALOG, I_SD, I_SNW, I_GCW, I_GDTB, I_GALOG, I_GNW, I_HLB, I_HNW, I_WOUT, I_LN1G, I_LN1B, I_WRG, I_BRG, I_WRE, I_BRE, I_WGU, I_WDN, I_LN2G, I_LN2B };

__device__ __forceinline__ void transpose_item(const float* W, int ldw, int nvalid, int k0, int n0, bf16* WT, size_t ldt, int drow0, int dk0, int lane) {
    const int q = lane >> 4, c = lane & 15, n = n0 + 4 * c; const bool ok = n < nvalid;
    const float* src = W + (size_t)(k0 + 16 * q) * ldw + n;
    f32x4 f[16];
#pragma unroll
    for (int i = 0; i < 16; ++i) f[i] = ok ? *(const GAS f32x4*)(src + (size_t)i * ldw) : (f32x4){0.f, 0.f, 0.f, 0.f};
    bf16* dst = WT + (size_t)(drow0 + 4 * c) * ldt + dk0 + k0 + 16 * q;
#pragma unroll
    for (int j = 0; j < 4; ++j) {
        v4u o0, o1;
        o0.x = pk2(f[0][j], f[1][j]); o0.y = pk2(f[2][j], f[3][j]); o0.z = pk2(f[4][j], f[5][j]); o0.w = pk2(f[6][j], f[7][j]);
        o1.x = pk2(f[8][j], f[9][j]); o1.y = pk2(f[10][j], f[11][j]); o1.z = pk2(f[12][j], f[13][j]); o1.w = pk2(f[14][j], f[15][j]);
        *(GAS v4u*)(dst + (size_t)j * ldt) = o0; *(GAS v4u*)(dst + (size_t)j * ldt + 8) = o1; }
}
__device__ __forceinline__ void weights_phase(CArgs a, int l, const int which, LAS unsigned char* lds, int wwg, int nwg, int tid) {
    asm volatile("" : "+v"(tid));
    const int lane = tid & 63, wave = tid >> 6, gw = wwg * NWAVES + wave, NGW = nwg * NWAVES;
    (void)lds;
    constexpr int I_IN = 16 * (NPROJ / 64), I_OUT = (DMIX / 64) * (D / 64), I_GU = NEXP * 16 * 8, I_DN = NEXP * 4 * 16;
    const int n_in = (which & 1) ? I_IN : 0, n_out = (which & 2) ? I_OUT : 0, n_gu = (which & 4) ? I_GU : 0, n_dn = (which & 8) ? I_DN : 0;
    unsigned char* ws = a->ws;
    for (int it = gw; it < n_in + n_out + n_gu + n_dn; it += NGW) {
        int r = it;
        if (r < n_in) { const int kb = r / (NPROJ / 64), nb = r % (NPROJ / 64);
            transpose_item(a->in[I_WIN] + (size_t)l * D * IN_COLS, IN_COLS, IN_COLS, 64 * kb, 64 * nb, (bf16*)(ws + WS_WIN), D, 64 * nb, 0, lane); continue; }
        r -= n_in;
        if (r < n_out) { const int kb = r / (D / 64), nb = r % (D / 64);
            transpose_item(a->in[I_WOUT] + (size_t)l * DMIX * D, D, D, 64 * kb, 64 * nb, (bf16*)(ws + WS_WOUT), DMIX, 64 * nb, 0, lane); continue; }
        r -= n_out;
        if (r < n_gu) { const int e = r / 128, q = r % 128, kb = q / 8, nb = q % 8, c0 = 64 * nb, bj = c0 / 256, hf = (c0 % 256) / 128, j0 = c0 % 128;
            transpose_item(a->in[I_WGU] + (size_t)(l * NEXP + e) * D * 512, 512, 512, 64 * kb, c0, (bf16*)(ws + WS_WGU), D, e * 512 + hf * 256 + bj * 128 + j0, 0, lane); continue; }
        r -= n_gu;
        { const int e = r / 64, q = r % 64, kb = q / 16, nb = q % 16;
            transpose_item(a->in[I_WDN] + (size_t)(l * NEXP + e) * DEXP * D, D, D, 64 * kb, 64 * nb, (bf16*)(ws + WS_WDN), DEXP, e * D + 64 * nb, 0, lane); }
    }
}
__device__ __forceinline__ void p0_prologue(CArgs a, LAS unsigned char* lds, int wg, int G, int tid) {
    asm volatile("" : "+v"(tid));
    const f32x4* x4 = (const f32x4*)a->in[I_X]; f32x4* h4 = (f32x4*)a->out; unsigned long long* hb8 = (unsigned long long*)(a->ws + WS_HB);
    for (size_t i = (size_t)wg * NTHR + tid; i < (size_t)M * D / 4; i += (size_t)G * NTHR) { const f32x4 v = x4[i]; (void)h4;
        hb8[i] = (unsigned long long)pk2(v.x, v.y) | ((unsigned long long)pk2(v.z, v.w) << 32); }
}

#define WG_BAR() do { asm volatile("s_waitcnt lgkmcnt(0)" ::: "memory"); __builtin_amdgcn_s_barrier(); asm volatile("" ::: "memory"); } while (0)
__device__ __forceinline__ f32x4 mfma16(bf16x8 x, bf16x8 y, f32x4 c) { return __builtin_amdgcn_mfma_f32_16x16x32_bf16(x, y, c, 0, 0, 0); }
__device__ __forceinline__ bf16x8 lds_frag(const LAS bf16* base, int row0, int stride, int k0, int lane) { return *(const LAS bf16x8*)(base + (row0 + (lane & 15)) * stride + k0 + 8 * (lane >> 4)); }
__device__ __forceinline__ bf16x8 pack8(const float* v) { v4u w; w.x = pk2(v[0], v[1]); w.y = pk2(v[2], v[3]); w.z = pk2(v[4], v[5]); w.w = pk2(v[6], v[7]); return __builtin_bit_cast(bf16x8, w); }
__device__ __forceinline__ unsigned long long pack4(f32x4 v) { return (unsigned long long)pk2(v[0], v[1]) | ((unsigned long long)pk2(v[2], v[3]) << 32); }

__device__ __forceinline__ void hgrn_prep_phase(CArgs a, int l, LAS unsigned char* lds, int wg, int G, int tid) {
    asm volatile("" : "+v"(tid));
    constexpr int LS = 132;
    LAS float* sQ = (LAS float*)lds; LAS float* sK = sQ + 64 * LS; LAS float* sB = sK + 64 * LS; LAS float* sT = sB + 64 * LS; LAS float* sLb = sT + 512;
    const bf16* PROJ = (const bf16*)(a->ws + WS_PROJ);
    const int lane = tid & 63, w = tid >> 6, r = lane & 15, q4 = lane >> 4;
    for (int unit = wg; unit < 1024; unit += G) {
        const int b = unit >> 8, head = (unit >> 6) & 3, c = unit & 63;
        const size_t row0 = (size_t)b * SEQ + c * 64;
        __syncthreads();
        if (tid < 128) {
            const int ch = head * 128 + tid; float lg[DEPTH], mx = -1e30f;
#pragma unroll
            for (int j = 0; j < DEPTH; ++j) { lg[j] = a->in[I_HLB][j * 512 + ch]; mx = fmaxf(mx, lg[j]); }
            float den = 0.f, num = 0.f;
#pragma unroll
            for (int j = 0; j < DEPTH; ++j) { const float e = __expf(lg[j] - mx); den += e; if (j >= 1 && j <= l) num += e; }
            sLb[tid] = num / den;
        }
        __syncthreads();
        for (int p = tid; p < 1024; p += NTHR) {
            const int t = p >> 4, d8 = (p & 15) * 8;
            const v4u qv = *(const GAS v4u*)(PROJ + (row0 + t) * NPROJ + O_HQ + head * 128 + d8), fv = *(const GAS v4u*)(PROJ + (row0 + t) * NPROJ + O_HF + head * 128 + d8);
            const f32x4 lbA = *(const LAS f32x4*)(sLb + d8), lbB = *(const LAS f32x4*)(sLb + d8 + 4); float qo[8], ko[8], bo[8];
#pragma unroll
            for (int i = 0; i < 4; ++i) {
                const float lb0 = (2 * i < 4) ? lbA[(2 * i) & 3] : lbB[(2 * i) & 3], lb1 = (2 * i + 1 < 4) ? lbA[(2 * i + 1) & 3] : lbB[(2 * i + 1) & 3];
                qo[2 * i] = siluf(bflo(qv[i])); qo[2 * i + 1] = siluf(bfhi(qv[i]));
                const float f0 = lb0 + (1.f - lb0) * sigmoidf_(bflo(fv[i])), f1 = lb1 + (1.f - lb1) * sigmoidf_(bfhi(fv[i]));
                ko[2 * i] = 1.f - f0; ko[2 * i + 1] = 1.f - f1; bo[2 * i] = __logf(f0); bo[2 * i + 1] = __logf(f1);
            }
            *(LAS f32x4*)(sQ + t * LS + d8) = (f32x4){qo[0], qo[1], qo[2], qo[3]}; *(LAS f32x4*)(sQ + t * LS + d8 + 4) = (f32x4){qo[4], qo[5], qo[6], qo[7]};
            *(LAS f32x4*)(sK + t * LS + d8) = (f32x4){ko[0], ko[1], ko[2], ko[3]}; *(LAS f32x4*)(sK + t * LS + d8 + 4) = (f32x4){ko[4], ko[5], ko[6], ko[7]};
            *(LAS f32x4*)(sB + t * LS + d8) = (f32x4){bo[0], bo[1], bo[2], bo[3]}; *(LAS f32x4*)(sB + t * LS + d8 + 4) = (f32x4){bo[4], bo[5], bo[6], bo[7]};
        }
        __syncthreads();
        {
            const int d = tid & 127, seg = tid >> 7; float run = 0.f, vals[16];
#pragma unroll
            for (int i = 0; i < 16; ++i) { run += sB[(seg * 16 + i) * LS + d]; vals[i] = run; }
            sT[seg * 128 + d] = run;
            __syncthreads();
            float off = 0.f;
#pragma unroll
            for (int s2 = 0; s2 < 3; ++s2) if (s2 < seg) off += sT[s2 * 128 + d];
#pragma unroll
            for (int i = 0; i < 16; ++i) sB[(seg * 16 + i) * LS + d] = vals[i] + off;
        }
        __syncthreads();
        bf16* qg = (bf16*)(a->ws + WS_HG_QG) + (size_t)unit * 64 * 128; bf16* kdt = (bf16*)(a->ws + WS_HG_KDT) + (size_t)unit * 128 * 64;
        bf16* am = (bf16*)(a->ws + WS_HG_A) + (size_t)unit * 64 * 64; float* gl = (float*)(a->ws + WS_HG_GL) + (size_t)unit * 128;
        for (int p = tid; p < 1024; p += NTHR) { const int t = p >> 4, d8 = (p & 15) * 8; float v[8];
            const f32x4 q0 = *(const LAS f32x4*)(sQ + t * LS + d8), q1 = *(const LAS f32x4*)(sQ + t * LS + d8 + 4), b0 = *(const LAS f32x4*)(sB + t * LS + d8), b1 = *(const LAS f32x4*)(sB + t * LS + d8 + 4);
#pragma unroll
            for (int jj = 0; jj < 4; ++jj) { v[jj] = q0[jj] * __expf(b0[jj]); v[4 + jj] = q1[jj] * __expf(b1[jj]); }
            *(GAS bf16x8*)(qg + t * 128 + d8) = pack8(v); }
        for (int p = tid; p < 1024; p += NTHR) { const int d = p >> 3, s8 = (p & 7) * 8; const float bl = sB[63 * LS + d]; float v[8];
#pragma unroll
            for (int jj = 0; jj < 8; ++jj) v[jj] = sK[(s8 + jj) * LS + d] * __expf(bl - sB[(s8 + jj) * LS + d]);
            *(GAS bf16x8*)(kdt + d * 64 + s8) = pack8(v); }
        if (tid < 128) gl[tid] = __expf(sB[63 * LS + tid]);
        for (int p = w; p < 16; p += NWAVES) {
            const int i = p >> 2, j = p & 3; f32x4 acc = {0.f, 0.f, 0.f, 0.f};
            if (j <= i) {
#pragma unroll
                for (int ks = 0; ks < 4; ++ks) { const int d0 = 32 * ks + 8 * q4, t = 16 * i + r, s_ = 16 * j + r; float qf[8], kf[8];
                    const int rrow = i ? 16 * i - 1 : 0;
#pragma unroll
                    for (int hh = 0; hh < 2; ++hh) { const int dd = d0 + 4 * hh;
                        f32x4 rf = *(const LAS f32x4*)(sB + rrow * LS + dd); if (!i) rf = (f32x4){0.f, 0.f, 0.f, 0.f};
                        const f32x4 qq = *(const LAS f32x4*)(sQ + t * LS + dd), bt = *(const LAS f32x4*)(sB + t * LS + dd), kk_ = *(const LAS f32x4*)(sK + s_ * LS + dd), bs = *(const LAS f32x4*)(sB + s_ * LS + dd);
#pragma unroll
                        for (int jj = 0; jj < 4; ++jj) { qf[4 * hh + jj] = qq[jj] * __expf(bt[jj] - rf[jj]); kf[4 * hh + jj] = kk_[jj] * __expf(rf[jj] - bs[jj]); } }
                    acc = mfma16(pack8(kf), pack8(qf), acc); }
                const int t = 16 * i + r;
#pragma unroll
                for (int ii = 0; ii < 4; ++ii) if (16 * j + 4 * q4 + ii > t) acc[ii] = 0.f;
            }
            *(GAS unsigned long long*)(am + (16 * i + r) * 64 + 16 * j + 4 * q4) = pack4(acc);
        }
    }
}
__device__ __forceinline__ void hgrn_scan_phase(CArgs a, int l, LAS unsigned char* lds, const int b, const int head, const int eb, int tid) {
    asm volatile("" : "+v"(tid));
    constexpr int QS = 136, KS = 72;
    constexpr int B_QG = 0, B_KDT = 17408, B_A = B_KDT + 18432, B_VT = B_A + 9216, B_GL = B_VT + 4608, BUF = B_GL + 512;
    LAS unsigned char* sST0 = lds + 2 * BUF;
    const bf16* PROJ = (const bf16*)(a->ws + WS_PROJ); bf16* YMIX = (bf16*)(a->ws + WS_YMIX);
    const int lane = tid & 63, w = tid >> 6, r = lane & 15, q4 = lane >> 4;
    {
        const size_t cu0 = (size_t)(b * 4 + head) * 64;
        const bf16* QG = (const bf16*)(a->ws + WS_HG_QG) + cu0 * 64 * 128; const bf16* KDT = (const bf16*)(a->ws + WS_HG_KDT) + cu0 * 128 * 64;
        const bf16* AM = (const bf16*)(a->ws + WS_HG_A) + cu0 * 64 * 64; const float* GL = (const float*)(a->ws + WS_HG_GL) + cu0 * 128;
        const bf16* VP = PROJ + (size_t)b * SEQ * NPROJ + O_HI + head * 128 + eb * 32;
        v4u rq[2], rk[2], ra, rv; f32x4 rg;
#define HG_LOAD(n) do { _Pragma("unroll") for (int i = 0; i < 2; ++i) { const int p = tid + NTHR * i; rq[i] = *(const GAS v4u*)(QG + (size_t)(n) * 8192 + (p >> 4) * 128 + (p & 15) * 8); \
            rk[i] = *(const GAS v4u*)(KDT + (size_t)(n) * 8192 + (p >> 3) * 64 + (p & 7) * 8); } \
            ra = *(const GAS v4u*)(AM + (size_t)(n) * 4096 + (tid >> 3) * 64 + (tid & 7) * 8); \
            if (tid < 256) rv = *(const GAS v4u*)(VP + (size_t)((n) * 64 + (tid >> 2)) * NPROJ + (tid & 3) * 8); \
            if (tid < 32) rg = *(const GAS f32x4*)(GL + (size_t)(n) * 128 + tid * 4); } while (0)
#define HG_STORE(bufp) do { LAS unsigned char* bp_ = (bufp); _Pragma("unroll") for (int i = 0; i < 2; ++i) { const int p = tid + NTHR * i; \
            *(LAS v4u*)(bp_ + B_QG + ((p >> 4) * QS + (p & 15) * 8) * 2) = rq[i]; *(LAS v4u*)(bp_ + B_KDT + ((p >> 3) * KS + (p & 7) * 8) * 2) = rk[i]; } \
            *(LAS v4u*)(bp_ + B_A + ((tid >> 3) * KS + (tid & 7) * 8) * 2) = ra; \
            if (tid < 256) { LAS bf16* vt = (LAS bf16*)(bp_ + B_VT); const int t_ = tid >> 2, e8 = (tid & 3) * 8; _Pragma("unroll") for (int i = 0; i < 4; ++i) { \
                vt[(e8 + 2 * i) * KS + t_] = (bf16)(rv[i] & 0xffffu); vt[(e8 + 2 * i + 1) * KS + t_] = (bf16)(rv[i] >> 16); } } \
            if (tid < 32) *(LAS f32x4*)(bp_ + B_GL + tid * 16) = rg; } while (0)
        __syncthreads();
        HG_LOAD(0);
        for (int i = tid; i < 8704 / 4; i += NTHR) ((LAS unsigned*)sST0)[i] = 0u;
        HG_STORE(lds);
        f32x4 accS[2] = {{0.f, 0.f, 0.f, 0.f}, {0.f, 0.f, 0.f, 0.f}};
        __syncthreads();
        for (int n = 0; n < 64; ++n) {
            const int cur = n & 1; LAS unsigned char* bp = lds + cur * BUF; LAS bf16* sST = (LAS bf16*)(sST0 + cur * 8704); LAS bf16* sSTn = (LAS bf16*)(sST0 + (cur ^ 1) * 8704);
            if (n + 1 < 64) HG_LOAD(n + 1);
            {
                const int tt = w >> 1, et = w & 1; f32x4 acc = {0.f, 0.f, 0.f, 0.f};
#pragma unroll
                for (int ks = 0; ks < 4; ++ks) acc = mfma16(lds_frag(sST, 16 * et, QS, 32 * ks, lane), lds_frag((LAS bf16*)(bp + B_QG), 16 * tt, QS, 32 * ks, lane), acc);
#pragma unroll
                for (int ks = 0; ks < 2; ++ks) acc = mfma16(lds_frag((LAS bf16*)(bp + B_VT), 16 * et, KS, 32 * ks, lane), lds_frag((LAS bf16*)(bp + B_A), 16 * tt, KS, 32 * ks, lane), acc);
                *(GAS unsigned long long*)(YMIX + ((size_t)b * SEQ + n * 64 + 16 * tt + r) * DMIX + 1536 + head * 128 + eb * 32 + 16 * et + 4 * q4) = pack4(acc);
            }
            {
                const f32x4 glv = *(const LAS f32x4*)(bp + B_GL + (16 * w + 4 * q4) * 4);
#pragma unroll
                for (int et = 0; et < 2; ++et) { accS[et] = accS[et] * glv;
#pragma unroll
                    for (int ks = 0; ks < 2; ++ks) accS[et] = mfma16(lds_frag((LAS bf16*)(bp + B_KDT), 16 * w, KS, 32 * ks, lane), lds_frag((LAS bf16*)(bp + B_VT), 16 * et, KS, 32 * ks, lane), accS[et]);
                    *(LAS unsigned long long*)(sSTn + (16 * et + r) * QS + 16 * w + 4 * q4) = pack4(accS[et]); }
            }
            if (n + 1 < 64) HG_STORE(lds + (cur ^ 1) * BUF);
            WG_BAR();
        }
#undef HG_LOAD
#undef HG_STORE
    }
}

__device__ __forceinline__ void ssd_rec_phase(CArgs a, int l, LAS unsigned char* lds, int wg, int G, int tid) {
    asm volatile("" : "+v"(tid));
    constexpr int TB = 64;
    LAS float* sX = (LAS float*)lds; LAS float* sB = sX + TB * 16; LAS float* sC = sB + TB * 128; LAS float* sDt = sC + TB * 128; LAS float* sDa = sDt + TB; LAS float* sY = sDa + TB;
    const bf16* PROJ = (const bf16*)(a->ws + WS_PROJ); bf16* YMIX = (bf16*)(a->ws + WS_YMIX);
    const float* cw = a->in[I_SCW] + (size_t)l * 4 * 1536; const float* cb = a->in[I_SCB] + (size_t)l * 1536;
    const int p_local = tid >> 5, nq = tid & 31;
    for (int unit = wg; unit < 256; unit += G) {
        const int b = unit >> 6, head = (unit >> 2) & 15, pq = unit & 3, g = head >> 3;
        const float A = -__expf(a->in[I_SALOG][l * 16 + head]), dtb = a->in[I_SDTB][l * 16 + head], Dsk = a->in[I_SD][l * 16 + head];
        float h0 = 0.f, h1 = 0.f, h2 = 0.f, h3 = 0.f;
        for (int t0 = 0; t0 < SEQ; t0 += TB) {
            __syncthreads();
            for (int idx = tid; idx < TB * 272; idx += NTHR) {
                const int tt = idx / 272, ci = idx % 272, t = t0 + tt;
                const int ch = ci < 16 ? head * 64 + pq * 16 + ci : (ci < 144 ? 1024 + g * 128 + (ci - 16) : 1280 + g * 128 + (ci - 144));
                float acc = cb[ch];
#pragma unroll
                for (int k = 0; k < 4; ++k) { const int ts = t - 3 + k; if (ts >= 0) acc += cw[k * 1536 + ch] * bf2f(PROJ[(size_t)(b * SEQ + ts) * NPROJ + O_XBC + ch]); }
                const float v = siluf(acc);
                if (ci < 16) sX[tt * 16 + ci] = v; else if (ci < 144) sB[tt * 128 + ci - 16] = v; else sC[tt * 128 + ci - 144] = v;
            }
            if (tid < TB) { const float raw = bf2f(PROJ[(size_t)(b * SEQ + t0 + tid) * NPROJ + O_DT + head]); const float dt = softplusf_(raw + dtb); sDt[tid] = dt; sDa[tid] = __expf(dt * A); }
            __syncthreads();
#pragma unroll 4
            for (int tt = 0; tt < TB; ++tt) {
                const float xv = sX[tt * 16 + p_local], da = sDa[tt], dx = sDt[tt] * xv;
                const f32x4 Bv = *(const LAS f32x4*)(sB + tt * 128 + nq * 4), Cv = *(const LAS f32x4*)(sC + tt * 128 + nq * 4);
                h0 = da * h0 + dx * Bv.x; h1 = da * h1 + dx * Bv.y; h2 = da * h2 + dx * Bv.z; h3 = da * h3 + dx * Bv.w;
                float part = (Cv.x * h0 + Cv.y * h1) + (Cv.z * h2 + Cv.w * h3);
                part += __shfl_xor(part, 1); part += __shfl_xor(part, 2); part += __shfl_xor(part, 4); part += __shfl_xor(part, 8); part += __shfl_xor(part, 16);
                if (nq == 0) sY[tt * 16 + p_local] = part + Dsk * xv;
            }
            __syncthreads();
            for (int idx = tid; idx < TB * 16; idx += NTHR) { const int tt = idx >> 4, i = idx & 15; YMIX[(size_t)(b * SEQ + t0 + tt) * DMIX + head * 64 + pq * 16 + i] = (bf16)f2bf(sY[idx]); }
        }
    }
}

__device__ __forceinline__ void ssd_prep_phase(CArgs a, int l, LAS unsigned char* lds, int wg, int G, int tid) {
    asm volatile("" : "+v"(tid));
    constexpr int PS = 136;
    LAS bf16* sB = (LAS bf16*)lds; LAS bf16* sC = sB + 128 * PS; LAS bf16* sXT = (LAS bf16*)lds; LAS float* sDt = (LAS float*)(lds + 2 * 128 * PS * 2); LAS bf16* sCB = (LAS bf16*)(lds + 2 * 128 * PS * 2 + 4096);
    const bf16* PROJ = (const bf16*)(a->ws + WS_PROJ);
    const float* cw = a->in[I_SCW] + (size_t)l * 4 * 1536; const float* cb = a->in[I_SCB] + (size_t)l * 1536;
    const int lane = tid & 63, w = tid >> 6, r = lane & 15, q4 = lane >> 4;
    for (int unit = wg; unit < 256; unit += G) {
        const int b = unit >> 6, c = (unit >> 1) & 31, g = unit & 1;
        const size_t row0 = (size_t)b * SEQ + c * 128;
        bf16* Cg = (bf16*)(a->ws + WS_SSD_C) + (size_t)unit * 16384; bf16* BTg = (bf16*)(a->ws + WS_SSD_BT) + (size_t)unit * 16384; bf16* CBg = (bf16*)(a->ws + WS_SSD_CB) + (size_t)unit * 16384;
        __syncthreads();
        {
            const int c16 = tid & 31, l0 = tid >> 5; const int ch = (c16 < 16 ? 1024 + g * 128 + c16 * 8 : 1280 + g * 128 + (c16 - 16) * 8);
            float wk[4][8], bias[8];
#pragma unroll
            for (int jj = 0; jj < 8; ++jj) { bias[jj] = cb[ch + jj];
#pragma unroll
                for (int k = 0; k < 4; ++k) wk[k][jj] = cw[k * 1536 + ch + jj]; }
            LAS bf16* dst = (c16 < 16 ? sB : sC) + (c16 & 15) * 8;
#pragma unroll 2
            for (int i = 0; i < 8; ++i) { const int ll = l0 + 16 * i; float acc[8];
#pragma unroll
                for (int jj = 0; jj < 8; ++jj) acc[jj] = bias[jj];
#pragma unroll
                for (int k = 0; k < 4; ++k) { const int ts = c * 128 + ll - 3 + k;
                    if (ts >= 0) { const v4u xv = *(const GAS v4u*)(PROJ + ((size_t)b * SEQ + ts) * NPROJ + O_XBC + ch);
#pragma unroll
                        for (int j = 0; j < 4; ++j) { acc[2 * j] += wk[k][2 * j] * bflo(xv[j]); acc[2 * j + 1] += wk[k][2 * j + 1] * bfhi(xv[j]); } } }
#pragma unroll
                for (int jj = 0; jj < 8; ++jj) acc[jj] = siluf(acc[jj]);
                *(LAS bf16x8*)(dst + ll * PS) = pack8(acc); }
        }
        {
            const int head = g * 8 + w; const float A = -__expf(a->in[I_SALOG][l * 16 + head]), dtb = a->in[I_SDTB][l * 16 + head];
            const int l2 = 2 * lane;
            const float dt0 = softplusf_(bf2f(PROJ[(row0 + l2) * NPROJ + O_DT + head]) + dtb), dt1 = softplusf_(bf2f(PROJ[(row0 + l2 + 1) * NPROJ + O_DT + head]) + dtb);
            const float da1 = dt1 * A; float sc = dt0 * A + da1;
#pragma unroll
            for (int o = 1; o < 64; o <<= 1) { const float t_ = __shfl_up(sc, o); if (lane >= o) sc += t_; }
            sDt[w * 128 + l2] = dt0; sDt[w * 128 + l2 + 1] = dt1;
            const size_t uh = (size_t)((b * 16 + head) * 32 + c) * 128;
            float* AC = (float*)(a->ws + WS_SSD_AC) + uh; float* DT = (float*)(a->ws + WS_SSD_DT) + uh;
            AC[l2] = sc - da1; AC[l2 + 1] = sc; DT[l2] = dt0; DT[l2 + 1] = dt1;
        }
        __syncthreads();
#pragma unroll
        for (int st = 0; st < 8; ++st) {
            f32x4 acc = {0.f, 0.f, 0.f, 0.f};
            if (st <= w) {
#pragma unroll
                for (int ks = 0; ks < 4; ++ks) acc = mfma16(lds_frag(sB, 16 * st, PS, 32 * ks, lane), lds_frag(sC, 16 * w, PS, 32 * ks, lane), acc); }
            *(LAS unsigned long long*)(sCB + (16 * w + r) * PS + 16 * st + 4 * q4) = pack4(acc);
        }
        __syncthreads();
        for (int f = w; f < 32; f += NWAVES) { const int tile = f >> 2, ks = f & 3;
            *(GAS v4u*)(Cg + f * 512 + lane * 8) = *(const LAS v4u*)(sC + (16 * tile + r) * PS + 32 * ks + 8 * q4);
            *(GAS v4u*)(CBg + f * 512 + lane * 8) = *(const LAS v4u*)(sCB + (16 * tile + r) * PS + 32 * ks + 8 * q4);
            const int n = 16 * tile + r, l0 = 32 * ks + 8 * q4; v4u o;
#pragma unroll
            for (int j = 0; j < 4; ++j) o[j] = (unsigned)sB[(l0 + 2 * j) * PS + n] | ((unsigned)sB[(l0 + 2 * j + 1) * PS + n] << 16);
            *(GAS v4u*)(BTg + f * 512 + lane * 8) = o; }
#pragma unroll 1
        for (int hf = 0; hf < 2; ++hf) {
            __syncthreads();
            {   const int cg = tid & 31, l0 = tid >> 5, chl = cg * 8, ch = g * 512 + hf * 256 + chl, hh = hf * 4 + (cg >> 3);
                float wk[4][8], bias[8];
#pragma unroll
                for (int jj = 0; jj < 8; ++jj) { bias[jj] = cb[ch + jj];
#pragma unroll
                    for (int k = 0; k < 4; ++k) wk[k][jj] = cw[k * 1536 + ch + jj]; }
#pragma unroll 2
                for (int i = 0; i < 8; ++i) { const int ll = l0 + 16 * i; float acc[8];
#pragma unroll
                    for (int jj = 0; jj < 8; ++jj) acc[jj] = bias[jj];
#pragma unroll
                    for (int k = 0; k < 4; ++k) { const int ts = c * 128 + ll - 3 + k;
                        if (ts >= 0) { const v4u xv = *(const GAS v4u*)(PROJ + ((size_t)b * SEQ + ts) * NPROJ + O_XBC + ch);
#pragma unroll
                            for (int j = 0; j < 4; ++j) { acc[2 * j] += wk[k][2 * j] * bflo(xv[j]); acc[2 * j + 1] += wk[k][2 * j + 1] * bfhi(xv[j]); } } }
                    const float dtv = sDt[hh * 128 + ll];
#pragma unroll
                    for (int jj = 0; jj < 8; ++jj) sXT[(chl + jj) * PS + ll] = (bf16)f2bf(siluf(acc[jj]) * dtv); }
            }
            __syncthreads();
            for (int p = tid; p < 4096; p += NTHR) { const int chl = p >> 4, l8 = (p & 15) * 8, hh = hf * 4 + (chl >> 6), pp = chl & 63;
                const size_t uh = (size_t)((b * 16 + g * 8 + hh) * 32 + c);
                *(GAS v4u*)((bf16*)(a->ws + WS_SSD_XT) + (uh * 64 + pp) * 128 + l8) = *(const LAS v4u*)(sXT + chl * PS + l8); }
        }
    }
}
__device__ __forceinline__ void ssd_scan_phase(CArgs a, int l, LAS unsigned char* lds, const int b, const int head, int tid) {
    asm volatile("" : "+v"(tid));
    constexpr int PS = 136, O_S = 0, O_X = 34816, O_AC = 69632, O_TE = 70656, O_DT = 71680;
    bf16* YMIX = (bf16*)(a->ws + WS_YMIX);
    const int lane = tid & 63, w = tid >> 6, r = lane & 15, q4 = lane >> 4;
    {
        const int g = head >> 3;
        const float Dsk = a->in[I_SD][l * 16 + head];
        const bf16* Cg = (const bf16*)(a->ws + WS_SSD_C) + (size_t)((b * 32) * 2 + g) * 16384 + (w * 4) * 512 + lane * 8;
        const bf16* CBg = (const bf16*)(a->ws + WS_SSD_CB) + (size_t)((b * 32) * 2 + g) * 16384 + (w * 4) * 512 + lane * 8;
        const bf16* BTg = (const bf16*)(a->ws + WS_SSD_BT) + (size_t)((b * 32) * 2 + g) * 16384 + (w * 4) * 512 + lane * 8;
        const size_t uh0 = (size_t)(b * 16 + head) * 32;
        const bf16* XTg = (const bf16*)(a->ws + WS_SSD_XT) + uh0 * 8192; const float* ACg = (const float*)(a->ws + WS_SSD_AC) + uh0 * 128; const float* DTg = (const float*)(a->ws + WS_SSD_DT) + uh0 * 128;
        v4u fC[4], fCB[4], fBT[4], rx[2]; float rac = 0.f, racl = 0.f, rdt = 0.f;
#define SSD_LDF(cc, dst, src) do { _Pragma("unroll") for (int ks = 0; ks < 4; ++ks) dst[ks] = *(const GAS v4u*)(src + (size_t)(cc) * 32768 + 512 * ks); } while (0)
#define SSD_LOADX(cc) do { _Pragma("unroll") for (int i = 0; i < 2; ++i) { const int p = tid + NTHR * i; rx[i] = *(const GAS v4u*)(XTg + (size_t)(cc) * 8192 + (p >> 4) * 128 + (p & 15) * 8); } \
            if (tid < 128) { rac = ACg[(cc) * 128 + tid]; racl = ACg[(cc) * 128 + 127]; rdt = DTg[(cc) * 128 + tid]; } } while (0)
#define SSD_STORE(bi) do { _Pragma("unroll") for (int i = 0; i < 2; ++i) { const int p = tid + NTHR * i; *(LAS v4u*)(lds + O_X + (bi) * 17408 + ((p >> 4) * PS + (p & 15) * 8) * 2) = rx[i]; } \
            if (tid < 128) { ((LAS float*)(lds + O_AC))[(bi) * 128 + tid] = rac; ((LAS float*)(lds + O_TE))[(bi) * 128 + tid] = __expf(racl - rac); ((LAS float*)(lds + O_DT))[(bi) * 128 + tid] = rdt; } } while (0)
        __syncthreads();
        SSD_LDF(0, fC, Cg); SSD_LDF(0, fCB, CBg); SSD_LDF(0, fBT, BTg); SSD_LOADX(0);
        for (int i = tid; i < 17408 / 4; i += NTHR) ((LAS unsigned*)(lds + O_S))[i] = 0u;
        SSD_STORE(0);
        f32x4 accS[4];
#pragma unroll
        for (int pt = 0; pt < 4; ++pt) accS[pt] = (f32x4){0.f, 0.f, 0.f, 0.f};
        __syncthreads();
        for (int c = 0; c < 32; ++c) {
            const int cur = c & 1;
            const LAS bf16* sS = (const LAS bf16*)(lds + O_S + cur * 17408); LAS bf16* sSn = (LAS bf16*)(lds + O_S + (cur ^ 1) * 17408); const LAS bf16* sXT = (const LAS bf16*)(lds + O_X + cur * 17408);
            const LAS float* sAc = (const LAS float*)(lds + O_AC) + cur * 128; const LAS float* sTe = (const LAS float*)(lds + O_TE) + cur * 128; const LAS float* sDt = (const LAS float*)(lds + O_DT) + cur * 128;
            const int cn = c + 1 < 32 ? c + 1 : c;
            SSD_LOADX(cn);
            const int lrow = 16 * w + r; const float ac_l = sAc[lrow];
            f32x4 accO[4], accD[4];
#pragma unroll
            for (int pt = 0; pt < 4; ++pt) { accO[pt] = (f32x4){0.f, 0.f, 0.f, 0.f}; accD[pt] = (f32x4){0.f, 0.f, 0.f, 0.f}; }
#pragma unroll
            for (int ks = 0; ks < 4; ++ks) { const bf16x8 yf = __builtin_bit_cast(bf16x8, fC[ks]);
#pragma unroll
                for (int pt = 0; pt < 4; ++pt) accO[pt] = mfma16(lds_frag(sS, 16 * pt, PS, 32 * ks, lane), yf, accO[pt]); }
            SSD_LDF(cn, fC, Cg);
#pragma unroll
            for (int ks = 0; ks < 4; ++ks) if (32 * ks <= 16 * w + 15) {
                float v[8]; const f32x4 a0 = *(const LAS f32x4*)(sAc + 32 * ks + 8 * q4), a1 = *(const LAS f32x4*)(sAc + 32 * ks + 8 * q4 + 4);
#pragma unroll
                for (int j = 0; j < 4; ++j) { const int s0 = 32 * ks + 8 * q4 + 2 * j; const float as0 = (2 * j < 4) ? a0[(2 * j) & 3] : a1[(2 * j) & 3], as1 = (2 * j + 1 < 4) ? a0[(2 * j + 1) & 3] : a1[(2 * j + 1) & 3];
                    v[2 * j] = (s0 <= lrow) ? bflo(fCB[ks][j]) * __expf(ac_l - as0) : 0.f; v[2 * j + 1] = (s0 + 1 <= lrow) ? bfhi(fCB[ks][j]) * __expf(ac_l - as1) : 0.f; }
                const bf16x8 yf = pack8(v);
#pragma unroll
                for (int pt = 0; pt < 4; ++pt) accD[pt] = mfma16(lds_frag(sXT, 16 * pt, PS, 32 * ks, lane), yf, accD[pt]); }
            SSD_LDF(cn, fCB, CBg);
            {   const float ea = __expf(ac_l), rdtl = Dsk / sDt[lrow];
#pragma unroll
                for (int pt = 0; pt < 4; ++pt) { f32x4 y = accO[pt] * ea + accD[pt];
#pragma unroll
                    for (int ii = 0; ii < 4; ++ii) y[ii] += rdtl * bf2f(sXT[(16 * pt + 4 * q4 + ii) * PS + lrow]);
                    *(GAS unsigned long long*)(YMIX + ((size_t)b * SEQ + c * 128 + lrow) * DMIX + head * 64 + 16 * pt + 4 * q4) = pack4(y); } }
            {   const float cd = __expf(sAc[127]);
#pragma unroll
                for (int pt = 0; pt < 4; ++pt) accS[pt] = accS[pt] * cd;
#pragma unroll
                for (int ks = 0; ks < 4; ++ks) { float v[8]; const f32x4 t0 = *(const LAS f32x4*)(sTe + 32 * ks + 8 * q4), t1 = *(const LAS f32x4*)(sTe + 32 * ks + 8 * q4 + 4);
#pragma unroll
                    for (int j = 0; j < 4; ++j) { const float ts0 = (2 * j < 4) ? t0[(2 * j) & 3] : t1[(2 * j) & 3], ts1 = (2 * j + 1 < 4) ? t0[(2 * j + 1) & 3] : t1[(2 * j + 1) & 3];
                        v[2 * j] = bflo(fBT[ks][j]) * ts0; v[2 * j + 1] = bfhi(fBT[ks][j]) * ts1; }
                    const bf16x8 xf = pack8(v);
#pragma unroll
                    for (int pt = 0; pt < 4; ++pt) accS[pt] = mfma16(xf, lds_frag(sXT, 16 * pt, PS, 32 * ks, lane), accS[pt]); }
#pragma unroll
                for (int pt = 0; pt < 4; ++pt) *(LAS unsigned long long*)(sSn + (16 * pt + r) * PS + 16 * w + 4 * q4) = pack4(accS[pt]);
            }
            SSD_LDF(cn, fBT, BTg);
            if (c + 1 < 32) SSD_STORE(cur ^ 1);
            WG_BAR();
        }
#undef SSD_LDF
#undef SSD_LOADX
#undef SSD_STORE
    }
}

__device__ __forceinline__ void gdn_prep_phase(CArgs a, int l, LAS unsigned char* lds, int wg, int G, int tid) {
    asm volatile("" : "+v"(tid));
    constexpr int PS = 136, TS = 72, MS = 68, TT = 65;
    LAS bf16* sKb = (LAS bf16*)lds; LAS bf16* sQb = sKb + 64 * PS; LAS bf16* sQG = sQb + 64 * PS; LAS bf16* sVT = sQG + 64 * PS;
    LAS float* sM = (LAS float*)(lds + 3 * 17408 + 18432); LAS float* sT = sM + 64 * MS; LAS float* sVec = sT + 64 * TT; LAS bf16* sQK = (LAS bf16*)(sVec + 256);
    const bf16* PROJ = (const bf16*)(a->ws + WS_PROJ);
    const float* cw = a->in[I_GCW] + (size_t)l * 4 * 1536;
    const int lane = tid & 63, w = tid >> 6, r = lane & 15, q4 = lane >> 4;
    for (int unit = wg; unit < 1024; unit += G) {
        const int b = unit >> 8, head = (unit >> 6) & 3, n = unit & 63;
        const size_t row0 = (size_t)b * SEQ + n * 64;
#define GW ((bf16*)(a->ws + WS_GD_K) + (size_t)unit * 8192)
#define GKT ((bf16*)(a->ws + WS_GD_KT) + (size_t)unit * 8192)
#define GQG ((bf16*)(a->ws + WS_GD_QG) + (size_t)unit * 8192)
#define GUT ((bf16*)(a->ws + WS_GD_VT) + (size_t)unit * 8192)
#define GT ((bf16*)(a->ws + WS_GD_T) + (size_t)unit * 4096)
#define GQK ((bf16*)(a->ws + WS_GD_QK) + (size_t)unit * 4096)
#define GVEC ((float*)(a->ws + WS_GD_VEC) + (size_t)unit * 256)
        __syncthreads();
        for (int i = tid; i < 64 * MS; i += NTHR) sM[i] = 0.f;
        if (w == 0) {
            const float nA = -__expf(a->in[I_GALOG][l * 4 + head]), dtb = a->in[I_GDTB][l * 4 + head];
            const size_t ro = (row0 + lane) * NPROJ;
            const float be = sigmoidf_(bf2f(PROJ[ro + O_GB + head])); float gsum = nA * softplusf_(bf2f(PROJ[ro + O_GA + head]) + dtb);
#pragma unroll
            for (int o = 1; o < 64; o <<= 1) { const float t_ = __shfl_up(gsum, o); if (lane >= o) gsum += t_; }
            const float glast = __shfl(gsum, 63), eg = __expf(gsum), cc = __expf(glast - gsum);
            sVec[lane] = gsum; sVec[64 + lane] = be; sVec[128 + lane] = eg;
            GVEC[lane] = be; GVEC[64 + lane] = eg; GVEC[128 + lane] = cc; GVEC[192 + lane] = __expf(glast);
        }
        __syncthreads();
        {
            const int rg = lane >> 4, c8 = (lane & 15) * 8;
#pragma unroll 1
            for (int part = 0; part < 3; ++part) {
                float wt[4][8];
#pragma unroll
                for (int k = 0; k < 4; ++k) { const f32x4 w0 = *(const f32x4*)(cw + k * 1536 + part * 512 + head * 128 + c8), w1 = *(const f32x4*)(cw + k * 1536 + part * 512 + head * 128 + c8 + 4);
#pragma unroll
                    for (int jj = 0; jj < 4; ++jj) { wt[k][jj] = w0[jj]; wt[k][4 + jj] = w1[jj]; } }
#pragma unroll
                for (int it = 0; it < 2; ++it) { const int t = 8 * w + 4 * it + rg; float acc[8];
#pragma unroll
                    for (int jj = 0; jj < 8; ++jj) acc[jj] = 0.f;
#pragma unroll
                    for (int k = 0; k < 4; ++k) { const int ts = n * 64 + t - 3 + k;
                        if (ts >= 0) { const v4u xv = *(const GAS v4u*)(PROJ + ((size_t)b * SEQ + ts) * NPROJ + O_QKV + part * 512 + head * 128 + c8);
#pragma unroll
                            for (int j = 0; j < 4; ++j) { acc[2 * j] += wt[k][2 * j] * bflo(xv[j]); acc[2 * j + 1] += wt[k][2 * j + 1] * bfhi(xv[j]); } } }
                    float ss = 0.f;
#pragma unroll
                    for (int jj = 0; jj < 8; ++jj) { acc[jj] = siluf(acc[jj]); ss += acc[jj] * acc[jj]; }
                    if (part == 2) {
#pragma unroll
                        for (int jj = 0; jj < 8; ++jj) sVT[(c8 + jj) * TS + t] = (bf16)f2bf(acc[jj]);
                    } else {
                        const float sc = rsqrtf(row16_sum(ss) + 1e-6f) * (part == 0 ? 0.08838834764831845f : 1.0f);
#pragma unroll
                        for (int jj = 0; jj < 8; ++jj) acc[jj] *= sc;
                        if (part == 1) *(LAS bf16x8*)(sKb + t * PS + c8) = pack8(acc);
                        else { *(LAS bf16x8*)(sQb + t * PS + c8) = pack8(acc); const float eg = sVec[128 + t];
#pragma unroll
                            for (int jj = 0; jj < 8; ++jj) acc[jj] *= eg;
                            *(LAS bf16x8*)(sQG + t * PS + c8) = pack8(acc); }
                    }
                }
            }
        }
        __syncthreads();
        for (int p = w; p < 26; p += NWAVES) {
            int it, jt; bool isq;
            if (p < 10) { isq = false; it = p < 1 ? 0 : (p < 3 ? 1 : (p < 6 ? 2 : 3)); jt = p - (it * (it + 1)) / 2; } else { isq = true; it = (p - 10) >> 2; jt = (p - 10) & 3; }
            f32x4 acc = {0.f, 0.f, 0.f, 0.f};
            if (jt <= it) {
#pragma unroll
                for (int ks = 0; ks < 4; ++ks) acc = mfma16(lds_frag(sKb, 16 * jt, PS, 32 * ks, lane), lds_frag(isq ? sQb : sKb, 16 * it, PS, 32 * ks, lane), acc);
                const int i = 16 * it + r; const float gi = sVec[i], bi = sVec[64 + i];
#pragma unroll
                for (int ii = 0; ii < 4; ++ii) { const int j = 16 * jt + 4 * q4 + ii; const float dec = __expf(gi - sVec[j]);
                    acc[ii] = isq ? (j <= i ? acc[ii] * dec : 0.f) : (j < i ? acc[ii] * dec * bi : 0.f); }
            }
            if (isq) *(LAS unsigned long long*)(sQK + (16 * it + r) * TS + 16 * jt + 4 * q4) = pack4(acc);
            else *(LAS f32x4*)(sM + (16 * it + r) * MS + 16 * jt + 4 * q4) = acc;
        }
        __syncthreads();
        {
            LAS float* sX = (LAS float*)(sQK + 64 * TS);
            if (w < 4) {
                int zo = 0; asm volatile("" : "+v"(zo)); const LAS float* sMv = sM + zo + (16 * w) * MS + 16 * w;
                if (lane < 16) { float ud[16];
#pragma unroll
                    for (int rr = 0; rr < 16; ++rr) { float acc = -sMv[rr * MS + lane];
#pragma unroll
                        for (int j = 0; j < rr; ++j) acc -= sMv[rr * MS + j] * ud[j];
                        ud[rr] = acc; sT[(16 * w + rr) * TT + 16 * w + lane] = acc + ((rr == lane) ? 1.f : 0.f); } }
                for (int jb = w + 1; jb < 4; ++jb)
                    for (int idx = lane; idx < 256; idx += 64) sT[(16 * w + (idx >> 4)) * TT + 16 * jb + (idx & 15)] = 0.f;
            } else {
                for (int f = w - 4; f < 16; f += 4) { const int tile = f >> 2, ks = f & 3;
                    *(GAS v4u*)(GQG + f * 512 + lane * 8) = *(const LAS v4u*)(sQG + (16 * tile + r) * PS + 32 * ks + 8 * q4); }
                for (int f = w - 4; f < 8; f += 4) { const int tile = f >> 1, ks = f & 1;
                    *(GAS v4u*)(GQK + f * 512 + lane * 8) = *(const LAS v4u*)(sQK + (16 * tile + r) * TS + 32 * ks + 8 * q4); }
                for (int f = w - 4; f < 16; f += 4) { const int dt = f >> 1, ks = f & 1, d = 16 * dt + r, s0 = 32 * ks + 8 * q4; v4u o;
#pragma unroll
                    for (int j = 0; j < 4; ++j) o[j] = (unsigned)sKb[(s0 + 2 * j) * PS + d] | ((unsigned)sKb[(s0 + 2 * j + 1) * PS + d] << 16);
                    *(GAS v4u*)(GKT + f * 512 + lane * 8) = o; }
            }
            WG_BAR();
#pragma unroll
            for (int ib = 1; ib < 4; ++ib) {
                if (w < ib) { const int jb = w; f32x4 acc = {0.f, 0.f, 0.f, 0.f};
                    for (int kb = jb; kb < ib; ++kb)
#pragma unroll
                        for (int kc = 0; kc < 4; ++kc) acc = __builtin_amdgcn_mfma_f32_16x16x4f32(sM[(16 * ib + r) * MS + 16 * kb + 4 * kc + q4], sT[(16 * kb + 4 * kc + q4) * TT + 16 * jb + r], acc, 0, 0, 0);
                    LAS float* sx = sX + w * 272;
#pragma unroll
                    for (int rr = 0; rr < 4; ++rr) sx[(4 * q4 + rr) * 17 + r] = acc[rr];
                    asm volatile("s_waitcnt lgkmcnt(0)" ::: "memory");
                    f32x4 acc2 = {0.f, 0.f, 0.f, 0.f};
#pragma unroll
                    for (int kc = 0; kc < 4; ++kc) acc2 = __builtin_amdgcn_mfma_f32_16x16x4f32(sT[(16 * ib + r) * TT + 16 * ib + 4 * kc + q4], sx[(4 * kc + q4) * 17 + r], acc2, 0, 0, 0);
#pragma unroll
                    for (int rr = 0; rr < 4; ++rr) sT[(16 * ib + 4 * q4 + rr) * TT + 16 * jb + r] = -acc2[rr];
                }
                WG_BAR();
            }
        }
        {
            LAS bf16* sTb = (LAS bf16*)sM; LAS bf16* sKgT = sQb;
            { const int t = tid >> 3, s8 = (tid & 7) * 8; float v[8];
#pragma unroll
                for (int jj = 0; jj < 8; ++jj) v[jj] = sT[t * TT + s8 + jj];
                *(LAS bf16x8*)(sTb + t * TS + s8) = pack8(v); }
            for (int p = tid; p < 1024; p += NTHR) { const int d = p >> 3, s8 = (p & 7) * 8; float v[8], u8[8]; const v4u vv = *(const LAS v4u*)(sVT + d * TS + s8);
#pragma unroll
                for (int jj = 0; jj < 8; ++jj) { const float be = sVec[64 + s8 + jj]; v[jj] = bf2f(sKb[(s8 + jj) * PS + d]) * be * sVec[128 + s8 + jj]; u8[jj] = ((jj & 1) ? bfhi(vv[jj >> 1]) : bflo(vv[jj >> 1])) * be; }
                *(LAS bf16x8*)(sKgT + d * TS + s8) = pack8(v); *(LAS bf16x8*)(sVT + d * TS + s8) = pack8(u8); }
        }
        __syncthreads();
        {
            const LAS bf16* sTb = (const LAS bf16*)sM; const LAS bf16* sKgT = sQb; LAS bf16* sW = (LAS bf16*)((LAS unsigned char*)sM + 9216);
            const int st_ = w >> 1;
            const bf16x8 t0 = lds_frag(sTb, 16 * st_, TS, 0, lane), t1 = lds_frag(sTb, 16 * st_, TS, 32, lane);
#pragma unroll
            for (int c4_ = 0; c4_ < 4; ++c4_) { const int ct = (w & 1) * 4 + c4_;
                f32x4 aw = {0.f, 0.f, 0.f, 0.f}, au = {0.f, 0.f, 0.f, 0.f};
                aw = mfma16(lds_frag(sKgT, 16 * ct, TS, 0, lane), t0, aw); aw = mfma16(lds_frag(sKgT, 16 * ct, TS, 32, lane), t1, aw);
                au = mfma16(t0, lds_frag(sVT, 16 * ct, TS, 0, lane), au); au = mfma16(t1, lds_frag(sVT, 16 * ct, TS, 32, lane), au);
                *(LAS unsigned long long*)(sW + (16 * st_ + r) * PS + 16 * ct + 4 * q4) = pack4(aw);
                *(GAS unsigned long long*)(GUT + (ct * 4 + st_) * 256 + lane * 4) = pack4(au); }
        }
        __syncthreads();
        { const LAS bf16* sW = (const LAS bf16*)((LAS unsigned char*)sM + 9216);
            for (int f = w; f < 16; f += NWAVES) { const int tile = f >> 2, ks = f & 3;
                *(GAS v4u*)(GW + f * 512 + lane * 8) = *(const LAS v4u*)(sW + (16 * tile + r) * PS + 32 * ks + 8 * q4); } }
    }
#undef GW
#undef GKT
#undef GQG
#undef GUT
#undef GT
#undef GQK
#undef GVEC
}
__device__ __forceinline__ void gdn_scan_phase(CArgs a, int l, LAS unsigned char* lds, const int b, const int head, const int eb, int tid) {
    asm volatile("" : "+v"(tid));
    constexpr int PS = 136, TS = 72, O_ST = 0, O_RT = 34816, O_VN = O_RT + 9216, O_VC = O_VN + 9216;
    bf16* YMIX = (bf16*)(a->ws + WS_YMIX);
    const int lane = tid & 63, w = tid >> 6, r = lane & 15, q4 = lane >> 4, st = w >> 1, eh = w & 1;
    LAS bf16* sRT = (LAS bf16*)(lds + O_RT); LAS bf16* sVN = (LAS bf16*)(lds + O_VN); LAS bf16* sVC = (LAS bf16*)(lds + O_VC);
    {
        const size_t u0 = (size_t)(b * 4 + head) * 64;
        const bf16* pW = (const bf16*)(a->ws + WS_GD_K) + u0 * 8192 + (st * 4) * 512 + lane * 8; const bf16* pQG = (const bf16*)(a->ws + WS_GD_QG) + u0 * 8192 + (st * 4) * 512 + lane * 8;
        const bf16* pQK = (const bf16*)(a->ws + WS_GD_QK) + u0 * 4096 + (st * 2) * 512 + lane * 8;
        const bf16* pKT = (const bf16*)(a->ws + WS_GD_KT) + u0 * 8192 + (w * 2) * 512 + lane * 8;
        const bf16* pUT = (const bf16*)(a->ws + WS_GD_VT) + u0 * 8192 + (size_t)(((eb * 4 + 2 * eh) * 4 + st) * 256) + lane * 4;
        const float* pVec = (const float*)(a->ws + WS_GD_VEC) + u0 * 256 + 16 * st + 4 * q4;
        v4u xW[4], yQG[4], yQK[2], xKT[2], nQG[4], nQK[2]; unsigned long long uT[2]; f32x4 c4; float gl;
#define GD_LD_A(nn) do { _Pragma("unroll") for (int ks = 0; ks < 4; ++ks) xW[ks] = *(const GAS v4u*)(pW + (size_t)(nn) * 8192 + 512 * ks); \
            _Pragma("unroll") for (int j = 0; j < 2; ++j) uT[j] = *(const GAS unsigned long long*)(pUT + (size_t)(nn) * 8192 + j * 1024); \
            c4 = *(const GAS f32x4*)(pVec + (size_t)(nn) * 256 + 128); } while (0)
#define GD_LD_C(nn, QG_, QK_) do { _Pragma("unroll") for (int ks = 0; ks < 4; ++ks) QG_[ks] = *(const GAS v4u*)(pQG + (size_t)(nn) * 8192 + 512 * ks); \
            _Pragma("unroll") for (int ks = 0; ks < 2; ++ks) QK_[ks] = *(const GAS v4u*)(pQK + (size_t)(nn) * 4096 + 512 * ks); } while (0)
#define GD_LD_D(nn) do { _Pragma("unroll") for (int ks = 0; ks < 2; ++ks) xKT[ks] = *(const GAS v4u*)(pKT + (size_t)(nn) * 8192 + 512 * ks); gl = pVec[(size_t)(nn) * 256 + 192 - (16 * st + 4 * q4)]; } while (0)
        __syncthreads();
        GD_LD_A(0); GD_LD_C(0, yQG, yQK); GD_LD_D(0);
        for (int i = tid; i < 17408 / 4; i += NTHR) ((LAS unsigned*)(lds + O_ST))[i] = 0u;
        f32x4 accS[4];
#pragma unroll
        for (int et = 0; et < 4; ++et) accS[et] = (f32x4){0.f, 0.f, 0.f, 0.f};
        __syncthreads();
        for (int n = 0; n < 64; ++n) {
            const int cur = n & 1; const LAS bf16* sST = (const LAS bf16*)(lds + O_ST + cur * 17408); LAS bf16* sSTn = (LAS bf16*)(lds + O_ST + (cur ^ 1) * 17408);
            const int nn = n + 1 < 64 ? n + 1 : n;
            {
                bf16x8 fs[2][4];
#pragma unroll
                for (int j = 0; j < 2; ++j)
#pragma unroll
                    for (int ks = 0; ks < 4; ++ks) fs[j][ks] = lds_frag(sST, 16 * (2 * eh + j), PS, 32 * ks, lane);
                __builtin_amdgcn_sched_barrier(0);
#pragma unroll
                for (int j = 0; j < 2; ++j) { const int e0 = 16 * (2 * eh + j); f32x4 acc = {0.f, 0.f, 0.f, 0.f};
#pragma unroll
                    for (int ks = 0; ks < 4; ++ks) acc = mfma16(__builtin_bit_cast(bf16x8, xW[ks]), fs[j][ks], acc);
                    const unsigned ulo = (unsigned)uT[j], uhi = (unsigned)(uT[j] >> 32); f32x4 vn;
                    vn[0] = bflo(ulo) - acc[0]; vn[1] = bfhi(ulo) - acc[1]; vn[2] = bflo(uhi) - acc[2]; vn[3] = bfhi(uhi) - acc[3];
                    *(LAS unsigned long long*)(sVN + (e0 + r) * TS + 16 * st + 4 * q4) = pack4(vn); *(LAS unsigned long long*)(sVC + (e0 + r) * TS + 16 * st + 4 * q4) = pack4(vn * c4); }
            }
            GD_LD_A(nn); GD_LD_C(nn, nQG, nQK);
            WG_BAR();
            {
                bf16x8 fv[4][2];
#pragma unroll
                for (int et = 0; et < 4; ++et)
#pragma unroll
                    for (int ks = 0; ks < 2; ++ks) fv[et][ks] = lds_frag(sVC, 16 * et, TS, 32 * ks, lane);
                __builtin_amdgcn_sched_barrier(0);
#pragma unroll
                for (int et = 0; et < 4; ++et) { accS[et] = accS[et] * gl;
#pragma unroll
                    for (int ks = 0; ks < 2; ++ks) accS[et] = mfma16(__builtin_bit_cast(bf16x8, xKT[ks]), fv[et][ks], accS[et]);
                    *(LAS unsigned long long*)(sSTn + (16 * et + r) * PS + 16 * w + 4 * q4) = pack4(accS[et]); }
            }
            GD_LD_D(nn);
            {
                bf16x8 fs[2][4], fn[2][2];
#pragma unroll
                for (int j = 0; j < 2; ++j) {
#pragma unroll
                    for (int ks = 0; ks < 4; ++ks) fs[j][ks] = lds_frag(sST, 16 * (2 * eh + j), PS, 32 * ks, lane);
#pragma unroll
                    for (int ks = 0; ks < 2; ++ks) fn[j][ks] = lds_frag(sVN, 16 * (2 * eh + j), TS, 32 * ks, lane); }
                __builtin_amdgcn_sched_barrier(0);
#pragma unroll
                for (int j = 0; j < 2; ++j) { const int e0 = 16 * (2 * eh + j); f32x4 acc = {0.f, 0.f, 0.f, 0.f};
#pragma unroll
                    for (int ks = 0; ks < 4; ++ks) acc = mfma16(fs[j][ks], __builtin_bit_cast(bf16x8, yQG[ks]), acc);
#pragma unroll
                    for (int ks = 0; ks < 2; ++ks) acc = mfma16(fn[j][ks], __builtin_bit_cast(bf16x8, yQK[ks]), acc);
                    *(GAS unsigned long long*)(YMIX + ((size_t)b * SEQ + n * 64 + 16 * st + r) * DMIX + 1024 + head * 128 + eb * 64 + e0 + 4 * q4) = pack4(acc); }
            }
#pragma unroll
            for (int ks = 0; ks < 4; ++ks) yQG[ks] = nQG[ks];
#pragma unroll
            for (int ks = 0; ks < 2; ++ks) yQK[ks] = nQK[ks];
            WG_BAR();
        }
#undef GD_LD_A
#undef GD_LD_C
#undef GD_LD_D
    }
}

__device__ __forceinline__ void gdn_rec_phase(CArgs a, int l, LAS unsigned char* lds, int wg, int G, int tid) {
    asm volatile("" : "+v"(tid));
    constexpr int TB = 32;
    LAS float* sQ = (LAS float*)lds; LAS float* sK = sQ + TB * 128; LAS float* sV = sK + TB * 128; LAS float* sBe = sV + TB * 8; LAS float* sAl = sBe + TB; LAS float* sO = sAl + TB;
    const bf16* PROJ = (const bf16*)(a->ws + WS_PROJ); bf16* YMIX = (bf16*)(a->ws + WS_YMIX);
    const float* cw = a->in[I_GCW] + (size_t)l * 4 * 1536;
    const int lane = tid & 63, w = tid >> 6;
    for (int unit = wg; unit < 256; unit += G) {
        const int b = unit >> 6, head = (unit >> 4) & 3, eb = unit & 15;
        const float nA = -__expf(a->in[I_GALOG][l * 4 + head]), dtb = a->in[I_GDTB][l * 4 + head];
        float S0 = 0.f, S1 = 0.f;
        for (int t0 = 0; t0 < SEQ; t0 += TB) {
            __syncthreads();
            for (int idx = tid; idx < TB * 264; idx += NTHR) {
                const int tt = idx / 264, ci = idx % 264, t = t0 + tt;
                const int ch = ci < 128 ? head * 128 + ci : (ci < 256 ? 512 + head * 128 + (ci - 128) : 1024 + head * 128 + eb * 8 + (ci - 256));
                float acc = 0.f;
#pragma unroll
                for (int k = 0; k < 4; ++k) { const int ts = t - 3 + k; if (ts >= 0) acc += cw[k * 1536 + ch] * bf2f(PROJ[(size_t)(b * SEQ + ts) * NPROJ + O_QKV + ch]); }
                const float v = siluf(acc);
                if (ci < 128) sQ[tt * 128 + ci] = v; else if (ci < 256) sK[tt * 128 + ci - 128] = v; else sV[tt * 8 + ci - 256] = v;
            }
            if (tid < TB) { const size_t ro = (size_t)(b * SEQ + t0 + tid) * NPROJ; const float braw = bf2f(PROJ[ro + O_GB + head]), araw = bf2f(PROJ[ro + O_GA + head]);
                sBe[tid] = sigmoidf_(braw); sAl[tid] = __expf(nA * softplusf_(araw + dtb)); }
            __syncthreads();
            for (int tt = w; tt < TB; tt += NWAVES) {
                const float q0 = sQ[tt * 128 + lane], q1 = sQ[tt * 128 + 64 + lane], k0 = sK[tt * 128 + lane], k1 = sK[tt * 128 + 64 + lane];
                const float sq = rsqrtf(wave_sum(q0 * q0 + q1 * q1) + 1e-6f) * 0.08838834764831845f, sk = rsqrtf(wave_sum(k0 * k0 + k1 * k1) + 1e-6f);
                sQ[tt * 128 + lane] = q0 * sq; sQ[tt * 128 + 64 + lane] = q1 * sq; sK[tt * 128 + lane] = k0 * sk; sK[tt * 128 + 64 + lane] = k1 * sk;
            }
            __syncthreads();
#pragma unroll 2
            for (int tt = 0; tt < TB; ++tt) {
                const float k0 = sK[tt * 128 + lane], k1 = sK[tt * 128 + 64 + lane], q0 = sQ[tt * 128 + lane], q1 = sQ[tt * 128 + 64 + lane];
                const float al = sAl[tt], be = sBe[tt], v = sV[tt * 8 + w];
                const float dot = wave_sum(k0 * S0 + k1 * S1);
                const float vn = be * (v - al * dot);
                S0 = al * S0 + k0 * vn; S1 = al * S1 + k1 * vn;
                const float od = wave_sum(q0 * S0 + q1 * S1);
                if (lane == 0) sO[tt * 8 + w] = od;
            }
            __syncthreads();
            if (tid < TB * 8) { const int tt = tid >> 3, i = tid & 7; YMIX[(size_t)(b * SEQ + t0 + tt) * DMIX + 1024 + head * 128 + eb * 8 + i] = (bf16)f2bf(sO[tid]); }
        }
    }
}

__device__ __forceinline__ void hgrn_rec_phase(CArgs a, int l, LAS unsigned char* lds, int wg, int G, int tid) {
    asm volatile("" : "+v"(tid));
    constexpr int TB = 32;
    LAS float* sQ = (LAS float*)lds; LAS float* sF = sQ + TB * 128; LAS float* sV = sF + TB * 128; LAS float* sO = sV + TB * 8; LAS float* sLb = sO + TB * 8;
    const bf16* PROJ = (const bf16*)(a->ws + WS_PROJ); bf16* YMIX = (bf16*)(a->ws + WS_YMIX);
    const int lane = tid & 63, w = tid >> 6;
    for (int unit = wg; unit < 256; unit += G) {
        const int b = unit >> 6, head = (unit >> 4) & 3, eb = unit & 15;
        __syncthreads();
        if (tid < 128) {
            const int c = head * 128 + tid; float lg[DEPTH], mx = -1e30f;
#pragma unroll
            for (int j = 0; j < DEPTH; ++j) { lg[j] = a->in[I_HLB][j * 512 + c]; mx = fmaxf(mx, lg[j]); }
            float den = 0.f, num = 0.f;
#pragma unroll
            for (int j = 0; j < DEPTH; ++j) { const float e = __expf(lg[j] - mx); den += e; if (j >= 1 && j <= l) num += e; }
            sLb[tid] = num / den;
        }
        float S0 = 0.f, S1 = 0.f;
        for (int t0 = 0; t0 < SEQ; t0 += TB) {
            __syncthreads();
            for (int idx = tid; idx < TB * 264; idx += NTHR) {
                const int tt = idx / 264, ci = idx % 264; const size_t ro = (size_t)(b * SEQ + t0 + tt) * NPROJ;
                if (ci < 128) sQ[tt * 128 + ci] = siluf(bf2f(PROJ[ro + O_HQ + head * 128 + ci]));
                else if (ci < 256) { const int d = ci - 128; const float lb = sLb[d]; sF[tt * 128 + d] = lb + (1.f - lb) * sigmoidf_(bf2f(PROJ[ro + O_HF + head * 128 + d])); }
                else sV[tt * 8 + ci - 256] = bf2f(PROJ[ro + O_HI + head * 128 + eb * 8 + (ci - 256)]);
            }
            __syncthreads();
#pragma unroll 2
            for (int tt = 0; tt < TB; ++tt) {
                const float f0 = sF[tt * 128 + lane], f1 = sF[tt * 128 + 64 + lane], q0 = sQ[tt * 128 + lane], q1 = sQ[tt * 128 + 64 + lane], v = sV[tt * 8 + w];
                S0 = f0 * S0 + (1.f - f0) * v; S1 = f1 * S1 + (1.f - f1) * v;
                const float od = wave_sum(q0 * S0 + q1 * S1);
                if (lane == 0) sO[tt * 8 + w] = od;
            }
            __syncthreads();
            if (tid < TB * 8) { const int tt = tid >> 3, i = tid & 7; YMIX[(size_t)(b * SEQ + t0 + tt) * DMIX + 1536 + head * 128 + eb * 8 + i] = (bf16)f2bf(sO[tid]); }
        }
    }
}

__device__ __forceinline__ void mix_post_phase(CArgs a, int l, int wg, int G, int tid) {
    asm volatile("" : "+v"(tid));
    const bf16* PROJ = (const bf16*)(a->ws + WS_PROJ); bf16* YMIX = (bf16*)(a->ws + WS_YMIX);
    const int lane = tid & 63, gw = wg * NWAVES + (tid >> 6), NGW = G * NWAVES;
    const float* snw = a->in[I_SNW] + l * 1024; const float* gnw = a->in[I_GNW] + l * 128; const float* hnw = a->in[I_HNW] + l * 128;
    for (int row = gw; row < M; row += NGW) {
        const bf16* pr = PROJ + (size_t)row * NPROJ; bf16* yr = YMIX + (size_t)row * DMIX;
#pragma unroll
        for (int j = 0; j < 2; ++j) {
            const int ch = j * 512 + lane * 8; const v4u yv = *(const GAS v4u*)(yr + ch), zv = *(const GAS v4u*)(pr + O_Z + ch);
            float v[8]; float ss = 0.f;
#pragma unroll
            for (int i = 0; i < 4; ++i) { v[2 * i] = bflo(yv[i]) * siluf(bflo(zv[i])); v[2 * i + 1] = bfhi(yv[i]) * siluf(bfhi(zv[i])); ss += v[2 * i] * v[2 * i] + v[2 * i + 1] * v[2 * i + 1]; }
            const float rstd = rsqrtf(wave_sum(ss) * (1.f / 512.f) + 1e-6f);
            v4u o;
#pragma unroll
            for (int i = 0; i < 4; ++i) o[i] = pk2(v[2 * i] * rstd * snw[ch + 2 * i], v[2 * i + 1] * rstd * snw[ch + 2 * i + 1]);
            *(GAS v4u*)(yr + ch) = o;
        }
#pragma unroll
        for (int part = 0; part < 2; ++part) {
            const int ch = lane * 8, yo = 1024 + part * 512 + ch, go = (part == 0 ? O_GG : O_HG) + ch; const float* nw = part == 0 ? gnw : hnw;
            const v4u yv = *(const GAS v4u*)(yr + yo), gv = *(const GAS v4u*)(pr + go);
            float v[8]; float ss = 0.f;
#pragma unroll
            for (int i = 0; i < 4; ++i) { v[2 * i] = bflo(yv[i]); v[2 * i + 1] = bfhi(yv[i]); ss += v[2 * i] * v[2 * i] + v[2 * i + 1] * v[2 * i + 1]; }
            ss = row16_sum(ss);
            const float rstd = rsqrtf(ss * (1.f / 128.f) + 1e-6f);
            v4u o;
#pragma unroll
            for (int i = 0; i < 4; ++i) { const int c = (ch & 127) + 2 * i; o[i] = pk2(v[2 * i] * rstd * nw[c] * siluf(bflo(gv[i])), v[2 * i + 1] * rstd * nw[c + 1] * siluf(bfhi(gv[i]))); }
            *(GAS v4u*)(yr + yo) = o;
        }
    }
}

__device__ __forceinline__ void moe_tables(const gu32* cnt, LAS unsigned char* lds, int tid) {
    LAS int* tab = (LAS int*)(lds + LDS_OFF_TAB);
    __syncthreads();
    if (tid == 0) { int p = 0, q = 0;
        for (int e = 0; e < 16; ++e) { const int c = (int)__hip_atomic_load(cnt + e, RLX_AGENT); tab[e] = p; tab[17 + e] = q; p += (c + 255) & ~255; q += c; }
        tab[16] = p; tab[33] = q; }
    __syncthreads();
}
template <bool ROUTER>
__device__ __forceinline__ void ln_phase(CArgs a, int l, const float* gam, const float* bet, LAS unsigned char* lds, int wg, int G, int tid) {
    asm volatile("" : "+v"(tid));
    const int lane = tid & 63, wave = tid >> 6, gw = wg * NWAVES + wave, NGW = G * NWAVES;
    const bf16* ADD = (const bf16*)(a->ws + WS_MIX); float* H = a->out; bf16* HB = (bf16*)(a->ws + WS_HB);
    gu32* cnt = (gu32*)(a->ws + WS_CTL) + CW_CNT + l * 16;
    LAS float* sW = (LAS float*)lds;
    LAS float* sL = sW + 20 * D + wave * 32;
    LAS int* sCnt = (LAS int*)(sW + 20 * D + 256);
    LAS unsigned* sEnt = (LAS unsigned*)(sCnt + 32);
    constexpr int MAXENT = 2 * NWAVES * 8;
    if (ROUTER) {
        __syncthreads();
        const float* wrg = a->in[I_WRG] + (size_t)l * D * 4; const float* wre = a->in[I_WRE] + (size_t)l * D * 16;
        for (int i = tid; i < D * 20; i += NTHR) { const int c = i >> 10, k = i & 1023; sW[i] = c < 4 ? wrg[k * 4 + c] : wre[k * 16 + c - 4]; }
        if (tid < 32) sCnt[tid] = 0;
        __syncthreads();
    } else moe_tables(cnt, lds, tid);
    const LAS int* tab = (const LAS int*)(lds + LDS_OFF_TAB);
    f32x4 gv[4], bv[4];
#pragma unroll
    for (int j = 0; j < 4; ++j) { gv[j] = *(const f32x4*)(gam + 4 * lane + 256 * j); bv[j] = *(const f32x4*)(bet + 4 * lane + 256 * j); }
    int kk = 0;
    f32x4 ph[4]; unsigned long long pa[4];
    const float* Hin = (ROUTER && l == 0) ? a->in[I_X] : H;
    if (ROUTER && gw < M) {
#pragma unroll
        for (int j = 0; j < 4; ++j) { ph[j] = *(const GAS f32x4*)(Hin + (size_t)gw * D + 4 * lane + 256 * j); pa[j] = *(const GAS unsigned long long*)(ADD + (size_t)gw * D + 4 * lane + 256 * j); } }
    for (int row = gw; row < M; row += NGW, ++kk) {
        f32x4 v[4]; float s = 0.f;
        if (ROUTER) {
#pragma unroll
            for (int j = 0; j < 4; ++j) { const f32x4 av = {bflo((unsigned)pa[j]), bfhi((unsigned)pa[j]), bflo((unsigned)(pa[j] >> 32)), bfhi((unsigned)(pa[j] >> 32))}; v[j] = ph[j] * DN_ALPHA + av; s += (v[j].x + v[j].y) + (v[j].z + v[j].w); }
            const int nrow = row + NGW < M ? row + NGW : row;
#pragma unroll
            for (int j = 0; j < 4; ++j) { ph[j] = *(const GAS f32x4*)(Hin + (size_t)nrow * D + 4 * lane + 256 * j); pa[j] = *(const GAS unsigned long long*)(ADD + (size_t)nrow * D + 4 * lane + 256 * j); }
        } else {
            const unsigned s0 = ((const GAS unsigned*)(a->ws + WS_SLOT))[2 * row], s1 = ((const GAS unsigned*)(a->ws + WS_SLOT))[2 * row + 1];
            const bf16* y0 = (const bf16*)(a->ws + WS_YS) + (size_t)(tab[s0 >> 16] + (int)(s0 & 0xffffu)) * D; const bf16* y1 = (const bf16*)(a->ws + WS_YS) + (size_t)(tab[s1 >> 16] + (int)(s1 & 0xffffu)) * D;
#pragma unroll
            for (int j = 0; j < 4; ++j) { const f32x4 hv = *(const GAS f32x4*)(H + (size_t)row * D + 4 * lane + 256 * j);
                const unsigned long long p0 = *(const GAS unsigned long long*)(y0 + 4 * lane + 256 * j), p1 = *(const GAS unsigned long long*)(y1 + 4 * lane + 256 * j);
                f32x4 av; av.x = bflo((unsigned)p0) + bflo((unsigned)p1); av.y = bfhi((unsigned)p0) + bfhi((unsigned)p1); av.z = bflo((unsigned)(p0 >> 32)) + bflo((unsigned)(p1 >> 32)); av.w = bfhi((unsigned)(p0 >> 32)) + bfhi((unsigned)(p1 >> 32));
                v[j] = hv * DN_ALPHA + av; s += (v[j].x + v[j].y) + (v[j].z + v[j].w); }
        }
        const float mean = wave_sum(s) * (1.f / D); float s2 = 0.f;
#pragma unroll
        for (int j = 0; j < 4; ++j) { v[j] = v[j] - mean; s2 += (v[j].x * v[j].x + v[j].y * v[j].y) + (v[j].z * v[j].z + v[j].w * v[j].w); }
        const float rstd = rsqrtf(wave_sum(s2) * (1.f / D) + LN_EPS);
#pragma unroll
        for (int j = 0; j < 4; ++j) { v[j] = v[j] * rstd * gv[j] + bv[j];
            *(GAS f32x4*)(H + (size_t)row * D + 4 * lane + 256 * j) = v[j];
            *(GAS unsigned long long*)(HB + (size_t)row * D + 4 * lane + 256 * j) = (unsigned long long)pk2(v[j].x, v[j].y) | ((unsigned long long)pk2(v[j].z, v[j].w) << 32); }
        if (ROUTER) {
            float lg[20];
#pragma unroll 1
            for (int c = 0; c < 20; ++c) { float p = 0.f;
#pragma unroll
                for (int j = 0; j < 4; ++j) { const f32x4 wv = *(const LAS f32x4*)(sW + c * D + 4 * lane + 256 * j); p += (v[j].x * wv.x + v[j].y * wv.y) + (v[j].z * wv.z + v[j].w * wv.w); }
                p = wave_sum(p); if (lane == 0) sL[c] = p; }
#pragma unroll
            for (int c = 0; c < 20; ++c) lg[c] = sL[c];
            float pg[4], mx = -1e30f; int gi = 0;
#pragma unroll
            for (int c = 0; c < 4; ++c) { pg[c] = lg[c] + a->in[I_BRG][l * 4 + c]; if (pg[c] > mx) { mx = pg[c]; gi = c; } }
            float den = 0.f;
#pragma unroll
            for (int c = 0; c < 4; ++c) den += __expf(pg[c] - mx);
            const float g_p = 1.0f / den;
            float le[4], emx = -1e30f; int i1 = 0;
#pragma unroll
            for (int c = 0; c < 4; ++c) { float x = 0.f;
#pragma unroll
                for (int gg = 0; gg < 4; ++gg) x = (gi == gg) ? lg[4 + gg * 4 + c] + a->in[I_BRE][l * 16 + gg * 4 + c] : x;
                le[c] = x; if (x > emx) { emx = x; i1 = c; } }
            float e2mx = -1e30f; int i2 = 0;
#pragma unroll
            for (int c = 0; c < 4; ++c) if (c != i1 && le[c] > e2mx) { e2mx = le[c]; i2 = c; }
            const float x2 = __expf(e2mx - emx), w1 = g_p / (1.0f + x2), w2 = g_p * x2 / (1.0f + x2);
            if (lane < 2) {
                const int e = gi * 4 + (lane == 0 ? i1 : i2); const float wv = lane == 0 ? w1 : w2;
                if (kk < 8) { const int lp = __hip_atomic_fetch_add(sCnt + e, 1, __ATOMIC_RELAXED, __HIP_MEMORY_SCOPE_WORKGROUP); LAS unsigned* en = sEnt + ((wave * 8 + kk) * 2 + lane) * 4;
                    en[0] = (unsigned)row; en[1] = (unsigned)e; en[2] = (unsigned)lp; en[3] = __builtin_bit_cast(unsigned, wv); }
                else { const int pos = (int)__hip_atomic_fetch_add(cnt + e, 1u, RLX_AGENT);
                    ((GAS int*)(a->ws + WS_LTOK))[e * M + pos] = row; ((GAS float*)(a->ws + WS_LW))[e * M + pos] = wv; ((GAS unsigned*)(a->ws + WS_SLOT))[2 * row + lane] = ((unsigned)e << 16) | (unsigned)pos; }
            }
        }
    }
    if (ROUTER) {
        __syncthreads();
        if (tid < 16) sCnt[16 + tid] = (int)__hip_atomic_fetch_add(cnt + tid, (unsigned)sCnt[tid], RLX_AGENT);
        __syncthreads();
        const int nk = kk < 8 ? kk : 8;
        if (tid < MAXENT) { const int wv_ = tid >> 4, k_ = (tid >> 1) & 7;
            int nkw = 0;
#pragma unroll
            for (int k2 = 0; k2 < 8; ++k2) nkw += (wg * NWAVES + wv_ + k2 * NGW < M) ? 1 : 0;
            if (k_ < nkw) { const LAS unsigned* en = sEnt + tid * 4; const int e = (int)en[1], pos = sCnt[16 + e] + (int)en[2];
                ((GAS int*)(a->ws + WS_LTOK))[e * M + pos] = (int)en[0]; ((GAS unsigned*)(a->ws + WS_LW))[e * M + pos] = en[3]; ((GAS unsigned*)(a->ws + WS_SLOT))[2 * en[0] + (tid & 1)] = ((unsigned)e << 16) | (unsigned)pos; } }
        (void)nk;
    }
}
__device__ __forceinline__ void moe_gather_phase(CArgs a, int l, LAS unsigned char* lds, int wg, int G, int tid) {
    asm volatile("" : "+v"(tid));
    const int lane = tid & 63, gw = wg * NWAVES + (tid >> 6), NGW = G * NWAVES;
    moe_tables((gu32*)(a->ws + WS_CTL) + CW_CNT + l * 16, lds, tid);
    const LAS int* tab = (const LAS int*)(lds + LDS_OFF_TAB);
    const bf16* HB = (const bf16*)(a->ws + WS_HB); bf16* XS = (bf16*)(a->ws + WS_XS);
    for (int idx = gw; idx < 2 * M; idx += NGW) {
        int e = 0;
#pragma unroll
        for (int k = 1; k < 16; ++k) e += (tab[17 + k] <= idx) ? 1 : 0;
        const int pos = idx - tab[17 + e], dst = tab[e] + pos;
        const int row = ((const GAS int*)(a->ws + WS_LTOK))[e * M + pos];
        const v4u x0 = *(const GAS v4u*)(HB + (size_t)row * D + 8 * lane), x1 = *(const GAS v4u*)(HB + (size_t)row * D + 512 + 8 * lane);
        *(GAS v4u*)(XS + (size_t)dst * D + 8 * lane) = x0; *(GAS v4u*)(XS + (size_t)dst * D + 512 + 8 * lane) = x1;
        if (lane == 0) ((GAS float*)(a->ws + WS_WSORT))[dst] = ((const GAS float*)(a->ws + WS_LW))[e * M + pos];
    }
}

enum { P_IN = 0, P_PREP, P_SCAN, P_POST, P_OUT, P_LN1, P_GU, P_DN, P_LN2, NPH };
constexpr int N_PHASES = 1 + DEPTH * NPH;
__global__ void __launch_bounds__(NTHR, 2) fwd(Args args) {
    extern __shared__ __attribute__((aligned(16))) unsigned char lds_raw[];
    LAS unsigned char* lds = (LAS unsigned char*)lds_raw;
    volatile LAS unsigned* MISC = (volatile LAS unsigned*)(lds + MISC_OFF);
    const int tid = threadIdx.x, G = gridDim.x, bx = blockIdx.x;
    unsigned char* ws0 = args.ws;
    gu32* ctl = (gu32*)(ws0 + WS_CTL);
    for (int u = tid; u < (LDS_BYTES - LDSCTL_OFF) / 4; u += NTHR) ((LAS unsigned*)(lds + LDSCTL_OFF))[u] = 0u;
    __syncthreads();
    const int lo = args.ph_lo, hi = args.ph_hi;
    const bool use_bar = (hi - lo) > 1;
    XcdBarrier bar; bar.bar = (unsigned*)(ctl + CW_BAR); bar.x = 0; bar.st = nullptr;
    if (use_bar) bar = xcd_barrier_post((unsigned*)(ctl + CW_BAR), MISC + 8);
#define IN(k) (lo <= (k) && (k) < hi)
#define SEAM(k) do { if (IN(k) && IN((k) + 1)) xcd_barrier(bar); } while (0)

    if (IN(0)) { p0_prologue(ARGS_HERE(), lds, bx, G, tid); weights_phase(ARGS_HERE(), 0, 1, lds, bx, G, tid); SEAM(0); }

    for (int l = 0; l < DEPTH; ++l) {
        const int base = 1 + l * NPH;
        unsigned char* ws = ws0; asm volatile("" : "+s"(ws));
        if (IN(base + P_IN)) {
            pg8::Gemm g{(const pg8::bf16_t*)(ws + WS_HB), (const pg8::bf16_t*)(ws + WS_WIN), M, NPROJ, D}; pg8::StaticOrder S; S.init(M, NPROJ, G, bx);
            pg8::EpiBf16<0> E{(pg8::bf16_t*)(ws + WS_PROJ), NPROJ, nullptr, 0, 0, 1.f};
            pg8::gemm_phase<pg8::EpiBf16<0>, pg8::StaticOrder, true, true>(lds + RING_OFF, g, S, E);
            SEAM(base + P_IN);
        }
        if (IN(base + P_PREP)) {
            hgrn_prep_phase(ARGS_HERE(), l, lds, bx, G, tid);
            ssd_prep_phase(ARGS_HERE(), l, lds, bx, G, tid);
            gdn_prep_phase(ARGS_HERE(), l, lds, bx, G, tid);
            SEAM(base + P_PREP); }
        if (IN(base + P_SCAN)) {
            if (G >= 192) {
                if (bx < 64) { const int pr = bx & 7, hh = bx >> 3; ssd_scan_phase(ARGS_HERE(), l, lds, pr >> 1, (pr & 1) * 8 + hh, tid); }
                else if (bx < 96) { const int x = (bx - 64) & 7, y = (bx - 64) >> 3, pr = x * 2 + (y >> 1); gdn_scan_phase(ARGS_HERE(), l, lds, pr >> 2, pr & 3, y & 1, tid); }
                else if (bx < 160) { const int x = (bx - 96) & 7, y = (bx - 96) >> 3, pr = x * 2 + (y >> 2); hgrn_scan_phase(ARGS_HERE(), l, lds, pr >> 2, pr & 3, y & 3, tid); }
                else { weights_phase(ARGS_HERE(), l, 14, lds, bx - 160, G - 160, tid);
                       if (l + 1 < DEPTH) weights_phase(ARGS_HERE(), l + 1, 1, lds, bx - 160, G - 160, tid); }
            }
            SEAM(base + P_SCAN); }
        if (IN(base + P_POST)) { mix_post_phase(ARGS_HERE(), l, bx, G, tid); SEAM(base + P_POST); }
        if (IN(base + P_OUT)) {
            pg8::Gemm g{(const pg8::bf16_t*)(ws + WS_YMIX), (const pg8::bf16_t*)(ws + WS_WOUT), M, D, DMIX}; pg8::StaticOrder S; S.init(M, D, G, bx);
            pg8::EpiBf16<0> E{(pg8::bf16_t*)(ws + WS_MIX), D, nullptr, 0, 0, 1.f};
            pg8::gemm_phase<pg8::EpiBf16<0>, pg8::StaticOrder, true, true>(lds + RING_OFF, g, S, E);
            SEAM(base + P_OUT);
        }
        if (IN(base + P_LN1)) { CArgs a_ = ARGS_HERE(); ln_phase<true>(a_, l, a_->in[I_LN1G] + l * D, a_->in[I_LN1B] + l * D, lds, bx, G, tid); SEAM(base + P_LN1); }
        if (IN(base + P_GU)) {
            moe_tables(ctl + CW_CNT + l * 16, lds, tid);
            pg8::Gemm g{(const pg8::bf16_t*)(ws + WS_HB), (const pg8::bf16_t*)(ws + WS_WGU), MAXROWS, NGU, D}; pg8::MoeOrder<2, true> S{(const LAS int*)(lds + LDS_OFF_TAB), G, bx, (const int*)(ws + WS_LTOK), M};
            pg8::EpiSwiGLUs E{(pg8::bf16_t*)(ws + WS_HS), (const float*)(ws + WS_LW), M, (const LAS int*)(lds + LDS_OFF_TAB)};
            pg8::gemm_phase<pg8::EpiSwiGLUs, pg8::MoeOrder<2, true>, true, true>(lds + RING_OFF, g, S, E);
            SEAM(base + P_GU);
        }
        if (IN(base + P_DN)) {
            moe_tables(ctl + CW_CNT + l * 16, lds, tid);
            pg8::Gemm g{(const pg8::bf16_t*)(ws + WS_HS), (const pg8::bf16_t*)(ws + WS_WDN), MAXROWS, NEXP * D, DEXP}; pg8::MoeOrder<4> S{(const LAS int*)(lds + LDS_OFF_TAB), G, bx, nullptr, 0};
            pg8::EpiBf16s E{(pg8::bf16_t*)(ws + WS_YS)};
            pg8::gemm_phase<pg8::EpiBf16s, pg8::MoeOrder<4>, true, true>(lds + RING_OFF, g, S, E);
            SEAM(base + P_DN);
        }
        if (IN(base + P_LN2)) { CArgs a_ = ARGS_HERE(); ln_phase<false>(a_, l, a_->in[I_LN2G] + l * D, a_->in[I_LN2B] + l * D, lds, bx, G, tid); SEAM(base + P_LN2); }
    }
#undef IN
#undef SEAM
}

#ifndef MK_ONE_LAUNCH
#define MK_ONE_LAUNCH 1
#endif
extern "C" void kernel_launch(void* const* d_in, const int* in_sizes, int n_in, void* d_out, int out_size, void* d_ws, size_t ws_size, hipStream_t stream) {
    static int grid = 0;
    if (grid == 0) {
        if (n_in != 25 || out_size != M * D || ws_size < WS_END) { fprintf(stderr, "kernel_launch: unexpected shapes (n_in %d out %d ws %zu)\n", n_in, out_size, ws_size); grid = -1; return; }
        int dev = 0, cus = 0, per_cu = 0;
        if (hipGetDevice(&dev) != hipSuccess || hipDeviceGetAttribute(&cus, hipDeviceAttributeMultiprocessorCount, dev) != hipSuccess) { grid = -1; return; }
        if (hipFuncSetAttribute((const void*)fwd, hipFuncAttributeMaxDynamicSharedMemorySize, LDS_BYTES) != hipSuccess) { fprintf(stderr, "kernel_launch: hipFuncSetAttribute failed\n"); grid = -1; return; }
        if (hipOccupancyMaxActiveBlocksPerMultiprocessor(&per_cu, (const void*)fwd, NTHR, LDS_BYTES) != hipSuccess || per_cu < 1) { fprintf(stderr, "kernel_launch: occupancy query says %d\n", per_cu); (void)hipGetLastError(); grid = -1; return; }
        grid = cus;
    }
    if (grid < 0) return;
    if (hipMemsetAsync((char*)d_ws + WS_CTL, 0, CTL_ZERO_BYTES, stream) != hipSuccess) return;
    Args a{};
    for (int i = 0; i < 25; ++i) a.in[i] = (const float*)d_in[i];
    a.out = (float*)d_out; a.ws = (unsigned char*)d_ws;
#if MK_ONE_LAUNCH
    a.ph_lo = 0; a.ph_hi = N_PHASES;
    hipLaunchKernelGGL(fwd, dim3(grid), dim3(NTHR), LDS_BYTES, stream, a);
#else
    for (int p = 0; p < N_PHASES; ++p) { a.ph_lo = p; a.ph_hi = p + 1; hipLaunchKernelGGL(fwd, dim3(grid), dim3(NTHR), LDS_BYTES, stream, a); }
#endif
}
```
